# Optimizing an MI355X kernel written in HIP

```python
import math
import jax, jax.numpy as jnp
from jax import lax
import numpy as np

D_MODEL = 1024
BATCH = 16
SEQ = 2048
DEPTH = 4

ROPE_THETA = 10000.0
LN_EPS = 1e-5
Q_BLOCK = 128
M_HEADS = 4
M_DQK = 64
M_DV = 64
M_CHUNK = 64
CONV_WIDTH = 4
DF_HEADS = 4
DF_DQK = 64
DF_DV = 2 * DF_DQK
SA_HEADS = 4
SA_DH = 64
IDX_HEADS = 8
IDX_DIM = 64
INDEX_TOPK_MAX = 256
N_EXPERTS = 32
TOP_K = 4
D_FF = D_MODEL
SWIGLU_LIMIT = 7.0
SWIGLU_ALPHA = 1.702
DEEPNORM_ALPHA = (2 * DEPTH) ** 0.25
DEEPNORM_BETA = (8 * DEPTH) ** -0.25
N_MOD = 6

M_QK_W = M_HEADS * M_DQK
M_V_W = M_HEADS * M_DV
DF_QK_W = 2 * DF_HEADS * DF_DQK
DF_V_W = DF_HEADS * DF_DV
SA_W = SA_HEADS * SA_DH
IDX_Q_W = IDX_HEADS * IDX_DIM
IN_SPLITS = (M_QK_W, M_QK_W, M_V_W, M_HEADS, M_HEADS, M_V_W,
             DF_QK_W, DF_QK_W, DF_V_W,
             SA_W, SA_W, SA_W,
             IDX_Q_W, IDX_DIM, IDX_HEADS)
N_IN_COLS = sum(IN_SPLITS)
D_MIX = M_V_W + DF_V_W + SA_W

kernel_name = "hymba_style_mlstm_diffattn_dsa_moe_trunk"


def _split_columns(h):
    offs, acc = [], 0
    for w in IN_SPLITS[:-1]:
        acc += w
        offs.append(acc)
    return jnp.split(h, offs, axis=-1)


def layer_norm(x, g, b):
    xf = x.astype(jnp.float32)
    mu = xf.mean(-1, keepdims=True)
    var = jnp.square(xf - mu).mean(-1, keepdims=True)
    return ((xf - mu) * lax.rsqrt(var + LN_EPS)).astype(x.dtype) * g + b


def head_norm(h, g, center):
    hf = h.astype(jnp.float32)
    if center:
        hf = hf - hf.mean(-1, keepdims=True)
    hf = hf * lax.rsqrt(jnp.mean(jnp.square(hf), -1, keepdims=True) + LN_EPS)
    return (hf * g).astype(g.dtype)


def rope_tables(positions, dim):
    inv = ROPE_THETA ** (-jnp.arange(0, dim, 2, dtype=jnp.float32) / dim)
    ang = positions.astype(jnp.float32)[..., None] * inv
    return jnp.cos(ang)[:, :, None, :], jnp.sin(ang)[:, :, None, :]


def apply_rope(x, cos, sin):
    x1, x2 = jnp.split(x, 2, axis=-1)
    c = cos.astype(x.dtype)
    s = sin.astype(x.dtype)
    return jnp.concatenate([x1 * c - x2 * s, x2 * c + x1 * s], axis=-1)


def causal_conv(x, w, b):
    y = lax.conv_general_dilated(x, w[:, None, :], window_strides=(1,),
                                 padding=[(CONV_WIDTH - 1, 0)],
                                 dimension_numbers=("NWC", "WIO", "NWC"),
                                 feature_group_count=x.shape[-1])
    return y + b


def mlstm_chunkwise(q, k, v, i_pre, f_pre):
    B, S, H, dk = q.shape
    dv = v.shape[-1]
    nc = S // M_CHUNK
    f32 = jnp.float32

    def to_chunks(a):
        a = a.astype(f32).reshape(B, nc, M_CHUNK, H, *a.shape[3:])
        return jnp.moveaxis(a, (1, 3), (0, 2))

    qc = to_chunks(q) * dk ** -0.5
    kc = to_chunks(k)
    vc = to_chunks(v)
    ic = to_chunks(i_pre)
    lfc = to_chunks(jax.nn.log_sigmoid(f_pre.astype(f32)))
    causal = jnp.tril(jnp.ones((M_CHUNK, M_CHUNK), dtype=bool))

    def step(carry, xs):
        C, n, m = carry
        qi, ki, vi, ii, lf = xs
        bcum = jnp.cumsum(lf, axis=-1)
        logd = bcum[..., :, None] - bcum[..., None, :] + ii[..., None, :]
        logd = jnp.where(causal, logd, -jnp.inf)
        log_inter = bcum + m[..., None]
        m_t = jnp.maximum(log_inter, logd.max(-1))
        dmat = jnp.exp(logd - m_t[..., None])
        inter = jnp.exp(log_inter - m_t)
        s = jnp.einsum("bhtd,bhsd->bhts", qi, ki) * dmat
        num = jnp.einsum("bhts,bhsv->bhtv", s, vi) + inter[..., None] * jnp.einsum("bhtd,bhdv->bhtv", qi, C)
        den = s.sum(-1) + inter * jnp.einsum("bhtd,bhd->bht", qi, n)
        h = num / jnp.maximum(jnp.abs(den), jnp.exp(-m_t))[..., None]
        b_last = bcum[..., -1]
        log_w = b_last[..., None] - bcum + ii
        m_new = jnp.maximum(b_last + m, log_w.max(-1))
        w = jnp.exp(log_w - m_new[..., None])
        decay = jnp.exp(b_last + m - m_new)
        C_new = decay[..., None, None] * C + jnp.einsum("bhs,bhsd,bhsv->bhdv", w, ki, vi)
        n_new = decay[..., None] * n + jnp.einsum("bhs,bhsd->bhd", w, ki)
        return (C_new, n_new, m_new), h

    init = (jnp.zeros((B, H, dk, dv), f32), jnp.zeros((B, H, dk), f32), jnp.zeros((B, H), f32))
    _, hc = lax.scan(step, init, (qc, kc, vc, ic, lfc))
    return jnp.moveaxis(hc, (0, 2), (1, 3)).reshape(B, S, H, dv)


def diff_attention(q, k, v, lam):
    B, S, H2, d = q.shape
    H = H2 // 2
    dv = v.shape[-1]
    nb = S // Q_BLOCK
    qb = q.reshape(B, nb, Q_BLOCK, H2, d).swapaxes(0, 1)
    key_pos = jnp.arange(S)

    def block(args):
        qi, blk = args
        s = jnp.einsum("bqgd,bkgd->bgqk", qi, k).astype(jnp.float32) * d ** -0.5
        qpos = blk * Q_BLOCK + jnp.arange(Q_BLOCK)
        s = jnp.where(key_pos[None, :] <= qpos[:, None], s, -jnp.inf)
        p = jax.nn.softmax(s, axis=-1).reshape(B, H, 2, Q_BLOCK, S)
        a = p[:, :, 0] - lam * p[:, :, 1]
        return jnp.einsum("bhqk,bkhv->bqhv", a.astype(v.dtype), v)

    out = lax.map(block, (qb, jnp.arange(nb)))
    return out.swapaxes(0, 1).reshape(B, S, H, dv)


def dsa_attention(q, k, v, q_idx, k_idx, w_idx):
    B, S, H, d = q.shape
    topk = min(INDEX_TOPK_MAX, S // 4)
    nb = S // Q_BLOCK
    key_pos = jnp.arange(S)

    def to_blocks(a):
        return a.reshape(B, nb, Q_BLOCK, *a.shape[2:]).swapaxes(0, 1)

    gather = jax.vmap(lambda a, i: a[i])

    def block(args):
        qi, qxi, wi, blk = args
        qpos = blk * Q_BLOCK + jnp.arange(Q_BLOCK)
        logits = jnp.einsum("bqjd,bkd->bqjk", qxi, k_idx).astype(jnp.float32) * IDX_DIM ** -0.5
        score = jnp.einsum("bqj,bqjk->bqk", wi.astype(jnp.float32) * IDX_HEADS ** -0.5, jax.nn.relu(logits))
        score = jnp.where((key_pos[None, :] <= qpos[:, None])[None], score, -jnp.inf)
        _, idx = lax.top_k(score, topk)
        valid = idx <= qpos[None, :, None]
        flat = idx.reshape(B, Q_BLOCK * topk)
        k_sel = gather(k, flat).reshape(B, Q_BLOCK, topk, H, d)
        v_sel = gather(v, flat).reshape(B, Q_BLOCK, topk, H, d)
        s = jnp.einsum("bqhd,bqkhd->bqhk", qi, k_sel).astype(jnp.float32) * d ** -0.5
        s = jnp.where(valid[:, :, None, :], s, -jnp.inf)
        p = jax.nn.softmax(s, axis=-1)
        return jnp.einsum("bqhk,bqkhd->bqhd", p.astype(v.dtype), v_sel)

    out = lax.map(block, (to_blocks(q), to_blocks(q_idx), to_blocks(w_idx), jnp.arange(nb)))
    return out.swapaxes(0, 1).reshape(B, S, H, d)


def hybrid_mixer(u, cos, sin, layer, w_in, m_gate_bias, m_conv_w, m_conv_b, m_norm_g,
                 df_lambda, df_norm_g, idx_norm_g, idx_norm_b, w_out):
    B, S, _ = u.shape
    h = jnp.einsum("bsd,dc->bsc", u, w_in)
    (mq, mk, mv, mi, mf, mo, dq, dk, dv, sq, sk, sv, xq, xk, xw) = _split_columns(h)

    qk = jax.nn.silu(causal_conv(jnp.concatenate([mq, mk], axis=-1), m_conv_w, m_conv_b))
    mq, mk = jnp.split(qk, 2, axis=-1)
    i_pre = mi + m_gate_bias[:M_HEADS]
    f_pre = mf + m_gate_bias[M_HEADS:]
    hm = mlstm_chunkwise(mq.reshape(B, S, M_HEADS, M_DQK), mk.reshape(B, S, M_HEADS, M_DQK),
                         mv.reshape(B, S, M_HEADS, M_DV), i_pre, f_pre)
    hm = head_norm(hm, m_norm_g.reshape(M_HEADS, M_DV), True).reshape(B, S, M_V_W)
    hm = jax.nn.sigmoid(mo) * hm

    lam_init = 0.8 - 0.6 * math.exp(-0.3 * layer)
    lf = df_lambda.astype(jnp.float32)
    lam = jnp.exp(jnp.sum(lf[0] * lf[1])) - jnp.exp(jnp.sum(lf[2] * lf[3])) + lam_init
    dq = apply_rope(dq.reshape(B, S, 2 * DF_HEADS, DF_DQK), cos, sin)
    dk = apply_rope(dk.reshape(B, S, 2 * DF_HEADS, DF_DQK), cos, sin)
    hd = diff_attention(dq, dk, dv.reshape(B, S, DF_HEADS, DF_DV), lam)
    hd = head_norm(hd, df_norm_g.reshape(DF_HEADS, DF_DV), False) * (1.0 - lam_init)
    hd = hd.reshape(B, S, DF_V_W)

    sq = apply_rope(sq.reshape(B, S, SA_HEADS, SA_DH), cos, sin)
    sk = apply_rope(sk.reshape(B, S, SA_HEADS, SA_DH), cos, sin)
    xq = apply_rope(xq.reshape(B, S, IDX_HEADS, IDX_DIM), cos, sin)
    xk = apply_rope(layer_norm(xk, idx_norm_g, idx_norm_b)[:, :, None, :], cos, sin)[:, :, 0, :]
    hs = dsa_attention(sq, sk, sv.reshape(B, S, SA_HEADS, SA_DH), xq, xk, xw)
    hs = hs.reshape(B, S, SA_W)

    return jnp.einsum("bsm,md->bsd", jnp.concatenate([hm, hd, hs], axis=-1), w_out)


def expert_ffn(u, router_w, router_b, w1, b1, w2, b2):
    B, S, D = u.shape
    t = u.reshape(B * S, D)
    logits = (jnp.einsum("td,de->te", t, router_w) + router_b).astype(jnp.float32)
    top_val, top_idx = lax.top_k(logits, TOP_K)
    p = jax.nn.softmax(top_val, axis=-1)
    combine = jnp.einsum("tk,tke->te", p, jax.nn.one_hot(top_idx, N_EXPERTS, dtype=jnp.float32))

    def expert(acc, xs):
        w1e, b1e, w2e, b2e, ce = xs
        hh = t @ w1e + b1e
        gate, up = jnp.split(hh, 2, axis=-1)
        gate = jnp.minimum(gate, SWIGLU_LIMIT)
        up = jnp.clip(up, -SWIGLU_LIMIT, SWIGLU_LIMIT)
        y = ((up + 1.0) * (gate * jax.nn.sigmoid(SWIGLU_ALPHA * gate))) @ w2e + b2e
        return acc + ce[:, None].astype(y.dtype) * y, None

    out, _ = lax.scan(expert, jnp.zeros_like(t), (w1, b1, w2, b2, combine.T))
    return out.reshape(B, S, D)


def setup_inputs(seed: int = 0) -> dict:
    key = jax.random.key(seed)
    ks = jax.random.split(key, 27)
    f32 = jnp.float32

    def nrm(k, shape, s):
        return jax.random.normal(k, shape, f32) * s

    x = nrm(ks[0], (BATCH, SEQ, D_MODEL), 1.0)
    c = nrm(ks[1], (BATCH, D_MODEL), 1.0)
    offset = jax.random.randint(ks[2], (BATCH, 1), 0, 64, dtype=jnp.int32)
    positions = offset + jnp.arange(SEQ, dtype=jnp.int32)[None, :]
    w_in = nrm(ks[3], (DEPTH, D_MODEL, N_IN_COLS), D_MODEL ** -0.5)
    m_gate_bias = jnp.concatenate([nrm(ks[4], (DEPTH, M_HEADS), 0.1),
                                   3.0 + nrm(ks[5], (DEPTH, M_HEADS), 0.5)], axis=-1)
    m_conv_w = nrm(ks[6], (DEPTH, CONV_WIDTH, 2 * M_QK_W), CONV_WIDTH ** -0.5)
    m_conv_b = nrm(ks[7], (DEPTH, 2 * M_QK_W), 0.02)
    m_norm_g = 1.0 + nrm(ks[8], (DEPTH, M_V_W), 0.02)
    df_lambda = nrm(ks[9], (DEPTH, 4, DF_DQK), 0.1)
    df_norm_g = 1.0 + nrm(ks[10], (DEPTH, DF_V_W), 0.02)
    idx_norm_g = 1.0 + nrm(ks[11], (DEPTH, IDX_DIM), 0.02)
    idx_norm_b = nrm(ks[12], (DEPTH, IDX_DIM), 0.02)
    w_out = nrm(ks[13], (DEPTH, D_MIX, D_MODEL), D_MIX ** -0.5 * DEEPNORM_BETA)
    ada_w = nrm(ks[14], (DEPTH, D_MODEL, N_MOD * D_MODEL), 0.1 * D_MODEL ** -0.5)
    ada_b = nrm(ks[15], (DEPTH, N_MOD * D_MODEL), 0.02)
    ln1_g = 1.0 + nrm(ks[16], (DEPTH, D_MODEL), 0.02)
    ln1_b = nrm(ks[17], (DEPTH, D_MODEL), 0.02)
    ln2_g = 1.0 + nrm(ks[18], (DEPTH, D_MODEL), 0.02)
    ln2_b = nrm(ks[19], (DEPTH, D_MODEL), 0.02)
    router_w = nrm(ks[20], (DEPTH, D_MODEL, N_EXPERTS), D_MODEL ** -0.5)
    router_b = nrm(ks[21], (DEPTH, N_EXPERTS), 0.01)
    w1 = nrm(ks[22], (DEPTH, N_EXPERTS, D_MODEL, 2 * D_FF), D_MODEL ** -0.5)
    b1 = nrm(ks[23], (DEPTH, N_EXPERTS, 2 * D_FF), 0.02)
    w2 = nrm(ks[24], (DEPTH, N_EXPERTS, D_FF, D_MODEL), D_FF ** -0.5 * DEEPNORM_BETA)
    b2 = nrm(ks[25], (DEPTH, N_EXPERTS, D_MODEL), 0.02)
    return {"x": x, "c": c, "positions": positions, "w_in": w_in, "m_gate_bias": m_gate_bias,
            "m_conv_w": m_conv_w, "m_conv_b": m_conv_b, "m_norm_g": m_norm_g,
            "df_lambda": df_lambda, "df_norm_g": df_norm_g, "idx_norm_g": idx_norm_g,
            "idx_norm_b": idx_norm_b, "w_out": w_out, "ada_w": ada_w, "ada_b": ada_b,
            "ln1_g": ln1_g, "ln1_b": ln1_b, "ln2_g": ln2_g, "ln2_b": ln2_b,
            "router_w": router_w, "router_b": router_b, "w1": w1, "b1": b1, "w2": w2, "b2": b2}


def reference(x, c, positions, w_in, m_gate_bias, m_conv_w, m_conv_b, m_norm_g,
              df_lambda, df_norm_g, idx_norm_g, idx_norm_b, w_out, ada_w, ada_b,
              ln1_g, ln1_b, ln2_g, ln2_b, router_w, router_b, w1, b1, w2, b2):
    cos, sin = rope_tables(positions, SA_DH)
    c_act = jax.nn.silu(c)
    for l in range(DEPTH):
        mod = jnp.einsum("bd,dm->bm", c_act, ada_w[l]) + ada_b[l]
        sh1, sc1, g1, sh2, sc2, g2 = [m[:, None, :] for m in jnp.split(mod, N_MOD, axis=-1)]
        u = x * (1.0 + sc1) + sh1
        y = hybrid_mixer(u, cos, sin, l, w_in[l], m_gate_bias[l], m_conv_w[l], m_conv_b[l],
                         m_norm_g[l], df_lambda[l], df_norm_g[l], idx_norm_g[l], idx_norm_b[l], w_out[l])
        x = layer_norm(DEEPNORM_ALPHA * x + (1.0 + g1) * y, ln1_g[l], ln1_b[l])
        u = x * (1.0 + sc2) + sh2
        y = expert_ffn(u, router_w[l], router_b[l], w1[l], b1[l], w2[l], b2[l])
        x = layer_norm(DEEPNORM_ALPHA * x + (1.0 + g2) * y, ln2_g[l], ln2_b[l])
    return x
```

```cpp
#include <hip/hip_runtime.h>
#include <cstdio>
#include <cstdint>

namespace pg8 {
#define PG8_LAS __attribute__((address_space(3)))
typedef unsigned short bf16_t;
typedef short bf16x8 __attribute__((ext_vector_type(8)));
typedef float f32x4 __attribute__((ext_vector_type(4)));
typedef unsigned u32x4 __attribute__((ext_vector_type(4)));
constexpr int BM = 256, BK = 64, HALF = 128, HTB = HALF * BK * 2  , STAGE_BYTES = 8 * HTB, NXCD = 8, WGM = 8;

__host__ __device__ __forceinline__ int lds_byte(int r, int c) { const int st = (r >> 4) * 2 + (c >> 5), rr = r & 15, cc = c & 31, ob = rr * 64 + cc * 2; return st * 1024 + (ob ^ (((ob >> 9) & 1) << 5)); }
__host__ __device__ __forceinline__ void stage_rc(int b, int& R, int& C) { const int st = b / 1024, sb = b % 1024, swz = sb ^ (((sb >> 9) & 1) << 5); R = (st >> 1) * 16 + swz / 64; C = (st & 1) * 32 + (swz % 64) / 2; }
__host__ __device__ __forceinline__ int perm32(int rho) { const int n = rho >> 4, i = rho & 15; return 8 * (i >> 2) + 4 * n + (i & 3); }

struct Unit { int pm, pn; };
struct Gemm { const bf16_t* A; const bf16_t* Bt; int M, N, K; };

struct StaticOrder {
    int nM, nN, nwg, G, c;
    __host__ __device__ void init(int M, int N, int G_, int c_) { nM = M / BM; nN = N / BM; nwg = nM * nN; G = G_; c = c_; }
    __host__ __device__ bool next(int i, Unit& u) const {
        const long L = (long)i * G + c; if (L >= nwg) return false;
        int wgid = (int)L; { const int q = nwg / NXCD, r = nwg % NXCD, xcd = wgid % NXCD, off = wgid / NXCD; wgid = (xcd < r ? xcd * (q + 1) : r * (q + 1) + (xcd - r) * q) + off; }
        const int nig = WGM * nN, gid = wgid / nig, fm = gid * WGM, gsz = (nM - fm) < WGM ? (nM - fm) : WGM;
        u.pm = fm + ((wgid % nig) % gsz); u.pn = (wgid % nig) / gsz; return true;
    }
    __device__ __forceinline__ void a_ready(const Unit&) const {}
    __device__ __forceinline__ void done(const Unit&) const {}
};
struct MoeOrder {
    int nM, nN, nwg, G, c; const PG8_LAS unsigned char* tile_e;
    __device__ void init(int nRT, int NTN, int G_, int c_, const PG8_LAS unsigned char* te) { nM = nRT; nN = NTN; nwg = nM * nN; G = G_; c = c_; tile_e = te; }
    __device__ bool next(int i, Unit& u) const {
        const long L = (long)i * G + c; if (L >= nwg) return false;
        int wgid = (int)L; { const int q = nwg / NXCD, r = nwg % NXCD, xcd = wgid % NXCD, off = wgid / NXCD; wgid = (xcd < r ? xcd * (q + 1) : r * (q + 1) + (xcd - r) * q) + off; }
        const int nig = WGM * nN, gid = wgid / nig, fm = gid * WGM, gsz = (nM - fm) < WGM ? (nM - fm) : WGM;
        u.pm = fm + ((wgid % nig) % gsz); const int pl = (wgid % nig) / gsz; u.pn = (int)tile_e[u.pm] * nN + pl; return true;
    }
    __device__ __forceinline__ void a_ready(const Unit&) const {}
    __device__ __forceinline__ void done(const Unit&) const {}
};
__device__ __forceinline__ unsigned cvt_pk_bf16(float lo, float hi) { unsigned r; asm volatile("v_cvt_pk_bf16_f32 %0, %1, %2" : "=v"(r) : "v"(lo), "v"(hi)); return r; }
typedef float f32x2 __attribute__((ext_vector_type(2)));
__device__ __forceinline__ f32x2 gelu_pk(f32x2 v) {
    const f32x2 av = __builtin_elementwise_abs(v), d = av * 0.2316418882f + 1.0f;
    f32x2 t; t.x = __builtin_amdgcn_rcpf(d.x); t.y = __builtin_amdgcn_rcpf(d.y);
    f32x2 q = t * 0.5307027145f + (-0.7265760135f); q = q * t + 0.7107068705f; q = q * t + (-0.142248368f); q = q * t + 0.127414796f; q = q * t;
    const f32x2 s = (v * v) * (-0.72134752044f);
    f32x2 e; e.x = __builtin_amdgcn_exp2f(s.x); e.y = __builtin_amdgcn_exp2f(s.y);
    const f32x2 m = v * (q * e), r = v - m;
    f32x2 o; o.x = v.x < 0.f ? m.x : r.x; o.y = v.y < 0.f ? m.y : r.y; return o;
}

template <int ACT  > struct EpiBf16 {
    static constexpr bool PERM = true, AFTER_DRAIN = false; static_assert(ACT == 0 || ACT == 1, "EpiBf16: ACT is 0 (none) or 1 (gelu_pk)");
    bf16_t* O; int ldc; const float* bias; int split_cols; size_t split_stride; float scale0;
    __device__ __forceinline__ void operator()(const f32x4 (&acc)[2][2][4][2], const Unit& u, int wr, int wc, int fr, int fq) const {
        const int row0 = u.pm * BM + wr * 64 + fr; int colt = u.pn * BM; bf16_t* base = O;
        float sc = 1.f; if (split_cols) { const int t = colt / split_cols; base += (size_t)t * split_stride; colt -= t * split_cols; if (t == 0) sc = scale0; }
        const int col0 = colt + wc * 32 + 8 * fq, bcol0 = u.pn * BM + wc * 32 + 8 * fq;
        f32x4 bv[2][2];
#pragma unroll
        for (int bj = 0; bj < 2; ++bj)
#pragma unroll
            for (int n = 0; n < 2; ++n) bv[bj][n] = bias ? *(const f32x4*)(bias + bcol0 + bj * HALF + 4 * n) : (f32x4){0.f, 0.f, 0.f, 0.f};
#pragma unroll
        for (int ai = 0; ai < 2; ++ai)
#pragma unroll
            for (int m = 0; m < 4; ++m) { bf16_t* rowp = base + (size_t)(row0 + ai * HALF + m * 16) * ldc + col0;
#pragma unroll
                for (int bj = 0; bj < 2; ++bj) { f32x4 v0 = acc[ai][bj][m][0] + bv[bj][0], v1 = acc[ai][bj][m][1] + bv[bj][1];
                    if (ACT == 1) { f32x2 a = gelu_pk((f32x2){v0[0], v0[1]}), b = gelu_pk((f32x2){v0[2], v0[3]}), c = gelu_pk((f32x2){v1[0], v1[1]}), d = gelu_pk((f32x2){v1[2], v1[3]});
                        v0 = (f32x4){a.x, a.y, b.x, b.y}; v1 = (f32x4){c.x, c.y, d.x, d.y}; }
                    v0 = v0 * sc; v1 = v1 * sc; u32x4 w; w.x = cvt_pk_bf16(v0[0], v0[1]); w.y = cvt_pk_bf16(v0[2], v0[3]); w.z = cvt_pk_bf16(v1[0], v1[1]); w.w = cvt_pk_bf16(v1[2], v1[3]);
                    *(u32x4*)(rowp + bj * HALF) = w; } }
    }
};
constexpr float C2 = 0.125f * 1.4426950408889634f;
struct EpiIn {
    static constexpr bool PERM = true, AFTER_DRAIN = false;
    bf16_t* O; const float* cs;
    __device__ __forceinline__ void operator()(const f32x4 (&acc)[2][2][4][2], const Unit& u, int wr, int wc, int fr, int fq) const {
        const int pn = u.pn;
        const bool rope = (0x6CF0 >> pn) & 1;
        const float sc = ((0x0430 >> pn) & 1) ? C2 : 1.f;
        const int row0 = u.pm * BM + wr * 64 + fr, col0 = pn * BM + wc * 32 + 8 * fq, i0 = (wc & 1) * 16 + 4 * fq;
#pragma unroll
        for (int ai = 0; ai < 2; ++ai)
#pragma unroll
            for (int m = 0; m < 4; ++m) {
                const int row = row0 + ai * HALF + m * 16;
                f32x4 c01 = (f32x4){1.f, 0.f, 1.f, 0.f}, c23 = c01;
                if (rope) { c01 = *(const f32x4*)(cs + (size_t)row * 64 + i0 * 2); c23 = *(const f32x4*)(cs + (size_t)row * 64 + i0 * 2 + 4); }
                bf16_t* rowp = O + (size_t)row * 4096 + col0;
#pragma unroll
                for (int bj = 0; bj < 2; ++bj) {
                    f32x4 v0 = acc[ai][bj][m][0], v1 = acc[ai][bj][m][1];
                    if (rope) {
                        f32x4 r0, r1;
                        r0[0] = v0[0] * c01[0] - v0[1] * c01[1]; r0[1] = v0[1] * c01[0] + v0[0] * c01[1];
                        r0[2] = v0[2] * c01[2] - v0[3] * c01[3]; r0[3] = v0[3] * c01[2] + v0[2] * c01[3];
                        r1[0] = v1[0] * c23[0] - v1[1] * c23[1]; r1[1] = v1[1] * c23[0] + v1[0] * c23[1];
                        r1[2] = v1[2] * c23[2] - v1[3] * c23[3]; r1[3] = v1[3] * c23[2] + v1[2] * c23[3];
                        v0 = r0; v1 = r1;
                    }
                    v0 = v0 * sc; v1 = v1 * sc;
                    u32x4 w; w.x = cvt_pk_bf16(v0[0], v0[1]); w.y = cvt_pk_bf16(v0[2], v0[3]); w.z = cvt_pk_bf16(v1[0], v1[1]); w.w = cvt_pk_bf16(v1[2], v1[3]);
                    *(u32x4*)(rowp + bj * HALF) = w;
                }
            }
    }
};
struct EpiSwiGLU {
    static constexpr bool PERM = true, AFTER_DRAIN = false;
    bf16_t* O; const float* b1;
    __device__ __forceinline__ void operator()(const f32x4 (&acc)[2][2][4][2], const Unit& u, int wr, int wc, int fr, int fq) const {
        const int e = u.pn >> 3, pl = u.pn & 7, colh = pl * 128 + wc * 32 + 8 * fq;
        const float* bp = b1 + (size_t)e * 2048 + colh;
        f32x4 bg[2], bu[2];
#pragma unroll
        for (int n = 0; n < 2; ++n) { bg[n] = *(const f32x4*)(bp + 4 * n); bu[n] = *(const f32x4*)(bp + 1024 + 4 * n); }
        const int row0 = u.pm * BM + wr * 64 + fr;
#pragma unroll
        for (int ai = 0; ai < 2; ++ai)
#pragma unroll
            for (int m = 0; m < 4; ++m) {
                f32x4 o[2];
#pragma unroll
                for (int n = 0; n < 2; ++n) {
                    const f32x4 g4 = acc[ai][0][m][n] + bg[n], u4 = acc[ai][1][m][n] + bu[n];
#pragma unroll
                    for (int c = 0; c < 4; ++c) {
                        const float g = fminf(g4[c], 7.0f), up = fminf(fmaxf(u4[c], -7.0f), 7.0f);
                        const float sg = __builtin_amdgcn_rcpf(1.0f + __builtin_amdgcn_exp2f(-1.702f * 1.4426950408889634f * g));
                        o[n][c] = (up + 1.0f) * (g * sg);
                    }
                }
                u32x4 w; w.x = cvt_pk_bf16(o[0][0], o[0][1]); w.y = cvt_pk_bf16(o[0][2], o[0][3]); w.z = cvt_pk_bf16(o[1][0], o[1][1]); w.w = cvt_pk_bf16(o[1][2], o[1][3]);
                *(u32x4*)(O + (size_t)(row0 + ai * HALF + m * 16) * 1024 + colh) = w;
            }
    }
};
template <class Epi, class Sched, bool ALIGN_EPI = false, bool SP2 = false>
__device__ __forceinline__ void gemm_phase(PG8_LAS unsigned char* lds, const Gemm g, const Sched& S, const Epi& E) {
    const int tid = threadIdx.x, wid = __builtin_amdgcn_readfirstlane(tid >> 6), lane = tid & 63, wr = wid >> 2, wc = wid & 3, fr = lane & 15, fq = lane >> 4;
    const int K = g.K, nt = K / BK;
    unsigned voffA[2], voffB[2];
#pragma unroll
    for (int i = 0; i < 2; ++i) { int R, C; stage_rc(tid * 16 + i * 8192, R, C); const int Rb = Epi::PERM ? ((R & ~31) + perm32(R & 31)) : R;
        voffA[i] = (unsigned)(R * K + C) * 2u; voffB[i] = (unsigned)(Rb * K + C) * 2u; }
    const size_t kstep = (size_t)(BK * 2);
    const size_t hstep = (size_t)HALF * K * 2;
    const size_t tstep = 2 * hstep;
    const unsigned ldsw = (unsigned)wid * 1024u;
    const int aoff = lds_byte(wr * 64 + fr, fq * 8), boff = lds_byte(wc * 32 + fr, fq * 8);
#define PG8_SA(b, h) (((b) * 2 + (h)) * HTB)
#define PG8_SB(b, h) ((4 + (b) * 2 + (h)) * HTB)
#define PG8_STAGE(bufoff, gbase, voff) do { _Pragma("unroll") for (int _i = 0; _i < 2; ++_i) \
        __builtin_amdgcn_global_load_lds((const unsigned*)((const char*)(gbase) + (voff)[_i]), (PG8_LAS unsigned*)(lds + (bufoff) + ldsw + _i * 8192), 16, 0, 0); } while (0)
#define PG8_LDA(dst, b, h) do { _Pragma("unroll") for (int m = 0; m < 4; ++m) _Pragma("unroll") for (int k = 0; k < 2; ++k) dst[m][k] = *(const PG8_LAS bf16x8*)(lds + PG8_SA(b, h) + aoff + m * 2048 + k * 1024); } while (0)
#define PG8_LDB(dst, b, h) do { _Pragma("unroll") for (int n = 0; n < 2; ++n) _Pragma("unroll") for (int k = 0; k < 2; ++k) dst[n][k] = *(const PG8_LAS bf16x8*)(lds + PG8_SB(b, h) + boff + n * 2048 + k * 1024); } while (0)
#define PG8_MMA(ai, bj, At, Bt) do { __builtin_amdgcn_s_setprio(1); _Pragma("unroll") for (int m = 0; m < 4; ++m) _Pragma("unroll") for (int n = 0; n < 2; ++n) _Pragma("unroll") for (int k = 0; k < 2; ++k) \
        acc[ai][bj][m][n] = __builtin_amdgcn_mfma_f32_16x16x32_bf16(Bt[n][k], At[m][k], acc[ai][bj][m][n], 0, 0, 0); __builtin_amdgcn_s_setprio(0); } while (0)
#define PG8_WAIT_V(n) asm volatile("s_waitcnt vmcnt(" #n ")" ::: "memory")
#define PG8_WAIT_L(n) asm volatile("s_waitcnt lgkmcnt(" #n ")" ::: "memory")
#define PG8_BAR __builtin_amdgcn_s_barrier()
#define PG8_SCHED __builtin_amdgcn_sched_barrier(0)
    Unit cur, nxt; int ui = 0;
    if (!S.next(0, cur)) return;
    f32x4 acc[2][2][4][2];
#pragma unroll
    for (int a = 0; a < 2; ++a)
#pragma unroll
        for (int b = 0; b < 2; ++b)
#pragma unroll
            for (int m = 0; m < 4; ++m)
#pragma unroll
                for (int n = 0; n < 2; ++n) acc[a][b][m][n] = (f32x4){0.f, 0.f, 0.f, 0.f};
    bf16x8 At[4][2], B0[2][2], B1[2][2];
    const char* cA = (const char*)g.A + (size_t)cur.pm * tstep; const char* cB = (const char*)g.Bt + (size_t)cur.pn * tstep;
    S.a_ready(cur);
    if constexpr (SP2) {
        PG8_STAGE(PG8_SB(0, 0), cB, voffB); PG8_STAGE(PG8_SB(0, 1), cB + hstep, voffB); PG8_STAGE(PG8_SA(0, 0), cA, voffA); PG8_STAGE(PG8_SA(0, 1), cA + hstep, voffA);
        if (wr == 1) PG8_BAR;
        PG8_WAIT_V(2); PG8_BAR;
        PG8_STAGE(PG8_SB(1, 0), cB + kstep, voffB); PG8_STAGE(PG8_SA(1, 0), cA + kstep, voffA); PG8_STAGE(PG8_SB(1, 1), cB + hstep + kstep, voffB);
        PG8_WAIT_V(6); PG8_BAR;
    } else {
        PG8_STAGE(PG8_SB(0, 0), cB, voffB); PG8_STAGE(PG8_SA(0, 0), cA, voffA); PG8_STAGE(PG8_SB(0, 1), cB + hstep, voffB); PG8_STAGE(PG8_SA(0, 1), cA + hstep, voffA);
        if (wr == 1) PG8_BAR;
        PG8_WAIT_V(4); PG8_BAR;
        PG8_STAGE(PG8_SB(1, 0), cB + kstep, voffB); PG8_STAGE(PG8_SA(1, 0), cA + kstep, voffA); PG8_STAGE(PG8_SB(1, 1), cB + hstep + kstep, voffB);
        PG8_WAIT_V(6); PG8_BAR;
    }
    for (;;) {
        const bool has_next = S.next(ui + 1, nxt);
        const char* nA = has_next ? (const char*)g.A + (size_t)nxt.pm * tstep : cA; const char* nB = has_next ? (const char*)g.Bt + (size_t)nxt.pn * tstep : cB;
        for (int t = 0; t < nt; t += 2) {
            const bool last = (t == nt - 2);
            const char* a1 = cA + (size_t)(t + 1) * kstep;
            const char* a2 = last ? nA : cA + (size_t)(t + 2) * kstep; const char* b2 = last ? nB : cB + (size_t)(t + 2) * kstep;
            const char* a3 = a2 + kstep; const char* b3 = b2 + kstep;
            if (last && has_next) S.a_ready(nxt);
            if constexpr (SP2) {
            PG8_LDB(B0, 0, 0); PG8_LDB(B1, 0, 1); PG8_SCHED; PG8_LDA(At, 0, 0); PG8_STAGE(PG8_SA(1, 1), a1 + hstep, voffA);
            PG8_WAIT_V(8); PG8_WAIT_L(0); PG8_BAR; PG8_MMA(0, 0, At, B0); PG8_MMA(0, 1, At, B1); PG8_BAR; PG8_SCHED;
            PG8_LDA(At, 0, 1); PG8_STAGE(PG8_SB(0, 0), b2, voffB); PG8_STAGE(PG8_SB(0, 1), b2 + hstep, voffB); PG8_STAGE(PG8_SA(0, 0), a2, voffA);
            PG8_WAIT_V(8); PG8_WAIT_L(0); PG8_BAR; PG8_MMA(1, 0, At, B0); PG8_MMA(1, 1, At, B1); PG8_BAR; PG8_SCHED;
            PG8_LDB(B0, 1, 0); PG8_LDB(B1, 1, 1); PG8_SCHED; PG8_LDA(At, 1, 0); PG8_STAGE(PG8_SA(0, 1), a2 + hstep, voffA);
            PG8_WAIT_V(8); PG8_WAIT_L(0); PG8_BAR; PG8_MMA(0, 0, At, B0); PG8_MMA(0, 1, At, B1); PG8_BAR; PG8_SCHED;
            PG8_LDA(At, 1, 1); PG8_STAGE(PG8_SB(1, 0), b3, voffB); PG8_STAGE(PG8_SB(1, 1), b3 + hstep, voffB); PG8_STAGE(PG8_SA(1, 0), a3, voffA);
            PG8_WAIT_V(8); PG8_WAIT_L(0); PG8_BAR; PG8_MMA(1, 0, At, B0); PG8_MMA(1, 1, At, B1); PG8_BAR; PG8_SCHED;
            } else {
            PG8_LDB(B0, 0, 0); PG8_SCHED; PG8_LDA(At, 0, 0); PG8_STAGE(PG8_SA(1, 1), a1 + hstep, voffA);
            PG8_WAIT_L(8); PG8_BAR; PG8_WAIT_L(0); PG8_MMA(0, 0, At, B0); PG8_BAR; PG8_SCHED;
            PG8_LDB(B1, 0, 1); PG8_STAGE(PG8_SB(0, 0), b2, voffB);
            PG8_BAR; PG8_WAIT_L(0); PG8_MMA(0, 1, At, B1); PG8_BAR;
            PG8_LDA(At, 0, 1); PG8_STAGE(PG8_SA(0, 0), a2, voffA);
            PG8_BAR; PG8_WAIT_L(0); PG8_MMA(1, 0, At, B0); PG8_BAR; PG8_SCHED;
            PG8_STAGE(PG8_SB(0, 1), b2 + hstep, voffB);
            PG8_WAIT_V(6); PG8_BAR; PG8_MMA(1, 1, At, B1); PG8_BAR;
            PG8_LDB(B0, 1, 0); PG8_SCHED; PG8_LDA(At, 1, 0); PG8_STAGE(PG8_SA(0, 1), a2 + hstep, voffA);
            PG8_WAIT_L(8); PG8_BAR; PG8_WAIT_L(0); PG8_MMA(0, 0, At, B0); PG8_BAR; PG8_SCHED;
            PG8_LDB(B1, 1, 1); PG8_STAGE(PG8_SB(1, 0), b3, voffB);
            PG8_BAR; PG8_WAIT_L(0); PG8_MMA(0, 1, At, B1); PG8_BAR;
            PG8_LDA(At, 1, 1); PG8_STAGE(PG8_SA(1, 0), a3, voffA);
            PG8_BAR; PG8_WAIT_L(0); PG8_MMA(1, 0, At, B0); PG8_BAR; PG8_SCHED;
            PG8_STAGE(PG8_SB(1, 1), b3 + hstep, voffB);
            PG8_WAIT_V(6); PG8_BAR; PG8_MMA(1, 1, At, B1); PG8_BAR;
            }
        }
        if constexpr (ALIGN_EPI) { if (wr == 0) PG8_BAR; }
        if constexpr (!Epi::AFTER_DRAIN) { E(acc, cur, wr, wc, fr, fq); S.done(cur); }
        if (!has_next) break;
#pragma unroll
        for (int a = 0; a < 2; ++a)
#pragma unroll
            for (int b = 0; b < 2; ++b)
#pragma unroll
                for (int m = 0; m < 4; ++m)
#pragma unroll
                    for (int n = 0; n < 2; ++n) acc[a][b][m][n] = (f32x4){0.f, 0.f, 0.f, 0.f};
        cur = nxt; cA = nA; cB = nB; ++ui;
        if constexpr (ALIGN_EPI) { if (wr == 1) PG8_BAR; }
    }
    PG8_WAIT_V(0);
    if constexpr (!ALIGN_EPI) { if (wr == 0) PG8_BAR; }
    PG8_BAR;
    if constexpr (Epi::AFTER_DRAIN) { E.fused(acc, cur, wr, wc, fr, fq, lds, wid, lane); S.done(cur); }
#undef PG8_SA
#undef PG8_SB
#undef PG8_STAGE
#undef PG8_LDA
#undef PG8_LDB
#undef PG8_MMA
#undef PG8_WAIT_V
#undef PG8_WAIT_L
#undef PG8_BAR
#undef PG8_SCHED
}
}
#define GAS __attribute__((address_space(1)))
#define LAS __attribute__((address_space(3)))
typedef unsigned short bf16;
typedef unsigned v4u __attribute__((ext_vector_type(4)));
typedef float f32x4 __attribute__((ext_vector_type(4)));
typedef short bf16x8 __attribute__((ext_vector_type(8)));
typedef GAS unsigned gu32;
typedef GAS unsigned long long gu64;
#define RLX_AGENT __ATOMIC_RELAXED, __HIP_MEMORY_SCOPE_AGENT
#define LDS_WAIT() asm volatile("s_waitcnt lgkmcnt(0)" ::: "memory")
#define VM_WAIT() asm volatile("s_waitcnt vmcnt(0)" ::: "memory")
__device__ __forceinline__ unsigned long long rt() { return __builtin_amdgcn_s_memrealtime(); }
__device__ __forceinline__ unsigned f2bf(float f) { unsigned u = __builtin_bit_cast(unsigned, f); return (u + 0x7fffu + ((u >> 16) & 1u)) >> 16; }
__device__ __forceinline__ unsigned pk2(float lo, float hi) { return f2bf(lo) | (f2bf(hi) << 16); }
#define XB_TMO      128
#define XB_XCNT(j)  (256  + 64 * (j))
#define XB_XSUB(j)  (1280 + 64 * (j))
#define XB_XGEN(j)  (2304 + 64 * (j))
#define XB_TOP      3328
#define XB_TOPGEN   3392
#define XCD_BAR_WORDS 3456
#define XB_SPIN_CAP (1u << 18)

__device__ __forceinline__ unsigned xb_ld(unsigned* p)              { return __hip_atomic_load(p, __ATOMIC_RELAXED, __HIP_MEMORY_SCOPE_AGENT); }
__device__ __forceinline__ unsigned xb_add(unsigned* p, unsigned v) { return __hip_atomic_fetch_add(p, v, __ATOMIC_RELAXED, __HIP_MEMORY_SCOPE_AGENT); }
__device__ __forceinline__ unsigned xb_xcc_id() { return (unsigned)__builtin_amdgcn_s_getreg((3 << 11) | 20) & 0xFu; }
#define XB_SPIN(cond, bar) do { unsigned _sp = 0; while (cond) { __builtin_amdgcn_s_sleep(1); \
    if ((++_sp & 255u) == 0u) { if (xb_ld(&(bar)[XB_TMO])) break; if (_sp > XB_SPIN_CAP) { atomicAdd(&(bar)[XB_TMO], 1u); break; } } } } while (0)

struct XcdBarrier {
    unsigned* bar; unsigned x;
    volatile LAS unsigned* st;
};

__device__ __forceinline__ XcdBarrier xcd_barrier_post(unsigned* bar, volatile LAS unsigned* st) {
    XcdBarrier b; b.bar = bar; b.x = xb_xcc_id(); b.st = st;
    if (threadIdx.x == 0) (void)xb_add(&bar[XB_XCNT(b.x)], 1u);
    return b;
}
__device__ __forceinline__ void xcd_barrier_complete(unsigned* bar, unsigned x, unsigned& nloc, unsigned& nx) {
    const unsigned G = gridDim.x * gridDim.y * gridDim.z;
    unsigned sum, cnt, mine, sp = 0u;
    for (;;) {
        sum = 0u; cnt = 0u; mine = 0u;
#pragma unroll
        for (unsigned j = 0; j < 16; ++j) { const unsigned c = xb_ld(&bar[XB_XCNT(j)]); sum += c; cnt += (c > 0u) ? 1u : 0u; mine = (j == x) ? c : mine; }
        if (sum == G) break;
        __builtin_amdgcn_s_sleep(1);
        if ((++sp & 255u) == 0u) { if (xb_ld(&bar[XB_TMO])) break; if (sp > XB_SPIN_CAP) { atomicAdd(&bar[XB_TMO], 1u); break; } }
    }
    nloc = mine > 0u ? mine : 1u; nx = cnt > 0u ? cnt : 1u;
}

__device__ __forceinline__ void xcd_barrier(const XcdBarrier& b) {
    asm volatile("s_waitcnt vmcnt(0)" ::: "memory");
    __syncthreads();
    if (threadIdx.x == 0) {
        unsigned* bar = b.bar;
        __builtin_amdgcn_s_waitcnt(0);
        unsigned nloc = b.st[0], nx = b.st[1];
        if (nloc == 0u) { xcd_barrier_complete(bar, b.x, nloc, nx); b.st[0] = nloc; b.st[1] = nx; }
        const unsigned old = xb_add(&bar[XB_XSUB(b.x)], 1u);
        const unsigned gen = old / nloc;
        if (old + 1u == (gen + 1u) * nloc) {
            __builtin_amdgcn_fence(__ATOMIC_RELEASE, "agent");
            asm volatile("s_waitcnt vmcnt(0)" ::: "memory");
            const unsigned og = xb_add(&bar[XB_TOP], 1u);
            const unsigned tg = og / nx;
            if (og + 1u == (tg + 1u) * nx) xb_add(&bar[XB_TOPGEN], 1u);
            else XB_SPIN(xb_ld(&bar[XB_TOPGEN]) == tg, bar);
            __builtin_amdgcn_fence(__ATOMIC_ACQUIRE, "agent");
            xb_add(&bar[XB_XGEN(b.x)], 1u);
            asm volatile("s_waitcnt vmcnt(0)" ::: "memory");
        } else {
            XB_SPIN(xb_ld(&bar[XB_XGEN(b.x)]) == gen, bar);
            __builtin_amdgcn_fence(__ATOMIC_ACQUIRE, "agent");
            asm volatile("s_waitcnt vmcnt(0)" ::: "memory");
        }
    }
    __syncthreads();
}
constexpr int NB = 16, SEQ = 2048, T = NB * SEQ, D = 1024, DEPTH = 4, NHC = 4096, NEXP = 32, NWAVES = 8;
constexpr int NIN = 3920;
constexpr float LN_EPS = 1e-5f, DN_ALPHA = 1.6817928305074290f;
constexpr int RPAD = T * 4 + NEXP * 256;
constexpr int HC_MQ = 0, HC_MK = 256, HC_MV = 512, HC_MO = 768, HC_DQ = 1024, HC_DK = 1536, HC_DV = 2048, HC_SQ = 2560, HC_SK = 2816, HC_SV = 3072, HC_XQ = 3328, HC_XK = 3840, HC_MI = 3904, HC_MF = 3908, HC_XW = 3912;
constexpr size_t MiB = 1u << 20;
constexpr size_t WS_CTL = 0, CTL_ZERO_BYTES = 2 * MiB;
constexpr size_t WS_MOD = 2 * MiB;
constexpr size_t WS_LAM = WS_MOD + 7 * MiB / 4;
constexpr size_t WS_RWT = 4 * MiB;
constexpr size_t WS_CS = 8 * MiB;
constexpr size_t WS_WIN = 16 * MiB;
constexpr size_t WS_WOUT = 48 * MiB;
constexpr size_t WS_W1 = 64 * MiB;
constexpr size_t WS_W2 = 576 * MiB;
constexpr size_t WS_XB = 832 * MiB;
constexpr size_t WS_U = 960 * MiB;
constexpr size_t WS_H = 1024 * MiB;
constexpr size_t WS_QKC = 1280 * MiB;
constexpr size_t WS_XKP = 1312 * MiB;
constexpr size_t WS_MASK = 1316 * MiB;
constexpr size_t WS_TOK = 1324 * MiB;
constexpr size_t WS_MIX = 1344 * MiB;
constexpr size_t WS_Y = 1408 * MiB;
constexpr size_t WS_SC = 1472 * MiB;
constexpr size_t WS_XG = 1728 * MiB;
constexpr size_t WS_HM = 2000 * MiB;
constexpr size_t WS_YM = 2272 * MiB;
constexpr size_t WS_END = 2544 * MiB;
constexpr int CW_CNT = 1024;
constexpr int CW_BAR = 4096;
constexpr int RING_BYTES = 131072, TAB_OFF = RING_BYTES, MISC_OFF = RING_BYTES + 4096, LDS_BYTES = 147456;
constexpr int NPH = 11, NSTEPS = 2 + NPH * DEPTH;
enum { PH_IN = 0, PH_POST, PH_MIXA, PH_SEL, PH_DSA, PH_OUT, PH_ROW1, PH_GATH, PH_G1, PH_G2, PH_ROW2 };

__device__ __forceinline__ float bf2f(bf16 h) { return __uint_as_float((unsigned)h << 16); }
__device__ __forceinline__ float wave_sum(float v) {
#pragma unroll
    for (int o = 1; o < 64; o <<= 1) v += __shfl_xor(v, o);
    return v;
}
__device__ __forceinline__ float wave_max(float v) {
#pragma unroll
    for (int o = 1; o < 64; o <<= 1) v = fmaxf(v, __shfl_xor(v, o));
    return v;
}
__device__ __forceinline__ float sigmoidf_(float x) { return 1.0f / (1.0f + __expf(-x)); }
struct Ctx {
    LAS unsigned char* lds;
    int tid, lane, wave, gw, ngw;
    const float* in[25];
    float* out; unsigned char* ws;
};
#define WSP(type, off) ((type*)(C.ws + (off)))
enum { I_X = 0, I_C, I_POS, I_WIN, I_GATEB, I_CONVW, I_CONVB, I_MNORM, I_DFLAM, I_DFNORM, I_IDXG, I_IDXB, I_WOUT, I_ADAW, I_ADAB, I_LN1G, I_LN1B, I_LN2G, I_LN2B, I_RW, I_RB, I_W1, I_B1, I_W2, I_B2 };

__device__ __forceinline__ int in_dest_col(int n) {
    auto rp = [](int j) { const int hd = j >> 6, d = j & 63; return hd * 64 + ((d < 32) ? 2 * d : 2 * (d - 32) + 1); };
    if (n < 256) return HC_MQ + n;
    if (n < 512) return HC_MK + (n - 256);
    if (n < 768) return HC_MV + (n - 512);
    if (n < 772) return HC_MI + (n - 768);
    if (n < 776) return HC_MF + (n - 772);
    if (n < 1032) return HC_MO + (n - 776);
    if (n < 1544) return HC_DQ + rp(n - 1032);
    if (n < 2056) return HC_DK + rp(n - 1544);
    if (n < 2568) return HC_DV + (n - 2056);
    if (n < 2824) return HC_SQ + rp(n - 2568);
    if (n < 3080) return HC_SK + rp(n - 2824);
    if (n < 3336) return HC_SV + (n - 3080);
    if (n < 3848) return HC_XQ + rp(n - 3336);
    if (n < 3912) return HC_XK + (n - 3848);
    return HC_XW + (n - 3912);
}
template <class F> __device__ __forceinline__ void transpose_item(const float* W, int ldw, int K, int nvalid, int k0, int n0, bf16* WT, LAS float* scr, int lane, F drow) {
    const int nn = n0 + (lane & 31); const bool ok = nn < nvalid;
#pragma unroll 8
    for (int i = 0; i < 32; ++i) { const int kk = 2 * i + (lane >> 5); scr[kk * 33 + (lane & 31)] = ok ? W[(size_t)(k0 + kk) * ldw + nn] : 0.f; }
    LDS_WAIT(); asm volatile("" ::: "memory");
    const int c = lane & 7;
#pragma unroll
    for (int j = 0; j < 4; ++j) { const int n = (lane >> 3) + 8 * j; const LAS float* s = scr + (8 * c) * 33 + n;
        v4u o; o.x = pk2(s[0 * 33], s[1 * 33]); o.y = pk2(s[2 * 33], s[3 * 33]); o.z = pk2(s[4 * 33], s[5 * 33]); o.w = pk2(s[6 * 33], s[7 * 33]);
        if (n0 + n < nvalid) *(GAS v4u*)(WT + (size_t)drow(n0 + n) * K + k0 + 8 * c) = o; }
    LDS_WAIT(); asm volatile("" ::: "memory");
}
struct Args { const float* in[25]; float* out; unsigned char* ws; int s_lo, s_hi, li, pad; };
typedef __attribute__((address_space(4))) const Args CArgs;
__device__ __forceinline__ CArgs* kargs() { CArgs* p = (CArgs*)__builtin_amdgcn_kernarg_segment_ptr(); asm volatile("" : "+s"(p)); return p; }
#define WS(type, off) ((type*)(A->ws + (off)))
#define TIDX CArgs* A = kargs(); int tid_ = threadIdx.x; asm volatile("" : "+v"(tid_)); const int tid = tid_, lane = tid & 63, wave = __builtin_amdgcn_readfirstlane(tid >> 6); const int gw = blockIdx.x * NWAVES + wave, ngw = gridDim.x * NWAVES; (void)lane; (void)gw; (void)ngw

__device__ __forceinline__ void pro_a(LAS unsigned char* lds) {
    TIDX;
    LAS float* scr = (LAS float*)(lds + wave * 16384);
    constexpr int IT_IN = 16 * 123, IT_OUT = 16 * 32, IT_W1 = 16 * 64, IT_W2 = 16 * 32;
    constexpr int N_IN = DEPTH * IT_IN, N_OUT = DEPTH * IT_OUT, N_W1 = DEPTH * NEXP * IT_W1, N_W2 = DEPTH * NEXP * IT_W2;
    constexpr int NITEMS = N_IN + N_OUT + N_W1 + N_W2;
    for (int it = gw; it < NITEMS; it += ngw) {
        int r = it;
        if (r < N_IN) { const int l = r / IT_IN, q = r % IT_IN, kb = q / 123, nb = q % 123;
            transpose_item(A->in[I_WIN] + (size_t)l * D * NIN, NIN, D, NIN, kb * 64, nb * 32, WS(bf16, WS_WIN) + (size_t)l * NHC * D, scr, lane, [](int n) { return in_dest_col(n); }); continue; }
        r -= N_IN;
        if (r < N_OUT) { const int l = r / IT_OUT, q = r % IT_OUT, kb = q / 32, nb = q % 32;
            transpose_item(A->in[I_WOUT] + (size_t)l * D * D, D, D, D, kb * 64, nb * 32, WS(bf16, WS_WOUT) + (size_t)l * D * D, scr, lane, [](int n) { return n; }); continue; }
        r -= N_OUT;
        if (r < N_W1) { const int le = r / IT_W1, q = r % IT_W1, kb = q / 64, nb = q % 64;
            transpose_item(A->in[I_W1] + (size_t)le * D * 2048, 2048, D, 2048, kb * 64, nb * 32, WS(bf16, WS_W1) + (size_t)le * 2048 * D, scr, lane,
                           [](int n) { const int up = n >> 10, j = n & 1023; return (j >> 7) * 256 + up * 128 + (j & 127); }); continue; }
        r -= N_W1;
        { const int le = r / IT_W2, q = r % IT_W2, kb = q / 32, nb = q % 32;
            transpose_item(A->in[I_W2] + (size_t)le * D * D, D, D, D, kb * 64, nb * 32, WS(bf16, WS_W2) + (size_t)le * D * D, scr, lane, [](int n) { return n; }); }
    }
    for (int r = gw; r < DEPTH * (NHC - NIN); r += ngw) { const int l = r / (NHC - NIN), row = NIN + r % (NHC - NIN);
        GAS v4u* p = (GAS v4u*)(WS(bf16, WS_WIN) + ((size_t)l * NHC + row) * D) + lane; p[0] = (v4u){0u, 0u, 0u, 0u}; p[64] = (v4u){0u, 0u, 0u, 0u}; }
    for (int idx = blockIdx.x * 512 + tid; idx < T * 32; idx += gridDim.x * 512) {
        const int tok = idx >> 5, i = idx & 31;
        const double inv = exp(-(double)i * (9.210340371976184 / 32.0));
        const double ang = (double)((const int*)A->in[I_POS])[tok] * inv;
        const double rev = ang * 0.15915494309189535;
        const float fr = (float)(rev - rint(rev));
        float2 v; v.x = __builtin_amdgcn_cosf(fr); v.y = __builtin_amdgcn_sinf(fr);
        WS(float2, WS_CS)[idx] = v;
    }
    for (int idx = blockIdx.x * 512 + tid; idx < DEPTH * NEXP * D; idx += gridDim.x * 512) {
        const int l = idx / (NEXP * D), r = idx % (NEXP * D), e = r / D, d = r % D;
        WS(float, WS_RWT)[idx] = A->in[I_RW][((size_t)l * D + d) * NEXP + e];
    }
    if (blockIdx.x == 0 && wave == 0) {
        for (int l = 0; l < DEPTH; ++l) { const float* lf = A->in[I_DFLAM] + l * 256;
            const float a = wave_sum(lf[lane] * lf[64 + lane]), b = wave_sum(lf[128 + lane] * lf[192 + lane]);
            if (lane == 0) WS(float, WS_LAM)[l] = __expf(a) - __expf(b) + (0.8f - 0.6f * __expf(-0.3f * (float)l)); }
    }
    __syncthreads();
    if (blockIdx.x < (DEPTH * 6144) / 512) {
        LAS float* ca = (LAS float*)lds;
        for (int i = tid; i < NB * D; i += 512) { const float v = A->in[I_C][i]; ca[i] = v / (1.0f + __expf(-v)); }
        __syncthreads();
        const int col = blockIdx.x * 512 + tid, l = col / 6144, m = col % 6144;
        const float* w = A->in[I_ADAW] + (size_t)l * D * 6144 + m;
        float acc[NB];
#pragma unroll
        for (int b = 0; b < NB; ++b) acc[b] = 0.f;
        for (int d = 0; d < D; ++d) { const float wv = w[(size_t)d * 6144];
#pragma unroll
            for (int b = 0; b < NB; ++b) acc[b] += ca[b * D + d] * wv; }
        const float bias = A->in[I_ADAB][col];
#pragma unroll
        for (int b = 0; b < NB; ++b) WS(float, WS_MOD)[((size_t)l * NB + b) * 6144 + m] = acc[b] + bias;
        __syncthreads();
    }
}
__device__ __forceinline__ void pro_b() {
    TIDX;
    for (int tok = gw; tok < T; tok += ngw) {
        const int b = tok / SEQ; const float* mod = WS(float, WS_MOD) + (size_t)b * 6144;
        const GAS f32x4* xr = (const GAS f32x4*)(A->in[I_X] + (size_t)tok * D) + lane;
        GAS unsigned long long* o8 = (GAS unsigned long long*)(WS(bf16, WS_U) + (size_t)tok * D) + lane;
#pragma unroll
        for (int j = 0; j < 4; ++j) { const f32x4 x = xr[64 * j]; const f32x4 sh = *(const f32x4*)(mod + 4 * lane + 256 * j), sc = *(const f32x4*)(mod + 1024 + 4 * lane + 256 * j);
            const f32x4 u = x * (1.0f + sc) + sh; o8[64 * j] = (unsigned long long)pk2(u.x, u.y) | ((unsigned long long)pk2(u.z, u.w) << 32); }
    }
}
__device__ __forceinline__ void ph_post(int l) {
    TIDX;
    const bf16* H = WS(bf16, WS_H); bf16* XKP = WS(bf16, WS_XKP); bf16* QKC = WS(bf16, WS_QKC);
    const float* cw = A->in[I_CONVW] + (size_t)l * 4 * 512; const float* cb = A->in[I_CONVB] + (size_t)l * 512;
    const float gi = A->in[I_IDXG][l * 64 + lane], bi = A->in[I_IDXB][l * 64 + lane];
    for (int tok = gw; tok < T; tok += ngw) {
        const bf16* hrow = H + (size_t)tok * NHC;
        {
            const float v = bf2f(hrow[HC_XK + lane]);
            const float mean = wave_sum(v) * (1.0f / 64.0f); const float dv = v - mean;
            const float var = wave_sum(dv * dv) * (1.0f / 64.0f);
            const float nv = dv * (1.0f / sqrtf(var + LN_EPS)) * gi + bi;
            const float pv = __shfl_xor(nv, 32);
            const int i = lane & 31; const float2 cs = WS(float2, WS_CS)[(size_t)tok * 32 + i];
            const float o = (lane < 32) ? (nv * cs.x - pv * cs.y) : (nv * cs.x + pv * cs.y);
            XKP[(size_t)tok * 64 + 2 * i + (lane >> 5)] = (bf16)f2bf(o);
        }
        {
            const int s = tok % SEQ, c0 = 8 * lane;
            float acc[8];
#pragma unroll
            for (int c = 0; c < 8; ++c) acc[c] = cb[c0 + c];
#pragma unroll
            for (int j = 0; j < 4; ++j) {
                if (s - 3 + j >= 0) {
                    const v4u raw = *(const GAS v4u*)(H + (size_t)(tok - 3 + j) * NHC + c0);
                    const unsigned rw[4] = {raw.x, raw.y, raw.z, raw.w};
#pragma unroll
                    for (int c = 0; c < 8; ++c) { const float x = __uint_as_float((c & 1) ? (rw[c >> 1] & 0xffff0000u) : (rw[c >> 1] << 16)); acc[c] += cw[j * 512 + c0 + c] * x; }
                }
            }
            v4u o;
#define SILU(x) ((x) / (1.0f + __expf(-(x))))
            o.x = pk2(SILU(acc[0]), SILU(acc[1])); o.y = pk2(SILU(acc[2]), SILU(acc[3])); o.z = pk2(SILU(acc[4]), SILU(acc[5])); o.w = pk2(SILU(acc[6]), SILU(acc[7]));
#undef SILU
            *(GAS v4u*)(QKC + (size_t)tok * 512 + c0) = o;
        }
    }
}
typedef float f32x16 __attribute__((ext_vector_type(16)));
__device__ __forceinline__ void ph_idx_scores() {
    TIDX;
    const bf16* H = WS(bf16, WS_H); const bf16* XKP = WS(bf16, WS_XKP); float* SC = WS(float, WS_SC);
    const int r = lane & 31, hh = lane >> 5, ql = r >> 3, hd = r & 7;
    for (int unit = blockIdx.x; unit < NB * (SEQ / 32); unit += gridDim.x) {
        const int b = unit / (SEQ / 32), q0 = (unit % (SEQ / 32)) * 32 + 4 * wave, tok0 = b * SEQ + q0;
        bf16x8 af[4];
        { const bf16* ap = H + (size_t)(tok0 + ql) * NHC + HC_XQ + hd * 64 + 8 * hh;
#pragma unroll
          for (int ks = 0; ks < 4; ++ks) af[ks] = *(const GAS bf16x8*)(ap + ks * 16); }
        float wv[4][4];
#pragma unroll
        for (int q = 0; q < 4; ++q)
#pragma unroll
            for (int i = 0; i < 4; ++i) wv[q][i] = bf2f(H[(size_t)(tok0 + q) * NHC + HC_XW + 4 * hh + i]);
        const int nkt = (q0 + 3) / 32 + 1;
        for (int kt = 0; kt < nkt; ++kt) {
            const int key = kt * 32 + r;
            const bf16* kp = XKP + (size_t)(b * SEQ + key) * 64 + 8 * hh;
            f32x16 acc = {};
#pragma unroll
            for (int ks = 0; ks < 4; ++ks) { const bf16x8 bfr = *(const GAS bf16x8*)(kp + ks * 16); acc = __builtin_amdgcn_mfma_f32_32x32x16_bf16(af[ks], bfr, acc, 0, 0, 0); }
            float tot[4];
#pragma unroll
            for (int q = 0; q < 4; ++q) { float p = 0.f;
#pragma unroll
                for (int i = 0; i < 4; ++i) p += wv[q][i] * fmaxf(acc[4 * q + i], 0.f);
                tot[q] = p + __shfl_xor(p, 32); }
            const float o0 = hh ? tot[2] : tot[0], o1 = hh ? tot[3] : tot[1];
            SC[(size_t)(tok0 + 2 * hh) * SEQ + key] = o0; SC[(size_t)(tok0 + 2 * hh + 1) * SEQ + key] = o1;
        }
    }
}
__device__ __forceinline__ void ph_mlstm(LAS unsigned char* lds, int l) {
    TIDX;
    const bf16* H = WS(bf16, WS_H); const bf16* QKC = WS(bf16, WS_QKC); bf16* MIX = WS(bf16, WS_MIX);
    constexpr int P = 65;
    LAS float* q = (LAS float*)lds; LAS float* k = q + 64 * P; LAS float* v = k + 64 * P; LAS float* Sm = v + 64 * P; LAS float* Cst = Sm + 64 * P;
    LAS float* nst = Cst + 64 * P; LAS float* bcum = nst + 64; LAS float* ii = bcum + 64; LAS float* mt = ii + 64; LAS float* inter = mt + 64; LAS float* den = inter + 64; LAS float* wvv = den + 64; LAS float* sc = wvv + 64;
    for (int unit = blockIdx.x; unit < NB * 4; unit += gridDim.x) {
        const int b = unit >> 2, h = unit & 3;
        const float gbi = A->in[I_GATEB][l * 8 + h], gbf = A->in[I_GATEB][l * 8 + 4 + h];
        for (int i = tid; i < 64 * P; i += 512) Cst[i] = 0.f;
        if (tid < 64) nst[tid] = 0.f;
        if (tid == 0) sc[0] = 0.f;
        __syncthreads();
        for (int ch = 0; ch < SEQ / 64; ++ch) {
            const int tok0 = b * SEQ + ch * 64;
            for (int idx = tid; idx < 4096; idx += 512) { const int rr = idx >> 6, d = idx & 63; const size_t tk = (size_t)(tok0 + rr);
                q[rr * P + d] = bf2f(QKC[tk * 512 + h * 64 + d]) * 0.125f; k[rr * P + d] = bf2f(QKC[tk * 512 + 256 + h * 64 + d]); v[rr * P + d] = bf2f(H[tk * NHC + HC_MV + h * 64 + d]); }
            if (wave == 0) {
                const size_t tk = (size_t)(tok0 + lane);
                const float ip = bf2f(H[tk * NHC + HC_MI + h]) + gbi, fp = bf2f(H[tk * NHC + HC_MF + h]) + gbf;
                float lf = fminf(fp, 0.f) - log1pf(__expf(-fabsf(fp)));
#pragma unroll
                for (int o = 1; o < 64; o <<= 1) { const float t_ = __shfl_up(lf, o); if (lane >= o) lf += t_; }
                ii[lane] = ip; bcum[lane] = lf;
            }
            __syncthreads();
            const float mprev = sc[0];
            if (tid < 64) { const int t = tid; float mx = -INFINITY; const float bt = bcum[t];
                for (int s = 0; s <= t; ++s) mx = fmaxf(mx, bt - bcum[s] + ii[s]);
                const float li = bt + mprev, m_t = fmaxf(li, mx); mt[t] = m_t; inter[t] = __expf(li - m_t); }
            __syncthreads();
            for (int idx = tid; idx < 4096; idx += 512) { const int t = idx >> 6, s = idx & 63; float val = 0.f;
                if (s <= t) { float dot = 0.f;
#pragma unroll 16
                    for (int d = 0; d < 64; ++d) dot += q[t * P + d] * k[s * P + d];
                    val = dot * __expf(bcum[t] - bcum[s] + ii[s] - mt[t]); }
                Sm[t * P + s] = val; }
            __syncthreads();
            if (tid < 64) { const int t = tid; float a = 0.f, qn = 0.f;
                for (int s = 0; s < 64; ++s) a += Sm[t * P + s];
                for (int d = 0; d < 64; ++d) qn += q[t * P + d] * nst[d];
                den[t] = a + inter[t] * qn; }
            float num[8];
#pragma unroll
            for (int j = 0; j < 8; ++j) { const int t = wave + 8 * j, vc = lane; float a = 0.f, qc = 0.f;
                for (int s = 0; s < 64; ++s) a += Sm[t * P + s] * v[s * P + vc];
                for (int d = 0; d < 64; ++d) qc += q[t * P + d] * Cst[d * P + vc];
                num[j] = a + inter[t] * qc; }
            __syncthreads();
#pragma unroll
            for (int j = 0; j < 8; ++j) { const int t = wave + 8 * j, vc = lane; const size_t tk = (size_t)(tok0 + t);
                const float hv = num[j] / fmaxf(fabsf(den[t]), __expf(-mt[t]));
                const float mean = wave_sum(hv) * (1.0f / 64.0f), hc = hv - mean;
                const float rs = 1.0f / sqrtf(wave_sum(hc * hc) * (1.0f / 64.0f) + LN_EPS);
                const float og = sigmoidf_(bf2f(H[tk * NHC + HC_MO + h * 64 + vc]));
                MIX[tk * D + h * 64 + vc] = (bf16)f2bf(og * (hc * rs * A->in[I_MNORM][l * 256 + h * 64 + vc])); }
            if (wave == 0) { const float bl = bcum[63]; const float lw = bl - bcum[lane] + ii[lane];
                const float mnew = fmaxf(bl + mprev, wave_max(lw)); wvv[lane] = __expf(lw - mnew);
                if (lane == 0) { sc[1] = __expf(bl + mprev - mnew); sc[2] = mnew; } }
            __syncthreads();
            { const float decay = sc[1];
#pragma unroll
              for (int j = 0; j < 8; ++j) { const int d = wave + 8 * j, vc = lane; float a = 0.f;
                  for (int s = 0; s < 64; ++s) a += wvv[s] * k[s * P + d] * v[s * P + vc];
                  Cst[d * P + vc] = decay * Cst[d * P + vc] + a; }
              if (tid < 64) { float a = 0.f; for (int s = 0; s < 64; ++s) a += wvv[s] * k[s * P + tid]; nst[tid] = decay * nst[tid] + a; }
              if (tid == 0) sc[0] = sc[2]; }
            __syncthreads();
        }
    }
}
template <int NV> __device__ __forceinline__ void naive_attn_row(const bf16* qp, const bf16* Kb, const bf16* Vb, int tl, const unsigned* maskrow, int lane, float (&o)[NV], float& l_out) {
    float qf[64];
#pragma unroll
    for (int c = 0; c < 8; ++c) { const v4u raw = *(const GAS v4u*)(qp + 8 * c); const unsigned rw[4] = {raw.x, raw.y, raw.z, raw.w};
#pragma unroll
        for (int e = 0; e < 8; ++e) qf[8 * c + e] = __uint_as_float((e & 1) ? (rw[e >> 1] & 0xffff0000u) : (rw[e >> 1] << 16)); }
    float m = -INFINITY, l = 0.f;
#pragma unroll
    for (int n = 0; n < NV; ++n) o[n] = 0.f;
    for (int kb = 0; kb * 64 <= tl; ++kb) {
        const int s = kb * 64 + lane; bool valid = s <= tl;
        if (maskrow) valid = valid && ((maskrow[2 * kb + (lane >> 5)] >> (lane & 31)) & 1u);
        float dot = 0.f;
        const bf16* kr = Kb + (size_t)s * NHC;
#pragma unroll
        for (int c = 0; c < 8; ++c) { const v4u raw = *(const GAS v4u*)(kr + 8 * c); const unsigned rw[4] = {raw.x, raw.y, raw.z, raw.w};
#pragma unroll
            for (int e = 0; e < 8; ++e) dot += qf[8 * c + e] * __uint_as_float((e & 1) ? (rw[e >> 1] & 0xffff0000u) : (rw[e >> 1] << 16)); }
        const float scv = valid ? dot : -INFINITY;
        const float bm = wave_max(scv);
        if (bm == -INFINITY) continue;
        const float mn = fmaxf(m, bm), alpha = __builtin_amdgcn_exp2f(m - mn), p = __builtin_amdgcn_exp2f(scv - mn);
        l = l * alpha + wave_sum(p); m = mn;
#pragma unroll
        for (int n = 0; n < NV; ++n) o[n] *= alpha;
        const int nk = min(64, tl - kb * 64 + 1);
        const bf16* vr = Vb + (size_t)(kb * 64) * NHC + lane;
        for (int j = 0; j < nk; ++j) { const float pj = __shfl(p, j);
#pragma unroll
            for (int n = 0; n < NV; ++n) o[n] += pj * bf2f(vr[(size_t)j * NHC + 64 * n]); }
    }
    l_out = l;
}
__device__ __forceinline__ void ph_diff_naive(int l) {
    TIDX;
    const bf16* H = WS(bf16, WS_H); bf16* MIX = WS(bf16, WS_MIX);
    const float lam = WS(float, WS_LAM)[l], lam_init = 0.8f - 0.6f * __expf(-0.3f * (float)l);
    for (int task = gw; task < T * 4; task += ngw) {
        const int tok = task >> 2, h = task & 3, b = tok / SEQ, tl = tok % SEQ;
        const bf16* Hb = H + (size_t)b * SEQ * NHC;
        float o1[2], o2[2], l1, l2;
        naive_attn_row<2>(H + (size_t)tok * NHC + HC_DQ + (2 * h) * 64, Hb + HC_DK + (2 * h) * 64, Hb + HC_DV + h * 128, tl, nullptr, lane, o1, l1);
        naive_attn_row<2>(H + (size_t)tok * NHC + HC_DQ + (2 * h + 1) * 64, Hb + HC_DK + (2 * h + 1) * 64, Hb + HC_DV + h * 128, tl, nullptr, lane, o2, l2);
        const float i1 = 1.0f / l1, i2 = 1.0f / l2;
        const float d0 = o1[0] * i1 - lam * o2[0] * i2, d1 = o1[1] * i1 - lam * o2[1] * i2;
        const float rs = 1.0f / sqrtf(wave_sum(d0 * d0 + d1 * d1) * (1.0f / 128.0f) + LN_EPS);
        const float* g = A->in[I_DFNORM] + l * 512 + h * 128;
        MIX[(size_t)tok * D + 256 + h * 128 + lane] = (bf16)f2bf(d0 * rs * g[lane] * (1.0f - lam_init));
        MIX[(size_t)tok * D + 256 + h * 128 + 64 + lane] = (bf16)f2bf(d1 * rs * g[64 + lane] * (1.0f - lam_init));
    }
}
__device__ __forceinline__ void ph_dsa_naive() {
    TIDX;
    const bf16* H = WS(bf16, WS_H); bf16* MIX = WS(bf16, WS_MIX); const unsigned* MASK = WS(unsigned, WS_MASK);
    for (int task = gw; task < T * 4; task += ngw) {
        const int tok = task >> 2, h = task & 3, b = tok / SEQ, tl = tok % SEQ;
        const bf16* Hb = H + (size_t)b * SEQ * NHC;
        float o[1], ll;
        naive_attn_row<1>(H + (size_t)tok * NHC + HC_SQ + h * 64, Hb + HC_SK + h * 64, Hb + HC_SV + h * 64, tl, MASK + (size_t)tok * 64, lane, o, ll);
        MIX[(size_t)tok * D + 768 + h * 64 + lane] = (bf16)f2bf(o[0] / ll);
    }
}
__device__ __forceinline__ void ph_select(LAS unsigned char* lds) {
    TIDX;
    const float* SC = WS(float, WS_SC); unsigned* MASK = WS(unsigned, WS_MASK);
    LAS unsigned* hist = (LAS unsigned*)lds + wave * 256;
    const unsigned long long lt_mask = (1ull << lane) - 1ull;
    for (int tok = gw; tok < T; tok += ngw) {
        const int tl = tok % SEQ;
        if (tl < 256) {
            const int lo = 32 * lane; unsigned w;
            if (lo + 31 <= tl) w = 0xffffffffu; else if (lo > tl) w = 0u; else w = (2u << (tl - lo)) - 1u;
            MASK[(size_t)tok * 64 + lane] = w; continue;
        }
        unsigned key[32]; unsigned vbits = 0u;
#pragma unroll
        for (int i = 0; i < 32; ++i) { const int s = 64 * i + lane; const bool valid = s <= tl;
            const unsigned u = valid ? __float_as_uint(SC[(size_t)tok * SEQ + s]) : 0u;
            key[i] = valid ? ((u >> 31) ? ~u : (u | 0x80000000u)) : 0u; vbits |= valid ? (1u << i) : 0u; }
        unsigned prefix = 0u; int need = 256;
#pragma unroll
        for (int pass = 0; pass < 4; ++pass) {
            const int shift = 24 - 8 * pass;
            hist[4 * lane + 0] = 0u; hist[4 * lane + 1] = 0u; hist[4 * lane + 2] = 0u; hist[4 * lane + 3] = 0u;
            LDS_WAIT(); asm volatile("" ::: "memory");
#pragma unroll
            for (int i = 0; i < 32; ++i) { const bool in = ((vbits >> i) & 1u) && (pass == 0 || (key[i] >> (shift + 8)) == prefix);
                if (in) (void)__hip_atomic_fetch_add(&hist[(key[i] >> shift) & 255u], 1u, __ATOMIC_RELAXED, __HIP_MEMORY_SCOPE_WORKGROUP); }
            LDS_WAIT(); asm volatile("" ::: "memory");
            const unsigned c0 = hist[4 * lane], c1 = hist[4 * lane + 1], c2 = hist[4 * lane + 2], c3 = hist[4 * lane + 3];
            LDS_WAIT(); asm volatile("" ::: "memory");
            const int tot = (int)(c0 + c1 + c2 + c3);
            int incl = tot;
#pragma unroll
            for (int o = 1; o < 64; o <<= 1) { const int t_ = __shfl_down(incl, o); if (lane + o < 64) incl += t_; }
            int cum = incl - tot;
            int fv = -1, fneed = 0;
            { const int cc[4] = {(int)c0, (int)c1, (int)c2, (int)c3};
#pragma unroll
              for (int j = 3; j >= 0; --j) { if (fv < 0 && cum < need && cum + cc[j] >= need) { fv = 4 * lane + j; fneed = need - cum; } cum += cc[j]; } }
            const unsigned long long fm = __ballot(fv >= 0);
            const int src = fm ? (int)__builtin_ctzll(fm) : 0;
            const int v = __shfl(fv, src); need = __shfl(fneed, src);
            prefix = (prefix << 8) | (unsigned)(v & 255);
        }
        unsigned myw = 0u; int cbefore = 0;
#pragma unroll
        for (int i = 0; i < 32; ++i) {
            const bool vld = (vbits >> i) & 1u; const bool eq = vld && key[i] == prefix, gt = vld && key[i] > prefix;
            const unsigned long long em = __ballot(eq);
            const int rank = cbefore + __popcll(em & lt_mask);
            const bool sel = gt || (eq && rank < need);
            cbefore += __popcll(em);
            const unsigned long long bm = __ballot(sel);
            if (lane == 2 * i) myw = (unsigned)bm;
            if (lane == 2 * i + 1) myw = (unsigned)(bm >> 32);
        }
        MASK[(size_t)tok * 64 + lane] = myw;
    }
}
__device__ __forceinline__ void ph_row1(int l) {
    TIDX;
    const float* xin = (l == 0) ? A->in[I_X] : WS(float, WS_XB); float* XB = WS(float, WS_XB);
    const bf16* Y = WS(bf16, WS_Y); bf16* U = WS(bf16, WS_U);
    const float* RWT = WS(float, WS_RWT) + (size_t)l * NEXP * D;
    unsigned* cnt = WS(unsigned, WS_CTL) + CW_CNT + l * NEXP; unsigned* TOK = WS(unsigned, WS_TOK);
    const float* lg = A->in[I_LN1G] + l * D; const float* lb = A->in[I_LN1B] + l * D;
    const float* rbp = A->in[I_RB] + l * NEXP;
    for (int tok = gw; tok < T; tok += ngw) {
        const int b = tok / SEQ; const float* mod = WS(float, WS_MOD) + ((size_t)l * NB + b) * 6144;
        f32x4 v[4]; float s = 0.f;
#pragma unroll
        for (int j = 0; j < 4; ++j) { const int c = 4 * lane + 256 * j;
            const f32x4 x = *(const GAS f32x4*)(xin + (size_t)tok * D + c); const f32x4 g1 = *(const f32x4*)(mod + 2048 + c);
            const unsigned long long yr = *(const GAS unsigned long long*)(Y + (size_t)tok * D + c);
            f32x4 y; y.x = __uint_as_float((unsigned)yr << 16); y.y = __uint_as_float((unsigned)yr & 0xffff0000u); y.z = __uint_as_float((unsigned)(yr >> 32) << 16); y.w = __uint_as_float((unsigned)(yr >> 32) & 0xffff0000u);
            v[j] = x * DN_ALPHA + (1.0f + g1) * y; s += (v[j].x + v[j].y) + (v[j].z + v[j].w); }
        const float mean = wave_sum(s) * (1.0f / D); float s2 = 0.f;
#pragma unroll
        for (int j = 0; j < 4; ++j) { v[j] = v[j] - mean; s2 += (v[j].x * v[j].x + v[j].y * v[j].y) + (v[j].z * v[j].z + v[j].w * v[j].w); }
        const float rstd = 1.0f / sqrtf(wave_sum(s2) * (1.0f / D) + LN_EPS);
        f32x4 u2[4];
#pragma unroll
        for (int j = 0; j < 4; ++j) { const int c = 4 * lane + 256 * j;
            const f32x4 xn = v[j] * rstd * *(const f32x4*)(lg + c) + *(const f32x4*)(lb + c);
            *(GAS f32x4*)(XB + (size_t)tok * D + c) = xn;
            u2[j] = xn * (1.0f + *(const f32x4*)(mod + 4096 + c)) + *(const f32x4*)(mod + 3072 + c);
            *(GAS unsigned long long*)(U + (size_t)tok * D + c) = (unsigned long long)pk2(u2[j].x, u2[j].y) | ((unsigned long long)pk2(u2[j].z, u2[j].w) << 32); }
        float tv[4] = {-INFINITY, -INFINITY, -INFINITY, -INFINITY}; int te[4] = {0, 0, 0, 0};
#pragma unroll 1
        for (int e = 0; e < NEXP; ++e) {
            const float* w = RWT + (size_t)e * D + 4 * lane; float a = 0.f;
#pragma unroll
            for (int j = 0; j < 4; ++j) { const f32x4 w4 = *(const f32x4*)(w + 256 * j); a += (u2[j].x * w4.x + u2[j].y * w4.y) + (u2[j].z * w4.z + u2[j].w * w4.w); }
            a = wave_sum(a) + rbp[e];
            if (a > tv[0]) { tv[3] = tv[2]; te[3] = te[2]; tv[2] = tv[1]; te[2] = te[1]; tv[1] = tv[0]; te[1] = te[0]; tv[0] = a; te[0] = e; }
            else if (a > tv[1]) { tv[3] = tv[2]; te[3] = te[2]; tv[2] = tv[1]; te[2] = te[1]; tv[1] = a; te[1] = e; }
            else if (a > tv[2]) { tv[3] = tv[2]; te[3] = te[2]; tv[2] = a; te[2] = e; }
            else if (a > tv[3]) { tv[3] = a; te[3] = e; }
        }
        const float e1 = __expf(tv[1] - tv[0]), e2 = __expf(tv[2] - tv[0]), e3 = __expf(tv[3] - tv[0]); const float inv = 1.0f / (1.0f + e1 + e2 + e3);
        if (lane < 4) { const int ek = lane == 0 ? te[0] : lane == 1 ? te[1] : lane == 2 ? te[2] : te[3]; const float pk = (lane == 0 ? 1.0f : lane == 1 ? e1 : lane == 2 ? e2 : e3) * inv;
            const unsigned pos = __hip_atomic_fetch_add(cnt + ek, 1u, __ATOMIC_RELAXED, __HIP_MEMORY_SCOPE_AGENT);
            *(GAS v4u*)(TOK + ((size_t)tok * 4 + lane) * 4) = (v4u){(unsigned)ek, pos, __float_as_uint(pk), 0u}; }
    }
}
__device__ __forceinline__ int moe_tables(LAS unsigned char* lds, int l) {
    CArgs* A = kargs();
    LAS unsigned* base = (LAS unsigned*)(lds + TAB_OFF); LAS unsigned char* tile_e = lds + TAB_OFF + 256;
    const unsigned* cnt = WS(unsigned, WS_CTL) + CW_CNT + l * NEXP;
    if (threadIdx.x == 0) { unsigned acc = 0u;
#pragma unroll 1
        for (int e = 0; e < NEXP; ++e) { const unsigned c = __hip_atomic_load(cnt + e, __ATOMIC_RELAXED, __HIP_MEMORY_SCOPE_AGENT); const unsigned nt = (c + 255u) >> 8; base[e] = acc;
#pragma unroll 1
            for (unsigned t = 0; t < nt; ++t) tile_e[(acc >> 8) + t] = (unsigned char)e; acc += nt << 8; }
        base[NEXP] = acc; }
    __syncthreads();
    return (int)(base[NEXP] >> 8);
}
__device__ __forceinline__ void ph_gather(LAS unsigned char* lds, int l) {
    TIDX;
    (void)moe_tables(lds, l);
    const LAS unsigned* base = (const LAS unsigned*)(lds + TAB_OFF);
    const unsigned* TOK = WS(unsigned, WS_TOK); const bf16* U = WS(bf16, WS_U); bf16* XG = WS(bf16, WS_XG);
    for (int task = gw; task < T * 4; task += ngw) {
        const v4u ti = *(const GAS v4u*)(TOK + (size_t)task * 4); const size_t row = (size_t)base[ti.x] + ti.y;
        const GAS v4u* src = (const GAS v4u*)(U + (size_t)(task >> 2) * D) + lane; GAS v4u* dst = (GAS v4u*)(XG + row * D) + lane;
        dst[0] = src[0]; dst[64] = src[64];
    }
    __syncthreads();
}
__device__ __forceinline__ void ph_row2(LAS unsigned char* lds, int l) {
    TIDX;
    (void)moe_tables(lds, l);
    const LAS unsigned* base = (const LAS unsigned*)(lds + TAB_OFF);
    float* XB = WS(float, WS_XB); const bf16* YM = WS(bf16, WS_YM); bf16* U = WS(bf16, WS_U); const unsigned* TOK = WS(unsigned, WS_TOK);
    const float* lg = A->in[I_LN2G] + l * D; const float* lb = A->in[I_LN2B] + l * D; const float* b2 = A->in[I_B2] + (size_t)l * NEXP * D;
    float* dst = (l == DEPTH - 1) ? A->out : XB;
    for (int tok = gw; tok < T; tok += ngw) {
        const int b = tok / SEQ; const float* mod = WS(float, WS_MOD) + ((size_t)l * NB + b) * 6144;
        f32x4 acc[4];
#pragma unroll
        for (int j = 0; j < 4; ++j) acc[j] = (f32x4){0.f, 0.f, 0.f, 0.f};
#pragma unroll
        for (int k = 0; k < 4; ++k) { const v4u ti = *(const GAS v4u*)(TOK + ((size_t)tok * 4 + k) * 4); const size_t row = (size_t)base[ti.x] + ti.y; const float p = __uint_as_float(ti.z);
#pragma unroll
            for (int j = 0; j < 4; ++j) { const int c = 4 * lane + 256 * j; const unsigned long long yr = *(const GAS unsigned long long*)(YM + row * D + c);
                f32x4 y; y.x = __uint_as_float((unsigned)yr << 16); y.y = __uint_as_float((unsigned)yr & 0xffff0000u); y.z = __uint_as_float((unsigned)(yr >> 32) << 16); y.w = __uint_as_float((unsigned)(yr >> 32) & 0xffff0000u);
                acc[j] = acc[j] + p * (y + *(const f32x4*)(b2 + (size_t)ti.x * D + c)); } }
        f32x4 v[4]; float s = 0.f;
#pragma unroll
        for (int j = 0; j < 4; ++j) { const int c = 4 * lane + 256 * j; const f32x4 x = *(const GAS f32x4*)(XB + (size_t)tok * D + c);
            v[j] = x * DN_ALPHA + (1.0f + *(const f32x4*)(mod + 5120 + c)) * acc[j]; s += (v[j].x + v[j].y) + (v[j].z + v[j].w); }
        const float mean = wave_sum(s) * (1.0f / D); float s2 = 0.f;
#pragma unroll
        for (int j = 0; j < 4; ++j) { v[j] = v[j] - mean; s2 += (v[j].x * v[j].x + v[j].y * v[j].y) + (v[j].z * v[j].z + v[j].w * v[j].w); }
        const float rstd = 1.0f / sqrtf(wave_sum(s2) * (1.0f / D) + LN_EPS);
        const float* modn = WS(float, WS_MOD) + ((size_t)(l + 1 < DEPTH ? l + 1 : l) * NB + b) * 6144;
#pragma unroll
        for (int j = 0; j < 4; ++j) { const int c = 4 * lane + 256 * j;
            const f32x4 xn = v[j] * rstd * *(const f32x4*)(lg + c) + *(const f32x4*)(lb + c);
            *(GAS f32x4*)(dst + (size_t)tok * D + c) = xn;
            if (l + 1 < DEPTH) { const f32x4 u = xn * (1.0f + *(const f32x4*)(modn + 1024 + c)) + *(const f32x4*)(modn + c);
                *(GAS unsigned long long*)(U + (size_t)tok * D + c) = (unsigned long long)pk2(u.x, u.y) | ((unsigned long long)pk2(u.z, u.w) << 32); } }
    }
    __syncthreads();
}
__global__ void __launch_bounds__(NWAVES * 64, 2) mega_fwd(Args A_) {
    extern __shared__ __attribute__((aligned(16))) unsigned char lds_raw[];
    LAS unsigned char* lds = (LAS unsigned char*)lds_raw;
    const int tid = threadIdx.x;
    volatile LAS unsigned* MISC = (volatile LAS unsigned*)(lds + MISC_OFF);
    for (int u = tid; u < (LDS_BYTES - TAB_OFF) / 4; u += NWAVES * 64) ((LAS unsigned*)(lds + TAB_OFF))[u] = 0u;
    __syncthreads();
    CArgs* A = kargs(); const bool multi = (A->s_hi - A->s_lo) > 1;
    XcdBarrier bar; bar.bar = WS(unsigned, WS_CTL) + CW_BAR + A->li * XCD_BAR_WORDS; bar.x = 0; bar.st = MISC + 8;
    if (multi) bar = xcd_barrier_post(WS(unsigned, WS_CTL) + CW_BAR + A->li * XCD_BAR_WORDS, MISC + 8);
    const int lo = A->s_lo, hi = A->s_hi;
#ifndef PHMASK
#define PHMASK 0xffffffffu
#endif
#define PHM(b) (((PHMASK) >> (b)) & 1u)
#define RUN(s) (lo <= (s) && (s) < hi)
#define SEAM(s) do { if ((s) + 1 < hi) xcd_barrier(bar); } while (0)
    if (RUN(0)) { if (PHM(0)) pro_a(lds); SEAM(0); }
    if (RUN(1)) { if (PHM(1)) pro_b(); SEAM(1); }
    for (int l = 0; l < DEPTH; ++l) {
        const int sb = 2 + NPH * l;
        if (RUN(sb + PH_IN)) { CArgs* A = kargs();
            pg8::Gemm g{WS(bf16, WS_U), WS(bf16, WS_WIN) + (size_t)l * NHC * D, T, NHC, D}; pg8::StaticOrder S; S.init(T, NHC, (int)gridDim.x, (int)blockIdx.x);
            pg8::EpiIn E{WS(bf16, WS_H), WS(float, WS_CS)};
            if (PHM(2)) pg8::gemm_phase<pg8::EpiIn, pg8::StaticOrder, true, true>(lds, g, S, E);
            SEAM(sb + PH_IN);
        }
        if (RUN(sb + PH_POST)) { if (PHM(3)) ph_post(l); SEAM(sb + PH_POST); }
        if (RUN(sb + PH_MIXA)) { if (PHM(4)) ph_idx_scores(); if (PHM(5)) ph_mlstm(lds, l); if (PHM(6)) ph_diff_naive(l); SEAM(sb + PH_MIXA); }
        if (RUN(sb + PH_SEL)) { if (PHM(7)) ph_select(lds); SEAM(sb + PH_SEL); }
        if (RUN(sb + PH_DSA)) { if (PHM(8)) ph_dsa_naive(); SEAM(sb + PH_DSA); }
        if (RUN(sb + PH_OUT)) { CArgs* A = kargs();
            pg8::Gemm g{WS(bf16, WS_MIX), WS(bf16, WS_WOUT) + (size_t)l * D * D, T, D, D}; pg8::StaticOrder S; S.init(T, D, (int)gridDim.x, (int)blockIdx.x);
            pg8::EpiBf16<0> E{WS(bf16, WS_Y), D, nullptr, 0, 0, 1.f};
            if (PHM(9)) pg8::gemm_phase<pg8::EpiBf16<0>, pg8::StaticOrder, true, true>(lds, g, S, E);
            SEAM(sb + PH_OUT);
        }
        if (RUN(sb + PH_ROW1)) { if (PHM(10)) ph_row1(l); SEAM(sb + PH_ROW1); }
        if (RUN(sb + PH_GATH)) { if (PHM(11)) ph_gather(lds, l); SEAM(sb + PH_GATH); }
        if (RUN(sb + PH_G1)) { CArgs* A = kargs();
            const int nrt = moe_tables(lds, l);
            pg8::Gemm g{WS(bf16, WS_XG), WS(bf16, WS_W1) + (size_t)l * NEXP * 2048 * D, RPAD, NEXP * 2048, D}; pg8::MoeOrder S; S.init(nrt, 8, (int)gridDim.x, (int)blockIdx.x, (const LAS unsigned char*)(lds + TAB_OFF + 256));
            pg8::EpiSwiGLU E{WS(bf16, WS_HM), A->in[I_B1] + (size_t)l * NEXP * 2048};
            if (PHM(12)) pg8::gemm_phase<pg8::EpiSwiGLU, pg8::MoeOrder, true, true>(lds, g, S, E);
            SEAM(sb + PH_G1);
        }
        if (RUN(sb + PH_G2)) { CArgs* A = kargs();
            const int nrt = moe_tables(lds, l);
            pg8::Gemm g{WS(bf16, WS_HM), WS(bf16, WS_W2) + (size_t)l * NEXP * D * D, RPAD, NEXP * D, D}; pg8::MoeOrder S; S.init(nrt, 4, (int)gridDim.x, (int)blockIdx.x, (const LAS unsigned char*)(lds + TAB_OFF + 256));
            pg8::EpiBf16<0> E{WS(bf16, WS_YM), D, nullptr, D, 0, 1.f};
            if (PHM(13)) pg8::gemm_phase<pg8::EpiBf16<0>, pg8::MoeOrder, true, true>(lds, g, S, E);
            SEAM(sb + PH_G2);
        }
        if (RUN(sb + PH_ROW2)) { if (PHM(14)) ph_row2(lds, l); SEAM(sb + PH_ROW2); }
    }
#undef RUN
#undef SEAM
}

#ifndef MK_STEPS_PER_LAUNCH
#define MK_STEPS_PER_LAUNCH 1
#endif
extern "C" void kernel_launch(void* const* d_in, const int* in_sizes, int n_in, void* d_out, int out_size, void* d_ws, size_t ws_size, hipStream_t stream) {
    static int grid = 0;
    if (grid == 0) {
        if (n_in != 25 || out_size != T * D || ws_size < WS_END) { fprintf(stderr, "kernel_launch: unexpected shapes (n_in %d out %d ws %zu)\n", n_in, out_size, ws_size); grid = -1; return; }
        int dev = 0, cus = 0, per_cu = 0;
        if (hipGetDevice(&dev) != hipSuccess || hipDeviceGetAttribute(&cus, hipDeviceAttributeMultiprocessorCount, dev) != hipSuccess) { grid = -1; return; }
        if (hipFuncSetAttribute((const void*)mega_fwd, hipFuncAttributeMaxDynamicSharedMemorySize, LDS_BYTES) != hipSuccess) { fprintf(stderr, "kernel_launch: hipFuncSetAttribute failed\n"); grid = -1; return; }
        if (hipOccupancyMaxActiveBlocksPerMultiprocessor(&per_cu, (const void*)mega_fwd, NWAVES * 64, LDS_BYTES) != hipSuccess || per_cu < 1) { fprintf(stderr, "kernel_launch: occupancy query says %d\n", per_cu); }
        (void)hipGetLastError();
        grid = cus;
    }
    if (grid < 0) return;
    if (hipMemsetAsync((char*)d_ws + WS_CTL, 0, CTL_ZERO_BYTES, stream) != hipSuccess) return;
    Args a{};
    for (int i = 0; i < 25; ++i) a.in[i] = (const float*)d_in[i];
    a.out = (float*)d_out; a.ws = (unsigned char*)d_ws;
    int li = 0;
    for (int s = 0; s < NSTEPS; s += MK_STEPS_PER_LAUNCH, ++li) {
        a.s_lo = s; a.s_hi = (s + MK_STEPS_PER_LAUNCH < NSTEPS) ? s + MK_STEPS_PER_LAUNCH : NSTEPS; a.li = li; a.pad = 0;
        hipLaunchKernelGGL(mega_fwd, dim3(grid), dim3(NWAVES * 64), LDS_BYTES, stream, a);
    }
}
```

```cpp
#include <hip/hip_runtime.h>
#include <cstdio>
#include <cstdint>

namespace pg8 {
#define PG8_LAS __attribute__((address_space(3)))
typedef unsigned short bf16_t;
typedef short bf16x8 __attribute__((ext_vector_type(8)));
typedef float f32x4 __attribute__((ext_vector_type(4)));
typedef unsigned u32x4 __attribute__((ext_vector_type(4)));
constexpr int BM = 256, BK = 64, HALF = 128, HTB = HALF * BK * 2  , STAGE_BYTES = 8 * HTB, NXCD = 8, WGM = 8;

__host__ __device__ __forceinline__ int lds_byte(int r, int c) { const int st = (r >> 4) * 2 + (c >> 5), rr = r & 15, cc = c & 31, ob = rr * 64 + cc * 2; return st * 1024 + (ob ^ (((ob >> 9) & 1) << 5)); }
__host__ __device__ __forceinline__ void stage_rc(int b, int& R, int& C) { const int st = b / 1024, sb = b % 1024, swz = sb ^ (((sb >> 9) & 1) << 5); R = (st >> 1) * 16 + swz / 64; C = (st & 1) * 32 + (swz % 64) / 2; }
__host__ __device__ __forceinline__ int perm32(int rho) { const int n = rho >> 4, i = rho & 15; return 8 * (i >> 2) + 4 * n + (i & 3); }

struct Unit { int pm, pn; };
struct Gemm { const bf16_t* A; const bf16_t* Bt; int M, N, K; };

struct StaticOrder {
    int nM, nN, nwg, G, c;
    __host__ __device__ void init(int M, int N, int G_, int c_) { nM = M / BM; nN = N / BM; nwg = nM * nN; G = G_; c = c_; }
    __host__ __device__ bool next(int i, Unit& u) const {
        const long L = (long)i * G + c; if (L >= nwg) return false;
        int wgid = (int)L; { const int q = nwg / NXCD, r = nwg % NXCD, xcd = wgid % NXCD, off = wgid / NXCD; wgid = (xcd < r ? xcd * (q + 1) : r * (q + 1) + (xcd - r) * q) + off; }
        const int nig = WGM * nN, gid = wgid / nig, fm = gid * WGM, gsz = (nM - fm) < WGM ? (nM - fm) : WGM;
        u.pm = fm + ((wgid % nig) % gsz); u.pn = (wgid % nig) / gsz; return true;
    }
    __device__ __forceinline__ void a_ready(const Unit&) const {}
    __device__ __forceinline__ void done(const Unit&) const {}
};
struct MoeOrder {
    int nM, nN, nwg, G, c; const PG8_LAS unsigned char* tile_e;
    __device__ void init(int nRT, int NTN, int G_, int c_, const PG8_LAS unsigned char* te) { nM = nRT; nN = NTN; nwg = nM * nN; G = G_; c = c_; tile_e = te; }
    __device__ bool next(int i, Unit& u) const {
        const long L = (long)i * G + c; if (L >= nwg) return false;
        int wgid = (int)L; { const int q = nwg / NXCD, r = nwg % NXCD, xcd = wgid % NXCD, off = wgid / NXCD; wgid = (xcd < r ? xcd * (q + 1) : r * (q + 1) + (xcd - r) * q) + off; }
        const int nig = WGM * nN, gid = wgid / nig, fm = gid * WGM, gsz = (nM - fm) < WGM ? (nM - fm) : WGM;
        u.pm = fm + ((wgid % nig) % gsz); const int pl = (wgid % nig) / gsz; u.pn = (int)tile_e[u.pm] * nN + pl; return true;
    }
    __device__ __forceinline__ void a_ready(const Unit&) const {}
    __device__ __forceinline__ void done(const Unit&) const {}
};
__device__ __forceinline__ unsigned cvt_pk_bf16(float lo, float hi) { unsigned r; asm volatile("v_cvt_pk_bf16_f32 %0, %1, %2" : "=v"(r) : "v"(lo), "v"(hi)); return r; }
typedef float f32x2 __attribute__((ext_vector_type(2)));
__device__ __forceinline__ f32x2 gelu_pk(f32x2 v) {
    const f32x2 av = __builtin_elementwise_abs(v), d = av * 0.2316418882f + 1.0f;
    f32x2 t; t.x = __builtin_amdgcn_rcpf(d.x); t.y = __builtin_amdgcn_rcpf(d.y);
    f32x2 q = t * 0.5307027145f + (-0.7265760135f); q = q * t + 0.7107068705f; q = q * t + (-0.142248368f); q = q * t + 0.127414796f; q = q * t;
    const f32x2 s = (v * v) * (-0.72134752044f);
    f32x2 e; e.x = __builtin_amdgcn_exp2f(s.x); e.y = __builtin_amdgcn_exp2f(s.y);
    const f32x2 m = v * (q * e), r = v - m;
    f32x2 o; o.x = v.x < 0.f ? m.x : r.x; o.y = v.y < 0.f ? m.y : r.y; return o;
}

template <int ACT  > struct EpiBf16 {
    static constexpr bool PERM = true, AFTER_DRAIN = false; static_assert(ACT == 0 || ACT == 1, "EpiBf16: ACT is 0 (none) or 1 (gelu_pk)");
    bf16_t* O; int ldc; const float* bias; int split_cols; size_t split_stride; float scale0;
    __device__ __forceinline__ void operator()(const f32x4 (&acc)[2][2][4][2], const Unit& u, int wr, int wc, int fr, int fq) const {
        const int row0 = u.pm * BM + wr * 64 + fr; int colt = u.pn * BM; bf16_t* base = O;
        float sc = 1.f; if (split_cols) { const int t = colt / split_cols; base += (size_t)t * split_stride; colt -= t * split_cols; if (t == 0) sc = scale0; }
        const int col0 = colt + wc * 32 + 8 * fq, bcol0 = u.pn * BM + wc * 32 + 8 * fq;
        f32x4 bv[2][2];
#pragma unroll
        for (int bj = 0; bj < 2; ++bj)
#pragma unroll
            for (int n = 0; n < 2; ++n) bv[bj][n] = bias ? *(const f32x4*)(bias + bcol0 + bj * HALF + 4 * n) : (f32x4){0.f, 0.f, 0.f, 0.f};
#pragma unroll
        for (int ai = 0; ai < 2; ++ai)
#pragma unroll
            for (int m = 0; m < 4; ++m) { bf16_t* rowp = base + (size_t)(row0 + ai * HALF + m * 16) * ldc + col0;
#pragma unroll
                for (int bj = 0; bj < 2; ++bj) { f32x4 v0 = acc[ai][bj][m][0] + bv[bj][0], v1 = acc[ai][bj][m][1] + bv[bj][1];
                    if (ACT == 1) { f32x2 a = gelu_pk((f32x2){v0[0], v0[1]}), b = gelu_pk((f32x2){v0[2], v0[3]}), c = gelu_pk((f32x2){v1[0], v1[1]}), d = gelu_pk((f32x2){v1[2], v1[3]});
                        v0 = (f32x4){a.x, a.y, b.x, b.y}; v1 = (f32x4){c.x, c.y, d.x, d.y}; }
                    v0 = v0 * sc; v1 = v1 * sc; u32x4 w; w.x = cvt_pk_bf16(v0[0], v0[1]); w.y = cvt_pk_bf16(v0[2], v0[3]); w.z = cvt_pk_bf16(v1[0], v1[1]); w.w = cvt_pk_bf16(v1[2], v1[3]);
                    *(u32x4*)(rowp + bj * HALF) = w; } }
    }
};
constexpr float C2 = 0.125f * 1.4426950408889634f;
struct EpiIn {
    static constexpr bool PERM = true, AFTER_DRAIN = false;
    bf16_t* O; const float* cs;
    __device__ __forceinline__ void operator()(const f32x4 (&acc)[2][2][4][2], const Unit& u, int wr, int wc, int fr, int fq) const {
        const int pn = u.pn;
        const bool rope = (0x6CF0 >> pn) & 1;
        const float sc = ((0x0430 >> pn) & 1) ? C2 : 1.f;
        const int row0 = u.pm * BM + wr * 64 + fr, col0 = pn * BM + wc * 32 + 8 * fq, i0 = (wc & 1) * 16 + 4 * fq;
#pragma unroll
        for (int ai = 0; ai < 2; ++ai)
#pragma unroll
            for (int m = 0; m < 4; ++m) {
                const int row = row0 + ai * HALF + m * 16;
                f32x4 c01 = (f32x4){1.f, 0.f, 1.f, 0.f}, c23 = c01;
                if (rope) { c01 = *(const f32x4*)(cs + (size_t)row * 64 + i0 * 2); c23 = *(const f32x4*)(cs + (size_t)row * 64 + i0 * 2 + 4); }
                bf16_t* rowp = O + (size_t)row * 4096 + col0;
#pragma unroll
                for (int bj = 0; bj < 2; ++bj) {
                    f32x4 v0 = acc[ai][bj][m][0], v1 = acc[ai][bj][m][1];
                    if (rope) {
                        f32x4 r0, r1;
                        r0[0] = v0[0] * c01[0] - v0[1] * c01[1]; r0[1] = v0[1] * c01[0] + v0[0] * c01[1];
                        r0[2] = v0[2] * c01[2] - v0[3] * c01[3]; r0[3] = v0[3] * c01[2] + v0[2] * c01[3];
                        r1[0] = v1[0] * c23[0] - v1[1] * c23[1]; r1[1] = v1[1] * c23[0] + v1[0] * c23[1];
                        r1[2] = v1[2] * c23[2] - v1[3] * c23[3]; r1[3] = v1[3] * c23[2] + v1[2] * c23[3];
                        v0 = r0; v1 = r1;
                    }
                    v0 = v0 * sc; v1 = v1 * sc;
                    u32x4 w; w.x = cvt_pk_bf16(v0[0], v0[1]); w.y = cvt_pk_bf16(v0[2], v0[3]); w.z = cvt_pk_bf16(v1[0], v1[1]); w.w = cvt_pk_bf16(v1[2], v1[3]);
                    *(u32x4*)(rowp + bj * HALF) = w;
                }
            }
    }
};
struct EpiSwiGLU {
    static constexpr bool PERM = true, AFTER_DRAIN = false;
    bf16_t* O; const float* b1;
    __device__ __forceinline__ void operator()(const f32x4 (&acc)[2][2][4][2], const Unit& u, int wr, int wc, int fr, int fq) const {
        const int e = u.pn >> 3, pl = u.pn & 7, colh = pl * 128 + wc * 32 + 8 * fq;
        const float* bp = b1 + (size_t)e * 2048 + colh;
        f32x4 bg[2], bu[2];
#pragma unroll
        for (int n = 0; n < 2; ++n) { bg[n] = *(const f32x4*)(bp + 4 * n); bu[n] = *(const f32x4*)(bp + 1024 + 4 * n); }
        const int row0 = u.pm * BM + wr * 64 + fr;
#pragma unroll
        for (int ai = 0; ai < 2; ++ai)
#pragma unroll
            for (int m = 0; m < 4; ++m) {
                f32x4 o[2];
#pragma unroll
                for (int n = 0; n < 2; ++n) {
                    const f32x4 g4 = acc[ai][0][m][n] + bg[n], u4 = acc[ai][1][m][n] + bu[n];
#pragma unroll
                    for (int c = 0; c < 4; ++c) {
                        const float g = fminf(g4[c], 7.0f), up = fminf(fmaxf(u4[c], -7.0f), 7.0f);
                        const float sg = __builtin_amdgcn_rcpf(1.0f + __builtin_amdgcn_exp2f(-1.702f * 1.4426950408889634f * g));
                        o[n][c] = (up + 1.0f) * (g * sg);
                    }
                }
                u32x4 w; w.x = cvt_pk_bf16(o[0][0], o[0][1]); w.y = cvt_pk_bf16(o[0][2], o[0][3]); w.z = cvt_pk_bf16(o[1][0], o[1][1]); w.w = cvt_pk_bf16(o[1][2], o[1][3]);
                *(u32x4*)(O + (size_t)(row0 + ai * HALF + m * 16) * 1024 + colh) = w;
            }
    }
};
template <class Epi, class Sched, bool ALIGN_EPI = false, bool SP2 = false>
__device__ __forceinline__ void gemm_phase(PG8_LAS unsigned char* lds, const Gemm g, const Sched& S, const Epi& E) {
    const int tid = threadIdx.x, wid = __builtin_amdgcn_readfirstlane(tid >> 6), lane = tid & 63, wr = wid >> 2, wc = wid & 3, fr = lane & 15, fq = lane >> 4;
    const int K = g.K, nt = K / BK;
    unsigned voffA[2], voffB[2];
#pragma unroll
    for (int i = 0; i < 2; ++i) { int R, C; stage_rc(tid * 16 + i * 8192, R, C); const int Rb = Epi::PERM ? ((R & ~31) + perm32(R & 31)) : R;
        voffA[i] = (unsigned)(R * K + C) * 2u; voffB[i] = (unsigned)(Rb * K + C) * 2u; }
    const size_t kstep = (size_t)(BK * 2);
    const size_t hstep = (size_t)HALF * K * 2;
    const size_t tstep = 2 * hstep;
    const unsigned ldsw = (unsigned)wid * 1024u;
    const int aoff = lds_byte(wr * 64 + fr, fq * 8), boff = lds_byte(wc * 32 + fr, fq * 8);
#define PG8_SA(b, h) (((b) * 2 + (h)) * HTB)
#define PG8_SB(b, h) ((4 + (b) * 2 + (h)) * HTB)
#define PG8_STAGE(bufoff, gbase, voff) do { _Pragma("unroll") for (int _i = 0; _i < 2; ++_i) \
        __builtin_amdgcn_global_load_lds((const unsigned*)((const char*)(gbase) + (voff)[_i]), (PG8_LAS unsigned*)(lds + (bufoff) + ldsw + _i * 8192), 16, 0, 0); } while (0)
#define PG8_LDA(dst, b, h) do { _Pragma("unroll") for (int m = 0; m < 4; ++m) _Pragma("unroll") for (int k = 0; k < 2; ++k) dst[m][k] = *(const PG8_LAS bf16x8*)(lds + PG8_SA(b, h) + aoff + m * 2048 + k * 1024); } while (0)
#define PG8_LDB(dst, b, h) do { _Pragma("unroll") for (int n = 0; n < 2; ++n) _Pragma("unroll") for (int k = 0; k < 2; ++k) dst[n][k] = *(const PG8_LAS bf16x8*)(lds + PG8_SB(b, h) + boff + n * 2048 + k * 1024); } while (0)
#define PG8_MMA(ai, bj, At, Bt) do { __builtin_amdgcn_s_setprio(1); _Pragma("unroll") for (int m = 0; m < 4; ++m) _Pragma("unroll") for (int n = 0; n < 2; ++n) _Pragma("unroll") for (int k = 0; k < 2; ++k) \
        acc[ai][bj][m][n] = __builtin_amdgcn_mfma_f32_16x16x32_bf16(Bt[n][k], At[m][k], acc[ai][bj][m][n], 0, 0, 0); __builtin_amdgcn_s_setprio(0); } while (0)
#define PG8_WAIT_V(n) asm volatile("s_waitcnt vmcnt(" #n ")" ::: "memory")
#define PG8_WAIT_L(n) asm volatile("s_waitcnt lgkmcnt(" #n ")" ::: "memory")
#define PG8_BAR __builtin_amdgcn_s_barrier()
#define PG8_SCHED __builtin_amdgcn_sched_barrier(0)
    Unit cur, nxt; int ui = 0;
    if (!S.next(0, cur)) return;
    f32x4 acc[2][2][4][2];
#pragma unroll
    for (int a = 0; a < 2; ++a)
#pragma unroll
        for (int b = 0; b < 2; ++b)
#pragma unroll
            for (int m = 0; m < 4; ++m)
#pragma unroll
                for (int n = 0; n < 2; ++n) acc[a][b][m][n] = (f32x4){0.f, 0.f, 0.f, 0.f};
    bf16x8 At[4][2], B0[2][2], B1[2][2];
    const char* cA = (const char*)g.A + (size_t)cur.pm * tstep; const char* cB = (const char*)g.Bt + (size_t)cur.pn * tstep;
    S.a_ready(cur);
    if constexpr (SP2) {
        PG8_STAGE(PG8_SB(0, 0), cB, voffB); PG8_STAGE(PG8_SB(0, 1), cB + hstep, voffB); PG8_STAGE(PG8_SA(0, 0), cA, voffA); PG8_STAGE(PG8_SA(0, 1), cA + hstep, voffA);
        if (wr == 1) PG8_BAR;
        PG8_WAIT_V(2); PG8_BAR;
        PG8_STAGE(PG8_SB(1, 0), cB + kstep, voffB); PG8_STAGE(PG8_SA(1, 0), cA + kstep, voffA); PG8_STAGE(PG8_SB(1, 1), cB + hstep + kstep, voffB);
        PG8_WAIT_V(6); PG8_BAR;
    } else {
        PG8_STAGE(PG8_SB(0, 0), cB, voffB); PG8_STAGE(PG8_SA(0, 0), cA, voffA); PG8_STAGE(PG8_SB(0, 1), cB + hstep, voffB); PG8_STAGE(PG8_SA(0, 1), cA + hstep, voffA);
        if (wr == 1) PG8_BAR;
        PG8_WAIT_V(4); PG8_BAR;
        PG8_STAGE(PG8_SB(1, 0), cB + kstep, voffB); PG8_STAGE(PG8_SA(1, 0), cA + kstep, voffA); PG8_STAGE(PG8_SB(1, 1), cB + hstep + kstep, voffB);
        PG8_WAIT_V(6); PG8_BAR;
    }
    for (;;) {
        const bool has_next = S.next(ui + 1, nxt);
        const char* nA = has_next ? (const char*)g.A + (size_t)nxt.pm * tstep : cA; const char* nB = has_next ? (const char*)g.Bt + (size_t)nxt.pn * tstep : cB;
        for (int t = 0; t < nt; t += 2) {
            const bool last = (t == nt - 2);
            const char* a1 = cA + (size_t)(t + 1) * kstep;
            const char* a2 = last ? nA : cA + (size_t)(t + 2) * kstep; const char* b2 = last ? nB : cB + (size_t)(t + 2) * kstep;
            const char* a3 = a2 + kstep; const char* b3 = b2 + kstep;
            if (last && has_next) S.a_ready(nxt);
            if constexpr (SP2) {
            PG8_LDB(B0, 0, 0); PG8_LDB(B1, 0, 1); PG8_SCHED; PG8_LDA(At, 0, 0); PG8_STAGE(PG8_SA(1, 1), a1 + hstep, voffA);
            PG8_WAIT_V(8); PG8_WAIT_L(0); PG8_BAR; PG8_MMA(0, 0, At, B0); PG8_MMA(0, 1, At, B1); PG8_BAR; PG8_SCHED;
            PG8_LDA(At, 0, 1); PG8_STAGE(PG8_SB(0, 0), b2, voffB); PG8_STAGE(PG8_SB(0, 1), b2 + hstep, voffB); PG8_STAGE(PG8_SA(0, 0), a2, voffA);
            PG8_WAIT_V(8); PG8_WAIT_L(0); PG8_BAR; PG8_MMA(1, 0, At, B0); PG8_MMA(1, 1, At, B1); PG8_BAR; PG8_SCHED;
            PG8_LDB(B0, 1, 0); PG8_LDB(B1, 1, 1); PG8_SCHED; PG8_LDA(At, 1, 0); PG8_STAGE(PG8_SA(0, 1), a2 + hstep, voffA);
            PG8_WAIT_V(8); PG8_WAIT_L(0); PG8_BAR; PG8_MMA(0, 0, At, B0); PG8_MMA(0, 1, At, B1); PG8_BAR; PG8_SCHED;
            PG8_LDA(At, 1, 1); PG8_STAGE(PG8_SB(1, 0), b3, voffB); PG8_STAGE(PG8_SB(1, 1), b3 + hstep, voffB); PG8_STAGE(PG8_SA(1, 0), a3, voffA);
            PG8_WAIT_V(8); PG8_WAIT_L(0); PG8_BAR; PG8_MMA(1, 0, At, B0); PG8_MMA(1, 1, At, B1); PG8_BAR; PG8_SCHED;
            } else {
            PG8_LDB(B0, 0, 0); PG8_SCHED; PG8_LDA(At, 0, 0); PG8_STAGE(PG8_SA(1, 1), a1 + hstep, voffA);
            PG8_WAIT_L(8); PG8_BAR; PG8_WAIT_L(0); PG8_MMA(0, 0, At, B0); PG8_BAR; PG8_SCHED;
            PG8_LDB(B1, 0, 1); PG8_STAGE(PG8_SB(0, 0), b2, voffB);
            PG8_BAR; PG8_WAIT_L(0); PG8_MMA(0, 1, At, B1); PG8_BAR;
            PG8_LDA(At, 0, 1); PG8_STAGE(PG8_SA(0, 0), a2, voffA);
            PG8_BAR; PG8_WAIT_L(0); PG8_MMA(1, 0, At, B0); PG8_BAR; PG8_SCHED;
            PG8_STAGE(PG8_SB(0, 1), b2 + hstep, voffB);
            PG8_WAIT_V(6); PG8_BAR; PG8_MMA(1, 1, At, B1); PG8_BAR;
            PG8_LDB(B0, 1, 0); PG8_SCHED; PG8_LDA(At, 1, 0); PG8_STAGE(PG8_SA(0, 1), a2 + hstep, voffA);
            PG8_WAIT_L(8); PG8_BAR; PG8_WAIT_L(0); PG8_MMA(0, 0, At, B0); PG8_BAR; PG8_SCHED;
            PG8_LDB(B1, 1, 1); PG8_STAGE(PG8_SB(1, 0), b3, voffB);
            PG8_BAR; PG8_WAIT_L(0); PG8_MMA(0, 1, At, B1); PG8_BAR;
            PG8_LDA(At, 1, 1); PG8_STAGE(PG8_SA(1, 0), a3, voffA);
            PG8_BAR; PG8_WAIT_L(0); PG8_MMA(1, 0, At, B0); PG8_BAR; PG8_SCHED;
            PG8_STAGE(PG8_SB(1, 1), b3 + hstep, voffB);
            PG8_WAIT_V(6); PG8_BAR; PG8_MMA(1, 1, At, B1); PG8_BAR;
            }
        }
        if constexpr (ALIGN_EPI) { if (wr == 0) PG8_BAR; }
        if constexpr (!Epi::AFTER_DRAIN) { E(acc, cur, wr, wc, fr, fq); S.done(cur); }
        if (!has_next) break;
#pragma unroll
        for (int a = 0; a < 2; ++a)
#pragma unroll
            for (int b = 0; b < 2; ++b)
#pragma unroll
                for (int m = 0; m < 4; ++m)
#pragma unroll
                    for (int n = 0; n < 2; ++n) acc[a][b][m][n] = (f32x4){0.f, 0.f, 0.f, 0.f};
        cur = nxt; cA = nA; cB = nB; ++ui;
        if constexpr (ALIGN_EPI) { if (wr == 1) PG8_BAR; }
    }
    PG8_WAIT_V(0);
    if constexpr (!ALIGN_EPI) { if (wr == 0) PG8_BAR; }
    PG8_BAR;
    if constexpr (Epi::AFTER_DRAIN) { E.fused(acc, cur, wr, wc, fr, fq, lds, wid, lane); S.done(cur); }
#undef PG8_SA
#undef PG8_SB
#undef PG8_STAGE
#undef PG8_LDA
#undef PG8_LDB
#undef PG8_MMA
#undef PG8_WAIT_V
#undef PG8_WAIT_L
#undef PG8_BAR
#undef PG8_SCHED
}
}
#define GAS __attribute__((address_space(1)))
#define LAS __attribute__((address_space(3)))
typedef unsigned short bf16;
typedef unsigned v4u __attribute__((ext_vector_type(4)));
typedef float f32x4 __attribute__((ext_vector_type(4)));
typedef short bf16x8 __attribute__((ext_vector_type(8)));
typedef GAS unsigned gu32;
typedef GAS unsigned long long gu64;
#define RLX_AGENT __ATOMIC_RELAXED, __HIP_MEMORY_SCOPE_AGENT
#define LDS_WAIT() asm volatile("s_waitcnt lgkmcnt(0)" ::: "memory")
#define VM_WAIT() asm volatile("s_waitcnt vmcnt(0)" ::: "memory")
__device__ __forceinline__ unsigned long long rt() { return __builtin_amdgcn_s_memrealtime(); }
__device__ __forceinline__ unsigned f2bf(float f) { unsigned u = __builtin_bit_cast(unsigned, f); return (u + 0x7fffu + ((u >> 16) & 1u)) >> 16; }
__device__ __forceinline__ unsigned pk2(float lo, float hi) { return f2bf(lo) | (f2bf(hi) << 16); }
#define XB_TMO      128
#define XB_XCNT(j)  (256  + 64 * (j))
#define XB_XSUB(j)  (1280 + 64 * (j))
#define XB_XGEN(j)  (2304 + 64 * (j))
#define XB_TOP      3328
#define XB_TOPGEN   3392
#define XCD_BAR_WORDS 3456
#define XB_SPIN_CAP (1u << 20)

__device__ __forceinline__ unsigned xb_ld(unsigned* p)              { return __hip_atomic_load(p, __ATOMIC_RELAXED, __HIP_MEMORY_SCOPE_AGENT); }
__device__ __forceinline__ unsigned xb_add(unsigned* p, unsigned v) { return __hip_atomic_fetch_add(p, v, __ATOMIC_RELAXED, __HIP_MEMORY_SCOPE_AGENT); }
__device__ __forceinline__ unsigned xb_xcc_id() { return (unsigned)__builtin_amdgcn_s_getreg((3 << 11) | 20) & 0xFu; }
#define XB_SPIN(cond, bar) do { unsigned _sp = 0; while (cond) { __builtin_amdgcn_s_sleep(1); \
    if ((++_sp & 255u) == 0u) { if (xb_ld(&(bar)[XB_TMO])) break; if (_sp > XB_SPIN_CAP) { atomicAdd(&(bar)[XB_TMO], 1u); break; } } } } while (0)

struct XcdBarrier {
    unsigned* bar; unsigned x;
    volatile LAS unsigned* st;
};

__device__ __forceinline__ XcdBarrier xcd_barrier_post(unsigned* bar, volatile LAS unsigned* st) {
    XcdBarrier b; b.bar = bar; b.x = xb_xcc_id(); b.st = st;
    if (threadIdx.x == 0) (void)xb_add(&bar[XB_XCNT(b.x)], 1u);
    return b;
}
__device__ __forceinline__ void xcd_barrier_complete(unsigned* bar, unsigned x, unsigned& nloc, unsigned& nx) {
    const unsigned G = gridDim.x * gridDim.y * gridDim.z;
    unsigned sum, cnt, mine, sp = 0u;
    for (;;) {
        sum = 0u; cnt = 0u; mine = 0u;
#pragma unroll
        for (unsigned j = 0; j < 16; ++j) { const unsigned c = xb_ld(&bar[XB_XCNT(j)]); sum += c; cnt += (c > 0u) ? 1u : 0u; mine = (j == x) ? c : mine; }
        if (sum == G) break;
        __builtin_amdgcn_s_sleep(1);
        if ((++sp & 255u) == 0u) { if (xb_ld(&bar[XB_TMO])) break; if (sp > XB_SPIN_CAP) { atomicAdd(&bar[XB_TMO], 1u); break; } }
    }
    nloc = mine > 0u ? mine : 1u; nx = cnt > 0u ? cnt : 1u;
}

__device__ __forceinline__ void xcd_barrier(const XcdBarrier& b) {
    asm volatile("s_waitcnt vmcnt(0)" ::: "memory");
    __syncthreads();
    if (threadIdx.x == 0) {
        unsigned* bar = b.bar;
        __builtin_amdgcn_s_waitcnt(0);
        unsigned nloc = b.st[0], nx = b.st[1];
        if (nloc == 0u) { xcd_barrier_complete(bar, b.x, nloc, nx); b.st[0] = nloc; b.st[1] = nx; }
        const unsigned old = xb_add(&bar[XB_XSUB(b.x)], 1u);
        const unsigned gen = old / nloc;
        if (old + 1u == (gen + 1u) * nloc) {
            __builtin_amdgcn_fence(__ATOMIC_RELEASE, "agent");
            asm volatile("s_waitcnt vmcnt(0)" ::: "memory");
            const unsigned og = xb_add(&bar[XB_TOP], 1u);
            const unsigned tg = og / nx;
            if (og + 1u == (tg + 1u) * nx) xb_add(&bar[XB_TOPGEN], 1u);
            else XB_SPIN(xb_ld(&bar[XB_TOPGEN]) == tg, bar);
            __builtin_amdgcn_fence(__ATOMIC_ACQUIRE, "agent");
            xb_add(&bar[XB_XGEN(b.x)], 1u);
            asm volatile("s_waitcnt vmcnt(0)" ::: "memory");
        } else {
            XB_SPIN(xb_ld(&bar[XB_XGEN(b.x)]) == gen, bar);
            __builtin_amdgcn_fence(__ATOMIC_ACQUIRE, "agent");
            asm volatile("s_waitcnt vmcnt(0)" ::: "memory");
        }
    }
    __syncthreads();
}
constexpr int NB = 16, SEQ = 2048, T = NB * SEQ, D = 1024, DEPTH = 4, NHC = 4096, NEXP = 32, NWAVES = 8;
constexpr int NIN = 3920;
constexpr float LN_EPS = 1e-5f, DN_ALPHA = 1.6817928305074290f;
constexpr int RPAD = T * 4 + NEXP * 256;
constexpr int HC_MQ = 0, HC_MK = 256, HC_MV = 512, HC_MO = 768, HC_DQ = 1024, HC_DK = 1536, HC_DV = 2048, HC_SQ = 2560, HC_SK = 2816, HC_SV = 3072, HC_XQ = 3328, HC_XK = 3840, HC_MI = 3904, HC_MF = 3908, HC_XW = 3912;
constexpr size_t MiB = 1u << 20;
constexpr size_t WS_CTL = 0, CTL_ZERO_BYTES = 2 * MiB;
constexpr size_t WS_MOD = 2 * MiB;
constexpr size_t WS_LAM = WS_MOD + 7 * MiB / 4;
constexpr size_t WS_RWT = 4 * MiB;
constexpr size_t WS_CS = 8 * MiB;
constexpr size_t WS_WIN = 16 * MiB;
constexpr size_t WS_WOUT = 48 * MiB;
constexpr size_t WS_W1 = 64 * MiB;
constexpr size_t WS_W2 = 576 * MiB;
constexpr size_t WS_XB = 832 * MiB;
constexpr size_t WS_U = 960 * MiB;
constexpr size_t WS_H = 1024 * MiB;
constexpr size_t WS_QKC = 1280 * MiB;
constexpr size_t WS_XKP = 1312 * MiB;
constexpr size_t WS_MASK = 1316 * MiB;
constexpr size_t WS_TOK = 1324 * MiB;
constexpr size_t WS_MIX = 1344 * MiB;
constexpr size_t WS_Y = 1408 * MiB;
constexpr size_t WS_SC = 1472 * MiB;
constexpr size_t WS_XG = 1728 * MiB;
constexpr size_t WS_HM = 2000 * MiB;
constexpr size_t WS_YM = 2272 * MiB;
constexpr size_t WS_END = 2544 * MiB;
constexpr int CW_CNT = 1024;
constexpr int CW_BAR = 4096;
constexpr int RING_BYTES = 131072, TAB_OFF = RING_BYTES, MISC_OFF = RING_BYTES + 4096, LDS_BYTES = 147456;
constexpr int NPH = 11, NSTEPS = 2 + NPH * DEPTH;
enum { PH_IN = 0, PH_POST, PH_MIXA, PH_SEL, PH_DSA, PH_OUT, PH_ROW1, PH_GATH, PH_G1, PH_G2, PH_ROW2 };

__device__ __forceinline__ float bf2f(bf16 h) { return __uint_as_float((unsigned)h << 16); }
__device__ __forceinline__ float wave_sum(float v) {
#pragma unroll
    for (int o = 1; o < 64; o <<= 1) v += __shfl_xor(v, o);
    return v;
}
__device__ __forceinline__ float wave_max(float v) {
#pragma unroll
    for (int o = 1; o < 64; o <<= 1) v = fmaxf(v, __shfl_xor(v, o));
    return v;
}
__device__ __forceinline__ float sigmoidf_(float x) { return 1.0f / (1.0f + __expf(-x)); }
struct Ctx {
    LAS unsigned char* lds;
    int tid, lane, wave, gw, ngw;
    const float* in[25];
    float* out; unsigned char* ws;
};
#define WSP(type, off) ((type*)(C.ws + (off)))
enum { I_X = 0, I_C, I_POS, I_WIN, I_GATEB, I_CONVW, I_CONVB, I_MNORM, I_DFLAM, I_DFNORM, I_IDXG, I_IDXB, I_WOUT, I_ADAW, I_ADAB, I_LN1G, I_LN1B, I_LN2G, I_LN2B, I_RW, I_RB, I_W1, I_B1, I_W2, I_B2 };

__device__ __forceinline__ int in_dest_col(int n) {
    auto rp = [](int j) { const int hd = j >> 6, d = j & 63; return hd * 64 + ((d < 32) ? 2 * d : 2 * (d - 32) + 1); };
    if (n < 256) return HC_MQ + n;
    if (n < 512) return HC_MK + (n - 256);
    if (n < 768) return HC_MV + (n - 512);
    if (n < 772) return HC_MI + (n - 768);
    if (n < 776) return HC_MF + (n - 772);
    if (n < 1032) return HC_MO + (n - 776);
    if (n < 1544) return HC_DQ + rp(n - 1032);
    if (n < 2056) return HC_DK + rp(n - 1544);
    if (n < 2568) return HC_DV + (n - 2056);
    if (n < 2824) return HC_SQ + rp(n - 2568);
    if (n < 3080) return HC_SK + rp(n - 2824);
    if (n < 3336) return HC_SV + (n - 3080);
    if (n < 3848) return HC_XQ + rp(n - 3336);
    if (n < 3912) return HC_XK + (n - 3848);
    return HC_XW + (n - 3912);
}
template <class F> __device__ __forceinline__ void transpose_item(const float* W, int ldw, int K, int nvalid, int k0, int n0, bf16* WT, LAS float* scr, int lane, F drow) {
    const int nn = n0 + (lane & 31); const bool ok = nn < nvalid;
#pragma unroll 8
    for (int i = 0; i < 32; ++i) { const int kk = 2 * i + (lane >> 5); scr[kk * 33 + (lane & 31)] = ok ? W[(size_t)(k0 + kk) * ldw + nn] : 0.f; }
    LDS_WAIT(); asm volatile("" ::: "memory");
    const int c = lane & 7;
#pragma unroll
    for (int j = 0; j < 4; ++j) { const int n = (lane >> 3) + 8 * j; const LAS float* s = scr + (8 * c) * 33 + n;
        v4u o; o.x = pk2(s[0 * 33], s[1 * 33]); o.y = pk2(s[2 * 33], s[3 * 33]); o.z = pk2(s[4 * 33], s[5 * 33]); o.w = pk2(s[6 * 33], s[7 * 33]);
        if (n0 + n < nvalid) *(GAS v4u*)(WT + (size_t)drow(n0 + n) * K + k0 + 8 * c) = o; }
    LDS_WAIT(); asm volatile("" ::: "memory");
}
struct Args { const float* in[25]; float* out; unsigned char* ws; int s_lo, s_hi, li, pad; };
typedef __attribute__((address_space(4))) const Args CArgs;
__device__ __forceinline__ CArgs* kargs() { CArgs* p = (CArgs*)__builtin_amdgcn_kernarg_segment_ptr(); asm volatile("" : "+s"(p)); return p; }
#define WS(type, off) ((type*)(A->ws + (off)))
#define TIDX CArgs* A = kargs(); int tid_ = threadIdx.x; asm volatile("" : "+v"(tid_)); const int tid = tid_, lane = tid & 63, wave = __builtin_amdgcn_readfirstlane(tid >> 6); const int gw = blockIdx.x * NWAVES + wave, ngw = gridDim.x * NWAVES; (void)lane; (void)gw; (void)ngw

__device__ __forceinline__ void pro_a(LAS unsigned char* lds) {
    TIDX;
    LAS float* scr = (LAS float*)(lds + wave * 16384);
    constexpr int IT_IN = 16 * 123, IT_OUT = 16 * 32, IT_W1 = 16 * 64, IT_W2 = 16 * 32;
    constexpr int N_IN = DEPTH * IT_IN, N_OUT = DEPTH * IT_OUT, N_W1 = DEPTH * NEXP * IT_W1, N_W2 = DEPTH * NEXP * IT_W2;
    constexpr int NITEMS = N_IN + N_OUT + N_W1 + N_W2;
    for (int it = gw; it < NITEMS; it += ngw) {
        int r = it;
        if (r < N_IN) { const int l = r / IT_IN, q = r % IT_IN, kb = q / 123, nb = q % 123;
            transpose_item(A->in[I_WIN] + (size_t)l * D * NIN, NIN, D, NIN, kb * 64, nb * 32, WS(bf16, WS_WIN) + (size_t)l * NHC * D, scr, lane, [](int n) { return in_dest_col(n); }); continue; }
        r -= N_IN;
        if (r < N_OUT) { const int l = r / IT_OUT, q = r % IT_OUT, kb = q / 32, nb = q % 32;
            transpose_item(A->in[I_WOUT] + (size_t)l * D * D, D, D, D, kb * 64, nb * 32, WS(bf16, WS_WOUT) + (size_t)l * D * D, scr, lane, [](int n) { return n; }); continue; }
        r -= N_OUT;
        if (r < N_W1) { const int le = r / IT_W1, q = r % IT_W1, kb = q / 64, nb = q % 64;
            transpose_item(A->in[I_W1] + (size_t)le * D * 2048, 2048, D, 2048, kb * 64, nb * 32, WS(bf16, WS_W1) + (size_t)le * 2048 * D, scr, lane,
                           [](int n) { const int up = n >> 10, j = n & 1023; return (j >> 7) * 256 + up * 128 + (j & 127); }); continue; }
        r -= N_W1;
        { const int le = r / IT_W2, q = r % IT_W2, kb = q / 32, nb = q % 32;
            transpose_item(A->in[I_W2] + (size_t)le * D * D, D, D, D, kb * 64, nb * 32, WS(bf16, WS_W2) + (size_t)le * D * D, scr, lane, [](int n) { return n; }); }
    }
    for (int r = gw; r < DEPTH * (NHC - NIN); r += ngw) { const int l = r / (NHC - NIN), row = NIN + r % (NHC - NIN);
        GAS v4u* p = (GAS v4u*)(WS(bf16, WS_WIN) + ((size_t)l * NHC + row) * D) + lane; p[0] = (v4u){0u, 0u, 0u, 0u}; p[64] = (v4u){0u, 0u, 0u, 0u}; }
    for (int idx = blockIdx.x * 512 + tid; idx < T * 32; idx += gridDim.x * 512) {
        const int tok = idx >> 5, i = idx & 31;
        const double inv = exp(-(double)i * (9.210340371976184 / 32.0));
        const double ang = (double)((const int*)A->in[I_POS])[tok] * inv;
        const double rev = ang * 0.15915494309189535;
        const float fr = (float)(rev - rint(rev));
        float2 v; v.x = __builtin_amdgcn_cosf(fr); v.y = __builtin_amdgcn_sinf(fr);
        WS(float2, WS_CS)[idx] = v;
    }
    for (int idx = blockIdx.x * 512 + tid; idx < DEPTH * NEXP * D; idx += gridDim.x * 512) {
        const int l = idx / (NEXP * D), r = idx % (NEXP * D), e = r / D, d = r % D;
        WS(float, WS_RWT)[idx] = A->in[I_RW][((size_t)l * D + d) * NEXP + e];
    }
    if (blockIdx.x == 0 && wave == 0) {
        for (int l = 0; l < DEPTH; ++l) { const float* lf = A->in[I_DFLAM] + l * 256;
            const float a = wave_sum(lf[lane] * lf[64 + lane]), b = wave_sum(lf[128 + lane] * lf[192 + lane]);
            if (lane == 0) WS(float, WS_LAM)[l] = __expf(a) - __expf(b) + (0.8f - 0.6f * __expf(-0.3f * (float)l)); }
    }
    __syncthreads();
    if (blockIdx.x < (DEPTH * 6144) / 512) {
        LAS float* ca = (LAS float*)lds;
        for (int i = tid; i < NB * D; i += 512) { const float v = A->in[I_C][i]; ca[i] = v / (1.0f + __expf(-v)); }
        __syncthreads();
        const int col = blockIdx.x * 512 + tid, l = col / 6144, m = col % 6144;
        const float* w = A->in[I_ADAW] + (size_t)l * D * 6144 + m;
        float acc[NB];
#pragma unroll
        for (int b = 0; b < NB; ++b) acc[b] = 0.f;
        for (int d = 0; d < D; ++d) { const float wv = w[(size_t)d * 6144];
#pragma unroll
            for (int b = 0; b < NB; ++b) acc[b] += ca[b * D + d] * wv; }
        const float bias = A->in[I_ADAB][col];
#pragma unroll
        for (int b = 0; b < NB; ++b) WS(float, WS_MOD)[((size_t)l * NB + b) * 6144 + m] = acc[b] + bias;
        __syncthreads();
    }
}
__device__ __forceinline__ void pro_b() {
    TIDX;
    for (int tok = gw; tok < T; tok += ngw) {
        const int b = tok / SEQ; const float* mod = WS(float, WS_MOD) + (size_t)b * 6144;
        const GAS f32x4* xr = (const GAS f32x4*)(A->in[I_X] + (size_t)tok * D) + lane;
        GAS unsigned long long* o8 = (GAS unsigned long long*)(WS(bf16, WS_U) + (size_t)tok * D) + lane;
#pragma unroll
        for (int j = 0; j < 4; ++j) { const f32x4 x = xr[64 * j]; const f32x4 sh = *(const f32x4*)(mod + 4 * lane + 256 * j), sc = *(const f32x4*)(mod + 1024 + 4 * lane + 256 * j);
            const f32x4 u = x * (1.0f + sc) + sh; o8[64 * j] = (unsigned long long)pk2(u.x, u.y) | ((unsigned long long)pk2(u.z, u.w) << 32); }
    }
}
__device__ __forceinline__ void ph_post(int l) {
    TIDX;
    const bf16* H = WS(bf16, WS_H); bf16* XKP = WS(bf16, WS_XKP); bf16* QKC = WS(bf16, WS_QKC);
    const float* cw = A->in[I_CONVW] + (size_t)l * 4 * 512; const float* cb = A->in[I_CONVB] + (size_t)l * 512;
    const float gi = A->in[I_IDXG][l * 64 + lane], bi = A->in[I_IDXB][l * 64 + lane];
    for (int tok = gw; tok < T; tok += ngw) {
        const bf16* hrow = H + (size_t)tok * NHC;
        {
            const float v = bf2f(hrow[HC_XK + lane]);
            const float mean = wave_sum(v) * (1.0f / 64.0f); const float dv = v - mean;
            const float var = wave_sum(dv * dv) * (1.0f / 64.0f);
            const float nv = dv * (1.0f / sqrtf(var + LN_EPS)) * gi + bi;
            const float pv = __shfl_xor(nv, 32);
            const int i = lane & 31; const float2 cs = WS(float2, WS_CS)[(size_t)tok * 32 + i];
            const float o = (lane < 32) ? (nv * cs.x - pv * cs.y) : (nv * cs.x + pv * cs.y);
            XKP[(size_t)tok * 64 + 2 * i + (lane >> 5)] = (bf16)f2bf(o);
        }
        {
            const int s = tok % SEQ, c0 = 8 * lane;
            float acc[8];
#pragma unroll
            for (int c = 0; c < 8; ++c) acc[c] = cb[c0 + c];
#pragma unroll
            for (int j = 0; j < 4; ++j) {
                if (s - 3 + j >= 0) {
                    const v4u raw = *(const GAS v4u*)(H + (size_t)(tok - 3 + j) * NHC + c0);
                    const unsigned rw[4] = {raw.x, raw.y, raw.z, raw.w};
#pragma unroll
                    for (int c = 0; c < 8; ++c) { const float x = __uint_as_float((c & 1) ? (rw[c >> 1] & 0xffff0000u) : (rw[c >> 1] << 16)); acc[c] += cw[j * 512 + c0 + c] * x; }
                }
            }
            v4u o;
#define SILU(x) ((x) / (1.0f + __expf(-(x))))
            o.x = pk2(SILU(acc[0]), SILU(acc[1])); o.y = pk2(SILU(acc[2]), SILU(acc[3])); o.z = pk2(SILU(acc[4]), SILU(acc[5])); o.w = pk2(SILU(acc[6]), SILU(acc[7]));
#undef SILU
            *(GAS v4u*)(QKC + (size_t)tok * 512 + c0) = o;
        }
    }
}
typedef float f32x16 __attribute__((ext_vector_type(16)));
__device__ __forceinline__ void ph_idx_scores() {
    TIDX;
    const bf16* H = WS(bf16, WS_H); const bf16* XKP = WS(bf16, WS_XKP); float* SC = WS(float, WS_SC);
    const int r = lane & 31, hh = lane >> 5, ql = r >> 3, hd = r & 7;
    for (int unit = blockIdx.x; unit < NB * (SEQ / 32); unit += gridDim.x) {
        const int b = unit / (SEQ / 32), q0 = (unit % (SEQ / 32)) * 32 + 4 * wave, tok0 = b * SEQ + q0;
        bf16x8 af[4];
        { const bf16* ap = H + (size_t)(tok0 + ql) * NHC + HC_XQ + hd * 64 + 8 * hh;
#pragma unroll
          for (int ks = 0; ks < 4; ++ks) af[ks] = *(const GAS bf16x8*)(ap + ks * 16); }
        float wv[4][4];
#pragma unroll
        for (int q = 0; q < 4; ++q)
#pragma unroll
            for (int i = 0; i < 4; ++i) wv[q][i] = bf2f(H[(size_t)(tok0 + q) * NHC + HC_XW + 4 * hh + i]);
        const int nkt = (q0 + 3) / 32 + 1;
        for (int kt = 0; kt < nkt; ++kt) {
            const int key = kt * 32 + r;
            const bf16* kp = XKP + (size_t)(b * SEQ + key) * 64 + 8 * hh;
            f32x16 acc = {};
#pragma unroll
            for (int ks = 0; ks < 4; ++ks) { const bf16x8 bfr = *(const GAS bf16x8*)(kp + ks * 16); acc = __builtin_amdgcn_mfma_f32_32x32x16_bf16(af[ks], bfr, acc, 0, 0, 0); }
            float tot[4];
#pragma unroll
            for (int q = 0; q < 4; ++q) { float p = 0.f;
#pragma unroll
                for (int i = 0; i < 4; ++i) p += wv[q][i] * fmaxf(acc[4 * q + i], 0.f);
                tot[q] = p + __shfl_xor(p, 32); }
            const float o0 = hh ? tot[2] : tot[0], o1 = hh ? tot[3] : tot[1];
            SC[(size_t)(tok0 + 2 * hh) * SEQ + key] = o0; SC[(size_t)(tok0 + 2 * hh + 1) * SEQ + key] = o1;
        }
    }
}
__device__ __forceinline__ void ph_mlstm(LAS unsigned char* lds, int l) {
    TIDX;
    const bf16* H = WS(bf16, WS_H); const bf16* QKC = WS(bf16, WS_QKC); bf16* MIX = WS(bf16, WS_MIX);
    constexpr int P = 65;
    LAS float* q = (LAS float*)lds; LAS float* k = q + 64 * P; LAS float* v = k + 64 * P; LAS float* Sm = v + 64 * P; LAS float* Cst = Sm + 64 * P;
    LAS float* nst = Cst + 64 * P; LAS float* bcum = nst + 64; LAS float* ii = bcum + 64; LAS float* mt = ii + 64; LAS float* inter = mt + 64; LAS float* den = inter + 64; LAS float* wvv = den + 64; LAS float* sc = wvv + 64;
    for (int unit = blockIdx.x; unit < NB * 4; unit += gridDim.x) {
        const int b = unit >> 2, h = unit & 3;
        const float gbi = A->in[I_GATEB][l * 8 + h], gbf = A->in[I_GATEB][l * 8 + 4 + h];
        for (int i = tid; i < 64 * P; i += 512) Cst[i] = 0.f;
        if (tid < 64) nst[tid] = 0.f;
        if (tid == 0) sc[0] = 0.f;
        __syncthreads();
        for (int ch = 0; ch < SEQ / 64; ++ch) {
            const int tok0 = b * SEQ + ch * 64;
            for (int idx = tid; idx < 4096; idx += 512) { const int rr = idx >> 6, d = idx & 63; const size_t tk = (size_t)(tok0 + rr);
                q[rr * P + d] = bf2f(QKC[tk * 512 + h * 64 + d]) * 0.125f; k[rr * P + d] = bf2f(QKC[tk * 512 + 256 + h * 64 + d]); v[rr * P + d] = bf2f(H[tk * NHC + HC_MV + h * 64 + d]); }
            if (wave == 0) {
                const size_t tk = (size_t)(tok0 + lane);
                const float ip = bf2f(H[tk * NHC + HC_MI + h]) + gbi, fp = bf2f(H[tk * NHC + HC_MF + h]) + gbf;
                float lf = fminf(fp, 0.f) - log1pf(__expf(-fabsf(fp)));
#pragma unroll
                for (int o = 1; o < 64; o <<= 1) { const float t_ = __shfl_up(lf, o); if (lane >= o) lf += t_; }
                ii[lane] = ip; bcum[lane] = lf;
            }
            __syncthreads();
            const float mprev = sc[0];
            if (tid < 64) { const int t = tid; float mx = -INFINITY; const float bt = bcum[t];
                for (int s = 0; s <= t; ++s) mx = fmaxf(mx, bt - bcum[s] + ii[s]);
                const float li = bt + mprev, m_t = fmaxf(li, mx); mt[t] = m_t; inter[t] = __expf(li - m_t); }
            __syncthreads();
            for (int idx = tid; idx < 4096; idx += 512) { const int t = idx >> 6, s = idx & 63; float val = 0.f;
                if (s <= t) { float dot = 0.f;
#pragma unroll 16
                    for (int d = 0; d < 64; ++d) dot += q[t * P + d] * k[s * P + d];
                    val = dot * __expf(bcum[t] - bcum[s] + ii[s] - mt[t]); }
                Sm[t * P + s] = val; }
            __syncthreads();
            if (tid < 64) { const int t = tid; float a = 0.f, qn = 0.f;
                for (int s = 0; s < 64; ++s) a += Sm[t * P + s];
                for (int d = 0; d < 64; ++d) qn += q[t * P + d] * nst[d];
                den[t] = a + inter[t] * qn; }
            float num[8];
#pragma unroll
            for (int j = 0; j < 8; ++j) { const int t = wave + 8 * j, vc = lane; float a = 0.f, qc = 0.f;
                for (int s = 0; s < 64; ++s) a += Sm[t * P + s] * v[s * P + vc];
                for (int d = 0; d < 64; ++d) qc += q[t * P + d] * Cst[d * P + vc];
                num[j] = a + inter[t] * qc; }
            __syncthreads();
#pragma unroll
            for (int j = 0; j < 8; ++j) { const int t = wave + 8 * j, vc = lane; const size_t tk = (size_t)(tok0 + t);
                const float hv = num[j] / fmaxf(fabsf(den[t]), __expf(-mt[t]));
                const float mean = wave_sum(hv) * (1.0f / 64.0f), hc = hv - mean;
                const float rs = 1.0f / sqrtf(wave_sum(hc * hc) * (1.0f / 64.0f) + LN_EPS);
                const float og = sigmoidf_(bf2f(H[tk * NHC + HC_MO + h * 64 + vc]));
                MIX[tk * D + h * 64 + vc] = (bf16)f2bf(og * (hc * rs * A->in[I_MNORM][l * 256 + h * 64 + vc])); }
            if (wave == 0) { const float bl = bcum[63]; const float lw = bl - bcum[lane] + ii[lane];
                const float mnew = fmaxf(bl + mprev, wave_max(lw)); wvv[lane] = __expf(lw - mnew);
                if (lane == 0) { sc[1] = __expf(bl + mprev - mnew); sc[2] = mnew; } }
            __syncthreads();
            { const float decay = sc[1];
#pragma unroll
              for (int j = 0; j < 8; ++j) { const int d = wave + 8 * j, vc = lane; float a = 0.f;
                  for (int s = 0; s < 64; ++s) a += wvv[s] * k[s * P + d] * v[s * P + vc];
                  Cst[d * P + vc] = decay * Cst[d * P + vc] + a; }
              if (tid < 64) { float a = 0.f; for (int s = 0; s < 64; ++s) a += wvv[s] * k[s * P + tid]; nst[tid] = decay * nst[tid] + a; }
              if (tid == 0) sc[0] = sc[2]; }
            __syncthreads();
        }
    }
}
template <int NV> __device__ __forceinline__ void naive_attn_row(const bf16* qp, const bf16* Kb, const bf16* Vb, int tl, const unsigned* maskrow, int lane, float (&o)[NV], float& l_out) {
    float qf[64];
#pragma unroll
    for (int c = 0; c < 8; ++c) { const v4u raw = *(const GAS v4u*)(qp + 8 * c); const unsigned rw[4] = {raw.x, raw.y, raw.z, raw.w};
#pragma unroll
        for (int e = 0; e < 8; ++e) qf[8 * c + e] = __uint_as_float((e & 1) ? (rw[e >> 1] & 0xffff0000u) : (rw[e >> 1] << 16)); }
    float m = -INFINITY, l = 0.f;
#pragma unroll
    for (int n = 0; n < NV; ++n) o[n] = 0.f;
    for (int kb = 0; kb * 64 <= tl; ++kb) {
        const int s = kb * 64 + lane; bool valid = s <= tl;
        if (maskrow) valid = valid && ((maskrow[2 * kb + (lane >> 5)] >> (lane & 31)) & 1u);
        float dot = 0.f;
        const bf16* kr = Kb + (size_t)s * NHC;
#pragma unroll
        for (int c = 0; c < 8; ++c) { const v4u raw = *(const GAS v4u*)(kr + 8 * c); const unsigned rw[4] = {raw.x, raw.y, raw.z, raw.w};
#pragma unroll
            for (int e = 0; e < 8; ++e) dot += qf[8 * c + e] * __uint_as_float((e & 1) ? (rw[e >> 1] & 0xffff0000u) : (rw[e >> 1] << 16)); }
        const float scv = valid ? dot : -INFINITY;
        const float bm = wave_max(scv);
        if (bm == -INFINITY) continue;
        const float mn = fmaxf(m, bm), alpha = __builtin_amdgcn_exp2f(m - mn), p = __builtin_amdgcn_exp2f(scv - mn);
        l = l * alpha + wave_sum(p); m = mn;
#pragma unroll
        for (int n = 0; n < NV; ++n) o[n] *= alpha;
        const int nk = min(64, tl - kb * 64 + 1);
        const bf16* vr = Vb + (size_t)(kb * 64) * NHC + lane;
        for (int j = 0; j < nk; ++j) { const float pj = __shfl(p, j);
#pragma unroll
            for (int n = 0; n < NV; ++n) o[n] += pj * bf2f(vr[(size_t)j * NHC + 64 * n]); }
    }
    l_out = l;
}
__device__ __forceinline__ void ph_diff_naive(int l) {
    TIDX;
    const bf16* H = WS(bf16, WS_H); bf16* MIX = WS(bf16, WS_MIX);
    const float lam = WS(float, WS_LAM)[l], lam_init = 0.8f - 0.6f * __expf(-0.3f * (float)l);
    for (int task = gw; task < T * 4; task += ngw) {
        const int tok = task >> 2, h = task & 3, b = tok / SEQ, tl = tok % SEQ;
        const bf16* Hb = H + (size_t)b * SEQ * NHC;
        float o1[2], o2[2], l1, l2;
        naive_attn_row<2>(H + (size_t)tok * NHC + HC_DQ + (2 * h) * 64, Hb + HC_DK + (2 * h) * 64, Hb + HC_DV + h * 128, tl, nullptr, lane, o1, l1);
        naive_attn_row<2>(H + (size_t)tok * NHC + HC_DQ + (2 * h + 1) * 64, Hb + HC_DK + (2 * h + 1) * 64, Hb + HC_DV + h * 128, tl, nullptr, lane, o2, l2);
        const float i1 = 1.0f / l1, i2 = 1.0f / l2;
        const float d0 = o1[0] * i1 - lam * o2[0] * i2, d1 = o1[1] * i1 - lam * o2[1] * i2;
        const float rs = 1.0f / sqrtf(wave_sum(d0 * d0 + d1 * d1) * (1.0f / 128.0f) + LN_EPS);
        const float* g = A->in[I_DFNORM] + l * 512 + h * 128;
        MIX[(size_t)tok * D + 256 + h * 128 + lane] = (bf16)f2bf(d0 * rs * g[lane] * (1.0f - lam_init));
        MIX[(size_t)tok * D + 256 + h * 128 + 64 + lane] = (bf16)f2bf(d1 * rs * g[64 + lane] * (1.0f - lam_init));
    }
}
__device__ __forceinline__ void ph_dsa_naive() {
    TIDX;
    const bf16* H = WS(bf16, WS_H); bf16* MIX = WS(bf16, WS_MIX); const unsigned* MASK = WS(unsigned, WS_MASK);
    for (int task = gw; task < T * 4; task += ngw) {
        const int tok = task >> 2, h = task & 3, b = tok / SEQ, tl = tok % SEQ;
        const bf16* Hb = H + (size_t)b * SEQ * NHC;
        float o[1], ll;
        naive_attn_row<1>(H + (size_t)tok * NHC + HC_SQ + h * 64, Hb + HC_SK + h * 64, Hb + HC_SV + h * 64, tl, MASK + (size_t)tok * 64, lane, o, ll);
        MIX[(size_t)tok * D + 768 + h * 64 + lane] = (bf16)f2bf(o[0] / ll);
    }
}
__device__ __forceinline__ void ph_select(LAS unsigned char* lds) {
    TIDX;
    const float* SC = WS(float, WS_SC); unsigned* MASK = WS(unsigned, WS_MASK);
    LAS unsigned* hist = (LAS unsigned*)lds + wave * 256;
    const unsigned long long lt_mask = (1ull << lane) - 1ull;
    for (int tok = gw; tok < T; tok += ngw) {
        const int tl = tok % SEQ;
        if (tl < 256) {
            const int lo = 32 * lane; unsigned w;
            if (lo + 31 <= tl) w = 0xffffffffu; else if (lo > tl) w = 0u; else w = (2u << (tl - lo)) - 1u;
            MASK[(size_t)tok * 64 + lane] = w; continue;
        }
        unsigned key[32]; unsigned vbits = 0u;
#pragma unroll
        for (int i = 0; i < 32; ++i) { const int s = 64 * i + lane; const bool valid = s <= tl;
            const unsigned u = valid ? __float_as_uint(SC[(size_t)tok * SEQ + s]) : 0u;
            key[i] = valid ? ((u >> 31) ? ~u : (u | 0x80000000u)) : 0u; vbits |= valid ? (1u << i) : 0u; }
        unsigned prefix = 0u; int need = 256;
#pragma unroll
        for (int pass = 0; pass < 4; ++pass) {
            const int shift = 24 - 8 * pass;
            hist[4 * lane + 0] = 0u; hist[4 * lane + 1] = 0u; hist[4 * lane + 2] = 0u; hist[4 * lane + 3] = 0u;
            LDS_WAIT(); asm volatile("" ::: "memory");
#pragma unroll
            for (int i = 0; i < 32; ++i) { const bool in = ((vbits >> i) & 1u) && (pass == 0 || (key[i] >> (shift + 8)) == prefix);
                if (in) (void)__hip_atomic_fetch_add(&hist[(key[i] >> shift) & 255u], 1u, __ATOMIC_RELAXED, __HIP_MEMORY_SCOPE_WORKGROUP); }
            LDS_WAIT(); asm volatile("" ::: "memory");
            const unsigned c0 = hist[4 * lane], c1 = hist[4 * lane + 1], c2 = hist[4 * lane + 2], c3 = hist[4 * lane + 3];
            LDS_WAIT(); asm volatile("" ::: "memory");
            const int tot = (int)(c0 + c1 + c2 + c3);
            int incl = tot;
#pragma unroll
            for (int o = 1; o < 64; o <<= 1) { const int t_ = __shfl_down(incl, o); if (lane + o < 64) incl += t_; }
            int cum = incl - tot;
            int fv = -1, fneed = 0;
            { const int cc[4] = {(int)c0, (int)c1, (int)c2, (int)c3};
#pragma unroll
              for (int j = 3; j >= 0; --j) { if (fv < 0 && cum < need && cum + cc[j] >= need) { fv = 4 * lane + j; fneed = need - cum; } cum += cc[j]; } }
            const unsigned long long fm = __ballot(fv >= 0);
            const int src = fm ? (int)__builtin_ctzll(fm) : 0;
            const int v = __shfl(fv, src); need = __shfl(fneed, src);
            prefix = (prefix << 8) | (unsigned)(v & 255);
        }
        unsigned myw = 0u; int cbefore = 0;
#pragma unroll
        for (int i = 0; i < 32; ++i) {
            const bool vld = (vbits >> i) & 1u; const bool eq = vld && key[i] == prefix, gt = vld && key[i] > prefix;
            const unsigned long long em = __ballot(eq);
            const int rank = cbefore + __popcll(em & lt_mask);
            const bool sel = gt || (eq && rank < need);
            cbefore += __popcll(em);
            const unsigned long long bm = __ballot(sel);
            if (lane == 2 * i) myw = (unsigned)bm;
            if (lane == 2 * i + 1) myw = (unsigned)(bm >> 32);
        }
        MASK[(size_t)tok * 64 + lane] = myw;
    }
}
__device__ __forceinline__ void ph_row1(int l) {
    TIDX;
    const float* xin = (l == 0) ? A->in[I_X] : WS(float, WS_XB); float* XB = WS(float, WS_XB);
    const bf16* Y = WS(bf16, WS_Y); bf16* U = WS(bf16, WS_U);
    const float* RWT = WS(float, WS_RWT) + (size_t)l * NEXP * D;
    unsigned* cnt = WS(unsigned, WS_CTL) + CW_CNT + l * NEXP; unsigned* TOK = WS(unsigned, WS_TOK);
    const float* lg = A->in[I_LN1G] + l * D; const float* lb = A->in[I_LN1B] + l * D;
    const float* rbp = A->in[I_RB] + l * NEXP;
    for (int tok = gw; tok < T; tok += ngw) {
        const int b = tok / SEQ; const float* mod = WS(float, WS_MOD) + ((size_t)l * NB + b) * 6144;
        f32x4 v[4]; float s = 0.f;
#pragma unroll
        for (int j = 0; j < 4; ++j) { const int c = 4 * lane + 256 * j;
            const f32x4 x = *(const GAS f32x4*)(xin + (size_t)tok * D + c); const f32x4 g1 = *(const f32x4*)(mod + 2048 + c);
            const unsigned long long yr = *(const GAS unsigned long long*)(Y + (size_t)tok * D + c);
            f32x4 y; y.x = __uint_as_float((unsigned)yr << 16); y.y = __uint_as_float((unsigned)yr & 0xffff0000u); y.z = __uint_as_float((unsigned)(yr >> 32) << 16); y.w = __uint_as_float((unsigned)(yr >> 32) & 0xffff0000u);
            v[j] = x * DN_ALPHA + (1.0f + g1) * y; s += (v[j].x + v[j].y) + (v[j].z + v[j].w); }
        const float mean = wave_sum(s) * (1.0f / D); float s2 = 0.f;
#pragma unroll
        for (int j = 0; j < 4; ++j) { v[j] = v[j] - mean; s2 += (v[j].x * v[j].x + v[j].y * v[j].y) + (v[j].z * v[j].z + v[j].w * v[j].w); }
        const float rstd = 1.0f / sqrtf(wave_sum(s2) * (1.0f / D) + LN_EPS);
        f32x4 u2[4];
#pragma unroll
        for (int j = 0; j < 4; ++j) { const int c = 4 * lane + 256 * j;
            const f32x4 xn = v[j] * rstd * *(const f32x4*)(lg + c) + *(const f32x4*)(lb + c);
            *(GAS f32x4*)(XB + (size_t)tok * D + c) = xn;
            u2[j] = xn * (1.0f + *(const f32x4*)(mod + 4096 + c)) + *(const f32x4*)(mod + 3072 + c);
            *(GAS unsigned long long*)(U + (size_t)tok * D + c) = (unsigned long long)pk2(u2[j].x, u2[j].y) | ((unsigned long long)pk2(u2[j].z, u2[j].w) << 32); }
        float tv[4] = {-INFINITY, -INFINITY, -INFINITY, -INFINITY}; int te[4] = {0, 0, 0, 0};
#pragma unroll 1
        for (int e = 0; e < NEXP; ++e) {
            const float* w = RWT + (size_t)e * D + 4 * lane; float a = 0.f;
#pragma unroll
            for (int j = 0; j < 4; ++j) { const f32x4 w4 = *(const f32x4*)(w + 256 * j); a += (u2[j].x * w4.x + u2[j].y * w4.y) + (u2[j].z * w4.z + u2[j].w * w4.w); }
            a = wave_sum(a) + rbp[e];
            if (a > tv[0]) { tv[3] = tv[2]; te[3] = te[2]; tv[2] = tv[1]; te[2] = te[1]; tv[1] = tv[0]; te[1] = te[0]; tv[0] = a; te[0] = e; }
            else if (a > tv[1]) { tv[3] = tv[2]; te[3] = te[2]; tv[2] = tv[1]; te[2] = te[1]; tv[1] = a; te[1] = e; }
            else if (a > tv[2]) { tv[3] = tv[2]; te[3] = te[2]; tv[2] = a; te[2] = e; }
            else if (a > tv[3]) { tv[3] = a; te[3] = e; }
        }
        const float e1 = __expf(tv[1] - tv[0]), e2 = __expf(tv[2] - tv[0]), e3 = __expf(tv[3] - tv[0]); const float inv = 1.0f / (1.0f + e1 + e2 + e3);
        if (lane < 4) { const int ek = lane == 0 ? te[0] : lane == 1 ? te[1] : lane == 2 ? te[2] : te[3]; const float pk = (lane == 0 ? 1.0f : lane == 1 ? e1 : lane == 2 ? e2 : e3) * inv;
            const unsigned pos = __hip_atomic_fetch_add(cnt + ek, 1u, __ATOMIC_RELAXED, __HIP_MEMORY_SCOPE_AGENT);
            *(GAS v4u*)(TOK + ((size_t)tok * 4 + lane) * 4) = (v4u){(unsigned)ek, pos, __float_as_uint(pk), 0u}; }
    }
}
__device__ __forceinline__ int moe_tables(LAS unsigned char* lds, int l) {
    CArgs* A = kargs();
    LAS unsigned* base = (LAS unsigned*)(lds + TAB_OFF); LAS unsigned char* tile_e = lds + TAB_OFF + 256;
    const unsigned* cnt = WS(unsigned, WS_CTL) + CW_CNT + l * NEXP;
    if (threadIdx.x == 0) { unsigned acc = 0u;
#pragma unroll 1
        for (int e = 0; e < NEXP; ++e) { const unsigned c = __hip_atomic_load(cnt + e, __ATOMIC_RELAXED, __HIP_MEMORY_SCOPE_AGENT); const unsigned nt = (c + 255u) >> 8; base[e] = acc;
#pragma unroll 1
            for (unsigned t = 0; t < nt; ++t) tile_e[(acc >> 8) + t] = (unsigned char)e; acc += nt << 8; }
        base[NEXP] = acc; }
    __syncthreads();
    return (int)(base[NEXP] >> 8);
}
__device__ __forceinline__ void ph_gather(LAS unsigned char* lds, int l) {
    TIDX;
    (void)moe_tables(lds, l);
    const LAS unsigned* base = (const LAS unsigned*)(lds + TAB_OFF);
    const unsigned* TOK = WS(unsigned, WS_TOK); const bf16* U = WS(bf16, WS_U); bf16* XG = WS(bf16, WS_XG);
    for (int task = gw; task < T * 4; task += ngw) {
        const v4u ti = *(const GAS v4u*)(TOK + (size_t)task * 4); const size_t row = (size_t)base[ti.x] + ti.y;
        const GAS v4u* src = (const GAS v4u*)(U + (size_t)(task >> 2) * D) + lane; GAS v4u* dst = (GAS v4u*)(XG + row * D) + lane;
        dst[0] = src[0]; dst[64] = src[64];
    }
    __syncthreads();
}
__device__ __forceinline__ void ph_row2(LAS unsigned char* lds, int l) {
    TIDX;
    (void)moe_tables(lds, l);
    const LAS unsigned* base = (const LAS unsigned*)(lds + TAB_OFF);
    float* XB = WS(float, WS_XB); const bf16* YM = WS(bf16, WS_YM); bf16* U = WS(bf16, WS_U); const unsigned* TOK = WS(unsigned, WS_TOK);
    const float* lg = A->in[I_LN2G] + l * D; const float* lb = A->in[I_LN2B] + l * D; const float* b2 = A->in[I_B2] + (size_t)l * NEXP * D;
    float* dst = (l == DEPTH - 1) ? A->out : XB;
    for (int tok = gw; tok < T; tok += ngw) {
        const int b = tok / SEQ; const float* mod = WS(float, WS_MOD) + ((size_t)l * NB + b) * 6144;
        f32x4 acc[4];
#pragma unroll
        for (int j = 0; j < 4; ++j) acc[j] = (f32x4){0.f, 0.f, 0.f, 0.f};
#pragma unroll
        for (int k = 0; k < 4; ++k) { const v4u ti = *(const GAS v4u*)(TOK + ((size_t)tok * 4 + k) * 4); const size_t row = (size_t)base[ti.x] + ti.y; const float p = __uint_as_float(ti.z);
#pragma unroll
            for (int j = 0; j < 4; ++j) { const int c = 4 * lane + 256 * j; const unsigned long long yr = *(const GAS unsigned long long*)(YM + row * D + c);
                f32x4 y; y.x = __uint_as_float((unsigned)yr << 16); y.y = __uint_as_float((unsigned)yr & 0xffff0000u); y.z = __uint_as_float((unsigned)(yr >> 32) << 16); y.w = __uint_as_float((unsigned)(yr >> 32) & 0xffff0000u);
                acc[j] = acc[j] + p * (y + *(const f32x4*)(b2 + (size_t)ti.x * D + c)); } }
        f32x4 v[4]; float s = 0.f;
#pragma unroll
        for (int j = 0; j < 4; ++j) { const int c = 4 * lane + 256 * j; const f32x4 x = *(const GAS f32x4*)(XB + (size_t)tok * D + c);
            v[j] = x * DN_ALPHA + (1.0f + *(const f32x4*)(mod + 5120 + c)) * acc[j]; s += (v[j].x + v[j].y) + (v[j].z + v[j].w); }
        const float mean = wave_sum(s) * (1.0f / D); float s2 = 0.f;
#pragma unroll
        for (int j = 0; j < 4; ++j) { v[j] = v[j] - mean; s2 += (v[j].x * v[j].x + v[j].y * v[j].y) + (v[j].z * v[j].z + v[j].w * v[j].w); }
        const float rstd = 1.0f / sqrtf(wave_sum(s2) * (1.0f / D) + LN_EPS);
        const float* modn = WS(float, WS_MOD) + ((size_t)(l + 1 < DEPTH ? l + 1 : l) * NB + b) * 6144;
#pragma unroll
        for (int j = 0; j < 4; ++j) { const int c = 4 * lane + 256 * j;
            const f32x4 xn = v[j] * rstd * *(const f32x4*)(lg + c) + *(const f32x4*)(lb + c);
            *(GAS f32x4*)(dst + (size_t)tok * D + c) = xn;
            if (l + 1 < DEPTH) { const f32x4 u = xn * (1.0f + *(const f32x4*)(modn + 1024 + c)) + *(const f32x4*)(modn + c);
                *(GAS unsigned long long*)(U + (size_t)tok * D + c) = (unsigned long long)pk2(u.x, u.y) | ((unsigned long long)pk2(u.z, u.w) << 32); } }
    }
    __syncthreads();
}
__global__ void __launch_bounds__(NWAVES * 64, 2) mega_fwd(Args A_) {
    extern __shared__ __attribute__((aligned(16))) unsigned char lds_raw[];
    LAS unsigned char* lds = (LAS unsigned char*)lds_raw;
    const int tid = threadIdx.x;
    volatile LAS unsigned* MISC = (volatile LAS unsigned*)(lds + MISC_OFF);
    for (int u = tid; u < (LDS_BYTES - TAB_OFF) / 4; u += NWAVES * 64) ((LAS unsigned*)(lds + TAB_OFF))[u] = 0u;
    __syncthreads();
    CArgs* A = kargs(); const bool multi = (A->s_hi - A->s_lo) > 1;
    XcdBarrier bar; bar.bar = WS(unsigned, WS_CTL) + CW_BAR + A->li * XCD_BAR_WORDS; bar.x = 0; bar.st = MISC + 8;
    if (multi) bar = xcd_barrier_post(WS(unsigned, WS_CTL) + CW_BAR + A->li * XCD_BAR_WORDS, MISC + 8);
    const int lo = A->s_lo, hi = A->s_hi;
#ifndef PHMASK
#define PHMASK 0xffffffffu
#endif
#define PHM(b) (((PHMASK) >> (b)) & 1u)
#define RUN(s) (lo <= (s) && (s) < hi)
#define SEAM(s) do { if ((s) + 1 < hi) xcd_barrier(bar); } while (0)
    if (RUN(0)) { if (PHM(0)) pro_a(lds); SEAM(0); }
    if (RUN(1)) { if (PHM(1)) pro_b(); SEAM(1); }
    for (int l = 0; l < DEPTH; ++l) {
        const int sb = 2 + NPH * l;
        if (RUN(sb + PH_IN)) { CArgs* A = kargs();
            pg8::Gemm g{WS(bf16, WS_U), WS(bf16, WS_WIN) + (size_t)l * NHC * D, T, NHC, D}; pg8::StaticOrder S; S.init(T, NHC, (int)gridDim.x, (int)blockIdx.x);
            pg8::EpiIn E{WS(bf16, WS_H), WS(float, WS_CS)};
            if (PHM(2)) pg8::gemm_phase<pg8::EpiIn, pg8::StaticOrder, true, true>(lds, g, S, E);
            SEAM(sb + PH_IN);
        }
        if (RUN(sb + PH_POST)) { if (PHM(3)) ph_post(l); SEAM(sb + PH_POST); }
        if (RUN(sb + PH_MIXA)) { if (PHM(4)) ph_idx_scores(); if (PHM(5)) ph_mlstm(lds, l); if (PHM(6)) ph_diff_naive(l); SEAM(sb + PH_MIXA); }
        if (RUN(sb + PH_SEL)) { if (PHM(7)) ph_select(lds); SEAM(sb + PH_SEL); }
        if (RUN(sb + PH_DSA)) { if (PHM(8)) ph_dsa_naive(); SEAM(sb + PH_DSA); }
        if (RUN(sb + PH_OUT)) { CArgs* A = kargs();
            pg8::Gemm g{WS(bf16, WS_MIX), WS(bf16, WS_WOUT) + (size_t)l * D * D, T, D, D}; pg8::StaticOrder S; S.init(T, D, (int)gridDim.x, (int)blockIdx.x);
            pg8::EpiBf16<0> E{WS(bf16, WS_Y), D, nullptr, 0, 0, 1.f};
            if (PHM(9)) pg8::gemm_phase<pg8::EpiBf16<0>, pg8::StaticOrder, true, true>(lds, g, S, E);
            SEAM(sb + PH_OUT);
        }
        if (RUN(sb + PH_ROW1)) { if (PHM(10)) ph_row1(l); SEAM(sb + PH_ROW1); }
        if (RUN(sb + PH_GATH)) { if (PHM(11)) ph_gather(lds, l); SEAM(sb + PH_GATH); }
        if (RUN(sb + PH_G1)) { CArgs* A = kargs();
            const int nrt = moe_tables(lds, l);
            pg8::Gemm g{WS(bf16, WS_XG), WS(bf16, WS_W1) + (size_t)l * NEXP * 2048 * D, RPAD, NEXP * 2048, D}; pg8::MoeOrder S; S.init(nrt, 8, (int)gridDim.x, (int)blockIdx.x, (const LAS unsigned char*)(lds + TAB_OFF + 256));
            pg8::EpiSwiGLU E{WS(bf16, WS_HM), A->in[I_B1] + (size_t)l * NEXP * 2048};
            if (PHM(12)) pg8::gemm_phase<pg8::EpiSwiGLU, pg8::MoeOrder, true, true>(lds, g, S, E);
            SEAM(sb + PH_G1);
        }
        if (RUN(sb + PH_G2)) { CArgs* A = kargs();
            const int nrt = moe_tables(lds, l);
            pg8::Gemm g{WS(bf16, WS_HM), WS(bf16, WS_W2) + (size_t)l * NEXP * D * D, RPAD, NEXP * D, D}; pg8::MoeOrder S; S.init(nrt, 4, (int)gridDim.x, (int)blockIdx.x, (const LAS unsigned char*)(lds + TAB_OFF + 256));
            pg8::EpiBf16<0> E{WS(bf16, WS_YM), D, nullptr, D, 0, 1.f};
            if (PHM(13)) pg8::gemm_phase<pg8::EpiBf16<0>, pg8::MoeOrder, true, true>(lds, g, S, E);
            SEAM(sb + PH_G2);
        }
        if (RUN(sb + PH_ROW2)) { if (PHM(14)) ph_row2(lds, l); SEAM(sb + PH_ROW2); }
    }
#undef RUN
#undef SEAM
}

#ifndef MK_STEPS_PER_LAUNCH
#define MK_STEPS_PER_LAUNCH 1000
#endif
extern "C" void kernel_launch(void* const* d_in, const int* in_sizes, int n_in, void* d_out, int out_size, void* d_ws, size_t ws_size, hipStream_t stream) {
    static int grid = 0;
    if (grid == 0) {
        if (n_in != 25 || out_size != T * D || ws_size < WS_END) { fprintf(stderr, "kernel_launch: unexpected shapes (n_in %d out %d ws %zu)\n", n_in, out_size, ws_size); grid = -1; return; }
        int dev = 0, cus = 0, per_cu = 0;
        if (hipGetDevice(&dev) != hipSuccess || hipDeviceGetAttribute(&cus, hipDeviceAttributeMultiprocessorCount, dev) != hipSuccess) { grid = -1; return; }
        if (hipFuncSetAttribute((const void*)mega_fwd, hipFuncAttributeMaxDynamicSharedMemorySize, LDS_BYTES) != hipSuccess) { fprintf(stderr, "kernel_launch: hipFuncSetAttribute failed\n"); grid = -1; return; }
        if (hipOccupancyMaxActiveBlocksPerMultiprocessor(&per_cu, (const void*)mega_fwd, NWAVES * 64, LDS_BYTES) != hipSuccess || per_cu < 1) { fprintf(stderr, "kernel_launch: occupancy query says %d\n", per_cu); }
        (void)hipGetLastError();
        grid = cus;
    }
    if (grid < 0) return;
    if (hipMemsetAsync((char*)d_ws + WS_CTL, 0, CTL_ZERO_BYTES, stream) != hipSuccess) return;
    Args a{};
    for (int i = 0; i < 25; ++i) a.in[i] = (const float*)d_in[i];
    a.out = (float*)d_out; a.ws = (unsigned char*)d_ws;
    int li = 0;
    for (int s = 0; s < NSTEPS; s += MK_STEPS_PER_LAUNCH, ++li) {
        a.s_lo = s; a.s_hi = (s + MK_STEPS_PER_LAUNCH < NSTEPS) ? s + MK_STEPS_PER_LAUNCH : NSTEPS; a.li = li; a.pad = 0;
        hipLaunchKernelGGL(mega_fwd, dim3(grid), dim3(NWAVES * 64), LDS_BYTES, stream, a);
    }
}
```

```cpp
#include <hip/hip_runtime.h>
#include <cstdio>
#include <cstdint>

namespace pg8 {
#define PG8_LAS __attribute__((address_space(3)))
typedef unsigned short bf16_t;
typedef short bf16x8 __attribute__((ext_vector_type(8)));
typedef float f32x4 __attribute__((ext_vector_type(4)));
typedef unsigned u32x4 __attribute__((ext_vector_type(4)));
constexpr int BM = 256, BK = 64, HALF = 128, HTB = HALF * BK * 2  , STAGE_BYTES = 8 * HTB, NXCD = 8, WGM = 8;

__host__ __device__ __forceinline__ int lds_byte(int r, int c) { const int st = (r >> 4) * 2 + (c >> 5), rr = r & 15, cc = c & 31, ob = rr * 64 + cc * 2; return st * 1024 + (ob ^ (((ob >> 9) & 1) << 5)); }
__host__ __device__ __forceinline__ void stage_rc(int b, int& R, int& C) { const int st = b / 1024, sb = b % 1024, swz = sb ^ (((sb >> 9) & 1) << 5); R = (st >> 1) * 16 + swz / 64; C = (st & 1) * 32 + (swz % 64) / 2; }
__host__ __device__ __forceinline__ int perm32(int rho) { const int n = rho >> 4, i = rho & 15; return 8 * (i >> 2) + 4 * n + (i & 3); }

struct Unit { int pm, pn; };
struct Gemm { const bf16_t* A; const bf16_t* Bt; int M, N, K; };

struct StaticOrder {
    int nM, nN, nwg, G, c;
    __host__ __device__ void init(int M, int N, int G_, int c_) { nM = M / BM; nN = N / BM; nwg = nM * nN; G = G_; c = c_; }
    __host__ __device__ bool next(int i, Unit& u) const {
        const long L = (long)i * G + c; if (L >= nwg) return false;
        int wgid = (int)L; { const int q = nwg / NXCD, r = nwg % NXCD, xcd = wgid % NXCD, off = wgid / NXCD; wgid = (xcd < r ? xcd * (q + 1) : r * (q + 1) + (xcd - r) * q) + off; }
        const int nig = WGM * nN, gid = wgid / nig, fm = gid * WGM, gsz = (nM - fm) < WGM ? (nM - fm) : WGM;
        u.pm = fm + ((wgid % nig) % gsz); u.pn = (wgid % nig) / gsz; return true;
    }
    __device__ __forceinline__ void a_ready(const Unit&) const {}
    __device__ __forceinline__ void done(const Unit&) const {}
};
struct MoeOrder {
    int nM, nN, nwg, G, c; const PG8_LAS unsigned char* tile_e;
    __device__ void init(int nRT, int NTN, int G_, int c_, const PG8_LAS unsigned char* te) { nM = nRT; nN = NTN; nwg = nM * nN; G = G_; c = c_; tile_e = te; }
    __device__ bool next(int i, Unit& u) const {
        const long L = (long)i * G + c; if (L >= nwg) return false;
        int wgid = (int)L; { const int q = nwg / NXCD, r = nwg % NXCD, xcd = wgid % NXCD, off = wgid / NXCD; wgid = (xcd < r ? xcd * (q + 1) : r * (q + 1) + (xcd - r) * q) + off; }
        const int nig = WGM * nN, gid = wgid / nig, fm = gid * WGM, gsz = (nM - fm) < WGM ? (nM - fm) : WGM;
        u.pm = fm + ((wgid % nig) % gsz); const int pl = (wgid % nig) / gsz; u.pn = (int)tile_e[u.pm] * nN + pl; return true;
    }
    __device__ __forceinline__ void a_ready(const Unit&) const {}
    __device__ __forceinline__ void done(const Unit&) const {}
};
__device__ __forceinline__ unsigned cvt_pk_bf16(float lo, float hi) { unsigned r; asm volatile("v_cvt_pk_bf16_f32 %0, %1, %2" : "=v"(r) : "v"(lo), "v"(hi)); return r; }
typedef float f32x2 __attribute__((ext_vector_type(2)));
__device__ __forceinline__ f32x2 gelu_pk(f32x2 v) {
    const f32x2 av = __builtin_elementwise_abs(v), d = av * 0.2316418882f + 1.0f;
    f32x2 t; t.x = __builtin_amdgcn_rcpf(d.x); t.y = __builtin_amdgcn_rcpf(d.y);
    f32x2 q = t * 0.5307027145f + (-0.7265760135f); q = q * t + 0.7107068705f; q = q * t + (-0.142248368f); q = q * t + 0.127414796f; q = q * t;
    const f32x2 s = (v * v) * (-0.72134752044f);
    f32x2 e; e.x = __builtin_amdgcn_exp2f(s.x); e.y = __builtin_amdgcn_exp2f(s.y);
    const f32x2 m = v * (q * e), r = v - m;
    f32x2 o; o.x = v.x < 0.f ? m.x : r.x; o.y = v.y < 0.f ? m.y : r.y; return o;
}

template <int ACT  > struct EpiBf16 {
    static constexpr bool PERM = true, AFTER_DRAIN = false; static_assert(ACT == 0 || ACT == 1, "EpiBf16: ACT is 0 (none) or 1 (gelu_pk)");
    bf16_t* O; int ldc; const float* bias; int split_cols; size_t split_stride; float scale0;
    __device__ __forceinline__ void operator()(const f32x4 (&acc)[2][2][4][2], const Unit& u, int wr, int wc, int fr, int fq) const {
        const int row0 = u.pm * BM + wr * 64 + fr; int colt = u.pn * BM; bf16_t* base = O;
        float sc = 1.f; if (split_cols) { const int t = colt / split_cols; base += (size_t)t * split_stride; colt -= t * split_cols; if (t == 0) sc = scale0; }
        const int col0 = colt + wc * 32 + 8 * fq, bcol0 = u.pn * BM + wc * 32 + 8 * fq;
        f32x4 bv[2][2];
#pragma unroll
        for (int bj = 0; bj < 2; ++bj)
#pragma unroll
            for (int n = 0; n < 2; ++n) bv[bj][n] = bias ? *(const f32x4*)(bias + bcol0 + bj * HALF + 4 * n) : (f32x4){0.f, 0.f, 0.f, 0.f};
#pragma unroll
        for (int ai = 0; ai < 2; ++ai)
#pragma unroll
            for (int m = 0; m < 4; ++m) { bf16_t* rowp = base + (size_t)(row0 + ai * HALF + m * 16) * ldc + col0;
#pragma unroll
                for (int bj = 0; bj < 2; ++bj) { f32x4 v0 = acc[ai][bj][m][0] + bv[bj][0], v1 = acc[ai][bj][m][1] + bv[bj][1];
                    if (ACT == 1) { f32x2 a = gelu_pk((f32x2){v0[0], v0[1]}), b = gelu_pk((f32x2){v0[2], v0[3]}), c = gelu_pk((f32x2){v1[0], v1[1]}), d = gelu_pk((f32x2){v1[2], v1[3]});
                        v0 = (f32x4){a.x, a.y, b.x, b.y}; v1 = (f32x4){c.x, c.y, d.x, d.y}; }
                    v0 = v0 * sc; v1 = v1 * sc; u32x4 w; w.x = cvt_pk_bf16(v0[0], v0[1]); w.y = cvt_pk_bf16(v0[2], v0[3]); w.z = cvt_pk_bf16(v1[0], v1[1]); w.w = cvt_pk_bf16(v1[2], v1[3]);
                    *(u32x4*)(rowp + bj * HALF) = w; } }
    }
};
constexpr float C2 = 0.125f * 1.4426950408889634f;
struct EpiIn {
    static constexpr bool PERM = true, AFTER_DRAIN = false;
    bf16_t* O; const float* cs;
    __device__ __forceinline__ void operator()(const f32x4 (&acc)[2][2][4][2], const Unit& u, int wr, int wc, int fr, int fq) const {
        const int pn = u.pn;
        const bool rope = (0x6CF0 >> pn) & 1;
        const float sc = ((0x0430 >> pn) & 1) ? C2 : 1.f;
        const int row0 = u.pm * BM + wr * 64 + fr, col0 = pn * BM + wc * 32 + 8 * fq, i0 = (wc & 1) * 16 + 4 * fq;
#pragma unroll
        for (int ai = 0; ai < 2; ++ai)
#pragma unroll
            for (int m = 0; m < 4; ++m) {
                const int row = row0 + ai * HALF + m * 16;
                f32x4 c01 = (f32x4){1.f, 0.f, 1.f, 0.f}, c23 = c01;
                if (rope) { c01 = *(const f32x4*)(cs + (size_t)row * 64 + i0 * 2); c23 = *(const f32x4*)(cs + (size_t)row * 64 + i0 * 2 + 4); }
                bf16_t* rowp = O + (size_t)row * 4096 + col0;
#pragma unroll
                for (int bj = 0; bj < 2; ++bj) {
                    f32x4 v0 = acc[ai][bj][m][0], v1 = acc[ai][bj][m][1];
                    if (rope) {
                        f32x4 r0, r1;
                        r0[0] = v0[0] * c01[0] - v0[1] * c01[1]; r0[1] = v0[1] * c01[0] + v0[0] * c01[1];
                        r0[2] = v0[2] * c01[2] - v0[3] * c01[3]; r0[3] = v0[3] * c01[2] + v0[2] * c01[3];
                        r1[0] = v1[0] * c23[0] - v1[1] * c23[1]; r1[1] = v1[1] * c23[0] + v1[0] * c23[1];
                        r1[2] = v1[2] * c23[2] - v1[3] * c23[3]; r1[3] = v1[3] * c23[2] + v1[2] * c23[3];
                        v0 = r0; v1 = r1;
                    }
                    v0 = v0 * sc; v1 = v1 * sc;
                    u32x4 w; w.x = cvt_pk_bf16(v0[0], v0[1]); w.y = cvt_pk_bf16(v0[2], v0[3]); w.z = cvt_pk_bf16(v1[0], v1[1]); w.w = cvt_pk_bf16(v1[2], v1[3]);
                    *(u32x4*)(rowp + bj * HALF) = w;
                }
            }
    }
};
struct EpiSwiGLU {
    static constexpr bool PERM = true, AFTER_DRAIN = false;
    bf16_t* O; const float* b1;
    __device__ __forceinline__ void operator()(const f32x4 (&acc)[2][2][4][2], const Unit& u, int wr, int wc, int fr, int fq) const {
        const int e = u.pn >> 3, pl = u.pn & 7, colh = pl * 128 + wc * 32 + 8 * fq;
        const float* bp = b1 + (size_t)e * 2048 + colh;
        f32x4 bg[2], bu[2];
#pragma unroll
        for (int n = 0; n < 2; ++n) { bg[n] = *(const f32x4*)(bp + 4 * n); bu[n] = *(const f32x4*)(bp + 1024 + 4 * n); }
        const int row0 = u.pm * BM + wr * 64 + fr;
#pragma unroll
        for (int ai = 0; ai < 2; ++ai)
#pragma unroll
            for (int m = 0; m < 4; ++m) {
                f32x4 o[2];
#pragma unroll
                for (int n = 0; n < 2; ++n) {
                    const f32x4 g4 = acc[ai][0][m][n] + bg[n], u4 = acc[ai][1][m][n] + bu[n];
#pragma unroll
                    for (int c = 0; c < 4; ++c) {
                        const float g = fminf(g4[c], 7.0f), up = fminf(fmaxf(u4[c], -7.0f), 7.0f);
                        const float sg = __builtin_amdgcn_rcpf(1.0f + __builtin_amdgcn_exp2f(-1.702f * 1.4426950408889634f * g));
                        o[n][c] = (up + 1.0f) * (g * sg);
                    }
                }
                u32x4 w; w.x = cvt_pk_bf16(o[0][0], o[0][1]); w.y = cvt_pk_bf16(o[0][2], o[0][3]); w.z = cvt_pk_bf16(o[1][0], o[1][1]); w.w = cvt_pk_bf16(o[1][2], o[1][3]);
                *(u32x4*)(O + (size_t)(row0 + ai * HALF + m * 16) * 1024 + colh) = w;
            }
    }
};
template <class Epi, class Sched, bool ALIGN_EPI = false, bool SP2 = false>
__device__ __forceinline__ void gemm_phase(PG8_LAS unsigned char* lds, const Gemm g, const Sched& S, const Epi& E) {
    int tid_ = threadIdx.x; asm volatile("" : "+v"(tid_));
    const int tid = tid_, wid = __builtin_amdgcn_readfirstlane(tid >> 6), lane = tid & 63, wr = wid >> 2, wc = wid & 3, fr = lane & 15, fq = lane >> 4;
    const int K = g.K, nt = K / BK;
    unsigned voffA[2], voffB[2];
#pragma unroll
    for (int i = 0; i < 2; ++i) { int R, C; stage_rc(tid * 16 + i * 8192, R, C); const int Rb = Epi::PERM ? ((R & ~31) + perm32(R & 31)) : R;
        voffA[i] = (unsigned)(R * K + C) * 2u; voffB[i] = (unsigned)(Rb * K + C) * 2u; }
    const size_t kstep = (size_t)(BK * 2);
    const size_t hstep = (size_t)HALF * K * 2;
    const size_t tstep = 2 * hstep;
    const unsigned ldsw = (unsigned)wid * 1024u;
    const int aoff = lds_byte(wr * 64 + fr, fq * 8), boff = lds_byte(wc * 32 + fr, fq * 8);
#define PG8_SA(b, h) (((b) * 2 + (h)) * HTB)
#define PG8_SB(b, h) ((4 + (b) * 2 + (h)) * HTB)
#define PG8_STAGE(bufoff, gbase, voff) do { _Pragma("unroll") for (int _i = 0; _i < 2; ++_i) \
        __builtin_amdgcn_global_load_lds((const unsigned*)((const char*)(gbase) + (voff)[_i]), (PG8_LAS unsigned*)(lds + (bufoff) + ldsw + _i * 8192), 16, 0, 0); } while (0)
#define PG8_LDA(dst, b, h) do { _Pragma("unroll") for (int m = 0; m < 4; ++m) _Pragma("unroll") for (int k = 0; k < 2; ++k) dst[m][k] = *(const PG8_LAS bf16x8*)(lds + PG8_SA(b, h) + aoff + m * 2048 + k * 1024); } while (0)
#define PG8_LDB(dst, b, h) do { _Pragma("unroll") for (int n = 0; n < 2; ++n) _Pragma("unroll") for (int k = 0; k < 2; ++k) dst[n][k] = *(const PG8_LAS bf16x8*)(lds + PG8_SB(b, h) + boff + n * 2048 + k * 1024); } while (0)
#define PG8_MMA(ai, bj, At, Bt) do { __builtin_amdgcn_s_setprio(1); _Pragma("unroll") for (int m = 0; m < 4; ++m) _Pragma("unroll") for (int n = 0; n < 2; ++n) _Pragma("unroll") for (int k = 0; k < 2; ++k) \
        acc[ai][bj][m][n] = __builtin_amdgcn_mfma_f32_16x16x32_bf16(Bt[n][k], At[m][k], acc[ai][bj][m][n], 0, 0, 0); __builtin_amdgcn_s_setprio(0); } while (0)
#define PG8_WAIT_V(n) asm volatile("s_waitcnt vmcnt(" #n ")" ::: "memory")
#define PG8_WAIT_L(n) asm volatile("s_waitcnt lgkmcnt(" #n ")" ::: "memory")
#define PG8_BAR __builtin_amdgcn_s_barrier()
#define PG8_SCHED __builtin_amdgcn_sched_barrier(0)
    Unit cur, nxt; int ui = 0;
    if (!S.next(0, cur)) return;
    f32x4 acc[2][2][4][2];
#pragma unroll
    for (int a = 0; a < 2; ++a)
#pragma unroll
        for (int b = 0; b < 2; ++b)
#pragma unroll
            for (int m = 0; m < 4; ++m)
#pragma unroll
                for (int n = 0; n < 2; ++n) acc[a][b][m][n] = (f32x4){0.f, 0.f, 0.f, 0.f};
    bf16x8 At[4][2], B0[2][2], B1[2][2];
    const char* cA = (const char*)g.A + (size_t)cur.pm * tstep; const char* cB = (const char*)g.Bt + (size_t)cur.pn * tstep;
    S.a_ready(cur);
    if constexpr (SP2) {
        PG8_STAGE(PG8_SB(0, 0), cB, voffB); PG8_STAGE(PG8_SB(0, 1), cB + hstep, voffB); PG8_STAGE(PG8_SA(0, 0), cA, voffA); PG8_STAGE(PG8_SA(0, 1), cA + hstep, voffA);
        if (wr == 1) PG8_BAR;
        PG8_WAIT_V(2); PG8_BAR;
        PG8_STAGE(PG8_SB(1, 0), cB + kstep, voffB); PG8_STAGE(PG8_SA(1, 0), cA + kstep, voffA); PG8_STAGE(PG8_SB(1, 1), cB + hstep + kstep, voffB);
        PG8_WAIT_V(6); PG8_BAR;
    } else {
        PG8_STAGE(PG8_SB(0, 0), cB, voffB); PG8_STAGE(PG8_SA(0, 0), cA, voffA); PG8_STAGE(PG8_SB(0, 1), cB + hstep, voffB); PG8_STAGE(PG8_SA(0, 1), cA + hstep, voffA);
        if (wr == 1) PG8_BAR;
        PG8_WAIT_V(4); PG8_BAR;
        PG8_STAGE(PG8_SB(1, 0), cB + kstep, voffB); PG8_STAGE(PG8_SA(1, 0), cA + kstep, voffA); PG8_STAGE(PG8_SB(1, 1), cB + hstep + kstep, voffB);
        PG8_WAIT_V(6); PG8_BAR;
    }
    for (;;) {
        const bool has_next = S.next(ui + 1, nxt);
        const char* nA = has_next ? (const char*)g.A + (size_t)nxt.pm * tstep : cA; const char* nB = has_next ? (const char*)g.Bt + (size_t)nxt.pn * tstep : cB;
        for (int t = 0; t < nt; t += 2) {
            const bool last = (t == nt - 2);
            const char* a1 = cA + (size_t)(t + 1) * kstep;
            const char* a2 = last ? nA : cA + (size_t)(t + 2) * kstep; const char* b2 = last ? nB : cB + (size_t)(t + 2) * kstep;
            const char* a3 = a2 + kstep; const char* b3 = b2 + kstep;
            if (last && has_next) S.a_ready(nxt);
            if constexpr (SP2) {
            PG8_LDB(B0, 0, 0); PG8_LDB(B1, 0, 1); PG8_SCHED; PG8_LDA(At, 0, 0); PG8_STAGE(PG8_SA(1, 1), a1 + hstep, voffA);
            PG8_WAIT_V(8); PG8_WAIT_L(0); PG8_BAR; PG8_MMA(0, 0, At, B0); PG8_MMA(0, 1, At, B1); PG8_BAR; PG8_SCHED;
            PG8_LDA(At, 0, 1); PG8_STAGE(PG8_SB(0, 0), b2, voffB); PG8_STAGE(PG8_SB(0, 1), b2 + hstep, voffB); PG8_STAGE(PG8_SA(0, 0), a2, voffA);
            PG8_WAIT_V(8); PG8_WAIT_L(0); PG8_BAR; PG8_MMA(1, 0, At, B0); PG8_MMA(1, 1, At, B1); PG8_BAR; PG8_SCHED;
            PG8_LDB(B0, 1, 0); PG8_LDB(B1, 1, 1); PG8_SCHED; PG8_LDA(At, 1, 0); PG8_STAGE(PG8_SA(0, 1), a2 + hstep, voffA);
            PG8_WAIT_V(8); PG8_WAIT_L(0); PG8_BAR; PG8_MMA(0, 0, At, B0); PG8_MMA(0, 1, At, B1); PG8_BAR; PG8_SCHED;
            PG8_LDA(At, 1, 1); PG8_STAGE(PG8_SB(1, 0), b3, voffB); PG8_STAGE(PG8_SB(1, 1), b3 + hstep, voffB); PG8_STAGE(PG8_SA(1, 0), a3, voffA);
            PG8_WAIT_V(8); PG8_WAIT_L(0); PG8_BAR; PG8_MMA(1, 0, At, B0); PG8_MMA(1, 1, At, B1); PG8_BAR; PG8_SCHED;
            } else {
            PG8_LDB(B0, 0, 0); PG8_SCHED; PG8_LDA(At, 0, 0); PG8_STAGE(PG8_SA(1, 1), a1 + hstep, voffA);
            PG8_WAIT_L(8); PG8_BAR; PG8_WAIT_L(0); PG8_MMA(0, 0, At, B0); PG8_BAR; PG8_SCHED;
            PG8_LDB(B1, 0, 1); PG8_STAGE(PG8_SB(0, 0), b2, voffB);
            PG8_BAR; PG8_WAIT_L(0); PG8_MMA(0, 1, At, B1); PG8_BAR;
            PG8_LDA(At, 0, 1); PG8_STAGE(PG8_SA(0, 0), a2, voffA);
            PG8_BAR; PG8_WAIT_L(0); PG8_MMA(1, 0, At, B0); PG8_BAR; PG8_SCHED;
            PG8_STAGE(PG8_SB(0, 1), b2 + hstep, voffB);
            PG8_WAIT_V(6); PG8_BAR; PG8_MMA(1, 1, At, B1); PG8_BAR;
            PG8_LDB(B0, 1, 0); PG8_SCHED; PG8_LDA(At, 1, 0); PG8_STAGE(PG8_SA(0, 1), a2 + hstep, voffA);
            PG8_WAIT_L(8); PG8_BAR; PG8_WAIT_L(0); PG8_MMA(0, 0, At, B0); PG8_BAR; PG8_SCHED;
            PG8_LDB(B1, 1, 1); PG8_STAGE(PG8_SB(1, 0), b3, voffB);
            PG8_BAR; PG8_WAIT_L(0); PG8_MMA(0, 1, At, B1); PG8_BAR;
            PG8_LDA(At, 1, 1); PG8_STAGE(PG8_SA(1, 0), a3, voffA);
            PG8_BAR; PG8_WAIT_L(0); PG8_MMA(1, 0, At, B0); PG8_BAR; PG8_SCHED;
            PG8_STAGE(PG8_SB(1, 1), b3 + hstep, voffB);
            PG8_WAIT_V(6); PG8_BAR; PG8_MMA(1, 1, At, B1); PG8_BAR;
            }
        }
        if constexpr (ALIGN_EPI) { if (wr == 0) PG8_BAR; }
        if constexpr (!Epi::AFTER_DRAIN) { E(acc, cur, wr, wc, fr, fq); S.done(cur); }
        if (!has_next) break;
#pragma unroll
        for (int a = 0; a < 2; ++a)
#pragma unroll
            for (int b = 0; b < 2; ++b)
#pragma unroll
                for (int m = 0; m < 4; ++m)
#pragma unroll
                    for (int n = 0; n < 2; ++n) acc[a][b][m][n] = (f32x4){0.f, 0.f, 0.f, 0.f};
        cur = nxt; cA = nA; cB = nB; ++ui;
        if constexpr (ALIGN_EPI) { if (wr == 1) PG8_BAR; }
    }
    PG8_WAIT_V(0);
    if constexpr (!ALIGN_EPI) { if (wr == 0) PG8_BAR; }
    PG8_BAR;
    if constexpr (Epi::AFTER_DRAIN) { E.fused(acc, cur, wr, wc, fr, fq, lds, wid, lane); S.done(cur); }
#undef PG8_SA
#undef PG8_SB
#undef PG8_STAGE
#undef PG8_LDA
#undef PG8_LDB
#undef PG8_MMA
#undef PG8_WAIT_V
#undef PG8_WAIT_L
#undef PG8_BAR
#undef PG8_SCHED
}
}
namespace attn_body {
using bf16=unsigned short;
using bf16x8=__attribute__((ext_vector_type(8)))short;
using s16x4=__attribute__((ext_vector_type(4)))short;
using f32x16=__attribute__((ext_vector_type(16)))float;
using u32x4=__attribute__((ext_vector_type(4)))unsigned;
constexpr int SEQ=2048,D=64,DM=4096,DMO=1024;
constexpr int NW=8,QBLK=32,QB=QBLK*NW,KVBLK=64,NQB=SEQ/QB;
__device__ __forceinline__ unsigned f2bf_(float f){unsigned u=__builtin_bit_cast(unsigned,f);return (u+0x7fffu+((u>>16)&1u))>>16;}
__device__ __forceinline__ int crow(int r,int hi){return (r&3)+8*(r>>2)+4*hi;}
#define SBAR() __builtin_amdgcn_sched_barrier(0)
__device__ __forceinline__ void cmask(f32x16&p0,f32x16&p1,int jb,int qrel,int hi){
  const float NEG=-INFINITY; int kb=64*jb+4*hi;
  #pragma unroll
  for(int r=0;r<16;++r){int kv=kb+(r&3)+8*(r>>2); if(kv>qrel)p0[r]=NEG; if(kv+32>qrel)p1[r]=NEG;}
}

__device__ __forceinline__ uint2 mld_asm(const unsigned*p){ uint2 v; asm volatile("global_load_dwordx2 %0, %1, off":"=v"(v):"v"(p):"memory"); return v; }
__device__ __forceinline__ void bmask(f32x16&p0,f32x16&p1,uint2 w,int hi){
  const float NEG=-INFINITY; const unsigned a=w.x>>(4*hi), b=w.y>>(4*hi);
  #pragma unroll
  for(int r=0;r<16;++r){const int bit=(r&3)+8*(r>>2); if(!((a>>bit)&1u))p0[r]=NEG; if(!((b>>bit)&1u))p1[r]=NEG;}
}
constexpr int NSLOT=3, SLOTB=8192;
constexpr int LDS_K=0, LDS_V=NSLOT*SLOTB, LDS_WS=2*NSLOT*SLOTB, LDS_OST=LDS_WS+NW*64*4, LDS_BYTES=LDS_OST+NW*4096;
constexpr float C2=0.125f*1.4426950408889634f;
__device__ __forceinline__ void glds16(const void*gsrc,unsigned lds_dst){unsigned keep;
  asm volatile("s_mov_b32 %0, m0\n\ts_mov_b32 m0, %2\n\ts_nop 0\n\tglobal_load_lds_dwordx4 %1, off\n\ts_mov_b32 m0, %0":"=&s"(keep):"v"(gsrc),"s"(lds_dst):"memory");}
__device__ __forceinline__ float max3f(float a,float b,float c){float r;asm("v_max3_f32 %0, %1, %2, %3":"=v"(r):"v"(a),"v"(b),"v"(c));return r;}
__device__ __forceinline__ float max2f(float a,float b){float r;asm("v_max_f32_e32 %0, %1, %2":"=v"(r):"v"(a),"v"(b));return r;}
__device__ __forceinline__ float fadd_s(float a,float b){float r;asm("v_add_f32_e32 %0, %1, %2":"=v"(r):"v"(a),"v"(b));return r;}
__device__ __forceinline__ float fsub_s(float a,float b){float r;asm("v_sub_f32_e32 %0, %1, %2":"=v"(r):"v"(a),"v"(b));return r;}
typedef float f32x2_t __attribute__((ext_vector_type(2))); typedef __bf16 bf16x2_t __attribute__((ext_vector_type(2)));
__device__ __forceinline__ unsigned cvtpk_s(float lo,float hi){f32x2_t v={lo,hi};bf16x2_t b=__builtin_convertvector(v,bf16x2_t);return __builtin_bit_cast(unsigned,b);}
#define WAIT_BAR(N) asm volatile("s_waitcnt vmcnt(" #N ") lgkmcnt(0)\n\ts_barrier":::"memory")

__device__ __forceinline__ void qkt(f32x16&p0,f32x16&p1,const char*Kslot,const bf16x8*qr,const f32x16&negm,int r32,int hi){
  const char*kb=Kslot+hi*1024+r32*16;
  #pragma unroll
  for(int d0=0;d0<4;++d0){
    const bf16x8 b0=*reinterpret_cast<const bf16x8*>(kb+d0*2048);
    const bf16x8 b1=*reinterpret_cast<const bf16x8*>(kb+d0*2048+512);
    if(d0==0){p0=__builtin_amdgcn_mfma_f32_32x32x16_bf16(b0,qr[0],negm,0,0,0);p1=__builtin_amdgcn_mfma_f32_32x32x16_bf16(b1,qr[0],negm,0,0,0);}
    else{p0=__builtin_amdgcn_mfma_f32_32x32x16_bf16(b0,qr[d0],p0,0,0,0);p1=__builtin_amdgcn_mfma_f32_32x32x16_bf16(b1,qr[d0],p1,0,0,0);}}
}
typedef __attribute__((address_space(3))) const char* lds_cptr;
typedef short v4i16_t __attribute__((ext_vector_type(4)));
__device__ __forceinline__ void kload8(bf16x8*kf,lds_cptr kp){
  kf[0]=*(const __attribute__((address_space(3))) bf16x8*)(kp);      kf[1]=*(const __attribute__((address_space(3))) bf16x8*)(kp+512);
  kf[2]=*(const __attribute__((address_space(3))) bf16x8*)(kp+2048); kf[3]=*(const __attribute__((address_space(3))) bf16x8*)(kp+2560);
  kf[4]=*(const __attribute__((address_space(3))) bf16x8*)(kp+4096); kf[5]=*(const __attribute__((address_space(3))) bf16x8*)(kp+4608);
  kf[6]=*(const __attribute__((address_space(3))) bf16x8*)(kp+6144); kf[7]=*(const __attribute__((address_space(3))) bf16x8*)(kp+6656);
}
__device__ __forceinline__ void kload2(bf16x8*kf,lds_cptr kp,int j){ kf[2*j]=*(const __attribute__((address_space(3))) bf16x8*)(kp+j*2048); kf[2*j+1]=*(const __attribute__((address_space(3))) bf16x8*)(kp+j*2048+512); }
__device__ __forceinline__ s16x4 vtr(lds_cptr p){ return __builtin_bit_cast(s16x4,__builtin_amdgcn_ds_read_tr16_b64_v4i16((__attribute__((address_space(3))) v4i16_t*)p)); }
__device__ __forceinline__ float rowmax(const f32x16&p0,const f32x16&p1){
  float a=max3f(p0[0],p0[1],p1[0]),b=max3f(p0[2],p0[3],p1[1]);a=max3f(a,p1[2],p1[3]);
  #pragma unroll
  for(int r=4;r<16;r+=4){a=max3f(a,p0[r],p0[r+1]);b=max3f(b,p0[r+2],p0[r+3]);a=max3f(a,p1[r],p1[r+1]);b=max3f(b,p1[r+2],p1[r+3]);}
  const float m=max2f(a,b);
  auto rr=__builtin_amdgcn_permlane32_swap(__float_as_uint(m),__float_as_uint(m),false,false);
  return max2f(__uint_as_float(rr[0]),__uint_as_float(rr[1]));
}
__device__ __forceinline__ void pv(f32x16*o,int vb,bf16x8 pa0,bf16x8 pa1,bf16x8 pa2,bf16x8 pa3){
  #pragma unroll
  for(int d0=0;d0<2;++d0){s16x4 lo[4],hi[4];
    #pragma unroll
    for(int ks=0;ks<4;++ks){
      asm volatile("ds_read_b64_tr_b16 %0,%1 offset:%c2":"=&v"(lo[ks]):"v"(vb),"i"(d0*4096+ks*1024):"memory");
      asm volatile("ds_read_b64_tr_b16 %0,%1 offset:%c2":"=&v"(hi[ks]):"v"(vb),"i"(d0*4096+ks*1024+512):"memory");}
    asm volatile("s_waitcnt lgkmcnt(0)":::"memory");SBAR();
    #define PK(k) (bf16x8){lo[k][0],lo[k][1],lo[k][2],lo[k][3],hi[k][0],hi[k][1],hi[k][2],hi[k][3]}
    o[d0]=__builtin_amdgcn_mfma_f32_32x32x16_bf16(pa0,PK(0),o[d0],0,0,0);
    o[d0]=__builtin_amdgcn_mfma_f32_32x32x16_bf16(pa1,PK(1),o[d0],0,0,0);
    o[d0]=__builtin_amdgcn_mfma_f32_32x32x16_bf16(pa2,PK(2),o[d0],0,0,0);
    o[d0]=__builtin_amdgcn_mfma_f32_32x32x16_bf16(pa3,PK(3),o[d0],0,0,0);
    #undef PK
  }
}

#ifndef ATTN_STORE16
#define ATTN_STORE16(p,v) (*(u32x4*)(p)=(v))
#endif
template<int THRL,bool MASKED> __device__ __forceinline__ void attn_unit(int b,int qb,const bf16*Q,const bf16*__restrict__ K,const bf16*__restrict__ V,bf16*O,const unsigned*MASK,char*shm){
  int tid_=threadIdx.x; asm volatile("":"+v"(tid_));
  const int tid=tid_,lane=tid&63,r32=lane&31,hi=lane>>5; const int wid=__builtin_amdgcn_readfirstlane(tid>>6);
  const long rowbase=(long)b*SEQ; const int q0=qb*QB;
  const bf16*Qw=Q+(rowbase+q0+wid*QBLK)*DM;
  const bf16*Kh=K+rowbase*DM,*Vh=V+rowbase*DM;
  const unsigned*mrow=MASK+(size_t)(rowbase+q0+wid*QBLK+r32)*64;
  #define MLD(tt) mld_asm(mrow+2*(tt))
  const unsigned lds0=(unsigned)(uintptr_t)shm;
  float*wsf=(float*)(shm+LDS_WS)+wid*64;
  const bf16*ksrc=Kh+(long)lane*DM+wid*8;
  const bf16*vsrc=Vh+(long)(16*(wid&3)+(lane>>2))*DM+(wid>>2)*32+(lane&3)*8;
  const unsigned kdst=lds0+LDS_K+wid*1024, vdst=lds0+LDS_V+wid*1024;
  #define DMA_K(t,slot) glds16(ksrc+(long)(t)*KVBLK*DM,(unsigned)__builtin_amdgcn_readfirstlane(kdst+(slot)))
  #define DMA_V(t,slot) glds16(vsrc+(long)(t)*KVBLK*DM,(unsigned)__builtin_amdgcn_readfirstlane(vdst+(slot)))
  const int vb0=(int)(lds0+LDS_V)+((lane>>4)&1)*32+(lane&3)*8+(4*hi+((lane&15)>>2))*64;
  const char*Kbase=shm+LDS_K; bf16x8 kf[8];
  const lds_cptr shm3=(lds_cptr)shm; const lds_cptr kp0=shm3+LDS_K+hi*1024+r32*16; const lds_cptr vp0=shm3+LDS_V+((lane>>4)&1)*32+(lane&3)*8+(4*hi+((lane&15)>>2))*64;
  const int NT=(q0+QB)/KVBLK;
  uint2 mw_cur=make_uint2(~0u,~0u), mw_next=make_uint2(~0u,~0u); if(MASKED){ mw_cur=MLD(0); mw_next=MLD(1); }
  DMA_K(0,0);DMA_V(0,0);DMA_K(1,SLOTB);
  bf16x8 qr[4];
  #pragma unroll
  for(int d0=0;d0<4;++d0)qr[d0]=*reinterpret_cast<const bf16x8*>(&Qw[(long)r32*DM+d0*16+hi*8]);
  float mhat=0.f,l_reg=0.f;f32x16 o[2];o[0]=f32x16{};o[1]=f32x16{};f32x16 negm=f32x16{};asm volatile("":"+v"(negm));
  const int qrel=wid*QBLK+r32;
  #define CMASK(P0,P1,t) do{ if(MASKED){bmask(P0,P1,mw_cur,hi);} else {int jb_=(t)-(NT-4); if(jb_>=0)cmask(P0,P1,jb_,qrel,hi);} }while(0)
  bool resc=false;
  #define START(P0,P1) do{ float rm=rowmax(P0,P1); if(MASKED)rm=max2f(rm,-64.f); resc=false; \
    { const float dl=rm; mhat=fadd_s(mhat,dl); \
      _Pragma("unroll") for(int r=0;r<16;++r){P0[r]=fsub_s(P0[r],dl);P1[r]=fsub_s(P1[r],dl);} \
      _Pragma("unroll") for(int r=0;r<16;++r)negm[r]=-mhat; asm volatile("":"+v"(negm)); } \
    _Pragma("unroll") for(int r=0;r<16;++r)P0[r]=__builtin_amdgcn_exp2f(P0[r]); }while(0)
  #define RESC() do{ if(resc){ asm volatile("s_waitcnt lgkmcnt(0)":::"memory"); \
      _Pragma("unroll") for(int d_=0;d_<2;++d_) _Pragma("unroll") for(int r=0;r<16;++r)o[d_][r]*=wsf[crow(r,hi)]; } }while(0)
  f32x16 pA0,pA1,pB0,pB1;
  int sl_prev=0,sl_cur=0,sl_next=SLOTB;
  #define ROT() do{sl_prev=sl_cur;sl_cur=sl_next;sl_next=(sl_next==(NSLOT-1)*SLOTB)?0:sl_next+SLOTB;}while(0)
  DMA_K(2,2*SLOTB);
  WAIT_BAR(3);
  qkt(pA0,pA1,Kbase,qr,negm,r32,hi);asm volatile("s_nop 15\n\ts_nop 7":"+v"(pA0),"+v"(pA1));CMASK(pA0,pA1,0);
  START(pA0,pA1);
  _Pragma("unroll") for(int r=0;r<16;++r)pA1[r]=__builtin_amdgcn_exp2f(pA1[r]);
  WAIT_BAR(0);
  DMA_K(3,0);DMA_V(1,SLOTB);
  ROT();
  kload8(kf,kp0+sl_cur);
  WAIT_BAR(2);
  s16x4 vlo[8],vhi[8]; u32x4 pw0,pw1,pw2,pw3;
  #define PKW(P,B) cvtpk_s(P[B],P[B+1])
  #define PAF(k) __builtin_bit_cast(bf16x8,pw##k)
  #define VFR(i) (bf16x8){vlo[i][0],vlo[i][1],vlo[i][2],vlo[i][3],vhi[i][0],vhi[i][1],vhi[i][2],vhi[i][3]}
  #define PIN(x) asm volatile("":"+v"(x))
  #define MX3(a,b,c) __builtin_fmaxf(__builtin_fmaxf((a),(b)),(c))
  #define GAPA(MF,A0,A1,A2,A3,W0,W1,PW) do{ MF; sacc+=A0; sacc+=A1; sacc+=A2; sacc+=A3; PIN(sacc); W0; W1; PIN(PW); SBAR(); }while(0)
  #define EX(v) __builtin_amdgcn_exp2f(v)
  #define GAPB(MF,X,B) do{ MF; X[B]=EX(X[B]); X[B+1]=EX(X[B+1]); X[B+2]=EX(X[B+2]); X[B+3]=EX(X[B+3]); PIN(X); SBAR(); }while(0)
  #define VRD(i) do{ vlo[i]=vtr(vp_+(((i)>>2)*4096+((i)&3)*1024)); vhi[i]=vtr(vp_+(((i)>>2)*4096+((i)&3)*1024+512)); }while(0)
  #define KRD(G,j) do{ if(G){ kload2(kf,kp0+sl_next,j); SBAR(); } }while(0)
  #define STEP(C0,C1,P0,P1,t,GK,GV,GL) do{ SBAR(); if(MASKED){ mw_cur=mw_next; if((t)+1<NT) mw_next=MLD((t)+1); } \
    const lds_cptr vp_=vp0+sl_prev; \
    VRD(0); SBAR(); float sacc=(P0[0]+P0[1]); \
    GAPA(C0=__builtin_amdgcn_mfma_f32_32x32x16_bf16(kf[0],qr[0],negm,0,0,0), P0[2],P0[3],P0[4],P0[5],     pw0[0]=PKW(P0,0), pw0[1]=PKW(P0,2), pw0); \
    VRD(4); SBAR(); GAPA(C1=__builtin_amdgcn_mfma_f32_32x32x16_bf16(kf[1],qr[0],negm,0,0,0), P0[6],P0[7],P0[8],P0[9],     pw0[2]=PKW(P0,4), pw0[3]=PKW(P0,6), pw0); \
    VRD(1); SBAR(); GAPA(C0=__builtin_amdgcn_mfma_f32_32x32x16_bf16(kf[2],qr[1],C0,0,0,0),   P0[10],P0[11],P0[12],P0[13], pw1[0]=PKW(P0,8), pw1[1]=PKW(P0,10), pw1); \
    VRD(5); SBAR(); GAPA(C1=__builtin_amdgcn_mfma_f32_32x32x16_bf16(kf[3],qr[1],C1,0,0,0),   P0[14],P0[15],P1[0],P1[1],   pw1[2]=PKW(P0,12),pw1[3]=PKW(P0,14), pw1); \
    VRD(2); SBAR(); GAPA(C0=__builtin_amdgcn_mfma_f32_32x32x16_bf16(kf[4],qr[2],C0,0,0,0),   P1[2],P1[3],P1[4],P1[5],     pw2[0]=PKW(P1,0), pw2[1]=PKW(P1,2), pw2); \
    VRD(6); SBAR(); GAPA(C1=__builtin_amdgcn_mfma_f32_32x32x16_bf16(kf[5],qr[2],C1,0,0,0),   P1[6],P1[7],P1[8],P1[9],     pw2[2]=PKW(P1,4), pw2[3]=PKW(P1,6), pw2); \
    VRD(3); SBAR(); GAPA(C0=__builtin_amdgcn_mfma_f32_32x32x16_bf16(kf[6],qr[3],C0,0,0,0),   P1[10],P1[11],P1[12],P1[13], pw3[0]=PKW(P1,8), pw3[1]=PKW(P1,10), pw3); \
    VRD(7); SBAR(); GAPA(C1=__builtin_amdgcn_mfma_f32_32x32x16_bf16(kf[7],qr[3],C1,0,0,0),   P1[14],P1[15],0.f,0.f,       pw3[2]=PKW(P1,12),pw3[3]=PKW(P1,14), pw3); \
    l_reg+=sacc; \
    if(GK){DMA_K((t)+3,sl_cur);} if(GV){DMA_V((t)+1,sl_next);} \
    CMASK(C0,C1,t); \
    { float a=MX3(C0[0],C0[1],C1[0]),b=MX3(C0[2],C0[3],C1[1]); a=MX3(a,C1[2],C1[3]); \
      _Pragma("unroll") for(int r=4;r<16;r+=4){a=MX3(a,C0[r],C0[r+1]);b=MX3(b,C0[r+2],C0[r+3]);a=MX3(a,C1[r],C1[r+1]);b=MX3(b,C1[r+2],C1[r+3]);} \
      float rm=__builtin_fmaxf(a,b); { auto rr=__builtin_amdgcn_permlane32_swap(__float_as_uint(rm),__float_as_uint(rm),false,false); rm=__builtin_fmaxf(__uint_as_float(rr[0]),__uint_as_float(rr[1])); } \
      resc=false; \
      if(__builtin_expect(__any(rm>(float)THRL),0)){ const float dl=__builtin_fmaxf(rm,0.f); mhat+=dl; \
        _Pragma("unroll") for(int r=0;r<16;++r){C0[r]-=dl;C1[r]-=dl;} \
        _Pragma("unroll") for(int r=0;r<16;++r)negm[r]=-mhat; asm volatile("":"+v"(negm)); \
        const float f=__builtin_amdgcn_exp2f(-dl); l_reg*=f; if(hi==0)wsf[r32]=f; resc=true; } } \
    SBAR(); \
    GAPB(o[0]=__builtin_amdgcn_mfma_f32_32x32x16_bf16(PAF(0),VFR(0),o[0],0,0,0), C0,0); \
    GAPB(o[1]=__builtin_amdgcn_mfma_f32_32x32x16_bf16(PAF(0),VFR(4),o[1],0,0,0), C0,4); \
    KRD(GL,0); GAPB(o[0]=__builtin_amdgcn_mfma_f32_32x32x16_bf16(PAF(1),VFR(1),o[0],0,0,0), C0,8); \
    KRD(GL,1); GAPB(o[1]=__builtin_amdgcn_mfma_f32_32x32x16_bf16(PAF(1),VFR(5),o[1],0,0,0), C0,12); \
    KRD(GL,2); GAPB(o[0]=__builtin_amdgcn_mfma_f32_32x32x16_bf16(PAF(2),VFR(2),o[0],0,0,0), C1,0); \
    KRD(GL,3); GAPB(o[1]=__builtin_amdgcn_mfma_f32_32x32x16_bf16(PAF(2),VFR(6),o[1],0,0,0), C1,4); \
    GAPB(o[0]=__builtin_amdgcn_mfma_f32_32x32x16_bf16(PAF(3),VFR(3),o[0],0,0,0), C1,8); \
    GAPB(o[1]=__builtin_amdgcn_mfma_f32_32x32x16_bf16(PAF(3),VFR(7),o[1],0,0,0), C1,12); \
    }while(0)
  int t=1;
  #undef CMASK
  #define CMASK(P0,P1,t) do{ if(MASKED){bmask(P0,P1,mw_cur,hi);} }while(0)
  for(;t+5<NT;t+=2){
    STEP(pB0,pB1,pA0,pA1,t,true,true,true);     WAIT_BAR(2); RESC(); ROT();
    STEP(pA0,pA1,pB0,pB1,t+1,true,true,true);   WAIT_BAR(2); RESC(); ROT();
  }
  #undef CMASK
  #define CMASK(P0,P1,t) do{ if(MASKED){bmask(P0,P1,mw_cur,hi);} else {int jb_=(t)-(NT-4); if(jb_>=0)cmask(P0,P1,jb_,qrel,hi);} }while(0)
  #define ENDW(tt) do{ if((tt)+3<NT){WAIT_BAR(2);} else if((tt)+2<NT){WAIT_BAR(1);} else {WAIT_BAR(0);} }while(0)
  for(;t+1<NT;t+=2){
    STEP(pB0,pB1,pA0,pA1,t,(t+3<NT),(t+1<NT),(t+1<NT));       ENDW(t);   RESC(); ROT();
    STEP(pA0,pA1,pB0,pB1,t+1,(t+4<NT),(t+2<NT),(t+2<NT));     ENDW(t+1); RESC(); ROT();
  }
  STEP(pB0,pB1,pA0,pA1,NT-1,false,false,false); RESC();
  { float sacc=pB0[0]+pB0[1]; _Pragma("unroll") for(int r=2;r<16;++r)sacc+=pB0[r]; _Pragma("unroll") for(int r=0;r<16;++r)sacc+=pB1[r]; l_reg+=sacc;
    pw0=(u32x4){PKW(pB0,0),PKW(pB0,2),PKW(pB0,4),PKW(pB0,6)};pw1=(u32x4){PKW(pB0,8),PKW(pB0,10),PKW(pB0,12),PKW(pB0,14)};pw2=(u32x4){PKW(pB1,0),PKW(pB1,2),PKW(pB1,4),PKW(pB1,6)};pw3=(u32x4){PKW(pB1,8),PKW(pB1,10),PKW(pB1,12),PKW(pB1,14)};
    SBAR(); pv(o,vb0+sl_cur,PAF(0),PAF(1),PAF(2),PAF(3)); }
  #undef PKW
  #undef PAF
  #undef VFR
  #undef PIN
  #undef MX3
  #undef GAPA
  #undef GAPB
  #undef EX
  #undef VRD
  #undef KRD
  #undef STEP
  #undef ENDW
  {auto rr=__builtin_amdgcn_permlane32_swap(__float_as_uint(l_reg),__float_as_uint(l_reg),false,false);l_reg=__uint_as_float(rr[0])+__uint_as_float(rr[1]);}
  if(hi==0)wsf[32+r32]=l_reg;asm volatile("s_waitcnt lgkmcnt(0)":::"memory");
  float rli[16];
  #pragma unroll
  for(int r=0;r<16;++r)rli[r]=__builtin_amdgcn_rcpf(wsf[32+crow(r,hi)]);
  bf16*Ow=O+(rowbase+q0+wid*QBLK)*DMO;
  { bf16*stg=(bf16*)(shm+LDS_OST)+wid*2048;
    #pragma unroll
    for(int r=0;r<16;++r){const int orow=crow(r,hi);
      #pragma unroll
      for(int d0=0;d0<2;++d0)stg[orow*64+d0*32+r32]=(bf16)f2bf_(o[d0][r]*rli[r]);}
    asm volatile("s_waitcnt lgkmcnt(0)":::"memory");
    #pragma unroll
    for(int i=0;i<4;++i){const int row=i*8+(lane>>3),ch=lane&7; const u32x4 v=*(const u32x4*)(stg+row*64+ch*8); ATTN_STORE16(Ow+(long)row*DMO+ch*8,v);} }
  asm volatile("s_waitcnt lgkmcnt(0)\n\ts_barrier":::"memory");
  #undef DMA_K
  #undef DMA_V
  #undef MLD
  #undef CMASK
  #undef START
  #undef RESC
  #undef ROT
}
constexpr int ATTN_LDS_BYTES=LDS_BYTES;
#undef SBAR
#undef WAIT_BAR
}
#define GAS __attribute__((address_space(1)))
#define LAS __attribute__((address_space(3)))
typedef unsigned short bf16;
typedef unsigned v4u __attribute__((ext_vector_type(4)));
typedef float f32x4 __attribute__((ext_vector_type(4)));
typedef short bf16x8 __attribute__((ext_vector_type(8)));
typedef GAS unsigned gu32;
typedef GAS unsigned long long gu64;
#define RLX_AGENT __ATOMIC_RELAXED, __HIP_MEMORY_SCOPE_AGENT
#define LDS_WAIT() asm volatile("s_waitcnt lgkmcnt(0)" ::: "memory")
#define VM_WAIT() asm volatile("s_waitcnt vmcnt(0)" ::: "memory")
__device__ __forceinline__ unsigned long long rt() { return __builtin_amdgcn_s_memrealtime(); }
__device__ __forceinline__ unsigned f2bf(float f) { unsigned u = __builtin_bit_cast(unsigned, f); return (u + 0x7fffu + ((u >> 16) & 1u)) >> 16; }
__device__ __forceinline__ unsigned pk2(float lo, float hi) { return f2bf(lo) | (f2bf(hi) << 16); }
#define XB_TMO      128
#define XB_XCNT(j)  (256  + 64 * (j))
#define XB_XSUB(j)  (1280 + 64 * (j))
#define XB_XGEN(j)  (2304 + 64 * (j))
#define XB_TOP      3328
#define XB_TOPGEN   3392
#define XCD_BAR_WORDS 3456
#define XB_SPIN_CAP (1u << 20)

__device__ __forceinline__ unsigned xb_ld(unsigned* p)              { return __hip_atomic_load(p, __ATOMIC_RELAXED, __HIP_MEMORY_SCOPE_AGENT); }
__device__ __forceinline__ unsigned xb_add(unsigned* p, unsigned v) { return __hip_atomic_fetch_add(p, v, __ATOMIC_RELAXED, __HIP_MEMORY_SCOPE_AGENT); }
__device__ __forceinline__ unsigned xb_xcc_id() { return (unsigned)__builtin_amdgcn_s_getreg((3 << 11) | 20) & 0xFu; }
#define XB_SPIN(cond, bar) do { unsigned _sp = 0; while (cond) { __builtin_amdgcn_s_sleep(1); \
    if ((++_sp & 255u) == 0u) { if (xb_ld(&(bar)[XB_TMO])) break; if (_sp > XB_SPIN_CAP) { atomicAdd(&(bar)[XB_TMO], 1u); break; } } } } while (0)

struct XcdBarrier {
    unsigned* bar; unsigned x;
    volatile LAS unsigned* st;
};

__device__ __forceinline__ XcdBarrier xcd_barrier_post(unsigned* bar, volatile LAS unsigned* st) {
    XcdBarrier b; b.bar = bar; b.x = xb_xcc_id(); b.st = st;
    if (threadIdx.x == 0) (void)xb_add(&bar[XB_XCNT(b.x)], 1u);
    return b;
}
__device__ __forceinline__ void xcd_barrier_complete(unsigned* bar, unsigned x, unsigned& nloc, unsigned& nx) {
    const unsigned G = gridDim.x * gridDim.y * gridDim.z;
    unsigned sum, cnt, mine, sp = 0u;
    for (;;) {
        sum = 0u; cnt = 0u; mine = 0u;
#pragma unroll
        for (unsigned j = 0; j < 16; ++j) { const unsigned c = xb_ld(&bar[XB_XCNT(j)]); sum += c; cnt += (c > 0u) ? 1u : 0u; mine = (j == x) ? c : mine; }
        if (sum == G) break;
        __builtin_amdgcn_s_sleep(1);
        if ((++sp & 255u) == 0u) { if (xb_ld(&bar[XB_TMO])) break; if (sp > XB_SPIN_CAP) { atomicAdd(&bar[XB_TMO], 1u); break; } }
    }
    nloc = mine > 0u ? mine : 1u; nx = cnt > 0u ? cnt : 1u;
}

__device__ __forceinline__ void xcd_barrier(const XcdBarrier& b) {
    asm volatile("s_waitcnt vmcnt(0)" ::: "memory");
    __syncthreads();
    if (threadIdx.x == 0) {
        unsigned* bar = b.bar;
        __builtin_amdgcn_s_waitcnt(0);
        unsigned nloc = b.st[0], nx = b.st[1];
        if (nloc == 0u) { xcd_barrier_complete(bar, b.x, nloc, nx); b.st[0] = nloc; b.st[1] = nx; }
        const unsigned old = xb_add(&bar[XB_XSUB(b.x)], 1u);
        const unsigned gen = old / nloc;
        if (old + 1u == (gen + 1u) * nloc) {
            __builtin_amdgcn_fence(__ATOMIC_RELEASE, "agent");
            asm volatile("s_waitcnt vmcnt(0)" ::: "memory");
            const unsigned og = xb_add(&bar[XB_TOP], 1u);
            const unsigned tg = og / nx;
            if (og + 1u == (tg + 1u) * nx) xb_add(&bar[XB_TOPGEN], 1u);
            else XB_SPIN(xb_ld(&bar[XB_TOPGEN]) == tg, bar);
            __builtin_amdgcn_fence(__ATOMIC_ACQUIRE, "agent");
            xb_add(&bar[XB_XGEN(b.x)], 1u);
            asm volatile("s_waitcnt vmcnt(0)" ::: "memory");
        } else {
            XB_SPIN(xb_ld(&bar[XB_XGEN(b.x)]) == gen, bar);
            __builtin_amdgcn_fence(__ATOMIC_ACQUIRE, "agent");
            asm volatile("s_waitcnt vmcnt(0)" ::: "memory");
        }
    }
    __syncthreads();
}
constexpr int NB = 16, SEQ = 2048, T = NB * SEQ, D = 1024, DEPTH = 4, NHC = 4096, NEXP = 32, NWAVES = 8;
constexpr int NIN = 3920;
constexpr float LN_EPS = 1e-5f, DN_ALPHA = 1.6817928305074290f;
constexpr int RPAD = T * 4 + NEXP * 256;
constexpr int HC_MQ = 0, HC_MK = 256, HC_MV = 512, HC_MO = 768, HC_DQ = 1024, HC_DK = 1536, HC_DV = 2048, HC_SQ = 2560, HC_SK = 2816, HC_SV = 3072, HC_XQ = 3328, HC_XK = 3840, HC_MI = 3904, HC_MF = 3908, HC_XW = 3912;
constexpr size_t MiB = 1u << 20;
constexpr size_t WS_CTL = 0, CTL_ZERO_BYTES = 2 * MiB;
constexpr size_t WS_MOD = 2 * MiB;
constexpr size_t WS_LAM = WS_MOD + 7 * MiB / 4;
constexpr size_t WS_RWT = 4 * MiB;
constexpr size_t WS_CS = 8 * MiB;
constexpr size_t WS_WIN = 16 * MiB;
constexpr size_t WS_WOUT = 48 * MiB;
constexpr size_t WS_W1 = 64 * MiB;
constexpr size_t WS_W2 = 576 * MiB;
constexpr size_t WS_XB = 832 * MiB;
constexpr size_t WS_U = 960 * MiB;
constexpr size_t WS_H = 1024 * MiB;
constexpr size_t WS_QKC = 1280 * MiB;
constexpr size_t WS_XKP = 1312 * MiB;
constexpr size_t WS_MASK = 1316 * MiB;
constexpr size_t WS_TOK = 1324 * MiB;
constexpr size_t WS_MIX = 1344 * MiB;
constexpr size_t WS_Y = 1408 * MiB;
constexpr size_t WS_SC = 1472 * MiB;
constexpr size_t WS_XG = 1728 * MiB;
constexpr size_t WS_HM = 2000 * MiB;
constexpr size_t WS_YM = 2272 * MiB;
constexpr size_t WS_END = 2544 * MiB;
constexpr int CW_CNT = 1024;
constexpr int CW_BAR = 4096;
constexpr int RING_BYTES = 131072, TAB_OFF = RING_BYTES, MISC_OFF = RING_BYTES + 4096, LDS_BYTES = 147456;
constexpr int NPH = 11, NSTEPS = 2 + NPH * DEPTH;
enum { PH_IN = 0, PH_POST, PH_MIXA, PH_SEL, PH_DSA, PH_OUT, PH_ROW1, PH_GATH, PH_G1, PH_G2, PH_ROW2 };

__device__ __forceinline__ float bf2f(bf16 h) { return __uint_as_float((unsigned)h << 16); }
__device__ __forceinline__ float wave_sum(float v) {
#pragma unroll
    for (int o = 1; o < 64; o <<= 1) v += __shfl_xor(v, o);
    return v;
}
__device__ __forceinline__ float wave_max(float v) {
#pragma unroll
    for (int o = 1; o < 64; o <<= 1) v = fmaxf(v, __shfl_xor(v, o));
    return v;
}
__device__ __forceinline__ float sigmoidf_(float x) { return 1.0f / (1.0f + __expf(-x)); }
struct Ctx {
    LAS unsigned char* lds;
    int tid, lane, wave, gw, ngw;
    const float* in[25];
    float* out; unsigned char* ws;
};
#define WSP(type, off) ((type*)(C.ws + (off)))
enum { I_X = 0, I_C, I_POS, I_WIN, I_GATEB, I_CONVW, I_CONVB, I_MNORM, I_DFLAM, I_DFNORM, I_IDXG, I_IDXB, I_WOUT, I_ADAW, I_ADAB, I_LN1G, I_LN1B, I_LN2G, I_LN2B, I_RW, I_RB, I_W1, I_B1, I_W2, I_B2 };

__device__ __forceinline__ int in_dest_col(int n) {
    auto rp = [](int j) { const int hd = j >> 6, d = j & 63; return hd * 64 + ((d < 32) ? 2 * d : 2 * (d - 32) + 1); };
    if (n < 256) return HC_MQ + n;
    if (n < 512) return HC_MK + (n - 256);
    if (n < 768) return HC_MV + (n - 512);
    if (n < 772) return HC_MI + (n - 768);
    if (n < 776) return HC_MF + (n - 772);
    if (n < 1032) return HC_MO + (n - 776);
    if (n < 1544) return HC_DQ + rp(n - 1032);
    if (n < 2056) return HC_DK + rp(n - 1544);
    if (n < 2568) return HC_DV + (n - 2056);
    if (n < 2824) return HC_SQ + rp(n - 2568);
    if (n < 3080) return HC_SK + rp(n - 2824);
    if (n < 3336) return HC_SV + (n - 3080);
    if (n < 3848) return HC_XQ + rp(n - 3336);
    if (n < 3912) return HC_XK + (n - 3848);
    return HC_XW + (n - 3912);
}
template <class F> __device__ __forceinline__ void transpose_item(const float* W, int ldw, int K, int nvalid, int k0, int n0, bf16* WT, LAS float* scr, int lane, F drow) {
    const int nn = n0 + (lane & 31); const bool ok = nn < nvalid;
#pragma unroll 8
    for (int i = 0; i < 32; ++i) { const int kk = 2 * i + (lane >> 5); scr[kk * 33 + (lane & 31)] = ok ? W[(size_t)(k0 + kk) * ldw + nn] : 0.f; }
    LDS_WAIT(); asm volatile("" ::: "memory");
    const int c = lane & 7;
#pragma unroll
    for (int j = 0; j < 4; ++j) { const int n = (lane >> 3) + 8 * j; const LAS float* s = scr + (8 * c) * 33 + n;
        v4u o; o.x = pk2(s[0 * 33], s[1 * 33]); o.y = pk2(s[2 * 33], s[3 * 33]); o.z = pk2(s[4 * 33], s[5 * 33]); o.w = pk2(s[6 * 33], s[7 * 33]);
        if (n0 + n < nvalid) *(GAS v4u*)(WT + (size_t)drow(n0 + n) * K + k0 + 8 * c) = o; }
    LDS_WAIT(); asm volatile("" ::: "memory");
}
struct Args { const float* in[25]; float* out; unsigned char* ws; int s_lo, s_hi, li, pad; };
typedef __attribute__((address_space(4))) const Args CArgs;
__device__ __forceinline__ CArgs* kargs() { CArgs* p = (CArgs*)__builtin_amdgcn_kernarg_segment_ptr(); asm volatile("" : "+s"(p)); return p; }
#define WS(type, off) ((type*)(A->ws + (off)))
#define TIDX CArgs* A = kargs(); int tid_ = threadIdx.x; asm volatile("" : "+v"(tid_)); const int tid = tid_, lane = tid & 63, wave = __builtin_amdgcn_readfirstlane(tid >> 6); const int gw = blockIdx.x * NWAVES + wave, ngw = gridDim.x * NWAVES; (void)lane; (void)gw; (void)ngw

__device__ __forceinline__ void pro_a(LAS unsigned char* lds) {
    TIDX;
    LAS float* scr = (LAS float*)(lds + wave * 16384);
    constexpr int IT_IN = 16 * 123, IT_OUT = 16 * 32, IT_W1 = 16 * 64, IT_W2 = 16 * 32;
    constexpr int N_IN = DEPTH * IT_IN, N_OUT = DEPTH * IT_OUT, N_W1 = DEPTH * NEXP * IT_W1, N_W2 = DEPTH * NEXP * IT_W2;
    constexpr int NITEMS = N_IN + N_OUT + N_W1 + N_W2;
    for (int it = gw; it < NITEMS; it += ngw) {
        int r = it;
        if (r < N_IN) { const int l = r / IT_IN, q = r % IT_IN, kb = q / 123, nb = q % 123;
            transpose_item(A->in[I_WIN] + (size_t)l * D * NIN, NIN, D, NIN, kb * 64, nb * 32, WS(bf16, WS_WIN) + (size_t)l * NHC * D, scr, lane, [](int n) { return in_dest_col(n); }); continue; }
        r -= N_IN;
        if (r < N_OUT) { const int l = r / IT_OUT, q = r % IT_OUT, kb = q / 32, nb = q % 32;
            transpose_item(A->in[I_WOUT] + (size_t)l * D * D, D, D, D, kb * 64, nb * 32, WS(bf16, WS_WOUT) + (size_t)l * D * D, scr, lane, [](int n) { return n; }); continue; }
        r -= N_OUT;
        if (r < N_W1) { const int le = r / IT_W1, q = r % IT_W1, kb = q / 64, nb = q % 64;
            transpose_item(A->in[I_W1] + (size_t)le * D * 2048, 2048, D, 2048, kb * 64, nb * 32, WS(bf16, WS_W1) + (size_t)le * 2048 * D, scr, lane,
                           [](int n) { const int up = n >> 10, j = n & 1023; return (j >> 7) * 256 + up * 128 + (j & 127); }); continue; }
        r -= N_W1;
        { const int le = r / IT_W2, q = r % IT_W2, kb = q / 32, nb = q % 32;
            transpose_item(A->in[I_W2] + (size_t)le * D * D, D, D, D, kb * 64, nb * 32, WS(bf16, WS_W2) + (size_t)le * D * D, scr, lane, [](int n) { return n; }); }
    }
    for (int r = gw; r < DEPTH * (NHC - NIN); r += ngw) { const int l = r / (NHC - NIN), row = NIN + r % (NHC - NIN);
        GAS v4u* p = (GAS v4u*)(WS(bf16, WS_WIN) + ((size_t)l * NHC + row) * D) + lane; p[0] = (v4u){0u, 0u, 0u, 0u}; p[64] = (v4u){0u, 0u, 0u, 0u}; }
    for (int idx = blockIdx.x * 512 + tid; idx < T * 32; idx += gridDim.x * 512) {
        const int tok = idx >> 5, i = idx & 31;
        const double inv = exp(-(double)i * (9.210340371976184 / 32.0));
        const double ang = (double)((const int*)A->in[I_POS])[tok] * inv;
        const double rev = ang * 0.15915494309189535;
        const float fr = (float)(rev - rint(rev));
        float2 v; v.x = __builtin_amdgcn_cosf(fr); v.y = __builtin_amdgcn_sinf(fr);
        WS(float2, WS_CS)[idx] = v;
    }
    for (int idx = blockIdx.x * 512 + tid; idx < DEPTH * NEXP * D; idx += gridDim.x * 512) {
        const int l = idx / (NEXP * D), r = idx % (NEXP * D), e = r / D, d = r % D;
        WS(float, WS_RWT)[idx] = A->in[I_RW][((size_t)l * D + d) * NEXP + e];
    }
    if (blockIdx.x == 0 && wave == 0) {
        for (int l = 0; l < DEPTH; ++l) { const float* lf = A->in[I_DFLAM] + l * 256;
            const float a = wave_sum(lf[lane] * lf[64 + lane]), b = wave_sum(lf[128 + lane] * lf[192 + lane]);
            if (lane == 0) WS(float, WS_LAM)[l] = __expf(a) - __expf(b) + (0.8f - 0.6f * __expf(-0.3f * (float)l)); }
    }
    __syncthreads();
    if (blockIdx.x < (DEPTH * 6144) / 512) {
        LAS float* ca = (LAS float*)lds;
        for (int i = tid; i < NB * D; i += 512) { const float v = A->in[I_C][i]; ca[i] = v / (1.0f + __expf(-v)); }
        __syncthreads();
        const int col = blockIdx.x * 512 + tid, l = col / 6144, m = col % 6144;
        const float* w = A->in[I_ADAW] + (size_t)l * D * 6144 + m;
        float acc[NB];
#pragma unroll
        for (int b = 0; b < NB; ++b) acc[b] = 0.f;
        for (int d = 0; d < D; ++d) { const float wv = w[(size_t)d * 6144];
#pragma unroll
            for (int b = 0; b < NB; ++b) acc[b] += ca[b * D + d] * wv; }
        const float bias = A->in[I_ADAB][col];
#pragma unroll
        for (int b = 0; b < NB; ++b) WS(float, WS_MOD)[((size_t)l * NB + b) * 6144 + m] = acc[b] + bias;
        __syncthreads();
    }
}
__device__ __forceinline__ void pro_b() {
    TIDX;
    for (int tok = gw; tok < T; tok += ngw) {
        const int b = tok / SEQ; const float* mod = WS(float, WS_MOD) + (size_t)b * 6144;
        const GAS f32x4* xr = (const GAS f32x4*)(A->in[I_X] + (size_t)tok * D) + lane;
        GAS unsigned long long* o8 = (GAS unsigned long long*)(WS(bf16, WS_U) + (size_t)tok * D) + lane;
#pragma unroll
        for (int j = 0; j < 4; ++j) { const f32x4 x = xr[64 * j]; const f32x4 sh = *(const f32x4*)(mod + 4 * lane + 256 * j), sc = *(const f32x4*)(mod + 1024 + 4 * lane + 256 * j);
            const f32x4 u = x * (1.0f + sc) + sh; o8[64 * j] = (unsigned long long)pk2(u.x, u.y) | ((unsigned long long)pk2(u.z, u.w) << 32); }
    }
}
__device__ __forceinline__ void ph_post(int l) {
    TIDX;
    const bf16* H = WS(bf16, WS_H); bf16* XKP = WS(bf16, WS_XKP); bf16* QKC = WS(bf16, WS_QKC);
    const float* cw = A->in[I_CONVW] + (size_t)l * 4 * 512; const float* cb = A->in[I_CONVB] + (size_t)l * 512;
    const float gi = A->in[I_IDXG][l * 64 + lane], bi = A->in[I_IDXB][l * 64 + lane];
    for (int tok = gw; tok < T; tok += ngw) {
        const bf16* hrow = H + (size_t)tok * NHC;
        {
            const float v = bf2f(hrow[HC_XK + lane]);
            const float mean = wave_sum(v) * (1.0f / 64.0f); const float dv = v - mean;
            const float var = wave_sum(dv * dv) * (1.0f / 64.0f);
            const float nv = dv * (1.0f / sqrtf(var + LN_EPS)) * gi + bi;
            const float pv = __shfl_xor(nv, 32);
            const int i = lane & 31; const float2 cs = WS(float2, WS_CS)[(size_t)tok * 32 + i];
            const float o = (lane < 32) ? (nv * cs.x - pv * cs.y) : (nv * cs.x + pv * cs.y);
            XKP[(size_t)tok * 64 + 2 * i + (lane >> 5)] = (bf16)f2bf(o);
        }
        {
            const int s = tok % SEQ, c0 = 8 * lane;
            float acc[8];
#pragma unroll
            for (int c = 0; c < 8; ++c) acc[c] = cb[c0 + c];
#pragma unroll
            for (int j = 0; j < 4; ++j) {
                if (s - 3 + j >= 0) {
                    const v4u raw = *(const GAS v4u*)(H + (size_t)(tok - 3 + j) * NHC + c0);
                    const unsigned rw[4] = {raw.x, raw.y, raw.z, raw.w};
#pragma unroll
                    for (int c = 0; c < 8; ++c) { const float x = __uint_as_float((c & 1) ? (rw[c >> 1] & 0xffff0000u) : (rw[c >> 1] << 16)); acc[c] += cw[j * 512 + c0 + c] * x; }
                }
            }
            v4u o;
#define SILU(x) ((x) / (1.0f + __expf(-(x))))
            o.x = pk2(SILU(acc[0]), SILU(acc[1])); o.y = pk2(SILU(acc[2]), SILU(acc[3])); o.z = pk2(SILU(acc[4]), SILU(acc[5])); o.w = pk2(SILU(acc[6]), SILU(acc[7]));
#undef SILU
            *(GAS v4u*)(QKC + (size_t)tok * 512 + c0) = o;
        }
    }
}
typedef float f32x16 __attribute__((ext_vector_type(16)));
__device__ __forceinline__ void ph_idx_scores() {
    TIDX;
    const bf16* H = WS(bf16, WS_H); const bf16* XKP = WS(bf16, WS_XKP); float* SC = WS(float, WS_SC);
    const int r = lane & 31, hh = lane >> 5, ql = r >> 3, hd = r & 7;
    for (int unit = blockIdx.x; unit < NB * (SEQ / 32); unit += gridDim.x) {
        const int b = unit / (SEQ / 32), q0 = (unit % (SEQ / 32)) * 32 + 4 * wave, tok0 = b * SEQ + q0;
        bf16x8 af[4];
        { const bf16* ap = H + (size_t)(tok0 + ql) * NHC + HC_XQ + hd * 64 + 8 * hh;
#pragma unroll
          for (int ks = 0; ks < 4; ++ks) af[ks] = *(const GAS bf16x8*)(ap + ks * 16); }
        float wv[4][4];
#pragma unroll
        for (int q = 0; q < 4; ++q)
#pragma unroll
            for (int i = 0; i < 4; ++i) wv[q][i] = bf2f(H[(size_t)(tok0 + q) * NHC + HC_XW + 4 * hh + i]);
        const int nkt = (q0 + 3) / 32 + 1;
        for (int kt = 0; kt < nkt; ++kt) {
            const int key = kt * 32 + r;
            const bf16* kp = XKP + (size_t)(b * SEQ + key) * 64 + 8 * hh;
            f32x16 acc = {};
#pragma unroll
            for (int ks = 0; ks < 4; ++ks) { const bf16x8 bfr = *(const GAS bf16x8*)(kp + ks * 16); acc = __builtin_amdgcn_mfma_f32_32x32x16_bf16(af[ks], bfr, acc, 0, 0, 0); }
            float tot[4];
#pragma unroll
            for (int q = 0; q < 4; ++q) { float p = 0.f;
#pragma unroll
                for (int i = 0; i < 4; ++i) p += wv[q][i] * fmaxf(acc[4 * q + i], 0.f);
                tot[q] = p + __shfl_xor(p, 32); }
            const float o0 = hh ? tot[2] : tot[0], o1 = hh ? tot[3] : tot[1];
            SC[(size_t)(tok0 + 2 * hh) * SEQ + key] = o0; SC[(size_t)(tok0 + 2 * hh + 1) * SEQ + key] = o1;
        }
    }
}
__device__ __forceinline__ void ph_mlstm(LAS unsigned char* lds, int l) {
    TIDX;
    const bf16* H = WS(bf16, WS_H); const bf16* QKC = WS(bf16, WS_QKC); bf16* MIX = WS(bf16, WS_MIX);
    constexpr int P = 65;
    LAS float* q = (LAS float*)lds; LAS float* k = q + 64 * P; LAS float* v = k + 64 * P; LAS float* Sm = v + 64 * P; LAS float* Cst = Sm + 64 * P;
    LAS float* nst = Cst + 64 * P; LAS float* bcum = nst + 64; LAS float* ii = bcum + 64; LAS float* mt = ii + 64; LAS float* inter = mt + 64; LAS float* den = inter + 64; LAS float* wvv = den + 64; LAS float* sc = wvv + 64;
    for (int unit = blockIdx.x; unit < NB * 4; unit += gridDim.x) {
        const int b = unit >> 2, h = unit & 3;
        const float gbi = A->in[I_GATEB][l * 8 + h], gbf = A->in[I_GATEB][l * 8 + 4 + h];
        for (int i = tid; i < 64 * P; i += 512) Cst[i] = 0.f;
        if (tid < 64) nst[tid] = 0.f;
        if (tid == 0) sc[0] = 0.f;
        __syncthreads();
        for (int ch = 0; ch < SEQ / 64; ++ch) {
            const int tok0 = b * SEQ + ch * 64;
            for (int idx = tid; idx < 4096; idx += 512) { const int rr = idx >> 6, d = idx & 63; const size_t tk = (size_t)(tok0 + rr);
                q[rr * P + d] = bf2f(QKC[tk * 512 + h * 64 + d]) * 0.125f; k[rr * P + d] = bf2f(QKC[tk * 512 + 256 + h * 64 + d]); v[rr * P + d] = bf2f(H[tk * NHC + HC_MV + h * 64 + d]); }
            if (wave == 0) {
                const size_t tk = (size_t)(tok0 + lane);
                const float ip = bf2f(H[tk * NHC + HC_MI + h]) + gbi, fp = bf2f(H[tk * NHC + HC_MF + h]) + gbf;
                float lf = fminf(fp, 0.f) - log1pf(__expf(-fabsf(fp)));
#pragma unroll
                for (int o = 1; o < 64; o <<= 1) { const float t_ = __shfl_up(lf, o); if (lane >= o) lf += t_; }
                ii[lane] = ip; bcum[lane] = lf;
            }
            __syncthreads();
            const float mprev = sc[0];
            if (tid < 64) { const int t = tid; float mx = -INFINITY; const float bt = bcum[t];
                for (int s = 0; s <= t; ++s) mx = fmaxf(mx, bt - bcum[s] + ii[s]);
                const float li = bt + mprev, m_t = fmaxf(li, mx); mt[t] = m_t; inter[t] = __expf(li - m_t); }
            __syncthreads();
            for (int idx = tid; idx < 4096; idx += 512) { const int t = idx >> 6, s = idx & 63; float val = 0.f;
                if (s <= t) { float dot = 0.f;
#pragma unroll 16
                    for (int d = 0; d < 64; ++d) dot += q[t * P + d] * k[s * P + d];
                    val = dot * __expf(bcum[t] - bcum[s] + ii[s] - mt[t]); }
                Sm[t * P + s] = val; }
            __syncthreads();
            if (tid < 64) { const int t = tid; float a = 0.f, qn = 0.f;
                for (int s = 0; s < 64; ++s) a += Sm[t * P + s];
                for (int d = 0; d < 64; ++d) qn += q[t * P + d] * nst[d];
                den[t] = a + inter[t] * qn; }
            float num[8];
#pragma unroll
            for (int j = 0; j < 8; ++j) { const int t = wave + 8 * j, vc = lane; float a = 0.f, qc = 0.f;
                for (int s = 0; s < 64; ++s) a += Sm[t * P + s] * v[s * P + vc];
                for (int d = 0; d < 64; ++d) qc += q[t * P + d] * Cst[d * P + vc];
                num[j] = a + inter[t] * qc; }
            __syncthreads();
#pragma unroll
            for (int j = 0; j < 8; ++j) { const int t = wave + 8 * j, vc = lane; const size_t tk = (size_t)(tok0 + t);
                const float hv = num[j] / fmaxf(fabsf(den[t]), __expf(-mt[t]));
                const float mean = wave_sum(hv) * (1.0f / 64.0f), hc = hv - mean;
                const float rs = 1.0f / sqrtf(wave_sum(hc * hc) * (1.0f / 64.0f) + LN_EPS);
                const float og = sigmoidf_(bf2f(H[tk * NHC + HC_MO + h * 64 + vc]));
                MIX[tk * D + h * 64 + vc] = (bf16)f2bf(og * (hc * rs * A->in[I_MNORM][l * 256 + h * 64 + vc])); }
            if (wave == 0) { const float bl = bcum[63]; const float lw = bl - bcum[lane] + ii[lane];
                const float mnew = fmaxf(bl + mprev, wave_max(lw)); wvv[lane] = __expf(lw - mnew);
                if (lane == 0) { sc[1] = __expf(bl + mprev - mnew); sc[2] = mnew; } }
            __syncthreads();
            { const float decay = sc[1];
#pragma unroll
              for (int j = 0; j < 8; ++j) { const int d = wave + 8 * j, vc = lane; float a = 0.f;
                  for (int s = 0; s < 64; ++s) a += wvv[s] * k[s * P + d] * v[s * P + vc];
                  Cst[d * P + vc] = decay * Cst[d * P + vc] + a; }
              if (tid < 64) { float a = 0.f; for (int s = 0; s < 64; ++s) a += wvv[s] * k[s * P + tid]; nst[tid] = decay * nst[tid] + a; }
              if (tid == 0) sc[0] = sc[2]; }
            __syncthreads();
        }
    }
}
template <int NV> __device__ __forceinline__ void naive_attn_row(const bf16* qp, const bf16* Kb, const bf16* Vb, int tl, const unsigned* maskrow, int lane, float (&o)[NV], float& l_out) {
    float qf[64];
#pragma unroll
    for (int c = 0; c < 8; ++c) { const v4u raw = *(const GAS v4u*)(qp + 8 * c); const unsigned rw[4] = {raw.x, raw.y, raw.z, raw.w};
#pragma unroll
        for (int e = 0; e < 8; ++e) qf[8 * c + e] = __uint_as_float((e & 1) ? (rw[e >> 1] & 0xffff0000u) : (rw[e >> 1] << 16)); }
    float m = -INFINITY, l = 0.f;
#pragma unroll
    for (int n = 0; n < NV; ++n) o[n] = 0.f;
    for (int kb = 0; kb * 64 <= tl; ++kb) {
        const int s = kb * 64 + lane; bool valid = s <= tl;
        if (maskrow) valid = valid && ((maskrow[2 * kb + (lane >> 5)] >> (lane & 31)) & 1u);
        float dot = 0.f;
        const bf16* kr = Kb + (size_t)s * NHC;
#pragma unroll
        for (int c = 0; c < 8; ++c) { const v4u raw = *(const GAS v4u*)(kr + 8 * c); const unsigned rw[4] = {raw.x, raw.y, raw.z, raw.w};
#pragma unroll
            for (int e = 0; e < 8; ++e) dot += qf[8 * c + e] * __uint_as_float((e & 1) ? (rw[e >> 1] & 0xffff0000u) : (rw[e >> 1] << 16)); }
        const float scv = valid ? dot : -INFINITY;
        const float bm = wave_max(scv);
        if (bm == -INFINITY) continue;
        const float mn = fmaxf(m, bm), alpha = __builtin_amdgcn_exp2f(m - mn), p = __builtin_amdgcn_exp2f(scv - mn);
        l = l * alpha + wave_sum(p); m = mn;
#pragma unroll
        for (int n = 0; n < NV; ++n) o[n] *= alpha;
        const int nk = min(64, tl - kb * 64 + 1);
        const bf16* vr = Vb + (size_t)(kb * 64) * NHC + lane;
        for (int j = 0; j < nk; ++j) { const float pj = __shfl(p, j);
#pragma unroll
            for (int n = 0; n < NV; ++n) o[n] += pj * bf2f(vr[(size_t)j * NHC + 64 * n]); }
    }
    l_out = l;
}
__device__ __forceinline__ void ph_diff_naive(int l) {
    TIDX;
    const bf16* H = WS(bf16, WS_H); bf16* MIX = WS(bf16, WS_MIX);
    const float lam = WS(float, WS_LAM)[l], lam_init = 0.8f - 0.6f * __expf(-0.3f * (float)l);
    for (int task = gw; task < T * 4; task += ngw) {
        const int tok = task >> 2, h = task & 3, b = tok / SEQ, tl = tok % SEQ;
        const bf16* Hb = H + (size_t)b * SEQ * NHC;
        float o1[2], o2[2], l1, l2;
        naive_attn_row<2>(H + (size_t)tok * NHC + HC_DQ + (2 * h) * 64, Hb + HC_DK + (2 * h) * 64, Hb + HC_DV + h * 128, tl, nullptr, lane, o1, l1);
        naive_attn_row<2>(H + (size_t)tok * NHC + HC_DQ + (2 * h + 1) * 64, Hb + HC_DK + (2 * h + 1) * 64, Hb + HC_DV + h * 128, tl, nullptr, lane, o2, l2);
        const float i1 = 1.0f / l1, i2 = 1.0f / l2;
        const float d0 = o1[0] * i1 - lam * o2[0] * i2, d1 = o1[1] * i1 - lam * o2[1] * i2;
        const float rs = 1.0f / sqrtf(wave_sum(d0 * d0 + d1 * d1) * (1.0f / 128.0f) + LN_EPS);
        const float* g = A->in[I_DFNORM] + l * 512 + h * 128;
        MIX[(size_t)tok * D + 256 + h * 128 + lane] = (bf16)f2bf(d0 * rs * g[lane] * (1.0f - lam_init));
        MIX[(size_t)tok * D + 256 + h * 128 + 64 + lane] = (bf16)f2bf(d1 * rs * g[64 + lane] * (1.0f - lam_init));
    }
}
__device__ __forceinline__ void ph_dsa_naive() {
    TIDX;
    const bf16* H = WS(bf16, WS_H); bf16* MIX = WS(bf16, WS_MIX); const unsigned* MASK = WS(unsigned, WS_MASK);
    for (int task = gw; task < T * 4; task += ngw) {
        const int tok = task >> 2, h = task & 3, b = tok / SEQ, tl = tok % SEQ;
        const bf16* Hb = H + (size_t)b * SEQ * NHC;
        float o[1], ll;
        naive_attn_row<1>(H + (size_t)tok * NHC + HC_SQ + h * 64, Hb + HC_SK + h * 64, Hb + HC_SV + h * 64, tl, MASK + (size_t)tok * 64, lane, o, ll);
        MIX[(size_t)tok * D + 768 + h * 64 + lane] = (bf16)f2bf(o[0] / ll);
    }
}
constexpr size_t WS_OD = WS_END;
constexpr size_t WS_END2 = WS_END + 64 * MiB;
__device__ __forceinline__ void ph_diff_attn(LAS unsigned char* lds) {
    CArgs* A = kargs();
    const int G = gridDim.x, bx = blockIdx.x, vcu = (G % 8 == 0) ? (bx % 8) * (G / 8) + bx / 8 : bx;
    const bf16* H = WS(bf16, WS_H); bf16* OD = WS(bf16, WS_OD);
    for (int item = vcu; item < NB * 16; item += G) {
        const int b = item >> 4, vh = item & 15, g = vh >> 1, half = vh & 1;
#pragma unroll 1
        for (int qb = 7; qb >= 0; --qb)
            attn_body::attn_unit<8, false>(b, qb, H + HC_DQ + g * 64, H + HC_DK + g * 64, H + HC_DV + (g >> 1) * 128 + half * 64, OD + g * 128 + half * 64, nullptr, (char*)lds);
    }
}
__device__ __forceinline__ void ph_diff_post(int l) {
    TIDX;
    const bf16* OD = WS(bf16, WS_OD); bf16* MIX = WS(bf16, WS_MIX);
    const float lam = WS(float, WS_LAM)[l], lam_init = 0.8f - 0.6f * __expf(-0.3f * (float)l);
    for (int task = gw; task < T * 4; task += ngw) {
        const int tok = task >> 2, h = task & 3;
        const bf16* o1 = OD + (size_t)tok * D + (2 * h) * 128, *o2 = o1 + 128;
        const float d0 = bf2f(o1[lane]) - lam * bf2f(o2[lane]), d1 = bf2f(o1[64 + lane]) - lam * bf2f(o2[64 + lane]);
        const float rs = 1.0f / sqrtf(wave_sum(d0 * d0 + d1 * d1) * (1.0f / 128.0f) + LN_EPS);
        const float* g = A->in[I_DFNORM] + l * 512 + h * 128;
        MIX[(size_t)tok * D + 256 + h * 128 + lane] = (bf16)f2bf(d0 * rs * g[lane] * (1.0f - lam_init));
        MIX[(size_t)tok * D + 256 + h * 128 + 64 + lane] = (bf16)f2bf(d1 * rs * g[64 + lane] * (1.0f - lam_init));
    }
}
__device__ __forceinline__ void ph_dsa_attn(LAS unsigned char* lds) {
    CArgs* A = kargs();
    const int G = gridDim.x, bx = blockIdx.x, vcu = (G % 8 == 0) ? (bx % 8) * (G / 8) + bx / 8 : bx;
    const bf16* H = WS(bf16, WS_H); bf16* MIX = WS(bf16, WS_MIX); const unsigned* MASK = WS(unsigned, WS_MASK);
    for (int item = vcu; item < NB * 4 * 4; item += G) {
        const int bh = item >> 2, p = item & 3, b = bh >> 2, h = bh & 3;
        attn_body::attn_unit<8, true>(b, 7 - p, H + HC_SQ + h * 64, H + HC_SK + h * 64, H + HC_SV + h * 64, MIX + 768 + h * 64, MASK, (char*)lds);
        attn_body::attn_unit<8, true>(b, p, H + HC_SQ + h * 64, H + HC_SK + h * 64, H + HC_SV + h * 64, MIX + 768 + h * 64, MASK, (char*)lds);
    }
}
__device__ __forceinline__ void ph_select(LAS unsigned char* lds) {
    TIDX;
    const float* SC = WS(float, WS_SC); unsigned* MASK = WS(unsigned, WS_MASK);
    LAS unsigned* hist = (LAS unsigned*)lds + wave * 256;
    const unsigned long long lt_mask = (1ull << lane) - 1ull;
    for (int tok = gw; tok < T; tok += ngw) {
        const int tl = tok % SEQ;
        if (tl < 256) {
            const int lo = 32 * lane; unsigned w;
            if (lo + 31 <= tl) w = 0xffffffffu; else if (lo > tl) w = 0u; else w = (2u << (tl - lo)) - 1u;
            MASK[(size_t)tok * 64 + lane] = w; continue;
        }
        unsigned key[32]; unsigned vbits = 0u;
#pragma unroll
        for (int i = 0; i < 32; ++i) { const int s = 64 * i + lane; const bool valid = s <= tl;
            const unsigned u = valid ? __float_as_uint(SC[(size_t)tok * SEQ + s]) : 0u;
            key[i] = valid ? ((u >> 31) ? ~u : (u | 0x80000000u)) : 0u; vbits |= valid ? (1u << i) : 0u; }
        unsigned prefix = 0u; int need = 256;
#pragma unroll
        for (int pass = 0; pass < 4; ++pass) {
            const int shift = 24 - 8 * pass;
            hist[4 * lane + 0] = 0u; hist[4 * lane + 1] = 0u; hist[4 * lane + 2] = 0u; hist[4 * lane + 3] = 0u;
            LDS_WAIT(); asm volatile("" ::: "memory");
#pragma unroll
            for (int i = 0; i < 32; ++i) { const bool in = ((vbits >> i) & 1u) && (pass == 0 || (key[i] >> (shift + 8)) == prefix);
                if (in) (void)__hip_atomic_fetch_add(&hist[(key[i] >> shift) & 255u], 1u, __ATOMIC_RELAXED, __HIP_MEMORY_SCOPE_WORKGROUP); }
            LDS_WAIT(); asm volatile("" ::: "memory");
            const unsigned c0 = hist[4 * lane], c1 = hist[4 * lane + 1], c2 = hist[4 * lane + 2], c3 = hist[4 * lane + 3];
            LDS_WAIT(); asm volatile("" ::: "memory");
            const int tot = (int)(c0 + c1 + c2 + c3);
            int incl = tot;
#pragma unroll
            for (int o = 1; o < 64; o <<= 1) { const int t_ = __shfl_down(incl, o); if (lane + o < 64) incl += t_; }
            int cum = incl - tot;
            int fv = -1, fneed = 0;
            { const int cc[4] = {(int)c0, (int)c1, (int)c2, (int)c3};
#pragma unroll
              for (int j = 3; j >= 0; --j) { if (fv < 0 && cum < need && cum + cc[j] >= need) { fv = 4 * lane + j; fneed = need - cum; } cum += cc[j]; } }
            const unsigned long long fm = __ballot(fv >= 0);
            const int src = fm ? (int)__builtin_ctzll(fm) : 0;
            const int v = __shfl(fv, src); need = __shfl(fneed, src);
            prefix = (prefix << 8) | (unsigned)(v & 255);
        }
        unsigned myw = 0u; int cbefore = 0;
#pragma unroll
        for (int i = 0; i < 32; ++i) {
            const bool vld = (vbits >> i) & 1u; const bool eq = vld && key[i] == prefix, gt = vld && key[i] > prefix;
            const unsigned long long em = __ballot(eq);
            const int rank = cbefore + __popcll(em & lt_mask);
            const bool sel = gt || (eq && rank < need);
            cbefore += __popcll(em);
            const unsigned long long bm = __ballot(sel);
            if (lane == 2 * i) myw = (unsigned)bm;
            if (lane == 2 * i + 1) myw = (unsigned)(bm >> 32);
        }
        MASK[(size_t)tok * 64 + lane] = myw;
    }
}
__device__ __forceinline__ void ph_row1(int l) {
    TIDX;
    const float* xin = (l == 0) ? A->in[I_X] : WS(float, WS_XB); float* XB = WS(float, WS_XB);
    const bf16* Y = WS(bf16, WS_Y); bf16* U = WS(bf16, WS_U);
    const float* RWT = WS(float, WS_RWT) + (size_t)l * NEXP * D;
    unsigned* cnt = WS(unsigned, WS_CTL) + CW_CNT + l * NEXP; unsigned* TOK = WS(unsigned, WS_TOK);
    const float* lg = A->in[I_LN1G] + l * D; const float* lb = A->in[I_LN1B] + l * D;
    const float* rbp = A->in[I_RB] + l * NEXP;
    for (int tok = gw; tok < T; tok += ngw) {
        const int b = tok / SEQ; const float* mod = WS(float, WS_MOD) + ((size_t)l * NB + b) * 6144;
        f32x4 v[4]; float s = 0.f;
#pragma unroll
        for (int j = 0; j < 4; ++j) { const int c = 4 * lane + 256 * j;
            const f32x4 x = *(const GAS f32x4*)(xin + (size_t)tok * D + c); const f32x4 g1 = *(const f32x4*)(mod + 2048 + c);
            const unsigned long long yr = *(const GAS unsigned long long*)(Y + (size_t)tok * D + c);
            f32x4 y; y.x = __uint_as_float((unsigned)yr << 16); y.y = __uint_as_float((unsigned)yr & 0xffff0000u); y.z = __uint_as_float((unsigned)(yr >> 32) << 16); y.w = __uint_as_float((unsigned)(yr >> 32) & 0xffff0000u);
            v[j] = x * DN_ALPHA + (1.0f + g1) * y; s += (v[j].x + v[j].y) + (v[j].z + v[j].w); }
        const float mean = wave_sum(s) * (1.0f / D); float s2 = 0.f;
#pragma unroll
        for (int j = 0; j < 4; ++j) { v[j] = v[j] - mean; s2 += (v[j].x * v[j].x + v[j].y * v[j].y) + (v[j].z * v[j].z + v[j].w * v[j].w); }
        const float rstd = 1.0f / sqrtf(wave_sum(s2) * (1.0f / D) + LN_EPS);
        f32x4 u2[4];
#pragma unroll
        for (int j = 0; j < 4; ++j) { const int c = 4 * lane + 256 * j;
            const f32x4 xn = v[j] * rstd * *(const f32x4*)(lg + c) + *(const f32x4*)(lb + c);
            *(GAS f32x4*)(XB + (size_t)tok * D + c) = xn;
            u2[j] = xn * (1.0f + *(const f32x4*)(mod + 4096 + c)) + *(const f32x4*)(mod + 3072 + c);
            *(GAS unsigned long long*)(U + (size_t)tok * D + c) = (unsigned long long)pk2(u2[j].x, u2[j].y) | ((unsigned long long)pk2(u2[j].z, u2[j].w) << 32); }
        float tv[4] = {-INFINITY, -INFINITY, -INFINITY, -INFINITY}; int te[4] = {0, 0, 0, 0};
#pragma unroll 1
        for (int e = 0; e < NEXP; ++e) {
            const float* w = RWT + (size_t)e * D + 4 * lane; float a = 0.f;
#pragma unroll
            for (int j = 0; j < 4; ++j) { const f32x4 w4 = *(const f32x4*)(w + 256 * j); a += (u2[j].x * w4.x + u2[j].y * w4.y) + (u2[j].z * w4.z + u2[j].w * w4.w); }
            a = wave_sum(a) + rbp[e];
            if (a > tv[0]) { tv[3] = tv[2]; te[3] = te[2]; tv[2] = tv[1]; te[2] = te[1]; tv[1] = tv[0]; te[1] = te[0]; tv[0] = a; te[0] = e; }
            else if (a > tv[1]) { tv[3] = tv[2]; te[3] = te[2]; tv[2] = tv[1]; te[2] = te[1]; tv[1] = a; te[1] = e; }
            else if (a > tv[2]) { tv[3] = tv[2]; te[3] = te[2]; tv[2] = a; te[2] = e; }
            else if (a > tv[3]) { tv[3] = a; te[3] = e; }
        }
        const float e1 = __expf(tv[1] - tv[0]), e2 = __expf(tv[2] - tv[0]), e3 = __expf(tv[3] - tv[0]); const float inv = 1.0f / (1.0f + e1 + e2 + e3);
        if (lane < 4) { const int ek = lane == 0 ? te[0] : lane == 1 ? te[1] : lane == 2 ? te[2] : te[3]; const float pk = (lane == 0 ? 1.0f : lane == 1 ? e1 : lane == 2 ? e2 : e3) * inv;
            const unsigned pos = __hip_atomic_fetch_add(cnt + ek, 1u, __ATOMIC_RELAXED, __HIP_MEMORY_SCOPE_AGENT);
            *(GAS v4u*)(TOK + ((size_t)tok * 4 + lane) * 4) = (v4u){(unsigned)ek, pos, __float_as_uint(pk), 0u}; }
    }
}
__device__ __forceinline__ int moe_tables(LAS unsigned char* lds, int l) {
    CArgs* A = kargs();
    LAS unsigned* base = (LAS unsigned*)(lds + TAB_OFF); LAS unsigned char* tile_e = lds + TAB_OFF + 256;
    const unsigned* cnt = WS(unsigned, WS_CTL) + CW_CNT + l * NEXP;
    if (threadIdx.x == 0) { unsigned acc = 0u;
#pragma unroll 1
        for (int e = 0; e < NEXP; ++e) { const unsigned c = __hip_atomic_load(cnt + e, __ATOMIC_RELAXED, __HIP_MEMORY_SCOPE_AGENT); const unsigned nt = (c + 255u) >> 8; base[e] = acc;
#pragma unroll 1
            for (unsigned t = 0; t < nt; ++t) tile_e[(acc >> 8) + t] = (unsigned char)e; acc += nt << 8; }
        base[NEXP] = acc; }
    __syncthreads();
    return (int)(base[NEXP] >> 8);
}
__device__ __forceinline__ void ph_gather(LAS unsigned char* lds, int l) {
    TIDX;
    (void)moe_tables(lds, l);
    const LAS unsigned* base = (const LAS unsigned*)(lds + TAB_OFF);
    const unsigned* TOK = WS(unsigned, WS_TOK); const bf16* U = WS(bf16, WS_U); bf16* XG = WS(bf16, WS_XG);
    for (int task = gw; task < T * 4; task += ngw) {
        const v4u ti = *(const GAS v4u*)(TOK + (size_t)task * 4); const size_t row = (size_t)base[ti.x] + ti.y;
        const GAS v4u* src = (const GAS v4u*)(U + (size_t)(task >> 2) * D) + lane; GAS v4u* dst = (GAS v4u*)(XG + row * D) + lane;
        dst[0] = src[0]; dst[64] = src[64];
    }
    __syncthreads();
}
__device__ __forceinline__ void ph_row2(LAS unsigned char* lds, int l) {
    TIDX;
    (void)moe_tables(lds, l);
    const LAS unsigned* base = (const LAS unsigned*)(lds + TAB_OFF);
    float* XB = WS(float, WS_XB); const bf16* YM = WS(bf16, WS_YM); bf16* U = WS(bf16, WS_U); const unsigned* TOK = WS(unsigned, WS_TOK);
    const float* lg = A->in[I_LN2G] + l * D; const float* lb = A->in[I_LN2B] + l * D; const float* b2 = A->in[I_B2] + (size_t)l * NEXP * D;
    float* dst = (l == DEPTH - 1) ? A->out : XB;
    for (int tok = gw; tok < T; tok += ngw) {
        const int b = tok / SEQ; const float* mod = WS(float, WS_MOD) + ((size_t)l * NB + b) * 6144;
        f32x4 acc[4];
#pragma unroll
        for (int j = 0; j < 4; ++j) acc[j] = (f32x4){0.f, 0.f, 0.f, 0.f};
#pragma unroll
        for (int k = 0; k < 4; ++k) { const v4u ti = *(const GAS v4u*)(TOK + ((size_t)tok * 4 + k) * 4); const size_t row = (size_t)base[ti.x] + ti.y; const float p = __uint_as_float(ti.z);
#pragma unroll
            for (int j = 0; j < 4; ++j) { const int c = 4 * lane + 256 * j; const unsigned long long yr = *(const GAS unsigned long long*)(YM + row * D + c);
                f32x4 y; y.x = __uint_as_float((unsigned)yr << 16); y.y = __uint_as_float((unsigned)yr & 0xffff0000u); y.z = __uint_as_float((unsigned)(yr >> 32) << 16); y.w = __uint_as_float((unsigned)(yr >> 32) & 0xffff0000u);
                acc[j] = acc[j] + p * (y + *(const f32x4*)(b2 + (size_t)ti.x * D + c)); } }
        f32x4 v[4]; float s = 0.f;
#pragma unroll
        for (int j = 0; j < 4; ++j) { const int c = 4 * lane + 256 * j; const f32x4 x = *(const GAS f32x4*)(XB + (size_t)tok * D + c);
            v[j] = x * DN_ALPHA + (1.0f + *(const f32x4*)(mod + 5120 + c)) * acc[j]; s += (v[j].x + v[j].y) + (v[j].z + v[j].w); }
        const float mean = wave_sum(s) * (1.0f / D); float s2 = 0.f;
#pragma unroll
        for (int j = 0; j < 4; ++j) { v[j] = v[j] - mean; s2 += (v[j].x * v[j].x + v[j].y * v[j].y) + (v[j].z * v[j].z + v[j].w * v[j].w); }
        const float rstd = 1.0f / sqrtf(wave_sum(s2) * (1.0f / D) + LN_EPS);
        const float* modn = WS(float, WS_MOD) + ((size_t)(l + 1 < DEPTH ? l + 1 : l) * NB + b) * 6144;
#pragma unroll
        for (int j = 0; j < 4; ++j) { const int c = 4 * lane + 256 * j;
            const f32x4 xn = v[j] * rstd * *(const f32x4*)(lg + c) + *(const f32x4*)(lb + c);
            *(GAS f32x4*)(dst + (size_t)tok * D + c) = xn;
            if (l + 1 < DEPTH) { const f32x4 u = xn * (1.0f + *(const f32x4*)(modn + 1024 + c)) + *(const f32x4*)(modn + c);
                *(GAS unsigned long long*)(U + (size_t)tok * D + c) = (unsigned long long)pk2(u.x, u.y) | ((unsigned long long)pk2(u.z, u.w) << 32); } }
    }
    __syncthreads();
}
__global__ void __launch_bounds__(NWAVES * 64, 2) mega_fwd(Args A_) {
    extern __shared__ __attribute__((aligned(16))) unsigned char lds_raw[];
    LAS unsigned char* lds = (LAS unsigned char*)lds_raw;
    const int tid = threadIdx.x;
    volatile LAS unsigned* MISC = (volatile LAS unsigned*)(lds + MISC_OFF);
    for (int u = tid; u < (LDS_BYTES - TAB_OFF) / 4; u += NWAVES * 64) ((LAS unsigned*)(lds + TAB_OFF))[u] = 0u;
    __syncthreads();
    CArgs* A = kargs(); const bool multi = (A->s_hi - A->s_lo) > 1;
    XcdBarrier bar; bar.bar = WS(unsigned, WS_CTL) + CW_BAR + A->li * XCD_BAR_WORDS; bar.x = 0; bar.st = MISC + 8;
    if (multi) bar = xcd_barrier_post(WS(unsigned, WS_CTL) + CW_BAR + A->li * XCD_BAR_WORDS, MISC + 8);
    const int lo = A->s_lo, hi = A->s_hi;
#ifndef PHMASK
#define PHMASK 0xffffffffu
#endif
#define PHM(b) (((PHMASK) >> (b)) & 1u)
#define RUN(s) (lo <= (s) && (s) < hi)
#define SEAM(s) do { if ((s) + 1 < hi) xcd_barrier(bar); } while (0)
    if (RUN(0)) { if (PHM(0)) pro_a(lds); SEAM(0); }
    if (RUN(1)) { if (PHM(1)) pro_b(); SEAM(1); }
    for (int l = 0; l < DEPTH; ++l) {
        const int sb = 2 + NPH * l;
        if (RUN(sb + PH_IN)) { CArgs* A = kargs();
            pg8::Gemm g{WS(bf16, WS_U), WS(bf16, WS_WIN) + (size_t)l * NHC * D, T, NHC, D}; pg8::StaticOrder S; S.init(T, NHC, (int)gridDim.x, (int)blockIdx.x);
            pg8::EpiIn E{WS(bf16, WS_H), WS(float, WS_CS)};
            if (PHM(2)) pg8::gemm_phase<pg8::EpiIn, pg8::StaticOrder, true, true>(lds, g, S, E);
            SEAM(sb + PH_IN);
        }
        if (RUN(sb + PH_POST)) { if (PHM(3)) ph_post(l); SEAM(sb + PH_POST); }
        if (RUN(sb + PH_MIXA)) { if (PHM(4)) ph_idx_scores(); if (PHM(5)) ph_mlstm(lds, l); if (PHM(6)) ph_diff_attn(lds); SEAM(sb + PH_MIXA); }
        if (RUN(sb + PH_SEL)) { if (PHM(7)) ph_select(lds); SEAM(sb + PH_SEL); }
        if (RUN(sb + PH_DSA)) { if (PHM(8)) { ph_diff_post(l); ph_dsa_attn(lds); } SEAM(sb + PH_DSA); }
        if (RUN(sb + PH_OUT)) { CArgs* A = kargs();
            pg8::Gemm g{WS(bf16, WS_MIX), WS(bf16, WS_WOUT) + (size_t)l * D * D, T, D, D}; pg8::StaticOrder S; S.init(T, D, (int)gridDim.x, (int)blockIdx.x);
            pg8::EpiBf16<0> E{WS(bf16, WS_Y), D, nullptr, 0, 0, 1.f};
            if (PHM(9)) pg8::gemm_phase<pg8::EpiBf16<0>, pg8::StaticOrder, true, true>(lds, g, S, E);
            SEAM(sb + PH_OUT);
        }
        if (RUN(sb + PH_ROW1)) { if (PHM(10)) ph_row1(l); SEAM(sb + PH_ROW1); }
        if (RUN(sb + PH_GATH)) { if (PHM(11)) ph_gather(lds, l); SEAM(sb + PH_GATH); }
        if (RUN(sb + PH_G1)) { CArgs* A = kargs();
            const int nrt = moe_tables(lds, l);
            pg8::Gemm g{WS(bf16, WS_XG), WS(bf16, WS_W1) + (size_t)l * NEXP * 2048 * D, RPAD, NEXP * 2048, D}; pg8::MoeOrder S; S.init(nrt, 8, (int)gridDim.x, (int)blockIdx.x, (const LAS unsigned char*)(lds + TAB_OFF + 256));
            pg8::EpiSwiGLU E{WS(bf16, WS_HM), A->in[I_B1] + (size_t)l * NEXP * 2048};
            if (PHM(12)) pg8::gemm_phase<pg8::EpiSwiGLU, pg8::MoeOrder, true, true>(lds, g, S, E);
            SEAM(sb + PH_G1);
        }
        if (RUN(sb + PH_G2)) { CArgs* A = kargs();
            const int nrt = moe_tables(lds, l);
            pg8::Gemm g{WS(bf16, WS_HM), WS(bf16, WS_W2) + (size_t)l * NEXP * D * D, RPAD, NEXP * D, D}; pg8::MoeOrder S; S.init(nrt, 4, (int)gridDim.x, (int)blockIdx.x, (const LAS unsigned char*)(lds + TAB_OFF + 256));
            pg8::EpiBf16<0> E{WS(bf16, WS_YM), D, nullptr, D, 0, 1.f};
            if (PHM(13)) pg8::gemm_phase<pg8::EpiBf16<0>, pg8::MoeOrder, true, true>(lds, g, S, E);
            SEAM(sb + PH_G2);
        }
        if (RUN(sb + PH_ROW2)) { if (PHM(14)) ph_row2(lds, l); SEAM(sb + PH_ROW2); }
    }
#undef RUN
#undef SEAM
}

#ifndef MK_STEPS_PER_LAUNCH
#define MK_STEPS_PER_LAUNCH 1000
#endif
extern "C" void kernel_launch(void* const* d_in, const int* in_sizes, int n_in, void* d_out, int out_size, void* d_ws, size_t ws_size, hipStream_t stream) {
    static int grid = 0;
    if (grid == 0) {
        if (n_in != 25 || out_size != T * D || ws_size < WS_END2) { fprintf(stderr, "kernel_launch: unexpected shapes (n_in %d out %d ws %zu)\n", n_in, out_size, ws_size); grid = -1; return; }
        int dev = 0, cus = 0, per_cu = 0;
        if (hipGetDevice(&dev) != hipSuccess || hipDeviceGetAttribute(&cus, hipDeviceAttributeMultiprocessorCount, dev) != hipSuccess) { grid = -1; return; }
        if (hipFuncSetAttribute((const void*)mega_fwd, hipFuncAttributeMaxDynamicSharedMemorySize, LDS_BYTES) != hipSuccess) { fprintf(stderr, "kernel_launch: hipFuncSetAttribute failed\n"); grid = -1; return; }
        if (hipOccupancyMaxActiveBlocksPerMultiprocessor(&per_cu, (const void*)mega_fwd, NWAVES * 64, LDS_BYTES) != hipSuccess || per_cu < 1) { fprintf(stderr, "kernel_launch: occupancy query says %d\n", per_cu); }
        (void)hipGetLastError();
        grid = cus;
    }
    if (grid < 0) return;
    if (hipMemsetAsync((char*)d_ws + WS_CTL, 0, CTL_ZERO_BYTES, stream) != hipSuccess) return;
    Args a{};
    for (int i = 0; i < 25; ++i) a.in[i] = (const float*)d_in[i];
    a.out = (float*)d_out; a.ws = (unsigned char*)d_ws;
    int li = 0;
    for (int s = 0; s < NSTEPS; s += MK_STEPS_PER_LAUNCH, ++li) {
        a.s_lo = s; a.s_hi = (s + MK_STEPS_PER_LAUNCH < NSTEPS) ? s + MK_STEPS_PER_LAUNCH : NSTEPS; a.li = li; a.pad = 0;
        hipLaunchKernelGGL(mega_fwd, dim3(grid), dim3(NWAVES * 64), LDS_BYTES, stream, a);
    }
}
```

```cpp
#include <hip/hip_runtime.h>
#include <cstdio>
#include <cstdint>

namespace pg8 {
#define PG8_LAS __attribute__((address_space(3)))
typedef unsigned short bf16_t;
typedef short bf16x8 __attribute__((ext_vector_type(8)));
typedef float f32x4 __attribute__((ext_vector_type(4)));
typedef unsigned u32x4 __attribute__((ext_vector_type(4)));
constexpr int BM = 256, BK = 64, HALF = 128, HTB = HALF * BK * 2  , STAGE_BYTES = 8 * HTB, NXCD = 8, WGM = 8;

__host__ __device__ __forceinline__ int lds_byte(int r, int c) { const int st = (r >> 4) * 2 + (c >> 5), rr = r & 15, cc = c & 31, ob = rr * 64 + cc * 2; return st * 1024 + (ob ^ (((ob >> 9) & 1) << 5)); }
__host__ __device__ __forceinline__ void stage_rc(int b, int& R, int& C) { const int st = b / 1024, sb = b % 1024, swz = sb ^ (((sb >> 9) & 1) << 5); R = (st >> 1) * 16 + swz / 64; C = (st & 1) * 32 + (swz % 64) / 2; }
__host__ __device__ __forceinline__ int perm32(int rho) { const int n = rho >> 4, i = rho & 15; return 8 * (i >> 2) + 4 * n + (i & 3); }

struct Unit { int pm, pn; };
struct Gemm { const bf16_t* A; const bf16_t* Bt; int M, N, K; };

struct StaticOrder {
    int nM, nN, nwg, G, c;
    __host__ __device__ void init(int M, int N, int G_, int c_) { nM = M / BM; nN = N / BM; nwg = nM * nN; G = G_; c = c_; }
    __host__ __device__ bool next(int i, Unit& u) const {
        const long L = (long)i * G + c; if (L >= nwg) return false;
        int wgid = (int)L; { const int q = nwg / NXCD, r = nwg % NXCD, xcd = wgid % NXCD, off = wgid / NXCD; wgid = (xcd < r ? xcd * (q + 1) : r * (q + 1) + (xcd - r) * q) + off; }
        const int nig = WGM * nN, gid = wgid / nig, fm = gid * WGM, gsz = (nM - fm) < WGM ? (nM - fm) : WGM;
        u.pm = fm + ((wgid % nig) % gsz); u.pn = (wgid % nig) / gsz; return true;
    }
    __device__ __forceinline__ void a_ready(const Unit&) const {}
    __device__ __forceinline__ void done(const Unit&) const {}
};
struct MoeOrder {
    int nM, nN, nwg, G, c; const PG8_LAS unsigned char* tile_e;
    __device__ void init(int nRT, int NTN, int G_, int c_, const PG8_LAS unsigned char* te) { nM = nRT; nN = NTN; nwg = nM * nN; G = G_; c = c_; tile_e = te; }
    __device__ bool next(int i, Unit& u) const {
        const long L = (long)i * G + c; if (L >= nwg) return false;
        int wgid = (int)L; { const int q = nwg / NXCD, r = nwg % NXCD, xcd = wgid % NXCD, off = wgid / NXCD; wgid = (xcd < r ? xcd * (q + 1) : r * (q + 1) + (xcd - r) * q) + off; }
        const int nig = WGM * nN, gid = wgid / nig, fm = gid * WGM, gsz = (nM - fm) < WGM ? (nM - fm) : WGM;
        u.pm = fm + ((wgid % nig) % gsz); const int pl = (wgid % nig) / gsz; u.pn = (int)tile_e[u.pm] * nN + pl; return true;
    }
    __device__ __forceinline__ void a_ready(const Unit&) const {}
    __device__ __forceinline__ void done(const Unit&) const {}
};
__device__ __forceinline__ unsigned cvt_pk_bf16(float lo, float hi) { unsigned r; asm volatile("v_cvt_pk_bf16_f32 %0, %1, %2" : "=v"(r) : "v"(lo), "v"(hi)); return r; }
typedef float f32x2 __attribute__((ext_vector_type(2)));
__device__ __forceinline__ f32x2 gelu_pk(f32x2 v) {
    const f32x2 av = __builtin_elementwise_abs(v), d = av * 0.2316418882f + 1.0f;
    f32x2 t; t.x = __builtin_amdgcn_rcpf(d.x); t.y = __builtin_amdgcn_rcpf(d.y);
    f32x2 q = t * 0.5307027145f + (-0.7265760135f); q = q * t + 0.7107068705f; q = q * t + (-0.142248368f); q = q * t + 0.127414796f; q = q * t;
    const f32x2 s = (v * v) * (-0.72134752044f);
    f32x2 e; e.x = __builtin_amdgcn_exp2f(s.x); e.y = __builtin_amdgcn_exp2f(s.y);
    const f32x2 m = v * (q * e), r = v - m;
    f32x2 o; o.x = v.x < 0.f ? m.x : r.x; o.y = v.y < 0.f ? m.y : r.y; return o;
}

template <int ACT  > struct EpiBf16 {
    static constexpr bool PERM = true, AFTER_DRAIN = false; static_assert(ACT == 0 || ACT == 1, "EpiBf16: ACT is 0 (none) or 1 (gelu_pk)");
    bf16_t* O; int ldc; const float* bias; int split_cols; size_t split_stride; float scale0;
    __device__ __forceinline__ void operator()(const f32x4 (&acc)[2][2][4][2], const Unit& u, int wr, int wc, int fr, int fq) const {
        const int row0 = u.pm * BM + wr * 64 + fr; int colt = u.pn * BM; bf16_t* base = O;
        float sc = 1.f; if (split_cols) { const int t = colt / split_cols; base += (size_t)t * split_stride; colt -= t * split_cols; if (t == 0) sc = scale0; }
        const int col0 = colt + wc * 32 + 8 * fq, bcol0 = u.pn * BM + wc * 32 + 8 * fq;
        f32x4 bv[2][2];
#pragma unroll
        for (int bj = 0; bj < 2; ++bj)
#pragma unroll
            for (int n = 0; n < 2; ++n) bv[bj][n] = bias ? *(const f32x4*)(bias + bcol0 + bj * HALF + 4 * n) : (f32x4){0.f, 0.f, 0.f, 0.f};
#pragma unroll
        for (int ai = 0; ai < 2; ++ai)
#pragma unroll
            for (int m = 0; m < 4; ++m) { bf16_t* rowp = base + (size_t)(row0 + ai * HALF + m * 16) * ldc + col0;
#pragma unroll
                for (int bj = 0; bj < 2; ++bj) { f32x4 v0 = acc[ai][bj][m][0] + bv[bj][0], v1 = acc[ai][bj][m][1] + bv[bj][1];
                    if (ACT == 1) { f32x2 a = gelu_pk((f32x2){v0[0], v0[1]}), b = gelu_pk((f32x2){v0[2], v0[3]}), c = gelu_pk((f32x2){v1[0], v1[1]}), d = gelu_pk((f32x2){v1[2], v1[3]});
                        v0 = (f32x4){a.x, a.y, b.x, b.y}; v1 = (f32x4){c.x, c.y, d.x, d.y}; }
                    v0 = v0 * sc; v1 = v1 * sc; u32x4 w; w.x = cvt_pk_bf16(v0[0], v0[1]); w.y = cvt_pk_bf16(v0[2], v0[3]); w.z = cvt_pk_bf16(v1[0], v1[1]); w.w = cvt_pk_bf16(v1[2], v1[3]);
                    *(u32x4*)(rowp + bj * HALF) = w; } }
    }
};
constexpr float C2 = 0.125f * 1.4426950408889634f;
struct EpiIn {
    static constexpr bool PERM = true, AFTER_DRAIN = false;
    bf16_t* O; const float* cs;
    __device__ __forceinline__ void operator()(const f32x4 (&acc)[2][2][4][2], const Unit& u, int wr, int wc, int fr, int fq) const {
        const int pn = u.pn;
        const bool rope = (0x6CF0 >> pn) & 1;
        const float sc = ((0x0430 >> pn) & 1) ? C2 : 1.f;
        const int row0 = u.pm * BM + wr * 64 + fr, col0 = pn * BM + wc * 32 + 8 * fq, i0 = (wc & 1) * 16 + 4 * fq;
#pragma unroll
        for (int ai = 0; ai < 2; ++ai)
#pragma unroll
            for (int m = 0; m < 4; ++m) {
                const int row = row0 + ai * HALF + m * 16;
                f32x4 c01 = (f32x4){1.f, 0.f, 1.f, 0.f}, c23 = c01;
                if (rope) { c01 = *(const f32x4*)(cs + (size_t)row * 64 + i0 * 2); c23 = *(const f32x4*)(cs + (size_t)row * 64 + i0 * 2 + 4); }
                bf16_t* rowp = O + (size_t)row * 4096 + col0;
#pragma unroll
                for (int bj = 0; bj < 2; ++bj) {
                    f32x4 v0 = acc[ai][bj][m][0], v1 = acc[ai][bj][m][1];
                    if (rope) {
                        f32x4 r0, r1;
                        r0[0] = v0[0] * c01[0] - v0[1] * c01[1]; r0[1] = v0[1] * c01[0] + v0[0] * c01[1];
                        r0[2] = v0[2] * c01[2] - v0[3] * c01[3]; r0[3] = v0[3] * c01[2] + v0[2] * c01[3];
                        r1[0] = v1[0] * c23[0] - v1[1] * c23[1]; r1[1] = v1[1] * c23[0] + v1[0] * c23[1];
                        r1[2] = v1[2] * c23[2] - v1[3] * c23[3]; r1[3] = v1[3] * c23[2] + v1[2] * c23[3];
                        v0 = r0; v1 = r1;
                    }
                    v0 = v0 * sc; v1 = v1 * sc;
                    u32x4 w; w.x = cvt_pk_bf16(v0[0], v0[1]); w.y = cvt_pk_bf16(v0[2], v0[3]); w.z = cvt_pk_bf16(v1[0], v1[1]); w.w = cvt_pk_bf16(v1[2], v1[3]);
                    *(u32x4*)(rowp + bj * HALF) = w;
                }
            }
    }
};
struct EpiSwiGLU {
    static constexpr bool PERM = true, AFTER_DRAIN = false;
    bf16_t* O; const float* b1;
    __device__ __forceinline__ void operator()(const f32x4 (&acc)[2][2][4][2], const Unit& u, int wr, int wc, int fr, int fq) const {
        const int e = u.pn >> 3, pl = u.pn & 7, colh = pl * 128 + wc * 32 + 8 * fq;
        const float* bp = b1 + (size_t)e * 2048 + colh;
        f32x4 bg[2], bu[2];
#pragma unroll
        for (int n = 0; n < 2; ++n) { bg[n] = *(const f32x4*)(bp + 4 * n); bu[n] = *(const f32x4*)(bp + 1024 + 4 * n); }
        const int row0 = u.pm * BM + wr * 64 + fr;
#pragma unroll
        for (int ai = 0; ai < 2; ++ai)
#pragma unroll
            for (int m = 0; m < 4; ++m) {
                f32x4 o[2];
#pragma unroll
                for (int n = 0; n < 2; ++n) {
                    const f32x4 g4 = acc[ai][0][m][n] + bg[n], u4 = acc[ai][1][m][n] + bu[n];
#pragma unroll
                    for (int c = 0; c < 4; ++c) {
                        const float g = fminf(g4[c], 7.0f), up = fminf(fmaxf(u4[c], -7.0f), 7.0f);
                        const float sg = __builtin_amdgcn_rcpf(1.0f + __builtin_amdgcn_exp2f(-1.702f * 1.4426950408889634f * g));
                        o[n][c] = (up + 1.0f) * (g * sg);
                    }
                }
                u32x4 w; w.x = cvt_pk_bf16(o[0][0], o[0][1]); w.y = cvt_pk_bf16(o[0][2], o[0][3]); w.z = cvt_pk_bf16(o[1][0], o[1][1]); w.w = cvt_pk_bf16(o[1][2], o[1][3]);
                *(u32x4*)(O + (size_t)(row0 + ai * HALF + m * 16) * 1024 + colh) = w;
            }
    }
};
template <class Epi, class Sched, bool ALIGN_EPI = false, bool SP2 = false>
__device__ __forceinline__ void gemm_phase(PG8_LAS unsigned char* lds, const Gemm g, const Sched& S, const Epi& E) {
    int tid_ = threadIdx.x; asm volatile("" : "+v"(tid_));
    const int tid = tid_, wid = __builtin_amdgcn_readfirstlane(tid >> 6), lane = tid & 63, wr = wid >> 2, wc = wid & 3, fr = lane & 15, fq = lane >> 4;
    const int K = g.K, nt = K / BK;
    unsigned voffA[2], voffB[2];
#pragma unroll
    for (int i = 0; i < 2; ++i) { int R, C; stage_rc(tid * 16 + i * 8192, R, C); const int Rb = Epi::PERM ? ((R & ~31) + perm32(R & 31)) : R;
        voffA[i] = (unsigned)(R * K + C) * 2u; voffB[i] = (unsigned)(Rb * K + C) * 2u; }
    const size_t kstep = (size_t)(BK * 2);
    const size_t hstep = (size_t)HALF * K * 2;
    const size_t tstep = 2 * hstep;
    const unsigned ldsw = (unsigned)wid * 1024u;
    const int aoff = lds_byte(wr * 64 + fr, fq * 8), boff = lds_byte(wc * 32 + fr, fq * 8);
#define PG8_SA(b, h) (((b) * 2 + (h)) * HTB)
#define PG8_SB(b, h) ((4 + (b) * 2 + (h)) * HTB)
#define PG8_STAGE(bufoff, gbase, voff) do { _Pragma("unroll") for (int _i = 0; _i < 2; ++_i) \
        __builtin_amdgcn_global_load_lds((const unsigned*)((const char*)(gbase) + (voff)[_i]), (PG8_LAS unsigned*)(lds + (bufoff) + ldsw + _i * 8192), 16, 0, 0); } while (0)
#define PG8_LDA(dst, b, h) do { _Pragma("unroll") for (int m = 0; m < 4; ++m) _Pragma("unroll") for (int k = 0; k < 2; ++k) dst[m][k] = *(const PG8_LAS bf16x8*)(lds + PG8_SA(b, h) + aoff + m * 2048 + k * 1024); } while (0)
#define PG8_LDB(dst, b, h) do { _Pragma("unroll") for (int n = 0; n < 2; ++n) _Pragma("unroll") for (int k = 0; k < 2; ++k) dst[n][k] = *(const PG8_LAS bf16x8*)(lds + PG8_SB(b, h) + boff + n * 2048 + k * 1024); } while (0)
#define PG8_MMA(ai, bj, At, Bt) do { __builtin_amdgcn_s_setprio(1); _Pragma("unroll") for (int m = 0; m < 4; ++m) _Pragma("unroll") for (int n = 0; n < 2; ++n) _Pragma("unroll") for (int k = 0; k < 2; ++k) \
        acc[ai][bj][m][n] = __builtin_amdgcn_mfma_f32_16x16x32_bf16(Bt[n][k], At[m][k], acc[ai][bj][m][n], 0, 0, 0); __builtin_amdgcn_s_setprio(0); } while (0)
#define PG8_WAIT_V(n) asm volatile("s_waitcnt vmcnt(" #n ")" ::: "memory")
#define PG8_WAIT_L(n) asm volatile("s_waitcnt lgkmcnt(" #n ")" ::: "memory")
#define PG8_BAR __builtin_amdgcn_s_barrier()
#define PG8_SCHED __builtin_amdgcn_sched_barrier(0)
    Unit cur, nxt; int ui = 0;
    if (!S.next(0, cur)) return;
    f32x4 acc[2][2][4][2];
#pragma unroll
    for (int a = 0; a < 2; ++a)
#pragma unroll
        for (int b = 0; b < 2; ++b)
#pragma unroll
            for (int m = 0; m < 4; ++m)
#pragma unroll
                for (int n = 0; n < 2; ++n) acc[a][b][m][n] = (f32x4){0.f, 0.f, 0.f, 0.f};
    bf16x8 At[4][2], B0[2][2], B1[2][2];
    const char* cA = (const char*)g.A + (size_t)cur.pm * tstep; const char* cB = (const char*)g.Bt + (size_t)cur.pn * tstep;
    S.a_ready(cur);
    if constexpr (SP2) {
        PG8_STAGE(PG8_SB(0, 0), cB, voffB); PG8_STAGE(PG8_SB(0, 1), cB + hstep, voffB); PG8_STAGE(PG8_SA(0, 0), cA, voffA); PG8_STAGE(PG8_SA(0, 1), cA + hstep, voffA);
        if (wr == 1) PG8_BAR;
        PG8_WAIT_V(2); PG8_BAR;
        PG8_STAGE(PG8_SB(1, 0), cB + kstep, voffB); PG8_STAGE(PG8_SA(1, 0), cA + kstep, voffA); PG8_STAGE(PG8_SB(1, 1), cB + hstep + kstep, voffB);
        PG8_WAIT_V(6); PG8_BAR;
    } else {
        PG8_STAGE(PG8_SB(0, 0), cB, voffB); PG8_STAGE(PG8_SA(0, 0), cA, voffA); PG8_STAGE(PG8_SB(0, 1), cB + hstep, voffB); PG8_STAGE(PG8_SA(0, 1), cA + hstep, voffA);
        if (wr == 1) PG8_BAR;
        PG8_WAIT_V(4); PG8_BAR;
        PG8_STAGE(PG8_SB(1, 0), cB + kstep, voffB); PG8_STAGE(PG8_SA(1, 0), cA + kstep, voffA); PG8_STAGE(PG8_SB(1, 1), cB + hstep + kstep, voffB);
        PG8_WAIT_V(6); PG8_BAR;
    }
    for (;;) {
        const bool has_next = S.next(ui + 1, nxt);
        const char* nA = has_next ? (const char*)g.A + (size_t)nxt.pm * tstep : cA; const char* nB = has_next ? (const char*)g.Bt + (size_t)nxt.pn * tstep : cB;
        for (int t = 0; t < nt; t += 2) {
            const bool last = (t == nt - 2);
            const char* a1 = cA + (size_t)(t + 1) * kstep;
            const char* a2 = last ? nA : cA + (size_t)(t + 2) * kstep; const char* b2 = last ? nB : cB + (size_t)(t + 2) * kstep;
            const char* a3 = a2 + kstep; const char* b3 = b2 + kstep;
            if (last && has_next) S.a_ready(nxt);
            if constexpr (SP2) {
            PG8_LDB(B0, 0, 0); PG8_LDB(B1, 0, 1); PG8_SCHED; PG8_LDA(At, 0, 0); PG8_STAGE(PG8_SA(1, 1), a1 + hstep, voffA);
            PG8_WAIT_V(8); PG8_WAIT_L(0); PG8_BAR; PG8_MMA(0, 0, At, B0); PG8_MMA(0, 1, At, B1); PG8_BAR; PG8_SCHED;
            PG8_LDA(At, 0, 1); PG8_STAGE(PG8_SB(0, 0), b2, voffB); PG8_STAGE(PG8_SB(0, 1), b2 + hstep, voffB); PG8_STAGE(PG8_SA(0, 0), a2, voffA);
            PG8_WAIT_V(8); PG8_WAIT_L(0); PG8_BAR; PG8_MMA(1, 0, At, B0); PG8_MMA(1, 1, At, B1); PG8_BAR; PG8_SCHED;
            PG8_LDB(B0, 1, 0); PG8_LDB(B1, 1, 1); PG8_SCHED; PG8_LDA(At, 1, 0); PG8_STAGE(PG8_SA(0, 1), a2 + hstep, voffA);
            PG8_WAIT_V(8); PG8_WAIT_L(0); PG8_BAR; PG8_MMA(0, 0, At, B0); PG8_MMA(0, 1, At, B1); PG8_BAR; PG8_SCHED;
            PG8_LDA(At, 1, 1); PG8_STAGE(PG8_SB(1, 0), b3, voffB); PG8_STAGE(PG8_SB(1, 1), b3 + hstep, voffB); PG8_STAGE(PG8_SA(1, 0), a3, voffA);
            PG8_WAIT_V(8); PG8_WAIT_L(0); PG8_BAR; PG8_MMA(1, 0, At, B0); PG8_MMA(1, 1, At, B1); PG8_BAR; PG8_SCHED;
            } else {
            PG8_LDB(B0, 0, 0); PG8_SCHED; PG8_LDA(At, 0, 0); PG8_STAGE(PG8_SA(1, 1), a1 + hstep, voffA);
            PG8_WAIT_L(8); PG8_BAR; PG8_WAIT_L(0); PG8_MMA(0, 0, At, B0); PG8_BAR; PG8_SCHED;
            PG8_LDB(B1, 0, 1); PG8_STAGE(PG8_SB(0, 0), b2, voffB);
            PG8_BAR; PG8_WAIT_L(0); PG8_MMA(0, 1, At, B1); PG8_BAR;
            PG8_LDA(At, 0, 1); PG8_STAGE(PG8_SA(0, 0), a2, voffA);
            PG8_BAR; PG8_WAIT_L(0); PG8_MMA(1, 0, At, B0); PG8_BAR; PG8_SCHED;
            PG8_STAGE(PG8_SB(0, 1), b2 + hstep, voffB);
            PG8_WAIT_V(6); PG8_BAR; PG8_MMA(1, 1, At, B1); PG8_BAR;
            PG8_LDB(B0, 1, 0); PG8_SCHED; PG8_LDA(At, 1, 0); PG8_STAGE(PG8_SA(0, 1), a2 + hstep, voffA);
            PG8_WAIT_L(8); PG8_BAR; PG8_WAIT_L(0); PG8_MMA(0, 0, At, B0); PG8_BAR; PG8_SCHED;
            PG8_LDB(B1, 1, 1); PG8_STAGE(PG8_SB(1, 0), b3, voffB);
            PG8_BAR; PG8_WAIT_L(0); PG8_MMA(0, 1, At, B1); PG8_BAR;
            PG8_LDA(At, 1, 1); PG8_STAGE(PG8_SA(1, 0), a3, voffA);
            PG8_BAR; PG8_WAIT_L(0); PG8_MMA(1, 0, At, B0); PG8_BAR; PG8_SCHED;
            PG8_STAGE(PG8_SB(1, 1), b3 + hstep, voffB);
            PG8_WAIT_V(6); PG8_BAR; PG8_MMA(1, 1, At, B1); PG8_BAR;
            }
        }
        if constexpr (ALIGN_EPI) { if (wr == 0) PG8_BAR; }
        if constexpr (!Epi::AFTER_DRAIN) { E(acc, cur, wr, wc, fr, fq); S.done(cur); }
        if (!has_next) break;
#pragma unroll
        for (int a = 0; a < 2; ++a)
#pragma unroll
            for (int b = 0; b < 2; ++b)
#pragma unroll
                for (int m = 0; m < 4; ++m)
#pragma unroll
                    for (int n = 0; n < 2; ++n) acc[a][b][m][n] = (f32x4){0.f, 0.f, 0.f, 0.f};
        cur = nxt; cA = nA; cB = nB; ++ui;
        if constexpr (ALIGN_EPI) { if (wr == 1) PG8_BAR; }
    }
    PG8_WAIT_V(0);
    if constexpr (!ALIGN_EPI) { if (wr == 0) PG8_BAR; }
    PG8_BAR;
    if constexpr (Epi::AFTER_DRAIN) { E.fused(acc, cur, wr, wc, fr, fq, lds, wid, lane); S.done(cur); }
#undef PG8_SA
#undef PG8_SB
#undef PG8_STAGE
#undef PG8_LDA
#undef PG8_LDB
#undef PG8_MMA
#undef PG8_WAIT_V
#undef PG8_WAIT_L
#undef PG8_BAR
#undef PG8_SCHED
}
}
namespace attn_body {
using bf16=unsigned short;
using bf16x8=__attribute__((ext_vector_type(8)))short;
using s16x4=__attribute__((ext_vector_type(4)))short;
using f32x16=__attribute__((ext_vector_type(16)))float;
using u32x4=__attribute__((ext_vector_type(4)))unsigned;
constexpr int SEQ=2048,D=64,DM=4096,DMO=1024;
constexpr int NW=8,QBLK=32,QB=QBLK*NW,KVBLK=64,NQB=SEQ/QB;
__device__ __forceinline__ unsigned f2bf_(float f){unsigned u=__builtin_bit_cast(unsigned,f);return (u+0x7fffu+((u>>16)&1u))>>16;}
__device__ __forceinline__ int crow(int r,int hi){return (r&3)+8*(r>>2)+4*hi;}
#define SBAR() __builtin_amdgcn_sched_barrier(0)
__device__ __forceinline__ void cmask(f32x16&p0,f32x16&p1,int jb,int qrel,int hi){
  const float NEG=-INFINITY; int kb=64*jb+4*hi;
  #pragma unroll
  for(int r=0;r<16;++r){int kv=kb+(r&3)+8*(r>>2); if(kv>qrel)p0[r]=NEG; if(kv+32>qrel)p1[r]=NEG;}
}

__device__ __forceinline__ uint2 mld_asm(const unsigned*p){ uint2 v; asm volatile("global_load_dwordx2 %0, %1, off":"=v"(v):"v"(p):"memory"); return v; }
__device__ __forceinline__ void bmask(f32x16&p0,f32x16&p1,uint2 w,int hi){
  const float NEG=-INFINITY; const unsigned a=w.x>>(4*hi), b=w.y>>(4*hi);
  #pragma unroll
  for(int r=0;r<16;++r){const int bit=(r&3)+8*(r>>2); if(!((a>>bit)&1u))p0[r]=NEG; if(!((b>>bit)&1u))p1[r]=NEG;}
}
constexpr int NSLOT=3, SLOTB=8192;
constexpr int LDS_K=0, LDS_V=NSLOT*SLOTB, LDS_WS=2*NSLOT*SLOTB, LDS_OST=LDS_WS+NW*64*4, LDS_BYTES=LDS_OST+NW*4096;
constexpr float C2=0.125f*1.4426950408889634f;
__device__ __forceinline__ void glds16(const void*gsrc,unsigned lds_dst){unsigned keep;
  asm volatile("s_mov_b32 %0, m0\n\ts_mov_b32 m0, %2\n\ts_nop 0\n\tglobal_load_lds_dwordx4 %1, off\n\ts_mov_b32 m0, %0":"=&s"(keep):"v"(gsrc),"s"(lds_dst):"memory");}
__device__ __forceinline__ float max3f(float a,float b,float c){float r;asm("v_max3_f32 %0, %1, %2, %3":"=v"(r):"v"(a),"v"(b),"v"(c));return r;}
__device__ __forceinline__ float max2f(float a,float b){float r;asm("v_max_f32_e32 %0, %1, %2":"=v"(r):"v"(a),"v"(b));return r;}
__device__ __forceinline__ float fadd_s(float a,float b){float r;asm("v_add_f32_e32 %0, %1, %2":"=v"(r):"v"(a),"v"(b));return r;}
__device__ __forceinline__ float fsub_s(float a,float b){float r;asm("v_sub_f32_e32 %0, %1, %2":"=v"(r):"v"(a),"v"(b));return r;}
typedef float f32x2_t __attribute__((ext_vector_type(2))); typedef __bf16 bf16x2_t __attribute__((ext_vector_type(2)));
__device__ __forceinline__ unsigned cvtpk_s(float lo,float hi){f32x2_t v={lo,hi};bf16x2_t b=__builtin_convertvector(v,bf16x2_t);return __builtin_bit_cast(unsigned,b);}
#define WAIT_BAR(N) asm volatile("s_waitcnt vmcnt(" #N ") lgkmcnt(0)\n\ts_barrier":::"memory")

__device__ __forceinline__ void qkt(f32x16&p0,f32x16&p1,const char*Kslot,const bf16x8*qr,const f32x16&negm,int r32,int hi){
  const char*kb=Kslot+hi*1024+r32*16;
  #pragma unroll
  for(int d0=0;d0<4;++d0){
    const bf16x8 b0=*reinterpret_cast<const bf16x8*>(kb+d0*2048);
    const bf16x8 b1=*reinterpret_cast<const bf16x8*>(kb+d0*2048+512);
    if(d0==0){p0=__builtin_amdgcn_mfma_f32_32x32x16_bf16(b0,qr[0],negm,0,0,0);p1=__builtin_amdgcn_mfma_f32_32x32x16_bf16(b1,qr[0],negm,0,0,0);}
    else{p0=__builtin_amdgcn_mfma_f32_32x32x16_bf16(b0,qr[d0],p0,0,0,0);p1=__builtin_amdgcn_mfma_f32_32x32x16_bf16(b1,qr[d0],p1,0,0,0);}}
}
typedef __attribute__((address_space(3))) const char* lds_cptr;
typedef short v4i16_t __attribute__((ext_vector_type(4)));
__device__ __forceinline__ void kload8(bf16x8*kf,lds_cptr kp){
  kf[0]=*(const __attribute__((address_space(3))) bf16x8*)(kp);      kf[1]=*(const __attribute__((address_space(3))) bf16x8*)(kp+512);
  kf[2]=*(const __attribute__((address_space(3))) bf16x8*)(kp+2048); kf[3]=*(const __attribute__((address_space(3))) bf16x8*)(kp+2560);
  kf[4]=*(const __attribute__((address_space(3))) bf16x8*)(kp+4096); kf[5]=*(const __attribute__((address_space(3))) bf16x8*)(kp+4608);
  kf[6]=*(const __attribute__((address_space(3))) bf16x8*)(kp+6144); kf[7]=*(const __attribute__((address_space(3))) bf16x8*)(kp+6656);
}
__device__ __forceinline__ void kload2(bf16x8*kf,lds_cptr kp,int j){ kf[2*j]=*(const __attribute__((address_space(3))) bf16x8*)(kp+j*2048); kf[2*j+1]=*(const __attribute__((address_space(3))) bf16x8*)(kp+j*2048+512); }
__device__ __forceinline__ s16x4 vtr(lds_cptr p){ return __builtin_bit_cast(s16x4,__builtin_amdgcn_ds_read_tr16_b64_v4i16((__attribute__((address_space(3))) v4i16_t*)p)); }
__device__ __forceinline__ float rowmax(const f32x16&p0,const f32x16&p1){
  float a=max3f(p0[0],p0[1],p1[0]),b=max3f(p0[2],p0[3],p1[1]);a=max3f(a,p1[2],p1[3]);
  #pragma unroll
  for(int r=4;r<16;r+=4){a=max3f(a,p0[r],p0[r+1]);b=max3f(b,p0[r+2],p0[r+3]);a=max3f(a,p1[r],p1[r+1]);b=max3f(b,p1[r+2],p1[r+3]);}
  const float m=max2f(a,b);
  auto rr=__builtin_amdgcn_permlane32_swap(__float_as_uint(m),__float_as_uint(m),false,false);
  return max2f(__uint_as_float(rr[0]),__uint_as_float(rr[1]));
}
__device__ __forceinline__ void pv(f32x16*o,int vb,bf16x8 pa0,bf16x8 pa1,bf16x8 pa2,bf16x8 pa3){
  #pragma unroll
  for(int d0=0;d0<2;++d0){s16x4 lo[4],hi[4];
    #pragma unroll
    for(int ks=0;ks<4;++ks){
      asm volatile("ds_read_b64_tr_b16 %0,%1 offset:%c2":"=&v"(lo[ks]):"v"(vb),"i"(d0*4096+ks*1024):"memory");
      asm volatile("ds_read_b64_tr_b16 %0,%1 offset:%c2":"=&v"(hi[ks]):"v"(vb),"i"(d0*4096+ks*1024+512):"memory");}
    asm volatile("s_waitcnt lgkmcnt(0)":::"memory");SBAR();
    #define PK(k) (bf16x8){lo[k][0],lo[k][1],lo[k][2],lo[k][3],hi[k][0],hi[k][1],hi[k][2],hi[k][3]}
    o[d0]=__builtin_amdgcn_mfma_f32_32x32x16_bf16(pa0,PK(0),o[d0],0,0,0);
    o[d0]=__builtin_amdgcn_mfma_f32_32x32x16_bf16(pa1,PK(1),o[d0],0,0,0);
    o[d0]=__builtin_amdgcn_mfma_f32_32x32x16_bf16(pa2,PK(2),o[d0],0,0,0);
    o[d0]=__builtin_amdgcn_mfma_f32_32x32x16_bf16(pa3,PK(3),o[d0],0,0,0);
    #undef PK
  }
}

#ifndef ATTN_STORE16
#define ATTN_STORE16(p,v) (*(u32x4*)(p)=(v))
#endif
template<int THRL,bool MASKED> __device__ __forceinline__ void attn_unit(int b,int qb,const bf16*Q,const bf16*__restrict__ K,const bf16*__restrict__ V,bf16*O,const unsigned*MASK,char*shm){
  int tid_=threadIdx.x; asm volatile("":"+v"(tid_));
  const int tid=tid_,lane=tid&63,r32=lane&31,hi=lane>>5; const int wid=__builtin_amdgcn_readfirstlane(tid>>6);
  const long rowbase=(long)b*SEQ; const int q0=qb*QB;
  const bf16*Qw=Q+(rowbase+q0+wid*QBLK)*DM;
  const bf16*Kh=K+rowbase*DM,*Vh=V+rowbase*DM;
  const unsigned*mrow=MASK+(size_t)(rowbase+q0+wid*QBLK+r32)*64;
  #define MLD(tt) mld_asm(mrow+2*(tt))
  const unsigned lds0=(unsigned)(uintptr_t)shm;
  float*wsf=(float*)(shm+LDS_WS)+wid*64;
  const bf16*ksrc=Kh+(long)lane*DM+wid*8;
  const bf16*vsrc=Vh+(long)(16*(wid&3)+(lane>>2))*DM+(wid>>2)*32+(lane&3)*8;
  const unsigned kdst=lds0+LDS_K+wid*1024, vdst=lds0+LDS_V+wid*1024;
  #define DMA_K(t,slot) glds16(ksrc+(long)(t)*KVBLK*DM,(unsigned)__builtin_amdgcn_readfirstlane(kdst+(slot)))
  #define DMA_V(t,slot) glds16(vsrc+(long)(t)*KVBLK*DM,(unsigned)__builtin_amdgcn_readfirstlane(vdst+(slot)))
  const int vb0=(int)(lds0+LDS_V)+((lane>>4)&1)*32+(lane&3)*8+(4*hi+((lane&15)>>2))*64;
  const char*Kbase=shm+LDS_K; bf16x8 kf[8];
  const lds_cptr shm3=(lds_cptr)shm; const lds_cptr kp0=shm3+LDS_K+hi*1024+r32*16; const lds_cptr vp0=shm3+LDS_V+((lane>>4)&1)*32+(lane&3)*8+(4*hi+((lane&15)>>2))*64;
  const int NT=(q0+QB)/KVBLK;
  uint2 mw_cur=make_uint2(~0u,~0u), mw_next=make_uint2(~0u,~0u); if(MASKED){ mw_cur=MLD(0); mw_next=MLD(1); }
  DMA_K(0,0);DMA_V(0,0);DMA_K(1,SLOTB);
  bf16x8 qr[4];
  #pragma unroll
  for(int d0=0;d0<4;++d0)qr[d0]=*reinterpret_cast<const bf16x8*>(&Qw[(long)r32*DM+d0*16+hi*8]);
  float mhat=0.f,l_reg=0.f;f32x16 o[2];o[0]=f32x16{};o[1]=f32x16{};f32x16 negm=f32x16{};asm volatile("":"+v"(negm));
  const int qrel=wid*QBLK+r32;
  #define CMASK(P0,P1,t) do{ if(MASKED){bmask(P0,P1,mw_cur,hi);} else {int jb_=(t)-(NT-4); if(jb_>=0)cmask(P0,P1,jb_,qrel,hi);} }while(0)
  bool resc=false;
  #define START(P0,P1) do{ float rm=rowmax(P0,P1); if(MASKED)rm=max2f(rm,-64.f); resc=false; \
    { const float dl=rm; mhat=fadd_s(mhat,dl); \
      _Pragma("unroll") for(int r=0;r<16;++r){P0[r]=fsub_s(P0[r],dl);P1[r]=fsub_s(P1[r],dl);} \
      _Pragma("unroll") for(int r=0;r<16;++r)negm[r]=-mhat; asm volatile("":"+v"(negm)); } \
    _Pragma("unroll") for(int r=0;r<16;++r)P0[r]=__builtin_amdgcn_exp2f(P0[r]); }while(0)
  #define RESC() do{ if(resc){ asm volatile("s_waitcnt lgkmcnt(0)":::"memory"); \
      _Pragma("unroll") for(int d_=0;d_<2;++d_) _Pragma("unroll") for(int r=0;r<16;++r)o[d_][r]*=wsf[crow(r,hi)]; } }while(0)
  f32x16 pA0,pA1,pB0,pB1;
  int sl_prev=0,sl_cur=0,sl_next=SLOTB;
  #define ROT() do{sl_prev=sl_cur;sl_cur=sl_next;sl_next=(sl_next==(NSLOT-1)*SLOTB)?0:sl_next+SLOTB;}while(0)
  DMA_K(2,2*SLOTB);
  WAIT_BAR(3);
  qkt(pA0,pA1,Kbase,qr,negm,r32,hi);asm volatile("s_nop 15\n\ts_nop 7":"+v"(pA0),"+v"(pA1));CMASK(pA0,pA1,0);
  START(pA0,pA1);
  _Pragma("unroll") for(int r=0;r<16;++r)pA1[r]=__builtin_amdgcn_exp2f(pA1[r]);
  WAIT_BAR(0);
  DMA_K(3,0);DMA_V(1,SLOTB);
  ROT();
  kload8(kf,kp0+sl_cur);
  WAIT_BAR(2);
  s16x4 vlo[8],vhi[8]; u32x4 pw0,pw1,pw2,pw3;
  #define PKW(P,B) cvtpk_s(P[B],P[B+1])
  #define PAF(k) __builtin_bit_cast(bf16x8,pw##k)
  #define VFR(i) (bf16x8){vlo[i][0],vlo[i][1],vlo[i][2],vlo[i][3],vhi[i][0],vhi[i][1],vhi[i][2],vhi[i][3]}
  #define PIN(x) asm volatile("":"+v"(x))
  #define MX3(a,b,c) __builtin_fmaxf(__builtin_fmaxf((a),(b)),(c))
  #define GAPA(MF,A0,A1,A2,A3,W0,W1,PW) do{ MF; sacc+=A0; sacc+=A1; sacc+=A2; sacc+=A3; PIN(sacc); W0; W1; PIN(PW); SBAR(); }while(0)
  #define EX(v) __builtin_amdgcn_exp2f(v)
  #define GAPB(MF,X,B) do{ MF; X[B]=EX(X[B]); X[B+1]=EX(X[B+1]); X[B+2]=EX(X[B+2]); X[B+3]=EX(X[B+3]); PIN(X); SBAR(); }while(0)
  #define VRD(i) do{ vlo[i]=vtr(vp_+(((i)>>2)*4096+((i)&3)*1024)); vhi[i]=vtr(vp_+(((i)>>2)*4096+((i)&3)*1024+512)); }while(0)
  #define KRD(G,j) do{ if(G){ kload2(kf,kp0+sl_next,j); SBAR(); } }while(0)
  #define STEP(C0,C1,P0,P1,t,GK,GV,GL) do{ SBAR(); if(MASKED){ mw_cur=mw_next; if((t)+1<NT) mw_next=MLD((t)+1); } \
    const lds_cptr vp_=vp0+sl_prev; \
    VRD(0); SBAR(); float sacc=(P0[0]+P0[1]); \
    GAPA(C0=__builtin_amdgcn_mfma_f32_32x32x16_bf16(kf[0],qr[0],negm,0,0,0), P0[2],P0[3],P0[4],P0[5],     pw0[0]=PKW(P0,0), pw0[1]=PKW(P0,2), pw0); \
    VRD(4); SBAR(); GAPA(C1=__builtin_amdgcn_mfma_f32_32x32x16_bf16(kf[1],qr[0],negm,0,0,0), P0[6],P0[7],P0[8],P0[9],     pw0[2]=PKW(P0,4), pw0[3]=PKW(P0,6), pw0); \
    VRD(1); SBAR(); GAPA(C0=__builtin_amdgcn_mfma_f32_32x32x16_bf16(kf[2],qr[1],C0,0,0,0),   P0[10],P0[11],P0[12],P0[13], pw1[0]=PKW(P0,8), pw1[1]=PKW(P0,10), pw1); \
    VRD(5); SBAR(); GAPA(C1=__builtin_amdgcn_mfma_f32_32x32x16_bf16(kf[3],qr[1],C1,0,0,0),   P0[14],P0[15],P1[0],P1[1],   pw1[2]=PKW(P0,12),pw1[3]=PKW(P0,14), pw1); \
    VRD(2); SBAR(); GAPA(C0=__builtin_amdgcn_mfma_f32_32x32x16_bf16(kf[4],qr[2],C0,0,0,0),   P1[2],P1[3],P1[4],P1[5],     pw2[0]=PKW(P1,0), pw2[1]=PKW(P1,2), pw2); \
    VRD(6); SBAR(); GAPA(C1=__builtin_amdgcn_mfma_f32_32x32x16_bf16(kf[5],qr[2],C1,0,0,0),   P1[6],P1[7],P1[8],P1[9],     pw2[2]=PKW(P1,4), pw2[3]=PKW(P1,6), pw2); \
    VRD(3); SBAR(); GAPA(C0=__builtin_amdgcn_mfma_f32_32x32x16_bf16(kf[6],qr[3],C0,0,0,0),   P1[10],P1[11],P1[12],P1[13], pw3[0]=PKW(P1,8), pw3[1]=PKW(P1,10), pw3); \
    VRD(7); SBAR(); GAPA(C1=__builtin_amdgcn_mfma_f32_32x32x16_bf16(kf[7],qr[3],C1,0,0,0),   P1[14],P1[15],0.f,0.f,       pw3[2]=PKW(P1,12),pw3[3]=PKW(P1,14), pw3); \
    l_reg+=sacc; \
    if(GK){DMA_K((t)+3,sl_cur);} if(GV){DMA_V((t)+1,sl_next);} \
    CMASK(C0,C1,t); \
    { float a=MX3(C0[0],C0[1],C1[0]),b=MX3(C0[2],C0[3],C1[1]); a=MX3(a,C1[2],C1[3]); \
      _Pragma("unroll") for(int r=4;r<16;r+=4){a=MX3(a,C0[r],C0[r+1]);b=MX3(b,C0[r+2],C0[r+3]);a=MX3(a,C1[r],C1[r+1]);b=MX3(b,C1[r+2],C1[r+3]);} \
      float rm=__builtin_fmaxf(a,b); { auto rr=__builtin_amdgcn_permlane32_swap(__float_as_uint(rm),__float_as_uint(rm),false,false); rm=__builtin_fmaxf(__uint_as_float(rr[0]),__uint_as_float(rr[1])); } \
      resc=false; \
      if(__builtin_expect(__any(rm>(float)THRL),0)){ const float dl=__builtin_fmaxf(rm,0.f); mhat+=dl; \
        _Pragma("unroll") for(int r=0;r<16;++r){C0[r]-=dl;C1[r]-=dl;} \
        _Pragma("unroll") for(int r=0;r<16;++r)negm[r]=-mhat; asm volatile("":"+v"(negm)); \
        const float f=__builtin_amdgcn_exp2f(-dl); l_reg*=f; if(hi==0)wsf[r32]=f; resc=true; } } \
    SBAR(); \
    GAPB(o[0]=__builtin_amdgcn_mfma_f32_32x32x16_bf16(PAF(0),VFR(0),o[0],0,0,0), C0,0); \
    GAPB(o[1]=__builtin_amdgcn_mfma_f32_32x32x16_bf16(PAF(0),VFR(4),o[1],0,0,0), C0,4); \
    KRD(GL,0); GAPB(o[0]=__builtin_amdgcn_mfma_f32_32x32x16_bf16(PAF(1),VFR(1),o[0],0,0,0), C0,8); \
    KRD(GL,1); GAPB(o[1]=__builtin_amdgcn_mfma_f32_32x32x16_bf16(PAF(1),VFR(5),o[1],0,0,0), C0,12); \
    KRD(GL,2); GAPB(o[0]=__builtin_amdgcn_mfma_f32_32x32x16_bf16(PAF(2),VFR(2),o[0],0,0,0), C1,0); \
    KRD(GL,3); GAPB(o[1]=__builtin_amdgcn_mfma_f32_32x32x16_bf16(PAF(2),VFR(6),o[1],0,0,0), C1,4); \
    GAPB(o[0]=__builtin_amdgcn_mfma_f32_32x32x16_bf16(PAF(3),VFR(3),o[0],0,0,0), C1,8); \
    GAPB(o[1]=__builtin_amdgcn_mfma_f32_32x32x16_bf16(PAF(3),VFR(7),o[1],0,0,0), C1,12); \
    }while(0)
  int t=1;
  #undef CMASK
  #define CMASK(P0,P1,t) do{ if(MASKED){bmask(P0,P1,mw_cur,hi);} }while(0)
  for(;t+5<NT;t+=2){
    STEP(pB0,pB1,pA0,pA1,t,true,true,true);     WAIT_BAR(2); RESC(); ROT();
    STEP(pA0,pA1,pB0,pB1,t+1,true,true,true);   WAIT_BAR(2); RESC(); ROT();
  }
  #undef CMASK
  #define CMASK(P0,P1,t) do{ if(MASKED){bmask(P0,P1,mw_cur,hi);} else {int jb_=(t)-(NT-4); if(jb_>=0)cmask(P0,P1,jb_,qrel,hi);} }while(0)
  #define ENDW(tt) do{ if((tt)+3<NT){WAIT_BAR(2);} else if((tt)+2<NT){WAIT_BAR(1);} else {WAIT_BAR(0);} }while(0)
  for(;t+1<NT;t+=2){
    STEP(pB0,pB1,pA0,pA1,t,(t+3<NT),(t+1<NT),(t+1<NT));       ENDW(t);   RESC(); ROT();
    STEP(pA0,pA1,pB0,pB1,t+1,(t+4<NT),(t+2<NT),(t+2<NT));     ENDW(t+1); RESC(); ROT();
  }
  STEP(pB0,pB1,pA0,pA1,NT-1,false,false,false); RESC();
  { float sacc=pB0[0]+pB0[1]; _Pragma("unroll") for(int r=2;r<16;++r)sacc+=pB0[r]; _Pragma("unroll") for(int r=0;r<16;++r)sacc+=pB1[r]; l_reg+=sacc;
    pw0=(u32x4){PKW(pB0,0),PKW(pB0,2),PKW(pB0,4),PKW(pB0,6)};pw1=(u32x4){PKW(pB0,8),PKW(pB0,10),PKW(pB0,12),PKW(pB0,14)};pw2=(u32x4){PKW(pB1,0),PKW(pB1,2),PKW(pB1,4),PKW(pB1,6)};pw3=(u32x4){PKW(pB1,8),PKW(pB1,10),PKW(pB1,12),PKW(pB1,14)};
    SBAR(); pv(o,vb0+sl_cur,PAF(0),PAF(1),PAF(2),PAF(3)); }
  #undef PKW
  #undef PAF
  #undef VFR
  #undef PIN
  #undef MX3
  #undef GAPA
  #undef GAPB
  #undef EX
  #undef VRD
  #undef KRD
  #undef STEP
  #undef ENDW
  {auto rr=__builtin_amdgcn_permlane32_swap(__float_as_uint(l_reg),__float_as_uint(l_reg),false,false);l_reg=__uint_as_float(rr[0])+__uint_as_float(rr[1]);}
  if(hi==0)wsf[32+r32]=l_reg;asm volatile("s_waitcnt lgkmcnt(0)":::"memory");
  float rli[16];
  #pragma unroll
  for(int r=0;r<16;++r)rli[r]=__builtin_amdgcn_rcpf(wsf[32+crow(r,hi)]);
  bf16*Ow=O+(rowbase+q0+wid*QBLK)*DMO;
  { bf16*stg=(bf16*)(shm+LDS_OST)+wid*2048;
    #pragma unroll
    for(int r=0;r<16;++r){const int orow=crow(r,hi);
      #pragma unroll
      for(int d0=0;d0<2;++d0)stg[orow*64+d0*32+r32]=(bf16)f2bf_(o[d0][r]*rli[r]);}
    asm volatile("s_waitcnt lgkmcnt(0)":::"memory");
    #pragma unroll
    for(int i=0;i<4;++i){const int row=i*8+(lane>>3),ch=lane&7; const u32x4 v=*(const u32x4*)(stg+row*64+ch*8); ATTN_STORE16(Ow+(long)row*DMO+ch*8,v);} }
  asm volatile("s_waitcnt lgkmcnt(0)\n\ts_barrier":::"memory");
  #undef DMA_K
  #undef DMA_V
  #undef MLD
  #undef CMASK
  #undef START
  #undef RESC
  #undef ROT
}
constexpr int ATTN_LDS_BYTES=LDS_BYTES;
#undef SBAR
#undef WAIT_BAR
}
#define GAS __attribute__((address_space(1)))
#define LAS __attribute__((address_space(3)))
typedef unsigned short bf16;
typedef unsigned v4u __attribute__((ext_vector_type(4)));
typedef float f32x4 __attribute__((ext_vector_type(4)));
typedef short bf16x8 __attribute__((ext_vector_type(8)));
typedef GAS unsigned gu32;
typedef GAS unsigned long long gu64;
#define RLX_AGENT __ATOMIC_RELAXED, __HIP_MEMORY_SCOPE_AGENT
#define LDS_WAIT() asm volatile("s_waitcnt lgkmcnt(0)" ::: "memory")
#define VM_WAIT() asm volatile("s_waitcnt vmcnt(0)" ::: "memory")
__device__ __forceinline__ unsigned long long rt() { return __builtin_amdgcn_s_memrealtime(); }
__device__ __forceinline__ unsigned f2bf(float f) { unsigned u = __builtin_bit_cast(unsigned, f); return (u + 0x7fffu + ((u >> 16) & 1u)) >> 16; }
__device__ __forceinline__ unsigned pk2(float lo, float hi) { return f2bf(lo) | (f2bf(hi) << 16); }
#define XB_TMO      128
#define XB_XCNT(j)  (256  + 64 * (j))
#define XB_XSUB(j)  (1280 + 64 * (j))
#define XB_XGEN(j)  (2304 + 64 * (j))
#define XB_TOP      3328
#define XB_TOPGEN   3392
#define XCD_BAR_WORDS 3456
#define XB_SPIN_CAP (1u << 20)

__device__ __forceinline__ unsigned xb_ld(unsigned* p)              { return __hip_atomic_load(p, __ATOMIC_RELAXED, __HIP_MEMORY_SCOPE_AGENT); }
__device__ __forceinline__ unsigned xb_add(unsigned* p, unsigned v) { return __hip_atomic_fetch_add(p, v, __ATOMIC_RELAXED, __HIP_MEMORY_SCOPE_AGENT); }
__device__ __forceinline__ unsigned xb_xcc_id() { return (unsigned)__builtin_amdgcn_s_getreg((3 << 11) | 20) & 0xFu; }
#define XB_SPIN(cond, bar) do { unsigned _sp = 0; while (cond) { __builtin_amdgcn_s_sleep(1); \
    if ((++_sp & 255u) == 0u) { if (xb_ld(&(bar)[XB_TMO])) break; if (_sp > XB_SPIN_CAP) { atomicAdd(&(bar)[XB_TMO], 1u); break; } } } } while (0)

struct XcdBarrier {
    unsigned* bar; unsigned x;
    volatile LAS unsigned* st;
};

__device__ __forceinline__ XcdBarrier xcd_barrier_post(unsigned* bar, volatile LAS unsigned* st) {
    XcdBarrier b; b.bar = bar; b.x = xb_xcc_id(); b.st = st;
    if (threadIdx.x == 0) (void)xb_add(&bar[XB_XCNT(b.x)], 1u);
    return b;
}
__device__ __forceinline__ void xcd_barrier_complete(unsigned* bar, unsigned x, unsigned& nloc, unsigned& nx) {
    const unsigned G = gridDim.x * gridDim.y * gridDim.z;
    unsigned sum, cnt, mine, sp = 0u;
    for (;;) {
        sum = 0u; cnt = 0u; mine = 0u;
#pragma unroll
        for (unsigned j = 0; j < 16; ++j) { const unsigned c = xb_ld(&bar[XB_XCNT(j)]); sum += c; cnt += (c > 0u) ? 1u : 0u; mine = (j == x) ? c : mine; }
        if (sum == G) break;
        __builtin_amdgcn_s_sleep(1);
        if ((++sp & 255u) == 0u) { if (xb_ld(&bar[XB_TMO])) break; if (sp > XB_SPIN_CAP) { atomicAdd(&bar[XB_TMO], 1u); break; } }
    }
    nloc = mine > 0u ? mine : 1u; nx = cnt > 0u ? cnt : 1u;
}

__device__ __forceinline__ void xcd_barrier(const XcdBarrier& b) {
    asm volatile("s_waitcnt vmcnt(0)" ::: "memory");
    __syncthreads();
    if (threadIdx.x == 0) {
        unsigned* bar = b.bar;
        __builtin_amdgcn_s_waitcnt(0);
        unsigned nloc = b.st[0], nx = b.st[1];
        if (nloc == 0u) { xcd_barrier_complete(bar, b.x, nloc, nx); b.st[0] = nloc; b.st[1] = nx; }
        const unsigned old = xb_add(&bar[XB_XSUB(b.x)], 1u);
        const unsigned gen = old / nloc;
        if (old + 1u == (gen + 1u) * nloc) {
            __builtin_amdgcn_fence(__ATOMIC_RELEASE, "agent");
            asm volatile("s_waitcnt vmcnt(0)" ::: "memory");
            const unsigned og = xb_add(&bar[XB_TOP], 1u);
            const unsigned tg = og / nx;
            if (og + 1u == (tg + 1u) * nx) xb_add(&bar[XB_TOPGEN], 1u);
            else XB_SPIN(xb_ld(&bar[XB_TOPGEN]) == tg, bar);
            __builtin_amdgcn_fence(__ATOMIC_ACQUIRE, "agent");
            xb_add(&bar[XB_XGEN(b.x)], 1u);
            asm volatile("s_waitcnt vmcnt(0)" ::: "memory");
        } else {
            XB_SPIN(xb_ld(&bar[XB_XGEN(b.x)]) == gen, bar);
            __builtin_amdgcn_fence(__ATOMIC_ACQUIRE, "agent");
            asm volatile("s_waitcnt vmcnt(0)" ::: "memory");
        }
    }
    __syncthreads();
}
constexpr int NB = 16, SEQ = 2048, T = NB * SEQ, D = 1024, DEPTH = 4, NHC = 4096, NEXP = 32, NWAVES = 8;
constexpr int NIN = 3920;
constexpr float LN_EPS = 1e-5f, DN_ALPHA = 1.6817928305074290f;
constexpr int RPAD = T * 4 + NEXP * 256;
constexpr int HC_MQ = 0, HC_MK = 256, HC_MV = 512, HC_MO = 768, HC_DQ = 1024, HC_DK = 1536, HC_DV = 2048, HC_SQ = 2560, HC_SK = 2816, HC_SV = 3072, HC_XQ = 3328, HC_XK = 3840, HC_MI = 3904, HC_MF = 3908, HC_XW = 3912;
constexpr size_t MiB = 1u << 20;
constexpr size_t WS_CTL = 0, CTL_ZERO_BYTES = 2 * MiB;
constexpr size_t WS_MOD = 2 * MiB;
constexpr size_t WS_LAM = WS_MOD + 7 * MiB / 4;
constexpr size_t WS_RWT = 4 * MiB;
constexpr size_t WS_CS = 8 * MiB;
constexpr size_t WS_WIN = 16 * MiB;
constexpr size_t WS_WOUT = 48 * MiB;
constexpr size_t WS_W1 = 64 * MiB;
constexpr size_t WS_W2 = 576 * MiB;
constexpr size_t WS_XB = 832 * MiB;
constexpr size_t WS_U = 960 * MiB;
constexpr size_t WS_H = 1024 * MiB;
constexpr size_t WS_QKC = 1280 * MiB;
constexpr size_t WS_XKP = 1312 * MiB;
constexpr size_t WS_MASK = 1316 * MiB;
constexpr size_t WS_TOK = 1324 * MiB;
constexpr size_t WS_MIX = 1344 * MiB;
constexpr size_t WS_Y = 1408 * MiB;
constexpr size_t WS_SC = 1472 * MiB;
constexpr size_t WS_XG = 1728 * MiB;
constexpr size_t WS_HM = 2000 * MiB;
constexpr size_t WS_YM = 2272 * MiB;
constexpr size_t WS_END = 2544 * MiB;
constexpr int CW_CNT = 1024;
constexpr int CW_BAR = 4096;
constexpr int RING_BYTES = 131072, TAB_OFF = RING_BYTES, MISC_OFF = RING_BYTES + 4096, LDS_BYTES = 147456;
constexpr int NPH = 11, NSTEPS = 2 + NPH * DEPTH;
enum { PH_IN = 0, PH_POST, PH_MIXA, PH_SEL, PH_DSA, PH_OUT, PH_ROW1, PH_GATH, PH_G1, PH_G2, PH_ROW2 };

__device__ __forceinline__ float bf2f(bf16 h) { return __uint_as_float((unsigned)h << 16); }
__device__ __forceinline__ float wave_sum(float v) {
#pragma unroll
    for (int o = 1; o < 64; o <<= 1) v += __shfl_xor(v, o);
    return v;
}
__device__ __forceinline__ float wave_max(float v) {
#pragma unroll
    for (int o = 1; o < 64; o <<= 1) v = fmaxf(v, __shfl_xor(v, o));
    return v;
}
__device__ __forceinline__ float sigmoidf_(float x) { return 1.0f / (1.0f + __expf(-x)); }
struct Ctx {
    LAS unsigned char* lds;
    int tid, lane, wave, gw, ngw;
    const float* in[25];
    float* out; unsigned char* ws;
};
#define WSP(type, off) ((type*)(C.ws + (off)))
enum { I_X = 0, I_C, I_POS, I_WIN, I_GATEB, I_CONVW, I_CONVB, I_MNORM, I_DFLAM, I_DFNORM, I_IDXG, I_IDXB, I_WOUT, I_ADAW, I_ADAB, I_LN1G, I_LN1B, I_LN2G, I_LN2B, I_RW, I_RB, I_W1, I_B1, I_W2, I_B2 };

__device__ __forceinline__ int in_dest_col(int n) {
    auto rp = [](int j) { const int hd = j >> 6, d = j & 63; return hd * 64 + ((d < 32) ? 2 * d : 2 * (d - 32) + 1); };
    if (n < 256) return HC_MQ + n;
    if (n < 512) return HC_MK + (n - 256);
    if (n < 768) return HC_MV + (n - 512);
    if (n < 772) return HC_MI + (n - 768);
    if (n < 776) return HC_MF + (n - 772);
    if (n < 1032) return HC_MO + (n - 776);
    if (n < 1544) return HC_DQ + rp(n - 1032);
    if (n < 2056) return HC_DK + rp(n - 1544);
    if (n < 2568) return HC_DV + (n - 2056);
    if (n < 2824) return HC_SQ + rp(n - 2568);
    if (n < 3080) return HC_SK + rp(n - 2824);
    if (n < 3336) return HC_SV + (n - 3080);
    if (n < 3848) return HC_XQ + rp(n - 3336);
    if (n < 3912) return HC_XK + (n - 3848);
    return HC_XW + (n - 3912);
}
template <class F> __device__ __forceinline__ void transpose_item(const float* W, int ldw, int K, int nvalid, int k0, int n0, bf16* WT, LAS float* scr, int lane, F drow) {
    const int nn = n0 + (lane & 31); const bool ok = nn < nvalid;
#pragma unroll 8
    for (int i = 0; i < 32; ++i) { const int kk = 2 * i + (lane >> 5); scr[kk * 33 + (lane & 31)] = ok ? W[(size_t)(k0 + kk) * ldw + nn] : 0.f; }
    LDS_WAIT(); asm volatile("" ::: "memory");
    const int c = lane & 7;
#pragma unroll
    for (int j = 0; j < 4; ++j) { const int n = (lane >> 3) + 8 * j; const LAS float* s = scr + (8 * c) * 33 + n;
        v4u o; o.x = pk2(s[0 * 33], s[1 * 33]); o.y = pk2(s[2 * 33], s[3 * 33]); o.z = pk2(s[4 * 33], s[5 * 33]); o.w = pk2(s[6 * 33], s[7 * 33]);
        if (n0 + n < nvalid) *(GAS v4u*)(WT + (size_t)drow(n0 + n) * K + k0 + 8 * c) = o; }
    LDS_WAIT(); asm volatile("" ::: "memory");
}
struct Args { const float* in[25]; float* out; unsigned char* ws; int s_lo, s_hi, li, pad; };
typedef __attribute__((address_space(4))) const Args CArgs;
__device__ __forceinline__ CArgs* kargs() { CArgs* p = (CArgs*)__builtin_amdgcn_kernarg_segment_ptr(); asm volatile("" : "+s"(p)); return p; }
__device__ __forceinline__ LAS unsigned char* lds_launder(LAS unsigned char* q) { unsigned v = (unsigned)(size_t)q; asm volatile("" : "+s"(v)); return (LAS unsigned char*)(size_t)v; }
#define WS(type, off) ((type*)(A->ws + (off)))
#define TIDX CArgs* A = kargs(); int tid_ = threadIdx.x; asm volatile("" : "+v"(tid_)); const int tid = tid_, lane = tid & 63, wave = __builtin_amdgcn_readfirstlane(tid >> 6); const int gw = blockIdx.x * NWAVES + wave, ngw = gridDim.x * NWAVES; (void)lane; (void)gw; (void)ngw

__device__ __forceinline__ void pro_a(LAS unsigned char* lds) {
    TIDX;
    LAS float* scr = (LAS float*)(lds + wave * 16384);
    constexpr int IT_IN = 16 * 123, IT_OUT = 16 * 32, IT_W1 = 16 * 64, IT_W2 = 16 * 32;
    constexpr int N_IN = DEPTH * IT_IN, N_OUT = DEPTH * IT_OUT, N_W1 = DEPTH * NEXP * IT_W1, N_W2 = DEPTH * NEXP * IT_W2;
    constexpr int NITEMS = N_IN + N_OUT + N_W1 + N_W2;
    for (int it = gw; it < NITEMS; it += ngw) {
        int r = it;
        if (r < N_IN) { const int l = r / IT_IN, q = r % IT_IN, kb = q / 123, nb = q % 123;
            transpose_item(A->in[I_WIN] + (size_t)l * D * NIN, NIN, D, NIN, kb * 64, nb * 32, WS(bf16, WS_WIN) + (size_t)l * NHC * D, scr, lane, [](int n) { return in_dest_col(n); }); continue; }
        r -= N_IN;
        if (r < N_OUT) { const int l = r / IT_OUT, q = r % IT_OUT, kb = q / 32, nb = q % 32;
            transpose_item(A->in[I_WOUT] + (size_t)l * D * D, D, D, D, kb * 64, nb * 32, WS(bf16, WS_WOUT) + (size_t)l * D * D, scr, lane, [](int n) { return n; }); continue; }
        r -= N_OUT;
        if (r < N_W1) { const int le = r / IT_W1, q = r % IT_W1, kb = q / 64, nb = q % 64;
            transpose_item(A->in[I_W1] + (size_t)le * D * 2048, 2048, D, 2048, kb * 64, nb * 32, WS(bf16, WS_W1) + (size_t)le * 2048 * D, scr, lane,
                           [](int n) { const int up = n >> 10, j = n & 1023; return (j >> 7) * 256 + up * 128 + (j & 127); }); continue; }
        r -= N_W1;
        { const int le = r / IT_W2, q = r % IT_W2, kb = q / 32, nb = q % 32;
            transpose_item(A->in[I_W2] + (size_t)le * D * D, D, D, D, kb * 64, nb * 32, WS(bf16, WS_W2) + (size_t)le * D * D, scr, lane, [](int n) { return n; }); }
    }
    for (int r = gw; r < DEPTH * (NHC - NIN); r += ngw) { const int l = r / (NHC - NIN), row = NIN + r % (NHC - NIN);
        GAS v4u* p = (GAS v4u*)(WS(bf16, WS_WIN) + ((size_t)l * NHC + row) * D) + lane; p[0] = (v4u){0u, 0u, 0u, 0u}; p[64] = (v4u){0u, 0u, 0u, 0u}; }
    for (int idx = blockIdx.x * 512 + tid; idx < T * 32; idx += gridDim.x * 512) {
        const int tok = idx >> 5, i = idx & 31;
        const double inv = exp(-(double)i * (9.210340371976184 / 32.0));
        const double ang = (double)((const int*)A->in[I_POS])[tok] * inv;
        const double rev = ang * 0.15915494309189535;
        const float fr = (float)(rev - rint(rev));
        float2 v; v.x = __builtin_amdgcn_cosf(fr); v.y = __builtin_amdgcn_sinf(fr);
        WS(float2, WS_CS)[idx] = v;
    }
    for (int idx = blockIdx.x * 512 + tid; idx < DEPTH * NEXP * D; idx += gridDim.x * 512) {
        const int l = idx / (NEXP * D), r = idx % (NEXP * D), e = r / D, d = r % D;
        WS(float, WS_RWT)[idx] = A->in[I_RW][((size_t)l * D + d) * NEXP + e];
    }
    if (blockIdx.x == 0 && wave == 0) {
        for (int l = 0; l < DEPTH; ++l) { const float* lf = A->in[I_DFLAM] + l * 256;
            const float a = wave_sum(lf[lane] * lf[64 + lane]), b = wave_sum(lf[128 + lane] * lf[192 + lane]);
            if (lane == 0) WS(float, WS_LAM)[l] = __expf(a) - __expf(b) + (0.8f - 0.6f * __expf(-0.3f * (float)l)); }
    }
    __syncthreads();
    if (blockIdx.x < (DEPTH * 6144) / 512) {
        LAS float* ca = (LAS float*)lds;
        for (int i = tid; i < NB * D; i += 512) { const float v = A->in[I_C][i]; ca[i] = v / (1.0f + __expf(-v)); }
        __syncthreads();
        const int col = blockIdx.x * 512 + tid, l = col / 6144, m = col % 6144;
        const float* w = A->in[I_ADAW] + (size_t)l * D * 6144 + m;
        float acc[NB];
#pragma unroll
        for (int b = 0; b < NB; ++b) acc[b] = 0.f;
        for (int d = 0; d < D; ++d) { const float wv = w[(size_t)d * 6144];
#pragma unroll
            for (int b = 0; b < NB; ++b) acc[b] += ca[b * D + d] * wv; }
        const float bias = A->in[I_ADAB][col];
#pragma unroll
        for (int b = 0; b < NB; ++b) WS(float, WS_MOD)[((size_t)l * NB + b) * 6144 + m] = acc[b] + bias;
        __syncthreads();
    }
}
__device__ __forceinline__ void pro_b() {
    TIDX;
    for (int tok = gw; tok < T; tok += ngw) {
        const int b = tok / SEQ; const float* mod = WS(float, WS_MOD) + (size_t)b * 6144;
        const GAS f32x4* xr = (const GAS f32x4*)(A->in[I_X] + (size_t)tok * D) + lane;
        GAS unsigned long long* o8 = (GAS unsigned long long*)(WS(bf16, WS_U) + (size_t)tok * D) + lane;
#pragma unroll
        for (int j = 0; j < 4; ++j) { const f32x4 x = xr[64 * j]; const f32x4 sh = *(const f32x4*)(mod + 4 * lane + 256 * j), sc = *(const f32x4*)(mod + 1024 + 4 * lane + 256 * j);
            const f32x4 u = x * (1.0f + sc) + sh; o8[64 * j] = (unsigned long long)pk2(u.x, u.y) | ((unsigned long long)pk2(u.z, u.w) << 32); }
    }
}
__device__ __forceinline__ void ph_post(int l) {
    TIDX;
    const bf16* H = WS(bf16, WS_H); bf16* XKP = WS(bf16, WS_XKP); bf16* QKC = WS(bf16, WS_QKC);
    const float* cw = A->in[I_CONVW] + (size_t)l * 4 * 512; const float* cb = A->in[I_CONVB] + (size_t)l * 512;
    const float gi = A->in[I_IDXG][l * 64 + lane], bi = A->in[I_IDXB][l * 64 + lane];
    for (int tok = gw; tok < T; tok += ngw) {
        const bf16* hrow = H + (size_t)tok * NHC;
        {
            const float v = bf2f(hrow[HC_XK + lane]);
            const float mean = wave_sum(v) * (1.0f / 64.0f); const float dv = v - mean;
            const float var = wave_sum(dv * dv) * (1.0f / 64.0f);
            const float nv = dv * (1.0f / sqrtf(var + LN_EPS)) * gi + bi;
            const float pv = __shfl_xor(nv, 32);
            const int i = lane & 31; const float2 cs = WS(float2, WS_CS)[(size_t)tok * 32 + i];
            const float o = (lane < 32) ? (nv * cs.x - pv * cs.y) : (nv * cs.x + pv * cs.y);
            XKP[(size_t)tok * 64 + 2 * i + (lane >> 5)] = (bf16)f2bf(o);
        }
        {
            const int s = tok % SEQ, c0 = 8 * lane;
            float acc[8];
#pragma unroll
            for (int c = 0; c < 8; ++c) acc[c] = cb[c0 + c];
#pragma unroll
            for (int j = 0; j < 4; ++j) {
                if (s - 3 + j >= 0) {
                    const v4u raw = *(const GAS v4u*)(H + (size_t)(tok - 3 + j) * NHC + c0);
                    const unsigned rw[4] = {raw.x, raw.y, raw.z, raw.w};
#pragma unroll
                    for (int c = 0; c < 8; ++c) { const float x = __uint_as_float((c & 1) ? (rw[c >> 1] & 0xffff0000u) : (rw[c >> 1] << 16)); acc[c] += cw[j * 512 + c0 + c] * x; }
                }
            }
            v4u o;
#define SILU(x) ((x) / (1.0f + __expf(-(x))))
            o.x = pk2(SILU(acc[0]), SILU(acc[1])); o.y = pk2(SILU(acc[2]), SILU(acc[3])); o.z = pk2(SILU(acc[4]), SILU(acc[5])); o.w = pk2(SILU(acc[6]), SILU(acc[7]));
#undef SILU
            *(GAS v4u*)(QKC + (size_t)tok * 512 + c0) = o;
        }
    }
}
typedef float f32x16 __attribute__((ext_vector_type(16)));
__device__ __forceinline__ void ph_idx_scores() {
    TIDX;
    const bf16* H = WS(bf16, WS_H); const bf16* XKP = WS(bf16, WS_XKP); float* SC = WS(float, WS_SC);
    const int r = lane & 31, hh = lane >> 5, ql = r >> 3, hd = r & 7;
    for (int unit = blockIdx.x; unit < NB * (SEQ / 32); unit += gridDim.x) {
        const int b = unit / (SEQ / 32), q0 = (unit % (SEQ / 32)) * 32 + 4 * wave, tok0 = b * SEQ + q0;
        bf16x8 af[4];
        { const bf16* ap = H + (size_t)(tok0 + ql) * NHC + HC_XQ + hd * 64 + 8 * hh;
#pragma unroll
          for (int ks = 0; ks < 4; ++ks) af[ks] = *(const GAS bf16x8*)(ap + ks * 16); }
        float wv[4][4];
#pragma unroll
        for (int q = 0; q < 4; ++q)
#pragma unroll
            for (int i = 0; i < 4; ++i) wv[q][i] = bf2f(H[(size_t)(tok0 + q) * NHC + HC_XW + 4 * hh + i]);
        const int nkt = (q0 + 3) / 32 + 1;
        for (int kt = 0; kt < nkt; ++kt) {
            const int key = kt * 32 + r;
            const bf16* kp = XKP + (size_t)(b * SEQ + key) * 64 + 8 * hh;
            f32x16 acc = {};
#pragma unroll
            for (int ks = 0; ks < 4; ++ks) { const bf16x8 bfr = *(const GAS bf16x8*)(kp + ks * 16); acc = __builtin_amdgcn_mfma_f32_32x32x16_bf16(af[ks], bfr, acc, 0, 0, 0); }
            float tot[4];
#pragma unroll
            for (int q = 0; q < 4; ++q) { float p = 0.f;
#pragma unroll
                for (int i = 0; i < 4; ++i) p += wv[q][i] * fmaxf(acc[4 * q + i], 0.f);
                tot[q] = p + __shfl_xor(p, 32); }
            const float o0 = hh ? tot[2] : tot[0], o1 = hh ? tot[3] : tot[1];
            SC[(size_t)(tok0 + 2 * hh) * SEQ + key] = o0; SC[(size_t)(tok0 + 2 * hh + 1) * SEQ + key] = o1;
        }
    }
}
__device__ __forceinline__ void ph_mlstm(LAS unsigned char* lds, int l) {
    TIDX;
    const bf16* H = WS(bf16, WS_H); const bf16* QKC = WS(bf16, WS_QKC); bf16* MIX = WS(bf16, WS_MIX);
    constexpr int P = 65;
    LAS float* q = (LAS float*)lds; LAS float* k = q + 64 * P; LAS float* v = k + 64 * P; LAS float* Sm = v + 64 * P; LAS float* Cst = Sm + 64 * P;
    LAS float* nst = Cst + 64 * P; LAS float* bcum = nst + 64; LAS float* ii = bcum + 64; LAS float* mt = ii + 64; LAS float* inter = mt + 64; LAS float* den = inter + 64; LAS float* wvv = den + 64; LAS float* sc = wvv + 64;
    for (int unit = blockIdx.x; unit < NB * 4; unit += gridDim.x) {
        const int b = unit >> 2, h = unit & 3;
        const float gbi = A->in[I_GATEB][l * 8 + h], gbf = A->in[I_GATEB][l * 8 + 4 + h];
        for (int i = tid; i < 64 * P; i += 512) Cst[i] = 0.f;
        if (tid < 64) nst[tid] = 0.f;
        if (tid == 0) sc[0] = 0.f;
        __syncthreads();
        for (int ch = 0; ch < SEQ / 64; ++ch) {
            const int tok0 = b * SEQ + ch * 64;
            for (int idx = tid; idx < 4096; idx += 512) { const int rr = idx >> 6, d = idx & 63; const size_t tk = (size_t)(tok0 + rr);
                q[rr * P + d] = bf2f(QKC[tk * 512 + h * 64 + d]) * 0.125f; k[rr * P + d] = bf2f(QKC[tk * 512 + 256 + h * 64 + d]); v[rr * P + d] = bf2f(H[tk * NHC + HC_MV + h * 64 + d]); }
            if (wave == 0) {
                const size_t tk = (size_t)(tok0 + lane);
                const float ip = bf2f(H[tk * NHC + HC_MI + h]) + gbi, fp = bf2f(H[tk * NHC + HC_MF + h]) + gbf;
                float lf = fminf(fp, 0.f) - log1pf(__expf(-fabsf(fp)));
#pragma unroll
                for (int o = 1; o < 64; o <<= 1) { const float t_ = __shfl_up(lf, o); if (lane >= o) lf += t_; }
                ii[lane] = ip; bcum[lane] = lf;
            }
            __syncthreads();
            const float mprev = sc[0];
            if (tid < 64) { const int t = tid; float mx = -INFINITY; const float bt = bcum[t];
                for (int s = 0; s <= t; ++s) mx = fmaxf(mx, bt - bcum[s] + ii[s]);
                const float li = bt + mprev, m_t = fmaxf(li, mx); mt[t] = m_t; inter[t] = __expf(li - m_t); }
            __syncthreads();
            for (int idx = tid; idx < 4096; idx += 512) { const int t = idx >> 6, s = idx & 63; float val = 0.f;
                if (s <= t) { float dot = 0.f;
#pragma unroll 16
                    for (int d = 0; d < 64; ++d) dot += q[t * P + d] * k[s * P + d];
                    val = dot * __expf(bcum[t] - bcum[s] + ii[s] - mt[t]); }
                Sm[t * P + s] = val; }
            __syncthreads();
            if (tid < 64) { const int t = tid; float a = 0.f, qn = 0.f;
                for (int s = 0; s < 64; ++s) a += Sm[t * P + s];
                for (int d = 0; d < 64; ++d) qn += q[t * P + d] * nst[d];
                den[t] = a + inter[t] * qn; }
            float num[8];
#pragma unroll
            for (int j = 0; j < 8; ++j) { const int t = wave + 8 * j, vc = lane; float a = 0.f, qc = 0.f;
                for (int s = 0; s < 64; ++s) a += Sm[t * P + s] * v[s * P + vc];
                for (int d = 0; d < 64; ++d) qc += q[t * P + d] * Cst[d * P + vc];
                num[j] = a + inter[t] * qc; }
            __syncthreads();
#pragma unroll
            for (int j = 0; j < 8; ++j) { const int t = wave + 8 * j, vc = lane; const size_t tk = (size_t)(tok0 + t);
                const float hv = num[j] / fmaxf(fabsf(den[t]), __expf(-mt[t]));
                const float mean = wave_sum(hv) * (1.0f / 64.0f), hc = hv - mean;
                const float rs = 1.0f / sqrtf(wave_sum(hc * hc) * (1.0f / 64.0f) + LN_EPS);
                const float og = sigmoidf_(bf2f(H[tk * NHC + HC_MO + h * 64 + vc]));
                MIX[tk * D + h * 64 + vc] = (bf16)f2bf(og * (hc * rs * A->in[I_MNORM][l * 256 + h * 64 + vc])); }
            if (wave == 0) { const float bl = bcum[63]; const float lw = bl - bcum[lane] + ii[lane];
                const float mnew = fmaxf(bl + mprev, wave_max(lw)); wvv[lane] = __expf(lw - mnew);
                if (lane == 0) { sc[1] = __expf(bl + mprev - mnew); sc[2] = mnew; } }
            __syncthreads();
            { const float decay = sc[1];
#pragma unroll
              for (int j = 0; j < 8; ++j) { const int d = wave + 8 * j, vc = lane; float a = 0.f;
                  for (int s = 0; s < 64; ++s) a += wvv[s] * k[s * P + d] * v[s * P + vc];
                  Cst[d * P + vc] = decay * Cst[d * P + vc] + a; }
              if (tid < 64) { float a = 0.f; for (int s = 0; s < 64; ++s) a += wvv[s] * k[s * P + tid]; nst[tid] = decay * nst[tid] + a; }
              if (tid == 0) sc[0] = sc[2]; }
            __syncthreads();
        }
    }
}
template <int NV> __device__ __forceinline__ void naive_attn_row(const bf16* qp, const bf16* Kb, const bf16* Vb, int tl, const unsigned* maskrow, int lane, float (&o)[NV], float& l_out) {
    float qf[64];
#pragma unroll
    for (int c = 0; c < 8; ++c) { const v4u raw = *(const GAS v4u*)(qp + 8 * c); const unsigned rw[4] = {raw.x, raw.y, raw.z, raw.w};
#pragma unroll
        for (int e = 0; e < 8; ++e) qf[8 * c + e] = __uint_as_float((e & 1) ? (rw[e >> 1] & 0xffff0000u) : (rw[e >> 1] << 16)); }
    float m = -INFINITY, l = 0.f;
#pragma unroll
    for (int n = 0; n < NV; ++n) o[n] = 0.f;
    for (int kb = 0; kb * 64 <= tl; ++kb) {
        const int s = kb * 64 + lane; bool valid = s <= tl;
        if (maskrow) valid = valid && ((maskrow[2 * kb + (lane >> 5)] >> (lane & 31)) & 1u);
        float dot = 0.f;
        const bf16* kr = Kb + (size_t)s * NHC;
#pragma unroll
        for (int c = 0; c < 8; ++c) { const v4u raw = *(const GAS v4u*)(kr + 8 * c); const unsigned rw[4] = {raw.x, raw.y, raw.z, raw.w};
#pragma unroll
            for (int e = 0; e < 8; ++e) dot += qf[8 * c + e] * __uint_as_float((e & 1) ? (rw[e >> 1] & 0xffff0000u) : (rw[e >> 1] << 16)); }
        const float scv = valid ? dot : -INFINITY;
        const float bm = wave_max(scv);
        if (bm == -INFINITY) continue;
        const float mn = fmaxf(m, bm), alpha = __builtin_amdgcn_exp2f(m - mn), p = __builtin_amdgcn_exp2f(scv - mn);
        l = l * alpha + wave_sum(p); m = mn;
#pragma unroll
        for (int n = 0; n < NV; ++n) o[n] *= alpha;
        const int nk = min(64, tl - kb * 64 + 1);
        const bf16* vr = Vb + (size_t)(kb * 64) * NHC + lane;
        for (int j = 0; j < nk; ++j) { const float pj = __shfl(p, j);
#pragma unroll
            for (int n = 0; n < NV; ++n) o[n] += pj * bf2f(vr[(size_t)j * NHC + 64 * n]); }
    }
    l_out = l;
}
__device__ __forceinline__ void ph_diff_naive(int l) {
    TIDX;
    const bf16* H = WS(bf16, WS_H); bf16* MIX = WS(bf16, WS_MIX);
    const float lam = WS(float, WS_LAM)[l], lam_init = 0.8f - 0.6f * __expf(-0.3f * (float)l);
    for (int task = gw; task < T * 4; task += ngw) {
        const int tok = task >> 2, h = task & 3, b = tok / SEQ, tl = tok % SEQ;
        const bf16* Hb = H + (size_t)b * SEQ * NHC;
        float o1[2], o2[2], l1, l2;
        naive_attn_row<2>(H + (size_t)tok * NHC + HC_DQ + (2 * h) * 64, Hb + HC_DK + (2 * h) * 64, Hb + HC_DV + h * 128, tl, nullptr, lane, o1, l1);
        naive_attn_row<2>(H + (size_t)tok * NHC + HC_DQ + (2 * h + 1) * 64, Hb + HC_DK + (2 * h + 1) * 64, Hb + HC_DV + h * 128, tl, nullptr, lane, o2, l2);
        const float i1 = 1.0f / l1, i2 = 1.0f / l2;
        const float d0 = o1[0] * i1 - lam * o2[0] * i2, d1 = o1[1] * i1 - lam * o2[1] * i2;
        const float rs = 1.0f / sqrtf(wave_sum(d0 * d0 + d1 * d1) * (1.0f / 128.0f) + LN_EPS);
        const float* g = A->in[I_DFNORM] + l * 512 + h * 128;
        MIX[(size_t)tok * D + 256 + h * 128 + lane] = (bf16)f2bf(d0 * rs * g[lane] * (1.0f - lam_init));
        MIX[(size_t)tok * D + 256 + h * 128 + 64 + lane] = (bf16)f2bf(d1 * rs * g[64 + lane] * (1.0f - lam_init));
    }
}
__device__ __forceinline__ void ph_dsa_naive() {
    TIDX;
    const bf16* H = WS(bf16, WS_H); bf16* MIX = WS(bf16, WS_MIX); const unsigned* MASK = WS(unsigned, WS_MASK);
    for (int task = gw; task < T * 4; task += ngw) {
        const int tok = task >> 2, h = task & 3, b = tok / SEQ, tl = tok % SEQ;
        const bf16* Hb = H + (size_t)b * SEQ * NHC;
        float o[1], ll;
        naive_attn_row<1>(H + (size_t)tok * NHC + HC_SQ + h * 64, Hb + HC_SK + h * 64, Hb + HC_SV + h * 64, tl, MASK + (size_t)tok * 64, lane, o, ll);
        MIX[(size_t)tok * D + 768 + h * 64 + lane] = (bf16)f2bf(o[0] / ll);
    }
}
constexpr size_t WS_OD = WS_END;
constexpr size_t WS_END2 = WS_END + 64 * MiB;
__device__ __forceinline__ void ph_diff_attn(LAS unsigned char* lds) {
    CArgs* A = kargs();
    const int G = gridDim.x, bx = blockIdx.x, vcu = (G % 8 == 0) ? (bx % 8) * (G / 8) + bx / 8 : bx;
    const bf16* H = WS(bf16, WS_H); bf16* OD = WS(bf16, WS_OD);
    for (int item = vcu; item < NB * 16; item += G) {
        const int b = item >> 4, vh = item & 15, g = vh >> 1, half = vh & 1;
#pragma unroll 1
        for (int qb = 7; qb >= 0; --qb)
            attn_body::attn_unit<8, false>(b, qb, H + HC_DQ + g * 64, H + HC_DK + g * 64, H + HC_DV + (g >> 1) * 128 + half * 64, OD + g * 128 + half * 64, nullptr, (char*)lds);
    }
}
__device__ __forceinline__ void ph_diff_post(int l) {
    TIDX;
    const bf16* OD = WS(bf16, WS_OD); bf16* MIX = WS(bf16, WS_MIX);
    const float lam = WS(float, WS_LAM)[l], lam_init = 0.8f - 0.6f * __expf(-0.3f * (float)l);
    for (int task = gw; task < T * 4; task += ngw) {
        const int tok = task >> 2, h = task & 3;
        const bf16* o1 = OD + (size_t)tok * D + (2 * h) * 128, *o2 = o1 + 128;
        const float d0 = bf2f(o1[lane]) - lam * bf2f(o2[lane]), d1 = bf2f(o1[64 + lane]) - lam * bf2f(o2[64 + lane]);
        const float rs = 1.0f / sqrtf(wave_sum(d0 * d0 + d1 * d1) * (1.0f / 128.0f) + LN_EPS);
        const float* g = A->in[I_DFNORM] + l * 512 + h * 128;
        MIX[(size_t)tok * D + 256 + h * 128 + lane] = (bf16)f2bf(d0 * rs * g[lane] * (1.0f - lam_init));
        MIX[(size_t)tok * D + 256 + h * 128 + 64 + lane] = (bf16)f2bf(d1 * rs * g[64 + lane] * (1.0f - lam_init));
    }
}
__device__ __forceinline__ void ph_dsa_attn(LAS unsigned char* lds) {
    CArgs* A = kargs();
    const int G = gridDim.x, bx = blockIdx.x, vcu = (G % 8 == 0) ? (bx % 8) * (G / 8) + bx / 8 : bx;
    const bf16* H = WS(bf16, WS_H); bf16* MIX = WS(bf16, WS_MIX); const unsigned* MASK = WS(unsigned, WS_MASK);
    for (int item = vcu; item < NB * 4 * 4; item += G) {
        const int bh = item >> 2, p = item & 3, b = bh >> 2, h = bh & 3;
        attn_body::attn_unit<8, true>(b, 7 - p, H + HC_SQ + h * 64, H + HC_SK + h * 64, H + HC_SV + h * 64, MIX + 768 + h * 64, MASK, (char*)lds);
        attn_body::attn_unit<8, true>(b, p, H + HC_SQ + h * 64, H + HC_SK + h * 64, H + HC_SV + h * 64, MIX + 768 + h * 64, MASK, (char*)lds);
    }
}
constexpr size_t WS_DC = WS_END2;
constexpr size_t WS_CST = WS_DC + 32 * MiB;
constexpr size_t WS_DN = WS_CST + 32 * MiB;
constexpr size_t WS_END3 = WS_DN + 4 * MiB;
typedef float f32x2_ __attribute__((ext_vector_type(2)));
constexpr int MP = 68;
__device__ __forceinline__ float log_sigmoid_(float x) { return fminf(x, 0.f) - log1pf(__expf(-fabsf(x))); }
__device__ __forceinline__ void mlstm_gates(const bf16* H, int tok0, int h, float gbi, float gbf, int lane, LAS float* bcum, LAS float* av) {
    const size_t tk = (size_t)(tok0 + lane);
    const float ip = bf2f(H[tk * NHC + HC_MI + h]) + gbi; float lf = log_sigmoid_(bf2f(H[tk * NHC + HC_MF + h]) + gbf);
#pragma unroll
    for (int o = 1; o < 64; o <<= 1) { const float t_ = __shfl_up(lf, o); if (lane >= o) lf += t_; }
    bcum[lane] = lf; av[lane] = ip - lf;
}
__device__ __forceinline__ void ph_mlstm_m1(LAS unsigned char* lds, int l) {
    TIDX;
    const bf16* H = WS(bf16, WS_H); const bf16* QKC = WS(bf16, WS_QKC);
    float* DC = WS(float, WS_DC); float* DN = WS(float, WS_DN); float* SCAL = WS(float, WS_DN + 2 * MiB);
    LAS float* kS = (LAS float*)lds; LAS float* vS = kS + 64 * MP; LAS float* bcum = vS + 64 * MP; LAS float* av = bcum + 64; LAS float* wv = av + 64;
    const int tb = tid >> 5, cb = tid & 31;
    for (int u = blockIdx.x; u < NB * 4 * 32; u += gridDim.x) {
        const int bh = u >> 5, c = u & 31, b = bh >> 2, h = bh & 3, tok0 = b * SEQ + c * 64;
        for (int idx = tid; idx < 4096; idx += 512) { const int r = idx >> 6, d = idx & 63; const size_t tk = (size_t)(tok0 + r);
            kS[r * MP + d] = bf2f(QKC[tk * 512 + 256 + h * 64 + d]); vS[r * MP + d] = bf2f(H[tk * NHC + HC_MV + h * 64 + d]); }
        if (wave == 0) { mlstm_gates(H, tok0, h, A->in[I_GATEB][l * 8 + h], A->in[I_GATEB][l * 8 + 4 + h], lane, bcum, av); }
        __syncthreads();
        if (wave == 0) { const float a = av[lane], amax = wave_max(a); wv[lane] = __expf(a - amax); if (lane == 0) { SCAL[u * 4 + 0] = bcum[63]; SCAL[u * 4 + 1] = bcum[63] + amax; } }
        __syncthreads();
        float acc[4][2] = {};
#pragma unroll 4
        for (int s = 0; s < 64; ++s) { const float w = wv[s]; const f32x4 kv = *(const LAS f32x4*)(kS + s * MP + 4 * tb); const f32x2_ vv = *(const LAS f32x2_*)(vS + s * MP + 2 * cb);
#pragma unroll
            for (int i = 0; i < 4; ++i) { const float kw = kv[i] * w; acc[i][0] += kw * vv.x; acc[i][1] += kw * vv.y; } }
#pragma unroll
        for (int i = 0; i < 4; ++i) *(f32x2_*)(DC + (size_t)u * 4096 + (4 * tb + i) * 64 + 2 * cb) = (f32x2_){acc[i][0], acc[i][1]};
        if (tid < 64) { float a = 0.f;
#pragma unroll 8
            for (int s = 0; s < 64; ++s) a += wv[s] * kS[s * MP + tid]; DN[(size_t)u * 64 + tid] = a; }
        __syncthreads();
    }
}
__device__ __forceinline__ void ph_mlstm_m2() {
    TIDX;
    const float* DC = WS(float, WS_DC); float* CS = WS(float, WS_CST); const float* DN = WS(float, WS_DN); float* NS = WS(float, WS_DN + 1 * MiB); float* SCAL = WS(float, WS_DN + 2 * MiB);
    for (int item = blockIdx.x; item < NB * 4 * 4; item += gridDim.x) {
        const int bh = item >> 2, qtr = item & 3, e0 = qtr * 1024 + tid * 2;
        float m = 0.f; f32x2_ C = (f32x2_){0.f, 0.f}; float n = 0.f;
#pragma unroll 4
        for (int c = 0; c < 32; ++c) {
            const int u = bh * 32 + c;
            const float bl = SCAL[u * 4 + 0], ml = SCAL[u * 4 + 1];
            *(f32x2_*)(CS + (size_t)u * 4096 + e0) = C;
            if (qtr == 0 && tid < 64) NS[(size_t)u * 64 + tid] = n;
            if (qtr == 0 && tid == 0) SCAL[u * 4 + 2] = m;
            const float mn = fmaxf(bl + m, ml), f1 = __expf(bl + m - mn), f2 = __expf(ml - mn);
            const f32x2_ dc = *(const f32x2_*)(DC + (size_t)u * 4096 + e0);
            C.x = f1 * C.x + f2 * dc.x; C.y = f1 * C.y + f2 * dc.y;
            if (qtr == 0 && tid < 64) n = f1 * n + f2 * DN[(size_t)u * 64 + tid];
            m = mn;
        }
    }
}
__device__ __forceinline__ void ph_mlstm_m3(LAS unsigned char* lds, int l) {
    TIDX;
    const bf16* H = WS(bf16, WS_H); const bf16* QKC = WS(bf16, WS_QKC); bf16* MIX = WS(bf16, WS_MIX);
    const float* CS = WS(float, WS_CST); const float* NS = WS(float, WS_DN + 1 * MiB); const float* SCAL = WS(float, WS_DN + 2 * MiB);
    LAS float* qT = (LAS float*)lds; LAS float* kT = qT + 64 * MP; LAS float* vS = kT + 64 * MP; LAS float* SmT = vS + 64 * MP; LAS float* Cst = SmT + 64 * MP; LAS float* hS = Cst + 64 * MP;
    LAS float* bcum = hS + 64 * MP; LAS float* av = bcum + 64; LAS float* mm = av + 64; LAS float* inter = mm + 64; LAS float* den = inter + 64; LAS float* nst = den + 64;
    const int tb = tid >> 5, cb = tid & 31;
    for (int u = blockIdx.x; u < NB * 4 * 32; u += gridDim.x) {
        const int bh = u >> 5, c = u & 31, b = bh >> 2, h = bh & 3, tok0 = b * SEQ + c * 64;
        const float mc = SCAL[u * 4 + 2];
        for (int idx = tid; idx < 4096; idx += 512) { const int r = idx >> 6, d = idx & 63; const size_t tk = (size_t)(tok0 + r);
            qT[d * MP + r] = bf2f(QKC[tk * 512 + h * 64 + d]) * 0.125f; kT[d * MP + r] = bf2f(QKC[tk * 512 + 256 + h * 64 + d]); vS[r * MP + d] = bf2f(H[tk * NHC + HC_MV + h * 64 + d]);
            Cst[r * MP + d] = CS[(size_t)u * 4096 + idx]; }
        if (tid < 64) nst[tid] = NS[(size_t)u * 64 + tid];
        if (wave == 0) { mlstm_gates(H, tok0, h, A->in[I_GATEB][l * 8 + h], A->in[I_GATEB][l * 8 + 4 + h], lane, bcum, av); }
        __syncthreads();
        if (wave == 0) { float pm = av[lane];
#pragma unroll
            for (int o = 1; o < 64; o <<= 1) { const float t_ = __shfl_up(pm, o); if (lane >= o) pm = fmaxf(pm, t_); }
            const float m_ = fmaxf(mc, pm); mm[lane] = m_; inter[lane] = __expf(mc - m_); }
        __syncthreads();
        {
            float acc[4][2] = {};
#pragma unroll 4
            for (int d = 0; d < 64; ++d) { const f32x4 qv = *(const LAS f32x4*)(qT + d * MP + 4 * tb); const f32x2_ kv = *(const LAS f32x2_*)(kT + d * MP + 2 * cb);
#pragma unroll
                for (int i = 0; i < 4; ++i) { acc[i][0] += qv[i] * kv.x; acc[i][1] += qv[i] * kv.y; } }
#pragma unroll
            for (int j = 0; j < 2; ++j) { const int s = 2 * cb + j; const float as = av[s]; f32x4 o;
#pragma unroll
                for (int i = 0; i < 4; ++i) { const int t = 4 * tb + i; o[i] = (s <= t) ? acc[i][j] * __expf(as - mm[t]) : 0.f; }
                *(LAS f32x4*)(SmT + s * MP + 4 * tb) = o; }
        }
        __syncthreads();
        if (tid < 64) { float a = 0.f, qn = 0.f;
#pragma unroll 8
            for (int s = 0; s < 64; ++s) a += SmT[s * MP + tid];
#pragma unroll 8
            for (int d = 0; d < 64; ++d) qn += qT[d * MP + tid] * nst[d];
            const float dn = a + inter[tid] * qn; den[tid] = 1.0f / fmaxf(fabsf(dn), __expf(-(bcum[tid] + mm[tid]))); }
        {
            float a1[4][2] = {}, a2[4][2] = {};
#pragma unroll 4
            for (int s = 0; s < 64; ++s) { const f32x4 sv = *(const LAS f32x4*)(SmT + s * MP + 4 * tb); const f32x2_ vv = *(const LAS f32x2_*)(vS + s * MP + 2 * cb);
#pragma unroll
                for (int i = 0; i < 4; ++i) { a1[i][0] += sv[i] * vv.x; a1[i][1] += sv[i] * vv.y; } }
#pragma unroll 4
            for (int d = 0; d < 64; ++d) { const f32x4 qv = *(const LAS f32x4*)(qT + d * MP + 4 * tb); const f32x2_ cv = *(const LAS f32x2_*)(Cst + d * MP + 2 * cb);
#pragma unroll
                for (int i = 0; i < 4; ++i) { a2[i][0] += qv[i] * cv.x; a2[i][1] += qv[i] * cv.y; } }
            __syncthreads();
#pragma unroll
            for (int i = 0; i < 4; ++i) { const int t = 4 * tb + i; const float it = inter[t], dv = den[t];
                *(LAS f32x2_*)(hS + t * MP + 2 * cb) = (f32x2_){(a1[i][0] + it * a2[i][0]) * dv, (a1[i][1] + it * a2[i][1]) * dv}; }
        }
        __syncthreads();
#pragma unroll
        for (int j = 0; j < 8; ++j) { const int t = wave + 8 * j, vc = lane; const size_t tk = (size_t)(tok0 + t);
            const float hv = hS[t * MP + vc];
            const float mean = wave_sum(hv) * (1.0f / 64.0f), hc = hv - mean;
            const float rs = 1.0f / sqrtf(wave_sum(hc * hc) * (1.0f / 64.0f) + LN_EPS);
            const float og = sigmoidf_(bf2f(H[tk * NHC + HC_MO + h * 64 + vc]));
            MIX[tk * D + h * 64 + vc] = (bf16)f2bf(og * (hc * rs * A->in[I_MNORM][l * 256 + h * 64 + vc])); }
        __syncthreads();
    }
}
__device__ __forceinline__ void ph_select(LAS unsigned char* lds) {
    TIDX;
    const float* SC = WS(float, WS_SC); unsigned* MASK = WS(unsigned, WS_MASK);
    LAS unsigned* hist = (LAS unsigned*)lds + wave * 256;
    const unsigned long long lt_mask = (1ull << lane) - 1ull;
    for (int tok = gw; tok < T; tok += ngw) {
        const int tl = tok % SEQ;
        if (tl < 256) {
            const int lo = 32 * lane; unsigned w;
            if (lo + 31 <= tl) w = 0xffffffffu; else if (lo > tl) w = 0u; else w = (2u << (tl - lo)) - 1u;
            MASK[(size_t)tok * 64 + lane] = w; continue;
        }
        unsigned key[32]; unsigned vbits = 0u;
#pragma unroll
        for (int i = 0; i < 32; ++i) { const int s = 64 * i + lane; const bool valid = s <= tl;
            const unsigned u = valid ? __float_as_uint(SC[(size_t)tok * SEQ + s]) : 0u;
            key[i] = valid ? ((u >> 31) ? ~u : (u | 0x80000000u)) : 0u; vbits |= valid ? (1u << i) : 0u; }
        unsigned prefix = 0u; int need = 256;
#pragma unroll
        for (int pass = 0; pass < 4; ++pass) {
            const int shift = 24 - 8 * pass;
            hist[4 * lane + 0] = 0u; hist[4 * lane + 1] = 0u; hist[4 * lane + 2] = 0u; hist[4 * lane + 3] = 0u;
            LDS_WAIT(); asm volatile("" ::: "memory");
#pragma unroll
            for (int i = 0; i < 32; ++i) { const bool in = ((vbits >> i) & 1u) && (pass == 0 || (key[i] >> (shift + 8)) == prefix);
                if (in) (void)__hip_atomic_fetch_add(&hist[(key[i] >> shift) & 255u], 1u, __ATOMIC_RELAXED, __HIP_MEMORY_SCOPE_WORKGROUP); }
            LDS_WAIT(); asm volatile("" ::: "memory");
            const unsigned c0 = hist[4 * lane], c1 = hist[4 * lane + 1], c2 = hist[4 * lane + 2], c3 = hist[4 * lane + 3];
            LDS_WAIT(); asm volatile("" ::: "memory");
            const int tot = (int)(c0 + c1 + c2 + c3);
            int incl = tot;
#pragma unroll
            for (int o = 1; o < 64; o <<= 1) { const int t_ = __shfl_down(incl, o); if (lane + o < 64) incl += t_; }
            int cum = incl - tot;
            int fv = -1, fneed = 0;
            { const int cc[4] = {(int)c0, (int)c1, (int)c2, (int)c3};
#pragma unroll
              for (int j = 3; j >= 0; --j) { if (fv < 0 && cum < need && cum + cc[j] >= need) { fv = 4 * lane + j; fneed = need - cum; } cum += cc[j]; } }
            const unsigned long long fm = __ballot(fv >= 0);
            const int src = fm ? (int)__builtin_ctzll(fm) : 0;
            const int v = __shfl(fv, src); need = __shfl(fneed, src);
            prefix = (prefix << 8) | (unsigned)(v & 255);
        }
        unsigned myw = 0u; int cbefore = 0;
#pragma unroll
        for (int i = 0; i < 32; ++i) {
            const bool vld = (vbits >> i) & 1u; const bool eq = vld && key[i] == prefix, gt = vld && key[i] > prefix;
            const unsigned long long em = __ballot(eq);
            const int rank = cbefore + __popcll(em & lt_mask);
            const bool sel = gt || (eq && rank < need);
            cbefore += __popcll(em);
            const unsigned long long bm = __ballot(sel);
            if (lane == 2 * i) myw = (unsigned)bm;
            if (lane == 2 * i + 1) myw = (unsigned)(bm >> 32);
        }
        MASK[(size_t)tok * 64 + lane] = myw;
    }
}
__device__ __forceinline__ void ph_row1(int l) {
    TIDX;
    const float* xin = (l == 0) ? A->in[I_X] : WS(float, WS_XB); float* XB = WS(float, WS_XB);
    const bf16* Y = WS(bf16, WS_Y); bf16* U = WS(bf16, WS_U);
    const float* RWT = WS(float, WS_RWT) + (size_t)l * NEXP * D;
    unsigned* cnt = WS(unsigned, WS_CTL) + CW_CNT + l * NEXP; unsigned* TOK = WS(unsigned, WS_TOK);
    const float* lg = A->in[I_LN1G] + l * D; const float* lb = A->in[I_LN1B] + l * D;
    const float* rbp = A->in[I_RB] + l * NEXP;
    for (int tok = gw; tok < T; tok += ngw) {
        const int b = tok / SEQ; const float* mod = WS(float, WS_MOD) + ((size_t)l * NB + b) * 6144;
        f32x4 v[4]; float s = 0.f;
#pragma unroll
        for (int j = 0; j < 4; ++j) { const int c = 4 * lane + 256 * j;
            const f32x4 x = *(const GAS f32x4*)(xin + (size_t)tok * D + c); const f32x4 g1 = *(const f32x4*)(mod + 2048 + c);
            const unsigned long long yr = *(const GAS unsigned long long*)(Y + (size_t)tok * D + c);
            f32x4 y; y.x = __uint_as_float((unsigned)yr << 16); y.y = __uint_as_float((unsigned)yr & 0xffff0000u); y.z = __uint_as_float((unsigned)(yr >> 32) << 16); y.w = __uint_as_float((unsigned)(yr >> 32) & 0xffff0000u);
            v[j] = x * DN_ALPHA + (1.0f + g1) * y; s += (v[j].x + v[j].y) + (v[j].z + v[j].w); }
        const float mean = wave_sum(s) * (1.0f / D); float s2 = 0.f;
#pragma unroll
        for (int j = 0; j < 4; ++j) { v[j] = v[j] - mean; s2 += (v[j].x * v[j].x + v[j].y * v[j].y) + (v[j].z * v[j].z + v[j].w * v[j].w); }
        const float rstd = 1.0f / sqrtf(wave_sum(s2) * (1.0f / D) + LN_EPS);
        f32x4 u2[4];
#pragma unroll
        for (int j = 0; j < 4; ++j) { const int c = 4 * lane + 256 * j;
            const f32x4 xn = v[j] * rstd * *(const f32x4*)(lg + c) + *(const f32x4*)(lb + c);
            *(GAS f32x4*)(XB + (size_t)tok * D + c) = xn;
            u2[j] = xn * (1.0f + *(const f32x4*)(mod + 4096 + c)) + *(const f32x4*)(mod + 3072 + c);
            *(GAS unsigned long long*)(U + (size_t)tok * D + c) = (unsigned long long)pk2(u2[j].x, u2[j].y) | ((unsigned long long)pk2(u2[j].z, u2[j].w) << 32); }
        float tv[4] = {-INFINITY, -INFINITY, -INFINITY, -INFINITY}; int te[4] = {0, 0, 0, 0};
#pragma unroll 1
        for (int e = 0; e < NEXP; ++e) {
            const float* w = RWT + (size_t)e * D + 4 * lane; float a = 0.f;
#pragma unroll
            for (int j = 0; j < 4; ++j) { const f32x4 w4 = *(const f32x4*)(w + 256 * j); a += (u2[j].x * w4.x + u2[j].y * w4.y) + (u2[j].z * w4.z + u2[j].w * w4.w); }
            a = wave_sum(a) + rbp[e];
            if (a > tv[0]) { tv[3] = tv[2]; te[3] = te[2]; tv[2] = tv[1]; te[2] = te[1]; tv[1] = tv[0]; te[1] = te[0]; tv[0] = a; te[0] = e; }
            else if (a > tv[1]) { tv[3] = tv[2]; te[3] = te[2]; tv[2] = tv[1]; te[2] = te[1]; tv[1] = a; te[1] = e; }
            else if (a > tv[2]) { tv[3] = tv[2]; te[3] = te[2]; tv[2] = a; te[2] = e; }
            else if (a > tv[3]) { tv[3] = a; te[3] = e; }
        }
        const float e1 = __expf(tv[1] - tv[0]), e2 = __expf(tv[2] - tv[0]), e3 = __expf(tv[3] - tv[0]); const float inv = 1.0f / (1.0f + e1 + e2 + e3);
        if (lane < 4) { const int ek = lane == 0 ? te[0] : lane == 1 ? te[1] : lane == 2 ? te[2] : te[3]; const float pk = (lane == 0 ? 1.0f : lane == 1 ? e1 : lane == 2 ? e2 : e3) * inv;
            const unsigned pos = __hip_atomic_fetch_add(cnt + ek, 1u, __ATOMIC_RELAXED, __HIP_MEMORY_SCOPE_AGENT);
            *(GAS v4u*)(TOK + ((size_t)tok * 4 + lane) * 4) = (v4u){(unsigned)ek, pos, __float_as_uint(pk), 0u}; }
    }
}
__device__ __forceinline__ int moe_tables(LAS unsigned char* lds, int l) {
    CArgs* A = kargs();
    LAS unsigned* base = (LAS unsigned*)(lds + TAB_OFF); LAS unsigned char* tile_e = lds + TAB_OFF + 256;
    const unsigned* cnt = WS(unsigned, WS_CTL) + CW_CNT + l * NEXP;
    if (threadIdx.x == 0) { unsigned acc = 0u;
#pragma unroll 1
        for (int e = 0; e < NEXP; ++e) { const unsigned c = __hip_atomic_load(cnt + e, __ATOMIC_RELAXED, __HIP_MEMORY_SCOPE_AGENT); const unsigned nt = (c + 255u) >> 8; base[e] = acc;
#pragma unroll 1
            for (unsigned t = 0; t < nt; ++t) tile_e[(acc >> 8) + t] = (unsigned char)e; acc += nt << 8; }
        base[NEXP] = acc; }
    __syncthreads();
    return (int)(base[NEXP] >> 8);
}
__device__ __forceinline__ void ph_gather(LAS unsigned char* lds, int l) {
    TIDX;
    (void)moe_tables(lds, l);
    const LAS unsigned* base = (const LAS unsigned*)(lds + TAB_OFF);
    const unsigned* TOK = WS(unsigned, WS_TOK); const bf16* U = WS(bf16, WS_U); bf16* XG = WS(bf16, WS_XG);
    for (int task = gw; task < T * 4; task += ngw) {
        const v4u ti = *(const GAS v4u*)(TOK + (size_t)task * 4); const size_t row = (size_t)base[ti.x] + ti.y;
        const GAS v4u* src = (const GAS v4u*)(U + (size_t)(task >> 2) * D) + lane; GAS v4u* dst = (GAS v4u*)(XG + row * D) + lane;
        dst[0] = src[0]; dst[64] = src[64];
    }
    __syncthreads();
}
__device__ __forceinline__ void ph_row2(LAS unsigned char* lds, int l) {
    TIDX;
    (void)moe_tables(lds, l);
    const LAS unsigned* base = (const LAS unsigned*)(lds + TAB_OFF);
    float* XB = WS(float, WS_XB); const bf16* YM = WS(bf16, WS_YM); bf16* U = WS(bf16, WS_U); const unsigned* TOK = WS(unsigned, WS_TOK);
    const float* lg = A->in[I_LN2G] + l * D; const float* lb = A->in[I_LN2B] + l * D; const float* b2 = A->in[I_B2] + (size_t)l * NEXP * D;
    float* dst = (l == DEPTH - 1) ? A->out : XB;
    for (int tok = gw; tok < T; tok += ngw) {
        const int b = tok / SEQ; const float* mod = WS(float, WS_MOD) + ((size_t)l * NB + b) * 6144;
        f32x4 acc[4];
#pragma unroll
        for (int j = 0; j < 4; ++j) acc[j] = (f32x4){0.f, 0.f, 0.f, 0.f};
#pragma unroll
        for (int k = 0; k < 4; ++k) { const v4u ti = *(const GAS v4u*)(TOK + ((size_t)tok * 4 + k) * 4); const size_t row = (size_t)base[ti.x] + ti.y; const float p = __uint_as_float(ti.z);
#pragma unroll
            for (int j = 0; j < 4; ++j) { const int c = 4 * lane + 256 * j; const unsigned long long yr = *(const GAS unsigned long long*)(YM + row * D + c);
                f32x4 y; y.x = __uint_as_float((unsigned)yr << 16); y.y = __uint_as_float((unsigned)yr & 0xffff0000u); y.z = __uint_as_float((unsigned)(yr >> 32) << 16); y.w = __uint_as_float((unsigned)(yr >> 32) & 0xffff0000u);
                acc[j] = acc[j] + p * (y + *(const f32x4*)(b2 + (size_t)ti.x * D + c)); } }
        f32x4 v[4]; float s = 0.f;
#pragma unroll
        for (int j = 0; j < 4; ++j) { const int c = 4 * lane + 256 * j; const f32x4 x = *(const GAS f32x4*)(XB + (size_t)tok * D + c);
            v[j] = x * DN_ALPHA + (1.0f + *(const f32x4*)(mod + 5120 + c)) * acc[j]; s += (v[j].x + v[j].y) + (v[j].z + v[j].w); }
        const float mean = wave_sum(s) * (1.0f / D); float s2 = 0.f;
#pragma unroll
        for (int j = 0; j < 4; ++j) { v[j] = v[j] - mean; s2 += (v[j].x * v[j].x + v[j].y * v[j].y) + (v[j].z * v[j].z + v[j].w * v[j].w); }
        const float rstd = 1.0f / sqrtf(wave_sum(s2) * (1.0f / D) + LN_EPS);
        const float* modn = WS(float, WS_MOD) + ((size_t)(l + 1 < DEPTH ? l + 1 : l) * NB + b) * 6144;
#pragma unroll
        for (int j = 0; j < 4; ++j) { const int c = 4 * lane + 256 * j;
            const f32x4 xn = v[j] * rstd * *(const f32x4*)(lg + c) + *(const f32x4*)(lb + c);
            *(GAS f32x4*)(dst + (size_t)tok * D + c) = xn;
            if (l + 1 < DEPTH) { const f32x4 u = xn * (1.0f + *(const f32x4*)(modn + 1024 + c)) + *(const f32x4*)(modn + c);
                *(GAS unsigned long long*)(U + (size_t)tok * D + c) = (unsigned long long)pk2(u.x, u.y) | ((unsigned long long)pk2(u.z, u.w) << 32); } }
    }
    __syncthreads();
}
__global__ void __launch_bounds__(NWAVES * 64, 2) mega_fwd(Args A_) {
    extern __shared__ __attribute__((aligned(16))) unsigned char lds_raw[];
    LAS unsigned char* lds = (LAS unsigned char*)lds_raw;
    const int tid = threadIdx.x;
    volatile LAS unsigned* MISC = (volatile LAS unsigned*)(lds + MISC_OFF);
    for (int u = tid; u < (LDS_BYTES - TAB_OFF) / 4; u += NWAVES * 64) ((LAS unsigned*)(lds + TAB_OFF))[u] = 0u;
    __syncthreads();
    CArgs* A = kargs(); const bool multi = (A->s_hi - A->s_lo) > 1;
    XcdBarrier bar; bar.bar = WS(unsigned, WS_CTL) + CW_BAR + A->li * XCD_BAR_WORDS; bar.x = 0; bar.st = MISC + 8;
    if (multi) bar = xcd_barrier_post(WS(unsigned, WS_CTL) + CW_BAR + A->li * XCD_BAR_WORDS, MISC + 8);
    const int lo = A->s_lo, hi = A->s_hi;
#ifndef PHMASK
#define PHMASK 0xffffffffu
#endif
#define PHM(b) (((PHMASK) >> (b)) & 1u)
#define RUN(s) (lo <= (s) && (s) < hi)
#define SEAM(s) do { if ((s) + 1 < hi) xcd_barrier(bar); } while (0)
    if (RUN(0)) { if (PHM(0)) pro_a(lds_launder(lds)); SEAM(0); }
    if (RUN(1)) { if (PHM(1)) pro_b(); SEAM(1); }
    for (int l = 0; l < DEPTH; ++l) {
        const int sb = 2 + NPH * l;
        if (RUN(sb + PH_IN)) { CArgs* A = kargs();
            pg8::Gemm g{WS(bf16, WS_U), WS(bf16, WS_WIN) + (size_t)l * NHC * D, T, NHC, D}; pg8::StaticOrder S; S.init(T, NHC, (int)gridDim.x, (int)blockIdx.x);
            pg8::EpiIn E{WS(bf16, WS_H), WS(float, WS_CS)};
            if (PHM(2)) pg8::gemm_phase<pg8::EpiIn, pg8::StaticOrder, true, true>(lds_launder(lds), g, S, E);
            SEAM(sb + PH_IN);
        }
        if (RUN(sb + PH_POST)) { if (PHM(3)) ph_post(l); SEAM(sb + PH_POST); }
        if (RUN(sb + PH_MIXA)) { if (PHM(4)) ph_idx_scores(); if (PHM(5)) ph_mlstm_m1(lds_launder(lds), l); if (PHM(6)) ph_diff_attn(lds_launder(lds)); SEAM(sb + PH_MIXA); }
        if (RUN(sb + PH_SEL)) { if (PHM(5)) ph_mlstm_m2(); if (PHM(7)) ph_select(lds_launder(lds)); SEAM(sb + PH_SEL); }
        if (RUN(sb + PH_DSA)) { if (PHM(5)) ph_mlstm_m3(lds_launder(lds), l); if (PHM(8)) { ph_diff_post(l); ph_dsa_attn(lds_launder(lds)); } SEAM(sb + PH_DSA); }
        if (RUN(sb + PH_OUT)) { CArgs* A = kargs();
            pg8::Gemm g{WS(bf16, WS_MIX), WS(bf16, WS_WOUT) + (size_t)l * D * D, T, D, D}; pg8::StaticOrder S; S.init(T, D, (int)gridDim.x, (int)blockIdx.x);
            pg8::EpiBf16<0> E{WS(bf16, WS_Y), D, nullptr, 0, 0, 1.f};
            if (PHM(9)) pg8::gemm_phase<pg8::EpiBf16<0>, pg8::StaticOrder, true, true>(lds_launder(lds), g, S, E);
            SEAM(sb + PH_OUT);
        }
        if (RUN(sb + PH_ROW1)) { if (PHM(10)) ph_row1(l); SEAM(sb + PH_ROW1); }
        if (RUN(sb + PH_GATH)) { if (PHM(11)) ph_gather(lds_launder(lds), l); SEAM(sb + PH_GATH); }
        if (RUN(sb + PH_G1)) { CArgs* A = kargs();
            const int nrt = moe_tables(lds_launder(lds), l);
            pg8::Gemm g{WS(bf16, WS_XG), WS(bf16, WS_W1) + (size_t)l * NEXP * 2048 * D, RPAD, NEXP * 2048, D}; pg8::MoeOrder S; S.init(nrt, 8, (int)gridDim.x, (int)blockIdx.x, (const LAS unsigned char*)(lds_launder(lds) + TAB_OFF + 256));
            pg8::EpiSwiGLU E{WS(bf16, WS_HM), A->in[I_B1] + (size_t)l * NEXP * 2048};
            if (PHM(12)) pg8::gemm_phase<pg8::EpiSwiGLU, pg8::MoeOrder, true, true>(lds_launder(lds), g, S, E);
            SEAM(sb + PH_G1);
        }
        if (RUN(sb + PH_G2)) { CArgs* A = kargs();
            const int nrt = moe_tables(lds_launder(lds), l);
            pg8::Gemm g{WS(bf16, WS_HM), WS(bf16, WS_W2) + (size_t)l * NEXP * D * D, RPAD, NEXP * D, D}; pg8::MoeOrder S; S.init(nrt, 4, (int)gridDim.x, (int)blockIdx.x, (const LAS unsigned char*)(lds_launder(lds) + TAB_OFF + 256));
            pg8::EpiBf16<0> E{WS(bf16, WS_YM), D, nullptr, D, 0, 1.f};
            if (PHM(13)) pg8::gemm_phase<pg8::EpiBf16<0>, pg8::MoeOrder, true, true>(lds_launder(lds), g, S, E);
            SEAM(sb + PH_G2);
        }
        if (RUN(sb + PH_ROW2)) { if (PHM(14)) ph_row2(lds_launder(lds), l); SEAM(sb + PH_ROW2); }
    }
#undef RUN
#undef SEAM
}

#ifndef MK_STEPS_PER_LAUNCH
#define MK_STEPS_PER_LAUNCH 1000
#endif
extern "C" void kernel_launch(void* const* d_in, const int* in_sizes, int n_in, void* d_out, int out_size, void* d_ws, size_t ws_size, hipStream_t stream) {
    static int grid = 0;
    if (grid == 0) {
        if (n_in != 25 || out_size != T * D || ws_size < WS_END3) { fprintf(stderr, "kernel_launch: unexpected shapes (n_in %d out %d ws %zu)\n", n_in, out_size, ws_size); grid = -1; return; }
        int dev = 0, cus = 0, per_cu = 0;
        if (hipGetDevice(&dev) != hipSuccess || hipDeviceGetAttribute(&cus, hipDeviceAttributeMultiprocessorCount, dev) != hipSuccess) { grid = -1; return; }
        if (hipFuncSetAttribute((const void*)mega_fwd, hipFuncAttributeMaxDynamicSharedMemorySize, LDS_BYTES) != hipSuccess) { fprintf(stderr, "kernel_launch: hipFuncSetAttribute failed\n"); grid = -1; return; }
        if (hipOccupancyMaxActiveBlocksPerMultiprocessor(&per_cu, (const void*)mega_fwd, NWAVES * 64, LDS_BYTES) != hipSuccess || per_cu < 1) { fprintf(stderr, "kernel_launch: occupancy query says %d\n", per_cu); }
        (void)hipGetLastError();
        grid = cus;
    }
    if (grid < 0) return;
    if (hipMemsetAsync((char*)d_ws + WS_CTL, 0, CTL_ZERO_BYTES, stream) != hipSuccess) return;
    Args a{};
    for (int i = 0; i < 25; ++i) a.in[i] = (const float*)d_in[i];
    a.out = (float*)d_out; a.ws = (unsigned char*)d_ws;
    int li = 0;
    for (int s = 0; s < NSTEPS; s += MK_STEPS_PER_LAUNCH, ++li) {
        a.s_lo = s; a.s_hi = (s + MK_STEPS_PER_LAUNCH < NSTEPS) ? s + MK_STEPS_PER_LAUNCH : NSTEPS; a.li = li; a.pad = 0;
        hipLaunchKernelGGL(mega_fwd, dim3(grid), dim3(NWAVES * 64), LDS_BYTES, stream, a);
    }
}
```

```cpp
#include <hip/hip_runtime.h>
#include <cstdio>
#include <cstdint>

namespace pg8 {
#define PG8_LAS __attribute__((address_space(3)))
typedef unsigned short bf16_t;
typedef short bf16x8 __attribute__((ext_vector_type(8)));
typedef float f32x4 __attribute__((ext_vector_type(4)));
typedef unsigned u32x4 __attribute__((ext_vector_type(4)));
constexpr int BM = 256, BK = 64, HALF = 128, HTB = HALF * BK * 2  , STAGE_BYTES = 8 * HTB, NXCD = 8, WGM = 8;

__host__ __device__ __forceinline__ int lds_byte(int r, int c) { const int st = (r >> 4) * 2 + (c >> 5), rr = r & 15, cc = c & 31, ob = rr * 64 + cc * 2; return st * 1024 + (ob ^ (((ob >> 9) & 1) << 5)); }
__host__ __device__ __forceinline__ void stage_rc(int b, int& R, int& C) { const int st = b / 1024, sb = b % 1024, swz = sb ^ (((sb >> 9) & 1) << 5); R = (st >> 1) * 16 + swz / 64; C = (st & 1) * 32 + (swz % 64) / 2; }
__host__ __device__ __forceinline__ int perm32(int rho) { const int n = rho >> 4, i = rho & 15; return 8 * (i >> 2) + 4 * n + (i & 3); }

struct Unit { int pm, pn; };
struct Gemm { const bf16_t* A; const bf16_t* Bt; int M, N, K; };

struct StaticOrder {
    int nM, nN, nwg, G, c;
    __host__ __device__ void init(int M, int N, int G_, int c_) { nM = M / BM; nN = N / BM; nwg = nM * nN; G = G_; c = c_; }
    __host__ __device__ bool next(int i, Unit& u) const {
        const long L = (long)i * G + c; if (L >= nwg) return false;
        int wgid = (int)L; { const int q = nwg / NXCD, r = nwg % NXCD, xcd = wgid % NXCD, off = wgid / NXCD; wgid = (xcd < r ? xcd * (q + 1) : r * (q + 1) + (xcd - r) * q) + off; }
        const int nig = WGM * nN, gid = wgid / nig, fm = gid * WGM, gsz = (nM - fm) < WGM ? (nM - fm) : WGM;
        u.pm = fm + ((wgid % nig) % gsz); u.pn = (wgid % nig) / gsz; return true;
    }
    __device__ __forceinline__ void a_ready(const Unit&) const {}
    __device__ __forceinline__ void done(const Unit&) const {}
};
struct MoeOrder {
    int nM, nN, nwg, G, c; const PG8_LAS unsigned char* tile_e;
    __device__ void init(int nRT, int NTN, int G_, int c_, const PG8_LAS unsigned char* te) { nM = nRT; nN = NTN; nwg = nM * nN; G = G_; c = c_; tile_e = te; }
    __device__ bool next(int i, Unit& u) const {
        const long L = (long)i * G + c; if (L >= nwg) return false;
        int wgid = (int)L; { const int q = nwg / NXCD, r = nwg % NXCD, xcd = wgid % NXCD, off = wgid / NXCD; wgid = (xcd < r ? xcd * (q + 1) : r * (q + 1) + (xcd - r) * q) + off; }
        const int nig = WGM * nN, gid = wgid / nig, fm = gid * WGM, gsz = (nM - fm) < WGM ? (nM - fm) : WGM;
        u.pm = fm + ((wgid % nig) % gsz); const int pl = (wgid % nig) / gsz; u.pn = (int)tile_e[u.pm] * nN + pl; return true;
    }
    __device__ __forceinline__ void a_ready(const Unit&) const {}
    __device__ __forceinline__ void done(const Unit&) const {}
};
__device__ __forceinline__ unsigned cvt_pk_bf16(float lo, float hi) { unsigned r; asm volatile("v_cvt_pk_bf16_f32 %0, %1, %2" : "=v"(r) : "v"(lo), "v"(hi)); return r; }
typedef float f32x2 __attribute__((ext_vector_type(2)));
__device__ __forceinline__ f32x2 gelu_pk(f32x2 v) {
    const f32x2 av = __builtin_elementwise_abs(v), d = av * 0.2316418882f + 1.0f;
    f32x2 t; t.x = __builtin_amdgcn_rcpf(d.x); t.y = __builtin_amdgcn_rcpf(d.y);
    f32x2 q = t * 0.5307027145f + (-0.7265760135f); q = q * t + 0.7107068705f; q = q * t + (-0.142248368f); q = q * t + 0.127414796f; q = q * t;
    const f32x2 s = (v * v) * (-0.72134752044f);
    f32x2 e; e.x = __builtin_amdgcn_exp2f(s.x); e.y = __builtin_amdgcn_exp2f(s.y);
    const f32x2 m = v * (q * e), r = v - m;
    f32x2 o; o.x = v.x < 0.f ? m.x : r.x; o.y = v.y < 0.f ? m.y : r.y; return o;
}

template <int ACT  > struct EpiBf16 {
    static constexpr bool PERM = true, AFTER_DRAIN = false; static_assert(ACT == 0 || ACT == 1, "EpiBf16: ACT is 0 (none) or 1 (gelu_pk)");
    bf16_t* O; int ldc; const float* bias; int split_cols; size_t split_stride; float scale0;
    __device__ __forceinline__ void operator()(const f32x4 (&acc)[2][2][4][2], const Unit& u, int wr, int wc, int fr, int fq) const {
        const int row0 = u.pm * BM + wr * 64 + fr; int colt = u.pn * BM; bf16_t* base = O;
        float sc = 1.f; if (split_cols) { const int t = colt / split_cols; base += (size_t)t * split_stride; colt -= t * split_cols; if (t == 0) sc = scale0; }
        const int col0 = colt + wc * 32 + 8 * fq, bcol0 = u.pn * BM + wc * 32 + 8 * fq;
        f32x4 bv[2][2];
#pragma unroll
        for (int bj = 0; bj < 2; ++bj)
#pragma unroll
            for (int n = 0; n < 2; ++n) bv[bj][n] = bias ? *(const f32x4*)(bias + bcol0 + bj * HALF + 4 * n) : (f32x4){0.f, 0.f, 0.f, 0.f};
#pragma unroll
        for (int ai = 0; ai < 2; ++ai)
#pragma unroll
            for (int m = 0; m < 4; ++m) { bf16_t* rowp = base + (size_t)(row0 + ai * HALF + m * 16) * ldc + col0;
#pragma unroll
                for (int bj = 0; bj < 2; ++bj) { f32x4 v0 = acc[ai][bj][m][0] + bv[bj][0], v1 = acc[ai][bj][m][1] + bv[bj][1];
                    if (ACT == 1) { f32x2 a = gelu_pk((f32x2){v0[0], v0[1]}), b = gelu_pk((f32x2){v0[2], v0[3]}), c = gelu_pk((f32x2){v1[0], v1[1]}), d = gelu_pk((f32x2){v1[2], v1[3]});
                        v0 = (f32x4){a.x, a.y, b.x, b.y}; v1 = (f32x4){c.x, c.y, d.x, d.y}; }
                    v0 = v0 * sc; v1 = v1 * sc; u32x4 w; w.x = cvt_pk_bf16(v0[0], v0[1]); w.y = cvt_pk_bf16(v0[2], v0[3]); w.z = cvt_pk_bf16(v1[0], v1[1]); w.w = cvt_pk_bf16(v1[2], v1[3]);
                    *(u32x4*)(rowp + bj * HALF) = w; } }
    }
};
constexpr float C2 = 0.125f * 1.4426950408889634f;
struct EpiIn {
    static constexpr bool PERM = true, AFTER_DRAIN = false;
    bf16_t* O; const float* cs;
    __device__ __forceinline__ void operator()(const f32x4 (&acc)[2][2][4][2], const Unit& u, int wr, int wc, int fr, int fq) const {
        const int pn = u.pn;
        const bool rope = (0x6CF0 >> pn) & 1;
        const float sc = ((0x0430 >> pn) & 1) ? C2 : 1.f;
        const int row0 = u.pm * BM + wr * 64 + fr, col0 = pn * BM + wc * 32 + 8 * fq, i0 = (wc & 1) * 16 + 4 * fq;
#pragma unroll
        for (int ai = 0; ai < 2; ++ai)
#pragma unroll
            for (int m = 0; m < 4; ++m) {
                const int row = row0 + ai * HALF + m * 16;
                f32x4 c01 = (f32x4){1.f, 0.f, 1.f, 0.f}, c23 = c01;
                if (rope) { c01 = *(const f32x4*)(cs + (size_t)row * 64 + i0 * 2); c23 = *(const f32x4*)(cs + (size_t)row * 64 + i0 * 2 + 4); }
                bf16_t* rowp = O + (size_t)row * 4096 + col0;
#pragma unroll
                for (int bj = 0; bj < 2; ++bj) {
                    f32x4 v0 = acc[ai][bj][m][0], v1 = acc[ai][bj][m][1];
                    if (rope) {
                        f32x4 r0, r1;
                        r0[0] = v0[0] * c01[0] - v0[1] * c01[1]; r0[1] = v0[1] * c01[0] + v0[0] * c01[1];
                        r0[2] = v0[2] * c01[2] - v0[3] * c01[3]; r0[3] = v0[3] * c01[2] + v0[2] * c01[3];
                        r1[0] = v1[0] * c23[0] - v1[1] * c23[1]; r1[1] = v1[1] * c23[0] + v1[0] * c23[1];
                        r1[2] = v1[2] * c23[2] - v1[3] * c23[3]; r1[3] = v1[3] * c23[2] + v1[2] * c23[3];
                        v0 = r0; v1 = r1;
                    }
                    v0 = v0 * sc; v1 = v1 * sc;
                    u32x4 w; w.x = cvt_pk_bf16(v0[0], v0[1]); w.y = cvt_pk_bf16(v0[2], v0[3]); w.z = cvt_pk_bf16(v1[0], v1[1]); w.w = cvt_pk_bf16(v1[2], v1[3]);
                    *(u32x4*)(rowp + bj * HALF) = w;
                }
            }
    }
};
struct EpiSwiGLU {
    static constexpr bool PERM = true, AFTER_DRAIN = false;
    bf16_t* O; const float* b1;
    __device__ __forceinline__ void operator()(const f32x4 (&acc)[2][2][4][2], const Unit& u, int wr, int wc, int fr, int fq) const {
        const int e = u.pn >> 3, pl = u.pn & 7, colh = pl * 128 + wc * 32 + 8 * fq;
        const float* bp = b1 + (size_t)e * 2048 + colh;
        f32x4 bg[2], bu[2];
#pragma unroll
        for (int n = 0; n < 2; ++n) { bg[n] = *(const f32x4*)(bp + 4 * n); bu[n] = *(const f32x4*)(bp + 1024 + 4 * n); }
        const int row0 = u.pm * BM + wr * 64 + fr;
#pragma unroll
        for (int ai = 0; ai < 2; ++ai)
#pragma unroll
            for (int m = 0; m < 4; ++m) {
                f32x4 o[2];
#pragma unroll
                for (int n = 0; n < 2; ++n) {
                    const f32x4 g4 = acc[ai][0][m][n] + bg[n], u4 = acc[ai][1][m][n] + bu[n];
#pragma unroll
                    for (int c = 0; c < 4; ++c) {
                        const float g = fminf(g4[c], 7.0f), up = fminf(fmaxf(u4[c], -7.0f), 7.0f);
                        const float sg = __builtin_amdgcn_rcpf(1.0f + __builtin_amdgcn_exp2f(-1.702f * 1.4426950408889634f * g));
                        o[n][c] = (up + 1.0f) * (g * sg);
                    }
                }
                u32x4 w; w.x = cvt_pk_bf16(o[0][0], o[0][1]); w.y = cvt_pk_bf16(o[0][2], o[0][3]); w.z = cvt_pk_bf16(o[1][0], o[1][1]); w.w = cvt_pk_bf16(o[1][2], o[1][3]);
                *(u32x4*)(O + (size_t)(row0 + ai * HALF + m * 16) * 1024 + colh) = w;
            }
    }
};
template <class Epi, class Sched, bool ALIGN_EPI = false, bool SP2 = false>
__device__ __forceinline__ void gemm_phase(PG8_LAS unsigned char* lds, const Gemm g, const Sched& S, const Epi& E) {
    int tid_ = threadIdx.x; asm volatile("" : "+v"(tid_));
    const int tid = tid_, wid = __builtin_amdgcn_readfirstlane(tid >> 6), lane = tid & 63, wr = wid >> 2, wc = wid & 3, fr = lane & 15, fq = lane >> 4;
    const int K = g.K, nt = K / BK;
    unsigned voffA[2], voffB[2];
#pragma unroll
    for (int i = 0; i < 2; ++i) { int R, C; stage_rc(tid * 16 + i * 8192, R, C); const int Rb = Epi::PERM ? ((R & ~31) + perm32(R & 31)) : R;
        voffA[i] = (unsigned)(R * K + C) * 2u; voffB[i] = (unsigned)(Rb * K + C) * 2u; }
    const size_t kstep = (size_t)(BK * 2);
    const size_t hstep = (size_t)HALF * K * 2;
    const size_t tstep = 2 * hstep;
    const unsigned ldsw = (unsigned)wid * 1024u;
    const int aoff = lds_byte(wr * 64 + fr, fq * 8), boff = lds_byte(wc * 32 + fr, fq * 8);
#define PG8_SA(b, h) (((b) * 2 + (h)) * HTB)
#define PG8_SB(b, h) ((4 + (b) * 2 + (h)) * HTB)
#define PG8_STAGE(bufoff, gbase, voff) do { _Pragma("unroll") for (int _i = 0; _i < 2; ++_i) \
        __builtin_amdgcn_global_load_lds((const unsigned*)((const char*)(gbase) + (voff)[_i]), (PG8_LAS unsigned*)(lds + (bufoff) + ldsw + _i * 8192), 16, 0, 0); } while (0)
#define PG8_LDA(dst, b, h) do { _Pragma("unroll") for (int m = 0; m < 4; ++m) _Pragma("unroll") for (int k = 0; k < 2; ++k) dst[m][k] = *(const PG8_LAS bf16x8*)(lds + PG8_SA(b, h) + aoff + m * 2048 + k * 1024); } while (0)
#define PG8_LDB(dst, b, h) do { _Pragma("unroll") for (int n = 0; n < 2; ++n) _Pragma("unroll") for (int k = 0; k < 2; ++k) dst[n][k] = *(const PG8_LAS bf16x8*)(lds + PG8_SB(b, h) + boff + n * 2048 + k * 1024); } while (0)
#define PG8_MMA(ai, bj, At, Bt) do { __builtin_amdgcn_s_setprio(1); _Pragma("unroll") for (int m = 0; m < 4; ++m) _Pragma("unroll") for (int n = 0; n < 2; ++n) _Pragma("unroll") for (int k = 0; k < 2; ++k) \
        acc[ai][bj][m][n] = __builtin_amdgcn_mfma_f32_16x16x32_bf16(Bt[n][k], At[m][k], acc[ai][bj][m][n], 0, 0, 0); __builtin_amdgcn_s_setprio(0); } while (0)
#define PG8_WAIT_V(n) asm volatile("s_waitcnt vmcnt(" #n ")" ::: "memory")
#define PG8_WAIT_L(n) asm volatile("s_waitcnt lgkmcnt(" #n ")" ::: "memory")
#define PG8_BAR __builtin_amdgcn_s_barrier()
#define PG8_SCHED __builtin_amdgcn_sched_barrier(0)
    Unit cur, nxt; int ui = 0;
    if (!S.next(0, cur)) return;
    f32x4 acc[2][2][4][2];
#pragma unroll
    for (int a = 0; a < 2; ++a)
#pragma unroll
        for (int b = 0; b < 2; ++b)
#pragma unroll
            for (int m = 0; m < 4; ++m)
#pragma unroll
                for (int n = 0; n < 2; ++n) acc[a][b][m][n] = (f32x4){0.f, 0.f, 0.f, 0.f};
    bf16x8 At[4][2], B0[2][2], B1[2][2];
    const char* cA = (const char*)g.A + (size_t)cur.pm * tstep; const char* cB = (const char*)g.Bt + (size_t)cur.pn * tstep;
    S.a_ready(cur);
    if constexpr (SP2) {
        PG8_STAGE(PG8_SB(0, 0), cB, voffB); PG8_STAGE(PG8_SB(0, 1), cB + hstep, voffB); PG8_STAGE(PG8_SA(0, 0), cA, voffA); PG8_STAGE(PG8_SA(0, 1), cA + hstep, voffA);
        if (wr == 1) PG8_BAR;
        PG8_WAIT_V(2); PG8_BAR;
        PG8_STAGE(PG8_SB(1, 0), cB + kstep, voffB); PG8_STAGE(PG8_SA(1, 0), cA + kstep, voffA); PG8_STAGE(PG8_SB(1, 1), cB + hstep + kstep, voffB);
        PG8_WAIT_V(6); PG8_BAR;
    } else {
        PG8_STAGE(PG8_SB(0, 0), cB, voffB); PG8_STAGE(PG8_SA(0, 0), cA, voffA); PG8_STAGE(PG8_SB(0, 1), cB + hstep, voffB); PG8_STAGE(PG8_SA(0, 1), cA + hstep, voffA);
        if (wr == 1) PG8_BAR;
        PG8_WAIT_V(4); PG8_BAR;
        PG8_STAGE(PG8_SB(1, 0), cB + kstep, voffB); PG8_STAGE(PG8_SA(1, 0), cA + kstep, voffA); PG8_STAGE(PG8_SB(1, 1), cB + hstep + kstep, voffB);
        PG8_WAIT_V(6); PG8_BAR;
    }
    for (;;) {
        const bool has_next = S.next(ui + 1, nxt);
        const char* nA = has_next ? (const char*)g.A + (size_t)nxt.pm * tstep : cA; const char* nB = has_next ? (const char*)g.Bt + (size_t)nxt.pn * tstep : cB;
        for (int t = 0; t < nt; t += 2) {
            const bool last = (t == nt - 2);
            const char* a1 = cA + (size_t)(t + 1) * kstep;
            const char* a2 = last ? nA : cA + (size_t)(t + 2) * kstep; const char* b2 = last ? nB : cB + (size_t)(t + 2) * kstep;
            const char* a3 = a2 + kstep; const char* b3 = b2 + kstep;
            if (last && has_next) S.a_ready(nxt);
            if constexpr (SP2) {
            PG8_LDB(B0, 0, 0); PG8_LDB(B1, 0, 1); PG8_SCHED; PG8_LDA(At, 0, 0); PG8_STAGE(PG8_SA(1, 1), a1 + hstep, voffA);
            PG8_WAIT_V(8); PG8_WAIT_L(0); PG8_BAR; PG8_MMA(0, 0, At, B0); PG8_MMA(0, 1, At, B1); PG8_BAR; PG8_SCHED;
            PG8_LDA(At, 0, 1); PG8_STAGE(PG8_SB(0, 0), b2, voffB); PG8_STAGE(PG8_SB(0, 1), b2 + hstep, voffB); PG8_STAGE(PG8_SA(0, 0), a2, voffA);
            PG8_WAIT_V(8); PG8_WAIT_L(0); PG8_BAR; PG8_MMA(1, 0, At, B0); PG8_MMA(1, 1, At, B1); PG8_BAR; PG8_SCHED;
            PG8_LDB(B0, 1, 0); PG8_LDB(B1, 1, 1); PG8_SCHED; PG8_LDA(At, 1, 0); PG8_STAGE(PG8_SA(0, 1), a2 + hstep, voffA);
            PG8_WAIT_V(8); PG8_WAIT_L(0); PG8_BAR; PG8_MMA(0, 0, At, B0); PG8_MMA(0, 1, At, B1); PG8_BAR; PG8_SCHED;
            PG8_LDA(At, 1, 1); PG8_STAGE(PG8_SB(1, 0), b3, voffB); PG8_STAGE(PG8_SB(1, 1), b3 + hstep, voffB); PG8_STAGE(PG8_SA(1, 0), a3, voffA);
            PG8_WAIT_V(8); PG8_WAIT_L(0); PG8_BAR; PG8_MMA(1, 0, At, B0); PG8_MMA(1, 1, At, B1); PG8_BAR; PG8_SCHED;
            } else {
            PG8_LDB(B0, 0, 0); PG8_SCHED; PG8_LDA(At, 0, 0); PG8_STAGE(PG8_SA(1, 1), a1 + hstep, voffA);
            PG8_WAIT_L(8); PG8_BAR; PG8_WAIT_L(0); PG8_MMA(0, 0, At, B0); PG8_BAR; PG8_SCHED;
            PG8_LDB(B1, 0, 1); PG8_STAGE(PG8_SB(0, 0), b2, voffB);
            PG8_BAR; PG8_WAIT_L(0); PG8_MMA(0, 1, At, B1); PG8_BAR;
            PG8_LDA(At, 0, 1); PG8_STAGE(PG8_SA(0, 0), a2, voffA);
            PG8_BAR; PG8_WAIT_L(0); PG8_MMA(1, 0, At, B0); PG8_BAR; PG8_SCHED;
            PG8_STAGE(PG8_SB(0, 1), b2 + hstep, voffB);
            PG8_WAIT_V(6); PG8_BAR; PG8_MMA(1, 1, At, B1); PG8_BAR;
            PG8_LDB(B0, 1, 0); PG8_SCHED; PG8_LDA(At, 1, 0); PG8_STAGE(PG8_SA(0, 1), a2 + hstep, voffA);
            PG8_WAIT_L(8); PG8_BAR; PG8_WAIT_L(0); PG8_MMA(0, 0, At, B0); PG8_BAR; PG8_SCHED;
            PG8_LDB(B1, 1, 1); PG8_STAGE(PG8_SB(1, 0), b3, voffB);
            PG8_BAR; PG8_WAIT_L(0); PG8_MMA(0, 1, At, B1); PG8_BAR;
            PG8_LDA(At, 1, 1); PG8_STAGE(PG8_SA(1, 0), a3, voffA);
            PG8_BAR; PG8_WAIT_L(0); PG8_MMA(1, 0, At, B0); PG8_BAR; PG8_SCHED;
            PG8_STAGE(PG8_SB(1, 1), b3 + hstep, voffB);
            PG8_WAIT_V(6); PG8_BAR; PG8_MMA(1, 1, At, B1); PG8_BAR;
            }
        }
        if constexpr (ALIGN_EPI) { if (wr == 0) PG8_BAR; }
        if constexpr (!Epi::AFTER_DRAIN) { E(acc, cur, wr, wc, fr, fq); S.done(cur); }
        if (!has_next) break;
#pragma unroll
        for (int a = 0; a < 2; ++a)
#pragma unroll
            for (int b = 0; b < 2; ++b)
#pragma unroll
                for (int m = 0; m < 4; ++m)
#pragma unroll
                    for (int n = 0; n < 2; ++n) acc[a][b][m][n] = (f32x4){0.f, 0.f, 0.f, 0.f};
        cur = nxt; cA = nA; cB = nB; ++ui;
        if constexpr (ALIGN_EPI) { if (wr == 1) PG8_BAR; }
    }
    PG8_WAIT_V(0);
    if constexpr (!ALIGN_EPI) { if (wr == 0) PG8_BAR; }
    PG8_BAR;
    if constexpr (Epi::AFTER_DRAIN) { E.fused(acc, cur, wr, wc, fr, fq, lds, wid, lane); S.done(cur); }
#undef PG8_SA
#undef PG8_SB
#undef PG8_STAGE
#undef PG8_LDA
#undef PG8_LDB
#undef PG8_MMA
#undef PG8_WAIT_V
#undef PG8_WAIT_L
#undef PG8_BAR
#undef PG8_SCHED
}
}
namespace attn_body {
using bf16=unsigned short;
using bf16x8=__attribute__((ext_vector_type(8)))short;
using s16x4=__attribute__((ext_vector_type(4)))short;
using f32x16=__attribute__((ext_vector_type(16)))float;
using u32x4=__attribute__((ext_vector_type(4)))unsigned;
constexpr int SEQ=2048,D=64,DM=4096,DMO=1024;
constexpr int NW=8,QBLK=32,QB=QBLK*NW,KVBLK=64,NQB=SEQ/QB;
__device__ __forceinline__ unsigned f2bf_(float f){unsigned u=__builtin_bit_cast(unsigned,f);return (u+0x7fffu+((u>>16)&1u))>>16;}
__device__ __forceinline__ int crow(int r,int hi){return (r&3)+8*(r>>2)+4*hi;}
#define SBAR() __builtin_amdgcn_sched_barrier(0)
__device__ __forceinline__ void cmask(f32x16&p0,f32x16&p1,int jb,int qrel,int hi){
  const float NEG=-INFINITY; int kb=64*jb+4*hi;
  #pragma unroll
  for(int r=0;r<16;++r){int kv=kb+(r&3)+8*(r>>2); if(kv>qrel)p0[r]=NEG; if(kv+32>qrel)p1[r]=NEG;}
}

__device__ __forceinline__ uint2 mld_asm(const unsigned*p){ uint2 v; asm volatile("global_load_dwordx2 %0, %1, off":"=v"(v):"v"(p):"memory"); return v; }
__device__ __forceinline__ void bmask(f32x16&p0,f32x16&p1,uint2 w,int hi){
  const float NEG=-INFINITY; const unsigned a=w.x>>(4*hi), b=w.y>>(4*hi);
  #pragma unroll
  for(int r=0;r<16;++r){const int bit=(r&3)+8*(r>>2); if(!((a>>bit)&1u))p0[r]=NEG; if(!((b>>bit)&1u))p1[r]=NEG;}
}
constexpr int NSLOT=3, SLOTB=8192;
constexpr int LDS_K=0, LDS_V=NSLOT*SLOTB, LDS_WS=2*NSLOT*SLOTB, LDS_OST=LDS_WS+NW*64*4, LDS_BYTES=LDS_OST+NW*4096;
constexpr float C2=0.125f*1.4426950408889634f;
__device__ __forceinline__ void glds16(const void*gsrc,unsigned lds_dst){unsigned keep;
  asm volatile("s_mov_b32 %0, m0\n\ts_mov_b32 m0, %2\n\ts_nop 0\n\tglobal_load_lds_dwordx4 %1, off\n\ts_mov_b32 m0, %0":"=&s"(keep):"v"(gsrc),"s"(lds_dst):"memory");}
__device__ __forceinline__ float max3f(float a,float b,float c){float r;asm("v_max3_f32 %0, %1, %2, %3":"=v"(r):"v"(a),"v"(b),"v"(c));return r;}
__device__ __forceinline__ float max2f(float a,float b){float r;asm("v_max_f32_e32 %0, %1, %2":"=v"(r):"v"(a),"v"(b));return r;}
__device__ __forceinline__ float fadd_s(float a,float b){float r;asm("v_add_f32_e32 %0, %1, %2":"=v"(r):"v"(a),"v"(b));return r;}
__device__ __forceinline__ float fsub_s(float a,float b){float r;asm("v_sub_f32_e32 %0, %1, %2":"=v"(r):"v"(a),"v"(b));return r;}
typedef float f32x2_t __attribute__((ext_vector_type(2))); typedef __bf16 bf16x2_t __attribute__((ext_vector_type(2)));
__device__ __forceinline__ unsigned cvtpk_s(float lo,float hi){f32x2_t v={lo,hi};bf16x2_t b=__builtin_convertvector(v,bf16x2_t);return __builtin_bit_cast(unsigned,b);}
#define WAIT_BAR(N) asm volatile("s_waitcnt vmcnt(" #N ") lgkmcnt(0)\n\ts_barrier":::"memory")

__device__ __forceinline__ void qkt(f32x16&p0,f32x16&p1,const char*Kslot,const bf16x8*qr,const f32x16&negm,int r32,int hi){
  const char*kb=Kslot+hi*1024+r32*16;
  #pragma unroll
  for(int d0=0;d0<4;++d0){
    const bf16x8 b0=*reinterpret_cast<const bf16x8*>(kb+d0*2048);
    const bf16x8 b1=*reinterpret_cast<const bf16x8*>(kb+d0*2048+512);
    if(d0==0){p0=__builtin_amdgcn_mfma_f32_32x32x16_bf16(b0,qr[0],negm,0,0,0);p1=__builtin_amdgcn_mfma_f32_32x32x16_bf16(b1,qr[0],negm,0,0,0);}
    else{p0=__builtin_amdgcn_mfma_f32_32x32x16_bf16(b0,qr[d0],p0,0,0,0);p1=__builtin_amdgcn_mfma_f32_32x32x16_bf16(b1,qr[d0],p1,0,0,0);}}
}
typedef __attribute__((address_space(3))) const char* lds_cptr;
typedef short v4i16_t __attribute__((ext_vector_type(4)));
__device__ __forceinline__ void kload8(bf16x8*kf,lds_cptr kp){
  kf[0]=*(const __attribute__((address_space(3))) bf16x8*)(kp);      kf[1]=*(const __attribute__((address_space(3))) bf16x8*)(kp+512);
  kf[2]=*(const __attribute__((address_space(3))) bf16x8*)(kp+2048); kf[3]=*(const __attribute__((address_space(3))) bf16x8*)(kp+2560);
  kf[4]=*(const __attribute__((address_space(3))) bf16x8*)(kp+4096); kf[5]=*(const __attribute__((address_space(3))) bf16x8*)(kp+4608);
  kf[6]=*(const __attribute__((address_space(3))) bf16x8*)(kp+6144); kf[7]=*(const __attribute__((address_space(3))) bf16x8*)(kp+6656);
}
__device__ __forceinline__ void kload2(bf16x8*kf,lds_cptr kp,int j){ kf[2*j]=*(const __attribute__((address_space(3))) bf16x8*)(kp+j*2048); kf[2*j+1]=*(const __attribute__((address_space(3))) bf16x8*)(kp+j*2048+512); }
__device__ __forceinline__ s16x4 vtr(lds_cptr p){ return __builtin_bit_cast(s16x4,__builtin_amdgcn_ds_read_tr16_b64_v4i16((__attribute__((address_space(3))) v4i16_t*)p)); }
__device__ __forceinline__ float rowmax(const f32x16&p0,const f32x16&p1){
  float a=max3f(p0[0],p0[1],p1[0]),b=max3f(p0[2],p0[3],p1[1]);a=max3f(a,p1[2],p1[3]);
  #pragma unroll
  for(int r=4;r<16;r+=4){a=max3f(a,p0[r],p0[r+1]);b=max3f(b,p0[r+2],p0[r+3]);a=max3f(a,p1[r],p1[r+1]);b=max3f(b,p1[r+2],p1[r+3]);}
  const float m=max2f(a,b);
  auto rr=__builtin_amdgcn_permlane32_swap(__float_as_uint(m),__float_as_uint(m),false,false);
  return max2f(__uint_as_float(rr[0]),__uint_as_float(rr[1]));
}
__device__ __forceinline__ void pv(f32x16*o,int vb,bf16x8 pa0,bf16x8 pa1,bf16x8 pa2,bf16x8 pa3){
  #pragma unroll
  for(int d0=0;d0<2;++d0){s16x4 lo[4],hi[4];
    #pragma unroll
    for(int ks=0;ks<4;++ks){
      asm volatile("ds_read_b64_tr_b16 %0,%1 offset:%c2":"=&v"(lo[ks]):"v"(vb),"i"(d0*4096+ks*1024):"memory");
      asm volatile("ds_read_b64_tr_b16 %0,%1 offset:%c2":"=&v"(hi[ks]):"v"(vb),"i"(d0*4096+ks*1024+512):"memory");}
    asm volatile("s_waitcnt lgkmcnt(0)":::"memory");SBAR();
    #define PK(k) (bf16x8){lo[k][0],lo[k][1],lo[k][2],lo[k][3],hi[k][0],hi[k][1],hi[k][2],hi[k][3]}
    o[d0]=__builtin_amdgcn_mfma_f32_32x32x16_bf16(pa0,PK(0),o[d0],0,0,0);
    o[d0]=__builtin_amdgcn_mfma_f32_32x32x16_bf16(pa1,PK(1),o[d0],0,0,0);
    o[d0]=__builtin_amdgcn_mfma_f32_32x32x16_bf16(pa2,PK(2),o[d0],0,0,0);
    o[d0]=__builtin_amdgcn_mfma_f32_32x32x16_bf16(pa3,PK(3),o[d0],0,0,0);
    #undef PK
  }
}

#ifndef ATTN_STORE16
#define ATTN_STORE16(p,v) (*(u32x4*)(p)=(v))
#endif
template<int THRL,bool MASKED> __device__ __forceinline__ void attn_unit(int b,int qb,const bf16*Q,const bf16*__restrict__ K,const bf16*__restrict__ V,bf16*O,const unsigned*MASK,char*shm){
  int tid_=threadIdx.x; asm volatile("":"+v"(tid_));
  const int tid=tid_,lane=tid&63,r32=lane&31,hi=lane>>5; const int wid=__builtin_amdgcn_readfirstlane(tid>>6);
  const long rowbase=(long)b*SEQ; const int q0=qb*QB;
  const bf16*Qw=Q+(rowbase+q0+wid*QBLK)*DM;
  const bf16*Kh=K+rowbase*DM,*Vh=V+rowbase*DM;
  const unsigned*mrow=MASK+(size_t)(rowbase+q0+wid*QBLK+r32)*64;
  #define MLD(tt) mld_asm(mrow+2*(tt))
  const unsigned lds0=(unsigned)(uintptr_t)shm;
  float*wsf=(float*)(shm+LDS_WS)+wid*64;
  const bf16*ksrc=Kh+(long)lane*DM+wid*8;
  const bf16*vsrc=Vh+(long)(16*(wid&3)+(lane>>2))*DM+(wid>>2)*32+(lane&3)*8;
  const unsigned kdst=lds0+LDS_K+wid*1024, vdst=lds0+LDS_V+wid*1024;
  #define DMA_K(t,slot) glds16(ksrc+(long)(t)*KVBLK*DM,(unsigned)__builtin_amdgcn_readfirstlane(kdst+(slot)))
  #define DMA_V(t,slot) glds16(vsrc+(long)(t)*KVBLK*DM,(unsigned)__builtin_amdgcn_readfirstlane(vdst+(slot)))
  const int vb0=(int)(lds0+LDS_V)+((lane>>4)&1)*32+(lane&3)*8+(4*hi+((lane&15)>>2))*64;
  const char*Kbase=shm+LDS_K; bf16x8 kf[8];
  const lds_cptr shm3=(lds_cptr)shm; const lds_cptr kp0=shm3+LDS_K+hi*1024+r32*16; const lds_cptr vp0=shm3+LDS_V+((lane>>4)&1)*32+(lane&3)*8+(4*hi+((lane&15)>>2))*64;
  const int NT=(q0+QB)/KVBLK;
  uint2 mw_cur=make_uint2(~0u,~0u), mw_next=make_uint2(~0u,~0u); if(MASKED){ mw_cur=MLD(0); mw_next=MLD(1); }
  DMA_K(0,0);DMA_V(0,0);DMA_K(1,SLOTB);
  bf16x8 qr[4];
  #pragma unroll
  for(int d0=0;d0<4;++d0)qr[d0]=*reinterpret_cast<const bf16x8*>(&Qw[(long)r32*DM+d0*16+hi*8]);
  float mhat=0.f,l_reg=0.f;f32x16 o[2];o[0]=f32x16{};o[1]=f32x16{};f32x16 negm=f32x16{};asm volatile("":"+v"(negm));
  const int qrel=wid*QBLK+r32;
  #define CMASK(P0,P1,t) do{ if(MASKED){bmask(P0,P1,mw_cur,hi);} else {int jb_=(t)-(NT-4); if(jb_>=0)cmask(P0,P1,jb_,qrel,hi);} }while(0)
  bool resc=false;
  #define START(P0,P1) do{ float rm=rowmax(P0,P1); if(MASKED)rm=max2f(rm,-64.f); resc=false; \
    { const float dl=rm; mhat=fadd_s(mhat,dl); \
      _Pragma("unroll") for(int r=0;r<16;++r){P0[r]=fsub_s(P0[r],dl);P1[r]=fsub_s(P1[r],dl);} \
      _Pragma("unroll") for(int r=0;r<16;++r)negm[r]=-mhat; asm volatile("":"+v"(negm)); } \
    _Pragma("unroll") for(int r=0;r<16;++r)P0[r]=__builtin_amdgcn_exp2f(P0[r]); }while(0)
  #define RESC() do{ if(resc){ asm volatile("s_waitcnt lgkmcnt(0)":::"memory"); \
      _Pragma("unroll") for(int d_=0;d_<2;++d_) _Pragma("unroll") for(int r=0;r<16;++r)o[d_][r]*=wsf[crow(r,hi)]; } }while(0)
  f32x16 pA0,pA1,pB0,pB1;
  int sl_prev=0,sl_cur=0,sl_next=SLOTB;
  #define ROT() do{sl_prev=sl_cur;sl_cur=sl_next;sl_next=(sl_next==(NSLOT-1)*SLOTB)?0:sl_next+SLOTB;}while(0)
  DMA_K(2,2*SLOTB);
  WAIT_BAR(3);
  qkt(pA0,pA1,Kbase,qr,negm,r32,hi);asm volatile("s_nop 15\n\ts_nop 7":"+v"(pA0),"+v"(pA1));CMASK(pA0,pA1,0);
  START(pA0,pA1);
  _Pragma("unroll") for(int r=0;r<16;++r)pA1[r]=__builtin_amdgcn_exp2f(pA1[r]);
  WAIT_BAR(0);
  DMA_K(3,0);DMA_V(1,SLOTB);
  ROT();
  kload8(kf,kp0+sl_cur);
  WAIT_BAR(2);
  s16x4 vlo[8],vhi[8]; u32x4 pw0,pw1,pw2,pw3;
  #define PKW(P,B) cvtpk_s(P[B],P[B+1])
  #define PAF(k) __builtin_bit_cast(bf16x8,pw##k)
  #define VFR(i) (bf16x8){vlo[i][0],vlo[i][1],vlo[i][2],vlo[i][3],vhi[i][0],vhi[i][1],vhi[i][2],vhi[i][3]}
  #define PIN(x) asm volatile("":"+v"(x))
  #define MX3(a,b,c) __builtin_fmaxf(__builtin_fmaxf((a),(b)),(c))
  #define GAPA(MF,A0,A1,A2,A3,W0,W1,PW) do{ MF; sacc+=A0; sacc+=A1; sacc+=A2; sacc+=A3; PIN(sacc); W0; W1; PIN(PW); SBAR(); }while(0)
  #define EX(v) __builtin_amdgcn_exp2f(v)
  #define GAPB(MF,X,B) do{ MF; X[B]=EX(X[B]); X[B+1]=EX(X[B+1]); X[B+2]=EX(X[B+2]); X[B+3]=EX(X[B+3]); PIN(X); SBAR(); }while(0)
  #define VRD(i) do{ vlo[i]=vtr(vp_+(((i)>>2)*4096+((i)&3)*1024)); vhi[i]=vtr(vp_+(((i)>>2)*4096+((i)&3)*1024+512)); }while(0)
  #define KRD(G,j) do{ if(G){ kload2(kf,kp0+sl_next,j); SBAR(); } }while(0)
  #define STEP(C0,C1,P0,P1,t,GK,GV,GL) do{ SBAR(); if(MASKED){ mw_cur=mw_next; if((t)+1<NT) mw_next=MLD((t)+1); } \
    const lds_cptr vp_=vp0+sl_prev; \
    VRD(0); SBAR(); float sacc=(P0[0]+P0[1]); \
    GAPA(C0=__builtin_amdgcn_mfma_f32_32x32x16_bf16(kf[0],qr[0],negm,0,0,0), P0[2],P0[3],P0[4],P0[5],     pw0[0]=PKW(P0,0), pw0[1]=PKW(P0,2), pw0); \
    VRD(4); SBAR(); GAPA(C1=__builtin_amdgcn_mfma_f32_32x32x16_bf16(kf[1],qr[0],negm,0,0,0), P0[6],P0[7],P0[8],P0[9],     pw0[2]=PKW(P0,4), pw0[3]=PKW(P0,6), pw0); \
    VRD(1); SBAR(); GAPA(C0=__builtin_amdgcn_mfma_f32_32x32x16_bf16(kf[2],qr[1],C0,0,0,0),   P0[10],P0[11],P0[12],P0[13], pw1[0]=PKW(P0,8), pw1[1]=PKW(P0,10), pw1); \
    VRD(5); SBAR(); GAPA(C1=__builtin_amdgcn_mfma_f32_32x32x16_bf16(kf[3],qr[1],C1,0,0,0),   P0[14],P0[15],P1[0],P1[1],   pw1[2]=PKW(P0,12),pw1[3]=PKW(P0,14), pw1); \
    VRD(2); SBAR(); GAPA(C0=__builtin_amdgcn_mfma_f32_32x32x16_bf16(kf[4],qr[2],C0,0,0,0),   P1[2],P1[3],P1[4],P1[5],     pw2[0]=PKW(P1,0), pw2[1]=PKW(P1,2), pw2); \
    VRD(6); SBAR(); GAPA(C1=__builtin_amdgcn_mfma_f32_32x32x16_bf16(kf[5],qr[2],C1,0,0,0),   P1[6],P1[7],P1[8],P1[9],     pw2[2]=PKW(P1,4), pw2[3]=PKW(P1,6), pw2); \
    VRD(3); SBAR(); GAPA(C0=__builtin_amdgcn_mfma_f32_32x32x16_bf16(kf[6],qr[3],C0,0,0,0),   P1[10],P1[11],P1[12],P1[13], pw3[0]=PKW(P1,8), pw3[1]=PKW(P1,10), pw3); \
    VRD(7); SBAR(); GAPA(C1=__builtin_amdgcn_mfma_f32_32x32x16_bf16(kf[7],qr[3],C1,0,0,0),   P1[14],P1[15],0.f,0.f,       pw3[2]=PKW(P1,12),pw3[3]=PKW(P1,14), pw3); \
    l_reg+=sacc; \
    if(GK){DMA_K((t)+3,sl_cur);} if(GV){DMA_V((t)+1,sl_next);} \
    CMASK(C0,C1,t); \
    { float a=MX3(C0[0],C0[1],C1[0]),b=MX3(C0[2],C0[3],C1[1]); a=MX3(a,C1[2],C1[3]); \
      _Pragma("unroll") for(int r=4;r<16;r+=4){a=MX3(a,C0[r],C0[r+1]);b=MX3(b,C0[r+2],C0[r+3]);a=MX3(a,C1[r],C1[r+1]);b=MX3(b,C1[r+2],C1[r+3]);} \
      float rm=__builtin_fmaxf(a,b); { auto rr=__builtin_amdgcn_permlane32_swap(__float_as_uint(rm),__float_as_uint(rm),false,false); rm=__builtin_fmaxf(__uint_as_float(rr[0]),__uint_as_float(rr[1])); } \
      resc=false; \
      if(__builtin_expect(__any(rm>(float)THRL),0)){ const float dl=__builtin_fmaxf(rm,0.f); mhat+=dl; \
        _Pragma("unroll") for(int r=0;r<16;++r){C0[r]-=dl;C1[r]-=dl;} \
        _Pragma("unroll") for(int r=0;r<16;++r)negm[r]=-mhat; asm volatile("":"+v"(negm)); \
        const float f=__builtin_amdgcn_exp2f(-dl); l_reg*=f; if(hi==0)wsf[r32]=f; resc=true; } } \
    SBAR(); \
    GAPB(o[0]=__builtin_amdgcn_mfma_f32_32x32x16_bf16(PAF(0),VFR(0),o[0],0,0,0), C0,0); \
    GAPB(o[1]=__builtin_amdgcn_mfma_f32_32x32x16_bf16(PAF(0),VFR(4),o[1],0,0,0), C0,4); \
    KRD(GL,0); GAPB(o[0]=__builtin_amdgcn_mfma_f32_32x32x16_bf16(PAF(1),VFR(1),o[0],0,0,0), C0,8); \
    KRD(GL,1); GAPB(o[1]=__builtin_amdgcn_mfma_f32_32x32x16_bf16(PAF(1),VFR(5),o[1],0,0,0), C0,12); \
    KRD(GL,2); GAPB(o[0]=__builtin_amdgcn_mfma_f32_32x32x16_bf16(PAF(2),VFR(2),o[0],0,0,0), C1,0); \
    KRD(GL,3); GAPB(o[1]=__builtin_amdgcn_mfma_f32_32x32x16_bf16(PAF(2),VFR(6),o[1],0,0,0), C1,4); \
    GAPB(o[0]=__builtin_amdgcn_mfma_f32_32x32x16_bf16(PAF(3),VFR(3),o[0],0,0,0), C1,8); \
    GAPB(o[1]=__builtin_amdgcn_mfma_f32_32x32x16_bf16(PAF(3),VFR(7),o[1],0,0,0), C1,12); \
    }while(0)
  int t=1;
  #undef CMASK
  #define CMASK(P0,P1,t) do{ if(MASKED){bmask(P0,P1,mw_cur,hi);} }while(0)
  for(;t+5<NT;t+=2){
    STEP(pB0,pB1,pA0,pA1,t,true,true,true);     WAIT_BAR(2); RESC(); ROT();
    STEP(pA0,pA1,pB0,pB1,t+1,true,true,true);   WAIT_BAR(2); RESC(); ROT();
  }
  #undef CMASK
  #define CMASK(P0,P1,t) do{ if(MASKED){bmask(P0,P1,mw_cur,hi);} else {int jb_=(t)-(NT-4); if(jb_>=0)cmask(P0,P1,jb_,qrel,hi);} }while(0)
  #define ENDW(tt) do{ if((tt)+3<NT){WAIT_BAR(2);} else if((tt)+2<NT){WAIT_BAR(1);} else {WAIT_BAR(0);} }while(0)
  for(;t+1<NT;t+=2){
    STEP(pB0,pB1,pA0,pA1,t,(t+3<NT),(t+1<NT),(t+1<NT));       ENDW(t);   RESC(); ROT();
    STEP(pA0,pA1,pB0,pB1,t+1,(t+4<NT),(t+2<NT),(t+2<NT));     ENDW(t+1); RESC(); ROT();
  }
  STEP(pB0,pB1,pA0,pA1,NT-1,false,false,false); RESC();
  { float sacc=pB0[0]+pB0[1]; _Pragma("unroll") for(int r=2;r<16;++r)sacc+=pB0[r]; _Pragma("unroll") for(int r=0;r<16;++r)sacc+=pB1[r]; l_reg+=sacc;
    pw0=(u32x4){PKW(pB0,0),PKW(pB0,2),PKW(pB0,4),PKW(pB0,6)};pw1=(u32x4){PKW(pB0,8),PKW(pB0,10),PKW(pB0,12),PKW(pB0,14)};pw2=(u32x4){PKW(pB1,0),PKW(pB1,2),PKW(pB1,4),PKW(pB1,6)};pw3=(u32x4){PKW(pB1,8),PKW(pB1,10),PKW(pB1,12),PKW(pB1,14)};
    SBAR(); pv(o,vb0+sl_cur,PAF(0),PAF(1),PAF(2),PAF(3)); }
  #undef PKW
  #undef PAF
  #undef VFR
  #undef PIN
  #undef MX3
  #undef GAPA
  #undef GAPB
  #undef EX
  #undef VRD
  #undef KRD
  #undef STEP
  #undef ENDW
  {auto rr=__builtin_amdgcn_permlane32_swap(__float_as_uint(l_reg),__float_as_uint(l_reg),false,false);l_reg=__uint_as_float(rr[0])+__uint_as_float(rr[1]);}
  if(hi==0)wsf[32+r32]=l_reg;asm volatile("s_waitcnt lgkmcnt(0)":::"memory");
  float rli[16];
  #pragma unroll
  for(int r=0;r<16;++r)rli[r]=__builtin_amdgcn_rcpf(wsf[32+crow(r,hi)]);
  bf16*Ow=O+(rowbase+q0+wid*QBLK)*DMO;
  { bf16*stg=(bf16*)(shm+LDS_OST)+wid*2048;
    #pragma unroll
    for(int r=0;r<16;++r){const int orow=crow(r,hi);
      #pragma unroll
      for(int d0=0;d0<2;++d0)stg[orow*64+d0*32+r32]=(bf16)f2bf_(o[d0][r]*rli[r]);}
    asm volatile("s_waitcnt lgkmcnt(0)":::"memory");
    #pragma unroll
    for(int i=0;i<4;++i){const int row=i*8+(lane>>3),ch=lane&7; const u32x4 v=*(const u32x4*)(stg+row*64+ch*8); ATTN_STORE16(Ow+(long)row*DMO+ch*8,v);} }
  asm volatile("s_waitcnt lgkmcnt(0)\n\ts_barrier":::"memory");
  #undef DMA_K
  #undef DMA_V
  #undef MLD
  #undef CMASK
  #undef START
  #undef RESC
  #undef ROT
}
constexpr int ATTN_LDS_BYTES=LDS_BYTES;
#undef SBAR
#undef WAIT_BAR
}
#define GAS __attribute__((address_space(1)))
#define LAS __attribute__((address_space(3)))
typedef unsigned short bf16;
typedef unsigned v4u __attribute__((ext_vector_type(4)));
typedef float f32x4 __attribute__((ext_vector_type(4)));
typedef short bf16x8 __attribute__((ext_vector_type(8)));
typedef GAS unsigned gu32;
typedef GAS unsigned long long gu64;
#define RLX_AGENT __ATOMIC_RELAXED, __HIP_MEMORY_SCOPE_AGENT
#define LDS_WAIT() asm volatile("s_waitcnt lgkmcnt(0)" ::: "memory")
#define VM_WAIT() asm volatile("s_waitcnt vmcnt(0)" ::: "memory")
__device__ __forceinline__ unsigned long long rt() { return __builtin_amdgcn_s_memrealtime(); }
__device__ __forceinline__ unsigned f2bf(float f) { unsigned u = __builtin_bit_cast(unsigned, f); return (u + 0x7fffu + ((u >> 16) & 1u)) >> 16; }
__device__ __forceinline__ unsigned pk2(float lo, float hi) { return f2bf(lo) | (f2bf(hi) << 16); }
#define XB_TMO      128
#define XB_XCNT(j)  (256  + 64 * (j))
#define XB_XSUB(j)  (1280 + 64 * (j))
#define XB_XGEN(j)  (2304 + 64 * (j))
#define XB_TOP      3328
#define XB_TOPGEN   3392
#define XCD_BAR_WORDS 3456
#define XB_SPIN_CAP (1u << 20)

__device__ __forceinline__ unsigned xb_ld(unsigned* p)              { return __hip_atomic_load(p, __ATOMIC_RELAXED, __HIP_MEMORY_SCOPE_AGENT); }
__device__ __forceinline__ unsigned xb_add(unsigned* p, unsigned v) { return __hip_atomic_fetch_add(p, v, __ATOMIC_RELAXED, __HIP_MEMORY_SCOPE_AGENT); }
__device__ __forceinline__ unsigned xb_xcc_id() { return (unsigned)__builtin_amdgcn_s_getreg((3 << 11) | 20) & 0xFu; }
#define XB_SPIN(cond, bar) do { unsigned _sp = 0; while (cond) { __builtin_amdgcn_s_sleep(1); \
    if ((++_sp & 255u) == 0u) { if (xb_ld(&(bar)[XB_TMO])) break; if (_sp > XB_SPIN_CAP) { atomicAdd(&(bar)[XB_TMO], 1u); break; } } } } while (0)

struct XcdBarrier {
    unsigned* bar; unsigned x;
    volatile LAS unsigned* st;
};

__device__ __forceinline__ XcdBarrier xcd_barrier_post(unsigned* bar, volatile LAS unsigned* st) {
    XcdBarrier b; b.bar = bar; b.x = xb_xcc_id(); b.st = st;
    if (threadIdx.x == 0) (void)xb_add(&bar[XB_XCNT(b.x)], 1u);
    return b;
}
__device__ __forceinline__ void xcd_barrier_complete(unsigned* bar, unsigned x, unsigned& nloc, unsigned& nx) {
    const unsigned G = gridDim.x * gridDim.y * gridDim.z;
    unsigned sum, cnt, mine, sp = 0u;
    for (;;) {
        sum = 0u; cnt = 0u; mine = 0u;
#pragma unroll
        for (unsigned j = 0; j < 16; ++j) { const unsigned c = xb_ld(&bar[XB_XCNT(j)]); sum += c; cnt += (c > 0u) ? 1u : 0u; mine = (j == x) ? c : mine; }
        if (sum == G) break;
        __builtin_amdgcn_s_sleep(1);
        if ((++sp & 255u) == 0u) { if (xb_ld(&bar[XB_TMO])) break; if (sp > XB_SPIN_CAP) { atomicAdd(&bar[XB_TMO], 1u); break; } }
    }
    nloc = mine > 0u ? mine : 1u; nx = cnt > 0u ? cnt : 1u;
}

__device__ __attribute__((noinline)) void xcd_barrier_fn(unsigned* bar_, unsigned x_, volatile LAS unsigned* st_) {
    XcdBarrier b; b.bar = bar_; b.x = x_; b.st = st_;
    asm volatile("s_waitcnt vmcnt(0)" ::: "memory");
    __syncthreads();
    if (threadIdx.x == 0) {
        unsigned* bar = b.bar;
        __builtin_amdgcn_s_waitcnt(0);
        unsigned nloc = b.st[0], nx = b.st[1];
        if (nloc == 0u) { xcd_barrier_complete(bar, b.x, nloc, nx); b.st[0] = nloc; b.st[1] = nx; }
        const unsigned old = xb_add(&bar[XB_XSUB(b.x)], 1u);
        const unsigned gen = old / nloc;
        if (old + 1u == (gen + 1u) * nloc) {
            __builtin_amdgcn_fence(__ATOMIC_RELEASE, "agent");
            asm volatile("s_waitcnt vmcnt(0)" ::: "memory");
            const unsigned og = xb_add(&bar[XB_TOP], 1u);
            const unsigned tg = og / nx;
            if (og + 1u == (tg + 1u) * nx) xb_add(&bar[XB_TOPGEN], 1u);
            else XB_SPIN(xb_ld(&bar[XB_TOPGEN]) == tg, bar);
            __builtin_amdgcn_fence(__ATOMIC_ACQUIRE, "agent");
            xb_add(&bar[XB_XGEN(b.x)], 1u);
            asm volatile("s_waitcnt vmcnt(0)" ::: "memory");
        } else {
            XB_SPIN(xb_ld(&bar[XB_XGEN(b.x)]) == gen, bar);
            __builtin_amdgcn_fence(__ATOMIC_ACQUIRE, "agent");
            asm volatile("s_waitcnt vmcnt(0)" ::: "memory");
        }
    }
    __syncthreads();
}

__device__ __forceinline__ void xcd_barrier(const XcdBarrier& b) { xcd_barrier_fn(b.bar, b.x, b.st); }
constexpr int NB = 16, SEQ = 2048, T = NB * SEQ, D = 1024, DEPTH = 4, NHC = 4096, NEXP = 32, NWAVES = 8;
constexpr int NIN = 3920;
constexpr float LN_EPS = 1e-5f, DN_ALPHA = 1.6817928305074290f;
constexpr int RPAD = T * 4 + NEXP * 256;
constexpr int HC_MQ = 0, HC_MK = 256, HC_MV = 512, HC_MO = 768, HC_DQ = 1024, HC_DK = 1536, HC_DV = 2048, HC_SQ = 2560, HC_SK = 2816, HC_SV = 3072, HC_XQ = 3328, HC_XK = 3840, HC_MI = 3904, HC_MF = 3908, HC_XW = 3912;
constexpr size_t MiB = 1u << 20;
constexpr size_t WS_CTL = 0, CTL_ZERO_BYTES = 2 * MiB;
constexpr size_t WS_MOD = 2 * MiB;
constexpr size_t WS_LAM = WS_MOD + 7 * MiB / 4;
constexpr size_t WS_RWT = 4 * MiB;
constexpr size_t WS_CS = 8 * MiB;
constexpr size_t WS_WIN = 16 * MiB;
constexpr size_t WS_WOUT = 48 * MiB;
constexpr size_t WS_W1 = 64 * MiB;
constexpr size_t WS_W2 = 576 * MiB;
constexpr size_t WS_XB = 832 * MiB;
constexpr size_t WS_U = 960 * MiB;
constexpr size_t WS_H = 1024 * MiB;
constexpr size_t WS_QKC = 1280 * MiB;
constexpr size_t WS_XKP = 1312 * MiB;
constexpr size_t WS_MASK = 1316 * MiB;
constexpr size_t WS_TOK = 1324 * MiB;
constexpr size_t WS_MIX = 1344 * MiB;
constexpr size_t WS_Y = 1408 * MiB;
constexpr size_t WS_SC = 1472 * MiB;
constexpr size_t WS_XG = 1728 * MiB;
constexpr size_t WS_HM = 2000 * MiB;
constexpr size_t WS_YM = 2272 * MiB;
constexpr size_t WS_END = 2544 * MiB;
constexpr int CW_CNT = 1024;
constexpr int CW_BAR = 16384;
constexpr int RING_BYTES = 131072, TAB_OFF = RING_BYTES, MISC_OFF = RING_BYTES + 4096, LDS_BYTES = 147456;
constexpr int NPH = 11, NSTEPS = 2 + NPH * DEPTH;
enum { PH_IN = 0, PH_POST, PH_MIXA, PH_SEL, PH_DSA, PH_OUT, PH_ROW1, PH_GATH, PH_G1, PH_G2, PH_ROW2 };

__device__ __forceinline__ float bf2f(bf16 h) { return __uint_as_float((unsigned)h << 16); }
__device__ __forceinline__ float wave_sum(float v) {
#pragma unroll
    for (int o = 1; o < 64; o <<= 1) v += __shfl_xor(v, o);
    return v;
}
__device__ __forceinline__ float wave_max(float v) {
#pragma unroll
    for (int o = 1; o < 64; o <<= 1) v = fmaxf(v, __shfl_xor(v, o));
    return v;
}
__device__ __forceinline__ float sigmoidf_(float x) { return 1.0f / (1.0f + __expf(-x)); }
struct Ctx {
    LAS unsigned char* lds;
    int tid, lane, wave, gw, ngw;
    const float* in[25];
    float* out; unsigned char* ws;
};
#define WSP(type, off) ((type*)(C.ws + (off)))
enum { I_X = 0, I_C, I_POS, I_WIN, I_GATEB, I_CONVW, I_CONVB, I_MNORM, I_DFLAM, I_DFNORM, I_IDXG, I_IDXB, I_WOUT, I_ADAW, I_ADAB, I_LN1G, I_LN1B, I_LN2G, I_LN2B, I_RW, I_RB, I_W1, I_B1, I_W2, I_B2 };

__device__ __forceinline__ int in_dest_col(int n) {
    auto rp = [](int j) { const int hd = j >> 6, d = j & 63; return hd * 64 + ((d < 32) ? 2 * d : 2 * (d - 32) + 1); };
    if (n < 256) return HC_MQ + n;
    if (n < 512) return HC_MK + (n - 256);
    if (n < 768) return HC_MV + (n - 512);
    if (n < 772) return HC_MI + (n - 768);
    if (n < 776) return HC_MF + (n - 772);
    if (n < 1032) return HC_MO + (n - 776);
    if (n < 1544) return HC_DQ + rp(n - 1032);
    if (n < 2056) return HC_DK + rp(n - 1544);
    if (n < 2568) return HC_DV + (n - 2056);
    if (n < 2824) return HC_SQ + rp(n - 2568);
    if (n < 3080) return HC_SK + rp(n - 2824);
    if (n < 3336) return HC_SV + (n - 3080);
    if (n < 3848) return HC_XQ + rp(n - 3336);
    if (n < 3912) return HC_XK + (n - 3848);
    return HC_XW + (n - 3912);
}
template <class F> __device__ __forceinline__ void transpose_item(const float* W, int ldw, int K, int nvalid, int k0, int n0, bf16* WT, LAS float* scr, int lane, F drow) {
    const int nn = n0 + (lane & 31); const bool ok = nn < nvalid;
#pragma unroll 8
    for (int i = 0; i < 32; ++i) { const int kk = 2 * i + (lane >> 5); scr[kk * 33 + (lane & 31)] = ok ? W[(size_t)(k0 + kk) * ldw + nn] : 0.f; }
    LDS_WAIT(); asm volatile("" ::: "memory");
    const int c = lane & 7;
#pragma unroll
    for (int j = 0; j < 4; ++j) { const int n = (lane >> 3) + 8 * j; const LAS float* s = scr + (8 * c) * 33 + n;
        v4u o; o.x = pk2(s[0 * 33], s[1 * 33]); o.y = pk2(s[2 * 33], s[3 * 33]); o.z = pk2(s[4 * 33], s[5 * 33]); o.w = pk2(s[6 * 33], s[7 * 33]);
        if (n0 + n < nvalid) *(GAS v4u*)(WT + (size_t)drow(n0 + n) * K + k0 + 8 * c) = o; }
    LDS_WAIT(); asm volatile("" ::: "memory");
}
struct Args { const float* in[25]; float* out; unsigned char* ws; int s_lo, s_hi, li, pad; };
typedef __attribute__((address_space(4))) const Args CArgs;
__device__ __forceinline__ CArgs* kargs() { CArgs* p = (CArgs*)__builtin_amdgcn_kernarg_segment_ptr(); asm volatile("" : "+s"(p)); return p; }
__device__ __forceinline__ LAS unsigned char* lds_launder(LAS unsigned char* q) { unsigned v = (unsigned)(size_t)q; asm volatile("" : "+s"(v)); return (LAS unsigned char*)(size_t)v; }
#define WS(type, off) ((type*)(A->ws + (off)))
#define TIDX CArgs* A = kargs(); int tid_ = threadIdx.x; asm volatile("" : "+v"(tid_)); const int tid = tid_, lane = tid & 63, wave = __builtin_amdgcn_readfirstlane(tid >> 6); const int gw = blockIdx.x * NWAVES + wave, ngw = gridDim.x * NWAVES; (void)lane; (void)gw; (void)ngw

__device__ __forceinline__ void pro_a(LAS unsigned char* lds) {
    TIDX;
    LAS float* scr = (LAS float*)(lds + wave * 16384);
    constexpr int IT_IN = 16 * 123, IT_OUT = 16 * 32, IT_W1 = 16 * 64, IT_W2 = 16 * 32;
    constexpr int N_IN = DEPTH * IT_IN, N_OUT = DEPTH * IT_OUT, N_W1 = DEPTH * NEXP * IT_W1, N_W2 = DEPTH * NEXP * IT_W2;
    constexpr int NITEMS = N_IN + N_OUT + N_W1 + N_W2;
    for (int it = gw; it < NITEMS; it += ngw) {
        int r = it;
        if (r < N_IN) { const int l = r / IT_IN, q = r % IT_IN, kb = q / 123, nb = q % 123;
            transpose_item(A->in[I_WIN] + (size_t)l * D * NIN, NIN, D, NIN, kb * 64, nb * 32, WS(bf16, WS_WIN) + (size_t)l * NHC * D, scr, lane, [](int n) { return in_dest_col(n); }); continue; }
        r -= N_IN;
        if (r < N_OUT) { const int l = r / IT_OUT, q = r % IT_OUT, kb = q / 32, nb = q % 32;
            transpose_item(A->in[I_WOUT] + (size_t)l * D * D, D, D, D, kb * 64, nb * 32, WS(bf16, WS_WOUT) + (size_t)l * D * D, scr, lane, [](int n) { return n; }); continue; }
        r -= N_OUT;
        if (r < N_W1) { const int le = r / IT_W1, q = r % IT_W1, kb = q / 64, nb = q % 64;
            transpose_item(A->in[I_W1] + (size_t)le * D * 2048, 2048, D, 2048, kb * 64, nb * 32, WS(bf16, WS_W1) + (size_t)le * 2048 * D, scr, lane,
                           [](int n) { const int up = n >> 10, j = n & 1023; return (j >> 7) * 256 + up * 128 + (j & 127); }); continue; }
        r -= N_W1;
        { const int le = r / IT_W2, q = r % IT_W2, kb = q / 32, nb = q % 32;
            transpose_item(A->in[I_W2] + (size_t)le * D * D, D, D, D, kb * 64, nb * 32, WS(bf16, WS_W2) + (size_t)le * D * D, scr, lane, [](int n) { return n; }); }
    }
    for (int r = gw; r < DEPTH * (NHC - NIN); r += ngw) { const int l = r / (NHC - NIN), row = NIN + r % (NHC - NIN);
        GAS v4u* p = (GAS v4u*)(WS(bf16, WS_WIN) + ((size_t)l * NHC + row) * D) + lane; p[0] = (v4u){0u, 0u, 0u, 0u}; p[64] = (v4u){0u, 0u, 0u, 0u}; }
    for (int idx = blockIdx.x * 512 + tid; idx < T * 32; idx += gridDim.x * 512) {
        const int tok = idx >> 5, i = idx & 31;
        const double inv = exp(-(double)i * (9.210340371976184 / 32.0));
        const double ang = (double)((const int*)A->in[I_POS])[tok] * inv;
        const double rev = ang * 0.15915494309189535;
        const float fr = (float)(rev - rint(rev));
        float2 v; v.x = __builtin_amdgcn_cosf(fr); v.y = __builtin_amdgcn_sinf(fr);
        WS(float2, WS_CS)[idx] = v;
    }
    for (int idx = blockIdx.x * 512 + tid; idx < DEPTH * NEXP * D; idx += gridDim.x * 512) {
        const int l = idx / (NEXP * D), r = idx % (NEXP * D), e = r / D, d = r % D;
        WS(float, WS_RWT)[idx] = A->in[I_RW][((size_t)l * D + d) * NEXP + e];
    }
    if (blockIdx.x == 0 && wave == 0) {
        for (int l = 0; l < DEPTH; ++l) { const float* lf = A->in[I_DFLAM] + l * 256;
            const float a = wave_sum(lf[lane] * lf[64 + lane]), b = wave_sum(lf[128 + lane] * lf[192 + lane]);
            if (lane == 0) WS(float, WS_LAM)[l] = __expf(a) - __expf(b) + (0.8f - 0.6f * __expf(-0.3f * (float)l)); }
    }
    __syncthreads();
    if (blockIdx.x < (DEPTH * 6144) / 512) {
        LAS float* ca = (LAS float*)lds;
        for (int i = tid; i < NB * D; i += 512) { const float v = A->in[I_C][i]; ca[i] = v / (1.0f + __expf(-v)); }
        __syncthreads();
        const int col = blockIdx.x * 512 + tid, l = col / 6144, m = col % 6144;
        const float* w = A->in[I_ADAW] + (size_t)l * D * 6144 + m;
        float acc[NB];
#pragma unroll
        for (int b = 0; b < NB; ++b) acc[b] = 0.f;
        for (int d = 0; d < D; ++d) { const float wv = w[(size_t)d * 6144];
#pragma unroll
            for (int b = 0; b < NB; ++b) acc[b] += ca[b * D + d] * wv; }
        const float bias = A->in[I_ADAB][col];
#pragma unroll
        for (int b = 0; b < NB; ++b) WS(float, WS_MOD)[((size_t)l * NB + b) * 6144 + m] = acc[b] + bias;
        __syncthreads();
    }
}
__device__ __forceinline__ void pro_b() {
    TIDX;
    for (int tok = gw; tok < T; tok += ngw) {
        const int b = tok / SEQ; const float* mod = WS(float, WS_MOD) + (size_t)b * 6144;
        const GAS f32x4* xr = (const GAS f32x4*)(A->in[I_X] + (size_t)tok * D) + lane;
        GAS unsigned long long* o8 = (GAS unsigned long long*)(WS(bf16, WS_U) + (size_t)tok * D) + lane;
#pragma unroll
        for (int j = 0; j < 4; ++j) { const f32x4 x = xr[64 * j]; const f32x4 sh = *(const f32x4*)(mod + 4 * lane + 256 * j), sc = *(const f32x4*)(mod + 1024 + 4 * lane + 256 * j);
            const f32x4 u = x * (1.0f + sc) + sh; o8[64 * j] = (unsigned long long)pk2(u.x, u.y) | ((unsigned long long)pk2(u.z, u.w) << 32); }
    }
}
__device__ __forceinline__ void ph_post(int l) {
    TIDX;
    const bf16* H = WS(bf16, WS_H); bf16* XKP = WS(bf16, WS_XKP); bf16* QKC = WS(bf16, WS_QKC);
    const float* cw = A->in[I_CONVW] + (size_t)l * 4 * 512; const float* cb = A->in[I_CONVB] + (size_t)l * 512;
    const float gi = A->in[I_IDXG][l * 64 + lane], bi = A->in[I_IDXB][l * 64 + lane];
    for (int tok = gw; tok < T; tok += ngw) {
        const bf16* hrow = H + (size_t)tok * NHC;
        {
            const float v = bf2f(hrow[HC_XK + lane]);
            const float mean = wave_sum(v) * (1.0f / 64.0f); const float dv = v - mean;
            const float var = wave_sum(dv * dv) * (1.0f / 64.0f);
            const float nv = dv * (1.0f / sqrtf(var + LN_EPS)) * gi + bi;
            const float pv = __shfl_xor(nv, 32);
            const int i = lane & 31; const float2 cs = WS(float2, WS_CS)[(size_t)tok * 32 + i];
            const float o = (lane < 32) ? (nv * cs.x - pv * cs.y) : (nv * cs.x + pv * cs.y);
            XKP[(size_t)tok * 64 + 2 * i + (lane >> 5)] = (bf16)f2bf(o);
        }
        {
            const int s = tok % SEQ, c0 = 8 * lane;
            float acc[8];
#pragma unroll
            for (int c = 0; c < 8; ++c) acc[c] = cb[c0 + c];
#pragma unroll
            for (int j = 0; j < 4; ++j) {
                if (s - 3 + j >= 0) {
                    const v4u raw = *(const GAS v4u*)(H + (size_t)(tok - 3 + j) * NHC + c0);
                    const unsigned rw[4] = {raw.x, raw.y, raw.z, raw.w};
#pragma unroll
                    for (int c = 0; c < 8; ++c) { const float x = __uint_as_float((c & 1) ? (rw[c >> 1] & 0xffff0000u) : (rw[c >> 1] << 16)); acc[c] += cw[j * 512 + c0 + c] * x; }
                }
            }
            v4u o;
#define SILU(x) ((x) / (1.0f + __expf(-(x))))
            o.x = pk2(SILU(acc[0]), SILU(acc[1])); o.y = pk2(SILU(acc[2]), SILU(acc[3])); o.z = pk2(SILU(acc[4]), SILU(acc[5])); o.w = pk2(SILU(acc[6]), SILU(acc[7]));
#undef SILU
            *(GAS v4u*)(QKC + (size_t)tok * 512 + c0) = o;
        }
    }
}
typedef float f32x16 __attribute__((ext_vector_type(16)));
__device__ __forceinline__ void ph_idx_scores() {
    TIDX;
    const bf16* H = WS(bf16, WS_H); const bf16* XKP = WS(bf16, WS_XKP); float* SC = WS(float, WS_SC);
    const int r = lane & 31, hh = lane >> 5, ql = r >> 3, hd = r & 7;
    for (int item = blockIdx.x; item < 256; item += gridDim.x) {
        const int g = item >> 5, p = item & 31;
#pragma unroll 1
        for (int sub = 0; sub < 4; ++sub) {
            const int b = 2 * g + (sub >> 1), qblk = (sub & 1) ? 63 - p : p, q0 = qblk * 32 + 4 * wave, tok0 = b * SEQ + q0;
            bf16x8 af[4];
            { const bf16* ap = H + (size_t)(tok0 + ql) * NHC + HC_XQ + hd * 64 + 8 * hh;
#pragma unroll
              for (int ks = 0; ks < 4; ++ks) af[ks] = *(const GAS bf16x8*)(ap + ks * 16); }
            float wv[4][4];
#pragma unroll
            for (int q = 0; q < 4; ++q)
#pragma unroll
                for (int i = 0; i < 4; ++i) wv[q][i] = bf2f(H[(size_t)(tok0 + q) * NHC + HC_XW + 4 * hh + i]);
            const int npair = (qblk + 2) >> 1;
            const bf16* kp = XKP + (size_t)(b * SEQ + r) * 64 + 8 * hh;
            bf16x8 bc[2][4], bn[2][4];
#pragma unroll
            for (int t2 = 0; t2 < 2; ++t2)
#pragma unroll
                for (int ks = 0; ks < 4; ++ks) bc[t2][ks] = *(const GAS bf16x8*)(kp + t2 * 2048 + ks * 16);
            for (int pr = 0; pr < npair; ++pr) {
                const bf16* kn = kp + (size_t)((pr + 1 < npair) ? pr + 1 : pr) * 4096;
#pragma unroll
                for (int t2 = 0; t2 < 2; ++t2)
#pragma unroll
                    for (int ks = 0; ks < 4; ++ks) bn[t2][ks] = *(const GAS bf16x8*)(kn + t2 * 2048 + ks * 16);
#pragma unroll
                for (int t2 = 0; t2 < 2; ++t2) {
                    f32x16 acc = {};
#pragma unroll
                    for (int ks = 0; ks < 4; ++ks) acc = __builtin_amdgcn_mfma_f32_32x32x16_bf16(af[ks], bc[t2][ks], acc, 0, 0, 0);
                    float tot[4];
#pragma unroll
                    for (int q = 0; q < 4; ++q) { float pp = 0.f;
#pragma unroll
                        for (int i = 0; i < 4; ++i) pp += wv[q][i] * fmaxf(acc[4 * q + i], 0.f);
                        tot[q] = pp + __shfl_xor(pp, 32); }
                    const int key = pr * 64 + t2 * 32 + r;
                    const float o0 = hh ? tot[2] : tot[0], o1 = hh ? tot[3] : tot[1];
                    SC[(size_t)(tok0 + 2 * hh) * SEQ + key] = o0; SC[(size_t)(tok0 + 2 * hh + 1) * SEQ + key] = o1;
                }
#pragma unroll
                for (int t2 = 0; t2 < 2; ++t2)
#pragma unroll
                    for (int ks = 0; ks < 4; ++ks) bc[t2][ks] = bn[t2][ks];
            }
        }
    }
}
__device__ __forceinline__ void ph_mlstm(LAS unsigned char* lds, int l) {
    TIDX;
    const bf16* H = WS(bf16, WS_H); const bf16* QKC = WS(bf16, WS_QKC); bf16* MIX = WS(bf16, WS_MIX);
    constexpr int P = 65;
    LAS float* q = (LAS float*)lds; LAS float* k = q + 64 * P; LAS float* v = k + 64 * P; LAS float* Sm = v + 64 * P; LAS float* Cst = Sm + 64 * P;
    LAS float* nst = Cst + 64 * P; LAS float* bcum = nst + 64; LAS float* ii = bcum + 64; LAS float* mt = ii + 64; LAS float* inter = mt + 64; LAS float* den = inter + 64; LAS float* wvv = den + 64; LAS float* sc = wvv + 64;
    for (int unit = blockIdx.x; unit < NB * 4; unit += gridDim.x) {
        const int b = unit >> 2, h = unit & 3;
        const float gbi = A->in[I_GATEB][l * 8 + h], gbf = A->in[I_GATEB][l * 8 + 4 + h];
        for (int i = tid; i < 64 * P; i += 512) Cst[i] = 0.f;
        if (tid < 64) nst[tid] = 0.f;
        if (tid == 0) sc[0] = 0.f;
        __syncthreads();
        for (int ch = 0; ch < SEQ / 64; ++ch) {
            const int tok0 = b * SEQ + ch * 64;
            for (int idx = tid; idx < 4096; idx += 512) { const int rr = idx >> 6, d = idx & 63; const size_t tk = (size_t)(tok0 + rr);
                q[rr * P + d] = bf2f(QKC[tk * 512 + h * 64 + d]) * 0.125f; k[rr * P + d] = bf2f(QKC[tk * 512 + 256 + h * 64 + d]); v[rr * P + d] = bf2f(H[tk * NHC + HC_MV + h * 64 + d]); }
            if (wave == 0) {
                const size_t tk = (size_t)(tok0 + lane);
                const float ip = bf2f(H[tk * NHC + HC_MI + h]) + gbi, fp = bf2f(H[tk * NHC + HC_MF + h]) + gbf;
                float lf = fminf(fp, 0.f) - log1pf(__expf(-fabsf(fp)));
#pragma unroll
                for (int o = 1; o < 64; o <<= 1) { const float t_ = __shfl_up(lf, o); if (lane >= o) lf += t_; }
                ii[lane] = ip; bcum[lane] = lf;
            }
            __syncthreads();
            const float mprev = sc[0];
            if (tid < 64) { const int t = tid; float mx = -INFINITY; const float bt = bcum[t];
                for (int s = 0; s <= t; ++s) mx = fmaxf(mx, bt - bcum[s] + ii[s]);
                const float li = bt + mprev, m_t = fmaxf(li, mx); mt[t] = m_t; inter[t] = __expf(li - m_t); }
            __syncthreads();
            for (int idx = tid; idx < 4096; idx += 512) { const int t = idx >> 6, s = idx & 63; float val = 0.f;
                if (s <= t) { float dot = 0.f;
#pragma unroll 16
                    for (int d = 0; d < 64; ++d) dot += q[t * P + d] * k[s * P + d];
                    val = dot * __expf(bcum[t] - bcum[s] + ii[s] - mt[t]); }
                Sm[t * P + s] = val; }
            __syncthreads();
            if (tid < 64) { const int t = tid; float a = 0.f, qn = 0.f;
                for (int s = 0; s < 64; ++s) a += Sm[t * P + s];
                for (int d = 0; d < 64; ++d) qn += q[t * P + d] * nst[d];
                den[t] = a + inter[t] * qn; }
            float num[8];
#pragma unroll
            for (int j = 0; j < 8; ++j) { const int t = wave + 8 * j, vc = lane; float a = 0.f, qc = 0.f;
                for (int s = 0; s < 64; ++s) a += Sm[t * P + s] * v[s * P + vc];
                for (int d = 0; d < 64; ++d) qc += q[t * P + d] * Cst[d * P + vc];
                num[j] = a + inter[t] * qc; }
            __syncthreads();
#pragma unroll
            for (int j = 0; j < 8; ++j) { const int t = wave + 8 * j, vc = lane; const size_t tk = (size_t)(tok0 + t);
                const float hv = num[j] / fmaxf(fabsf(den[t]), __expf(-mt[t]));
                const float mean = wave_sum(hv) * (1.0f / 64.0f), hc = hv - mean;
                const float rs = 1.0f / sqrtf(wave_sum(hc * hc) * (1.0f / 64.0f) + LN_EPS);
                const float og = sigmoidf_(bf2f(H[tk * NHC + HC_MO + h * 64 + vc]));
                MIX[tk * D + h * 64 + vc] = (bf16)f2bf(og * (hc * rs * A->in[I_MNORM][l * 256 + h * 64 + vc])); }
            if (wave == 0) { const float bl = bcum[63]; const float lw = bl - bcum[lane] + ii[lane];
                const float mnew = fmaxf(bl + mprev, wave_max(lw)); wvv[lane] = __expf(lw - mnew);
                if (lane == 0) { sc[1] = __expf(bl + mprev - mnew); sc[2] = mnew; } }
            __syncthreads();
            { const float decay = sc[1];
#pragma unroll
              for (int j = 0; j < 8; ++j) { const int d = wave + 8 * j, vc = lane; float a = 0.f;
                  for (int s = 0; s < 64; ++s) a += wvv[s] * k[s * P + d] * v[s * P + vc];
                  Cst[d * P + vc] = decay * Cst[d * P + vc] + a; }
              if (tid < 64) { float a = 0.f; for (int s = 0; s < 64; ++s) a += wvv[s] * k[s * P + tid]; nst[tid] = decay * nst[tid] + a; }
              if (tid == 0) sc[0] = sc[2]; }
            __syncthreads();
        }
    }
}
template <int NV> __device__ __forceinline__ void naive_attn_row(const bf16* qp, const bf16* Kb, const bf16* Vb, int tl, const unsigned* maskrow, int lane, float (&o)[NV], float& l_out) {
    float qf[64];
#pragma unroll
    for (int c = 0; c < 8; ++c) { const v4u raw = *(const GAS v4u*)(qp + 8 * c); const unsigned rw[4] = {raw.x, raw.y, raw.z, raw.w};
#pragma unroll
        for (int e = 0; e < 8; ++e) qf[8 * c + e] = __uint_as_float((e & 1) ? (rw[e >> 1] & 0xffff0000u) : (rw[e >> 1] << 16)); }
    float m = -INFINITY, l = 0.f;
#pragma unroll
    for (int n = 0; n < NV; ++n) o[n] = 0.f;
    for (int kb = 0; kb * 64 <= tl; ++kb) {
        const int s = kb * 64 + lane; bool valid = s <= tl;
        if (maskrow) valid = valid && ((maskrow[2 * kb + (lane >> 5)] >> (lane & 31)) & 1u);
        float dot = 0.f;
        const bf16* kr = Kb + (size_t)s * NHC;
#pragma unroll
        for (int c = 0; c < 8; ++c) { const v4u raw = *(const GAS v4u*)(kr + 8 * c); const unsigned rw[4] = {raw.x, raw.y, raw.z, raw.w};
#pragma unroll
            for (int e = 0; e < 8; ++e) dot += qf[8 * c + e] * __uint_as_float((e & 1) ? (rw[e >> 1] & 0xffff0000u) : (rw[e >> 1] << 16)); }
        const float scv = valid ? dot : -INFINITY;
        const float bm = wave_max(scv);
        if (bm == -INFINITY) continue;
        const float mn = fmaxf(m, bm), alpha = __builtin_amdgcn_exp2f(m - mn), p = __builtin_amdgcn_exp2f(scv - mn);
        l = l * alpha + wave_sum(p); m = mn;
#pragma unroll
        for (int n = 0; n < NV; ++n) o[n] *= alpha;
        const int nk = min(64, tl - kb * 64 + 1);
        const bf16* vr = Vb + (size_t)(kb * 64) * NHC + lane;
        for (int j = 0; j < nk; ++j) { const float pj = __shfl(p, j);
#pragma unroll
            for (int n = 0; n < NV; ++n) o[n] += pj * bf2f(vr[(size_t)j * NHC + 64 * n]); }
    }
    l_out = l;
}
__device__ __forceinline__ void ph_diff_naive(int l) {
    TIDX;
    const bf16* H = WS(bf16, WS_H); bf16* MIX = WS(bf16, WS_MIX);
    const float lam = WS(float, WS_LAM)[l], lam_init = 0.8f - 0.6f * __expf(-0.3f * (float)l);
    for (int task = gw; task < T * 4; task += ngw) {
        const int tok = task >> 2, h = task & 3, b = tok / SEQ, tl = tok % SEQ;
        const bf16* Hb = H + (size_t)b * SEQ * NHC;
        float o1[2], o2[2], l1, l2;
        naive_attn_row<2>(H + (size_t)tok * NHC + HC_DQ + (2 * h) * 64, Hb + HC_DK + (2 * h) * 64, Hb + HC_DV + h * 128, tl, nullptr, lane, o1, l1);
        naive_attn_row<2>(H + (size_t)tok * NHC + HC_DQ + (2 * h + 1) * 64, Hb + HC_DK + (2 * h + 1) * 64, Hb + HC_DV + h * 128, tl, nullptr, lane, o2, l2);
        const float i1 = 1.0f / l1, i2 = 1.0f / l2;
        const float d0 = o1[0] * i1 - lam * o2[0] * i2, d1 = o1[1] * i1 - lam * o2[1] * i2;
        const float rs = 1.0f / sqrtf(wave_sum(d0 * d0 + d1 * d1) * (1.0f / 128.0f) + LN_EPS);
        const float* g = A->in[I_DFNORM] + l * 512 + h * 128;
        MIX[(size_t)tok * D + 256 + h * 128 + lane] = (bf16)f2bf(d0 * rs * g[lane] * (1.0f - lam_init));
        MIX[(size_t)tok * D + 256 + h * 128 + 64 + lane] = (bf16)f2bf(d1 * rs * g[64 + lane] * (1.0f - lam_init));
    }
}
__device__ __forceinline__ void ph_dsa_naive() {
    TIDX;
    const bf16* H = WS(bf16, WS_H); bf16* MIX = WS(bf16, WS_MIX); const unsigned* MASK = WS(unsigned, WS_MASK);
    for (int task = gw; task < T * 4; task += ngw) {
        const int tok = task >> 2, h = task & 3, b = tok / SEQ, tl = tok % SEQ;
        const bf16* Hb = H + (size_t)b * SEQ * NHC;
        float o[1], ll;
        naive_attn_row<1>(H + (size_t)tok * NHC + HC_SQ + h * 64, Hb + HC_SK + h * 64, Hb + HC_SV + h * 64, tl, MASK + (size_t)tok * 64, lane, o, ll);
        MIX[(size_t)tok * D + 768 + h * 64 + lane] = (bf16)f2bf(o[0] / ll);
    }
}
constexpr size_t WS_OD = WS_END;
constexpr size_t WS_END2 = WS_END + 64 * MiB;
__device__ __forceinline__ void ph_diff_attn(LAS unsigned char* lds) {
    CArgs* A = kargs();
    const int G = gridDim.x, bx = blockIdx.x, vcu = (G % 8 == 0) ? (bx % 8) * (G / 8) + bx / 8 : bx;
    const bf16* H = WS(bf16, WS_H); bf16* OD = WS(bf16, WS_OD);
    for (int item = vcu; item < NB * 16; item += G) {
        const int b = item >> 4, vh = item & 15, g = vh >> 1, half = vh & 1;
#pragma unroll 1
        for (int qb = 7; qb >= 0; --qb)
            attn_body::attn_unit<8, false>(b, qb, H + HC_DQ + g * 64, H + HC_DK + g * 64, H + HC_DV + (g >> 1) * 128 + half * 64, OD + g * 128 + half * 64, nullptr, (char*)lds);
    }
}
__device__ __forceinline__ void ph_diff_post(int l) {
    TIDX;
    const bf16* OD = WS(bf16, WS_OD); bf16* MIX = WS(bf16, WS_MIX);
    const float lam = WS(float, WS_LAM)[l], lam_init = 0.8f - 0.6f * __expf(-0.3f * (float)l);
    for (int task = gw; task < T * 4; task += ngw) {
        const int tok = task >> 2, h = task & 3;
        const bf16* o1 = OD + (size_t)tok * D + (2 * h) * 128, *o2 = o1 + 128;
        const float d0 = bf2f(o1[lane]) - lam * bf2f(o2[lane]), d1 = bf2f(o1[64 + lane]) - lam * bf2f(o2[64 + lane]);
        const float rs = 1.0f / sqrtf(wave_sum(d0 * d0 + d1 * d1) * (1.0f / 128.0f) + LN_EPS);
        const float* g = A->in[I_DFNORM] + l * 512 + h * 128;
        MIX[(size_t)tok * D + 256 + h * 128 + lane] = (bf16)f2bf(d0 * rs * g[lane] * (1.0f - lam_init));
        MIX[(size_t)tok * D + 256 + h * 128 + 64 + lane] = (bf16)f2bf(d1 * rs * g[64 + lane] * (1.0f - lam_init));
    }
}
__device__ __forceinline__ void ph_dsa_attn(LAS unsigned char* lds) {
    CArgs* A = kargs();
    const int G = gridDim.x, bx = blockIdx.x, vcu = (G % 8 == 0) ? (bx % 8) * (G / 8) + bx / 8 : bx;
    const bf16* H = WS(bf16, WS_H); bf16* MIX = WS(bf16, WS_MIX); const unsigned* MASK = WS(unsigned, WS_MASK);
    for (int item = vcu; item < NB * 4 * 4; item += G) {
        const int bh = item >> 2, p = item & 3, b = bh >> 2, h = bh & 3;
        attn_body::attn_unit<8, true>(b, 7 - p, H + HC_SQ + h * 64, H + HC_SK + h * 64, H + HC_SV + h * 64, MIX + 768 + h * 64, MASK, (char*)lds);
        attn_body::attn_unit<8, true>(b, p, H + HC_SQ + h * 64, H + HC_SK + h * 64, H + HC_SV + h * 64, MIX + 768 + h * 64, MASK, (char*)lds);
    }
}
constexpr size_t WS_DC = WS_END2;
constexpr size_t WS_CST = WS_DC + 32 * MiB;
constexpr size_t WS_DN = WS_CST + 32 * MiB;
constexpr size_t WS_END3 = WS_DN + 4 * MiB;
typedef float f32x2_ __attribute__((ext_vector_type(2)));
constexpr int MP = 68;
__device__ __forceinline__ float log_sigmoid_(float x) { return fminf(x, 0.f) - log1pf(__expf(-fabsf(x))); }
__device__ __forceinline__ void mlstm_gates(const bf16* H, int tok0, int h, float gbi, float gbf, int lane, LAS float* bcum, LAS float* av) {
    const size_t tk = (size_t)(tok0 + lane);
    const float ip = bf2f(H[tk * NHC + HC_MI + h]) + gbi; float lf = log_sigmoid_(bf2f(H[tk * NHC + HC_MF + h]) + gbf);
#pragma unroll
    for (int o = 1; o < 64; o <<= 1) { const float t_ = __shfl_up(lf, o); if (lane >= o) lf += t_; }
    bcum[lane] = lf; av[lane] = ip - lf;
}
__device__ __forceinline__ void ph_mlstm_m1(LAS unsigned char* lds, int l) {
    TIDX;
    const bf16* H = WS(bf16, WS_H); const bf16* QKC = WS(bf16, WS_QKC);
    float* DC = WS(float, WS_DC); float* DN = WS(float, WS_DN); float* SCAL = WS(float, WS_DN + 2 * MiB);
    LAS float* kS = (LAS float*)lds; LAS float* vS = kS + 64 * MP; LAS float* bcum = vS + 64 * MP; LAS float* av = bcum + 64; LAS float* wv = av + 64;
    const int tb = tid >> 5, cb = tid & 31;
    for (int u = blockIdx.x; u < NB * 4 * 32; u += gridDim.x) {
        const int bh = u >> 5, c = u & 31, b = bh >> 2, h = bh & 3, tok0 = b * SEQ + c * 64;
        for (int idx = tid; idx < 4096; idx += 512) { const int r = idx >> 6, d = idx & 63; const size_t tk = (size_t)(tok0 + r);
            kS[r * MP + d] = bf2f(QKC[tk * 512 + 256 + h * 64 + d]); vS[r * MP + d] = bf2f(H[tk * NHC + HC_MV + h * 64 + d]); }
        if (wave == 0) { mlstm_gates(H, tok0, h, A->in[I_GATEB][l * 8 + h], A->in[I_GATEB][l * 8 + 4 + h], lane, bcum, av); }
        __syncthreads();
        if (wave == 0) { const float a = av[lane], amax = wave_max(a); wv[lane] = __expf(a - amax); if (lane == 0) { SCAL[u * 4 + 0] = bcum[63]; SCAL[u * 4 + 1] = bcum[63] + amax; } }
        __syncthreads();
        float acc[4][2] = {};
#pragma unroll 4
        for (int s = 0; s < 64; ++s) { const float w = wv[s]; const f32x4 kv = *(const LAS f32x4*)(kS + s * MP + 4 * tb); const f32x2_ vv = *(const LAS f32x2_*)(vS + s * MP + 2 * cb);
#pragma unroll
            for (int i = 0; i < 4; ++i) { const float kw = kv[i] * w; acc[i][0] += kw * vv.x; acc[i][1] += kw * vv.y; } }
#pragma unroll
        for (int i = 0; i < 4; ++i) *(f32x2_*)(DC + (size_t)u * 4096 + (4 * tb + i) * 64 + 2 * cb) = (f32x2_){acc[i][0], acc[i][1]};
        if (tid < 64) { float a = 0.f;
#pragma unroll 8
            for (int s = 0; s < 64; ++s) a += wv[s] * kS[s * MP + tid]; DN[(size_t)u * 64 + tid] = a; }
        __syncthreads();
    }
}
__device__ __forceinline__ void ph_mlstm_m2() {
    TIDX;
    const float* DC = WS(float, WS_DC); float* CS = WS(float, WS_CST); const float* DN = WS(float, WS_DN); float* NS = WS(float, WS_DN + 1 * MiB); float* SCAL = WS(float, WS_DN + 2 * MiB);
    for (int item = blockIdx.x; item < NB * 4 * 4; item += gridDim.x) {
        const int bh = item >> 2, qtr = item & 3, e0 = qtr * 1024 + tid * 2;
        float m = 0.f; f32x2_ C = (f32x2_){0.f, 0.f}; float n = 0.f;
#pragma unroll 4
        for (int c = 0; c < 32; ++c) {
            const int u = bh * 32 + c;
            const float bl = SCAL[u * 4 + 0], ml = SCAL[u * 4 + 1];
            *(f32x2_*)(CS + (size_t)u * 4096 + e0) = C;
            if (qtr == 0 && tid < 64) NS[(size_t)u * 64 + tid] = n;
            if (qtr == 0 && tid == 0) SCAL[u * 4 + 2] = m;
            const float mn = fmaxf(bl + m, ml), f1 = __expf(bl + m - mn), f2 = __expf(ml - mn);
            const f32x2_ dc = *(const f32x2_*)(DC + (size_t)u * 4096 + e0);
            C.x = f1 * C.x + f2 * dc.x; C.y = f1 * C.y + f2 * dc.y;
            if (qtr == 0 && tid < 64) n = f1 * n + f2 * DN[(size_t)u * 64 + tid];
            m = mn;
        }
    }
}
__device__ __forceinline__ void ph_mlstm_m3(LAS unsigned char* lds, int l) {
    TIDX;
    const bf16* H = WS(bf16, WS_H); const bf16* QKC = WS(bf16, WS_QKC); bf16* MIX = WS(bf16, WS_MIX);
    const float* CS = WS(float, WS_CST); const float* NS = WS(float, WS_DN + 1 * MiB); const float* SCAL = WS(float, WS_DN + 2 * MiB);
    LAS float* qT = (LAS float*)lds; LAS float* kT = qT + 64 * MP; LAS float* vS = kT + 64 * MP; LAS float* SmT = vS + 64 * MP; LAS float* Cst = SmT + 64 * MP; LAS float* hS = Cst + 64 * MP;
    LAS float* bcum = hS + 64 * MP; LAS float* av = bcum + 64; LAS float* mm = av + 64; LAS float* inter = mm + 64; LAS float* den = inter + 64; LAS float* nst = den + 64;
    const int tb = tid >> 5, cb = tid & 31;
    for (int u = blockIdx.x; u < NB * 4 * 32; u += gridDim.x) {
        const int bh = u >> 5, c = u & 31, b = bh >> 2, h = bh & 3, tok0 = b * SEQ + c * 64;
        const float mc = SCAL[u * 4 + 2];
        for (int idx = tid; idx < 4096; idx += 512) { const int r = idx >> 6, d = idx & 63; const size_t tk = (size_t)(tok0 + r);
            qT[d * MP + r] = bf2f(QKC[tk * 512 + h * 64 + d]) * 0.125f; kT[d * MP + r] = bf2f(QKC[tk * 512 + 256 + h * 64 + d]); vS[r * MP + d] = bf2f(H[tk * NHC + HC_MV + h * 64 + d]);
            Cst[r * MP + d] = CS[(size_t)u * 4096 + idx]; }
        if (tid < 64) nst[tid] = NS[(size_t)u * 64 + tid];
        if (wave == 0) { mlstm_gates(H, tok0, h, A->in[I_GATEB][l * 8 + h], A->in[I_GATEB][l * 8 + 4 + h], lane, bcum, av); }
        __syncthreads();
        if (wave == 0) { float pm = av[lane];
#pragma unroll
            for (int o = 1; o < 64; o <<= 1) { const float t_ = __shfl_up(pm, o); if (lane >= o) pm = fmaxf(pm, t_); }
            const float m_ = fmaxf(mc, pm); mm[lane] = m_; inter[lane] = __expf(mc - m_); }
        __syncthreads();
        {
            float acc[4][2] = {};
#pragma unroll 4
            for (int d = 0; d < 64; ++d) { const f32x4 qv = *(const LAS f32x4*)(qT + d * MP + 4 * tb); const f32x2_ kv = *(const LAS f32x2_*)(kT + d * MP + 2 * cb);
#pragma unroll
                for (int i = 0; i < 4; ++i) { acc[i][0] += qv[i] * kv.x; acc[i][1] += qv[i] * kv.y; } }
#pragma unroll
            for (int j = 0; j < 2; ++j) { const int s = 2 * cb + j; const float as = av[s]; f32x4 o;
#pragma unroll
                for (int i = 0; i < 4; ++i) { const int t = 4 * tb + i; o[i] = (s <= t) ? acc[i][j] * __expf(as - mm[t]) : 0.f; }
                *(LAS f32x4*)(SmT + s * MP + 4 * tb) = o; }
        }
        __syncthreads();
        if (tid < 64) { float a = 0.f, qn = 0.f;
#pragma unroll 8
            for (int s = 0; s < 64; ++s) a += SmT[s * MP + tid];
#pragma unroll 8
            for (int d = 0; d < 64; ++d) qn += qT[d * MP + tid] * nst[d];
            const float dn = a + inter[tid] * qn; den[tid] = 1.0f / fmaxf(fabsf(dn), __expf(-(bcum[tid] + mm[tid]))); }
        {
            float a1[4][2] = {}, a2[4][2] = {};
#pragma unroll 4
            for (int s = 0; s < 64; ++s) { const f32x4 sv = *(const LAS f32x4*)(SmT + s * MP + 4 * tb); const f32x2_ vv = *(const LAS f32x2_*)(vS + s * MP + 2 * cb);
#pragma unroll
                for (int i = 0; i < 4; ++i) { a1[i][0] += sv[i] * vv.x; a1[i][1] += sv[i] * vv.y; } }
#pragma unroll 4
            for (int d = 0; d < 64; ++d) { const f32x4 qv = *(const LAS f32x4*)(qT + d * MP + 4 * tb); const f32x2_ cv = *(const LAS f32x2_*)(Cst + d * MP + 2 * cb);
#pragma unroll
                for (int i = 0; i < 4; ++i) { a2[i][0] += qv[i] * cv.x; a2[i][1] += qv[i] * cv.y; } }
            __syncthreads();
#pragma unroll
            for (int i = 0; i < 4; ++i) { const int t = 4 * tb + i; const float it = inter[t], dv = den[t];
                *(LAS f32x2_*)(hS + t * MP + 2 * cb) = (f32x2_){(a1[i][0] + it * a2[i][0]) * dv, (a1[i][1] + it * a2[i][1]) * dv}; }
        }
        __syncthreads();
#pragma unroll
        for (int j = 0; j < 8; ++j) { const int t = wave + 8 * j, vc = lane; const size_t tk = (size_t)(tok0 + t);
            const float hv = hS[t * MP + vc];
            const float mean = wave_sum(hv) * (1.0f / 64.0f), hc = hv - mean;
            const float rs = 1.0f / sqrtf(wave_sum(hc * hc) * (1.0f / 64.0f) + LN_EPS);
            const float og = sigmoidf_(bf2f(H[tk * NHC + HC_MO + h * 64 + vc]));
            MIX[tk * D + h * 64 + vc] = (bf16)f2bf(og * (hc * rs * A->in[I_MNORM][l * 256 + h * 64 + vc])); }
        __syncthreads();
    }
}
__device__ __forceinline__ void ph_select(LAS unsigned char* lds) {
    TIDX;
    const float* SC = WS(float, WS_SC); unsigned* MASK = WS(unsigned, WS_MASK);
    LAS unsigned* hist = (LAS unsigned*)lds + wave * 256;
    const unsigned long long lt_mask = (1ull << lane) - 1ull;
    for (int tok = gw; tok < T; tok += ngw) {
        const int tl = tok % SEQ;
        if (tl < 256) {
            const int lo = 32 * lane; unsigned w;
            if (lo + 31 <= tl) w = 0xffffffffu; else if (lo > tl) w = 0u; else w = (2u << (tl - lo)) - 1u;
            MASK[(size_t)tok * 64 + lane] = w; continue;
        }
        unsigned key[32]; unsigned vbits = 0u;
#pragma unroll
        for (int i = 0; i < 32; ++i) { const int s = 64 * i + lane; const bool valid = s <= tl;
            const unsigned u = valid ? __float_as_uint(SC[(size_t)tok * SEQ + s]) : 0u;
            key[i] = valid ? ((u >> 31) ? ~u : (u | 0x80000000u)) : 0u; vbits |= valid ? (1u << i) : 0u; }
        unsigned prefix = 0u; int need = 256;
#pragma unroll
        for (int pass = 0; pass < 4; ++pass) {
            const int shift = 24 - 8 * pass;
            hist[4 * lane + 0] = 0u; hist[4 * lane + 1] = 0u; hist[4 * lane + 2] = 0u; hist[4 * lane + 3] = 0u;
            LDS_WAIT(); asm volatile("" ::: "memory");
#pragma unroll
            for (int i = 0; i < 32; ++i) { const bool in = ((vbits >> i) & 1u) && (pass == 0 || (key[i] >> (shift + 8)) == prefix);
                if (in) (void)__hip_atomic_fetch_add(&hist[(key[i] >> shift) & 255u], 1u, __ATOMIC_RELAXED, __HIP_MEMORY_SCOPE_WORKGROUP); }
            LDS_WAIT(); asm volatile("" ::: "memory");
            const unsigned c0 = hist[4 * lane], c1 = hist[4 * lane + 1], c2 = hist[4 * lane + 2], c3 = hist[4 * lane + 3];
            LDS_WAIT(); asm volatile("" ::: "memory");
            const int tot = (int)(c0 + c1 + c2 + c3);
            int incl = tot;
#pragma unroll
            for (int o = 1; o < 64; o <<= 1) { const int t_ = __shfl_down(incl, o); if (lane + o < 64) incl += t_; }
            int cum = incl - tot;
            int fv = -1, fneed = 0;
            { const int cc[4] = {(int)c0, (int)c1, (int)c2, (int)c3};
#pragma unroll
              for (int j = 3; j >= 0; --j) { if (fv < 0 && cum < need && cum + cc[j] >= need) { fv = 4 * lane + j; fneed = need - cum; } cum += cc[j]; } }
            const unsigned long long fm = __ballot(fv >= 0);
            const int src = fm ? (int)__builtin_ctzll(fm) : 0;
            const int v = __shfl(fv, src); need = __shfl(fneed, src);
            prefix = (prefix << 8) | (unsigned)(v & 255);
        }
        unsigned myw = 0u; int cbefore = 0;
#pragma unroll
        for (int i = 0; i < 32; ++i) {
            const bool vld = (vbits >> i) & 1u; const bool eq = vld && key[i] == prefix, gt = vld && key[i] > prefix;
            const unsigned long long em = __ballot(eq);
            const int rank = cbefore + __popcll(em & lt_mask);
            const bool sel = gt || (eq && rank < need);
            cbefore += __popcll(em);
            const unsigned long long bm = __ballot(sel);
            if (lane == 2 * i) myw = (unsigned)bm;
            if (lane == 2 * i + 1) myw = (unsigned)(bm >> 32);
        }
        MASK[(size_t)tok * 64 + lane] = myw;
    }
}
constexpr int R1_OFF = RING_BYTES + 8192;
__device__ __forceinline__ void ph_row1(LAS unsigned char* lds, int l) {
    TIDX;
    const float* xin = (l == 0) ? A->in[I_X] : WS(float, WS_XB); float* XB = WS(float, WS_XB);
    const bf16* Y = WS(bf16, WS_Y); bf16* U = WS(bf16, WS_U);
    unsigned* cnt = WS(unsigned, WS_CTL) + CW_CNT + l * NEXP * 64; unsigned* TOK = WS(unsigned, WS_TOK);
    const float* lg = A->in[I_LN1G] + l * D; const float* lb = A->in[I_LN1B] + l * D;
    LAS float* rw = (LAS float*)lds; LAS unsigned* lcnt = (LAS unsigned*)(lds + R1_OFF); LAS unsigned* lbase = lcnt + 32; LAS unsigned* nrec = lbase + 32; LAS unsigned* rec = nrec + 4;
    { const GAS f32x4* src = (const GAS f32x4*)(WS(float, WS_RWT) + (size_t)l * NEXP * D);
      for (int i = tid; i < NEXP * D / 4; i += 512) ((LAS f32x4*)rw)[i] = src[i];
      if (tid < 32) lcnt[tid] = 0u; if (tid == 32) nrec[0] = 0u; }
    __syncthreads();
    const float rbias = A->in[I_RB][l * NEXP + (lane >> 1)];
    for (int tok = gw; tok < T; tok += ngw) {
        const int b = tok / SEQ; const float* mod = WS(float, WS_MOD) + ((size_t)l * NB + b) * 6144;
        f32x4 v[4]; float s = 0.f;
#pragma unroll
        for (int j = 0; j < 4; ++j) { const int c = 4 * lane + 256 * j;
            const f32x4 x = *(const GAS f32x4*)(xin + (size_t)tok * D + c); const f32x4 g1 = *(const f32x4*)(mod + 2048 + c);
            const unsigned long long yr = *(const GAS unsigned long long*)(Y + (size_t)tok * D + c);
            f32x4 y; y.x = __uint_as_float((unsigned)yr << 16); y.y = __uint_as_float((unsigned)yr & 0xffff0000u); y.z = __uint_as_float((unsigned)(yr >> 32) << 16); y.w = __uint_as_float((unsigned)(yr >> 32) & 0xffff0000u);
            v[j] = x * DN_ALPHA + (1.0f + g1) * y; s += (v[j].x + v[j].y) + (v[j].z + v[j].w); }
        const float mean = wave_sum(s) * (1.0f / D); float s2 = 0.f;
#pragma unroll
        for (int j = 0; j < 4; ++j) { v[j] = v[j] - mean; s2 += (v[j].x * v[j].x + v[j].y * v[j].y) + (v[j].z * v[j].z + v[j].w * v[j].w); }
        const float rstd = 1.0f / sqrtf(wave_sum(s2) * (1.0f / D) + LN_EPS);
        f32x4 u2[4];
#pragma unroll
        for (int j = 0; j < 4; ++j) { const int c = 4 * lane + 256 * j;
            const f32x4 xn = v[j] * rstd * *(const f32x4*)(lg + c) + *(const f32x4*)(lb + c);
            *(GAS f32x4*)(XB + (size_t)tok * D + c) = xn;
            u2[j] = xn * (1.0f + *(const f32x4*)(mod + 4096 + c)) + *(const f32x4*)(mod + 3072 + c);
            *(GAS unsigned long long*)(U + (size_t)tok * D + c) = (unsigned long long)pk2(u2[j].x, u2[j].y) | ((unsigned long long)pk2(u2[j].z, u2[j].w) << 32); }
        float part[32];
#pragma unroll
        for (int e = 0; e < 32; ++e) { float a = 0.f;
#pragma unroll
            for (int j = 0; j < 4; ++j) { const f32x4 w = *(const LAS f32x4*)(rw + e * D + 4 * lane + 256 * j); a += (u2[j].x * w.x + u2[j].y * w.y) + (u2[j].z * w.z + u2[j].w * w.w); }
            part[e] = a; }
#define RSTEP(N, OFF) _Pragma("unroll") for (int e = 0; e < N; ++e) { const bool hi = (lane & OFF) != 0; const float send = hi ? part[e] : part[e + N]; const float recv = __shfl_xor(send, OFF); part[e] = (hi ? part[e + N] : part[e]) + recv; }
        RSTEP(16, 32) RSTEP(8, 16) RSTEP(4, 8) RSTEP(2, 4) RSTEP(1, 2)
#undef RSTEP
        float logit = part[0] + __shfl_xor(part[0], 1) + rbias;
        const int myexp = lane >> 1;
        float tv[4]; int te[4];
#pragma unroll
        for (int k = 0; k < 4; ++k) { float bv = logit; int be = myexp;
#pragma unroll
            for (int o = 2; o < 64; o <<= 1) { const float ov = __shfl_xor(bv, o); const int oe = __shfl_xor(be, o); if (ov > bv || (ov == bv && oe < be)) { bv = ov; be = oe; } }
            tv[k] = bv; te[k] = be; if (myexp == be) logit = -INFINITY; }
        const float e1 = __expf(tv[1] - tv[0]), e2 = __expf(tv[2] - tv[0]), e3 = __expf(tv[3] - tv[0]); const float inv = 1.0f / (1.0f + e1 + e2 + e3);
        if (lane < 4) { const int ek = lane == 0 ? te[0] : lane == 1 ? te[1] : lane == 2 ? te[2] : te[3]; const float pk = (lane == 0 ? 1.0f : lane == 1 ? e1 : lane == 2 ? e2 : e3) * inv;
            const unsigned lp = __hip_atomic_fetch_add(lcnt + ek, 1u, __ATOMIC_RELAXED, __HIP_MEMORY_SCOPE_WORKGROUP);
            const unsigned ri = __hip_atomic_fetch_add(nrec, 1u, __ATOMIC_RELAXED, __HIP_MEMORY_SCOPE_WORKGROUP);
            if (ri < 640u) { LAS unsigned* r = rec + ri * 3; r[0] = (unsigned)tok * 4u + (unsigned)lane; r[1] = (unsigned)ek | (lp << 8); r[2] = __float_as_uint(pk); } }
    }
    __syncthreads();
    if (tid < 32) lbase[tid] = __hip_atomic_fetch_add(cnt + tid * 64, lcnt[tid], __ATOMIC_RELAXED, __HIP_MEMORY_SCOPE_AGENT);
    __syncthreads();
    { const int n = (int)min(nrec[0], 640u);
      for (int i = tid; i < n; i += 512) { const unsigned r0 = rec[i * 3], r1 = rec[i * 3 + 1], r2 = rec[i * 3 + 2]; const unsigned ek = r1 & 255u;
          *(GAS v4u*)(TOK + (size_t)r0 * 4) = (v4u){ek, lbase[ek] + (r1 >> 8), r2, 0u}; } }
    __syncthreads();
}
__device__ __forceinline__ int moe_tables(LAS unsigned char* lds, int l) {
    CArgs* A = kargs();
    LAS unsigned* base = (LAS unsigned*)(lds + TAB_OFF); LAS unsigned char* tile_e = lds + TAB_OFF + 256;
    const unsigned* cnt = WS(unsigned, WS_CTL) + CW_CNT + l * NEXP * 64;
    if (threadIdx.x == 0) { unsigned acc = 0u;
#pragma unroll 1
        for (int e = 0; e < NEXP; ++e) { const unsigned c = __hip_atomic_load(cnt + e * 64, __ATOMIC_RELAXED, __HIP_MEMORY_SCOPE_AGENT); const unsigned nt = (c + 255u) >> 8; base[e] = acc;
#pragma unroll 1
            for (unsigned t = 0; t < nt; ++t) tile_e[(acc >> 8) + t] = (unsigned char)e; acc += nt << 8; }
        base[NEXP] = acc; }
    __syncthreads();
    return (int)(base[NEXP] >> 8);
}
__device__ __forceinline__ void ph_gather(LAS unsigned char* lds, int l) {
    TIDX;
    (void)moe_tables(lds, l);
    const LAS unsigned* base = (const LAS unsigned*)(lds + TAB_OFF);
    const unsigned* TOK = WS(unsigned, WS_TOK); const bf16* U = WS(bf16, WS_U); bf16* XG = WS(bf16, WS_XG);
    for (int task = gw; task < T * 4; task += ngw) {
        const v4u ti = *(const GAS v4u*)(TOK + (size_t)task * 4); const size_t row = (size_t)base[ti.x] + ti.y;
        const GAS v4u* src = (const GAS v4u*)(U + (size_t)(task >> 2) * D) + lane; GAS v4u* dst = (GAS v4u*)(XG + row * D) + lane;
        dst[0] = src[0]; dst[64] = src[64];
    }
    __syncthreads();
}
__device__ __forceinline__ void ph_row2(LAS unsigned char* lds, int l) {
    TIDX;
    (void)moe_tables(lds, l);
    const LAS unsigned* base = (const LAS unsigned*)(lds + TAB_OFF);
    float* XB = WS(float, WS_XB); const bf16* YM = WS(bf16, WS_YM); bf16* U = WS(bf16, WS_U); const unsigned* TOK = WS(unsigned, WS_TOK);
    const float* lg = A->in[I_LN2G] + l * D; const float* lb = A->in[I_LN2B] + l * D; const float* b2 = A->in[I_B2] + (size_t)l * NEXP * D;
    float* dst = (l == DEPTH - 1) ? A->out : XB;
    for (int tok = gw; tok < T; tok += ngw) {
        const int b = tok / SEQ; const float* mod = WS(float, WS_MOD) + ((size_t)l * NB + b) * 6144;
        f32x4 acc[4];
#pragma unroll
        for (int j = 0; j < 4; ++j) acc[j] = (f32x4){0.f, 0.f, 0.f, 0.f};
#pragma unroll
        for (int k = 0; k < 4; ++k) { const v4u ti = *(const GAS v4u*)(TOK + ((size_t)tok * 4 + k) * 4); const size_t row = (size_t)base[ti.x] + ti.y; const float p = __uint_as_float(ti.z);
#pragma unroll
            for (int j = 0; j < 4; ++j) { const int c = 4 * lane + 256 * j; const unsigned long long yr = *(const GAS unsigned long long*)(YM + row * D + c);
                f32x4 y; y.x = __uint_as_float((unsigned)yr << 16); y.y = __uint_as_float((unsigned)yr & 0xffff0000u); y.z = __uint_as_float((unsigned)(yr >> 32) << 16); y.w = __uint_as_float((unsigned)(yr >> 32) & 0xffff0000u);
                acc[j] = acc[j] + p * (y + *(const f32x4*)(b2 + (size_t)ti.x * D + c)); } }
        f32x4 v[4]; float s = 0.f;
#pragma unroll
        for (int j = 0; j < 4; ++j) { const int c = 4 * lane + 256 * j; const f32x4 x = *(const GAS f32x4*)(XB + (size_t)tok * D + c);
            v[j] = x * DN_ALPHA + (1.0f + *(const f32x4*)(mod + 5120 + c)) * acc[j]; s += (v[j].x + v[j].y) + (v[j].z + v[j].w); }
        const float mean = wave_sum(s) * (1.0f / D); float s2 = 0.f;
#pragma unroll
        for (int j = 0; j < 4; ++j) { v[j] = v[j] - mean; s2 += (v[j].x * v[j].x + v[j].y * v[j].y) + (v[j].z * v[j].z + v[j].w * v[j].w); }
        const float rstd = 1.0f / sqrtf(wave_sum(s2) * (1.0f / D) + LN_EPS);
        const float* modn = WS(float, WS_MOD) + ((size_t)(l + 1 < DEPTH ? l + 1 : l) * NB + b) * 6144;
#pragma unroll
        for (int j = 0; j < 4; ++j) { const int c = 4 * lane + 256 * j;
            const f32x4 xn = v[j] * rstd * *(const f32x4*)(lg + c) + *(const f32x4*)(lb + c);
            *(GAS f32x4*)(dst + (size_t)tok * D + c) = xn;
            if (l + 1 < DEPTH) { const f32x4 u = xn * (1.0f + *(const f32x4*)(modn + 1024 + c)) + *(const f32x4*)(modn + c);
                *(GAS unsigned long long*)(U + (size_t)tok * D + c) = (unsigned long long)pk2(u.x, u.y) | ((unsigned long long)pk2(u.z, u.w) << 32); } }
    }
    __syncthreads();
}
__global__ void __launch_bounds__(NWAVES * 64, 2) mega_fwd(Args A_) {
    extern __shared__ __attribute__((aligned(16))) unsigned char lds_raw[];
    LAS unsigned char* lds = (LAS unsigned char*)lds_raw;
    const int tid = threadIdx.x;
    volatile LAS unsigned* MISC = (volatile LAS unsigned*)(lds + MISC_OFF);
    for (int u = tid; u < (LDS_BYTES - TAB_OFF) / 4; u += NWAVES * 64) ((LAS unsigned*)(lds + TAB_OFF))[u] = 0u;
    __syncthreads();
    CArgs* A = kargs(); const bool multi = (A->s_hi - A->s_lo) > 1;
    XcdBarrier bar; bar.bar = WS(unsigned, WS_CTL) + CW_BAR + A->li * XCD_BAR_WORDS; bar.x = 0; bar.st = MISC + 8;
    if (multi) bar = xcd_barrier_post(WS(unsigned, WS_CTL) + CW_BAR + A->li * XCD_BAR_WORDS, MISC + 8);
    const int lo = A->s_lo, hi = A->s_hi;
#ifndef PHMASK
#define PHMASK 0xffffffffu
#endif
#define PHM(b) (((PHMASK) >> (b)) & 1u)
#ifndef RPTMASK
#define RPTMASK 0u
#endif
#define RPT(b) _Pragma("unroll 1") for (int rep_ = 0; rep_ < ((((RPTMASK) >> (b)) & 1u) ? 2 : 1); ++rep_)
#define RUN(s) (lo <= (s) && (s) < hi)
#define SEAM(s) do { if ((s) + 1 < hi) xcd_barrier(bar); } while (0)
    if (RUN(0)) { if (PHM(0)) RPT(0) pro_a(lds_launder(lds)); SEAM(0); }
    if (RUN(1)) { if (PHM(1)) RPT(1) pro_b(); SEAM(1); }
    for (int l = 0; l < DEPTH; ++l) {
        const int sb = 2 + NPH * l;
        if (RUN(sb + PH_IN)) { CArgs* A = kargs();
            pg8::Gemm g{WS(bf16, WS_U), WS(bf16, WS_WIN) + (size_t)l * NHC * D, T, NHC, D}; pg8::StaticOrder S; S.init(T, NHC, (int)gridDim.x, (int)blockIdx.x);
            pg8::EpiIn E{WS(bf16, WS_H), WS(float, WS_CS)};
            if (PHM(2)) RPT(2) pg8::gemm_phase<pg8::EpiIn, pg8::StaticOrder, true, true>(lds_launder(lds), g, S, E);
            SEAM(sb + PH_IN);
        }
        if (RUN(sb + PH_POST)) { if (PHM(3)) RPT(3) ph_post(l); SEAM(sb + PH_POST); }
        if (RUN(sb + PH_MIXA)) { if (PHM(4)) RPT(4) ph_idx_scores(); if (PHM(5)) RPT(5) ph_mlstm_m1(lds_launder(lds), l); if (PHM(6)) RPT(6) ph_diff_attn(lds_launder(lds)); SEAM(sb + PH_MIXA); }
        if (RUN(sb + PH_SEL)) { if (PHM(5)) RPT(5) ph_mlstm_m2(); if (PHM(7)) RPT(7) ph_select(lds_launder(lds)); SEAM(sb + PH_SEL); }
        if (RUN(sb + PH_DSA)) { if (PHM(5)) RPT(5) ph_mlstm_m3(lds_launder(lds), l); if (PHM(8)) RPT(8) { ph_diff_post(l); ph_dsa_attn(lds_launder(lds)); } SEAM(sb + PH_DSA); }
        if (RUN(sb + PH_OUT)) { CArgs* A = kargs();
            pg8::Gemm g{WS(bf16, WS_MIX), WS(bf16, WS_WOUT) + (size_t)l * D * D, T, D, D}; pg8::StaticOrder S; S.init(T, D, (int)gridDim.x, (int)blockIdx.x);
            pg8::EpiBf16<0> E{WS(bf16, WS_Y), D, nullptr, 0, 0, 1.f};
            if (PHM(9)) RPT(9) pg8::gemm_phase<pg8::EpiBf16<0>, pg8::StaticOrder, true, true>(lds_launder(lds), g, S, E);
            SEAM(sb + PH_OUT);
        }
        if (RUN(sb + PH_ROW1)) { if (PHM(10)) RPT(10) ph_row1(lds_launder(lds), l); SEAM(sb + PH_ROW1); }
        if (RUN(sb + PH_GATH)) { if (PHM(11)) RPT(11) ph_gather(lds_launder(lds), l); SEAM(sb + PH_GATH); }
        if (RUN(sb + PH_G1)) { CArgs* A = kargs();
            const int nrt = moe_tables(lds_launder(lds), l);
            pg8::Gemm g{WS(bf16, WS_XG), WS(bf16, WS_W1) + (size_t)l * NEXP * 2048 * D, RPAD, NEXP * 2048, D}; pg8::MoeOrder S; S.init(nrt, 8, (int)gridDim.x, (int)blockIdx.x, (const LAS unsigned char*)(lds_launder(lds) + TAB_OFF + 256));
            pg8::EpiSwiGLU E{WS(bf16, WS_HM), A->in[I_B1] + (size_t)l * NEXP * 2048};
            if (PHM(12)) RPT(12) pg8::gemm_phase<pg8::EpiSwiGLU, pg8::MoeOrder, true, true>(lds_launder(lds), g, S, E);
            SEAM(sb + PH_G1);
        }
        if (RUN(sb + PH_G2)) { CArgs* A = kargs();
            const int nrt = moe_tables(lds_launder(lds), l);
            pg8::Gemm g{WS(bf16, WS_HM), WS(bf16, WS_W2) + (size_t)l * NEXP * D * D, RPAD, NEXP * D, D}; pg8::MoeOrder S; S.init(nrt, 4, (int)gridDim.x, (int)blockIdx.x, (const LAS unsigned char*)(lds_launder(lds) + TAB_OFF + 256));
            pg8::EpiBf16<0> E{WS(bf16, WS_YM), D, nullptr, D, 0, 1.f};
            if (PHM(13)) RPT(13) pg8::gemm_phase<pg8::EpiBf16<0>, pg8::MoeOrder, true, true>(lds_launder(lds), g, S, E);
            SEAM(sb + PH_G2);
        }
        if (RUN(sb + PH_ROW2)) { if (PHM(14)) RPT(14) ph_row2(lds_launder(lds), l); SEAM(sb + PH_ROW2); }
    }
#undef RUN
#undef SEAM
}

#ifndef MK_STEPS_PER_LAUNCH
#define MK_STEPS_PER_LAUNCH 1000
#endif
extern "C" void kernel_launch(void* const* d_in, const int* in_sizes, int n_in, void* d_out, int out_size, void* d_ws, size_t ws_size, hipStream_t stream) {
    static int grid = 0;
    if (grid == 0) {
        if (n_in != 25 || out_size != T * D || ws_size < WS_END3) { fprintf(stderr, "kernel_launch: unexpected shapes (n_in %d out %d ws %zu)\n", n_in, out_size, ws_size); grid = -1; return; }
        int dev = 0, cus = 0, per_cu = 0;
        if (hipGetDevice(&dev) != hipSuccess || hipDeviceGetAttribute(&cus, hipDeviceAttributeMultiprocessorCount, dev) != hipSuccess) { grid = -1; return; }
        if (hipFuncSetAttribute((const void*)mega_fwd, hipFuncAttributeMaxDynamicSharedMemorySize, LDS_BYTES) != hipSuccess) { fprintf(stderr, "kernel_launch: hipFuncSetAttribute failed\n"); grid = -1; return; }
        if (hipOccupancyMaxActiveBlocksPerMultiprocessor(&per_cu, (const void*)mega_fwd, NWAVES * 64, LDS_BYTES) != hipSuccess || per_cu < 1) { fprintf(stderr, "kernel_launch: occupancy query says %d\n", per_cu); }
        (void)hipGetLastError();
        grid = cus;
    }
    if (grid < 0) return;
    if (hipMemsetAsync((char*)d_ws + WS_CTL, 0, CTL_ZERO_BYTES, stream) != hipSuccess) return;
    Args a{};
    for (int i = 0; i < 25; ++i) a.in[i] = (const float*)d_in[i];
    a.out = (float*)d_out; a.ws = (unsigned char*)d_ws;
    int li = 0;
    for (int s = 0; s < NSTEPS; s += MK_STEPS_PER_LAUNCH, ++li) {
        a.s_lo = s; a.s_hi = (s + MK_STEPS_PER_LAUNCH < NSTEPS) ? s + MK_STEPS_PER_LAUNCH : NSTEPS; a.li = li; a.pad = 0;
        hipLaunchKernelGGL(mega_fwd, dim3(grid), dim3(NWAVES * 64), LDS_BYTES, stream, a);
    }
}
```

```cpp
#include <hip/hip_runtime.h>
#include <cstdio>
#include <cstdint>

namespace pg8 {
#define PG8_LAS __attribute__((address_space(3)))
typedef unsigned short bf16_t;
typedef short bf16x8 __attribute__((ext_vector_type(8)));
typedef float f32x4 __attribute__((ext_vector_type(4)));
typedef unsigned u32x4 __attribute__((ext_vector_type(4)));
constexpr int BM = 256, BK = 64, HALF = 128, HTB = HALF * BK * 2  , STAGE_BYTES = 8 * HTB, NXCD = 8, WGM = 8;

__host__ __device__ __forceinline__ int lds_byte(int r, int c) { const int st = (r >> 4) * 2 + (c >> 5), rr = r & 15, cc = c & 31, ob = rr * 64 + cc * 2; return st * 1024 + (ob ^ (((ob >> 9) & 1) << 5)); }
__host__ __device__ __forceinline__ void stage_rc(int b, int& R, int& C) { const int st = b / 1024, sb = b % 1024, swz = sb ^ (((sb >> 9) & 1) << 5); R = (st >> 1) * 16 + swz / 64; C = (st & 1) * 32 + (swz % 64) / 2; }
__host__ __device__ __forceinline__ int perm32(int rho) { const int n = rho >> 4, i = rho & 15; return 8 * (i >> 2) + 4 * n + (i & 3); }

struct Unit { int pm, pn; };
struct Gemm { const bf16_t* A; const bf16_t* Bt; int M, N, K; };

struct StaticOrder {
    int nM, nN, nwg, G, c;
    __host__ __device__ void init(int M, int N, int G_, int c_) { nM = M / BM; nN = N / BM; nwg = nM * nN; G = G_; c = c_; }
    __host__ __device__ bool next(int i, Unit& u) const {
        const long L = (long)i * G + c; if (L >= nwg) return false;
        int wgid = (int)L; { const int q = nwg / NXCD, r = nwg % NXCD, xcd = wgid % NXCD, off = wgid / NXCD; wgid = (xcd < r ? xcd * (q + 1) : r * (q + 1) + (xcd - r) * q) + off; }
        const int nig = WGM * nN, gid = wgid / nig, fm = gid * WGM, gsz = (nM - fm) < WGM ? (nM - fm) : WGM;
        u.pm = fm + ((wgid % nig) % gsz); u.pn = (wgid % nig) / gsz; return true;
    }
    __device__ __forceinline__ void a_ready(const Unit&) const {}
    __device__ __forceinline__ void done(const Unit&) const {}
};
struct MoeOrder {
    int nM, nN, nwg, G, c; const PG8_LAS unsigned char* tile_e;
    __device__ void init(int nRT, int NTN, int G_, int c_, const PG8_LAS unsigned char* te) { nM = nRT; nN = NTN; nwg = nM * nN; G = G_; c = c_; tile_e = te; }
    __device__ bool next(int i, Unit& u) const {
        const long L = (long)i * G + c; if (L >= nwg) return false;
        int wgid = (int)L; { const int q = nwg / NXCD, r = nwg % NXCD, xcd = wgid % NXCD, off = wgid / NXCD; wgid = (xcd < r ? xcd * (q + 1) : r * (q + 1) + (xcd - r) * q) + off; }
        const int nig = WGM * nN, gid = wgid / nig, fm = gid * WGM, gsz = (nM - fm) < WGM ? (nM - fm) : WGM;
        u.pm = fm + ((wgid % nig) % gsz); const int pl = (wgid % nig) / gsz; u.pn = (int)tile_e[u.pm] * nN + pl; return true;
    }
    __device__ __forceinline__ void a_ready(const Unit&) const {}
    __device__ __forceinline__ void done(const Unit&) const {}
};
struct MoeGatherA {
    const unsigned* rowmap; const PG8_LAS unsigned* base; const PG8_LAS unsigned* cnt; const PG8_LAS unsigned char* tile_e; int ntok;
    __device__ __forceinline__ unsigned off(const Unit& u, int h, int rA, int cA, int K) const {
        const int e = tile_e[u.pm]; const unsigned pos = (unsigned)u.pm * 256u - base[e] + 128u * h + (unsigned)rA;
        const unsigned tok = pos < cnt[e] ? rowmap[(size_t)e * ntok + pos] : 0u;
        return (tok * (unsigned)K + (unsigned)cA) * 2u;
    }
};
__device__ __forceinline__ unsigned cvt_pk_bf16(float lo, float hi) { unsigned r; asm volatile("v_cvt_pk_bf16_f32 %0, %1, %2" : "=v"(r) : "v"(lo), "v"(hi)); return r; }
typedef float f32x2 __attribute__((ext_vector_type(2)));
__device__ __forceinline__ f32x2 gelu_pk(f32x2 v) {
    const f32x2 av = __builtin_elementwise_abs(v), d = av * 0.2316418882f + 1.0f;
    f32x2 t; t.x = __builtin_amdgcn_rcpf(d.x); t.y = __builtin_amdgcn_rcpf(d.y);
    f32x2 q = t * 0.5307027145f + (-0.7265760135f); q = q * t + 0.7107068705f; q = q * t + (-0.142248368f); q = q * t + 0.127414796f; q = q * t;
    const f32x2 s = (v * v) * (-0.72134752044f);
    f32x2 e; e.x = __builtin_amdgcn_exp2f(s.x); e.y = __builtin_amdgcn_exp2f(s.y);
    const f32x2 m = v * (q * e), r = v - m;
    f32x2 o; o.x = v.x < 0.f ? m.x : r.x; o.y = v.y < 0.f ? m.y : r.y; return o;
}

template <int ACT  > struct EpiBf16 {
    static constexpr bool PERM = true, AFTER_DRAIN = false; static_assert(ACT == 0 || ACT == 1, "EpiBf16: ACT is 0 (none) or 1 (gelu_pk)");
    bf16_t* O; int ldc; const float* bias; int split_cols; size_t split_stride; float scale0;
    __device__ __forceinline__ void operator()(const f32x4 (&acc)[2][2][4][2], const Unit& u, int wr, int wc, int fr, int fq) const {
        const int row0 = u.pm * BM + wr * 64 + fr; int colt = u.pn * BM; bf16_t* base = O;
        float sc = 1.f; if (split_cols) { const int t = colt / split_cols; base += (size_t)t * split_stride; colt -= t * split_cols; if (t == 0) sc = scale0; }
        const int col0 = colt + wc * 32 + 8 * fq, bcol0 = u.pn * BM + wc * 32 + 8 * fq;
        f32x4 bv[2][2];
#pragma unroll
        for (int bj = 0; bj < 2; ++bj)
#pragma unroll
            for (int n = 0; n < 2; ++n) bv[bj][n] = bias ? *(const f32x4*)(bias + bcol0 + bj * HALF + 4 * n) : (f32x4){0.f, 0.f, 0.f, 0.f};
#pragma unroll
        for (int ai = 0; ai < 2; ++ai)
#pragma unroll
            for (int m = 0; m < 4; ++m) { bf16_t* rowp = base + (size_t)(row0 + ai * HALF + m * 16) * ldc + col0;
#pragma unroll
                for (int bj = 0; bj < 2; ++bj) { f32x4 v0 = acc[ai][bj][m][0] + bv[bj][0], v1 = acc[ai][bj][m][1] + bv[bj][1];
                    if (ACT == 1) { f32x2 a = gelu_pk((f32x2){v0[0], v0[1]}), b = gelu_pk((f32x2){v0[2], v0[3]}), c = gelu_pk((f32x2){v1[0], v1[1]}), d = gelu_pk((f32x2){v1[2], v1[3]});
                        v0 = (f32x4){a.x, a.y, b.x, b.y}; v1 = (f32x4){c.x, c.y, d.x, d.y}; }
                    v0 = v0 * sc; v1 = v1 * sc; u32x4 w; w.x = cvt_pk_bf16(v0[0], v0[1]); w.y = cvt_pk_bf16(v0[2], v0[3]); w.z = cvt_pk_bf16(v1[0], v1[1]); w.w = cvt_pk_bf16(v1[2], v1[3]);
                    *(u32x4*)(rowp + bj * HALF) = w; } }
    }
};
constexpr float C2 = 0.125f * 1.4426950408889634f;
struct EpiIn {
    static constexpr bool PERM = true, AFTER_DRAIN = false;
    bf16_t* O; const float* cs;
    __device__ __forceinline__ void operator()(const f32x4 (&acc)[2][2][4][2], const Unit& u, int wr, int wc, int fr, int fq) const {
        const int pn = u.pn;
        const bool rope = (0x6CF0 >> pn) & 1;
        const float sc = ((0x0430 >> pn) & 1) ? C2 : 1.f;
        const int row0 = u.pm * BM + wr * 64 + fr, col0 = pn * BM + wc * 32 + 8 * fq, i0 = (wc & 1) * 16 + 4 * fq;
#pragma unroll
        for (int ai = 0; ai < 2; ++ai)
#pragma unroll
            for (int m = 0; m < 4; ++m) {
                const int row = row0 + ai * HALF + m * 16;
                f32x4 c01 = (f32x4){1.f, 0.f, 1.f, 0.f}, c23 = c01;
                if (rope) { c01 = *(const f32x4*)(cs + (size_t)row * 64 + i0 * 2); c23 = *(const f32x4*)(cs + (size_t)row * 64 + i0 * 2 + 4); }
                bf16_t* rowp = O + (size_t)row * 4096 + col0;
#pragma unroll
                for (int bj = 0; bj < 2; ++bj) {
                    f32x4 v0 = acc[ai][bj][m][0], v1 = acc[ai][bj][m][1];
                    if (rope) {
                        f32x4 r0, r1;
                        r0[0] = v0[0] * c01[0] - v0[1] * c01[1]; r0[1] = v0[1] * c01[0] + v0[0] * c01[1];
                        r0[2] = v0[2] * c01[2] - v0[3] * c01[3]; r0[3] = v0[3] * c01[2] + v0[2] * c01[3];
                        r1[0] = v1[0] * c23[0] - v1[1] * c23[1]; r1[1] = v1[1] * c23[0] + v1[0] * c23[1];
                        r1[2] = v1[2] * c23[2] - v1[3] * c23[3]; r1[3] = v1[3] * c23[2] + v1[2] * c23[3];
                        v0 = r0; v1 = r1;
                    }
                    v0 = v0 * sc; v1 = v1 * sc;
                    u32x4 w; w.x = cvt_pk_bf16(v0[0], v0[1]); w.y = cvt_pk_bf16(v0[2], v0[3]); w.z = cvt_pk_bf16(v1[0], v1[1]); w.w = cvt_pk_bf16(v1[2], v1[3]);
                    *(u32x4*)(rowp + bj * HALF) = w;
                }
            }
    }
};
struct EpiSwiGLU {
    static constexpr bool PERM = true, AFTER_DRAIN = false;
    bf16_t* O; const float* b1;
    __device__ __forceinline__ void operator()(const f32x4 (&acc)[2][2][4][2], const Unit& u, int wr, int wc, int fr, int fq) const {
        const int e = u.pn >> 3, pl = u.pn & 7, colh = pl * 128 + wc * 32 + 8 * fq;
        const float* bp = b1 + (size_t)e * 2048 + colh;
        f32x4 bg[2], bu[2];
#pragma unroll
        for (int n = 0; n < 2; ++n) { bg[n] = *(const f32x4*)(bp + 4 * n); bu[n] = *(const f32x4*)(bp + 1024 + 4 * n); }
        const int row0 = u.pm * BM + wr * 64 + fr;
#pragma unroll
        for (int ai = 0; ai < 2; ++ai)
#pragma unroll
            for (int m = 0; m < 4; ++m) {
                f32x4 o[2];
#pragma unroll
                for (int n = 0; n < 2; ++n) {
                    const f32x4 g4 = acc[ai][0][m][n] + bg[n], u4 = acc[ai][1][m][n] + bu[n];
#pragma unroll
                    for (int c = 0; c < 4; ++c) {
                        const float g = fminf(g4[c], 7.0f), up = fminf(fmaxf(u4[c], -7.0f), 7.0f);
                        const float sg = __builtin_amdgcn_rcpf(1.0f + __builtin_amdgcn_exp2f(-1.702f * 1.4426950408889634f * g));
                        o[n][c] = (up + 1.0f) * (g * sg);
                    }
                }
                u32x4 w; w.x = cvt_pk_bf16(o[0][0], o[0][1]); w.y = cvt_pk_bf16(o[0][2], o[0][3]); w.z = cvt_pk_bf16(o[1][0], o[1][1]); w.w = cvt_pk_bf16(o[1][2], o[1][3]);
                *(u32x4*)(O + (size_t)(row0 + ai * HALF + m * 16) * 1024 + colh) = w;
            }
    }
};
struct DirectA { __device__ __forceinline__ unsigned off(const Unit& u, int h, int rA, int cA, int K) const { return (unsigned)(((size_t)u.pm * BM + 128 * h + rA) * K + cA) * 2u; } };
template <class Epi, class Sched, bool ALIGN_EPI = false, bool SP2 = false, class AMap = DirectA>
__device__ __forceinline__ void gemm_phase(PG8_LAS unsigned char* lds, const Gemm g, const Sched& S, const Epi& E, const AMap& AM = AMap()) {
    int tid_ = threadIdx.x; asm volatile("" : "+v"(tid_));
    const int tid = tid_, wid = __builtin_amdgcn_readfirstlane(tid >> 6), lane = tid & 63, wr = wid >> 2, wc = wid & 3, fr = lane & 15, fq = lane >> 4;
    const int K = g.K, nt = K / BK;
    unsigned voffB[2]; int rA[2], cA_[2];
#pragma unroll
    for (int i = 0; i < 2; ++i) { int R, C; stage_rc(tid * 16 + i * 8192, R, C); const int Rb = Epi::PERM ? ((R & ~31) + perm32(R & 31)) : R;
        rA[i] = R; cA_[i] = C; voffB[i] = (unsigned)(Rb * K + C) * 2u; }
    const size_t kstep = (size_t)(BK * 2);
    const size_t hstep = (size_t)HALF * K * 2;
    const size_t tstep = 2 * hstep;
    const unsigned ldsw = (unsigned)wid * 1024u;
    const int aoff = lds_byte(wr * 64 + fr, fq * 8), boff = lds_byte(wc * 32 + fr, fq * 8);
#define PG8_SA(b, h) (((b) * 2 + (h)) * HTB)
#define PG8_SB(b, h) ((4 + (b) * 2 + (h)) * HTB)
#define PG8_STAGEA(bufoff, kb, off) do { _Pragma("unroll") for (int _i = 0; _i < 2; ++_i) \
        __builtin_amdgcn_global_load_lds((const unsigned*)(Abase + (kb) + (off)[_i]), (PG8_LAS unsigned*)(lds + (bufoff) + ldsw + _i * 8192), 16, 0, 0); } while (0)
#define PG8_AOFF(dst, u) do { _Pragma("unroll") for (int _h = 0; _h < 2; ++_h) _Pragma("unroll") for (int _i = 0; _i < 2; ++_i) dst[_h][_i] = AM.off(u, _h, rA[_i], cA_[_i], K); } while (0)
#define PG8_STAGE(bufoff, gbase, voff) do { _Pragma("unroll") for (int _i = 0; _i < 2; ++_i) \
        __builtin_amdgcn_global_load_lds((const unsigned*)((const char*)(gbase) + (voff)[_i]), (PG8_LAS unsigned*)(lds + (bufoff) + ldsw + _i * 8192), 16, 0, 0); } while (0)
#define PG8_LDA(dst, b, h) do { _Pragma("unroll") for (int m = 0; m < 4; ++m) _Pragma("unroll") for (int k = 0; k < 2; ++k) dst[m][k] = *(const PG8_LAS bf16x8*)(lds + PG8_SA(b, h) + aoff + m * 2048 + k * 1024); } while (0)
#define PG8_LDB(dst, b, h) do { _Pragma("unroll") for (int n = 0; n < 2; ++n) _Pragma("unroll") for (int k = 0; k < 2; ++k) dst[n][k] = *(const PG8_LAS bf16x8*)(lds + PG8_SB(b, h) + boff + n * 2048 + k * 1024); } while (0)
#define PG8_MMA(ai, bj, At, Bt) do { __builtin_amdgcn_s_setprio(1); _Pragma("unroll") for (int m = 0; m < 4; ++m) _Pragma("unroll") for (int n = 0; n < 2; ++n) _Pragma("unroll") for (int k = 0; k < 2; ++k) \
        acc[ai][bj][m][n] = __builtin_amdgcn_mfma_f32_16x16x32_bf16(Bt[n][k], At[m][k], acc[ai][bj][m][n], 0, 0, 0); __builtin_amdgcn_s_setprio(0); } while (0)
#define PG8_WAIT_V(n) asm volatile("s_waitcnt vmcnt(" #n ")" ::: "memory")
#define PG8_WAIT_L(n) asm volatile("s_waitcnt lgkmcnt(" #n ")" ::: "memory")
#define PG8_BAR __builtin_amdgcn_s_barrier()
#define PG8_SCHED __builtin_amdgcn_sched_barrier(0)
    Unit cur, nxt; int ui = 0;
    if (!S.next(0, cur)) return;
    f32x4 acc[2][2][4][2];
#pragma unroll
    for (int a = 0; a < 2; ++a)
#pragma unroll
        for (int b = 0; b < 2; ++b)
#pragma unroll
            for (int m = 0; m < 4; ++m)
#pragma unroll
                for (int n = 0; n < 2; ++n) acc[a][b][m][n] = (f32x4){0.f, 0.f, 0.f, 0.f};
    bf16x8 At[4][2], B0[2][2], B1[2][2];
    const char* Abase = (const char*)g.A; const char* cB = (const char*)g.Bt + (size_t)cur.pn * tstep;
    unsigned oC[2][2], oN[2][2]; PG8_AOFF(oC, cur);
    S.a_ready(cur);
    if constexpr (SP2) {
        PG8_STAGE(PG8_SB(0, 0), cB, voffB); PG8_STAGE(PG8_SB(0, 1), cB + hstep, voffB); PG8_STAGEA(PG8_SA(0, 0), 0, oC[0]); PG8_STAGEA(PG8_SA(0, 1), 0, oC[1]);
        if (wr == 1) PG8_BAR;
        PG8_WAIT_V(2); PG8_BAR;
        PG8_STAGE(PG8_SB(1, 0), cB + kstep, voffB); PG8_STAGEA(PG8_SA(1, 0), kstep, oC[0]); PG8_STAGE(PG8_SB(1, 1), cB + hstep + kstep, voffB);
        PG8_WAIT_V(6); PG8_BAR;
    } else {
        PG8_STAGE(PG8_SB(0, 0), cB, voffB); PG8_STAGEA(PG8_SA(0, 0), 0, oC[0]); PG8_STAGE(PG8_SB(0, 1), cB + hstep, voffB); PG8_STAGEA(PG8_SA(0, 1), 0, oC[1]);
        if (wr == 1) PG8_BAR;
        PG8_WAIT_V(4); PG8_BAR;
        PG8_STAGE(PG8_SB(1, 0), cB + kstep, voffB); PG8_STAGEA(PG8_SA(1, 0), kstep, oC[0]); PG8_STAGE(PG8_SB(1, 1), cB + hstep + kstep, voffB);
        PG8_WAIT_V(6); PG8_BAR;
    }
    for (;;) {
        const bool has_next = S.next(ui + 1, nxt);
        const char* nB = has_next ? (const char*)g.Bt + (size_t)nxt.pn * tstep : cB;
        if (has_next) { PG8_AOFF(oN, nxt); } else {
#pragma unroll
            for (int _h = 0; _h < 2; ++_h) { oN[_h][0] = oC[_h][0]; oN[_h][1] = oC[_h][1]; } }
        for (int t = 0; t < nt; t += 2) {
            const bool last = (t == nt - 2);
            const size_t ka1 = (size_t)(t + 1) * kstep, ka2 = last ? (size_t)0 : (size_t)(t + 2) * kstep, ka3 = ka2 + kstep;
            unsigned o2[2][2];
#pragma unroll
            for (int _h = 0; _h < 2; ++_h) { o2[_h][0] = last ? oN[_h][0] : oC[_h][0]; o2[_h][1] = last ? oN[_h][1] : oC[_h][1]; }
            const char* b2 = last ? nB : cB + (size_t)(t + 2) * kstep; const char* b3 = b2 + kstep;
            if (last && has_next) S.a_ready(nxt);
            if constexpr (SP2) {
            PG8_LDB(B0, 0, 0); PG8_LDB(B1, 0, 1); PG8_SCHED; PG8_LDA(At, 0, 0); PG8_STAGEA(PG8_SA(1, 1), ka1, oC[1]);
            PG8_WAIT_V(8); PG8_WAIT_L(0); PG8_BAR; PG8_MMA(0, 0, At, B0); PG8_MMA(0, 1, At, B1); PG8_BAR; PG8_SCHED;
            PG8_LDA(At, 0, 1); PG8_STAGE(PG8_SB(0, 0), b2, voffB); PG8_STAGE(PG8_SB(0, 1), b2 + hstep, voffB); PG8_STAGEA(PG8_SA(0, 0), ka2, o2[0]);
            PG8_WAIT_V(8); PG8_WAIT_L(0); PG8_BAR; PG8_MMA(1, 0, At, B0); PG8_MMA(1, 1, At, B1); PG8_BAR; PG8_SCHED;
            PG8_LDB(B0, 1, 0); PG8_LDB(B1, 1, 1); PG8_SCHED; PG8_LDA(At, 1, 0); PG8_STAGEA(PG8_SA(0, 1), ka2, o2[1]);
            PG8_WAIT_V(8); PG8_WAIT_L(0); PG8_BAR; PG8_MMA(0, 0, At, B0); PG8_MMA(0, 1, At, B1); PG8_BAR; PG8_SCHED;
            PG8_LDA(At, 1, 1); PG8_STAGE(PG8_SB(1, 0), b3, voffB); PG8_STAGE(PG8_SB(1, 1), b3 + hstep, voffB); PG8_STAGEA(PG8_SA(1, 0), ka3, o2[0]);
            PG8_WAIT_V(8); PG8_WAIT_L(0); PG8_BAR; PG8_MMA(1, 0, At, B0); PG8_MMA(1, 1, At, B1); PG8_BAR; PG8_SCHED;
            } else {
            PG8_LDB(B0, 0, 0); PG8_SCHED; PG8_LDA(At, 0, 0); PG8_STAGEA(PG8_SA(1, 1), ka1, oC[1]);
            PG8_WAIT_L(8); PG8_BAR; PG8_WAIT_L(0); PG8_MMA(0, 0, At, B0); PG8_BAR; PG8_SCHED;
            PG8_LDB(B1, 0, 1); PG8_STAGE(PG8_SB(0, 0), b2, voffB);
            PG8_BAR; PG8_WAIT_L(0); PG8_MMA(0, 1, At, B1); PG8_BAR;
            PG8_LDA(At, 0, 1); PG8_STAGEA(PG8_SA(0, 0), ka2, o2[0]);
            PG8_BAR; PG8_WAIT_L(0); PG8_MMA(1, 0, At, B0); PG8_BAR; PG8_SCHED;
            PG8_STAGE(PG8_SB(0, 1), b2 + hstep, voffB);
            PG8_WAIT_V(6); PG8_BAR; PG8_MMA(1, 1, At, B1); PG8_BAR;
            PG8_LDB(B0, 1, 0); PG8_SCHED; PG8_LDA(At, 1, 0); PG8_STAGEA(PG8_SA(0, 1), ka2, o2[1]);
            PG8_WAIT_L(8); PG8_BAR; PG8_WAIT_L(0); PG8_MMA(0, 0, At, B0); PG8_BAR; PG8_SCHED;
            PG8_LDB(B1, 1, 1); PG8_STAGE(PG8_SB(1, 0), b3, voffB);
            PG8_BAR; PG8_WAIT_L(0); PG8_MMA(0, 1, At, B1); PG8_BAR;
            PG8_LDA(At, 1, 1); PG8_STAGEA(PG8_SA(1, 0), ka3, o2[0]);
            PG8_BAR; PG8_WAIT_L(0); PG8_MMA(1, 0, At, B0); PG8_BAR; PG8_SCHED;
            PG8_STAGE(PG8_SB(1, 1), b3 + hstep, voffB);
            PG8_WAIT_V(6); PG8_BAR; PG8_MMA(1, 1, At, B1); PG8_BAR;
            }
        }
        if constexpr (ALIGN_EPI) { if (wr == 0) PG8_BAR; }
        if constexpr (!Epi::AFTER_DRAIN) { E(acc, cur, wr, wc, fr, fq); S.done(cur); }
        if (!has_next) break;
#pragma unroll
        for (int a = 0; a < 2; ++a)
#pragma unroll
            for (int b = 0; b < 2; ++b)
#pragma unroll
                for (int m = 0; m < 4; ++m)
#pragma unroll
                    for (int n = 0; n < 2; ++n) acc[a][b][m][n] = (f32x4){0.f, 0.f, 0.f, 0.f};
        cur = nxt; cB = nB; ++ui;
#pragma unroll
        for (int _h = 0; _h < 2; ++_h) { oC[_h][0] = oN[_h][0]; oC[_h][1] = oN[_h][1]; }
        if constexpr (ALIGN_EPI) { if (wr == 1) PG8_BAR; }
    }
    PG8_WAIT_V(0);
    if constexpr (!ALIGN_EPI) { if (wr == 0) PG8_BAR; }
    PG8_BAR;
    if constexpr (Epi::AFTER_DRAIN) { E.fused(acc, cur, wr, wc, fr, fq, lds, wid, lane); S.done(cur); }
#undef PG8_SA
#undef PG8_SB
#undef PG8_STAGE
#undef PG8_STAGEA
#undef PG8_AOFF
#undef PG8_LDA
#undef PG8_LDB
#undef PG8_MMA
#undef PG8_WAIT_V
#undef PG8_WAIT_L
#undef PG8_BAR
#undef PG8_SCHED
}
}
namespace attn_body {
using bf16=unsigned short;
using bf16x8=__attribute__((ext_vector_type(8)))short;
using s16x4=__attribute__((ext_vector_type(4)))short;
using f32x16=__attribute__((ext_vector_type(16)))float;
using u32x4=__attribute__((ext_vector_type(4)))unsigned;
constexpr int SEQ=2048,D=64,DM=4096,DMO=1024;
constexpr int NW=8,QBLK=32,QB=QBLK*NW,KVBLK=64,NQB=SEQ/QB;
__device__ __forceinline__ unsigned f2bf_(float f){unsigned u=__builtin_bit_cast(unsigned,f);return (u+0x7fffu+((u>>16)&1u))>>16;}
__device__ __forceinline__ int crow(int r,int hi){return (r&3)+8*(r>>2)+4*hi;}
#define SBAR() __builtin_amdgcn_sched_barrier(0)
__device__ __forceinline__ void cmask(f32x16&p0,f32x16&p1,int jb,int qrel,int hi){
  const float NEG=-INFINITY; int kb=64*jb+4*hi;
  #pragma unroll
  for(int r=0;r<16;++r){int kv=kb+(r&3)+8*(r>>2); if(kv>qrel)p0[r]=NEG; if(kv+32>qrel)p1[r]=NEG;}
}

__device__ __forceinline__ uint2 mld_asm(const unsigned*p){ uint2 v; asm volatile("global_load_dwordx2 %0, %1, off":"=v"(v):"v"(p):"memory"); return v; }
__device__ __forceinline__ void bmask(f32x16&p0,f32x16&p1,uint2 w,int hi){
  const float NEG=-INFINITY; const unsigned a=w.x>>(4*hi), b=w.y>>(4*hi);
  #pragma unroll
  for(int r=0;r<16;++r){const int bit=(r&3)+8*(r>>2); if(!((a>>bit)&1u))p0[r]=NEG; if(!((b>>bit)&1u))p1[r]=NEG;}
}
constexpr int NSLOT=3, SLOTB=8192;
constexpr int LDS_K=0, LDS_V=NSLOT*SLOTB, LDS_WS=2*NSLOT*SLOTB, LDS_OST=LDS_WS+NW*64*4, LDS_BYTES=LDS_OST+NW*4096;
constexpr float C2=0.125f*1.4426950408889634f;
__device__ __forceinline__ void glds16(const void*gsrc,unsigned lds_dst){unsigned keep;
  asm volatile("s_mov_b32 %0, m0\n\ts_mov_b32 m0, %2\n\ts_nop 0\n\tglobal_load_lds_dwordx4 %1, off\n\ts_mov_b32 m0, %0":"=&s"(keep):"v"(gsrc),"s"(lds_dst):"memory");}
__device__ __forceinline__ float max3f(float a,float b,float c){float r;asm("v_max3_f32 %0, %1, %2, %3":"=v"(r):"v"(a),"v"(b),"v"(c));return r;}
__device__ __forceinline__ float max2f(float a,float b){float r;asm("v_max_f32_e32 %0, %1, %2":"=v"(r):"v"(a),"v"(b));return r;}
__device__ __forceinline__ float fadd_s(float a,float b){float r;asm("v_add_f32_e32 %0, %1, %2":"=v"(r):"v"(a),"v"(b));return r;}
__device__ __forceinline__ float fsub_s(float a,float b){float r;asm("v_sub_f32_e32 %0, %1, %2":"=v"(r):"v"(a),"v"(b));return r;}
typedef float f32x2_t __attribute__((ext_vector_type(2))); typedef __bf16 bf16x2_t __attribute__((ext_vector_type(2)));
__device__ __forceinline__ unsigned cvtpk_s(float lo,float hi){f32x2_t v={lo,hi};bf16x2_t b=__builtin_convertvector(v,bf16x2_t);return __builtin_bit_cast(unsigned,b);}
#define WAIT_BAR(N) asm volatile("s_waitcnt vmcnt(" #N ") lgkmcnt(0)\n\ts_barrier":::"memory")

__device__ __forceinline__ void qkt(f32x16&p0,f32x16&p1,const char*Kslot,const bf16x8*qr,const f32x16&negm,int r32,int hi){
  const char*kb=Kslot+hi*1024+r32*16;
  #pragma unroll
  for(int d0=0;d0<4;++d0){
    const bf16x8 b0=*reinterpret_cast<const bf16x8*>(kb+d0*2048);
    const bf16x8 b1=*reinterpret_cast<const bf16x8*>(kb+d0*2048+512);
    if(d0==0){p0=__builtin_amdgcn_mfma_f32_32x32x16_bf16(b0,qr[0],negm,0,0,0);p1=__builtin_amdgcn_mfma_f32_32x32x16_bf16(b1,qr[0],negm,0,0,0);}
    else{p0=__builtin_amdgcn_mfma_f32_32x32x16_bf16(b0,qr[d0],p0,0,0,0);p1=__builtin_amdgcn_mfma_f32_32x32x16_bf16(b1,qr[d0],p1,0,0,0);}}
}
typedef __attribute__((address_space(3))) const char* lds_cptr;
typedef short v4i16_t __attribute__((ext_vector_type(4)));
__device__ __forceinline__ void kload8(bf16x8*kf,lds_cptr kp){
  kf[0]=*(const __attribute__((address_space(3))) bf16x8*)(kp);      kf[1]=*(const __attribute__((address_space(3))) bf16x8*)(kp+512);
  kf[2]=*(const __attribute__((address_space(3))) bf16x8*)(kp+2048); kf[3]=*(const __attribute__((address_space(3))) bf16x8*)(kp+2560);
  kf[4]=*(const __attribute__((address_space(3))) bf16x8*)(kp+4096); kf[5]=*(const __attribute__((address_space(3))) bf16x8*)(kp+4608);
  kf[6]=*(const __attribute__((address_space(3))) bf16x8*)(kp+6144); kf[7]=*(const __attribute__((address_space(3))) bf16x8*)(kp+6656);
}
__device__ __forceinline__ void kload2(bf16x8*kf,lds_cptr kp,int j){ kf[2*j]=*(const __attribute__((address_space(3))) bf16x8*)(kp+j*2048); kf[2*j+1]=*(const __attribute__((address_space(3))) bf16x8*)(kp+j*2048+512); }
__device__ __forceinline__ s16x4 vtr(lds_cptr p){ return __builtin_bit_cast(s16x4,__builtin_amdgcn_ds_read_tr16_b64_v4i16((__attribute__((address_space(3))) v4i16_t*)p)); }
__device__ __forceinline__ float rowmax(const f32x16&p0,const f32x16&p1){
  float a=max3f(p0[0],p0[1],p1[0]),b=max3f(p0[2],p0[3],p1[1]);a=max3f(a,p1[2],p1[3]);
  #pragma unroll
  for(int r=4;r<16;r+=4){a=max3f(a,p0[r],p0[r+1]);b=max3f(b,p0[r+2],p0[r+3]);a=max3f(a,p1[r],p1[r+1]);b=max3f(b,p1[r+2],p1[r+3]);}
  const float m=max2f(a,b);
  auto rr=__builtin_amdgcn_permlane32_swap(__float_as_uint(m),__float_as_uint(m),false,false);
  return max2f(__uint_as_float(rr[0]),__uint_as_float(rr[1]));
}
__device__ __forceinline__ void pv(f32x16*o,int vb,bf16x8 pa0,bf16x8 pa1,bf16x8 pa2,bf16x8 pa3){
  #pragma unroll
  for(int d0=0;d0<2;++d0){s16x4 lo[4],hi[4];
    #pragma unroll
    for(int ks=0;ks<4;++ks){
      asm volatile("ds_read_b64_tr_b16 %0,%1 offset:%c2":"=&v"(lo[ks]):"v"(vb),"i"(d0*4096+ks*1024):"memory");
      asm volatile("ds_read_b64_tr_b16 %0,%1 offset:%c2":"=&v"(hi[ks]):"v"(vb),"i"(d0*4096+ks*1024+512):"memory");}
    asm volatile("s_waitcnt lgkmcnt(0)":::"memory");SBAR();
    #define PK(k) (bf16x8){lo[k][0],lo[k][1],lo[k][2],lo[k][3],hi[k][0],hi[k][1],hi[k][2],hi[k][3]}
    o[d0]=__builtin_amdgcn_mfma_f32_32x32x16_bf16(pa0,PK(0),o[d0],0,0,0);
    o[d0]=__builtin_amdgcn_mfma_f32_32x32x16_bf16(pa1,PK(1),o[d0],0,0,0);
    o[d0]=__builtin_amdgcn_mfma_f32_32x32x16_bf16(pa2,PK(2),o[d0],0,0,0);
    o[d0]=__builtin_amdgcn_mfma_f32_32x32x16_bf16(pa3,PK(3),o[d0],0,0,0);
    #undef PK
  }
}

#ifndef ATTN_STORE16
#define ATTN_STORE16(p,v) (*(u32x4*)(p)=(v))
#endif
template<int THRL,bool MASKED> __device__ __forceinline__ void attn_unit(int b,int qb,const bf16*Q,const bf16*__restrict__ K,const bf16*__restrict__ V,bf16*O,const unsigned*MASK,char*shm){
  int tid_=threadIdx.x; asm volatile("":"+v"(tid_));
  const int tid=tid_,lane=tid&63,r32=lane&31,hi=lane>>5; const int wid=__builtin_amdgcn_readfirstlane(tid>>6);
  const long rowbase=(long)b*SEQ; const int q0=qb*QB;
  const bf16*Qw=Q+(rowbase+q0+wid*QBLK)*DM;
  const bf16*Kh=K+rowbase*DM,*Vh=V+rowbase*DM;
  const unsigned*mrow=MASK+(size_t)(rowbase+q0+wid*QBLK+r32)*64;
  #define MLD(tt) mld_asm(mrow+2*(tt))
  const unsigned lds0=(unsigned)(uintptr_t)shm;
  float*wsf=(float*)(shm+LDS_WS)+wid*64;
  const bf16*ksrc=Kh+(long)lane*DM+wid*8;
  const bf16*vsrc=Vh+(long)(16*(wid&3)+(lane>>2))*DM+(wid>>2)*32+(lane&3)*8;
  const unsigned kdst=lds0+LDS_K+wid*1024, vdst=lds0+LDS_V+wid*1024;
  #define DMA_K(t,slot) glds16(ksrc+(long)(t)*KVBLK*DM,(unsigned)__builtin_amdgcn_readfirstlane(kdst+(slot)))
  #define DMA_V(t,slot) glds16(vsrc+(long)(t)*KVBLK*DM,(unsigned)__builtin_amdgcn_readfirstlane(vdst+(slot)))
  const int vb0=(int)(lds0+LDS_V)+((lane>>4)&1)*32+(lane&3)*8+(4*hi+((lane&15)>>2))*64;
  const char*Kbase=shm+LDS_K; bf16x8 kf[8];
  const lds_cptr shm3=(lds_cptr)shm; const lds_cptr kp0=shm3+LDS_K+hi*1024+r32*16; const lds_cptr vp0=shm3+LDS_V+((lane>>4)&1)*32+(lane&3)*8+(4*hi+((lane&15)>>2))*64;
  const int NT=(q0+QB)/KVBLK;
  uint2 mw_cur=make_uint2(~0u,~0u), mw_next=make_uint2(~0u,~0u); if(MASKED){ mw_cur=MLD(0); mw_next=MLD(1); }
  DMA_K(0,0);DMA_V(0,0);DMA_K(1,SLOTB);
  bf16x8 qr[4];
  #pragma unroll
  for(int d0=0;d0<4;++d0)qr[d0]=*reinterpret_cast<const bf16x8*>(&Qw[(long)r32*DM+d0*16+hi*8]);
  float mhat=0.f,l_reg=0.f;f32x16 o[2];o[0]=f32x16{};o[1]=f32x16{};f32x16 negm=f32x16{};asm volatile("":"+v"(negm));
  const int qrel=wid*QBLK+r32;
  #define CMASK(P0,P1,t) do{ if(MASKED){bmask(P0,P1,mw_cur,hi);} else {int jb_=(t)-(NT-4); if(jb_>=0)cmask(P0,P1,jb_,qrel,hi);} }while(0)
  bool resc=false;
  #define START(P0,P1) do{ float rm=rowmax(P0,P1); if(MASKED)rm=max2f(rm,-64.f); resc=false; \
    { const float dl=rm; mhat=fadd_s(mhat,dl); \
      _Pragma("unroll") for(int r=0;r<16;++r){P0[r]=fsub_s(P0[r],dl);P1[r]=fsub_s(P1[r],dl);} \
      _Pragma("unroll") for(int r=0;r<16;++r)negm[r]=-mhat; asm volatile("":"+v"(negm)); } \
    _Pragma("unroll") for(int r=0;r<16;++r)P0[r]=__builtin_amdgcn_exp2f(P0[r]); }while(0)
  #define RESC() do{ if(resc){ asm volatile("s_waitcnt lgkmcnt(0)":::"memory"); \
      _Pragma("unroll") for(int d_=0;d_<2;++d_) _Pragma("unroll") for(int r=0;r<16;++r)o[d_][r]*=wsf[crow(r,hi)]; } }while(0)
  f32x16 pA0,pA1,pB0,pB1;
  int sl_prev=0,sl_cur=0,sl_next=SLOTB;
  #define ROT() do{sl_prev=sl_cur;sl_cur=sl_next;sl_next=(sl_next==(NSLOT-1)*SLOTB)?0:sl_next+SLOTB;}while(0)
  DMA_K(2,2*SLOTB);
  WAIT_BAR(3);
  qkt(pA0,pA1,Kbase,qr,negm,r32,hi);asm volatile("s_nop 15\n\ts_nop 7":"+v"(pA0),"+v"(pA1));CMASK(pA0,pA1,0);
  START(pA0,pA1);
  _Pragma("unroll") for(int r=0;r<16;++r)pA1[r]=__builtin_amdgcn_exp2f(pA1[r]);
  WAIT_BAR(0);
  DMA_K(3,0);DMA_V(1,SLOTB);
  ROT();
  kload8(kf,kp0+sl_cur);
  WAIT_BAR(2);
  s16x4 vlo[8],vhi[8]; u32x4 pw0,pw1,pw2,pw3;
  #define PKW(P,B) cvtpk_s(P[B],P[B+1])
  #define PAF(k) __builtin_bit_cast(bf16x8,pw##k)
  #define VFR(i) (bf16x8){vlo[i][0],vlo[i][1],vlo[i][2],vlo[i][3],vhi[i][0],vhi[i][1],vhi[i][2],vhi[i][3]}
  #define PIN(x) asm volatile("":"+v"(x))
  #define MX3(a,b,c) __builtin_fmaxf(__builtin_fmaxf((a),(b)),(c))
  #define GAPA(MF,A0,A1,A2,A3,W0,W1,PW) do{ MF; sacc+=A0; sacc+=A1; sacc+=A2; sacc+=A3; PIN(sacc); W0; W1; PIN(PW); SBAR(); }while(0)
  #define EX(v) __builtin_amdgcn_exp2f(v)
  #define GAPB(MF,X,B) do{ MF; X[B]=EX(X[B]); X[B+1]=EX(X[B+1]); X[B+2]=EX(X[B+2]); X[B+3]=EX(X[B+3]); PIN(X); SBAR(); }while(0)
  #define VRD(i) do{ vlo[i]=vtr(vp_+(((i)>>2)*4096+((i)&3)*1024)); vhi[i]=vtr(vp_+(((i)>>2)*4096+((i)&3)*1024+512)); }while(0)
  #define KRD(G,j) do{ if(G){ kload2(kf,kp0+sl_next,j); SBAR(); } }while(0)
  #define STEP(C0,C1,P0,P1,t,GK,GV,GL) do{ SBAR(); if(MASKED){ mw_cur=mw_next; if((t)+1<NT) mw_next=MLD((t)+1); } \
    const lds_cptr vp_=vp0+sl_prev; \
    VRD(0); SBAR(); float sacc=(P0[0]+P0[1]); \
    GAPA(C0=__builtin_amdgcn_mfma_f32_32x32x16_bf16(kf[0],qr[0],negm,0,0,0), P0[2],P0[3],P0[4],P0[5],     pw0[0]=PKW(P0,0), pw0[1]=PKW(P0,2), pw0); \
    VRD(4); SBAR(); GAPA(C1=__builtin_amdgcn_mfma_f32_32x32x16_bf16(kf[1],qr[0],negm,0,0,0), P0[6],P0[7],P0[8],P0[9],     pw0[2]=PKW(P0,4), pw0[3]=PKW(P0,6), pw0); \
    VRD(1); SBAR(); GAPA(C0=__builtin_amdgcn_mfma_f32_32x32x16_bf16(kf[2],qr[1],C0,0,0,0),   P0[10],P0[11],P0[12],P0[13], pw1[0]=PKW(P0,8), pw1[1]=PKW(P0,10), pw1); \
    VRD(5); SBAR(); GAPA(C1=__builtin_amdgcn_mfma_f32_32x32x16_bf16(kf[3],qr[1],C1,0,0,0),   P0[14],P0[15],P1[0],P1[1],   pw1[2]=PKW(P0,12),pw1[3]=PKW(P0,14), pw1); \
    VRD(2); SBAR(); GAPA(C0=__builtin_amdgcn_mfma_f32_32x32x16_bf16(kf[4],qr[2],C0,0,0,0),   P1[2],P1[3],P1[4],P1[5],     pw2[0]=PKW(P1,0), pw2[1]=PKW(P1,2), pw2); \
    VRD(6); SBAR(); GAPA(C1=__builtin_amdgcn_mfma_f32_32x32x16_bf16(kf[5],qr[2],C1,0,0,0),   P1[6],P1[7],P1[8],P1[9],     pw2[2]=PKW(P1,4), pw2[3]=PKW(P1,6), pw2); \
    VRD(3); SBAR(); GAPA(C0=__builtin_amdgcn_mfma_f32_32x32x16_bf16(kf[6],qr[3],C0,0,0,0),   P1[10],P1[11],P1[12],P1[13], pw3[0]=PKW(P1,8), pw3[1]=PKW(P1,10), pw3); \
    VRD(7); SBAR(); GAPA(C1=__builtin_amdgcn_mfma_f32_32x32x16_bf16(kf[7],qr[3],C1,0,0,0),   P1[14],P1[15],0.f,0.f,       pw3[2]=PKW(P1,12),pw3[3]=PKW(P1,14), pw3); \
    l_reg+=sacc; \
    if(GK){DMA_K((t)+3,sl_cur);} if(GV){DMA_V((t)+1,sl_next);} \
    CMASK(C0,C1,t); \
    { float a=MX3(C0[0],C0[1],C1[0]),b=MX3(C0[2],C0[3],C1[1]); a=MX3(a,C1[2],C1[3]); \
      _Pragma("unroll") for(int r=4;r<16;r+=4){a=MX3(a,C0[r],C0[r+1]);b=MX3(b,C0[r+2],C0[r+3]);a=MX3(a,C1[r],C1[r+1]);b=MX3(b,C1[r+2],C1[r+3]);} \
      float rm=__builtin_fmaxf(a,b); { auto rr=__builtin_amdgcn_permlane32_swap(__float_as_uint(rm),__float_as_uint(rm),false,false); rm=__builtin_fmaxf(__uint_as_float(rr[0]),__uint_as_float(rr[1])); } \
      resc=false; \
      if(__builtin_expect(__any(rm>(float)THRL),0)){ const float dl=__builtin_fmaxf(rm,0.f); mhat+=dl; \
        _Pragma("unroll") for(int r=0;r<16;++r){C0[r]-=dl;C1[r]-=dl;} \
        _Pragma("unroll") for(int r=0;r<16;++r)negm[r]=-mhat; asm volatile("":"+v"(negm)); \
        const float f=__builtin_amdgcn_exp2f(-dl); l_reg*=f; if(hi==0)wsf[r32]=f; resc=true; } } \
    SBAR(); \
    GAPB(o[0]=__builtin_amdgcn_mfma_f32_32x32x16_bf16(PAF(0),VFR(0),o[0],0,0,0), C0,0); \
    GAPB(o[1]=__builtin_amdgcn_mfma_f32_32x32x16_bf16(PAF(0),VFR(4),o[1],0,0,0), C0,4); \
    KRD(GL,0); GAPB(o[0]=__builtin_amdgcn_mfma_f32_32x32x16_bf16(PAF(1),VFR(1),o[0],0,0,0), C0,8); \
    KRD(GL,1); GAPB(o[1]=__builtin_amdgcn_mfma_f32_32x32x16_bf16(PAF(1),VFR(5),o[1],0,0,0), C0,12); \
    KRD(GL,2); GAPB(o[0]=__builtin_amdgcn_mfma_f32_32x32x16_bf16(PAF(2),VFR(2),o[0],0,0,0), C1,0); \
    KRD(GL,3); GAPB(o[1]=__builtin_amdgcn_mfma_f32_32x32x16_bf16(PAF(2),VFR(6),o[1],0,0,0), C1,4); \
    GAPB(o[0]=__builtin_amdgcn_mfma_f32_32x32x16_bf16(PAF(3),VFR(3),o[0],0,0,0), C1,8); \
    GAPB(o[1]=__builtin_amdgcn_mfma_f32_32x32x16_bf16(PAF(3),VFR(7),o[1],0,0,0), C1,12); \
    }while(0)
  int t=1;
  #undef CMASK
  #define CMASK(P0,P1,t) do{ if(MASKED){bmask(P0,P1,mw_cur,hi);} }while(0)
  for(;t+5<NT;t+=2){
    STEP(pB0,pB1,pA0,pA1,t,true,true,true);     WAIT_BAR(2); RESC(); ROT();
    STEP(pA0,pA1,pB0,pB1,t+1,true,true,true);   WAIT_BAR(2); RESC(); ROT();
  }
  #undef CMASK
  #define CMASK(P0,P1,t) do{ if(MASKED){bmask(P0,P1,mw_cur,hi);} else {int jb_=(t)-(NT-4); if(jb_>=0)cmask(P0,P1,jb_,qrel,hi);} }while(0)
  #define ENDW(tt) do{ if((tt)+3<NT){WAIT_BAR(2);} else if((tt)+2<NT){WAIT_BAR(1);} else {WAIT_BAR(0);} }while(0)
  for(;t+1<NT;t+=2){
    STEP(pB0,pB1,pA0,pA1,t,(t+3<NT),(t+1<NT),(t+1<NT));       ENDW(t);   RESC(); ROT();
    STEP(pA0,pA1,pB0,pB1,t+1,(t+4<NT),(t+2<NT),(t+2<NT));     ENDW(t+1); RESC(); ROT();
  }
  STEP(pB0,pB1,pA0,pA1,NT-1,false,false,false); RESC();
  { float sacc=pB0[0]+pB0[1]; _Pragma("unroll") for(int r=2;r<16;++r)sacc+=pB0[r]; _Pragma("unroll") for(int r=0;r<16;++r)sacc+=pB1[r]; l_reg+=sacc;
    pw0=(u32x4){PKW(pB0,0),PKW(pB0,2),PKW(pB0,4),PKW(pB0,6)};pw1=(u32x4){PKW(pB0,8),PKW(pB0,10),PKW(pB0,12),PKW(pB0,14)};pw2=(u32x4){PKW(pB1,0),PKW(pB1,2),PKW(pB1,4),PKW(pB1,6)};pw3=(u32x4){PKW(pB1,8),PKW(pB1,10),PKW(pB1,12),PKW(pB1,14)};
    SBAR(); pv(o,vb0+sl_cur,PAF(0),PAF(1),PAF(2),PAF(3)); }
  #undef PKW
  #undef PAF
  #undef VFR
  #undef PIN
  #undef MX3
  #undef GAPA
  #undef GAPB
  #undef EX
  #undef VRD
  #undef KRD
  #undef STEP
  #undef ENDW
  {auto rr=__builtin_amdgcn_permlane32_swap(__float_as_uint(l_reg),__float_as_uint(l_reg),false,false);l_reg=__uint_as_float(rr[0])+__uint_as_float(rr[1]);}
  if(hi==0)wsf[32+r32]=l_reg;asm volatile("s_waitcnt lgkmcnt(0)":::"memory");
  float rli[16];
  #pragma unroll
  for(int r=0;r<16;++r)rli[r]=__builtin_amdgcn_rcpf(wsf[32+crow(r,hi)]);
  bf16*Ow=O+(rowbase+q0+wid*QBLK)*DMO;
  { bf16*stg=(bf16*)(shm+LDS_OST)+wid*2048;
    #pragma unroll
    for(int r=0;r<16;++r){const int orow=crow(r,hi);
      #pragma unroll
      for(int d0=0;d0<2;++d0)stg[orow*64+d0*32+r32]=(bf16)f2bf_(o[d0][r]*rli[r]);}
    asm volatile("s_waitcnt lgkmcnt(0)":::"memory");
    #pragma unroll
    for(int i=0;i<4;++i){const int row=i*8+(lane>>3),ch=lane&7; const u32x4 v=*(const u32x4*)(stg+row*64+ch*8); ATTN_STORE16(Ow+(long)row*DMO+ch*8,v);} }
  asm volatile("s_waitcnt lgkmcnt(0)\n\ts_barrier":::"memory");
  #undef DMA_K
  #undef DMA_V
  #undef MLD
  #undef CMASK
  #undef START
  #undef RESC
  #undef ROT
}
constexpr int ATTN_LDS_BYTES=LDS_BYTES;
#undef SBAR
#undef WAIT_BAR
}
#define GAS __attribute__((address_space(1)))
#define LAS __attribute__((address_space(3)))
typedef unsigned short bf16;
typedef unsigned v4u __attribute__((ext_vector_type(4)));
typedef float f32x4 __attribute__((ext_vector_type(4)));
typedef short bf16x8 __attribute__((ext_vector_type(8)));
typedef GAS unsigned gu32;
typedef GAS unsigned long long gu64;
#define RLX_AGENT __ATOMIC_RELAXED, __HIP_MEMORY_SCOPE_AGENT
#define LDS_WAIT() asm volatile("s_waitcnt lgkmcnt(0)" ::: "memory")
#define VM_WAIT() asm volatile("s_waitcnt vmcnt(0)" ::: "memory")
__device__ __forceinline__ unsigned long long rt() { return __builtin_amdgcn_s_memrealtime(); }
__device__ __forceinline__ unsigned f2bf(float f) { unsigned u = __builtin_bit_cast(unsigned, f); return (u + 0x7fffu + ((u >> 16) & 1u)) >> 16; }
__device__ __forceinline__ unsigned pk2(float lo, float hi) { return f2bf(lo) | (f2bf(hi) << 16); }
#define XB_TMO      128
#define XB_XCNT(j)  (256  + 64 * (j))
#define XB_XSUB(j)  (1280 + 64 * (j))
#define XB_XGEN(j)  (2304 + 64 * (j))
#define XB_TOP      3328
#define XB_TOPGEN   3392
#define XCD_BAR_WORDS 3456
#define XB_SPIN_CAP (1u << 20)

__device__ __forceinline__ unsigned xb_ld(unsigned* p)              { return __hip_atomic_load(p, __ATOMIC_RELAXED, __HIP_MEMORY_SCOPE_AGENT); }
__device__ __forceinline__ unsigned xb_add(unsigned* p, unsigned v) { return __hip_atomic_fetch_add(p, v, __ATOMIC_RELAXED, __HIP_MEMORY_SCOPE_AGENT); }
__device__ __forceinline__ unsigned xb_xcc_id() { return (unsigned)__builtin_amdgcn_s_getreg((3 << 11) | 20) & 0xFu; }
#define XB_SPIN(cond, bar) do { unsigned _sp = 0; while (cond) { __builtin_amdgcn_s_sleep(1); \
    if ((++_sp & 255u) == 0u) { if (xb_ld(&(bar)[XB_TMO])) break; if (_sp > XB_SPIN_CAP) { atomicAdd(&(bar)[XB_TMO], 1u); break; } } } } while (0)

struct XcdBarrier {
    unsigned* bar; unsigned x;
    volatile LAS unsigned* st;
};

__device__ __forceinline__ XcdBarrier xcd_barrier_post(unsigned* bar, volatile LAS unsigned* st) {
    XcdBarrier b; b.bar = bar; b.x = xb_xcc_id(); b.st = st;
    if (threadIdx.x == 0) (void)xb_add(&bar[XB_XCNT(b.x)], 1u);
    return b;
}
__device__ __forceinline__ void xcd_barrier_complete(unsigned* bar, unsigned x, unsigned& nloc, unsigned& nx) {
    const unsigned G = gridDim.x * gridDim.y * gridDim.z;
    unsigned sum, cnt, mine, sp = 0u;
    for (;;) {
        sum = 0u; cnt = 0u; mine = 0u;
#pragma unroll
        for (unsigned j = 0; j < 16; ++j) { const unsigned c = xb_ld(&bar[XB_XCNT(j)]); sum += c; cnt += (c > 0u) ? 1u : 0u; mine = (j == x) ? c : mine; }
        if (sum == G) break;
        __builtin_amdgcn_s_sleep(1);
        if ((++sp & 255u) == 0u) { if (xb_ld(&bar[XB_TMO])) break; if (sp > XB_SPIN_CAP) { atomicAdd(&bar[XB_TMO], 1u); break; } }
    }
    nloc = mine > 0u ? mine : 1u; nx = cnt > 0u ? cnt : 1u;
}

__device__ __attribute__((noinline)) void xcd_barrier_fn(unsigned* bar_, unsigned x_, volatile LAS unsigned* st_) {
    XcdBarrier b; b.bar = bar_; b.x = x_; b.st = st_;
    asm volatile("s_waitcnt vmcnt(0)" ::: "memory");
    __syncthreads();
    if (threadIdx.x == 0) {
        unsigned* bar = b.bar;
        __builtin_amdgcn_s_waitcnt(0);
        unsigned nloc = b.st[0], nx = b.st[1];
        if (nloc == 0u) { xcd_barrier_complete(bar, b.x, nloc, nx); b.st[0] = nloc; b.st[1] = nx; }
        const unsigned old = xb_add(&bar[XB_XSUB(b.x)], 1u);
        const unsigned gen = old / nloc;
        if (old + 1u == (gen + 1u) * nloc) {
            __builtin_amdgcn_fence(__ATOMIC_RELEASE, "agent");
            asm volatile("s_waitcnt vmcnt(0)" ::: "memory");
            const unsigned og = xb_add(&bar[XB_TOP], 1u);
            const unsigned tg = og / nx;
            if (og + 1u == (tg + 1u) * nx) xb_add(&bar[XB_TOPGEN], 1u);
            else XB_SPIN(xb_ld(&bar[XB_TOPGEN]) == tg, bar);
            __builtin_amdgcn_fence(__ATOMIC_ACQUIRE, "agent");
            xb_add(&bar[XB_XGEN(b.x)], 1u);
            asm volatile("s_waitcnt vmcnt(0)" ::: "memory");
        } else {
            XB_SPIN(xb_ld(&bar[XB_XGEN(b.x)]) == gen, bar);
            __builtin_amdgcn_fence(__ATOMIC_ACQUIRE, "agent");
            asm volatile("s_waitcnt vmcnt(0)" ::: "memory");
        }
    }
    __syncthreads();
}

__device__ __forceinline__ void xcd_barrier(const XcdBarrier& b) { xcd_barrier_fn(b.bar, b.x, b.st); }
constexpr int NB = 16, SEQ = 2048, T = NB * SEQ, D = 1024, DEPTH = 4, NHC = 4096, NEXP = 32, NWAVES = 8;
constexpr int NIN = 3920;
constexpr float LN_EPS = 1e-5f, DN_ALPHA = 1.6817928305074290f;
constexpr int RPAD = T * 4 + NEXP * 256;
constexpr int HC_MQ = 0, HC_MK = 256, HC_MV = 512, HC_MO = 768, HC_DQ = 1024, HC_DK = 1536, HC_DV = 2048, HC_SQ = 2560, HC_SK = 2816, HC_SV = 3072, HC_XQ = 3328, HC_XK = 3840, HC_MI = 3904, HC_MF = 3908, HC_XW = 3912;
constexpr size_t MiB = 1u << 20;
constexpr size_t WS_CTL = 0, CTL_ZERO_BYTES = 2 * MiB;
constexpr size_t WS_MOD = 2 * MiB;
constexpr size_t WS_LAM = WS_MOD + 7 * MiB / 4;
constexpr size_t WS_RWT = 4 * MiB;
constexpr size_t WS_CS = 8 * MiB;
constexpr size_t WS_WIN = 16 * MiB;
constexpr size_t WS_WOUT = 48 * MiB;
constexpr size_t WS_W1 = 64 * MiB;
constexpr size_t WS_W2 = 576 * MiB;
constexpr size_t WS_XB = 832 * MiB;
constexpr size_t WS_U = 960 * MiB;
constexpr size_t WS_H = 1024 * MiB;
constexpr size_t WS_QKC = 1280 * MiB;
constexpr size_t WS_XKP = 1312 * MiB;
constexpr size_t WS_MASK = 1316 * MiB;
constexpr size_t WS_TOK = 1324 * MiB;
constexpr size_t WS_MIX = 1344 * MiB;
constexpr size_t WS_Y = 1408 * MiB;
constexpr size_t WS_SC = 1472 * MiB;
constexpr size_t WS_XG = 1728 * MiB;
constexpr size_t WS_HM = 2000 * MiB;
constexpr size_t WS_YM = 2272 * MiB;
constexpr size_t WS_END = 2544 * MiB;
constexpr int CW_CNT = 1024;
constexpr int CW_BAR = 16384;
constexpr int RING_BYTES = 131072, TAB_OFF = RING_BYTES, MISC_OFF = RING_BYTES + 4096, LDS_BYTES = 147456;
constexpr int NPH = 10, NSTEPS = 2 + NPH * DEPTH;
enum { PH_IN = 0, PH_POST, PH_MIXA, PH_SEL, PH_DSA, PH_OUT, PH_ROW1, PH_G1, PH_G2, PH_ROW2 };

__device__ __forceinline__ float bf2f(bf16 h) { return __uint_as_float((unsigned)h << 16); }
__device__ __forceinline__ float wave_sum(float v) {
#pragma unroll
    for (int o = 1; o < 64; o <<= 1) v += __shfl_xor(v, o);
    return v;
}
__device__ __forceinline__ float wave_max(float v) {
#pragma unroll
    for (int o = 1; o < 64; o <<= 1) v = fmaxf(v, __shfl_xor(v, o));
    return v;
}
__device__ __forceinline__ float sigmoidf_(float x) { return 1.0f / (1.0f + __expf(-x)); }
struct Ctx {
    LAS unsigned char* lds;
    int tid, lane, wave, gw, ngw;
    const float* in[25];
    float* out; unsigned char* ws;
};
#define WSP(type, off) ((type*)(C.ws + (off)))
enum { I_X = 0, I_C, I_POS, I_WIN, I_GATEB, I_CONVW, I_CONVB, I_MNORM, I_DFLAM, I_DFNORM, I_IDXG, I_IDXB, I_WOUT, I_ADAW, I_ADAB, I_LN1G, I_LN1B, I_LN2G, I_LN2B, I_RW, I_RB, I_W1, I_B1, I_W2, I_B2 };

__device__ __forceinline__ int in_dest_col(int n) {
    auto rp = [](int j) { const int hd = j >> 6, d = j & 63; return hd * 64 + ((d < 32) ? 2 * d : 2 * (d - 32) + 1); };
    if (n < 256) return HC_MQ + n;
    if (n < 512) return HC_MK + (n - 256);
    if (n < 768) return HC_MV + (n - 512);
    if (n < 772) return HC_MI + (n - 768);
    if (n < 776) return HC_MF + (n - 772);
    if (n < 1032) return HC_MO + (n - 776);
    if (n < 1544) return HC_DQ + rp(n - 1032);
    if (n < 2056) return HC_DK + rp(n - 1544);
    if (n < 2568) return HC_DV + (n - 2056);
    if (n < 2824) return HC_SQ + rp(n - 2568);
    if (n < 3080) return HC_SK + rp(n - 2824);
    if (n < 3336) return HC_SV + (n - 3080);
    if (n < 3848) return HC_XQ + rp(n - 3336);
    if (n < 3912) return HC_XK + (n - 3848);
    return HC_XW + (n - 3912);
}
template <class F> __device__ __forceinline__ void transpose_item(const float* W, int ldw, int K, int nvalid, int k0, int n0, bf16* WT, LAS float* scr, int lane, F drow) {
    const int nn = n0 + (lane & 31); const bool ok = nn < nvalid;
#pragma unroll 8
    for (int i = 0; i < 32; ++i) { const int kk = 2 * i + (lane >> 5); scr[kk * 33 + (lane & 31)] = ok ? W[(size_t)(k0 + kk) * ldw + nn] : 0.f; }
    LDS_WAIT(); asm volatile("" ::: "memory");
    const int c = lane & 7;
#pragma unroll
    for (int j = 0; j < 4; ++j) { const int n = (lane >> 3) + 8 * j; const LAS float* s = scr + (8 * c) * 33 + n;
        v4u o; o.x = pk2(s[0 * 33], s[1 * 33]); o.y = pk2(s[2 * 33], s[3 * 33]); o.z = pk2(s[4 * 33], s[5 * 33]); o.w = pk2(s[6 * 33], s[7 * 33]);
        if (n0 + n < nvalid) *(GAS v4u*)(WT + (size_t)drow(n0 + n) * K + k0 + 8 * c) = o; }
    LDS_WAIT(); asm volatile("" ::: "memory");
}
struct Args { const float* in[25]; float* out; unsigned char* ws; int s_lo, s_hi, li, pad; };
typedef __attribute__((address_space(4))) const Args CArgs;
__device__ __forceinline__ CArgs* kargs() { CArgs* p = (CArgs*)__builtin_amdgcn_kernarg_segment_ptr(); asm volatile("" : "+s"(p)); return p; }
__device__ __forceinline__ LAS unsigned char* lds_launder(LAS unsigned char* q) { unsigned v = (unsigned)(size_t)q; asm volatile("" : "+s"(v)); return (LAS unsigned char*)(size_t)v; }
#define WS(type, off) ((type*)(A->ws + (off)))
#define TIDX CArgs* A = kargs(); int tid_ = threadIdx.x; asm volatile("" : "+v"(tid_)); const int tid = tid_, lane = tid & 63, wave = __builtin_amdgcn_readfirstlane(tid >> 6); const int gw = blockIdx.x * NWAVES + wave, ngw = gridDim.x * NWAVES; (void)lane; (void)gw; (void)ngw

__device__ __forceinline__ void pro_a(LAS unsigned char* lds) {
    TIDX;
    LAS float* scr = (LAS float*)(lds + wave * 16384);
    constexpr int IT_IN = 16 * 123, IT_OUT = 16 * 32, IT_W1 = 16 * 64, IT_W2 = 16 * 32;
    constexpr int N_IN = DEPTH * IT_IN, N_OUT = DEPTH * IT_OUT, N_W1 = DEPTH * NEXP * IT_W1, N_W2 = DEPTH * NEXP * IT_W2;
    constexpr int NITEMS = N_IN + N_OUT + N_W1 + N_W2;
    for (int it = gw; it < NITEMS; it += ngw) {
        int r = it;
        if (r < N_IN) { const int l = r / IT_IN, q = r % IT_IN, kb = q / 123, nb = q % 123;
            transpose_item(A->in[I_WIN] + (size_t)l * D * NIN, NIN, D, NIN, kb * 64, nb * 32, WS(bf16, WS_WIN) + (size_t)l * NHC * D, scr, lane, [](int n) { return in_dest_col(n); }); continue; }
        r -= N_IN;
        if (r < N_OUT) { const int l = r / IT_OUT, q = r % IT_OUT, kb = q / 32, nb = q % 32;
            transpose_item(A->in[I_WOUT] + (size_t)l * D * D, D, D, D, kb * 64, nb * 32, WS(bf16, WS_WOUT) + (size_t)l * D * D, scr, lane, [](int n) { return n; }); continue; }
        r -= N_OUT;
        if (r < N_W1) { const int le = r / IT_W1, q = r % IT_W1, kb = q / 64, nb = q % 64;
            transpose_item(A->in[I_W1] + (size_t)le * D * 2048, 2048, D, 2048, kb * 64, nb * 32, WS(bf16, WS_W1) + (size_t)le * 2048 * D, scr, lane,
                           [](int n) { const int up = n >> 10, j = n & 1023; return (j >> 7) * 256 + up * 128 + (j & 127); }); continue; }
        r -= N_W1;
        { const int le = r / IT_W2, q = r % IT_W2, kb = q / 32, nb = q % 32;
            transpose_item(A->in[I_W2] + (size_t)le * D * D, D, D, D, kb * 64, nb * 32, WS(bf16, WS_W2) + (size_t)le * D * D, scr, lane, [](int n) { return n; }); }
    }
    for (int r = gw; r < DEPTH * (NHC - NIN); r += ngw) { const int l = r / (NHC - NIN), row = NIN + r % (NHC - NIN);
        GAS v4u* p = (GAS v4u*)(WS(bf16, WS_WIN) + ((size_t)l * NHC + row) * D) + lane; p[0] = (v4u){0u, 0u, 0u, 0u}; p[64] = (v4u){0u, 0u, 0u, 0u}; }
    for (int idx = blockIdx.x * 512 + tid; idx < T * 32; idx += gridDim.x * 512) {
        const int tok = idx >> 5, i = idx & 31;
        const double inv = exp(-(double)i * (9.210340371976184 / 32.0));
        const double ang = (double)((const int*)A->in[I_POS])[tok] * inv;
        const double rev = ang * 0.15915494309189535;
        const float fr = (float)(rev - rint(rev));
        float2 v; v.x = __builtin_amdgcn_cosf(fr); v.y = __builtin_amdgcn_sinf(fr);
        WS(float2, WS_CS)[idx] = v;
    }
    for (int idx = blockIdx.x * 512 + tid; idx < DEPTH * NEXP * D; idx += gridDim.x * 512) {
        const int l = idx / (NEXP * D), r = idx % (NEXP * D), e = r / D, d = r % D;
        WS(float, WS_RWT)[idx] = A->in[I_RW][((size_t)l * D + d) * NEXP + e];
    }
    if (blockIdx.x == 0 && wave == 0) {
        for (int l = 0; l < DEPTH; ++l) { const float* lf = A->in[I_DFLAM] + l * 256;
            const float a = wave_sum(lf[lane] * lf[64 + lane]), b = wave_sum(lf[128 + lane] * lf[192 + lane]);
            if (lane == 0) WS(float, WS_LAM)[l] = __expf(a) - __expf(b) + (0.8f - 0.6f * __expf(-0.3f * (float)l)); }
    }
    __syncthreads();
    if (blockIdx.x < (DEPTH * 6144) / 512) {
        LAS float* ca = (LAS float*)lds;
        for (int i = tid; i < NB * D; i += 512) { const float v = A->in[I_C][i]; ca[i] = v / (1.0f + __expf(-v)); }
        __syncthreads();
        const int col = blockIdx.x * 512 + tid, l = col / 6144, m = col % 6144;
        const float* w = A->in[I_ADAW] + (size_t)l * D * 6144 + m;
        float acc[NB];
#pragma unroll
        for (int b = 0; b < NB; ++b) acc[b] = 0.f;
        for (int d = 0; d < D; ++d) { const float wv = w[(size_t)d * 6144];
#pragma unroll
            for (int b = 0; b < NB; ++b) acc[b] += ca[b * D + d] * wv; }
        const float bias = A->in[I_ADAB][col];
#pragma unroll
        for (int b = 0; b < NB; ++b) WS(float, WS_MOD)[((size_t)l * NB + b) * 6144 + m] = acc[b] + bias;
        __syncthreads();
    }
}
__device__ __forceinline__ void pro_b() {
    TIDX;
    for (int tok = gw; tok < T; tok += ngw) {
        const int b = tok / SEQ; const float* mod = WS(float, WS_MOD) + (size_t)b * 6144;
        const GAS f32x4* xr = (const GAS f32x4*)(A->in[I_X] + (size_t)tok * D) + lane;
        GAS unsigned long long* o8 = (GAS unsigned long long*)(WS(bf16, WS_U) + (size_t)tok * D) + lane;
#pragma unroll
        for (int j = 0; j < 4; ++j) { const f32x4 x = xr[64 * j]; const f32x4 sh = *(const f32x4*)(mod + 4 * lane + 256 * j), sc = *(const f32x4*)(mod + 1024 + 4 * lane + 256 * j);
            const f32x4 u = x * (1.0f + sc) + sh; o8[64 * j] = (unsigned long long)pk2(u.x, u.y) | ((unsigned long long)pk2(u.z, u.w) << 32); }
    }
}
__device__ __forceinline__ void ph_post(int l) {
    TIDX;
    const bf16* H = WS(bf16, WS_H); bf16* XKP = WS(bf16, WS_XKP); bf16* QKC = WS(bf16, WS_QKC);
    const float* cw = A->in[I_CONVW] + (size_t)l * 4 * 512; const float* cb = A->in[I_CONVB] + (size_t)l * 512;
    const float gi = A->in[I_IDXG][l * 64 + lane], bi = A->in[I_IDXB][l * 64 + lane];
    for (int tok = gw; tok < T; tok += ngw) {
        const bf16* hrow = H + (size_t)tok * NHC;
        {
            const float v = bf2f(hrow[HC_XK + lane]);
            const float mean = wave_sum(v) * (1.0f / 64.0f); const float dv = v - mean;
            const float var = wave_sum(dv * dv) * (1.0f / 64.0f);
            const float nv = dv * (1.0f / sqrtf(var + LN_EPS)) * gi + bi;
            const float pv = __shfl_xor(nv, 32);
            const int i = lane & 31; const float2 cs = WS(float2, WS_CS)[(size_t)tok * 32 + i];
            const float o = (lane < 32) ? (nv * cs.x - pv * cs.y) : (nv * cs.x + pv * cs.y);
            XKP[(size_t)tok * 64 + 2 * i + (lane >> 5)] = (bf16)f2bf(o);
        }
        {
            const int s = tok % SEQ, c0 = 8 * lane;
            float acc[8];
#pragma unroll
            for (int c = 0; c < 8; ++c) acc[c] = cb[c0 + c];
#pragma unroll
            for (int j = 0; j < 4; ++j) {
                if (s - 3 + j >= 0) {
                    const v4u raw = *(const GAS v4u*)(H + (size_t)(tok - 3 + j) * NHC + c0);
                    const unsigned rw[4] = {raw.x, raw.y, raw.z, raw.w};
#pragma unroll
                    for (int c = 0; c < 8; ++c) { const float x = __uint_as_float((c & 1) ? (rw[c >> 1] & 0xffff0000u) : (rw[c >> 1] << 16)); acc[c] += cw[j * 512 + c0 + c] * x; }
                }
            }
            v4u o;
#define SILU(x) ((x) / (1.0f + __expf(-(x))))
            o.x = pk2(SILU(acc[0]), SILU(acc[1])); o.y = pk2(SILU(acc[2]), SILU(acc[3])); o.z = pk2(SILU(acc[4]), SILU(acc[5])); o.w = pk2(SILU(acc[6]), SILU(acc[7]));
#undef SILU
            *(GAS v4u*)(QKC + (size_t)tok * 512 + c0) = o;
        }
    }
}
typedef float f32x16 __attribute__((ext_vector_type(16)));
__device__ __forceinline__ void ph_idx_scores() {
    TIDX;
    const bf16* H = WS(bf16, WS_H); const bf16* XKP = WS(bf16, WS_XKP); float* SC = WS(float, WS_SC);
    const int r = lane & 31, hh = lane >> 5, ql = r >> 3, hd = r & 7;
    for (int item = blockIdx.x; item < 256; item += gridDim.x) {
        const int g = item >> 5, p = item & 31;
#pragma unroll 1
        for (int sub = 0; sub < 4; ++sub) {
            const int b = 2 * g + (sub >> 1), qblk = (sub & 1) ? 63 - p : p, q0 = qblk * 32 + 4 * wave, tok0 = b * SEQ + q0;
            bf16x8 af[4];
            { const bf16* ap = H + (size_t)(tok0 + ql) * NHC + HC_XQ + hd * 64 + 8 * hh;
#pragma unroll
              for (int ks = 0; ks < 4; ++ks) af[ks] = *(const GAS bf16x8*)(ap + ks * 16); }
            float wv[4][4];
#pragma unroll
            for (int q = 0; q < 4; ++q)
#pragma unroll
                for (int i = 0; i < 4; ++i) wv[q][i] = bf2f(H[(size_t)(tok0 + q) * NHC + HC_XW + 4 * hh + i]);
            const int npair = (qblk + 2) >> 1;
            const bf16* kp = XKP + (size_t)(b * SEQ + r) * 64 + 8 * hh;
            bf16x8 bc[2][4], bn[2][4];
#pragma unroll
            for (int t2 = 0; t2 < 2; ++t2)
#pragma unroll
                for (int ks = 0; ks < 4; ++ks) bc[t2][ks] = *(const GAS bf16x8*)(kp + t2 * 2048 + ks * 16);
            for (int pr = 0; pr < npair; ++pr) {
                const bf16* kn = kp + (size_t)((pr + 1 < npair) ? pr + 1 : pr) * 4096;
#pragma unroll
                for (int t2 = 0; t2 < 2; ++t2)
#pragma unroll
                    for (int ks = 0; ks < 4; ++ks) bn[t2][ks] = *(const GAS bf16x8*)(kn + t2 * 2048 + ks * 16);
#pragma unroll
                for (int t2 = 0; t2 < 2; ++t2) {
                    f32x16 acc = {};
#pragma unroll
                    for (int ks = 0; ks < 4; ++ks) acc = __builtin_amdgcn_mfma_f32_32x32x16_bf16(af[ks], bc[t2][ks], acc, 0, 0, 0);
                    float tot[4];
#pragma unroll
                    for (int q = 0; q < 4; ++q) { float pp = 0.f;
#pragma unroll
                        for (int i = 0; i < 4; ++i) pp += wv[q][i] * fmaxf(acc[4 * q + i], 0.f);
                        tot[q] = pp + __shfl_xor(pp, 32); }
                    const int key = pr * 64 + t2 * 32 + r;
                    const float o0 = hh ? tot[2] : tot[0], o1 = hh ? tot[3] : tot[1];
                    SC[(size_t)(tok0 + 2 * hh) * SEQ + key] = o0; SC[(size_t)(tok0 + 2 * hh + 1) * SEQ + key] = o1;
                }
#pragma unroll
                for (int t2 = 0; t2 < 2; ++t2)
#pragma unroll
                    for (int ks = 0; ks < 4; ++ks) bc[t2][ks] = bn[t2][ks];
            }
        }
    }
}
__device__ __forceinline__ void ph_mlstm(LAS unsigned char* lds, int l) {
    TIDX;
    const bf16* H = WS(bf16, WS_H); const bf16* QKC = WS(bf16, WS_QKC); bf16* MIX = WS(bf16, WS_MIX);
    constexpr int P = 65;
    LAS float* q = (LAS float*)lds; LAS float* k = q + 64 * P; LAS float* v = k + 64 * P; LAS float* Sm = v + 64 * P; LAS float* Cst = Sm + 64 * P;
    LAS float* nst = Cst + 64 * P; LAS float* bcum = nst + 64; LAS float* ii = bcum + 64; LAS float* mt = ii + 64; LAS float* inter = mt + 64; LAS float* den = inter + 64; LAS float* wvv = den + 64; LAS float* sc = wvv + 64;
    for (int unit = blockIdx.x; unit < NB * 4; unit += gridDim.x) {
        const int b = unit >> 2, h = unit & 3;
        const float gbi = A->in[I_GATEB][l * 8 + h], gbf = A->in[I_GATEB][l * 8 + 4 + h];
        for (int i = tid; i < 64 * P; i += 512) Cst[i] = 0.f;
        if (tid < 64) nst[tid] = 0.f;
        if (tid == 0) sc[0] = 0.f;
        __syncthreads();
        for (int ch = 0; ch < SEQ / 64; ++ch) {
            const int tok0 = b * SEQ + ch * 64;
            for (int idx = tid; idx < 4096; idx += 512) { const int rr = idx >> 6, d = idx & 63; const size_t tk = (size_t)(tok0 + rr);
                q[rr * P + d] = bf2f(QKC[tk * 512 + h * 64 + d]) * 0.125f; k[rr * P + d] = bf2f(QKC[tk * 512 + 256 + h * 64 + d]); v[rr * P + d] = bf2f(H[tk * NHC + HC_MV + h * 64 + d]); }
            if (wave == 0) {
                const size_t tk = (size_t)(tok0 + lane);
                const float ip = bf2f(H[tk * NHC + HC_MI + h]) + gbi, fp = bf2f(H[tk * NHC + HC_MF + h]) + gbf;
                float lf = fminf(fp, 0.f) - log1pf(__expf(-fabsf(fp)));
#pragma unroll
                for (int o = 1; o < 64; o <<= 1) { const float t_ = __shfl_up(lf, o); if (lane >= o) lf += t_; }
                ii[lane] = ip; bcum[lane] = lf;
            }
            __syncthreads();
            const float mprev = sc[0];
            if (tid < 64) { const int t = tid; float mx = -INFINITY; const float bt = bcum[t];
                for (int s = 0; s <= t; ++s) mx = fmaxf(mx, bt - bcum[s] + ii[s]);
                const float li = bt + mprev, m_t = fmaxf(li, mx); mt[t] = m_t; inter[t] = __expf(li - m_t); }
            __syncthreads();
            for (int idx = tid; idx < 4096; idx += 512) { const int t = idx >> 6, s = idx & 63; float val = 0.f;
                if (s <= t) { float dot = 0.f;
#pragma unroll 16
                    for (int d = 0; d < 64; ++d) dot += q[t * P + d] * k[s * P + d];
                    val = dot * __expf(bcum[t] - bcum[s] + ii[s] - mt[t]); }
                Sm[t * P + s] = val; }
            __syncthreads();
            if (tid < 64) { const int t = tid; float a = 0.f, qn = 0.f;
                for (int s = 0; s < 64; ++s) a += Sm[t * P + s];
                for (int d = 0; d < 64; ++d) qn += q[t * P + d] * nst[d];
                den[t] = a + inter[t] * qn; }
            float num[8];
#pragma unroll
            for (int j = 0; j < 8; ++j) { const int t = wave + 8 * j, vc = lane; float a = 0.f, qc = 0.f;
                for (int s = 0; s < 64; ++s) a += Sm[t * P + s] * v[s * P + vc];
                for (int d = 0; d < 64; ++d) qc += q[t * P + d] * Cst[d * P + vc];
                num[j] = a + inter[t] * qc; }
            __syncthreads();
#pragma unroll
            for (int j = 0; j < 8; ++j) { const int t = wave + 8 * j, vc = lane; const size_t tk = (size_t)(tok0 + t);
                const float hv = num[j] / fmaxf(fabsf(den[t]), __expf(-mt[t]));
                const float mean = wave_sum(hv) * (1.0f / 64.0f), hc = hv - mean;
                const float rs = 1.0f / sqrtf(wave_sum(hc * hc) * (1.0f / 64.0f) + LN_EPS);
                const float og = sigmoidf_(bf2f(H[tk * NHC + HC_MO + h * 64 + vc]));
                MIX[tk * D + h * 64 + vc] = (bf16)f2bf(og * (hc * rs * A->in[I_MNORM][l * 256 + h * 64 + vc])); }
            if (wave == 0) { const float bl = bcum[63]; const float lw = bl - bcum[lane] + ii[lane];
                const float mnew = fmaxf(bl + mprev, wave_max(lw)); wvv[lane] = __expf(lw - mnew);
                if (lane == 0) { sc[1] = __expf(bl + mprev - mnew); sc[2] = mnew; } }
            __syncthreads();
            { const float decay = sc[1];
#pragma unroll
              for (int j = 0; j < 8; ++j) { const int d = wave + 8 * j, vc = lane; float a = 0.f;
                  for (int s = 0; s < 64; ++s) a += wvv[s] * k[s * P + d] * v[s * P + vc];
                  Cst[d * P + vc] = decay * Cst[d * P + vc] + a; }
              if (tid < 64) { float a = 0.f; for (int s = 0; s < 64; ++s) a += wvv[s] * k[s * P + tid]; nst[tid] = decay * nst[tid] + a; }
              if (tid == 0) sc[0] = sc[2]; }
            __syncthreads();
        }
    }
}
template <int NV> __device__ __forceinline__ void naive_attn_row(const bf16* qp, const bf16* Kb, const bf16* Vb, int tl, const unsigned* maskrow, int lane, float (&o)[NV], float& l_out) {
    float qf[64];
#pragma unroll
    for (int c = 0; c < 8; ++c) { const v4u raw = *(const GAS v4u*)(qp + 8 * c); const unsigned rw[4] = {raw.x, raw.y, raw.z, raw.w};
#pragma unroll
        for (int e = 0; e < 8; ++e) qf[8 * c + e] = __uint_as_float((e & 1) ? (rw[e >> 1] & 0xffff0000u) : (rw[e >> 1] << 16)); }
    float m = -INFINITY, l = 0.f;
#pragma unroll
    for (int n = 0; n < NV; ++n) o[n] = 0.f;
    for (int kb = 0; kb * 64 <= tl; ++kb) {
        const int s = kb * 64 + lane; bool valid = s <= tl;
        if (maskrow) valid = valid && ((maskrow[2 * kb + (lane >> 5)] >> (lane & 31)) & 1u);
        float dot = 0.f;
        const bf16* kr = Kb + (size_t)s * NHC;
#pragma unroll
        for (int c = 0; c < 8; ++c) { const v4u raw = *(const GAS v4u*)(kr + 8 * c); const unsigned rw[4] = {raw.x, raw.y, raw.z, raw.w};
#pragma unroll
            for (int e = 0; e < 8; ++e) dot += qf[8 * c + e] * __uint_as_float((e & 1) ? (rw[e >> 1] & 0xffff0000u) : (rw[e >> 1] << 16)); }
        const float scv = valid ? dot : -INFINITY;
        const float bm = wave_max(scv);
        if (bm == -INFINITY) continue;
        const float mn = fmaxf(m, bm), alpha = __builtin_amdgcn_exp2f(m - mn), p = __builtin_amdgcn_exp2f(scv - mn);
        l = l * alpha + wave_sum(p); m = mn;
#pragma unroll
        for (int n = 0; n < NV; ++n) o[n] *= alpha;
        const int nk = min(64, tl - kb * 64 + 1);
        const bf16* vr = Vb + (size_t)(kb * 64) * NHC + lane;
        for (int j = 0; j < nk; ++j) { const float pj = __shfl(p, j);
#pragma unroll
            for (int n = 0; n < NV; ++n) o[n] += pj * bf2f(vr[(size_t)j * NHC + 64 * n]); }
    }
    l_out = l;
}
__device__ __forceinline__ void ph_diff_naive(int l) {
    TIDX;
    const bf16* H = WS(bf16, WS_H); bf16* MIX = WS(bf16, WS_MIX);
    const float lam = WS(float, WS_LAM)[l], lam_init = 0.8f - 0.6f * __expf(-0.3f * (float)l);
    for (int task = gw; task < T * 4; task += ngw) {
        const int tok = task >> 2, h = task & 3, b = tok / SEQ, tl = tok % SEQ;
        const bf16* Hb = H + (size_t)b * SEQ * NHC;
        float o1[2], o2[2], l1, l2;
        naive_attn_row<2>(H + (size_t)tok * NHC + HC_DQ + (2 * h) * 64, Hb + HC_DK + (2 * h) * 64, Hb + HC_DV + h * 128, tl, nullptr, lane, o1, l1);
        naive_attn_row<2>(H + (size_t)tok * NHC + HC_DQ + (2 * h + 1) * 64, Hb + HC_DK + (2 * h + 1) * 64, Hb + HC_DV + h * 128, tl, nullptr, lane, o2, l2);
        const float i1 = 1.0f / l1, i2 = 1.0f / l2;
        const float d0 = o1[0] * i1 - lam * o2[0] * i2, d1 = o1[1] * i1 - lam * o2[1] * i2;
        const float rs = 1.0f / sqrtf(wave_sum(d0 * d0 + d1 * d1) * (1.0f / 128.0f) + LN_EPS);
        const float* g = A->in[I_DFNORM] + l * 512 + h * 128;
        MIX[(size_t)tok * D + 256 + h * 128 + lane] = (bf16)f2bf(d0 * rs * g[lane] * (1.0f - lam_init));
        MIX[(size_t)tok * D + 256 + h * 128 + 64 + lane] = (bf16)f2bf(d1 * rs * g[64 + lane] * (1.0f - lam_init));
    }
}
__device__ __forceinline__ void ph_dsa_naive() {
    TIDX;
    const bf16* H = WS(bf16, WS_H); bf16* MIX = WS(bf16, WS_MIX); const unsigned* MASK = WS(unsigned, WS_MASK);
    for (int task = gw; task < T * 4; task += ngw) {
        const int tok = task >> 2, h = task & 3, b = tok / SEQ, tl = tok % SEQ;
        const bf16* Hb = H + (size_t)b * SEQ * NHC;
        float o[1], ll;
        naive_attn_row<1>(H + (size_t)tok * NHC + HC_SQ + h * 64, Hb + HC_SK + h * 64, Hb + HC_SV + h * 64, tl, MASK + (size_t)tok * 64, lane, o, ll);
        MIX[(size_t)tok * D + 768 + h * 64 + lane] = (bf16)f2bf(o[0] / ll);
    }
}
constexpr size_t WS_OD = WS_END;
constexpr size_t WS_END2 = WS_END + 64 * MiB;
__device__ __forceinline__ void ph_diff_attn(LAS unsigned char* lds) {
    CArgs* A = kargs();
    const int G = gridDim.x, bx = blockIdx.x, vcu = (G % 8 == 0) ? (bx % 8) * (G / 8) + bx / 8 : bx;
    const bf16* H = WS(bf16, WS_H); bf16* OD = WS(bf16, WS_OD);
    for (int item = vcu; item < NB * 16; item += G) {
        const int b = item >> 4, vh = item & 15, g = vh >> 1, half = vh & 1;
#pragma unroll 1
        for (int qb = 7; qb >= 0; --qb)
            attn_body::attn_unit<8, false>(b, qb, H + HC_DQ + g * 64, H + HC_DK + g * 64, H + HC_DV + (g >> 1) * 128 + half * 64, OD + g * 128 + half * 64, nullptr, (char*)lds);
    }
}
__device__ __forceinline__ void ph_diff_post(int l) {
    TIDX;
    const bf16* OD = WS(bf16, WS_OD); bf16* MIX = WS(bf16, WS_MIX);
    const float lam = WS(float, WS_LAM)[l], lam_init = 0.8f - 0.6f * __expf(-0.3f * (float)l);
    for (int task = gw; task < T * 4; task += ngw) {
        const int tok = task >> 2, h = task & 3;
        const bf16* o1 = OD + (size_t)tok * D + (2 * h) * 128, *o2 = o1 + 128;
        const float d0 = bf2f(o1[lane]) - lam * bf2f(o2[lane]), d1 = bf2f(o1[64 + lane]) - lam * bf2f(o2[64 + lane]);
        const float rs = 1.0f / sqrtf(wave_sum(d0 * d0 + d1 * d1) * (1.0f / 128.0f) + LN_EPS);
        const float* g = A->in[I_DFNORM] + l * 512 + h * 128;
        MIX[(size_t)tok * D + 256 + h * 128 + lane] = (bf16)f2bf(d0 * rs * g[lane] * (1.0f - lam_init));
        MIX[(size_t)tok * D + 256 + h * 128 + 64 + lane] = (bf16)f2bf(d1 * rs * g[64 + lane] * (1.0f - lam_init));
    }
}
__device__ __forceinline__ void ph_dsa_attn(LAS unsigned char* lds) {
    CArgs* A = kargs();
    const int G = gridDim.x, bx = blockIdx.x, vcu = (G % 8 == 0) ? (bx % 8) * (G / 8) + bx / 8 : bx;
    const bf16* H = WS(bf16, WS_H); bf16* MIX = WS(bf16, WS_MIX); const unsigned* MASK = WS(unsigned, WS_MASK);
    for (int item = vcu; item < NB * 4 * 4; item += G) {
        const int bh = item >> 2, p = item & 3, b = bh >> 2, h = bh & 3;
        attn_body::attn_unit<8, true>(b, 7 - p, H + HC_SQ + h * 64, H + HC_SK + h * 64, H + HC_SV + h * 64, MIX + 768 + h * 64, MASK, (char*)lds);
        attn_body::attn_unit<8, true>(b, p, H + HC_SQ + h * 64, H + HC_SK + h * 64, H + HC_SV + h * 64, MIX + 768 + h * 64, MASK, (char*)lds);
    }
}
constexpr size_t WS_DC = WS_END2;
constexpr size_t WS_CST = WS_DC + 32 * MiB;
constexpr size_t WS_DN = WS_CST + 32 * MiB;
constexpr size_t WS_END3 = WS_DN + 4 * MiB;
constexpr size_t WS_DUMMY = WS_END3;
constexpr size_t WS_END4 = WS_DUMMY + 256 * MiB;
typedef float f32x2_ __attribute__((ext_vector_type(2)));
constexpr int MP = 68;
__device__ __forceinline__ float log_sigmoid_(float x) { return fminf(x, 0.f) - log1pf(__expf(-fabsf(x))); }
__device__ __forceinline__ void mlstm_gates(const bf16* H, int tok0, int h, float gbi, float gbf, int lane, LAS float* bcum, LAS float* av) {
    const size_t tk = (size_t)(tok0 + lane);
    const float ip = bf2f(H[tk * NHC + HC_MI + h]) + gbi; float lf = log_sigmoid_(bf2f(H[tk * NHC + HC_MF + h]) + gbf);
#pragma unroll
    for (int o = 1; o < 64; o <<= 1) { const float t_ = __shfl_up(lf, o); if (lane >= o) lf += t_; }
    bcum[lane] = lf; av[lane] = ip - lf;
}
__device__ __forceinline__ void ph_mlstm_m1(LAS unsigned char* lds, int l) {
    TIDX;
    const bf16* H = WS(bf16, WS_H); const bf16* QKC = WS(bf16, WS_QKC);
    float* DC = WS(float, WS_DC); float* DN = WS(float, WS_DN); float* SCAL = WS(float, WS_DN + 2 * MiB);
    LAS float* kS = (LAS float*)lds; LAS float* vS = kS + 64 * MP; LAS float* bcum = vS + 64 * MP; LAS float* av = bcum + 64; LAS float* wv = av + 64;
    const int tb = tid >> 5, cb = tid & 31;
    for (int u = blockIdx.x; u < NB * 4 * 32; u += gridDim.x) {
        const int bh = u >> 5, c = u & 31, b = bh >> 2, h = bh & 3, tok0 = b * SEQ + c * 64;
        for (int idx = tid; idx < 4096; idx += 512) { const int r = idx >> 6, d = idx & 63; const size_t tk = (size_t)(tok0 + r);
            kS[r * MP + d] = bf2f(QKC[tk * 512 + 256 + h * 64 + d]); vS[r * MP + d] = bf2f(H[tk * NHC + HC_MV + h * 64 + d]); }
        if (wave == 0) { mlstm_gates(H, tok0, h, A->in[I_GATEB][l * 8 + h], A->in[I_GATEB][l * 8 + 4 + h], lane, bcum, av); }
        __syncthreads();
        if (wave == 0) { const float a = av[lane], amax = wave_max(a); wv[lane] = __expf(a - amax); if (lane == 0) { SCAL[u * 4 + 0] = bcum[63]; SCAL[u * 4 + 1] = bcum[63] + amax; } }
        __syncthreads();
        float acc[4][2] = {};
#pragma unroll 4
        for (int s = 0; s < 64; ++s) { const float w = wv[s]; const f32x4 kv = *(const LAS f32x4*)(kS + s * MP + 4 * tb); const f32x2_ vv = *(const LAS f32x2_*)(vS + s * MP + 2 * cb);
#pragma unroll
            for (int i = 0; i < 4; ++i) { const float kw = kv[i] * w; acc[i][0] += kw * vv.x; acc[i][1] += kw * vv.y; } }
#pragma unroll
        for (int i = 0; i < 4; ++i) *(f32x2_*)(DC + (size_t)u * 4096 + (4 * tb + i) * 64 + 2 * cb) = (f32x2_){acc[i][0], acc[i][1]};
        if (tid < 64) { float a = 0.f;
#pragma unroll 8
            for (int s = 0; s < 64; ++s) a += wv[s] * kS[s * MP + tid]; DN[(size_t)u * 64 + tid] = a; }
        __syncthreads();
    }
}
__device__ __forceinline__ void ph_mlstm_m2() {
    TIDX;
    const float* DC = WS(float, WS_DC); float* CS = WS(float, WS_CST); const float* DN = WS(float, WS_DN); float* NS = WS(float, WS_DN + 1 * MiB); float* SCAL = WS(float, WS_DN + 2 * MiB);
    for (int item = blockIdx.x; item < NB * 4 * 4; item += gridDim.x) {
        const int bh = item >> 2, qtr = item & 3, e0 = qtr * 1024 + tid * 2;
        float m = 0.f; f32x2_ C = (f32x2_){0.f, 0.f}; float n = 0.f;
#pragma unroll 4
        for (int c = 0; c < 32; ++c) {
            const int u = bh * 32 + c;
            const float bl = SCAL[u * 4 + 0], ml = SCAL[u * 4 + 1];
            *(f32x2_*)(CS + (size_t)u * 4096 + e0) = C;
            if (qtr == 0 && tid < 64) NS[(size_t)u * 64 + tid] = n;
            if (qtr == 0 && tid == 0) SCAL[u * 4 + 2] = m;
            const float mn = fmaxf(bl + m, ml), f1 = __expf(bl + m - mn), f2 = __expf(ml - mn);
            const f32x2_ dc = *(const f32x2_*)(DC + (size_t)u * 4096 + e0);
            C.x = f1 * C.x + f2 * dc.x; C.y = f1 * C.y + f2 * dc.y;
            if (qtr == 0 && tid < 64) n = f1 * n + f2 * DN[(size_t)u * 64 + tid];
            m = mn;
        }
    }
}
__device__ __forceinline__ void ph_mlstm_m3(LAS unsigned char* lds, int l) {
    TIDX;
    const bf16* H = WS(bf16, WS_H); const bf16* QKC = WS(bf16, WS_QKC); bf16* MIX = WS(bf16, WS_MIX);
    const float* CS = WS(float, WS_CST); const float* NS = WS(float, WS_DN + 1 * MiB); const float* SCAL = WS(float, WS_DN + 2 * MiB);
    LAS float* qT = (LAS float*)lds; LAS float* kT = qT + 64 * MP; LAS float* vS = kT + 64 * MP; LAS float* SmT = vS + 64 * MP; LAS float* Cst = SmT + 64 * MP; LAS float* hS = Cst + 64 * MP;
    LAS float* bcum = hS + 64 * MP; LAS float* av = bcum + 64; LAS float* mm = av + 64; LAS float* inter = mm + 64; LAS float* den = inter + 64; LAS float* nst = den + 64;
    const int tb = tid >> 5, cb = tid & 31;
    for (int u = blockIdx.x; u < NB * 4 * 32; u += gridDim.x) {
        const int bh = u >> 5, c = u & 31, b = bh >> 2, h = bh & 3, tok0 = b * SEQ + c * 64;
        const float mc = SCAL[u * 4 + 2];
        for (int idx = tid; idx < 4096; idx += 512) { const int r = idx >> 6, d = idx & 63; const size_t tk = (size_t)(tok0 + r);
            qT[d * MP + r] = bf2f(QKC[tk * 512 + h * 64 + d]) * 0.125f; kT[d * MP + r] = bf2f(QKC[tk * 512 + 256 + h * 64 + d]); vS[r * MP + d] = bf2f(H[tk * NHC + HC_MV + h * 64 + d]);
            Cst[r * MP + d] = CS[(size_t)u * 4096 + idx]; }
        if (tid < 64) nst[tid] = NS[(size_t)u * 64 + tid];
        if (wave == 0) { mlstm_gates(H, tok0, h, A->in[I_GATEB][l * 8 + h], A->in[I_GATEB][l * 8 + 4 + h], lane, bcum, av); }
        __syncthreads();
        if (wave == 0) { float pm = av[lane];
#pragma unroll
            for (int o = 1; o < 64; o <<= 1) { const float t_ = __shfl_up(pm, o); if (lane >= o) pm = fmaxf(pm, t_); }
            const float m_ = fmaxf(mc, pm); mm[lane] = m_; inter[lane] = __expf(mc - m_); }
        __syncthreads();
        {
            float acc[4][2] = {};
#pragma unroll 4
            for (int d = 0; d < 64; ++d) { const f32x4 qv = *(const LAS f32x4*)(qT + d * MP + 4 * tb); const f32x2_ kv = *(const LAS f32x2_*)(kT + d * MP + 2 * cb);
#pragma unroll
                for (int i = 0; i < 4; ++i) { acc[i][0] += qv[i] * kv.x; acc[i][1] += qv[i] * kv.y; } }
#pragma unroll
            for (int j = 0; j < 2; ++j) { const int s = 2 * cb + j; const float as = av[s]; f32x4 o;
#pragma unroll
                for (int i = 0; i < 4; ++i) { const int t = 4 * tb + i; o[i] = (s <= t) ? acc[i][j] * __expf(as - mm[t]) : 0.f; }
                *(LAS f32x4*)(SmT + s * MP + 4 * tb) = o; }
        }
        __syncthreads();
        if (tid < 64) { float a = 0.f, qn = 0.f;
#pragma unroll 8
            for (int s = 0; s < 64; ++s) a += SmT[s * MP + tid];
#pragma unroll 8
            for (int d = 0; d < 64; ++d) qn += qT[d * MP + tid] * nst[d];
            const float dn = a + inter[tid] * qn; den[tid] = 1.0f / fmaxf(fabsf(dn), __expf(-(bcum[tid] + mm[tid]))); }
        {
            float a1[4][2] = {}, a2[4][2] = {};
#pragma unroll 4
            for (int s = 0; s < 64; ++s) { const f32x4 sv = *(const LAS f32x4*)(SmT + s * MP + 4 * tb); const f32x2_ vv = *(const LAS f32x2_*)(vS + s * MP + 2 * cb);
#pragma unroll
                for (int i = 0; i < 4; ++i) { a1[i][0] += sv[i] * vv.x; a1[i][1] += sv[i] * vv.y; } }
#pragma unroll 4
            for (int d = 0; d < 64; ++d) { const f32x4 qv = *(const LAS f32x4*)(qT + d * MP + 4 * tb); const f32x2_ cv = *(const LAS f32x2_*)(Cst + d * MP + 2 * cb);
#pragma unroll
                for (int i = 0; i < 4; ++i) { a2[i][0] += qv[i] * cv.x; a2[i][1] += qv[i] * cv.y; } }
            __syncthreads();
#pragma unroll
            for (int i = 0; i < 4; ++i) { const int t = 4 * tb + i; const float it = inter[t], dv = den[t];
                *(LAS f32x2_*)(hS + t * MP + 2 * cb) = (f32x2_){(a1[i][0] + it * a2[i][0]) * dv, (a1[i][1] + it * a2[i][1]) * dv}; }
        }
        __syncthreads();
#pragma unroll
        for (int j = 0; j < 8; ++j) { const int t = wave + 8 * j, vc = lane; const size_t tk = (size_t)(tok0 + t);
            const float hv = hS[t * MP + vc];
            const float mean = wave_sum(hv) * (1.0f / 64.0f), hc = hv - mean;
            const float rs = 1.0f / sqrtf(wave_sum(hc * hc) * (1.0f / 64.0f) + LN_EPS);
            const float og = sigmoidf_(bf2f(H[tk * NHC + HC_MO + h * 64 + vc]));
            MIX[tk * D + h * 64 + vc] = (bf16)f2bf(og * (hc * rs * A->in[I_MNORM][l * 256 + h * 64 + vc])); }
        __syncthreads();
    }
}
__device__ __forceinline__ int wave_sum_i(int x) {
    x += __builtin_amdgcn_update_dpp(0, x, 0xB1, 0xF, 0xF, true);
    x += __builtin_amdgcn_update_dpp(0, x, 0x4E, 0xF, 0xF, true);
    x += __builtin_amdgcn_update_dpp(0, x, 0x141, 0xF, 0xF, true);
    x += __builtin_amdgcn_update_dpp(0, x, 0x140, 0xF, 0xF, true);
    return __builtin_amdgcn_readlane(x, 0) + __builtin_amdgcn_readlane(x, 16) + __builtin_amdgcn_readlane(x, 32) + __builtin_amdgcn_readlane(x, 48);
}
__device__ __forceinline__ void ph_select() {
    TIDX;
    const float* SC = WS(float, WS_SC); unsigned* MASK = WS(unsigned, WS_MASK);
    for (int tok = gw; tok < T; tok += ngw) {
        const int tl = tok % SEQ, lo = 32 * lane;
        const int nv = min(max(tl + 1 - lo, 0), 32);
        unsigned cand = (nv >= 32) ? 0xffffffffu : ((1u << nv) - 1u);
        if (tl < 256) { MASK[(size_t)tok * 64 + lane] = cand; continue; }
        unsigned a[32];
#pragma unroll
        for (int j = 0; j < 8; ++j) {
            f32x4 v = (f32x4){0.f, 0.f, 0.f, 0.f};
            if (nv > 0) v = *(const GAS f32x4*)(SC + (size_t)tok * SEQ + lo + 4 * j);
#pragma unroll
            for (int c = 0; c < 4; ++c) { unsigned u = __float_as_uint(v[c]); u = (u == 0x80000000u) ? 0u : u; a[4 * j + c] = (u >> 31) ? ~u : (u | 0x80000000u); }
        }
#define TSTAGE(J, M) _Pragma("unroll") for (int k0 = 0; k0 < 32; ++k0) { if ((k0 & J) == 0) { const unsigned t_ = ((a[k0] >> J) ^ a[k0 + J]) & M; a[k0] ^= t_ << J; a[k0 + J] ^= t_; } }
        TSTAGE(16, 0x0000FFFFu) TSTAGE(8, 0x00FF00FFu) TSTAGE(4, 0x0F0F0F0Fu) TSTAGE(2, 0x33333333u) TSTAGE(1, 0x55555555u)
#undef TSTAGE
        unsigned sel = 0u; int need = 256, ncand = tl + 1;
#pragma unroll
        for (int b = 31; b >= 0; --b) {
            if (ncand != need) {
                const unsigned hit = cand & a[b];
                const int cnt = wave_sum_i(__popc(hit));
                if (cnt >= need) { cand = hit; ncand = cnt; }
                else { sel |= hit; cand &= ~a[b]; need -= cnt; ncand -= cnt; }
            }
        }
        if (ncand == need) sel |= cand;
        else {
            const int my = __popc(cand); int incl = my;
#pragma unroll
            for (int o = 1; o < 64; o <<= 1) { const int t_ = __shfl_up(incl, o); if (lane >= o) incl += t_; }
            const int take = min(max(need - (incl - my), 0), my); int taken = 0;
#pragma unroll 1
            for (int k = 0; k < 32; ++k) { if (((cand >> k) & 1u) && taken < take) { sel |= 1u << k; ++taken; } }
        }
        MASK[(size_t)tok * 64 + lane] = sel;
    }
}
constexpr int R1_OFF = RING_BYTES + 8192;
__device__ __forceinline__ void ph_row1(LAS unsigned char* lds, int l, bool dry = false) {
    TIDX;
    const float* xin = (l == 0) ? A->in[I_X] : WS(float, WS_XB); float* XB = dry ? WS(float, WS_DUMMY) : WS(float, WS_XB);
    const bf16* Y = WS(bf16, WS_Y); bf16* U = dry ? WS(bf16, WS_DUMMY + 128 * MiB) : WS(bf16, WS_U);
    unsigned* cnt = dry ? WS(unsigned, WS_DUMMY + 200 * MiB) : WS(unsigned, WS_CTL) + CW_CNT + l * NEXP * 64; unsigned* TOK = dry ? WS(unsigned, WS_DUMMY + 192 * MiB) : WS(unsigned, WS_TOK);
    const float* lg = A->in[I_LN1G] + l * D; const float* lb = A->in[I_LN1B] + l * D;
    unsigned* RMAP = dry ? WS(unsigned, WS_DUMMY + 208 * MiB) : WS(unsigned, WS_XG);
    LAS float* rw = (LAS float*)lds; LAS unsigned* lcnt = (LAS unsigned*)(lds + R1_OFF); LAS unsigned* lbase = lcnt + 32; LAS unsigned* nrec = lbase + 32; LAS unsigned* rec = nrec + 4;
    { const GAS f32x4* src = (const GAS f32x4*)(WS(float, WS_RWT) + (size_t)l * NEXP * D);
      for (int i = tid; i < NEXP * D / 4; i += 512) ((LAS f32x4*)rw)[i] = src[i];
      if (tid < 32) lcnt[tid] = 0u; if (tid == 32) nrec[0] = 0u; }
    __syncthreads();
    const float rbias = A->in[I_RB][l * NEXP + (lane >> 1)];
    f32x4 px[4], pg[4]; unsigned long long py[4];
#define R1_LOAD(tk) do { const float* mod_ = WS(float, WS_MOD) + ((size_t)l * NB + (tk) / SEQ) * 6144; _Pragma("unroll") for (int j = 0; j < 4; ++j) { const int c = 4 * lane + 256 * j; \
        px[j] = *(const GAS f32x4*)(xin + (size_t)(tk) * D + c); pg[j] = *(const GAS f32x4*)(mod_ + 2048 + c); py[j] = *(const GAS unsigned long long*)(Y + (size_t)(tk) * D + c); } } while (0)
    if (gw < T) R1_LOAD(gw);
    for (int tok = gw; tok < T; tok += ngw) {
        const int b = tok / SEQ; const float* mod = WS(float, WS_MOD) + ((size_t)l * NB + b) * 6144;
        f32x4 v[4]; float s = 0.f;
#pragma unroll
        for (int j = 0; j < 4; ++j) {
            const f32x4 x = px[j]; const f32x4 g1 = pg[j];
            const unsigned long long yr = py[j];
            f32x4 y; y.x = __uint_as_float((unsigned)yr << 16); y.y = __uint_as_float((unsigned)yr & 0xffff0000u); y.z = __uint_as_float((unsigned)(yr >> 32) << 16); y.w = __uint_as_float((unsigned)(yr >> 32) & 0xffff0000u);
            v[j] = x * DN_ALPHA + (1.0f + g1) * y; s += (v[j].x + v[j].y) + (v[j].z + v[j].w); }
        if (tok + ngw < T) R1_LOAD(tok + ngw);
        const float mean = wave_sum(s) * (1.0f / D); float s2 = 0.f;
#pragma unroll
        for (int j = 0; j < 4; ++j) { v[j] = v[j] - mean; s2 += (v[j].x * v[j].x + v[j].y * v[j].y) + (v[j].z * v[j].z + v[j].w * v[j].w); }
        const float rstd = 1.0f / sqrtf(wave_sum(s2) * (1.0f / D) + LN_EPS);
        f32x4 u2[4];
#pragma unroll
        for (int j = 0; j < 4; ++j) { const int c = 4 * lane + 256 * j;
            const f32x4 xn = v[j] * rstd * *(const f32x4*)(lg + c) + *(const f32x4*)(lb + c);
            *(GAS f32x4*)(XB + (size_t)tok * D + c) = xn;
            u2[j] = xn * (1.0f + *(const f32x4*)(mod + 4096 + c)) + *(const f32x4*)(mod + 3072 + c);
            *(GAS unsigned long long*)(U + (size_t)tok * D + c) = (unsigned long long)pk2(u2[j].x, u2[j].y) | ((unsigned long long)pk2(u2[j].z, u2[j].w) << 32); }
        float part[32];
#pragma unroll
        for (int e = 0; e < 32; ++e) { float a = 0.f;
#pragma unroll
            for (int j = 0; j < 4; ++j) { const f32x4 w = *(const LAS f32x4*)(rw + e * D + 4 * lane + 256 * j); a += (u2[j].x * w.x + u2[j].y * w.y) + (u2[j].z * w.z + u2[j].w * w.w); }
            part[e] = a; }
#define RSTEP(N, OFF) _Pragma("unroll") for (int e = 0; e < N; ++e) { const bool hi = (lane & OFF) != 0; const float send = hi ? part[e] : part[e + N]; const float recv = __shfl_xor(send, OFF); part[e] = (hi ? part[e + N] : part[e]) + recv; }
        RSTEP(16, 32) RSTEP(8, 16) RSTEP(4, 8) RSTEP(2, 4) RSTEP(1, 2)
#undef RSTEP
        float logit = part[0] + __shfl_xor(part[0], 1) + rbias;
        const int myexp = lane >> 1;
        float tv[4]; int te[4];
#pragma unroll
        for (int k = 0; k < 4; ++k) { float bv = logit; int be = myexp;
#pragma unroll
            for (int o = 2; o < 64; o <<= 1) { const float ov = __shfl_xor(bv, o); const int oe = __shfl_xor(be, o); if (ov > bv || (ov == bv && oe < be)) { bv = ov; be = oe; } }
            tv[k] = bv; te[k] = be; if (myexp == be) logit = -INFINITY; }
        const float e1 = __expf(tv[1] - tv[0]), e2 = __expf(tv[2] - tv[0]), e3 = __expf(tv[3] - tv[0]); const float inv = 1.0f / (1.0f + e1 + e2 + e3);
        if (lane < 4) { const int ek = lane == 0 ? te[0] : lane == 1 ? te[1] : lane == 2 ? te[2] : te[3]; const float pk = (lane == 0 ? 1.0f : lane == 1 ? e1 : lane == 2 ? e2 : e3) * inv;
            const unsigned lp = __hip_atomic_fetch_add(lcnt + ek, 1u, __ATOMIC_RELAXED, __HIP_MEMORY_SCOPE_WORKGROUP);
            const unsigned ri = __hip_atomic_fetch_add(nrec, 1u, __ATOMIC_RELAXED, __HIP_MEMORY_SCOPE_WORKGROUP);
            if (ri < 640u) { LAS unsigned* r = rec + ri * 3; r[0] = (unsigned)tok * 4u + (unsigned)lane; r[1] = (unsigned)ek | (lp << 8); r[2] = __float_as_uint(pk); } }
    }
#undef R1_LOAD
    __syncthreads();
    if (tid < 32) lbase[tid] = __hip_atomic_fetch_add(cnt + tid * 64, lcnt[tid], __ATOMIC_RELAXED, __HIP_MEMORY_SCOPE_AGENT);
    __syncthreads();
    { const int n = (int)min(nrec[0], 640u);
      for (int i = tid; i < n; i += 512) { const unsigned r0 = rec[i * 3], r1 = rec[i * 3 + 1], r2 = rec[i * 3 + 2]; const unsigned ek = r1 & 255u;
          const unsigned pos = lbase[ek] + (r1 >> 8);
          *(GAS v4u*)(TOK + (size_t)r0 * 4) = (v4u){ek, pos, r2, 0u}; RMAP[(size_t)ek * T + pos] = r0 >> 2; } }
    __syncthreads();
}
__device__ __forceinline__ int moe_tables(LAS unsigned char* lds, int l) {
    CArgs* A = kargs();
    LAS unsigned* base = (LAS unsigned*)(lds + TAB_OFF); LAS unsigned char* tile_e = lds + TAB_OFF + 256; LAS unsigned* cntl = (LAS unsigned*)(lds + TAB_OFF + 1024);
    const unsigned* cnt = WS(unsigned, WS_CTL) + CW_CNT + l * NEXP * 64;
    if (threadIdx.x == 0) { unsigned acc = 0u;
#pragma unroll 1
        for (int e = 0; e < NEXP; ++e) { const unsigned c = __hip_atomic_load(cnt + e * 64, __ATOMIC_RELAXED, __HIP_MEMORY_SCOPE_AGENT); const unsigned nt = (c + 255u) >> 8; base[e] = acc; cntl[e] = c;
#pragma unroll 1
            for (unsigned t = 0; t < nt; ++t) tile_e[(acc >> 8) + t] = (unsigned char)e; acc += nt << 8; }
        base[NEXP] = acc; }
    __syncthreads();
    return (int)(base[NEXP] >> 8);
}
__device__ __forceinline__ void ph_row2(LAS unsigned char* lds, int l, bool dry = false) {
    TIDX;
    (void)moe_tables(lds, l);
    const LAS unsigned* base = (const LAS unsigned*)(lds + TAB_OFF);
    float* XB = WS(float, WS_XB); const bf16* YM = WS(bf16, WS_YM); bf16* U = WS(bf16, WS_U); const unsigned* TOK = WS(unsigned, WS_TOK);
    const float* lg = A->in[I_LN2G] + l * D; const float* lb = A->in[I_LN2B] + l * D; const float* b2 = A->in[I_B2] + (size_t)l * NEXP * D;
    float* dst = dry ? WS(float, WS_DUMMY) : (l == DEPTH - 1) ? A->out : XB; bf16* Uw = dry ? WS(bf16, WS_DUMMY + 128 * MiB) : U;
    v4u rcA[4], rcB[4]; unsigned long long yq[4][4]; f32x4 xq[4];
#define R2_REC(dst, tk) do { _Pragma("unroll") for (int k = 0; k < 4; ++k) dst[k] = *(const GAS v4u*)(TOK + ((size_t)(tk) * 4 + k) * 4); } while (0)
#define R2_ROWS(rc, tk) do { _Pragma("unroll") for (int k = 0; k < 4; ++k) { const size_t row_ = (size_t)base[rc[k].x] + rc[k].y; _Pragma("unroll") for (int j = 0; j < 4; ++j) yq[k][j] = *(const GAS unsigned long long*)(YM + row_ * D + 4 * lane + 256 * j); } \
        _Pragma("unroll") for (int j = 0; j < 4; ++j) xq[j] = *(const GAS f32x4*)(XB + (size_t)(tk) * D + 4 * lane + 256 * j); } while (0)
    if (gw < T) { R2_REC(rcA, gw); R2_ROWS(rcA, gw); }
    if (gw + ngw < T) R2_REC(rcB, gw + ngw);
    for (int tok = gw; tok < T; tok += ngw) {
        const int b = tok / SEQ; const float* mod = WS(float, WS_MOD) + ((size_t)l * NB + b) * 6144;
        f32x4 acc[4];
#pragma unroll
        for (int j = 0; j < 4; ++j) acc[j] = (f32x4){0.f, 0.f, 0.f, 0.f};
#pragma unroll
        for (int k = 0; k < 4; ++k) { const float p = __uint_as_float(rcA[k].z);
#pragma unroll
            for (int j = 0; j < 4; ++j) { const int c = 4 * lane + 256 * j; const unsigned long long yr = yq[k][j];
                f32x4 y; y.x = __uint_as_float((unsigned)yr << 16); y.y = __uint_as_float((unsigned)yr & 0xffff0000u); y.z = __uint_as_float((unsigned)(yr >> 32) << 16); y.w = __uint_as_float((unsigned)(yr >> 32) & 0xffff0000u);
                acc[j] = acc[j] + p * (y + *(const f32x4*)(b2 + (size_t)rcA[k].x * D + c)); } }
        f32x4 xc[4];
#pragma unroll
        for (int j = 0; j < 4; ++j) xc[j] = xq[j];
#pragma unroll
        for (int k = 0; k < 4; ++k) rcA[k] = rcB[k];
        if (tok + ngw < T) R2_ROWS(rcA, tok + ngw);
        if (tok + 2 * ngw < T) R2_REC(rcB, tok + 2 * ngw);
        f32x4 v[4]; float s = 0.f;
#pragma unroll
        for (int j = 0; j < 4; ++j) { const int c = 4 * lane + 256 * j; const f32x4 x = xc[j];
            v[j] = x * DN_ALPHA + (1.0f + *(const f32x4*)(mod + 5120 + c)) * acc[j]; s += (v[j].x + v[j].y) + (v[j].z + v[j].w); }
        const float mean = wave_sum(s) * (1.0f / D); float s2 = 0.f;
#pragma unroll
        for (int j = 0; j < 4; ++j) { v[j] = v[j] - mean; s2 += (v[j].x * v[j].x + v[j].y * v[j].y) + (v[j].z * v[j].z + v[j].w * v[j].w); }
        const float rstd = 1.0f / sqrtf(wave_sum(s2) * (1.0f / D) + LN_EPS);
        const float* modn = WS(float, WS_MOD) + ((size_t)(l + 1 < DEPTH ? l + 1 : l) * NB + b) * 6144;
#pragma unroll
        for (int j = 0; j < 4; ++j) { const int c = 4 * lane + 256 * j;
            const f32x4 xn = v[j] * rstd * *(const f32x4*)(lg + c) + *(const f32x4*)(lb + c);
            *(GAS f32x4*)(dst + (size_t)tok * D + c) = xn;
            if (l + 1 < DEPTH) { const f32x4 u = xn * (1.0f + *(const f32x4*)(modn + 1024 + c)) + *(const f32x4*)(modn + c);
                *(GAS unsigned long long*)(Uw + (size_t)tok * D + c) = (unsigned long long)pk2(u.x, u.y) | ((unsigned long long)pk2(u.z, u.w) << 32); } }
    }
#undef R2_REC
#undef R2_ROWS
    __syncthreads();
}
__global__ void __launch_bounds__(NWAVES * 64, 2) mega_fwd(Args A_) {
    extern __shared__ __attribute__((aligned(16))) unsigned char lds_raw[];
    LAS unsigned char* lds = (LAS unsigned char*)lds_raw;
    const int tid = threadIdx.x;
    volatile LAS unsigned* MISC = (volatile LAS unsigned*)(lds + MISC_OFF);
    for (int u = tid; u < (LDS_BYTES - TAB_OFF) / 4; u += NWAVES * 64) ((LAS unsigned*)(lds + TAB_OFF))[u] = 0u;
    __syncthreads();
    CArgs* A = kargs(); const bool multi = (A->s_hi - A->s_lo) > 1;
    XcdBarrier bar; bar.bar = WS(unsigned, WS_CTL) + CW_BAR + A->li * XCD_BAR_WORDS; bar.x = 0; bar.st = MISC + 8;
    if (multi) bar = xcd_barrier_post(WS(unsigned, WS_CTL) + CW_BAR + A->li * XCD_BAR_WORDS, MISC + 8);
    const int lo = A->s_lo, hi = A->s_hi;
#ifndef PHMASK
#define PHMASK 0xffffffffu
#endif
#define PHM(b) (((PHMASK) >> (b)) & 1u)
#ifndef RPTMASK
#define RPTMASK 0u
#endif
#define RPT(b) _Pragma("unroll 1") for (int rep_ = 0; rep_ < ((((RPTMASK) >> (b)) & 1u) ? 2 : 1); ++rep_)
#define RUN(s) (lo <= (s) && (s) < hi)
#define SEAM(s) do { if ((s) + 1 < hi) xcd_barrier(bar); } while (0)
    if (RUN(0)) { if (PHM(0)) RPT(0) pro_a(lds_launder(lds)); SEAM(0); }
    if (RUN(1)) { if (PHM(1)) RPT(1) pro_b(); SEAM(1); }
    for (int l = 0; l < DEPTH; ++l) {
        const int sb = 2 + NPH * l;
        if (RUN(sb + PH_IN)) { CArgs* A = kargs();
            pg8::Gemm g{WS(bf16, WS_U), WS(bf16, WS_WIN) + (size_t)l * NHC * D, T, NHC, D}; pg8::StaticOrder S; S.init(T, NHC, (int)gridDim.x, (int)blockIdx.x);
            pg8::EpiIn E{WS(bf16, WS_H), WS(float, WS_CS)};
            if (PHM(2)) RPT(2) pg8::gemm_phase<pg8::EpiIn, pg8::StaticOrder, true, true>(lds_launder(lds), g, S, E);
            SEAM(sb + PH_IN);
        }
        if (RUN(sb + PH_POST)) { if (PHM(3)) RPT(3) ph_post(l); SEAM(sb + PH_POST); }
        if (RUN(sb + PH_MIXA)) { if (PHM(4)) RPT(4) ph_idx_scores(); if (PHM(5)) RPT(16) ph_mlstm_m1(lds_launder(lds), l); if (PHM(6)) RPT(6) ph_diff_attn(lds_launder(lds)); SEAM(sb + PH_MIXA); }
        if (RUN(sb + PH_SEL)) { if (PHM(5)) RPT(17) ph_mlstm_m2(); if (PHM(7)) RPT(7) ph_select(); SEAM(sb + PH_SEL); }
        if (RUN(sb + PH_DSA)) { if (PHM(5)) RPT(18) ph_mlstm_m3(lds_launder(lds), l); if (PHM(8)) RPT(8) { ph_diff_post(l); ph_dsa_attn(lds_launder(lds)); } SEAM(sb + PH_DSA); }
        if (RUN(sb + PH_OUT)) { CArgs* A = kargs();
            pg8::Gemm g{WS(bf16, WS_MIX), WS(bf16, WS_WOUT) + (size_t)l * D * D, T, D, D}; pg8::StaticOrder S; S.init(T, D, (int)gridDim.x, (int)blockIdx.x);
            pg8::EpiBf16<0> E{WS(bf16, WS_Y), D, nullptr, 0, 0, 1.f};
            if (PHM(9)) RPT(9) pg8::gemm_phase<pg8::EpiBf16<0>, pg8::StaticOrder, true, true>(lds_launder(lds), g, S, E);
            SEAM(sb + PH_OUT);
        }
        if (RUN(sb + PH_ROW1)) { if (PHM(10)) { if ((RPTMASK >> 10) & 1u) ph_row1(lds_launder(lds), l, true); ph_row1(lds_launder(lds), l); } SEAM(sb + PH_ROW1); }
        if (RUN(sb + PH_G1)) { CArgs* A = kargs();
            const int nrt = moe_tables(lds_launder(lds), l);
            pg8::Gemm g{WS(bf16, WS_U), WS(bf16, WS_W1) + (size_t)l * NEXP * 2048 * D, RPAD, NEXP * 2048, D}; pg8::MoeOrder S; S.init(nrt, 8, (int)gridDim.x, (int)blockIdx.x, (const LAS unsigned char*)(lds_launder(lds) + TAB_OFF + 256));
            pg8::EpiSwiGLU E{WS(bf16, WS_HM), A->in[I_B1] + (size_t)l * NEXP * 2048};
            LAS unsigned char* tb = lds_launder(lds) + TAB_OFF;
            pg8::MoeGatherA AM{WS(unsigned, WS_XG), (const LAS unsigned*)tb, (const LAS unsigned*)(tb + 1024), (const LAS unsigned char*)(tb + 256), T};
            if (PHM(12)) RPT(12) pg8::gemm_phase<pg8::EpiSwiGLU, pg8::MoeOrder, true, true, pg8::MoeGatherA>(lds_launder(lds), g, S, E, AM);
            SEAM(sb + PH_G1);
        }
        if (RUN(sb + PH_G2)) { CArgs* A = kargs();
            const int nrt = moe_tables(lds_launder(lds), l);
            pg8::Gemm g{WS(bf16, WS_HM), WS(bf16, WS_W2) + (size_t)l * NEXP * D * D, RPAD, NEXP * D, D}; pg8::MoeOrder S; S.init(nrt, 4, (int)gridDim.x, (int)blockIdx.x, (const LAS unsigned char*)(lds_launder(lds) + TAB_OFF + 256));
            pg8::EpiBf16<0> E{WS(bf16, WS_YM), D, nullptr, D, 0, 1.f};
            if (PHM(13)) RPT(13) pg8::gemm_phase<pg8::EpiBf16<0>, pg8::MoeOrder, true, true>(lds_launder(lds), g, S, E);
            SEAM(sb + PH_G2);
        }
        if (RUN(sb + PH_ROW2)) { if (PHM(14)) { if ((RPTMASK >> 14) & 1u) ph_row2(lds_launder(lds), l, true); ph_row2(lds_launder(lds), l); } SEAM(sb + PH_ROW2); }
    }
#undef RUN
#undef SEAM
}

#ifndef MK_STEPS_PER_LAUNCH
#define MK_STEPS_PER_LAUNCH 1000
#endif
extern "C" void kernel_launch(void* const* d_in, const int* in_sizes, int n_in, void* d_out, int out_size, void* d_ws, size_t ws_size, hipStream_t stream) {
    static int grid = 0;
    if (grid == 0) {
        if (n_in != 25 || out_size != T * D || ws_size < WS_END4) { fprintf(stderr, "kernel_launch: unexpected shapes (n_in %d out %d ws %zu)\n", n_in, out_size, ws_size); grid = -1; return; }
        int dev = 0, cus = 0, per_cu = 0;
        if (hipGetDevice(&dev) != hipSuccess || hipDeviceGetAttribute(&cus, hipDeviceAttributeMultiprocessorCount, dev) != hipSuccess) { grid = -1; return; }
        if (hipFuncSetAttribute((const void*)mega_fwd, hipFuncAttributeMaxDynamicSharedMemorySize, LDS_BYTES) != hipSuccess) { fprintf(stderr, "kernel_launch: hipFuncSetAttribute failed\n"); grid = -1; return; }
        if (hipOccupancyMaxActiveBlocksPerMultiprocessor(&per_cu, (const void*)mega_fwd, NWAVES * 64, LDS_BYTES) != hipSuccess || per_cu < 1) { fprintf(stderr, "kernel_launch: occupancy query says %d\n", per_cu); }
        (void)hipGetLastError();
        grid = cus;
    }
    if (grid < 0) return;
    if (hipMemsetAsync((char*)d_ws + WS_CTL, 0, CTL_ZERO_BYTES, stream) != hipSuccess) return;
    Args a{};
    for (int i = 0; i < 25; ++i) a.in[i] = (const float*)d_in[i];
    a.out = (float*)d_out; a.ws = (unsigned char*)d_ws;
    int li = 0;
    for (int s = 0; s < NSTEPS; s += MK_STEPS_PER_LAUNCH, ++li) {
        a.s_lo = s; a.s_hi = (s + MK_STEPS_PER_LAUNCH < NSTEPS) ? s + MK_STEPS_PER_LAUNCH : NSTEPS; a.li = li; a.pad = 0;
        hipLaunchKernelGGL(mega_fwd, dim3(grid), dim3(NWAVES * 64), LDS_BYTES, stream, a);
    }
}
```

```cpp
#include <hip/hip_runtime.h>
#include <cstdio>
#include <cstdint>

__device__ __forceinline__ int lane_id_() { int l_; asm volatile("v_mbcnt_lo_u32_b32 %0, -1, 0\n\tv_mbcnt_hi_u32_b32 %0, -1, %0" : "=&v"(l_)); return l_; }
namespace pg8 {
#define PG8_LAS __attribute__((address_space(3)))
typedef unsigned short bf16_t;
typedef short bf16x8 __attribute__((ext_vector_type(8)));
typedef float f32x4 __attribute__((ext_vector_type(4)));
typedef unsigned u32x4 __attribute__((ext_vector_type(4)));
constexpr int BM = 256, BK = 64, HALF = 128, HTB = HALF * BK * 2  , STAGE_BYTES = 8 * HTB, NXCD = 8, WGM = 8;

__host__ __device__ __forceinline__ int lds_byte(int r, int c) { const int st = (r >> 4) * 2 + (c >> 5), rr = r & 15, cc = c & 31, ob = rr * 64 + cc * 2; return st * 1024 + (ob ^ (((ob >> 9) & 1) << 5)); }
__host__ __device__ __forceinline__ void stage_rc(int b, int& R, int& C) { const int st = b / 1024, sb = b % 1024, swz = sb ^ (((sb >> 9) & 1) << 5); R = (st >> 1) * 16 + swz / 64; C = (st & 1) * 32 + (swz % 64) / 2; }
__host__ __device__ __forceinline__ int perm32(int rho) { const int n = rho >> 4, i = rho & 15; return 8 * (i >> 2) + 4 * n + (i & 3); }

struct Unit { int pm, pn; };
struct Gemm { const bf16_t* A; const bf16_t* Bt; int M, N, K; };

struct StaticOrder {
    int nM, nN, nwg, G, c;
    __host__ __device__ void init(int M, int N, int G_, int c_) { nM = M / BM; nN = N / BM; nwg = nM * nN; G = G_; c = c_; }
    __host__ __device__ bool next(int i, Unit& u) const {
        const long L = (long)i * G + c; if (L >= nwg) return false;
        int wgid = (int)L; { const int q = nwg / NXCD, r = nwg % NXCD, xcd = wgid % NXCD, off = wgid / NXCD; wgid = (xcd < r ? xcd * (q + 1) : r * (q + 1) + (xcd - r) * q) + off; }
        const int nig = WGM * nN, gid = wgid / nig, fm = gid * WGM, gsz = (nM - fm) < WGM ? (nM - fm) : WGM;
        u.pm = fm + ((wgid % nig) % gsz); u.pn = (wgid % nig) / gsz; return true;
    }
    __device__ __forceinline__ void a_ready(const Unit&) const {}
    __device__ __forceinline__ void done(const Unit&) const {}
};
struct MoeOrder {
    int nM, nN, nwg, G, c; const PG8_LAS unsigned char* tile_e;
    __device__ void init(int nRT, int NTN, int G_, int c_, const PG8_LAS unsigned char* te) { nM = nRT; nN = NTN; nwg = nM * nN; G = G_; c = c_; tile_e = te; }
    __device__ bool next(int i, Unit& u) const {
        const long L = (long)i * G + c; if (L >= nwg) return false;
        int wgid = (int)L; { const int q = nwg / NXCD, r = nwg % NXCD, xcd = wgid % NXCD, off = wgid / NXCD; wgid = (xcd < r ? xcd * (q + 1) : r * (q + 1) + (xcd - r) * q) + off; }
        const int nig = WGM * nN, gid = wgid / nig, fm = gid * WGM, gsz = (nM - fm) < WGM ? (nM - fm) : WGM;
        u.pm = fm + ((wgid % nig) % gsz); const int pl = (wgid % nig) / gsz; u.pn = (int)tile_e[u.pm] * nN + pl; return true;
    }
    __device__ __forceinline__ void a_ready(const Unit&) const {}
    __device__ __forceinline__ void done(const Unit&) const {}
};
struct MoeGatherA {
    static constexpr bool GATHER = true;
    const unsigned* rowmap; const PG8_LAS unsigned* base; const PG8_LAS unsigned* cnt; const PG8_LAS unsigned char* tile_e; int ntok;
    __device__ __forceinline__ unsigned off(const Unit& u, int h, int rA, int cA, int K) const {
        const int e = tile_e[u.pm]; const unsigned pos = (unsigned)u.pm * 256u - base[e] + 128u * h + (unsigned)rA;
        const unsigned tok = pos < cnt[e] ? rowmap[(size_t)e * ntok + pos] : 0u;
        return (tok * (unsigned)K + (unsigned)cA) * 2u;
    }
};
__device__ __forceinline__ unsigned cvt_pk_bf16(float lo, float hi) { unsigned r; asm volatile("v_cvt_pk_bf16_f32 %0, %1, %2" : "=v"(r) : "v"(lo), "v"(hi)); return r; }
typedef float f32x2 __attribute__((ext_vector_type(2)));
__device__ __forceinline__ f32x2 gelu_pk(f32x2 v) {
    const f32x2 av = __builtin_elementwise_abs(v), d = av * 0.2316418882f + 1.0f;
    f32x2 t; t.x = __builtin_amdgcn_rcpf(d.x); t.y = __builtin_amdgcn_rcpf(d.y);
    f32x2 q = t * 0.5307027145f + (-0.7265760135f); q = q * t + 0.7107068705f; q = q * t + (-0.142248368f); q = q * t + 0.127414796f; q = q * t;
    const f32x2 s = (v * v) * (-0.72134752044f);
    f32x2 e; e.x = __builtin_amdgcn_exp2f(s.x); e.y = __builtin_amdgcn_exp2f(s.y);
    const f32x2 m = v * (q * e), r = v - m;
    f32x2 o; o.x = v.x < 0.f ? m.x : r.x; o.y = v.y < 0.f ? m.y : r.y; return o;
}

template <int ACT  > struct EpiBf16 {
    static constexpr bool PERM = true, AFTER_DRAIN = false; static_assert(ACT == 0 || ACT == 1, "EpiBf16: ACT is 0 (none) or 1 (gelu_pk)");
    bf16_t* O; int ldc; const float* bias; int split_cols; size_t split_stride; float scale0;
    __device__ __forceinline__ void operator()(const f32x4 (&acc)[2][2][4][2], const Unit& u, int wr, int wc, int fr, int fq) const {
        const int row0 = u.pm * BM + wr * 64 + fr; int colt = u.pn * BM; bf16_t* base = O;
        float sc = 1.f; if (split_cols) { const int t = colt / split_cols; base += (size_t)t * split_stride; colt -= t * split_cols; if (t == 0) sc = scale0; }
        const int col0 = colt + wc * 32 + 8 * fq, bcol0 = u.pn * BM + wc * 32 + 8 * fq;
        f32x4 bv[2][2];
#pragma unroll
        for (int bj = 0; bj < 2; ++bj)
#pragma unroll
            for (int n = 0; n < 2; ++n) bv[bj][n] = bias ? *(const f32x4*)(bias + bcol0 + bj * HALF + 4 * n) : (f32x4){0.f, 0.f, 0.f, 0.f};
#pragma unroll
        for (int ai = 0; ai < 2; ++ai)
#pragma unroll
            for (int m = 0; m < 4; ++m) { bf16_t* rowp = base + (size_t)(row0 + ai * HALF + m * 16) * ldc + col0;
#pragma unroll
                for (int bj = 0; bj < 2; ++bj) { f32x4 v0 = acc[ai][bj][m][0] + bv[bj][0], v1 = acc[ai][bj][m][1] + bv[bj][1];
                    if (ACT == 1) { f32x2 a = gelu_pk((f32x2){v0[0], v0[1]}), b = gelu_pk((f32x2){v0[2], v0[3]}), c = gelu_pk((f32x2){v1[0], v1[1]}), d = gelu_pk((f32x2){v1[2], v1[3]});
                        v0 = (f32x4){a.x, a.y, b.x, b.y}; v1 = (f32x4){c.x, c.y, d.x, d.y}; }
                    v0 = v0 * sc; v1 = v1 * sc; u32x4 w; w.x = cvt_pk_bf16(v0[0], v0[1]); w.y = cvt_pk_bf16(v0[2], v0[3]); w.z = cvt_pk_bf16(v1[0], v1[1]); w.w = cvt_pk_bf16(v1[2], v1[3]);
                    *(u32x4*)(rowp + bj * HALF) = w; } }
    }
};
constexpr float C2 = 0.125f * 1.4426950408889634f;
struct EpiIn {
    static constexpr bool PERM = true, AFTER_DRAIN = false;
    bf16_t* O; const float* cs;
    __device__ __forceinline__ void operator()(const f32x4 (&acc)[2][2][4][2], const Unit& u, int wr, int wc, int fr, int fq) const {
        const int pn = u.pn;
        const bool rope = (0x6CF0 >> pn) & 1;
        const float sc = ((0x0430 >> pn) & 1) ? C2 : 1.f;
        const int row0 = u.pm * BM + wr * 64 + fr, col0 = pn * BM + wc * 32 + 8 * fq, i0 = (wc & 1) * 16 + 4 * fq;
#pragma unroll
        for (int ai = 0; ai < 2; ++ai)
#pragma unroll
            for (int m = 0; m < 4; ++m) {
                const int row = row0 + ai * HALF + m * 16;
                f32x4 c01 = (f32x4){1.f, 0.f, 1.f, 0.f}, c23 = c01;
                if (rope) { c01 = *(const f32x4*)(cs + (size_t)row * 64 + i0 * 2); c23 = *(const f32x4*)(cs + (size_t)row * 64 + i0 * 2 + 4); }
                bf16_t* rowp = O + (size_t)row * 4096 + col0;
#pragma unroll
                for (int bj = 0; bj < 2; ++bj) {
                    f32x4 v0 = acc[ai][bj][m][0], v1 = acc[ai][bj][m][1];
                    if (rope) {
                        f32x4 r0, r1;
                        r0[0] = v0[0] * c01[0] - v0[1] * c01[1]; r0[1] = v0[1] * c01[0] + v0[0] * c01[1];
                        r0[2] = v0[2] * c01[2] - v0[3] * c01[3]; r0[3] = v0[3] * c01[2] + v0[2] * c01[3];
                        r1[0] = v1[0] * c23[0] - v1[1] * c23[1]; r1[1] = v1[1] * c23[0] + v1[0] * c23[1];
                        r1[2] = v1[2] * c23[2] - v1[3] * c23[3]; r1[3] = v1[3] * c23[2] + v1[2] * c23[3];
                        v0 = r0; v1 = r1;
                    }
                    v0 = v0 * sc; v1 = v1 * sc;
                    u32x4 w; w.x = cvt_pk_bf16(v0[0], v0[1]); w.y = cvt_pk_bf16(v0[2], v0[3]); w.z = cvt_pk_bf16(v1[0], v1[1]); w.w = cvt_pk_bf16(v1[2], v1[3]);
                    *(u32x4*)(rowp + bj * HALF) = w;
                }
            }
    }
};
__device__ __forceinline__ unsigned pk4_fp8(float a, float b, float c, float d, float sc) {
    a = fminf(fmaxf(a * sc, -448.f), 448.f); b = fminf(fmaxf(b * sc, -448.f), 448.f); c = fminf(fmaxf(c * sc, -448.f), 448.f); d = fminf(fmaxf(d * sc, -448.f), 448.f);
    int w = __builtin_amdgcn_cvt_pk_fp8_f32(a, b, 0, false); w = __builtin_amdgcn_cvt_pk_fp8_f32(c, d, w, true); return (unsigned)w; }
template <bool F8OUT> struct EpiSwiGLU {
    static constexpr bool PERM = true, AFTER_DRAIN = false;
    bf16_t* O; const float* b1; float asc;
    __device__ __forceinline__ void operator()(const f32x4 (&acc)[2][2][4][2], const Unit& u, int wr, int wc, int fr, int fq) const {
        const int e = u.pn >> 3, pl = u.pn & 7, colh = pl * 128 + wc * 32 + 8 * fq;
        const float* bp = b1 + (size_t)e * 2048 + colh;
        f32x4 bg[2], bu[2];
#pragma unroll
        for (int n = 0; n < 2; ++n) { bg[n] = *(const f32x4*)(bp + 4 * n); bu[n] = *(const f32x4*)(bp + 1024 + 4 * n); }
        const int row0 = u.pm * BM + wr * 64 + fr;
#pragma unroll
        for (int ai = 0; ai < 2; ++ai)
#pragma unroll
            for (int m = 0; m < 4; ++m) {
                f32x4 o[2];
#pragma unroll
                for (int n = 0; n < 2; ++n) {
                    const f32x4 g4 = acc[ai][0][m][n] * asc + bg[n], u4 = acc[ai][1][m][n] * asc + bu[n];
#pragma unroll
                    for (int c = 0; c < 4; ++c) {
                        const float g = fminf(g4[c], 7.0f), up = fminf(fmaxf(u4[c], -7.0f), 7.0f);
                        const float sg = __builtin_amdgcn_rcpf(1.0f + __builtin_amdgcn_exp2f(-1.702f * 1.4426950408889634f * g));
                        o[n][c] = (up + 1.0f) * (g * sg);
                    }
                }
                if constexpr (F8OUT) { typedef unsigned u32x2_ __attribute__((ext_vector_type(2))); u32x2_ w; w.x = pk4_fp8(o[0][0], o[0][1], o[0][2], o[0][3], 8.0f); w.y = pk4_fp8(o[1][0], o[1][1], o[1][2], o[1][3], 8.0f);
                    *(u32x2_*)((unsigned char*)O + (size_t)(row0 + ai * HALF + m * 16) * 1024 + colh) = w; }
                else { u32x4 w; w.x = cvt_pk_bf16(o[0][0], o[0][1]); w.y = cvt_pk_bf16(o[0][2], o[0][3]); w.z = cvt_pk_bf16(o[1][0], o[1][1]); w.w = cvt_pk_bf16(o[1][2], o[1][3]);
                    *(u32x4*)(O + (size_t)(row0 + ai * HALF + m * 16) * 1024 + colh) = w; }
            }
    }
};
struct EpiMoeOut {
    static constexpr bool PERM = true, AFTER_DRAIN = false;
    bf16_t* O; float asc;
    __device__ __forceinline__ void operator()(const f32x4 (&acc)[2][2][4][2], const Unit& u, int wr, int wc, int fr, int fq) const {
        const int row0 = u.pm * BM + wr * 64 + fr, col0 = (u.pn & 3) * BM + wc * 32 + 8 * fq;
#pragma unroll
        for (int ai = 0; ai < 2; ++ai)
#pragma unroll
            for (int m = 0; m < 4; ++m) { bf16_t* rowp = O + (size_t)(row0 + ai * HALF + m * 16) * 1024 + col0;
#pragma unroll
                for (int bj = 0; bj < 2; ++bj) { const f32x4 v0 = acc[ai][bj][m][0] * asc, v1 = acc[ai][bj][m][1] * asc;
                    u32x4 w; w.x = cvt_pk_bf16(v0[0], v0[1]); w.y = cvt_pk_bf16(v0[2], v0[3]); w.z = cvt_pk_bf16(v1[0], v1[1]); w.w = cvt_pk_bf16(v1[2], v1[3]);
                    *(u32x4*)(rowp + bj * HALF) = w; } }
    }
};
struct DirectA { static constexpr bool GATHER = false; __device__ __forceinline__ unsigned off(const Unit&, int, int, int, int) const { return 0u; } };
typedef int v8i32 __attribute__((ext_vector_type(8)));
template <class Epi, class Sched, bool ALIGN_EPI = false, bool SP2 = false, class AMap = DirectA, bool F8 = false>
__device__ __forceinline__ void gemm_phase(PG8_LAS unsigned char* lds, int wvx, const Gemm g, const Sched& S, const Epi& E, const AMap& AM = AMap(), int scA = 0x7f7f7f7f, int scB = 0x7f7f7f7f) {
    int tid_ = wvx * 64 + lane_id_(); asm volatile("" : "+v"(tid_));
    const int tid = tid_, wid = __builtin_amdgcn_readfirstlane(tid >> 6), lane = tid & 63, wr = wid >> 2, wc = wid & 3, fr = lane & 15, fq = lane >> 4;
    const int K = g.K, nt = K / BK;
    unsigned voffB[2], vA[2];
#pragma unroll
    for (int i = 0; i < 2; ++i) { int R, C; stage_rc(tid * 16 + i * 8192, R, C); const int Rb = Epi::PERM ? ((R & ~31) + perm32(R & 31)) : R;
        vA[i] = (unsigned)(R * K + C) * 2u; voffB[i] = (unsigned)(Rb * K + C) * 2u; }
    const size_t kstep = (size_t)(BK * 2);
    const size_t hstep = (size_t)HALF * K * 2;
    const size_t tstep = 2 * hstep;
    const unsigned ldsw = (unsigned)wid * 1024u;
    const int aoff = F8 ? lds_byte(wr * 64 + fr, 16 * (fq & 1)) + (fq >> 1) * 1024 : lds_byte(wr * 64 + fr, fq * 8), boff = F8 ? lds_byte(wc * 32 + fr, 16 * (fq & 1)) + (fq >> 1) * 1024 : lds_byte(wc * 32 + fr, fq * 8);
#define PG8_SA(b, h) (((b) * 2 + (h)) * HTB)
#define PG8_SB(b, h) ((4 + (b) * 2 + (h)) * HTB)
#define PG8_STAGEA(bufoff, kb, h, nx) do { size_t ubx_ = (size_t)(kb); unsigned lo_[2]; \
        if constexpr (AMap::GATHER) { _Pragma("unroll") for (int _i = 0; _i < 2; ++_i) lo_[_i] = (nx) ? oN[h][_i] : oC[h][_i]; } \
        else { ubx_ += (nx) ? uN[h] : uC[h]; _Pragma("unroll") for (int _i = 0; _i < 2; ++_i) lo_[_i] = vA[_i]; } \
        const char* ub_ = Abase + ubx_; asm("" : "+s"(ub_)); _Pragma("unroll") for (int _i = 0; _i < 2; ++_i) asm("" : "+v"(lo_[_i]));     \
        _Pragma("unroll") for (int _i = 0; _i < 2; ++_i) \
        __builtin_amdgcn_global_load_lds((const unsigned*)(ub_ + lo_[_i]), (PG8_LAS unsigned*)(lds + (bufoff) + ldsw + _i * 8192), 16, 0, 0); } while (0)
#define PG8_AOFF(dstL, dstU, u) do { if constexpr (AMap::GATHER) { int t2_ = wvx * 64 + lane_id_(); asm volatile("" : "+v"(t2_)); _Pragma("unroll") for (int _i = 0; _i < 2; ++_i) { int R_, C_; stage_rc(t2_ * 16 + _i * 8192, R_, C_); \
            _Pragma("unroll") for (int _h = 0; _h < 2; ++_h) dstL[_h][_i] = AM.off(u, _h, R_, C_, K); } } \
        else { _Pragma("unroll") for (int _h = 0; _h < 2; ++_h) dstU[_h] = ((size_t)(u).pm * BM + 128 * _h) * (size_t)K * 2; } } while (0)
#define PG8_STAGE(bufoff, gbase, voff) do { const char* ub_ = (const char*)(gbase); asm("" : "+s"(ub_)); _Pragma("unroll") for (int _i = 0; _i < 2; ++_i) \
        __builtin_amdgcn_global_load_lds((const unsigned*)(ub_ + (voff)[_i]), (PG8_LAS unsigned*)(lds + (bufoff) + ldsw + _i * 8192), 16, 0, 0); } while (0)
#define PG8_LDA(dst, b, h) do { if constexpr (F8) { _Pragma("unroll") for (int m = 0; m < 4; ++m) dst##8[m] = *(const PG8_LAS v8i32*)(lds + PG8_SA(b, h) + aoff + m * 2048); } \
        else { _Pragma("unroll") for (int m = 0; m < 4; ++m) _Pragma("unroll") for (int k = 0; k < 2; ++k) dst[m][k] = *(const PG8_LAS bf16x8*)(lds + PG8_SA(b, h) + aoff + m * 2048 + k * 1024); } } while (0)
#define PG8_LDB(dst, b, h) do { if constexpr (F8) { _Pragma("unroll") for (int n = 0; n < 2; ++n) dst##8[n] = *(const PG8_LAS v8i32*)(lds + PG8_SB(b, h) + boff + n * 2048); } \
        else { _Pragma("unroll") for (int n = 0; n < 2; ++n) _Pragma("unroll") for (int k = 0; k < 2; ++k) dst[n][k] = *(const PG8_LAS bf16x8*)(lds + PG8_SB(b, h) + boff + n * 2048 + k * 1024); } } while (0)
#define PG8_MMA(ai, bj, At, Bt) do { __builtin_amdgcn_s_setprio(1); _Pragma("unroll") for (int m = 0; m < 4; ++m) _Pragma("unroll") for (int n = 0; n < 2; ++n) { \
        if constexpr (F8) acc[ai][bj][m][n] = __builtin_amdgcn_mfma_scale_f32_16x16x128_f8f6f4(Bt##8[n], At##8[m], acc[ai][bj][m][n], 0, 0, 0, scB, 0, scA); \
        else { _Pragma("unroll") for (int k = 0; k < 2; ++k) acc[ai][bj][m][n] = __builtin_amdgcn_mfma_f32_16x16x32_bf16(Bt[n][k], At[m][k], acc[ai][bj][m][n], 0, 0, 0); } } __builtin_amdgcn_s_setprio(0); } while (0)
#define PG8_WAIT_V(n) asm volatile("s_waitcnt vmcnt(" #n ")" ::: "memory")
#define PG8_WAIT_L(n) asm volatile("s_waitcnt lgkmcnt(" #n ")" ::: "memory")
#define PG8_BAR __builtin_amdgcn_s_barrier()
#define PG8_SCHED __builtin_amdgcn_sched_barrier(0)
    Unit cur, nxt; int ui = 0;
    if (!S.next(0, cur)) return;
    f32x4 acc[2][2][4][2];
#pragma unroll
    for (int a = 0; a < 2; ++a)
#pragma unroll
        for (int b = 0; b < 2; ++b)
#pragma unroll
            for (int m = 0; m < 4; ++m)
#pragma unroll
                for (int n = 0; n < 2; ++n) acc[a][b][m][n] = (f32x4){0.f, 0.f, 0.f, 0.f};
    bf16x8 At[4][2], B0[2][2], B1[2][2]; v8i32 At8[4], B08[2], B18[2];
    const char* Abase = (const char*)g.A; const char* cB = (const char*)g.Bt + (size_t)cur.pn * tstep;
    unsigned oC[2][2], oN[2][2]; size_t uC[2] = {0, 0}, uN[2] = {0, 0}; PG8_AOFF(oC, uC, cur);
    S.a_ready(cur);
    if constexpr (SP2) {
        PG8_STAGE(PG8_SB(0, 0), cB, voffB); PG8_STAGE(PG8_SB(0, 1), cB + hstep, voffB); PG8_STAGEA(PG8_SA(0, 0), 0, 0, false); PG8_STAGEA(PG8_SA(0, 1), 0, 1, false);
        if (wr == 1) PG8_BAR;
        PG8_WAIT_V(2); PG8_BAR;
        PG8_STAGE(PG8_SB(1, 0), cB + kstep, voffB); PG8_STAGEA(PG8_SA(1, 0), kstep, 0, false); PG8_STAGE(PG8_SB(1, 1), cB + hstep + kstep, voffB);
        PG8_WAIT_V(6); PG8_BAR;
    } else {
        PG8_STAGE(PG8_SB(0, 0), cB, voffB); PG8_STAGEA(PG8_SA(0, 0), 0, 0, false); PG8_STAGE(PG8_SB(0, 1), cB + hstep, voffB); PG8_STAGEA(PG8_SA(0, 1), 0, 1, false);
        if (wr == 1) PG8_BAR;
        PG8_WAIT_V(4); PG8_BAR;
        PG8_STAGE(PG8_SB(1, 0), cB + kstep, voffB); PG8_STAGEA(PG8_SA(1, 0), kstep, 0, false); PG8_STAGE(PG8_SB(1, 1), cB + hstep + kstep, voffB);
        PG8_WAIT_V(6); PG8_BAR;
    }
    for (;;) {
        const bool has_next = S.next(ui + 1, nxt);
        const char* nB = has_next ? (const char*)g.Bt + (size_t)nxt.pn * tstep : cB;
        if (has_next) { PG8_AOFF(oN, uN, nxt); } else {
#pragma unroll
            for (int _h = 0; _h < 2; ++_h) { oN[_h][0] = oC[_h][0]; oN[_h][1] = oC[_h][1]; uN[_h] = uC[_h]; } }
#pragma unroll 1
        for (int t = 0; t < nt; t += 2) {
            const bool last = (t == nt - 2);
            const size_t ka1 = (size_t)(t + 1) * kstep, ka2 = last ? (size_t)0 : (size_t)(t + 2) * kstep, ka3 = ka2 + kstep;
            const char* b2 = last ? nB : cB + (size_t)(t + 2) * kstep; const char* b3 = b2 + kstep;
            if (last && has_next) S.a_ready(nxt);
            if constexpr (SP2) {
            PG8_LDB(B0, 0, 0); PG8_LDB(B1, 0, 1); PG8_SCHED; PG8_LDA(At, 0, 0); PG8_STAGEA(PG8_SA(1, 1), ka1, 1, false);
            PG8_WAIT_V(8); PG8_WAIT_L(0); PG8_BAR; PG8_MMA(0, 0, At, B0); PG8_MMA(0, 1, At, B1); PG8_BAR; PG8_SCHED;
            PG8_LDA(At, 0, 1); PG8_STAGE(PG8_SB(0, 0), b2, voffB); PG8_STAGE(PG8_SB(0, 1), b2 + hstep, voffB); PG8_STAGEA(PG8_SA(0, 0), ka2, 0, last);
            PG8_WAIT_V(8); PG8_WAIT_L(0); PG8_BAR; PG8_MMA(1, 0, At, B0); PG8_MMA(1, 1, At, B1); PG8_BAR; PG8_SCHED;
            PG8_LDB(B0, 1, 0); PG8_LDB(B1, 1, 1); PG8_SCHED; PG8_LDA(At, 1, 0); PG8_STAGEA(PG8_SA(0, 1), ka2, 1, last);
            PG8_WAIT_V(8); PG8_WAIT_L(0); PG8_BAR; PG8_MMA(0, 0, At, B0); PG8_MMA(0, 1, At, B1); PG8_BAR; PG8_SCHED;
            PG8_LDA(At, 1, 1); PG8_STAGE(PG8_SB(1, 0), b3, voffB); PG8_STAGE(PG8_SB(1, 1), b3 + hstep, voffB); PG8_STAGEA(PG8_SA(1, 0), ka3, 0, last);
            PG8_WAIT_V(8); PG8_WAIT_L(0); PG8_BAR; PG8_MMA(1, 0, At, B0); PG8_MMA(1, 1, At, B1); PG8_BAR; PG8_SCHED;
            } else {
            PG8_LDB(B0, 0, 0); PG8_SCHED; PG8_LDA(At, 0, 0); PG8_STAGEA(PG8_SA(1, 1), ka1, 1, false);
            PG8_WAIT_L(8); PG8_BAR; PG8_WAIT_L(0); PG8_MMA(0, 0, At, B0); PG8_BAR; PG8_SCHED;
            PG8_LDB(B1, 0, 1); PG8_STAGE(PG8_SB(0, 0), b2, voffB);
            PG8_BAR; PG8_WAIT_L(0); PG8_MMA(0, 1, At, B1); PG8_BAR;
            PG8_LDA(At, 0, 1); PG8_STAGEA(PG8_SA(0, 0), ka2, 0, last);
            PG8_BAR; PG8_WAIT_L(0); PG8_MMA(1, 0, At, B0); PG8_BAR; PG8_SCHED;
            PG8_STAGE(PG8_SB(0, 1), b2 + hstep, voffB);
            PG8_WAIT_V(6); PG8_BAR; PG8_MMA(1, 1, At, B1); PG8_BAR;
            PG8_LDB(B0, 1, 0); PG8_SCHED; PG8_LDA(At, 1, 0); PG8_STAGEA(PG8_SA(0, 1), ka2, 1, last);
            PG8_WAIT_L(8); PG8_BAR; PG8_WAIT_L(0); PG8_MMA(0, 0, At, B0); PG8_BAR; PG8_SCHED;
            PG8_LDB(B1, 1, 1); PG8_STAGE(PG8_SB(1, 0), b3, voffB);
            PG8_BAR; PG8_WAIT_L(0); PG8_MMA(0, 1, At, B1); PG8_BAR;
            PG8_LDA(At, 1, 1); PG8_STAGEA(PG8_SA(1, 0), ka3, 0, last);
            PG8_BAR; PG8_WAIT_L(0); PG8_MMA(1, 0, At, B0); PG8_BAR; PG8_SCHED;
            PG8_STAGE(PG8_SB(1, 1), b3 + hstep, voffB);
            PG8_WAIT_V(6); PG8_BAR; PG8_MMA(1, 1, At, B1); PG8_BAR;
            }
        }
        if constexpr (ALIGN_EPI) { if (wr == 0) PG8_BAR; }
        if constexpr (!Epi::AFTER_DRAIN) { const int l2_ = lane_id_(); const int fr_ = l2_ & 15, fq_ = l2_ >> 4;
            E(acc, cur, wr, wc, fr_, fq_); S.done(cur); }
        if (!has_next) break;
#pragma unroll
        for (int a = 0; a < 2; ++a)
#pragma unroll
            for (int b = 0; b < 2; ++b)
#pragma unroll
                for (int m = 0; m < 4; ++m)
#pragma unroll
                    for (int n = 0; n < 2; ++n) acc[a][b][m][n] = (f32x4){0.f, 0.f, 0.f, 0.f};
        cur = nxt; cB = nB; ++ui;
#pragma unroll
        for (int _h = 0; _h < 2; ++_h) { oC[_h][0] = oN[_h][0]; oC[_h][1] = oN[_h][1]; uC[_h] = uN[_h]; }
        if constexpr (ALIGN_EPI) { if (wr == 1) PG8_BAR; }
    }
    PG8_WAIT_V(0);
    if constexpr (!ALIGN_EPI) { if (wr == 0) PG8_BAR; }
    PG8_BAR;
    if constexpr (Epi::AFTER_DRAIN) { E.fused(acc, cur, wr, wc, fr, fq, lds, wid, lane); S.done(cur); }
#undef PG8_SA
#undef PG8_SB
#undef PG8_STAGE
#undef PG8_STAGEA
#undef PG8_AOFF
#undef PG8_LDA
#undef PG8_LDB
#undef PG8_MMA
#undef PG8_WAIT_V
#undef PG8_WAIT_L
#undef PG8_BAR
#undef PG8_SCHED
}
}
namespace attn_body {
using bf16=unsigned short;
using bf16x8=__attribute__((ext_vector_type(8)))short;
using s16x4=__attribute__((ext_vector_type(4)))short;
using f32x16=__attribute__((ext_vector_type(16)))float;
using u32x4=__attribute__((ext_vector_type(4)))unsigned;
constexpr int SEQ=2048,D=64,DM=4096,DMO=1024;
constexpr int NW=8,QBLK=32,QB=QBLK*NW,KVBLK=64,NQB=SEQ/QB;
__device__ __forceinline__ unsigned f2bf_(float f){unsigned u=__builtin_bit_cast(unsigned,f);return (u+0x7fffu+((u>>16)&1u))>>16;}
__device__ __forceinline__ int crow(int r,int hi){return (r&3)+8*(r>>2)+4*hi;}
#define SBAR() __builtin_amdgcn_sched_barrier(0)
__device__ __forceinline__ void cmask(f32x16&p0,f32x16&p1,int jb,int qrel,int hi){
  const float NEG=-INFINITY; int kb=64*jb+4*hi;
  #pragma unroll
  for(int r=0;r<16;++r){int kv=kb+(r&3)+8*(r>>2); if(kv>qrel)p0[r]=NEG; if(kv+32>qrel)p1[r]=NEG;}
}

__device__ __forceinline__ uint2 mld_asm(const unsigned*p){ uint2 v; asm volatile("global_load_dwordx2 %0, %1, off":"=v"(v):"v"(p):"memory"); return v; }
__device__ __forceinline__ void bmask(f32x16&p0,f32x16&p1,uint2 w,int hi){
  const float NEG=-INFINITY; const unsigned a=w.x>>(4*hi), b=w.y>>(4*hi);
  #pragma unroll
  for(int r=0;r<16;++r){const int bit=(r&3)+8*(r>>2); if(!((a>>bit)&1u))p0[r]=NEG; if(!((b>>bit)&1u))p1[r]=NEG;}
}
constexpr int NSLOT=3, SLOTB=8192;
constexpr int LDS_K=0, LDS_V=NSLOT*SLOTB, LDS_WS=2*NSLOT*SLOTB, LDS_OST=LDS_WS+NW*64*4, LDS_BYTES=LDS_OST+NW*4096;
constexpr float C2=0.125f*1.4426950408889634f;
__device__ __forceinline__ void glds16(const void*gsrc,unsigned lds_dst){unsigned keep;
  asm volatile("s_mov_b32 %0, m0\n\ts_mov_b32 m0, %2\n\ts_nop 0\n\tglobal_load_lds_dwordx4 %1, off\n\ts_mov_b32 m0, %0":"=&s"(keep):"v"(gsrc),"s"(lds_dst):"memory");}
__device__ __forceinline__ float max3f(float a,float b,float c){float r;asm("v_max3_f32 %0, %1, %2, %3":"=v"(r):"v"(a),"v"(b),"v"(c));return r;}
__device__ __forceinline__ float max2f(float a,float b){float r;asm("v_max_f32_e32 %0, %1, %2":"=v"(r):"v"(a),"v"(b));return r;}
__device__ __forceinline__ float fadd_s(float a,float b){float r;asm("v_add_f32_e32 %0, %1, %2":"=v"(r):"v"(a),"v"(b));return r;}
__device__ __forceinline__ float fsub_s(float a,float b){float r;asm("v_sub_f32_e32 %0, %1, %2":"=v"(r):"v"(a),"v"(b));return r;}
typedef float f32x2_t __attribute__((ext_vector_type(2))); typedef __bf16 bf16x2_t __attribute__((ext_vector_type(2)));
__device__ __forceinline__ unsigned cvtpk_s(float lo,float hi){f32x2_t v={lo,hi};bf16x2_t b=__builtin_convertvector(v,bf16x2_t);return __builtin_bit_cast(unsigned,b);}
#define WAIT_BAR(N) asm volatile("s_waitcnt vmcnt(" #N ") lgkmcnt(0)\n\ts_barrier":::"memory")

__device__ __forceinline__ void qkt(f32x16&p0,f32x16&p1,const char*Kslot,const bf16x8*qr,const f32x16&negm,int r32,int hi){
  const char*kb=Kslot+hi*1024+r32*16;
  #pragma unroll
  for(int d0=0;d0<4;++d0){
    const bf16x8 b0=*reinterpret_cast<const bf16x8*>(kb+d0*2048);
    const bf16x8 b1=*reinterpret_cast<const bf16x8*>(kb+d0*2048+512);
    if(d0==0){p0=__builtin_amdgcn_mfma_f32_32x32x16_bf16(b0,qr[0],negm,0,0,0);p1=__builtin_amdgcn_mfma_f32_32x32x16_bf16(b1,qr[0],negm,0,0,0);}
    else{p0=__builtin_amdgcn_mfma_f32_32x32x16_bf16(b0,qr[d0],p0,0,0,0);p1=__builtin_amdgcn_mfma_f32_32x32x16_bf16(b1,qr[d0],p1,0,0,0);}}
}
typedef __attribute__((address_space(3))) const char* lds_cptr;
typedef short v4i16_t __attribute__((ext_vector_type(4)));
__device__ __forceinline__ void kload8(bf16x8*kf,lds_cptr kp){
  kf[0]=*(const __attribute__((address_space(3))) bf16x8*)(kp);      kf[1]=*(const __attribute__((address_space(3))) bf16x8*)(kp+512);
  kf[2]=*(const __attribute__((address_space(3))) bf16x8*)(kp+2048); kf[3]=*(const __attribute__((address_space(3))) bf16x8*)(kp+2560);
  kf[4]=*(const __attribute__((address_space(3))) bf16x8*)(kp+4096); kf[5]=*(const __attribute__((address_space(3))) bf16x8*)(kp+4608);
  kf[6]=*(const __attribute__((address_space(3))) bf16x8*)(kp+6144); kf[7]=*(const __attribute__((address_space(3))) bf16x8*)(kp+6656);
}
__device__ __forceinline__ void kload2(bf16x8*kf,lds_cptr kp,int j){ kf[2*j]=*(const __attribute__((address_space(3))) bf16x8*)(kp+j*2048); kf[2*j+1]=*(const __attribute__((address_space(3))) bf16x8*)(kp+j*2048+512); }
__device__ __forceinline__ s16x4 vtr(lds_cptr p){ return __builtin_bit_cast(s16x4,__builtin_amdgcn_ds_read_tr16_b64_v4i16((__attribute__((address_space(3))) v4i16_t*)p)); }
__device__ __forceinline__ float rowmax(const f32x16&p0,const f32x16&p1){
  float a=max3f(p0[0],p0[1],p1[0]),b=max3f(p0[2],p0[3],p1[1]);a=max3f(a,p1[2],p1[3]);
  #pragma unroll
  for(int r=4;r<16;r+=4){a=max3f(a,p0[r],p0[r+1]);b=max3f(b,p0[r+2],p0[r+3]);a=max3f(a,p1[r],p1[r+1]);b=max3f(b,p1[r+2],p1[r+3]);}
  const float m=max2f(a,b);
  auto rr=__builtin_amdgcn_permlane32_swap(__float_as_uint(m),__float_as_uint(m),false,false);
  return max2f(__uint_as_float(rr[0]),__uint_as_float(rr[1]));
}
__device__ __forceinline__ void pv(f32x16*o,int vb,bf16x8 pa0,bf16x8 pa1,bf16x8 pa2,bf16x8 pa3){
  #pragma unroll
  for(int d0=0;d0<2;++d0){s16x4 lo[4],hi[4];
    #pragma unroll
    for(int ks=0;ks<4;++ks){
      asm volatile("ds_read_b64_tr_b16 %0,%1 offset:%c2":"=&v"(lo[ks]):"v"(vb),"i"(d0*4096+ks*1024):"memory");
      asm volatile("ds_read_b64_tr_b16 %0,%1 offset:%c2":"=&v"(hi[ks]):"v"(vb),"i"(d0*4096+ks*1024+512):"memory");}
    asm volatile("s_waitcnt lgkmcnt(0)":::"memory");SBAR();
    #define PK(k) (bf16x8){lo[k][0],lo[k][1],lo[k][2],lo[k][3],hi[k][0],hi[k][1],hi[k][2],hi[k][3]}
    o[d0]=__builtin_amdgcn_mfma_f32_32x32x16_bf16(pa0,PK(0),o[d0],0,0,0);
    o[d0]=__builtin_amdgcn_mfma_f32_32x32x16_bf16(pa1,PK(1),o[d0],0,0,0);
    o[d0]=__builtin_amdgcn_mfma_f32_32x32x16_bf16(pa2,PK(2),o[d0],0,0,0);
    o[d0]=__builtin_amdgcn_mfma_f32_32x32x16_bf16(pa3,PK(3),o[d0],0,0,0);
    #undef PK
  }
}

#ifndef ATTN_STORE16
#define ATTN_STORE16(p,v) (*(u32x4*)(p)=(v))
#endif
template<int THRL,bool MASKED> __device__ __forceinline__ void attn_unit(int wvx,int b,int qb,const bf16*Q,const bf16*__restrict__ K,const bf16*__restrict__ V,bf16*O,const unsigned*MASK,char*shm){
  int tid_=wvx*64+lane_id_(); asm volatile("":"+v"(tid_));
  const int tid=tid_,lane=tid&63,r32=lane&31,hi=lane>>5; const int wid=__builtin_amdgcn_readfirstlane(tid>>6);
  const long rowbase=(long)b*SEQ; const int q0=qb*QB;
  const bf16*Qw=Q+(rowbase+q0+wid*QBLK)*DM;
  const bf16*Kh=K+rowbase*DM,*Vh=V+rowbase*DM;
  const unsigned*mrow=MASK+(size_t)(rowbase+q0+wid*QBLK+r32)*64;
  #define MLD(tt) mld_asm(mrow+2*(tt))
  const unsigned lds0=(unsigned)(uintptr_t)shm;
  float*wsf=(float*)(shm+LDS_WS)+wid*64;
  const bf16*ksrc=Kh+(long)lane*DM+wid*8;
  const bf16*vsrc=Vh+(long)(16*(wid&3)+(lane>>2))*DM+(wid>>2)*32+(lane&3)*8;
  const unsigned kdst=lds0+LDS_K+wid*1024, vdst=lds0+LDS_V+wid*1024;
  #define DMA_K(t,slot) glds16(ksrc+(long)(t)*KVBLK*DM,(unsigned)__builtin_amdgcn_readfirstlane(kdst+(slot)))
  #define DMA_V(t,slot) glds16(vsrc+(long)(t)*KVBLK*DM,(unsigned)__builtin_amdgcn_readfirstlane(vdst+(slot)))
  const int vb0=(int)(lds0+LDS_V)+((lane>>4)&1)*32+(lane&3)*8+(4*hi+((lane&15)>>2))*64;
  const char*Kbase=shm+LDS_K; bf16x8 kf[8];
  const lds_cptr shm3=(lds_cptr)shm; const lds_cptr kp0=shm3+LDS_K+hi*1024+r32*16; const lds_cptr vp0=shm3+LDS_V+((lane>>4)&1)*32+(lane&3)*8+(4*hi+((lane&15)>>2))*64;
  const int NT=(q0+QB)/KVBLK;
  uint2 mw_cur=make_uint2(~0u,~0u), mw_next=make_uint2(~0u,~0u); if(MASKED){ mw_cur=MLD(0); mw_next=MLD(1); }
  DMA_K(0,0);DMA_V(0,0);DMA_K(1,SLOTB);
  bf16x8 qr[4];
  #pragma unroll
  for(int d0=0;d0<4;++d0)qr[d0]=*reinterpret_cast<const bf16x8*>(&Qw[(long)r32*DM+d0*16+hi*8]);
  float mhat=0.f,l_reg=0.f;f32x16 o[2];o[0]=f32x16{};o[1]=f32x16{};f32x16 negm=f32x16{};asm volatile("":"+v"(negm));
  const int qrel=wid*QBLK+r32;
  #define CMASK(P0,P1,t) do{ if(MASKED){bmask(P0,P1,mw_cur,hi);} else {int jb_=(t)-(NT-4); if(jb_>=0)cmask(P0,P1,jb_,qrel,hi);} }while(0)
  bool resc=false;
  #define START(P0,P1) do{ float rm=rowmax(P0,P1); if(MASKED)rm=max2f(rm,-64.f); resc=false; \
    { const float dl=rm; mhat=fadd_s(mhat,dl); \
      _Pragma("unroll") for(int r=0;r<16;++r){P0[r]=fsub_s(P0[r],dl);P1[r]=fsub_s(P1[r],dl);} \
      _Pragma("unroll") for(int r=0;r<16;++r)negm[r]=-mhat; asm volatile("":"+v"(negm)); } \
    _Pragma("unroll") for(int r=0;r<16;++r)P0[r]=__builtin_amdgcn_exp2f(P0[r]); }while(0)
  #define RESC() do{ if(resc){ asm volatile("s_waitcnt lgkmcnt(0)":::"memory"); \
      _Pragma("unroll") for(int d_=0;d_<2;++d_) _Pragma("unroll") for(int r=0;r<16;++r)o[d_][r]*=wsf[crow(r,hi)]; } }while(0)
  f32x16 pA0,pA1,pB0,pB1;
  int sl_prev=0,sl_cur=0,sl_next=SLOTB;
  #define ROT() do{sl_prev=sl_cur;sl_cur=sl_next;sl_next=(sl_next==(NSLOT-1)*SLOTB)?0:sl_next+SLOTB;}while(0)
  DMA_K(2,2*SLOTB);
  WAIT_BAR(3);
  qkt(pA0,pA1,Kbase,qr,negm,r32,hi);asm volatile("s_nop 15\n\ts_nop 7":"+v"(pA0),"+v"(pA1));CMASK(pA0,pA1,0);
  START(pA0,pA1);
  _Pragma("unroll") for(int r=0;r<16;++r)pA1[r]=__builtin_amdgcn_exp2f(pA1[r]);
  WAIT_BAR(0);
  DMA_K(3,0);DMA_V(1,SLOTB);
  ROT();
  kload8(kf,kp0+sl_cur);
  WAIT_BAR(2);
  s16x4 vlo[8],vhi[8]; u32x4 pw0,pw1,pw2,pw3;
  #define PKW(P,B) cvtpk_s(P[B],P[B+1])
  #define PAF(k) __builtin_bit_cast(bf16x8,pw##k)
  #define VFR(i) (bf16x8){vlo[i][0],vlo[i][1],vlo[i][2],vlo[i][3],vhi[i][0],vhi[i][1],vhi[i][2],vhi[i][3]}
  #define PIN(x) asm volatile("":"+v"(x))
  #define MX3(a,b,c) __builtin_fmaxf(__builtin_fmaxf((a),(b)),(c))
  #define GAPA(MF,A0,A1,A2,A3,W0,W1,PW) do{ MF; sacc+=A0; sacc+=A1; sacc+=A2; sacc+=A3; PIN(sacc); W0; W1; PIN(PW); SBAR(); }while(0)
  #define EX(v) __builtin_amdgcn_exp2f(v)
  #define GAPB(MF,X,B) do{ MF; X[B]=EX(X[B]); X[B+1]=EX(X[B+1]); X[B+2]=EX(X[B+2]); X[B+3]=EX(X[B+3]); PIN(X); SBAR(); }while(0)
  #define VRD(i) do{ vlo[i]=vtr(vp_+(((i)>>2)*4096+((i)&3)*1024)); vhi[i]=vtr(vp_+(((i)>>2)*4096+((i)&3)*1024+512)); }while(0)
  #define KRD(G,j) do{ if(G){ kload2(kf,kp0+sl_next,j); SBAR(); } }while(0)
  #define STEP(C0,C1,P0,P1,t,GK,GV,GL) do{ SBAR(); if(MASKED){ mw_cur=mw_next; if((t)+1<NT) mw_next=MLD((t)+1); } \
    const lds_cptr vp_=vp0+sl_prev; \
    VRD(0); SBAR(); float sacc=(P0[0]+P0[1]); \
    GAPA(C0=__builtin_amdgcn_mfma_f32_32x32x16_bf16(kf[0],qr[0],negm,0,0,0), P0[2],P0[3],P0[4],P0[5],     pw0[0]=PKW(P0,0), pw0[1]=PKW(P0,2), pw0); \
    VRD(4); SBAR(); GAPA(C1=__builtin_amdgcn_mfma_f32_32x32x16_bf16(kf[1],qr[0],negm,0,0,0), P0[6],P0[7],P0[8],P0[9],     pw0[2]=PKW(P0,4), pw0[3]=PKW(P0,6), pw0); \
    VRD(1); SBAR(); GAPA(C0=__builtin_amdgcn_mfma_f32_32x32x16_bf16(kf[2],qr[1],C0,0,0,0),   P0[10],P0[11],P0[12],P0[13], pw1[0]=PKW(P0,8), pw1[1]=PKW(P0,10), pw1); \
    VRD(5); SBAR(); GAPA(C1=__builtin_amdgcn_mfma_f32_32x32x16_bf16(kf[3],qr[1],C1,0,0,0),   P0[14],P0[15],P1[0],P1[1],   pw1[2]=PKW(P0,12),pw1[3]=PKW(P0,14), pw1); \
    VRD(2); SBAR(); GAPA(C0=__builtin_amdgcn_mfma_f32_32x32x16_bf16(kf[4],qr[2],C0,0,0,0),   P1[2],P1[3],P1[4],P1[5],     pw2[0]=PKW(P1,0), pw2[1]=PKW(P1,2), pw2); \
    VRD(6); SBAR(); GAPA(C1=__builtin_amdgcn_mfma_f32_32x32x16_bf16(kf[5],qr[2],C1,0,0,0),   P1[6],P1[7],P1[8],P1[9],     pw2[2]=PKW(P1,4), pw2[3]=PKW(P1,6), pw2); \
    VRD(3); SBAR(); GAPA(C0=__builtin_amdgcn_mfma_f32_32x32x16_bf16(kf[6],qr[3],C0,0,0,0),   P1[10],P1[11],P1[12],P1[13], pw3[0]=PKW(P1,8), pw3[1]=PKW(P1,10), pw3); \
    VRD(7); SBAR(); GAPA(C1=__builtin_amdgcn_mfma_f32_32x32x16_bf16(kf[7],qr[3],C1,0,0,0),   P1[14],P1[15],0.f,0.f,       pw3[2]=PKW(P1,12),pw3[3]=PKW(P1,14), pw3); \
    l_reg+=sacc; \
    if(GK){DMA_K((t)+3,sl_cur);} if(GV){DMA_V((t)+1,sl_next);} \
    CMASK(C0,C1,t); \
    { float a=MX3(C0[0],C0[1],C1[0]),b=MX3(C0[2],C0[3],C1[1]); a=MX3(a,C1[2],C1[3]); \
      _Pragma("unroll") for(int r=4;r<16;r+=4){a=MX3(a,C0[r],C0[r+1]);b=MX3(b,C0[r+2],C0[r+3]);a=MX3(a,C1[r],C1[r+1]);b=MX3(b,C1[r+2],C1[r+3]);} \
      float rm=__builtin_fmaxf(a,b); { auto rr=__builtin_amdgcn_permlane32_swap(__float_as_uint(rm),__float_as_uint(rm),false,false); rm=__builtin_fmaxf(__uint_as_float(rr[0]),__uint_as_float(rr[1])); } \
      resc=false; \
      if(__builtin_expect(__any(rm>(float)THRL),0)){ const float dl=__builtin_fmaxf(rm,0.f); mhat+=dl; \
        _Pragma("unroll") for(int r=0;r<16;++r){C0[r]-=dl;C1[r]-=dl;} \
        _Pragma("unroll") for(int r=0;r<16;++r)negm[r]=-mhat; asm volatile("":"+v"(negm)); \
        const float f=__builtin_amdgcn_exp2f(-dl); l_reg*=f; if(hi==0)wsf[r32]=f; resc=true; } } \
    SBAR(); \
    GAPB(o[0]=__builtin_amdgcn_mfma_f32_32x32x16_bf16(PAF(0),VFR(0),o[0],0,0,0), C0,0); \
    GAPB(o[1]=__builtin_amdgcn_mfma_f32_32x32x16_bf16(PAF(0),VFR(4),o[1],0,0,0), C0,4); \
    KRD(GL,0); GAPB(o[0]=__builtin_amdgcn_mfma_f32_32x32x16_bf16(PAF(1),VFR(1),o[0],0,0,0), C0,8); \
    KRD(GL,1); GAPB(o[1]=__builtin_amdgcn_mfma_f32_32x32x16_bf16(PAF(1),VFR(5),o[1],0,0,0), C0,12); \
    KRD(GL,2); GAPB(o[0]=__builtin_amdgcn_mfma_f32_32x32x16_bf16(PAF(2),VFR(2),o[0],0,0,0), C1,0); \
    KRD(GL,3); GAPB(o[1]=__builtin_amdgcn_mfma_f32_32x32x16_bf16(PAF(2),VFR(6),o[1],0,0,0), C1,4); \
    GAPB(o[0]=__builtin_amdgcn_mfma_f32_32x32x16_bf16(PAF(3),VFR(3),o[0],0,0,0), C1,8); \
    GAPB(o[1]=__builtin_amdgcn_mfma_f32_32x32x16_bf16(PAF(3),VFR(7),o[1],0,0,0), C1,12); \
    }while(0)
  int t=1;
  #undef CMASK
  #define CMASK(P0,P1,t) do{ if(MASKED){bmask(P0,P1,mw_cur,hi);} }while(0)
  for(;t+5<NT;t+=2){
    STEP(pB0,pB1,pA0,pA1,t,true,true,true);     WAIT_BAR(2); RESC(); ROT();
    STEP(pA0,pA1,pB0,pB1,t+1,true,true,true);   WAIT_BAR(2); RESC(); ROT();
  }
  #undef CMASK
  #define CMASK(P0,P1,t) do{ if(MASKED){bmask(P0,P1,mw_cur,hi);} else {int jb_=(t)-(NT-4); if(jb_>=0)cmask(P0,P1,jb_,qrel,hi);} }while(0)
  #define ENDW(tt) do{ if((tt)+3<NT){WAIT_BAR(2);} else if((tt)+2<NT){WAIT_BAR(1);} else {WAIT_BAR(0);} }while(0)
  for(;t+1<NT;t+=2){
    STEP(pB0,pB1,pA0,pA1,t,(t+3<NT),(t+1<NT),(t+1<NT));       ENDW(t);   RESC(); ROT();
    STEP(pA0,pA1,pB0,pB1,t+1,(t+4<NT),(t+2<NT),(t+2<NT));     ENDW(t+1); RESC(); ROT();
  }
  STEP(pB0,pB1,pA0,pA1,NT-1,false,false,false); RESC();
  { float sacc=pB0[0]+pB0[1]; _Pragma("unroll") for(int r=2;r<16;++r)sacc+=pB0[r]; _Pragma("unroll") for(int r=0;r<16;++r)sacc+=pB1[r]; l_reg+=sacc;
    pw0=(u32x4){PKW(pB0,0),PKW(pB0,2),PKW(pB0,4),PKW(pB0,6)};pw1=(u32x4){PKW(pB0,8),PKW(pB0,10),PKW(pB0,12),PKW(pB0,14)};pw2=(u32x4){PKW(pB1,0),PKW(pB1,2),PKW(pB1,4),PKW(pB1,6)};pw3=(u32x4){PKW(pB1,8),PKW(pB1,10),PKW(pB1,12),PKW(pB1,14)};
    SBAR(); pv(o,vb0+sl_cur,PAF(0),PAF(1),PAF(2),PAF(3)); }
  #undef PKW
  #undef PAF
  #undef VFR
  #undef PIN
  #undef MX3
  #undef GAPA
  #undef GAPB
  #undef EX
  #undef VRD
  #undef KRD
  #undef STEP
  #undef ENDW
  {auto rr=__builtin_amdgcn_permlane32_swap(__float_as_uint(l_reg),__float_as_uint(l_reg),false,false);l_reg=__uint_as_float(rr[0])+__uint_as_float(rr[1]);}
  if(hi==0)wsf[32+r32]=l_reg;asm volatile("s_waitcnt lgkmcnt(0)":::"memory");
  float rli[16];
  #pragma unroll
  for(int r=0;r<16;++r)rli[r]=__builtin_amdgcn_rcpf(wsf[32+crow(r,hi)]);
  bf16*Ow=O+(rowbase+q0+wid*QBLK)*DMO;
  { bf16*stg=(bf16*)(shm+LDS_OST)+wid*2048;
    #pragma unroll
    for(int r=0;r<16;++r){const int orow=crow(r,hi);
      #pragma unroll
      for(int d0=0;d0<2;++d0)stg[orow*64+d0*32+r32]=(bf16)f2bf_(o[d0][r]*rli[r]);}
    asm volatile("s_waitcnt lgkmcnt(0)":::"memory");
    #pragma unroll
    for(int i=0;i<4;++i){const int row=i*8+(lane>>3),ch=lane&7; const u32x4 v=*(const u32x4*)(stg+row*64+ch*8); ATTN_STORE16(Ow+(long)row*DMO+ch*8,v);} }
  asm volatile("s_waitcnt lgkmcnt(0)\n\ts_barrier":::"memory");
  #undef DMA_K
  #undef DMA_V
  #undef MLD
  #undef CMASK
  #undef START
  #undef RESC
  #undef ROT
}
constexpr int ATTN_LDS_BYTES=LDS_BYTES;
#undef SBAR
#undef WAIT_BAR
}
#define GAS __attribute__((address_space(1)))
#define LAS __attribute__((address_space(3)))
typedef unsigned short bf16;
typedef unsigned v4u __attribute__((ext_vector_type(4)));
typedef float f32x4 __attribute__((ext_vector_type(4)));
typedef short bf16x8 __attribute__((ext_vector_type(8)));
typedef GAS unsigned gu32;
typedef GAS unsigned long long gu64;
#define RLX_AGENT __ATOMIC_RELAXED, __HIP_MEMORY_SCOPE_AGENT
#define LDS_WAIT() asm volatile("s_waitcnt lgkmcnt(0)" ::: "memory")
#define VM_WAIT() asm volatile("s_waitcnt vmcnt(0)" ::: "memory")
__device__ __forceinline__ unsigned long long rt() { return __builtin_amdgcn_s_memrealtime(); }
__device__ __forceinline__ unsigned f2bf(float f) { unsigned u = __builtin_bit_cast(unsigned, f); return (u + 0x7fffu + ((u >> 16) & 1u)) >> 16; }
__device__ __forceinline__ unsigned pk2(float lo, float hi) { return f2bf(lo) | (f2bf(hi) << 16); }
__device__ __forceinline__ int tid_of(int wvx) { return wvx * 64 + lane_id_(); }
#define XB_TMO      128
#define XB_XCNT(j)  (256  + 64 * (j))
#define XB_XSUB(j)  (1280 + 64 * (j))
#define XB_XGEN(j)  (2304 + 64 * (j))
#define XB_TOP      3328
#define XB_TOPGEN   3392
#define XCD_BAR_WORDS 3456
#define XB_SPIN_CAP (1u << 20)

__device__ __forceinline__ unsigned xb_ld(unsigned* p)              { return __hip_atomic_load(p, __ATOMIC_RELAXED, __HIP_MEMORY_SCOPE_AGENT); }
__device__ __forceinline__ unsigned xb_add(unsigned* p, unsigned v) { return __hip_atomic_fetch_add(p, v, __ATOMIC_RELAXED, __HIP_MEMORY_SCOPE_AGENT); }
__device__ __forceinline__ unsigned xb_xcc_id() { return (unsigned)__builtin_amdgcn_s_getreg((3 << 11) | 20) & 0xFu; }
#define XB_SPIN(cond, bar) do { unsigned _sp = 0; while (cond) { __builtin_amdgcn_s_sleep(1); \
    if ((++_sp & 255u) == 0u) { if (xb_ld(&(bar)[XB_TMO])) break; if (_sp > XB_SPIN_CAP) { atomicAdd(&(bar)[XB_TMO], 1u); break; } } } } while (0)

struct XcdBarrier {
    unsigned* bar; unsigned x;
    volatile LAS unsigned* st;
};

__device__ __forceinline__ XcdBarrier xcd_barrier_post(unsigned* bar, volatile LAS unsigned* st) {
    XcdBarrier b; b.bar = bar; b.x = xb_xcc_id(); b.st = st;
    if (threadIdx.x == 0) (void)xb_add(&bar[XB_XCNT(b.x)], 1u);
    return b;
}
__device__ __forceinline__ void xcd_barrier_complete(unsigned* bar, unsigned x, unsigned& nloc, unsigned& nx) {
    const unsigned G = gridDim.x * gridDim.y * gridDim.z;
    unsigned sum, cnt, mine, sp = 0u;
    for (;;) {
        sum = 0u; cnt = 0u; mine = 0u;
#pragma unroll
        for (unsigned j = 0; j < 16; ++j) { const unsigned c = xb_ld(&bar[XB_XCNT(j)]); sum += c; cnt += (c > 0u) ? 1u : 0u; mine = (j == x) ? c : mine; }
        if (sum == G) break;
        __builtin_amdgcn_s_sleep(1);
        if ((++sp & 255u) == 0u) { if (xb_ld(&bar[XB_TMO])) break; if (sp > XB_SPIN_CAP) { atomicAdd(&bar[XB_TMO], 1u); break; } }
    }
    nloc = mine > 0u ? mine : 1u; nx = cnt > 0u ? cnt : 1u;
}

__device__ __attribute__((noinline)) void xcd_barrier_fn(unsigned* bar_, unsigned x_, volatile LAS unsigned* st_, bool leader_) {
    XcdBarrier b; b.bar = bar_; b.x = x_; b.st = st_;
    asm volatile("s_waitcnt vmcnt(0)" ::: "memory");
    __syncthreads();
    if (leader_) {
        unsigned* bar = b.bar;
        __builtin_amdgcn_s_waitcnt(0);
        unsigned nloc = b.st[0], nx = b.st[1];
        if (nloc == 0u) { xcd_barrier_complete(bar, b.x, nloc, nx); b.st[0] = nloc; b.st[1] = nx; }
        const unsigned old = xb_add(&bar[XB_XSUB(b.x)], 1u);
        const unsigned gen = old / nloc;
        if (old + 1u == (gen + 1u) * nloc) {
            __builtin_amdgcn_fence(__ATOMIC_RELEASE, "agent");
            asm volatile("s_waitcnt vmcnt(0)" ::: "memory");
            const unsigned og = xb_add(&bar[XB_TOP], 1u);
            const unsigned tg = og / nx;
            if (og + 1u == (tg + 1u) * nx) xb_add(&bar[XB_TOPGEN], 1u);
            else XB_SPIN(xb_ld(&bar[XB_TOPGEN]) == tg, bar);
            __builtin_amdgcn_fence(__ATOMIC_ACQUIRE, "agent");
            xb_add(&bar[XB_XGEN(b.x)], 1u);
            asm volatile("s_waitcnt vmcnt(0)" ::: "memory");
        } else {
            XB_SPIN(xb_ld(&bar[XB_XGEN(b.x)]) == gen, bar);
            __builtin_amdgcn_fence(__ATOMIC_ACQUIRE, "agent");
            asm volatile("s_waitcnt vmcnt(0)" ::: "memory");
        }
    }
    __syncthreads();
}


constexpr int NB = 16, SEQ = 2048, T = NB * SEQ, D = 1024, DEPTH = 4, NHC = 4096, NEXP = 32, NWAVES = 8;
constexpr int NIN = 3920;
constexpr float LN_EPS = 1e-5f, DN_ALPHA = 1.6817928305074290f;
constexpr int RPAD = T * 4 + NEXP * 256;
constexpr int HC_MQ = 0, HC_MK = 256, HC_MV = 512, HC_MO = 768, HC_DQ = 1024, HC_DK = 1536, HC_DV = 2048, HC_SQ = 2560, HC_SK = 2816, HC_SV = 3072, HC_XQ = 3328, HC_XK = 3840, HC_MI = 3904, HC_MF = 3908, HC_XW = 3912;
constexpr size_t MiB = 1u << 20;
constexpr size_t WS_CTL = 0, CTL_ZERO_BYTES = 2 * MiB;
constexpr size_t WS_MOD = 2 * MiB;
constexpr size_t WS_LAM = WS_MOD + 7 * MiB / 4;
constexpr size_t WS_RWT = 4 * MiB;
constexpr size_t WS_CS = 8 * MiB;
constexpr size_t WS_WIN = 16 * MiB;
constexpr size_t WS_WOUT = 48 * MiB;
constexpr size_t WS_W1 = 64 * MiB;
constexpr size_t WS_W2 = 576 * MiB;
constexpr size_t WS_XB = 832 * MiB;
constexpr size_t WS_U = 960 * MiB;
constexpr size_t WS_H = 1024 * MiB;
constexpr size_t WS_QKC = 1280 * MiB;
constexpr size_t WS_XKP = 1312 * MiB;
constexpr size_t WS_MASK = 1316 * MiB;
constexpr size_t WS_TOK = 1324 * MiB;
constexpr size_t WS_MIX = 1344 * MiB;
constexpr size_t WS_Y = 1408 * MiB;
constexpr size_t WS_SC = 1472 * MiB;
constexpr size_t WS_XG = 1728 * MiB;
constexpr size_t WS_HM = 2000 * MiB;
constexpr size_t WS_YM = 2272 * MiB;
constexpr size_t WS_END = 2544 * MiB;
constexpr int CW_CNT = 1024;
constexpr int CW_BAR = 16384;
constexpr int RING_BYTES = 131072, TAB_OFF = RING_BYTES, MISC_OFF = RING_BYTES + 4096, LDS_BYTES = 147456;
constexpr int NPH = 10, NSTEPS = 2 + NPH * DEPTH;
enum { PH_IN = 0, PH_POST, PH_MIXA, PH_SEL, PH_DSA, PH_OUT, PH_ROW1, PH_G1, PH_G2, PH_ROW2 };

__device__ __forceinline__ float bf2f(bf16 h) { return __uint_as_float((unsigned)h << 16); }
#define DPPF(x, c) __int_as_float(__builtin_amdgcn_update_dpp(0, __float_as_int(x), c, 0xF, 0xF, true))
__device__ __forceinline__ float wave_sum(float v) {
    v += DPPF(v, 0xB1); v += DPPF(v, 0x4E); v += DPPF(v, 0x141); v += DPPF(v, 0x140);
    return (__int_as_float(__builtin_amdgcn_readlane(__float_as_int(v), 0)) + __int_as_float(__builtin_amdgcn_readlane(__float_as_int(v), 16))) + (__int_as_float(__builtin_amdgcn_readlane(__float_as_int(v), 32)) + __int_as_float(__builtin_amdgcn_readlane(__float_as_int(v), 48)));
}
__device__ __forceinline__ float wave_max(float v) {
    v = fmaxf(v, DPPF(v, 0xB1)); v = fmaxf(v, DPPF(v, 0x4E)); v = fmaxf(v, DPPF(v, 0x141)); v = fmaxf(v, DPPF(v, 0x140));
    return fmaxf(fmaxf(__int_as_float(__builtin_amdgcn_readlane(__float_as_int(v), 0)), __int_as_float(__builtin_amdgcn_readlane(__float_as_int(v), 16))), fmaxf(__int_as_float(__builtin_amdgcn_readlane(__float_as_int(v), 32)), __int_as_float(__builtin_amdgcn_readlane(__float_as_int(v), 48))));
}
__device__ __forceinline__ float shx(float v, int lane, int m) { return __int_as_float(__builtin_amdgcn_ds_bpermute((lane ^ m) << 2, __float_as_int(v))); }
__device__ __forceinline__ int shxi(int v, int lane, int m) { return __builtin_amdgcn_ds_bpermute((lane ^ m) << 2, v); }
__device__ __forceinline__ float shup(float v, int lane, int o) { return __int_as_float(__builtin_amdgcn_ds_bpermute(((lane - o) & 63) << 2, __float_as_int(v))); }
__device__ __forceinline__ int shupi(int v, int lane, int o) { return __builtin_amdgcn_ds_bpermute(((lane - o) & 63) << 2, v); }
__device__ __forceinline__ float sigmoidf_(float x) { return 1.0f / (1.0f + __expf(-x)); }
struct Ctx {
    LAS unsigned char* lds;
    int tid, lane, wave, gw, ngw;
    const float* in[25];
    float* out; unsigned char* ws;
};
#define WSP(type, off) ((type*)(C.ws + (off)))
enum { I_X = 0, I_C, I_POS, I_WIN, I_GATEB, I_CONVW, I_CONVB, I_MNORM, I_DFLAM, I_DFNORM, I_IDXG, I_IDXB, I_WOUT, I_ADAW, I_ADAB, I_LN1G, I_LN1B, I_LN2G, I_LN2B, I_RW, I_RB, I_W1, I_B1, I_W2, I_B2 };

__device__ __forceinline__ int in_dest_col(int n) {
    auto rp = [](int j) { const int hd = j >> 6, d = j & 63; return hd * 64 + ((d < 32) ? 2 * d : 2 * (d - 32) + 1); };
    if (n < 256) return HC_MQ + n;
    if (n < 512) return HC_MK + (n - 256);
    if (n < 768) return HC_MV + (n - 512);
    if (n < 772) return HC_MI + (n - 768);
    if (n < 776) return HC_MF + (n - 772);
    if (n < 1032) return HC_MO + (n - 776);
    if (n < 1544) return HC_DQ + rp(n - 1032);
    if (n < 2056) return HC_DK + rp(n - 1544);
    if (n < 2568) return HC_DV + (n - 2056);
    if (n < 2824) return HC_SQ + rp(n - 2568);
    if (n < 3080) return HC_SK + rp(n - 2824);
    if (n < 3336) return HC_SV + (n - 3080);
    if (n < 3848) return HC_XQ + rp(n - 3336);
    if (n < 3912) return HC_XK + (n - 3848);
    return HC_XW + (n - 3912);
}
template <class F> __device__ __forceinline__ void transpose_item(const float* W, int ldw, int K, int nvalid, int k0, int n0, bf16* WT, LAS float* scr, int lane, F drow) {
    const int nn = n0 + (lane & 31); const bool ok = nn < nvalid;
    float tv_[32];
#pragma unroll
    for (int i = 0; i < 32; ++i) { const int kk = 2 * i + (lane >> 5); tv_[i] = ok ? W[(size_t)(k0 + kk) * ldw + nn] : 0.f; }
#pragma unroll
    for (int i = 0; i < 32; ++i) { const int kk = 2 * i + (lane >> 5); scr[kk * 33 + (lane & 31)] = tv_[i]; }
    LDS_WAIT(); asm volatile("" ::: "memory");
    const int c = lane & 7;
#pragma unroll
    for (int j = 0; j < 4; ++j) { const int n = (lane >> 3) + 8 * j; const LAS float* s = scr + (8 * c) * 33 + n;
        v4u o; o.x = pk2(s[0 * 33], s[1 * 33]); o.y = pk2(s[2 * 33], s[3 * 33]); o.z = pk2(s[4 * 33], s[5 * 33]); o.w = pk2(s[6 * 33], s[7 * 33]);
        if (n0 + n < nvalid) *(GAS v4u*)(WT + (size_t)drow(n0 + n) * K + k0 + 8 * c) = o; }
    LDS_WAIT(); asm volatile("" ::: "memory");
}

template <class F> __device__ __forceinline__ void transpose_item_f8(const float* W, int ldw, int K, int nvalid, int k0, int n0, unsigned char* WT8, LAS float* scr, int lane, float sc, F drow) {
    const int nn = n0 + (lane & 31); const bool ok = nn < nvalid;
    float tv_[32];
#pragma unroll
    for (int i = 0; i < 32; ++i) { const int kk = 2 * i + (lane >> 5); tv_[i] = ok ? W[(size_t)(k0 + kk) * ldw + nn] : 0.f; }
#pragma unroll
    for (int i = 0; i < 32; ++i) { const int kk = 2 * i + (lane >> 5); scr[kk * 33 + (lane & 31)] = tv_[i]; }
    LDS_WAIT(); asm volatile("" ::: "memory");
    const int c = lane & 7;
#pragma unroll
    for (int j = 0; j < 4; ++j) { const int n = (lane >> 3) + 8 * j; const LAS float* s = scr + (8 * c) * 33 + n;
        typedef unsigned u32x2_ __attribute__((ext_vector_type(2))); u32x2_ o; o.x = pg8::pk4_fp8(s[0 * 33], s[1 * 33], s[2 * 33], s[3 * 33], sc); o.y = pg8::pk4_fp8(s[4 * 33], s[5 * 33], s[6 * 33], s[7 * 33], sc);
        if (n0 + n < nvalid) *(GAS u32x2_*)(WT8 + (size_t)drow(n0 + n) * K + k0 + 8 * c) = o; }
    LDS_WAIT(); asm volatile("" ::: "memory");
}
struct Args { const float* in[25]; float* out; unsigned char* ws; int s_lo, s_hi, li, pad; };
typedef __attribute__((address_space(4))) const Args CArgs;
__device__ __forceinline__ CArgs* kargs() { CArgs* p = (CArgs*)__builtin_amdgcn_kernarg_segment_ptr(); asm volatile("" : "+s"(p)); return p; }
__device__ __forceinline__ LAS unsigned char* lds_launder(LAS unsigned char* q) { unsigned v = (unsigned)(size_t)q; asm volatile("" : "+s"(v)); return (LAS unsigned char*)(size_t)v; }
#define WS(type, off) ((type*)(A->ws + (off)))
#define TIDX CArgs* A = kargs(); int tid_ = tid_of(wvx); asm volatile("" : "+v"(tid_)); const int tid = tid_, lane = tid & 63, wave = __builtin_amdgcn_readfirstlane(tid >> 6); const int gw = blockIdx.x * NWAVES + wave, ngw = gridDim.x * NWAVES; (void)lane; (void)gw; (void)ngw

__device__ __forceinline__ void pro_a(LAS unsigned char* lds, int wvx) {
    TIDX;
    LAS float* scr = (LAS float*)(lds + wave * 16384);
    constexpr int IT_IN = 16 * 123, IT_OUT = 16 * 32, IT_W1 = 16 * 64, IT_W2 = 16 * 32;
    constexpr int N_IN = DEPTH * IT_IN, N_OUT = DEPTH * IT_OUT, N_W1 = DEPTH * NEXP * IT_W1, N_W2 = DEPTH * NEXP * IT_W2;
    constexpr int NITEMS = N_IN + N_OUT + N_W1 + N_W2;
    for (int it = gw; it < NITEMS; it += ngw) {
        int r = it;
        if (r < N_IN) { const int l = r / IT_IN, q = r % IT_IN, kb = q / 123, nb = q % 123;
            transpose_item(A->in[I_WIN] + (size_t)l * D * NIN, NIN, D, NIN, kb * 64, nb * 32, WS(bf16, WS_WIN) + (size_t)l * NHC * D, scr, lane, [](int n) { return in_dest_col(n); }); continue; }
        r -= N_IN;
        if (r < N_OUT) { const int l = r / IT_OUT, q = r % IT_OUT, kb = q / 32, nb = q % 32;
            transpose_item(A->in[I_WOUT] + (size_t)l * D * D, D, D, D, kb * 64, nb * 32, WS(bf16, WS_WOUT) + (size_t)l * D * D, scr, lane, [](int n) { return n; }); continue; }
        r -= N_OUT;
        if (r < N_W1) { const int le = r / IT_W1, q = r % IT_W1, kb = q / 64, nb = q % 64;
            transpose_item_f8(A->in[I_W1] + (size_t)le * D * 2048, 2048, D, 2048, kb * 64, nb * 32, WS(unsigned char, WS_W1) + (size_t)le * 2048 * D, scr, lane, 256.0f,
                           [](int n) { const int up = n >> 10, j = n & 1023; return (j >> 7) * 256 + up * 128 + (j & 127); }); continue; }
        r -= N_W1;
        { const int le = r / IT_W2, q = r % IT_W2, kb = q / 32, nb = q % 32;
            transpose_item_f8(A->in[I_W2] + (size_t)le * D * D, D, D, D, kb * 64, nb * 32, WS(unsigned char, WS_W2) + (size_t)le * D * D, scr, lane, 256.0f, [](int n) { return n; }); }
    }
    for (int r = gw; r < DEPTH * (NHC - NIN); r += ngw) { const int l = r / (NHC - NIN), row = NIN + r % (NHC - NIN);
        GAS v4u* p = (GAS v4u*)(WS(bf16, WS_WIN) + ((size_t)l * NHC + row) * D) + lane; p[0] = (v4u){0u, 0u, 0u, 0u}; p[64] = (v4u){0u, 0u, 0u, 0u}; }
    for (int idx = blockIdx.x * 512 + tid; idx < T * 32; idx += gridDim.x * 512) {
        const int tok = idx >> 5, i = idx & 31;
        const double inv = exp(-(double)i * (9.210340371976184 / 32.0));
        const double ang = (double)((const int*)A->in[I_POS])[tok] * inv;
        const double rev = ang * 0.15915494309189535;
        const float fr = (float)(rev - rint(rev));
        float2 v; v.x = __builtin_amdgcn_cosf(fr); v.y = __builtin_amdgcn_sinf(fr);
        WS(float2, WS_CS)[idx] = v;
    }
    for (int idx = blockIdx.x * 512 + tid; idx < DEPTH * NEXP * D; idx += gridDim.x * 512) {
        const int l = idx / (NEXP * D), r = idx % (NEXP * D), e = r / D, d = r % D;
        WS(float, WS_RWT)[idx] = A->in[I_RW][((size_t)l * D + d) * NEXP + e];
    }
    if (blockIdx.x == 0 && wave == 0) {
        for (int l = 0; l < DEPTH; ++l) { const float* lf = A->in[I_DFLAM] + l * 256;
            const float a = wave_sum(lf[lane] * lf[64 + lane]), b = wave_sum(lf[128 + lane] * lf[192 + lane]);
            if (lane == 0) WS(float, WS_LAM)[l] = __expf(a) - __expf(b) + (0.8f - 0.6f * __expf(-0.3f * (float)l)); }
    }
    __syncthreads();
    if (blockIdx.x < (DEPTH * 6144) / 512) {
        LAS float* ca = (LAS float*)lds;
        for (int i = tid; i < NB * D; i += 512) { const float v = A->in[I_C][i]; ca[i] = v / (1.0f + __expf(-v)); }
        __syncthreads();
        const int col = blockIdx.x * 512 + tid, l = col / 6144, m = col % 6144;
        const float* w = A->in[I_ADAW] + (size_t)l * D * 6144 + m;
        float acc[NB];
#pragma unroll
        for (int b = 0; b < NB; ++b) acc[b] = 0.f;
        for (int d = 0; d < D; ++d) { const float wv = w[(size_t)d * 6144];
#pragma unroll
            for (int b = 0; b < NB; ++b) acc[b] += ca[b * D + d] * wv; }
        const float bias = A->in[I_ADAB][col];
#pragma unroll
        for (int b = 0; b < NB; ++b) WS(float, WS_MOD)[((size_t)l * NB + b) * 6144 + m] = acc[b] + bias;
        __syncthreads();
    }
}
__device__ __forceinline__ void pro_b(int wvx) {
    TIDX;
    for (int tok = gw; tok < T; tok += ngw) {
        const int b = tok / SEQ; const float* mod = WS(float, WS_MOD) + (size_t)b * 6144;
        const GAS f32x4* xr = (const GAS f32x4*)(A->in[I_X] + (size_t)tok * D) + lane;
        GAS unsigned long long* o8 = (GAS unsigned long long*)(WS(bf16, WS_U) + (size_t)tok * D) + lane;
#pragma unroll
        for (int j = 0; j < 4; ++j) { const f32x4 x = xr[64 * j]; const f32x4 sh = *(const f32x4*)(mod + 4 * lane + 256 * j), sc = *(const f32x4*)(mod + 1024 + 4 * lane + 256 * j);
            const f32x4 u = x * (1.0f + sc) + sh; o8[64 * j] = (unsigned long long)pk2(u.x, u.y) | ((unsigned long long)pk2(u.z, u.w) << 32); }
    }
}
__device__ __forceinline__ void ph_post(int l, int wvx) {
    TIDX;
    const bf16* H = WS(bf16, WS_H); bf16* XKP = WS(bf16, WS_XKP); bf16* QKC = WS(bf16, WS_QKC);
    const float* cw = A->in[I_CONVW] + (size_t)l * 4 * 512; const float* cb = A->in[I_CONVB] + (size_t)l * 512;
    const float gi = A->in[I_IDXG][l * 64 + lane], bi = A->in[I_IDXB][l * 64 + lane];
    for (int tok = gw; tok < T; tok += ngw) {
        const bf16* hrow = H + (size_t)tok * NHC;
        {
            const float v = bf2f(hrow[HC_XK + lane]);
            const float mean = wave_sum(v) * (1.0f / 64.0f); const float dv = v - mean;
            const float var = wave_sum(dv * dv) * (1.0f / 64.0f);
            const float nv = dv * (1.0f / sqrtf(var + LN_EPS)) * gi + bi;
            const float pv = shx(nv, lane, 32);
            const int i = lane & 31; const float2 cs = WS(float2, WS_CS)[(size_t)tok * 32 + i];
            const float o = (lane < 32) ? (nv * cs.x - pv * cs.y) : (nv * cs.x + pv * cs.y);
            XKP[(size_t)tok * 64 + 2 * i + (lane >> 5)] = (bf16)f2bf(o);
        }
        {
            const int s = tok % SEQ, c0 = 8 * lane;
            float acc[8];
#pragma unroll
            for (int c = 0; c < 8; ++c) acc[c] = cb[c0 + c];
#pragma unroll
            for (int j = 0; j < 4; ++j) {
                if (s - 3 + j >= 0) {
                    const v4u raw = *(const GAS v4u*)(H + (size_t)(tok - 3 + j) * NHC + c0);
                    const unsigned rw[4] = {raw.x, raw.y, raw.z, raw.w};
#pragma unroll
                    for (int c = 0; c < 8; ++c) { const float x = __uint_as_float((c & 1) ? (rw[c >> 1] & 0xffff0000u) : (rw[c >> 1] << 16)); acc[c] += cw[j * 512 + c0 + c] * x; }
                }
            }
            v4u o;
#define SILU(x) ((x) / (1.0f + __expf(-(x))))
            o.x = pk2(SILU(acc[0]), SILU(acc[1])); o.y = pk2(SILU(acc[2]), SILU(acc[3])); o.z = pk2(SILU(acc[4]), SILU(acc[5])); o.w = pk2(SILU(acc[6]), SILU(acc[7]));
#undef SILU
            *(GAS v4u*)(QKC + (size_t)tok * 512 + c0) = o;
        }
    }
}
typedef float f32x16 __attribute__((ext_vector_type(16)));
__device__ __forceinline__ void ph_idx_scores(int wvx) {
    TIDX;
    const bf16* H = WS(bf16, WS_H); const bf16* XKP = WS(bf16, WS_XKP); float* SC = WS(float, WS_SC);
    const int r = lane & 31, hh = lane >> 5, ql = r >> 3, hd = r & 7;
    for (int item = blockIdx.x; item < 256; item += gridDim.x) {
        const int g = item >> 5, p = item & 31;
#pragma unroll 1
        for (int sub = 0; sub < 4; ++sub) {
            const int b = 2 * g + (sub >> 1), qblk = (sub & 1) ? 63 - p : p, q0 = qblk * 32 + 4 * wave, tok0 = b * SEQ + q0;
            bf16x8 af[4];
            { const bf16* ap = H + (size_t)(tok0 + ql) * NHC + HC_XQ + hd * 64 + 8 * hh;
#pragma unroll
              for (int ks = 0; ks < 4; ++ks) af[ks] = *(const GAS bf16x8*)(ap + ks * 16); }
            float wv[4][4];
#pragma unroll
            for (int q = 0; q < 4; ++q)
#pragma unroll
                for (int i = 0; i < 4; ++i) wv[q][i] = bf2f(H[(size_t)(tok0 + q) * NHC + HC_XW + 4 * hh + i]);
            const int npair = (qblk + 2) >> 1;
            const bf16* kp = XKP + (size_t)(b * SEQ + r) * 64 + 8 * hh;
            bf16x8 bc[2][4], bn[2][4];
#pragma unroll
            for (int t2 = 0; t2 < 2; ++t2)
#pragma unroll
                for (int ks = 0; ks < 4; ++ks) bc[t2][ks] = *(const GAS bf16x8*)(kp + t2 * 2048 + ks * 16);
            for (int pr = 0; pr < npair; ++pr) {
                const bf16* kn = kp + (size_t)((pr + 1 < npair) ? pr + 1 : pr) * 4096;
#pragma unroll
                for (int t2 = 0; t2 < 2; ++t2)
#pragma unroll
                    for (int ks = 0; ks < 4; ++ks) bn[t2][ks] = *(const GAS bf16x8*)(kn + t2 * 2048 + ks * 16);
#pragma unroll
                for (int t2 = 0; t2 < 2; ++t2) {
                    f32x16 acc = {};
#pragma unroll
                    for (int ks = 0; ks < 4; ++ks) acc = __builtin_amdgcn_mfma_f32_32x32x16_bf16(af[ks], bc[t2][ks], acc, 0, 0, 0);
                    float tot[4];
#pragma unroll
                    for (int q = 0; q < 4; ++q) { float pp = 0.f;
#pragma unroll
                        for (int i = 0; i < 4; ++i) pp += wv[q][i] * fmaxf(acc[4 * q + i], 0.f);
                        tot[q] = pp + shx(pp, lane, 32); }
                    const int key = pr * 64 + t2 * 32 + r;
                    const float o0 = hh ? tot[2] : tot[0], o1 = hh ? tot[3] : tot[1];
                    SC[(size_t)(tok0 + 2 * hh) * SEQ + key] = o0; SC[(size_t)(tok0 + 2 * hh + 1) * SEQ + key] = o1;
                }
#pragma unroll
                for (int t2 = 0; t2 < 2; ++t2)
#pragma unroll
                    for (int ks = 0; ks < 4; ++ks) bc[t2][ks] = bn[t2][ks];
            }
        }
    }
}
constexpr size_t WS_OD = WS_END;
constexpr size_t WS_END2 = WS_END + 64 * MiB;
__device__ __forceinline__ void ph_diff_attn(LAS unsigned char* lds, int wvx) {
    CArgs* A = kargs();
    const int G = gridDim.x, bx = blockIdx.x, vcu = (G % 8 == 0) ? (bx % 8) * (G / 8) + bx / 8 : bx;
    const bf16* H = WS(bf16, WS_H); bf16* OD = WS(bf16, WS_OD);
    for (int item = vcu; item < NB * 16; item += G) {
        const int b = item >> 4, vh = item & 15, g = vh >> 1, half = vh & 1;
#pragma unroll 1
        for (int qb = 7; qb >= 0; --qb)
            attn_body::attn_unit<8, false>(wvx, b, qb, H + HC_DQ + g * 64, H + HC_DK + g * 64, H + HC_DV + (g >> 1) * 128 + half * 64, OD + g * 128 + half * 64, nullptr, (char*)lds);
    }
}
__device__ __forceinline__ void ph_diff_post(int l, int wvx) {
    TIDX;
    const bf16* OD = WS(bf16, WS_OD); bf16* MIX = WS(bf16, WS_MIX);
    const float lam = WS(float, WS_LAM)[l], lam_init = 0.8f - 0.6f * __expf(-0.3f * (float)l);
    for (int task = gw; task < T * 4; task += ngw) {
        const int tok = task >> 2, h = task & 3;
        const bf16* o1 = OD + (size_t)tok * D + (2 * h) * 128, *o2 = o1 + 128;
        const float d0 = bf2f(o1[lane]) - lam * bf2f(o2[lane]), d1 = bf2f(o1[64 + lane]) - lam * bf2f(o2[64 + lane]);
        const float rs = 1.0f / sqrtf(wave_sum(d0 * d0 + d1 * d1) * (1.0f / 128.0f) + LN_EPS);
        const float* g = A->in[I_DFNORM] + l * 512 + h * 128;
        MIX[(size_t)tok * D + 256 + h * 128 + lane] = (bf16)f2bf(d0 * rs * g[lane] * (1.0f - lam_init));
        MIX[(size_t)tok * D + 256 + h * 128 + 64 + lane] = (bf16)f2bf(d1 * rs * g[64 + lane] * (1.0f - lam_init));
    }
}
__device__ __forceinline__ void ph_dsa_attn(LAS unsigned char* lds, int wvx) {
    CArgs* A = kargs();
    const int G = gridDim.x, bx = blockIdx.x, vcu = (G % 8 == 0) ? (bx % 8) * (G / 8) + bx / 8 : bx;
    const bf16* H = WS(bf16, WS_H); bf16* MIX = WS(bf16, WS_MIX); const unsigned* MASK = WS(unsigned, WS_MASK);
    for (int item = vcu; item < NB * 4 * 4; item += G) {
        const int bh = item >> 2, p = item & 3, b = bh >> 2, h = bh & 3;
        attn_body::attn_unit<8, true>(wvx, b, 7 - p, H + HC_SQ + h * 64, H + HC_SK + h * 64, H + HC_SV + h * 64, MIX + 768 + h * 64, MASK, (char*)lds);
        attn_body::attn_unit<8, true>(wvx, b, p, H + HC_SQ + h * 64, H + HC_SK + h * 64, H + HC_SV + h * 64, MIX + 768 + h * 64, MASK, (char*)lds);
    }
}
constexpr size_t WS_DC = WS_END2;
constexpr size_t WS_CST = WS_DC + 32 * MiB;
constexpr size_t WS_DN = WS_CST + 32 * MiB;
constexpr size_t WS_END3 = WS_DN + 4 * MiB;
constexpr size_t WS_DUMMY = WS_END3;
constexpr size_t WS_END4 = WS_DUMMY + 256 * MiB;
typedef float f32x2_ __attribute__((ext_vector_type(2)));
constexpr int MP = 68;
__device__ __forceinline__ float log_sigmoid_(float x) { return fminf(x, 0.f) - log1pf(__expf(-fabsf(x))); }
__device__ __forceinline__ void mlstm_gates(const bf16* H, int tok0, int h, float gbi, float gbf, int lane, LAS float* bcum, LAS float* av) {
    const size_t tk = (size_t)(tok0 + lane);
    const float ip = bf2f(H[tk * NHC + HC_MI + h]) + gbi; float lf = log_sigmoid_(bf2f(H[tk * NHC + HC_MF + h]) + gbf);
#pragma unroll
    for (int o = 1; o < 64; o <<= 1) { const float t_ = shup(lf, lane, o); if (lane >= o) lf += t_; }
    bcum[lane] = lf; av[lane] = ip - lf;
}
constexpr int PB = 72;
typedef unsigned short us8 __attribute__((ext_vector_type(8)));
__device__ __forceinline__ f32x16 mfma_tile(const LAS bf16* Xa, int mt, const LAS bf16* Xb, int nt, int r, int hh, f32x16 acc) {
#pragma unroll
    for (int ks = 0; ks < 4; ++ks) { const bf16x8 a = *(const LAS bf16x8*)(Xa + (32 * mt + r) * PB + 16 * ks + 8 * hh), b = *(const LAS bf16x8*)(Xb + (32 * nt + r) * PB + 16 * ks + 8 * hh);
        acc = __builtin_amdgcn_mfma_f32_32x32x16_bf16(a, b, acc, 0, 0, 0); }
    return acc;
}
__device__ __forceinline__ void ph_mlstm_m1(LAS unsigned char* lds, int l, int wvx) {
    TIDX;
    const bf16* H = WS(bf16, WS_H); const bf16* QKC = WS(bf16, WS_QKC);
    float* DC = WS(float, WS_DC); float* DN = WS(float, WS_DN); float* SCAL = WS(float, WS_DN + 2 * MiB);
    LAS bf16* kT = (LAS bf16*)lds; LAS bf16* vwT = kT + 64 * PB;
    LAS float* bcum = (LAS float*)(vwT + 96 * PB); LAS float* av = bcum + 64; LAS float* wv = av + 64;
    const int r = lane & 31, hh = lane >> 5, srow = tid >> 3, ch = tid & 7;
    for (int u = blockIdx.x; u < NB * 4 * 32; u += gridDim.x) {
        const int bh = u >> 5, c = u & 31, b = bh >> 2, h = bh & 3, tok0 = b * SEQ + c * 64;
        const us8 kraw = *(const GAS us8*)(QKC + (size_t)(tok0 + srow) * 512 + 256 + h * 64 + 8 * ch);
        const us8 vraw = *(const GAS us8*)(H + (size_t)(tok0 + srow) * NHC + HC_MV + h * 64 + 8 * ch);
        if (wave == 0) { mlstm_gates(H, tok0, h, A->in[I_GATEB][l * 8 + h], A->in[I_GATEB][l * 8 + 4 + h], lane, bcum, av); }
        __syncthreads();
        if (wave == 0) { const float a = av[lane], amax = wave_max(a); wv[lane] = __expf(a - amax); if (lane == 0) { SCAL[u * 4 + 0] = bcum[63]; SCAL[u * 4 + 1] = bcum[63] + amax; } }
        __syncthreads();
        { const float w = wv[srow];
#pragma unroll
          for (int e = 0; e < 8; ++e) { kT[(8 * ch + e) * PB + srow] = kraw[e]; vwT[(8 * ch + e) * PB + srow] = (bf16)f2bf(w * bf2f(vraw[e])); }
          if (tid < 64) vwT[64 * PB + tid] = (bf16)f2bf(wv[tid]);
          for (int i = tid; i < 31 * 64; i += 512) vwT[(65 + i / 64) * PB + (i & 63)] = 0; }
        __syncthreads();
        if (wave < 6) { const int mt = wave >> 1, nt = wave & 1;
            f32x16 acc = {}; acc = mfma_tile(vwT, mt, kT, nt, r, hh, acc);
#pragma unroll
            for (int g = 0; g < 16; ++g) { const int vrow = 32 * mt + (g & 3) + 8 * (g >> 2) + 4 * hh, d = 32 * nt + r;
                if (vrow < 64) DC[(size_t)u * 4096 + vrow * 64 + d] = acc[g]; else if (vrow == 64) DN[(size_t)u * 64 + d] = acc[g]; } }
        __syncthreads();
    }
}
__device__ __forceinline__ void ph_mlstm_m2(int wvx) {
    TIDX;
    const float* DC = WS(float, WS_DC); float* CS = WS(float, WS_CST); const float* DN = WS(float, WS_DN); float* NS = WS(float, WS_DN + 1 * MiB); float* SCAL = WS(float, WS_DN + 2 * MiB);
    for (int item = blockIdx.x; item < NB * 4 * 4; item += gridDim.x) {
        const int bh = item >> 2, qtr = item & 3, e0 = qtr * 1024 + tid * 2;
        float m = 0.f; f32x2_ C = (f32x2_){0.f, 0.f}; float n = 0.f;
#pragma unroll 4
        for (int c = 0; c < 32; ++c) {
            const int u = bh * 32 + c;
            const float bl = SCAL[u * 4 + 0], ml = SCAL[u * 4 + 1];
            *(f32x2_*)(CS + (size_t)u * 4096 + e0) = C;
            if (qtr == 0 && tid < 64) NS[(size_t)u * 64 + tid] = n;
            if (qtr == 0 && tid == 0) SCAL[u * 4 + 2] = m;
            const float mn = fmaxf(bl + m, ml), f1 = __expf(bl + m - mn), f2 = __expf(ml - mn);
            const f32x2_ dc = *(const f32x2_*)(DC + (size_t)u * 4096 + e0);
            C.x = f1 * C.x + f2 * dc.x; C.y = f1 * C.y + f2 * dc.y;
            if (qtr == 0 && tid < 64) n = f1 * n + f2 * DN[(size_t)u * 64 + tid];
            m = mn;
        }
    }
}
__device__ __forceinline__ void ph_mlstm_m3(LAS unsigned char* lds, int l, int wvx) {
    TIDX;
    const bf16* H = WS(bf16, WS_H); const bf16* QKC = WS(bf16, WS_QKC); bf16* MIX = WS(bf16, WS_MIX);
    const float* CS = WS(float, WS_CST); const float* NS = WS(float, WS_DN + 1 * MiB); const float* SCAL = WS(float, WS_DN + 2 * MiB);
    LAS bf16* qS = (LAS bf16*)lds; LAS bf16* kS = qS + 64 * PB; LAS bf16* vT = kS + 64 * PB; LAS bf16* cT = vT + 96 * PB; LAS bf16* Sb = cT + 96 * PB;
    LAS float* hS = (LAS float*)(Sb + 64 * PB);
    LAS float* bcum = hS + 64 * MP; LAS float* av = bcum + 64; LAS float* mm = av + 64; LAS float* inter = mm + 64; LAS float* dinv = inter + 64;
    const int r = lane & 31, hh = lane >> 5, srow = tid >> 3, ch = tid & 7;
    for (int u = blockIdx.x; u < NB * 4 * 32; u += gridDim.x) {
        const int bh = u >> 5, c = u & 31, b = bh >> 2, h = bh & 3, tok0 = b * SEQ + c * 64;
        const float mc = SCAL[u * 4 + 2];
        {
            const us8 qraw = *(const GAS us8*)(QKC + (size_t)(tok0 + srow) * 512 + h * 64 + 8 * ch);
            const us8 kraw = *(const GAS us8*)(QKC + (size_t)(tok0 + srow) * 512 + 256 + h * 64 + 8 * ch);
            const us8 vraw = *(const GAS us8*)(H + (size_t)(tok0 + srow) * NHC + HC_MV + h * 64 + 8 * ch);
            const f32x4 c0 = *(const GAS f32x4*)(CS + (size_t)u * 4096 + srow * 64 + 8 * ch), c1 = *(const GAS f32x4*)(CS + (size_t)u * 4096 + srow * 64 + 8 * ch + 4);
            us8 qs;
#pragma unroll
            for (int e = 0; e < 8; ++e) qs[e] = (bf16)f2bf(bf2f(qraw[e]) * 0.125f);
            *(LAS us8*)(qS + srow * PB + 8 * ch) = qs; *(LAS us8*)(kS + srow * PB + 8 * ch) = kraw;
#pragma unroll
            for (int e = 0; e < 8; ++e) vT[(8 * ch + e) * PB + srow] = vraw[e];
            v4u cp; cp.x = pk2(c0[0], c0[1]); cp.y = pk2(c0[2], c0[3]); cp.z = pk2(c1[0], c1[1]); cp.w = pk2(c1[2], c1[3]);
            *(LAS v4u*)(cT + srow * PB + 8 * ch) = cp;
            if (tid < 64) { vT[64 * PB + tid] = (bf16)0x3f80; cT[64 * PB + tid] = (bf16)f2bf(NS[(size_t)u * 64 + tid]); }
            for (int i = tid; i < 31 * 64; i += 512) { vT[(65 + i / 64) * PB + (i & 63)] = 0; cT[(65 + i / 64) * PB + (i & 63)] = 0; }
        }
        if (wave == 0) { mlstm_gates(H, tok0, h, A->in[I_GATEB][l * 8 + h], A->in[I_GATEB][l * 8 + 4 + h], lane, bcum, av); }
        __syncthreads();
        if (wave == 0) { float pm = av[lane];
#pragma unroll
            for (int o = 1; o < 64; o <<= 1) { const float t_ = shup(pm, lane, o); if (lane >= o) pm = fmaxf(pm, t_); }
            const float m_ = fmaxf(mc, pm); mm[lane] = m_; inter[lane] = __expf(mc - m_); }
        __syncthreads();
        if (wave < 4) { const int tt = wave >> 1, st = wave & 1;
            f32x16 acc = {}; acc = mfma_tile(qS, tt, kS, st, r, hh, acc);
            const int s = 32 * st + r; const float as = av[s];
#pragma unroll
            for (int g = 0; g < 16; ++g) { const int t = 32 * tt + (g & 3) + 8 * (g >> 2) + 4 * hh;
                const float val = (s <= t) ? acc[g] * __expf(as - mm[t]) : 0.f; Sb[t * PB + s] = (bf16)f2bf(val); } }
        __syncthreads();
        f32x16 aS = {}, aC = {}; const int tt = (wave < 6) ? wave / 3 : 0, nt = (wave < 6) ? wave % 3 : 0;
        if (wave < 6) { aS = mfma_tile(Sb, tt, vT, nt, r, hh, aS); aC = mfma_tile(qS, tt, cT, nt, r, hh, aC); }
        if (wave < 6 && nt == 2 && r == 0) {
#pragma unroll
            for (int g = 0; g < 16; ++g) { const int t = 32 * tt + (g & 3) + 8 * (g >> 2) + 4 * hh;
                const float dn = aS[g] + inter[t] * aC[g]; dinv[t] = 1.0f / fmaxf(fabsf(dn), __expf(-(bcum[t] + mm[t]))); } }
        __syncthreads();
        if (wave < 6 && nt < 2) {
#pragma unroll
            for (int g = 0; g < 16; ++g) { const int t = 32 * tt + (g & 3) + 8 * (g >> 2) + 4 * hh;
                hS[t * MP + 32 * nt + r] = (aS[g] + inter[t] * aC[g]) * dinv[t]; } }
        __syncthreads();
#pragma unroll
        for (int j = 0; j < 8; ++j) { const int t = wave + 8 * j, vc = lane; const size_t tk = (size_t)(tok0 + t);
            const float hv = hS[t * MP + vc];
            const float mean = wave_sum(hv) * (1.0f / 64.0f), hc = hv - mean;
            const float rs = 1.0f / sqrtf(wave_sum(hc * hc) * (1.0f / 64.0f) + LN_EPS);
            const float og = sigmoidf_(bf2f(H[tk * NHC + HC_MO + h * 64 + vc]));
            MIX[tk * D + h * 64 + vc] = (bf16)f2bf(og * (hc * rs * A->in[I_MNORM][l * 256 + h * 64 + vc])); }
        __syncthreads();
    }
}
__device__ __forceinline__ int wave_sum_i(int x) {
    x += __builtin_amdgcn_update_dpp(0, x, 0xB1, 0xF, 0xF, true);
    x += __builtin_amdgcn_update_dpp(0, x, 0x4E, 0xF, 0xF, true);
    x += __builtin_amdgcn_update_dpp(0, x, 0x141, 0xF, 0xF, true);
    x += __builtin_amdgcn_update_dpp(0, x, 0x140, 0xF, 0xF, true);
    return __builtin_amdgcn_readlane(x, 0) + __builtin_amdgcn_readlane(x, 16) + __builtin_amdgcn_readlane(x, 32) + __builtin_amdgcn_readlane(x, 48);
}
__device__ __forceinline__ void ph_select(int wvx) {
    TIDX;
    const float* SC = WS(float, WS_SC); unsigned* MASK = WS(unsigned, WS_MASK);
    for (int tok = gw; tok < T; tok += ngw) {
        const int tl = tok % SEQ, lo = 32 * lane;
        const int nv = min(max(tl + 1 - lo, 0), 32);
        unsigned cand = (nv >= 32) ? 0xffffffffu : ((1u << nv) - 1u);
        if (tl < 256) { MASK[(size_t)tok * 64 + lane] = cand; continue; }
        unsigned a[32];
#pragma unroll
        for (int j = 0; j < 8; ++j) {
            f32x4 v = (f32x4){0.f, 0.f, 0.f, 0.f};
            if (nv > 0) v = *(const GAS f32x4*)(SC + (size_t)tok * SEQ + lo + 4 * j);
#pragma unroll
            for (int c = 0; c < 4; ++c) { unsigned u = __float_as_uint(v[c]); u = (u == 0x80000000u) ? 0u : u; a[4 * j + c] = (u >> 31) ? ~u : (u | 0x80000000u); }
        }
#define TSTAGE(J, M) _Pragma("unroll") for (int k0 = 0; k0 < 32; ++k0) { if ((k0 & J) == 0) { const unsigned t_ = ((a[k0] >> J) ^ a[k0 + J]) & M; a[k0] ^= t_ << J; a[k0 + J] ^= t_; } }
        TSTAGE(16, 0x0000FFFFu) TSTAGE(8, 0x00FF00FFu) TSTAGE(4, 0x0F0F0F0Fu) TSTAGE(2, 0x33333333u) TSTAGE(1, 0x55555555u)
#undef TSTAGE
        unsigned sel = 0u; int need = 256, ncand = tl + 1;
#pragma unroll
        for (int b = 31; b >= 0; --b) {
            if (ncand != need) {
                const unsigned hit = cand & a[b];
                const int cnt = wave_sum_i(__popc(hit));
                if (cnt >= need) { cand = hit; ncand = cnt; }
                else { sel |= hit; cand &= ~a[b]; need -= cnt; ncand -= cnt; }
            }
        }
        if (ncand == need) sel |= cand;
        else {
            const int my = __popc(cand); int incl = my;
#pragma unroll
            for (int o = 1; o < 64; o <<= 1) { const int t_ = shupi(incl, lane, o); if (lane >= o) incl += t_; }
            const int take = min(max(need - (incl - my), 0), my); int taken = 0;
#pragma unroll 1
            for (int k = 0; k < 32; ++k) { if (((cand >> k) & 1u) && taken < take) { sel |= 1u << k; ++taken; } }
        }
        MASK[(size_t)tok * 64 + lane] = sel;
    }
}
constexpr int R1_OFF = RING_BYTES + 8192;
__device__ __forceinline__ void ph_row1(LAS unsigned char* lds, int l, int wvx, bool dry = false) {
    TIDX;
    const float* xin = (l == 0) ? A->in[I_X] : WS(float, WS_XB); float* XB = dry ? WS(float, WS_DUMMY) : WS(float, WS_XB);
    const bf16* Y = WS(bf16, WS_Y); bf16* U = dry ? WS(bf16, WS_DUMMY + 128 * MiB) : WS(bf16, WS_U);
    unsigned* cnt = dry ? WS(unsigned, WS_DUMMY + 200 * MiB) : WS(unsigned, WS_CTL) + CW_CNT + l * NEXP * 64; unsigned* TOK = dry ? WS(unsigned, WS_DUMMY + 192 * MiB) : WS(unsigned, WS_TOK);
    const float* lg = A->in[I_LN1G] + l * D; const float* lb = A->in[I_LN1B] + l * D;
    unsigned* RMAP = dry ? WS(unsigned, WS_DUMMY + 208 * MiB) : WS(unsigned, WS_XG);
    LAS float* rw = (LAS float*)lds; LAS unsigned* lcnt = (LAS unsigned*)(lds + R1_OFF); LAS unsigned* lbase = lcnt + 32; LAS unsigned* nrec = lbase + 32; LAS unsigned* rec = nrec + 4;
    { const GAS f32x4* src = (const GAS f32x4*)(WS(float, WS_RWT) + (size_t)l * NEXP * D);
      for (int i = tid; i < NEXP * D / 4; i += 512) ((LAS f32x4*)rw)[i] = src[i];
      if (tid < 32) lcnt[tid] = 0u; if (tid == 32) nrec[0] = 0u; }
    __syncthreads();
    const float rbias = A->in[I_RB][l * NEXP + (lane >> 1)];
    f32x4 px[4], pg[4]; unsigned long long py[4];
#define R1_LOAD(tk) do { const float* mod_ = WS(float, WS_MOD) + ((size_t)l * NB + (tk) / SEQ) * 6144; _Pragma("unroll") for (int j = 0; j < 4; ++j) { const int c = 4 * lane + 256 * j; \
        px[j] = *(const GAS f32x4*)(xin + (size_t)(tk) * D + c); pg[j] = *(const GAS f32x4*)(mod_ + 2048 + c); py[j] = *(const GAS unsigned long long*)(Y + (size_t)(tk) * D + c); } } while (0)
    if (gw < T) R1_LOAD(gw);
    for (int tok = gw; tok < T; tok += ngw) {
        const int b = tok / SEQ; const float* mod = WS(float, WS_MOD) + ((size_t)l * NB + b) * 6144;
        f32x4 v[4]; float s = 0.f;
#pragma unroll
        for (int j = 0; j < 4; ++j) {
            const f32x4 x = px[j]; const f32x4 g1 = pg[j];
            const unsigned long long yr = py[j];
            f32x4 y; y.x = __uint_as_float((unsigned)yr << 16); y.y = __uint_as_float((unsigned)yr & 0xffff0000u); y.z = __uint_as_float((unsigned)(yr >> 32) << 16); y.w = __uint_as_float((unsigned)(yr >> 32) & 0xffff0000u);
            v[j] = x * DN_ALPHA + (1.0f + g1) * y; s += (v[j].x + v[j].y) + (v[j].z + v[j].w); }
        if (tok + ngw < T) R1_LOAD(tok + ngw);
        const float mean = wave_sum(s) * (1.0f / D); float s2 = 0.f;
#pragma unroll
        for (int j = 0; j < 4; ++j) { v[j] = v[j] - mean; s2 += (v[j].x * v[j].x + v[j].y * v[j].y) + (v[j].z * v[j].z + v[j].w * v[j].w); }
        const float rstd = 1.0f / sqrtf(wave_sum(s2) * (1.0f / D) + LN_EPS);
        f32x4 u2[4];
#pragma unroll
        for (int j = 0; j < 4; ++j) { const int c = 4 * lane + 256 * j;
            const f32x4 xn = v[j] * rstd * *(const f32x4*)(lg + c) + *(const f32x4*)(lb + c);
            *(GAS f32x4*)(XB + (size_t)tok * D + c) = xn;
            u2[j] = xn * (1.0f + *(const f32x4*)(mod + 4096 + c)) + *(const f32x4*)(mod + 3072 + c);
            *(GAS unsigned*)((unsigned char*)U + (size_t)tok * D + c) = pg8::pk4_fp8(u2[j].x, u2[j].y, u2[j].z, u2[j].w, 16.0f); }
        float part[32];
#pragma unroll
        for (int e = 0; e < 32; ++e) { float a = 0.f;
#pragma unroll
            for (int j = 0; j < 4; ++j) { const f32x4 w = *(const LAS f32x4*)(rw + e * D + 4 * lane + 256 * j); a += (u2[j].x * w.x + u2[j].y * w.y) + (u2[j].z * w.z + u2[j].w * w.w); }
            part[e] = a; }
#define RSTEP(N, OFF) _Pragma("unroll") for (int e = 0; e < N; ++e) { const bool hi = (lane & OFF) != 0; const float send = hi ? part[e] : part[e + N]; const float recv = shx(send, lane, OFF); part[e] = (hi ? part[e + N] : part[e]) + recv; }
        RSTEP(16, 32) RSTEP(8, 16) RSTEP(4, 8) RSTEP(2, 4) RSTEP(1, 2)
#undef RSTEP
        float logit = part[0] + shx(part[0], lane, 1) + rbias;
        const int myexp = lane >> 1;
        float tv[4]; int te[4];
#pragma unroll
        for (int k = 0; k < 4; ++k) { float bv = logit; int be = myexp;
#pragma unroll
            for (int o = 2; o < 64; o <<= 1) { const float ov = shx(bv, lane, o); const int oe = shxi(be, lane, o); if (ov > bv || (ov == bv && oe < be)) { bv = ov; be = oe; } }
            tv[k] = bv; te[k] = be; if (myexp == be) logit = -INFINITY; }
        const float e1 = __expf(tv[1] - tv[0]), e2 = __expf(tv[2] - tv[0]), e3 = __expf(tv[3] - tv[0]); const float inv = 1.0f / (1.0f + e1 + e2 + e3);
        if (lane < 4) { const int ek = lane == 0 ? te[0] : lane == 1 ? te[1] : lane == 2 ? te[2] : te[3]; const float pk = (lane == 0 ? 1.0f : lane == 1 ? e1 : lane == 2 ? e2 : e3) * inv;
            const unsigned lp = __hip_atomic_fetch_add(lcnt + ek, 1u, __ATOMIC_RELAXED, __HIP_MEMORY_SCOPE_WORKGROUP);
            const unsigned ri = __hip_atomic_fetch_add(nrec, 1u, __ATOMIC_RELAXED, __HIP_MEMORY_SCOPE_WORKGROUP);
            if (ri < 640u) { LAS unsigned* r = rec + ri * 3; r[0] = (unsigned)tok * 4u + (unsigned)lane; r[1] = (unsigned)ek | (lp << 8); r[2] = __float_as_uint(pk); } }
    }
#undef R1_LOAD
    __syncthreads();
    if (tid < 32) lbase[tid] = __hip_atomic_fetch_add(cnt + tid * 64, lcnt[tid], __ATOMIC_RELAXED, __HIP_MEMORY_SCOPE_AGENT);
    __syncthreads();
    { const int n = (int)min(nrec[0], 640u);
      for (int i = tid; i < n; i += 512) { const unsigned r0 = rec[i * 3], r1 = rec[i * 3 + 1], r2 = rec[i * 3 + 2]; const unsigned ek = r1 & 255u;
          const unsigned pos = lbase[ek] + (r1 >> 8);
          *(GAS v4u*)(TOK + (size_t)r0 * 4) = (v4u){ek, pos, r2, 0u}; RMAP[(size_t)ek * T + pos] = r0 >> 2; } }
    __syncthreads();
}
__device__ __forceinline__ int moe_tables(LAS unsigned char* lds, int l, int wvx) {
    CArgs* A = kargs();
    LAS unsigned* base = (LAS unsigned*)(lds + TAB_OFF); LAS unsigned char* tile_e = lds + TAB_OFF + 256; LAS unsigned* cntl = (LAS unsigned*)(lds + TAB_OFF + 1024);
    const unsigned* cnt = WS(unsigned, WS_CTL) + CW_CNT + l * NEXP * 64;
    if (tid_of(wvx) == 0) { unsigned acc = 0u;
#pragma unroll 1
        for (int e = 0; e < NEXP; ++e) { const unsigned c = __hip_atomic_load(cnt + e * 64, __ATOMIC_RELAXED, __HIP_MEMORY_SCOPE_AGENT); const unsigned nt = (c + 255u) >> 8; base[e] = acc; cntl[e] = c;
#pragma unroll 1
            for (unsigned t = 0; t < nt; ++t) tile_e[(acc >> 8) + t] = (unsigned char)e; acc += nt << 8; }
        base[NEXP] = acc; }
    __syncthreads();
    return (int)(base[NEXP] >> 8);
}
__device__ __forceinline__ void ph_row2(LAS unsigned char* lds, int l, int wvx, bool dry = false) {
    TIDX;
    (void)moe_tables(lds, l, wvx);
    const LAS unsigned* base = (const LAS unsigned*)(lds + TAB_OFF);
    float* XB = WS(float, WS_XB); const bf16* YM = WS(bf16, WS_YM); bf16* U = WS(bf16, WS_U); const unsigned* TOK = WS(unsigned, WS_TOK);
    const float* lg = A->in[I_LN2G] + l * D; const float* lb = A->in[I_LN2B] + l * D; const float* b2 = A->in[I_B2] + (size_t)l * NEXP * D;
    float* dst = dry ? WS(float, WS_DUMMY) : (l == DEPTH - 1) ? A->out : XB; bf16* Uw = dry ? WS(bf16, WS_DUMMY + 128 * MiB) : U;
    v4u rcA[4], rcB[4]; unsigned long long yq[4][4]; f32x4 xq[4];
#define R2_REC(dst, tk) do { _Pragma("unroll") for (int k = 0; k < 4; ++k) dst[k] = *(const GAS v4u*)(TOK + ((size_t)(tk) * 4 + k) * 4); } while (0)
#define R2_ROWS(rc, tk) do { _Pragma("unroll") for (int k = 0; k < 4; ++k) { const size_t row_ = (size_t)base[rc[k].x] + rc[k].y; _Pragma("unroll") for (int j = 0; j < 4; ++j) yq[k][j] = *(const GAS unsigned long long*)(YM + row_ * D + 4 * lane + 256 * j); } \
        _Pragma("unroll") for (int j = 0; j < 4; ++j) xq[j] = *(const GAS f32x4*)(XB + (size_t)(tk) * D + 4 * lane + 256 * j); } while (0)
    if (gw < T) { R2_REC(rcA, gw); R2_ROWS(rcA, gw); }
    if (gw + ngw < T) R2_REC(rcB, gw + ngw);
    for (int tok = gw; tok < T; tok += ngw) {
        const int b = tok / SEQ; const float* mod = WS(float, WS_MOD) + ((size_t)l * NB + b) * 6144;
        f32x4 acc[4];
#pragma unroll
        for (int j = 0; j < 4; ++j) acc[j] = (f32x4){0.f, 0.f, 0.f, 0.f};
#pragma unroll
        for (int k = 0; k < 4; ++k) { const float p = __uint_as_float(rcA[k].z);
#pragma unroll
            for (int j = 0; j < 4; ++j) { const int c = 4 * lane + 256 * j; const unsigned long long yr = yq[k][j];
                f32x4 y; y.x = __uint_as_float((unsigned)yr << 16); y.y = __uint_as_float((unsigned)yr & 0xffff0000u); y.z = __uint_as_float((unsigned)(yr >> 32) << 16); y.w = __uint_as_float((unsigned)(yr >> 32) & 0xffff0000u);
                acc[j] = acc[j] + p * (y + *(const f32x4*)(b2 + (size_t)rcA[k].x * D + c)); } }
        f32x4 xc[4];
#pragma unroll
        for (int j = 0; j < 4; ++j) xc[j] = xq[j];
#pragma unroll
        for (int k = 0; k < 4; ++k) rcA[k] = rcB[k];
        if (tok + ngw < T) R2_ROWS(rcA, tok + ngw);
        if (tok + 2 * ngw < T) R2_REC(rcB, tok + 2 * ngw);
        f32x4 v[4]; float s = 0.f;
#pragma unroll
        for (int j = 0; j < 4; ++j) { const int c = 4 * lane + 256 * j; const f32x4 x = xc[j];
            v[j] = x * DN_ALPHA + (1.0f + *(const f32x4*)(mod + 5120 + c)) * acc[j]; s += (v[j].x + v[j].y) + (v[j].z + v[j].w); }
        const float mean = wave_sum(s) * (1.0f / D); float s2 = 0.f;
#pragma unroll
        for (int j = 0; j < 4; ++j) { v[j] = v[j] - mean; s2 += (v[j].x * v[j].x + v[j].y * v[j].y) + (v[j].z * v[j].z + v[j].w * v[j].w); }
        const float rstd = 1.0f / sqrtf(wave_sum(s2) * (1.0f / D) + LN_EPS);
        const float* modn = WS(float, WS_MOD) + ((size_t)(l + 1 < DEPTH ? l + 1 : l) * NB + b) * 6144;
#pragma unroll
        for (int j = 0; j < 4; ++j) { const int c = 4 * lane + 256 * j;
            f32x4 xn = v[j] * rstd * *(const f32x4*)(lg + c) + *(const f32x4*)(lb + c);
#ifdef F8PROBE
            { const unsigned* fl = WS(unsigned, WS_CTL) + 600; if (l == DEPTH - 1) { if (fl[0]) xn = xn * __builtin_nanf(""); else if (fl[1]) xn = xn * 2.0f; } }
#endif
            *(GAS f32x4*)(dst + (size_t)tok * D + c) = xn;
            if (l + 1 < DEPTH) { const f32x4 u = xn * (1.0f + *(const f32x4*)(modn + 1024 + c)) + *(const f32x4*)(modn + c);
                *(GAS unsigned long long*)(Uw + (size_t)tok * D + c) = (unsigned long long)pk2(u.x, u.y) | ((unsigned long long)pk2(u.z, u.w) << 32); } }
    }
#undef R2_REC
#undef R2_ROWS
    __syncthreads();
}
typedef int v8i_ __attribute__((ext_vector_type(8)));
__device__ __forceinline__ unsigned f8enc(int v) {
    const int a = v < 0 ? -v : v; const unsigned c = a == 0 ? 0x00u : a == 1 ? 0x38u : a == 2 ? 0x40u : a == 3 ? 0x44u : 0x48u; return c | (v < 0 ? 0x80u : 0u); }
__device__ __forceinline__ int f8_aval(int i, int k) { return ((i * 7 + k * 3) % 9) - 4; }
__device__ __forceinline__ int f8_bval(int k, int j) { return ((k * 5 + j * 11) % 7) - 3; }
__device__ __forceinline__ void f8_probe(unsigned* flags, int wvx) {
    const int lane = tid_of(wvx) & 63, rc = lane & 15, kg = lane >> 4;
    v8i_ av, bv;
#pragma unroll
    for (int w = 0; w < 8; ++w) { unsigned pa = 0u, pb = 0u;
#pragma unroll
        for (int e = 0; e < 4; ++e) { const int k = 32 * kg + 4 * w + e; pa |= f8enc(f8_aval(rc, k)) << (8 * e); pb |= f8enc(f8_bval(k, rc)) << (8 * e); }
        av[w] = (int)pa; bv[w] = (int)pb; }
    f32x4 z = {0.f, 0.f, 0.f, 0.f};
    const f32x4 d1 = __builtin_amdgcn_mfma_scale_f32_16x16x128_f8f6f4(av, bv, z, 0, 0, 0, 0x7f7f7f7f, 0, 0x7f7f7f7f);
    const f32x4 d2 = __builtin_amdgcn_mfma_scale_f32_16x16x128_f8f6f4(av, bv, z, 0, 0, 0, 0x7b7b7b7b, 0, 0x77777777);
    bool bad1 = false, bad2 = false;
#pragma unroll
    for (int g = 0; g < 4; ++g) { const int i = 4 * kg + g, j = rc; int e = 0;
        for (int k = 0; k < 128; ++k) e += f8_aval(i, k) * f8_bval(k, j);
        if (d1[g] != (float)e) bad1 = true; if (d2[g] != (float)e * (1.0f / 4096.0f)) bad2 = true; }
    if (__any(bad1) && lane == 0) flags[0] = 1u;
    if (__any(bad2) && lane == 0) flags[1] = 1u;
}
__global__ void __launch_bounds__(NWAVES * 64, 2) mega_fwd(Args A_) {
    extern __shared__ __attribute__((aligned(16))) unsigned char lds_raw[];
    LAS unsigned char* lds = (LAS unsigned char*)lds_raw;
    const int tid = threadIdx.x; const int wv0 = __builtin_amdgcn_readfirstlane(tid >> 6);
    volatile LAS unsigned* MISC = (volatile LAS unsigned*)(lds + MISC_OFF);
    for (int u = tid; u < (LDS_BYTES - TAB_OFF) / 4; u += NWAVES * 64) ((LAS unsigned*)(lds + TAB_OFF))[u] = 0u;
    __syncthreads();
    CArgs* A = kargs(); const bool multi = (A->s_hi - A->s_lo) > 1;
    if (multi) (void)xcd_barrier_post(WS(unsigned, WS_CTL) + CW_BAR + A->li * XCD_BAR_WORDS, MISC + 8);
    const int lo = A->s_lo, hi = A->s_hi;
#ifndef PHMASK
#define PHMASK 0xffffffffu
#endif
#define PHM(b) (((PHMASK) >> (b)) & 1u)
#ifndef RPTMASK
#define RPTMASK 0u
#endif
#define RPT(b) _Pragma("unroll 1") for (int rep_ = 0; rep_ < ((((RPTMASK) >> (b)) & 1u) ? 2 : 1); ++rep_)
#define RUN(s) (lo <= (s) && (s) < hi)
#define SEAM(s) do { if ((s) + 1 < hi) { CArgs* A_ = kargs(); xcd_barrier_fn((unsigned*)(A_->ws + WS_CTL) + CW_BAR + A_->li * XCD_BAR_WORDS, xb_xcc_id(), (volatile LAS unsigned*)(lds_launder(lds) + MISC_OFF) + 8, tid_of(wv0) == 0); } } while (0)
#ifdef F8PROBE
    if (RUN(0) && blockIdx.x == 0 && wv0 == 0) { CArgs* A = kargs(); f8_probe(WS(unsigned, WS_CTL) + 600, wv0); }
#endif
    if (RUN(0)) { if (PHM(0)) RPT(0) pro_a(lds_launder(lds), wv0); SEAM(0); }
    if (RUN(1)) { if (PHM(1)) RPT(1) pro_b(wv0); SEAM(1); }
    for (int l = 0; l < DEPTH; ++l) {
        const int sb = 2 + NPH * l;
        if (RUN(sb + PH_IN)) { CArgs* A = kargs();
            pg8::Gemm g{WS(bf16, WS_U), WS(bf16, WS_WIN) + (size_t)l * NHC * D, T, NHC, D}; pg8::StaticOrder S; S.init(T, NHC, (int)gridDim.x, (int)blockIdx.x);
            pg8::EpiIn E{WS(bf16, WS_H), WS(float, WS_CS)};
            if (PHM(2)) RPT(2) pg8::gemm_phase<pg8::EpiIn, pg8::StaticOrder, true, true>(lds_launder(lds), wv0, g, S, E);
            SEAM(sb + PH_IN);
        }
        if (RUN(sb + PH_POST)) { if (PHM(3)) RPT(3) ph_post(l, wv0); SEAM(sb + PH_POST); }
        if (RUN(sb + PH_MIXA)) { if (PHM(4)) RPT(4) ph_idx_scores(wv0); if (PHM(5)) RPT(16) ph_mlstm_m1(lds_launder(lds), l, wv0); if (PHM(6)) RPT(6) ph_diff_attn(lds_launder(lds), wv0); SEAM(sb + PH_MIXA); }
        if (RUN(sb + PH_SEL)) { if (PHM(5)) RPT(17) ph_mlstm_m2(wv0); if (PHM(7)) RPT(7) ph_select(wv0); SEAM(sb + PH_SEL); }
        if (RUN(sb + PH_DSA)) { if (PHM(5)) RPT(18) ph_mlstm_m3(lds_launder(lds), l, wv0); if (PHM(8)) RPT(8) { ph_diff_post(l, wv0); ph_dsa_attn(lds_launder(lds), wv0); } SEAM(sb + PH_DSA); }
        if (RUN(sb + PH_OUT)) { CArgs* A = kargs();
            pg8::Gemm g{WS(bf16, WS_MIX), WS(bf16, WS_WOUT) + (size_t)l * D * D, T, D, D}; pg8::StaticOrder S; S.init(T, D, (int)gridDim.x, (int)blockIdx.x);
            pg8::EpiBf16<0> E{WS(bf16, WS_Y), D, nullptr, 0, 0, 1.f};
            if (PHM(9)) RPT(9) pg8::gemm_phase<pg8::EpiBf16<0>, pg8::StaticOrder, true, true>(lds_launder(lds), wv0, g, S, E);
            SEAM(sb + PH_OUT);
        }
        if (RUN(sb + PH_ROW1)) { if (PHM(10)) { if ((RPTMASK >> 10) & 1u) ph_row1(lds_launder(lds), l, wv0, true); ph_row1(lds_launder(lds), l, wv0); } SEAM(sb + PH_ROW1); }
        if (RUN(sb + PH_G1)) { CArgs* A = kargs();
            const int nrt = moe_tables(lds_launder(lds), l, wv0);
            pg8::Gemm g{WS(bf16, WS_U), (const bf16*)(WS(unsigned char, WS_W1) + (size_t)l * NEXP * 2048 * D), RPAD, NEXP * 2048, D / 2}; pg8::MoeOrder S; S.init(nrt, 8, (int)gridDim.x, (int)blockIdx.x, (const LAS unsigned char*)(lds_launder(lds) + TAB_OFF + 256));
            pg8::EpiSwiGLU<true> E{WS(bf16, WS_HM), A->in[I_B1] + (size_t)l * NEXP * 2048, 1.0f / 4096.0f};
            LAS unsigned char* tb = lds_launder(lds) + TAB_OFF;
            pg8::MoeGatherA AM{WS(unsigned, WS_XG), (const LAS unsigned*)tb, (const LAS unsigned*)(tb + 1024), (const LAS unsigned char*)(tb + 256), T};
            if (PHM(12)) RPT(12) pg8::gemm_phase<pg8::EpiSwiGLU<true>, pg8::MoeOrder, true, true, pg8::MoeGatherA, true>(lds_launder(lds), wv0, g, S, E, AM, 0, 0);
            SEAM(sb + PH_G1);
        }
        if (RUN(sb + PH_G2)) { CArgs* A = kargs();
            const int nrt = moe_tables(lds_launder(lds), l, wv0);
            pg8::Gemm g{WS(bf16, WS_HM), (const bf16*)(WS(unsigned char, WS_W2) + (size_t)l * NEXP * D * D), RPAD, NEXP * D, D / 2}; pg8::MoeOrder S; S.init(nrt, 4, (int)gridDim.x, (int)blockIdx.x, (const LAS unsigned char*)(lds_launder(lds) + TAB_OFF + 256));
            pg8::EpiMoeOut E{WS(bf16, WS_YM), 1.0f / 2048.0f};
            if (PHM(13)) RPT(13) pg8::gemm_phase<pg8::EpiMoeOut, pg8::MoeOrder, true, true, pg8::DirectA, true>(lds_launder(lds), wv0, g, S, E, pg8::DirectA(), 0, 0);
            SEAM(sb + PH_G2);
        }
        if (RUN(sb + PH_ROW2)) { if (PHM(14)) { if ((RPTMASK >> 14) & 1u) ph_row2(lds_launder(lds), l, wv0, true); ph_row2(lds_launder(lds), l, wv0); } SEAM(sb + PH_ROW2); }
    }
#undef RUN
#undef SEAM
}

#ifndef MK_STEPS_PER_LAUNCH
#define MK_STEPS_PER_LAUNCH 1000
#endif
extern "C" void kernel_launch(void* const* d_in, const int* in_sizes, int n_in, void* d_out, int out_size, void* d_ws, size_t ws_size, hipStream_t stream) {
    static int grid = 0;
    if (grid == 0) {
        if (n_in != 25 || out_size != T * D || ws_size < WS_END4) { fprintf(stderr, "kernel_launch: unexpected shapes (n_in %d out %d ws %zu)\n", n_in, out_size, ws_size); grid = -1; return; }
        int dev = 0, cus = 0, per_cu = 0;
        if (hipGetDevice(&dev) != hipSuccess || hipDeviceGetAttribute(&cus, hipDeviceAttributeMultiprocessorCount, dev) != hipSuccess) { grid = -1; return; }
        if (hipFuncSetAttribute((const void*)mega_fwd, hipFuncAttributeMaxDynamicSharedMemorySize, LDS_BYTES) != hipSuccess) { fprintf(stderr, "kernel_launch: hipFuncSetAttribute failed\n"); grid = -1; return; }
        if (hipOccupancyMaxActiveBlocksPerMultiprocessor(&per_cu, (const void*)mega_fwd, NWAVES * 64, LDS_BYTES) != hipSuccess || per_cu < 1) { fprintf(stderr, "kernel_launch: occupancy query says %d\n", per_cu); }
        (void)hipGetLastError();
        grid = cus;
    }
    if (grid < 0) return;
    if (hipMemsetAsync((char*)d_ws + WS_CTL, 0, CTL_ZERO_BYTES, stream) != hipSuccess) return;
    Args a{};
    for (int i = 0; i < 25; ++i) a.in[i] = (const float*)d_in[i];
    a.out = (float*)d_out; a.ws = (unsigned char*)d_ws;
    int li = 0;
    for (int s = 0; s < NSTEPS; s += MK_STEPS_PER_LAUNCH, ++li) {
        a.s_lo = s; a.s_hi = (s + MK_STEPS_PER_LAUNCH < NSTEPS) ? s + MK_STEPS_PER_LAUNCH : NSTEPS; a.li = li; a.pad = 0;
        hipLaunchKernelGGL(mega_fwd, dim3(grid), dim3(NWAVES * 64), LDS_BYTES, stream, a);
    }
}
```

```cpp
#include <hip/hip_runtime.h>
#include <cstdio>
#include <cstdint>

__device__ __forceinline__ int lane_id_() { int l_; asm volatile("v_mbcnt_lo_u32_b32 %0, -1, 0\n\tv_mbcnt_hi_u32_b32 %0, -1, %0" : "=&v"(l_)); return l_; }
namespace pg8 {
#define PG8_LAS __attribute__((address_space(3)))
typedef unsigned short bf16_t;
typedef short bf16x8 __attribute__((ext_vector_type(8)));
typedef float f32x4 __attribute__((ext_vector_type(4)));
typedef unsigned u32x4 __attribute__((ext_vector_type(4)));
constexpr int BM = 256, BK = 64, HALF = 128, HTB = HALF * BK * 2  , STAGE_BYTES = 8 * HTB, NXCD = 8, WGM = 8;

__host__ __device__ __forceinline__ int lds_byte(int r, int c) { const int st = (r >> 4) * 2 + (c >> 5), rr = r & 15, cc = c & 31, ob = rr * 64 + cc * 2; return st * 1024 + (ob ^ (((ob >> 9) & 1) << 5)); }
__host__ __device__ __forceinline__ void stage_rc(int b, int& R, int& C) { const int st = b / 1024, sb = b % 1024, swz = sb ^ (((sb >> 9) & 1) << 5); R = (st >> 1) * 16 + swz / 64; C = (st & 1) * 32 + (swz % 64) / 2; }
__host__ __device__ __forceinline__ int perm32(int rho) { const int n = rho >> 4, i = rho & 15; return 8 * (i >> 2) + 4 * n + (i & 3); }

struct Unit { int pm, pn; };
struct Gemm { const bf16_t* A; const bf16_t* Bt; int M, N, K; };

struct StaticOrder {
    int nM, nN, nwg, G, c;
    __host__ __device__ void init(int M, int N, int G_, int c_) { nM = M / BM; nN = N / BM; nwg = nM * nN; G = G_; c = c_; }
    __host__ __device__ bool next(int i, Unit& u) const {
        const long L = (long)i * G + c; if (L >= nwg) return false;
        int wgid = (int)L; { const int q = nwg / NXCD, r = nwg % NXCD, xcd = wgid % NXCD, off = wgid / NXCD; wgid = (xcd < r ? xcd * (q + 1) : r * (q + 1) + (xcd - r) * q) + off; }
        const int nig = WGM * nN, gid = wgid / nig, fm = gid * WGM, gsz = (nM - fm) < WGM ? (nM - fm) : WGM;
        u.pm = fm + ((wgid % nig) % gsz); u.pn = (wgid % nig) / gsz; return true;
    }
    __device__ __forceinline__ void a_ready(const Unit&) const {}
    __device__ __forceinline__ void done(const Unit&) const {}
};
struct MoeOrder {
    int nM, nN, nwg, G, c; const PG8_LAS unsigned char* tile_e;
    __device__ void init(int nRT, int NTN, int G_, int c_, const PG8_LAS unsigned char* te) { nM = nRT; nN = NTN; nwg = nM * nN; G = G_; c = c_; tile_e = te; }
    __device__ bool next(int i, Unit& u) const {
        const long L = (long)i * G + c; if (L >= nwg) return false;
        int wgid = (int)L; { const int q = nwg / NXCD, r = nwg % NXCD, xcd = wgid % NXCD, off = wgid / NXCD; wgid = (xcd < r ? xcd * (q + 1) : r * (q + 1) + (xcd - r) * q) + off; }
        const int nig = WGM * nN, gid = wgid / nig, fm = gid * WGM, gsz = (nM - fm) < WGM ? (nM - fm) : WGM;
        u.pm = fm + ((wgid % nig) % gsz); const int pl = (wgid % nig) / gsz; u.pn = (int)tile_e[u.pm] * nN + pl; return true;
    }
    __device__ __forceinline__ void a_ready(const Unit&) const {}
    __device__ __forceinline__ void done(const Unit&) const {}
};
struct MoeGatherA {
    static constexpr bool GATHER = true;
    const unsigned* rowmap; const PG8_LAS unsigned* base; const PG8_LAS unsigned* cnt; const PG8_LAS unsigned char* tile_e; int ntok;
    __device__ __forceinline__ unsigned off(const Unit& u, int h, int rA, int cA, int K) const {
        const int e = tile_e[u.pm]; const unsigned pos = (unsigned)u.pm * 256u - base[e] + 128u * h + (unsigned)rA;
        const unsigned tok = pos < cnt[e] ? rowmap[(size_t)e * ntok + pos] : 0u;
        return (tok * (unsigned)K + (unsigned)cA) * 2u;
    }
};
__device__ __forceinline__ unsigned cvt_pk_bf16(float lo, float hi) { unsigned r; asm volatile("v_cvt_pk_bf16_f32 %0, %1, %2" : "=v"(r) : "v"(lo), "v"(hi)); return r; }
typedef float f32x2 __attribute__((ext_vector_type(2)));
__device__ __forceinline__ f32x2 gelu_pk(f32x2 v) {
    const f32x2 av = __builtin_elementwise_abs(v), d = av * 0.2316418882f + 1.0f;
    f32x2 t; t.x = __builtin_amdgcn_rcpf(d.x); t.y = __builtin_amdgcn_rcpf(d.y);
    f32x2 q = t * 0.5307027145f + (-0.7265760135f); q = q * t + 0.7107068705f; q = q * t + (-0.142248368f); q = q * t + 0.127414796f; q = q * t;
    const f32x2 s = (v * v) * (-0.72134752044f);
    f32x2 e; e.x = __builtin_amdgcn_exp2f(s.x); e.y = __builtin_amdgcn_exp2f(s.y);
    const f32x2 m = v * (q * e), r = v - m;
    f32x2 o; o.x = v.x < 0.f ? m.x : r.x; o.y = v.y < 0.f ? m.y : r.y; return o;
}

template <int ACT  > struct EpiBf16 {
    static constexpr bool PERM = true, AFTER_DRAIN = false; static_assert(ACT == 0 || ACT == 1, "EpiBf16: ACT is 0 (none) or 1 (gelu_pk)");
    bf16_t* O; int ldc; const float* bias; int split_cols; size_t split_stride; float scale0;
    __device__ __forceinline__ void operator()(const f32x4 (&acc)[2][2][4][2], const Unit& u, int wr, int wc, int fr, int fq) const {
        const int row0 = u.pm * BM + wr * 64 + fr; int colt = u.pn * BM; bf16_t* base = O;
        float sc = 1.f; if (split_cols) { const int t = colt / split_cols; base += (size_t)t * split_stride; colt -= t * split_cols; if (t == 0) sc = scale0; }
        const int col0 = colt + wc * 32 + 8 * fq, bcol0 = u.pn * BM + wc * 32 + 8 * fq;
        f32x4 bv[2][2];
#pragma unroll
        for (int bj = 0; bj < 2; ++bj)
#pragma unroll
            for (int n = 0; n < 2; ++n) bv[bj][n] = bias ? *(const f32x4*)(bias + bcol0 + bj * HALF + 4 * n) : (f32x4){0.f, 0.f, 0.f, 0.f};
#pragma unroll
        for (int ai = 0; ai < 2; ++ai)
#pragma unroll
            for (int m = 0; m < 4; ++m) { bf16_t* rowp = base + (size_t)(row0 + ai * HALF + m * 16) * ldc + col0;
#pragma unroll
                for (int bj = 0; bj < 2; ++bj) { f32x4 v0 = acc[ai][bj][m][0] + bv[bj][0], v1 = acc[ai][bj][m][1] + bv[bj][1];
                    if (ACT == 1) { f32x2 a = gelu_pk((f32x2){v0[0], v0[1]}), b = gelu_pk((f32x2){v0[2], v0[3]}), c = gelu_pk((f32x2){v1[0], v1[1]}), d = gelu_pk((f32x2){v1[2], v1[3]});
                        v0 = (f32x4){a.x, a.y, b.x, b.y}; v1 = (f32x4){c.x, c.y, d.x, d.y}; }
                    v0 = v0 * sc; v1 = v1 * sc; u32x4 w; w.x = cvt_pk_bf16(v0[0], v0[1]); w.y = cvt_pk_bf16(v0[2], v0[3]); w.z = cvt_pk_bf16(v1[0], v1[1]); w.w = cvt_pk_bf16(v1[2], v1[3]);
                    *(u32x4*)(rowp + bj * HALF) = w; } }
    }
};
constexpr float C2 = 0.125f * 1.4426950408889634f;
struct EpiIn {
    static constexpr bool PERM = true, AFTER_DRAIN = false;
    bf16_t* O; const float* cs;
    __device__ __forceinline__ void operator()(const f32x4 (&acc)[2][2][4][2], const Unit& u, int wr, int wc, int fr, int fq) const {
        const int pn = u.pn;
        const bool rope = (0x6CF0 >> pn) & 1;
        const float sc = ((0x0430 >> pn) & 1) ? C2 : 1.f;
        const int row0 = u.pm * BM + wr * 64 + fr, col0 = pn * BM + wc * 32 + 8 * fq, i0 = (wc & 1) * 16 + 4 * fq;
#pragma unroll
        for (int ai = 0; ai < 2; ++ai)
#pragma unroll
            for (int m = 0; m < 4; ++m) {
                const int row = row0 + ai * HALF + m * 16;
                f32x4 c01 = (f32x4){1.f, 0.f, 1.f, 0.f}, c23 = c01;
                if (rope) { c01 = *(const f32x4*)(cs + (size_t)row * 64 + i0 * 2); c23 = *(const f32x4*)(cs + (size_t)row * 64 + i0 * 2 + 4); }
                bf16_t* rowp = O + (size_t)row * 4096 + col0;
#pragma unroll
                for (int bj = 0; bj < 2; ++bj) {
                    f32x4 v0 = acc[ai][bj][m][0], v1 = acc[ai][bj][m][1];
                    if (rope) {
                        f32x4 r0, r1;
                        r0[0] = v0[0] * c01[0] - v0[1] * c01[1]; r0[1] = v0[1] * c01[0] + v0[0] * c01[1];
                        r0[2] = v0[2] * c01[2] - v0[3] * c01[3]; r0[3] = v0[3] * c01[2] + v0[2] * c01[3];
                        r1[0] = v1[0] * c23[0] - v1[1] * c23[1]; r1[1] = v1[1] * c23[0] + v1[0] * c23[1];
                        r1[2] = v1[2] * c23[2] - v1[3] * c23[3]; r1[3] = v1[3] * c23[2] + v1[2] * c23[3];
                        v0 = r0; v1 = r1;
                    }
                    v0 = v0 * sc; v1 = v1 * sc;
                    u32x4 w; w.x = cvt_pk_bf16(v0[0], v0[1]); w.y = cvt_pk_bf16(v0[2], v0[3]); w.z = cvt_pk_bf16(v1[0], v1[1]); w.w = cvt_pk_bf16(v1[2], v1[3]);
                    *(u32x4*)(rowp + bj * HALF) = w;
                }
            }
    }
};
__device__ __forceinline__ unsigned pk4_fp8(float a, float b, float c, float d, float sc) {
    a = fminf(fmaxf(a * sc, -448.f), 448.f); b = fminf(fmaxf(b * sc, -448.f), 448.f); c = fminf(fmaxf(c * sc, -448.f), 448.f); d = fminf(fmaxf(d * sc, -448.f), 448.f);
    int w = __builtin_amdgcn_cvt_pk_fp8_f32(a, b, 0, false); w = __builtin_amdgcn_cvt_pk_fp8_f32(c, d, w, true); return (unsigned)w; }
template <bool F8OUT> struct EpiSwiGLU {
    static constexpr bool PERM = true, AFTER_DRAIN = false;
    bf16_t* O; const float* b1; float asc;
    __device__ __forceinline__ void operator()(const f32x4 (&acc)[2][2][4][2], const Unit& u, int wr, int wc, int fr, int fq) const {
        const int e = u.pn >> 3, pl = u.pn & 7, colh = pl * 128 + wc * 32 + 8 * fq;
        const float* bp = b1 + (size_t)e * 2048 + colh;
        f32x4 bg[2], bu[2];
#pragma unroll
        for (int n = 0; n < 2; ++n) { bg[n] = *(const f32x4*)(bp + 4 * n); bu[n] = *(const f32x4*)(bp + 1024 + 4 * n); }
        const int row0 = u.pm * BM + wr * 64 + fr;
#pragma unroll
        for (int ai = 0; ai < 2; ++ai)
#pragma unroll
            for (int m = 0; m < 4; ++m) {
                f32x4 o[2];
#pragma unroll
                for (int n = 0; n < 2; ++n) {
                    const f32x4 g4 = acc[ai][0][m][n] * asc + bg[n], u4 = acc[ai][1][m][n] * asc + bu[n];
#pragma unroll
                    for (int c = 0; c < 4; ++c) {
                        const float g = fminf(g4[c], 7.0f), up = fminf(fmaxf(u4[c], -7.0f), 7.0f);
                        const float sg = __builtin_amdgcn_rcpf(1.0f + __builtin_amdgcn_exp2f(-1.702f * 1.4426950408889634f * g));
                        o[n][c] = (up + 1.0f) * (g * sg);
                    }
                }
                if constexpr (F8OUT) { typedef unsigned u32x2_ __attribute__((ext_vector_type(2))); u32x2_ w; w.x = pk4_fp8(o[0][0], o[0][1], o[0][2], o[0][3], 8.0f); w.y = pk4_fp8(o[1][0], o[1][1], o[1][2], o[1][3], 8.0f);
                    *(u32x2_*)((unsigned char*)O + (size_t)(row0 + ai * HALF + m * 16) * 1024 + colh) = w; }
                else { u32x4 w; w.x = cvt_pk_bf16(o[0][0], o[0][1]); w.y = cvt_pk_bf16(o[0][2], o[0][3]); w.z = cvt_pk_bf16(o[1][0], o[1][1]); w.w = cvt_pk_bf16(o[1][2], o[1][3]);
                    *(u32x4*)(O + (size_t)(row0 + ai * HALF + m * 16) * 1024 + colh) = w; }
            }
    }
};
struct EpiMoeOut {
    static constexpr bool PERM = true, AFTER_DRAIN = false;
    bf16_t* O; float asc;
    __device__ __forceinline__ void operator()(const f32x4 (&acc)[2][2][4][2], const Unit& u, int wr, int wc, int fr, int fq) const {
        const int row0 = u.pm * BM + wr * 64 + fr, col0 = (u.pn & 3) * BM + wc * 32 + 8 * fq;
#pragma unroll
        for (int ai = 0; ai < 2; ++ai)
#pragma unroll
            for (int m = 0; m < 4; ++m) { bf16_t* rowp = O + (size_t)(row0 + ai * HALF + m * 16) * 1024 + col0;
#pragma unroll
                for (int bj = 0; bj < 2; ++bj) { const f32x4 v0 = acc[ai][bj][m][0] * asc, v1 = acc[ai][bj][m][1] * asc;
                    u32x4 w; w.x = cvt_pk_bf16(v0[0], v0[1]); w.y = cvt_pk_bf16(v0[2], v0[3]); w.z = cvt_pk_bf16(v1[0], v1[1]); w.w = cvt_pk_bf16(v1[2], v1[3]);
                    *(u32x4*)(rowp + bj * HALF) = w; } }
    }
};
struct DirectA { static constexpr bool GATHER = false; __device__ __forceinline__ unsigned off(const Unit&, int, int, int, int) const { return 0u; } };
typedef int v8i32 __attribute__((ext_vector_type(8)));
template <class Epi, class Sched, bool ALIGN_EPI = false, bool SP2 = false, class AMap = DirectA, bool F8 = false>
__device__ __forceinline__ void gemm_phase(PG8_LAS unsigned char* lds, int wvx, const Gemm g, const Sched& S, const Epi& E, const AMap& AM = AMap(), int scA = 0x7f7f7f7f, int scB = 0x7f7f7f7f) {
    int tid_ = wvx * 64 + lane_id_(); asm volatile("" : "+v"(tid_));
    const int tid = tid_, wid = __builtin_amdgcn_readfirstlane(tid >> 6), lane = tid & 63, wr = wid >> 2, wc = wid & 3, fr = lane & 15, fq = lane >> 4;
    const int K = g.K, nt = K / BK;
    unsigned voffB[2], vA[2];
#pragma unroll
    for (int i = 0; i < 2; ++i) { int R, C; stage_rc(tid * 16 + i * 8192, R, C); const int Rb = Epi::PERM ? ((R & ~31) + perm32(R & 31)) : R;
        vA[i] = (unsigned)(R * K + C) * 2u; voffB[i] = (unsigned)(Rb * K + C) * 2u; }
    const size_t kstep = (size_t)(BK * 2);
    const size_t hstep = (size_t)HALF * K * 2;
    const size_t tstep = 2 * hstep;
    const unsigned ldsw = (unsigned)wid * 1024u;
    const int aoff = lds_byte(wr * 64 + fr, fq * 8), boff = lds_byte(wc * 32 + fr, fq * 8);
#define PG8_SA(b, h) (((b) * 2 + (h)) * HTB)
#define PG8_SB(b, h) ((4 + (b) * 2 + (h)) * HTB)
#define PG8_STAGEA(bufoff, kb, h, nx) do { size_t ubx_ = (size_t)(kb); unsigned lo_[2]; \
        if constexpr (AMap::GATHER) { _Pragma("unroll") for (int _i = 0; _i < 2; ++_i) lo_[_i] = (nx) ? oN[h][_i] : oC[h][_i]; } \
        else { ubx_ += (nx) ? uN[h] : uC[h]; _Pragma("unroll") for (int _i = 0; _i < 2; ++_i) lo_[_i] = vA[_i]; } \
        const char* ub_ = Abase + ubx_; asm("" : "+s"(ub_)); _Pragma("unroll") for (int _i = 0; _i < 2; ++_i) asm("" : "+v"(lo_[_i]));     \
        _Pragma("unroll") for (int _i = 0; _i < 2; ++_i) \
        __builtin_amdgcn_global_load_lds((const unsigned*)(ub_ + lo_[_i]), (PG8_LAS unsigned*)(lds + (bufoff) + ldsw + _i * 8192), 16, 0, 0); } while (0)
#define PG8_AOFF(dstL, dstU, u) do { if constexpr (AMap::GATHER) { int t2_ = wvx * 64 + lane_id_(); asm volatile("" : "+v"(t2_)); _Pragma("unroll") for (int _i = 0; _i < 2; ++_i) { int R_, C_; stage_rc(t2_ * 16 + _i * 8192, R_, C_); \
            _Pragma("unroll") for (int _h = 0; _h < 2; ++_h) dstL[_h][_i] = AM.off(u, _h, R_, C_, K); } } \
        else { _Pragma("unroll") for (int _h = 0; _h < 2; ++_h) dstU[_h] = ((size_t)(u).pm * BM + 128 * _h) * (size_t)K * 2; } } while (0)
#define PG8_STAGE(bufoff, gbase, voff) do { const char* ub_ = (const char*)(gbase); asm("" : "+s"(ub_)); _Pragma("unroll") for (int _i = 0; _i < 2; ++_i) \
        __builtin_amdgcn_global_load_lds((const unsigned*)(ub_ + (voff)[_i]), (PG8_LAS unsigned*)(lds + (bufoff) + ldsw + _i * 8192), 16, 0, 0); } while (0)
#define PG8_LDA(dst, b, h) do { _Pragma("unroll") for (int m = 0; m < 4; ++m) _Pragma("unroll") for (int k = 0; k < 2; ++k) dst[m][k] = *(const PG8_LAS bf16x8*)(lds + PG8_SA(b, h) + aoff + m * 2048 + k * 1024); } while (0)
#define PG8_LDB(dst, b, h) do { _Pragma("unroll") for (int n = 0; n < 2; ++n) _Pragma("unroll") for (int k = 0; k < 2; ++k) dst[n][k] = *(const PG8_LAS bf16x8*)(lds + PG8_SB(b, h) + boff + n * 2048 + k * 1024); } while (0)
#define PG8_CAT(x) __builtin_bit_cast(v8i32, __builtin_shufflevector(x[0], x[1], 0, 1, 2, 3, 4, 5, 6, 7, 8, 9, 10, 11, 12, 13, 14, 15))
#define PG8_MMA(ai, bj, At, Bt) do { __builtin_amdgcn_s_setprio(1); _Pragma("unroll") for (int m = 0; m < 4; ++m) _Pragma("unroll") for (int n = 0; n < 2; ++n) { \
        if constexpr (F8) acc[ai][bj][m][n] = __builtin_amdgcn_mfma_scale_f32_16x16x128_f8f6f4(PG8_CAT(Bt[n]), PG8_CAT(At[m]), acc[ai][bj][m][n], 0, 0, 0, scB, 0, scA); \
        else { _Pragma("unroll") for (int k = 0; k < 2; ++k) acc[ai][bj][m][n] = __builtin_amdgcn_mfma_f32_16x16x32_bf16(Bt[n][k], At[m][k], acc[ai][bj][m][n], 0, 0, 0); } } __builtin_amdgcn_s_setprio(0); } while (0)
#define PG8_WAIT_V(n) asm volatile("s_waitcnt vmcnt(" #n ")" ::: "memory")
#define PG8_WAIT_L(n) asm volatile("s_waitcnt lgkmcnt(" #n ")" ::: "memory")
#define PG8_BAR __builtin_amdgcn_s_barrier()
#define PG8_SCHED __builtin_amdgcn_sched_barrier(0)
    Unit cur, nxt; int ui = 0;
    if (!S.next(0, cur)) return;
    f32x4 acc[2][2][4][2];
#pragma unroll
    for (int a = 0; a < 2; ++a)
#pragma unroll
        for (int b = 0; b < 2; ++b)
#pragma unroll
            for (int m = 0; m < 4; ++m)
#pragma unroll
                for (int n = 0; n < 2; ++n) acc[a][b][m][n] = (f32x4){0.f, 0.f, 0.f, 0.f};
    bf16x8 At[4][2], B0[2][2], B1[2][2];
    const char* Abase = (const char*)g.A; const char* cB = (const char*)g.Bt + (size_t)cur.pn * tstep;
    unsigned oC[2][2], oN[2][2]; size_t uC[2] = {0, 0}, uN[2] = {0, 0}; PG8_AOFF(oC, uC, cur);
    S.a_ready(cur);
    if constexpr (SP2) {
        PG8_STAGE(PG8_SB(0, 0), cB, voffB); PG8_STAGE(PG8_SB(0, 1), cB + hstep, voffB); PG8_STAGEA(PG8_SA(0, 0), 0, 0, false); PG8_STAGEA(PG8_SA(0, 1), 0, 1, false);
        if (wr == 1) PG8_BAR;
        PG8_WAIT_V(2); PG8_BAR;
        PG8_STAGE(PG8_SB(1, 0), cB + kstep, voffB); PG8_STAGEA(PG8_SA(1, 0), kstep, 0, false); PG8_STAGE(PG8_SB(1, 1), cB + hstep + kstep, voffB);
        PG8_WAIT_V(6); PG8_BAR;
    } else {
        PG8_STAGE(PG8_SB(0, 0), cB, voffB); PG8_STAGEA(PG8_SA(0, 0), 0, 0, false); PG8_STAGE(PG8_SB(0, 1), cB + hstep, voffB); PG8_STAGEA(PG8_SA(0, 1), 0, 1, false);
        if (wr == 1) PG8_BAR;
        PG8_WAIT_V(4); PG8_BAR;
        PG8_STAGE(PG8_SB(1, 0), cB + kstep, voffB); PG8_STAGEA(PG8_SA(1, 0), kstep, 0, false); PG8_STAGE(PG8_SB(1, 1), cB + hstep + kstep, voffB);
        PG8_WAIT_V(6); PG8_BAR;
    }
    for (;;) {
        const bool has_next = S.next(ui + 1, nxt);
        const char* nB = has_next ? (const char*)g.Bt + (size_t)nxt.pn * tstep : cB;
        if (has_next) { PG8_AOFF(oN, uN, nxt); } else {
#pragma unroll
            for (int _h = 0; _h < 2; ++_h) { oN[_h][0] = oC[_h][0]; oN[_h][1] = oC[_h][1]; uN[_h] = uC[_h]; } }
#pragma unroll 1
        for (int t = 0; t < nt; t += 2) {
            const bool last = (t == nt - 2);
            const size_t ka1 = (size_t)(t + 1) * kstep, ka2 = last ? (size_t)0 : (size_t)(t + 2) * kstep, ka3 = ka2 + kstep;
            const char* b2 = last ? nB : cB + (size_t)(t + 2) * kstep; const char* b3 = b2 + kstep;
            if (last && has_next) S.a_ready(nxt);
            if constexpr (SP2) {
            PG8_LDB(B0, 0, 0); PG8_LDB(B1, 0, 1); PG8_SCHED; PG8_LDA(At, 0, 0); PG8_STAGEA(PG8_SA(1, 1), ka1, 1, false);
            PG8_WAIT_V(8); PG8_WAIT_L(0); PG8_BAR; PG8_MMA(0, 0, At, B0); PG8_MMA(0, 1, At, B1); PG8_BAR; PG8_SCHED;
            PG8_LDA(At, 0, 1); PG8_STAGE(PG8_SB(0, 0), b2, voffB); PG8_STAGE(PG8_SB(0, 1), b2 + hstep, voffB); PG8_STAGEA(PG8_SA(0, 0), ka2, 0, last);
            PG8_WAIT_V(8); PG8_WAIT_L(0); PG8_BAR; PG8_MMA(1, 0, At, B0); PG8_MMA(1, 1, At, B1); PG8_BAR; PG8_SCHED;
            PG8_LDB(B0, 1, 0); PG8_LDB(B1, 1, 1); PG8_SCHED; PG8_LDA(At, 1, 0); PG8_STAGEA(PG8_SA(0, 1), ka2, 1, last);
            PG8_WAIT_V(8); PG8_WAIT_L(0); PG8_BAR; PG8_MMA(0, 0, At, B0); PG8_MMA(0, 1, At, B1); PG8_BAR; PG8_SCHED;
            PG8_LDA(At, 1, 1); PG8_STAGE(PG8_SB(1, 0), b3, voffB); PG8_STAGE(PG8_SB(1, 1), b3 + hstep, voffB); PG8_STAGEA(PG8_SA(1, 0), ka3, 0, last);
            PG8_WAIT_V(8); PG8_WAIT_L(0); PG8_BAR; PG8_MMA(1, 0, At, B0); PG8_MMA(1, 1, At, B1); PG8_BAR; PG8_SCHED;
            } else {
            PG8_LDB(B0, 0, 0); PG8_SCHED; PG8_LDA(At, 0, 0); PG8_STAGEA(PG8_SA(1, 1), ka1, 1, false);
            PG8_WAIT_L(8); PG8_BAR; PG8_WAIT_L(0); PG8_MMA(0, 0, At, B0); PG8_BAR; PG8_SCHED;
            PG8_LDB(B1, 0, 1); PG8_STAGE(PG8_SB(0, 0), b2, voffB);
            PG8_BAR; PG8_WAIT_L(0); PG8_MMA(0, 1, At, B1); PG8_BAR;
            PG8_LDA(At, 0, 1); PG8_STAGEA(PG8_SA(0, 0), ka2, 0, last);
            PG8_BAR; PG8_WAIT_L(0); PG8_MMA(1, 0, At, B0); PG8_BAR; PG8_SCHED;
            PG8_STAGE(PG8_SB(0, 1), b2 + hstep, voffB);
            PG8_WAIT_V(6); PG8_BAR; PG8_MMA(1, 1, At, B1); PG8_BAR;
            PG8_LDB(B0, 1, 0); PG8_SCHED; PG8_LDA(At, 1, 0); PG8_STAGEA(PG8_SA(0, 1), ka2, 1, last);
            PG8_WAIT_L(8); PG8_BAR; PG8_WAIT_L(0); PG8_MMA(0, 0, At, B0); PG8_BAR; PG8_SCHED;
            PG8_LDB(B1, 1, 1); PG8_STAGE(PG8_SB(1, 0), b3, voffB);
            PG8_BAR; PG8_WAIT_L(0); PG8_MMA(0, 1, At, B1); PG8_BAR;
            PG8_LDA(At, 1, 1); PG8_STAGEA(PG8_SA(1, 0), ka3, 0, last);
            PG8_BAR; PG8_WAIT_L(0); PG8_MMA(1, 0, At, B0); PG8_BAR; PG8_SCHED;
            PG8_STAGE(PG8_SB(1, 1), b3 + hstep, voffB);
            PG8_WAIT_V(6); PG8_BAR; PG8_MMA(1, 1, At, B1); PG8_BAR;
            }
        }
        if constexpr (ALIGN_EPI) { if (wr == 0) PG8_BAR; }
        if constexpr (!Epi::AFTER_DRAIN) { const int l2_ = lane_id_(); const int fr_ = l2_ & 15, fq_ = l2_ >> 4;
            E(acc, cur, wr, wc, fr_, fq_); S.done(cur); }
        if (!has_next) break;
#pragma unroll
        for (int a = 0; a < 2; ++a)
#pragma unroll
            for (int b = 0; b < 2; ++b)
#pragma unroll
                for (int m = 0; m < 4; ++m)
#pragma unroll
                    for (int n = 0; n < 2; ++n) acc[a][b][m][n] = (f32x4){0.f, 0.f, 0.f, 0.f};
        cur = nxt; cB = nB; ++ui;
#pragma unroll
        for (int _h = 0; _h < 2; ++_h) { oC[_h][0] = oN[_h][0]; oC[_h][1] = oN[_h][1]; uC[_h] = uN[_h]; }
        if constexpr (ALIGN_EPI) { if (wr == 1) PG8_BAR; }
    }
    PG8_WAIT_V(0);
    if constexpr (!ALIGN_EPI) { if (wr == 0) PG8_BAR; }
    PG8_BAR;
    if constexpr (Epi::AFTER_DRAIN) { E.fused(acc, cur, wr, wc, fr, fq, lds, wid, lane); S.done(cur); }
#undef PG8_SA
#undef PG8_SB
#undef PG8_STAGE
#undef PG8_STAGEA
#undef PG8_AOFF
#undef PG8_LDA
#undef PG8_LDB
#undef PG8_MMA
#undef PG8_CAT
#undef PG8_WAIT_V
#undef PG8_WAIT_L
#undef PG8_BAR
#undef PG8_SCHED
}
}
namespace attn_body {
using bf16=unsigned short;
using bf16x8=__attribute__((ext_vector_type(8)))short;
using s16x4=__attribute__((ext_vector_type(4)))short;
using f32x16=__attribute__((ext_vector_type(16)))float;
using u32x4=__attribute__((ext_vector_type(4)))unsigned;
constexpr int SEQ=2048,D=64,DM=4096,DMO=1024;
constexpr int NW=8,QBLK=32,QB=QBLK*NW,KVBLK=64,NQB=SEQ/QB;
__device__ __forceinline__ unsigned f2bf_(float f){unsigned u=__builtin_bit_cast(unsigned,f);return (u+0x7fffu+((u>>16)&1u))>>16;}
__device__ __forceinline__ int crow(int r,int hi){return (r&3)+8*(r>>2)+4*hi;}
#define SBAR() __builtin_amdgcn_sched_barrier(0)
__device__ __forceinline__ void cmask(f32x16&p0,f32x16&p1,int jb,int qrel,int hi){
  const float NEG=-INFINITY; int kb=64*jb+4*hi;
  #pragma unroll
  for(int r=0;r<16;++r){int kv=kb+(r&3)+8*(r>>2); if(kv>qrel)p0[r]=NEG; if(kv+32>qrel)p1[r]=NEG;}
}

__device__ __forceinline__ uint2 mld_asm(const unsigned*p){ uint2 v; asm volatile("global_load_dwordx2 %0, %1, off":"=v"(v):"v"(p):"memory"); return v; }
__device__ __forceinline__ void bmask(f32x16&p0,f32x16&p1,uint2 w,int hi){
  const float NEG=-INFINITY; const unsigned a=w.x>>(4*hi), b=w.y>>(4*hi);
  #pragma unroll
  for(int r=0;r<16;++r){const int bit=(r&3)+8*(r>>2); if(!((a>>bit)&1u))p0[r]=NEG; if(!((b>>bit)&1u))p1[r]=NEG;}
}
constexpr int NSLOT=3, SLOTB=8192;
constexpr int LDS_K=0, LDS_V=NSLOT*SLOTB, LDS_WS=2*NSLOT*SLOTB, LDS_OST=LDS_WS+NW*64*4, LDS_BYTES=LDS_OST+NW*4096;
constexpr float C2=0.125f*1.4426950408889634f;
__device__ __forceinline__ void glds16(const void*gsrc,unsigned lds_dst){unsigned keep;
  asm volatile("s_mov_b32 %0, m0\n\ts_mov_b32 m0, %2\n\ts_nop 0\n\tglobal_load_lds_dwordx4 %1, off\n\ts_mov_b32 m0, %0":"=&s"(keep):"v"(gsrc),"s"(lds_dst):"memory");}
__device__ __forceinline__ float max3f(float a,float b,float c){float r;asm("v_max3_f32 %0, %1, %2, %3":"=v"(r):"v"(a),"v"(b),"v"(c));return r;}
__device__ __forceinline__ float max2f(float a,float b){float r;asm("v_max_f32_e32 %0, %1, %2":"=v"(r):"v"(a),"v"(b));return r;}
__device__ __forceinline__ float fadd_s(float a,float b){float r;asm("v_add_f32_e32 %0, %1, %2":"=v"(r):"v"(a),"v"(b));return r;}
__device__ __forceinline__ float fsub_s(float a,float b){float r;asm("v_sub_f32_e32 %0, %1, %2":"=v"(r):"v"(a),"v"(b));return r;}
typedef float f32x2_t __attribute__((ext_vector_type(2))); typedef __bf16 bf16x2_t __attribute__((ext_vector_type(2)));
__device__ __forceinline__ unsigned cvtpk_s(float lo,float hi){f32x2_t v={lo,hi};bf16x2_t b=__builtin_convertvector(v,bf16x2_t);return __builtin_bit_cast(unsigned,b);}
#define WAIT_BAR(N) asm volatile("s_waitcnt vmcnt(" #N ") lgkmcnt(0)\n\ts_barrier":::"memory")

__device__ __forceinline__ void qkt(f32x16&p0,f32x16&p1,const char*Kslot,const bf16x8*qr,const f32x16&negm,int r32,int hi){
  const char*kb=Kslot+hi*1024+r32*16;
  #pragma unroll
  for(int d0=0;d0<4;++d0){
    const bf16x8 b0=*reinterpret_cast<const bf16x8*>(kb+d0*2048);
    const bf16x8 b1=*reinterpret_cast<const bf16x8*>(kb+d0*2048+512);
    if(d0==0){p0=__builtin_amdgcn_mfma_f32_32x32x16_bf16(b0,qr[0],negm,0,0,0);p1=__builtin_amdgcn_mfma_f32_32x32x16_bf16(b1,qr[0],negm,0,0,0);}
    else{p0=__builtin_amdgcn_mfma_f32_32x32x16_bf16(b0,qr[d0],p0,0,0,0);p1=__builtin_amdgcn_mfma_f32_32x32x16_bf16(b1,qr[d0],p1,0,0,0);}}
}
typedef __attribute__((address_space(3))) const char* lds_cptr;
typedef short v4i16_t __attribute__((ext_vector_type(4)));
__device__ __forceinline__ void kload8(bf16x8*kf,lds_cptr kp){
  kf[0]=*(const __attribute__((address_space(3))) bf16x8*)(kp);      kf[1]=*(const __attribute__((address_space(3))) bf16x8*)(kp+512);
  kf[2]=*(const __attribute__((address_space(3))) bf16x8*)(kp+2048); kf[3]=*(const __attribute__((address_space(3))) bf16x8*)(kp+2560);
  kf[4]=*(const __attribute__((address_space(3))) bf16x8*)(kp+4096); kf[5]=*(const __attribute__((address_space(3))) bf16x8*)(kp+4608);
  kf[6]=*(const __attribute__((address_space(3))) bf16x8*)(kp+6144); kf[7]=*(const __attribute__((address_space(3))) bf16x8*)(kp+6656);
}
__device__ __forceinline__ void kload2(bf16x8*kf,lds_cptr kp,int j){ kf[2*j]=*(const __attribute__((address_space(3))) bf16x8*)(kp+j*2048); kf[2*j+1]=*(const __attribute__((address_space(3))) bf16x8*)(kp+j*2048+512); }
__device__ __forceinline__ s16x4 vtr(lds_cptr p){ return __builtin_bit_cast(s16x4,__builtin_amdgcn_ds_read_tr16_b64_v4i16((__attribute__((address_space(3))) v4i16_t*)p)); }
__device__ __forceinline__ float rowmax(const f32x16&p0,const f32x16&p1){
  float a=max3f(p0[0],p0[1],p1[0]),b=max3f(p0[2],p0[3],p1[1]);a=max3f(a,p1[2],p1[3]);
  #pragma unroll
  for(int r=4;r<16;r+=4){a=max3f(a,p0[r],p0[r+1]);b=max3f(b,p0[r+2],p0[r+3]);a=max3f(a,p1[r],p1[r+1]);b=max3f(b,p1[r+2],p1[r+3]);}
  const float m=max2f(a,b);
  auto rr=__builtin_amdgcn_permlane32_swap(__float_as_uint(m),__float_as_uint(m),false,false);
  return max2f(__uint_as_float(rr[0]),__uint_as_float(rr[1]));
}
__device__ __forceinline__ void pv(f32x16*o,int vb,bf16x8 pa0,bf16x8 pa1,bf16x8 pa2,bf16x8 pa3){
  #pragma unroll
  for(int d0=0;d0<2;++d0){s16x4 lo[4],hi[4];
    #pragma unroll
    for(int ks=0;ks<4;++ks){
      asm volatile("ds_read_b64_tr_b16 %0,%1 offset:%c2":"=&v"(lo[ks]):"v"(vb),"i"(d0*4096+ks*1024):"memory");
      asm volatile("ds_read_b64_tr_b16 %0,%1 offset:%c2":"=&v"(hi[ks]):"v"(vb),"i"(d0*4096+ks*1024+512):"memory");}
    asm volatile("s_waitcnt lgkmcnt(0)":::"memory");SBAR();
    #define PK(k) (bf16x8){lo[k][0],lo[k][1],lo[k][2],lo[k][3],hi[k][0],hi[k][1],hi[k][2],hi[k][3]}
    o[d0]=__builtin_amdgcn_mfma_f32_32x32x16_bf16(pa0,PK(0),o[d0],0,0,0);
    o[d0]=__builtin_amdgcn_mfma_f32_32x32x16_bf16(pa1,PK(1),o[d0],0,0,0);
    o[d0]=__builtin_amdgcn_mfma_f32_32x32x16_bf16(pa2,PK(2),o[d0],0,0,0);
    o[d0]=__builtin_amdgcn_mfma_f32_32x32x16_bf16(pa3,PK(3),o[d0],0,0,0);
    #undef PK
  }
}

#ifndef ATTN_STORE16
#define ATTN_STORE16(p,v) (*(u32x4*)(p)=(v))
#endif
template<int THRL,bool MASKED> __device__ __forceinline__ void attn_unit(int wvx,int b,int qb,const bf16*Q,const bf16*__restrict__ K,const bf16*__restrict__ V,bf16*O,const unsigned*MASK,char*shm){
  int tid_=wvx*64+lane_id_(); asm volatile("":"+v"(tid_));
  const int tid=tid_,lane=tid&63,r32=lane&31,hi=lane>>5; const int wid=__builtin_amdgcn_readfirstlane(tid>>6);
  const long rowbase=(long)b*SEQ; const int q0=qb*QB;
  const bf16*Qw=Q+(rowbase+q0+wid*QBLK)*DM;
  const bf16*Kh=K+rowbase*DM,*Vh=V+rowbase*DM;
  const unsigned*mrow=MASK+(size_t)(rowbase+q0+wid*QBLK+r32)*64;
  #define MLD(tt) mld_asm(mrow+2*(tt))
  const unsigned lds0=(unsigned)(uintptr_t)shm;
  float*wsf=(float*)(shm+LDS_WS)+wid*64;
  const bf16*ksrc=Kh+(long)lane*DM+wid*8;
  const bf16*vsrc=Vh+(long)(16*(wid&3)+(lane>>2))*DM+(wid>>2)*32+(lane&3)*8;
  const unsigned kdst=lds0+LDS_K+wid*1024, vdst=lds0+LDS_V+wid*1024;
  #define DMA_K(t,slot) glds16(ksrc+(long)(t)*KVBLK*DM,(unsigned)__builtin_amdgcn_readfirstlane(kdst+(slot)))
  #define DMA_V(t,slot) glds16(vsrc+(long)(t)*KVBLK*DM,(unsigned)__builtin_amdgcn_readfirstlane(vdst+(slot)))
  const int vb0=(int)(lds0+LDS_V)+((lane>>4)&1)*32+(lane&3)*8+(4*hi+((lane&15)>>2))*64;
  const char*Kbase=shm+LDS_K; bf16x8 kf[8];
  const lds_cptr shm3=(lds_cptr)shm; const lds_cptr kp0=shm3+LDS_K+hi*1024+r32*16; const lds_cptr vp0=shm3+LDS_V+((lane>>4)&1)*32+(lane&3)*8+(4*hi+((lane&15)>>2))*64;
  const int NT=(q0+QB)/KVBLK;
  uint2 mw_cur=make_uint2(~0u,~0u), mw_next=make_uint2(~0u,~0u); if(MASKED){ mw_cur=MLD(0); mw_next=MLD(1); }
  DMA_K(0,0);DMA_V(0,0);DMA_K(1,SLOTB);
  bf16x8 qr[4];
  #pragma unroll
  for(int d0=0;d0<4;++d0)qr[d0]=*reinterpret_cast<const bf16x8*>(&Qw[(long)r32*DM+d0*16+hi*8]);
  float mhat=0.f,l_reg=0.f;f32x16 o[2];o[0]=f32x16{};o[1]=f32x16{};f32x16 negm=f32x16{};asm volatile("":"+v"(negm));
  const int qrel=wid*QBLK+r32;
  #define CMASK(P0,P1,t) do{ if(MASKED){bmask(P0,P1,mw_cur,hi);} else {int jb_=(t)-(NT-4); if(jb_>=0)cmask(P0,P1,jb_,qrel,hi);} }while(0)
  bool resc=false;
  #define START(P0,P1) do{ float rm=rowmax(P0,P1); if(MASKED)rm=max2f(rm,-64.f); resc=false; \
    { const float dl=rm; mhat=fadd_s(mhat,dl); \
      _Pragma("unroll") for(int r=0;r<16;++r){P0[r]=fsub_s(P0[r],dl);P1[r]=fsub_s(P1[r],dl);} \
      _Pragma("unroll") for(int r=0;r<16;++r)negm[r]=-mhat; asm volatile("":"+v"(negm)); } \
    _Pragma("unroll") for(int r=0;r<16;++r)P0[r]=__builtin_amdgcn_exp2f(P0[r]); }while(0)
  #define RESC() do{ if(resc){ asm volatile("s_waitcnt lgkmcnt(0)":::"memory"); \
      _Pragma("unroll") for(int d_=0;d_<2;++d_) _Pragma("unroll") for(int r=0;r<16;++r)o[d_][r]*=wsf[crow(r,hi)]; } }while(0)
  f32x16 pA0,pA1,pB0,pB1;
  int sl_prev=0,sl_cur=0,sl_next=SLOTB;
  #define ROT() do{sl_prev=sl_cur;sl_cur=sl_next;sl_next=(sl_next==(NSLOT-1)*SLOTB)?0:sl_next+SLOTB;}while(0)
  DMA_K(2,2*SLOTB);
  WAIT_BAR(3);
  qkt(pA0,pA1,Kbase,qr,negm,r32,hi);asm volatile("s_nop 15\n\ts_nop 7":"+v"(pA0),"+v"(pA1));CMASK(pA0,pA1,0);
  START(pA0,pA1);
  _Pragma("unroll") for(int r=0;r<16;++r)pA1[r]=__builtin_amdgcn_exp2f(pA1[r]);
  WAIT_BAR(0);
  DMA_K(3,0);DMA_V(1,SLOTB);
  ROT();
  kload8(kf,kp0+sl_cur);
  WAIT_BAR(2);
  s16x4 vlo[8],vhi[8]; u32x4 pw0,pw1,pw2,pw3;
  #define PKW(P,B) cvtpk_s(P[B],P[B+1])
  #define PAF(k) __builtin_bit_cast(bf16x8,pw##k)
  #define VFR(i) (bf16x8){vlo[i][0],vlo[i][1],vlo[i][2],vlo[i][3],vhi[i][0],vhi[i][1],vhi[i][2],vhi[i][3]}
  #define PIN(x) asm volatile("":"+v"(x))
  #define MX3(a,b,c) __builtin_fmaxf(__builtin_fmaxf((a),(b)),(c))
  #define GAPA(MF,A0,A1,A2,A3,W0,W1,PW) do{ MF; sacc+=A0; sacc+=A1; sacc+=A2; sacc+=A3; PIN(sacc); W0; W1; PIN(PW); SBAR(); }while(0)
  #define EX(v) __builtin_amdgcn_exp2f(v)
  #define GAPB(MF,X,B) do{ MF; X[B]=EX(X[B]); X[B+1]=EX(X[B+1]); X[B+2]=EX(X[B+2]); X[B+3]=EX(X[B+3]); PIN(X); SBAR(); }while(0)
  #define VRD(i) do{ vlo[i]=vtr(vp_+(((i)>>2)*4096+((i)&3)*1024)); vhi[i]=vtr(vp_+(((i)>>2)*4096+((i)&3)*1024+512)); }while(0)
  #define KRD(G,j) do{ if(G){ kload2(kf,kp0+sl_next,j); SBAR(); } }while(0)
  #define STEP(C0,C1,P0,P1,t,GK,GV,GL) do{ SBAR(); if(MASKED){ mw_cur=mw_next; if((t)+1<NT) mw_next=MLD((t)+1); } \
    const lds_cptr vp_=vp0+sl_prev; \
    VRD(0); SBAR(); float sacc=(P0[0]+P0[1]); \
    GAPA(C0=__builtin_amdgcn_mfma_f32_32x32x16_bf16(kf[0],qr[0],negm,0,0,0), P0[2],P0[3],P0[4],P0[5],     pw0[0]=PKW(P0,0), pw0[1]=PKW(P0,2), pw0); \
    VRD(4); SBAR(); GAPA(C1=__builtin_amdgcn_mfma_f32_32x32x16_bf16(kf[1],qr[0],negm,0,0,0), P0[6],P0[7],P0[8],P0[9],     pw0[2]=PKW(P0,4), pw0[3]=PKW(P0,6), pw0); \
    VRD(1); SBAR(); GAPA(C0=__builtin_amdgcn_mfma_f32_32x32x16_bf16(kf[2],qr[1],C0,0,0,0),   P0[10],P0[11],P0[12],P0[13], pw1[0]=PKW(P0,8), pw1[1]=PKW(P0,10), pw1); \
    VRD(5); SBAR(); GAPA(C1=__builtin_amdgcn_mfma_f32_32x32x16_bf16(kf[3],qr[1],C1,0,0,0),   P0[14],P0[15],P1[0],P1[1],   pw1[2]=PKW(P0,12),pw1[3]=PKW(P0,14), pw1); \
    VRD(2); SBAR(); GAPA(C0=__builtin_amdgcn_mfma_f32_32x32x16_bf16(kf[4],qr[2],C0,0,0,0),   P1[2],P1[3],P1[4],P1[5],     pw2[0]=PKW(P1,0), pw2[1]=PKW(P1,2), pw2); \
    VRD(6); SBAR(); GAPA(C1=__builtin_amdgcn_mfma_f32_32x32x16_bf16(kf[5],qr[2],C1,0,0,0),   P1[6],P1[7],P1[8],P1[9],     pw2[2]=PKW(P1,4), pw2[3]=PKW(P1,6), pw2); \
    VRD(3); SBAR(); GAPA(C0=__builtin_amdgcn_mfma_f32_32x32x16_bf16(kf[6],qr[3],C0,0,0,0),   P1[10],P1[11],P1[12],P1[13], pw3[0]=PKW(P1,8), pw3[1]=PKW(P1,10), pw3); \
    VRD(7); SBAR(); GAPA(C1=__builtin_amdgcn_mfma_f32_32x32x16_bf16(kf[7],qr[3],C1,0,0,0),   P1[14],P1[15],0.f,0.f,       pw3[2]=PKW(P1,12),pw3[3]=PKW(P1,14), pw3); \
    l_reg+=sacc; \
    if(GK){DMA_K((t)+3,sl_cur);} if(GV){DMA_V((t)+1,sl_next);} \
    CMASK(C0,C1,t); \
    { float a=MX3(C0[0],C0[1],C1[0]),b=MX3(C0[2],C0[3],C1[1]); a=MX3(a,C1[2],C1[3]); \
      _Pragma("unroll") for(int r=4;r<16;r+=4){a=MX3(a,C0[r],C0[r+1]);b=MX3(b,C0[r+2],C0[r+3]);a=MX3(a,C1[r],C1[r+1]);b=MX3(b,C1[r+2],C1[r+3]);} \
      float rm=__builtin_fmaxf(a,b); { auto rr=__builtin_amdgcn_permlane32_swap(__float_as_uint(rm),__float_as_uint(rm),false,false); rm=__builtin_fmaxf(__uint_as_float(rr[0]),__uint_as_float(rr[1])); } \
      resc=false; \
      if(__builtin_expect(__any(rm>(float)THRL),0)){ const float dl=__builtin_fmaxf(rm,0.f); mhat+=dl; \
        _Pragma("unroll") for(int r=0;r<16;++r){C0[r]-=dl;C1[r]-=dl;} \
        _Pragma("unroll") for(int r=0;r<16;++r)negm[r]=-mhat; asm volatile("":"+v"(negm)); \
        const float f=__builtin_amdgcn_exp2f(-dl); l_reg*=f; if(hi==0)wsf[r32]=f; resc=true; } } \
    SBAR(); \
    GAPB(o[0]=__builtin_amdgcn_mfma_f32_32x32x16_bf16(PAF(0),VFR(0),o[0],0,0,0), C0,0); \
    GAPB(o[1]=__builtin_amdgcn_mfma_f32_32x32x16_bf16(PAF(0),VFR(4),o[1],0,0,0), C0,4); \
    KRD(GL,0); GAPB(o[0]=__builtin_amdgcn_mfma_f32_32x32x16_bf16(PAF(1),VFR(1),o[0],0,0,0), C0,8); \
    KRD(GL,1); GAPB(o[1]=__builtin_amdgcn_mfma_f32_32x32x16_bf16(PAF(1),VFR(5),o[1],0,0,0), C0,12); \
    KRD(GL,2); GAPB(o[0]=__builtin_amdgcn_mfma_f32_32x32x16_bf16(PAF(2),VFR(2),o[0],0,0,0), C1,0); \
    KRD(GL,3); GAPB(o[1]=__builtin_amdgcn_mfma_f32_32x32x16_bf16(PAF(2),VFR(6),o[1],0,0,0), C1,4); \
    GAPB(o[0]=__builtin_amdgcn_mfma_f32_32x32x16_bf16(PAF(3),VFR(3),o[0],0,0,0), C1,8); \
    GAPB(o[1]=__builtin_amdgcn_mfma_f32_32x32x16_bf16(PAF(3),VFR(7),o[1],0,0,0), C1,12); \
    }while(0)
  int t=1;
  #undef CMASK
  #define CMASK(P0,P1,t) do{ if(MASKED){bmask(P0,P1,mw_cur,hi);} }while(0)
  for(;t+5<NT;t+=2){
    STEP(pB0,pB1,pA0,pA1,t,true,true,true);     WAIT_BAR(2); RESC(); ROT();
    STEP(pA0,pA1,pB0,pB1,t+1,true,true,true);   WAIT_BAR(2); RESC(); ROT();
  }
  #undef CMASK
  #define CMASK(P0,P1,t) do{ if(MASKED){bmask(P0,P1,mw_cur,hi);} else {int jb_=(t)-(NT-4); if(jb_>=0)cmask(P0,P1,jb_,qrel,hi);} }while(0)
  #define ENDW(tt) do{ if((tt)+3<NT){WAIT_BAR(2);} else if((tt)+2<NT){WAIT_BAR(1);} else {WAIT_BAR(0);} }while(0)
  for(;t+1<NT;t+=2){
    STEP(pB0,pB1,pA0,pA1,t,(t+3<NT),(t+1<NT),(t+1<NT));       ENDW(t);   RESC(); ROT();
    STEP(pA0,pA1,pB0,pB1,t+1,(t+4<NT),(t+2<NT),(t+2<NT));     ENDW(t+1); RESC(); ROT();
  }
  STEP(pB0,pB1,pA0,pA1,NT-1,false,false,false); RESC();
  { float sacc=pB0[0]+pB0[1]; _Pragma("unroll") for(int r=2;r<16;++r)sacc+=pB0[r]; _Pragma("unroll") for(int r=0;r<16;++r)sacc+=pB1[r]; l_reg+=sacc;
    pw0=(u32x4){PKW(pB0,0),PKW(pB0,2),PKW(pB0,4),PKW(pB0,6)};pw1=(u32x4){PKW(pB0,8),PKW(pB0,10),PKW(pB0,12),PKW(pB0,14)};pw2=(u32x4){PKW(pB1,0),PKW(pB1,2),PKW(pB1,4),PKW(pB1,6)};pw3=(u32x4){PKW(pB1,8),PKW(pB1,10),PKW(pB1,12),PKW(pB1,14)};
    SBAR(); pv(o,vb0+sl_cur,PAF(0),PAF(1),PAF(2),PAF(3)); }
  #undef PKW
  #undef PAF
  #undef VFR
  #undef PIN
  #undef MX3
  #undef GAPA
  #undef GAPB
  #undef EX
  #undef VRD
  #undef KRD
  #undef STEP
  #undef ENDW
  {auto rr=__builtin_amdgcn_permlane32_swap(__float_as_uint(l_reg),__float_as_uint(l_reg),false,false);l_reg=__uint_as_float(rr[0])+__uint_as_float(rr[1]);}
  if(hi==0)wsf[32+r32]=l_reg;asm volatile("s_waitcnt lgkmcnt(0)":::"memory");
  float rli[16];
  #pragma unroll
  for(int r=0;r<16;++r)rli[r]=__builtin_amdgcn_rcpf(wsf[32+crow(r,hi)]);
  bf16*Ow=O+(rowbase+q0+wid*QBLK)*DMO;
  { bf16*stg=(bf16*)(shm+LDS_OST)+wid*2048;
    #pragma unroll
    for(int r=0;r<16;++r){const int orow=crow(r,hi);
      #pragma unroll
      for(int d0=0;d0<2;++d0)stg[orow*64+d0*32+r32]=(bf16)f2bf_(o[d0][r]*rli[r]);}
    asm volatile("s_waitcnt lgkmcnt(0)":::"memory");
    #pragma unroll
    for(int i=0;i<4;++i){const int row=i*8+(lane>>3),ch=lane&7; const u32x4 v=*(const u32x4*)(stg+row*64+ch*8); ATTN_STORE16(Ow+(long)row*DMO+ch*8,v);} }
  asm volatile("s_waitcnt lgkmcnt(0)\n\ts_barrier":::"memory");
  #undef DMA_K
  #undef DMA_V
  #undef MLD
  #undef CMASK
  #undef START
  #undef RESC
  #undef ROT
}
constexpr int ATTN_LDS_BYTES=LDS_BYTES;
#undef SBAR
#undef WAIT_BAR
}
#define GAS __attribute__((address_space(1)))
#define LAS __attribute__((address_space(3)))
typedef unsigned short bf16;
typedef unsigned v4u __attribute__((ext_vector_type(4)));
typedef float f32x4 __attribute__((ext_vector_type(4)));
typedef short bf16x8 __attribute__((ext_vector_type(8)));
typedef GAS unsigned gu32;
typedef GAS unsigned long long gu64;
#define RLX_AGENT __ATOMIC_RELAXED, __HIP_MEMORY_SCOPE_AGENT
#define LDS_WAIT() asm volatile("s_waitcnt lgkmcnt(0)" ::: "memory")
#define VM_WAIT() asm volatile("s_waitcnt vmcnt(0)" ::: "memory")
__device__ __forceinline__ unsigned long long rt() { return __builtin_amdgcn_s_memrealtime(); }
__device__ __forceinline__ unsigned f2bf(float f) { unsigned u = __builtin_bit_cast(unsigned, f); return (u + 0x7fffu + ((u >> 16) & 1u)) >> 16; }
__device__ __forceinline__ unsigned pk2(float lo, float hi) { return f2bf(lo) | (f2bf(hi) << 16); }
__device__ __forceinline__ int tid_of(int wvx) { return wvx * 64 + lane_id_(); }
#define XB_TMO      128
#define XB_XCNT(j)  (256  + 64 * (j))
#define XB_XSUB(j)  (1280 + 64 * (j))
#define XB_XGEN(j)  (2304 + 64 * (j))
#define XB_TOP      3328
#define XB_TOPGEN   3392
#define XCD_BAR_WORDS 3456
#define XB_SPIN_CAP (1u << 20)

__device__ __forceinline__ unsigned xb_ld(unsigned* p)              { return __hip_atomic_load(p, __ATOMIC_RELAXED, __HIP_MEMORY_SCOPE_AGENT); }
__device__ __forceinline__ unsigned xb_add(unsigned* p, unsigned v) { return __hip_atomic_fetch_add(p, v, __ATOMIC_RELAXED, __HIP_MEMORY_SCOPE_AGENT); }
__device__ __forceinline__ unsigned xb_xcc_id() { return (unsigned)__builtin_amdgcn_s_getreg((3 << 11) | 20) & 0xFu; }
#define XB_SPIN(cond, bar) do { unsigned _sp = 0; while (cond) { __builtin_amdgcn_s_sleep(1); \
    if ((++_sp & 255u) == 0u) { if (xb_ld(&(bar)[XB_TMO])) break; if (_sp > XB_SPIN_CAP) { atomicAdd(&(bar)[XB_TMO], 1u); break; } } } } while (0)

struct XcdBarrier {
    unsigned* bar; unsigned x;
    volatile LAS unsigned* st;
};

__device__ __forceinline__ XcdBarrier xcd_barrier_post(unsigned* bar, volatile LAS unsigned* st) {
    XcdBarrier b; b.bar = bar; b.x = xb_xcc_id(); b.st = st;
    if (threadIdx.x == 0) (void)xb_add(&bar[XB_XCNT(b.x)], 1u);
    return b;
}
__device__ __forceinline__ void xcd_barrier_complete(unsigned* bar, unsigned x, unsigned& nloc, unsigned& nx) {
    const unsigned G = gridDim.x * gridDim.y * gridDim.z;
    unsigned sum, cnt, mine, sp = 0u;
    for (;;) {
        sum = 0u; cnt = 0u; mine = 0u;
#pragma unroll
        for (unsigned j = 0; j < 16; ++j) { const unsigned c = xb_ld(&bar[XB_XCNT(j)]); sum += c; cnt += (c > 0u) ? 1u : 0u; mine = (j == x) ? c : mine; }
        if (sum == G) break;
        __builtin_amdgcn_s_sleep(1);
        if ((++sp & 255u) == 0u) { if (xb_ld(&bar[XB_TMO])) break; if (sp > XB_SPIN_CAP) { atomicAdd(&bar[XB_TMO], 1u); break; } }
    }
    nloc = mine > 0u ? mine : 1u; nx = cnt > 0u ? cnt : 1u;
}

__device__ __attribute__((noinline)) void xcd_barrier_fn(unsigned* bar_, unsigned x_, volatile LAS unsigned* st_, bool leader_) {
    XcdBarrier b; b.bar = bar_; b.x = x_; b.st = st_;
    asm volatile("s_waitcnt vmcnt(0)" ::: "memory");
    __syncthreads();
    if (leader_) {
        unsigned* bar = b.bar;
        __builtin_amdgcn_s_waitcnt(0);
        unsigned nloc = b.st[0], nx = b.st[1];
        if (nloc == 0u) { xcd_barrier_complete(bar, b.x, nloc, nx); b.st[0] = nloc; b.st[1] = nx; }
        const unsigned old = xb_add(&bar[XB_XSUB(b.x)], 1u);
        const unsigned gen = old / nloc;
        if (old + 1u == (gen + 1u) * nloc) {
            __builtin_amdgcn_fence(__ATOMIC_RELEASE, "agent");
            asm volatile("s_waitcnt vmcnt(0)" ::: "memory");
            const unsigned og = xb_add(&bar[XB_TOP], 1u);
            const unsigned tg = og / nx;
            if (og + 1u == (tg + 1u) * nx) xb_add(&bar[XB_TOPGEN], 1u);
            else XB_SPIN(xb_ld(&bar[XB_TOPGEN]) == tg, bar);
            __builtin_amdgcn_fence(__ATOMIC_ACQUIRE, "agent");
            xb_add(&bar[XB_XGEN(b.x)], 1u);
            asm volatile("s_waitcnt vmcnt(0)" ::: "memory");
        } else {
            XB_SPIN(xb_ld(&bar[XB_XGEN(b.x)]) == gen, bar);
            __builtin_amdgcn_fence(__ATOMIC_ACQUIRE, "agent");
            asm volatile("s_waitcnt vmcnt(0)" ::: "memory");
        }
    }
    __syncthreads();
}


constexpr int NB = 16, SEQ = 2048, T = NB * SEQ, D = 1024, DEPTH = 4, NHC = 4096, NEXP = 32, NWAVES = 8;
constexpr int NIN = 3920;
constexpr float LN_EPS = 1e-5f, DN_ALPHA = 1.6817928305074290f;
constexpr int RPAD = T * 4 + NEXP * 256;
constexpr int HC_MQ = 0, HC_MK = 256, HC_MV = 512, HC_MO = 768, HC_DQ = 1024, HC_DK = 1536, HC_DV = 2048, HC_SQ = 2560, HC_SK = 2816, HC_SV = 3072, HC_XQ = 3328, HC_XK = 3840, HC_MI = 3904, HC_MF = 3908, HC_XW = 3912;
constexpr size_t MiB = 1u << 20;
constexpr size_t WS_CTL = 0, CTL_ZERO_BYTES = 2 * MiB;
constexpr size_t WS_MOD = 2 * MiB;
constexpr size_t WS_LAM = WS_MOD + 7 * MiB / 4;
constexpr size_t WS_RWT = 4 * MiB;
constexpr size_t WS_CS = 8 * MiB;
constexpr size_t WS_WIN = 16 * MiB;
constexpr size_t WS_WOUT = 48 * MiB;
constexpr size_t WS_W1 = 64 * MiB;
constexpr size_t WS_W2 = 576 * MiB;
constexpr size_t WS_XB = 832 * MiB;
constexpr size_t WS_U = 960 * MiB;
constexpr size_t WS_H = 1024 * MiB;
constexpr size_t WS_QKC = 1280 * MiB;
constexpr size_t WS_XKP = 1312 * MiB;
constexpr size_t WS_MASK = 1316 * MiB;
constexpr size_t WS_TOK = 1324 * MiB;
constexpr size_t WS_MIX = 1344 * MiB;
constexpr size_t WS_Y = 1408 * MiB;
constexpr size_t WS_SC = 1472 * MiB;
constexpr size_t WS_XG = 1728 * MiB;
constexpr size_t WS_HM = 2000 * MiB;
constexpr size_t WS_YM = 2272 * MiB;
constexpr size_t WS_END = 2544 * MiB;
constexpr int CW_CNT = 1024;
constexpr int CW_BAR = 16384;
constexpr int RING_BYTES = 131072, TAB_OFF = RING_BYTES, MISC_OFF = RING_BYTES + 4096, LDS_BYTES = 147456;
constexpr int NPH = 10, NSTEPS = 2 + NPH * DEPTH;
enum { PH_IN = 0, PH_POST, PH_MIXA, PH_SEL, PH_DSA, PH_OUT, PH_ROW1, PH_G1, PH_G2, PH_ROW2 };

__device__ __forceinline__ float bf2f(bf16 h) { return __uint_as_float((unsigned)h << 16); }
#define DPPF(x, c) __int_as_float(__builtin_amdgcn_update_dpp(0, __float_as_int(x), c, 0xF, 0xF, true))
__device__ __forceinline__ float wave_sum(float v) {
    v += DPPF(v, 0xB1); v += DPPF(v, 0x4E); v += DPPF(v, 0x141); v += DPPF(v, 0x140);
    return (__int_as_float(__builtin_amdgcn_readlane(__float_as_int(v), 0)) + __int_as_float(__builtin_amdgcn_readlane(__float_as_int(v), 16))) + (__int_as_float(__builtin_amdgcn_readlane(__float_as_int(v), 32)) + __int_as_float(__builtin_amdgcn_readlane(__float_as_int(v), 48)));
}
__device__ __forceinline__ float wave_max(float v) {
    v = fmaxf(v, DPPF(v, 0xB1)); v = fmaxf(v, DPPF(v, 0x4E)); v = fmaxf(v, DPPF(v, 0x141)); v = fmaxf(v, DPPF(v, 0x140));
    return fmaxf(fmaxf(__int_as_float(__builtin_amdgcn_readlane(__float_as_int(v), 0)), __int_as_float(__builtin_amdgcn_readlane(__float_as_int(v), 16))), fmaxf(__int_as_float(__builtin_amdgcn_readlane(__float_as_int(v), 32)), __int_as_float(__builtin_amdgcn_readlane(__float_as_int(v), 48))));
}
__device__ __forceinline__ float shx(float v, int lane, int m) { return __int_as_float(__builtin_amdgcn_ds_bpermute((lane ^ m) << 2, __float_as_int(v))); }
__device__ __forceinline__ int shxi(int v, int lane, int m) { return __builtin_amdgcn_ds_bpermute((lane ^ m) << 2, v); }
__device__ __forceinline__ float shup(float v, int lane, int o) { return __int_as_float(__builtin_amdgcn_ds_bpermute(((lane - o) & 63) << 2, __float_as_int(v))); }
__device__ __forceinline__ int shupi(int v, int lane, int o) { return __builtin_amdgcn_ds_bpermute(((lane - o) & 63) << 2, v); }
__device__ __forceinline__ float sigmoidf_(float x) { return 1.0f / (1.0f + __expf(-x)); }
struct Ctx {
    LAS unsigned char* lds;
    int tid, lane, wave, gw, ngw;
    const float* in[25];
    float* out; unsigned char* ws;
};
#define WSP(type, off) ((type*)(C.ws + (off)))
enum { I_X = 0, I_C, I_POS, I_WIN, I_GATEB, I_CONVW, I_CONVB, I_MNORM, I_DFLAM, I_DFNORM, I_IDXG, I_IDXB, I_WOUT, I_ADAW, I_ADAB, I_LN1G, I_LN1B, I_LN2G, I_LN2B, I_RW, I_RB, I_W1, I_B1, I_W2, I_B2 };

__device__ __forceinline__ int in_dest_col(int n) {
    auto rp = [](int j) { const int hd = j >> 6, d = j & 63; return hd * 64 + ((d < 32) ? 2 * d : 2 * (d - 32) + 1); };
    if (n < 256) return HC_MQ + n;
    if (n < 512) return HC_MK + (n - 256);
    if (n < 768) return HC_MV + (n - 512);
    if (n < 772) return HC_MI + (n - 768);
    if (n < 776) return HC_MF + (n - 772);
    if (n < 1032) return HC_MO + (n - 776);
    if (n < 1544) return HC_DQ + rp(n - 1032);
    if (n < 2056) return HC_DK + rp(n - 1544);
    if (n < 2568) return HC_DV + (n - 2056);
    if (n < 2824) return HC_SQ + rp(n - 2568);
    if (n < 3080) return HC_SK + rp(n - 2824);
    if (n < 3336) return HC_SV + (n - 3080);
    if (n < 3848) return HC_XQ + rp(n - 3336);
    if (n < 3912) return HC_XK + (n - 3848);
    return HC_XW + (n - 3912);
}
template <class F> __device__ __forceinline__ void transpose_item(const float* W, int ldw, int K, int nvalid, int k0, int n0, bf16* WT, LAS float* scr, int lane, F drow) {
    const int nn = n0 + (lane & 31); const bool ok = nn < nvalid;
    float tv_[32];
#pragma unroll
    for (int i = 0; i < 32; ++i) { const int kk = 2 * i + (lane >> 5); tv_[i] = ok ? W[(size_t)(k0 + kk) * ldw + nn] : 0.f; }
#pragma unroll
    for (int i = 0; i < 32; ++i) { const int kk = 2 * i + (lane >> 5); scr[kk * 33 + (lane & 31)] = tv_[i]; }
    LDS_WAIT(); asm volatile("" ::: "memory");
    const int c = lane & 7;
#pragma unroll
    for (int j = 0; j < 4; ++j) { const int n = (lane >> 3) + 8 * j; const LAS float* s = scr + (8 * c) * 33 + n;
        v4u o; o.x = pk2(s[0 * 33], s[1 * 33]); o.y = pk2(s[2 * 33], s[3 * 33]); o.z = pk2(s[4 * 33], s[5 * 33]); o.w = pk2(s[6 * 33], s[7 * 33]);
        if (n0 + n < nvalid) *(GAS v4u*)(WT + (size_t)drow(n0 + n) * K + k0 + 8 * c) = o; }
    LDS_WAIT(); asm volatile("" ::: "memory");
}

template <class F> __device__ __forceinline__ void transpose_item_f8(const float* W, int ldw, int K, int nvalid, int k0, int n0, unsigned char* WT8, LAS float* scr, int lane, float sc, F drow) {
    const int nn = n0 + (lane & 31); const bool ok = nn < nvalid;
    float tv_[32];
#pragma unroll
    for (int i = 0; i < 32; ++i) { const int kk = 2 * i + (lane >> 5); tv_[i] = ok ? W[(size_t)(k0 + kk) * ldw + nn] : 0.f; }
#pragma unroll
    for (int i = 0; i < 32; ++i) { const int kk = 2 * i + (lane >> 5); scr[kk * 33 + (lane & 31)] = tv_[i]; }
    LDS_WAIT(); asm volatile("" ::: "memory");
    const int c = lane & 7;
#pragma unroll
    for (int j = 0; j < 4; ++j) { const int n = (lane >> 3) + 8 * j; const LAS float* s = scr + (8 * c) * 33 + n;
        typedef unsigned u32x2_ __attribute__((ext_vector_type(2))); u32x2_ o; o.x = pg8::pk4_fp8(s[0 * 33], s[1 * 33], s[2 * 33], s[3 * 33], sc); o.y = pg8::pk4_fp8(s[4 * 33], s[5 * 33], s[6 * 33], s[7 * 33], sc);
        if (n0 + n < nvalid) *(GAS u32x2_*)(WT8 + (size_t)drow(n0 + n) * K + k0 + 8 * c) = o; }
    LDS_WAIT(); asm volatile("" ::: "memory");
}
struct Args { const float* in[25]; float* out; unsigned char* ws; int s_lo, s_hi, li, pad; };
typedef __attribute__((address_space(4))) const Args CArgs;
__device__ __forceinline__ CArgs* kargs() { CArgs* p = (CArgs*)__builtin_amdgcn_kernarg_segment_ptr(); asm volatile("" : "+s"(p)); return p; }
__device__ __forceinline__ LAS unsigned char* lds_launder(LAS unsigned char* q) { unsigned v = (unsigned)(size_t)q; asm volatile("" : "+s"(v)); return (LAS unsigned char*)(size_t)v; }
#define WS(type, off) ((type*)(A->ws + (off)))
#define TIDX CArgs* A = kargs(); int tid_ = tid_of(wvx); asm volatile("" : "+v"(tid_)); const int tid = tid_, lane = tid & 63, wave = __builtin_amdgcn_readfirstlane(tid >> 6); const int gw = blockIdx.x * NWAVES + wave, ngw = gridDim.x * NWAVES; (void)lane; (void)gw; (void)ngw

__device__ __forceinline__ void pro_a(LAS unsigned char* lds, int wvx) {
    TIDX;
    LAS float* scr = (LAS float*)(lds + wave * 16384);
    constexpr int IT_IN = 16 * 123, IT_OUT = 16 * 32, IT_W1 = 16 * 64, IT_W2 = 16 * 32;
    constexpr int N_IN = DEPTH * IT_IN, N_OUT = DEPTH * IT_OUT, N_W1 = DEPTH * NEXP * IT_W1, N_W2 = DEPTH * NEXP * IT_W2;
    constexpr int NITEMS = N_IN + N_OUT + N_W1 + N_W2;
    for (int it = gw; it < NITEMS; it += ngw) {
        int r = it;
        if (r < N_IN) { const int l = r / IT_IN, q = r % IT_IN, kb = q / 123, nb = q % 123;
            transpose_item(A->in[I_WIN] + (size_t)l * D * NIN, NIN, D, NIN, kb * 64, nb * 32, WS(bf16, WS_WIN) + (size_t)l * NHC * D, scr, lane, [](int n) { return in_dest_col(n); }); continue; }
        r -= N_IN;
        if (r < N_OUT) { const int l = r / IT_OUT, q = r % IT_OUT, kb = q / 32, nb = q % 32;
            transpose_item(A->in[I_WOUT] + (size_t)l * D * D, D, D, D, kb * 64, nb * 32, WS(bf16, WS_WOUT) + (size_t)l * D * D, scr, lane, [](int n) { return n; }); continue; }
        r -= N_OUT;
        if (r < N_W1) { const int le = r / IT_W1, q = r % IT_W1, kb = q / 64, nb = q % 64;
            transpose_item_f8(A->in[I_W1] + (size_t)le * D * 2048, 2048, D, 2048, kb * 64, nb * 32, WS(unsigned char, WS_W1) + (size_t)le * 2048 * D, scr, lane, 256.0f,
                           [](int n) { const int up = n >> 10, j = n & 1023; return (j >> 7) * 256 + up * 128 + (j & 127); }); continue; }
        r -= N_W1;
        { const int le = r / IT_W2, q = r % IT_W2, kb = q / 32, nb = q % 32;
            transpose_item_f8(A->in[I_W2] + (size_t)le * D * D, D, D, D, kb * 64, nb * 32, WS(unsigned char, WS_W2) + (size_t)le * D * D, scr, lane, 256.0f, [](int n) { return n; }); }
    }
    for (int r = gw; r < DEPTH * (NHC - NIN); r += ngw) { const int l = r / (NHC - NIN), row = NIN + r % (NHC - NIN);
        GAS v4u* p = (GAS v4u*)(WS(bf16, WS_WIN) + ((size_t)l * NHC + row) * D) + lane; p[0] = (v4u){0u, 0u, 0u, 0u}; p[64] = (v4u){0u, 0u, 0u, 0u}; }
    for (int idx = blockIdx.x * 512 + tid; idx < T * 32; idx += gridDim.x * 512) {
        const int tok = idx >> 5, i = idx & 31;
        const double inv = exp(-(double)i * (9.210340371976184 / 32.0));
        const double ang = (double)((const int*)A->in[I_POS])[tok] * inv;
        const double rev = ang * 0.15915494309189535;
        const float fr = (float)(rev - rint(rev));
        float2 v; v.x = __builtin_amdgcn_cosf(fr); v.y = __builtin_amdgcn_sinf(fr);
        WS(float2, WS_CS)[idx] = v;
    }
    for (int idx = blockIdx.x * 512 + tid; idx < DEPTH * NEXP * D; idx += gridDim.x * 512) {
        const int l = idx / (NEXP * D), r = idx % (NEXP * D), e = r / D, d = r % D;
        WS(float, WS_RWT)[idx] = A->in[I_RW][((size_t)l * D + d) * NEXP + e];
    }
    if (blockIdx.x == 0 && wave == 0) {
        for (int l = 0; l < DEPTH; ++l) { const float* lf = A->in[I_DFLAM] + l * 256;
            const float a = wave_sum(lf[lane] * lf[64 + lane]), b = wave_sum(lf[128 + lane] * lf[192 + lane]);
            if (lane == 0) WS(float, WS_LAM)[l] = __expf(a) - __expf(b) + (0.8f - 0.6f * __expf(-0.3f * (float)l)); }
    }
    __syncthreads();
    if (blockIdx.x < (DEPTH * 6144) / 512) {
        LAS float* ca = (LAS float*)lds;
        for (int i = tid; i < NB * D; i += 512) { const float v = A->in[I_C][i]; ca[i] = v / (1.0f + __expf(-v)); }
        __syncthreads();
        const int col = blockIdx.x * 512 + tid, l = col / 6144, m = col % 6144;
        const float* w = A->in[I_ADAW] + (size_t)l * D * 6144 + m;
        float acc[NB];
#pragma unroll
        for (int b = 0; b < NB; ++b) acc[b] = 0.f;
        for (int d = 0; d < D; ++d) { const float wv = w[(size_t)d * 6144];
#pragma unroll
            for (int b = 0; b < NB; ++b) acc[b] += ca[b * D + d] * wv; }
        const float bias = A->in[I_ADAB][col];
#pragma unroll
        for (int b = 0; b < NB; ++b) WS(float, WS_MOD)[((size_t)l * NB + b) * 6144 + m] = acc[b] + bias;
        __syncthreads();
    }
}
__device__ __forceinline__ void pro_b(int wvx) {
    TIDX;
    for (int tok = gw; tok < T; tok += ngw) {
        const int b = tok / SEQ; const float* mod = WS(float, WS_MOD) + (size_t)b * 6144;
        const GAS f32x4* xr = (const GAS f32x4*)(A->in[I_X] + (size_t)tok * D) + lane;
        GAS unsigned long long* o8 = (GAS unsigned long long*)(WS(bf16, WS_U) + (size_t)tok * D) + lane;
#pragma unroll
        for (int j = 0; j < 4; ++j) { const f32x4 x = xr[64 * j]; const f32x4 sh = *(const f32x4*)(mod + 4 * lane + 256 * j), sc = *(const f32x4*)(mod + 1024 + 4 * lane + 256 * j);
            const f32x4 u = x * (1.0f + sc) + sh; o8[64 * j] = (unsigned long long)pk2(u.x, u.y) | ((unsigned long long)pk2(u.z, u.w) << 32); }
    }
}
__device__ __forceinline__ void ph_post(int l, int wvx) {
    TIDX;
    const bf16* H = WS(bf16, WS_H); bf16* XKP = WS(bf16, WS_XKP); bf16* QKC = WS(bf16, WS_QKC);
    const float* cw = A->in[I_CONVW] + (size_t)l * 4 * 512; const float* cb = A->in[I_CONVB] + (size_t)l * 512;
    const float gi = A->in[I_IDXG][l * 64 + lane], bi = A->in[I_IDXB][l * 64 + lane];
    for (int tok = gw; tok < T; tok += ngw) {
        const bf16* hrow = H + (size_t)tok * NHC;
        {
            const float v = bf2f(hrow[HC_XK + lane]);
            const float mean = wave_sum(v) * (1.0f / 64.0f); const float dv = v - mean;
            const float var = wave_sum(dv * dv) * (1.0f / 64.0f);
            const float nv = dv * (1.0f / sqrtf(var + LN_EPS)) * gi + bi;
            const float pv = shx(nv, lane, 32);
            const int i = lane & 31; const float2 cs = WS(float2, WS_CS)[(size_t)tok * 32 + i];
            const float o = (lane < 32) ? (nv * cs.x - pv * cs.y) : (nv * cs.x + pv * cs.y);
            XKP[(size_t)tok * 64 + 2 * i + (lane >> 5)] = (bf16)f2bf(o);
        }
        {
            const int s = tok % SEQ, c0 = 8 * lane;
            float acc[8];
#pragma unroll
            for (int c = 0; c < 8; ++c) acc[c] = cb[c0 + c];
#pragma unroll
            for (int j = 0; j < 4; ++j) {
                if (s - 3 + j >= 0) {
                    const v4u raw = *(const GAS v4u*)(H + (size_t)(tok - 3 + j) * NHC + c0);
                    const unsigned rw[4] = {raw.x, raw.y, raw.z, raw.w};
#pragma unroll
                    for (int c = 0; c < 8; ++c) { const float x = __uint_as_float((c & 1) ? (rw[c >> 1] & 0xffff0000u) : (rw[c >> 1] << 16)); acc[c] += cw[j * 512 + c0 + c] * x; }
                }
            }
            v4u o;
#define SILU(x) ((x) / (1.0f + __expf(-(x))))
            o.x = pk2(SILU(acc[0]), SILU(acc[1])); o.y = pk2(SILU(acc[2]), SILU(acc[3])); o.z = pk2(SILU(acc[4]), SILU(acc[5])); o.w = pk2(SILU(acc[6]), SILU(acc[7]));
#undef SILU
            *(GAS v4u*)(QKC + (size_t)tok * 512 + c0) = o;
        }
    }
}
typedef float f32x16 __attribute__((ext_vector_type(16)));
__device__ __forceinline__ void select_row(const float* SC, unsigned* MASK, int tok, int lane);
__device__ __forceinline__ void ph_idx_scores(int wvx) {
    TIDX;
    const bf16* H = WS(bf16, WS_H); const bf16* XKP = WS(bf16, WS_XKP); float* SC = WS(float, WS_SC); unsigned* MASK = WS(unsigned, WS_MASK);
    const int r = lane & 31, hh = lane >> 5, ql = r >> 3, hd = r & 7;
    for (int item = blockIdx.x; item < 256; item += gridDim.x) {
        const int b = item >> 4, p = item & 15;
#pragma unroll 1
        for (int sub = 0; sub < 2; ++sub) {
            const int qblk = sub ? 31 - p : p, q0 = qblk * 64 + 8 * wave, tok0 = b * SEQ + q0;
            bf16x8 af[2][4];
#pragma unroll
            for (int g = 0; g < 2; ++g) { const bf16* ap = H + (size_t)(tok0 + 4 * g + ql) * NHC + HC_XQ + hd * 64 + 8 * hh;
#pragma unroll
              for (int ks = 0; ks < 4; ++ks) af[g][ks] = *(const GAS bf16x8*)(ap + ks * 16); }
            float wv[2][4][4];
#pragma unroll
            for (int g = 0; g < 2; ++g)
#pragma unroll
                for (int q = 0; q < 4; ++q)
#pragma unroll
                    for (int i = 0; i < 4; ++i) wv[g][q][i] = bf2f(H[(size_t)(tok0 + 4 * g + q) * NHC + HC_XW + 4 * hh + i]);
            const int npair = qblk + 1;
            const bf16* kp = XKP + (size_t)(b * SEQ + r) * 64 + 8 * hh;
            bf16x8 bc[2][4], bn[2][4];
#pragma unroll
            for (int t2 = 0; t2 < 2; ++t2)
#pragma unroll
                for (int ks = 0; ks < 4; ++ks) bc[t2][ks] = *(const GAS bf16x8*)(kp + t2 * 2048 + ks * 16);
            for (int pr = 0; pr < npair; ++pr) {
                const bf16* kn = kp + (size_t)((pr + 1 < npair) ? pr + 1 : pr) * 4096;
#pragma unroll
                for (int t2 = 0; t2 < 2; ++t2)
#pragma unroll
                    for (int ks = 0; ks < 4; ++ks) bn[t2][ks] = *(const GAS bf16x8*)(kn + t2 * 2048 + ks * 16);
#pragma unroll
                for (int t2 = 0; t2 < 2; ++t2) {
                    const int key = pr * 64 + t2 * 32 + r;
#pragma unroll
                    for (int g = 0; g < 2; ++g) {
                        f32x16 acc = {};
#pragma unroll
                        for (int ks = 0; ks < 4; ++ks) acc = __builtin_amdgcn_mfma_f32_32x32x16_bf16(af[g][ks], bc[t2][ks], acc, 0, 0, 0);
                        float tot[4];
#pragma unroll
                        for (int q = 0; q < 4; ++q) { float pp = 0.f;
#pragma unroll
                            for (int i = 0; i < 4; ++i) pp += wv[g][q][i] * fmaxf(acc[4 * q + i], 0.f);
                            tot[q] = pp + shx(pp, lane, 32); }
                        const float o0 = hh ? tot[2] : tot[0], o1 = hh ? tot[3] : tot[1];
                        SC[(size_t)(tok0 + 4 * g + 2 * hh) * SEQ + key] = o0; SC[(size_t)(tok0 + 4 * g + 2 * hh + 1) * SEQ + key] = o1;
                    }
                }
#pragma unroll
                for (int t2 = 0; t2 < 2; ++t2)
#pragma unroll
                    for (int ks = 0; ks < 4; ++ks) bc[t2][ks] = bn[t2][ks];
            }
            asm volatile("s_waitcnt vmcnt(0)" ::: "memory"); __builtin_amdgcn_fence(__ATOMIC_ACQUIRE, "agent"); asm volatile("s_waitcnt vmcnt(0)" ::: "memory");
#pragma unroll 1
            for (int q = 0; q < 8; ++q) select_row(SC, MASK, tok0 + q, lane);
        }
    }
}
constexpr size_t WS_OD = WS_END;
constexpr size_t WS_END2 = WS_END + 64 * MiB;
__device__ __forceinline__ void ph_diff_attn(LAS unsigned char* lds, int wvx) {
    CArgs* A = kargs();
    const int G = gridDim.x, bx = blockIdx.x, vcu = (G % 8 == 0) ? (bx % 8) * (G / 8) + bx / 8 : bx;
    const bf16* H = WS(bf16, WS_H); bf16* OD = WS(bf16, WS_OD);
    for (int item = vcu; item < NB * 16; item += G) {
        const int b = item >> 4, vh = item & 15, g = vh >> 1, half = vh & 1;
#pragma unroll 1
        for (int qb = 7; qb >= 0; --qb)
            attn_body::attn_unit<8, false>(wvx, b, qb, H + HC_DQ + g * 64, H + HC_DK + g * 64, H + HC_DV + (g >> 1) * 128 + half * 64, OD + g * 128 + half * 64, nullptr, (char*)lds);
    }
}
__device__ __forceinline__ void ph_diff_post(int l, int wvx) {
    TIDX;
    const bf16* OD = WS(bf16, WS_OD); bf16* MIX = WS(bf16, WS_MIX);
    const float lam = WS(float, WS_LAM)[l], lam_init = 0.8f - 0.6f * __expf(-0.3f * (float)l);
    for (int task = gw; task < T * 4; task += ngw) {
        const int tok = task >> 2, h = task & 3;
        const bf16* o1 = OD + (size_t)tok * D + (2 * h) * 128, *o2 = o1 + 128;
        const float d0 = bf2f(o1[lane]) - lam * bf2f(o2[lane]), d1 = bf2f(o1[64 + lane]) - lam * bf2f(o2[64 + lane]);
        const float rs = 1.0f / sqrtf(wave_sum(d0 * d0 + d1 * d1) * (1.0f / 128.0f) + LN_EPS);
        const float* g = A->in[I_DFNORM] + l * 512 + h * 128;
        MIX[(size_t)tok * D + 256 + h * 128 + lane] = (bf16)f2bf(d0 * rs * g[lane] * (1.0f - lam_init));
        MIX[(size_t)tok * D + 256 + h * 128 + 64 + lane] = (bf16)f2bf(d1 * rs * g[64 + lane] * (1.0f - lam_init));
    }
}
__device__ __forceinline__ void ph_dsa_attn(LAS unsigned char* lds, int wvx) {
    CArgs* A = kargs();
    const int G = gridDim.x, bx = blockIdx.x, vcu = (G % 8 == 0) ? (bx % 8) * (G / 8) + bx / 8 : bx;
    const bf16* H = WS(bf16, WS_H); bf16* MIX = WS(bf16, WS_MIX); const unsigned* MASK = WS(unsigned, WS_MASK);
    for (int item = vcu; item < NB * 4 * 4; item += G) {
        const int bh = item >> 2, p = item & 3, b = bh >> 2, h = bh & 3;
        attn_body::attn_unit<8, true>(wvx, b, 7 - p, H + HC_SQ + h * 64, H + HC_SK + h * 64, H + HC_SV + h * 64, MIX + 768 + h * 64, MASK, (char*)lds);
        attn_body::attn_unit<8, true>(wvx, b, p, H + HC_SQ + h * 64, H + HC_SK + h * 64, H + HC_SV + h * 64, MIX + 768 + h * 64, MASK, (char*)lds);
    }
}
constexpr size_t WS_DC = WS_END2;
constexpr size_t WS_CST = WS_DC + 32 * MiB;
constexpr size_t WS_DN = WS_CST + 32 * MiB;
constexpr size_t WS_END3 = WS_DN + 4 * MiB;
constexpr size_t WS_DUMMY = WS_END3;
constexpr size_t WS_END4 = WS_DUMMY + 256 * MiB;
typedef float f32x2_ __attribute__((ext_vector_type(2)));
constexpr int MP = 68;
__device__ __forceinline__ float log_sigmoid_(float x) { return fminf(x, 0.f) - log1pf(__expf(-fabsf(x))); }
__device__ __forceinline__ void mlstm_gates(const bf16* H, int tok0, int h, float gbi, float gbf, int lane, LAS float* bcum, LAS float* av) {
    const size_t tk = (size_t)(tok0 + lane);
    const float ip = bf2f(H[tk * NHC + HC_MI + h]) + gbi; float lf = log_sigmoid_(bf2f(H[tk * NHC + HC_MF + h]) + gbf);
#pragma unroll
    for (int o = 1; o < 64; o <<= 1) { const float t_ = shup(lf, lane, o); if (lane >= o) lf += t_; }
    bcum[lane] = lf; av[lane] = ip - lf;
}
constexpr int PB = 72;
typedef unsigned short us8 __attribute__((ext_vector_type(8)));
__device__ __forceinline__ f32x16 mfma_tile(const LAS bf16* Xa, int mt, const LAS bf16* Xb, int nt, int r, int hh, f32x16 acc) {
#pragma unroll
    for (int ks = 0; ks < 4; ++ks) { const bf16x8 a = *(const LAS bf16x8*)(Xa + (32 * mt + r) * PB + 16 * ks + 8 * hh), b = *(const LAS bf16x8*)(Xb + (32 * nt + r) * PB + 16 * ks + 8 * hh);
        acc = __builtin_amdgcn_mfma_f32_32x32x16_bf16(a, b, acc, 0, 0, 0); }
    return acc;
}
__device__ __forceinline__ void ph_mlstm_m1(LAS unsigned char* lds, int l, int wvx) {
    TIDX;
    const bf16* H = WS(bf16, WS_H); const bf16* QKC = WS(bf16, WS_QKC);
    float* DC = WS(float, WS_DC); float* DN = WS(float, WS_DN); float* SCAL = WS(float, WS_DN + 2 * MiB);
    LAS bf16* kT = (LAS bf16*)lds; LAS bf16* vwT = kT + 64 * PB;
    LAS float* bcum = (LAS float*)(vwT + 96 * PB); LAS float* av = bcum + 64; LAS float* wv = av + 64;
    const int r = lane & 31, hh = lane >> 5, srow = tid >> 3, ch = tid & 7;
    for (int u = blockIdx.x; u < NB * 4 * 32; u += gridDim.x) {
        const int bh = u >> 5, c = u & 31, b = bh >> 2, h = bh & 3, tok0 = b * SEQ + c * 64;
        const us8 kraw = *(const GAS us8*)(QKC + (size_t)(tok0 + srow) * 512 + 256 + h * 64 + 8 * ch);
        const us8 vraw = *(const GAS us8*)(H + (size_t)(tok0 + srow) * NHC + HC_MV + h * 64 + 8 * ch);
        if (wave == 0) { mlstm_gates(H, tok0, h, A->in[I_GATEB][l * 8 + h], A->in[I_GATEB][l * 8 + 4 + h], lane, bcum, av); }
        __syncthreads();
        if (wave == 0) { const float a = av[lane], amax = wave_max(a); wv[lane] = __expf(a - amax); if (lane == 0) { SCAL[u * 4 + 0] = bcum[63]; SCAL[u * 4 + 1] = bcum[63] + amax; } }
        __syncthreads();
        { const float w = wv[srow];
#pragma unroll
          for (int e = 0; e < 8; ++e) { kT[(8 * ch + e) * PB + srow] = kraw[e]; vwT[(8 * ch + e) * PB + srow] = (bf16)f2bf(w * bf2f(vraw[e])); }
          if (tid < 64) vwT[64 * PB + tid] = (bf16)f2bf(wv[tid]);
          for (int i = tid; i < 31 * 64; i += 512) vwT[(65 + i / 64) * PB + (i & 63)] = 0; }
        __syncthreads();
        if (wave < 6) { const int mt = wave >> 1, nt = wave & 1;
            f32x16 acc = {}; acc = mfma_tile(vwT, mt, kT, nt, r, hh, acc);
#pragma unroll
            for (int g = 0; g < 16; ++g) { const int vrow = 32 * mt + (g & 3) + 8 * (g >> 2) + 4 * hh, d = 32 * nt + r;
                if (vrow < 64) DC[(size_t)u * 4096 + vrow * 64 + d] = acc[g]; else if (vrow == 64) DN[(size_t)u * 64 + d] = acc[g]; } }
        __syncthreads();
    }
}
__device__ __forceinline__ void ph_mlstm_m2(int wvx) {
    TIDX;
    const float* DC = WS(float, WS_DC); float* CS = WS(float, WS_CST); const float* DN = WS(float, WS_DN); float* NS = WS(float, WS_DN + 1 * MiB); float* SCAL = WS(float, WS_DN + 2 * MiB);
    for (int item = blockIdx.x; item < NB * 4 * 4; item += gridDim.x) {
        const int bh = item >> 2, qtr = item & 3, e0 = qtr * 1024 + tid * 2;
        float m = 0.f; f32x2_ C = (f32x2_){0.f, 0.f}; float n = 0.f;
#pragma unroll 4
        for (int c = 0; c < 32; ++c) {
            const int u = bh * 32 + c;
            const float bl = SCAL[u * 4 + 0], ml = SCAL[u * 4 + 1];
            *(f32x2_*)(CS + (size_t)u * 4096 + e0) = C;
            if (qtr == 0 && tid < 64) NS[(size_t)u * 64 + tid] = n;
            if (qtr == 0 && tid == 0) SCAL[u * 4 + 2] = m;
            const float mn = fmaxf(bl + m, ml), f1 = __expf(bl + m - mn), f2 = __expf(ml - mn);
            const f32x2_ dc = *(const f32x2_*)(DC + (size_t)u * 4096 + e0);
            C.x = f1 * C.x + f2 * dc.x; C.y = f1 * C.y + f2 * dc.y;
            if (qtr == 0 && tid < 64) n = f1 * n + f2 * DN[(size_t)u * 64 + tid];
            m = mn;
        }
    }
}
__device__ __forceinline__ void ph_mlstm_m3(LAS unsigned char* lds, int l, int wvx) {
    TIDX;
    const bf16* H = WS(bf16, WS_H); const bf16* QKC = WS(bf16, WS_QKC); bf16* MIX = WS(bf16, WS_MIX);
    const float* CS = WS(float, WS_CST); const float* NS = WS(float, WS_DN + 1 * MiB); const float* SCAL = WS(float, WS_DN + 2 * MiB);
    LAS bf16* qS = (LAS bf16*)lds; LAS bf16* kS = qS + 64 * PB; LAS bf16* vT = kS + 64 * PB; LAS bf16* cT = vT + 96 * PB; LAS bf16* Sb = cT + 96 * PB;
    LAS float* hS = (LAS float*)(Sb + 64 * PB);
    LAS float* bcum = hS + 64 * MP; LAS float* av = bcum + 64; LAS float* mm = av + 64; LAS float* inter = mm + 64; LAS float* dinv = inter + 64;
    const int r = lane & 31, hh = lane >> 5, srow = tid >> 3, ch = tid & 7;
    for (int u = blockIdx.x; u < NB * 4 * 32; u += gridDim.x) {
        const int bh = u >> 5, c = u & 31, b = bh >> 2, h = bh & 3, tok0 = b * SEQ + c * 64;
        const float mc = SCAL[u * 4 + 2];
        {
            const us8 qraw = *(const GAS us8*)(QKC + (size_t)(tok0 + srow) * 512 + h * 64 + 8 * ch);
            const us8 kraw = *(const GAS us8*)(QKC + (size_t)(tok0 + srow) * 512 + 256 + h * 64 + 8 * ch);
            const us8 vraw = *(const GAS us8*)(H + (size_t)(tok0 + srow) * NHC + HC_MV + h * 64 + 8 * ch);
            const f32x4 c0 = *(const GAS f32x4*)(CS + (size_t)u * 4096 + srow * 64 + 8 * ch), c1 = *(const GAS f32x4*)(CS + (size_t)u * 4096 + srow * 64 + 8 * ch + 4);
            us8 qs;
#pragma unroll
            for (int e = 0; e < 8; ++e) qs[e] = (bf16)f2bf(bf2f(qraw[e]) * 0.125f);
            *(LAS us8*)(qS + srow * PB + 8 * ch) = qs; *(LAS us8*)(kS + srow * PB + 8 * ch) = kraw;
#pragma unroll
            for (int e = 0; e < 8; ++e) vT[(8 * ch + e) * PB + srow] = vraw[e];
            v4u cp; cp.x = pk2(c0[0], c0[1]); cp.y = pk2(c0[2], c0[3]); cp.z = pk2(c1[0], c1[1]); cp.w = pk2(c1[2], c1[3]);
            *(LAS v4u*)(cT + srow * PB + 8 * ch) = cp;
            if (tid < 64) { vT[64 * PB + tid] = (bf16)0x3f80; cT[64 * PB + tid] = (bf16)f2bf(NS[(size_t)u * 64 + tid]); }
            for (int i = tid; i < 31 * 64; i += 512) { vT[(65 + i / 64) * PB + (i & 63)] = 0; cT[(65 + i / 64) * PB + (i & 63)] = 0; }
        }
        if (wave == 0) { mlstm_gates(H, tok0, h, A->in[I_GATEB][l * 8 + h], A->in[I_GATEB][l * 8 + 4 + h], lane, bcum, av); }
        __syncthreads();
        if (wave == 0) { float pm = av[lane];
#pragma unroll
            for (int o = 1; o < 64; o <<= 1) { const float t_ = shup(pm, lane, o); if (lane >= o) pm = fmaxf(pm, t_); }
            const float m_ = fmaxf(mc, pm); mm[lane] = m_; inter[lane] = __expf(mc - m_); }
        __syncthreads();
        if (wave < 4) { const int tt = wave >> 1, st = wave & 1;
            f32x16 acc = {}; acc = mfma_tile(qS, tt, kS, st, r, hh, acc);
            const int s = 32 * st + r; const float as = av[s];
#pragma unroll
            for (int g = 0; g < 16; ++g) { const int t = 32 * tt + (g & 3) + 8 * (g >> 2) + 4 * hh;
                const float val = (s <= t) ? acc[g] * __expf(as - mm[t]) : 0.f; Sb[t * PB + s] = (bf16)f2bf(val); } }
        __syncthreads();
        f32x16 aS = {}, aC = {}; const int tt = (wave < 6) ? wave / 3 : 0, nt = (wave < 6) ? wave % 3 : 0;
        if (wave < 6) { aS = mfma_tile(Sb, tt, vT, nt, r, hh, aS); aC = mfma_tile(qS, tt, cT, nt, r, hh, aC); }
        if (wave < 6 && nt == 2 && r == 0) {
#pragma unroll
            for (int g = 0; g < 16; ++g) { const int t = 32 * tt + (g & 3) + 8 * (g >> 2) + 4 * hh;
                const float dn = aS[g] + inter[t] * aC[g]; dinv[t] = 1.0f / fmaxf(fabsf(dn), __expf(-(bcum[t] + mm[t]))); } }
        __syncthreads();
        if (wave < 6 && nt < 2) {
#pragma unroll
            for (int g = 0; g < 16; ++g) { const int t = 32 * tt + (g & 3) + 8 * (g >> 2) + 4 * hh;
                hS[t * MP + 32 * nt + r] = (aS[g] + inter[t] * aC[g]) * dinv[t]; } }
        __syncthreads();
#pragma unroll
        for (int j = 0; j < 8; ++j) { const int t = wave + 8 * j, vc = lane; const size_t tk = (size_t)(tok0 + t);
            const float hv = hS[t * MP + vc];
            const float mean = wave_sum(hv) * (1.0f / 64.0f), hc = hv - mean;
            const float rs = 1.0f / sqrtf(wave_sum(hc * hc) * (1.0f / 64.0f) + LN_EPS);
            const float og = sigmoidf_(bf2f(H[tk * NHC + HC_MO + h * 64 + vc]));
            MIX[tk * D + h * 64 + vc] = (bf16)f2bf(og * (hc * rs * A->in[I_MNORM][l * 256 + h * 64 + vc])); }
        __syncthreads();
    }
}
__device__ __forceinline__ int wave_sum_i(int x) {
    x += __builtin_amdgcn_update_dpp(0, x, 0xB1, 0xF, 0xF, true);
    x += __builtin_amdgcn_update_dpp(0, x, 0x4E, 0xF, 0xF, true);
    x += __builtin_amdgcn_update_dpp(0, x, 0x141, 0xF, 0xF, true);
    x += __builtin_amdgcn_update_dpp(0, x, 0x140, 0xF, 0xF, true);
    return __builtin_amdgcn_readlane(x, 0) + __builtin_amdgcn_readlane(x, 16) + __builtin_amdgcn_readlane(x, 32) + __builtin_amdgcn_readlane(x, 48);
}
__device__ __forceinline__ void select_row(const float* SC, unsigned* MASK, int tok, int lane) {
        const int tl = tok % SEQ, lo = 32 * lane;
        const int nv = min(max(tl + 1 - lo, 0), 32);
        unsigned cand = (nv >= 32) ? 0xffffffffu : ((1u << nv) - 1u);
        if (tl < 256) { MASK[(size_t)tok * 64 + lane] = cand; return; }
        unsigned a[32];
#pragma unroll
        for (int j = 0; j < 8; ++j) {
            f32x4 v = (f32x4){0.f, 0.f, 0.f, 0.f};
            if (nv > 0) v = *(const GAS f32x4*)(SC + (size_t)tok * SEQ + lo + 4 * j);
#pragma unroll
            for (int c = 0; c < 4; ++c) { unsigned u = __float_as_uint(v[c]); u = (u == 0x80000000u) ? 0u : u; a[4 * j + c] = (u >> 31) ? ~u : (u | 0x80000000u); }
        }
#define TSTAGE(J, M) _Pragma("unroll") for (int k0 = 0; k0 < 32; ++k0) { if ((k0 & J) == 0) { const unsigned t_ = ((a[k0] >> J) ^ a[k0 + J]) & M; a[k0] ^= t_ << J; a[k0 + J] ^= t_; } }
        TSTAGE(16, 0x0000FFFFu) TSTAGE(8, 0x00FF00FFu) TSTAGE(4, 0x0F0F0F0Fu) TSTAGE(2, 0x33333333u) TSTAGE(1, 0x55555555u)
#undef TSTAGE
        unsigned sel = 0u; int need = 256, ncand = tl + 1;
#pragma unroll
        for (int b = 31; b >= 0; --b) {
            if (ncand != need) {
                const unsigned hit = cand & a[b];
                const int cnt = wave_sum_i(__popc(hit));
                if (cnt >= need) { cand = hit; ncand = cnt; }
                else { sel |= hit; cand &= ~a[b]; need -= cnt; ncand -= cnt; }
            }
        }
        if (ncand == need) sel |= cand;
        else {
            const int my = __popc(cand); int incl = my;
#pragma unroll
            for (int o = 1; o < 64; o <<= 1) { const int t_ = shupi(incl, lane, o); if (lane >= o) incl += t_; }
            const int take = min(max(need - (incl - my), 0), my); int taken = 0;
#pragma unroll 1
            for (int k = 0; k < 32; ++k) { if (((cand >> k) & 1u) && taken < take) { sel |= 1u << k; ++taken; } }
        }
        MASK[(size_t)tok * 64 + lane] = sel;
}
__device__ __forceinline__ f32x4 bf4_(unsigned long long r) { f32x4 y; y.x = __uint_as_float((unsigned)r << 16); y.y = __uint_as_float((unsigned)r & 0xffff0000u); y.z = __uint_as_float((unsigned)(r >> 32) << 16); y.w = __uint_as_float((unsigned)(r >> 32) & 0xffff0000u); return y; }
__device__ __forceinline__ unsigned long long pk4_(f32x4 v) { return (unsigned long long)pk2(v.x, v.y) | ((unsigned long long)pk2(v.z, v.w) << 32); }
constexpr int R1_OFF = RING_BYTES + 8192;
__device__ __forceinline__ void ph_row1(LAS unsigned char* lds, int l, int wvx, bool dry = false) {
    TIDX;
    const float* xin = (l == 0) ? A->in[I_X] : WS(float, WS_XB); float* XB = dry ? WS(float, WS_DUMMY) : WS(float, WS_XB);
    const bf16* Y = WS(bf16, WS_Y); bf16* U = dry ? WS(bf16, WS_DUMMY + 128 * MiB) : WS(bf16, WS_U);
    unsigned* cnt = dry ? WS(unsigned, WS_DUMMY + 200 * MiB) : WS(unsigned, WS_CTL) + CW_CNT + l * NEXP * 64; unsigned* TOK = dry ? WS(unsigned, WS_DUMMY + 192 * MiB) : WS(unsigned, WS_TOK);
    const float* lg = A->in[I_LN1G] + l * D; const float* lb = A->in[I_LN1B] + l * D;
    unsigned* RMAP = dry ? WS(unsigned, WS_DUMMY + 208 * MiB) : WS(unsigned, WS_XG);
    LAS float* rw = (LAS float*)lds; LAS unsigned* lcnt = (LAS unsigned*)(lds + R1_OFF); LAS unsigned* lbase = lcnt + 32; LAS unsigned* nrec = lbase + 32; LAS unsigned* rec = nrec + 4;
    { const GAS f32x4* src = (const GAS f32x4*)(WS(float, WS_RWT) + (size_t)l * NEXP * D);
      for (int i = tid; i < NEXP * D / 4; i += 512) ((LAS f32x4*)rw)[i] = src[i];
      if (tid < 32) lcnt[tid] = 0u; if (tid == 32) nrec[0] = 0u; }
    __syncthreads();
    const float rbias = A->in[I_RB][l * NEXP + (lane >> 1)];
    f32x4 px[4], pg[4]; unsigned long long py[4];
#define R1_LOAD(tk) do { const float* mod_ = WS(float, WS_MOD) + ((size_t)l * NB + (tk) / SEQ) * 6144; _Pragma("unroll") for (int j = 0; j < 4; ++j) { const int c = 4 * lane + 256 * j; \
        px[j] = *(const GAS f32x4*)(xin + (size_t)(tk) * D + c); pg[j] = *(const GAS f32x4*)(mod_ + 2048 + c); py[j] = *(const GAS unsigned long long*)(Y + (size_t)(tk) * D + c); } } while (0)
    if (gw < T) R1_LOAD(gw);
    for (int tok = gw; tok < T; tok += ngw) {
        const int b = tok / SEQ; const float* mod = WS(float, WS_MOD) + ((size_t)l * NB + b) * 6144;
        f32x4 v[4]; float s = 0.f;
#pragma unroll
        for (int j = 0; j < 4; ++j) {
            const f32x4 x = px[j]; const f32x4 g1 = pg[j];
            const unsigned long long yr = py[j];
            f32x4 y; y.x = __uint_as_float((unsigned)yr << 16); y.y = __uint_as_float((unsigned)yr & 0xffff0000u); y.z = __uint_as_float((unsigned)(yr >> 32) << 16); y.w = __uint_as_float((unsigned)(yr >> 32) & 0xffff0000u);
            v[j] = x * DN_ALPHA + (1.0f + g1) * y; s += (v[j].x + v[j].y) + (v[j].z + v[j].w); }
        if (tok + ngw < T) R1_LOAD(tok + ngw);
        const float mean = wave_sum(s) * (1.0f / D); float s2 = 0.f;
#pragma unroll
        for (int j = 0; j < 4; ++j) { v[j] = v[j] - mean; s2 += (v[j].x * v[j].x + v[j].y * v[j].y) + (v[j].z * v[j].z + v[j].w * v[j].w); }
        const float rstd = 1.0f / sqrtf(wave_sum(s2) * (1.0f / D) + LN_EPS);
        f32x4 u2[4];
#pragma unroll
        for (int j = 0; j < 4; ++j) { const int c = 4 * lane + 256 * j;
            const f32x4 xn = v[j] * rstd * *(const f32x4*)(lg + c) + *(const f32x4*)(lb + c);
            *(GAS f32x4*)(XB + (size_t)tok * D + c) = xn;
            u2[j] = xn * (1.0f + *(const f32x4*)(mod + 4096 + c)) + *(const f32x4*)(mod + 3072 + c);
            *(GAS unsigned*)((unsigned char*)U + (size_t)tok * D + c) = pg8::pk4_fp8(u2[j].x, u2[j].y, u2[j].z, u2[j].w, 16.0f); }
        float part[32];
#pragma unroll
        for (int e = 0; e < 32; ++e) { float a = 0.f;
#pragma unroll
            for (int j = 0; j < 4; ++j) { const f32x4 w = *(const LAS f32x4*)(rw + e * D + 4 * lane + 256 * j); a += (u2[j].x * w.x + u2[j].y * w.y) + (u2[j].z * w.z + u2[j].w * w.w); }
            part[e] = a; }
#define RSTEP(N, OFF) _Pragma("unroll") for (int e = 0; e < N; ++e) { const bool hi = (lane & OFF) != 0; const float send = hi ? part[e] : part[e + N]; const float recv = shx(send, lane, OFF); part[e] = (hi ? part[e + N] : part[e]) + recv; }
        RSTEP(16, 32) RSTEP(8, 16) RSTEP(4, 8) RSTEP(2, 4) RSTEP(1, 2)
#undef RSTEP
        float logit = part[0] + shx(part[0], lane, 1) + rbias;
        const int myexp = lane >> 1;
        int rank = 0;
#pragma unroll
        for (int j = 0; j < 32; ++j) { const float lj = __int_as_float(__builtin_amdgcn_readlane(__float_as_int(logit), 2 * j)); rank += (lj > logit || (lj == logit && j < myexp)) ? 1 : 0; }
        float tv[4]; int te[4];
#pragma unroll
        for (int k = 0; k < 4; ++k) { const unsigned long long bm = __ballot(rank == k); const int ln = (int)__builtin_ctzll(bm); te[k] = ln >> 1; tv[k] = __int_as_float(__builtin_amdgcn_readlane(__float_as_int(logit), ln)); }
        const float e1 = __expf(tv[1] - tv[0]), e2 = __expf(tv[2] - tv[0]), e3 = __expf(tv[3] - tv[0]); const float inv = 1.0f / (1.0f + e1 + e2 + e3);
        if (lane < 4) { const int ek = lane == 0 ? te[0] : lane == 1 ? te[1] : lane == 2 ? te[2] : te[3]; const float pk = (lane == 0 ? 1.0f : lane == 1 ? e1 : lane == 2 ? e2 : e3) * inv;
            const unsigned lp = __hip_atomic_fetch_add(lcnt + ek, 1u, __ATOMIC_RELAXED, __HIP_MEMORY_SCOPE_WORKGROUP);
            const unsigned ri = __hip_atomic_fetch_add(nrec, 1u, __ATOMIC_RELAXED, __HIP_MEMORY_SCOPE_WORKGROUP);
            if (ri < 640u) { LAS unsigned* r = rec + ri * 3; r[0] = (unsigned)tok * 4u + (unsigned)lane; r[1] = (unsigned)ek | (lp << 8); r[2] = __float_as_uint(pk); } }
    }
#undef R1_LOAD
    __syncthreads();
    if (tid < 32) lbase[tid] = __hip_atomic_fetch_add(cnt + tid * 64, lcnt[tid], __ATOMIC_RELAXED, __HIP_MEMORY_SCOPE_AGENT);
    __syncthreads();
    { const int n = (int)min(nrec[0], 640u);
      for (int i = tid; i < n; i += 512) { const unsigned r0 = rec[i * 3], r1 = rec[i * 3 + 1], r2 = rec[i * 3 + 2]; const unsigned ek = r1 & 255u;
          const unsigned pos = lbase[ek] + (r1 >> 8);
          *(GAS v4u*)(TOK + (size_t)r0 * 4) = (v4u){ek, pos, r2, 0u}; RMAP[(size_t)ek * T + pos] = r0 >> 2; } }
    __syncthreads();
}
__device__ __forceinline__ int moe_tables(LAS unsigned char* lds, int l, int wvx) {
    CArgs* A = kargs();
    LAS unsigned* base = (LAS unsigned*)(lds + TAB_OFF); LAS unsigned char* tile_e = lds + TAB_OFF + 256; LAS unsigned* cntl = (LAS unsigned*)(lds + TAB_OFF + 1024);
    const unsigned* cnt = WS(unsigned, WS_CTL) + CW_CNT + l * NEXP * 64;
    if (wvx == 0) {
        const int lane = lane_id_(), e = lane & 31;
        const unsigned c = __hip_atomic_load(cnt + e * 64, __ATOMIC_RELAXED, __HIP_MEMORY_SCOPE_AGENT);
        const int nt = (int)((c + 255u) >> 8); int incl = nt;
#pragma unroll
        for (int o = 1; o < 32; o <<= 1) { const int t_ = shupi(incl, lane, o); if (e >= o) incl += t_; }
        if (lane < 32) { const int t0 = incl - nt; base[e] = (unsigned)t0 << 8; cntl[e] = c; if (e == 31) base[NEXP] = (unsigned)incl << 8;
#pragma unroll 1
            for (int t = 0; t < nt; ++t) tile_e[t0 + t] = (unsigned char)e; }
    }
    __syncthreads();
    return (int)(base[NEXP] >> 8);
}
__device__ __forceinline__ void ph_row2(LAS unsigned char* lds, int l, int wvx, bool dry = false) {
    TIDX;
    (void)moe_tables(lds, l, wvx);
    const LAS unsigned* base = (const LAS unsigned*)(lds + TAB_OFF);
    float* XB = WS(float, WS_XB); const bf16* YM = WS(bf16, WS_YM); bf16* U = WS(bf16, WS_U); const unsigned* TOK = WS(unsigned, WS_TOK);
    const float* lg = A->in[I_LN2G] + l * D; const float* lb = A->in[I_LN2B] + l * D; const float* b2 = A->in[I_B2] + (size_t)l * NEXP * D;
    float* dst = dry ? WS(float, WS_DUMMY) : (l == DEPTH - 1) ? A->out : XB; bf16* Uw = dry ? WS(bf16, WS_DUMMY + 128 * MiB) : U;
    v4u rcA[4], rcB[4]; unsigned long long yq[4][4]; f32x4 xq[4];
#define R2_REC(dst, tk) do { _Pragma("unroll") for (int k = 0; k < 4; ++k) dst[k] = *(const GAS v4u*)(TOK + ((size_t)(tk) * 4 + k) * 4); } while (0)
#define R2_ROWS(rc, tk) do { _Pragma("unroll") for (int k = 0; k < 4; ++k) { const size_t row_ = (size_t)base[rc[k].x] + rc[k].y; _Pragma("unroll") for (int j = 0; j < 4; ++j) yq[k][j] = *(const GAS unsigned long long*)(YM + row_ * D + 4 * lane + 256 * j); } \
        _Pragma("unroll") for (int j = 0; j < 4; ++j) xq[j] = *(const GAS f32x4*)(XB + (size_t)(tk) * D + 4 * lane + 256 * j); } while (0)
    if (gw < T) { R2_REC(rcA, gw); R2_ROWS(rcA, gw); }
    if (gw + ngw < T) R2_REC(rcB, gw + ngw);
    for (int tok = gw; tok < T; tok += ngw) {
        const int b = tok / SEQ; const float* mod = WS(float, WS_MOD) + ((size_t)l * NB + b) * 6144;
        f32x4 acc[4];
#pragma unroll
        for (int j = 0; j < 4; ++j) acc[j] = (f32x4){0.f, 0.f, 0.f, 0.f};
#pragma unroll
        for (int k = 0; k < 4; ++k) { const float p = __uint_as_float(rcA[k].z);
#pragma unroll
            for (int j = 0; j < 4; ++j) { const int c = 4 * lane + 256 * j; const unsigned long long yr = yq[k][j];
                f32x4 y; y.x = __uint_as_float((unsigned)yr << 16); y.y = __uint_as_float((unsigned)yr & 0xffff0000u); y.z = __uint_as_float((unsigned)(yr >> 32) << 16); y.w = __uint_as_float((unsigned)(yr >> 32) & 0xffff0000u);
                acc[j] = acc[j] + p * (y + *(const f32x4*)(b2 + (size_t)rcA[k].x * D + c)); } }
        f32x4 xc[4];
#pragma unroll
        for (int j = 0; j < 4; ++j) xc[j] = xq[j];
#pragma unroll
        for (int k = 0; k < 4; ++k) rcA[k] = rcB[k];
        if (tok + ngw < T) R2_ROWS(rcA, tok + ngw);
        if (tok + 2 * ngw < T) R2_REC(rcB, tok + 2 * ngw);
        f32x4 v[4]; float s = 0.f;
#pragma unroll
        for (int j = 0; j < 4; ++j) { const int c = 4 * lane + 256 * j; const f32x4 x = xc[j];
            v[j] = x * DN_ALPHA + (1.0f + *(const f32x4*)(mod + 5120 + c)) * acc[j]; s += (v[j].x + v[j].y) + (v[j].z + v[j].w); }
        const float mean = wave_sum(s) * (1.0f / D); float s2 = 0.f;
#pragma unroll
        for (int j = 0; j < 4; ++j) { v[j] = v[j] - mean; s2 += (v[j].x * v[j].x + v[j].y * v[j].y) + (v[j].z * v[j].z + v[j].w * v[j].w); }
        const float rstd = 1.0f / sqrtf(wave_sum(s2) * (1.0f / D) + LN_EPS);
        const float* modn = WS(float, WS_MOD) + ((size_t)(l + 1 < DEPTH ? l + 1 : l) * NB + b) * 6144;
#pragma unroll
        for (int j = 0; j < 4; ++j) { const int c = 4 * lane + 256 * j;
            f32x4 xn = v[j] * rstd * *(const f32x4*)(lg + c) + *(const f32x4*)(lb + c);
#ifdef F8PROBE
            { const unsigned* fl = WS(unsigned, WS_CTL) + 600; if (l == DEPTH - 1) { if (fl[0]) xn = xn * __builtin_nanf(""); else if (fl[1]) xn = xn * 2.0f; } }
#endif
            *(GAS f32x4*)(dst + (size_t)tok * D + c) = xn;
            if (l + 1 < DEPTH) { const f32x4 u = xn * (1.0f + *(const f32x4*)(modn + 1024 + c)) + *(const f32x4*)(modn + c);
                *(GAS unsigned long long*)(Uw + (size_t)tok * D + c) = (unsigned long long)pk2(u.x, u.y) | ((unsigned long long)pk2(u.z, u.w) << 32); } }
    }
#undef R2_REC
#undef R2_ROWS
    __syncthreads();
}
typedef int v8i_ __attribute__((ext_vector_type(8)));
__device__ __forceinline__ unsigned f8enc(int v) {
    const int a = v < 0 ? -v : v; const unsigned c = a == 0 ? 0x00u : a == 1 ? 0x38u : a == 2 ? 0x40u : a == 3 ? 0x44u : 0x48u; return c | (v < 0 ? 0x80u : 0u); }
__device__ __forceinline__ int f8_aval(int i, int k) { return ((i * 7 + k * 3) % 9) - 4; }
__device__ __forceinline__ int f8_bval(int k, int j) { return ((k * 5 + j * 11) % 7) - 3; }
__device__ __forceinline__ void f8_probe(unsigned* flags, int wvx) {
    const int lane = tid_of(wvx) & 63, rc = lane & 15, kg = lane >> 4;
    v8i_ av, bv;
#pragma unroll
    for (int w = 0; w < 8; ++w) { unsigned pa = 0u, pb = 0u;
#pragma unroll
        for (int e = 0; e < 4; ++e) { const int k = 32 * kg + 4 * w + e; pa |= f8enc(f8_aval(rc, k)) << (8 * e); pb |= f8enc(f8_bval(k, rc)) << (8 * e); }
        av[w] = (int)pa; bv[w] = (int)pb; }
    f32x4 z = {0.f, 0.f, 0.f, 0.f};
    const f32x4 d1 = __builtin_amdgcn_mfma_scale_f32_16x16x128_f8f6f4(av, bv, z, 0, 0, 0, 0x7f7f7f7f, 0, 0x7f7f7f7f);
    const f32x4 d2 = __builtin_amdgcn_mfma_scale_f32_16x16x128_f8f6f4(av, bv, z, 0, 0, 0, 0x7b7b7b7b, 0, 0x77777777);
    bool bad1 = false, bad2 = false;
#pragma unroll
    for (int g = 0; g < 4; ++g) { const int i = 4 * kg + g, j = rc; int e = 0;
        for (int k = 0; k < 128; ++k) e += f8_aval(i, k) * f8_bval(k, j);
        if (d1[g] != (float)e) bad1 = true; if (d2[g] != (float)e * (1.0f / 4096.0f)) bad2 = true; }
    if (__any(bad1) && lane == 0) flags[0] = 1u;
    if (__any(bad2) && lane == 0) flags[1] = 1u;
}
__global__ void __launch_bounds__(NWAVES * 64, 2) mega_fwd(Args A_) {
    extern __shared__ __attribute__((aligned(16))) unsigned char lds_raw[];
    LAS unsigned char* lds = (LAS unsigned char*)lds_raw;
    const int tid = threadIdx.x; const int wv0 = __builtin_amdgcn_readfirstlane(tid >> 6);
    volatile LAS unsigned* MISC = (volatile LAS unsigned*)(lds + MISC_OFF);
    for (int u = tid; u < (LDS_BYTES - TAB_OFF) / 4; u += NWAVES * 64) ((LAS unsigned*)(lds + TAB_OFF))[u] = 0u;
    __syncthreads();
    CArgs* A = kargs(); const bool multi = (A->s_hi - A->s_lo) > 1;
    if (multi) (void)xcd_barrier_post(WS(unsigned, WS_CTL) + CW_BAR + A->li * XCD_BAR_WORDS, MISC + 8);
    const int lo = A->s_lo, hi = A->s_hi;
#ifndef PHMASK
#define PHMASK 0xffffffffu
#endif
#define PHM(b) (((PHMASK) >> (b)) & 1u)
#ifndef RPTMASK
#define RPTMASK 0u
#endif
#define RPT(b) _Pragma("unroll 1") for (int rep_ = 0; rep_ < ((((RPTMASK) >> (b)) & 1u) ? 2 : 1); ++rep_)
#define RUN(s) (lo <= (s) && (s) < hi)
#ifdef BAR2
#define BAR2X(A_) xcd_barrier_fn((unsigned*)(A_->ws + WS_CTL) + CW_BAR + A_->li * XCD_BAR_WORDS, xb_xcc_id(), (volatile LAS unsigned*)(lds_launder(lds) + MISC_OFF) + 8, tid_of(wv0) == 0)
#else
#define BAR2X(A_) do {} while (0)
#endif
#define SEAM(s) do { if ((s) + 1 < hi) { CArgs* A_ = kargs(); xcd_barrier_fn((unsigned*)(A_->ws + WS_CTL) + CW_BAR + A_->li * XCD_BAR_WORDS, xb_xcc_id(), (volatile LAS unsigned*)(lds_launder(lds) + MISC_OFF) + 8, tid_of(wv0) == 0); BAR2X(A_); } } while (0)
#ifdef F8PROBE
    if (RUN(0) && blockIdx.x == 0 && wv0 == 0) { CArgs* A = kargs(); f8_probe(WS(unsigned, WS_CTL) + 600, wv0); }
#endif
    if (RUN(0)) { if (PHM(0)) RPT(0) pro_a(lds_launder(lds), wv0); SEAM(0); }
    if (RUN(1)) { if (PHM(1)) RPT(1) pro_b(wv0); SEAM(1); }
    for (int l = 0; l < DEPTH; ++l) {
        const int sb = 2 + NPH * l;
        if (RUN(sb + PH_IN)) { CArgs* A = kargs();
            pg8::Gemm g{WS(bf16, WS_U), WS(bf16, WS_WIN) + (size_t)l * NHC * D, T, NHC, D}; pg8::StaticOrder S; S.init(T, NHC, (int)gridDim.x, (int)blockIdx.x);
            pg8::EpiIn E{WS(bf16, WS_H), WS(float, WS_CS)};
            if (PHM(2)) RPT(2) pg8::gemm_phase<pg8::EpiIn, pg8::StaticOrder, true, true>(lds_launder(lds), wv0, g, S, E);
            SEAM(sb + PH_IN);
        }
        if (RUN(sb + PH_POST)) { if (PHM(3)) RPT(3) ph_post(l, wv0); SEAM(sb + PH_POST); }
        if (RUN(sb + PH_MIXA)) { if (PHM(4)) RPT(4) ph_idx_scores(wv0); if (PHM(5)) RPT(16) ph_mlstm_m1(lds_launder(lds), l, wv0); if (PHM(6)) RPT(6) ph_diff_attn(lds_launder(lds), wv0); SEAM(sb + PH_MIXA); }
        if (RUN(sb + PH_SEL)) { if (PHM(5)) RPT(17) ph_mlstm_m2(wv0);  SEAM(sb + PH_SEL); }
        if (RUN(sb + PH_DSA)) { if (PHM(5)) RPT(18) ph_mlstm_m3(lds_launder(lds), l, wv0); if (PHM(8)) RPT(8) { ph_diff_post(l, wv0); ph_dsa_attn(lds_launder(lds), wv0); } SEAM(sb + PH_DSA); }
        if (RUN(sb + PH_OUT)) { CArgs* A = kargs();
            pg8::Gemm g{WS(bf16, WS_MIX), WS(bf16, WS_WOUT) + (size_t)l * D * D, T, D, D}; pg8::StaticOrder S; S.init(T, D, (int)gridDim.x, (int)blockIdx.x);
            pg8::EpiBf16<0> E{WS(bf16, WS_Y), D, nullptr, 0, 0, 1.f};
            if (PHM(9)) RPT(9) pg8::gemm_phase<pg8::EpiBf16<0>, pg8::StaticOrder, true, true>(lds_launder(lds), wv0, g, S, E);
            SEAM(sb + PH_OUT);
        }
        if (RUN(sb + PH_ROW1)) { if (PHM(10)) { if ((RPTMASK >> 10) & 1u) ph_row1(lds_launder(lds), l, wv0, true); ph_row1(lds_launder(lds), l, wv0); } SEAM(sb + PH_ROW1); }
        if (RUN(sb + PH_G1)) { CArgs* A = kargs();
            const int nrt = moe_tables(lds_launder(lds), l, wv0);
            pg8::Gemm g{WS(bf16, WS_U), (const bf16*)(WS(unsigned char, WS_W1) + (size_t)l * NEXP * 2048 * D), RPAD, NEXP * 2048, D / 2}; pg8::MoeOrder S; S.init(nrt, 8, (int)gridDim.x, (int)blockIdx.x, (const LAS unsigned char*)(lds_launder(lds) + TAB_OFF + 256));
            pg8::EpiSwiGLU<true> E{WS(bf16, WS_HM), A->in[I_B1] + (size_t)l * NEXP * 2048, 1.0f / 4096.0f};
            LAS unsigned char* tb = lds_launder(lds) + TAB_OFF;
            pg8::MoeGatherA AM{WS(unsigned, WS_XG), (const LAS unsigned*)tb, (const LAS unsigned*)(tb + 1024), (const LAS unsigned char*)(tb + 256), T};
            if (PHM(12)) RPT(12) pg8::gemm_phase<pg8::EpiSwiGLU<true>, pg8::MoeOrder, true, true, pg8::MoeGatherA, true>(lds_launder(lds), wv0, g, S, E, AM, 0, 0);
            SEAM(sb + PH_G1);
        }
        if (RUN(sb + PH_G2)) { CArgs* A = kargs();
            const int nrt = moe_tables(lds_launder(lds), l, wv0);
            pg8::Gemm g{WS(bf16, WS_HM), (const bf16*)(WS(unsigned char, WS_W2) + (size_t)l * NEXP * D * D), RPAD, NEXP * D, D / 2}; pg8::MoeOrder S; S.init(nrt, 4, (int)gridDim.x, (int)blockIdx.x, (const LAS unsigned char*)(lds_launder(lds) + TAB_OFF + 256));
            pg8::EpiMoeOut E{WS(bf16, WS_YM), 1.0f / 2048.0f};
            if (PHM(13)) RPT(13) pg8::gemm_phase<pg8::EpiMoeOut, pg8::MoeOrder, true, true, pg8::DirectA, true>(lds_launder(lds), wv0, g, S, E, pg8::DirectA(), 0, 0);
            SEAM(sb + PH_G2);
        }
        if (RUN(sb + PH_ROW2)) { if (PHM(14)) { if ((RPTMASK >> 14) & 1u) ph_row2(lds_launder(lds), l, wv0, true); ph_row2(lds_launder(lds), l, wv0); } SEAM(sb + PH_ROW2); }
    }
#undef RUN
#undef SEAM
}

#ifndef MK_STEPS_PER_LAUNCH
#define MK_STEPS_PER_LAUNCH 1000
#endif
extern "C" void kernel_launch(void* const* d_in, const int* in_sizes, int n_in, void* d_out, int out_size, void* d_ws, size_t ws_size, hipStream_t stream) {
    static int grid = 0;
    if (grid == 0) {
        if (n_in != 25 || out_size != T * D || ws_size < WS_END4) { fprintf(stderr, "kernel_launch: unexpected shapes (n_in %d out %d ws %zu)\n", n_in, out_size, ws_size); grid = -1; return; }
        int dev = 0, cus = 0, per_cu = 0;
        if (hipGetDevice(&dev) != hipSuccess || hipDeviceGetAttribute(&cus, hipDeviceAttributeMultiprocessorCount, dev) != hipSuccess) { grid = -1; return; }
        if (hipFuncSetAttribute((const void*)mega_fwd, hipFuncAttributeMaxDynamicSharedMemorySize, LDS_BYTES) != hipSuccess) { fprintf(stderr, "kernel_launch: hipFuncSetAttribute failed\n"); grid = -1; return; }
        if (hipOccupancyMaxActiveBlocksPerMultiprocessor(&per_cu, (const void*)mega_fwd, NWAVES * 64, LDS_BYTES) != hipSuccess || per_cu < 1) { fprintf(stderr, "kernel_launch: occupancy query says %d\n", per_cu); }
        (void)hipGetLastError();
        grid = cus;
    }
    if (grid < 0) return;
    if (hipMemsetAsync((char*)d_ws + WS_CTL, 0, CTL_ZERO_BYTES, stream) != hipSuccess) return;
    Args a{};
    for (int i = 0; i < 25; ++i) a.in[i] = (const float*)d_in[i];
    a.out = (float*)d_out; a.ws = (unsigned char*)d_ws;
    int li = 0;
    for (int s = 0; s < NSTEPS; s += MK_STEPS_PER_LAUNCH, ++li) {
        a.s_lo = s; a.s_hi = (s + MK_STEPS_PER_LAUNCH < NSTEPS) ? s + MK_STEPS_PER_LAUNCH : NSTEPS; a.li = li; a.pad = 0;
        hipLaunchKernelGGL(mega_fwd, dim3(grid), dim3(NWAVES * 64), LDS_BYTES, stream, a);
    }
}
```

```cpp
#include <hip/hip_runtime.h>
#include <cstdio>
#include <cstdint>

__device__ __forceinline__ int lane_id_() { int l_; asm volatile("v_mbcnt_lo_u32_b32 %0, -1, 0\n\tv_mbcnt_hi_u32_b32 %0, -1, %0" : "=&v"(l_)); return l_; }
namespace pg8 {
#define PG8_LAS __attribute__((address_space(3)))
typedef unsigned short bf16_t;
typedef short bf16x8 __attribute__((ext_vector_type(8)));
typedef float f32x4 __attribute__((ext_vector_type(4)));
typedef unsigned u32x4 __attribute__((ext_vector_type(4)));
constexpr int BM = 256, BK = 64, HALF = 128, HTB = HALF * BK * 2  , STAGE_BYTES = 8 * HTB, NXCD = 8, WGM = 8;

__host__ __device__ __forceinline__ int lds_byte(int r, int c) { const int st = (r >> 4) * 2 + (c >> 5), rr = r & 15, cc = c & 31, ob = rr * 64 + cc * 2; return st * 1024 + (ob ^ (((ob >> 9) & 1) << 5)); }
__host__ __device__ __forceinline__ void stage_rc(int b, int& R, int& C) { const int st = b / 1024, sb = b % 1024, swz = sb ^ (((sb >> 9) & 1) << 5); R = (st >> 1) * 16 + swz / 64; C = (st & 1) * 32 + (swz % 64) / 2; }
__host__ __device__ __forceinline__ int perm32(int rho) { const int n = rho >> 4, i = rho & 15; return 8 * (i >> 2) + 4 * n + (i & 3); }

struct Unit { int pm, pn; };
struct Gemm { const bf16_t* A; const bf16_t* Bt; int M, N, K; };

struct StaticOrder {
    int nM, nN, nwg, G, c;
    __host__ __device__ void init(int M, int N, int G_, int c_) { nM = M / BM; nN = N / BM; nwg = nM * nN; G = G_; c = c_; }
    __host__ __device__ bool next(int i, Unit& u) const {
        const long L = (long)i * G + c; if (L >= nwg) return false;
        int wgid = (int)L; { const int q = nwg / NXCD, r = nwg % NXCD, xcd = wgid % NXCD, off = wgid / NXCD; wgid = (xcd < r ? xcd * (q + 1) : r * (q + 1) + (xcd - r) * q) + off; }
        const int nig = WGM * nN, gid = wgid / nig, fm = gid * WGM, gsz = (nM - fm) < WGM ? (nM - fm) : WGM;
        u.pm = fm + ((wgid % nig) % gsz); u.pn = (wgid % nig) / gsz; return true;
    }
    __device__ __forceinline__ void a_ready(const Unit&) const {}
    __device__ __forceinline__ void done(const Unit&) const {}
};
struct MoeOrder {
    int nM, nN, nwg, G, c; const PG8_LAS unsigned char* tile_e;
    __device__ void init(int nRT, int NTN, int G_, int c_, const PG8_LAS unsigned char* te) { nM = nRT; nN = NTN; nwg = nM * nN; G = G_; c = c_; tile_e = te; }
    __device__ bool next(int i, Unit& u) const {
        const long L = (long)i * G + c; if (L >= nwg) return false;
        int wgid = (int)L; { const int q = nwg / NXCD, r = nwg % NXCD, xcd = wgid % NXCD, off = wgid / NXCD; wgid = (xcd < r ? xcd * (q + 1) : r * (q + 1) + (xcd - r) * q) + off; }
        const int nig = WGM * nN, gid = wgid / nig, fm = gid * WGM, gsz = (nM - fm) < WGM ? (nM - fm) : WGM;
        u.pm = fm + ((wgid % nig) % gsz); const int pl = (wgid % nig) / gsz; u.pn = (int)tile_e[u.pm] * nN + pl; return true;
    }
    __device__ __forceinline__ void a_ready(const Unit&) const {}
    __device__ __forceinline__ void done(const Unit&) const {}
};
struct MoeGatherA {
    static constexpr bool GATHER = true;
    const unsigned* rowmap; const PG8_LAS unsigned* base; const PG8_LAS unsigned* cnt; const PG8_LAS unsigned char* tile_e; int ntok;
    __device__ __forceinline__ unsigned off(const Unit& u, int h, int rA, int cA, int K) const {
        const int e = tile_e[u.pm]; const unsigned pos = (unsigned)u.pm * 256u - base[e] + 128u * h + (unsigned)rA;
        const unsigned tok = pos < cnt[e] ? rowmap[(size_t)e * ntok + pos] : 0u;
        return (tok * (unsigned)K + (unsigned)cA) * 2u;
    }
};
__device__ __forceinline__ unsigned cvt_pk_bf16(float lo, float hi) { unsigned r; asm volatile("v_cvt_pk_bf16_f32 %0, %1, %2" : "=v"(r) : "v"(lo), "v"(hi)); return r; }
typedef float f32x2 __attribute__((ext_vector_type(2)));
__device__ __forceinline__ f32x2 gelu_pk(f32x2 v) {
    const f32x2 av = __builtin_elementwise_abs(v), d = av * 0.2316418882f + 1.0f;
    f32x2 t; t.x = __builtin_amdgcn_rcpf(d.x); t.y = __builtin_amdgcn_rcpf(d.y);
    f32x2 q = t * 0.5307027145f + (-0.7265760135f); q = q * t + 0.7107068705f; q = q * t + (-0.142248368f); q = q * t + 0.127414796f; q = q * t;
    const f32x2 s = (v * v) * (-0.72134752044f);
    f32x2 e; e.x = __builtin_amdgcn_exp2f(s.x); e.y = __builtin_amdgcn_exp2f(s.y);
    const f32x2 m = v * (q * e), r = v - m;
    f32x2 o; o.x = v.x < 0.f ? m.x : r.x; o.y = v.y < 0.f ? m.y : r.y; return o;
}

template <int ACT  > struct EpiBf16 {
    static constexpr bool PERM = true, AFTER_DRAIN = false; static_assert(ACT == 0 || ACT == 1, "EpiBf16: ACT is 0 (none) or 1 (gelu_pk)");
    bf16_t* O; int ldc; const float* bias; int split_cols; size_t split_stride; float scale0;
    __device__ __forceinline__ void operator()(const f32x4 (&acc)[2][2][4][2], const Unit& u, int wr, int wc, int fr, int fq) const {
        const int row0 = u.pm * BM + wr * 64 + fr; int colt = u.pn * BM; bf16_t* base = O;
        float sc = 1.f; if (split_cols) { const int t = colt / split_cols; base += (size_t)t * split_stride; colt -= t * split_cols; if (t == 0) sc = scale0; }
        const int col0 = colt + wc * 32 + 8 * fq, bcol0 = u.pn * BM + wc * 32 + 8 * fq;
        f32x4 bv[2][2];
#pragma unroll
        for (int bj = 0; bj < 2; ++bj)
#pragma unroll
            for (int n = 0; n < 2; ++n) bv[bj][n] = bias ? *(const f32x4*)(bias + bcol0 + bj * HALF + 4 * n) : (f32x4){0.f, 0.f, 0.f, 0.f};
#pragma unroll
        for (int ai = 0; ai < 2; ++ai)
#pragma unroll
            for (int m = 0; m < 4; ++m) { bf16_t* rowp = base + (size_t)(row0 + ai * HALF + m * 16) * ldc + col0;
#pragma unroll
                for (int bj = 0; bj < 2; ++bj) { f32x4 v0 = acc[ai][bj][m][0] + bv[bj][0], v1 = acc[ai][bj][m][1] + bv[bj][1];
                    if (ACT == 1) { f32x2 a = gelu_pk((f32x2){v0[0], v0[1]}), b = gelu_pk((f32x2){v0[2], v0[3]}), c = gelu_pk((f32x2){v1[0], v1[1]}), d = gelu_pk((f32x2){v1[2], v1[3]});
                        v0 = (f32x4){a.x, a.y, b.x, b.y}; v1 = (f32x4){c.x, c.y, d.x, d.y}; }
                    v0 = v0 * sc; v1 = v1 * sc; u32x4 w; w.x = cvt_pk_bf16(v0[0], v0[1]); w.y = cvt_pk_bf16(v0[2], v0[3]); w.z = cvt_pk_bf16(v1[0], v1[1]); w.w = cvt_pk_bf16(v1[2], v1[3]);
                    *(u32x4*)(rowp + bj * HALF) = w; } }
    }
};
constexpr float C2 = 0.125f * 1.4426950408889634f;
struct EpiIn {
    static constexpr bool PERM = true, AFTER_DRAIN = false;
    bf16_t* O; const float* cs;
    __device__ __forceinline__ void operator()(const f32x4 (&acc)[2][2][4][2], const Unit& u, int wr, int wc, int fr, int fq) const {
        const int pn = u.pn;
        const bool rope = (0x6CF0 >> pn) & 1;
        const float sc = ((0x0430 >> pn) & 1) ? C2 : 1.f;
        const int row0 = u.pm * BM + wr * 64 + fr, col0 = pn * BM + wc * 32 + 8 * fq, i0 = (wc & 1) * 16 + 4 * fq;
#pragma unroll
        for (int ai = 0; ai < 2; ++ai) {
            f32x4 c01[4], c23[4];
#pragma unroll
            for (int m = 0; m < 4; ++m) { c01[m] = (f32x4){1.f, 0.f, 1.f, 0.f}; c23[m] = c01[m]; }
            if (rope) {
#pragma unroll
                for (int m = 0; m < 4; ++m) { const float* cp = cs + (size_t)(row0 + ai * HALF + m * 16) * 64 + i0 * 2; c01[m] = *(const f32x4*)cp; c23[m] = *(const f32x4*)(cp + 4); }
            }
#pragma unroll
            for (int m = 0; m < 4; ++m) {
                const int row = row0 + ai * HALF + m * 16;
                const f32x4 ca = c01[m], cb = c23[m];
                bf16_t* rowp = O + (size_t)row * 4096 + col0;
#pragma unroll
                for (int bj = 0; bj < 2; ++bj) {
                    const f32x4 v0 = acc[ai][bj][m][0], v1 = acc[ai][bj][m][1];
                    f32x4 r0, r1;
                    r0[0] = v0[0] * ca[0] - v0[1] * ca[1]; r0[1] = v0[1] * ca[0] + v0[0] * ca[1];
                    r0[2] = v0[2] * ca[2] - v0[3] * ca[3]; r0[3] = v0[3] * ca[2] + v0[2] * ca[3];
                    r1[0] = v1[0] * cb[0] - v1[1] * cb[1]; r1[1] = v1[1] * cb[0] + v1[0] * cb[1];
                    r1[2] = v1[2] * cb[2] - v1[3] * cb[3]; r1[3] = v1[3] * cb[2] + v1[2] * cb[3];
                    r0 = r0 * sc; r1 = r1 * sc;
                    u32x4 w; w.x = cvt_pk_bf16(r0[0], r0[1]); w.y = cvt_pk_bf16(r0[2], r0[3]); w.z = cvt_pk_bf16(r1[0], r1[1]); w.w = cvt_pk_bf16(r1[2], r1[3]);
                    *(u32x4*)(rowp + bj * HALF) = w;
                }
            }
            asm volatile("" ::: "memory");
        }
    }
};
__device__ __forceinline__ unsigned pk4_fp8(float a, float b, float c, float d, float sc) {
    a = fminf(fmaxf(a * sc, -448.f), 448.f); b = fminf(fmaxf(b * sc, -448.f), 448.f); c = fminf(fmaxf(c * sc, -448.f), 448.f); d = fminf(fmaxf(d * sc, -448.f), 448.f);
    int w = __builtin_amdgcn_cvt_pk_fp8_f32(a, b, 0, false); w = __builtin_amdgcn_cvt_pk_fp8_f32(c, d, w, true); return (unsigned)w; }
template <bool F8OUT> struct EpiSwiGLU {
    static constexpr bool PERM = true, AFTER_DRAIN = false;
    bf16_t* O; const float* b1; float asc;
    __device__ __forceinline__ void operator()(const f32x4 (&acc)[2][2][4][2], const Unit& u, int wr, int wc, int fr, int fq) const {
        const int e = u.pn >> 3, pl = u.pn & 7, colh = pl * 128 + wc * 32 + 8 * fq;
        const float* bp = b1 + (size_t)e * 2048 + colh;
        f32x4 bg[2], bu[2];
#pragma unroll
        for (int n = 0; n < 2; ++n) { bg[n] = *(const f32x4*)(bp + 4 * n); bu[n] = *(const f32x4*)(bp + 1024 + 4 * n); }
        const int row0 = u.pm * BM + wr * 64 + fr;
#pragma unroll
        for (int ai = 0; ai < 2; ++ai)
#pragma unroll
            for (int m = 0; m < 4; ++m) {
                f32x4 o[2];
#pragma unroll
                for (int n = 0; n < 2; ++n) {
                    const f32x4 g4 = acc[ai][0][m][n] * asc + bg[n], u4 = acc[ai][1][m][n] * asc + bu[n];
#pragma unroll
                    for (int c = 0; c < 4; ++c) {
                        const float g = fminf(g4[c], 7.0f), up = fminf(fmaxf(u4[c], -7.0f), 7.0f);
                        const float sg = __builtin_amdgcn_rcpf(1.0f + __builtin_amdgcn_exp2f(-1.702f * 1.4426950408889634f * g));
                        o[n][c] = (up + 1.0f) * (g * sg);
                    }
                }
                if constexpr (F8OUT) { typedef unsigned u32x2_ __attribute__((ext_vector_type(2))); u32x2_ w; w.x = pk4_fp8(o[0][0], o[0][1], o[0][2], o[0][3], 8.0f); w.y = pk4_fp8(o[1][0], o[1][1], o[1][2], o[1][3], 8.0f);
                    *(u32x2_*)((unsigned char*)O + (size_t)(row0 + ai * HALF + m * 16) * 1024 + colh) = w; }
                else { u32x4 w; w.x = cvt_pk_bf16(o[0][0], o[0][1]); w.y = cvt_pk_bf16(o[0][2], o[0][3]); w.z = cvt_pk_bf16(o[1][0], o[1][1]); w.w = cvt_pk_bf16(o[1][2], o[1][3]);
                    *(u32x4*)(O + (size_t)(row0 + ai * HALF + m * 16) * 1024 + colh) = w; }
            }
    }
};
struct EpiMoeOut {
    static constexpr bool PERM = true, AFTER_DRAIN = false;
    bf16_t* O; float asc;
    __device__ __forceinline__ void operator()(const f32x4 (&acc)[2][2][4][2], const Unit& u, int wr, int wc, int fr, int fq) const {
        const int row0 = u.pm * BM + wr * 64 + fr, col0 = (u.pn & 3) * BM + wc * 32 + 8 * fq;
#pragma unroll
        for (int ai = 0; ai < 2; ++ai)
#pragma unroll
            for (int m = 0; m < 4; ++m) { bf16_t* rowp = O + (size_t)(row0 + ai * HALF + m * 16) * 1024 + col0;
#pragma unroll
                for (int bj = 0; bj < 2; ++bj) { const f32x4 v0 = acc[ai][bj][m][0] * asc, v1 = acc[ai][bj][m][1] * asc;
                    u32x4 w; w.x = cvt_pk_bf16(v0[0], v0[1]); w.y = cvt_pk_bf16(v0[2], v0[3]); w.z = cvt_pk_bf16(v1[0], v1[1]); w.w = cvt_pk_bf16(v1[2], v1[3]);
                    *(u32x4*)(rowp + bj * HALF) = w; } }
    }
};
struct DirectA { static constexpr bool GATHER = false; __device__ __forceinline__ unsigned off(const Unit&, int, int, int, int) const { return 0u; } };
typedef int v8i32 __attribute__((ext_vector_type(8)));
template <class Epi, class Sched, bool ALIGN_EPI = false, bool SP2 = false, class AMap = DirectA, bool F8 = false>
__device__ __forceinline__ void gemm_phase(PG8_LAS unsigned char* lds, int wvx, const Gemm g, const Sched& S, const Epi& E, const AMap& AM = AMap(), int scA = 0x7f7f7f7f, int scB = 0x7f7f7f7f) {
    int tid_ = wvx * 64 + lane_id_(); asm volatile("" : "+v"(tid_));
    const int tid = tid_, wid = __builtin_amdgcn_readfirstlane(tid >> 6), lane = tid & 63, wr = wid >> 2, wc = wid & 3, fr = lane & 15, fq = lane >> 4;
    const int K = g.K, nt = K / BK;
    unsigned voffB[2], vA[2];
#pragma unroll
    for (int i = 0; i < 2; ++i) { int R, C; stage_rc(tid * 16 + i * 8192, R, C); const int Rb = Epi::PERM ? ((R & ~31) + perm32(R & 31)) : R;
        vA[i] = (unsigned)(R * K + C) * 2u; voffB[i] = (unsigned)(Rb * K + C) * 2u; }
    const size_t kstep = (size_t)(BK * 2);
    const size_t hstep = (size_t)HALF * K * 2;
    const size_t tstep = 2 * hstep;
    const unsigned ldsw = (unsigned)wid * 1024u;
    const int aoff = lds_byte(wr * 64 + fr, fq * 8), boff = lds_byte(wc * 32 + fr, fq * 8);
#define PG8_SA(b, h) (((b) * 2 + (h)) * HTB)
#define PG8_SB(b, h) ((4 + (b) * 2 + (h)) * HTB)
#define PG8_STAGEA(bufoff, kb, h, nx) do { size_t ubx_ = (size_t)(kb); unsigned lo_[2]; \
        if constexpr (AMap::GATHER) { _Pragma("unroll") for (int _i = 0; _i < 2; ++_i) lo_[_i] = (nx) ? oN[h][_i] : oC[h][_i]; } \
        else { ubx_ += (nx) ? uN[h] : uC[h]; _Pragma("unroll") for (int _i = 0; _i < 2; ++_i) lo_[_i] = vA[_i]; } \
        const char* ub_ = Abase + ubx_; asm("" : "+s"(ub_)); _Pragma("unroll") for (int _i = 0; _i < 2; ++_i) asm("" : "+v"(lo_[_i]));     \
        _Pragma("unroll") for (int _i = 0; _i < 2; ++_i) \
        __builtin_amdgcn_global_load_lds((const unsigned*)(ub_ + lo_[_i]), (PG8_LAS unsigned*)(lds + (bufoff) + ldsw + _i * 8192), 16, 0, 0); } while (0)
#define PG8_AOFF(dstL, dstU, u) do { if constexpr (AMap::GATHER) { int t2_ = wvx * 64 + lane_id_(); asm volatile("" : "+v"(t2_)); _Pragma("unroll") for (int _i = 0; _i < 2; ++_i) { int R_, C_; stage_rc(t2_ * 16 + _i * 8192, R_, C_); \
            _Pragma("unroll") for (int _h = 0; _h < 2; ++_h) dstL[_h][_i] = AM.off(u, _h, R_, C_, K); } } \
        else { _Pragma("unroll") for (int _h = 0; _h < 2; ++_h) dstU[_h] = ((size_t)(u).pm * BM + 128 * _h) * (size_t)K * 2; } } while (0)
#define PG8_STAGE(bufoff, gbase, voff) do { const char* ub_ = (const char*)(gbase); asm("" : "+s"(ub_)); _Pragma("unroll") for (int _i = 0; _i < 2; ++_i) \
        __builtin_amdgcn_global_load_lds((const unsigned*)(ub_ + (voff)[_i]), (PG8_LAS unsigned*)(lds + (bufoff) + ldsw + _i * 8192), 16, 0, 0); } while (0)
#define PG8_LDA(dst, b, h) do { _Pragma("unroll") for (int m = 0; m < 4; ++m) _Pragma("unroll") for (int k = 0; k < 2; ++k) dst[m][k] = *(const PG8_LAS bf16x8*)(lds + PG8_SA(b, h) + aoff + m * 2048 + k * 1024); } while (0)
#define PG8_LDB(dst, b, h) do { _Pragma("unroll") for (int n = 0; n < 2; ++n) _Pragma("unroll") for (int k = 0; k < 2; ++k) dst[n][k] = *(const PG8_LAS bf16x8*)(lds + PG8_SB(b, h) + boff + n * 2048 + k * 1024); } while (0)
#define PG8_CAT(x) __builtin_bit_cast(v8i32, __builtin_shufflevector(x[0], x[1], 0, 1, 2, 3, 4, 5, 6, 7, 8, 9, 10, 11, 12, 13, 14, 15))
#define PG8_MMA(ai, bj, At, Bt) do { __builtin_amdgcn_s_setprio(1); _Pragma("unroll") for (int m = 0; m < 4; ++m) _Pragma("unroll") for (int n = 0; n < 2; ++n) { \
        if constexpr (F8) acc[ai][bj][m][n] = __builtin_amdgcn_mfma_scale_f32_16x16x128_f8f6f4(PG8_CAT(Bt[n]), PG8_CAT(At[m]), acc[ai][bj][m][n], 0, 0, 0, scB, 0, scA); \
        else { _Pragma("unroll") for (int k = 0; k < 2; ++k) acc[ai][bj][m][n] = __builtin_amdgcn_mfma_f32_16x16x32_bf16(Bt[n][k], At[m][k], acc[ai][bj][m][n], 0, 0, 0); } } __builtin_amdgcn_s_setprio(0); } while (0)
#define PG8_WAIT_V(n) asm volatile("s_waitcnt vmcnt(" #n ")" ::: "memory")
#define PG8_WAIT_L(n) asm volatile("s_waitcnt lgkmcnt(" #n ")" ::: "memory")
#define PG8_BAR __builtin_amdgcn_s_barrier()
#define PG8_SCHED __builtin_amdgcn_sched_barrier(0)
    Unit cur, nxt; int ui = 0;
    if (!S.next(0, cur)) return;
    f32x4 acc[2][2][4][2];
#pragma unroll
    for (int a = 0; a < 2; ++a)
#pragma unroll
        for (int b = 0; b < 2; ++b)
#pragma unroll
            for (int m = 0; m < 4; ++m)
#pragma unroll
                for (int n = 0; n < 2; ++n) acc[a][b][m][n] = (f32x4){0.f, 0.f, 0.f, 0.f};
    bf16x8 At[4][2], B0[2][2], B1[2][2];
    const char* Abase = (const char*)g.A; const char* cB = (const char*)g.Bt + (size_t)cur.pn * tstep;
    unsigned oC[2][2], oN[2][2]; size_t uC[2] = {0, 0}, uN[2] = {0, 0}; PG8_AOFF(oC, uC, cur);
    S.a_ready(cur);
    if constexpr (SP2) {
        PG8_STAGE(PG8_SB(0, 0), cB, voffB); PG8_STAGE(PG8_SB(0, 1), cB + hstep, voffB); PG8_STAGEA(PG8_SA(0, 0), 0, 0, false); PG8_STAGEA(PG8_SA(0, 1), 0, 1, false);
        if (wr == 1) PG8_BAR;
        PG8_WAIT_V(2); PG8_BAR;
        PG8_STAGE(PG8_SB(1, 0), cB + kstep, voffB); PG8_STAGEA(PG8_SA(1, 0), kstep, 0, false); PG8_STAGE(PG8_SB(1, 1), cB + hstep + kstep, voffB);
        PG8_WAIT_V(6); PG8_BAR;
    } else {
        PG8_STAGE(PG8_SB(0, 0), cB, voffB); PG8_STAGEA(PG8_SA(0, 0), 0, 0, false); PG8_STAGE(PG8_SB(0, 1), cB + hstep, voffB); PG8_STAGEA(PG8_SA(0, 1), 0, 1, false);
        if (wr == 1) PG8_BAR;
        PG8_WAIT_V(4); PG8_BAR;
        PG8_STAGE(PG8_SB(1, 0), cB + kstep, voffB); PG8_STAGEA(PG8_SA(1, 0), kstep, 0, false); PG8_STAGE(PG8_SB(1, 1), cB + hstep + kstep, voffB);
        PG8_WAIT_V(6); PG8_BAR;
    }
    for (;;) {
        const bool has_next = S.next(ui + 1, nxt);
        const char* nB = has_next ? (const char*)g.Bt + (size_t)nxt.pn * tstep : cB;
        if (has_next) { PG8_AOFF(oN, uN, nxt); } else {
#pragma unroll
            for (int _h = 0; _h < 2; ++_h) { oN[_h][0] = oC[_h][0]; oN[_h][1] = oC[_h][1]; uN[_h] = uC[_h]; } }
#pragma unroll 1
        for (int t = 0; t < nt; t += 2) {
            const bool last = (t == nt - 2);
            const size_t ka1 = (size_t)(t + 1) * kstep, ka2 = last ? (size_t)0 : (size_t)(t + 2) * kstep, ka3 = ka2 + kstep;
            const char* b2 = last ? nB : cB + (size_t)(t + 2) * kstep; const char* b3 = b2 + kstep;
            if (last && has_next) S.a_ready(nxt);
            if constexpr (SP2) {
            PG8_LDB(B0, 0, 0); PG8_LDB(B1, 0, 1); PG8_SCHED; PG8_LDA(At, 0, 0); PG8_STAGEA(PG8_SA(1, 1), ka1, 1, false);
            PG8_WAIT_V(8); PG8_WAIT_L(0); PG8_BAR; PG8_MMA(0, 0, At, B0); PG8_MMA(0, 1, At, B1); PG8_BAR; PG8_SCHED;
            PG8_LDA(At, 0, 1); PG8_STAGE(PG8_SB(0, 0), b2, voffB); PG8_STAGE(PG8_SB(0, 1), b2 + hstep, voffB); PG8_STAGEA(PG8_SA(0, 0), ka2, 0, last);
            PG8_WAIT_V(8); PG8_WAIT_L(0); PG8_BAR; PG8_MMA(1, 0, At, B0); PG8_MMA(1, 1, At, B1); PG8_BAR; PG8_SCHED;
            PG8_LDB(B0, 1, 0); PG8_LDB(B1, 1, 1); PG8_SCHED; PG8_LDA(At, 1, 0); PG8_STAGEA(PG8_SA(0, 1), ka2, 1, last);
            PG8_WAIT_V(8); PG8_WAIT_L(0); PG8_BAR; PG8_MMA(0, 0, At, B0); PG8_MMA(0, 1, At, B1); PG8_BAR; PG8_SCHED;
            PG8_LDA(At, 1, 1); PG8_STAGE(PG8_SB(1, 0), b3, voffB); PG8_STAGE(PG8_SB(1, 1), b3 + hstep, voffB); PG8_STAGEA(PG8_SA(1, 0), ka3, 0, last);
            PG8_WAIT_V(8); PG8_WAIT_L(0); PG8_BAR; PG8_MMA(1, 0, At, B0); PG8_MMA(1, 1, At, B1); PG8_BAR; PG8_SCHED;
            } else {
            PG8_LDB(B0, 0, 0); PG8_SCHED; PG8_LDA(At, 0, 0); PG8_STAGEA(PG8_SA(1, 1), ka1, 1, false);
            PG8_WAIT_L(8); PG8_BAR; PG8_WAIT_L(0); PG8_MMA(0, 0, At, B0); PG8_BAR; PG8_SCHED;
            PG8_LDB(B1, 0, 1); PG8_STAGE(PG8_SB(0, 0), b2, voffB);
            PG8_BAR; PG8_WAIT_L(0); PG8_MMA(0, 1, At, B1); PG8_BAR;
            PG8_LDA(At, 0, 1); PG8_STAGEA(PG8_SA(0, 0), ka2, 0, last);
            PG8_BAR; PG8_WAIT_L(0); PG8_MMA(1, 0, At, B0); PG8_BAR; PG8_SCHED;
            PG8_STAGE(PG8_SB(0, 1), b2 + hstep, voffB);
            PG8_WAIT_V(6); PG8_BAR; PG8_MMA(1, 1, At, B1); PG8_BAR;
            PG8_LDB(B0, 1, 0); PG8_SCHED; PG8_LDA(At, 1, 0); PG8_STAGEA(PG8_SA(0, 1), ka2, 1, last);
            PG8_WAIT_L(8); PG8_BAR; PG8_WAIT_L(0); PG8_MMA(0, 0, At, B0); PG8_BAR; PG8_SCHED;
            PG8_LDB(B1, 1, 1); PG8_STAGE(PG8_SB(1, 0), b3, voffB);
            PG8_BAR; PG8_WAIT_L(0); PG8_MMA(0, 1, At, B1); PG8_BAR;
            PG8_LDA(At, 1, 1); PG8_STAGEA(PG8_SA(1, 0), ka3, 0, last);
            PG8_BAR; PG8_WAIT_L(0); PG8_MMA(1, 0, At, B0); PG8_BAR; PG8_SCHED;
            PG8_STAGE(PG8_SB(1, 1), b3 + hstep, voffB);
            PG8_WAIT_V(6); PG8_BAR; PG8_MMA(1, 1, At, B1); PG8_BAR;
            }
        }
        if constexpr (ALIGN_EPI) { if (wr == 0) PG8_BAR; }
        if constexpr (!Epi::AFTER_DRAIN) { const int l2_ = lane_id_(); const int fr_ = l2_ & 15, fq_ = l2_ >> 4;
            E(acc, cur, wr, wc, fr_, fq_); S.done(cur); }
        if (!has_next) break;
#pragma unroll
        for (int a = 0; a < 2; ++a)
#pragma unroll
            for (int b = 0; b < 2; ++b)
#pragma unroll
                for (int m = 0; m < 4; ++m)
#pragma unroll
                    for (int n = 0; n < 2; ++n) acc[a][b][m][n] = (f32x4){0.f, 0.f, 0.f, 0.f};
        cur = nxt; cB = nB; ++ui;
#pragma unroll
        for (int _h = 0; _h < 2; ++_h) { oC[_h][0] = oN[_h][0]; oC[_h][1] = oN[_h][1]; uC[_h] = uN[_h]; }
        if constexpr (ALIGN_EPI) { if (wr == 1) PG8_BAR; }
    }
    PG8_WAIT_V(0);
    if constexpr (!ALIGN_EPI) { if (wr == 0) PG8_BAR; }
    PG8_BAR;
    if constexpr (Epi::AFTER_DRAIN) { E.fused(acc, cur, wr, wc, fr, fq, lds, wid, lane); S.done(cur); }
#undef PG8_SA
#undef PG8_SB
#undef PG8_STAGE
#undef PG8_STAGEA
#undef PG8_AOFF
#undef PG8_LDA
#undef PG8_LDB
#undef PG8_MMA
#undef PG8_CAT
#undef PG8_WAIT_V
#undef PG8_WAIT_L
#undef PG8_BAR
#undef PG8_SCHED
}
}
namespace attn_body {
using bf16=unsigned short;
using bf16x8=__attribute__((ext_vector_type(8)))short;
using s16x4=__attribute__((ext_vector_type(4)))short;
using f32x16=__attribute__((ext_vector_type(16)))float;
using u32x4=__attribute__((ext_vector_type(4)))unsigned;
constexpr int SEQ=2048,D=64,DM=4096,DMO=1024;
constexpr int NW=8,QBLK=32,QB=QBLK*NW,KVBLK=64,NQB=SEQ/QB;
__device__ __forceinline__ unsigned f2bf_(float f){unsigned u=__builtin_bit_cast(unsigned,f);return (u+0x7fffu+((u>>16)&1u))>>16;}
__device__ __forceinline__ int crow(int r,int hi){return (r&3)+8*(r>>2)+4*hi;}
#define SBAR() __builtin_amdgcn_sched_barrier(0)
__device__ __forceinline__ void cmask(f32x16&p0,f32x16&p1,int jb,int qrel,int hi){
  const float NEG=-INFINITY; int kb=64*jb+4*hi;
  #pragma unroll
  for(int r=0;r<16;++r){int kv=kb+(r&3)+8*(r>>2); if(kv>qrel)p0[r]=NEG; if(kv+32>qrel)p1[r]=NEG;}
}

__device__ __forceinline__ uint2 mld_asm(const unsigned*p){ uint2 v; asm volatile("global_load_dwordx2 %0, %1, off":"=v"(v):"v"(p):"memory"); return v; }
__device__ __forceinline__ void bmask(f32x16&p0,f32x16&p1,uint2 w,int hi){
  const float NEG=-INFINITY; const unsigned a=w.x>>(4*hi), b=w.y>>(4*hi);
  #pragma unroll
  for(int r=0;r<16;++r){const int bit=(r&3)+8*(r>>2); if(!((a>>bit)&1u))p0[r]=NEG; if(!((b>>bit)&1u))p1[r]=NEG;}
}
constexpr int NSLOT=3, SLOTB=8192;
constexpr int LDS_K=0, LDS_V=NSLOT*SLOTB, LDS_WS=2*NSLOT*SLOTB, LDS_OST=LDS_WS+NW*64*4, LDS_BYTES=LDS_OST+NW*4096;
constexpr float C2=0.125f*1.4426950408889634f;
__device__ __forceinline__ void glds16(const void*gsrc,unsigned lds_dst){unsigned keep;
  asm volatile("s_mov_b32 %0, m0\n\ts_mov_b32 m0, %2\n\ts_nop 0\n\tglobal_load_lds_dwordx4 %1, off\n\ts_mov_b32 m0, %0":"=&s"(keep):"v"(gsrc),"s"(lds_dst):"memory");}
__device__ __forceinline__ float max3f(float a,float b,float c){float r;asm("v_max3_f32 %0, %1, %2, %3":"=v"(r):"v"(a),"v"(b),"v"(c));return r;}
__device__ __forceinline__ float max2f(float a,float b){float r;asm("v_max_f32_e32 %0, %1, %2":"=v"(r):"v"(a),"v"(b));return r;}
__device__ __forceinline__ float fadd_s(float a,float b){float r;asm("v_add_f32_e32 %0, %1, %2":"=v"(r):"v"(a),"v"(b));return r;}
__device__ __forceinline__ float fsub_s(float a,float b){float r;asm("v_sub_f32_e32 %0, %1, %2":"=v"(r):"v"(a),"v"(b));return r;}
typedef float f32x2_t __attribute__((ext_vector_type(2))); typedef __bf16 bf16x2_t __attribute__((ext_vector_type(2)));
__device__ __forceinline__ unsigned cvtpk_s(float lo,float hi){f32x2_t v={lo,hi};bf16x2_t b=__builtin_convertvector(v,bf16x2_t);return __builtin_bit_cast(unsigned,b);}
#define WAIT_BAR(N) asm volatile("s_waitcnt vmcnt(" #N ") lgkmcnt(0)\n\ts_barrier":::"memory")

__device__ __forceinline__ void qkt(f32x16&p0,f32x16&p1,const char*Kslot,const bf16x8*qr,const f32x16&negm,int r32,int hi){
  const char*kb=Kslot+hi*1024+r32*16;
  #pragma unroll
  for(int d0=0;d0<4;++d0){
    const bf16x8 b0=*reinterpret_cast<const bf16x8*>(kb+d0*2048);
    const bf16x8 b1=*reinterpret_cast<const bf16x8*>(kb+d0*2048+512);
    if(d0==0){p0=__builtin_amdgcn_mfma_f32_32x32x16_bf16(b0,qr[0],negm,0,0,0);p1=__builtin_amdgcn_mfma_f32_32x32x16_bf16(b1,qr[0],negm,0,0,0);}
    else{p0=__builtin_amdgcn_mfma_f32_32x32x16_bf16(b0,qr[d0],p0,0,0,0);p1=__builtin_amdgcn_mfma_f32_32x32x16_bf16(b1,qr[d0],p1,0,0,0);}}
}
typedef __attribute__((address_space(3))) const char* lds_cptr;
typedef short v4i16_t __attribute__((ext_vector_type(4)));
__device__ __forceinline__ void kload8(bf16x8*kf,lds_cptr kp){
  kf[0]=*(const __attribute__((address_space(3))) bf16x8*)(kp);      kf[1]=*(const __attribute__((address_space(3))) bf16x8*)(kp+512);
  kf[2]=*(const __attribute__((address_space(3))) bf16x8*)(kp+2048); kf[3]=*(const __attribute__((address_space(3))) bf16x8*)(kp+2560);
  kf[4]=*(const __attribute__((address_space(3))) bf16x8*)(kp+4096); kf[5]=*(const __attribute__((address_space(3))) bf16x8*)(kp+4608);
  kf[6]=*(const __attribute__((address_space(3))) bf16x8*)(kp+6144); kf[7]=*(const __attribute__((address_space(3))) bf16x8*)(kp+6656);
}
__device__ __forceinline__ void kload2(bf16x8*kf,lds_cptr kp,int j){ kf[2*j]=*(const __attribute__((address_space(3))) bf16x8*)(kp+j*2048); kf[2*j+1]=*(const __attribute__((address_space(3))) bf16x8*)(kp+j*2048+512); }
__device__ __forceinline__ s16x4 vtr(lds_cptr p){ return __builtin_bit_cast(s16x4,__builtin_amdgcn_ds_read_tr16_b64_v4i16((__attribute__((address_space(3))) v4i16_t*)p)); }
__device__ __forceinline__ float rowmax(const f32x16&p0,const f32x16&p1){
  float a=max3f(p0[0],p0[1],p1[0]),b=max3f(p0[2],p0[3],p1[1]);a=max3f(a,p1[2],p1[3]);
  #pragma unroll
  for(int r=4;r<16;r+=4){a=max3f(a,p0[r],p0[r+1]);b=max3f(b,p0[r+2],p0[r+3]);a=max3f(a,p1[r],p1[r+1]);b=max3f(b,p1[r+2],p1[r+3]);}
  const float m=max2f(a,b);
  auto rr=__builtin_amdgcn_permlane32_swap(__float_as_uint(m),__float_as_uint(m),false,false);
  return max2f(__uint_as_float(rr[0]),__uint_as_float(rr[1]));
}
__device__ __forceinline__ void pv(f32x16*o,int vb,bf16x8 pa0,bf16x8 pa1,bf16x8 pa2,bf16x8 pa3){
  #pragma unroll
  for(int d0=0;d0<2;++d0){s16x4 lo[4],hi[4];
    #pragma unroll
    for(int ks=0;ks<4;++ks){
      asm volatile("ds_read_b64_tr_b16 %0,%1 offset:%c2":"=&v"(lo[ks]):"v"(vb),"i"(d0*4096+ks*1024):"memory");
      asm volatile("ds_read_b64_tr_b16 %0,%1 offset:%c2":"=&v"(hi[ks]):"v"(vb),"i"(d0*4096+ks*1024+512):"memory");}
    asm volatile("s_waitcnt lgkmcnt(0)":::"memory");SBAR();
    #define PK(k) (bf16x8){lo[k][0],lo[k][1],lo[k][2],lo[k][3],hi[k][0],hi[k][1],hi[k][2],hi[k][3]}
    o[d0]=__builtin_amdgcn_mfma_f32_32x32x16_bf16(pa0,PK(0),o[d0],0,0,0);
    o[d0]=__builtin_amdgcn_mfma_f32_32x32x16_bf16(pa1,PK(1),o[d0],0,0,0);
    o[d0]=__builtin_amdgcn_mfma_f32_32x32x16_bf16(pa2,PK(2),o[d0],0,0,0);
    o[d0]=__builtin_amdgcn_mfma_f32_32x32x16_bf16(pa3,PK(3),o[d0],0,0,0);
    #undef PK
  }
}

#ifndef ATTN_STORE16
#define ATTN_STORE16(p,v) (*(u32x4*)(p)=(v))
#endif
template<int THRL,bool MASKED> __device__ __forceinline__ void attn_unit(int wvx,int b,int qb,const bf16*Q,const bf16*__restrict__ K,const bf16*__restrict__ V,bf16*O,const unsigned*MASK,char*shm){
  int tid_=wvx*64+lane_id_(); asm volatile("":"+v"(tid_));
  const int tid=tid_,lane=tid&63,r32=lane&31,hi=lane>>5; const int wid=__builtin_amdgcn_readfirstlane(tid>>6);
  const long rowbase=(long)b*SEQ; const int q0=qb*QB;
  const bf16*Qw=Q+(rowbase+q0+wid*QBLK)*DM;
  const bf16*Kh=K+rowbase*DM,*Vh=V+rowbase*DM;
  const unsigned*mrow=MASK+(size_t)(rowbase+q0+wid*QBLK+r32)*64;
  #define MLD(tt) mld_asm(mrow+2*(tt))
  const unsigned lds0=(unsigned)(uintptr_t)shm;
  float*wsf=(float*)(shm+LDS_WS)+wid*64;
  const bf16*ksrc=Kh+(long)lane*DM+wid*8;
  const bf16*vsrc=Vh+(long)(16*(wid&3)+(lane>>2))*DM+(wid>>2)*32+(lane&3)*8;
  const unsigned kdst=lds0+LDS_K+wid*1024, vdst=lds0+LDS_V+wid*1024;
  #define DMA_K(t,slot) glds16(ksrc+(long)(t)*KVBLK*DM,(unsigned)__builtin_amdgcn_readfirstlane(kdst+(slot)))
  #define DMA_V(t,slot) glds16(vsrc+(long)(t)*KVBLK*DM,(unsigned)__builtin_amdgcn_readfirstlane(vdst+(slot)))
  const int vb0=(int)(lds0+LDS_V)+((lane>>4)&1)*32+(lane&3)*8+(4*hi+((lane&15)>>2))*64;
  const char*Kbase=shm+LDS_K; bf16x8 kf[8];
  const lds_cptr shm3=(lds_cptr)shm; const lds_cptr kp0=shm3+LDS_K+hi*1024+r32*16; const lds_cptr vp0=shm3+LDS_V+((lane>>4)&1)*32+(lane&3)*8+(4*hi+((lane&15)>>2))*64;
  const int NT=(q0+QB)/KVBLK;
  uint2 mw_cur=make_uint2(~0u,~0u), mw_next=make_uint2(~0u,~0u); if(MASKED){ mw_cur=MLD(0); mw_next=MLD(1); }
  DMA_K(0,0);DMA_V(0,0);DMA_K(1,SLOTB);
  bf16x8 qr[4];
  #pragma unroll
  for(int d0=0;d0<4;++d0)qr[d0]=*reinterpret_cast<const bf16x8*>(&Qw[(long)r32*DM+d0*16+hi*8]);
  float mhat=0.f,l_reg=0.f;f32x16 o[2];o[0]=f32x16{};o[1]=f32x16{};f32x16 negm=f32x16{};asm volatile("":"+v"(negm));
  const int qrel=wid*QBLK+r32;
  #define CMASK(P0,P1,t) do{ if(MASKED){bmask(P0,P1,mw_cur,hi);} else {int jb_=(t)-(NT-4); if(jb_>=0)cmask(P0,P1,jb_,qrel,hi);} }while(0)
  bool resc=false;
  #define START(P0,P1) do{ float rm=rowmax(P0,P1); if(MASKED)rm=max2f(rm,-64.f); resc=false; \
    { const float dl=rm; mhat=fadd_s(mhat,dl); \
      _Pragma("unroll") for(int r=0;r<16;++r){P0[r]=fsub_s(P0[r],dl);P1[r]=fsub_s(P1[r],dl);} \
      _Pragma("unroll") for(int r=0;r<16;++r)negm[r]=-mhat; asm volatile("":"+v"(negm)); } \
    _Pragma("unroll") for(int r=0;r<16;++r)P0[r]=__builtin_amdgcn_exp2f(P0[r]); }while(0)
  #define RESC() do{ if(resc){ asm volatile("s_waitcnt lgkmcnt(0)":::"memory"); \
      _Pragma("unroll") for(int d_=0;d_<2;++d_) _Pragma("unroll") for(int r=0;r<16;++r)o[d_][r]*=wsf[crow(r,hi)]; } }while(0)
  f32x16 pA0,pA1,pB0,pB1;
  int sl_prev=0,sl_cur=0,sl_next=SLOTB;
  #define ROT() do{sl_prev=sl_cur;sl_cur=sl_next;sl_next=(sl_next==(NSLOT-1)*SLOTB)?0:sl_next+SLOTB;}while(0)
  DMA_K(2,2*SLOTB);
  WAIT_BAR(3);
  qkt(pA0,pA1,Kbase,qr,negm,r32,hi);asm volatile("s_nop 15\n\ts_nop 7":"+v"(pA0),"+v"(pA1));CMASK(pA0,pA1,0);
  START(pA0,pA1);
  _Pragma("unroll") for(int r=0;r<16;++r)pA1[r]=__builtin_amdgcn_exp2f(pA1[r]);
  WAIT_BAR(0);
  DMA_K(3,0);DMA_V(1,SLOTB);
  ROT();
  kload8(kf,kp0+sl_cur);
  WAIT_BAR(2);
  s16x4 vlo[8],vhi[8]; u32x4 pw0,pw1,pw2,pw3;
  #define PKW(P,B) cvtpk_s(P[B],P[B+1])
  #define PAF(k) __builtin_bit_cast(bf16x8,pw##k)
  #define VFR(i) (bf16x8){vlo[i][0],vlo[i][1],vlo[i][2],vlo[i][3],vhi[i][0],vhi[i][1],vhi[i][2],vhi[i][3]}
  #define PIN(x) asm volatile("":"+v"(x))
  #define MX3(a,b,c) __builtin_fmaxf(__builtin_fmaxf((a),(b)),(c))
  #define GAPA(MF,A0,A1,A2,A3,W0,W1,PW) do{ MF; sacc+=A0; sacc+=A1; sacc+=A2; sacc+=A3; PIN(sacc); W0; W1; PIN(PW); SBAR(); }while(0)
  #define EX(v) __builtin_amdgcn_exp2f(v)
  #define GAPB(MF,X,B) do{ MF; X[B]=EX(X[B]); X[B+1]=EX(X[B+1]); X[B+2]=EX(X[B+2]); X[B+3]=EX(X[B+3]); PIN(X); SBAR(); }while(0)
  #define VRD(i) do{ vlo[i]=vtr(vp_+(((i)>>2)*4096+((i)&3)*1024)); vhi[i]=vtr(vp_+(((i)>>2)*4096+((i)&3)*1024+512)); }while(0)
  #define KRD(G,j) do{ if(G){ kload2(kf,kp0+sl_next,j); SBAR(); } }while(0)
  #define STEP(C0,C1,P0,P1,t,GK,GV,GL) do{ SBAR(); if(MASKED){ mw_cur=mw_next; if((t)+1<NT) mw_next=MLD((t)+1); } \
    const lds_cptr vp_=vp0+sl_prev; \
    VRD(0); SBAR(); float sacc=(P0[0]+P0[1]); \
    GAPA(C0=__builtin_amdgcn_mfma_f32_32x32x16_bf16(kf[0],qr[0],negm,0,0,0), P0[2],P0[3],P0[4],P0[5],     pw0[0]=PKW(P0,0), pw0[1]=PKW(P0,2), pw0); \
    VRD(4); SBAR(); GAPA(C1=__builtin_amdgcn_mfma_f32_32x32x16_bf16(kf[1],qr[0],negm,0,0,0), P0[6],P0[7],P0[8],P0[9],     pw0[2]=PKW(P0,4), pw0[3]=PKW(P0,6), pw0); \
    VRD(1); SBAR(); GAPA(C0=__builtin_amdgcn_mfma_f32_32x32x16_bf16(kf[2],qr[1],C0,0,0,0),   P0[10],P0[11],P0[12],P0[13], pw1[0]=PKW(P0,8), pw1[1]=PKW(P0,10), pw1); \
    VRD(5); SBAR(); GAPA(C1=__builtin_amdgcn_mfma_f32_32x32x16_bf16(kf[3],qr[1],C1,0,0,0),   P0[14],P0[15],P1[0],P1[1],   pw1[2]=PKW(P0,12),pw1[3]=PKW(P0,14), pw1); \
    VRD(2); SBAR(); GAPA(C0=__builtin_amdgcn_mfma_f32_32x32x16_bf16(kf[4],qr[2],C0,0,0,0),   P1[2],P1[3],P1[4],P1[5],     pw2[0]=PKW(P1,0), pw2[1]=PKW(P1,2), pw2); \
    VRD(6); SBAR(); GAPA(C1=__builtin_amdgcn_mfma_f32_32x32x16_bf16(kf[5],qr[2],C1,0,0,0),   P1[6],P1[7],P1[8],P1[9],     pw2[2]=PKW(P1,4), pw2[3]=PKW(P1,6), pw2); \
    VRD(3); SBAR(); GAPA(C0=__builtin_amdgcn_mfma_f32_32x32x16_bf16(kf[6],qr[3],C0,0,0,0),   P1[10],P1[11],P1[12],P1[13], pw3[0]=PKW(P1,8), pw3[1]=PKW(P1,10), pw3); \
    VRD(7); SBAR(); GAPA(C1=__builtin_amdgcn_mfma_f32_32x32x16_bf16(kf[7],qr[3],C1,0,0,0),   P1[14],P1[15],0.f,0.f,       pw3[2]=PKW(P1,12),pw3[3]=PKW(P1,14), pw3); \
    l_reg+=sacc; \
    if(GK){DMA_K((t)+3,sl_cur);} if(GV){DMA_V((t)+1,sl_next);} \
    CMASK(C0,C1,t); \
    { float a=MX3(C0[0],C0[1],C1[0]),b=MX3(C0[2],C0[3],C1[1]); a=MX3(a,C1[2],C1[3]); \
      _Pragma("unroll") for(int r=4;r<16;r+=4){a=MX3(a,C0[r],C0[r+1]);b=MX3(b,C0[r+2],C0[r+3]);a=MX3(a,C1[r],C1[r+1]);b=MX3(b,C1[r+2],C1[r+3]);} \
      float rm=__builtin_fmaxf(a,b); { auto rr=__builtin_amdgcn_permlane32_swap(__float_as_uint(rm),__float_as_uint(rm),false,false); rm=__builtin_fmaxf(__uint_as_float(rr[0]),__uint_as_float(rr[1])); } \
      resc=false; \
      if(__builtin_expect(__any(rm>(float)THRL),0)){ const float dl=__builtin_fmaxf(rm,0.f); mhat+=dl; \
        _Pragma("unroll") for(int r=0;r<16;++r){C0[r]-=dl;C1[r]-=dl;} \
        _Pragma("unroll") for(int r=0;r<16;++r)negm[r]=-mhat; asm volatile("":"+v"(negm)); \
        const float f=__builtin_amdgcn_exp2f(-dl); l_reg*=f; if(hi==0)wsf[r32]=f; resc=true; } } \
    SBAR(); \
    GAPB(o[0]=__builtin_amdgcn_mfma_f32_32x32x16_bf16(PAF(0),VFR(0),o[0],0,0,0), C0,0); \
    GAPB(o[1]=__builtin_amdgcn_mfma_f32_32x32x16_bf16(PAF(0),VFR(4),o[1],0,0,0), C0,4); \
    KRD(GL,0); GAPB(o[0]=__builtin_amdgcn_mfma_f32_32x32x16_bf16(PAF(1),VFR(1),o[0],0,0,0), C0,8); \
    KRD(GL,1); GAPB(o[1]=__builtin_amdgcn_mfma_f32_32x32x16_bf16(PAF(1),VFR(5),o[1],0,0,0), C0,12); \
    KRD(GL,2); GAPB(o[0]=__builtin_amdgcn_mfma_f32_32x32x16_bf16(PAF(2),VFR(2),o[0],0,0,0), C1,0); \
    KRD(GL,3); GAPB(o[1]=__builtin_amdgcn_mfma_f32_32x32x16_bf16(PAF(2),VFR(6),o[1],0,0,0), C1,4); \
    GAPB(o[0]=__builtin_amdgcn_mfma_f32_32x32x16_bf16(PAF(3),VFR(3),o[0],0,0,0), C1,8); \
    GAPB(o[1]=__builtin_amdgcn_mfma_f32_32x32x16_bf16(PAF(3),VFR(7),o[1],0,0,0), C1,12); \
    }while(0)
  int t=1;
  #undef CMASK
  #define CMASK(P0,P1,t) do{ if(MASKED){bmask(P0,P1,mw_cur,hi);} }while(0)
  for(;t+5<NT;t+=2){
    STEP(pB0,pB1,pA0,pA1,t,true,true,true);     WAIT_BAR(2); RESC(); ROT();
    STEP(pA0,pA1,pB0,pB1,t+1,true,true,true);   WAIT_BAR(2); RESC(); ROT();
  }
  #undef CMASK
  #define CMASK(P0,P1,t) do{ if(MASKED){bmask(P0,P1,mw_cur,hi);} else {int jb_=(t)-(NT-4); if(jb_>=0)cmask(P0,P1,jb_,qrel,hi);} }while(0)
  #define ENDW(tt) do{ if((tt)+3<NT){WAIT_BAR(2);} else if((tt)+2<NT){WAIT_BAR(1);} else {WAIT_BAR(0);} }while(0)
  for(;t+1<NT;t+=2){
    STEP(pB0,pB1,pA0,pA1,t,(t+3<NT),(t+1<NT),(t+1<NT));       ENDW(t);   RESC(); ROT();
    STEP(pA0,pA1,pB0,pB1,t+1,(t+4<NT),(t+2<NT),(t+2<NT));     ENDW(t+1); RESC(); ROT();
  }
  STEP(pB0,pB1,pA0,pA1,NT-1,false,false,false); RESC();
  { float sacc=pB0[0]+pB0[1]; _Pragma("unroll") for(int r=2;r<16;++r)sacc+=pB0[r]; _Pragma("unroll") for(int r=0;r<16;++r)sacc+=pB1[r]; l_reg+=sacc;
    pw0=(u32x4){PKW(pB0,0),PKW(pB0,2),PKW(pB0,4),PKW(pB0,6)};pw1=(u32x4){PKW(pB0,8),PKW(pB0,10),PKW(pB0,12),PKW(pB0,14)};pw2=(u32x4){PKW(pB1,0),PKW(pB1,2),PKW(pB1,4),PKW(pB1,6)};pw3=(u32x4){PKW(pB1,8),PKW(pB1,10),PKW(pB1,12),PKW(pB1,14)};
    SBAR(); pv(o,vb0+sl_cur,PAF(0),PAF(1),PAF(2),PAF(3)); }
  #undef PKW
  #undef PAF
  #undef VFR
  #undef PIN
  #undef MX3
  #undef GAPA
  #undef GAPB
  #undef EX
  #undef VRD
  #undef KRD
  #undef STEP
  #undef ENDW
  {auto rr=__builtin_amdgcn_permlane32_swap(__float_as_uint(l_reg),__float_as_uint(l_reg),false,false);l_reg=__uint_as_float(rr[0])+__uint_as_float(rr[1]);}
  if(hi==0)wsf[32+r32]=l_reg;asm volatile("s_waitcnt lgkmcnt(0)":::"memory");
  float rli[16];
  #pragma unroll
  for(int r=0;r<16;++r)rli[r]=__builtin_amdgcn_rcpf(wsf[32+crow(r,hi)]);
  bf16*Ow=O+(rowbase+q0+wid*QBLK)*DMO;
  { bf16*stg=(bf16*)(shm+LDS_OST)+wid*2048;
    #pragma unroll
    for(int r=0;r<16;++r){const int orow=crow(r,hi);
      #pragma unroll
      for(int d0=0;d0<2;++d0)stg[orow*64+d0*32+r32]=(bf16)f2bf_(o[d0][r]*rli[r]);}
    asm volatile("s_waitcnt lgkmcnt(0)":::"memory");
    #pragma unroll
    for(int i=0;i<4;++i){const int row=i*8+(lane>>3),ch=lane&7; const u32x4 v=*(const u32x4*)(stg+row*64+ch*8); ATTN_STORE16(Ow+(long)row*DMO+ch*8,v);} }
  asm volatile("s_waitcnt lgkmcnt(0)\n\ts_barrier":::"memory");
  #undef DMA_K
  #undef DMA_V
  #undef MLD
  #undef CMASK
  #undef START
  #undef RESC
  #undef ROT
}
constexpr int ATTN_LDS_BYTES=LDS_BYTES;
#undef SBAR
#undef WAIT_BAR
}
#define GAS __attribute__((address_space(1)))
#define LAS __attribute__((address_space(3)))
typedef unsigned short bf16;
typedef unsigned v4u __attribute__((ext_vector_type(4)));
typedef float f32x4 __attribute__((ext_vector_type(4)));
typedef short bf16x8 __attribute__((ext_vector_type(8)));
typedef GAS unsigned gu32;
typedef GAS unsigned long long gu64;
#define RLX_AGENT __ATOMIC_RELAXED, __HIP_MEMORY_SCOPE_AGENT
#define LDS_WAIT() asm volatile("s_waitcnt lgkmcnt(0)" ::: "memory")
#define VM_WAIT() asm volatile("s_waitcnt vmcnt(0)" ::: "memory")
__device__ __forceinline__ unsigned long long rt() { return __builtin_amdgcn_s_memrealtime(); }
__device__ __forceinline__ unsigned f2bf(float f) { unsigned u = __builtin_bit_cast(unsigned, f); return (u + 0x7fffu + ((u >> 16) & 1u)) >> 16; }
__device__ __forceinline__ unsigned pk2(float lo, float hi) { return f2bf(lo) | (f2bf(hi) << 16); }
__device__ __forceinline__ int tid_of(int wvx) { return wvx * 64 + lane_id_(); }
#define XB_TMO      128
#define XB_XCNT(j)  (256  + 64 * (j))
#define XB_XSUB(j)  (1280 + 64 * (j))
#define XB_XGEN(j)  (2304 + 64 * (j))
#define XB_TOP      3328
#define XB_TOPGEN   3392
#define XCD_BAR_WORDS 3456
#define XB_SPIN_CAP (1u << 20)

__device__ __forceinline__ unsigned xb_ld(unsigned* p)              { return __hip_atomic_load(p, __ATOMIC_RELAXED, __HIP_MEMORY_SCOPE_AGENT); }
__device__ __forceinline__ unsigned xb_add(unsigned* p, unsigned v) { return __hip_atomic_fetch_add(p, v, __ATOMIC_RELAXED, __HIP_MEMORY_SCOPE_AGENT); }
__device__ __forceinline__ unsigned xb_xcc_id() { return (unsigned)__builtin_amdgcn_s_getreg((3 << 11) | 20) & 0xFu; }
#define XB_SPIN(cond, bar) do { unsigned _sp = 0; while (cond) { __builtin_amdgcn_s_sleep(1); \
    if ((++_sp & 255u) == 0u) { if (xb_ld(&(bar)[XB_TMO])) break; if (_sp > XB_SPIN_CAP) { atomicAdd(&(bar)[XB_TMO], 1u); break; } } } } while (0)

struct XcdBarrier {
    unsigned* bar; unsigned x;
    volatile LAS unsigned* st;
};

__device__ __forceinline__ XcdBarrier xcd_barrier_post(unsigned* bar, volatile LAS unsigned* st) {
    XcdBarrier b; b.bar = bar; b.x = xb_xcc_id(); b.st = st;
    if (threadIdx.x == 0) (void)xb_add(&bar[XB_XCNT(b.x)], 1u);
    return b;
}
__device__ __forceinline__ void xcd_barrier_complete(unsigned* bar, unsigned x, unsigned& nloc, unsigned& nx) {
    const unsigned G = gridDim.x * gridDim.y * gridDim.z;
    unsigned sum, cnt, mine, sp = 0u;
    for (;;) {
        sum = 0u; cnt = 0u; mine = 0u;
#pragma unroll
        for (unsigned j = 0; j < 16; ++j) { const unsigned c = xb_ld(&bar[XB_XCNT(j)]); sum += c; cnt += (c > 0u) ? 1u : 0u; mine = (j == x) ? c : mine; }
        if (sum == G) break;
        __builtin_amdgcn_s_sleep(1);
        if ((++sp & 255u) == 0u) { if (xb_ld(&bar[XB_TMO])) break; if (sp > XB_SPIN_CAP) { atomicAdd(&bar[XB_TMO], 1u); break; } }
    }
    nloc = mine > 0u ? mine : 1u; nx = cnt > 0u ? cnt : 1u;
}

__device__ __attribute__((noinline)) void xcd_barrier_fn(unsigned* bar_, unsigned x_, volatile LAS unsigned* st_, bool leader_) {
    XcdBarrier b; b.bar = bar_; b.x = x_; b.st = st_;
    asm volatile("s_waitcnt vmcnt(0)" ::: "memory");
    __syncthreads();
    if (leader_) {
        unsigned* bar = b.bar;
        __builtin_amdgcn_s_waitcnt(0);
        unsigned nloc = b.st[0], nx = b.st[1];
        if (nloc == 0u) { xcd_barrier_complete(bar, b.x, nloc, nx); b.st[0] = nloc; b.st[1] = nx; }
        const unsigned old = xb_add(&bar[XB_XSUB(b.x)], 1u);
        const unsigned gen = old / nloc;
        if (old + 1u == (gen + 1u) * nloc) {
            __builtin_amdgcn_fence(__ATOMIC_RELEASE, "agent");
            asm volatile("s_waitcnt vmcnt(0)" ::: "memory");
            const unsigned og = xb_add(&bar[XB_TOP], 1u);
            const unsigned tg = og / nx;
            if (og + 1u == (tg + 1u) * nx) xb_add(&bar[XB_TOPGEN], 1u);
            else XB_SPIN(xb_ld(&bar[XB_TOPGEN]) == tg, bar);
            __builtin_amdgcn_fence(__ATOMIC_ACQUIRE, "agent");
            xb_add(&bar[XB_XGEN(b.x)], 1u);
            asm volatile("s_waitcnt vmcnt(0)" ::: "memory");
        } else {
            XB_SPIN(xb_ld(&bar[XB_XGEN(b.x)]) == gen, bar);
            __builtin_amdgcn_fence(__ATOMIC_ACQUIRE, "agent");
            asm volatile("s_waitcnt vmcnt(0)" ::: "memory");
        }
    }
    __syncthreads();
}


constexpr int NB = 16, SEQ = 2048, T = NB * SEQ, D = 1024, DEPTH = 4, NHC = 4096, NEXP = 32, NWAVES = 8;
constexpr int NIN = 3920;
constexpr float LN_EPS = 1e-5f, DN_ALPHA = 1.6817928305074290f;
constexpr int RPAD = T * 4 + NEXP * 256;
constexpr int HC_MQ = 0, HC_MK = 256, HC_MV = 512, HC_MO = 768, HC_DQ = 1024, HC_DK = 1536, HC_DV = 2048, HC_SQ = 2560, HC_SK = 2816, HC_SV = 3072, HC_XQ = 3328, HC_XK = 3840, HC_MI = 3904, HC_MF = 3908, HC_XW = 3912;
constexpr size_t MiB = 1u << 20;
constexpr size_t WS_CTL = 0, CTL_ZERO_BYTES = 2 * MiB;
constexpr size_t WS_MOD = 2 * MiB;
constexpr size_t WS_LAM = WS_MOD + 7 * MiB / 4;
constexpr size_t WS_RWT = 4 * MiB;
constexpr size_t WS_CS = 8 * MiB;
constexpr size_t WS_WIN = 16 * MiB;
constexpr size_t WS_WOUT = 48 * MiB;
constexpr size_t WS_W1 = 64 * MiB;
constexpr size_t WS_W2 = 576 * MiB;
constexpr size_t WS_XB = 832 * MiB;
constexpr size_t WS_U = 960 * MiB;
constexpr size_t WS_H = 1024 * MiB;
constexpr size_t WS_QKC = 1280 * MiB;
constexpr size_t WS_XKP = 1312 * MiB;
constexpr size_t WS_MASK = 1316 * MiB;
constexpr size_t WS_TOK = 1324 * MiB;
constexpr size_t WS_MIX = 1344 * MiB;
constexpr size_t WS_Y = 1408 * MiB;
constexpr size_t WS_SC = 1472 * MiB;
constexpr size_t WS_XG = 1728 * MiB;
constexpr size_t WS_HM = 2000 * MiB;
constexpr size_t WS_YM = 2272 * MiB;
constexpr size_t WS_END = 2544 * MiB;
constexpr int CW_CNT = 1024;
constexpr int CW_BAR = 16384;
constexpr int RING_BYTES = 131072, TAB_OFF = RING_BYTES, MISC_OFF = RING_BYTES + 4096, LDS_BYTES = 147456;
constexpr int NPH = 10, NSTEPS = 2 + NPH * DEPTH;
enum { PH_IN = 0, PH_POST, PH_MIXA, PH_SEL, PH_DSA, PH_OUT, PH_ROW1, PH_G1, PH_G2, PH_ROW2 };

typedef unsigned short us8 __attribute__((ext_vector_type(8)));
__device__ __forceinline__ float bf2f(bf16 h) { return __uint_as_float((unsigned)h << 16); }
#define DPPF(x, c) __int_as_float(__builtin_amdgcn_update_dpp(0, __float_as_int(x), c, 0xF, 0xF, true))
__device__ __forceinline__ float wave_sum(float v) {
    v += DPPF(v, 0xB1); v += DPPF(v, 0x4E); v += DPPF(v, 0x141); v += DPPF(v, 0x140);
    return (__int_as_float(__builtin_amdgcn_readlane(__float_as_int(v), 0)) + __int_as_float(__builtin_amdgcn_readlane(__float_as_int(v), 16))) + (__int_as_float(__builtin_amdgcn_readlane(__float_as_int(v), 32)) + __int_as_float(__builtin_amdgcn_readlane(__float_as_int(v), 48)));
}
__device__ __forceinline__ float wave_max(float v) {
    v = fmaxf(v, DPPF(v, 0xB1)); v = fmaxf(v, DPPF(v, 0x4E)); v = fmaxf(v, DPPF(v, 0x141)); v = fmaxf(v, DPPF(v, 0x140));
    return fmaxf(fmaxf(__int_as_float(__builtin_amdgcn_readlane(__float_as_int(v), 0)), __int_as_float(__builtin_amdgcn_readlane(__float_as_int(v), 16))), fmaxf(__int_as_float(__builtin_amdgcn_readlane(__float_as_int(v), 32)), __int_as_float(__builtin_amdgcn_readlane(__float_as_int(v), 48))));
}
__device__ __forceinline__ float shx(float v, int lane, int m) { return __int_as_float(__builtin_amdgcn_ds_bpermute((lane ^ m) << 2, __float_as_int(v))); }
__device__ __forceinline__ int shxi(int v, int lane, int m) { return __builtin_amdgcn_ds_bpermute((lane ^ m) << 2, v); }
__device__ __forceinline__ float shup(float v, int lane, int o) { return __int_as_float(__builtin_amdgcn_ds_bpermute(((lane - o) & 63) << 2, __float_as_int(v))); }
__device__ __forceinline__ int shupi(int v, int lane, int o) { return __builtin_amdgcn_ds_bpermute(((lane - o) & 63) << 2, v); }
__device__ __forceinline__ float sigmoidf_(float x) { return 1.0f / (1.0f + __expf(-x)); }
struct Ctx {
    LAS unsigned char* lds;
    int tid, lane, wave, gw, ngw;
    const float* in[25];
    float* out; unsigned char* ws;
};
#define WSP(type, off) ((type*)(C.ws + (off)))
enum { I_X = 0, I_C, I_POS, I_WIN, I_GATEB, I_CONVW, I_CONVB, I_MNORM, I_DFLAM, I_DFNORM, I_IDXG, I_IDXB, I_WOUT, I_ADAW, I_ADAB, I_LN1G, I_LN1B, I_LN2G, I_LN2B, I_RW, I_RB, I_W1, I_B1, I_W2, I_B2 };

__device__ __forceinline__ int in_dest_col(int n) {
    auto rp = [](int j) { const int hd = j >> 6, d = j & 63; return hd * 64 + ((d < 32) ? 2 * d : 2 * (d - 32) + 1); };
    if (n < 256) return HC_MQ + n;
    if (n < 512) return HC_MK + (n - 256);
    if (n < 768) return HC_MV + (n - 512);
    if (n < 772) return HC_MI + (n - 768);
    if (n < 776) return HC_MF + (n - 772);
    if (n < 1032) return HC_MO + (n - 776);
    if (n < 1544) return HC_DQ + rp(n - 1032);
    if (n < 2056) return HC_DK + rp(n - 1544);
    if (n < 2568) return HC_DV + (n - 2056);
    if (n < 2824) return HC_SQ + rp(n - 2568);
    if (n < 3080) return HC_SK + rp(n - 2824);
    if (n < 3336) return HC_SV + (n - 3080);
    if (n < 3848) return HC_XQ + rp(n - 3336);
    if (n < 3912) return HC_XK + (n - 3848);
    return HC_XW + (n - 3912);
}
template <class F> __device__ __forceinline__ void transpose_item(const float* W, int ldw, int K, int nvalid, int k0, int n0, bf16* WT, LAS float* scr, int lane, F drow) {
    const int nn = n0 + (lane & 31); const bool ok = nn < nvalid;
    float tv_[32];
#pragma unroll
    for (int i = 0; i < 32; ++i) { const int kk = 2 * i + (lane >> 5); tv_[i] = ok ? W[(size_t)(k0 + kk) * ldw + nn] : 0.f; }
#pragma unroll
    for (int i = 0; i < 32; ++i) { const int kk = 2 * i + (lane >> 5); scr[kk * 33 + (lane & 31)] = tv_[i]; }
    LDS_WAIT(); asm volatile("" ::: "memory");
    const int c = lane & 7;
#pragma unroll
    for (int j = 0; j < 4; ++j) { const int n = (lane >> 3) + 8 * j; const LAS float* s = scr + (8 * c) * 33 + n;
        v4u o; o.x = pk2(s[0 * 33], s[1 * 33]); o.y = pk2(s[2 * 33], s[3 * 33]); o.z = pk2(s[4 * 33], s[5 * 33]); o.w = pk2(s[6 * 33], s[7 * 33]);
        if (n0 + n < nvalid) *(GAS v4u*)(WT + (size_t)drow(n0 + n) * K + k0 + 8 * c) = o; }
    LDS_WAIT(); asm volatile("" ::: "memory");
}

template <class F> __device__ __forceinline__ void transpose_item_f8(const float* W, int ldw, int K, int nvalid, int k0, int n0, unsigned char* WT8, LAS float* scr, int lane, float sc, F drow) {
    const int nn = n0 + (lane & 31); const bool ok = nn < nvalid;
    float tv_[32];
#pragma unroll
    for (int i = 0; i < 32; ++i) { const int kk = 2 * i + (lane >> 5); tv_[i] = ok ? W[(size_t)(k0 + kk) * ldw + nn] : 0.f; }
#pragma unroll
    for (int i = 0; i < 32; ++i) { const int kk = 2 * i + (lane >> 5); scr[kk * 33 + (lane & 31)] = tv_[i]; }
    LDS_WAIT(); asm volatile("" ::: "memory");
    const int c = lane & 7;
#pragma unroll
    for (int j = 0; j < 4; ++j) { const int n = (lane >> 3) + 8 * j; const LAS float* s = scr + (8 * c) * 33 + n;
        typedef unsigned u32x2_ __attribute__((ext_vector_type(2))); u32x2_ o; o.x = pg8::pk4_fp8(s[0 * 33], s[1 * 33], s[2 * 33], s[3 * 33], sc); o.y = pg8::pk4_fp8(s[4 * 33], s[5 * 33], s[6 * 33], s[7 * 33], sc);
        if (n0 + n < nvalid) *(GAS u32x2_*)(WT8 + (size_t)drow(n0 + n) * K + k0 + 8 * c) = o; }
    LDS_WAIT(); asm volatile("" ::: "memory");
}
struct Args { const float* in[25]; float* out; unsigned char* ws; int s_lo, s_hi, li, pad; };
typedef __attribute__((address_space(4))) const Args CArgs;
__device__ __forceinline__ CArgs* kargs() { CArgs* p = (CArgs*)__builtin_amdgcn_kernarg_segment_ptr(); asm volatile("" : "+s"(p)); return p; }
__device__ __forceinline__ LAS unsigned char* lds_launder(LAS unsigned char* q) { unsigned v = (unsigned)(size_t)q; asm volatile("" : "+s"(v)); return (LAS unsigned char*)(size_t)v; }
#define WS(type, off) ((type*)(A->ws + (off)))
#define TIDX CArgs* A = kargs(); int tid_ = tid_of(wvx); asm volatile("" : "+v"(tid_)); const int tid = tid_, lane = tid & 63, wave = __builtin_amdgcn_readfirstlane(tid >> 6); const int gw = blockIdx.x * NWAVES + wave, ngw = gridDim.x * NWAVES; (void)lane; (void)gw; (void)ngw

__device__ __forceinline__ void pro_a(LAS unsigned char* lds, int wvx) {
    TIDX;
    LAS float* scr = (LAS float*)(lds + wave * 16384);
    constexpr int IT_IN = 16 * 123, IT_OUT = 16 * 32, IT_W1 = 16 * 64, IT_W2 = 16 * 32;
    constexpr int N_IN = DEPTH * IT_IN, N_OUT = DEPTH * IT_OUT, N_W1 = DEPTH * NEXP * IT_W1, N_W2 = DEPTH * NEXP * IT_W2;
    constexpr int NITEMS = N_IN + N_OUT;
    for (int it = gw; it < NITEMS; it += ngw) {
        int r = it;
        if (r < N_IN) { const int l = r / IT_IN, q = r % IT_IN, kb = q / 123, nb = q % 123;
            transpose_item(A->in[I_WIN] + (size_t)l * D * NIN, NIN, D, NIN, kb * 64, nb * 32, WS(bf16, WS_WIN) + (size_t)l * NHC * D, scr, lane, [](int n) { return in_dest_col(n); }); continue; }
        r -= N_IN;
        { const int l = r / IT_OUT, q = r % IT_OUT, kb = q / 32, nb = q % 32;
            transpose_item(A->in[I_WOUT] + (size_t)l * D * D, D, D, D, kb * 64, nb * 32, WS(bf16, WS_WOUT) + (size_t)l * D * D, scr, lane, [](int n) { return n; }); }
    }
    {
        constexpr int JW1 = 16 * 32, JW2 = 16 * 16, M_W1 = DEPTH * NEXP * JW1, M_W2 = DEPTH * NEXP * JW2, NX = M_W1 + M_W2;
        __syncthreads();
        LAS float* sx = (LAS float*)(lds + wave * 16640);
        for (int it = gw; it < NX; it += ngw) {
            int r = it; const float* src; int ldw, k0, n0; unsigned char* dst; const bool w1 = r < M_W1;
            if (w1) { const int le = r / JW1, q = r % JW1; k0 = (q / 32) * 64; n0 = (q % 32) * 64; ldw = 2048; src = A->in[I_W1] + (size_t)le * D * 2048; dst = WS(unsigned char, WS_W1) + (size_t)le * 2048 * D; }
            else { r -= M_W1; const int le = r / JW2, q = r % JW2; k0 = (q / 16) * 64; n0 = (q % 16) * 64; ldw = D; src = A->in[I_W2] + (size_t)le * D * D; dst = WS(unsigned char, WS_W2) + (size_t)le * D * D; }
            float tv_[64];
#pragma unroll
            for (int i = 0; i < 64; ++i) tv_[i] = src[(size_t)(k0 + i) * ldw + n0 + lane];
#pragma unroll
            for (int i = 0; i < 64; ++i) sx[i * 65 + lane] = tv_[i];
            LDS_WAIT(); asm volatile("" ::: "memory");
            const int c = lane & 7;
#pragma unroll
            for (int j = 0; j < 8; ++j) { const int nl = (lane >> 3) + 8 * j, n = n0 + nl; const LAS float* s = sx + (8 * c) * 65 + nl;
                typedef unsigned u32x2_ __attribute__((ext_vector_type(2))); u32x2_ o; o.x = pg8::pk4_fp8(s[0 * 65], s[1 * 65], s[2 * 65], s[3 * 65], 256.0f); o.y = pg8::pk4_fp8(s[4 * 65], s[5 * 65], s[6 * 65], s[7 * 65], 256.0f);
                const int up = n >> 10, jj = n & 1023; const int drow = w1 ? ((jj >> 7) * 256 + up * 128 + (jj & 127)) : n;
                *(GAS u32x2_*)(dst + (size_t)drow * D + k0 + 8 * c) = o; }
            LDS_WAIT(); asm volatile("" ::: "memory");
        }
    }
    for (int r = gw; r < DEPTH * (NHC - NIN); r += ngw) { const int l = r / (NHC - NIN), row = NIN + r % (NHC - NIN);
        GAS v4u* p = (GAS v4u*)(WS(bf16, WS_WIN) + ((size_t)l * NHC + row) * D) + lane; p[0] = (v4u){0u, 0u, 0u, 0u}; p[64] = (v4u){0u, 0u, 0u, 0u}; }
    for (int idx = blockIdx.x * 512 + tid; idx < T * 32; idx += gridDim.x * 512) {
        const int tok = idx >> 5, i = idx & 31;
        const double inv = exp(-(double)i * (9.210340371976184 / 32.0));
        const double ang = (double)((const int*)A->in[I_POS])[tok] * inv;
        const double rev = ang * 0.15915494309189535;
        const float fr = (float)(rev - rint(rev));
        float2 v; v.x = __builtin_amdgcn_cosf(fr); v.y = __builtin_amdgcn_sinf(fr);
        WS(float2, WS_CS)[idx] = v;
    }
    for (int idx = blockIdx.x * 512 + tid; idx < DEPTH * NEXP * D; idx += gridDim.x * 512) {
        const int l = idx / (NEXP * D), r = idx % (NEXP * D), e = r / D, d = r % D;
        WS(float, WS_RWT)[idx] = A->in[I_RW][((size_t)l * D + d) * NEXP + e];
    }
    if (blockIdx.x == 0 && wave == 0) {
        for (int l = 0; l < DEPTH; ++l) { const float* lf = A->in[I_DFLAM] + l * 256;
            const float a = wave_sum(lf[lane] * lf[64 + lane]), b = wave_sum(lf[128 + lane] * lf[192 + lane]);
            if (lane == 0) WS(float, WS_LAM)[l] = __expf(a) - __expf(b) + (0.8f - 0.6f * __expf(-0.3f * (float)l)); }
    }
    __syncthreads();
    if (blockIdx.x < (DEPTH * 6144) / 512) {
        LAS float* ca = (LAS float*)lds;
        for (int i = tid; i < NB * D; i += 512) { const float v = A->in[I_C][i]; ca[i] = v / (1.0f + __expf(-v)); }
        __syncthreads();
        const int col = blockIdx.x * 512 + tid, l = col / 6144, m = col % 6144;
        const float* w = A->in[I_ADAW] + (size_t)l * D * 6144 + m;
        float acc[NB];
#pragma unroll
        for (int b = 0; b < NB; ++b) acc[b] = 0.f;
        for (int d = 0; d < D; ++d) { const float wv = w[(size_t)d * 6144];
#pragma unroll
            for (int b = 0; b < NB; ++b) acc[b] += ca[b * D + d] * wv; }
        const float bias = A->in[I_ADAB][col];
#pragma unroll
        for (int b = 0; b < NB; ++b) WS(float, WS_MOD)[((size_t)l * NB + b) * 6144 + m] = acc[b] + bias;
        __syncthreads();
    }
}
__device__ __forceinline__ void pro_b(int wvx) {
    TIDX;
    for (int tok = gw; tok < T; tok += ngw) {
        const int b = tok / SEQ; const float* mod = WS(float, WS_MOD) + (size_t)b * 6144;
        const GAS f32x4* xr = (const GAS f32x4*)(A->in[I_X] + (size_t)tok * D) + lane;
        GAS unsigned long long* o8 = (GAS unsigned long long*)(WS(bf16, WS_U) + (size_t)tok * D) + lane;
#pragma unroll
        for (int j = 0; j < 4; ++j) { const f32x4 x = xr[64 * j]; const f32x4 sh = *(const f32x4*)(mod + 4 * lane + 256 * j), sc = *(const f32x4*)(mod + 1024 + 4 * lane + 256 * j);
            const f32x4 u = x * (1.0f + sc) + sh; o8[64 * j] = (unsigned long long)pk2(u.x, u.y) | ((unsigned long long)pk2(u.z, u.w) << 32); }
    }
}
__device__ __forceinline__ void ph_post(int l, int wvx) {
    TIDX;
    const bf16* H = WS(bf16, WS_H); bf16* XKP = WS(bf16, WS_XKP); bf16* QKC = WS(bf16, WS_QKC);
    const float* cw = A->in[I_CONVW] + (size_t)l * 4 * 512; const float* cb = A->in[I_CONVB] + (size_t)l * 512;
    const float gi = A->in[I_IDXG][l * 64 + lane], bi = A->in[I_IDXB][l * 64 + lane];
    bf16 nxk = 0; float2 ncs = make_float2(1.f, 0.f); v4u nraw[4];
#define POST_LOAD(tk) do { const int s_ = (tk) % SEQ; nxk = H[(size_t)(tk) * NHC + HC_XK + lane]; ncs = WS(float2, WS_CS)[(size_t)(tk) * 32 + (lane & 31)]; \
        _Pragma("unroll") for (int j = 0; j < 4; ++j) { nraw[j] = (v4u){0u, 0u, 0u, 0u}; if (s_ - 3 + j >= 0) nraw[j] = *(const GAS v4u*)(H + (size_t)((tk) - 3 + j) * NHC + 8 * lane); } } while (0)
    if (gw < T) POST_LOAD(gw);
    for (int tok = gw; tok < T; tok += ngw) {
        const bf16 cxk = nxk; const float2 cs = ncs; v4u craw[4];
#pragma unroll
        for (int j = 0; j < 4; ++j) craw[j] = nraw[j];
        if (tok + ngw < T) POST_LOAD(tok + ngw);
        {
            const float v = bf2f(cxk);
            const float mean = wave_sum(v) * (1.0f / 64.0f); const float dv = v - mean;
            const float var = wave_sum(dv * dv) * (1.0f / 64.0f);
            const float nv = dv * (1.0f / sqrtf(var + LN_EPS)) * gi + bi;
            const float pv = shx(nv, lane, 32);
            const int i = lane & 31;
            const float o = (lane < 32) ? (nv * cs.x - pv * cs.y) : (nv * cs.x + pv * cs.y);
            XKP[(size_t)tok * 64 + 2 * i + (lane >> 5)] = (bf16)f2bf(o);
        }
        {
            const int c0 = 8 * lane;
            float acc[8];
#pragma unroll
            for (int c = 0; c < 8; ++c) acc[c] = cb[c0 + c];
#pragma unroll
            for (int j = 0; j < 4; ++j) {
                const unsigned rw[4] = {craw[j].x, craw[j].y, craw[j].z, craw[j].w};
#pragma unroll
                for (int c = 0; c < 8; ++c) { const float x = __uint_as_float((c & 1) ? (rw[c >> 1] & 0xffff0000u) : (rw[c >> 1] << 16)); acc[c] += cw[j * 512 + c0 + c] * x; }
            }
            v4u o;
#define SILU(x) ((x) / (1.0f + __expf(-(x))))
            o.x = pk2(SILU(acc[0]), SILU(acc[1])); o.y = pk2(SILU(acc[2]), SILU(acc[3])); o.z = pk2(SILU(acc[4]), SILU(acc[5])); o.w = pk2(SILU(acc[6]), SILU(acc[7]));
#undef SILU
            *(GAS v4u*)(QKC + (size_t)tok * 512 + c0) = o;
        }
    }
#undef POST_LOAD
}
typedef float f32x16 __attribute__((ext_vector_type(16)));
__device__ __forceinline__ void select_load(const float* SC, int tok, int lane, f32x4 (&raw)[8]);
__device__ __forceinline__ void select_row(const f32x4 (&raw)[8], unsigned* MASK, int tok, int lane);
__device__ __forceinline__ void ph_idx_scores(int wvx) {
    TIDX;
    const bf16* H = WS(bf16, WS_H); const bf16* XKP = WS(bf16, WS_XKP); float* SC = WS(float, WS_SC); unsigned* MASK = WS(unsigned, WS_MASK);
    const int r = lane & 31, hh = lane >> 5, ql = r >> 3, hd = r & 7;
    for (int item = blockIdx.x; item < 256; item += gridDim.x) {
        const int b = item >> 4, p = item & 15;
#pragma unroll 1
        for (int sub = 0; sub < 2; ++sub) {
            const int qblk = sub ? 31 - p : p, q0 = qblk * 64 + 8 * wave, tok0 = b * SEQ + q0;
            bf16x8 af[2][4];
#pragma unroll
            for (int g = 0; g < 2; ++g) { const bf16* ap = H + (size_t)(tok0 + 4 * g + ql) * NHC + HC_XQ + hd * 64 + 8 * hh;
#pragma unroll
              for (int ks = 0; ks < 4; ++ks) af[g][ks] = *(const GAS bf16x8*)(ap + ks * 16); }
            float wv[2][4][4];
#pragma unroll
            for (int g = 0; g < 2; ++g)
#pragma unroll
                for (int q = 0; q < 4; ++q)
#pragma unroll
                    for (int i = 0; i < 4; ++i) wv[g][q][i] = bf2f(H[(size_t)(tok0 + 4 * g + q) * NHC + HC_XW + 4 * hh + i]);
            const int npair = qblk + 1;
            const bf16* kp = XKP + (size_t)(b * SEQ + r) * 64 + 8 * hh;
            bf16x8 bc[2][4], bn[2][4];
#pragma unroll
            for (int t2 = 0; t2 < 2; ++t2)
#pragma unroll
                for (int ks = 0; ks < 4; ++ks) bc[t2][ks] = *(const GAS bf16x8*)(kp + t2 * 2048 + ks * 16);
            for (int pr = 0; pr < npair; ++pr) {
                const bf16* kn = kp + (size_t)((pr + 1 < npair) ? pr + 1 : pr) * 4096;
#pragma unroll
                for (int t2 = 0; t2 < 2; ++t2)
#pragma unroll
                    for (int ks = 0; ks < 4; ++ks) bn[t2][ks] = *(const GAS bf16x8*)(kn + t2 * 2048 + ks * 16);
#pragma unroll
                for (int t2 = 0; t2 < 2; ++t2) {
                    const int key = pr * 64 + t2 * 32 + r;
#pragma unroll
                    for (int g = 0; g < 2; ++g) {
                        f32x16 acc = {};
#pragma unroll
                        for (int ks = 0; ks < 4; ++ks) acc = __builtin_amdgcn_mfma_f32_32x32x16_bf16(af[g][ks], bc[t2][ks], acc, 0, 0, 0);
                        float tot[4];
#pragma unroll
                        for (int q = 0; q < 4; ++q) { float pp = 0.f;
#pragma unroll
                            for (int i = 0; i < 4; ++i) pp += wv[g][q][i] * fmaxf(acc[4 * q + i], 0.f);
                            tot[q] = pp + shx(pp, lane, 32); }
                        const float o0 = hh ? tot[2] : tot[0], o1 = hh ? tot[3] : tot[1];
                        SC[(size_t)(tok0 + 4 * g + 2 * hh) * SEQ + key] = o0; SC[(size_t)(tok0 + 4 * g + 2 * hh + 1) * SEQ + key] = o1;
                    }
                }
#pragma unroll
                for (int t2 = 0; t2 < 2; ++t2)
#pragma unroll
                    for (int ks = 0; ks < 4; ++ks) bc[t2][ks] = bn[t2][ks];
            }
            asm volatile("s_waitcnt vmcnt(0)" ::: "memory"); __builtin_amdgcn_fence(__ATOMIC_ACQUIRE, "agent"); asm volatile("s_waitcnt vmcnt(0)" ::: "memory");
            { f32x4 rawc[8], rawn[8]; select_load(SC, tok0, lane, rawc);
#pragma unroll 1
              for (int q = 0; q < 8; ++q) { if (q + 1 < 8) select_load(SC, tok0 + q + 1, lane, rawn);
                  select_row(rawc, MASK, tok0 + q, lane);
#pragma unroll
                  for (int j = 0; j < 8; ++j) rawc[j] = rawn[j]; } }
        }
    }
}
constexpr size_t WS_OD = WS_END;
constexpr size_t WS_END2 = WS_END + 64 * MiB;
__device__ __forceinline__ void ph_diff_attn(LAS unsigned char* lds, int wvx) {
    CArgs* A = kargs();
    const int G = gridDim.x, bx = blockIdx.x, vcu = (G % 8 == 0) ? (bx % 8) * (G / 8) + bx / 8 : bx;
    const bf16* H = WS(bf16, WS_H); bf16* OD = WS(bf16, WS_OD);
    for (int item = vcu; item < NB * 16; item += G) {
        const int b = item >> 4, vh = item & 15, g = vh >> 1, half = vh & 1;
#pragma unroll 1
        for (int qb = 7; qb >= 0; --qb)
            attn_body::attn_unit<8, false>(wvx, b, qb, H + HC_DQ + g * 64, H + HC_DK + g * 64, H + HC_DV + (g >> 1) * 128 + half * 64, OD + g * 128 + half * 64, nullptr, (char*)lds);
    }
}
__device__ __forceinline__ void ph_diff_post(int l, int wvx) {
    TIDX;
    const bf16* OD = WS(bf16, WS_OD); bf16* MIX = WS(bf16, WS_MIX);
    const float lam = WS(float, WS_LAM)[l], sc1m = 1.0f - (0.8f - 0.6f * __expf(-0.3f * (float)l));
    const int h = lane >> 4, c0 = (lane & 15) * 8;
    float gv[8];
    { const float* g = A->in[I_DFNORM] + l * 512 + h * 128 + c0;
#pragma unroll
      for (int e = 0; e < 8; ++e) gv[e] = g[e] * sc1m; }
    us8 n1 = {}, n2 = {};
    if (gw < T) { n1 = *(const GAS us8*)(OD + (size_t)gw * D + (2 * h) * 128 + c0); n2 = *(const GAS us8*)(OD + (size_t)gw * D + (2 * h + 1) * 128 + c0); }
    for (int tok = gw; tok < T; tok += ngw) {
        const us8 a1 = n1, a2 = n2;
        if (tok + ngw < T) { n1 = *(const GAS us8*)(OD + (size_t)(tok + ngw) * D + (2 * h) * 128 + c0); n2 = *(const GAS us8*)(OD + (size_t)(tok + ngw) * D + (2 * h + 1) * 128 + c0); }
        float d[8], ss = 0.f;
#pragma unroll
        for (int e = 0; e < 8; ++e) { d[e] = bf2f(a1[e]) - lam * bf2f(a2[e]); ss += d[e] * d[e]; }
        ss += DPPF(ss, 0xB1); ss += DPPF(ss, 0x4E); ss += DPPF(ss, 0x141); ss += DPPF(ss, 0x140);
        const float rs = 1.0f / sqrtf(ss * (1.0f / 128.0f) + LN_EPS);
        v4u o; o.x = pk2(d[0] * rs * gv[0], d[1] * rs * gv[1]); o.y = pk2(d[2] * rs * gv[2], d[3] * rs * gv[3]); o.z = pk2(d[4] * rs * gv[4], d[5] * rs * gv[5]); o.w = pk2(d[6] * rs * gv[6], d[7] * rs * gv[7]);
        *(GAS v4u*)(MIX + (size_t)tok * D + 256 + h * 128 + c0) = o;
    }
}
__device__ __forceinline__ void ph_dsa_attn(LAS unsigned char* lds, int wvx) {
    CArgs* A = kargs();
    const int G = gridDim.x, bx = blockIdx.x, vcu = (G % 8 == 0) ? (bx % 8) * (G / 8) + bx / 8 : bx;
    const bf16* H = WS(bf16, WS_H); bf16* MIX = WS(bf16, WS_MIX); const unsigned* MASK = WS(unsigned, WS_MASK);
    for (int item = vcu; item < NB * 4 * 4; item += G) {
        const int bh = item >> 2, p = item & 3, b = bh >> 2, h = bh & 3;
        attn_body::attn_unit<8, true>(wvx, b, 7 - p, H + HC_SQ + h * 64, H + HC_SK + h * 64, H + HC_SV + h * 64, MIX + 768 + h * 64, MASK, (char*)lds);
        attn_body::attn_unit<8, true>(wvx, b, p, H + HC_SQ + h * 64, H + HC_SK + h * 64, H + HC_SV + h * 64, MIX + 768 + h * 64, MASK, (char*)lds);
    }
}
constexpr size_t WS_DC = WS_END2;
constexpr size_t WS_CST = WS_DC + 32 * MiB;
constexpr size_t WS_DN = WS_CST + 32 * MiB;
constexpr size_t WS_END3 = WS_DN + 4 * MiB;
constexpr size_t WS_DUMMY = WS_END3;
constexpr size_t WS_END4 = WS_DUMMY + 256 * MiB;
typedef float f32x2_ __attribute__((ext_vector_type(2)));
constexpr int MP = 68;
__device__ __forceinline__ float log_sigmoid_(float x) { return fminf(x, 0.f) - log1pf(__expf(-fabsf(x))); }
__device__ __forceinline__ void mlstm_gates(const bf16* H, int tok0, int h, float gbi, float gbf, int lane, LAS float* bcum, LAS float* av) {
    const size_t tk = (size_t)(tok0 + lane);
    const float ip = bf2f(H[tk * NHC + HC_MI + h]) + gbi; float lf = log_sigmoid_(bf2f(H[tk * NHC + HC_MF + h]) + gbf);
#pragma unroll
    for (int o = 1; o < 64; o <<= 1) { const float t_ = shup(lf, lane, o); if (lane >= o) lf += t_; }
    bcum[lane] = lf; av[lane] = ip - lf;
}
constexpr int PB = 72;

__device__ __forceinline__ f32x16 mfma_tile(const LAS bf16* Xa, int mt, const LAS bf16* Xb, int nt, int r, int hh, f32x16 acc) {
#pragma unroll
    for (int ks = 0; ks < 4; ++ks) { const bf16x8 a = *(const LAS bf16x8*)(Xa + (32 * mt + r) * PB + 16 * ks + 8 * hh), b = *(const LAS bf16x8*)(Xb + (32 * nt + r) * PB + 16 * ks + 8 * hh);
        acc = __builtin_amdgcn_mfma_f32_32x32x16_bf16(a, b, acc, 0, 0, 0); }
    return acc;
}
__device__ __forceinline__ void ph_mlstm_m1(LAS unsigned char* lds, int l, int wvx) {
    TIDX;
    const bf16* H = WS(bf16, WS_H); const bf16* QKC = WS(bf16, WS_QKC);
    float* DC = WS(float, WS_DC); float* DN = WS(float, WS_DN); float* SCAL = WS(float, WS_DN + 2 * MiB);
    LAS bf16* kT = (LAS bf16*)lds; LAS bf16* vwT = kT + 64 * PB;
    LAS float* bcum = (LAS float*)(vwT + 96 * PB); LAS float* av = bcum + 64; LAS float* wv = av + 64;
    const int r = lane & 31, hh = lane >> 5, srow = tid >> 3, ch = tid & 7;
    for (int u = blockIdx.x; u < NB * 4 * 32; u += gridDim.x) {
        const int bh = u >> 5, c = u & 31, b = bh >> 2, h = bh & 3, tok0 = b * SEQ + c * 64;
        const us8 kraw = *(const GAS us8*)(QKC + (size_t)(tok0 + srow) * 512 + 256 + h * 64 + 8 * ch);
        const us8 vraw = *(const GAS us8*)(H + (size_t)(tok0 + srow) * NHC + HC_MV + h * 64 + 8 * ch);
        if (wave == 0) { mlstm_gates(H, tok0, h, A->in[I_GATEB][l * 8 + h], A->in[I_GATEB][l * 8 + 4 + h], lane, bcum, av); }
        __syncthreads();
        if (wave == 0) { const float a = av[lane], amax = wave_max(a); wv[lane] = __expf(a - amax); if (lane == 0) { SCAL[u * 4 + 0] = bcum[63]; SCAL[u * 4 + 1] = bcum[63] + amax; } }
        __syncthreads();
        { const float w = wv[srow];
#pragma unroll
          for (int e = 0; e < 8; ++e) { kT[(8 * ch + e) * PB + srow] = kraw[e]; vwT[(8 * ch + e) * PB + srow] = (bf16)f2bf(w * bf2f(vraw[e])); }
          if (tid < 64) vwT[64 * PB + tid] = (bf16)f2bf(wv[tid]);
          for (int i = tid; i < 31 * 64; i += 512) vwT[(65 + i / 64) * PB + (i & 63)] = 0; }
        __syncthreads();
        if (wave < 6) { const int mt = wave >> 1, nt = wave & 1;
            f32x16 acc = {}; acc = mfma_tile(vwT, mt, kT, nt, r, hh, acc);
#pragma unroll
            for (int g = 0; g < 16; ++g) { const int vrow = 32 * mt + (g & 3) + 8 * (g >> 2) + 4 * hh, d = 32 * nt + r;
                if (vrow < 64) DC[(size_t)u * 4096 + vrow * 64 + d] = acc[g]; else if (vrow == 64) DN[(size_t)u * 64 + d] = acc[g]; } }
        __syncthreads();
    }
}
__device__ __forceinline__ void ph_mlstm_m2(int wvx) {
    TIDX;
    const float* DC = WS(float, WS_DC); float* CS = WS(float, WS_CST); const float* DN = WS(float, WS_DN); float* NS = WS(float, WS_DN + 1 * MiB); float* SCAL = WS(float, WS_DN + 2 * MiB);
    for (int item = blockIdx.x; item < NB * 4 * 4; item += gridDim.x) {
        const int bh = item >> 2, qtr = item & 3, e0 = qtr * 1024 + tid * 2;
        f32x2_ dc[32]; float dn[32];
#pragma unroll
        for (int c = 0; c < 32; ++c) { dc[c] = *(const GAS f32x2_*)(DC + (size_t)(bh * 32 + c) * 4096 + e0); dn[c] = (qtr == 0 && tid < 64) ? DN[(size_t)(bh * 32 + c) * 64 + tid] : 0.f; }
        float z_ = 0.f; asm volatile("" : "+v"(z_));
        float m = 0.f; f32x2_ C = (f32x2_){z_, z_}; float n = z_;
#pragma unroll
        for (int c = 0; c < 32; ++c) {
            const int u = bh * 32 + c;
            const float bl = SCAL[u * 4 + 0], ml = SCAL[u * 4 + 1];
            *(GAS f32x2_*)(CS + (size_t)u * 4096 + e0) = C;
            if (qtr == 0 && tid < 64) NS[(size_t)u * 64 + tid] = n;
            if (qtr == 0 && tid == 0) SCAL[u * 4 + 2] = m;
            const float mn = fmaxf(bl + m, ml), f1 = __expf(bl + m - mn), f2 = __expf(ml - mn);
            C.x = f1 * C.x + f2 * dc[c].x; C.y = f1 * C.y + f2 * dc[c].y;
            n = f1 * n + f2 * dn[c];
            m = mn;
        }
    }
}
__device__ __forceinline__ void ph_mlstm_m3(LAS unsigned char* lds, int l, int wvx) {
    TIDX;
    const bf16* H = WS(bf16, WS_H); const bf16* QKC = WS(bf16, WS_QKC); bf16* MIX = WS(bf16, WS_MIX);
    const float* CS = WS(float, WS_CST); const float* NS = WS(float, WS_DN + 1 * MiB); const float* SCAL = WS(float, WS_DN + 2 * MiB);
    LAS bf16* qS = (LAS bf16*)lds; LAS bf16* kS = qS + 64 * PB; LAS bf16* vT = kS + 64 * PB; LAS bf16* cT = vT + 96 * PB; LAS bf16* Sb = cT + 96 * PB;
    LAS float* hS = (LAS float*)(Sb + 64 * PB);
    LAS float* bcum = hS + 64 * MP; LAS float* av = bcum + 64; LAS float* mm = av + 64; LAS float* inter = mm + 64; LAS float* dinv = inter + 64;
    const int r = lane & 31, hh = lane >> 5, srow = tid >> 3, ch = tid & 7;
    for (int u = blockIdx.x; u < NB * 4 * 32; u += gridDim.x) {
        const int bh = u >> 5, c = u & 31, b = bh >> 2, h = bh & 3, tok0 = b * SEQ + c * 64;
        const float mc = SCAL[u * 4 + 2];
        bf16 ograw[8];
#pragma unroll
        for (int j = 0; j < 8; ++j) ograw[j] = H[(size_t)(tok0 + wave + 8 * j) * NHC + HC_MO + h * 64 + lane];
        const float gnorm = A->in[I_MNORM][l * 256 + h * 64 + lane];
        {
            const us8 qraw = *(const GAS us8*)(QKC + (size_t)(tok0 + srow) * 512 + h * 64 + 8 * ch);
            const us8 kraw = *(const GAS us8*)(QKC + (size_t)(tok0 + srow) * 512 + 256 + h * 64 + 8 * ch);
            const us8 vraw = *(const GAS us8*)(H + (size_t)(tok0 + srow) * NHC + HC_MV + h * 64 + 8 * ch);
            const f32x4 c0 = *(const GAS f32x4*)(CS + (size_t)u * 4096 + srow * 64 + 8 * ch), c1 = *(const GAS f32x4*)(CS + (size_t)u * 4096 + srow * 64 + 8 * ch + 4);
            us8 qs;
#pragma unroll
            for (int e = 0; e < 8; ++e) qs[e] = (bf16)f2bf(bf2f(qraw[e]) * 0.125f);
            *(LAS us8*)(qS + srow * PB + 8 * ch) = qs; *(LAS us8*)(kS + srow * PB + 8 * ch) = kraw;
#pragma unroll
            for (int e = 0; e < 8; ++e) vT[(8 * ch + e) * PB + srow] = vraw[e];
            v4u cp; cp.x = pk2(c0[0], c0[1]); cp.y = pk2(c0[2], c0[3]); cp.z = pk2(c1[0], c1[1]); cp.w = pk2(c1[2], c1[3]);
            *(LAS v4u*)(cT + srow * PB + 8 * ch) = cp;
            if (tid < 64) { vT[64 * PB + tid] = (bf16)0x3f80; cT[64 * PB + tid] = (bf16)f2bf(NS[(size_t)u * 64 + tid]); }
            for (int i = tid; i < 31 * 64; i += 512) { vT[(65 + i / 64) * PB + (i & 63)] = 0; cT[(65 + i / 64) * PB + (i & 63)] = 0; }
        }
        if (wave == 0) { mlstm_gates(H, tok0, h, A->in[I_GATEB][l * 8 + h], A->in[I_GATEB][l * 8 + 4 + h], lane, bcum, av); }
        __syncthreads();
        if (wave == 0) { float pm = av[lane];
#pragma unroll
            for (int o = 1; o < 64; o <<= 1) { const float t_ = shup(pm, lane, o); if (lane >= o) pm = fmaxf(pm, t_); }
            const float m_ = fmaxf(mc, pm); mm[lane] = m_; inter[lane] = __expf(mc - m_); }
        __syncthreads();
        if (wave < 4) { const int tt = wave >> 1, st = wave & 1;
            f32x16 acc = {}; acc = mfma_tile(qS, tt, kS, st, r, hh, acc);
            const int s = 32 * st + r; const float as = av[s];
#pragma unroll
            for (int g = 0; g < 16; ++g) { const int t = 32 * tt + (g & 3) + 8 * (g >> 2) + 4 * hh;
                const float val = (s <= t) ? acc[g] * __expf(as - mm[t]) : 0.f; Sb[t * PB + s] = (bf16)f2bf(val); } }
        __syncthreads();
        f32x16 aS = {}, aC = {}; const int tt = (wave < 6) ? wave / 3 : 0, nt = (wave < 6) ? wave % 3 : 0;
        if (wave < 6) { aS = mfma_tile(Sb, tt, vT, nt, r, hh, aS); aC = mfma_tile(qS, tt, cT, nt, r, hh, aC); }
        if (wave < 6 && nt == 2 && r == 0) {
#pragma unroll
            for (int g = 0; g < 16; ++g) { const int t = 32 * tt + (g & 3) + 8 * (g >> 2) + 4 * hh;
                const float dn = aS[g] + inter[t] * aC[g]; dinv[t] = 1.0f / fmaxf(fabsf(dn), __expf(-(bcum[t] + mm[t]))); } }
        __syncthreads();
        if (wave < 6 && nt < 2) {
#pragma unroll
            for (int g = 0; g < 16; ++g) { const int t = 32 * tt + (g & 3) + 8 * (g >> 2) + 4 * hh;
                hS[t * MP + 32 * nt + r] = (aS[g] + inter[t] * aC[g]) * dinv[t]; } }
        __syncthreads();
#pragma unroll
        for (int j = 0; j < 8; ++j) { const int t = wave + 8 * j, vc = lane; const size_t tk = (size_t)(tok0 + t);
            const float hv = hS[t * MP + vc];
            const float mean = wave_sum(hv) * (1.0f / 64.0f), hc = hv - mean;
            const float rs = 1.0f / sqrtf(wave_sum(hc * hc) * (1.0f / 64.0f) + LN_EPS);
            const float og = sigmoidf_(bf2f(ograw[j]));
            MIX[tk * D + h * 64 + vc] = (bf16)f2bf(og * (hc * rs * gnorm)); }
        __syncthreads();
    }
}
__device__ __forceinline__ int wave_sum_i(int x) {
    x += __builtin_amdgcn_update_dpp(0, x, 0xB1, 0xF, 0xF, true);
    x += __builtin_amdgcn_update_dpp(0, x, 0x4E, 0xF, 0xF, true);
    x += __builtin_amdgcn_update_dpp(0, x, 0x141, 0xF, 0xF, true);
    x += __builtin_amdgcn_update_dpp(0, x, 0x140, 0xF, 0xF, true);
    return __builtin_amdgcn_readlane(x, 0) + __builtin_amdgcn_readlane(x, 16) + __builtin_amdgcn_readlane(x, 32) + __builtin_amdgcn_readlane(x, 48);
}
__device__ __forceinline__ void select_load(const float* SC, int tok, int lane, f32x4 (&raw)[8]) {
    const int tl = tok % SEQ, lo = 32 * lane; const bool need = (tl >= 256) && (tl + 1 - lo > 0);
#pragma unroll
    for (int j = 0; j < 8; ++j) { raw[j] = (f32x4){0.f, 0.f, 0.f, 0.f}; if (need) raw[j] = *(const GAS f32x4*)(SC + (size_t)tok * SEQ + lo + 4 * j); }
}
__device__ __forceinline__ void select_row(const f32x4 (&raw)[8], unsigned* MASK, int tok, int lane) {
        const int tl = tok % SEQ, lo = 32 * lane;
        const int nv = min(max(tl + 1 - lo, 0), 32);
        unsigned cand = (nv >= 32) ? 0xffffffffu : ((1u << nv) - 1u);
        if (tl < 256) { MASK[(size_t)tok * 64 + lane] = cand; return; }
        unsigned a[32];
#pragma unroll
        for (int j = 0; j < 8; ++j) {
            const f32x4 v = raw[j];
#pragma unroll
            for (int c = 0; c < 4; ++c) { unsigned u = __float_as_uint(v[c]); u = (u == 0x80000000u) ? 0u : u; a[4 * j + c] = (u >> 31) ? ~u : (u | 0x80000000u); }
        }
#define TSTAGE(J, M) _Pragma("unroll") for (int k0 = 0; k0 < 32; ++k0) { if ((k0 & J) == 0) { const unsigned t_ = ((a[k0] >> J) ^ a[k0 + J]) & M; a[k0] ^= t_ << J; a[k0 + J] ^= t_; } }
        TSTAGE(16, 0x0000FFFFu) TSTAGE(8, 0x00FF00FFu) TSTAGE(4, 0x0F0F0F0Fu) TSTAGE(2, 0x33333333u) TSTAGE(1, 0x55555555u)
#undef TSTAGE
        unsigned sel = 0u; int need = 256, ncand = tl + 1;
#pragma unroll
        for (int b = 31; b >= 0; --b) {
            if (ncand != need) {
                const unsigned hit = cand & a[b];
                const int cnt = wave_sum_i(__popc(hit));
                if (cnt >= need) { cand = hit; ncand = cnt; }
                else { sel |= hit; cand &= ~a[b]; need -= cnt; ncand -= cnt; }
            }
        }
        if (ncand == need) sel |= cand;
        else {
            const int my = __popc(cand); int incl = my;
#pragma unroll
            for (int o = 1; o < 64; o <<= 1) { const int t_ = shupi(incl, lane, o); if (lane >= o) incl += t_; }
            const int take = min(max(need - (incl - my), 0), my); int taken = 0;
#pragma unroll 1
            for (int k = 0; k < 32; ++k) { if (((cand >> k) & 1u) && taken < take) { sel |= 1u << k; ++taken; } }
        }
        MASK[(size_t)tok * 64 + lane] = sel;
}
__device__ __forceinline__ f32x4 bf4_(unsigned long long r) { f32x4 y; y.x = __uint_as_float((unsigned)r << 16); y.y = __uint_as_float((unsigned)r & 0xffff0000u); y.z = __uint_as_float((unsigned)(r >> 32) << 16); y.w = __uint_as_float((unsigned)(r >> 32) & 0xffff0000u); return y; }
__device__ __forceinline__ unsigned long long pk4_(f32x4 v) { return (unsigned long long)pk2(v.x, v.y) | ((unsigned long long)pk2(v.z, v.w) << 32); }
constexpr int R1_OFF = RING_BYTES + 8192;
__device__ __forceinline__ void ph_row1(LAS unsigned char* lds, int l, int wvx, bool dry = false) {
    TIDX;
    const float* xin = (l == 0) ? A->in[I_X] : WS(float, WS_XB); float* XB = dry ? WS(float, WS_DUMMY) : WS(float, WS_XB);
    const bf16* Y = WS(bf16, WS_Y); bf16* U = dry ? WS(bf16, WS_DUMMY + 128 * MiB) : WS(bf16, WS_U);
    unsigned* cnt = dry ? WS(unsigned, WS_DUMMY + 200 * MiB) : WS(unsigned, WS_CTL) + CW_CNT + l * NEXP * 64; unsigned* TOK = dry ? WS(unsigned, WS_DUMMY + 192 * MiB) : WS(unsigned, WS_TOK);
    const float* lg = A->in[I_LN1G] + l * D; const float* lb = A->in[I_LN1B] + l * D;
    unsigned* RMAP = dry ? WS(unsigned, WS_DUMMY + 208 * MiB) : WS(unsigned, WS_XG);
    LAS float* rw = (LAS float*)lds; LAS unsigned* lcnt = (LAS unsigned*)(lds + R1_OFF); LAS unsigned* lbase = lcnt + 32; LAS unsigned* nrec = lbase + 32; LAS unsigned* rec = nrec + 4;
    { const GAS f32x4* src = (const GAS f32x4*)(WS(float, WS_RWT) + (size_t)l * NEXP * D);
      for (int i = tid; i < NEXP * D / 4; i += 512) ((LAS f32x4*)rw)[i] = src[i];
      if (tid < 32) lcnt[tid] = 0u; if (tid == 32) nrec[0] = 0u; }
    __syncthreads();
    const float rbias = A->in[I_RB][l * NEXP + (lane >> 1)];
    f32x4 px[4], pg[4]; unsigned long long py[4];
#define R1_LOAD(tk) do { const float* mod_ = WS(float, WS_MOD) + ((size_t)l * NB + (tk) / SEQ) * 6144; _Pragma("unroll") for (int j = 0; j < 4; ++j) { const int c = 4 * lane + 256 * j; \
        px[j] = *(const GAS f32x4*)(xin + (size_t)(tk) * D + c); pg[j] = *(const GAS f32x4*)(mod_ + 2048 + c); py[j] = *(const GAS unsigned long long*)(Y + (size_t)(tk) * D + c); } } while (0)
    if (gw < T) R1_LOAD(gw);
    for (int tok = gw; tok < T; tok += ngw) {
        const int b = tok / SEQ; const float* mod = WS(float, WS_MOD) + ((size_t)l * NB + b) * 6144;
        f32x4 v[4]; float s = 0.f;
#pragma unroll
        for (int j = 0; j < 4; ++j) {
            const f32x4 x = px[j]; const f32x4 g1 = pg[j];
            const unsigned long long yr = py[j];
            f32x4 y; y.x = __uint_as_float((unsigned)yr << 16); y.y = __uint_as_float((unsigned)yr & 0xffff0000u); y.z = __uint_as_float((unsigned)(yr >> 32) << 16); y.w = __uint_as_float((unsigned)(yr >> 32) & 0xffff0000u);
            v[j] = x * DN_ALPHA + (1.0f + g1) * y; s += (v[j].x + v[j].y) + (v[j].z + v[j].w); }
        if (tok + ngw < T) R1_LOAD(tok + ngw);
        const float mean = wave_sum(s) * (1.0f / D); float s2 = 0.f;
#pragma unroll
        for (int j = 0; j < 4; ++j) { v[j] = v[j] - mean; s2 += (v[j].x * v[j].x + v[j].y * v[j].y) + (v[j].z * v[j].z + v[j].w * v[j].w); }
        const float rstd = 1.0f / sqrtf(wave_sum(s2) * (1.0f / D) + LN_EPS);
        f32x4 u2[4];
#pragma unroll
        for (int j = 0; j < 4; ++j) { const int c = 4 * lane + 256 * j;
            const f32x4 xn = v[j] * rstd * *(const f32x4*)(lg + c) + *(const f32x4*)(lb + c);
            *(GAS f32x4*)(XB + (size_t)tok * D + c) = xn;
            u2[j] = xn * (1.0f + *(const f32x4*)(mod + 4096 + c)) + *(const f32x4*)(mod + 3072 + c);
            *(GAS unsigned*)((unsigned char*)U + (size_t)tok * D + c) = pg8::pk4_fp8(u2[j].x, u2[j].y, u2[j].z, u2[j].w, 16.0f); }
        float part[32];
#pragma unroll
        for (int e = 0; e < 32; ++e) { float a = 0.f;
#pragma unroll
            for (int j = 0; j < 4; ++j) { const f32x4 w = *(const LAS f32x4*)(rw + e * D + 4 * lane + 256 * j); a += (u2[j].x * w.x + u2[j].y * w.y) + (u2[j].z * w.z + u2[j].w * w.w); }
            part[e] = a; }
#define RSTEP(N, OFF) _Pragma("unroll") for (int e = 0; e < N; ++e) { const bool hi = (lane & OFF) != 0; const float send = hi ? part[e] : part[e + N]; const float recv = shx(send, lane, OFF); part[e] = (hi ? part[e + N] : part[e]) + recv; }
        RSTEP(16, 32) RSTEP(8, 16) RSTEP(4, 8) RSTEP(2, 4) RSTEP(1, 2)
#undef RSTEP
        float logit = part[0] + shx(part[0], lane, 1) + rbias;
        const int myexp = lane >> 1;
        int rank = 0;
#pragma unroll
        for (int j = 0; j < 32; ++j) { const float lj = __int_as_float(__builtin_amdgcn_readlane(__float_as_int(logit), 2 * j)); rank += (lj > logit || (lj == logit && j < myexp)) ? 1 : 0; }
        float tv[4]; int te[4];
#pragma unroll
        for (int k = 0; k < 4; ++k) { const unsigned long long bm = __ballot(rank == k); const int ln = (int)__builtin_ctzll(bm); te[k] = ln >> 1; tv[k] = __int_as_float(__builtin_amdgcn_readlane(__float_as_int(logit), ln)); }
        const float e1 = __expf(tv[1] - tv[0]), e2 = __expf(tv[2] - tv[0]), e3 = __expf(tv[3] - tv[0]); const float inv = 1.0f / (1.0f + e1 + e2 + e3);
        if (lane < 4) { const int ek = lane == 0 ? te[0] : lane == 1 ? te[1] : lane == 2 ? te[2] : te[3]; const float pk = (lane == 0 ? 1.0f : lane == 1 ? e1 : lane == 2 ? e2 : e3) * inv;
            const unsigned lp = __hip_atomic_fetch_add(lcnt + ek, 1u, __ATOMIC_RELAXED, __HIP_MEMORY_SCOPE_WORKGROUP);
            const unsigned ri = __hip_atomic_fetch_add(nrec, 1u, __ATOMIC_RELAXED, __HIP_MEMORY_SCOPE_WORKGROUP);
            if (ri < 640u) { LAS unsigned* r = rec + ri * 3; r[0] = (unsigned)tok * 4u + (unsigned)lane; r[1] = (unsigned)ek | (lp << 8); r[2] = __float_as_uint(pk); } }
    }
#undef R1_LOAD
    __syncthreads();
    if (tid < 32) lbase[tid] = __hip_atomic_fetch_add(cnt + tid * 64, lcnt[tid], __ATOMIC_RELAXED, __HIP_MEMORY_SCOPE_AGENT);
    __syncthreads();
    { const int n = (int)min(nrec[0], 640u);
      for (int i = tid; i < n; i += 512) { const unsigned r0 = rec[i * 3], r1 = rec[i * 3 + 1], r2 = rec[i * 3 + 2]; const unsigned ek = r1 & 255u;
          const unsigned pos = lbase[ek] + (r1 >> 8);
          *(GAS v4u*)(TOK + (size_t)r0 * 4) = (v4u){ek, pos, r2, 0u}; RMAP[(size_t)ek * T + pos] = r0 >> 2; } }
    __syncthreads();
}
__device__ __forceinline__ int moe_tables(LAS unsigned char* lds, int l, int wvx) {
    CArgs* A = kargs();
    LAS unsigned* base = (LAS unsigned*)(lds + TAB_OFF); LAS unsigned char* tile_e = lds + TAB_OFF + 256; LAS unsigned* cntl = (LAS unsigned*)(lds + TAB_OFF + 1024);
    const unsigned* cnt = WS(unsigned, WS_CTL) + CW_CNT + l * NEXP * 64;
    if (wvx == 0) {
        const int lane = lane_id_(), e = lane & 31;
        const unsigned c = __hip_atomic_load(cnt + e * 64, __ATOMIC_RELAXED, __HIP_MEMORY_SCOPE_AGENT);
        const int nt = (int)((c + 255u) >> 8); int incl = nt;
#pragma unroll
        for (int o = 1; o < 32; o <<= 1) { const int t_ = shupi(incl, lane, o); if (e >= o) incl += t_; }
        if (lane < 32) { const int t0 = incl - nt; base[e] = (unsigned)t0 << 8; cntl[e] = c; if (e == 31) base[NEXP] = (unsigned)incl << 8;
#pragma unroll 1
            for (int t = 0; t < nt; ++t) tile_e[t0 + t] = (unsigned char)e; }
    }
    __syncthreads();
    return (int)(base[NEXP] >> 8);
}
__device__ __forceinline__ void ph_row2(LAS unsigned char* lds, int l, int wvx, bool dry = false) {
    TIDX;
    (void)moe_tables(lds, l, wvx);
    const LAS unsigned* base = (const LAS unsigned*)(lds + TAB_OFF);
    float* XB = WS(float, WS_XB); const bf16* YM = WS(bf16, WS_YM); bf16* U = WS(bf16, WS_U); const unsigned* TOK = WS(unsigned, WS_TOK);
    const float* lg = A->in[I_LN2G] + l * D; const float* lb = A->in[I_LN2B] + l * D; const float* b2 = A->in[I_B2] + (size_t)l * NEXP * D;
    float* dst = dry ? WS(float, WS_DUMMY) : (l == DEPTH - 1) ? A->out : XB; bf16* Uw = dry ? WS(bf16, WS_DUMMY + 128 * MiB) : U;
    v4u rcA[4], rcB[4]; unsigned long long yq[4][4]; f32x4 xq[4];
#define R2_REC(dst, tk) do { _Pragma("unroll") for (int k = 0; k < 4; ++k) dst[k] = *(const GAS v4u*)(TOK + ((size_t)(tk) * 4 + k) * 4); } while (0)
#define R2_ROWS(rc, tk) do { _Pragma("unroll") for (int k = 0; k < 4; ++k) { const size_t row_ = (size_t)base[rc[k].x] + rc[k].y; _Pragma("unroll") for (int j = 0; j < 4; ++j) yq[k][j] = *(const GAS unsigned long long*)(YM + row_ * D + 4 * lane + 256 * j); } \
        _Pragma("unroll") for (int j = 0; j < 4; ++j) xq[j] = *(const GAS f32x4*)(XB + (size_t)(tk) * D + 4 * lane + 256 * j); } while (0)
    if (gw < T) { R2_REC(rcA, gw); R2_ROWS(rcA, gw); }
    if (gw + ngw < T) R2_REC(rcB, gw + ngw);
    for (int tok = gw; tok < T; tok += ngw) {
        const int b = tok / SEQ; const float* mod = WS(float, WS_MOD) + ((size_t)l * NB + b) * 6144;
        f32x4 acc[4];
#pragma unroll
        for (int j = 0; j < 4; ++j) acc[j] = (f32x4){0.f, 0.f, 0.f, 0.f};
#pragma unroll
        for (int k = 0; k < 4; ++k) { const float p = __uint_as_float(rcA[k].z);
#pragma unroll
            for (int j = 0; j < 4; ++j) { const int c = 4 * lane + 256 * j; const unsigned long long yr = yq[k][j];
                f32x4 y; y.x = __uint_as_float((unsigned)yr << 16); y.y = __uint_as_float((unsigned)yr & 0xffff0000u); y.z = __uint_as_float((unsigned)(yr >> 32) << 16); y.w = __uint_as_float((unsigned)(yr >> 32) & 0xffff0000u);
                acc[j] = acc[j] + p * (y + *(const f32x4*)(b2 + (size_t)rcA[k].x * D + c)); } }
        f32x4 xc[4];
#pragma unroll
        for (int j = 0; j < 4; ++j) xc[j] = xq[j];
#pragma unroll
        for (int k = 0; k < 4; ++k) rcA[k] = rcB[k];
        if (tok + ngw < T) R2_ROWS(rcA, tok + ngw);
        if (tok + 2 * ngw < T) R2_REC(rcB, tok + 2 * ngw);
        f32x4 v[4]; float s = 0.f;
#pragma unroll
        for (int j = 0; j < 4; ++j) { const int c = 4 * lane + 256 * j; const f32x4 x = xc[j];
            v[j] = x * DN_ALPHA + (1.0f + *(const f32x4*)(mod + 5120 + c)) * acc[j]; s += (v[j].x + v[j].y) + (v[j].z + v[j].w); }
        const float mean = wave_sum(s) * (1.0f / D); float s2 = 0.f;
#pragma unroll
        for (int j = 0; j < 4; ++j) { v[j] = v[j] - mean; s2 += (v[j].x * v[j].x + v[j].y * v[j].y) + (v[j].z * v[j].z + v[j].w * v[j].w); }
        const float rstd = 1.0f / sqrtf(wave_sum(s2) * (1.0f / D) + LN_EPS);
        const float* modn = WS(float, WS_MOD) + ((size_t)(l + 1 < DEPTH ? l + 1 : l) * NB + b) * 6144;
#pragma unroll
        for (int j = 0; j < 4; ++j) { const int c = 4 * lane + 256 * j;
            f32x4 xn = v[j] * rstd * *(const f32x4*)(lg + c) + *(const f32x4*)(lb + c);
#ifdef F8PROBE
            { const unsigned* fl = WS(unsigned, WS_CTL) + 600; if (l == DEPTH - 1) { if (fl[0]) xn = xn * __builtin_nanf(""); else if (fl[1]) xn = xn * 2.0f; } }
#endif
            *(GAS f32x4*)(dst + (size_t)tok * D + c) = xn;
            if (l + 1 < DEPTH) { const f32x4 u = xn * (1.0f + *(const f32x4*)(modn + 1024 + c)) + *(const f32x4*)(modn + c);
                *(GAS unsigned long long*)(Uw + (size_t)tok * D + c) = (unsigned long long)pk2(u.x, u.y) | ((unsigned long long)pk2(u.z, u.w) << 32); } }
    }
#undef R2_REC
#undef R2_ROWS
    __syncthreads();
}
typedef int v8i_ __attribute__((ext_vector_type(8)));
__device__ __forceinline__ unsigned f8enc(int v) {
    const int a = v < 0 ? -v : v; const unsigned c = a == 0 ? 0x00u : a == 1 ? 0x38u : a == 2 ? 0x40u : a == 3 ? 0x44u : 0x48u; return c | (v < 0 ? 0x80u : 0u); }
__device__ __forceinline__ int f8_aval(int i, int k) { return ((i * 7 + k * 3) % 9) - 4; }
__device__ __forceinline__ int f8_bval(int k, int j) { return ((k * 5 + j * 11) % 7) - 3; }
__device__ __forceinline__ void f8_probe(unsigned* flags, int wvx) {
    const int lane = tid_of(wvx) & 63, rc = lane & 15, kg = lane >> 4;
    v8i_ av, bv;
#pragma unroll
    for (int w = 0; w < 8; ++w) { unsigned pa = 0u, pb = 0u;
#pragma unroll
        for (int e = 0; e < 4; ++e) { const int k = 32 * kg + 4 * w + e; pa |= f8enc(f8_aval(rc, k)) << (8 * e); pb |= f8enc(f8_bval(k, rc)) << (8 * e); }
        av[w] = (int)pa; bv[w] = (int)pb; }
    f32x4 z = {0.f, 0.f, 0.f, 0.f};
    const f32x4 d1 = __builtin_amdgcn_mfma_scale_f32_16x16x128_f8f6f4(av, bv, z, 0, 0, 0, 0x7f7f7f7f, 0, 0x7f7f7f7f);
    const f32x4 d2 = __builtin_amdgcn_mfma_scale_f32_16x16x128_f8f6f4(av, bv, z, 0, 0, 0, 0x7b7b7b7b, 0, 0x77777777);
    bool bad1 = false, bad2 = false;
#pragma unroll
    for (int g = 0; g < 4; ++g) { const int i = 4 * kg + g, j = rc; int e = 0;
        for (int k = 0; k < 128; ++k) e += f8_aval(i, k) * f8_bval(k, j);
        if (d1[g] != (float)e) bad1 = true; if (d2[g] != (float)e * (1.0f / 4096.0f)) bad2 = true; }
    if (__any(bad1) && lane == 0) flags[0] = 1u;
    if (__any(bad2) && lane == 0) flags[1] = 1u;
}
__global__ void __launch_bounds__(NWAVES * 64, 2) mega_fwd(Args A_) {
    extern __shared__ __attribute__((aligned(16))) unsigned char lds_raw[];
    LAS unsigned char* lds = (LAS unsigned char*)lds_raw;
    const int tid = threadIdx.x; const int wv0 = __builtin_amdgcn_readfirstlane(tid >> 6);
    volatile LAS unsigned* MISC = (volatile LAS unsigned*)(lds + MISC_OFF);
    for (int u = tid; u < (LDS_BYTES - TAB_OFF) / 4; u += NWAVES * 64) ((LAS unsigned*)(lds + TAB_OFF))[u] = 0u;
    __syncthreads();
    CArgs* A = kargs(); const bool multi = (A->s_hi - A->s_lo) > 1;
    if (multi) (void)xcd_barrier_post(WS(unsigned, WS_CTL) + CW_BAR + A->li * XCD_BAR_WORDS, MISC + 8);
    const int lo = A->s_lo, hi = A->s_hi;
#ifndef PHMASK
#define PHMASK 0xffffffffu
#endif
#define PHM(b) (((PHMASK) >> (b)) & 1u)
#ifndef RPTMASK
#define RPTMASK 0u
#endif
#define RPT(b) _Pragma("unroll 1") for (int rep_ = 0; rep_ < ((((RPTMASK) >> (b)) & 1u) ? 2 : 1); ++rep_)
#define RUN(s) (lo <= (s) && (s) < hi)
#ifdef BAR2
#define BAR2X(A_) xcd_barrier_fn((unsigned*)(A_->ws + WS_CTL) + CW_BAR + A_->li * XCD_BAR_WORDS, xb_xcc_id(), (volatile LAS unsigned*)(lds_launder(lds) + MISC_OFF) + 8, tid_of(wv0) == 0)
#else
#define BAR2X(A_) do {} while (0)
#endif
#define SEAM(s) do { if ((s) + 1 < hi) { CArgs* A_ = kargs(); xcd_barrier_fn((unsigned*)(A_->ws + WS_CTL) + CW_BAR + A_->li * XCD_BAR_WORDS, xb_xcc_id(), (volatile LAS unsigned*)(lds_launder(lds) + MISC_OFF) + 8, tid_of(wv0) == 0); BAR2X(A_); } } while (0)
#ifdef F8PROBE
    if (RUN(0) && blockIdx.x == 0 && wv0 == 0) { CArgs* A = kargs(); f8_probe(WS(unsigned, WS_CTL) + 600, wv0); }
#endif
    if (RUN(0)) { if (PHM(0)) RPT(0) pro_a(lds_launder(lds), wv0); SEAM(0); }
    if (RUN(1)) { if (PHM(1)) RPT(1) pro_b(wv0); SEAM(1); }
    for (int l = 0; l < DEPTH; ++l) {
        const int sb = 2 + NPH * l;
        if (RUN(sb + PH_IN)) { CArgs* A = kargs();
            pg8::Gemm g{WS(bf16, WS_U), WS(bf16, WS_WIN) + (size_t)l * NHC * D, T, NHC, D}; pg8::StaticOrder S; S.init(T, NHC, (int)gridDim.x, (int)blockIdx.x);
            pg8::EpiIn E{WS(bf16, WS_H), WS(float, WS_CS)};
            if (PHM(2)) RPT(2) pg8::gemm_phase<pg8::EpiIn, pg8::StaticOrder, true, true>(lds_launder(lds), wv0, g, S, E);
            SEAM(sb + PH_IN);
        }
        if (RUN(sb + PH_POST)) { if (PHM(3)) RPT(3) ph_post(l, wv0); SEAM(sb + PH_POST); }
        if (RUN(sb + PH_MIXA)) { if (PHM(4)) RPT(4) ph_idx_scores(wv0); if (PHM(5)) RPT(16) ph_mlstm_m1(lds_launder(lds), l, wv0); if (PHM(6)) RPT(6) ph_diff_attn(lds_launder(lds), wv0); SEAM(sb + PH_MIXA); }
        if (RUN(sb + PH_SEL)) { if (PHM(5)) RPT(17) ph_mlstm_m2(wv0);  SEAM(sb + PH_SEL); }
        if (RUN(sb + PH_DSA)) { if (PHM(5)) RPT(18) ph_mlstm_m3(lds_launder(lds), l, wv0); if (PHM(8)) RPT(8) { ph_diff_post(l, wv0); ph_dsa_attn(lds_launder(lds), wv0); } SEAM(sb + PH_DSA); }
        if (RUN(sb + PH_OUT)) { CArgs* A = kargs();
            pg8::Gemm g{WS(bf16, WS_MIX), WS(bf16, WS_WOUT) + (size_t)l * D * D, T, D, D}; pg8::StaticOrder S; S.init(T, D, (int)gridDim.x, (int)blockIdx.x);
            pg8::EpiBf16<0> E{WS(bf16, WS_Y), D, nullptr, 0, 0, 1.f};
            if (PHM(9)) RPT(9) pg8::gemm_phase<pg8::EpiBf16<0>, pg8::StaticOrder, true, true>(lds_launder(lds), wv0, g, S, E);
            SEAM(sb + PH_OUT);
        }
        if (RUN(sb + PH_ROW1)) { if (PHM(10)) { if ((RPTMASK >> 10) & 1u) ph_row1(lds_launder(lds), l, wv0, true); ph_row1(lds_launder(lds), l, wv0); } SEAM(sb + PH_ROW1); }
        if (RUN(sb + PH_G1)) { CArgs* A = kargs();
            const int nrt = moe_tables(lds_launder(lds), l, wv0);
            pg8::Gemm g{WS(bf16, WS_U), (const bf16*)(WS(unsigned char, WS_W1) + (size_t)l * NEXP * 2048 * D), RPAD, NEXP * 2048, D / 2}; pg8::MoeOrder S; S.init(nrt, 8, (int)gridDim.x, (int)blockIdx.x, (const LAS unsigned char*)(lds_launder(lds) + TAB_OFF + 256));
            pg8::EpiSwiGLU<true> E{WS(bf16, WS_HM), A->in[I_B1] + (size_t)l * NEXP * 2048, 1.0f / 4096.0f};
            LAS unsigned char* tb = lds_launder(lds) + TAB_OFF;
            pg8::MoeGatherA AM{WS(unsigned, WS_XG), (const LAS unsigned*)tb, (const LAS unsigned*)(tb + 1024), (const LAS unsigned char*)(tb + 256), T};
            if (PHM(12)) RPT(12) pg8::gemm_phase<pg8::EpiSwiGLU<true>, pg8::MoeOrder, true, true, pg8::MoeGatherA, true>(lds_launder(lds), wv0, g, S, E, AM, 0, 0);
            SEAM(sb + PH_G1);
        }
        if (RUN(sb + PH_G2)) { CArgs* A = kargs();
            const int nrt = moe_tables(lds_launder(lds), l, wv0);
            pg8::Gemm g{WS(bf16, WS_HM), (const bf16*)(WS(unsigned char, WS_W2) + (size_t)l * NEXP * D * D), RPAD, NEXP * D, D / 2}; pg8::MoeOrder S; S.init(nrt, 4, (int)gridDim.x, (int)blockIdx.x, (const LAS unsigned char*)(lds_launder(lds) + TAB_OFF + 256));
            pg8::EpiMoeOut E{WS(bf16, WS_YM), 1.0f / 2048.0f};
            if (PHM(13)) RPT(13) pg8::gemm_phase<pg8::EpiMoeOut, pg8::MoeOrder, true, true, pg8::DirectA, true>(lds_launder(lds), wv0, g, S, E, pg8::DirectA(), 0, 0);
            SEAM(sb + PH_G2);
        }
        if (RUN(sb + PH_ROW2)) { if (PHM(14)) { if ((RPTMASK >> 14) & 1u) ph_row2(lds_launder(lds), l, wv0, true); ph_row2(lds_launder(lds), l, wv0); } SEAM(sb + PH_ROW2); }
    }
#undef RUN
#undef SEAM
}

#ifndef MK_STEPS_PER_LAUNCH
#define MK_STEPS_PER_LAUNCH 1000
#endif
extern "C" void kernel_launch(void* const* d_in, const int* in_sizes, int n_in, void* d_out, int out_size, void* d_ws, size_t ws_size, hipStream_t stream) {
    static int grid = 0;
    if (grid == 0) {
        if (n_in != 25 || out_size != T * D || ws_size < WS_END4) { fprintf(stderr, "kernel_launch: unexpected shapes (n_in %d out %d ws %zu)\n", n_in, out_size, ws_size); grid = -1; return; }
        int dev = 0, cus = 0, per_cu = 0;
        if (hipGetDevice(&dev) != hipSuccess || hipDeviceGetAttribute(&cus, hipDeviceAttributeMultiprocessorCount, dev) != hipSuccess) { grid = -1; return; }
        if (hipFuncSetAttribute((const void*)mega_fwd, hipFuncAttributeMaxDynamicSharedMemorySize, LDS_BYTES) != hipSuccess) { fprintf(stderr, "kernel_launch: hipFuncSetAttribute failed\n"); grid = -1; return; }
        if (hipOccupancyMaxActiveBlocksPerMultiprocessor(&per_cu, (const void*)mega_fwd, NWAVES * 64, LDS_BYTES) != hipSuccess || per_cu < 1) { fprintf(stderr, "kernel_launch: occupancy query says %d\n", per_cu); }
        (void)hipGetLastError();
        grid = cus;
    }
    if (grid < 0) return;
    if (hipMemsetAsync((char*)d_ws + WS_CTL, 0, CTL_ZERO_BYTES, stream) != hipSuccess) return;
    Args a{};
    for (int i = 0; i < 25; ++i) a.in[i] = (const float*)d_in[i];
    a.out = (float*)d_out; a.ws = (unsigned char*)d_ws;
    int li = 0;
    for (int s = 0; s < NSTEPS; s += MK_STEPS_PER_LAUNCH, ++li) {
        a.s_lo = s; a.s_hi = (s + MK_STEPS_PER_LAUNCH < NSTEPS) ? s + MK_STEPS_PER_LAUNCH : NSTEPS; a.li = li; a.pad = 0;
        hipLaunchKernelGGL(mega_fwd, dim3(grid), dim3(NWAVES * 64), LDS_BYTES, stream, a);
    }
}
```

```cpp
#include <hip/hip_runtime.h>
#include <cstdio>
#include <cstdint>

__device__ __forceinline__ int lane_id_() { int l_; asm volatile("v_mbcnt_lo_u32_b32 %0, -1, 0\n\tv_mbcnt_hi_u32_b32 %0, -1, %0" : "=&v"(l_)); return l_; }
namespace pg8 {
#define PG8_LAS __attribute__((address_space(3)))
typedef unsigned short bf16_t;
typedef short bf16x8 __attribute__((ext_vector_type(8)));
typedef float f32x4 __attribute__((ext_vector_type(4)));
typedef unsigned u32x4 __attribute__((ext_vector_type(4)));
constexpr int BM = 256, BK = 64, HALF = 128, HTB = HALF * BK * 2  , STAGE_BYTES = 8 * HTB, NXCD = 8, WGM = 8;

__host__ __device__ __forceinline__ int lds_byte(int r, int c) { const int st = (r >> 4) * 2 + (c >> 5), rr = r & 15, cc = c & 31, ob = rr * 64 + cc * 2; return st * 1024 + (ob ^ (((ob >> 9) & 1) << 5)); }
__host__ __device__ __forceinline__ void stage_rc(int b, int& R, int& C) { const int st = b / 1024, sb = b % 1024, swz = sb ^ (((sb >> 9) & 1) << 5); R = (st >> 1) * 16 + swz / 64; C = (st & 1) * 32 + (swz % 64) / 2; }
__host__ __device__ __forceinline__ int perm32(int rho) { const int n = rho >> 4, i = rho & 15; return 8 * (i >> 2) + 4 * n + (i & 3); }

struct Unit { int pm, pn; };
struct Gemm { const bf16_t* A; const bf16_t* Bt; int M, N, K; };

struct StaticOrder {
    int nM, nN, nwg, G, c;
    __host__ __device__ void init(int M, int N, int G_, int c_) { nM = M / BM; nN = N / BM; nwg = nM * nN; G = G_; c = c_; }
    __host__ __device__ bool next(int i, Unit& u) const {
        const long L = (long)i * G + c; if (L >= nwg) return false;
        int wgid = (int)L; { const int q = nwg / NXCD, r = nwg % NXCD, xcd = wgid % NXCD, off = wgid / NXCD; wgid = (xcd < r ? xcd * (q + 1) : r * (q + 1) + (xcd - r) * q) + off; }
        const int nig = WGM * nN, gid = wgid / nig, fm = gid * WGM, gsz = (nM - fm) < WGM ? (nM - fm) : WGM;
        u.pm = fm + ((wgid % nig) % gsz); u.pn = (wgid % nig) / gsz; return true;
    }
    __device__ __forceinline__ void a_ready(const Unit&) const {}
    __device__ __forceinline__ void done(const Unit&) const {}
};
struct MoeOrder {
    int nM, nN, nwg, G, c; const PG8_LAS unsigned char* tile_e;
    __device__ void init(int nRT, int NTN, int G_, int c_, const PG8_LAS unsigned char* te) { nM = nRT; nN = NTN; nwg = nM * nN; G = G_; c = c_; tile_e = te; }
    __device__ bool next(int i, Unit& u) const {
        const long L = (long)i * G + c; if (L >= nwg) return false;
        int wgid = (int)L; { const int q = nwg / NXCD, r = nwg % NXCD, xcd = wgid % NXCD, off = wgid / NXCD; wgid = (xcd < r ? xcd * (q + 1) : r * (q + 1) + (xcd - r) * q) + off; }
        const int nig = WGM * nN, gid = wgid / nig, fm = gid * WGM, gsz = (nM - fm) < WGM ? (nM - fm) : WGM;
        u.pm = fm + ((wgid % nig) % gsz); const int pl = (wgid % nig) / gsz; u.pn = (int)tile_e[u.pm] * nN + pl; return true;
    }
    __device__ __forceinline__ void a_ready(const Unit&) const {}
    __device__ __forceinline__ void done(const Unit&) const {}
};
struct MoeGatherA {
    static constexpr bool GATHER = true;
    const unsigned* rowmap; const PG8_LAS unsigned* base; const PG8_LAS unsigned* cnt; const PG8_LAS unsigned char* tile_e; int ntok;
    __device__ __forceinline__ unsigned off(const Unit& u, int h, int rA, int cA, int K) const {
        const int e = tile_e[u.pm]; const unsigned pos = (unsigned)u.pm * 256u - base[e] + 128u * h + (unsigned)rA;
        const unsigned tok = pos < cnt[e] ? rowmap[(size_t)e * ntok + pos] : 0u;
        return (tok * (unsigned)K + (unsigned)cA) * 2u;
    }
};
__device__ __forceinline__ unsigned cvt_pk_bf16(float lo, float hi) { unsigned r; asm volatile("v_cvt_pk_bf16_f32 %0, %1, %2" : "=v"(r) : "v"(lo), "v"(hi)); return r; }
typedef float f32x2 __attribute__((ext_vector_type(2)));
__device__ __forceinline__ f32x2 gelu_pk(f32x2 v) {
    const f32x2 av = __builtin_elementwise_abs(v), d = av * 0.2316418882f + 1.0f;
    f32x2 t; t.x = __builtin_amdgcn_rcpf(d.x); t.y = __builtin_amdgcn_rcpf(d.y);
    f32x2 q = t * 0.5307027145f + (-0.7265760135f); q = q * t + 0.7107068705f; q = q * t + (-0.142248368f); q = q * t + 0.127414796f; q = q * t;
    const f32x2 s = (v * v) * (-0.72134752044f);
    f32x2 e; e.x = __builtin_amdgcn_exp2f(s.x); e.y = __builtin_amdgcn_exp2f(s.y);
    const f32x2 m = v * (q * e), r = v - m;
    f32x2 o; o.x = v.x < 0.f ? m.x : r.x; o.y = v.y < 0.f ? m.y : r.y; return o;
}

template <int ACT  > struct EpiBf16 {
    static constexpr bool PERM = true, AFTER_DRAIN = false; static_assert(ACT == 0 || ACT == 1, "EpiBf16: ACT is 0 (none) or 1 (gelu_pk)");
    bf16_t* O; int ldc; const float* bias; int split_cols; size_t split_stride; float scale0;
    __device__ __forceinline__ void operator()(const f32x4 (&acc)[2][2][4][2], const Unit& u, int wr, int wc, int fr, int fq) const {
        const int row0 = u.pm * BM + wr * 64 + fr; int colt = u.pn * BM; bf16_t* base = O;
        float sc = 1.f; if (split_cols) { const int t = colt / split_cols; base += (size_t)t * split_stride; colt -= t * split_cols; if (t == 0) sc = scale0; }
        const int col0 = colt + wc * 32 + 8 * fq, bcol0 = u.pn * BM + wc * 32 + 8 * fq;
        f32x4 bv[2][2];
#pragma unroll
        for (int bj = 0; bj < 2; ++bj)
#pragma unroll
            for (int n = 0; n < 2; ++n) bv[bj][n] = bias ? *(const f32x4*)(bias + bcol0 + bj * HALF + 4 * n) : (f32x4){0.f, 0.f, 0.f, 0.f};
#pragma unroll
        for (int ai = 0; ai < 2; ++ai)
#pragma unroll
            for (int m = 0; m < 4; ++m) { bf16_t* rowp = base + (size_t)(row0 + ai * HALF + m * 16) * ldc + col0;
#pragma unroll
                for (int bj = 0; bj < 2; ++bj) { f32x4 v0 = acc[ai][bj][m][0] + bv[bj][0], v1 = acc[ai][bj][m][1] + bv[bj][1];
                    if (ACT == 1) { f32x2 a = gelu_pk((f32x2){v0[0], v0[1]}), b = gelu_pk((f32x2){v0[2], v0[3]}), c = gelu_pk((f32x2){v1[0], v1[1]}), d = gelu_pk((f32x2){v1[2], v1[3]});
                        v0 = (f32x4){a.x, a.y, b.x, b.y}; v1 = (f32x4){c.x, c.y, d.x, d.y}; }
                    v0 = v0 * sc; v1 = v1 * sc; u32x4 w; w.x = cvt_pk_bf16(v0[0], v0[1]); w.y = cvt_pk_bf16(v0[2], v0[3]); w.z = cvt_pk_bf16(v1[0], v1[1]); w.w = cvt_pk_bf16(v1[2], v1[3]);
                    *(u32x4*)(rowp + bj * HALF) = w; } }
    }
};
constexpr float C2 = 0.125f * 1.4426950408889634f;
struct EpiIn {
    static constexpr bool PERM = true, AFTER_DRAIN = false;
    bf16_t* O; const float* cs;
    __device__ __forceinline__ void operator()(const f32x4 (&acc)[2][2][4][2], const Unit& u, int wr, int wc, int fr, int fq) const {
        const int pn = u.pn;
        const bool rope = (0x6CF0 >> pn) & 1;
        const float sc = ((0x0430 >> pn) & 1) ? C2 : 1.f;
        const int row0 = u.pm * BM + wr * 64 + fr, col0 = pn * BM + wc * 32 + 8 * fq, i0 = (wc & 1) * 16 + 4 * fq;
#pragma unroll
        for (int ai = 0; ai < 2; ++ai) {
            f32x4 c01[4], c23[4];
#pragma unroll
            for (int m = 0; m < 4; ++m) { c01[m] = (f32x4){1.f, 0.f, 1.f, 0.f}; c23[m] = c01[m]; }
            if (rope) {
#pragma unroll
                for (int m = 0; m < 4; ++m) { const float* cp = cs + (size_t)(row0 + ai * HALF + m * 16) * 64 + i0 * 2; c01[m] = *(const f32x4*)cp; c23[m] = *(const f32x4*)(cp + 4); }
            }
#pragma unroll
            for (int m = 0; m < 4; ++m) {
                const int row = row0 + ai * HALF + m * 16;
                const f32x4 ca = c01[m], cb = c23[m];
                bf16_t* rowp = O + (size_t)row * 4096 + col0;
#pragma unroll
                for (int bj = 0; bj < 2; ++bj) {
                    const f32x4 v0 = acc[ai][bj][m][0], v1 = acc[ai][bj][m][1];
                    f32x4 r0, r1;
                    r0[0] = v0[0] * ca[0] - v0[1] * ca[1]; r0[1] = v0[1] * ca[0] + v0[0] * ca[1];
                    r0[2] = v0[2] * ca[2] - v0[3] * ca[3]; r0[3] = v0[3] * ca[2] + v0[2] * ca[3];
                    r1[0] = v1[0] * cb[0] - v1[1] * cb[1]; r1[1] = v1[1] * cb[0] + v1[0] * cb[1];
                    r1[2] = v1[2] * cb[2] - v1[3] * cb[3]; r1[3] = v1[3] * cb[2] + v1[2] * cb[3];
                    r0 = r0 * sc; r1 = r1 * sc;
                    u32x4 w; w.x = cvt_pk_bf16(r0[0], r0[1]); w.y = cvt_pk_bf16(r0[2], r0[3]); w.z = cvt_pk_bf16(r1[0], r1[1]); w.w = cvt_pk_bf16(r1[2], r1[3]);
                    *(u32x4*)(rowp + bj * HALF) = w;
                }
            }
            asm volatile("" ::: "memory");
        }
    }
};
__device__ __forceinline__ unsigned pk4_fp8(float a, float b, float c, float d, float sc) {
    a = fminf(fmaxf(a * sc, -448.f), 448.f); b = fminf(fmaxf(b * sc, -448.f), 448.f); c = fminf(fmaxf(c * sc, -448.f), 448.f); d = fminf(fmaxf(d * sc, -448.f), 448.f);
    int w = __builtin_amdgcn_cvt_pk_fp8_f32(a, b, 0, false); w = __builtin_amdgcn_cvt_pk_fp8_f32(c, d, w, true); return (unsigned)w; }
template <bool F8OUT> struct EpiSwiGLU {
    static constexpr bool PERM = true, AFTER_DRAIN = false;
    bf16_t* O; const float* b1; float asc;
    __device__ __forceinline__ void operator()(const f32x4 (&acc)[2][2][4][2], const Unit& u, int wr, int wc, int fr, int fq) const {
        const int e = u.pn >> 3, pl = u.pn & 7, colh = pl * 128 + wc * 32 + 8 * fq;
        const float* bp = b1 + (size_t)e * 2048 + colh;
        f32x4 bg[2], bu[2];
#pragma unroll
        for (int n = 0; n < 2; ++n) { bg[n] = *(const f32x4*)(bp + 4 * n); bu[n] = *(const f32x4*)(bp + 1024 + 4 * n); }
        const int row0 = u.pm * BM + wr * 64 + fr;
#pragma unroll
        for (int ai = 0; ai < 2; ++ai)
#pragma unroll
            for (int m = 0; m < 4; ++m) {
                f32x4 o[2];
#pragma unroll
                for (int n = 0; n < 2; ++n) {
                    const f32x4 g4 = acc[ai][0][m][n] * asc + bg[n], u4 = acc[ai][1][m][n] * asc + bu[n];
#pragma unroll
                    for (int c = 0; c < 4; ++c) {
                        const float g = fminf(g4[c], 7.0f), up = fminf(fmaxf(u4[c], -7.0f), 7.0f);
                        const float sg = __builtin_amdgcn_rcpf(1.0f + __builtin_amdgcn_exp2f(-1.702f * 1.4426950408889634f * g));
                        o[n][c] = (up + 1.0f) * (g * sg);
                    }
                }
                if constexpr (F8OUT) { typedef unsigned u32x2_ __attribute__((ext_vector_type(2))); u32x2_ w; w.x = pk4_fp8(o[0][0], o[0][1], o[0][2], o[0][3], 8.0f); w.y = pk4_fp8(o[1][0], o[1][1], o[1][2], o[1][3], 8.0f);
                    *(u32x2_*)((unsigned char*)O + (size_t)(row0 + ai * HALF + m * 16) * 1024 + colh) = w; }
                else { u32x4 w; w.x = cvt_pk_bf16(o[0][0], o[0][1]); w.y = cvt_pk_bf16(o[0][2], o[0][3]); w.z = cvt_pk_bf16(o[1][0], o[1][1]); w.w = cvt_pk_bf16(o[1][2], o[1][3]);
                    *(u32x4*)(O + (size_t)(row0 + ai * HALF + m * 16) * 1024 + colh) = w; }
            }
    }
};
struct EpiMoeOut {
    static constexpr bool PERM = true, AFTER_DRAIN = false;
    bf16_t* O; float asc;
    __device__ __forceinline__ void operator()(const f32x4 (&acc)[2][2][4][2], const Unit& u, int wr, int wc, int fr, int fq) const {
        const int row0 = u.pm * BM + wr * 64 + fr, col0 = (u.pn & 3) * BM + wc * 32 + 8 * fq;
#pragma unroll
        for (int ai = 0; ai < 2; ++ai)
#pragma unroll
            for (int m = 0; m < 4; ++m) { unsigned char* rowp = (unsigned char*)O + (size_t)(row0 + ai * HALF + m * 16) * 1024 + col0;
#pragma unroll
                for (int bj = 0; bj < 2; ++bj) { const f32x4 v0 = acc[ai][bj][m][0], v1 = acc[ai][bj][m][1];
                    typedef unsigned u32x2_ __attribute__((ext_vector_type(2))); u32x2_ w; w.x = pk4_fp8(v0[0], v0[1], v0[2], v0[3], 64.0f * asc); w.y = pk4_fp8(v1[0], v1[1], v1[2], v1[3], 64.0f * asc);
                    *(u32x2_*)(rowp + bj * HALF) = w; } }
    }
};
struct DirectA { static constexpr bool GATHER = false; __device__ __forceinline__ unsigned off(const Unit&, int, int, int, int) const { return 0u; } };
typedef int v8i32 __attribute__((ext_vector_type(8)));
template <class Epi, class Sched, bool ALIGN_EPI = false, bool SP2 = false, class AMap = DirectA, bool F8 = false>
__device__ __forceinline__ void gemm_phase(PG8_LAS unsigned char* lds, int wvx, const Gemm g, const Sched& S, const Epi& E, const AMap& AM = AMap(), int scA = 0x7f7f7f7f, int scB = 0x7f7f7f7f) {
    int tid_ = wvx * 64 + lane_id_(); asm volatile("" : "+v"(tid_));
    const int tid = tid_, wid = __builtin_amdgcn_readfirstlane(tid >> 6), lane = tid & 63, wr = wid >> 2, wc = wid & 3, fr = lane & 15, fq = lane >> 4;
    const int K = g.K, nt = K / BK;
    unsigned voffB[2], vA[2];
#pragma unroll
    for (int i = 0; i < 2; ++i) { int R, C; stage_rc(tid * 16 + i * 8192, R, C); const int Rb = Epi::PERM ? ((R & ~31) + perm32(R & 31)) : R;
        vA[i] = (unsigned)(R * K + C) * 2u; voffB[i] = (unsigned)(Rb * K + C) * 2u; }
    const size_t kstep = (size_t)(BK * 2);
    const size_t hstep = (size_t)HALF * K * 2;
    const size_t tstep = 2 * hstep;
    const unsigned ldsw = (unsigned)wid * 1024u;
    const int aoff = lds_byte(wr * 64 + fr, fq * 8), boff = lds_byte(wc * 32 + fr, fq * 8);
#define PG8_SA(b, h) (((b) * 2 + (h)) * HTB)
#define PG8_SB(b, h) ((4 + (b) * 2 + (h)) * HTB)
#define PG8_STAGEA(bufoff, kb, h, nx) do { size_t ubx_ = (size_t)(kb); unsigned lo_[2]; \
        if constexpr (AMap::GATHER) { _Pragma("unroll") for (int _i = 0; _i < 2; ++_i) lo_[_i] = (nx) ? oN[h][_i] : oC[h][_i]; } \
        else { ubx_ += (nx) ? uN[h] : uC[h]; _Pragma("unroll") for (int _i = 0; _i < 2; ++_i) lo_[_i] = vA[_i]; } \
        const char* ub_ = Abase + ubx_; asm("" : "+s"(ub_)); _Pragma("unroll") for (int _i = 0; _i < 2; ++_i) asm("" : "+v"(lo_[_i]));     \
        _Pragma("unroll") for (int _i = 0; _i < 2; ++_i) \
        __builtin_amdgcn_global_load_lds((const unsigned*)(ub_ + lo_[_i]), (PG8_LAS unsigned*)(lds + (bufoff) + ldsw + _i * 8192), 16, 0, 0); } while (0)
#define PG8_AOFF(dstL, dstU, u) do { if constexpr (AMap::GATHER) { int t2_ = wvx * 64 + lane_id_(); asm volatile("" : "+v"(t2_)); _Pragma("unroll") for (int _i = 0; _i < 2; ++_i) { int R_, C_; stage_rc(t2_ * 16 + _i * 8192, R_, C_); \
            _Pragma("unroll") for (int _h = 0; _h < 2; ++_h) dstL[_h][_i] = AM.off(u, _h, R_, C_, K); } } \
        else { _Pragma("unroll") for (int _h = 0; _h < 2; ++_h) dstU[_h] = ((size_t)(u).pm * BM + 128 * _h) * (size_t)K * 2; } } while (0)
#define PG8_STAGE(bufoff, gbase, voff) do { const char* ub_ = (const char*)(gbase); asm("" : "+s"(ub_)); _Pragma("unroll") for (int _i = 0; _i < 2; ++_i) \
        __builtin_amdgcn_global_load_lds((const unsigned*)(ub_ + (voff)[_i]), (PG8_LAS unsigned*)(lds + (bufoff) + ldsw + _i * 8192), 16, 0, 0); } while (0)
#define PG8_LDA(dst, b, h) do { _Pragma("unroll") for (int m = 0; m < 4; ++m) _Pragma("unroll") for (int k = 0; k < 2; ++k) dst[m][k] = *(const PG8_LAS bf16x8*)(lds + PG8_SA(b, h) + aoff + m * 2048 + k * 1024); } while (0)
#define PG8_LDB(dst, b, h) do { _Pragma("unroll") for (int n = 0; n < 2; ++n) _Pragma("unroll") for (int k = 0; k < 2; ++k) dst[n][k] = *(const PG8_LAS bf16x8*)(lds + PG8_SB(b, h) + boff + n * 2048 + k * 1024); } while (0)
#define PG8_CAT(x) __builtin_bit_cast(v8i32, __builtin_shufflevector(x[0], x[1], 0, 1, 2, 3, 4, 5, 6, 7, 8, 9, 10, 11, 12, 13, 14, 15))
#define PG8_MMA(ai, bj, At, Bt) do { __builtin_amdgcn_s_setprio(1); _Pragma("unroll") for (int m = 0; m < 4; ++m) _Pragma("unroll") for (int n = 0; n < 2; ++n) { \
        if constexpr (F8) acc[ai][bj][m][n] = __builtin_amdgcn_mfma_scale_f32_16x16x128_f8f6f4(PG8_CAT(Bt[n]), PG8_CAT(At[m]), acc[ai][bj][m][n], 0, 0, 0, scB, 0, scA); \
        else { _Pragma("unroll") for (int k = 0; k < 2; ++k) acc[ai][bj][m][n] = __builtin_amdgcn_mfma_f32_16x16x32_bf16(Bt[n][k], At[m][k], acc[ai][bj][m][n], 0, 0, 0); } } __builtin_amdgcn_s_setprio(0); } while (0)
#define PG8_WAIT_V(n) asm volatile("s_waitcnt vmcnt(" #n ")" ::: "memory")
#define PG8_WAIT_L(n) asm volatile("s_waitcnt lgkmcnt(" #n ")" ::: "memory")
#define PG8_BAR __builtin_amdgcn_s_barrier()
#define PG8_SCHED __builtin_amdgcn_sched_barrier(0)
    Unit cur, nxt; int ui = 0;
    if (!S.next(0, cur)) return;
    f32x4 acc[2][2][4][2];
#pragma unroll
    for (int a = 0; a < 2; ++a)
#pragma unroll
        for (int b = 0; b < 2; ++b)
#pragma unroll
            for (int m = 0; m < 4; ++m)
#pragma unroll
                for (int n = 0; n < 2; ++n) acc[a][b][m][n] = (f32x4){0.f, 0.f, 0.f, 0.f};
    bf16x8 At[4][2], B0[2][2], B1[2][2];
    const char* Abase = (const char*)g.A; const char* cB = (const char*)g.Bt + (size_t)cur.pn * tstep;
    unsigned oC[2][2], oN[2][2]; size_t uC[2] = {0, 0}, uN[2] = {0, 0}; PG8_AOFF(oC, uC, cur);
    S.a_ready(cur);
    if constexpr (SP2) {
        PG8_STAGE(PG8_SB(0, 0), cB, voffB); PG8_STAGE(PG8_SB(0, 1), cB + hstep, voffB); PG8_STAGEA(PG8_SA(0, 0), 0, 0, false); PG8_STAGEA(PG8_SA(0, 1), 0, 1, false);
        if (wr == 1) PG8_BAR;
        PG8_WAIT_V(2); PG8_BAR;
        PG8_STAGE(PG8_SB(1, 0), cB + kstep, voffB); PG8_STAGEA(PG8_SA(1, 0), kstep, 0, false); PG8_STAGE(PG8_SB(1, 1), cB + hstep + kstep, voffB);
        PG8_WAIT_V(6); PG8_BAR;
    } else {
        PG8_STAGE(PG8_SB(0, 0), cB, voffB); PG8_STAGEA(PG8_SA(0, 0), 0, 0, false); PG8_STAGE(PG8_SB(0, 1), cB + hstep, voffB); PG8_STAGEA(PG8_SA(0, 1), 0, 1, false);
        if (wr == 1) PG8_BAR;
        PG8_WAIT_V(4); PG8_BAR;
        PG8_STAGE(PG8_SB(1, 0), cB + kstep, voffB); PG8_STAGEA(PG8_SA(1, 0), kstep, 0, false); PG8_STAGE(PG8_SB(1, 1), cB + hstep + kstep, voffB);
        PG8_WAIT_V(6); PG8_BAR;
    }
    for (;;) {
        const bool has_next = S.next(ui + 1, nxt);
        const char* nB = has_next ? (const char*)g.Bt + (size_t)nxt.pn * tstep : cB;
        if (has_next) { PG8_AOFF(oN, uN, nxt); } else {
#pragma unroll
            for (int _h = 0; _h < 2; ++_h) { oN[_h][0] = oC[_h][0]; oN[_h][1] = oC[_h][1]; uN[_h] = uC[_h]; } }
#pragma unroll 1
        for (int t = 0; t < nt; t += 2) {
            const bool last = (t == nt - 2);
            const size_t ka1 = (size_t)(t + 1) * kstep, ka2 = last ? (size_t)0 : (size_t)(t + 2) * kstep, ka3 = ka2 + kstep;
            const char* b2 = last ? nB : cB + (size_t)(t + 2) * kstep; const char* b3 = b2 + kstep;
            if (last && has_next) S.a_ready(nxt);
            if constexpr (SP2) {
            PG8_LDB(B0, 0, 0); PG8_LDB(B1, 0, 1); PG8_SCHED; PG8_LDA(At, 0, 0); PG8_STAGEA(PG8_SA(1, 1), ka1, 1, false);
            PG8_WAIT_V(8); PG8_WAIT_L(0); PG8_BAR; PG8_MMA(0, 0, At, B0); PG8_MMA(0, 1, At, B1); PG8_BAR; PG8_SCHED;
            PG8_LDA(At, 0, 1); PG8_STAGE(PG8_SB(0, 0), b2, voffB); PG8_STAGE(PG8_SB(0, 1), b2 + hstep, voffB); PG8_STAGEA(PG8_SA(0, 0), ka2, 0, last);
            PG8_WAIT_V(8); PG8_WAIT_L(0); PG8_BAR; PG8_MMA(1, 0, At, B0); PG8_MMA(1, 1, At, B1); PG8_BAR; PG8_SCHED;
            PG8_LDB(B0, 1, 0); PG8_LDB(B1, 1, 1); PG8_SCHED; PG8_LDA(At, 1, 0); PG8_STAGEA(PG8_SA(0, 1), ka2, 1, last);
            PG8_WAIT_V(8); PG8_WAIT_L(0); PG8_BAR; PG8_MMA(0, 0, At, B0); PG8_MMA(0, 1, At, B1); PG8_BAR; PG8_SCHED;
            PG8_LDA(At, 1, 1); PG8_STAGE(PG8_SB(1, 0), b3, voffB); PG8_STAGE(PG8_SB(1, 1), b3 + hstep, voffB); PG8_STAGEA(PG8_SA(1, 0), ka3, 0, last);
            PG8_WAIT_V(8); PG8_WAIT_L(0); PG8_BAR; PG8_MMA(1, 0, At, B0); PG8_MMA(1, 1, At, B1); PG8_BAR; PG8_SCHED;
            } else {
            PG8_LDB(B0, 0, 0); PG8_SCHED; PG8_LDA(At, 0, 0); PG8_STAGEA(PG8_SA(1, 1), ka1, 1, false);
            PG8_WAIT_L(8); PG8_BAR; PG8_WAIT_L(0); PG8_MMA(0, 0, At, B0); PG8_BAR; PG8_SCHED;
            PG8_LDB(B1, 0, 1); PG8_STAGE(PG8_SB(0, 0), b2, voffB);
            PG8_BAR; PG8_WAIT_L(0); PG8_MMA(0, 1, At, B1); PG8_BAR;
            PG8_LDA(At, 0, 1); PG8_STAGEA(PG8_SA(0, 0), ka2, 0, last);
            PG8_BAR; PG8_WAIT_L(0); PG8_MMA(1, 0, At, B0); PG8_BAR; PG8_SCHED;
            PG8_STAGE(PG8_SB(0, 1), b2 + hstep, voffB);
            PG8_WAIT_V(6); PG8_BAR; PG8_MMA(1, 1, At, B1); PG8_BAR;
            PG8_LDB(B0, 1, 0); PG8_SCHED; PG8_LDA(At, 1, 0); PG8_STAGEA(PG8_SA(0, 1), ka2, 1, last);
            PG8_WAIT_L(8); PG8_BAR; PG8_WAIT_L(0); PG8_MMA(0, 0, At, B0); PG8_BAR; PG8_SCHED;
            PG8_LDB(B1, 1, 1); PG8_STAGE(PG8_SB(1, 0), b3, voffB);
            PG8_BAR; PG8_WAIT_L(0); PG8_MMA(0, 1, At, B1); PG8_BAR;
            PG8_LDA(At, 1, 1); PG8_STAGEA(PG8_SA(1, 0), ka3, 0, last);
            PG8_BAR; PG8_WAIT_L(0); PG8_MMA(1, 0, At, B0); PG8_BAR; PG8_SCHED;
            PG8_STAGE(PG8_SB(1, 1), b3 + hstep, voffB);
            PG8_WAIT_V(6); PG8_BAR; PG8_MMA(1, 1, At, B1); PG8_BAR;
            }
        }
        if constexpr (ALIGN_EPI) { if (wr == 0) PG8_BAR; }
        if constexpr (!Epi::AFTER_DRAIN) { const int l2_ = lane_id_(); const int fr_ = l2_ & 15, fq_ = l2_ >> 4;
            E(acc, cur, wr, wc, fr_, fq_); S.done(cur); }
        if (!has_next) break;
#pragma unroll
        for (int a = 0; a < 2; ++a)
#pragma unroll
            for (int b = 0; b < 2; ++b)
#pragma unroll
                for (int m = 0; m < 4; ++m)
#pragma unroll
                    for (int n = 0; n < 2; ++n) acc[a][b][m][n] = (f32x4){0.f, 0.f, 0.f, 0.f};
        cur = nxt; cB = nB; ++ui;
#pragma unroll
        for (int _h = 0; _h < 2; ++_h) { oC[_h][0] = oN[_h][0]; oC[_h][1] = oN[_h][1]; uC[_h] = uN[_h]; }
        if constexpr (ALIGN_EPI) { if (wr == 1) PG8_BAR; }
    }
    PG8_WAIT_V(0);
    if constexpr (!ALIGN_EPI) { if (wr == 0) PG8_BAR; }
    PG8_BAR;
    if constexpr (Epi::AFTER_DRAIN) { E.fused(acc, cur, wr, wc, fr, fq, lds, wid, lane); S.done(cur); }
#undef PG8_SA
#undef PG8_SB
#undef PG8_STAGE
#undef PG8_STAGEA
#undef PG8_AOFF
#undef PG8_LDA
#undef PG8_LDB
#undef PG8_MMA
#undef PG8_CAT
#undef PG8_WAIT_V
#undef PG8_WAIT_L
#undef PG8_BAR
#undef PG8_SCHED
}
}
namespace attn_body {
using bf16=unsigned short;
using bf16x8=__attribute__((ext_vector_type(8)))short;
using s16x4=__attribute__((ext_vector_type(4)))short;
using f32x16=__attribute__((ext_vector_type(16)))float;
using u32x4=__attribute__((ext_vector_type(4)))unsigned;
constexpr int SEQ=2048,D=64,DM=4096,DMO=1024;
constexpr int NW=8,QBLK=32,QB=QBLK*NW,KVBLK=64,NQB=SEQ/QB;
__device__ __forceinline__ unsigned f2bf_(float f){unsigned u=__builtin_bit_cast(unsigned,f);return (u+0x7fffu+((u>>16)&1u))>>16;}
__device__ __forceinline__ int crow(int r,int hi){return (r&3)+8*(r>>2)+4*hi;}
#define SBAR() __builtin_amdgcn_sched_barrier(0)
__device__ __forceinline__ void cmask(f32x16&p0,f32x16&p1,int jb,int qrel,int hi){
  const float NEG=-INFINITY; int kb=64*jb+4*hi;
  #pragma unroll
  for(int r=0;r<16;++r){int kv=kb+(r&3)+8*(r>>2); if(kv>qrel)p0[r]=NEG; if(kv+32>qrel)p1[r]=NEG;}
}

__device__ __forceinline__ uint2 mld_asm(const unsigned*p){ uint2 v; asm volatile("global_load_dwordx2 %0, %1, off":"=v"(v):"v"(p):"memory"); return v; }
__device__ __forceinline__ void bmask(f32x16&p0,f32x16&p1,uint2 w,int hi){
  const float NEG=-INFINITY; const unsigned a=w.x>>(4*hi), b=w.y>>(4*hi);
  #pragma unroll
  for(int r=0;r<16;++r){const int bit=(r&3)+8*(r>>2); if(!((a>>bit)&1u))p0[r]=NEG; if(!((b>>bit)&1u))p1[r]=NEG;}
}
constexpr int NSLOT=3, SLOTB=8192;
constexpr int LDS_K=0, LDS_V=NSLOT*SLOTB, LDS_WS=2*NSLOT*SLOTB, LDS_OST=LDS_WS+NW*64*4, LDS_BYTES=LDS_OST+NW*4096;
constexpr float C2=0.125f*1.4426950408889634f;
__device__ __forceinline__ void glds16(const void*gsrc,unsigned lds_dst){unsigned keep;
  asm volatile("s_mov_b32 %0, m0\n\ts_mov_b32 m0, %2\n\ts_nop 0\n\tglobal_load_lds_dwordx4 %1, off\n\ts_mov_b32 m0, %0":"=&s"(keep):"v"(gsrc),"s"(lds_dst):"memory");}
__device__ __forceinline__ float max3f(float a,float b,float c){float r;asm("v_max3_f32 %0, %1, %2, %3":"=v"(r):"v"(a),"v"(b),"v"(c));return r;}
__device__ __forceinline__ float max2f(float a,float b){float r;asm("v_max_f32_e32 %0, %1, %2":"=v"(r):"v"(a),"v"(b));return r;}
__device__ __forceinline__ float fadd_s(float a,float b){float r;asm("v_add_f32_e32 %0, %1, %2":"=v"(r):"v"(a),"v"(b));return r;}
__device__ __forceinline__ float fsub_s(float a,float b){float r;asm("v_sub_f32_e32 %0, %1, %2":"=v"(r):"v"(a),"v"(b));return r;}
typedef float f32x2_t __attribute__((ext_vector_type(2))); typedef __bf16 bf16x2_t __attribute__((ext_vector_type(2)));
__device__ __forceinline__ unsigned cvtpk_s(float lo,float hi){f32x2_t v={lo,hi};bf16x2_t b=__builtin_convertvector(v,bf16x2_t);return __builtin_bit_cast(unsigned,b);}
#define WAIT_BAR(N) asm volatile("s_waitcnt vmcnt(" #N ") lgkmcnt(0)\n\ts_barrier":::"memory")

__device__ __forceinline__ void qkt(f32x16&p0,f32x16&p1,const char*Kslot,const bf16x8*qr,const f32x16&negm,int r32,int hi){
  const char*kb=Kslot+hi*1024+r32*16;
  #pragma unroll
  for(int d0=0;d0<4;++d0){
    const bf16x8 b0=*reinterpret_cast<const bf16x8*>(kb+d0*2048);
    const bf16x8 b1=*reinterpret_cast<const bf16x8*>(kb+d0*2048+512);
    if(d0==0){p0=__builtin_amdgcn_mfma_f32_32x32x16_bf16(b0,qr[0],negm,0,0,0);p1=__builtin_amdgcn_mfma_f32_32x32x16_bf16(b1,qr[0],negm,0,0,0);}
    else{p0=__builtin_amdgcn_mfma_f32_32x32x16_bf16(b0,qr[d0],p0,0,0,0);p1=__builtin_amdgcn_mfma_f32_32x32x16_bf16(b1,qr[d0],p1,0,0,0);}}
}
typedef __attribute__((address_space(3))) const char* lds_cptr;
typedef short v4i16_t __attribute__((ext_vector_type(4)));
__device__ __forceinline__ void kload8(bf16x8*kf,lds_cptr kp){
  kf[0]=*(const __attribute__((address_space(3))) bf16x8*)(kp);      kf[1]=*(const __attribute__((address_space(3))) bf16x8*)(kp+512);
  kf[2]=*(const __attribute__((address_space(3))) bf16x8*)(kp+2048); kf[3]=*(const __attribute__((address_space(3))) bf16x8*)(kp+2560);
  kf[4]=*(const __attribute__((address_space(3))) bf16x8*)(kp+4096); kf[5]=*(const __attribute__((address_space(3))) bf16x8*)(kp+4608);
  kf[6]=*(const __attribute__((address_space(3))) bf16x8*)(kp+6144); kf[7]=*(const __attribute__((address_space(3))) bf16x8*)(kp+6656);
}
__device__ __forceinline__ void kload2(bf16x8*kf,lds_cptr kp,int j){ kf[2*j]=*(const __attribute__((address_space(3))) bf16x8*)(kp+j*2048); kf[2*j+1]=*(const __attribute__((address_space(3))) bf16x8*)(kp+j*2048+512); }
__device__ __forceinline__ s16x4 vtr(lds_cptr p){ return __builtin_bit_cast(s16x4,__builtin_amdgcn_ds_read_tr16_b64_v4i16((__attribute__((address_space(3))) v4i16_t*)p)); }
__device__ __forceinline__ float rowmax(const f32x16&p0,const f32x16&p1){
  float a=max3f(p0[0],p0[1],p1[0]),b=max3f(p0[2],p0[3],p1[1]);a=max3f(a,p1[2],p1[3]);
  #pragma unroll
  for(int r=4;r<16;r+=4){a=max3f(a,p0[r],p0[r+1]);b=max3f(b,p0[r+2],p0[r+3]);a=max3f(a,p1[r],p1[r+1]);b=max3f(b,p1[r+2],p1[r+3]);}
  const float m=max2f(a,b);
  auto rr=__builtin_amdgcn_permlane32_swap(__float_as_uint(m),__float_as_uint(m),false,false);
  return max2f(__uint_as_float(rr[0]),__uint_as_float(rr[1]));
}
__device__ __forceinline__ void pv(f32x16*o,int vb,bf16x8 pa0,bf16x8 pa1,bf16x8 pa2,bf16x8 pa3){
  #pragma unroll
  for(int d0=0;d0<2;++d0){s16x4 lo[4],hi[4];
    #pragma unroll
    for(int ks=0;ks<4;++ks){
      asm volatile("ds_read_b64_tr_b16 %0,%1 offset:%c2":"=&v"(lo[ks]):"v"(vb),"i"(d0*4096+ks*1024):"memory");
      asm volatile("ds_read_b64_tr_b16 %0,%1 offset:%c2":"=&v"(hi[ks]):"v"(vb),"i"(d0*4096+ks*1024+512):"memory");}
    asm volatile("s_waitcnt lgkmcnt(0)":::"memory");SBAR();
    #define PK(k) (bf16x8){lo[k][0],lo[k][1],lo[k][2],lo[k][3],hi[k][0],hi[k][1],hi[k][2],hi[k][3]}
    o[d0]=__builtin_amdgcn_mfma_f32_32x32x16_bf16(pa0,PK(0),o[d0],0,0,0);
    o[d0]=__builtin_amdgcn_mfma_f32_32x32x16_bf16(pa1,PK(1),o[d0],0,0,0);
    o[d0]=__builtin_amdgcn_mfma_f32_32x32x16_bf16(pa2,PK(2),o[d0],0,0,0);
    o[d0]=__builtin_amdgcn_mfma_f32_32x32x16_bf16(pa3,PK(3),o[d0],0,0,0);
    #undef PK
  }
}

#ifndef ATTN_STORE16
#define ATTN_STORE16(p,v) (*(u32x4*)(p)=(v))
#endif
template<int THRL,bool MASKED> __device__ __forceinline__ void attn_unit(int wvx,int b,int qb,const bf16*Q,const bf16*__restrict__ K,const bf16*__restrict__ V,bf16*O,const unsigned*MASK,char*shm){
  int tid_=wvx*64+lane_id_(); asm volatile("":"+v"(tid_));
  const int tid=tid_,lane=tid&63,r32=lane&31,hi=lane>>5; const int wid=__builtin_amdgcn_readfirstlane(tid>>6);
  const long rowbase=(long)b*SEQ; const int q0=qb*QB;
  const bf16*Qw=Q+(rowbase+q0+wid*QBLK)*DM;
  const bf16*Kh=K+rowbase*DM,*Vh=V+rowbase*DM;
  const unsigned*mrow=MASK+(size_t)(rowbase+q0+wid*QBLK+r32)*64;
  #define MLD(tt) mld_asm(mrow+2*(tt))
  const unsigned lds0=(unsigned)(uintptr_t)shm;
  float*wsf=(float*)(shm+LDS_WS)+wid*64;
  const bf16*ksrc=Kh+(long)lane*DM+wid*8;
  const bf16*vsrc=Vh+(long)(16*(wid&3)+(lane>>2))*DM+(wid>>2)*32+(lane&3)*8;
  const unsigned kdst=lds0+LDS_K+wid*1024, vdst=lds0+LDS_V+wid*1024;
  #define DMA_K(t,slot) glds16(ksrc+(long)(t)*KVBLK*DM,(unsigned)__builtin_amdgcn_readfirstlane(kdst+(slot)))
  #define DMA_V(t,slot) glds16(vsrc+(long)(t)*KVBLK*DM,(unsigned)__builtin_amdgcn_readfirstlane(vdst+(slot)))
  const int vb0=(int)(lds0+LDS_V)+((lane>>4)&1)*32+(lane&3)*8+(4*hi+((lane&15)>>2))*64;
  const char*Kbase=shm+LDS_K; bf16x8 kf[8];
  const lds_cptr shm3=(lds_cptr)shm; const lds_cptr kp0=shm3+LDS_K+hi*1024+r32*16; const lds_cptr vp0=shm3+LDS_V+((lane>>4)&1)*32+(lane&3)*8+(4*hi+((lane&15)>>2))*64;
  const int NT=(q0+QB)/KVBLK;
  uint2 mw_cur=make_uint2(~0u,~0u), mw_next=make_uint2(~0u,~0u); if(MASKED){ mw_cur=MLD(0); mw_next=MLD(1); }
  DMA_K(0,0);DMA_V(0,0);DMA_K(1,SLOTB);
  bf16x8 qr[4];
  #pragma unroll
  for(int d0=0;d0<4;++d0)qr[d0]=*reinterpret_cast<const bf16x8*>(&Qw[(long)r32*DM+d0*16+hi*8]);
  float mhat=0.f,l_reg=0.f;f32x16 o[2];o[0]=f32x16{};o[1]=f32x16{};f32x16 negm=f32x16{};asm volatile("":"+v"(negm));
  const int qrel=wid*QBLK+r32;
  #define CMASK(P0,P1,t) do{ if(MASKED){bmask(P0,P1,mw_cur,hi);} else {int jb_=(t)-(NT-4); if(jb_>=0)cmask(P0,P1,jb_,qrel,hi);} }while(0)
  bool resc=false;
  #define START(P0,P1) do{ float rm=rowmax(P0,P1); if(MASKED)rm=max2f(rm,-64.f); resc=false; \
    { const float dl=rm; mhat=fadd_s(mhat,dl); \
      _Pragma("unroll") for(int r=0;r<16;++r){P0[r]=fsub_s(P0[r],dl);P1[r]=fsub_s(P1[r],dl);} \
      _Pragma("unroll") for(int r=0;r<16;++r)negm[r]=-mhat; asm volatile("":"+v"(negm)); } \
    _Pragma("unroll") for(int r=0;r<16;++r)P0[r]=__builtin_amdgcn_exp2f(P0[r]); }while(0)
  #define RESC() do{ if(resc){ asm volatile("s_waitcnt lgkmcnt(0)":::"memory"); \
      _Pragma("unroll") for(int d_=0;d_<2;++d_) _Pragma("unroll") for(int r=0;r<16;++r)o[d_][r]*=wsf[crow(r,hi)]; } }while(0)
  f32x16 pA0,pA1,pB0,pB1;
  int sl_prev=0,sl_cur=0,sl_next=SLOTB;
  #define ROT() do{sl_prev=sl_cur;sl_cur=sl_next;sl_next=(sl_next==(NSLOT-1)*SLOTB)?0:sl_next+SLOTB;}while(0)
  DMA_K(2,2*SLOTB);
  WAIT_BAR(3);
  qkt(pA0,pA1,Kbase,qr,negm,r32,hi);asm volatile("s_nop 15\n\ts_nop 7":"+v"(pA0),"+v"(pA1));CMASK(pA0,pA1,0);
  START(pA0,pA1);
  _Pragma("unroll") for(int r=0;r<16;++r)pA1[r]=__builtin_amdgcn_exp2f(pA1[r]);
  WAIT_BAR(0);
  DMA_K(3,0);DMA_V(1,SLOTB);
  ROT();
  kload8(kf,kp0+sl_cur);
  WAIT_BAR(2);
  s16x4 vlo[8],vhi[8]; u32x4 pw0,pw1,pw2,pw3;
  #define PKW(P,B) cvtpk_s(P[B],P[B+1])
  #define PAF(k) __builtin_bit_cast(bf16x8,pw##k)
  #define VFR(i) (bf16x8){vlo[i][0],vlo[i][1],vlo[i][2],vlo[i][3],vhi[i][0],vhi[i][1],vhi[i][2],vhi[i][3]}
  #define PIN(x) asm volatile("":"+v"(x))
  #define MX3(a,b,c) __builtin_fmaxf(__builtin_fmaxf((a),(b)),(c))
  #define GAPA(MF,A0,A1,A2,A3,W0,W1,PW) do{ MF; sacc+=A0; sacc+=A1; sacc+=A2; sacc+=A3; PIN(sacc); W0; W1; PIN(PW); SBAR(); }while(0)
  #define EX(v) __builtin_amdgcn_exp2f(v)
  #define GAPB(MF,X,B) do{ MF; X[B]=EX(X[B]); X[B+1]=EX(X[B+1]); X[B+2]=EX(X[B+2]); X[B+3]=EX(X[B+3]); PIN(X); SBAR(); }while(0)
  #define VRD(i) do{ vlo[i]=vtr(vp_+(((i)>>2)*4096+((i)&3)*1024)); vhi[i]=vtr(vp_+(((i)>>2)*4096+((i)&3)*1024+512)); }while(0)
  #define KRD(G,j) do{ if(G){ kload2(kf,kp0+sl_next,j); SBAR(); } }while(0)
  #define STEP(C0,C1,P0,P1,t,GK,GV,GL) do{ SBAR(); if(MASKED){ mw_cur=mw_next; if((t)+1<NT) mw_next=MLD((t)+1); } \
    const lds_cptr vp_=vp0+sl_prev; \
    VRD(0); SBAR(); float sacc=(P0[0]+P0[1]); \
    GAPA(C0=__builtin_amdgcn_mfma_f32_32x32x16_bf16(kf[0],qr[0],negm,0,0,0), P0[2],P0[3],P0[4],P0[5],     pw0[0]=PKW(P0,0), pw0[1]=PKW(P0,2), pw0); \
    VRD(4); SBAR(); GAPA(C1=__builtin_amdgcn_mfma_f32_32x32x16_bf16(kf[1],qr[0],negm,0,0,0), P0[6],P0[7],P0[8],P0[9],     pw0[2]=PKW(P0,4), pw0[3]=PKW(P0,6), pw0); \
    VRD(1); SBAR(); GAPA(C0=__builtin_amdgcn_mfma_f32_32x32x16_bf16(kf[2],qr[1],C0,0,0,0),   P0[10],P0[11],P0[12],P0[13], pw1[0]=PKW(P0,8), pw1[1]=PKW(P0,10), pw1); \
    VRD(5); SBAR(); GAPA(C1=__builtin_amdgcn_mfma_f32_32x32x16_bf16(kf[3],qr[1],C1,0,0,0),   P0[14],P0[15],P1[0],P1[1],   pw1[2]=PKW(P0,12),pw1[3]=PKW(P0,14), pw1); \
    VRD(2); SBAR(); GAPA(C0=__builtin_amdgcn_mfma_f32_32x32x16_bf16(kf[4],qr[2],C0,0,0,0),   P1[2],P1[3],P1[4],P1[5],     pw2[0]=PKW(P1,0), pw2[1]=PKW(P1,2), pw2); \
    VRD(6); SBAR(); GAPA(C1=__builtin_amdgcn_mfma_f32_32x32x16_bf16(kf[5],qr[2],C1,0,0,0),   P1[6],P1[7],P1[8],P1[9],     pw2[2]=PKW(P1,4), pw2[3]=PKW(P1,6), pw2); \
    VRD(3); SBAR(); GAPA(C0=__builtin_amdgcn_mfma_f32_32x32x16_bf16(kf[6],qr[3],C0,0,0,0),   P1[10],P1[11],P1[12],P1[13], pw3[0]=PKW(P1,8), pw3[1]=PKW(P1,10), pw3); \
    VRD(7); SBAR(); GAPA(C1=__builtin_amdgcn_mfma_f32_32x32x16_bf16(kf[7],qr[3],C1,0,0,0),   P1[14],P1[15],0.f,0.f,       pw3[2]=PKW(P1,12),pw3[3]=PKW(P1,14), pw3); \
    l_reg+=sacc; \
    if(GK){DMA_K((t)+3,sl_cur);} if(GV){DMA_V((t)+1,sl_next);} \
    CMASK(C0,C1,t); \
    { float a=MX3(C0[0],C0[1],C1[0]),b=MX3(C0[2],C0[3],C1[1]); a=MX3(a,C1[2],C1[3]); \
      _Pragma("unroll") for(int r=4;r<16;r+=4){a=MX3(a,C0[r],C0[r+1]);b=MX3(b,C0[r+2],C0[r+3]);a=MX3(a,C1[r],C1[r+1]);b=MX3(b,C1[r+2],C1[r+3]);} \
      float rm=__builtin_fmaxf(a,b); { auto rr=__builtin_amdgcn_permlane32_swap(__float_as_uint(rm),__float_as_uint(rm),false,false); rm=__builtin_fmaxf(__uint_as_float(rr[0]),__uint_as_float(rr[1])); } \
      resc=false; \
      if(__builtin_expect(__any(rm>(float)THRL),0)){ const float dl=__builtin_fmaxf(rm,0.f); mhat+=dl; \
        _Pragma("unroll") for(int r=0;r<16;++r){C0[r]-=dl;C1[r]-=dl;} \
        _Pragma("unroll") for(int r=0;r<16;++r)negm[r]=-mhat; asm volatile("":"+v"(negm)); \
        const float f=__builtin_amdgcn_exp2f(-dl); l_reg*=f; if(hi==0)wsf[r32]=f; resc=true; } } \
    SBAR(); \
    GAPB(o[0]=__builtin_amdgcn_mfma_f32_32x32x16_bf16(PAF(0),VFR(0),o[0],0,0,0), C0,0); \
    GAPB(o[1]=__builtin_amdgcn_mfma_f32_32x32x16_bf16(PAF(0),VFR(4),o[1],0,0,0), C0,4); \
    KRD(GL,0); GAPB(o[0]=__builtin_amdgcn_mfma_f32_32x32x16_bf16(PAF(1),VFR(1),o[0],0,0,0), C0,8); \
    KRD(GL,1); GAPB(o[1]=__builtin_amdgcn_mfma_f32_32x32x16_bf16(PAF(1),VFR(5),o[1],0,0,0), C0,12); \
    KRD(GL,2); GAPB(o[0]=__builtin_amdgcn_mfma_f32_32x32x16_bf16(PAF(2),VFR(2),o[0],0,0,0), C1,0); \
    KRD(GL,3); GAPB(o[1]=__builtin_amdgcn_mfma_f32_32x32x16_bf16(PAF(2),VFR(6),o[1],0,0,0), C1,4); \
    GAPB(o[0]=__builtin_amdgcn_mfma_f32_32x32x16_bf16(PAF(3),VFR(3),o[0],0,0,0), C1,8); \
    GAPB(o[1]=__builtin_amdgcn_mfma_f32_32x32x16_bf16(PAF(3),VFR(7),o[1],0,0,0), C1,12); \
    }while(0)
  int t=1;
  #undef CMASK
  #define CMASK(P0,P1,t) do{ if(MASKED){bmask(P0,P1,mw_cur,hi);} }while(0)
  for(;t+5<NT;t+=2){
    STEP(pB0,pB1,pA0,pA1,t,true,true,true);     WAIT_BAR(2); RESC(); ROT();
    STEP(pA0,pA1,pB0,pB1,t+1,true,true,true);   WAIT_BAR(2); RESC(); ROT();
  }
  #undef CMASK
  #define CMASK(P0,P1,t) do{ if(MASKED){bmask(P0,P1,mw_cur,hi);} else {int jb_=(t)-(NT-4); if(jb_>=0)cmask(P0,P1,jb_,qrel,hi);} }while(0)
  #define ENDW(tt) do{ if((tt)+3<NT){WAIT_BAR(2);} else if((tt)+2<NT){WAIT_BAR(1);} else {WAIT_BAR(0);} }while(0)
  for(;t+1<NT;t+=2){
    STEP(pB0,pB1,pA0,pA1,t,(t+3<NT),(t+1<NT),(t+1<NT));       ENDW(t);   RESC(); ROT();
    STEP(pA0,pA1,pB0,pB1,t+1,(t+4<NT),(t+2<NT),(t+2<NT));     ENDW(t+1); RESC(); ROT();
  }
  STEP(pB0,pB1,pA0,pA1,NT-1,false,false,false); RESC();
  { float sacc=pB0[0]+pB0[1]; _Pragma("unroll") for(int r=2;r<16;++r)sacc+=pB0[r]; _Pragma("unroll") for(int r=0;r<16;++r)sacc+=pB1[r]; l_reg+=sacc;
    pw0=(u32x4){PKW(pB0,0),PKW(pB0,2),PKW(pB0,4),PKW(pB0,6)};pw1=(u32x4){PKW(pB0,8),PKW(pB0,10),PKW(pB0,12),PKW(pB0,14)};pw2=(u32x4){PKW(pB1,0),PKW(pB1,2),PKW(pB1,4),PKW(pB1,6)};pw3=(u32x4){PKW(pB1,8),PKW(pB1,10),PKW(pB1,12),PKW(pB1,14)};
    SBAR(); pv(o,vb0+sl_cur,PAF(0),PAF(1),PAF(2),PAF(3)); }
  #undef PKW
  #undef PAF
  #undef VFR
  #undef PIN
  #undef MX3
  #undef GAPA
  #undef GAPB
  #undef EX
  #undef VRD
  #undef KRD
  #undef STEP
  #undef ENDW
  {auto rr=__builtin_amdgcn_permlane32_swap(__float_as_uint(l_reg),__float_as_uint(l_reg),false,false);l_reg=__uint_as_float(rr[0])+__uint_as_float(rr[1]);}
  if(hi==0)wsf[32+r32]=l_reg;asm volatile("s_waitcnt lgkmcnt(0)":::"memory");
  float rli[16];
  #pragma unroll
  for(int r=0;r<16;++r)rli[r]=__builtin_amdgcn_rcpf(wsf[32+crow(r,hi)]);
  bf16*Ow=O+(rowbase+q0+wid*QBLK)*DMO;
  { bf16*stg=(bf16*)(shm+LDS_OST)+wid*2048;
    #pragma unroll
    for(int r=0;r<16;++r){const int orow=crow(r,hi);
      #pragma unroll
      for(int d0=0;d0<2;++d0)stg[orow*64+d0*32+r32]=(bf16)f2bf_(o[d0][r]*rli[r]);}
    asm volatile("s_waitcnt lgkmcnt(0)":::"memory");
    #pragma unroll
    for(int i=0;i<4;++i){const int row=i*8+(lane>>3),ch=lane&7; const u32x4 v=*(const u32x4*)(stg+row*64+ch*8); ATTN_STORE16(Ow+(long)row*DMO+ch*8,v);} }
  asm volatile("s_waitcnt lgkmcnt(0)\n\ts_barrier":::"memory");
  #undef DMA_K
  #undef DMA_V
  #undef MLD
  #undef CMASK
  #undef START
  #undef RESC
  #undef ROT
}
constexpr int ATTN_LDS_BYTES=LDS_BYTES;
#undef SBAR
#undef WAIT_BAR
}
#define GAS __attribute__((address_space(1)))
#define LAS __attribute__((address_space(3)))
typedef unsigned short bf16;
typedef unsigned v4u __attribute__((ext_vector_type(4)));
typedef float f32x4 __attribute__((ext_vector_type(4)));
typedef short bf16x8 __attribute__((ext_vector_type(8)));
typedef GAS unsigned gu32;
typedef GAS unsigned long long gu64;
#define RLX_AGENT __ATOMIC_RELAXED, __HIP_MEMORY_SCOPE_AGENT
#define LDS_WAIT() asm volatile("s_waitcnt lgkmcnt(0)" ::: "memory")
#define VM_WAIT() asm volatile("s_waitcnt vmcnt(0)" ::: "memory")
__device__ __forceinline__ unsigned long long rt() { return __builtin_amdgcn_s_memrealtime(); }
__device__ __forceinline__ unsigned f2bf(float f) { unsigned u = __builtin_bit_cast(unsigned, f); return (u + 0x7fffu + ((u >> 16) & 1u)) >> 16; }
__device__ __forceinline__ unsigned pk2(float lo, float hi) { return f2bf(lo) | (f2bf(hi) << 16); }
__device__ __forceinline__ int tid_of(int wvx) { return wvx * 64 + lane_id_(); }
__device__ __forceinline__ int bid_() { int b_ = (int)blockIdx.x; asm volatile("" : "+s"(b_)); return b_; }
__device__ __forceinline__ int gsz_() { int g_ = (int)gridDim.x; asm volatile("" : "+s"(g_)); return g_; }
#define XB_TMO      128
#define XB_XCNT(j)  (256  + 64 * (j))
#define XB_XSUB(j)  (1280 + 64 * (j))
#define XB_XGEN(j)  (2304 + 64 * (j))
#define XB_TOP      3328
#define XB_TOPGEN   3392
#define XCD_BAR_WORDS 3456
#define XB_SPIN_CAP (1u << 20)

__device__ __forceinline__ unsigned xb_ld(unsigned* p)              { return __hip_atomic_load(p, __ATOMIC_RELAXED, __HIP_MEMORY_SCOPE_AGENT); }
__device__ __forceinline__ unsigned xb_add(unsigned* p, unsigned v) { return __hip_atomic_fetch_add(p, v, __ATOMIC_RELAXED, __HIP_MEMORY_SCOPE_AGENT); }
__device__ __forceinline__ unsigned xb_xcc_id() { return (unsigned)__builtin_amdgcn_s_getreg((3 << 11) | 20) & 0xFu; }
#define XB_SPIN(cond, bar) do { unsigned _sp = 0; while (cond) { __builtin_amdgcn_s_sleep(1); \
    if ((++_sp & 255u) == 0u) { if (xb_ld(&(bar)[XB_TMO])) break; if (_sp > XB_SPIN_CAP) { atomicAdd(&(bar)[XB_TMO], 1u); break; } } } } while (0)

struct XcdBarrier {
    unsigned* bar; unsigned x;
    volatile LAS unsigned* st;
};

__device__ __forceinline__ XcdBarrier xcd_barrier_post(unsigned* bar, volatile LAS unsigned* st) {
    XcdBarrier b; b.bar = bar; b.x = xb_xcc_id(); b.st = st;
    if (threadIdx.x == 0) (void)xb_add(&bar[XB_XCNT(b.x)], 1u);
    return b;
}
__device__ __forceinline__ void xcd_barrier_complete(unsigned* bar, unsigned x, unsigned& nloc, unsigned& nx) {
    const unsigned G = gridDim.x * gridDim.y * gridDim.z;
    unsigned sum, cnt, mine, sp = 0u;
    for (;;) {
        sum = 0u; cnt = 0u; mine = 0u;
#pragma unroll
        for (unsigned j = 0; j < 16; ++j) { const unsigned c = xb_ld(&bar[XB_XCNT(j)]); sum += c; cnt += (c > 0u) ? 1u : 0u; mine = (j == x) ? c : mine; }
        if (sum == G) break;
        __builtin_amdgcn_s_sleep(1);
        if ((++sp & 255u) == 0u) { if (xb_ld(&bar[XB_TMO])) break; if (sp > XB_SPIN_CAP) { atomicAdd(&bar[XB_TMO], 1u); break; } }
    }
    nloc = mine > 0u ? mine : 1u; nx = cnt > 0u ? cnt : 1u;
}

__device__ __attribute__((noinline)) void xcd_barrier_fn(unsigned* bar_, unsigned x_, volatile LAS unsigned* st_, bool leader_) {
    XcdBarrier b; b.bar = bar_; b.x = x_; b.st = st_;
    asm volatile("s_waitcnt vmcnt(0)" ::: "memory");
    __syncthreads();
    if (leader_) {
        unsigned* bar = b.bar;
        __builtin_amdgcn_s_waitcnt(0);
        unsigned nloc = b.st[0], nx = b.st[1];
        if (nloc == 0u) { xcd_barrier_complete(bar, b.x, nloc, nx); b.st[0] = nloc; b.st[1] = nx; }
        const unsigned old = xb_add(&bar[XB_XSUB(b.x)], 1u);
        const unsigned gen = old / nloc;
        if (old + 1u == (gen + 1u) * nloc) {
            __builtin_amdgcn_fence(__ATOMIC_RELEASE, "agent");
            asm volatile("s_waitcnt vmcnt(0)" ::: "memory");
            const unsigned og = xb_add(&bar[XB_TOP], 1u);
            const unsigned tg = og / nx;
            if (og + 1u == (tg + 1u) * nx) xb_add(&bar[XB_TOPGEN], 1u);
            else XB_SPIN(xb_ld(&bar[XB_TOPGEN]) == tg, bar);
            __builtin_amdgcn_fence(__ATOMIC_ACQUIRE, "agent");
            xb_add(&bar[XB_XGEN(b.x)], 1u);
            asm volatile("s_waitcnt vmcnt(0)" ::: "memory");
        } else {
            XB_SPIN(xb_ld(&bar[XB_XGEN(b.x)]) == gen, bar);
            __builtin_amdgcn_fence(__ATOMIC_ACQUIRE, "agent");
            asm volatile("s_waitcnt vmcnt(0)" ::: "memory");
        }
    }
    __syncthreads();
}


constexpr int NB = 16, SEQ = 2048, T = NB * SEQ, D = 1024, DEPTH = 4, NHC = 4096, NEXP = 32, NWAVES = 8;
constexpr int NIN = 3920;
constexpr float LN_EPS = 1e-5f, DN_ALPHA = 1.6817928305074290f;
constexpr int RPAD = T * 4 + NEXP * 256;
constexpr int HC_MQ = 0, HC_MK = 256, HC_MV = 512, HC_MO = 768, HC_DQ = 1024, HC_DK = 1536, HC_DV = 2048, HC_SQ = 2560, HC_SK = 2816, HC_SV = 3072, HC_XQ = 3328, HC_XK = 3840, HC_MI = 3904, HC_MF = 3908, HC_XW = 3912;
constexpr size_t MiB = 1u << 20;
constexpr size_t WS_CTL = 0, CTL_ZERO_BYTES = 2 * MiB;
constexpr size_t WS_MOD = 2 * MiB;
constexpr size_t WS_LAM = WS_MOD + 7 * MiB / 4;
constexpr size_t WS_RWT = 4 * MiB;
constexpr size_t WS_CS = 8 * MiB;
constexpr size_t WS_WIN = 16 * MiB;
constexpr size_t WS_WOUT = 48 * MiB;
constexpr size_t WS_W1 = 64 * MiB;
constexpr size_t WS_W2 = 576 * MiB;
constexpr size_t WS_XB = 832 * MiB;
constexpr size_t WS_U = 960 * MiB;
constexpr size_t WS_H = 1024 * MiB;
constexpr size_t WS_QKC = 1280 * MiB;
constexpr size_t WS_XKP = 1312 * MiB;
constexpr size_t WS_MASK = 1316 * MiB;
constexpr size_t WS_TOK = 1324 * MiB;
constexpr size_t WS_MIX = 1344 * MiB;
constexpr size_t WS_Y = 1408 * MiB;
constexpr size_t WS_SC = 1472 * MiB;
constexpr size_t WS_XG = 1728 * MiB;
constexpr size_t WS_HM = 2000 * MiB;
constexpr size_t WS_YM = 2272 * MiB;
constexpr size_t WS_END = 2544 * MiB;
constexpr int CW_CNT = 1024;
constexpr int CW_BAR = 16384;
constexpr int RING_BYTES = 131072, TAB_OFF = RING_BYTES, MISC_OFF = RING_BYTES + 4096, LDS_BYTES = 147456;
constexpr int NPH = 10, NSTEPS = 2 + NPH * DEPTH;
enum { PH_IN = 0, PH_POST, PH_MIXA, PH_SEL, PH_DSA, PH_OUT, PH_ROW1, PH_G1, PH_G2, PH_ROW2 };

typedef unsigned short us8 __attribute__((ext_vector_type(8)));
__device__ __forceinline__ float bf2f(bf16 h) { return __uint_as_float((unsigned)h << 16); }
#define DPPF(x, c) __int_as_float(__builtin_amdgcn_update_dpp(0, __float_as_int(x), c, 0xF, 0xF, true))
__device__ __forceinline__ float wave_sum(float v) {
    v += DPPF(v, 0xB1); v += DPPF(v, 0x4E); v += DPPF(v, 0x141); v += DPPF(v, 0x140);
    return (__int_as_float(__builtin_amdgcn_readlane(__float_as_int(v), 0)) + __int_as_float(__builtin_amdgcn_readlane(__float_as_int(v), 16))) + (__int_as_float(__builtin_amdgcn_readlane(__float_as_int(v), 32)) + __int_as_float(__builtin_amdgcn_readlane(__float_as_int(v), 48)));
}
__device__ __forceinline__ float wave_max(float v) {
    v = fmaxf(v, DPPF(v, 0xB1)); v = fmaxf(v, DPPF(v, 0x4E)); v = fmaxf(v, DPPF(v, 0x141)); v = fmaxf(v, DPPF(v, 0x140));
    return fmaxf(fmaxf(__int_as_float(__builtin_amdgcn_readlane(__float_as_int(v), 0)), __int_as_float(__builtin_amdgcn_readlane(__float_as_int(v), 16))), fmaxf(__int_as_float(__builtin_amdgcn_readlane(__float_as_int(v), 32)), __int_as_float(__builtin_amdgcn_readlane(__float_as_int(v), 48))));
}
__device__ __forceinline__ float shx(float v, int lane, int m) { return __int_as_float(__builtin_amdgcn_ds_bpermute((lane ^ m) << 2, __float_as_int(v))); }
__device__ __forceinline__ int shxi(int v, int lane, int m) { return __builtin_amdgcn_ds_bpermute((lane ^ m) << 2, v); }
__device__ __forceinline__ float shup(float v, int lane, int o) { return __int_as_float(__builtin_amdgcn_ds_bpermute(((lane - o) & 63) << 2, __float_as_int(v))); }
__device__ __forceinline__ int shupi(int v, int lane, int o) { return __builtin_amdgcn_ds_bpermute(((lane - o) & 63) << 2, v); }
__device__ __forceinline__ float sigmoidf_(float x) { return 1.0f / (1.0f + __expf(-x)); }
struct Ctx {
    LAS unsigned char* lds;
    int tid, lane, wave, gw, ngw;
    const float* in[25];
    float* out; unsigned char* ws;
};
#define WSP(type, off) ((type*)(C.ws + (off)))
enum { I_X = 0, I_C, I_POS, I_WIN, I_GATEB, I_CONVW, I_CONVB, I_MNORM, I_DFLAM, I_DFNORM, I_IDXG, I_IDXB, I_WOUT, I_ADAW, I_ADAB, I_LN1G, I_LN1B, I_LN2G, I_LN2B, I_RW, I_RB, I_W1, I_B1, I_W2, I_B2 };

__device__ __forceinline__ int in_dest_col(int n) {
    auto rp = [](int j) { const int hd = j >> 6, d = j & 63; return hd * 64 + ((d < 32) ? 2 * d : 2 * (d - 32) + 1); };
    if (n < 256) return HC_MQ + n;
    if (n < 512) return HC_MK + (n - 256);
    if (n < 768) return HC_MV + (n - 512);
    if (n < 772) return HC_MI + (n - 768);
    if (n < 776) return HC_MF + (n - 772);
    if (n < 1032) return HC_MO + (n - 776);
    if (n < 1544) return HC_DQ + rp(n - 1032);
    if (n < 2056) return HC_DK + rp(n - 1544);
    if (n < 2568) return HC_DV + (n - 2056);
    if (n < 2824) return HC_SQ + rp(n - 2568);
    if (n < 3080) return HC_SK + rp(n - 2824);
    if (n < 3336) return HC_SV + (n - 3080);
    if (n < 3848) return HC_XQ + rp(n - 3336);
    if (n < 3912) return HC_XK + (n - 3848);
    return HC_XW + (n - 3912);
}
template <class F> __device__ __forceinline__ void transpose_item(const float* W, int ldw, int K, int nvalid, int k0, int n0, bf16* WT, LAS float* scr, int lane, F drow) {
    const int nn = n0 + (lane & 31); const bool ok = nn < nvalid;
    float tv_[32];
#pragma unroll
    for (int i = 0; i < 32; ++i) { const int kk = 2 * i + (lane >> 5); tv_[i] = ok ? W[(size_t)(k0 + kk) * ldw + nn] : 0.f; }
#pragma unroll
    for (int i = 0; i < 32; ++i) { const int kk = 2 * i + (lane >> 5); scr[kk * 33 + (lane & 31)] = tv_[i]; }
    LDS_WAIT(); asm volatile("" ::: "memory");
    const int c = lane & 7;
#pragma unroll
    for (int j = 0; j < 4; ++j) { const int n = (lane >> 3) + 8 * j; const LAS float* s = scr + (8 * c) * 33 + n;
        v4u o; o.x = pk2(s[0 * 33], s[1 * 33]); o.y = pk2(s[2 * 33], s[3 * 33]); o.z = pk2(s[4 * 33], s[5 * 33]); o.w = pk2(s[6 * 33], s[7 * 33]);
        if (n0 + n < nvalid) *(GAS v4u*)(WT + (size_t)drow(n0 + n) * K + k0 + 8 * c) = o; }
    LDS_WAIT(); asm volatile("" ::: "memory");
}

template <class F> __device__ __forceinline__ void transpose_item_f8(const float* W, int ldw, int K, int nvalid, int k0, int n0, unsigned char* WT8, LAS float* scr, int lane, float sc, F drow) {
    const int nn = n0 + (lane & 31); const bool ok = nn < nvalid;
    float tv_[32];
#pragma unroll
    for (int i = 0; i < 32; ++i) { const int kk = 2 * i + (lane >> 5); tv_[i] = ok ? W[(size_t)(k0 + kk) * ldw + nn] : 0.f; }
#pragma unroll
    for (int i = 0; i < 32; ++i) { const int kk = 2 * i + (lane >> 5); scr[kk * 33 + (lane & 31)] = tv_[i]; }
    LDS_WAIT(); asm volatile("" ::: "memory");
    const int c = lane & 7;
#pragma unroll
    for (int j = 0; j < 4; ++j) { const int n = (lane >> 3) + 8 * j; const LAS float* s = scr + (8 * c) * 33 + n;
        typedef unsigned u32x2_ __attribute__((ext_vector_type(2))); u32x2_ o; o.x = pg8::pk4_fp8(s[0 * 33], s[1 * 33], s[2 * 33], s[3 * 33], sc); o.y = pg8::pk4_fp8(s[4 * 33], s[5 * 33], s[6 * 33], s[7 * 33], sc);
        if (n0 + n < nvalid) *(GAS u32x2_*)(WT8 + (size_t)drow(n0 + n) * K + k0 + 8 * c) = o; }
    LDS_WAIT(); asm volatile("" ::: "memory");
}
struct Args { const float* in[25]; float* out; unsigned char* ws; int s_lo, s_hi, li, pad; };
typedef __attribute__((address_space(4))) const Args CArgs;
__device__ __forceinline__ CArgs* kargs() { CArgs* p = (CArgs*)__builtin_amdgcn_kernarg_segment_ptr(); asm volatile("" : "+s"(p)); return p; }
__device__ __forceinline__ LAS unsigned char* lds_launder(LAS unsigned char* q) { unsigned v = (unsigned)(size_t)q; asm volatile("" : "+s"(v)); return (LAS unsigned char*)(size_t)v; }
#define WS(type, off) ((type*)(A->ws + (off)))
#define TIDX CArgs* A = kargs(); int tid_ = tid_of(wvx); asm volatile("" : "+v"(tid_)); const int tid = tid_, lane = tid & 63, wave = __builtin_amdgcn_readfirstlane(tid >> 6); const int bidx = bid_(), gsz = gsz_(); const int gw = bidx * NWAVES + wave, ngw = gsz * NWAVES; (void)bidx; (void)gsz; (void)lane; (void)gw; (void)ngw

__device__ __forceinline__ void pro_a(LAS unsigned char* lds, int wvx) {
    TIDX;
    LAS float* scr = (LAS float*)(lds + wave * 16384);
    constexpr int IT_IN = 16 * 123, IT_OUT = 16 * 32, IT_W1 = 16 * 64, IT_W2 = 16 * 32;
    constexpr int N_IN = DEPTH * IT_IN, N_OUT = DEPTH * IT_OUT, N_W1 = DEPTH * NEXP * IT_W1, N_W2 = DEPTH * NEXP * IT_W2;
    constexpr int NITEMS = N_IN + N_OUT;
    for (int it = gw; it < NITEMS; it += ngw) {
        int r = it;
        if (r < N_IN) { const int l = r / IT_IN, q = r % IT_IN, kb = q / 123, nb = q % 123;
            transpose_item(A->in[I_WIN] + (size_t)l * D * NIN, NIN, D, NIN, kb * 64, nb * 32, WS(bf16, WS_WIN) + (size_t)l * NHC * D, scr, lane, [](int n) { return in_dest_col(n); }); continue; }
        r -= N_IN;
        { const int l = r / IT_OUT, q = r % IT_OUT, kb = q / 32, nb = q % 32;
            transpose_item(A->in[I_WOUT] + (size_t)l * D * D, D, D, D, kb * 64, nb * 32, WS(bf16, WS_WOUT) + (size_t)l * D * D, scr, lane, [](int n) { return n; }); }
    }
    {
        constexpr int JW1 = 16 * 32, JW2 = 16 * 16, M_W1 = DEPTH * NEXP * JW1, M_W2 = DEPTH * NEXP * JW2, NX = M_W1 + M_W2;
        __syncthreads();
        LAS float* sx = (LAS float*)(lds + wave * 16640);
        for (int it = gw; it < NX; it += ngw) {
            int r = it; const float* src; int ldw, k0, n0; unsigned char* dst; const bool w1 = r < M_W1;
            if (w1) { const int le = r / JW1, q = r % JW1; k0 = (q / 32) * 64; n0 = (q % 32) * 64; ldw = 2048; src = A->in[I_W1] + (size_t)le * D * 2048; dst = WS(unsigned char, WS_W1) + (size_t)le * 2048 * D; }
            else { r -= M_W1; const int le = r / JW2, q = r % JW2; k0 = (q / 16) * 64; n0 = (q % 16) * 64; ldw = D; src = A->in[I_W2] + (size_t)le * D * D; dst = WS(unsigned char, WS_W2) + (size_t)le * D * D; }
            float tv_[64];
#pragma unroll
            for (int i = 0; i < 64; ++i) tv_[i] = src[(size_t)(k0 + i) * ldw + n0 + lane];
#pragma unroll
            for (int i = 0; i < 64; ++i) sx[i * 65 + lane] = tv_[i];
            LDS_WAIT(); asm volatile("" ::: "memory");
            const int c = lane & 7;
#pragma unroll
            for (int j = 0; j < 8; ++j) { const int nl = (lane >> 3) + 8 * j, n = n0 + nl; const LAS float* s = sx + (8 * c) * 65 + nl;
                typedef unsigned u32x2_ __attribute__((ext_vector_type(2))); u32x2_ o; o.x = pg8::pk4_fp8(s[0 * 65], s[1 * 65], s[2 * 65], s[3 * 65], 256.0f); o.y = pg8::pk4_fp8(s[4 * 65], s[5 * 65], s[6 * 65], s[7 * 65], 256.0f);
                const int up = n >> 10, jj = n & 1023; const int drow = w1 ? ((jj >> 7) * 256 + up * 128 + (jj & 127)) : n;
                *(GAS u32x2_*)(dst + (size_t)drow * D + k0 + 8 * c) = o; }
            LDS_WAIT(); asm volatile("" ::: "memory");
        }
    }
    for (int r = gw; r < DEPTH * (NHC - NIN); r += ngw) { const int l = r / (NHC - NIN), row = NIN + r % (NHC - NIN);
        GAS v4u* p = (GAS v4u*)(WS(bf16, WS_WIN) + ((size_t)l * NHC + row) * D) + lane; p[0] = (v4u){0u, 0u, 0u, 0u}; p[64] = (v4u){0u, 0u, 0u, 0u}; }
    for (int idx = bidx * 512 + tid; idx < T * 32; idx += gsz * 512) {
        const int tok = idx >> 5, i = idx & 31;
        const double inv = exp(-(double)i * (9.210340371976184 / 32.0));
        const double ang = (double)((const int*)A->in[I_POS])[tok] * inv;
        const double rev = ang * 0.15915494309189535;
        const float fr = (float)(rev - rint(rev));
        float2 v; v.x = __builtin_amdgcn_cosf(fr); v.y = __builtin_amdgcn_sinf(fr);
        WS(float2, WS_CS)[idx] = v;
    }
    for (int idx = bidx * 512 + tid; idx < DEPTH * NEXP * D; idx += gsz * 512) {
        const int l = idx / (NEXP * D), r = idx % (NEXP * D), e = r / D, d = r % D;
        WS(float, WS_RWT)[idx] = A->in[I_RW][((size_t)l * D + d) * NEXP + e];
    }
    if (bidx == 0 && wave == 0) {
        for (int l = 0; l < DEPTH; ++l) { const float* lf = A->in[I_DFLAM] + l * 256;
            const float a = wave_sum(lf[lane] * lf[64 + lane]), b = wave_sum(lf[128 + lane] * lf[192 + lane]);
            if (lane == 0) WS(float, WS_LAM)[l] = __expf(a) - __expf(b) + (0.8f - 0.6f * __expf(-0.3f * (float)l)); }
    }
    __syncthreads();
    if (bidx < (DEPTH * 6144) / 512) {
        LAS float* ca = (LAS float*)lds;
        for (int i = tid; i < NB * D; i += 512) { const float v = A->in[I_C][i]; ca[i] = v / (1.0f + __expf(-v)); }
        __syncthreads();
        const int col = bidx * 512 + tid, l = col / 6144, m = col % 6144;
        const float* w = A->in[I_ADAW] + (size_t)l * D * 6144 + m;
        float acc[NB];
#pragma unroll
        for (int b = 0; b < NB; ++b) acc[b] = 0.f;
        for (int d = 0; d < D; ++d) { const float wv = w[(size_t)d * 6144];
#pragma unroll
            for (int b = 0; b < NB; ++b) acc[b] += ca[b * D + d] * wv; }
        const float bias = A->in[I_ADAB][col];
#pragma unroll
        for (int b = 0; b < NB; ++b) WS(float, WS_MOD)[((size_t)l * NB + b) * 6144 + m] = acc[b] + bias;
        __syncthreads();
    }
}
__device__ __forceinline__ void pro_b(int wvx) {
    TIDX;
    for (int tok = gw; tok < T; tok += ngw) {
        const int b = tok / SEQ; const float* mod = WS(float, WS_MOD) + (size_t)b * 6144;
        const GAS f32x4* xr = (const GAS f32x4*)(A->in[I_X] + (size_t)tok * D) + lane;
        GAS unsigned long long* o8 = (GAS unsigned long long*)(WS(bf16, WS_U) + (size_t)tok * D) + lane;
#pragma unroll
        for (int j = 0; j < 4; ++j) { const f32x4 x = xr[64 * j]; const f32x4 sh = *(const f32x4*)(mod + 4 * lane + 256 * j), sc = *(const f32x4*)(mod + 1024 + 4 * lane + 256 * j);
            const f32x4 u = x * (1.0f + sc) + sh; o8[64 * j] = (unsigned long long)pk2(u.x, u.y) | ((unsigned long long)pk2(u.z, u.w) << 32); }
    }
}
__device__ __forceinline__ void ph_post(int l, int wvx) {
    TIDX;
    const bf16* H = WS(bf16, WS_H); bf16* XKP = WS(bf16, WS_XKP); bf16* QKC = WS(bf16, WS_QKC);
    const float* cw = A->in[I_CONVW] + (size_t)l * 4 * 512; const float* cb = A->in[I_CONVB] + (size_t)l * 512;
    const float gi = A->in[I_IDXG][l * 64 + lane], bi = A->in[I_IDXB][l * 64 + lane];
    bf16 nxk = 0; float2 ncs = make_float2(1.f, 0.f); v4u nraw[4];
#define POST_LOAD(tk) do { const int s_ = (tk) % SEQ; nxk = H[(size_t)(tk) * NHC + HC_XK + lane]; ncs = WS(float2, WS_CS)[(size_t)(tk) * 32 + (lane & 31)]; \
        _Pragma("unroll") for (int j = 0; j < 4; ++j) { nraw[j] = (v4u){0u, 0u, 0u, 0u}; if (s_ - 3 + j >= 0) nraw[j] = *(const GAS v4u*)(H + (size_t)((tk) - 3 + j) * NHC + 8 * lane); } } while (0)
    if (gw < T) POST_LOAD(gw);
    for (int tok = gw; tok < T; tok += ngw) {
        const bf16 cxk = nxk; const float2 cs = ncs; v4u craw[4];
#pragma unroll
        for (int j = 0; j < 4; ++j) craw[j] = nraw[j];
        if (tok + ngw < T) POST_LOAD(tok + ngw);
        {
            const float v = bf2f(cxk);
            const float mean = wave_sum(v) * (1.0f / 64.0f); const float dv = v - mean;
            const float var = wave_sum(dv * dv) * (1.0f / 64.0f);
            const float nv = dv * (1.0f / sqrtf(var + LN_EPS)) * gi + bi;
            const float pv = shx(nv, lane, 32);
            const int i = lane & 31;
            const float o = (lane < 32) ? (nv * cs.x - pv * cs.y) : (nv * cs.x + pv * cs.y);
            XKP[(size_t)tok * 64 + 2 * i + (lane >> 5)] = (bf16)f2bf(o);
        }
        {
            const int c0 = 8 * lane;
            float acc[8];
#pragma unroll
            for (int c = 0; c < 8; ++c) acc[c] = cb[c0 + c];
#pragma unroll
            for (int j = 0; j < 4; ++j) {
                const unsigned rw[4] = {craw[j].x, craw[j].y, craw[j].z, craw[j].w};
#pragma unroll
                for (int c = 0; c < 8; ++c) { const float x = __uint_as_float((c & 1) ? (rw[c >> 1] & 0xffff0000u) : (rw[c >> 1] << 16)); acc[c] += cw[j * 512 + c0 + c] * x; }
            }
            v4u o;
#define SILU(x) ((x) / (1.0f + __expf(-(x))))
            o.x = pk2(SILU(acc[0]), SILU(acc[1])); o.y = pk2(SILU(acc[2]), SILU(acc[3])); o.z = pk2(SILU(acc[4]), SILU(acc[5])); o.w = pk2(SILU(acc[6]), SILU(acc[7]));
#undef SILU
            *(GAS v4u*)(QKC + (size_t)tok * 512 + c0) = o;
        }
    }
#undef POST_LOAD
}
typedef float f32x16 __attribute__((ext_vector_type(16)));
__device__ __forceinline__ void select_load(const float* SC, int tok, int lane, f32x4 (&raw)[8]);
__device__ __forceinline__ void select_row(const f32x4 (&raw)[8], unsigned* MASK, int tok, int lane);
__device__ __forceinline__ void ph_idx_scores(int wvx) {
    TIDX;
    const bf16* H = WS(bf16, WS_H); const bf16* XKP = WS(bf16, WS_XKP); float* SC = WS(float, WS_SC); unsigned* MASK = WS(unsigned, WS_MASK);
    const int r = lane & 31, hh = lane >> 5, ql = r >> 3, hd = r & 7;
    for (int item = bidx; item < 256; item += gsz) {
        const int b = item >> 4, p = item & 15;
#pragma unroll 1
        for (int sub = 0; sub < 2; ++sub) {
            const int qblk = sub ? 31 - p : p, q0 = qblk * 64 + 8 * wave, tok0 = b * SEQ + q0;
            bf16x8 af[2][4];
#pragma unroll
            for (int g = 0; g < 2; ++g) { const bf16* ap = H + (size_t)(tok0 + 4 * g + ql) * NHC + HC_XQ + hd * 64 + 8 * hh;
#pragma unroll
              for (int ks = 0; ks < 4; ++ks) af[g][ks] = *(const GAS bf16x8*)(ap + ks * 16); }
            float wv[2][4][4];
#pragma unroll
            for (int g = 0; g < 2; ++g)
#pragma unroll
                for (int q = 0; q < 4; ++q)
#pragma unroll
                    for (int i = 0; i < 4; ++i) wv[g][q][i] = bf2f(H[(size_t)(tok0 + 4 * g + q) * NHC + HC_XW + 4 * hh + i]);
            const int npair = qblk + 1;
            const bf16* kp = XKP + (size_t)(b * SEQ + r) * 64 + 8 * hh;
            bf16x8 bc[2][4], bn[2][4];
#pragma unroll
            for (int t2 = 0; t2 < 2; ++t2)
#pragma unroll
                for (int ks = 0; ks < 4; ++ks) bc[t2][ks] = *(const GAS bf16x8*)(kp + t2 * 2048 + ks * 16);
            for (int pr = 0; pr < npair; ++pr) {
                const bf16* kn = kp + (size_t)((pr + 1 < npair) ? pr + 1 : pr) * 4096;
#pragma unroll
                for (int t2 = 0; t2 < 2; ++t2)
#pragma unroll
                    for (int ks = 0; ks < 4; ++ks) bn[t2][ks] = *(const GAS bf16x8*)(kn + t2 * 2048 + ks * 16);
#pragma unroll
                for (int t2 = 0; t2 < 2; ++t2) {
                    const int key = pr * 64 + t2 * 32 + r;
#pragma unroll
                    for (int g = 0; g < 2; ++g) {
                        f32x16 acc = {};
#pragma unroll
                        for (int ks = 0; ks < 4; ++ks) acc = __builtin_amdgcn_mfma_f32_32x32x16_bf16(af[g][ks], bc[t2][ks], acc, 0, 0, 0);
                        float tot[4];
#pragma unroll
                        for (int q = 0; q < 4; ++q) { float pp = 0.f;
#pragma unroll
                            for (int i = 0; i < 4; ++i) pp += wv[g][q][i] * fmaxf(acc[4 * q + i], 0.f);
                            tot[q] = pp + shx(pp, lane, 32); }
                        const float o0 = hh ? tot[2] : tot[0], o1 = hh ? tot[3] : tot[1];
                        SC[(size_t)(tok0 + 4 * g + 2 * hh) * SEQ + key] = o0; SC[(size_t)(tok0 + 4 * g + 2 * hh + 1) * SEQ + key] = o1;
                    }
                }
#pragma unroll
                for (int t2 = 0; t2 < 2; ++t2)
#pragma unroll
                    for (int ks = 0; ks < 4; ++ks) bc[t2][ks] = bn[t2][ks];
            }
            asm volatile("s_waitcnt vmcnt(0)" ::: "memory"); __builtin_amdgcn_fence(__ATOMIC_ACQUIRE, "agent"); asm volatile("s_waitcnt vmcnt(0)" ::: "memory");
            { f32x4 rawc[8], rawn[8]; select_load(SC, tok0, lane, rawc);
#pragma unroll 1
              for (int q = 0; q < 8; ++q) { if (q + 1 < 8) select_load(SC, tok0 + q + 1, lane, rawn);
                  select_row(rawc, MASK, tok0 + q, lane);
#pragma unroll
                  for (int j = 0; j < 8; ++j) rawc[j] = rawn[j]; } }
        }
    }
}
constexpr size_t WS_OD = WS_END;
constexpr size_t WS_END2 = WS_END + 64 * MiB;
__device__ __forceinline__ void ph_diff_attn(LAS unsigned char* lds, int wvx) {
    CArgs* A = kargs();
    const int G = gsz_(), bx = bid_(), vcu = (G % 8 == 0) ? (bx % 8) * (G / 8) + bx / 8 : bx;
    const bf16* H = WS(bf16, WS_H); bf16* OD = WS(bf16, WS_OD);
    for (int item = vcu; item < NB * 16; item += G) {
        const int b = item >> 4, vh = item & 15, g = vh >> 1, half = vh & 1;
#pragma unroll 1
        for (int qb = 7; qb >= 0; --qb)
            attn_body::attn_unit<8, false>(wvx, b, qb, H + HC_DQ + g * 64, H + HC_DK + g * 64, H + HC_DV + (g >> 1) * 128 + half * 64, OD + g * 128 + half * 64, nullptr, (char*)lds);
    }
}
__device__ __forceinline__ void ph_diff_post(int l, int wvx) {
    TIDX;
    const bf16* OD = WS(bf16, WS_OD); bf16* MIX = WS(bf16, WS_MIX);
    const float lam = WS(float, WS_LAM)[l], sc1m = 1.0f - (0.8f - 0.6f * __expf(-0.3f * (float)l));
    const int h = lane >> 4, c0 = (lane & 15) * 8;
    float gv[8];
    { const float* g = A->in[I_DFNORM] + l * 512 + h * 128 + c0;
#pragma unroll
      for (int e = 0; e < 8; ++e) gv[e] = g[e] * sc1m; }
    us8 n1 = {}, n2 = {};
    if (gw < T) { n1 = *(const GAS us8*)(OD + (size_t)gw * D + (2 * h) * 128 + c0); n2 = *(const GAS us8*)(OD + (size_t)gw * D + (2 * h + 1) * 128 + c0); }
    for (int tok = gw; tok < T; tok += ngw) {
        const us8 a1 = n1, a2 = n2;
        if (tok + ngw < T) { n1 = *(const GAS us8*)(OD + (size_t)(tok + ngw) * D + (2 * h) * 128 + c0); n2 = *(const GAS us8*)(OD + (size_t)(tok + ngw) * D + (2 * h + 1) * 128 + c0); }
        float d[8], ss = 0.f;
#pragma unroll
        for (int e = 0; e < 8; ++e) { d[e] = bf2f(a1[e]) - lam * bf2f(a2[e]); ss += d[e] * d[e]; }
        ss += DPPF(ss, 0xB1); ss += DPPF(ss, 0x4E); ss += DPPF(ss, 0x141); ss += DPPF(ss, 0x140);
        const float rs = 1.0f / sqrtf(ss * (1.0f / 128.0f) + LN_EPS);
        v4u o; o.x = pk2(d[0] * rs * gv[0], d[1] * rs * gv[1]); o.y = pk2(d[2] * rs * gv[2], d[3] * rs * gv[3]); o.z = pk2(d[4] * rs * gv[4], d[5] * rs * gv[5]); o.w = pk2(d[6] * rs * gv[6], d[7] * rs * gv[7]);
        *(GAS v4u*)(MIX + (size_t)tok * D + 256 + h * 128 + c0) = o;
    }
}
__device__ __forceinline__ void ph_dsa_attn(LAS unsigned char* lds, int wvx) {
    CArgs* A = kargs();
    const int G = gsz_(), bx = bid_(), vcu = (G % 8 == 0) ? (bx % 8) * (G / 8) + bx / 8 : bx;
    const bf16* H = WS(bf16, WS_H); bf16* MIX = WS(bf16, WS_MIX); const unsigned* MASK = WS(unsigned, WS_MASK);
    for (int item = vcu; item < NB * 4 * 4; item += G) {
        const int bh = item >> 2, p = item & 3, b = bh >> 2, h = bh & 3;
        attn_body::attn_unit<8, true>(wvx, b, 7 - p, H + HC_SQ + h * 64, H + HC_SK + h * 64, H + HC_SV + h * 64, MIX + 768 + h * 64, MASK, (char*)lds);
        attn_body::attn_unit<8, true>(wvx, b, p, H + HC_SQ + h * 64, H + HC_SK + h * 64, H + HC_SV + h * 64, MIX + 768 + h * 64, MASK, (char*)lds);
    }
}
constexpr size_t WS_DC = WS_END2;
constexpr size_t WS_CST = WS_DC + 32 * MiB;
constexpr size_t WS_DN = WS_CST + 32 * MiB;
constexpr size_t WS_END3 = WS_DN + 4 * MiB;
constexpr size_t WS_DUMMY = WS_END3;
constexpr size_t WS_END4 = WS_DUMMY + 256 * MiB;
typedef float f32x2_ __attribute__((ext_vector_type(2)));
constexpr int MP = 68;
__device__ __forceinline__ float log_sigmoid_(float x) { return fminf(x, 0.f) - log1pf(__expf(-fabsf(x))); }
__device__ __forceinline__ void mlstm_gates(bf16 iraw, bf16 fraw, float gbi, float gbf, int lane, LAS float* bcum, LAS float* av) {
    const float ip = bf2f(iraw) + gbi; float lf = log_sigmoid_(bf2f(fraw) + gbf);
#pragma unroll
    for (int o = 1; o < 64; o <<= 1) { const float t_ = shup(lf, lane, o); if (lane >= o) lf += t_; }
    bcum[lane] = lf; av[lane] = ip - lf;
}
constexpr int PB = 72;

__device__ __forceinline__ f32x16 mfma_tile(const LAS bf16* Xa, int mt, const LAS bf16* Xb, int nt, int r, int hh, f32x16 acc) {
#pragma unroll
    for (int ks = 0; ks < 4; ++ks) { const bf16x8 a = *(const LAS bf16x8*)(Xa + (32 * mt + r) * PB + 16 * ks + 8 * hh), b = *(const LAS bf16x8*)(Xb + (32 * nt + r) * PB + 16 * ks + 8 * hh);
        acc = __builtin_amdgcn_mfma_f32_32x32x16_bf16(a, b, acc, 0, 0, 0); }
    return acc;
}
__device__ __forceinline__ void ph_mlstm_m1(LAS unsigned char* lds, int l, int wvx) {
    TIDX;
    const bf16* H = WS(bf16, WS_H); const bf16* QKC = WS(bf16, WS_QKC);
    float* DC = WS(float, WS_DC); float* DN = WS(float, WS_DN); float* SCAL = WS(float, WS_DN + 2 * MiB);
    LAS bf16* kT = (LAS bf16*)lds; LAS bf16* vwT = kT + 64 * PB;
    LAS float* bcum = (LAS float*)(vwT + 96 * PB); LAS float* av = bcum + 64; LAS float* wv = av + 64;
    const int r = lane & 31, hh = lane >> 5, srow = tid >> 3, ch = tid & 7;
    us8 nk = {}, nv_ = {}; bf16 nig = 0, nfg = 0;
#define M1_LOAD(uu) do { const int bh_ = (uu) >> 5, c_ = (uu) & 31, t0_ = (bh_ >> 2) * SEQ + c_ * 64, h_ = bh_ & 3; \
        nk = *(const GAS us8*)(QKC + (size_t)(t0_ + srow) * 512 + 256 + h_ * 64 + 8 * ch); nv_ = *(const GAS us8*)(H + (size_t)(t0_ + srow) * NHC + HC_MV + h_ * 64 + 8 * ch); \
        if (wave == 0) { nig = H[(size_t)(t0_ + lane) * NHC + HC_MI + h_]; nfg = H[(size_t)(t0_ + lane) * NHC + HC_MF + h_]; } } while (0)
    M1_LOAD(bidx);
    for (int u = bidx; u < NB * 4 * 32; u += gsz) {
        const int bh = u >> 5, c = u & 31, b = bh >> 2, h = bh & 3, tok0 = b * SEQ + c * 64; (void)tok0;
        const us8 kraw = nk, vraw = nv_; const bf16 igr = nig, fgr = nfg;
        if (u + gsz < NB * 4 * 32) M1_LOAD(u + gsz);
        if (wave == 0) { mlstm_gates(igr, fgr, A->in[I_GATEB][l * 8 + h], A->in[I_GATEB][l * 8 + 4 + h], lane, bcum, av); }
        __syncthreads();
        if (wave == 0) { const float a = av[lane], amax = wave_max(a); wv[lane] = __expf(a - amax); if (lane == 0) { SCAL[u * 4 + 0] = bcum[63]; SCAL[u * 4 + 1] = bcum[63] + amax; } }
        __syncthreads();
        { const float w = wv[srow];
#pragma unroll
          for (int e = 0; e < 8; ++e) { kT[(8 * ch + e) * PB + srow] = kraw[e]; vwT[(8 * ch + e) * PB + srow] = (bf16)f2bf(w * bf2f(vraw[e])); }
          if (tid < 64) vwT[64 * PB + tid] = (bf16)f2bf(wv[tid]);
          for (int i = tid; i < 31 * 64; i += 512) vwT[(65 + i / 64) * PB + (i & 63)] = 0; }
        __syncthreads();
        if (wave < 6) { const int mt = wave >> 1, nt = wave & 1;
            f32x16 acc = {}; acc = mfma_tile(vwT, mt, kT, nt, r, hh, acc);
#pragma unroll
            for (int g = 0; g < 16; ++g) { const int vrow = 32 * mt + (g & 3) + 8 * (g >> 2) + 4 * hh, d = 32 * nt + r;
                if (vrow < 64) DC[(size_t)u * 4096 + vrow * 64 + d] = acc[g]; else if (vrow == 64) DN[(size_t)u * 64 + d] = acc[g]; } }
        __syncthreads();
    }
#undef M1_LOAD
}
__device__ __forceinline__ void ph_mlstm_m2(int wvx) {
    TIDX;
    const float* DC = WS(float, WS_DC); float* CS = WS(float, WS_CST); const float* DN = WS(float, WS_DN); float* NS = WS(float, WS_DN + 1 * MiB); float* SCAL = WS(float, WS_DN + 2 * MiB);
    for (int item = bidx; item < NB * 4 * 4; item += gsz) {
        const int bh = item >> 2, qtr = item & 3, e0 = qtr * 1024 + tid * 2;
        f32x2_ dc[32]; float dn[32];
#pragma unroll
        for (int c = 0; c < 32; ++c) { dc[c] = *(const GAS f32x2_*)(DC + (size_t)(bh * 32 + c) * 4096 + e0); dn[c] = (qtr == 0 && tid < 64) ? DN[(size_t)(bh * 32 + c) * 64 + tid] : 0.f; }
        float z_ = 0.f; asm volatile("" : "+v"(z_));
        float m = 0.f; f32x2_ C = (f32x2_){z_, z_}; float n = z_;
#pragma unroll
        for (int c = 0; c < 32; ++c) {
            const int u = bh * 32 + c;
            const float bl = SCAL[u * 4 + 0], ml = SCAL[u * 4 + 1];
            *(GAS f32x2_*)(CS + (size_t)u * 4096 + e0) = C;
            if (qtr == 0 && tid < 64) NS[(size_t)u * 64 + tid] = n;
            if (qtr == 0 && tid == 0) SCAL[u * 4 + 2] = m;
            const float mn = fmaxf(bl + m, ml), f1 = __expf(bl + m - mn), f2 = __expf(ml - mn);
            C.x = f1 * C.x + f2 * dc[c].x; C.y = f1 * C.y + f2 * dc[c].y;
            n = f1 * n + f2 * dn[c];
            m = mn;
        }
    }
}
__device__ __forceinline__ void ph_mlstm_m3(LAS unsigned char* lds, int l, int wvx) {
    TIDX;
    const bf16* H = WS(bf16, WS_H); const bf16* QKC = WS(bf16, WS_QKC); bf16* MIX = WS(bf16, WS_MIX);
    const float* CS = WS(float, WS_CST); const float* NS = WS(float, WS_DN + 1 * MiB); const float* SCAL = WS(float, WS_DN + 2 * MiB);
    LAS bf16* qS = (LAS bf16*)lds; LAS bf16* kS = qS + 64 * PB; LAS bf16* vT = kS + 64 * PB; LAS bf16* cT = vT + 96 * PB; LAS bf16* Sb = cT + 96 * PB;
    LAS float* hS = (LAS float*)(Sb + 64 * PB);
    LAS float* bcum = hS + 64 * MP; LAS float* av = bcum + 64; LAS float* mm = av + 64; LAS float* inter = mm + 64; LAS float* dinv = inter + 64;
    const int r = lane & 31, hh = lane >> 5, srow = tid >> 3, ch = tid & 7;
    us8 nq = {}, nk = {}, nv_ = {}; f32x4 nc0 = {}, nc1 = {}; bf16 nog[8] = {}; bf16 nig = 0, nfg = 0; float nns = 0.f, nmc = 0.f;
#define M3_LOAD(uu) do { const int bh_ = (uu) >> 5, c_ = (uu) & 31, t0_ = (bh_ >> 2) * SEQ + c_ * 64, h_ = bh_ & 3; \
        nq = *(const GAS us8*)(QKC + (size_t)(t0_ + srow) * 512 + h_ * 64 + 8 * ch); nk = *(const GAS us8*)(QKC + (size_t)(t0_ + srow) * 512 + 256 + h_ * 64 + 8 * ch); \
        nv_ = *(const GAS us8*)(H + (size_t)(t0_ + srow) * NHC + HC_MV + h_ * 64 + 8 * ch); \
        nc0 = *(const GAS f32x4*)(CS + (size_t)(uu) * 4096 + srow * 64 + 8 * ch); nc1 = *(const GAS f32x4*)(CS + (size_t)(uu) * 4096 + srow * 64 + 8 * ch + 4); \
        _Pragma("unroll") for (int j = 0; j < 8; ++j) nog[j] = H[(size_t)(t0_ + wave + 8 * j) * NHC + HC_MO + h_ * 64 + lane]; \
        nmc = SCAL[(uu) * 4 + 2]; if (tid < 64) nns = NS[(size_t)(uu) * 64 + tid]; \
        if (wave == 0) { nig = H[(size_t)(t0_ + lane) * NHC + HC_MI + h_]; nfg = H[(size_t)(t0_ + lane) * NHC + HC_MF + h_]; } } while (0)
    M3_LOAD(bidx);
    for (int u = bidx; u < NB * 4 * 32; u += gsz) {
        const int bh = u >> 5, c = u & 31, b = bh >> 2, h = bh & 3, tok0 = b * SEQ + c * 64;
        const float mc = nmc, nsv = nns;
        bf16 ograw[8];
#pragma unroll
        for (int j = 0; j < 8; ++j) ograw[j] = nog[j];
        const float gnorm = A->in[I_MNORM][l * 256 + h * 64 + lane];
        const us8 qraw = nq, kraw = nk, vraw = nv_; const f32x4 c0 = nc0, c1 = nc1; const bf16 igr = nig, fgr = nfg;
        if (u + gsz < NB * 4 * 32) M3_LOAD(u + gsz);
        {
            us8 qs;
#pragma unroll
            for (int e = 0; e < 8; ++e) qs[e] = (bf16)f2bf(bf2f(qraw[e]) * 0.125f);
            *(LAS us8*)(qS + srow * PB + 8 * ch) = qs; *(LAS us8*)(kS + srow * PB + 8 * ch) = kraw;
#pragma unroll
            for (int e = 0; e < 8; ++e) vT[(8 * ch + e) * PB + srow] = vraw[e];
            v4u cp; cp.x = pk2(c0[0], c0[1]); cp.y = pk2(c0[2], c0[3]); cp.z = pk2(c1[0], c1[1]); cp.w = pk2(c1[2], c1[3]);
            *(LAS v4u*)(cT + srow * PB + 8 * ch) = cp;
            if (tid < 64) { vT[64 * PB + tid] = (bf16)0x3f80; cT[64 * PB + tid] = (bf16)f2bf(nsv); }
            for (int i = tid; i < 31 * 64; i += 512) { vT[(65 + i / 64) * PB + (i & 63)] = 0; cT[(65 + i / 64) * PB + (i & 63)] = 0; }
        }
        if (wave == 0) { mlstm_gates(igr, fgr, A->in[I_GATEB][l * 8 + h], A->in[I_GATEB][l * 8 + 4 + h], lane, bcum, av); }
        __syncthreads();
        if (wave == 0) { float pm = av[lane];
#pragma unroll
            for (int o = 1; o < 64; o <<= 1) { const float t_ = shup(pm, lane, o); if (lane >= o) pm = fmaxf(pm, t_); }
            const float m_ = fmaxf(mc, pm); mm[lane] = m_; inter[lane] = __expf(mc - m_); }
        __syncthreads();
        if (wave < 4) { const int tt = wave >> 1, st = wave & 1;
            f32x16 acc = {}; acc = mfma_tile(qS, tt, kS, st, r, hh, acc);
            const int s = 32 * st + r; const float as = av[s];
#pragma unroll
            for (int g = 0; g < 16; ++g) { const int t = 32 * tt + (g & 3) + 8 * (g >> 2) + 4 * hh;
                const float val = (s <= t) ? acc[g] * __expf(as - mm[t]) : 0.f; Sb[t * PB + s] = (bf16)f2bf(val); } }
        __syncthreads();
        f32x16 aS = {}, aC = {}; const int tt = (wave < 6) ? wave / 3 : 0, nt = (wave < 6) ? wave % 3 : 0;
        if (wave < 6) { aS = mfma_tile(Sb, tt, vT, nt, r, hh, aS); aC = mfma_tile(qS, tt, cT, nt, r, hh, aC); }
        if (wave < 6 && nt == 2 && r == 0) {
#pragma unroll
            for (int g = 0; g < 16; ++g) { const int t = 32 * tt + (g & 3) + 8 * (g >> 2) + 4 * hh;
                const float dn = aS[g] + inter[t] * aC[g]; dinv[t] = 1.0f / fmaxf(fabsf(dn), __expf(-(bcum[t] + mm[t]))); } }
        __syncthreads();
        if (wave < 6 && nt < 2) {
#pragma unroll
            for (int g = 0; g < 16; ++g) { const int t = 32 * tt + (g & 3) + 8 * (g >> 2) + 4 * hh;
                hS[t * MP + 32 * nt + r] = (aS[g] + inter[t] * aC[g]) * dinv[t]; } }
        __syncthreads();
#pragma unroll
        for (int j = 0; j < 8; ++j) { const int t = wave + 8 * j, vc = lane; const size_t tk = (size_t)(tok0 + t);
            const float hv = hS[t * MP + vc];
            const float mean = wave_sum(hv) * (1.0f / 64.0f), hc = hv - mean;
            const float rs = 1.0f / sqrtf(wave_sum(hc * hc) * (1.0f / 64.0f) + LN_EPS);
            const float og = sigmoidf_(bf2f(ograw[j]));
            MIX[tk * D + h * 64 + vc] = (bf16)f2bf(og * (hc * rs * gnorm)); }
        __syncthreads();
    }
#undef M3_LOAD
}
__device__ __forceinline__ int wave_sum_i(int x) {
    x += __builtin_amdgcn_update_dpp(0, x, 0xB1, 0xF, 0xF, true);
    x += __builtin_amdgcn_update_dpp(0, x, 0x4E, 0xF, 0xF, true);
    x += __builtin_amdgcn_update_dpp(0, x, 0x141, 0xF, 0xF, true);
    x += __builtin_amdgcn_update_dpp(0, x, 0x140, 0xF, 0xF, true);
    return __builtin_amdgcn_readlane(x, 0) + __builtin_amdgcn_readlane(x, 16) + __builtin_amdgcn_readlane(x, 32) + __builtin_amdgcn_readlane(x, 48);
}
__device__ __forceinline__ void select_load(const float* SC, int tok, int lane, f32x4 (&raw)[8]) {
    const int tl = tok % SEQ, lo = 32 * lane; const bool need = (tl >= 256) && (tl + 1 - lo > 0);
#pragma unroll
    for (int j = 0; j < 8; ++j) { raw[j] = (f32x4){0.f, 0.f, 0.f, 0.f}; if (need) raw[j] = *(const GAS f32x4*)(SC + (size_t)tok * SEQ + lo + 4 * j); }
}
__device__ __forceinline__ void select_row(const f32x4 (&raw)[8], unsigned* MASK, int tok, int lane) {
        const int tl = tok % SEQ, lo = 32 * lane;
        const int nv = min(max(tl + 1 - lo, 0), 32);
        unsigned cand = (nv >= 32) ? 0xffffffffu : ((1u << nv) - 1u);
        if (tl < 256) { MASK[(size_t)tok * 64 + lane] = cand; return; }
        unsigned a[32];
#pragma unroll
        for (int j = 0; j < 8; ++j) {
            const f32x4 v = raw[j];
#pragma unroll
            for (int c = 0; c < 4; ++c) { unsigned u = __float_as_uint(v[c]); u = (u == 0x80000000u) ? 0u : u; a[4 * j + c] = (u >> 31) ? ~u : (u | 0x80000000u); }
        }
#define TSTAGE(J, M) _Pragma("unroll") for (int k0 = 0; k0 < 32; ++k0) { if ((k0 & J) == 0) { const unsigned t_ = ((a[k0] >> J) ^ a[k0 + J]) & M; a[k0] ^= t_ << J; a[k0 + J] ^= t_; } }
        TSTAGE(16, 0x0000FFFFu) TSTAGE(8, 0x00FF00FFu) TSTAGE(4, 0x0F0F0F0Fu) TSTAGE(2, 0x33333333u) TSTAGE(1, 0x55555555u)
#undef TSTAGE
        unsigned sel = 0u; int need = 256, ncand = tl + 1;
#pragma unroll
        for (int b = 31; b >= 0; --b) {
            if (ncand != need) {
                const unsigned hit = cand & a[b];
                const int cnt = wave_sum_i(__popc(hit));
                if (cnt >= need) { cand = hit; ncand = cnt; }
                else { sel |= hit; cand &= ~a[b]; need -= cnt; ncand -= cnt; }
            }
        }
        if (ncand == need) sel |= cand;
        else {
            const int my = __popc(cand); int incl = my;
#pragma unroll
            for (int o = 1; o < 64; o <<= 1) { const int t_ = shupi(incl, lane, o); if (lane >= o) incl += t_; }
            const int take = min(max(need - (incl - my), 0), my); int taken = 0;
#pragma unroll 1
            for (int k = 0; k < 32; ++k) { if (((cand >> k) & 1u) && taken < take) { sel |= 1u << k; ++taken; } }
        }
        MASK[(size_t)tok * 64 + lane] = sel;
}
__device__ __forceinline__ f32x4 bf4_(unsigned long long r) { f32x4 y; y.x = __uint_as_float((unsigned)r << 16); y.y = __uint_as_float((unsigned)r & 0xffff0000u); y.z = __uint_as_float((unsigned)(r >> 32) << 16); y.w = __uint_as_float((unsigned)(r >> 32) & 0xffff0000u); return y; }
__device__ __forceinline__ unsigned long long pk4_(f32x4 v) { return (unsigned long long)pk2(v.x, v.y) | ((unsigned long long)pk2(v.z, v.w) << 32); }
constexpr int R1_OFF = RING_BYTES + 8192;
__device__ __forceinline__ void ph_row1(LAS unsigned char* lds, int l, int wvx, bool dry = false) {
    TIDX;
    const float* xin = (l == 0) ? A->in[I_X] : WS(float, WS_XB); float* XB = dry ? WS(float, WS_DUMMY) : WS(float, WS_XB);
    const bf16* Y = WS(bf16, WS_Y); bf16* U = dry ? WS(bf16, WS_DUMMY + 128 * MiB) : WS(bf16, WS_U);
    unsigned* cnt = dry ? WS(unsigned, WS_DUMMY + 200 * MiB) : WS(unsigned, WS_CTL) + CW_CNT + l * NEXP * 64; unsigned* TOK = dry ? WS(unsigned, WS_DUMMY + 192 * MiB) : WS(unsigned, WS_TOK);
    const float* lg = A->in[I_LN1G] + l * D; const float* lb = A->in[I_LN1B] + l * D;
    unsigned* RMAP = dry ? WS(unsigned, WS_DUMMY + 208 * MiB) : WS(unsigned, WS_XG);
    LAS float* rw = (LAS float*)lds; LAS unsigned* lcnt = (LAS unsigned*)(lds + R1_OFF); LAS unsigned* lbase = lcnt + 32; LAS unsigned* nrec = lbase + 32; LAS unsigned* rec = nrec + 4;
    { const GAS f32x4* src = (const GAS f32x4*)(WS(float, WS_RWT) + (size_t)l * NEXP * D);
      for (int i = tid; i < NEXP * D / 4; i += 512) ((LAS f32x4*)rw)[i] = src[i];
      if (tid < 32) lcnt[tid] = 0u; if (tid == 32) nrec[0] = 0u; }
    __syncthreads();
    const float rbias = A->in[I_RB][l * NEXP + (lane >> 1)];
    f32x4 px[4], pg[4]; unsigned long long py[4];
#define R1_LOAD(tk) do { const float* mod_ = WS(float, WS_MOD) + ((size_t)l * NB + (tk) / SEQ) * 6144; _Pragma("unroll") for (int j = 0; j < 4; ++j) { const int c = 4 * lane + 256 * j; \
        px[j] = *(const GAS f32x4*)(xin + (size_t)(tk) * D + c); pg[j] = *(const GAS f32x4*)(mod_ + 2048 + c); py[j] = *(const GAS unsigned long long*)(Y + (size_t)(tk) * D + c); } } while (0)
    if (gw < T) R1_LOAD(gw);
    for (int tok = gw; tok < T; tok += ngw) {
        const int b = tok / SEQ; const float* mod = WS(float, WS_MOD) + ((size_t)l * NB + b) * 6144;
        f32x4 v[4]; float s = 0.f;
#pragma unroll
        for (int j = 0; j < 4; ++j) {
            const f32x4 x = px[j]; const f32x4 g1 = pg[j];
            const unsigned long long yr = py[j];
            f32x4 y; y.x = __uint_as_float((unsigned)yr << 16); y.y = __uint_as_float((unsigned)yr & 0xffff0000u); y.z = __uint_as_float((unsigned)(yr >> 32) << 16); y.w = __uint_as_float((unsigned)(yr >> 32) & 0xffff0000u);
            v[j] = x * DN_ALPHA + (1.0f + g1) * y; s += (v[j].x + v[j].y) + (v[j].z + v[j].w); }
        if (tok + ngw < T) R1_LOAD(tok + ngw);
        const float mean = wave_sum(s) * (1.0f / D); float s2 = 0.f;
#pragma unroll
        for (int j = 0; j < 4; ++j) { v[j] = v[j] - mean; s2 += (v[j].x * v[j].x + v[j].y * v[j].y) + (v[j].z * v[j].z + v[j].w * v[j].w); }
        const float rstd = 1.0f / sqrtf(wave_sum(s2) * (1.0f / D) + LN_EPS);
        f32x4 u2[4];
#pragma unroll
        for (int j = 0; j < 4; ++j) { const int c = 4 * lane + 256 * j;
            const f32x4 xn = v[j] * rstd * *(const f32x4*)(lg + c) + *(const f32x4*)(lb + c);
            *(GAS f32x4*)(XB + (size_t)tok * D + c) = xn;
            u2[j] = xn * (1.0f + *(const f32x4*)(mod + 4096 + c)) + *(const f32x4*)(mod + 3072 + c);
            *(GAS unsigned*)((unsigned char*)U + (size_t)tok * D + c) = pg8::pk4_fp8(u2[j].x, u2[j].y, u2[j].z, u2[j].w, 16.0f); }
        float part[32];
#pragma unroll
        for (int e = 0; e < 32; ++e) { float a = 0.f;
#pragma unroll
            for (int j = 0; j < 4; ++j) { const f32x4 w = *(const LAS f32x4*)(rw + e * D + 4 * lane + 256 * j); a += (u2[j].x * w.x + u2[j].y * w.y) + (u2[j].z * w.z + u2[j].w * w.w); }
            part[e] = a; }
#define RSTEP(N, OFF) _Pragma("unroll") for (int e = 0; e < N; ++e) { const bool hi = (lane & OFF) != 0; const float send = hi ? part[e] : part[e + N]; const float recv = shx(send, lane, OFF); part[e] = (hi ? part[e + N] : part[e]) + recv; }
        RSTEP(16, 32) RSTEP(8, 16) RSTEP(4, 8) RSTEP(2, 4) RSTEP(1, 2)
#undef RSTEP
        float logit = part[0] + shx(part[0], lane, 1) + rbias;
        const int myexp = lane >> 1;
        int rank = 0;
#pragma unroll
        for (int j = 0; j < 32; ++j) { const float lj = __int_as_float(__builtin_amdgcn_readlane(__float_as_int(logit), 2 * j)); rank += (lj > logit || (lj == logit && j < myexp)) ? 1 : 0; }
        float tv[4]; int te[4];
#pragma unroll
        for (int k = 0; k < 4; ++k) { const unsigned long long bm = __ballot(rank == k); const int ln = (int)__builtin_ctzll(bm); te[k] = ln >> 1; tv[k] = __int_as_float(__builtin_amdgcn_readlane(__float_as_int(logit), ln)); }
        const float e1 = __expf(tv[1] - tv[0]), e2 = __expf(tv[2] - tv[0]), e3 = __expf(tv[3] - tv[0]); const float inv = 1.0f / (1.0f + e1 + e2 + e3);
        if (lane < 4) { const int ek = lane == 0 ? te[0] : lane == 1 ? te[1] : lane == 2 ? te[2] : te[3]; const float pk = (lane == 0 ? 1.0f : lane == 1 ? e1 : lane == 2 ? e2 : e3) * inv;
            const unsigned lp = __hip_atomic_fetch_add(lcnt + ek, 1u, __ATOMIC_RELAXED, __HIP_MEMORY_SCOPE_WORKGROUP);
            const unsigned ri = __hip_atomic_fetch_add(nrec, 1u, __ATOMIC_RELAXED, __HIP_MEMORY_SCOPE_WORKGROUP);
            if (ri < 640u) { LAS unsigned* r = rec + ri * 3; r[0] = (unsigned)tok * 4u + (unsigned)lane; r[1] = (unsigned)ek | (lp << 8); r[2] = __float_as_uint(pk); } }
    }
#undef R1_LOAD
    __syncthreads();
    if (tid < 32) lbase[tid] = __hip_atomic_fetch_add(cnt + tid * 64, lcnt[tid], __ATOMIC_RELAXED, __HIP_MEMORY_SCOPE_AGENT);
    __syncthreads();
    { const int n = (int)min(nrec[0], 640u);
      for (int i = tid; i < n; i += 512) { const unsigned r0 = rec[i * 3], r1 = rec[i * 3 + 1], r2 = rec[i * 3 + 2]; const unsigned ek = r1 & 255u;
          const unsigned pos = lbase[ek] + (r1 >> 8);
          *(GAS v4u*)(TOK + (size_t)r0 * 4) = (v4u){ek, pos, r2, 0u}; RMAP[(size_t)ek * T + pos] = r0 >> 2; } }
    __syncthreads();
}
__device__ __forceinline__ int moe_tables(LAS unsigned char* lds, int l, int wvx) {
    CArgs* A = kargs();
    LAS unsigned* base = (LAS unsigned*)(lds + TAB_OFF); LAS unsigned char* tile_e = lds + TAB_OFF + 256; LAS unsigned* cntl = (LAS unsigned*)(lds + TAB_OFF + 1024);
    const unsigned* cnt = WS(unsigned, WS_CTL) + CW_CNT + l * NEXP * 64;
    if (wvx == 0) {
        const int lane = lane_id_(), e = lane & 31;
        const unsigned c = __hip_atomic_load(cnt + e * 64, __ATOMIC_RELAXED, __HIP_MEMORY_SCOPE_AGENT);
        const int nt = (int)((c + 255u) >> 8); int incl = nt;
#pragma unroll
        for (int o = 1; o < 32; o <<= 1) { const int t_ = shupi(incl, lane, o); if (e >= o) incl += t_; }
        if (lane < 32) { const int t0 = incl - nt; base[e] = (unsigned)t0 << 8; cntl[e] = c; if (e == 31) base[NEXP] = (unsigned)incl << 8;
#pragma unroll 1
            for (int t = 0; t < nt; ++t) tile_e[t0 + t] = (unsigned char)e; }
    }
    __syncthreads();
    return (int)(base[NEXP] >> 8);
}
__device__ __forceinline__ void ph_row2(LAS unsigned char* lds, int l, int wvx, bool dry = false) {
    TIDX;
    (void)moe_tables(lds, l, wvx);
    const LAS unsigned* base = (const LAS unsigned*)(lds + TAB_OFF);
    float* XB = WS(float, WS_XB); const bf16* YM = WS(bf16, WS_YM); bf16* U = WS(bf16, WS_U); const unsigned* TOK = WS(unsigned, WS_TOK);
    const float* lg = A->in[I_LN2G] + l * D; const float* lb = A->in[I_LN2B] + l * D; const float* b2 = A->in[I_B2] + (size_t)l * NEXP * D;
    float* dst = dry ? WS(float, WS_DUMMY) : (l == DEPTH - 1) ? A->out : XB; bf16* Uw = dry ? WS(bf16, WS_DUMMY + 128 * MiB) : U;
    v4u rcA[4], rcB[4]; unsigned yq[4][4]; f32x4 xq[4];
#define R2_REC(dst, tk) do { _Pragma("unroll") for (int k = 0; k < 4; ++k) dst[k] = *(const GAS v4u*)(TOK + ((size_t)(tk) * 4 + k) * 4); } while (0)
#define R2_ROWS(rc, tk) do { _Pragma("unroll") for (int k = 0; k < 4; ++k) { const size_t row_ = (size_t)base[rc[k].x] + rc[k].y; _Pragma("unroll") for (int j = 0; j < 4; ++j) yq[k][j] = *(const GAS unsigned*)((const unsigned char*)YM + row_ * D + 4 * lane + 256 * j); } \
        _Pragma("unroll") for (int j = 0; j < 4; ++j) xq[j] = *(const GAS f32x4*)(XB + (size_t)(tk) * D + 4 * lane + 256 * j); } while (0)
    if (gw < T) { R2_REC(rcA, gw); R2_ROWS(rcA, gw); }
    if (gw + ngw < T) R2_REC(rcB, gw + ngw);
    for (int tok = gw; tok < T; tok += ngw) {
        const int b = tok / SEQ; const float* mod = WS(float, WS_MOD) + ((size_t)l * NB + b) * 6144;
        f32x4 acc[4];
#pragma unroll
        for (int j = 0; j < 4; ++j) acc[j] = (f32x4){0.f, 0.f, 0.f, 0.f};
#pragma unroll
        for (int k = 0; k < 4; ++k) { const float p = __uint_as_float(rcA[k].z);
#pragma unroll
            for (int j = 0; j < 4; ++j) { const int c = 4 * lane + 256 * j; const unsigned yr = yq[k][j];
                typedef float f32x2v_ __attribute__((ext_vector_type(2))); const f32x2v_ ylo = __builtin_amdgcn_cvt_pk_f32_fp8(yr, false), yhi = __builtin_amdgcn_cvt_pk_f32_fp8(yr, true);
                const f32x4 y = (f32x4){ylo.x, ylo.y, yhi.x, yhi.y} * (1.0f / 64.0f);
                acc[j] = acc[j] + p * (y + *(const f32x4*)(b2 + (size_t)rcA[k].x * D + c)); } }
        f32x4 xc[4];
#pragma unroll
        for (int j = 0; j < 4; ++j) xc[j] = xq[j];
#pragma unroll
        for (int k = 0; k < 4; ++k) rcA[k] = rcB[k];
        if (tok + ngw < T) R2_ROWS(rcA, tok + ngw);
        if (tok + 2 * ngw < T) R2_REC(rcB, tok + 2 * ngw);
        f32x4 v[4]; float s = 0.f;
#pragma unroll
        for (int j = 0; j < 4; ++j) { const int c = 4 * lane + 256 * j; const f32x4 x = xc[j];
            v[j] = x * DN_ALPHA + (1.0f + *(const f32x4*)(mod + 5120 + c)) * acc[j]; s += (v[j].x + v[j].y) + (v[j].z + v[j].w); }
        const float mean = wave_sum(s) * (1.0f / D); float s2 = 0.f;
#pragma unroll
        for (int j = 0; j < 4; ++j) { v[j] = v[j] - mean; s2 += (v[j].x * v[j].x + v[j].y * v[j].y) + (v[j].z * v[j].z + v[j].w * v[j].w); }
        const float rstd = 1.0f / sqrtf(wave_sum(s2) * (1.0f / D) + LN_EPS);
        const float* modn = WS(float, WS_MOD) + ((size_t)(l + 1 < DEPTH ? l + 1 : l) * NB + b) * 6144;
#pragma unroll
        for (int j = 0; j < 4; ++j) { const int c = 4 * lane + 256 * j;
            f32x4 xn = v[j] * rstd * *(const f32x4*)(lg + c) + *(const f32x4*)(lb + c);
#ifdef F8PROBE
            { const unsigned* fl = WS(unsigned, WS_CTL) + 600; if (l == DEPTH - 1) { if (fl[0]) xn = xn * __builtin_nanf(""); else if (fl[1]) xn = xn * 2.0f; } }
#endif
            *(GAS f32x4*)(dst + (size_t)tok * D + c) = xn;
            if (l + 1 < DEPTH) { const f32x4 u = xn * (1.0f + *(const f32x4*)(modn + 1024 + c)) + *(const f32x4*)(modn + c);
                *(GAS unsigned long long*)(Uw + (size_t)tok * D + c) = (unsigned long long)pk2(u.x, u.y) | ((unsigned long long)pk2(u.z, u.w) << 32); } }
    }
#undef R2_REC
#undef R2_ROWS
    __syncthreads();
}
typedef int v8i_ __attribute__((ext_vector_type(8)));
__device__ __forceinline__ unsigned f8enc(int v) {
    const int a = v < 0 ? -v : v; const unsigned c = a == 0 ? 0x00u : a == 1 ? 0x38u : a == 2 ? 0x40u : a == 3 ? 0x44u : 0x48u; return c | (v < 0 ? 0x80u : 0u); }
__device__ __forceinline__ int f8_aval(int i, int k) { return ((i * 7 + k * 3) % 9) - 4; }
__device__ __forceinline__ int f8_bval(int k, int j) { return ((k * 5 + j * 11) % 7) - 3; }
__device__ __forceinline__ void f8_probe(unsigned* flags, int wvx) {
    const int lane = tid_of(wvx) & 63, rc = lane & 15, kg = lane >> 4;
    v8i_ av, bv;
#pragma unroll
    for (int w = 0; w < 8; ++w) { unsigned pa = 0u, pb = 0u;
#pragma unroll
        for (int e = 0; e < 4; ++e) { const int k = 32 * kg + 4 * w + e; pa |= f8enc(f8_aval(rc, k)) << (8 * e); pb |= f8enc(f8_bval(k, rc)) << (8 * e); }
        av[w] = (int)pa; bv[w] = (int)pb; }
    f32x4 z = {0.f, 0.f, 0.f, 0.f};
    const f32x4 d1 = __builtin_amdgcn_mfma_scale_f32_16x16x128_f8f6f4(av, bv, z, 0, 0, 0, 0x7f7f7f7f, 0, 0x7f7f7f7f);
    const f32x4 d2 = __builtin_amdgcn_mfma_scale_f32_16x16x128_f8f6f4(av, bv, z, 0, 0, 0, 0x7b7b7b7b, 0, 0x77777777);
    bool bad1 = false, bad2 = false;
#pragma unroll
    for (int g = 0; g < 4; ++g) { const int i = 4 * kg + g, j = rc; int e = 0;
        for (int k = 0; k < 128; ++k) e += f8_aval(i, k) * f8_bval(k, j);
        if (d1[g] != (float)e) bad1 = true; if (d2[g] != (float)e * (1.0f / 4096.0f)) bad2 = true; }
    if (__any(bad1) && lane == 0) flags[0] = 1u;
    if (__any(bad2) && lane == 0) flags[1] = 1u;
}
__global__ void __launch_bounds__(NWAVES * 64, 2) mega_fwd(Args A_) {
    extern __shared__ __attribute__((aligned(16))) unsigned char lds_raw[];
    LAS unsigned char* lds = (LAS unsigned char*)lds_raw;
    const int tid = threadIdx.x; const int wv0 = __builtin_amdgcn_readfirstlane(tid >> 6);
    volatile LAS unsigned* MISC = (volatile LAS unsigned*)(lds + MISC_OFF);
    for (int u = tid; u < (LDS_BYTES - TAB_OFF) / 4; u += NWAVES * 64) ((LAS unsigned*)(lds + TAB_OFF))[u] = 0u;
    __syncthreads();
    CArgs* A = kargs(); const bool multi = (A->s_hi - A->s_lo) > 1;
    if (multi) (void)xcd_barrier_post(WS(unsigned, WS_CTL) + CW_BAR + A->li * XCD_BAR_WORDS, MISC + 8);
    const int lo = A->s_lo, hi = A->s_hi;
#ifndef PHMASK
#define PHMASK 0xffffffffu
#endif
#define PHM(b) (((PHMASK) >> (b)) & 1u)
#ifndef RPTMASK
#define RPTMASK 0u
#endif
#define RPT(b) _Pragma("unroll 1") for (int rep_ = 0; rep_ < ((((RPTMASK) >> (b)) & 1u) ? 2 : 1); ++rep_)
#define RUN(s) (lo <= (s) && (s) < hi)
#ifdef BAR2
#define BAR2X(A_) xcd_barrier_fn((unsigned*)(A_->ws + WS_CTL) + CW_BAR + A_->li * XCD_BAR_WORDS, xb_xcc_id(), (volatile LAS unsigned*)(lds_launder(lds) + MISC_OFF) + 8, tid_of(wv0) == 0)
#else
#define BAR2X(A_) do {} while (0)
#endif
#define SEAM(s) do { if ((s) + 1 < hi) { CArgs* A_ = kargs(); xcd_barrier_fn((unsigned*)(A_->ws + WS_CTL) + CW_BAR + A_->li * XCD_BAR_WORDS, xb_xcc_id(), (volatile LAS unsigned*)(lds_launder(lds) + MISC_OFF) + 8, tid_of(wv0) == 0); BAR2X(A_); } } while (0)
#ifdef F8PROBE
    if (RUN(0) && blockIdx.x == 0 && wv0 == 0) { CArgs* A = kargs(); f8_probe(WS(unsigned, WS_CTL) + 600, wv0); }
#endif
    if (RUN(0)) { if (PHM(0)) RPT(0) pro_a(lds_launder(lds), wv0); SEAM(0); }
    if (RUN(1)) { if (PHM(1)) RPT(1) pro_b(wv0); SEAM(1); }
    for (int l = 0; l < DEPTH; ++l) {
        const int sb = 2 + NPH * l;
        if (RUN(sb + PH_IN)) { CArgs* A = kargs();
            pg8::Gemm g{WS(bf16, WS_U), WS(bf16, WS_WIN) + (size_t)l * NHC * D, T, NHC, D}; pg8::StaticOrder S; S.init(T, NHC, gsz_(), bid_());
            pg8::EpiIn E{WS(bf16, WS_H), WS(float, WS_CS)};
            if (PHM(2)) RPT(2) pg8::gemm_phase<pg8::EpiIn, pg8::StaticOrder, true, true>(lds_launder(lds), wv0, g, S, E);
            SEAM(sb + PH_IN);
        }
        if (RUN(sb + PH_POST)) { if (PHM(3)) RPT(3) ph_post(l, wv0); SEAM(sb + PH_POST); }
        if (RUN(sb + PH_MIXA)) { if (PHM(4)) RPT(4) ph_idx_scores(wv0); if (PHM(5)) RPT(16) ph_mlstm_m1(lds_launder(lds), l, wv0); if (PHM(6)) RPT(6) ph_diff_attn(lds_launder(lds), wv0); SEAM(sb + PH_MIXA); }
        if (RUN(sb + PH_SEL)) { if (PHM(5)) RPT(17) ph_mlstm_m2(wv0);  SEAM(sb + PH_SEL); }
        if (RUN(sb + PH_DSA)) { if (PHM(5)) RPT(18) ph_mlstm_m3(lds_launder(lds), l, wv0); if (PHM(8)) RPT(8) { ph_diff_post(l, wv0); ph_dsa_attn(lds_launder(lds), wv0); } SEAM(sb + PH_DSA); }
        if (RUN(sb + PH_OUT)) { CArgs* A = kargs();
            pg8::Gemm g{WS(bf16, WS_MIX), WS(bf16, WS_WOUT) + (size_t)l * D * D, T, D, D}; pg8::StaticOrder S; S.init(T, D, gsz_(), bid_());
            pg8::EpiBf16<0> E{WS(bf16, WS_Y), D, nullptr, 0, 0, 1.f};
            if (PHM(9)) RPT(9) pg8::gemm_phase<pg8::EpiBf16<0>, pg8::StaticOrder, true, true>(lds_launder(lds), wv0, g, S, E);
            SEAM(sb + PH_OUT);
        }
        if (RUN(sb + PH_ROW1)) { if (PHM(10)) { if ((RPTMASK >> 10) & 1u) ph_row1(lds_launder(lds), l, wv0, true); ph_row1(lds_launder(lds), l, wv0); } SEAM(sb + PH_ROW1); }
        if (RUN(sb + PH_G1)) { CArgs* A = kargs();
            const int nrt = moe_tables(lds_launder(lds), l, wv0);
            pg8::Gemm g{WS(bf16, WS_U), (const bf16*)(WS(unsigned char, WS_W1) + (size_t)l * NEXP * 2048 * D), RPAD, NEXP * 2048, D / 2}; pg8::MoeOrder S; S.init(nrt, 8, gsz_(), bid_(), (const LAS unsigned char*)(lds_launder(lds) + TAB_OFF + 256));
            pg8::EpiSwiGLU<true> E{WS(bf16, WS_HM), A->in[I_B1] + (size_t)l * NEXP * 2048, 1.0f / 4096.0f};
            LAS unsigned char* tb = lds_launder(lds) + TAB_OFF;
            pg8::MoeGatherA AM{WS(unsigned, WS_XG), (const LAS unsigned*)tb, (const LAS unsigned*)(tb + 1024), (const LAS unsigned char*)(tb + 256), T};
            if (PHM(12)) RPT(12) pg8::gemm_phase<pg8::EpiSwiGLU<true>, pg8::MoeOrder, true, true, pg8::MoeGatherA, true>(lds_launder(lds), wv0, g, S, E, AM, 0, 0);
            SEAM(sb + PH_G1);
        }
        if (RUN(sb + PH_G2)) { CArgs* A = kargs();
            const int nrt = moe_tables(lds_launder(lds), l, wv0);
            pg8::Gemm g{WS(bf16, WS_HM), (const bf16*)(WS(unsigned char, WS_W2) + (size_t)l * NEXP * D * D), RPAD, NEXP * D, D / 2}; pg8::MoeOrder S; S.init(nrt, 4, gsz_(), bid_(), (const LAS unsigned char*)(lds_launder(lds) + TAB_OFF + 256));
            pg8::EpiMoeOut E{WS(bf16, WS_YM), 1.0f / 2048.0f};
            if (PHM(13)) RPT(13) pg8::gemm_phase<pg8::EpiMoeOut, pg8::MoeOrder, true, true, pg8::DirectA, true>(lds_launder(lds), wv0, g, S, E, pg8::DirectA(), 0, 0);
            SEAM(sb + PH_G2);
        }
        if (RUN(sb + PH_ROW2)) { if (PHM(14)) { if ((RPTMASK >> 14) & 1u) ph_row2(lds_launder(lds), l, wv0, true); ph_row2(lds_launder(lds), l, wv0); } SEAM(sb + PH_ROW2); }
    }
#undef RUN
#undef SEAM
}

#ifndef MK_STEPS_PER_LAUNCH
#define MK_STEPS_PER_LAUNCH 1000
#endif
extern "C" void kernel_launch(void* const* d_in, const int* in_sizes, int n_in, void* d_out, int out_size, void* d_ws, size_t ws_size, hipStream_t stream) {
    static int grid = 0;
    if (grid == 0) {
        if (n_in != 25 || out_size != T * D || ws_size < WS_END4) { fprintf(stderr, "kernel_launch: unexpected shapes (n_in %d out %d ws %zu)\n", n_in, out_size, ws_size); grid = -1; return; }
        int dev = 0, cus = 0, per_cu = 0;
        if (hipGetDevice(&dev) != hipSuccess || hipDeviceGetAttribute(&cus, hipDeviceAttributeMultiprocessorCount, dev) != hipSuccess) { grid = -1; return; }
        if (hipFuncSetAttribute((const void*)mega_fwd, hipFuncAttributeMaxDynamicSharedMemorySize, LDS_BYTES) != hipSuccess) { fprintf(stderr, "kernel_launch: hipFuncSetAttribute failed\n"); grid = -1; return; }
        if (hipOccupancyMaxActiveBlocksPerMultiprocessor(&per_cu, (const void*)mega_fwd, NWAVES * 64, LDS_BYTES) != hipSuccess || per_cu < 1) { fprintf(stderr, "kernel_launch: occupancy query says %d\n", per_cu); }
        (void)hipGetLastError();
        grid = cus;
    }
    if (grid < 0) return;
    if (hipMemsetAsync((char*)d_ws + WS_CTL, 0, CTL_ZERO_BYTES, stream) != hipSuccess) return;
    Args a{};
    for (int i = 0; i < 25; ++i) a.in[i] = (const float*)d_in[i];
    a.out = (float*)d_out; a.ws = (unsigned char*)d_ws;
    int li = 0;
    for (int s = 0; s < NSTEPS; s += MK_STEPS_PER_LAUNCH, ++li) {
        a.s_lo = s; a.s_hi = (s + MK_STEPS_PER_LAUNCH < NSTEPS) ? s + MK_STEPS_PER_LAUNCH : NSTEPS; a.li = li; a.pad = 0;
        hipLaunchKernelGGL(mega_fwd, dim3(grid), dim3(NWAVES * 64), LDS_BYTES, stream, a);
    }
}
```

```cpp
#define IN_F8_TILES 0xffffu
#include <hip/hip_runtime.h>
#include <cstdio>
#include <cstdint>

__device__ __forceinline__ int lane_id_() { int l_; asm volatile("v_mbcnt_lo_u32_b32 %0, -1, 0\n\tv_mbcnt_hi_u32_b32 %0, -1, %0" : "=&v"(l_)); return l_; }
namespace pg8 {
#define PG8_LAS __attribute__((address_space(3)))
typedef unsigned short bf16_t;
typedef short bf16x8 __attribute__((ext_vector_type(8)));
typedef float f32x4 __attribute__((ext_vector_type(4)));
typedef unsigned u32x4 __attribute__((ext_vector_type(4)));
constexpr int BM = 256, BK = 64, HALF = 128, HTB = HALF * BK * 2  , STAGE_BYTES = 8 * HTB, NXCD = 8, WGM = 8;

__host__ __device__ __forceinline__ int lds_byte(int r, int c) { const int st = (r >> 4) * 2 + (c >> 5), rr = r & 15, cc = c & 31, ob = rr * 64 + cc * 2; return st * 1024 + (ob ^ (((ob >> 9) & 1) << 5)); }
__host__ __device__ __forceinline__ void stage_rc(int b, int& R, int& C) { const int st = b / 1024, sb = b % 1024, swz = sb ^ (((sb >> 9) & 1) << 5); R = (st >> 1) * 16 + swz / 64; C = (st & 1) * 32 + (swz % 64) / 2; }
__host__ __device__ __forceinline__ int perm32(int rho) { const int n = rho >> 4, i = rho & 15; return 8 * (i >> 2) + 4 * n + (i & 3); }

struct Unit { int pm, pn; };
struct Gemm { const bf16_t* A; const bf16_t* Bt; int M, N, K; };

struct StaticOrder {
    int nM, nN, nwg, G, c;
    __host__ __device__ void init(int M, int N, int G_, int c_) { nM = M / BM; nN = N / BM; nwg = nM * nN; G = G_; c = c_; }
    __host__ __device__ bool next(int i, Unit& u) const {
        const long L = (long)i * G + c; if (L >= nwg) return false;
        int wgid = (int)L; { const int q = nwg / NXCD, r = nwg % NXCD, xcd = wgid % NXCD, off = wgid / NXCD; wgid = (xcd < r ? xcd * (q + 1) : r * (q + 1) + (xcd - r) * q) + off; }
        const int nig = WGM * nN, gid = wgid / nig, fm = gid * WGM, gsz = (nM - fm) < WGM ? (nM - fm) : WGM;
        u.pm = fm + ((wgid % nig) % gsz); u.pn = (wgid % nig) / gsz; return true;
    }
    __device__ __forceinline__ void a_ready(const Unit&) const {}
    __device__ __forceinline__ void done(const Unit&) const {}
};
struct MoeOrder {
    int nM, nN, nwg, G, c; const PG8_LAS unsigned char* tile_e;
    __device__ void init(int nRT, int NTN, int G_, int c_, const PG8_LAS unsigned char* te) { nM = nRT; nN = NTN; nwg = nM * nN; G = G_; c = c_; tile_e = te; }
    __device__ bool next(int i, Unit& u) const {
        const long L = (long)i * G + c; if (L >= nwg) return false;
        int wgid = (int)L; { const int q = nwg / NXCD, r = nwg % NXCD, xcd = wgid % NXCD, off = wgid / NXCD; wgid = (xcd < r ? xcd * (q + 1) : r * (q + 1) + (xcd - r) * q) + off; }
        const int nig = WGM * nN, gid = wgid / nig, fm = gid * WGM, gsz = (nM - fm) < WGM ? (nM - fm) : WGM;
        u.pm = fm + ((wgid % nig) % gsz); const int pl = (wgid % nig) / gsz; u.pn = (int)tile_e[u.pm] * nN + pl; return true;
    }
    __device__ __forceinline__ void a_ready(const Unit&) const {}
    __device__ __forceinline__ void done(const Unit&) const {}
};
struct MoeGatherA {
    static constexpr bool GATHER = true;
    const unsigned* rowmap; const PG8_LAS unsigned* base; const PG8_LAS unsigned* cnt; const PG8_LAS unsigned char* tile_e; int ntok;
    __device__ __forceinline__ unsigned off(const Unit& u, int h, int rA, int cA, int K) const {
        const int e = tile_e[u.pm]; const unsigned pos = (unsigned)u.pm * 256u - base[e] + 128u * h + (unsigned)rA;
        const unsigned tok = pos < cnt[e] ? rowmap[(size_t)e * ntok + pos] : 0u;
        return (tok * (unsigned)K + (unsigned)cA) * 2u;
    }
};
struct SubsetOrder {
    int nM, nN, nwg, G, c; unsigned long long colmap;
    __host__ __device__ void init(int M, int nsub, unsigned long long cm, int G_, int c_) { nM = M / BM; nN = nsub; nwg = nM * nN; G = G_; c = c_; colmap = cm; }
    __host__ __device__ bool next(int i, Unit& u) const {
        const long L = (long)i * G + c; if (L >= nwg) return false;
        int wgid = (int)L; { const int q = nwg / NXCD, r = nwg % NXCD, xcd = wgid % NXCD, off = wgid / NXCD; wgid = (xcd < r ? xcd * (q + 1) : r * (q + 1) + (xcd - r) * q) + off; }
        const int nig = WGM * nN, gid = wgid / nig, fm = gid * WGM, gsz = (nM - fm) < WGM ? (nM - fm) : WGM;
        u.pm = fm + ((wgid % nig) % gsz); const int j = (wgid % nig) / gsz; u.pn = (int)((colmap >> (4 * j)) & 15ull); return true;
    }
    __device__ __forceinline__ void a_ready(const Unit&) const {}
    __device__ __forceinline__ void done(const Unit&) const {}
};
__device__ __forceinline__ unsigned cvt_pk_bf16(float lo, float hi) { unsigned r; asm volatile("v_cvt_pk_bf16_f32 %0, %1, %2" : "=v"(r) : "v"(lo), "v"(hi)); return r; }
typedef float f32x2 __attribute__((ext_vector_type(2)));
__device__ __forceinline__ f32x2 gelu_pk(f32x2 v) {
    const f32x2 av = __builtin_elementwise_abs(v), d = av * 0.2316418882f + 1.0f;
    f32x2 t; t.x = __builtin_amdgcn_rcpf(d.x); t.y = __builtin_amdgcn_rcpf(d.y);
    f32x2 q = t * 0.5307027145f + (-0.7265760135f); q = q * t + 0.7107068705f; q = q * t + (-0.142248368f); q = q * t + 0.127414796f; q = q * t;
    const f32x2 s = (v * v) * (-0.72134752044f);
    f32x2 e; e.x = __builtin_amdgcn_exp2f(s.x); e.y = __builtin_amdgcn_exp2f(s.y);
    const f32x2 m = v * (q * e), r = v - m;
    f32x2 o; o.x = v.x < 0.f ? m.x : r.x; o.y = v.y < 0.f ? m.y : r.y; return o;
}

template <int ACT  > struct EpiBf16 {
    static constexpr bool PERM = true, AFTER_DRAIN = false; static_assert(ACT == 0 || ACT == 1, "EpiBf16: ACT is 0 (none) or 1 (gelu_pk)");
    bf16_t* O; int ldc; const float* bias; int split_cols; size_t split_stride; float scale0;
    __device__ __forceinline__ void operator()(const f32x4 (&acc)[2][2][4][2], const Unit& u, int wr, int wc, int fr, int fq) const {
        const int row0 = u.pm * BM + wr * 64 + fr; int colt = u.pn * BM; bf16_t* base = O;
        float sc = 1.f; if (split_cols) { const int t = colt / split_cols; base += (size_t)t * split_stride; colt -= t * split_cols; if (t == 0) sc = scale0; }
        const int col0 = colt + wc * 32 + 8 * fq, bcol0 = u.pn * BM + wc * 32 + 8 * fq;
        f32x4 bv[2][2];
#pragma unroll
        for (int bj = 0; bj < 2; ++bj)
#pragma unroll
            for (int n = 0; n < 2; ++n) bv[bj][n] = bias ? *(const f32x4*)(bias + bcol0 + bj * HALF + 4 * n) : (f32x4){0.f, 0.f, 0.f, 0.f};
#pragma unroll
        for (int ai = 0; ai < 2; ++ai)
#pragma unroll
            for (int m = 0; m < 4; ++m) { bf16_t* rowp = base + (size_t)(row0 + ai * HALF + m * 16) * ldc + col0;
#pragma unroll
                for (int bj = 0; bj < 2; ++bj) { f32x4 v0 = acc[ai][bj][m][0] + bv[bj][0], v1 = acc[ai][bj][m][1] + bv[bj][1];
                    if (ACT == 1) { f32x2 a = gelu_pk((f32x2){v0[0], v0[1]}), b = gelu_pk((f32x2){v0[2], v0[3]}), c = gelu_pk((f32x2){v1[0], v1[1]}), d = gelu_pk((f32x2){v1[2], v1[3]});
                        v0 = (f32x4){a.x, a.y, b.x, b.y}; v1 = (f32x4){c.x, c.y, d.x, d.y}; }
                    v0 = v0 * sc; v1 = v1 * sc; u32x4 w; w.x = cvt_pk_bf16(v0[0], v0[1]); w.y = cvt_pk_bf16(v0[2], v0[3]); w.z = cvt_pk_bf16(v1[0], v1[1]); w.w = cvt_pk_bf16(v1[2], v1[3]);
                    *(u32x4*)(rowp + bj * HALF) = w; } }
    }
};
constexpr float C2 = 0.125f * 1.4426950408889634f;
struct EpiIn {
    static constexpr bool PERM = true, AFTER_DRAIN = false;
    bf16_t* O; const float* cs; float asc;
    __device__ __forceinline__ void operator()(const f32x4 (&acc)[2][2][4][2], const Unit& u, int wr, int wc, int fr, int fq) const {
        const int pn = u.pn;
        const bool rope = (0x6CF0 >> pn) & 1;
        const float sc = (((0x0430 >> pn) & 1) ? C2 : 1.f) * asc;
        const int row0 = u.pm * BM + wr * 64 + fr, col0 = pn * BM + wc * 32 + 8 * fq, i0 = (wc & 1) * 16 + 4 * fq;
#pragma unroll
        for (int ai = 0; ai < 2; ++ai)
#pragma unroll
        for (int mh = 0; mh < 2; ++mh) {
            f32x4 c01[2], c23[2];
#pragma unroll
            for (int m2 = 0; m2 < 2; ++m2) { c01[m2] = (f32x4){1.f, 0.f, 1.f, 0.f}; c23[m2] = c01[m2]; }
            if (rope) {
#pragma unroll
                for (int m2 = 0; m2 < 2; ++m2) { const float* cp = cs + (size_t)(row0 + ai * HALF + (2 * mh + m2) * 16) * 64 + i0 * 2; c01[m2] = *(const f32x4*)cp; c23[m2] = *(const f32x4*)(cp + 4); }
            }
#pragma unroll
            for (int m2 = 0; m2 < 2; ++m2) {
                const int m = 2 * mh + m2;
                const int row = row0 + ai * HALF + m * 16;
                const f32x4 ca = c01[m2], cb = c23[m2];
                bf16_t* rowp = O + (size_t)row * 4096 + col0;
#pragma unroll
                for (int bj = 0; bj < 2; ++bj) {
                    const f32x4 v0 = acc[ai][bj][m][0], v1 = acc[ai][bj][m][1];
                    f32x4 r0, r1;
                    r0[0] = v0[0] * ca[0] - v0[1] * ca[1]; r0[1] = v0[1] * ca[0] + v0[0] * ca[1];
                    r0[2] = v0[2] * ca[2] - v0[3] * ca[3]; r0[3] = v0[3] * ca[2] + v0[2] * ca[3];
                    r1[0] = v1[0] * cb[0] - v1[1] * cb[1]; r1[1] = v1[1] * cb[0] + v1[0] * cb[1];
                    r1[2] = v1[2] * cb[2] - v1[3] * cb[3]; r1[3] = v1[3] * cb[2] + v1[2] * cb[3];
                    r0 = r0 * sc; r1 = r1 * sc;
                    u32x4 w; w.x = cvt_pk_bf16(r0[0], r0[1]); w.y = cvt_pk_bf16(r0[2], r0[3]); w.z = cvt_pk_bf16(r1[0], r1[1]); w.w = cvt_pk_bf16(r1[2], r1[3]);
                    *(u32x4*)(rowp + bj * HALF) = w;
                }
            }
            asm volatile("" ::: "memory");
        }
    }
};
__device__ __forceinline__ unsigned pk4_fp8(float a, float b, float c, float d, float sc) {
    a = fminf(fmaxf(a * sc, -448.f), 448.f); b = fminf(fmaxf(b * sc, -448.f), 448.f); c = fminf(fmaxf(c * sc, -448.f), 448.f); d = fminf(fmaxf(d * sc, -448.f), 448.f);
    int w = __builtin_amdgcn_cvt_pk_fp8_f32(a, b, 0, false); w = __builtin_amdgcn_cvt_pk_fp8_f32(c, d, w, true); return (unsigned)w; }
template <bool F8OUT> struct EpiSwiGLU {
    static constexpr bool PERM = true, AFTER_DRAIN = false;
    bf16_t* O; const float* b1; float asc;
    __device__ __forceinline__ void operator()(const f32x4 (&acc)[2][2][4][2], const Unit& u, int wr, int wc, int fr, int fq) const {
        const int e = u.pn >> 3, pl = u.pn & 7, colh = pl * 128 + wc * 32 + 8 * fq;
        const float* bp = b1 + (size_t)e * 2048 + colh;
        f32x4 bg[2], bu[2];
#pragma unroll
        for (int n = 0; n < 2; ++n) { bg[n] = *(const f32x4*)(bp + 4 * n); bu[n] = *(const f32x4*)(bp + 1024 + 4 * n); }
        const int row0 = u.pm * BM + wr * 64 + fr;
#pragma unroll
        for (int ai = 0; ai < 2; ++ai)
#pragma unroll
            for (int m = 0; m < 4; ++m) {
                f32x4 o[2];
#pragma unroll
                for (int n = 0; n < 2; ++n) {
                    const f32x4 g4 = acc[ai][0][m][n] * asc + bg[n], u4 = acc[ai][1][m][n] * asc + bu[n];
#pragma unroll
                    for (int c = 0; c < 4; ++c) {
                        const float g = fminf(g4[c], 7.0f), up = fminf(fmaxf(u4[c], -7.0f), 7.0f);
                        const float sg = __builtin_amdgcn_rcpf(1.0f + __builtin_amdgcn_exp2f(-1.702f * 1.4426950408889634f * g));
                        o[n][c] = (up + 1.0f) * (g * sg);
                    }
                }
                if constexpr (F8OUT) { typedef unsigned u32x2_ __attribute__((ext_vector_type(2))); u32x2_ w; w.x = pk4_fp8(o[0][0], o[0][1], o[0][2], o[0][3], 8.0f); w.y = pk4_fp8(o[1][0], o[1][1], o[1][2], o[1][3], 8.0f);
                    *(u32x2_*)((unsigned char*)O + (size_t)(row0 + ai * HALF + m * 16) * 1024 + colh) = w; }
                else { u32x4 w; w.x = cvt_pk_bf16(o[0][0], o[0][1]); w.y = cvt_pk_bf16(o[0][2], o[0][3]); w.z = cvt_pk_bf16(o[1][0], o[1][1]); w.w = cvt_pk_bf16(o[1][2], o[1][3]);
                    *(u32x4*)(O + (size_t)(row0 + ai * HALF + m * 16) * 1024 + colh) = w; }
            }
    }
};
struct EpiMoeOut {
    static constexpr bool PERM = true, AFTER_DRAIN = false;
    bf16_t* O; float asc;
    __device__ __forceinline__ void operator()(const f32x4 (&acc)[2][2][4][2], const Unit& u, int wr, int wc, int fr, int fq) const {
        const int row0 = u.pm * BM + wr * 64 + fr, col0 = (u.pn & 3) * BM + wc * 32 + 8 * fq;
#pragma unroll
        for (int ai = 0; ai < 2; ++ai)
#pragma unroll
            for (int m = 0; m < 4; ++m) { unsigned char* rowp = (unsigned char*)O + (size_t)(row0 + ai * HALF + m * 16) * 1024 + col0;
#pragma unroll
                for (int bj = 0; bj < 2; ++bj) { const f32x4 v0 = acc[ai][bj][m][0], v1 = acc[ai][bj][m][1];
                    typedef unsigned u32x2_ __attribute__((ext_vector_type(2))); u32x2_ w; w.x = pk4_fp8(v0[0], v0[1], v0[2], v0[3], 64.0f * asc); w.y = pk4_fp8(v1[0], v1[1], v1[2], v1[3], 64.0f * asc);
                    *(u32x2_*)(rowp + bj * HALF) = w; } }
    }
};
struct DirectA { static constexpr bool GATHER = false; __device__ __forceinline__ unsigned off(const Unit&, int, int, int, int) const { return 0u; } };
typedef int v8i32 __attribute__((ext_vector_type(8)));
template <class Epi, class Sched, bool ALIGN_EPI = false, bool SP2 = false, class AMap = DirectA, bool F8 = false>
__device__ __forceinline__ void gemm_phase(PG8_LAS unsigned char* lds, int wvx, const Gemm g, const Sched& S, const Epi& E, const AMap& AM = AMap(), int scA = 0x7f7f7f7f, int scB = 0x7f7f7f7f) {
    int tid_ = wvx * 64 + lane_id_(); asm volatile("" : "+v"(tid_));
    const int tid = tid_, wid = __builtin_amdgcn_readfirstlane(tid >> 6), lane = tid & 63, wr = wid >> 2, wc = wid & 3, fr = lane & 15, fq = lane >> 4;
    const int K = g.K, nt = K / BK;
    unsigned voffB[2], vA[2];
#pragma unroll
    for (int i = 0; i < 2; ++i) { int R, C; stage_rc(tid * 16 + i * 8192, R, C); const int Rb = Epi::PERM ? ((R & ~31) + perm32(R & 31)) : R;
        vA[i] = (unsigned)(R * K + C) * 2u; voffB[i] = (unsigned)(Rb * K + C) * 2u; }
    const size_t kstep = (size_t)(BK * 2);
    const size_t hstep = (size_t)HALF * K * 2;
    const size_t tstep = 2 * hstep;
    const unsigned ldsw = (unsigned)wid * 1024u;
    const int aoff = lds_byte(wr * 64 + fr, fq * 8), boff = lds_byte(wc * 32 + fr, fq * 8);
#define PG8_SA(b, h) (((b) * 2 + (h)) * HTB)
#define PG8_SB(b, h) ((4 + (b) * 2 + (h)) * HTB)
#define PG8_STAGEA(bufoff, kb, h, nx) do { size_t ubx_ = (size_t)(kb); unsigned lo_[2]; \
        if constexpr (AMap::GATHER) { _Pragma("unroll") for (int _i = 0; _i < 2; ++_i) lo_[_i] = (nx) ? oN[h][_i] : oC[h][_i]; } \
        else { ubx_ += (nx) ? uN[h] : uC[h]; _Pragma("unroll") for (int _i = 0; _i < 2; ++_i) lo_[_i] = vA[_i]; } \
        const char* ub_ = Abase + ubx_; asm("" : "+s"(ub_)); _Pragma("unroll") for (int _i = 0; _i < 2; ++_i) asm("" : "+v"(lo_[_i]));     \
        _Pragma("unroll") for (int _i = 0; _i < 2; ++_i) \
        __builtin_amdgcn_global_load_lds((const unsigned*)(ub_ + lo_[_i]), (PG8_LAS unsigned*)(lds + (bufoff) + ldsw + _i * 8192), 16, 0, 0); } while (0)
#define PG8_AOFF(dstL, dstU, u) do { if constexpr (AMap::GATHER) { int t2_ = wvx * 64 + lane_id_(); asm volatile("" : "+v"(t2_)); _Pragma("unroll") for (int _i = 0; _i < 2; ++_i) { int R_, C_; stage_rc(t2_ * 16 + _i * 8192, R_, C_); \
            _Pragma("unroll") for (int _h = 0; _h < 2; ++_h) dstL[_h][_i] = AM.off(u, _h, R_, C_, K); } } \
        else { _Pragma("unroll") for (int _h = 0; _h < 2; ++_h) dstU[_h] = ((size_t)(u).pm * BM + 128 * _h) * (size_t)K * 2; } } while (0)
#define PG8_STAGE(bufoff, gbase, voff) do { const char* ub_ = (const char*)(gbase); asm("" : "+s"(ub_)); _Pragma("unroll") for (int _i = 0; _i < 2; ++_i) \
        __builtin_amdgcn_global_load_lds((const unsigned*)(ub_ + (voff)[_i]), (PG8_LAS unsigned*)(lds + (bufoff) + ldsw + _i * 8192), 16, 0, 0); } while (0)
#define PG8_LDA(dst, b, h) do { _Pragma("unroll") for (int m = 0; m < 4; ++m) _Pragma("unroll") for (int k = 0; k < 2; ++k) dst[m][k] = *(const PG8_LAS bf16x8*)(lds + PG8_SA(b, h) + aoff + m * 2048 + k * 1024); } while (0)
#define PG8_LDB(dst, b, h) do { _Pragma("unroll") for (int n = 0; n < 2; ++n) _Pragma("unroll") for (int k = 0; k < 2; ++k) dst[n][k] = *(const PG8_LAS bf16x8*)(lds + PG8_SB(b, h) + boff + n * 2048 + k * 1024); } while (0)
#define PG8_CAT(x) __builtin_bit_cast(v8i32, __builtin_shufflevector(x[0], x[1], 0, 1, 2, 3, 4, 5, 6, 7, 8, 9, 10, 11, 12, 13, 14, 15))
#define PG8_MMA(ai, bj, At, Bt) do { __builtin_amdgcn_s_setprio(1); _Pragma("unroll") for (int m = 0; m < 4; ++m) _Pragma("unroll") for (int n = 0; n < 2; ++n) { \
        if constexpr (F8) acc[ai][bj][m][n] = __builtin_amdgcn_mfma_scale_f32_16x16x128_f8f6f4(PG8_CAT(Bt[n]), PG8_CAT(At[m]), acc[ai][bj][m][n], 0, 0, 0, scB, 0, scA); \
        else { _Pragma("unroll") for (int k = 0; k < 2; ++k) acc[ai][bj][m][n] = __builtin_amdgcn_mfma_f32_16x16x32_bf16(Bt[n][k], At[m][k], acc[ai][bj][m][n], 0, 0, 0); } } __builtin_amdgcn_s_setprio(0); } while (0)
#define PG8_WAIT_V(n) asm volatile("s_waitcnt vmcnt(" #n ")" ::: "memory")
#define PG8_WAIT_L(n) asm volatile("s_waitcnt lgkmcnt(" #n ")" ::: "memory")
#define PG8_BAR __builtin_amdgcn_s_barrier()
#define PG8_SCHED __builtin_amdgcn_sched_barrier(0)
    Unit cur, nxt; int ui = 0;
    if (!S.next(0, cur)) return;
    f32x4 acc[2][2][4][2];
#pragma unroll
    for (int a = 0; a < 2; ++a)
#pragma unroll
        for (int b = 0; b < 2; ++b)
#pragma unroll
            for (int m = 0; m < 4; ++m)
#pragma unroll
                for (int n = 0; n < 2; ++n) acc[a][b][m][n] = (f32x4){0.f, 0.f, 0.f, 0.f};
    bf16x8 At[4][2], B0[2][2], B1[2][2];
    const char* Abase = (const char*)g.A; const char* cB = (const char*)g.Bt + (size_t)cur.pn * tstep;
    unsigned oC[2][2], oN[2][2]; size_t uC[2] = {0, 0}, uN[2] = {0, 0}; PG8_AOFF(oC, uC, cur);
    S.a_ready(cur);
    if constexpr (SP2) {
        PG8_STAGE(PG8_SB(0, 0), cB, voffB); PG8_STAGE(PG8_SB(0, 1), cB + hstep, voffB); PG8_STAGEA(PG8_SA(0, 0), 0, 0, false); PG8_STAGEA(PG8_SA(0, 1), 0, 1, false);
        if (wr == 1) PG8_BAR;
        PG8_WAIT_V(2); PG8_BAR;
        PG8_STAGE(PG8_SB(1, 0), cB + kstep, voffB); PG8_STAGEA(PG8_SA(1, 0), kstep, 0, false); PG8_STAGE(PG8_SB(1, 1), cB + hstep + kstep, voffB);
        PG8_WAIT_V(6); PG8_BAR;
    } else {
        PG8_STAGE(PG8_SB(0, 0), cB, voffB); PG8_STAGEA(PG8_SA(0, 0), 0, 0, false); PG8_STAGE(PG8_SB(0, 1), cB + hstep, voffB); PG8_STAGEA(PG8_SA(0, 1), 0, 1, false);
        if (wr == 1) PG8_BAR;
        PG8_WAIT_V(4); PG8_BAR;
        PG8_STAGE(PG8_SB(1, 0), cB + kstep, voffB); PG8_STAGEA(PG8_SA(1, 0), kstep, 0, false); PG8_STAGE(PG8_SB(1, 1), cB + hstep + kstep, voffB);
        PG8_WAIT_V(6); PG8_BAR;
    }
    for (;;) {
        const bool has_next = S.next(ui + 1, nxt);
        const char* nB = has_next ? (const char*)g.Bt + (size_t)nxt.pn * tstep : cB;
        if (has_next) { PG8_AOFF(oN, uN, nxt); } else {
#pragma unroll
            for (int _h = 0; _h < 2; ++_h) { oN[_h][0] = oC[_h][0]; oN[_h][1] = oC[_h][1]; uN[_h] = uC[_h]; } }
#pragma unroll 1
        for (int t = 0; t < nt; t += 2) {
            const bool last = (t == nt - 2);
            const size_t ka1 = (size_t)(t + 1) * kstep, ka2 = last ? (size_t)0 : (size_t)(t + 2) * kstep, ka3 = ka2 + kstep;
            const char* b2 = last ? nB : cB + (size_t)(t + 2) * kstep; const char* b3 = b2 + kstep;
            if (last && has_next) S.a_ready(nxt);
            if constexpr (SP2) {
            PG8_LDB(B0, 0, 0); PG8_LDB(B1, 0, 1); PG8_SCHED; PG8_LDA(At, 0, 0); PG8_STAGEA(PG8_SA(1, 1), ka1, 1, false);
            PG8_WAIT_V(8); PG8_WAIT_L(0); PG8_BAR; PG8_MMA(0, 0, At, B0); PG8_MMA(0, 1, At, B1); PG8_BAR; PG8_SCHED;
            PG8_LDA(At, 0, 1); PG8_STAGE(PG8_SB(0, 0), b2, voffB); PG8_STAGE(PG8_SB(0, 1), b2 + hstep, voffB); PG8_STAGEA(PG8_SA(0, 0), ka2, 0, last);
            PG8_WAIT_V(8); PG8_WAIT_L(0); PG8_BAR; PG8_MMA(1, 0, At, B0); PG8_MMA(1, 1, At, B1); PG8_BAR; PG8_SCHED;
            PG8_LDB(B0, 1, 0); PG8_LDB(B1, 1, 1); PG8_SCHED; PG8_LDA(At, 1, 0); PG8_STAGEA(PG8_SA(0, 1), ka2, 1, last);
            PG8_WAIT_V(8); PG8_WAIT_L(0); PG8_BAR; PG8_MMA(0, 0, At, B0); PG8_MMA(0, 1, At, B1); PG8_BAR; PG8_SCHED;
            PG8_LDA(At, 1, 1); PG8_STAGE(PG8_SB(1, 0), b3, voffB); PG8_STAGE(PG8_SB(1, 1), b3 + hstep, voffB); PG8_STAGEA(PG8_SA(1, 0), ka3, 0, last);
            PG8_WAIT_V(8); PG8_WAIT_L(0); PG8_BAR; PG8_MMA(1, 0, At, B0); PG8_MMA(1, 1, At, B1); PG8_BAR; PG8_SCHED;
            } else {
            PG8_LDB(B0, 0, 0); PG8_SCHED; PG8_LDA(At, 0, 0); PG8_STAGEA(PG8_SA(1, 1), ka1, 1, false);
            PG8_WAIT_L(8); PG8_BAR; PG8_WAIT_L(0); PG8_MMA(0, 0, At, B0); PG8_BAR; PG8_SCHED;
            PG8_LDB(B1, 0, 1); PG8_STAGE(PG8_SB(0, 0), b2, voffB);
            PG8_BAR; PG8_WAIT_L(0); PG8_MMA(0, 1, At, B1); PG8_BAR;
            PG8_LDA(At, 0, 1); PG8_STAGEA(PG8_SA(0, 0), ka2, 0, last);
            PG8_BAR; PG8_WAIT_L(0); PG8_MMA(1, 0, At, B0); PG8_BAR; PG8_SCHED;
            PG8_STAGE(PG8_SB(0, 1), b2 + hstep, voffB);
            PG8_WAIT_V(6); PG8_BAR; PG8_MMA(1, 1, At, B1); PG8_BAR;
            PG8_LDB(B0, 1, 0); PG8_SCHED; PG8_LDA(At, 1, 0); PG8_STAGEA(PG8_SA(0, 1), ka2, 1, last);
            PG8_WAIT_L(8); PG8_BAR; PG8_WAIT_L(0); PG8_MMA(0, 0, At, B0); PG8_BAR; PG8_SCHED;
            PG8_LDB(B1, 1, 1); PG8_STAGE(PG8_SB(1, 0), b3, voffB);
            PG8_BAR; PG8_WAIT_L(0); PG8_MMA(0, 1, At, B1); PG8_BAR;
            PG8_LDA(At, 1, 1); PG8_STAGEA(PG8_SA(1, 0), ka3, 0, last);
            PG8_BAR; PG8_WAIT_L(0); PG8_MMA(1, 0, At, B0); PG8_BAR; PG8_SCHED;
            PG8_STAGE(PG8_SB(1, 1), b3 + hstep, voffB);
            PG8_WAIT_V(6); PG8_BAR; PG8_MMA(1, 1, At, B1); PG8_BAR;
            }
        }
        if constexpr (ALIGN_EPI) { if (wr == 0) PG8_BAR; }
        if constexpr (!Epi::AFTER_DRAIN) { const int l2_ = lane_id_(); const int fr_ = l2_ & 15, fq_ = l2_ >> 4;
            E(acc, cur, wr, wc, fr_, fq_); S.done(cur); }
        if (!has_next) break;
#pragma unroll
        for (int a = 0; a < 2; ++a)
#pragma unroll
            for (int b = 0; b < 2; ++b)
#pragma unroll
                for (int m = 0; m < 4; ++m)
#pragma unroll
                    for (int n = 0; n < 2; ++n) acc[a][b][m][n] = (f32x4){0.f, 0.f, 0.f, 0.f};
        cur = nxt; cB = nB; ++ui;
#pragma unroll
        for (int _h = 0; _h < 2; ++_h) { oC[_h][0] = oN[_h][0]; oC[_h][1] = oN[_h][1]; uC[_h] = uN[_h]; }
        if constexpr (ALIGN_EPI) { if (wr == 1) PG8_BAR; }
    }
    PG8_WAIT_V(0);
    if constexpr (!ALIGN_EPI) { if (wr == 0) PG8_BAR; }
    PG8_BAR;
    if constexpr (Epi::AFTER_DRAIN) { E.fused(acc, cur, wr, wc, fr, fq, lds, wid, lane); S.done(cur); }
#undef PG8_SA
#undef PG8_SB
#undef PG8_STAGE
#undef PG8_STAGEA
#undef PG8_AOFF
#undef PG8_LDA
#undef PG8_LDB
#undef PG8_MMA
#undef PG8_CAT
#undef PG8_WAIT_V
#undef PG8_WAIT_L
#undef PG8_BAR
#undef PG8_SCHED
}
}
namespace attn_body {
using bf16=unsigned short;
using bf16x8=__attribute__((ext_vector_type(8)))short;
using s16x4=__attribute__((ext_vector_type(4)))short;
using f32x16=__attribute__((ext_vector_type(16)))float;
using u32x4=__attribute__((ext_vector_type(4)))unsigned;
constexpr int SEQ=2048,D=64,DM=4096,DMO=1024;
constexpr int NW=8,QBLK=32,QB=QBLK*NW,KVBLK=64,NQB=SEQ/QB;
__device__ __forceinline__ unsigned f2bf_(float f){unsigned u=__builtin_bit_cast(unsigned,f);return (u+0x7fffu+((u>>16)&1u))>>16;}
__device__ __forceinline__ int crow(int r,int hi){return (r&3)+8*(r>>2)+4*hi;}
#define SBAR() __builtin_amdgcn_sched_barrier(0)
__device__ __forceinline__ void cmask(f32x16&p0,f32x16&p1,int jb,int qrel,int hi){
  const float NEG=-INFINITY; int kb=64*jb+4*hi;
  #pragma unroll
  for(int r=0;r<16;++r){int kv=kb+(r&3)+8*(r>>2); if(kv>qrel)p0[r]=NEG; if(kv+32>qrel)p1[r]=NEG;}
}

__device__ __forceinline__ uint2 mld_asm(const unsigned*p){ uint2 v; asm volatile("global_load_dwordx2 %0, %1, off":"=v"(v):"v"(p):"memory"); return v; }
__device__ __forceinline__ void bmask(f32x16&p0,f32x16&p1,uint2 w,int hi){
  const float NEG=-INFINITY; const unsigned a=w.x>>(4*hi), b=w.y>>(4*hi);
  #pragma unroll
  for(int r=0;r<16;++r){const int bit=(r&3)+8*(r>>2); if(!((a>>bit)&1u))p0[r]=NEG; if(!((b>>bit)&1u))p1[r]=NEG;}
}
constexpr int NSLOT=3, SLOTB=8192;
constexpr int LDS_K=0, LDS_V=NSLOT*SLOTB, LDS_WS=2*NSLOT*SLOTB, LDS_OST=LDS_WS+NW*64*4, LDS_BYTES=LDS_OST+NW*4096;
constexpr float C2=0.125f*1.4426950408889634f;
__device__ __forceinline__ void glds16(const void*gsrc,unsigned lds_dst){unsigned keep;
  asm volatile("s_mov_b32 %0, m0\n\ts_mov_b32 m0, %2\n\ts_nop 0\n\tglobal_load_lds_dwordx4 %1, off\n\ts_mov_b32 m0, %0":"=&s"(keep):"v"(gsrc),"s"(lds_dst):"memory");}
__device__ __forceinline__ float max3f(float a,float b,float c){float r;asm("v_max3_f32 %0, %1, %2, %3":"=v"(r):"v"(a),"v"(b),"v"(c));return r;}
__device__ __forceinline__ float max2f(float a,float b){float r;asm("v_max_f32_e32 %0, %1, %2":"=v"(r):"v"(a),"v"(b));return r;}
__device__ __forceinline__ float fadd_s(float a,float b){float r;asm("v_add_f32_e32 %0, %1, %2":"=v"(r):"v"(a),"v"(b));return r;}
__device__ __forceinline__ float fsub_s(float a,float b){float r;asm("v_sub_f32_e32 %0, %1, %2":"=v"(r):"v"(a),"v"(b));return r;}
typedef float f32x2_t __attribute__((ext_vector_type(2))); typedef __bf16 bf16x2_t __attribute__((ext_vector_type(2)));
__device__ __forceinline__ unsigned cvtpk_s(float lo,float hi){f32x2_t v={lo,hi};bf16x2_t b=__builtin_convertvector(v,bf16x2_t);return __builtin_bit_cast(unsigned,b);}
#define WAIT_BAR(N) asm volatile("s_waitcnt vmcnt(" #N ") lgkmcnt(0)\n\ts_barrier":::"memory")

__device__ __forceinline__ void qkt(f32x16&p0,f32x16&p1,const char*Kslot,const bf16x8*qr,const f32x16&negm,int r32,int hi){
  const char*kb=Kslot+hi*1024+r32*16;
  #pragma unroll
  for(int d0=0;d0<4;++d0){
    const bf16x8 b0=*reinterpret_cast<const bf16x8*>(kb+d0*2048);
    const bf16x8 b1=*reinterpret_cast<const bf16x8*>(kb+d0*2048+512);
    if(d0==0){p0=__builtin_amdgcn_mfma_f32_32x32x16_bf16(b0,qr[0],negm,0,0,0);p1=__builtin_amdgcn_mfma_f32_32x32x16_bf16(b1,qr[0],negm,0,0,0);}
    else{p0=__builtin_amdgcn_mfma_f32_32x32x16_bf16(b0,qr[d0],p0,0,0,0);p1=__builtin_amdgcn_mfma_f32_32x32x16_bf16(b1,qr[d0],p1,0,0,0);}}
}
typedef __attribute__((address_space(3))) const char* lds_cptr;
typedef short v4i16_t __attribute__((ext_vector_type(4)));
__device__ __forceinline__ void kload8(bf16x8*kf,lds_cptr kp){
  kf[0]=*(const __attribute__((address_space(3))) bf16x8*)(kp);      kf[1]=*(const __attribute__((address_space(3))) bf16x8*)(kp+512);
  kf[2]=*(const __attribute__((address_space(3))) bf16x8*)(kp+2048); kf[3]=*(const __attribute__((address_space(3))) bf16x8*)(kp+2560);
  kf[4]=*(const __attribute__((address_space(3))) bf16x8*)(kp+4096); kf[5]=*(const __attribute__((address_space(3))) bf16x8*)(kp+4608);
  kf[6]=*(const __attribute__((address_space(3))) bf16x8*)(kp+6144); kf[7]=*(const __attribute__((address_space(3))) bf16x8*)(kp+6656);
}
__device__ __forceinline__ void kload2(bf16x8*kf,lds_cptr kp,int j){ kf[2*j]=*(const __attribute__((address_space(3))) bf16x8*)(kp+j*2048); kf[2*j+1]=*(const __attribute__((address_space(3))) bf16x8*)(kp+j*2048+512); }
__device__ __forceinline__ s16x4 vtr(lds_cptr p){ return __builtin_bit_cast(s16x4,__builtin_amdgcn_ds_read_tr16_b64_v4i16((__attribute__((address_space(3))) v4i16_t*)p)); }
__device__ __forceinline__ float rowmax(const f32x16&p0,const f32x16&p1){
  float a=max3f(p0[0],p0[1],p1[0]),b=max3f(p0[2],p0[3],p1[1]);a=max3f(a,p1[2],p1[3]);
  #pragma unroll
  for(int r=4;r<16;r+=4){a=max3f(a,p0[r],p0[r+1]);b=max3f(b,p0[r+2],p0[r+3]);a=max3f(a,p1[r],p1[r+1]);b=max3f(b,p1[r+2],p1[r+3]);}
  const float m=max2f(a,b);
  auto rr=__builtin_amdgcn_permlane32_swap(__float_as_uint(m),__float_as_uint(m),false,false);
  return max2f(__uint_as_float(rr[0]),__uint_as_float(rr[1]));
}
__device__ __forceinline__ void pv(f32x16*o,int vb,bf16x8 pa0,bf16x8 pa1,bf16x8 pa2,bf16x8 pa3){
  #pragma unroll
  for(int d0=0;d0<2;++d0){s16x4 lo[4],hi[4];
    #pragma unroll
    for(int ks=0;ks<4;++ks){
      asm volatile("ds_read_b64_tr_b16 %0,%1 offset:%c2":"=&v"(lo[ks]):"v"(vb),"i"(d0*4096+ks*1024):"memory");
      asm volatile("ds_read_b64_tr_b16 %0,%1 offset:%c2":"=&v"(hi[ks]):"v"(vb),"i"(d0*4096+ks*1024+512):"memory");}
    asm volatile("s_waitcnt lgkmcnt(0)":::"memory");SBAR();
    #define PK(k) (bf16x8){lo[k][0],lo[k][1],lo[k][2],lo[k][3],hi[k][0],hi[k][1],hi[k][2],hi[k][3]}
    o[d0]=__builtin_amdgcn_mfma_f32_32x32x16_bf16(pa0,PK(0),o[d0],0,0,0);
    o[d0]=__builtin_amdgcn_mfma_f32_32x32x16_bf16(pa1,PK(1),o[d0],0,0,0);
    o[d0]=__builtin_amdgcn_mfma_f32_32x32x16_bf16(pa2,PK(2),o[d0],0,0,0);
    o[d0]=__builtin_amdgcn_mfma_f32_32x32x16_bf16(pa3,PK(3),o[d0],0,0,0);
    #undef PK
  }
}

#ifndef ATTN_STORE16
#define ATTN_STORE16(p,v) (*(u32x4*)(p)=(v))
#endif
template<int THRL,bool MASKED> __device__ __forceinline__ void attn_unit(int wvx,int b,int qb,const bf16*Q,const bf16*__restrict__ K,const bf16*__restrict__ V,bf16*O,const unsigned*MASK,char*shm){
  int tid_=wvx*64+lane_id_(); asm volatile("":"+v"(tid_));
  const int tid=tid_,lane=tid&63,r32=lane&31,hi=lane>>5; const int wid=__builtin_amdgcn_readfirstlane(tid>>6);
  const long rowbase=(long)b*SEQ; const int q0=qb*QB;
  const bf16*Qw=Q+(rowbase+q0+wid*QBLK)*DM;
  const bf16*Kh=K+rowbase*DM,*Vh=V+rowbase*DM;
  const unsigned*mrow=MASK+(size_t)(rowbase+q0+wid*QBLK+r32)*64;
  #define MLD(tt) mld_asm(mrow+2*(tt))
  const unsigned lds0=(unsigned)(uintptr_t)shm;
  float*wsf=(float*)(shm+LDS_WS)+wid*64;
  const bf16*ksrc=Kh+(long)lane*DM+wid*8;
  const bf16*vsrc=Vh+(long)(16*(wid&3)+(lane>>2))*DM+(wid>>2)*32+(lane&3)*8;
  const unsigned kdst=lds0+LDS_K+wid*1024, vdst=lds0+LDS_V+wid*1024;
  #define DMA_K(t,slot) glds16(ksrc+(long)(t)*KVBLK*DM,(unsigned)__builtin_amdgcn_readfirstlane(kdst+(slot)))
  #define DMA_V(t,slot) glds16(vsrc+(long)(t)*KVBLK*DM,(unsigned)__builtin_amdgcn_readfirstlane(vdst+(slot)))
  const int vb0=(int)(lds0+LDS_V)+((lane>>4)&1)*32+(lane&3)*8+(4*hi+((lane&15)>>2))*64;
  const char*Kbase=shm+LDS_K; bf16x8 kf[8];
  const lds_cptr shm3=(lds_cptr)shm; const lds_cptr kp0=shm3+LDS_K+hi*1024+r32*16; const lds_cptr vp0=shm3+LDS_V+((lane>>4)&1)*32+(lane&3)*8+(4*hi+((lane&15)>>2))*64;
  const int NT=(q0+QB)/KVBLK;
  uint2 mw_cur=make_uint2(~0u,~0u), mw_next=make_uint2(~0u,~0u); if(MASKED){ mw_cur=MLD(0); mw_next=MLD(1); }
  DMA_K(0,0);DMA_V(0,0);DMA_K(1,SLOTB);
  bf16x8 qr[4];
  #pragma unroll
  for(int d0=0;d0<4;++d0)qr[d0]=*reinterpret_cast<const bf16x8*>(&Qw[(long)r32*DM+d0*16+hi*8]);
  float mhat=0.f,l_reg=0.f;f32x16 o[2];o[0]=f32x16{};o[1]=f32x16{};f32x16 negm=f32x16{};asm volatile("":"+v"(negm));
  const int qrel=wid*QBLK+r32;
  #define CMASK(P0,P1,t) do{ if(MASKED){bmask(P0,P1,mw_cur,hi);} else {int jb_=(t)-(NT-4); if(jb_>=0)cmask(P0,P1,jb_,qrel,hi);} }while(0)
  bool resc=false;
  #define START(P0,P1) do{ float rm=rowmax(P0,P1); if(MASKED)rm=max2f(rm,-64.f); resc=false; \
    { const float dl=rm; mhat=fadd_s(mhat,dl); \
      _Pragma("unroll") for(int r=0;r<16;++r){P0[r]=fsub_s(P0[r],dl);P1[r]=fsub_s(P1[r],dl);} \
      _Pragma("unroll") for(int r=0;r<16;++r)negm[r]=-mhat; asm volatile("":"+v"(negm)); } \
    _Pragma("unroll") for(int r=0;r<16;++r)P0[r]=__builtin_amdgcn_exp2f(P0[r]); }while(0)
  #define RESC() do{ if(resc){ asm volatile("s_waitcnt lgkmcnt(0)":::"memory"); \
      _Pragma("unroll") for(int d_=0;d_<2;++d_) _Pragma("unroll") for(int r=0;r<16;++r)o[d_][r]*=wsf[crow(r,hi)]; } }while(0)
  f32x16 pA0,pA1,pB0,pB1;
  int sl_prev=0,sl_cur=0,sl_next=SLOTB;
  #define ROT() do{sl_prev=sl_cur;sl_cur=sl_next;sl_next=(sl_next==(NSLOT-1)*SLOTB)?0:sl_next+SLOTB;}while(0)
  DMA_K(2,2*SLOTB);
  WAIT_BAR(3);
  qkt(pA0,pA1,Kbase,qr,negm,r32,hi);asm volatile("s_nop 15\n\ts_nop 7":"+v"(pA0),"+v"(pA1));CMASK(pA0,pA1,0);
  START(pA0,pA1);
  _Pragma("unroll") for(int r=0;r<16;++r)pA1[r]=__builtin_amdgcn_exp2f(pA1[r]);
  WAIT_BAR(0);
  DMA_K(3,0);DMA_V(1,SLOTB);
  ROT();
  kload8(kf,kp0+sl_cur);
  WAIT_BAR(2);
  s16x4 vlo[8],vhi[8]; u32x4 pw0,pw1,pw2,pw3;
  #define PKW(P,B) cvtpk_s(P[B],P[B+1])
  #define PAF(k) __builtin_bit_cast(bf16x8,pw##k)
  #define VFR(i) (bf16x8){vlo[i][0],vlo[i][1],vlo[i][2],vlo[i][3],vhi[i][0],vhi[i][1],vhi[i][2],vhi[i][3]}
  #define PIN(x) asm volatile("":"+v"(x))
  #define MX3(a,b,c) __builtin_fmaxf(__builtin_fmaxf((a),(b)),(c))
  #define GAPA(MF,A0,A1,A2,A3,W0,W1,PW) do{ MF; sacc+=A0; sacc+=A1; sacc+=A2; sacc+=A3; PIN(sacc); W0; W1; PIN(PW); SBAR(); }while(0)
  #define EX(v) __builtin_amdgcn_exp2f(v)
  #define GAPB(MF,X,B) do{ MF; X[B]=EX(X[B]); X[B+1]=EX(X[B+1]); X[B+2]=EX(X[B+2]); X[B+3]=EX(X[B+3]); PIN(X); SBAR(); }while(0)
  #define VRD(i) do{ vlo[i]=vtr(vp_+(((i)>>2)*4096+((i)&3)*1024)); vhi[i]=vtr(vp_+(((i)>>2)*4096+((i)&3)*1024+512)); }while(0)
  #define KRD(G,j) do{ if(G){ kload2(kf,kp0+sl_next,j); SBAR(); } }while(0)
  #define STEP(C0,C1,P0,P1,t,GK,GV,GL) do{ SBAR(); if(MASKED){ mw_cur=mw_next; if((t)+1<NT) mw_next=MLD((t)+1); } \
    const lds_cptr vp_=vp0+sl_prev; \
    VRD(0); SBAR(); float sacc=(P0[0]+P0[1]); \
    GAPA(C0=__builtin_amdgcn_mfma_f32_32x32x16_bf16(kf[0],qr[0],negm,0,0,0), P0[2],P0[3],P0[4],P0[5],     pw0[0]=PKW(P0,0), pw0[1]=PKW(P0,2), pw0); \
    VRD(4); SBAR(); GAPA(C1=__builtin_amdgcn_mfma_f32_32x32x16_bf16(kf[1],qr[0],negm,0,0,0), P0[6],P0[7],P0[8],P0[9],     pw0[2]=PKW(P0,4), pw0[3]=PKW(P0,6), pw0); \
    VRD(1); SBAR(); GAPA(C0=__builtin_amdgcn_mfma_f32_32x32x16_bf16(kf[2],qr[1],C0,0,0,0),   P0[10],P0[11],P0[12],P0[13], pw1[0]=PKW(P0,8), pw1[1]=PKW(P0,10), pw1); \
    VRD(5); SBAR(); GAPA(C1=__builtin_amdgcn_mfma_f32_32x32x16_bf16(kf[3],qr[1],C1,0,0,0),   P0[14],P0[15],P1[0],P1[1],   pw1[2]=PKW(P0,12),pw1[3]=PKW(P0,14), pw1); \
    VRD(2); SBAR(); GAPA(C0=__builtin_amdgcn_mfma_f32_32x32x16_bf16(kf[4],qr[2],C0,0,0,0),   P1[2],P1[3],P1[4],P1[5],     pw2[0]=PKW(P1,0), pw2[1]=PKW(P1,2), pw2); \
    VRD(6); SBAR(); GAPA(C1=__builtin_amdgcn_mfma_f32_32x32x16_bf16(kf[5],qr[2],C1,0,0,0),   P1[6],P1[7],P1[8],P1[9],     pw2[2]=PKW(P1,4), pw2[3]=PKW(P1,6), pw2); \
    VRD(3); SBAR(); GAPA(C0=__builtin_amdgcn_mfma_f32_32x32x16_bf16(kf[6],qr[3],C0,0,0,0),   P1[10],P1[11],P1[12],P1[13], pw3[0]=PKW(P1,8), pw3[1]=PKW(P1,10), pw3); \
    VRD(7); SBAR(); GAPA(C1=__builtin_amdgcn_mfma_f32_32x32x16_bf16(kf[7],qr[3],C1,0,0,0),   P1[14],P1[15],0.f,0.f,       pw3[2]=PKW(P1,12),pw3[3]=PKW(P1,14), pw3); \
    l_reg+=sacc; \
    if(GK){DMA_K((t)+3,sl_cur);} if(GV){DMA_V((t)+1,sl_next);} \
    CMASK(C0,C1,t); \
    { float a=MX3(C0[0],C0[1],C1[0]),b=MX3(C0[2],C0[3],C1[1]); a=MX3(a,C1[2],C1[3]); \
      _Pragma("unroll") for(int r=4;r<16;r+=4){a=MX3(a,C0[r],C0[r+1]);b=MX3(b,C0[r+2],C0[r+3]);a=MX3(a,C1[r],C1[r+1]);b=MX3(b,C1[r+2],C1[r+3]);} \
      float rm=__builtin_fmaxf(a,b); { auto rr=__builtin_amdgcn_permlane32_swap(__float_as_uint(rm),__float_as_uint(rm),false,false); rm=__builtin_fmaxf(__uint_as_float(rr[0]),__uint_as_float(rr[1])); } \
      resc=false; \
      if(__builtin_expect(__any(rm>(float)THRL),0)){ const float dl=__builtin_fmaxf(rm,0.f); mhat+=dl; \
        _Pragma("unroll") for(int r=0;r<16;++r){C0[r]-=dl;C1[r]-=dl;} \
        _Pragma("unroll") for(int r=0;r<16;++r)negm[r]=-mhat; asm volatile("":"+v"(negm)); \
        const float f=__builtin_amdgcn_exp2f(-dl); l_reg*=f; if(hi==0)wsf[r32]=f; resc=true; } } \
    SBAR(); \
    GAPB(o[0]=__builtin_amdgcn_mfma_f32_32x32x16_bf16(PAF(0),VFR(0),o[0],0,0,0), C0,0); \
    GAPB(o[1]=__builtin_amdgcn_mfma_f32_32x32x16_bf16(PAF(0),VFR(4),o[1],0,0,0), C0,4); \
    KRD(GL,0); GAPB(o[0]=__builtin_amdgcn_mfma_f32_32x32x16_bf16(PAF(1),VFR(1),o[0],0,0,0), C0,8); \
    KRD(GL,1); GAPB(o[1]=__builtin_amdgcn_mfma_f32_32x32x16_bf16(PAF(1),VFR(5),o[1],0,0,0), C0,12); \
    KRD(GL,2); GAPB(o[0]=__builtin_amdgcn_mfma_f32_32x32x16_bf16(PAF(2),VFR(2),o[0],0,0,0), C1,0); \
    KRD(GL,3); GAPB(o[1]=__builtin_amdgcn_mfma_f32_32x32x16_bf16(PAF(2),VFR(6),o[1],0,0,0), C1,4); \
    GAPB(o[0]=__builtin_amdgcn_mfma_f32_32x32x16_bf16(PAF(3),VFR(3),o[0],0,0,0), C1,8); \
    GAPB(o[1]=__builtin_amdgcn_mfma_f32_32x32x16_bf16(PAF(3),VFR(7),o[1],0,0,0), C1,12); \
    }while(0)
  int t=1;
  #undef CMASK
  #define CMASK(P0,P1,t) do{ if(MASKED){bmask(P0,P1,mw_cur,hi);} }while(0)
  for(;t+5<NT;t+=2){
    STEP(pB0,pB1,pA0,pA1,t,true,true,true);     WAIT_BAR(2); RESC(); ROT();
    STEP(pA0,pA1,pB0,pB1,t+1,true,true,true);   WAIT_BAR(2); RESC(); ROT();
  }
  #undef CMASK
  #define CMASK(P0,P1,t) do{ if(MASKED){bmask(P0,P1,mw_cur,hi);} else {int jb_=(t)-(NT-4); if(jb_>=0)cmask(P0,P1,jb_,qrel,hi);} }while(0)
  #define ENDW(tt) do{ if((tt)+3<NT){WAIT_BAR(2);} else if((tt)+2<NT){WAIT_BAR(1);} else {WAIT_BAR(0);} }while(0)
  for(;t+1<NT;t+=2){
    STEP(pB0,pB1,pA0,pA1,t,(t+3<NT),(t+1<NT),(t+1<NT));       ENDW(t);   RESC(); ROT();
    STEP(pA0,pA1,pB0,pB1,t+1,(t+4<NT),(t+2<NT),(t+2<NT));     ENDW(t+1); RESC(); ROT();
  }
  STEP(pB0,pB1,pA0,pA1,NT-1,false,false,false); RESC();
  { float sacc=pB0[0]+pB0[1]; _Pragma("unroll") for(int r=2;r<16;++r)sacc+=pB0[r]; _Pragma("unroll") for(int r=0;r<16;++r)sacc+=pB1[r]; l_reg+=sacc;
    pw0=(u32x4){PKW(pB0,0),PKW(pB0,2),PKW(pB0,4),PKW(pB0,6)};pw1=(u32x4){PKW(pB0,8),PKW(pB0,10),PKW(pB0,12),PKW(pB0,14)};pw2=(u32x4){PKW(pB1,0),PKW(pB1,2),PKW(pB1,4),PKW(pB1,6)};pw3=(u32x4){PKW(pB1,8),PKW(pB1,10),PKW(pB1,12),PKW(pB1,14)};
    SBAR(); pv(o,vb0+sl_cur,PAF(0),PAF(1),PAF(2),PAF(3)); }
  #undef PKW
  #undef PAF
  #undef VFR
  #undef PIN
  #undef MX3
  #undef GAPA
  #undef GAPB
  #undef EX
  #undef VRD
  #undef KRD
  #undef STEP
  #undef ENDW
  {auto rr=__builtin_amdgcn_permlane32_swap(__float_as_uint(l_reg),__float_as_uint(l_reg),false,false);l_reg=__uint_as_float(rr[0])+__uint_as_float(rr[1]);}
  if(hi==0)wsf[32+r32]=l_reg;asm volatile("s_waitcnt lgkmcnt(0)":::"memory");
  float rli[16];
  #pragma unroll
  for(int r=0;r<16;++r)rli[r]=__builtin_amdgcn_rcpf(wsf[32+crow(r,hi)]);
  bf16*Ow=O+(rowbase+q0+wid*QBLK)*DMO;
  { bf16*stg=(bf16*)(shm+LDS_OST)+wid*2048;
    #pragma unroll
    for(int r=0;r<16;++r){const int orow=crow(r,hi);
      #pragma unroll
      for(int d0=0;d0<2;++d0)stg[orow*64+d0*32+r32]=(bf16)f2bf_(o[d0][r]*rli[r]);}
    asm volatile("s_waitcnt lgkmcnt(0)":::"memory");
    #pragma unroll
    for(int i=0;i<4;++i){const int row=i*8+(lane>>3),ch=lane&7; const u32x4 v=*(const u32x4*)(stg+row*64+ch*8); ATTN_STORE16(Ow+(long)row*DMO+ch*8,v);} }
  asm volatile("s_waitcnt lgkmcnt(0)\n\ts_barrier":::"memory");
  #undef DMA_K
  #undef DMA_V
  #undef MLD
  #undef CMASK
  #undef START
  #undef RESC
  #undef ROT
}
constexpr int ATTN_LDS_BYTES=LDS_BYTES;
#undef SBAR
#undef WAIT_BAR
}
#define GAS __attribute__((address_space(1)))
#define LAS __attribute__((address_space(3)))
typedef unsigned short bf16;
typedef unsigned v4u __attribute__((ext_vector_type(4)));
typedef float f32x4 __attribute__((ext_vector_type(4)));
typedef short bf16x8 __attribute__((ext_vector_type(8)));
typedef GAS unsigned gu32;
typedef GAS unsigned long long gu64;
#define RLX_AGENT __ATOMIC_RELAXED, __HIP_MEMORY_SCOPE_AGENT
#define LDS_WAIT() asm volatile("s_waitcnt lgkmcnt(0)" ::: "memory")
#define VM_WAIT() asm volatile("s_waitcnt vmcnt(0)" ::: "memory")
__device__ __forceinline__ unsigned long long rt() { return __builtin_amdgcn_s_memrealtime(); }
__device__ __forceinline__ unsigned f2bf(float f) { unsigned u = __builtin_bit_cast(unsigned, f); return (u + 0x7fffu + ((u >> 16) & 1u)) >> 16; }
__device__ __forceinline__ unsigned pk2(float lo, float hi) { return f2bf(lo) | (f2bf(hi) << 16); }
__device__ __forceinline__ int tid_of(int wvx) { return wvx * 64 + lane_id_(); }
__device__ __forceinline__ int bid_() { int b_ = (int)blockIdx.x; asm volatile("" : "+s"(b_)); return b_; }
__device__ __forceinline__ int gsz_() { int g_ = (int)gridDim.x; asm volatile("" : "+s"(g_)); return g_; }
#define XB_TMO      128
#define XB_XCNT(j)  (256  + 64 * (j))
#define XB_XSUB(j)  (1280 + 64 * (j))
#define XB_XGEN(j)  (2304 + 64 * (j))
#define XB_TOP      3328
#define XB_TOPGEN   3392
#define XCD_BAR_WORDS 3456
#define XB_SPIN_CAP (1u << 20)

__device__ __forceinline__ unsigned xb_ld(unsigned* p)              { return __hip_atomic_load(p, __ATOMIC_RELAXED, __HIP_MEMORY_SCOPE_AGENT); }
__device__ __forceinline__ unsigned xb_add(unsigned* p, unsigned v) { return __hip_atomic_fetch_add(p, v, __ATOMIC_RELAXED, __HIP_MEMORY_SCOPE_AGENT); }
__device__ __forceinline__ unsigned xb_xcc_id() { return (unsigned)__builtin_amdgcn_s_getreg((3 << 11) | 20) & 0xFu; }
#define XB_SPIN(cond, bar) do { unsigned _sp = 0; while (cond) { __builtin_amdgcn_s_sleep(1); \
    if ((++_sp & 255u) == 0u) { if (xb_ld(&(bar)[XB_TMO])) break; if (_sp > XB_SPIN_CAP) { atomicAdd(&(bar)[XB_TMO], 1u); break; } } } } while (0)

struct XcdBarrier {
    unsigned* bar; unsigned x;
    volatile LAS unsigned* st;
};

__device__ __forceinline__ XcdBarrier xcd_barrier_post(unsigned* bar, volatile LAS unsigned* st) {
    XcdBarrier b; b.bar = bar; b.x = xb_xcc_id(); b.st = st;
    if (threadIdx.x == 0) (void)xb_add(&bar[XB_XCNT(b.x)], 1u);
    return b;
}
__device__ __forceinline__ void xcd_barrier_complete(unsigned* bar, unsigned x, unsigned& nloc, unsigned& nx) {
    const unsigned G = gridDim.x * gridDim.y * gridDim.z;
    unsigned sum, cnt, mine, sp = 0u;
    for (;;) {
        sum = 0u; cnt = 0u; mine = 0u;
#pragma unroll
        for (unsigned j = 0; j < 16; ++j) { const unsigned c = xb_ld(&bar[XB_XCNT(j)]); sum += c; cnt += (c > 0u) ? 1u : 0u; mine = (j == x) ? c : mine; }
        if (sum == G) break;
        __builtin_amdgcn_s_sleep(1);
        if ((++sp & 255u) == 0u) { if (xb_ld(&bar[XB_TMO])) break; if (sp > XB_SPIN_CAP) { atomicAdd(&bar[XB_TMO], 1u); break; } }
    }
    nloc = mine > 0u ? mine : 1u; nx = cnt > 0u ? cnt : 1u;
}

__device__ __attribute__((noinline)) void xcd_barrier_fn(unsigned* bar_, unsigned x_, volatile LAS unsigned* st_, bool leader_) {
    XcdBarrier b; b.bar = bar_; b.x = x_; b.st = st_;
    asm volatile("s_waitcnt vmcnt(0)" ::: "memory");
    __syncthreads();
    if (leader_) {
        unsigned* bar = b.bar;
        __builtin_amdgcn_s_waitcnt(0);
        unsigned nloc = b.st[0], nx = b.st[1];
        if (nloc == 0u) { xcd_barrier_complete(bar, b.x, nloc, nx); b.st[0] = nloc; b.st[1] = nx; }
        const unsigned old = xb_add(&bar[XB_XSUB(b.x)], 1u);
        const unsigned gen = old / nloc;
        if (old + 1u == (gen + 1u) * nloc) {
            __builtin_amdgcn_fence(__ATOMIC_RELEASE, "agent");
            asm volatile("s_waitcnt vmcnt(0)" ::: "memory");
            const unsigned og = xb_add(&bar[XB_TOP], 1u);
            const unsigned tg = og / nx;
            if (og + 1u == (tg + 1u) * nx) xb_add(&bar[XB_TOPGEN], 1u);
            else XB_SPIN(xb_ld(&bar[XB_TOPGEN]) == tg, bar);
            __builtin_amdgcn_fence(__ATOMIC_ACQUIRE, "agent");
            xb_add(&bar[XB_XGEN(b.x)], 1u);
            asm volatile("s_waitcnt vmcnt(0)" ::: "memory");
        } else {
            XB_SPIN(xb_ld(&bar[XB_XGEN(b.x)]) == gen, bar);
            __builtin_amdgcn_fence(__ATOMIC_ACQUIRE, "agent");
            asm volatile("s_waitcnt vmcnt(0)" ::: "memory");
        }
    }
    __syncthreads();
}


constexpr int NB = 16, SEQ = 2048, T = NB * SEQ, D = 1024, DEPTH = 4, NHC = 4096, NEXP = 32, NWAVES = 8;
constexpr int NIN = 3920;
constexpr float LN_EPS = 1e-5f, DN_ALPHA = 1.6817928305074290f;
constexpr int RPAD = T * 4 + NEXP * 256;
constexpr int HC_MQ = 0, HC_MK = 256, HC_MV = 512, HC_MO = 768, HC_DQ = 1024, HC_DK = 1536, HC_DV = 2048, HC_SQ = 2560, HC_SK = 2816, HC_SV = 3072, HC_XQ = 3328, HC_XK = 3840, HC_MI = 3904, HC_MF = 3908, HC_XW = 3912;
constexpr size_t MiB = 1u << 20;
constexpr size_t WS_CTL = 0, CTL_ZERO_BYTES = 2 * MiB;
constexpr size_t WS_MOD = 2 * MiB;
constexpr size_t WS_LAM = WS_MOD + 7 * MiB / 4;
constexpr size_t WS_RWT = 4 * MiB;
constexpr size_t WS_CS = 8 * MiB;
constexpr size_t WS_WIN = 16 * MiB;
constexpr size_t WS_WOUT = 48 * MiB;
constexpr size_t WS_W1 = 64 * MiB;
constexpr size_t WS_W2 = 576 * MiB;
constexpr size_t WS_XB = 832 * MiB;
constexpr size_t WS_U = 960 * MiB;
constexpr size_t WS_H = 1024 * MiB;
constexpr size_t WS_QKC = 1280 * MiB;
constexpr size_t WS_XKP = 1312 * MiB;
constexpr size_t WS_MASK = 1316 * MiB;
constexpr size_t WS_TOK = 1324 * MiB;
constexpr size_t WS_MIX = 1344 * MiB;
constexpr size_t WS_Y = 1408 * MiB;
constexpr size_t WS_SC = 1472 * MiB;
constexpr size_t WS_XG = 1728 * MiB;
constexpr size_t WS_HM = 2000 * MiB;
constexpr size_t WS_YM = 2272 * MiB;
constexpr size_t WS_END = 2544 * MiB;
constexpr size_t WS_U8 = 3000 * MiB;
constexpr size_t WS_WIN8 = 3040 * MiB;
constexpr size_t WS_TOP = 3060 * MiB;
constexpr int CW_CNT = 1024;
constexpr int CW_BAR = 16384;
constexpr int RING_BYTES = 131072, TAB_OFF = RING_BYTES, MISC_OFF = RING_BYTES + 4096, LDS_BYTES = 147456;
constexpr int NPH = 10, NSTEPS = 2 + NPH * DEPTH;
enum { PH_IN = 0, PH_POST, PH_MIXA, PH_SEL, PH_DSA, PH_OUT, PH_ROW1, PH_G1, PH_G2, PH_ROW2 };

typedef unsigned short us8 __attribute__((ext_vector_type(8)));
__device__ __forceinline__ float bf2f(bf16 h) { return __uint_as_float((unsigned)h << 16); }
#define DPPF(x, c) __int_as_float(__builtin_amdgcn_update_dpp(0, __float_as_int(x), c, 0xF, 0xF, true))
__device__ __forceinline__ float wave_sum(float v) {
    v += DPPF(v, 0xB1); v += DPPF(v, 0x4E); v += DPPF(v, 0x141); v += DPPF(v, 0x140);
    return (__int_as_float(__builtin_amdgcn_readlane(__float_as_int(v), 0)) + __int_as_float(__builtin_amdgcn_readlane(__float_as_int(v), 16))) + (__int_as_float(__builtin_amdgcn_readlane(__float_as_int(v), 32)) + __int_as_float(__builtin_amdgcn_readlane(__float_as_int(v), 48)));
}
__device__ __forceinline__ float wave_max(float v) {
    v = fmaxf(v, DPPF(v, 0xB1)); v = fmaxf(v, DPPF(v, 0x4E)); v = fmaxf(v, DPPF(v, 0x141)); v = fmaxf(v, DPPF(v, 0x140));
    return fmaxf(fmaxf(__int_as_float(__builtin_amdgcn_readlane(__float_as_int(v), 0)), __int_as_float(__builtin_amdgcn_readlane(__float_as_int(v), 16))), fmaxf(__int_as_float(__builtin_amdgcn_readlane(__float_as_int(v), 32)), __int_as_float(__builtin_amdgcn_readlane(__float_as_int(v), 48))));
}
__device__ __forceinline__ float shx(float v, int lane, int m) { return __int_as_float(__builtin_amdgcn_ds_bpermute((lane ^ m) << 2, __float_as_int(v))); }
__device__ __forceinline__ int shxi(int v, int lane, int m) { return __builtin_amdgcn_ds_bpermute((lane ^ m) << 2, v); }
__device__ __forceinline__ float shup(float v, int lane, int o) { return __int_as_float(__builtin_amdgcn_ds_bpermute(((lane - o) & 63) << 2, __float_as_int(v))); }
__device__ __forceinline__ int shupi(int v, int lane, int o) { return __builtin_amdgcn_ds_bpermute(((lane - o) & 63) << 2, v); }
__device__ __forceinline__ float sigmoidf_(float x) { return 1.0f / (1.0f + __expf(-x)); }
struct Ctx {
    LAS unsigned char* lds;
    int tid, lane, wave, gw, ngw;
    const float* in[25];
    float* out; unsigned char* ws;
};
#define WSP(type, off) ((type*)(C.ws + (off)))
enum { I_X = 0, I_C, I_POS, I_WIN, I_GATEB, I_CONVW, I_CONVB, I_MNORM, I_DFLAM, I_DFNORM, I_IDXG, I_IDXB, I_WOUT, I_ADAW, I_ADAB, I_LN1G, I_LN1B, I_LN2G, I_LN2B, I_RW, I_RB, I_W1, I_B1, I_W2, I_B2 };

__device__ __forceinline__ int in_dest_col(int n) {
    auto rp = [](int j) { const int hd = j >> 6, d = j & 63; return hd * 64 + ((d < 32) ? 2 * d : 2 * (d - 32) + 1); };
    if (n < 256) return HC_MQ + n;
    if (n < 512) return HC_MK + (n - 256);
    if (n < 768) return HC_MV + (n - 512);
    if (n < 772) return HC_MI + (n - 768);
    if (n < 776) return HC_MF + (n - 772);
    if (n < 1032) return HC_MO + (n - 776);
    if (n < 1544) return HC_DQ + rp(n - 1032);
    if (n < 2056) return HC_DK + rp(n - 1544);
    if (n < 2568) return HC_DV + (n - 2056);
    if (n < 2824) return HC_SQ + rp(n - 2568);
    if (n < 3080) return HC_SK + rp(n - 2824);
    if (n < 3336) return HC_SV + (n - 3080);
    if (n < 3848) return HC_XQ + rp(n - 3336);
    if (n < 3912) return HC_XK + (n - 3848);
    return HC_XW + (n - 3912);
}
template <class F> __device__ __forceinline__ void transpose_item(const float* W, int ldw, int K, int nvalid, int k0, int n0, bf16* WT, LAS float* scr, int lane, F drow) {
    const int nn = n0 + (lane & 31); const bool ok = nn < nvalid;
    float tv_[32];
#pragma unroll
    for (int i = 0; i < 32; ++i) { const int kk = 2 * i + (lane >> 5); tv_[i] = ok ? W[(size_t)(k0 + kk) * ldw + nn] : 0.f; }
#pragma unroll
    for (int i = 0; i < 32; ++i) { const int kk = 2 * i + (lane >> 5); scr[kk * 33 + (lane & 31)] = tv_[i]; }
    LDS_WAIT(); asm volatile("" ::: "memory");
    const int c = lane & 7;
#pragma unroll
    for (int j = 0; j < 4; ++j) { const int n = (lane >> 3) + 8 * j; const LAS float* s = scr + (8 * c) * 33 + n;
        v4u o; o.x = pk2(s[0 * 33], s[1 * 33]); o.y = pk2(s[2 * 33], s[3 * 33]); o.z = pk2(s[4 * 33], s[5 * 33]); o.w = pk2(s[6 * 33], s[7 * 33]);
        if (n0 + n < nvalid) *(GAS v4u*)(WT + (size_t)drow(n0 + n) * K + k0 + 8 * c) = o; }
    LDS_WAIT(); asm volatile("" ::: "memory");
}

template <class F> __device__ __forceinline__ void transpose_item_f8(const float* W, int ldw, int K, int nvalid, int k0, int n0, unsigned char* WT8, LAS float* scr, int lane, float sc, F drow) {
    const int nn = n0 + (lane & 31); const bool ok = nn < nvalid;
    float tv_[32];
#pragma unroll
    for (int i = 0; i < 32; ++i) { const int kk = 2 * i + (lane >> 5); tv_[i] = ok ? W[(size_t)(k0 + kk) * ldw + nn] : 0.f; }
#pragma unroll
    for (int i = 0; i < 32; ++i) { const int kk = 2 * i + (lane >> 5); scr[kk * 33 + (lane & 31)] = tv_[i]; }
    LDS_WAIT(); asm volatile("" ::: "memory");
    const int c = lane & 7;
#pragma unroll
    for (int j = 0; j < 4; ++j) { const int n = (lane >> 3) + 8 * j; const LAS float* s = scr + (8 * c) * 33 + n;
        typedef unsigned u32x2_ __attribute__((ext_vector_type(2))); u32x2_ o; o.x = pg8::pk4_fp8(s[0 * 33], s[1 * 33], s[2 * 33], s[3 * 33], sc); o.y = pg8::pk4_fp8(s[4 * 33], s[5 * 33], s[6 * 33], s[7 * 33], sc);
        if (n0 + n < nvalid) *(GAS u32x2_*)(WT8 + (size_t)drow(n0 + n) * K + k0 + 8 * c) = o; }
    LDS_WAIT(); asm volatile("" ::: "memory");
}
struct Args { const float* in[25]; float* out; unsigned char* ws; int s_lo, s_hi, li, pad; };
typedef __attribute__((address_space(4))) const Args CArgs;
__device__ __forceinline__ CArgs* kargs() { CArgs* p = (CArgs*)__builtin_amdgcn_kernarg_segment_ptr(); asm volatile("" : "+s"(p)); return p; }
__device__ __forceinline__ LAS unsigned char* lds_launder(LAS unsigned char* q) { unsigned v = (unsigned)(size_t)q; asm volatile("" : "+s"(v)); return (LAS unsigned char*)(size_t)v; }
#define WS(type, off) ((type*)(A->ws + (off)))
#define TIDX CArgs* A = kargs(); int tid_ = tid_of(wvx); asm volatile("" : "+v"(tid_)); const int tid = tid_, lane = tid & 63, wave = __builtin_amdgcn_readfirstlane(tid >> 6); const int bidx = bid_(), gsz = gsz_(); const int gw = bidx * NWAVES + wave, ngw = gsz * NWAVES; (void)bidx; (void)gsz; (void)lane; (void)gw; (void)ngw

__device__ __forceinline__ void pro_a(LAS unsigned char* lds, int wvx) {
    TIDX;
    LAS float* scr = (LAS float*)(lds + wave * 16384);
    constexpr int IT_IN = 16 * 123, IT_OUT = 16 * 32, IT_W1 = 16 * 64, IT_W2 = 16 * 32;
    constexpr int N_IN = DEPTH * IT_IN, N_OUT = DEPTH * IT_OUT, N_W1 = DEPTH * NEXP * IT_W1, N_W2 = DEPTH * NEXP * IT_W2;
    constexpr int NITEMS = N_IN + N_OUT;
    for (int it = gw; it < NITEMS; it += ngw) {
        int r = it;
        if (r < N_IN) { const int l = r / IT_IN, q = r % IT_IN, kb = q / 123, nb = q % 123;
            transpose_item(A->in[I_WIN] + (size_t)l * D * NIN, NIN, D, NIN, kb * 64, nb * 32, WS(bf16, WS_WIN) + (size_t)l * NHC * D, scr, lane, [](int n) { return in_dest_col(n); });
            transpose_item_f8(A->in[I_WIN] + (size_t)l * D * NIN, NIN, D, NIN, kb * 64, nb * 32, WS(unsigned char, WS_WIN8) + (size_t)l * NHC * D, scr, lane, 256.0f, [](int n) { return in_dest_col(n); }); continue; }
        r -= N_IN;
        { const int l = r / IT_OUT, q = r % IT_OUT, kb = q / 32, nb = q % 32;
            transpose_item(A->in[I_WOUT] + (size_t)l * D * D, D, D, D, kb * 64, nb * 32, WS(bf16, WS_WOUT) + (size_t)l * D * D, scr, lane, [](int n) { return n; }); }
    }
    {
        constexpr int JW1 = 16 * 32, JW2 = 16 * 16, M_W1 = DEPTH * NEXP * JW1, M_W2 = DEPTH * NEXP * JW2, NX = M_W1 + M_W2;
        __syncthreads();
        LAS float* sx = (LAS float*)(lds + wave * 16640);
        for (int it = gw; it < NX; it += ngw) {
            int r = it; const float* src; int ldw, k0, n0; unsigned char* dst; const bool w1 = r < M_W1;
            if (w1) { const int le = r / JW1, q = r % JW1; k0 = (q / 32) * 64; n0 = (q % 32) * 64; ldw = 2048; src = A->in[I_W1] + (size_t)le * D * 2048; dst = WS(unsigned char, WS_W1) + (size_t)le * 2048 * D; }
            else { r -= M_W1; const int le = r / JW2, q = r % JW2; k0 = (q / 16) * 64; n0 = (q % 16) * 64; ldw = D; src = A->in[I_W2] + (size_t)le * D * D; dst = WS(unsigned char, WS_W2) + (size_t)le * D * D; }
            float tv_[64];
#pragma unroll
            for (int i = 0; i < 64; ++i) tv_[i] = src[(size_t)(k0 + i) * ldw + n0 + lane];
#pragma unroll
            for (int i = 0; i < 64; ++i) sx[i * 65 + lane] = tv_[i];
            LDS_WAIT(); asm volatile("" ::: "memory");
            const int c = lane & 7;
#pragma unroll
            for (int j = 0; j < 8; ++j) { const int nl = (lane >> 3) + 8 * j, n = n0 + nl; const LAS float* s = sx + (8 * c) * 65 + nl;
                typedef unsigned u32x2_ __attribute__((ext_vector_type(2))); u32x2_ o; o.x = pg8::pk4_fp8(s[0 * 65], s[1 * 65], s[2 * 65], s[3 * 65], 256.0f); o.y = pg8::pk4_fp8(s[4 * 65], s[5 * 65], s[6 * 65], s[7 * 65], 256.0f);
                const int up = n >> 10, jj = n & 1023; const int drow = w1 ? ((jj >> 7) * 256 + up * 128 + (jj & 127)) : n;
                *(GAS u32x2_*)(dst + (size_t)drow * D + k0 + 8 * c) = o; }
            LDS_WAIT(); asm volatile("" ::: "memory");
        }
    }
    for (int r = gw; r < DEPTH * (NHC - NIN); r += ngw) { const int l = r / (NHC - NIN), row = NIN + r % (NHC - NIN);
        GAS v4u* p = (GAS v4u*)(WS(bf16, WS_WIN) + ((size_t)l * NHC + row) * D) + lane; p[0] = (v4u){0u, 0u, 0u, 0u}; p[64] = (v4u){0u, 0u, 0u, 0u};
        GAS v4u* p8 = (GAS v4u*)(WS(unsigned char, WS_WIN8) + ((size_t)l * NHC + row) * D) + lane; p8[0] = (v4u){0u, 0u, 0u, 0u}; }
    for (int idx = bidx * 512 + tid; idx < T * 32; idx += gsz * 512) {
        const int tok = idx >> 5, i = idx & 31;
        const double inv = exp(-(double)i * (9.210340371976184 / 32.0));
        const double ang = (double)((const int*)A->in[I_POS])[tok] * inv;
        const double rev = ang * 0.15915494309189535;
        const float fr = (float)(rev - rint(rev));
        float2 v; v.x = __builtin_amdgcn_cosf(fr); v.y = __builtin_amdgcn_sinf(fr);
        WS(float2, WS_CS)[idx] = v;
    }
    for (int idx = bidx * 512 + tid; idx < DEPTH * NEXP * D; idx += gsz * 512) {
        const int l = idx / (NEXP * D), r = idx % (NEXP * D), e = r / D, d = r % D;
        WS(float, WS_RWT)[idx] = A->in[I_RW][((size_t)l * D + d) * NEXP + e];
    }
    if (bidx == 0 && wave == 0) {
        for (int l = 0; l < DEPTH; ++l) { const float* lf = A->in[I_DFLAM] + l * 256;
            const float a = wave_sum(lf[lane] * lf[64 + lane]), b = wave_sum(lf[128 + lane] * lf[192 + lane]);
            if (lane == 0) WS(float, WS_LAM)[l] = __expf(a) - __expf(b) + (0.8f - 0.6f * __expf(-0.3f * (float)l)); }
    }
    __syncthreads();
    if (bidx < (DEPTH * 6144) / 512) {
        LAS float* ca = (LAS float*)lds;
        for (int i = tid; i < NB * D; i += 512) { const float v = A->in[I_C][i]; ca[i] = v / (1.0f + __expf(-v)); }
        __syncthreads();
        const int col = bidx * 512 + tid, l = col / 6144, m = col % 6144;
        const float* w = A->in[I_ADAW] + (size_t)l * D * 6144 + m;
        float acc[NB];
#pragma unroll
        for (int b = 0; b < NB; ++b) acc[b] = 0.f;
        for (int d = 0; d < D; ++d) { const float wv = w[(size_t)d * 6144];
#pragma unroll
            for (int b = 0; b < NB; ++b) acc[b] += ca[b * D + d] * wv; }
        const float bias = A->in[I_ADAB][col];
#pragma unroll
        for (int b = 0; b < NB; ++b) WS(float, WS_MOD)[((size_t)l * NB + b) * 6144 + m] = acc[b] + bias;
        __syncthreads();
    }
}
__device__ __forceinline__ void pro_b(int wvx) {
    TIDX;
    for (int tok = gw; tok < T; tok += ngw) {
        const int b = tok / SEQ; const float* mod = WS(float, WS_MOD) + (size_t)b * 6144;
        const GAS f32x4* xr = (const GAS f32x4*)(A->in[I_X] + (size_t)tok * D) + lane;
        GAS unsigned long long* o8 = (GAS unsigned long long*)(WS(bf16, WS_U) + (size_t)tok * D) + lane;
#pragma unroll
        for (int j = 0; j < 4; ++j) { const f32x4 x = xr[64 * j]; const f32x4 sh = *(const f32x4*)(mod + 4 * lane + 256 * j), sc = *(const f32x4*)(mod + 1024 + 4 * lane + 256 * j);
            const f32x4 u = x * (1.0f + sc) + sh; o8[64 * j] = (unsigned long long)pk2(u.x, u.y) | ((unsigned long long)pk2(u.z, u.w) << 32);
            ((GAS unsigned*)(WS(unsigned char, WS_U8) + (size_t)tok * D) + lane)[64 * j] = pg8::pk4_fp8(u.x, u.y, u.z, u.w, 16.0f); }
    }
}
__device__ __forceinline__ void ph_post(int l, int wvx) {
    TIDX;
    const bf16* H = WS(bf16, WS_H); bf16* XKP = WS(bf16, WS_XKP); bf16* QKC = WS(bf16, WS_QKC);
    const float* cw = A->in[I_CONVW] + (size_t)l * 4 * 512; const float* cb = A->in[I_CONVB] + (size_t)l * 512;
    const float gi = A->in[I_IDXG][l * 64 + lane], bi = A->in[I_IDXB][l * 64 + lane];
    bf16 nxk = 0; float2 ncs = make_float2(1.f, 0.f); v4u nraw[4];
#define POST_LOAD(tk) do { const int s_ = (tk) % SEQ; nxk = H[(size_t)(tk) * NHC + HC_XK + lane]; ncs = WS(float2, WS_CS)[(size_t)(tk) * 32 + (lane & 31)]; \
        _Pragma("unroll") for (int j = 0; j < 4; ++j) { nraw[j] = (v4u){0u, 0u, 0u, 0u}; if (s_ - 3 + j >= 0) nraw[j] = *(const GAS v4u*)(H + (size_t)((tk) - 3 + j) * NHC + 8 * lane); } } while (0)
    if (gw < T) POST_LOAD(gw);
    for (int tok = gw; tok < T; tok += ngw) {
        const bf16 cxk = nxk; const float2 cs = ncs; v4u craw[4];
#pragma unroll
        for (int j = 0; j < 4; ++j) craw[j] = nraw[j];
        if (tok + ngw < T) POST_LOAD(tok + ngw);
        {
            const float v = bf2f(cxk);
            const float mean = wave_sum(v) * (1.0f / 64.0f); const float dv = v - mean;
            const float var = wave_sum(dv * dv) * (1.0f / 64.0f);
            const float nv = dv * (1.0f / sqrtf(var + LN_EPS)) * gi + bi;
            const float pv = shx(nv, lane, 32);
            const int i = lane & 31;
            const float o = (lane < 32) ? (nv * cs.x - pv * cs.y) : (nv * cs.x + pv * cs.y);
            XKP[(size_t)tok * 64 + 2 * i + (lane >> 5)] = (bf16)f2bf(o);
        }
        {
            const int c0 = 8 * lane;
            float acc[8];
#pragma unroll
            for (int c = 0; c < 8; ++c) acc[c] = cb[c0 + c];
#pragma unroll
            for (int j = 0; j < 4; ++j) {
                const unsigned rw[4] = {craw[j].x, craw[j].y, craw[j].z, craw[j].w};
#pragma unroll
                for (int c = 0; c < 8; ++c) { const float x = __uint_as_float((c & 1) ? (rw[c >> 1] & 0xffff0000u) : (rw[c >> 1] << 16)); acc[c] += cw[j * 512 + c0 + c] * x; }
            }
            v4u o;
#define SILU(x) ((x) / (1.0f + __expf(-(x))))
            o.x = pk2(SILU(acc[0]), SILU(acc[1])); o.y = pk2(SILU(acc[2]), SILU(acc[3])); o.z = pk2(SILU(acc[4]), SILU(acc[5])); o.w = pk2(SILU(acc[6]), SILU(acc[7]));
#undef SILU
            *(GAS v4u*)(QKC + (size_t)tok * 512 + c0) = o;
        }
    }
#undef POST_LOAD
}
typedef float f32x16 __attribute__((ext_vector_type(16)));
__device__ __forceinline__ void select_load(const float* SC, int tok, int lane, f32x4 (&raw)[8]);
__device__ __forceinline__ void select_row(const f32x4 (&raw)[8], unsigned* MASK, int tok, int lane);
__device__ __forceinline__ void ph_idx_scores(int wvx) {
    TIDX;
    const bf16* H = WS(bf16, WS_H); const bf16* XKP = WS(bf16, WS_XKP); float* SC = WS(float, WS_SC); unsigned* MASK = WS(unsigned, WS_MASK);
    const int r = lane & 31, hh = lane >> 5, ql = r >> 3, hd = r & 7;
    for (int item = bidx; item < 256; item += gsz) {
        const int b = item >> 4, p = item & 15;
#pragma unroll 1
        for (int sub = 0; sub < 2; ++sub) {
            const int qblk = sub ? 31 - p : p, q0 = qblk * 64 + 8 * wave, tok0 = b * SEQ + q0;
            bf16x8 af[2][4];
#pragma unroll
            for (int g = 0; g < 2; ++g) { const bf16* ap = H + (size_t)(tok0 + 4 * g + ql) * NHC + HC_XQ + hd * 64 + 8 * hh;
#pragma unroll
              for (int ks = 0; ks < 4; ++ks) af[g][ks] = *(const GAS bf16x8*)(ap + ks * 16); }
            float wv[2][4][4];
#pragma unroll
            for (int g = 0; g < 2; ++g)
#pragma unroll
                for (int q = 0; q < 4; ++q)
#pragma unroll
                    for (int i = 0; i < 4; ++i) wv[g][q][i] = bf2f(H[(size_t)(tok0 + 4 * g + q) * NHC + HC_XW + 4 * hh + i]);
            const int npair = qblk + 1;
            const bf16* kp = XKP + (size_t)(b * SEQ + r) * 64 + 8 * hh;
            bf16x8 bc[2][4], bn[2][4];
#pragma unroll
            for (int t2 = 0; t2 < 2; ++t2)
#pragma unroll
                for (int ks = 0; ks < 4; ++ks) bc[t2][ks] = *(const GAS bf16x8*)(kp + t2 * 2048 + ks * 16);
            for (int pr = 0; pr < npair; ++pr) {
                const bf16* kn = kp + (size_t)((pr + 1 < npair) ? pr + 1 : pr) * 4096;
#pragma unroll
                for (int t2 = 0; t2 < 2; ++t2)
#pragma unroll
                    for (int ks = 0; ks < 4; ++ks) bn[t2][ks] = *(const GAS bf16x8*)(kn + t2 * 2048 + ks * 16);
#pragma unroll
                for (int t2 = 0; t2 < 2; ++t2) {
                    const int key = pr * 64 + t2 * 32 + r;
#pragma unroll
                    for (int g = 0; g < 2; ++g) {
                        f32x16 acc = {};
#pragma unroll
                        for (int ks = 0; ks < 4; ++ks) acc = __builtin_amdgcn_mfma_f32_32x32x16_bf16(af[g][ks], bc[t2][ks], acc, 0, 0, 0);
                        float tot[4];
#pragma unroll
                        for (int q = 0; q < 4; ++q) { float pp = 0.f;
#pragma unroll
                            for (int i = 0; i < 4; ++i) pp += wv[g][q][i] * fmaxf(acc[4 * q + i], 0.f);
                            tot[q] = pp + shx(pp, lane, 32); }
                        const float o0 = hh ? tot[2] : tot[0], o1 = hh ? tot[3] : tot[1];
                        SC[(size_t)(tok0 + 4 * g + 2 * hh) * SEQ + key] = o0; SC[(size_t)(tok0 + 4 * g + 2 * hh + 1) * SEQ + key] = o1;
                    }
                }
#pragma unroll
                for (int t2 = 0; t2 < 2; ++t2)
#pragma unroll
                    for (int ks = 0; ks < 4; ++ks) bc[t2][ks] = bn[t2][ks];
            }
            asm volatile("s_waitcnt vmcnt(0)" ::: "memory"); __builtin_amdgcn_fence(__ATOMIC_ACQUIRE, "agent"); asm volatile("s_waitcnt vmcnt(0)" ::: "memory");
            { f32x4 rawc[8], rawn[8]; select_load(SC, tok0, lane, rawc);
#pragma unroll 1
              for (int q = 0; q < 8; ++q) { if (q + 1 < 8) select_load(SC, tok0 + q + 1, lane, rawn);
                  select_row(rawc, MASK, tok0 + q, lane);
#pragma unroll
                  for (int j = 0; j < 8; ++j) rawc[j] = rawn[j]; } }
        }
    }
}
constexpr size_t WS_OD = WS_END;
constexpr size_t WS_END2 = WS_END + 64 * MiB;
__device__ __forceinline__ void ph_diff_attn(LAS unsigned char* lds, int wvx) {
    CArgs* A = kargs();
    const int G = gsz_(), bx = bid_(), vcu = (G % 8 == 0) ? (bx % 8) * (G / 8) + bx / 8 : bx;
    const bf16* H = WS(bf16, WS_H); bf16* OD = WS(bf16, WS_OD);
    for (int item = vcu; item < NB * 16; item += G) {
        const int b = item >> 4, vh = item & 15, g = vh >> 1, half = vh & 1;
#pragma unroll 1
        for (int qb = 7; qb >= 0; --qb)
            attn_body::attn_unit<8, false>(wvx, b, qb, H + HC_DQ + g * 64, H + HC_DK + g * 64, H + HC_DV + (g >> 1) * 128 + half * 64, OD + g * 128 + half * 64, nullptr, (char*)lds);
    }
}
__device__ __forceinline__ void ph_diff_post(int l, int wvx) {
    TIDX;
    const bf16* OD = WS(bf16, WS_OD); bf16* MIX = WS(bf16, WS_MIX);
    const float lam = WS(float, WS_LAM)[l], sc1m = 1.0f - (0.8f - 0.6f * __expf(-0.3f * (float)l));
    const int h = lane >> 4, c0 = (lane & 15) * 8;
    float gv[8];
    { const float* g = A->in[I_DFNORM] + l * 512 + h * 128 + c0;
#pragma unroll
      for (int e = 0; e < 8; ++e) gv[e] = g[e] * sc1m; }
    us8 n1 = {}, n2 = {};
    if (gw < T) { n1 = *(const GAS us8*)(OD + (size_t)gw * D + (2 * h) * 128 + c0); n2 = *(const GAS us8*)(OD + (size_t)gw * D + (2 * h + 1) * 128 + c0); }
    for (int tok = gw; tok < T; tok += ngw) {
        const us8 a1 = n1, a2 = n2;
        if (tok + ngw < T) { n1 = *(const GAS us8*)(OD + (size_t)(tok + ngw) * D + (2 * h) * 128 + c0); n2 = *(const GAS us8*)(OD + (size_t)(tok + ngw) * D + (2 * h + 1) * 128 + c0); }
        float d[8], ss = 0.f;
#pragma unroll
        for (int e = 0; e < 8; ++e) { d[e] = bf2f(a1[e]) - lam * bf2f(a2[e]); ss += d[e] * d[e]; }
        ss += DPPF(ss, 0xB1); ss += DPPF(ss, 0x4E); ss += DPPF(ss, 0x141); ss += DPPF(ss, 0x140);
        const float rs = 1.0f / sqrtf(ss * (1.0f / 128.0f) + LN_EPS);
        v4u o; o.x = pk2(d[0] * rs * gv[0], d[1] * rs * gv[1]); o.y = pk2(d[2] * rs * gv[2], d[3] * rs * gv[3]); o.z = pk2(d[4] * rs * gv[4], d[5] * rs * gv[5]); o.w = pk2(d[6] * rs * gv[6], d[7] * rs * gv[7]);
        *(GAS v4u*)(MIX + (size_t)tok * D + 256 + h * 128 + c0) = o;
    }
}
__device__ __forceinline__ void ph_dsa_attn(LAS unsigned char* lds, int wvx) {
    CArgs* A = kargs();
    const int G = gsz_(), bx = bid_(), vcu = (G % 8 == 0) ? (bx % 8) * (G / 8) + bx / 8 : bx;
    const bf16* H = WS(bf16, WS_H); bf16* MIX = WS(bf16, WS_MIX); const unsigned* MASK = WS(unsigned, WS_MASK);
    for (int item = vcu; item < NB * 4 * 4; item += G) {
        const int bh = item >> 2, p = item & 3, b = bh >> 2, h = bh & 3;
        attn_body::attn_unit<8, true>(wvx, b, 7 - p, H + HC_SQ + h * 64, H + HC_SK + h * 64, H + HC_SV + h * 64, MIX + 768 + h * 64, MASK, (char*)lds);
        attn_body::attn_unit<8, true>(wvx, b, p, H + HC_SQ + h * 64, H + HC_SK + h * 64, H + HC_SV + h * 64, MIX + 768 + h * 64, MASK, (char*)lds);
    }
}
constexpr size_t WS_DC = WS_END2;
constexpr size_t WS_CST = WS_DC + 32 * MiB;
constexpr size_t WS_DN = WS_CST + 32 * MiB;
constexpr size_t WS_END3 = WS_DN + 4 * MiB;
constexpr size_t WS_DUMMY = WS_END3;
constexpr size_t WS_END4 = WS_DUMMY + 256 * MiB;
static_assert(WS_END4 <= WS_U8, "d_ws map");
typedef float f32x2_ __attribute__((ext_vector_type(2)));
constexpr int MP = 68;
__device__ __forceinline__ float log_sigmoid_(float x) { return fminf(x, 0.f) - log1pf(__expf(-fabsf(x))); }
__device__ __forceinline__ void mlstm_gates(bf16 iraw, bf16 fraw, float gbi, float gbf, int lane, LAS float* bcum, LAS float* av) {
    const float ip = bf2f(iraw) + gbi; float lf = log_sigmoid_(bf2f(fraw) + gbf);
#pragma unroll
    for (int o = 1; o < 64; o <<= 1) { const float t_ = shup(lf, lane, o); if (lane >= o) lf += t_; }
    bcum[lane] = lf; av[lane] = ip - lf;
}
constexpr int PB = 72;

__device__ __forceinline__ f32x16 mfma_tile(const LAS bf16* Xa, int mt, const LAS bf16* Xb, int nt, int r, int hh, f32x16 acc) {
#pragma unroll
    for (int ks = 0; ks < 4; ++ks) { const bf16x8 a = *(const LAS bf16x8*)(Xa + (32 * mt + r) * PB + 16 * ks + 8 * hh), b = *(const LAS bf16x8*)(Xb + (32 * nt + r) * PB + 16 * ks + 8 * hh);
        acc = __builtin_amdgcn_mfma_f32_32x32x16_bf16(a, b, acc, 0, 0, 0); }
    return acc;
}
__device__ __forceinline__ void ph_mlstm_m1(LAS unsigned char* lds, int l, int wvx) {
    TIDX;
    const bf16* H = WS(bf16, WS_H); const bf16* QKC = WS(bf16, WS_QKC);
    float* DC = WS(float, WS_DC); float* DN = WS(float, WS_DN); float* SCAL = WS(float, WS_DN + 2 * MiB);
    LAS bf16* kT = (LAS bf16*)lds; LAS bf16* vwT = kT + 64 * PB;
    LAS float* bcum = (LAS float*)(vwT + 96 * PB); LAS float* av = bcum + 64; LAS float* wv = av + 64;
    const int r = lane & 31, hh = lane >> 5, srow = tid >> 3, ch = tid & 7;
    us8 nk = {}, nv_ = {}; bf16 nig = 0, nfg = 0;
#define M1_LOAD(uu) do { const int bh_ = (uu) >> 5, c_ = (uu) & 31, t0_ = (bh_ >> 2) * SEQ + c_ * 64, h_ = bh_ & 3; \
        nk = *(const GAS us8*)(QKC + (size_t)(t0_ + srow) * 512 + 256 + h_ * 64 + 8 * ch); nv_ = *(const GAS us8*)(H + (size_t)(t0_ + srow) * NHC + HC_MV + h_ * 64 + 8 * ch); \
        if (wave == 0) { nig = H[(size_t)(t0_ + lane) * NHC + HC_MI + h_]; nfg = H[(size_t)(t0_ + lane) * NHC + HC_MF + h_]; } } while (0)
    M1_LOAD(bidx);
    for (int u = bidx; u < NB * 4 * 32; u += gsz) {
        const int bh = u >> 5, c = u & 31, b = bh >> 2, h = bh & 3, tok0 = b * SEQ + c * 64; (void)tok0;
        const us8 kraw = nk, vraw = nv_; const bf16 igr = nig, fgr = nfg;
        if (u + gsz < NB * 4 * 32) M1_LOAD(u + gsz);
        if (wave == 0) { mlstm_gates(igr, fgr, A->in[I_GATEB][l * 8 + h], A->in[I_GATEB][l * 8 + 4 + h], lane, bcum, av); }
        __syncthreads();
        if (wave == 0) { const float a = av[lane], amax = wave_max(a); wv[lane] = __expf(a - amax); if (lane == 0) { SCAL[u * 4 + 0] = bcum[63]; SCAL[u * 4 + 1] = bcum[63] + amax; } }
        __syncthreads();
        { const float w = wv[srow];
#pragma unroll
          for (int e = 0; e < 8; ++e) { kT[(8 * ch + e) * PB + srow] = kraw[e]; vwT[(8 * ch + e) * PB + srow] = (bf16)f2bf(w * bf2f(vraw[e])); }
          if (tid < 64) vwT[64 * PB + tid] = (bf16)f2bf(wv[tid]);
          for (int i = tid; i < 31 * 64; i += 512) vwT[(65 + i / 64) * PB + (i & 63)] = 0; }
        __syncthreads();
        if (wave < 6) { const int mt = wave >> 1, nt = wave & 1;
            f32x16 acc = {}; acc = mfma_tile(vwT, mt, kT, nt, r, hh, acc);
#pragma unroll
            for (int g = 0; g < 16; ++g) { const int vrow = 32 * mt + (g & 3) + 8 * (g >> 2) + 4 * hh, d = 32 * nt + r;
                if (vrow < 64) DC[(size_t)u * 4096 + vrow * 64 + d] = acc[g]; else if (vrow == 64) DN[(size_t)u * 64 + d] = acc[g]; } }
        __syncthreads();
    }
#undef M1_LOAD
}
__device__ __forceinline__ void ph_mlstm_m2(int wvx) {
    TIDX;
    const float* DC = WS(float, WS_DC); float* CS = WS(float, WS_CST); const float* DN = WS(float, WS_DN); float* NS = WS(float, WS_DN + 1 * MiB); float* SCAL = WS(float, WS_DN + 2 * MiB);
    for (int item = bidx; item < NB * 4 * 4; item += gsz) {
        const int bh = item >> 2, qtr = item & 3, e0 = qtr * 1024 + tid * 2;
        f32x2_ dc[32]; float dn[32];
#pragma unroll
        for (int c = 0; c < 32; ++c) { dc[c] = *(const GAS f32x2_*)(DC + (size_t)(bh * 32 + c) * 4096 + e0); dn[c] = (qtr == 0 && tid < 64) ? DN[(size_t)(bh * 32 + c) * 64 + tid] : 0.f; }
        float z_ = 0.f; asm volatile("" : "+v"(z_));
        float m = 0.f; f32x2_ C = (f32x2_){z_, z_}; float n = z_;
#pragma unroll
        for (int c = 0; c < 32; ++c) {
            const int u = bh * 32 + c;
            const float bl = SCAL[u * 4 + 0], ml = SCAL[u * 4 + 1];
            *(GAS f32x2_*)(CS + (size_t)u * 4096 + e0) = C;
            if (qtr == 0 && tid < 64) NS[(size_t)u * 64 + tid] = n;
            if (qtr == 0 && tid == 0) SCAL[u * 4 + 2] = m;
            const float mn = fmaxf(bl + m, ml), f1 = __expf(bl + m - mn), f2 = __expf(ml - mn);
            C.x = f1 * C.x + f2 * dc[c].x; C.y = f1 * C.y + f2 * dc[c].y;
            n = f1 * n + f2 * dn[c];
            m = mn;
        }
    }
}
__device__ __forceinline__ void ph_mlstm_m3(LAS unsigned char* lds, int l, int wvx) {
    TIDX;
    const bf16* H = WS(bf16, WS_H); const bf16* QKC = WS(bf16, WS_QKC); bf16* MIX = WS(bf16, WS_MIX);
    const float* CS = WS(float, WS_CST); const float* NS = WS(float, WS_DN + 1 * MiB); const float* SCAL = WS(float, WS_DN + 2 * MiB);
    LAS bf16* qS = (LAS bf16*)lds; LAS bf16* kS = qS + 64 * PB; LAS bf16* vT = kS + 64 * PB; LAS bf16* cT = vT + 96 * PB; LAS bf16* Sb = cT + 96 * PB;
    LAS float* hS = (LAS float*)(Sb + 64 * PB);
    LAS float* bcum = hS + 64 * MP; LAS float* av = bcum + 64; LAS float* mm = av + 64; LAS float* inter = mm + 64; LAS float* dinv = inter + 64;
    const int r = lane & 31, hh = lane >> 5, srow = tid >> 3, ch = tid & 7;
    us8 nq = {}, nk = {}, nv_ = {}; f32x4 nc0 = {}, nc1 = {}; bf16 nog[8] = {}; bf16 nig = 0, nfg = 0; float nns = 0.f, nmc = 0.f;
#define M3_LOAD(uu) do { const int bh_ = (uu) >> 5, c_ = (uu) & 31, t0_ = (bh_ >> 2) * SEQ + c_ * 64, h_ = bh_ & 3; \
        nq = *(const GAS us8*)(QKC + (size_t)(t0_ + srow) * 512 + h_ * 64 + 8 * ch); nk = *(const GAS us8*)(QKC + (size_t)(t0_ + srow) * 512 + 256 + h_ * 64 + 8 * ch); \
        nv_ = *(const GAS us8*)(H + (size_t)(t0_ + srow) * NHC + HC_MV + h_ * 64 + 8 * ch); \
        nc0 = *(const GAS f32x4*)(CS + (size_t)(uu) * 4096 + srow * 64 + 8 * ch); nc1 = *(const GAS f32x4*)(CS + (size_t)(uu) * 4096 + srow * 64 + 8 * ch + 4); \
        _Pragma("unroll") for (int j = 0; j < 8; ++j) nog[j] = H[(size_t)(t0_ + wave + 8 * j) * NHC + HC_MO + h_ * 64 + lane]; \
        nmc = SCAL[(uu) * 4 + 2]; if (tid < 64) nns = NS[(size_t)(uu) * 64 + tid]; \
        if (wave == 0) { nig = H[(size_t)(t0_ + lane) * NHC + HC_MI + h_]; nfg = H[(size_t)(t0_ + lane) * NHC + HC_MF + h_]; } } while (0)
    M3_LOAD(bidx);
    for (int u = bidx; u < NB * 4 * 32; u += gsz) {
        const int bh = u >> 5, c = u & 31, b = bh >> 2, h = bh & 3, tok0 = b * SEQ + c * 64;
        const float mc = nmc, nsv = nns;
        bf16 ograw[8];
#pragma unroll
        for (int j = 0; j < 8; ++j) ograw[j] = nog[j];
        const float gnorm = A->in[I_MNORM][l * 256 + h * 64 + lane];
        const us8 qraw = nq, kraw = nk, vraw = nv_; const f32x4 c0 = nc0, c1 = nc1; const bf16 igr = nig, fgr = nfg;
        if (u + gsz < NB * 4 * 32) M3_LOAD(u + gsz);
        {
            us8 qs;
#pragma unroll
            for (int e = 0; e < 8; ++e) qs[e] = (bf16)f2bf(bf2f(qraw[e]) * 0.125f);
            *(LAS us8*)(qS + srow * PB + 8 * ch) = qs; *(LAS us8*)(kS + srow * PB + 8 * ch) = kraw;
#pragma unroll
            for (int e = 0; e < 8; ++e) vT[(8 * ch + e) * PB + srow] = vraw[e];
            v4u cp; cp.x = pk2(c0[0], c0[1]); cp.y = pk2(c0[2], c0[3]); cp.z = pk2(c1[0], c1[1]); cp.w = pk2(c1[2], c1[3]);
            *(LAS v4u*)(cT + srow * PB + 8 * ch) = cp;
            if (tid < 64) { vT[64 * PB + tid] = (bf16)0x3f80; cT[64 * PB + tid] = (bf16)f2bf(nsv); }
            for (int i = tid; i < 31 * 64; i += 512) { vT[(65 + i / 64) * PB + (i & 63)] = 0; cT[(65 + i / 64) * PB + (i & 63)] = 0; }
        }
        if (wave == 0) { mlstm_gates(igr, fgr, A->in[I_GATEB][l * 8 + h], A->in[I_GATEB][l * 8 + 4 + h], lane, bcum, av); }
        __syncthreads();
        if (wave == 0) { float pm = av[lane];
#pragma unroll
            for (int o = 1; o < 64; o <<= 1) { const float t_ = shup(pm, lane, o); if (lane >= o) pm = fmaxf(pm, t_); }
            const float m_ = fmaxf(mc, pm); mm[lane] = m_; inter[lane] = __expf(mc - m_); }
        __syncthreads();
        if (wave < 4) { const int tt = wave >> 1, st = wave & 1;
            f32x16 acc = {}; acc = mfma_tile(qS, tt, kS, st, r, hh, acc);
            const int s = 32 * st + r; const float as = av[s];
#pragma unroll
            for (int g = 0; g < 16; ++g) { const int t = 32 * tt + (g & 3) + 8 * (g >> 2) + 4 * hh;
                const float val = (s <= t) ? acc[g] * __expf(as - mm[t]) : 0.f; Sb[t * PB + s] = (bf16)f2bf(val); } }
        __syncthreads();
        f32x16 aS = {}, aC = {}; const int tt = (wave < 6) ? wave / 3 : 0, nt = (wave < 6) ? wave % 3 : 0;
        if (wave < 6) { aS = mfma_tile(Sb, tt, vT, nt, r, hh, aS); aC = mfma_tile(qS, tt, cT, nt, r, hh, aC); }
        if (wave < 6 && nt == 2 && r == 0) {
#pragma unroll
            for (int g = 0; g < 16; ++g) { const int t = 32 * tt + (g & 3) + 8 * (g >> 2) + 4 * hh;
                const float dn = aS[g] + inter[t] * aC[g]; dinv[t] = 1.0f / fmaxf(fabsf(dn), __expf(-(bcum[t] + mm[t]))); } }
        __syncthreads();
        if (wave < 6 && nt < 2) {
#pragma unroll
            for (int g = 0; g < 16; ++g) { const int t = 32 * tt + (g & 3) + 8 * (g >> 2) + 4 * hh;
                hS[t * MP + 32 * nt + r] = (aS[g] + inter[t] * aC[g]) * dinv[t]; } }
        __syncthreads();
#pragma unroll
        for (int j = 0; j < 8; ++j) { const int t = wave + 8 * j, vc = lane; const size_t tk = (size_t)(tok0 + t);
            const float hv = hS[t * MP + vc];
            const float mean = wave_sum(hv) * (1.0f / 64.0f), hc = hv - mean;
            const float rs = 1.0f / sqrtf(wave_sum(hc * hc) * (1.0f / 64.0f) + LN_EPS);
            const float og = sigmoidf_(bf2f(ograw[j]));
            MIX[tk * D + h * 64 + vc] = (bf16)f2bf(og * (hc * rs * gnorm)); }
        __syncthreads();
    }
#undef M3_LOAD
}
__device__ __forceinline__ int wave_sum_i(int x) {
    x += __builtin_amdgcn_update_dpp(0, x, 0xB1, 0xF, 0xF, true);
    x += __builtin_amdgcn_update_dpp(0, x, 0x4E, 0xF, 0xF, true);
    x += __builtin_amdgcn_update_dpp(0, x, 0x141, 0xF, 0xF, true);
    x += __builtin_amdgcn_update_dpp(0, x, 0x140, 0xF, 0xF, true);
    return __builtin_amdgcn_readlane(x, 0) + __builtin_amdgcn_readlane(x, 16) + __builtin_amdgcn_readlane(x, 32) + __builtin_amdgcn_readlane(x, 48);
}
__device__ __forceinline__ void select_load(const float* SC, int tok, int lane, f32x4 (&raw)[8]) {
    const int tl = tok % SEQ, lo = 32 * lane; const bool need = (tl >= 256) && (tl + 1 - lo > 0);
#pragma unroll
    for (int j = 0; j < 8; ++j) { raw[j] = (f32x4){0.f, 0.f, 0.f, 0.f}; if (need) raw[j] = *(const GAS f32x4*)(SC + (size_t)tok * SEQ + lo + 4 * j); }
}
__device__ __forceinline__ void select_row(const f32x4 (&raw)[8], unsigned* MASK, int tok, int lane) {
        const int tl = tok % SEQ, lo = 32 * lane;
        const int nv = min(max(tl + 1 - lo, 0), 32);
        unsigned cand = (nv >= 32) ? 0xffffffffu : ((1u << nv) - 1u);
        if (tl < 256) { MASK[(size_t)tok * 64 + lane] = cand; return; }
        unsigned a[32];
#pragma unroll
        for (int j = 0; j < 8; ++j) {
            const f32x4 v = raw[j];
#pragma unroll
            for (int c = 0; c < 4; ++c) { unsigned u = __float_as_uint(v[c]); u = (u == 0x80000000u) ? 0u : u; a[4 * j + c] = (u >> 31) ? ~u : (u | 0x80000000u); }
        }
#define TSTAGE(J, M) _Pragma("unroll") for (int k0 = 0; k0 < 32; ++k0) { if ((k0 & J) == 0) { const unsigned t_ = ((a[k0] >> J) ^ a[k0 + J]) & M; a[k0] ^= t_ << J; a[k0 + J] ^= t_; } }
        TSTAGE(16, 0x0000FFFFu) TSTAGE(8, 0x00FF00FFu) TSTAGE(4, 0x0F0F0F0Fu) TSTAGE(2, 0x33333333u) TSTAGE(1, 0x55555555u)
#undef TSTAGE
        unsigned sel = 0u; int need = 256, ncand = tl + 1;
#pragma unroll
        for (int b = 31; b >= 0; --b) {
            if (ncand != need) {
                const unsigned hit = cand & a[b];
                const int cnt = wave_sum_i(__popc(hit));
                if (cnt >= need) { cand = hit; ncand = cnt; }
                else { sel |= hit; cand &= ~a[b]; need -= cnt; ncand -= cnt; }
            }
        }
        if (ncand == need) sel |= cand;
        else {
            const int my = __popc(cand); int incl = my;
#pragma unroll
            for (int o = 1; o < 64; o <<= 1) { const int t_ = shupi(incl, lane, o); if (lane >= o) incl += t_; }
            const int take = min(max(need - (incl - my), 0), my); int taken = 0;
#pragma unroll 1
            for (int k = 0; k < 32; ++k) { if (((cand >> k) & 1u) && taken < take) { sel |= 1u << k; ++taken; } }
        }
        MASK[(size_t)tok * 64 + lane] = sel;
}
__device__ __forceinline__ f32x4 bf4_(unsigned long long r) { f32x4 y; y.x = __uint_as_float((unsigned)r << 16); y.y = __uint_as_float((unsigned)r & 0xffff0000u); y.z = __uint_as_float((unsigned)(r >> 32) << 16); y.w = __uint_as_float((unsigned)(r >> 32) & 0xffff0000u); return y; }
__device__ __forceinline__ unsigned long long pk4_(f32x4 v) { return (unsigned long long)pk2(v.x, v.y) | ((unsigned long long)pk2(v.z, v.w) << 32); }
constexpr int R1_OFF = RING_BYTES + 8192;
__device__ __forceinline__ void ph_row1(LAS unsigned char* lds, int l, int wvx, bool dry = false) {
    TIDX;
    const float* xin = (l == 0) ? A->in[I_X] : WS(float, WS_XB); float* XB = dry ? WS(float, WS_DUMMY) : WS(float, WS_XB);
    const bf16* Y = WS(bf16, WS_Y); bf16* U = dry ? WS(bf16, WS_DUMMY + 128 * MiB) : (bf16*)WS(unsigned char, WS_U8);
    unsigned* cnt = dry ? WS(unsigned, WS_DUMMY + 200 * MiB) : WS(unsigned, WS_CTL) + CW_CNT + l * NEXP * 64; unsigned* TOK = dry ? WS(unsigned, WS_DUMMY + 192 * MiB) : WS(unsigned, WS_TOK);
    const float* lg = A->in[I_LN1G] + l * D; const float* lb = A->in[I_LN1B] + l * D;
    unsigned* RMAP = dry ? WS(unsigned, WS_DUMMY + 208 * MiB) : WS(unsigned, WS_XG);
    LAS float* rw = (LAS float*)lds; LAS unsigned* lcnt = (LAS unsigned*)(lds + R1_OFF); LAS unsigned* lbase = lcnt + 32; LAS unsigned* nrec = lbase + 32; LAS unsigned* rec = nrec + 4;
    { const GAS f32x4* src = (const GAS f32x4*)(WS(float, WS_RWT) + (size_t)l * NEXP * D);
      for (int i = tid; i < NEXP * D / 4; i += 512) ((LAS f32x4*)rw)[i] = src[i];
      if (tid < 32) lcnt[tid] = 0u; if (tid == 32) nrec[0] = 0u; }
    __syncthreads();
    const float rbias = A->in[I_RB][l * NEXP + (lane >> 1)];
    f32x4 px[4], pg[4]; unsigned long long py[4];
#define R1_LOAD(tk) do { const float* mod_ = WS(float, WS_MOD) + ((size_t)l * NB + (tk) / SEQ) * 6144; _Pragma("unroll") for (int j = 0; j < 4; ++j) { const int c = 4 * lane + 256 * j; \
        px[j] = *(const GAS f32x4*)(xin + (size_t)(tk) * D + c); pg[j] = *(const GAS f32x4*)(mod_ + 2048 + c); py[j] = *(const GAS unsigned long long*)(Y + (size_t)(tk) * D + c); } } while (0)
    if (gw < T) R1_LOAD(gw);
    for (int tok = gw; tok < T; tok += ngw) {
        const int b = tok / SEQ; const float* mod = WS(float, WS_MOD) + ((size_t)l * NB + b) * 6144;
        f32x4 v[4]; float s = 0.f;
#pragma unroll
        for (int j = 0; j < 4; ++j) {
            const f32x4 x = px[j]; const f32x4 g1 = pg[j];
            const unsigned long long yr = py[j];
            f32x4 y; y.x = __uint_as_float((unsigned)yr << 16); y.y = __uint_as_float((unsigned)yr & 0xffff0000u); y.z = __uint_as_float((unsigned)(yr >> 32) << 16); y.w = __uint_as_float((unsigned)(yr >> 32) & 0xffff0000u);
            v[j] = x * DN_ALPHA + (1.0f + g1) * y; s += (v[j].x + v[j].y) + (v[j].z + v[j].w); }
        if (tok + ngw < T) R1_LOAD(tok + ngw);
        const float mean = wave_sum(s) * (1.0f / D); float s2 = 0.f;
#pragma unroll
        for (int j = 0; j < 4; ++j) { v[j] = v[j] - mean; s2 += (v[j].x * v[j].x + v[j].y * v[j].y) + (v[j].z * v[j].z + v[j].w * v[j].w); }
        const float rstd = 1.0f / sqrtf(wave_sum(s2) * (1.0f / D) + LN_EPS);
        f32x4 u2[4];
#pragma unroll
        for (int j = 0; j < 4; ++j) { const int c = 4 * lane + 256 * j;
            const f32x4 xn = v[j] * rstd * *(const f32x4*)(lg + c) + *(const f32x4*)(lb + c);
            *(GAS f32x4*)(XB + (size_t)tok * D + c) = xn;
            u2[j] = xn * (1.0f + *(const f32x4*)(mod + 4096 + c)) + *(const f32x4*)(mod + 3072 + c);
            *(GAS unsigned*)((unsigned char*)U + (size_t)tok * D + c) = pg8::pk4_fp8(u2[j].x, u2[j].y, u2[j].z, u2[j].w, 16.0f); }
        float part[32];
#pragma unroll
        for (int e = 0; e < 32; ++e) { float a = 0.f;
#pragma unroll
            for (int j = 0; j < 4; ++j) { const f32x4 w = *(const LAS f32x4*)(rw + e * D + 4 * lane + 256 * j); a += (u2[j].x * w.x + u2[j].y * w.y) + (u2[j].z * w.z + u2[j].w * w.w); }
            part[e] = a; }
#define RSTEP(N, OFF) _Pragma("unroll") for (int e = 0; e < N; ++e) { const bool hi = (lane & OFF) != 0; const float send = hi ? part[e] : part[e + N]; const float recv = shx(send, lane, OFF); part[e] = (hi ? part[e + N] : part[e]) + recv; }
        RSTEP(16, 32) RSTEP(8, 16) RSTEP(4, 8) RSTEP(2, 4) RSTEP(1, 2)
#undef RSTEP
        float logit = part[0] + shx(part[0], lane, 1) + rbias;
        const int myexp = lane >> 1;
        int rank = 0;
#pragma unroll
        for (int j = 0; j < 32; ++j) { const float lj = __int_as_float(__builtin_amdgcn_readlane(__float_as_int(logit), 2 * j)); rank += (lj > logit || (lj == logit && j < myexp)) ? 1 : 0; }
        float tv[4]; int te[4];
#pragma unroll
        for (int k = 0; k < 4; ++k) { const unsigned long long bm = __ballot(rank == k); const int ln = (int)__builtin_ctzll(bm); te[k] = ln >> 1; tv[k] = __int_as_float(__builtin_amdgcn_readlane(__float_as_int(logit), ln)); }
        const float e1 = __expf(tv[1] - tv[0]), e2 = __expf(tv[2] - tv[0]), e3 = __expf(tv[3] - tv[0]); const float inv = 1.0f / (1.0f + e1 + e2 + e3);
        if (lane < 4) { const int ek = lane == 0 ? te[0] : lane == 1 ? te[1] : lane == 2 ? te[2] : te[3]; const float pk = (lane == 0 ? 1.0f : lane == 1 ? e1 : lane == 2 ? e2 : e3) * inv;
            const unsigned lp = __hip_atomic_fetch_add(lcnt + ek, 1u, __ATOMIC_RELAXED, __HIP_MEMORY_SCOPE_WORKGROUP);
            const unsigned ri = __hip_atomic_fetch_add(nrec, 1u, __ATOMIC_RELAXED, __HIP_MEMORY_SCOPE_WORKGROUP);
            if (ri < 640u) { LAS unsigned* r = rec + ri * 3; r[0] = (unsigned)tok * 4u + (unsigned)lane; r[1] = (unsigned)ek | (lp << 8); r[2] = __float_as_uint(pk); } }
    }
#undef R1_LOAD
    __syncthreads();
    if (tid < 32) lbase[tid] = __hip_atomic_fetch_add(cnt + tid * 64, lcnt[tid], __ATOMIC_RELAXED, __HIP_MEMORY_SCOPE_AGENT);
    __syncthreads();
    { const int n = (int)min(nrec[0], 640u);
      for (int i = tid; i < n; i += 512) { const unsigned r0 = rec[i * 3], r1 = rec[i * 3 + 1], r2 = rec[i * 3 + 2]; const unsigned ek = r1 & 255u;
          const unsigned pos = lbase[ek] + (r1 >> 8);
          *(GAS v4u*)(TOK + (size_t)r0 * 4) = (v4u){ek, pos, r2, 0u}; RMAP[(size_t)ek * T + pos] = r0 >> 2; } }
    __syncthreads();
}
__device__ __forceinline__ int moe_tables(LAS unsigned char* lds, int l, int wvx) {
    CArgs* A = kargs();
    LAS unsigned* base = (LAS unsigned*)(lds + TAB_OFF); LAS unsigned char* tile_e = lds + TAB_OFF + 256; LAS unsigned* cntl = (LAS unsigned*)(lds + TAB_OFF + 1024);
    const unsigned* cnt = WS(unsigned, WS_CTL) + CW_CNT + l * NEXP * 64;
    if (wvx == 0) {
        const int lane = lane_id_(), e = lane & 31;
        const unsigned c = __hip_atomic_load(cnt + e * 64, __ATOMIC_RELAXED, __HIP_MEMORY_SCOPE_AGENT);
        const int nt = (int)((c + 255u) >> 8); int incl = nt;
#pragma unroll
        for (int o = 1; o < 32; o <<= 1) { const int t_ = shupi(incl, lane, o); if (e >= o) incl += t_; }
        if (lane < 32) { const int t0 = incl - nt; base[e] = (unsigned)t0 << 8; cntl[e] = c; if (e == 31) base[NEXP] = (unsigned)incl << 8;
#pragma unroll 1
            for (int t = 0; t < nt; ++t) tile_e[t0 + t] = (unsigned char)e; }
    }
    __syncthreads();
    return (int)(base[NEXP] >> 8);
}
__device__ __forceinline__ void ph_row2(LAS unsigned char* lds, int l, int wvx, bool dry = false) {
    TIDX;
    (void)moe_tables(lds, l, wvx);
    const LAS unsigned* base = (const LAS unsigned*)(lds + TAB_OFF);
    float* XB = WS(float, WS_XB); const bf16* YM = WS(bf16, WS_YM); bf16* U = WS(bf16, WS_U); const unsigned* TOK = WS(unsigned, WS_TOK);
    const float* lg = A->in[I_LN2G] + l * D; const float* lb = A->in[I_LN2B] + l * D; const float* b2 = A->in[I_B2] + (size_t)l * NEXP * D;
    float* dst = dry ? WS(float, WS_DUMMY) : (l == DEPTH - 1) ? A->out : XB; bf16* Uw = dry ? WS(bf16, WS_DUMMY + 128 * MiB) : U;
    v4u rcA[4], rcB[4]; unsigned yq[4][4]; f32x4 xq[4];
#define R2_REC(dst, tk) do { _Pragma("unroll") for (int k = 0; k < 4; ++k) dst[k] = *(const GAS v4u*)(TOK + ((size_t)(tk) * 4 + k) * 4); } while (0)
#define R2_ROWS(rc, tk) do { _Pragma("unroll") for (int k = 0; k < 4; ++k) { const size_t row_ = (size_t)base[rc[k].x] + rc[k].y; _Pragma("unroll") for (int j = 0; j < 4; ++j) yq[k][j] = *(const GAS unsigned*)((const unsigned char*)YM + row_ * D + 4 * lane + 256 * j); } \
        _Pragma("unroll") for (int j = 0; j < 4; ++j) xq[j] = *(const GAS f32x4*)(XB + (size_t)(tk) * D + 4 * lane + 256 * j); } while (0)
    if (gw < T) { R2_REC(rcA, gw); R2_ROWS(rcA, gw); }
    if (gw + ngw < T) R2_REC(rcB, gw + ngw);
    for (int tok = gw; tok < T; tok += ngw) {
        const int b = tok / SEQ; const float* mod = WS(float, WS_MOD) + ((size_t)l * NB + b) * 6144;
        f32x4 acc[4];
#pragma unroll
        for (int j = 0; j < 4; ++j) acc[j] = (f32x4){0.f, 0.f, 0.f, 0.f};
#pragma unroll
        for (int k = 0; k < 4; ++k) { const float p = __uint_as_float(rcA[k].z);
#pragma unroll
            for (int j = 0; j < 4; ++j) { const int c = 4 * lane + 256 * j; const unsigned yr = yq[k][j];
                typedef float f32x2v_ __attribute__((ext_vector_type(2))); const f32x2v_ ylo = __builtin_amdgcn_cvt_pk_f32_fp8(yr, false), yhi = __builtin_amdgcn_cvt_pk_f32_fp8(yr, true);
                const f32x4 y = (f32x4){ylo.x, ylo.y, yhi.x, yhi.y} * (1.0f / 64.0f);
                acc[j] = acc[j] + p * (y + *(const f32x4*)(b2 + (size_t)rcA[k].x * D + c)); } }
        f32x4 xc[4];
#pragma unroll
        for (int j = 0; j < 4; ++j) xc[j] = xq[j];
#pragma unroll
        for (int k = 0; k < 4; ++k) rcA[k] = rcB[k];
        if (tok + ngw < T) R2_ROWS(rcA, tok + ngw);
        if (tok + 2 * ngw < T) R2_REC(rcB, tok + 2 * ngw);
        f32x4 v[4]; float s = 0.f;
#pragma unroll
        for (int j = 0; j < 4; ++j) { const int c = 4 * lane + 256 * j; const f32x4 x = xc[j];
            v[j] = x * DN_ALPHA + (1.0f + *(const f32x4*)(mod + 5120 + c)) * acc[j]; s += (v[j].x + v[j].y) + (v[j].z + v[j].w); }
        const float mean = wave_sum(s) * (1.0f / D); float s2 = 0.f;
#pragma unroll
        for (int j = 0; j < 4; ++j) { v[j] = v[j] - mean; s2 += (v[j].x * v[j].x + v[j].y * v[j].y) + (v[j].z * v[j].z + v[j].w * v[j].w); }
        const float rstd = 1.0f / sqrtf(wave_sum(s2) * (1.0f / D) + LN_EPS);
        const float* modn = WS(float, WS_MOD) + ((size_t)(l + 1 < DEPTH ? l + 1 : l) * NB + b) * 6144;
#pragma unroll
        for (int j = 0; j < 4; ++j) { const int c = 4 * lane + 256 * j;
            f32x4 xn = v[j] * rstd * *(const f32x4*)(lg + c) + *(const f32x4*)(lb + c);
#ifdef F8PROBE
            { const unsigned* fl = WS(unsigned, WS_CTL) + 600; if (l == DEPTH - 1) { if (fl[0]) xn = xn * __builtin_nanf(""); else if (fl[1]) xn = xn * 2.0f; } }
#endif
            *(GAS f32x4*)(dst + (size_t)tok * D + c) = xn;
            if (l + 1 < DEPTH) { const f32x4 u = xn * (1.0f + *(const f32x4*)(modn + 1024 + c)) + *(const f32x4*)(modn + c);
                *(GAS unsigned long long*)(Uw + (size_t)tok * D + c) = (unsigned long long)pk2(u.x, u.y) | ((unsigned long long)pk2(u.z, u.w) << 32);
                if (!dry) *(GAS unsigned*)(WS(unsigned char, WS_U8) + (size_t)tok * D + c) = pg8::pk4_fp8(u.x, u.y, u.z, u.w, 16.0f); } }
    }
#undef R2_REC
#undef R2_ROWS
    __syncthreads();
}
typedef int v8i_ __attribute__((ext_vector_type(8)));
__device__ __forceinline__ unsigned f8enc(int v) {
    const int a = v < 0 ? -v : v; const unsigned c = a == 0 ? 0x00u : a == 1 ? 0x38u : a == 2 ? 0x40u : a == 3 ? 0x44u : 0x48u; return c | (v < 0 ? 0x80u : 0u); }
__device__ __forceinline__ int f8_aval(int i, int k) { return ((i * 7 + k * 3) % 9) - 4; }
__device__ __forceinline__ int f8_bval(int k, int j) { return ((k * 5 + j * 11) % 7) - 3; }
__device__ __forceinline__ void f8_probe(unsigned* flags, int wvx) {
    const int lane = tid_of(wvx) & 63, rc = lane & 15, kg = lane >> 4;
    v8i_ av, bv;
#pragma unroll
    for (int w = 0; w < 8; ++w) { unsigned pa = 0u, pb = 0u;
#pragma unroll
        for (int e = 0; e < 4; ++e) { const int k = 32 * kg + 4 * w + e; pa |= f8enc(f8_aval(rc, k)) << (8 * e); pb |= f8enc(f8_bval(k, rc)) << (8 * e); }
        av[w] = (int)pa; bv[w] = (int)pb; }
    f32x4 z = {0.f, 0.f, 0.f, 0.f};
    const f32x4 d1 = __builtin_amdgcn_mfma_scale_f32_16x16x128_f8f6f4(av, bv, z, 0, 0, 0, 0x7f7f7f7f, 0, 0x7f7f7f7f);
    const f32x4 d2 = __builtin_amdgcn_mfma_scale_f32_16x16x128_f8f6f4(av, bv, z, 0, 0, 0, 0x7b7b7b7b, 0, 0x77777777);
    bool bad1 = false, bad2 = false;
#pragma unroll
    for (int g = 0; g < 4; ++g) { const int i = 4 * kg + g, j = rc; int e = 0;
        for (int k = 0; k < 128; ++k) e += f8_aval(i, k) * f8_bval(k, j);
        if (d1[g] != (float)e) bad1 = true; if (d2[g] != (float)e * (1.0f / 4096.0f)) bad2 = true; }
    if (__any(bad1) && lane == 0) flags[0] = 1u;
    if (__any(bad2) && lane == 0) flags[1] = 1u;
}
#ifndef IN_F8_TILES
#define IN_F8_TILES 0x0000u
#endif
constexpr unsigned long long in_map_(unsigned mask, bool want) { unsigned long long m = 0; int n = 0; for (int j = 0; j < 16; ++j) if ((((mask >> j) & 1u) != 0u) == want) { m |= (unsigned long long)j << (4 * n); ++n; } return m; }
constexpr int in_cnt_(unsigned mask, bool want) { int n = 0; for (int j = 0; j < 16; ++j) if ((((mask >> j) & 1u) != 0u) == want) ++n; return n; }
constexpr int IN_NF8 = in_cnt_(IN_F8_TILES, true), IN_NB16 = in_cnt_(IN_F8_TILES, false);
constexpr unsigned long long IN_MAP8 = in_map_(IN_F8_TILES, true), IN_MAP16 = in_map_(IN_F8_TILES, false);
__global__ void __launch_bounds__(NWAVES * 64, 2) mega_fwd(Args A_) {
    extern __shared__ __attribute__((aligned(16))) unsigned char lds_raw[];
    LAS unsigned char* lds = (LAS unsigned char*)lds_raw;
    const int tid = threadIdx.x; const int wv0 = __builtin_amdgcn_readfirstlane(tid >> 6);
    volatile LAS unsigned* MISC = (volatile LAS unsigned*)(lds + MISC_OFF);
    for (int u = tid; u < (LDS_BYTES - TAB_OFF) / 4; u += NWAVES * 64) ((LAS unsigned*)(lds + TAB_OFF))[u] = 0u;
    __syncthreads();
    CArgs* A = kargs(); const bool multi = (A->s_hi - A->s_lo) > 1;
    if (multi) (void)xcd_barrier_post(WS(unsigned, WS_CTL) + CW_BAR + A->li * XCD_BAR_WORDS, MISC + 8);
    const int lo = A->s_lo, hi = A->s_hi;
#ifndef PHMASK
#define PHMASK 0xffffffffu
#endif
#define PHM(b) (((PHMASK) >> (b)) & 1u)
#ifndef RPTMASK
#define RPTMASK 0u
#endif
#define RPT(b) _Pragma("unroll 1") for (int rep_ = 0; rep_ < ((((RPTMASK) >> (b)) & 1u) ? 2 : 1); ++rep_)
#define RUN(s) (lo <= (s) && (s) < hi)
#ifdef BAR2
#define BAR2X(A_) xcd_barrier_fn((unsigned*)(A_->ws + WS_CTL) + CW_BAR + A_->li * XCD_BAR_WORDS, xb_xcc_id(), (volatile LAS unsigned*)(lds_launder(lds) + MISC_OFF) + 8, tid_of(wv0) == 0)
#else
#define BAR2X(A_) do {} while (0)
#endif
#define SEAM(s) do { if ((s) + 1 < hi) { CArgs* A_ = kargs(); xcd_barrier_fn((unsigned*)(A_->ws + WS_CTL) + CW_BAR + A_->li * XCD_BAR_WORDS, xb_xcc_id(), (volatile LAS unsigned*)(lds_launder(lds) + MISC_OFF) + 8, tid_of(wv0) == 0); BAR2X(A_); } } while (0)
#ifdef F8PROBE
    if (RUN(0) && blockIdx.x == 0 && wv0 == 0) { CArgs* A = kargs(); f8_probe(WS(unsigned, WS_CTL) + 600, wv0); }
#endif
    if (RUN(0)) { if (PHM(0)) RPT(0) pro_a(lds_launder(lds), wv0); SEAM(0); }
    if (RUN(1)) { if (PHM(1)) RPT(1) pro_b(wv0); SEAM(1); }
    for (int l = 0; l < DEPTH; ++l) {
        const int sb = 2 + NPH * l;
        if (RUN(sb + PH_IN)) {
            { CArgs* A = kargs();
              pg8::Gemm g{WS(bf16, WS_U), WS(bf16, WS_WIN) + (size_t)l * NHC * D, T, NHC, D}; pg8::SubsetOrder S; S.init(T, IN_NB16, IN_MAP16, gsz_(), bid_());
              pg8::EpiIn E{WS(bf16, WS_H), WS(float, WS_CS), 1.0f};
              if (PHM(2)) RPT(2) pg8::gemm_phase<pg8::EpiIn, pg8::SubsetOrder, true, true>(lds_launder(lds), wv0, g, S, E); }
            if (IN_NF8 > 0) { CArgs* A = kargs();
              pg8::Gemm g{(const bf16*)WS(unsigned char, WS_U8), (const bf16*)(WS(unsigned char, WS_WIN8) + (size_t)l * NHC * D), T, NHC, D / 2}; pg8::SubsetOrder S; S.init(T, IN_NF8, IN_MAP8, gsz_(), bid_());
              pg8::EpiIn E{WS(bf16, WS_H), WS(float, WS_CS), 1.0f / 4096.0f};
              if (PHM(2)) RPT(2) pg8::gemm_phase<pg8::EpiIn, pg8::SubsetOrder, true, true, pg8::DirectA, true>(lds_launder(lds), wv0, g, S, E, pg8::DirectA(), 0, 0); }
            SEAM(sb + PH_IN);
        }
        if (RUN(sb + PH_POST)) { if (PHM(3)) RPT(3) ph_post(l, wv0); SEAM(sb + PH_POST); }
        if (RUN(sb + PH_MIXA)) { if (PHM(4)) RPT(4) ph_idx_scores(wv0); if (PHM(5)) RPT(16) ph_mlstm_m1(lds_launder(lds), l, wv0); if (PHM(6)) RPT(6) ph_diff_attn(lds_launder(lds), wv0); SEAM(sb + PH_MIXA); }
        if (RUN(sb + PH_SEL)) { if (PHM(5)) RPT(17) ph_mlstm_m2(wv0);  SEAM(sb + PH_SEL); }
        if (RUN(sb + PH_DSA)) { if (PHM(5)) RPT(18) ph_mlstm_m3(lds_launder(lds), l, wv0); if (PHM(8)) RPT(8) { ph_diff_post(l, wv0); ph_dsa_attn(lds_launder(lds), wv0); } SEAM(sb + PH_DSA); }
        if (RUN(sb + PH_OUT)) { CArgs* A = kargs();
            pg8::Gemm g{WS(bf16, WS_MIX), WS(bf16, WS_WOUT) + (size_t)l * D * D, T, D, D}; pg8::StaticOrder S; S.init(T, D, gsz_(), bid_());
            pg8::EpiBf16<0> E{WS(bf16, WS_Y), D, nullptr, 0, 0, 1.f};
            if (PHM(9)) RPT(9) pg8::gemm_phase<pg8::EpiBf16<0>, pg8::StaticOrder, true, true>(lds_launder(lds), wv0, g, S, E);
            SEAM(sb + PH_OUT);
        }
        if (RUN(sb + PH_ROW1)) { if (PHM(10)) { if ((RPTMASK >> 10) & 1u) ph_row1(lds_launder(lds), l, wv0, true); ph_row1(lds_launder(lds), l, wv0); } SEAM(sb + PH_ROW1); }
        if (RUN(sb + PH_G1)) { CArgs* A = kargs();
            const int nrt = moe_tables(lds_launder(lds), l, wv0);
            pg8::Gemm g{(const bf16*)WS(unsigned char, WS_U8), (const bf16*)(WS(unsigned char, WS_W1) + (size_t)l * NEXP * 2048 * D), RPAD, NEXP * 2048, D / 2}; pg8::MoeOrder S; S.init(nrt, 8, gsz_(), bid_(), (const LAS unsigned char*)(lds_launder(lds) + TAB_OFF + 256));
            pg8::EpiSwiGLU<true> E{WS(bf16, WS_HM), A->in[I_B1] + (size_t)l * NEXP * 2048, 1.0f / 4096.0f};
            LAS unsigned char* tb = lds_launder(lds) + TAB_OFF;
            pg8::MoeGatherA AM{WS(unsigned, WS_XG), (const LAS unsigned*)tb, (const LAS unsigned*)(tb + 1024), (const LAS unsigned char*)(tb + 256), T};
            if (PHM(12)) RPT(12) pg8::gemm_phase<pg8::EpiSwiGLU<true>, pg8::MoeOrder, true, true, pg8::MoeGatherA, true>(lds_launder(lds), wv0, g, S, E, AM, 0, 0);
            SEAM(sb + PH_G1);
        }
        if (RUN(sb + PH_G2)) { CArgs* A = kargs();
            const int nrt = moe_tables(lds_launder(lds), l, wv0);
            pg8::Gemm g{WS(bf16, WS_HM), (const bf16*)(WS(unsigned char, WS_W2) + (size_t)l * NEXP * D * D), RPAD, NEXP * D, D / 2}; pg8::MoeOrder S; S.init(nrt, 4, gsz_(), bid_(), (const LAS unsigned char*)(lds_launder(lds) + TAB_OFF + 256));
            pg8::EpiMoeOut E{WS(bf16, WS_YM), 1.0f / 2048.0f};
            if (PHM(13)) RPT(13) pg8::gemm_phase<pg8::EpiMoeOut, pg8::MoeOrder, true, true, pg8::DirectA, true>(lds_launder(lds), wv0, g, S, E, pg8::DirectA(), 0, 0);
            SEAM(sb + PH_G2);
        }
        if (RUN(sb + PH_ROW2)) { if (PHM(14)) { if ((RPTMASK >> 14) & 1u) ph_row2(lds_launder(lds), l, wv0, true); ph_row2(lds_launder(lds), l, wv0); } SEAM(sb + PH_ROW2); }
    }
#undef RUN
#undef SEAM
}

#ifndef MK_STEPS_PER_LAUNCH
#define MK_STEPS_PER_LAUNCH 1000
#endif
extern "C" void kernel_launch(void* const* d_in, const int* in_sizes, int n_in, void* d_out, int out_size, void* d_ws, size_t ws_size, hipStream_t stream) {
    static int grid = 0;
    if (grid == 0) {
        if (n_in != 25 || out_size != T * D || ws_size < WS_TOP) { fprintf(stderr, "kernel_launch: unexpected shapes (n_in %d out %d ws %zu)\n", n_in, out_size, ws_size); grid = -1; return; }
        int dev = 0, cus = 0, per_cu = 0;
        if (hipGetDevice(&dev) != hipSuccess || hipDeviceGetAttribute(&cus, hipDeviceAttributeMultiprocessorCount, dev) != hipSuccess) { grid = -1; return; }
        if (hipFuncSetAttribute((const void*)mega_fwd, hipFuncAttributeMaxDynamicSharedMemorySize, LDS_BYTES) != hipSuccess) { fprintf(stderr, "kernel_launch: hipFuncSetAttribute failed\n"); grid = -1; return; }
        if (hipOccupancyMaxActiveBlocksPerMultiprocessor(&per_cu, (const void*)mega_fwd, NWAVES * 64, LDS_BYTES) != hipSuccess || per_cu < 1) { fprintf(stderr, "kernel_launch: occupancy query says %d\n", per_cu); }
        (void)hipGetLastError();
        grid = cus;
    }
    if (grid < 0) return;
    if (hipMemsetAsync((char*)d_ws + WS_CTL, 0, CTL_ZERO_BYTES, stream) != hipSuccess) return;
    Args a{};
    for (int i = 0; i < 25; ++i) a.in[i] = (const float*)d_in[i];
    a.out = (float*)d_out; a.ws = (unsigned char*)d_ws;
    int li = 0;
    for (int s = 0; s < NSTEPS; s += MK_STEPS_PER_LAUNCH, ++li) {
        a.s_lo = s; a.s_hi = (s + MK_STEPS_PER_LAUNCH < NSTEPS) ? s + MK_STEPS_PER_LAUNCH : NSTEPS; a.li = li; a.pad = 0;
        hipLaunchKernelGGL(mega_fwd, dim3(grid), dim3(NWAVES * 64), LDS_BYTES, stream, a);
    }
}
```

```cpp
#include <hip/hip_runtime.h>
#include <cstdio>
#include <cstdint>

__device__ __forceinline__ int lane_id_() { int l_; asm volatile("v_mbcnt_lo_u32_b32 %0, -1, 0\n\tv_mbcnt_hi_u32_b32 %0, -1, %0" : "=&v"(l_)); return l_; }
namespace pg8 {
#define PG8_LAS __attribute__((address_space(3)))
typedef unsigned short bf16_t;
typedef short bf16x8 __attribute__((ext_vector_type(8)));
typedef float f32x4 __attribute__((ext_vector_type(4)));
typedef unsigned u32x4 __attribute__((ext_vector_type(4)));
constexpr int BM = 256, BK = 64, HALF = 128, HTB = HALF * BK * 2  , STAGE_BYTES = 8 * HTB, NXCD = 8, WGM = 8;

__host__ __device__ __forceinline__ int lds_byte(int r, int c) { const int st = (r >> 4) * 2 + (c >> 5), rr = r & 15, cc = c & 31, ob = rr * 64 + cc * 2; return st * 1024 + (ob ^ (((ob >> 9) & 1) << 5)); }
__host__ __device__ __forceinline__ void stage_rc(int b, int& R, int& C) { const int st = b / 1024, sb = b % 1024, swz = sb ^ (((sb >> 9) & 1) << 5); R = (st >> 1) * 16 + swz / 64; C = (st & 1) * 32 + (swz % 64) / 2; }
__host__ __device__ __forceinline__ int perm32(int rho) { const int n = rho >> 4, i = rho & 15; return 8 * (i >> 2) + 4 * n + (i & 3); }

struct Unit { int pm, pn; };
struct Gemm { const bf16_t* A; const bf16_t* Bt; int M, N, K; };

struct StaticOrder {
    int nM, nN, nwg, G, c;
    __host__ __device__ void init(int M, int N, int G_, int c_) { nM = M / BM; nN = N / BM; nwg = nM * nN; G = G_; c = c_; }
    __host__ __device__ bool next(int i, Unit& u) const {
        const long L = (long)i * G + c; if (L >= nwg) return false;
        int wgid = (int)L; { const int q = nwg / NXCD, r = nwg % NXCD, xcd = wgid % NXCD, off = wgid / NXCD; wgid = (xcd < r ? xcd * (q + 1) : r * (q + 1) + (xcd - r) * q) + off; }
        const int nig = WGM * nN, gid = wgid / nig, fm = gid * WGM, gsz = (nM - fm) < WGM ? (nM - fm) : WGM;
        u.pm = fm + ((wgid % nig) % gsz); u.pn = (wgid % nig) / gsz; return true;
    }
    __device__ __forceinline__ void a_ready(const Unit&) const {}
    __device__ __forceinline__ void done(const Unit&) const {}
};
struct MoeOrder {
    int nM, nN, nwg, G, c; const PG8_LAS unsigned char* tile_e;
    __device__ void init(int nRT, int NTN, int G_, int c_, const PG8_LAS unsigned char* te) { nM = nRT; nN = NTN; nwg = nM * nN; G = G_; c = c_; tile_e = te; }
    __device__ bool next(int i, Unit& u) const {
        const long L = (long)i * G + c; if (L >= nwg) return false;
        int wgid = (int)L; { const int q = nwg / NXCD, r = nwg % NXCD, xcd = wgid % NXCD, off = wgid / NXCD; wgid = (xcd < r ? xcd * (q + 1) : r * (q + 1) + (xcd - r) * q) + off; }
        const int nig = WGM * nN, gid = wgid / nig, fm = gid * WGM, gsz = (nM - fm) < WGM ? (nM - fm) : WGM;
        u.pm = fm + ((wgid % nig) % gsz); const int pl = (wgid % nig) / gsz; u.pn = (int)tile_e[u.pm] * nN + pl; return true;
    }
    __device__ __forceinline__ void a_ready(const Unit&) const {}
    __device__ __forceinline__ void done(const Unit&) const {}
};
struct MoeGatherA {
    static constexpr bool GATHER = true;
    const unsigned* rowmap; const PG8_LAS unsigned* base; const PG8_LAS unsigned* cnt; const PG8_LAS unsigned char* tile_e; int ntok; PG8_LAS unsigned* slot;
    __device__ __forceinline__ const unsigned* tokptr(const Unit& u, int h, int rA) const {
        const int e = tile_e[u.pm]; const unsigned pos = (unsigned)u.pm * 256u - base[e] + 128u * h + (unsigned)rA;
        return rowmap + (size_t)e * ntok + (pos < cnt[e] ? pos : 0u);
    }
    __device__ __forceinline__ unsigned off(const Unit& u, int h, int rA, int cA, int K) const { return (*tokptr(u, h, rA) * (unsigned)K + (unsigned)cA) * 2u; }
};
__device__ __forceinline__ unsigned cvt_pk_bf16(float lo, float hi) { unsigned r; asm volatile("v_cvt_pk_bf16_f32 %0, %1, %2" : "=v"(r) : "v"(lo), "v"(hi)); return r; }
typedef float f32x2 __attribute__((ext_vector_type(2)));
__device__ __forceinline__ f32x2 gelu_pk(f32x2 v) {
    const f32x2 av = __builtin_elementwise_abs(v), d = av * 0.2316418882f + 1.0f;
    f32x2 t; t.x = __builtin_amdgcn_rcpf(d.x); t.y = __builtin_amdgcn_rcpf(d.y);
    f32x2 q = t * 0.5307027145f + (-0.7265760135f); q = q * t + 0.7107068705f; q = q * t + (-0.142248368f); q = q * t + 0.127414796f; q = q * t;
    const f32x2 s = (v * v) * (-0.72134752044f);
    f32x2 e; e.x = __builtin_amdgcn_exp2f(s.x); e.y = __builtin_amdgcn_exp2f(s.y);
    const f32x2 m = v * (q * e), r = v - m;
    f32x2 o; o.x = v.x < 0.f ? m.x : r.x; o.y = v.y < 0.f ? m.y : r.y; return o;
}

template <int ACT  > struct EpiBf16 {
    static constexpr bool PERM = true, AFTER_DRAIN = false, PREFETCH = false; static constexpr int NST = 16; static_assert(ACT == 0 || ACT == 1, "EpiBf16: ACT is 0 (none) or 1 (gelu_pk)");
    bf16_t* O; int ldc; const float* bias; int split_cols; size_t split_stride; float scale0;
    __device__ __forceinline__ void operator()(const f32x4 (&acc)[2][2][4][2], const Unit& u, int wr, int wc, int fr, int fq) const {
        const int row0 = u.pm * BM + wr * 64 + fr; int colt = u.pn * BM; bf16_t* base = O;
        float sc = 1.f; if (split_cols) { const int t = colt / split_cols; base += (size_t)t * split_stride; colt -= t * split_cols; if (t == 0) sc = scale0; }
        const int col0 = colt + wc * 32 + 8 * fq, bcol0 = u.pn * BM + wc * 32 + 8 * fq;
        f32x4 bv[2][2];
#pragma unroll
        for (int bj = 0; bj < 2; ++bj)
#pragma unroll
            for (int n = 0; n < 2; ++n) bv[bj][n] = bias ? *(const f32x4*)(bias + bcol0 + bj * HALF + 4 * n) : (f32x4){0.f, 0.f, 0.f, 0.f};
#pragma unroll
        for (int ai = 0; ai < 2; ++ai)
#pragma unroll
            for (int m = 0; m < 4; ++m) { bf16_t* rowp = base + (size_t)(row0 + ai * HALF + m * 16) * ldc + col0;
#pragma unroll
                for (int bj = 0; bj < 2; ++bj) { f32x4 v0 = acc[ai][bj][m][0] + bv[bj][0], v1 = acc[ai][bj][m][1] + bv[bj][1];
                    if (ACT == 1) { f32x2 a = gelu_pk((f32x2){v0[0], v0[1]}), b = gelu_pk((f32x2){v0[2], v0[3]}), c = gelu_pk((f32x2){v1[0], v1[1]}), d = gelu_pk((f32x2){v1[2], v1[3]});
                        v0 = (f32x4){a.x, a.y, b.x, b.y}; v1 = (f32x4){c.x, c.y, d.x, d.y}; }
                    v0 = v0 * sc; v1 = v1 * sc; u32x4 w; w.x = cvt_pk_bf16(v0[0], v0[1]); w.y = cvt_pk_bf16(v0[2], v0[3]); w.z = cvt_pk_bf16(v1[0], v1[1]); w.w = cvt_pk_bf16(v1[2], v1[3]);
                    *(u32x4*)(rowp + bj * HALF) = w; } }
    }
};
constexpr float C2 = 0.125f * 1.4426950408889634f;
struct EpiIn {
    static constexpr bool PERM = true, AFTER_DRAIN = false, PREFETCH = false; static constexpr int NST = 16;
    bf16_t* O; const unsigned* cs; float asc;
    static __device__ __forceinline__ float h_lo(unsigned w) { return (float)__builtin_bit_cast(_Float16, (unsigned short)(w & 0xffffu)); }
    static __device__ __forceinline__ float h_hi(unsigned w) { return (float)__builtin_bit_cast(_Float16, (unsigned short)(w >> 16)); }
    __device__ __forceinline__ void operator()(const f32x4 (&acc)[2][2][4][2], const Unit& u, int wr, int wc, int fr, int fq) const {
        const int pn = u.pn;
        const bool rope = (0x6CF0 >> pn) & 1;
        const float sc = (((0x0430 >> pn) & 1) ? C2 : 1.f) * asc;
        const int row0 = u.pm * BM + wr * 64 + fr, col0 = pn * BM + wc * 32 + 8 * fq, i0 = (wc & 1) * 16 + 4 * fq;
        u32x4 cw[2][4];
#pragma unroll
        for (int ai = 0; ai < 2; ++ai)
#pragma unroll
            for (int m = 0; m < 4; ++m) cw[ai][m] = (u32x4){0x3C00u, 0x3C00u, 0x3C00u, 0x3C00u};
        if (rope) {
#pragma unroll
            for (int ai = 0; ai < 2; ++ai)
#pragma unroll
                for (int m = 0; m < 4; ++m) cw[ai][m] = *(const u32x4*)(cs + (size_t)(row0 + ai * HALF + m * 16) * 32 + i0);
        }
#pragma unroll
        for (int ai = 0; ai < 2; ++ai) {
#pragma unroll
            for (int m = 0; m < 4; ++m) {
                const int row = row0 + ai * HALF + m * 16;
                const u32x4 cq = cw[ai][m];
                const f32x4 ca = (f32x4){h_lo(cq.x), h_hi(cq.x), h_lo(cq.y), h_hi(cq.y)} * sc, cb = (f32x4){h_lo(cq.z), h_hi(cq.z), h_lo(cq.w), h_hi(cq.w)} * sc;
                bf16_t* rowp = O + (size_t)row * 4096 + col0;
#pragma unroll
                for (int bj = 0; bj < 2; ++bj) {
                    const f32x4 v0 = acc[ai][bj][m][0], v1 = acc[ai][bj][m][1];
                    f32x4 r0, r1;
                    r0[0] = v0[0] * ca[0] - v0[1] * ca[1]; r0[1] = v0[1] * ca[0] + v0[0] * ca[1];
                    r0[2] = v0[2] * ca[2] - v0[3] * ca[3]; r0[3] = v0[3] * ca[2] + v0[2] * ca[3];
                    r1[0] = v1[0] * cb[0] - v1[1] * cb[1]; r1[1] = v1[1] * cb[0] + v1[0] * cb[1];
                    r1[2] = v1[2] * cb[2] - v1[3] * cb[3]; r1[3] = v1[3] * cb[2] + v1[2] * cb[3];
                    u32x4 w; w.x = cvt_pk_bf16(r0[0], r0[1]); w.y = cvt_pk_bf16(r0[2], r0[3]); w.z = cvt_pk_bf16(r1[0], r1[1]); w.w = cvt_pk_bf16(r1[2], r1[3]);
                    *(u32x4*)(rowp + bj * HALF) = w;
                }
            }
            asm volatile("" ::: "memory");
        }
    }
};
__device__ __forceinline__ unsigned pk4_fp8(float a, float b, float c, float d, float sc) {
    a = fminf(fmaxf(a * sc, -448.f), 448.f); b = fminf(fmaxf(b * sc, -448.f), 448.f); c = fminf(fmaxf(c * sc, -448.f), 448.f); d = fminf(fmaxf(d * sc, -448.f), 448.f);
    int w = __builtin_amdgcn_cvt_pk_fp8_f32(a, b, 0, false); w = __builtin_amdgcn_cvt_pk_fp8_f32(c, d, w, true); return (unsigned)w; }
__device__ __forceinline__ unsigned pk4_fp8_raw(float a, float b, float c, float d) { int w = __builtin_amdgcn_cvt_pk_fp8_f32(a, b, 0, false); w = __builtin_amdgcn_cvt_pk_fp8_f32(c, d, w, true); return (unsigned)w; }
template <bool F8OUT> struct EpiSwiGLU {
    static constexpr bool PERM = true, AFTER_DRAIN = false, PREFETCH = true; static constexpr int NST = 8;
    bf16_t* O; const float* b1; float asc; PG8_LAS unsigned char* side;
    __device__ __forceinline__ void prefetch(const Unit& u, int slot, int wid, int lane) const {
        if (wid == 0) { const int ln = lane_id_(); const int e = u.pn >> 3, pl = u.pn & 7; const float* ub = b1 + (size_t)e * 2048 + pl * 128; asm("" : "+s"(ub)); const float* src = ub + ((ln & 32) ? 1024 : 0) + (ln & 31) * 4;
            __builtin_amdgcn_global_load_lds((const unsigned*)src, (PG8_LAS unsigned*)(side + slot * 1024), 16, 0, 0); } }
    __device__ __forceinline__ void operator()(const f32x4 (&acc)[2][2][4][2], const Unit& u, int wr, int wc, int fr, int fq, int slot) const {
        constexpr float OS = F8OUT ? 8.0f : 1.0f;
        const int pl = u.pn & 7, colh = pl * 128 + wc * 32 + 8 * fq;
        const PG8_LAS float* bp = (const PG8_LAS float*)(side + slot * 1024) + wc * 32 + 8 * fq;
        f32x4 bg[2], bu[2];
#pragma unroll
        for (int n = 0; n < 2; ++n) { bg[n] = *(const PG8_LAS f32x4*)(bp + 4 * n); bu[n] = *(const PG8_LAS f32x4*)(bp + 128 + 4 * n); }
        const int row0 = u.pm * BM + wr * 64 + fr;
#pragma unroll
        for (int ai = 0; ai < 2; ++ai)
#pragma unroll
            for (int m = 0; m < 4; ++m) {
                f32x4 o[2];
#pragma unroll
                for (int n = 0; n < 2; ++n) {
                    const f32x4 g4 = acc[ai][0][m][n] * asc + bg[n], u4 = acc[ai][1][m][n] * asc + bu[n];
#pragma unroll
                    for (int c = 0; c < 4; ++c) {
                        const float g = fminf(g4[c], 7.0f), up = fminf(fmaxf(u4[c], -7.0f), 7.0f);
                        const float sg = __builtin_amdgcn_rcpf(1.0f + __builtin_amdgcn_exp2f(-1.702f * 1.4426950408889634f * g));
                        o[n][c] = (up * OS + OS) * (g * sg);
                    }
                }
                if constexpr (F8OUT) { typedef unsigned u32x2_ __attribute__((ext_vector_type(2))); u32x2_ w; w.x = pk4_fp8_raw(o[0][0], o[0][1], o[0][2], o[0][3]); w.y = pk4_fp8_raw(o[1][0], o[1][1], o[1][2], o[1][3]);
                    *(u32x2_*)((unsigned char*)O + (size_t)(row0 + ai * HALF + m * 16) * 1024 + colh) = w; }
                else { u32x4 w; w.x = cvt_pk_bf16(o[0][0], o[0][1]); w.y = cvt_pk_bf16(o[0][2], o[0][3]); w.z = cvt_pk_bf16(o[1][0], o[1][1]); w.w = cvt_pk_bf16(o[1][2], o[1][3]);
                    *(u32x4*)(O + (size_t)(row0 + ai * HALF + m * 16) * 1024 + colh) = w; }
            }
    }
};
struct EpiMoeOut {
    static constexpr bool PERM = true, AFTER_DRAIN = false, PREFETCH = false; static constexpr int NST = 8;
    bf16_t* O; float asc;
    __device__ __forceinline__ void operator()(const f32x4 (&acc)[2][2][4][2], const Unit& u, int wr, int wc, int fr, int fq) const {
        const int row0 = u.pm * BM + wr * 64 + fr, col0 = (u.pn & 3) * BM + wc * 64 + 16 * fq;
#pragma unroll
        for (int ai = 0; ai < 2; ++ai)
#pragma unroll
            for (int m = 0; m < 4; ++m) { unsigned char* rowp = (unsigned char*)O + (size_t)(row0 + ai * HALF + m * 16) * 1024 + col0;
                u32x4 w;
                { const f32x4 v0 = acc[ai][0][m][0], v1 = acc[ai][0][m][1]; w.x = pk4_fp8(v0[0], v0[1], v0[2], v0[3], 64.0f * asc); w.y = pk4_fp8(v1[0], v1[1], v1[2], v1[3], 64.0f * asc); }
                { const f32x4 v0 = acc[ai][1][m][0], v1 = acc[ai][1][m][1]; w.z = pk4_fp8(v0[0], v0[1], v0[2], v0[3], 64.0f * asc); w.w = pk4_fp8(v1[0], v1[1], v1[2], v1[3], 64.0f * asc); }
                *(u32x4*)rowp = w; }
    }
};

struct EpiNull { static constexpr bool PERM = true, AFTER_DRAIN = false, PREFETCH = false;
    __device__ __forceinline__ void operator()(const f32x4 (&acc)[2][2][4][2], const Unit& u, int wr, int wc, int fr, int fq) const {
#pragma unroll
        for (int a = 0; a < 2; ++a)
#pragma unroll
            for (int b = 0; b < 2; ++b)
#pragma unroll
                for (int m = 0; m < 4; ++m)
#pragma unroll
                    for (int n = 0; n < 2; ++n) asm volatile("" :: "v"(acc[a][b][m][n]));
    } };
struct DirectA { static constexpr bool GATHER = false; __device__ __forceinline__ unsigned off(const Unit&, int, int, int, int) const { return 0u; } };
typedef int v8i32 __attribute__((ext_vector_type(8)));
template <class E, class = void> struct epi_nst { static constexpr int v = 0; };
template <class E> struct epi_nst<E, decltype((void)E::NST)> { static constexpr int v = E::NST; };
template <class Epi, class Sched, bool ALIGN_EPI = false, bool SP2 = false, class AMap = DirectA, bool F8 = false>
__device__ __forceinline__ void gemm_phase(PG8_LAS unsigned char* lds, int wvx, const Gemm g, const Sched& S, const Epi& E, const AMap& AM = AMap(), int scA = 0x7f7f7f7f, int scB = 0x7f7f7f7f) {
    int tid_ = wvx * 64 + lane_id_(); asm volatile("" : "+v"(tid_));
    const int tid = tid_, wid = __builtin_amdgcn_readfirstlane(tid >> 6), lane = tid & 63, wr = wid >> 2, wc = wid & 3, fr = lane & 15, fq = lane >> 4;
    const int K = g.K, nt = K / BK;
    unsigned voffB[2], vA[2];
#pragma unroll
    for (int i = 0; i < 2; ++i) { int R, C; stage_rc(tid * 16 + i * 8192, R, C); const int Rb = Epi::PERM ? ((R & ~31) + perm32(R & 31)) : R;
        vA[i] = (unsigned)(R * K + C) * 2u; voffB[i] = (unsigned)(Rb * K + C) * 2u; }
    const size_t kstep = (size_t)(BK * 2);
    const size_t hstep = (size_t)HALF * K * 2;
    const size_t tstep = 2 * hstep;
    const unsigned ldsw = (unsigned)wid * 1024u;
    const int aoff = lds_byte(wr * 64 + fr, fq * 8), boff = lds_byte(wc * 32 + fr, fq * 8);
#define PG8_SA(b, h) (((b) * 2 + (h)) * HTB)
#define PG8_SB(b, h) ((4 + (b) * 2 + (h)) * HTB)
#define PG8_STAGEA(bufoff, kb, h, nx) do { size_t ubx_ = (size_t)(kb); unsigned lo_[2]; \
        if constexpr (AMap::GATHER) { _Pragma("unroll") for (int _i = 0; _i < 2; ++_i) lo_[_i] = (nx) ? oN[h][_i] : oC[h][_i]; } \
        else { ubx_ += (nx) ? uN[h] : uC[h]; _Pragma("unroll") for (int _i = 0; _i < 2; ++_i) lo_[_i] = vA[_i]; } \
        const char* ub_ = Abase + ubx_; asm("" : "+s"(ub_)); _Pragma("unroll") for (int _i = 0; _i < 2; ++_i) asm("" : "+v"(lo_[_i]));     \
        _Pragma("unroll") for (int _i = 0; _i < 2; ++_i) \
        __builtin_amdgcn_global_load_lds((const unsigned*)(ub_ + lo_[_i]), (PG8_LAS unsigned*)(lds + (bufoff) + ldsw + _i * 8192), 16, 0, 0); } while (0)
#define PG8_AOFF(dstL, dstU, u) do { if constexpr (AMap::GATHER) { int t2_ = wvx * 64 + lane_id_(); asm volatile("" : "+v"(t2_)); _Pragma("unroll") for (int _i = 0; _i < 2; ++_i) { int R_, C_; stage_rc(t2_ * 16 + _i * 8192, R_, C_); \
            _Pragma("unroll") for (int _h = 0; _h < 2; ++_h) dstL[_h][_i] = AM.off(u, _h, R_, C_, K); } } \
        else { _Pragma("unroll") for (int _h = 0; _h < 2; ++_h) dstU[_h] = ((size_t)(u).pm * BM + 128 * _h) * (size_t)K * 2; } } while (0)
#define PG8_TOKDMA(u) do { int t2_ = wvx * 64 + lane_id_(); asm volatile("" : "+v"(t2_)); _Pragma("unroll") for (int _i = 0; _i < 2; ++_i) { int R_, C_; stage_rc(t2_ * 16 + _i * 8192, R_, C_); \
            _Pragma("unroll") for (int _h = 0; _h < 2; ++_h) __builtin_amdgcn_global_load_lds(AM.tokptr(u, _h, R_), AM.slot + wvx * 256 + (_h * 2 + _i) * 64, 4, 0, 0); } } while (0)
#define PG8_TOKOFF(dstL) do { int t2_ = wvx * 64 + lane_id_(); asm volatile("" : "+v"(t2_)); _Pragma("unroll") for (int _i = 0; _i < 2; ++_i) { int R_, C_; stage_rc(t2_ * 16 + _i * 8192, R_, C_); \
            _Pragma("unroll") for (int _h = 0; _h < 2; ++_h) dstL[_h][_i] = (AM.slot[wvx * 256 + (_h * 2 + _i) * 64 + (t2_ & 63)] * (unsigned)K + (unsigned)C_) * 2u; } } while (0)
#define PG8_STAGE(bufoff, gbase, voff) do { const char* ub_ = (const char*)(gbase); asm("" : "+s"(ub_)); _Pragma("unroll") for (int _i = 0; _i < 2; ++_i) \
        __builtin_amdgcn_global_load_lds((const unsigned*)(ub_ + (voff)[_i]), (PG8_LAS unsigned*)(lds + (bufoff) + ldsw + _i * 8192), 16, 0, 0); } while (0)
#define PG8_LDA(dst, b, h) do { _Pragma("unroll") for (int m = 0; m < 4; ++m) _Pragma("unroll") for (int k = 0; k < 2; ++k) dst[m][k] = *(const PG8_LAS bf16x8*)(lds + PG8_SA(b, h) + aoff + m * 2048 + k * 1024); } while (0)
#define PG8_LDB(dst, b, h) do { _Pragma("unroll") for (int n = 0; n < 2; ++n) _Pragma("unroll") for (int k = 0; k < 2; ++k) dst[n][k] = *(const PG8_LAS bf16x8*)(lds + PG8_SB(b, h) + boff + n * 2048 + k * 1024); } while (0)
#define PG8_CAT(x) __builtin_bit_cast(v8i32, __builtin_shufflevector(x[0], x[1], 0, 1, 2, 3, 4, 5, 6, 7, 8, 9, 10, 11, 12, 13, 14, 15))
#define PG8_MMA(ai, bj, At, Bt) do { __builtin_amdgcn_s_setprio(1); _Pragma("unroll") for (int m = 0; m < 4; ++m) _Pragma("unroll") for (int n = 0; n < 2; ++n) { \
        if constexpr (F8) acc[ai][bj][m][n] = __builtin_amdgcn_mfma_scale_f32_16x16x128_f8f6f4(PG8_CAT(Bt[n]), PG8_CAT(At[m]), acc[ai][bj][m][n], 0, 0, 0, scB, 0, scA); \
        else { _Pragma("unroll") for (int k = 0; k < 2; ++k) acc[ai][bj][m][n] = __builtin_amdgcn_mfma_f32_16x16x32_bf16(Bt[n][k], At[m][k], acc[ai][bj][m][n], 0, 0, 0); } } __builtin_amdgcn_s_setprio(0); } while (0)
#define PG8_WAIT_V(n) asm volatile("s_waitcnt vmcnt(" #n ")" ::: "memory")
#define PG8_WAIT_VR(n) do { if (rlx) asm volatile("s_waitcnt vmcnt(%0)" :: "n"((n) + epi_nst<Epi>::v) : "memory"); else PG8_WAIT_V(n); } while (0)
#define PG8_WAIT_L(n) asm volatile("s_waitcnt lgkmcnt(" #n ")" ::: "memory")
#define PG8_BAR __builtin_amdgcn_s_barrier()
#define PG8_SCHED __builtin_amdgcn_sched_barrier(0)
    Unit cur, nxt; int ui = 0;
    if (!S.next(0, cur)) return;
    f32x4 acc[2][2][4][2];
#pragma unroll
    for (int a = 0; a < 2; ++a)
#pragma unroll
        for (int b = 0; b < 2; ++b)
#pragma unroll
            for (int m = 0; m < 4; ++m)
#pragma unroll
                for (int n = 0; n < 2; ++n) acc[a][b][m][n] = (f32x4){0.f, 0.f, 0.f, 0.f};
    bf16x8 At[4][2], B0[2][2], B1[2][2];
    const char* Abase = (const char*)g.A; const char* cB = (const char*)g.Bt + (size_t)cur.pn * tstep;
    unsigned oC[2][2], oN[2][2]; size_t uC[2] = {0, 0}, uN[2] = {0, 0}; PG8_AOFF(oC, uC, cur); if constexpr (AMap::GATHER) { _Pragma("unroll") for (int _h = 0; _h < 2; ++_h) { oN[_h][0] = oC[_h][0]; oN[_h][1] = oC[_h][1]; } }
    if constexpr (AMap::GATHER) { Unit n1_; if (S.next(1, n1_)) PG8_TOKDMA(n1_); }
    S.a_ready(cur);
    if constexpr (Epi::PREFETCH) E.prefetch(cur, 0, wid, lane);
    if constexpr (SP2) {
        PG8_STAGE(PG8_SB(0, 0), cB, voffB); PG8_STAGE(PG8_SB(0, 1), cB + hstep, voffB); PG8_STAGEA(PG8_SA(0, 0), 0, 0, false); PG8_STAGEA(PG8_SA(0, 1), 0, 1, false);
        if (wr == 1) PG8_BAR;
        PG8_WAIT_V(2); PG8_BAR;
        PG8_STAGE(PG8_SB(1, 0), cB + kstep, voffB); PG8_STAGEA(PG8_SA(1, 0), kstep, 0, false); PG8_STAGE(PG8_SB(1, 1), cB + hstep + kstep, voffB);
        PG8_WAIT_V(6); PG8_BAR;
    } else {
        PG8_STAGE(PG8_SB(0, 0), cB, voffB); PG8_STAGEA(PG8_SA(0, 0), 0, 0, false); PG8_STAGE(PG8_SB(0, 1), cB + hstep, voffB); PG8_STAGEA(PG8_SA(0, 1), 0, 1, false);
        if (wr == 1) PG8_BAR;
        PG8_WAIT_V(4); PG8_BAR;
        PG8_STAGE(PG8_SB(1, 0), cB + kstep, voffB); PG8_STAGEA(PG8_SA(1, 0), kstep, 0, false); PG8_STAGE(PG8_SB(1, 1), cB + hstep + kstep, voffB);
        PG8_WAIT_V(6); PG8_BAR;
    }
    for (;;) {
        const bool has_next = S.next(ui + 1, nxt);
        if constexpr (Epi::PREFETCH) { if (has_next) E.prefetch(nxt, (ui + 1) & 1, wid, lane); }
        const char* nB = has_next ? (const char*)g.Bt + (size_t)nxt.pn * tstep : cB;
        if constexpr (!AMap::GATHER) { if (has_next) { PG8_AOFF(oN, uN, nxt); } else {
#pragma unroll
            for (int _h = 0; _h < 2; ++_h) { uN[_h] = uC[_h]; } } }
#pragma unroll 1
        for (int t = 0; t < nt; t += 2) {
            const bool last = (t == nt - 2), rlx = SP2 && (t == 0) && (ui > 0);
            const size_t ka1 = (size_t)(t + 1) * kstep, ka2 = last ? (size_t)0 : (size_t)(t + 2) * kstep, ka3 = ka2 + kstep;
            const char* b2 = last ? nB : cB + (size_t)(t + 2) * kstep; const char* b3 = b2 + kstep;
            if (last && has_next) S.a_ready(nxt);
            if constexpr (AMap::GATHER) { if (last) { if (has_next) { PG8_TOKOFF(oN); } else {
#pragma unroll
                for (int _h = 0; _h < 2; ++_h) { oN[_h][0] = oC[_h][0]; oN[_h][1] = oC[_h][1]; } } } }
            if constexpr (SP2) {
            PG8_LDB(B0, 0, 0); PG8_LDB(B1, 0, 1); PG8_SCHED; PG8_LDA(At, 0, 0); if (!(ALIGN_EPI && rlx)) PG8_STAGEA(PG8_SA(1, 1), ka1, 1, false);
            PG8_WAIT_VR(8); PG8_WAIT_L(0); PG8_BAR; PG8_MMA(0, 0, At, B0); PG8_MMA(0, 1, At, B1); PG8_BAR; PG8_SCHED;
            PG8_LDA(At, 0, 1); PG8_STAGE(PG8_SB(0, 0), b2, voffB); PG8_STAGE(PG8_SB(0, 1), b2 + hstep, voffB); PG8_STAGEA(PG8_SA(0, 0), ka2, 0, last);
            PG8_WAIT_VR(8); PG8_WAIT_L(0); PG8_BAR; PG8_MMA(1, 0, At, B0); PG8_MMA(1, 1, At, B1); PG8_BAR; PG8_SCHED;
            PG8_LDB(B0, 1, 0); PG8_LDB(B1, 1, 1); PG8_SCHED; PG8_LDA(At, 1, 0); PG8_STAGEA(PG8_SA(0, 1), ka2, 1, last);
            if constexpr (ALIGN_EPI) PG8_WAIT_VR(8); else PG8_WAIT_V(8); PG8_WAIT_L(0); PG8_BAR; PG8_MMA(0, 0, At, B0); PG8_MMA(0, 1, At, B1); PG8_BAR; PG8_SCHED;
            PG8_LDA(At, 1, 1); PG8_STAGE(PG8_SB(1, 0), b3, voffB); PG8_STAGE(PG8_SB(1, 1), b3 + hstep, voffB); PG8_STAGEA(PG8_SA(1, 0), ka3, 0, last);
            PG8_WAIT_V(8); PG8_WAIT_L(0); PG8_BAR; PG8_MMA(1, 0, At, B0); PG8_MMA(1, 1, At, B1); PG8_BAR; PG8_SCHED;
            } else {
            PG8_LDB(B0, 0, 0); PG8_SCHED; PG8_LDA(At, 0, 0); PG8_STAGEA(PG8_SA(1, 1), ka1, 1, false);
            PG8_WAIT_L(8); PG8_BAR; PG8_WAIT_L(0); PG8_MMA(0, 0, At, B0); PG8_BAR; PG8_SCHED;
            PG8_LDB(B1, 0, 1); PG8_STAGE(PG8_SB(0, 0), b2, voffB);
            PG8_BAR; PG8_WAIT_L(0); PG8_MMA(0, 1, At, B1); PG8_BAR;
            PG8_LDA(At, 0, 1); PG8_STAGEA(PG8_SA(0, 0), ka2, 0, last);
            PG8_BAR; PG8_WAIT_L(0); PG8_MMA(1, 0, At, B0); PG8_BAR; PG8_SCHED;
            PG8_STAGE(PG8_SB(0, 1), b2 + hstep, voffB);
            PG8_WAIT_V(6); PG8_BAR; PG8_MMA(1, 1, At, B1); PG8_BAR;
            PG8_LDB(B0, 1, 0); PG8_SCHED; PG8_LDA(At, 1, 0); PG8_STAGEA(PG8_SA(0, 1), ka2, 1, last);
            PG8_WAIT_L(8); PG8_BAR; PG8_WAIT_L(0); PG8_MMA(0, 0, At, B0); PG8_BAR; PG8_SCHED;
            PG8_LDB(B1, 1, 1); PG8_STAGE(PG8_SB(1, 0), b3, voffB);
            PG8_BAR; PG8_WAIT_L(0); PG8_MMA(0, 1, At, B1); PG8_BAR;
            PG8_LDA(At, 1, 1); PG8_STAGEA(PG8_SA(1, 0), ka3, 0, last);
            PG8_BAR; PG8_WAIT_L(0); PG8_MMA(1, 0, At, B0); PG8_BAR; PG8_SCHED;
            PG8_STAGE(PG8_SB(1, 1), b3 + hstep, voffB);
            PG8_WAIT_V(6); PG8_BAR; PG8_MMA(1, 1, At, B1); PG8_BAR;
            }
        }
        if constexpr (ALIGN_EPI) { if (wr == 0) PG8_BAR; }
        if constexpr (ALIGN_EPI && SP2) { if (has_next) PG8_STAGEA(PG8_SA(1, 1), kstep, 1, true); PG8_SCHED; }
        if constexpr (AMap::GATHER) { if (has_next) { Unit n2_; if (S.next(ui + 2, n2_)) PG8_TOKDMA(n2_); } }
        if constexpr (!Epi::AFTER_DRAIN) { const int l2_ = lane_id_(); const int fr_ = l2_ & 15, fq_ = l2_ >> 4;
            if constexpr (Epi::PREFETCH) E(acc, cur, wr, wc, fr_, fq_, ui & 1); else E(acc, cur, wr, wc, fr_, fq_); S.done(cur); }
        if (!has_next) break;
#pragma unroll
        for (int a = 0; a < 2; ++a)
#pragma unroll
            for (int b = 0; b < 2; ++b)
#pragma unroll
                for (int m = 0; m < 4; ++m)
#pragma unroll
                    for (int n = 0; n < 2; ++n) acc[a][b][m][n] = (f32x4){0.f, 0.f, 0.f, 0.f};
        cur = nxt; cB = nB; ++ui;
#pragma unroll
        for (int _h = 0; _h < 2; ++_h) { oC[_h][0] = oN[_h][0]; oC[_h][1] = oN[_h][1]; uC[_h] = uN[_h]; }
        if constexpr (ALIGN_EPI) { if (wr == 1) PG8_BAR; }
    }
    PG8_WAIT_V(0);
    if constexpr (!ALIGN_EPI) { if (wr == 0) PG8_BAR; }
    PG8_BAR;
    if constexpr (Epi::AFTER_DRAIN) { E.fused(acc, cur, wr, wc, fr, fq, lds, wid, lane); S.done(cur); }
#undef PG8_SA
#undef PG8_SB
#undef PG8_STAGE
#undef PG8_STAGEA
#undef PG8_AOFF
#undef PG8_TOKDMA
#undef PG8_TOKOFF
#undef PG8_LDA
#undef PG8_LDB
#undef PG8_MMA
#undef PG8_CAT
#undef PG8_WAIT_V
#undef PG8_WAIT_VR
#undef PG8_WAIT_L
#undef PG8_BAR
#undef PG8_SCHED
}
}
namespace attn_body {
using bf16=unsigned short;
using bf16x8=__attribute__((ext_vector_type(8)))short;
using s16x4=__attribute__((ext_vector_type(4)))short;
using f32x16=__attribute__((ext_vector_type(16)))float;
using u32x4=__attribute__((ext_vector_type(4)))unsigned;
constexpr int SEQ=2048,D=64,DM=4096,DMO=1024;
constexpr int NW=8,QBLK=32,QB=QBLK*NW,KVBLK=64,NQB=SEQ/QB;
__device__ __forceinline__ unsigned f2bf_(float f){unsigned u=__builtin_bit_cast(unsigned,f);return (u+0x7fffu+((u>>16)&1u))>>16;}
__device__ __forceinline__ int crow(int r,int hi){return (r&3)+8*(r>>2)+4*hi;}
#define SBAR() __builtin_amdgcn_sched_barrier(0)
__device__ __forceinline__ void cmask(f32x16&p0,f32x16&p1,int jb,int qrel,int hi){
  const float NEG=-INFINITY; int kb=64*jb+4*hi;
  #pragma unroll
  for(int r=0;r<16;++r){int kv=kb+(r&3)+8*(r>>2); if(kv>qrel)p0[r]=NEG; if(kv+32>qrel)p1[r]=NEG;}
}

__device__ __forceinline__ uint2 mld_asm(const unsigned*p){ uint2 v; asm volatile("global_load_dwordx2 %0, %1, off":"=v"(v):"v"(p):"memory"); return v; }
__device__ __forceinline__ void bmask(f32x16&p0,f32x16&p1,uint2 w,int hi){
  const float NEG=-INFINITY; const unsigned a=w.x>>(4*hi), b=w.y>>(4*hi);
  #pragma unroll
  for(int r=0;r<16;++r){const int bit=(r&3)+8*(r>>2); if(!((a>>bit)&1u))p0[r]=NEG; if(!((b>>bit)&1u))p1[r]=NEG;}
}
constexpr int NSLOT=3, SLOTB=8192;
constexpr int LDS_K=0, LDS_V=NSLOT*SLOTB, LDS_WS=2*NSLOT*SLOTB, LDS_OST=LDS_WS+NW*64*4, LDS_BYTES=LDS_OST+NW*4096;
constexpr float C2=0.125f*1.4426950408889634f;
__device__ __forceinline__ void glds16(const void*gsrc,unsigned lds_dst){unsigned keep;
  asm volatile("s_mov_b32 %0, m0\n\ts_mov_b32 m0, %2\n\ts_nop 0\n\tglobal_load_lds_dwordx4 %1, off\n\ts_mov_b32 m0, %0":"=&s"(keep):"v"(gsrc),"s"(lds_dst):"memory");}
__device__ __forceinline__ float max3f(float a,float b,float c){float r;asm("v_max3_f32 %0, %1, %2, %3":"=v"(r):"v"(a),"v"(b),"v"(c));return r;}
__device__ __forceinline__ float max2f(float a,float b){float r;asm("v_max_f32_e32 %0, %1, %2":"=v"(r):"v"(a),"v"(b));return r;}
__device__ __forceinline__ float fadd_s(float a,float b){float r;asm("v_add_f32_e32 %0, %1, %2":"=v"(r):"v"(a),"v"(b));return r;}
__device__ __forceinline__ float fsub_s(float a,float b){float r;asm("v_sub_f32_e32 %0, %1, %2":"=v"(r):"v"(a),"v"(b));return r;}
typedef float f32x2_t __attribute__((ext_vector_type(2))); typedef __bf16 bf16x2_t __attribute__((ext_vector_type(2)));
__device__ __forceinline__ unsigned cvtpk_s(float lo,float hi){f32x2_t v={lo,hi};bf16x2_t b=__builtin_convertvector(v,bf16x2_t);return __builtin_bit_cast(unsigned,b);}
#define WAIT_BAR(N) asm volatile("s_waitcnt vmcnt(" #N ") lgkmcnt(0)\n\ts_barrier":::"memory")

__device__ __forceinline__ void qkt(f32x16&p0,f32x16&p1,const char*Kslot,const bf16x8*qr,const f32x16&negm,int r32,int hi){
  const char*kb=Kslot+hi*1024+r32*16;
  #pragma unroll
  for(int d0=0;d0<4;++d0){
    const bf16x8 b0=*reinterpret_cast<const bf16x8*>(kb+d0*2048);
    const bf16x8 b1=*reinterpret_cast<const bf16x8*>(kb+d0*2048+512);
    if(d0==0){p0=__builtin_amdgcn_mfma_f32_32x32x16_bf16(b0,qr[0],negm,0,0,0);p1=__builtin_amdgcn_mfma_f32_32x32x16_bf16(b1,qr[0],negm,0,0,0);}
    else{p0=__builtin_amdgcn_mfma_f32_32x32x16_bf16(b0,qr[d0],p0,0,0,0);p1=__builtin_amdgcn_mfma_f32_32x32x16_bf16(b1,qr[d0],p1,0,0,0);}}
}
typedef __attribute__((address_space(3))) const char* lds_cptr;
typedef short v4i16_t __attribute__((ext_vector_type(4)));
__device__ __forceinline__ void kload8(bf16x8*kf,lds_cptr kp){
  kf[0]=*(const __attribute__((address_space(3))) bf16x8*)(kp);      kf[1]=*(const __attribute__((address_space(3))) bf16x8*)(kp+512);
  kf[2]=*(const __attribute__((address_space(3))) bf16x8*)(kp+2048); kf[3]=*(const __attribute__((address_space(3))) bf16x8*)(kp+2560);
  kf[4]=*(const __attribute__((address_space(3))) bf16x8*)(kp+4096); kf[5]=*(const __attribute__((address_space(3))) bf16x8*)(kp+4608);
  kf[6]=*(const __attribute__((address_space(3))) bf16x8*)(kp+6144); kf[7]=*(const __attribute__((address_space(3))) bf16x8*)(kp+6656);
}
__device__ __forceinline__ void kload2(bf16x8*kf,lds_cptr kp,int j){ kf[2*j]=*(const __attribute__((address_space(3))) bf16x8*)(kp+j*2048); kf[2*j+1]=*(const __attribute__((address_space(3))) bf16x8*)(kp+j*2048+512); }
__device__ __forceinline__ s16x4 vtr(lds_cptr p){ return __builtin_bit_cast(s16x4,__builtin_amdgcn_ds_read_tr16_b64_v4i16((__attribute__((address_space(3))) v4i16_t*)p)); }
__device__ __forceinline__ float rowmax(const f32x16&p0,const f32x16&p1){
  float a=max3f(p0[0],p0[1],p1[0]),b=max3f(p0[2],p0[3],p1[1]);a=max3f(a,p1[2],p1[3]);
  #pragma unroll
  for(int r=4;r<16;r+=4){a=max3f(a,p0[r],p0[r+1]);b=max3f(b,p0[r+2],p0[r+3]);a=max3f(a,p1[r],p1[r+1]);b=max3f(b,p1[r+2],p1[r+3]);}
  const float m=max2f(a,b);
  auto rr=__builtin_amdgcn_permlane32_swap(__float_as_uint(m),__float_as_uint(m),false,false);
  return max2f(__uint_as_float(rr[0]),__uint_as_float(rr[1]));
}
__device__ __forceinline__ void pv(f32x16*o,int vb,bf16x8 pa0,bf16x8 pa1,bf16x8 pa2,bf16x8 pa3){
  #pragma unroll
  for(int d0=0;d0<2;++d0){s16x4 lo[4],hi[4];
    #pragma unroll
    for(int ks=0;ks<4;++ks){
      asm volatile("ds_read_b64_tr_b16 %0,%1 offset:%c2":"=&v"(lo[ks]):"v"(vb),"i"(d0*4096+ks*1024):"memory");
      asm volatile("ds_read_b64_tr_b16 %0,%1 offset:%c2":"=&v"(hi[ks]):"v"(vb),"i"(d0*4096+ks*1024+512):"memory");}
    asm volatile("s_waitcnt lgkmcnt(0)":::"memory");SBAR();
    #define PK(k) (bf16x8){lo[k][0],lo[k][1],lo[k][2],lo[k][3],hi[k][0],hi[k][1],hi[k][2],hi[k][3]}
    o[d0]=__builtin_amdgcn_mfma_f32_32x32x16_bf16(pa0,PK(0),o[d0],0,0,0);
    o[d0]=__builtin_amdgcn_mfma_f32_32x32x16_bf16(pa1,PK(1),o[d0],0,0,0);
    o[d0]=__builtin_amdgcn_mfma_f32_32x32x16_bf16(pa2,PK(2),o[d0],0,0,0);
    o[d0]=__builtin_amdgcn_mfma_f32_32x32x16_bf16(pa3,PK(3),o[d0],0,0,0);
    #undef PK
  }
}

#ifndef ATTN_STORE16
#define ATTN_STORE16(p,v) (*(u32x4*)(p)=(v))
#endif
template<int THRL,bool MASKED> __device__ __forceinline__ void attn_unit(int wvx,int b,int qb,const bf16*Q,const bf16*__restrict__ K,const bf16*__restrict__ V,bf16*O,const unsigned*MASK,char*shm){
  int tid_=wvx*64+lane_id_(); asm volatile("":"+v"(tid_));
  const int tid=tid_,lane=tid&63,r32=lane&31,hi=lane>>5; const int wid=__builtin_amdgcn_readfirstlane(tid>>6);
  const long rowbase=(long)b*SEQ; const int q0=qb*QB;
  const bf16*Qw=Q+(rowbase+q0+wid*QBLK)*DM;
  const bf16*Kh=K+rowbase*DM,*Vh=V+rowbase*DM;
  const unsigned*mrow=MASK+(size_t)(rowbase+q0+wid*QBLK+r32)*64;
  #define MLD(tt) mld_asm(mrow+2*(tt))
  const unsigned lds0=(unsigned)(uintptr_t)shm;
  float*wsf=(float*)(shm+LDS_WS)+wid*64;
  const bf16*ksrc=Kh+(long)lane*DM+wid*8;
  const bf16*vsrc=Vh+(long)(16*(wid&3)+(lane>>2))*DM+(wid>>2)*32+(lane&3)*8;
  const unsigned kdst=lds0+LDS_K+wid*1024, vdst=lds0+LDS_V+wid*1024;
  #define DMA_K(t,slot) glds16(ksrc+(long)(t)*KVBLK*DM,(unsigned)__builtin_amdgcn_readfirstlane(kdst+(slot)))
  #define DMA_V(t,slot) glds16(vsrc+(long)(t)*KVBLK*DM,(unsigned)__builtin_amdgcn_readfirstlane(vdst+(slot)))
  const int vb0=(int)(lds0+LDS_V)+((lane>>4)&1)*32+(lane&3)*8+(4*hi+((lane&15)>>2))*64;
  const char*Kbase=shm+LDS_K; bf16x8 kf[8];
  const lds_cptr shm3=(lds_cptr)shm; const lds_cptr kp0=shm3+LDS_K+hi*1024+r32*16; const lds_cptr vp0=shm3+LDS_V+((lane>>4)&1)*32+(lane&3)*8+(4*hi+((lane&15)>>2))*64;
  const int NT=(q0+QB)/KVBLK;
  uint2 mw_cur=make_uint2(~0u,~0u), mw_next=make_uint2(~0u,~0u); if(MASKED){ mw_cur=MLD(0); mw_next=MLD(1); }
  DMA_K(0,0);DMA_V(0,0);DMA_K(1,SLOTB);
  bf16x8 qr[4];
  #pragma unroll
  for(int d0=0;d0<4;++d0)qr[d0]=*reinterpret_cast<const bf16x8*>(&Qw[(long)r32*DM+d0*16+hi*8]);
  float mhat=0.f,l_reg=0.f;f32x16 o[2];o[0]=f32x16{};o[1]=f32x16{};f32x16 negm=f32x16{};asm volatile("":"+v"(negm));
  const int qrel=wid*QBLK+r32;
  #define CMASK(P0,P1,t) do{ if(MASKED){bmask(P0,P1,mw_cur,hi);} else {int jb_=(t)-(NT-4); if(jb_>=0)cmask(P0,P1,jb_,qrel,hi);} }while(0)
  bool resc=false;
  #define START(P0,P1) do{ float rm=rowmax(P0,P1); if(MASKED)rm=max2f(rm,-64.f); resc=false; \
    { const float dl=rm; mhat=fadd_s(mhat,dl); \
      _Pragma("unroll") for(int r=0;r<16;++r){P0[r]=fsub_s(P0[r],dl);P1[r]=fsub_s(P1[r],dl);} \
      _Pragma("unroll") for(int r=0;r<16;++r)negm[r]=-mhat; asm volatile("":"+v"(negm)); } \
    _Pragma("unroll") for(int r=0;r<16;++r)P0[r]=__builtin_amdgcn_exp2f(P0[r]); }while(0)
  #define RESC() do{ if(resc){ asm volatile("s_waitcnt lgkmcnt(0)":::"memory"); \
      _Pragma("unroll") for(int d_=0;d_<2;++d_) _Pragma("unroll") for(int r=0;r<16;++r)o[d_][r]*=wsf[crow(r,hi)]; } }while(0)
  f32x16 pA0,pA1,pB0,pB1;
  int sl_prev=0,sl_cur=0,sl_next=SLOTB;
  #define ROT() do{sl_prev=sl_cur;sl_cur=sl_next;sl_next=(sl_next==(NSLOT-1)*SLOTB)?0:sl_next+SLOTB;}while(0)
  DMA_K(2,2*SLOTB);
  WAIT_BAR(3);
  qkt(pA0,pA1,Kbase,qr,negm,r32,hi);asm volatile("s_nop 15\n\ts_nop 7":"+v"(pA0),"+v"(pA1));CMASK(pA0,pA1,0);
  START(pA0,pA1);
  _Pragma("unroll") for(int r=0;r<16;++r)pA1[r]=__builtin_amdgcn_exp2f(pA1[r]);
  WAIT_BAR(0);
  DMA_K(3,0);DMA_V(1,SLOTB);
  ROT();
  kload8(kf,kp0+sl_cur);
  WAIT_BAR(2);
  s16x4 vlo[8],vhi[8]; u32x4 pw0,pw1,pw2,pw3;
  #define PKW(P,B) cvtpk_s(P[B],P[B+1])
  #define PAF(k) __builtin_bit_cast(bf16x8,pw##k)
  #define VFR(i) (bf16x8){vlo[i][0],vlo[i][1],vlo[i][2],vlo[i][3],vhi[i][0],vhi[i][1],vhi[i][2],vhi[i][3]}
  #define PIN(x) asm volatile("":"+v"(x))
  #define MX3(a,b,c) __builtin_fmaxf(__builtin_fmaxf((a),(b)),(c))
  #define GAPA(MF,A0,A1,A2,A3,W0,W1,PW) do{ MF; sacc+=A0; sacc+=A1; sacc+=A2; sacc+=A3; PIN(sacc); W0; W1; PIN(PW); SBAR(); }while(0)
  #define EX(v) __builtin_amdgcn_exp2f(v)
  #define GAPB(MF,X,B) do{ MF; X[B]=EX(X[B]); X[B+1]=EX(X[B+1]); X[B+2]=EX(X[B+2]); X[B+3]=EX(X[B+3]); PIN(X); SBAR(); }while(0)
  #define VRD(i) do{ vlo[i]=vtr(vp_+(((i)>>2)*4096+((i)&3)*1024)); vhi[i]=vtr(vp_+(((i)>>2)*4096+((i)&3)*1024+512)); }while(0)
  #define KRD(G,j) do{ if(G){ kload2(kf,kp0+sl_next,j); SBAR(); } }while(0)
  #define STEP(C0,C1,P0,P1,t,GK,GV,GL) do{ SBAR(); if(MASKED){ mw_cur=mw_next; if((t)+1<NT) mw_next=MLD((t)+1); } \
    const lds_cptr vp_=vp0+sl_prev; \
    VRD(0); SBAR(); float sacc=(P0[0]+P0[1]); \
    GAPA(C0=__builtin_amdgcn_mfma_f32_32x32x16_bf16(kf[0],qr[0],negm,0,0,0), P0[2],P0[3],P0[4],P0[5],     pw0[0]=PKW(P0,0), pw0[1]=PKW(P0,2), pw0); \
    VRD(4); SBAR(); GAPA(C1=__builtin_amdgcn_mfma_f32_32x32x16_bf16(kf[1],qr[0],negm,0,0,0), P0[6],P0[7],P0[8],P0[9],     pw0[2]=PKW(P0,4), pw0[3]=PKW(P0,6), pw0); \
    VRD(1); SBAR(); GAPA(C0=__builtin_amdgcn_mfma_f32_32x32x16_bf16(kf[2],qr[1],C0,0,0,0),   P0[10],P0[11],P0[12],P0[13], pw1[0]=PKW(P0,8), pw1[1]=PKW(P0,10), pw1); \
    VRD(5); SBAR(); GAPA(C1=__builtin_amdgcn_mfma_f32_32x32x16_bf16(kf[3],qr[1],C1,0,0,0),   P0[14],P0[15],P1[0],P1[1],   pw1[2]=PKW(P0,12),pw1[3]=PKW(P0,14), pw1); \
    VRD(2); SBAR(); GAPA(C0=__builtin_amdgcn_mfma_f32_32x32x16_bf16(kf[4],qr[2],C0,0,0,0),   P1[2],P1[3],P1[4],P1[5],     pw2[0]=PKW(P1,0), pw2[1]=PKW(P1,2), pw2); \
    VRD(6); SBAR(); GAPA(C1=__builtin_amdgcn_mfma_f32_32x32x16_bf16(kf[5],qr[2],C1,0,0,0),   P1[6],P1[7],P1[8],P1[9],     pw2[2]=PKW(P1,4), pw2[3]=PKW(P1,6), pw2); \
    VRD(3); SBAR(); GAPA(C0=__builtin_amdgcn_mfma_f32_32x32x16_bf16(kf[6],qr[3],C0,0,0,0),   P1[10],P1[11],P1[12],P1[13], pw3[0]=PKW(P1,8), pw3[1]=PKW(P1,10), pw3); \
    VRD(7); SBAR(); GAPA(C1=__builtin_amdgcn_mfma_f32_32x32x16_bf16(kf[7],qr[3],C1,0,0,0),   P1[14],P1[15],0.f,0.f,       pw3[2]=PKW(P1,12),pw3[3]=PKW(P1,14), pw3); \
    l_reg+=sacc; \
    if(GK){DMA_K((t)+3,sl_cur);} if(GV){DMA_V((t)+1,sl_next);} \
    CMASK(C0,C1,t); \
    { float a=MX3(C0[0],C0[1],C1[0]),b=MX3(C0[2],C0[3],C1[1]); a=MX3(a,C1[2],C1[3]); \
      _Pragma("unroll") for(int r=4;r<16;r+=4){a=MX3(a,C0[r],C0[r+1]);b=MX3(b,C0[r+2],C0[r+3]);a=MX3(a,C1[r],C1[r+1]);b=MX3(b,C1[r+2],C1[r+3]);} \
      float rm=__builtin_fmaxf(a,b); { auto rr=__builtin_amdgcn_permlane32_swap(__float_as_uint(rm),__float_as_uint(rm),false,false); rm=__builtin_fmaxf(__uint_as_float(rr[0]),__uint_as_float(rr[1])); } \
      resc=false; \
      if(__builtin_expect(__any(rm>(float)THRL),0)){ const float dl=__builtin_fmaxf(rm,0.f); mhat+=dl; \
        _Pragma("unroll") for(int r=0;r<16;++r){C0[r]-=dl;C1[r]-=dl;} \
        _Pragma("unroll") for(int r=0;r<16;++r)negm[r]=-mhat; asm volatile("":"+v"(negm)); \
        const float f=__builtin_amdgcn_exp2f(-dl); l_reg*=f; if(hi==0)wsf[r32]=f; resc=true; } } \
    SBAR(); \
    GAPB(o[0]=__builtin_amdgcn_mfma_f32_32x32x16_bf16(PAF(0),VFR(0),o[0],0,0,0), C0,0); \
    GAPB(o[1]=__builtin_amdgcn_mfma_f32_32x32x16_bf16(PAF(0),VFR(4),o[1],0,0,0), C0,4); \
    KRD(GL,0); GAPB(o[0]=__builtin_amdgcn_mfma_f32_32x32x16_bf16(PAF(1),VFR(1),o[0],0,0,0), C0,8); \
    KRD(GL,1); GAPB(o[1]=__builtin_amdgcn_mfma_f32_32x32x16_bf16(PAF(1),VFR(5),o[1],0,0,0), C0,12); \
    KRD(GL,2); GAPB(o[0]=__builtin_amdgcn_mfma_f32_32x32x16_bf16(PAF(2),VFR(2),o[0],0,0,0), C1,0); \
    KRD(GL,3); GAPB(o[1]=__builtin_amdgcn_mfma_f32_32x32x16_bf16(PAF(2),VFR(6),o[1],0,0,0), C1,4); \
    GAPB(o[0]=__builtin_amdgcn_mfma_f32_32x32x16_bf16(PAF(3),VFR(3),o[0],0,0,0), C1,8); \
    GAPB(o[1]=__builtin_amdgcn_mfma_f32_32x32x16_bf16(PAF(3),VFR(7),o[1],0,0,0), C1,12); \
    }while(0)
  int t=1;
  #undef CMASK
  #define CMASK(P0,P1,t) do{ if(MASKED){bmask(P0,P1,mw_cur,hi);} }while(0)
  for(;t+5<NT;t+=2){
    STEP(pB0,pB1,pA0,pA1,t,true,true,true);     WAIT_BAR(2); RESC(); ROT();
    STEP(pA0,pA1,pB0,pB1,t+1,true,true,true);   WAIT_BAR(2); RESC(); ROT();
  }
  #undef CMASK
  #define CMASK(P0,P1,t) do{ if(MASKED){bmask(P0,P1,mw_cur,hi);} else {int jb_=(t)-(NT-4); if(jb_>=0)cmask(P0,P1,jb_,qrel,hi);} }while(0)
  #define ENDW(tt) do{ if((tt)+3<NT){WAIT_BAR(2);} else if((tt)+2<NT){WAIT_BAR(1);} else {WAIT_BAR(0);} }while(0)
  for(;t+1<NT;t+=2){
    STEP(pB0,pB1,pA0,pA1,t,(t+3<NT),(t+1<NT),(t+1<NT));       ENDW(t);   RESC(); ROT();
    STEP(pA0,pA1,pB0,pB1,t+1,(t+4<NT),(t+2<NT),(t+2<NT));     ENDW(t+1); RESC(); ROT();
  }
  STEP(pB0,pB1,pA0,pA1,NT-1,false,false,false); RESC();
  { float sacc=pB0[0]+pB0[1]; _Pragma("unroll") for(int r=2;r<16;++r)sacc+=pB0[r]; _Pragma("unroll") for(int r=0;r<16;++r)sacc+=pB1[r]; l_reg+=sacc;
    pw0=(u32x4){PKW(pB0,0),PKW(pB0,2),PKW(pB0,4),PKW(pB0,6)};pw1=(u32x4){PKW(pB0,8),PKW(pB0,10),PKW(pB0,12),PKW(pB0,14)};pw2=(u32x4){PKW(pB1,0),PKW(pB1,2),PKW(pB1,4),PKW(pB1,6)};pw3=(u32x4){PKW(pB1,8),PKW(pB1,10),PKW(pB1,12),PKW(pB1,14)};
    SBAR(); pv(o,vb0+sl_cur,PAF(0),PAF(1),PAF(2),PAF(3)); }
  #undef PKW
  #undef PAF
  #undef VFR
  #undef PIN
  #undef MX3
  #undef GAPA
  #undef GAPB
  #undef EX
  #undef VRD
  #undef KRD
  #undef STEP
  #undef ENDW
  {auto rr=__builtin_amdgcn_permlane32_swap(__float_as_uint(l_reg),__float_as_uint(l_reg),false,false);l_reg=__uint_as_float(rr[0])+__uint_as_float(rr[1]);}
  if(hi==0)wsf[32+r32]=l_reg;asm volatile("s_waitcnt lgkmcnt(0)":::"memory");
  float rli[16];
  #pragma unroll
  for(int r=0;r<16;++r)rli[r]=__builtin_amdgcn_rcpf(wsf[32+crow(r,hi)]);
  bf16*Ow=O+(rowbase+q0+wid*QBLK)*DMO;
  { bf16*stg=(bf16*)(shm+LDS_OST)+wid*2048;
    #pragma unroll
    for(int r=0;r<16;++r){const int orow=crow(r,hi);
      #pragma unroll
      for(int d0=0;d0<2;++d0)stg[orow*64+d0*32+r32]=(bf16)f2bf_(o[d0][r]*rli[r]);}
    asm volatile("s_waitcnt lgkmcnt(0)":::"memory");
    #pragma unroll
    for(int i=0;i<4;++i){const int row=i*8+(lane>>3),ch=lane&7; const u32x4 v=*(const u32x4*)(stg+row*64+ch*8); ATTN_STORE16(Ow+(long)row*DMO+ch*8,v);} }
  asm volatile("s_waitcnt lgkmcnt(0)\n\ts_barrier":::"memory");
  #undef DMA_K
  #undef DMA_V
  #undef MLD
  #undef CMASK
  #undef START
  #undef RESC
  #undef ROT
}
constexpr int ATTN_LDS_BYTES=LDS_BYTES;
#undef SBAR
#undef WAIT_BAR
}
#define GAS __attribute__((address_space(1)))
#define LAS __attribute__((address_space(3)))
typedef unsigned short bf16;
typedef unsigned v4u __attribute__((ext_vector_type(4)));
typedef float f32x4 __attribute__((ext_vector_type(4)));
typedef short bf16x8 __attribute__((ext_vector_type(8)));
typedef GAS unsigned gu32;
typedef GAS unsigned long long gu64;
#define RLX_AGENT __ATOMIC_RELAXED, __HIP_MEMORY_SCOPE_AGENT
#define LDS_WAIT() asm volatile("s_waitcnt lgkmcnt(0)" ::: "memory")
#define VM_WAIT() asm volatile("s_waitcnt vmcnt(0)" ::: "memory")
__device__ __forceinline__ unsigned long long rt() { return __builtin_amdgcn_s_memrealtime(); }
__device__ __forceinline__ unsigned f2bf(float f) { unsigned u = __builtin_bit_cast(unsigned, f); return (u + 0x7fffu + ((u >> 16) & 1u)) >> 16; }
__device__ __forceinline__ unsigned pk2(float lo, float hi) { unsigned r; asm("v_cvt_pk_bf16_f32 %0, %1, %2" : "=v"(r) : "v"(lo), "v"(hi)); return r; }
__device__ __forceinline__ int tid_of(int wvx) { return wvx * 64 + lane_id_(); }
__device__ __forceinline__ int bid_() { int b_ = (int)blockIdx.x; asm volatile("" : "+s"(b_)); return b_; }
__device__ __forceinline__ int gsz_() { int g_ = (int)gridDim.x; asm volatile("" : "+s"(g_)); return g_; }
#define XB_TMO      128
#define XB_XCNT(j)  (256  + 64 * (j))
#define XB_XSUB(j)  (1280 + 64 * (j))
#define XB_XGEN(j)  (2304 + 64 * (j))
#define XB_TOP      3328
#define XB_TOPGEN   3392
#define XCD_BAR_WORDS 3456
#define XB_SPIN_CAP (1u << 20)

__device__ __forceinline__ unsigned xb_ld(unsigned* p)              { return __hip_atomic_load(p, __ATOMIC_RELAXED, __HIP_MEMORY_SCOPE_AGENT); }
__device__ __forceinline__ unsigned xb_add(unsigned* p, unsigned v) { return __hip_atomic_fetch_add(p, v, __ATOMIC_RELAXED, __HIP_MEMORY_SCOPE_AGENT); }
__device__ __forceinline__ unsigned xb_xcc_id() { return (unsigned)__builtin_amdgcn_s_getreg((3 << 11) | 20) & 0xFu; }
#define XB_SPIN(cond, bar) do { unsigned _sp = 0; while (cond) { __builtin_amdgcn_s_sleep(1); \
    if ((++_sp & 255u) == 0u) { if (xb_ld(&(bar)[XB_TMO])) break; if (_sp > XB_SPIN_CAP) { atomicAdd(&(bar)[XB_TMO], 1u); break; } } } } while (0)

struct XcdBarrier {
    unsigned* bar; unsigned x;
    volatile LAS unsigned* st;
};

__device__ __forceinline__ XcdBarrier xcd_barrier_post(unsigned* bar, volatile LAS unsigned* st) {
    XcdBarrier b; b.bar = bar; b.x = xb_xcc_id(); b.st = st;
    if (threadIdx.x == 0) (void)xb_add(&bar[XB_XCNT(b.x)], 1u);
    return b;
}
__device__ __forceinline__ void xcd_barrier_complete(unsigned* bar, unsigned x, unsigned& nloc, unsigned& nx) {
    const unsigned G = gridDim.x * gridDim.y * gridDim.z;
    unsigned sum, cnt, mine, sp = 0u;
    for (;;) {
        sum = 0u; cnt = 0u; mine = 0u;
#pragma unroll
        for (unsigned j = 0; j < 16; ++j) { const unsigned c = xb_ld(&bar[XB_XCNT(j)]); sum += c; cnt += (c > 0u) ? 1u : 0u; mine = (j == x) ? c : mine; }
        if (sum == G) break;
        __builtin_amdgcn_s_sleep(1);
        if ((++sp & 255u) == 0u) { if (xb_ld(&bar[XB_TMO])) break; if (sp > XB_SPIN_CAP) { atomicAdd(&bar[XB_TMO], 1u); break; } }
    }
    nloc = mine > 0u ? mine : 1u; nx = cnt > 0u ? cnt : 1u;
}

__device__ __attribute__((noinline)) void xcd_barrier_fn(unsigned* bar_, unsigned x_, volatile LAS unsigned* st_, bool leader_) {
    XcdBarrier b; b.bar = bar_; b.x = x_; b.st = st_;
    asm volatile("s_waitcnt vmcnt(0)" ::: "memory");
    __syncthreads();
    if (leader_) {
        unsigned* bar = b.bar;
        __builtin_amdgcn_s_waitcnt(0);
        unsigned nloc = b.st[0], nx = b.st[1];
        if (nloc == 0u) { xcd_barrier_complete(bar, b.x, nloc, nx); b.st[0] = nloc; b.st[1] = nx; }
        const unsigned old = xb_add(&bar[XB_XSUB(b.x)], 1u);
        const unsigned gen = old / nloc;
        if (old + 1u == (gen + 1u) * nloc) {
            __builtin_amdgcn_fence(__ATOMIC_RELEASE, "agent");
            asm volatile("s_waitcnt vmcnt(0)" ::: "memory");
            const unsigned og = xb_add(&bar[XB_TOP], 1u);
            const unsigned tg = og / nx;
            if (og + 1u == (tg + 1u) * nx) xb_add(&bar[XB_TOPGEN], 1u);
            else XB_SPIN(xb_ld(&bar[XB_TOPGEN]) == tg, bar);
            __builtin_amdgcn_fence(__ATOMIC_ACQUIRE, "agent");
            xb_add(&bar[XB_XGEN(b.x)], 1u);
            asm volatile("s_waitcnt vmcnt(0)" ::: "memory");
        } else {
            XB_SPIN(xb_ld(&bar[XB_XGEN(b.x)]) == gen, bar);
            __builtin_amdgcn_fence(__ATOMIC_ACQUIRE, "agent");
            asm volatile("s_waitcnt vmcnt(0)" ::: "memory");
        }
    }
    __syncthreads();
}


constexpr int NB = 16, SEQ = 2048, T = NB * SEQ, D = 1024, DEPTH = 4, NHC = 4096, NEXP = 32, NWAVES = 8;
constexpr int NIN = 3920;
constexpr float LN_EPS = 1e-5f, DN_ALPHA = 1.6817928305074290f;
constexpr int RPAD = T * 4 + NEXP * 256;
constexpr int HC_MQ = 0, HC_MK = 256, HC_MV = 512, HC_MO = 768, HC_DQ = 1024, HC_DK = 1536, HC_DV = 2048, HC_SQ = 2560, HC_SK = 2816, HC_SV = 3072, HC_XQ = 3328, HC_XK = 3840, HC_MI = 3904, HC_MF = 3908, HC_XW = 3912;
constexpr size_t MiB = 1u << 20;
constexpr size_t WS_CTL = 0, CTL_ZERO_BYTES = 128 * 1024;
constexpr size_t WS_MOD = 2 * MiB;
constexpr size_t WS_LAM = WS_MOD + 7 * MiB / 4;
constexpr size_t WS_RWT = 4 * MiB;
constexpr size_t WS_CS = 8 * MiB;
constexpr size_t WS_WIN = 16 * MiB;
constexpr size_t WS_WOUT = 48 * MiB;
constexpr size_t WS_W1 = 64 * MiB;
constexpr size_t WS_W2 = 576 * MiB;
constexpr size_t WS_XB = 832 * MiB;
constexpr size_t WS_U = 960 * MiB;
constexpr size_t WS_H = 1024 * MiB;
constexpr size_t WS_QKC = 1280 * MiB;
constexpr size_t WS_XKP = 1312 * MiB;
constexpr size_t WS_MASK = 1316 * MiB;
constexpr size_t WS_TOK = 1324 * MiB;
constexpr size_t WS_CS16 = 1328 * MiB;
constexpr size_t WS_MIX = 1344 * MiB;
constexpr size_t WS_Y = 1408 * MiB;
constexpr size_t WS_SC = 1472 * MiB;
constexpr size_t WS_XG = 1728 * MiB;
constexpr size_t WS_HM = 2000 * MiB;
constexpr size_t WS_YM = 2272 * MiB;
constexpr size_t WS_END = 2544 * MiB;
constexpr int CW_CNT = 1024;
constexpr int CW_BAR = 16384;
constexpr int RING_BYTES = 131072, TAB_OFF = RING_BYTES, LDS_BYTES = 147456, MISC_OFF = LDS_BYTES - 256;
constexpr int NPH = 10, NSTEPS = 2 + NPH * DEPTH;
enum { PH_IN = 0, PH_POST, PH_MIXA, PH_SEL, PH_DSA, PH_OUT, PH_ROW1, PH_G1, PH_G2, PH_ROW2 };

typedef unsigned short us8 __attribute__((ext_vector_type(8)));
__device__ __forceinline__ float bf2f(bf16 h) { return __uint_as_float((unsigned)h << 16); }
#define DPPF(x, c) __int_as_float(__builtin_amdgcn_update_dpp(0, __float_as_int(x), c, 0xF, 0xF, true))
__device__ __forceinline__ float wave_sum(float v) {
    v += DPPF(v, 0xB1); v += DPPF(v, 0x4E); v += DPPF(v, 0x141); v += DPPF(v, 0x140);
    return (__int_as_float(__builtin_amdgcn_readlane(__float_as_int(v), 0)) + __int_as_float(__builtin_amdgcn_readlane(__float_as_int(v), 16))) + (__int_as_float(__builtin_amdgcn_readlane(__float_as_int(v), 32)) + __int_as_float(__builtin_amdgcn_readlane(__float_as_int(v), 48)));
}
__device__ __forceinline__ float wave_max(float v) {
    v = fmaxf(v, DPPF(v, 0xB1)); v = fmaxf(v, DPPF(v, 0x4E)); v = fmaxf(v, DPPF(v, 0x141)); v = fmaxf(v, DPPF(v, 0x140));
    return fmaxf(fmaxf(__int_as_float(__builtin_amdgcn_readlane(__float_as_int(v), 0)), __int_as_float(__builtin_amdgcn_readlane(__float_as_int(v), 16))), fmaxf(__int_as_float(__builtin_amdgcn_readlane(__float_as_int(v), 32)), __int_as_float(__builtin_amdgcn_readlane(__float_as_int(v), 48))));
}
__device__ __forceinline__ float shx(float v, int lane, int m) { return __int_as_float(__builtin_amdgcn_ds_bpermute((lane ^ m) << 2, __float_as_int(v))); }
__device__ __forceinline__ int shxi(int v, int lane, int m) { return __builtin_amdgcn_ds_bpermute((lane ^ m) << 2, v); }
__device__ __forceinline__ float shup(float v, int lane, int o) { return __int_as_float(__builtin_amdgcn_ds_bpermute(((lane - o) & 63) << 2, __float_as_int(v))); }
__device__ __forceinline__ int shupi(int v, int lane, int o) { return __builtin_amdgcn_ds_bpermute(((lane - o) & 63) << 2, v); }
__device__ __forceinline__ float sigmoidf_(float x) { return 1.0f / (1.0f + __expf(-x)); }
struct Ctx {
    LAS unsigned char* lds;
    int tid, lane, wave, gw, ngw;
    const float* in[25];
    float* out; unsigned char* ws;
};
#define WSP(type, off) ((type*)(C.ws + (off)))
enum { I_X = 0, I_C, I_POS, I_WIN, I_GATEB, I_CONVW, I_CONVB, I_MNORM, I_DFLAM, I_DFNORM, I_IDXG, I_IDXB, I_WOUT, I_ADAW, I_ADAB, I_LN1G, I_LN1B, I_LN2G, I_LN2B, I_RW, I_RB, I_W1, I_B1, I_W2, I_B2 };

__device__ __forceinline__ int in_dest_col(int n) {
    auto rp = [](int j) { const int hd = j >> 6, d = j & 63; return hd * 64 + ((d < 32) ? 2 * d : 2 * (d - 32) + 1); };
    if (n < 256) return HC_MQ + n;
    if (n < 512) return HC_MK + (n - 256);
    if (n < 768) return HC_MV + (n - 512);
    if (n < 772) return HC_MI + (n - 768);
    if (n < 776) return HC_MF + (n - 772);
    if (n < 1032) return HC_MO + (n - 776);
    if (n < 1544) return HC_DQ + rp(n - 1032);
    if (n < 2056) return HC_DK + rp(n - 1544);
    if (n < 2568) return HC_DV + (n - 2056);
    if (n < 2824) return HC_SQ + rp(n - 2568);
    if (n < 3080) return HC_SK + rp(n - 2824);
    if (n < 3336) return HC_SV + (n - 3080);
    if (n < 3848) return HC_XQ + rp(n - 3336);
    if (n < 3912) return HC_XK + (n - 3848);
    return HC_XW + (n - 3912);
}
template <class F> __device__ __forceinline__ void transpose_item(const float* W, int ldw, int K, int nvalid, int k0, int n0, bf16* WT, LAS float* scr, int lane, F drow) {
    const int nn = n0 + (lane & 31); const bool ok = nn < nvalid;
    float tv_[32];
#pragma unroll
    for (int i = 0; i < 32; ++i) { const int kk = 2 * i + (lane >> 5); tv_[i] = ok ? W[(size_t)(k0 + kk) * ldw + nn] : 0.f; }
#pragma unroll
    for (int i = 0; i < 32; ++i) { const int kk = 2 * i + (lane >> 5); scr[kk * 33 + (lane & 31)] = tv_[i]; }
    LDS_WAIT(); asm volatile("" ::: "memory");
    const int c = lane & 7;
#pragma unroll
    for (int j = 0; j < 4; ++j) { const int n = (lane >> 3) + 8 * j; const LAS float* s = scr + (8 * c) * 33 + n;
        v4u o; o.x = pk2(s[0 * 33], s[1 * 33]); o.y = pk2(s[2 * 33], s[3 * 33]); o.z = pk2(s[4 * 33], s[5 * 33]); o.w = pk2(s[6 * 33], s[7 * 33]);
        if (n0 + n < nvalid) *(GAS v4u*)(WT + (size_t)drow(n0 + n) * K + k0 + 8 * c) = o; }
    LDS_WAIT(); asm volatile("" ::: "memory");
}

template <class F> __device__ __forceinline__ void transpose_item_f8(const float* W, int ldw, int K, int nvalid, int k0, int n0, unsigned char* WT8, LAS float* scr, int lane, float sc, F drow) {
    const int nn = n0 + (lane & 31); const bool ok = nn < nvalid;
    float tv_[32];
#pragma unroll
    for (int i = 0; i < 32; ++i) { const int kk = 2 * i + (lane >> 5); tv_[i] = ok ? W[(size_t)(k0 + kk) * ldw + nn] : 0.f; }
#pragma unroll
    for (int i = 0; i < 32; ++i) { const int kk = 2 * i + (lane >> 5); scr[kk * 33 + (lane & 31)] = tv_[i]; }
    LDS_WAIT(); asm volatile("" ::: "memory");
    const int c = lane & 7;
#pragma unroll
    for (int j = 0; j < 4; ++j) { const int n = (lane >> 3) + 8 * j; const LAS float* s = scr + (8 * c) * 33 + n;
        typedef unsigned u32x2_ __attribute__((ext_vector_type(2))); u32x2_ o; o.x = pg8::pk4_fp8(s[0 * 33], s[1 * 33], s[2 * 33], s[3 * 33], sc); o.y = pg8::pk4_fp8(s[4 * 33], s[5 * 33], s[6 * 33], s[7 * 33], sc);
        if (n0 + n < nvalid) *(GAS u32x2_*)(WT8 + (size_t)drow(n0 + n) * K + k0 + 8 * c) = o; }
    LDS_WAIT(); asm volatile("" ::: "memory");
}
struct Args { const float* in[25]; float* out; unsigned char* ws; int s_lo, s_hi, li, pad; };
typedef __attribute__((address_space(4))) const Args CArgs;
__device__ __forceinline__ CArgs* kargs() { CArgs* p = (CArgs*)__builtin_amdgcn_kernarg_segment_ptr(); asm volatile("" : "+s"(p)); return p; }
__device__ __forceinline__ LAS unsigned char* lds_launder(LAS unsigned char* q) { unsigned v = (unsigned)(size_t)q; asm volatile("" : "+s"(v)); return (LAS unsigned char*)(size_t)v; }
#define WS(type, off) ((type*)(A->ws + (off)))
#define TIDX CArgs* A = kargs(); int tid_ = tid_of(wvx); asm volatile("" : "+v"(tid_)); const int tid = tid_, lane = tid & 63, wave = __builtin_amdgcn_readfirstlane(tid >> 6); const int bidx = bid_(), gsz = gsz_(); const int gw = bidx * NWAVES + wave, ngw = gsz * NWAVES; (void)bidx; (void)gsz; (void)lane; (void)gw; (void)ngw

#ifndef PRORPT
#define PRORPT 0u
#endif
#define PRPT(b) _Pragma("unroll 1") for (int prep_ = 0; prep_ < ((((PRORPT) >> (b)) & 1u) ? 2 : 1); ++prep_)
__device__ __forceinline__ void pro_a(LAS unsigned char* lds, int wvx) {
    TIDX;
    LAS float* scr = (LAS float*)(lds + wave * 16384);
    constexpr int IT_IN = 16 * 123, IT_OUT = 16 * 32, IT_W1 = 16 * 64, IT_W2 = 16 * 32;
    constexpr int N_IN = DEPTH * IT_IN, N_OUT = DEPTH * IT_OUT, N_W1 = DEPTH * NEXP * IT_W1, N_W2 = DEPTH * NEXP * IT_W2;
    constexpr int NITEMS = N_IN + N_OUT;
    PRPT(0) for (int it = gw; it < NITEMS; it += ngw) {
        int r = it;
        if (r < N_IN) { const int l = r / IT_IN, q = r % IT_IN, kb = q / 123, nb = q % 123;
#ifdef INPROJ_F8
            transpose_item_f8(A->in[I_WIN] + (size_t)l * D * NIN, NIN, D, NIN, kb * 64, nb * 32, WS(unsigned char, WS_WIN) + (size_t)l * NHC * D, scr, lane, 256.0f, [](int n) { return in_dest_col(n); }); continue; }
#else
            transpose_item(A->in[I_WIN] + (size_t)l * D * NIN, NIN, D, NIN, kb * 64, nb * 32, WS(bf16, WS_WIN) + (size_t)l * NHC * D, scr, lane, [](int n) { return in_dest_col(n); }); continue; }
#endif
        r -= N_IN;
        { const int l = r / IT_OUT, q = r % IT_OUT, kb = q / 32, nb = q % 32;
            transpose_item(A->in[I_WOUT] + (size_t)l * D * D, D, D, D, kb * 64, nb * 32, WS(bf16, WS_WOUT) + (size_t)l * D * D, scr, lane, [](int n) { return n; }); }
    }
    PRPT(1) {
        constexpr int JW1 = 8 * 8, JW2 = 8 * 4, M_W1 = DEPTH * NEXP * JW1, M_W2 = DEPTH * NEXP * JW2, NX = M_W1 + M_W2;
        constexpr int XPITCH = 144, XTILE = 256 * XPITCH;
        __syncthreads();
        f32x4 tv_[16];
        const float* src_n = nullptr; unsigned char* dst_n = nullptr; int ldw_n = 0, k0_n = 0, n0_n = 0; bool w1_n = false;
        auto decode = [&](int r) {
            w1_n = r < M_W1;
            if (w1_n) { const int le = r / JW1, q = r % JW1; k0_n = (q / 8) * 128; n0_n = (q % 8) * 256; ldw_n = 2048; src_n = A->in[I_W1] + (size_t)le * D * 2048; dst_n = WS(unsigned char, WS_W1) + (size_t)le * 2048 * D; }
            else { r -= M_W1; const int le = r / JW2, q = r % JW2; k0_n = (q / 4) * 128; n0_n = (q % 4) * 256; ldw_n = D; src_n = A->in[I_W2] + (size_t)le * D * D; dst_n = WS(unsigned char, WS_W2) + (size_t)le * D * D; }
        };
        int it = bidx, buf = 0;
        if (it < NX) { decode(it); const float* sp = src_n + (size_t)(k0_n + 16 * wave) * ldw_n + n0_n + 4 * lane;
#pragma unroll
            for (int r = 0; r < 16; ++r) tv_[r] = *(const GAS f32x4*)(sp + (size_t)r * ldw_n); }
#pragma unroll 1
        while (it < NX) {
            LAS unsigned char* tile = lds + buf * XTILE;
#pragma unroll
            for (int j = 0; j < 4; ++j) { v4u o;
                o.x = pg8::pk4_fp8(tv_[0][j], tv_[1][j], tv_[2][j], tv_[3][j], 256.0f); o.y = pg8::pk4_fp8(tv_[4][j], tv_[5][j], tv_[6][j], tv_[7][j], 256.0f);
                o.z = pg8::pk4_fp8(tv_[8][j], tv_[9][j], tv_[10][j], tv_[11][j], 256.0f); o.w = pg8::pk4_fp8(tv_[12][j], tv_[13][j], tv_[14][j], tv_[15][j], 256.0f);
                *(LAS v4u*)(tile + (j * 64 + lane) * XPITCH + 16 * wave) = o; }
            unsigned char* const dst = dst_n; const int k0 = k0_n, n0 = n0_n; const bool w1 = w1_n;
            it += gsz;
            if (it < NX) { decode(it); const float* sp = src_n + (size_t)(k0_n + 16 * wave) * ldw_n + n0_n + 4 * lane;
#pragma unroll
                for (int r = 0; r < 16; ++r) tv_[r] = *(const GAS f32x4*)(sp + (size_t)r * ldw_n); }
            asm volatile("s_waitcnt lgkmcnt(0)\n\ts_barrier" ::: "memory");
#pragma unroll
            for (int rr = 0; rr < 4; ++rr) { const int idx = rr * 512 + tid, sl = idx >> 3, seg = idx & 7; const int n = n0 + (sl & 63) * 4 + (sl >> 6);
                const v4u v = *(const LAS v4u*)(tile + sl * XPITCH + 16 * seg);
                const int up = n >> 10, jj = n & 1023; const int j8 = n & 255;
                const int drow = w1 ? ((jj >> 7) * 256 + up * 128 + (jj & 127)) : ((n & ~255) + ((j8 >> 3) & 1) * 128 + (j8 >> 6) * 32 + ((j8 >> 4) & 3) * 8 + (j8 & 7));
                *(GAS v4u*)(dst + (size_t)drow * D + k0 + 16 * seg) = v; }
            buf ^= 1;
        }
        __syncthreads();
    }
    for (int r = gw; r < DEPTH * (NHC - NIN); r += ngw) { const int l = r / (NHC - NIN), row = NIN + r % (NHC - NIN);
#ifdef INPROJ_F8
        GAS v4u* p = (GAS v4u*)(WS(unsigned char, WS_WIN) + ((size_t)l * NHC + row) * D) + lane; p[0] = (v4u){0u, 0u, 0u, 0u}; }
#else
        GAS v4u* p = (GAS v4u*)(WS(bf16, WS_WIN) + ((size_t)l * NHC + row) * D) + lane; p[0] = (v4u){0u, 0u, 0u, 0u}; p[64] = (v4u){0u, 0u, 0u, 0u}; }
#endif
    PRPT(2) for (int idx = bidx * 512 + tid; idx < T * 32; idx += gsz * 512) {
        const int tok = idx >> 5, i = idx & 31;
        const double inv = exp(-(double)i * (9.210340371976184 / 32.0));
        const double ang = (double)((const int*)A->in[I_POS])[tok] * inv;
        const double rev = ang * 0.15915494309189535;
        const float fr = (float)(rev - rint(rev));
        float2 v; v.x = __builtin_amdgcn_cosf(fr); v.y = __builtin_amdgcn_sinf(fr);
        WS(float2, WS_CS)[idx] = v;
        { const _Float16 hc = (_Float16)v.x, hs = (_Float16)v.y; WS(unsigned, WS_CS16)[idx] = (unsigned)__builtin_bit_cast(unsigned short, hc) | ((unsigned)__builtin_bit_cast(unsigned short, hs) << 16); }
    }
    for (int idx = bidx * 512 + tid; idx < DEPTH * NEXP * D; idx += gsz * 512) {
        const int l = idx / (NEXP * D), r = idx % (NEXP * D), e = r / D, d = r % D;
        WS(float, WS_RWT)[idx] = A->in[I_RW][((size_t)l * D + d) * NEXP + e];
    }
    if (bidx == 0 && wave == 0) {
        for (int l = 0; l < DEPTH; ++l) { const float* lf = A->in[I_DFLAM] + l * 256;
            const float a = wave_sum(lf[lane] * lf[64 + lane]), b = wave_sum(lf[128 + lane] * lf[192 + lane]);
            if (lane == 0) WS(float, WS_LAM)[l] = __expf(a) - __expf(b) + (0.8f - 0.6f * __expf(-0.3f * (float)l)); }
    }
    __syncthreads();
    PRPT(3) {
        LAS float* ca = (LAS float*)lds;
        LAS float* part = (LAS float*)(lds + 65536);
        for (int i = tid; i < NB * D; i += 512) { const float v = A->in[I_C][i]; ca[(i & (D - 1)) * NB + (i >> 10)] = v / (1.0f + __expf(-v)); }
        __syncthreads();
#pragma unroll 1
        for (int cg = bidx; cg < (DEPTH * 6144) / 96; cg += gsz) {
            const int l = cg >> 6, m0 = (cg & 63) * 96;
            const int r = lane >> 5, cl = lane & 31;
            const float* w = A->in[I_ADAW] + (size_t)l * D * 6144 + m0 + cl + (size_t)(wave * 128 + r) * 6144;
            const LAS float* cp = ca + (wave * 128 + r) * NB;
            float acc[NB][3];
#pragma unroll
            for (int b = 0; b < NB; ++b) { acc[b][0] = 0.f; acc[b][1] = 0.f; acc[b][2] = 0.f; }
#pragma unroll 4
            for (int i = 0; i < 64; ++i) {
                const float w0 = w[(size_t)i * 2 * 6144], w1_ = w[(size_t)i * 2 * 6144 + 32], w2_ = w[(size_t)i * 2 * 6144 + 64];
                const LAS f32x4* c4 = (const LAS f32x4*)(cp + i * 2 * NB);
#pragma unroll
                for (int q = 0; q < 4; ++q) { const f32x4 cv = c4[q];
                    acc[4 * q + 0][0] += cv.x * w0; acc[4 * q + 0][1] += cv.x * w1_; acc[4 * q + 0][2] += cv.x * w2_;
                    acc[4 * q + 1][0] += cv.y * w0; acc[4 * q + 1][1] += cv.y * w1_; acc[4 * q + 1][2] += cv.y * w2_;
                    acc[4 * q + 2][0] += cv.z * w0; acc[4 * q + 2][1] += cv.z * w1_; acc[4 * q + 2][2] += cv.z * w2_;
                    acc[4 * q + 3][0] += cv.w * w0; acc[4 * q + 3][1] += cv.w * w1_; acc[4 * q + 3][2] += cv.w * w2_; }
            }
#pragma unroll
            for (int b = 0; b < NB; ++b) {
#pragma unroll
                for (int j = 0; j < 3; ++j) { const float v = acc[b][j] + shx(acc[b][j], lane, 32); if (r == 0) part[(wave * NB + b) * 96 + 32 * j + cl] = v; } }
            __syncthreads();
            for (int idx = tid; idx < NB * 96; idx += 512) { const int b = idx / 96, j = idx % 96; float v = A->in[I_ADAB][l * 6144 + m0 + j];
#pragma unroll
                for (int wv_ = 0; wv_ < NWAVES; ++wv_) v += part[(wv_ * NB + b) * 96 + j];
                WS(float, WS_MOD)[((size_t)l * NB + b) * 6144 + m0 + j] = v; }
            __syncthreads();
        }
    }
}
__device__ __forceinline__ void pro_b(int wvx) {
    TIDX;
    for (int tok = gw; tok < T; tok += ngw) {
        const int b = tok / SEQ; const float* mod = WS(float, WS_MOD) + (size_t)b * 6144;
        const GAS f32x4* xr = (const GAS f32x4*)(A->in[I_X] + (size_t)tok * D) + lane;
        GAS unsigned long long* o8 = (GAS unsigned long long*)(WS(bf16, WS_U) + (size_t)tok * D) + lane;
#pragma unroll
        for (int j = 0; j < 4; ++j) { const f32x4 x = xr[64 * j]; const f32x4 sh = *(const f32x4*)(mod + 4 * lane + 256 * j), sc = *(const f32x4*)(mod + 1024 + 4 * lane + 256 * j);
            const f32x4 u = x * (1.0f + sc) + sh;
            ((GAS unsigned long long*)(WS(bf16, WS_XB) + (size_t)tok * D) + lane)[64 * j] = (unsigned long long)pk2(x.x, x.y) | ((unsigned long long)pk2(x.z, x.w) << 32);
#ifdef INPROJ_F8
            ((GAS unsigned*)(WS(unsigned char, WS_U) + (size_t)tok * D) + lane)[64 * j] = pg8::pk4_fp8(u.x, u.y, u.z, u.w, 16.0f); }
#else
            o8[64 * j] = (unsigned long long)pk2(u.x, u.y) | ((unsigned long long)pk2(u.z, u.w) << 32); }
#endif
    }
}
__device__ __forceinline__ void ph_post(int l, int wvx) {
    TIDX;
    const bf16* H = WS(bf16, WS_H); bf16* XKP = WS(bf16, WS_XKP); bf16* QKC = WS(bf16, WS_QKC);
    const float* cw = A->in[I_CONVW] + (size_t)l * 4 * 512; const float* cb = A->in[I_CONVB] + (size_t)l * 512;
    const float gi = A->in[I_IDXG][l * 64 + lane], bi = A->in[I_IDXB][l * 64 + lane];
    float cwr[4][8], cbr[8];
#pragma unroll
    for (int c = 0; c < 8; ++c) { cbr[c] = cb[8 * lane + c];
#pragma unroll
        for (int j = 0; j < 4; ++j) cwr[j][c] = cw[j * 512 + 8 * lane + c]; }
    bf16 nxk = 0; float2 ncs = make_float2(1.f, 0.f); v4u nraw[4];
#define POST_LOAD(tk) do { const int s_ = (tk) % SEQ; nxk = H[(size_t)(tk) * NHC + HC_XK + lane]; ncs = WS(float2, WS_CS)[(size_t)(tk) * 32 + (lane & 31)]; \
        _Pragma("unroll") for (int j = 0; j < 4; ++j) { nraw[j] = (v4u){0u, 0u, 0u, 0u}; if (s_ - 3 + j >= 0) nraw[j] = *(const GAS v4u*)(H + (size_t)((tk) - 3 + j) * NHC + 8 * lane); } } while (0)
    if (gw < T) POST_LOAD(gw);
    for (int tok = gw; tok < T; tok += ngw) {
        const bf16 cxk = nxk; const float2 cs = ncs; v4u craw[4];
#pragma unroll
        for (int j = 0; j < 4; ++j) craw[j] = nraw[j];
        if (tok + ngw < T) POST_LOAD(tok + ngw);
        {
            const float v = bf2f(cxk);
            const float mean = wave_sum(v) * (1.0f / 64.0f); const float dv = v - mean;
            const float var = wave_sum(dv * dv) * (1.0f / 64.0f);
            const float nv = dv * (1.0f / sqrtf(var + LN_EPS)) * gi + bi;
            const float pv = shx(nv, lane, 32);
            const int i = lane & 31;
            const float o = (lane < 32) ? (nv * cs.x - pv * cs.y) : (nv * cs.x + pv * cs.y);
            XKP[(size_t)tok * 64 + 2 * i + (lane >> 5)] = (bf16)f2bf(o);
        }
        {
            const int c0 = 8 * lane;
            float acc[8];
#pragma unroll
            for (int c = 0; c < 8; ++c) acc[c] = cbr[c];
#pragma unroll
            for (int j = 0; j < 4; ++j) {
                const unsigned rw[4] = {craw[j].x, craw[j].y, craw[j].z, craw[j].w};
#pragma unroll
                for (int c = 0; c < 8; ++c) { const float x = __uint_as_float((c & 1) ? (rw[c >> 1] & 0xffff0000u) : (rw[c >> 1] << 16)); acc[c] += cwr[j][c] * x; }
            }
            v4u o;
#define SILU(x) ((x) / (1.0f + __expf(-(x))))
            o.x = pk2(SILU(acc[0]), SILU(acc[1])); o.y = pk2(SILU(acc[2]), SILU(acc[3])); o.z = pk2(SILU(acc[4]), SILU(acc[5])); o.w = pk2(SILU(acc[6]), SILU(acc[7]));
#undef SILU
            *(GAS v4u*)(QKC + (size_t)tok * 512 + c0) = o;
        }
    }
#undef POST_LOAD
}
typedef float f32x16 __attribute__((ext_vector_type(16)));
__device__ __forceinline__ void select_load(const float* SC, int tok, int lane, f32x4 (&raw)[8]);
__device__ __forceinline__ void select_row(const f32x4 (&raw)[8], unsigned* MASK, int tok, int lane);
__device__ __forceinline__ void ph_idx_scores(LAS unsigned char* lds, int wvx) {
    TIDX;
    const bf16* H = WS(bf16, WS_H); const bf16* XKP = WS(bf16, WS_XKP); float* SC = WS(float, WS_SC); unsigned* MASK = WS(unsigned, WS_MASK);
    const int r = lane & 31, hh = lane >> 5, ql = r >> 3, hd = r & 7;
    constexpr int KP = 144;
    LAS unsigned char* kt = lds;
    const int skey = tid >> 3, sch = tid & 7;
    for (int item = bidx; item < 256; item += gsz) {
        const int b = item >> 4, p = item & 15;
#pragma unroll 1
        for (int sub = 0; sub < 2; ++sub) {
            const int qblk = sub ? 31 - p : p, q0 = qblk * 64 + 8 * wave, tok0 = b * SEQ + q0;
            bf16x8 af[2][4];
#pragma unroll
            for (int g = 0; g < 2; ++g) { const bf16* ap = H + (size_t)(tok0 + 4 * g + ql) * NHC + HC_XQ + hd * 64 + 8 * hh;
#pragma unroll
              for (int ks = 0; ks < 4; ++ks) af[g][ks] = *(const GAS bf16x8*)(ap + ks * 16); }
            float wv[2][4][4];
#pragma unroll
            for (int g = 0; g < 2; ++g)
#pragma unroll
                for (int q = 0; q < 4; ++q)
#pragma unroll
                    for (int i = 0; i < 4; ++i) wv[g][q][i] = bf2f(H[(size_t)(tok0 + 4 * g + q) * NHC + HC_XW + 4 * hh + i]);
            const int npair = qblk + 1;
            const bf16* ksrc = XKP + (size_t)(b * SEQ + skey) * 64 + 8 * sch;
            __syncthreads();
            { const v4u t0 = *(const GAS v4u*)ksrc; *(LAS v4u*)(kt + skey * KP + 16 * sch) = t0; }
            v4u stg = (v4u){0u, 0u, 0u, 0u};
            if (npair > 1) stg = *(const GAS v4u*)(ksrc + 4096);
            __syncthreads();
            for (int pr = 0; pr < npair; ++pr) {
                const LAS unsigned char* kb = kt + (pr & 1) * (64 * KP);
                bf16x8 bc[2][4];
#pragma unroll
                for (int t2 = 0; t2 < 2; ++t2)
#pragma unroll
                    for (int ks = 0; ks < 4; ++ks) bc[t2][ks] = *(const LAS bf16x8*)(kb + (32 * t2 + r) * KP + 32 * ks + 16 * hh);
                v4u stg2 = (v4u){0u, 0u, 0u, 0u};
                if (pr + 2 < npair) stg2 = *(const GAS v4u*)(ksrc + (size_t)(pr + 2) * 4096);
#pragma unroll
                for (int t2 = 0; t2 < 2; ++t2) {
                    const int key = pr * 64 + t2 * 32 + r;
#pragma unroll
                    for (int g = 0; g < 2; ++g) {
                        f32x16 acc = {};
#pragma unroll
                        for (int ks = 0; ks < 4; ++ks) acc = __builtin_amdgcn_mfma_f32_32x32x16_bf16(af[g][ks], bc[t2][ks], acc, 0, 0, 0);
                        float tot[4];
#pragma unroll
                        for (int q = 0; q < 4; ++q) { float pp = 0.f;
#pragma unroll
                            for (int i = 0; i < 4; ++i) pp += wv[g][q][i] * fmaxf(acc[4 * q + i], 0.f);
                            tot[q] = pp + shx(pp, lane, 32); }
                        const float o0 = hh ? tot[2] : tot[0], o1 = hh ? tot[3] : tot[1];
                        SC[(size_t)(tok0 + 4 * g + 2 * hh) * SEQ + key] = o0; SC[(size_t)(tok0 + 4 * g + 2 * hh + 1) * SEQ + key] = o1;
                    }
                }
                if (pr + 1 < npair) *(LAS v4u*)(kt + ((pr + 1) & 1) * (64 * KP) + skey * KP + 16 * sch) = stg;
                stg = stg2;
                __syncthreads();
            }
            asm volatile("s_waitcnt vmcnt(0)" ::: "memory"); __builtin_amdgcn_fence(__ATOMIC_ACQUIRE, "agent"); asm volatile("s_waitcnt vmcnt(0)" ::: "memory");
            { f32x4 rawc[8], rawn[8]; select_load(SC, tok0, lane, rawc);
#pragma unroll 1
              for (int q = 0; q < 8; ++q) { if (q + 1 < 8) select_load(SC, tok0 + q + 1, lane, rawn);
                  select_row(rawc, MASK, tok0 + q, lane);
#pragma unroll
                  for (int j = 0; j < 8; ++j) rawc[j] = rawn[j]; } }
        }
    }
}
constexpr size_t WS_OD = WS_END;
constexpr size_t WS_END2 = WS_END + 64 * MiB;
__device__ __forceinline__ void ph_diff_attn(LAS unsigned char* lds, int wvx) {
    CArgs* A = kargs();
    const int G = gsz_(), bx = bid_(), vcu = (G % 8 == 0) ? (bx % 8) * (G / 8) + bx / 8 : bx;
    const bf16* H = WS(bf16, WS_H); bf16* OD = WS(bf16, WS_OD);
    for (int item = vcu; item < NB * 16; item += G) {
        const int b = item >> 4, vh = item & 15, g = vh >> 1, half = vh & 1;
#pragma unroll 1
        for (int qb = 7; qb >= 0; --qb)
            attn_body::attn_unit<8, false>(wvx, b, qb, H + HC_DQ + g * 64, H + HC_DK + g * 64, H + HC_DV + (g >> 1) * 128 + half * 64, OD + g * 128 + half * 64, nullptr, (char*)lds);
    }
}
__device__ __forceinline__ void ph_diff_post(int l, int wvx) {
    TIDX;
    const bf16* OD = WS(bf16, WS_OD); bf16* MIX = WS(bf16, WS_MIX);
    const float lam = WS(float, WS_LAM)[l], sc1m = 1.0f - (0.8f - 0.6f * __expf(-0.3f * (float)l));
    const int h = lane >> 4, c0 = (lane & 15) * 8;
    float gv[8];
    { const float* g = A->in[I_DFNORM] + l * 512 + h * 128 + c0;
#pragma unroll
      for (int e = 0; e < 8; ++e) gv[e] = g[e] * sc1m; }
    us8 n1 = {}, n2 = {};
    if (gw < T) { n1 = *(const GAS us8*)(OD + (size_t)gw * D + (2 * h) * 128 + c0); n2 = *(const GAS us8*)(OD + (size_t)gw * D + (2 * h + 1) * 128 + c0); }
    for (int tok = gw; tok < T; tok += ngw) {
        const us8 a1 = n1, a2 = n2;
        if (tok + ngw < T) { n1 = *(const GAS us8*)(OD + (size_t)(tok + ngw) * D + (2 * h) * 128 + c0); n2 = *(const GAS us8*)(OD + (size_t)(tok + ngw) * D + (2 * h + 1) * 128 + c0); }
        float d[8], ss = 0.f;
#pragma unroll
        for (int e = 0; e < 8; ++e) { d[e] = bf2f(a1[e]) - lam * bf2f(a2[e]); ss += d[e] * d[e]; }
        ss += DPPF(ss, 0xB1); ss += DPPF(ss, 0x4E); ss += DPPF(ss, 0x141); ss += DPPF(ss, 0x140);
        const float rs = 1.0f / sqrtf(ss * (1.0f / 128.0f) + LN_EPS);
        v4u o; o.x = pk2(d[0] * rs * gv[0], d[1] * rs * gv[1]); o.y = pk2(d[2] * rs * gv[2], d[3] * rs * gv[3]); o.z = pk2(d[4] * rs * gv[4], d[5] * rs * gv[5]); o.w = pk2(d[6] * rs * gv[6], d[7] * rs * gv[7]);
        *(GAS v4u*)(MIX + (size_t)tok * D + 256 + h * 128 + c0) = o;
    }
}
__device__ __forceinline__ void ph_dsa_attn(LAS unsigned char* lds, int wvx) {
    CArgs* A = kargs();
    const int G = gsz_(), bx = bid_(), vcu = (G % 8 == 0) ? (bx % 8) * (G / 8) + bx / 8 : bx;
    const bf16* H = WS(bf16, WS_H); bf16* MIX = WS(bf16, WS_MIX); const unsigned* MASK = WS(unsigned, WS_MASK);
    for (int item = vcu; item < NB * 4 * 4; item += G) {
        const int bh = item >> 2, p = item & 3, b = bh >> 2, h = bh & 3;
        attn_body::attn_unit<8, true>(wvx, b, 7 - p, H + HC_SQ + h * 64, H + HC_SK + h * 64, H + HC_SV + h * 64, MIX + 768 + h * 64, MASK, (char*)lds);
        attn_body::attn_unit<8, true>(wvx, b, p, H + HC_SQ + h * 64, H + HC_SK + h * 64, H + HC_SV + h * 64, MIX + 768 + h * 64, MASK, (char*)lds);
    }
}
constexpr size_t WS_DC = WS_END2;
constexpr size_t WS_CST = WS_DC + 32 * MiB;
constexpr size_t WS_DN = WS_CST + 32 * MiB;
constexpr size_t WS_END3 = WS_DN + 4 * MiB;
constexpr size_t WS_DUMMY = WS_END3;
constexpr size_t WS_END4 = WS_DUMMY + 256 * MiB;
typedef float f32x2_ __attribute__((ext_vector_type(2)));
constexpr int MP = 68;
__device__ __forceinline__ float log_sigmoid_(float x) { return fminf(x, 0.f) - log1pf(__expf(-fabsf(x))); }
__device__ __forceinline__ void mlstm_gates(bf16 iraw, bf16 fraw, float gbi, float gbf, int lane, LAS float* bcum, LAS float* av) {
    const float ip = bf2f(iraw) + gbi; float lf = log_sigmoid_(bf2f(fraw) + gbf);
#pragma unroll
    for (int o = 1; o < 64; o <<= 1) { const float t_ = shup(lf, lane, o); if (lane >= o) lf += t_; }
    bcum[lane] = lf; av[lane] = ip - lf;
}
constexpr int PB = 72;

__device__ __forceinline__ f32x16 mfma_tile(const LAS bf16* Xa, int mt, const LAS bf16* Xb, int nt, int r, int hh, f32x16 acc) {
#pragma unroll
    for (int ks = 0; ks < 4; ++ks) { const bf16x8 a = *(const LAS bf16x8*)(Xa + (32 * mt + r) * PB + 16 * ks + 8 * hh), b = *(const LAS bf16x8*)(Xb + (32 * nt + r) * PB + 16 * ks + 8 * hh);
        acc = __builtin_amdgcn_mfma_f32_32x32x16_bf16(a, b, acc, 0, 0, 0); }
    return acc;
}
__device__ __forceinline__ void ph_mlstm_m1(LAS unsigned char* lds, int l, int wvx) {
    TIDX;
    const bf16* H = WS(bf16, WS_H); const bf16* QKC = WS(bf16, WS_QKC);
    float* DC = WS(float, WS_DC); float* DN = WS(float, WS_DN); float* SCAL = WS(float, WS_DN + 2 * MiB);
    LAS bf16* kT = (LAS bf16*)lds; LAS bf16* vwT = kT + 64 * PB;
    LAS float* bcum = (LAS float*)(vwT + 96 * PB); LAS float* av = bcum + 64; LAS float* wv = av + 64;
    const int r = lane & 31, hh = lane >> 5, srow = tid >> 3, ch = tid & 7;
    us8 nk = {}, nv_ = {}; bf16 nig = 0, nfg = 0;
#define M1_LOAD(uu) do { const int bh_ = (uu) >> 5, c_ = (uu) & 31, t0_ = (bh_ >> 2) * SEQ + c_ * 64, h_ = bh_ & 3; \
        nk = *(const GAS us8*)(QKC + (size_t)(t0_ + srow) * 512 + 256 + h_ * 64 + 8 * ch); nv_ = *(const GAS us8*)(H + (size_t)(t0_ + srow) * NHC + HC_MV + h_ * 64 + 8 * ch); \
        if (wave == 0) { nig = H[(size_t)(t0_ + lane) * NHC + HC_MI + h_]; nfg = H[(size_t)(t0_ + lane) * NHC + HC_MF + h_]; } } while (0)
    M1_LOAD(bidx);
    for (int u = bidx; u < NB * 4 * 32; u += gsz) {
        const int bh = u >> 5, c = u & 31, b = bh >> 2, h = bh & 3, tok0 = b * SEQ + c * 64; (void)tok0;
        const us8 kraw = nk, vraw = nv_; const bf16 igr = nig, fgr = nfg;
        if (u + gsz < NB * 4 * 32) M1_LOAD(u + gsz);
        if (wave == 0) { mlstm_gates(igr, fgr, A->in[I_GATEB][l * 8 + h], A->in[I_GATEB][l * 8 + 4 + h], lane, bcum, av); }
        __syncthreads();
        if (wave == 0) { const float a = av[lane], amax = wave_max(a); wv[lane] = __expf(a - amax); if (lane == 0) { SCAL[u * 4 + 0] = bcum[63]; SCAL[u * 4 + 1] = bcum[63] + amax; } }
        __syncthreads();
        { const float w = wv[srow];
#pragma unroll
          for (int e = 0; e < 8; ++e) { kT[(8 * ch + e) * PB + srow] = kraw[e]; vwT[(8 * ch + e) * PB + srow] = (bf16)f2bf(w * bf2f(vraw[e])); }
          if (tid < 64) vwT[64 * PB + tid] = (bf16)f2bf(wv[tid]);
          for (int i = tid; i < 31 * 64; i += 512) vwT[(65 + i / 64) * PB + (i & 63)] = 0; }
        __syncthreads();
        if (wave < 6) { const int mt = wave >> 1, nt = wave & 1;
            f32x16 acc = {}; acc = mfma_tile(vwT, mt, kT, nt, r, hh, acc);
#pragma unroll
            for (int g = 0; g < 16; ++g) { const int vrow = 32 * mt + (g & 3) + 8 * (g >> 2) + 4 * hh, d = 32 * nt + r;
                if (vrow < 64) DC[(size_t)u * 4096 + vrow * 64 + d] = acc[g]; else if (vrow == 64) DN[(size_t)u * 64 + d] = acc[g]; } }
        __syncthreads();
    }
#undef M1_LOAD
}
__device__ __forceinline__ void ph_mlstm_m2(int wvx) {
    TIDX;
    const float* DC = WS(float, WS_DC); float* CS = WS(float, WS_CST); const float* DN = WS(float, WS_DN); float* NS = WS(float, WS_DN + 1 * MiB); float* SCAL = WS(float, WS_DN + 2 * MiB);
    for (int item = bidx; item < NB * 4 * 4; item += gsz) {
        const int bh = item >> 2, qtr = item & 3, e0 = qtr * 1024 + tid * 2;
        f32x2_ dc[32]; float dn[32];
#pragma unroll
        for (int c = 0; c < 32; ++c) { dc[c] = *(const GAS f32x2_*)(DC + (size_t)(bh * 32 + c) * 4096 + e0); dn[c] = (qtr == 0 && tid < 64) ? DN[(size_t)(bh * 32 + c) * 64 + tid] : 0.f; }
        float z_ = 0.f; asm volatile("" : "+v"(z_));
        float m = 0.f; f32x2_ C = (f32x2_){z_, z_}; float n = z_;
#pragma unroll
        for (int c = 0; c < 32; ++c) {
            const int u = bh * 32 + c;
            const float bl = SCAL[u * 4 + 0], ml = SCAL[u * 4 + 1];
            *(GAS f32x2_*)(CS + (size_t)u * 4096 + e0) = C;
            if (qtr == 0 && tid < 64) NS[(size_t)u * 64 + tid] = n;
            if (qtr == 0 && tid == 0) SCAL[u * 4 + 2] = m;
            const float mn = fmaxf(bl + m, ml), f1 = __expf(bl + m - mn), f2 = __expf(ml - mn);
            C.x = f1 * C.x + f2 * dc[c].x; C.y = f1 * C.y + f2 * dc[c].y;
            n = f1 * n + f2 * dn[c];
            m = mn;
        }
    }
}
__device__ __forceinline__ void ph_mlstm_m3(LAS unsigned char* lds, int l, int wvx) {
    TIDX;
    const bf16* H = WS(bf16, WS_H); const bf16* QKC = WS(bf16, WS_QKC); bf16* MIX = WS(bf16, WS_MIX);
    const float* CS = WS(float, WS_CST); const float* NS = WS(float, WS_DN + 1 * MiB); const float* SCAL = WS(float, WS_DN + 2 * MiB);
    LAS bf16* qS = (LAS bf16*)lds; LAS bf16* kS = qS + 64 * PB; LAS bf16* vT = kS + 64 * PB; LAS bf16* cT = vT + 96 * PB; LAS bf16* Sb = cT + 96 * PB;
    LAS float* hS = (LAS float*)(Sb + 64 * PB);
    LAS float* bcum = hS + 64 * MP; LAS float* av = bcum + 64; LAS float* mm = av + 64; LAS float* inter = mm + 64; LAS float* dinv = inter + 64;
    const int r = lane & 31, hh = lane >> 5, srow = tid >> 3, ch = tid & 7;
    us8 nq = {}, nk = {}, nv_ = {}; f32x4 nc0 = {}, nc1 = {}; bf16 nog[8] = {}; bf16 nig = 0, nfg = 0; float nns = 0.f, nmc = 0.f;
#define M3_LOAD(uu) do { const int bh_ = (uu) >> 5, c_ = (uu) & 31, t0_ = (bh_ >> 2) * SEQ + c_ * 64, h_ = bh_ & 3; \
        nq = *(const GAS us8*)(QKC + (size_t)(t0_ + srow) * 512 + h_ * 64 + 8 * ch); nk = *(const GAS us8*)(QKC + (size_t)(t0_ + srow) * 512 + 256 + h_ * 64 + 8 * ch); \
        nv_ = *(const GAS us8*)(H + (size_t)(t0_ + srow) * NHC + HC_MV + h_ * 64 + 8 * ch); \
        nc0 = *(const GAS f32x4*)(CS + (size_t)(uu) * 4096 + srow * 64 + 8 * ch); nc1 = *(const GAS f32x4*)(CS + (size_t)(uu) * 4096 + srow * 64 + 8 * ch + 4); \
        _Pragma("unroll") for (int j = 0; j < 8; ++j) nog[j] = H[(size_t)(t0_ + wave + 8 * j) * NHC + HC_MO + h_ * 64 + lane]; \
        nmc = SCAL[(uu) * 4 + 2]; if (tid < 64) nns = NS[(size_t)(uu) * 64 + tid]; \
        if (wave == 0) { nig = H[(size_t)(t0_ + lane) * NHC + HC_MI + h_]; nfg = H[(size_t)(t0_ + lane) * NHC + HC_MF + h_]; } } while (0)
    M3_LOAD(bidx);
    for (int u = bidx; u < NB * 4 * 32; u += gsz) {
        const int bh = u >> 5, c = u & 31, b = bh >> 2, h = bh & 3, tok0 = b * SEQ + c * 64;
        const float mc = nmc, nsv = nns;
        bf16 ograw[8];
#pragma unroll
        for (int j = 0; j < 8; ++j) ograw[j] = nog[j];
        const float gnorm = A->in[I_MNORM][l * 256 + h * 64 + lane];
        const us8 qraw = nq, kraw = nk, vraw = nv_; const f32x4 c0 = nc0, c1 = nc1; const bf16 igr = nig, fgr = nfg;
        if (u + gsz < NB * 4 * 32) M3_LOAD(u + gsz);
        {
            us8 qs;
#pragma unroll
            for (int e = 0; e < 8; ++e) qs[e] = (bf16)f2bf(bf2f(qraw[e]) * 0.125f);
            *(LAS us8*)(qS + srow * PB + 8 * ch) = qs; *(LAS us8*)(kS + srow * PB + 8 * ch) = kraw;
#pragma unroll
            for (int e = 0; e < 8; ++e) vT[(8 * ch + e) * PB + srow] = vraw[e];
            v4u cp; cp.x = pk2(c0[0], c0[1]); cp.y = pk2(c0[2], c0[3]); cp.z = pk2(c1[0], c1[1]); cp.w = pk2(c1[2], c1[3]);
            *(LAS v4u*)(cT + srow * PB + 8 * ch) = cp;
            if (tid < 64) { vT[64 * PB + tid] = (bf16)0x3f80; cT[64 * PB + tid] = (bf16)f2bf(nsv); }
            for (int i = tid; i < 31 * 64; i += 512) { vT[(65 + i / 64) * PB + (i & 63)] = 0; cT[(65 + i / 64) * PB + (i & 63)] = 0; }
        }
        if (wave == 0) { mlstm_gates(igr, fgr, A->in[I_GATEB][l * 8 + h], A->in[I_GATEB][l * 8 + 4 + h], lane, bcum, av); }
        __syncthreads();
        if (wave == 0) { float pm = av[lane];
#pragma unroll
            for (int o = 1; o < 64; o <<= 1) { const float t_ = shup(pm, lane, o); if (lane >= o) pm = fmaxf(pm, t_); }
            const float m_ = fmaxf(mc, pm); mm[lane] = m_; inter[lane] = __expf(mc - m_); }
        __syncthreads();
        if (wave < 4) { const int tt = wave >> 1, st = wave & 1;
            f32x16 acc = {}; acc = mfma_tile(qS, tt, kS, st, r, hh, acc);
            const int s = 32 * st + r; const float as = av[s];
#pragma unroll
            for (int g = 0; g < 16; ++g) { const int t = 32 * tt + (g & 3) + 8 * (g >> 2) + 4 * hh;
                const float val = (s <= t) ? acc[g] * __expf(as - mm[t]) : 0.f; Sb[t * PB + s] = (bf16)f2bf(val); } }
        __syncthreads();
        f32x16 aS = {}, aC = {}; const int tt = (wave < 6) ? wave / 3 : 0, nt = (wave < 6) ? wave % 3 : 0;
        if (wave < 6) { aS = mfma_tile(Sb, tt, vT, nt, r, hh, aS); aC = mfma_tile(qS, tt, cT, nt, r, hh, aC); }
        if (wave < 6 && nt == 2 && r == 0) {
#pragma unroll
            for (int g = 0; g < 16; ++g) { const int t = 32 * tt + (g & 3) + 8 * (g >> 2) + 4 * hh;
                const float dn = aS[g] + inter[t] * aC[g]; dinv[t] = 1.0f / fmaxf(fabsf(dn), __expf(-(bcum[t] + mm[t]))); } }
        __syncthreads();
        if (wave < 6 && nt < 2) {
#pragma unroll
            for (int g = 0; g < 16; ++g) { const int t = 32 * tt + (g & 3) + 8 * (g >> 2) + 4 * hh;
                hS[t * MP + 32 * nt + r] = (aS[g] + inter[t] * aC[g]) * dinv[t]; } }
        __syncthreads();
#pragma unroll
        for (int j = 0; j < 8; ++j) { const int t = wave + 8 * j, vc = lane; const size_t tk = (size_t)(tok0 + t);
            const float hv = hS[t * MP + vc];
            const float mean = wave_sum(hv) * (1.0f / 64.0f), hc = hv - mean;
            const float rs = 1.0f / sqrtf(wave_sum(hc * hc) * (1.0f / 64.0f) + LN_EPS);
            const float og = sigmoidf_(bf2f(ograw[j]));
            MIX[tk * D + h * 64 + vc] = (bf16)f2bf(og * (hc * rs * gnorm)); }
        __syncthreads();
    }
#undef M3_LOAD
}
__device__ __forceinline__ int wave_sum_i(int x) {
    x += __builtin_amdgcn_update_dpp(0, x, 0xB1, 0xF, 0xF, true);
    x += __builtin_amdgcn_update_dpp(0, x, 0x4E, 0xF, 0xF, true);
    x += __builtin_amdgcn_update_dpp(0, x, 0x141, 0xF, 0xF, true);
    x += __builtin_amdgcn_update_dpp(0, x, 0x140, 0xF, 0xF, true);
    return __builtin_amdgcn_readlane(x, 0) + __builtin_amdgcn_readlane(x, 16) + __builtin_amdgcn_readlane(x, 32) + __builtin_amdgcn_readlane(x, 48);
}
__device__ __forceinline__ void select_load(const float* SC, int tok, int lane, f32x4 (&raw)[8]) {
    const int tl = tok % SEQ, lo = 32 * lane; const bool need = (tl >= 256) && (tl + 1 - lo > 0);
#pragma unroll
    for (int j = 0; j < 8; ++j) { raw[j] = (f32x4){0.f, 0.f, 0.f, 0.f}; if (need) raw[j] = *(const GAS f32x4*)(SC + (size_t)tok * SEQ + lo + 4 * j); }
}
__device__ __forceinline__ void select_row(const f32x4 (&raw)[8], unsigned* MASK, int tok, int lane) {
        const int tl = tok % SEQ, lo = 32 * lane;
        const int nv = min(max(tl + 1 - lo, 0), 32);
        unsigned cand = (nv >= 32) ? 0xffffffffu : ((1u << nv) - 1u);
        if (tl < 256) { MASK[(size_t)tok * 64 + lane] = cand; return; }
        unsigned a[32];
#pragma unroll
        for (int j = 0; j < 8; ++j) {
            const f32x4 v = raw[j];
#pragma unroll
            for (int c = 0; c < 4; ++c) { unsigned u = __float_as_uint(v[c]); u = (u == 0x80000000u) ? 0u : u; a[4 * j + c] = (u >> 31) ? ~u : (u | 0x80000000u); }
        }
#define TSTAGE(J, M) _Pragma("unroll") for (int k0 = 0; k0 < 32; ++k0) { if ((k0 & J) == 0) { const unsigned t_ = ((a[k0] >> J) ^ a[k0 + J]) & M; a[k0] ^= t_ << J; a[k0 + J] ^= t_; } }
#define PSTAGE(J, SA, SB) _Pragma("unroll") for (int k0 = 0; k0 < 32; ++k0) { if ((k0 & J) == 0) { const unsigned x_ = a[k0], y_ = a[k0 + J]; a[k0] = __builtin_amdgcn_perm(y_, x_, SA); a[k0 + J] = __builtin_amdgcn_perm(y_, x_, SB); } }
        PSTAGE(16, 0x05040100u, 0x07060302u) PSTAGE(8, 0x06020400u, 0x07030501u) TSTAGE(4, 0x0F0F0F0Fu) TSTAGE(2, 0x33333333u) TSTAGE(1, 0x55555555u)
#undef PSTAGE
#undef TSTAGE
        unsigned sel = 0u; int need = 256, ncand = tl + 1;
#pragma unroll
        for (int b = 31; b >= 0; --b) {
            if (ncand != need) {
                const unsigned hit = cand & a[b];
                const int cnt = wave_sum_i(__popc(hit));
                if (cnt >= need) { cand = hit; ncand = cnt; }
                else { sel |= hit; cand &= ~a[b]; need -= cnt; ncand -= cnt; }
            }
        }
        if (ncand == need) sel |= cand;
        else {
            const int my = __popc(cand); int incl = my;
#pragma unroll
            for (int o = 1; o < 64; o <<= 1) { const int t_ = shupi(incl, lane, o); if (lane >= o) incl += t_; }
            const int take = min(max(need - (incl - my), 0), my); int taken = 0;
#pragma unroll 1
            for (int k = 0; k < 32; ++k) { if (((cand >> k) & 1u) && taken < take) { sel |= 1u << k; ++taken; } }
        }
        MASK[(size_t)tok * 64 + lane] = sel;
}
constexpr int R1_OFF = RING_BYTES + 8192;
__device__ __forceinline__ void ph_row1(LAS unsigned char* lds, int l, int wvx, bool dry = false) {
    TIDX;
    const bf16* xin = WS(bf16, WS_XB); bf16* XB = dry ? WS(bf16, WS_DUMMY) : WS(bf16, WS_XB);
    const bf16* Y = WS(bf16, WS_Y); bf16* U = dry ? WS(bf16, WS_DUMMY + 128 * MiB) : WS(bf16, WS_U);
    unsigned* cnt = dry ? WS(unsigned, WS_DUMMY + 200 * MiB) : WS(unsigned, WS_CTL) + CW_CNT + l * NEXP * 64; unsigned* TOK = dry ? WS(unsigned, WS_DUMMY + 192 * MiB) : WS(unsigned, WS_TOK);
    unsigned* RMAP = dry ? WS(unsigned, WS_DUMMY + 208 * MiB) : WS(unsigned, WS_XG);
    constexpr int RWP = 1032;
    LAS bf16* rw = (LAS bf16*)lds; LAS bf16* UT = rw + 32 * RWP; LAS float* PT = (LAS float*)(UT + 16 * RWP); LAS float* LG = PT + 8 * 16 * 33; LAS float* TP = LG + 16 * 33; LAS float* VT = TP + 64;
    static_assert((32 * RWP + 16 * RWP) * 2 + (8 * 16 * 33 + 16 * 33 + 64 + 5 * 1024) * 4 <= R1_OFF, "row1 LDS map");
    LAS unsigned* lcnt = (LAS unsigned*)(lds + R1_OFF); LAS unsigned* lbase = lcnt + 32; LAS unsigned* nrec = lbase + 32; LAS unsigned* rec = nrec + 4;
    { const GAS f32x4* src = (const GAS f32x4*)(WS(float, WS_RWT) + (size_t)l * NEXP * D);
      f32x4 w4[16];
#pragma unroll
      for (int q = 0; q < 16; ++q) w4[q] = src[tid + 512 * q];
#pragma unroll
      for (int q = 0; q < 16; ++q) { const int i = tid + 512 * q, e_ = i >> 8, c_ = (i & 255) * 4; *(LAS unsigned long long*)(rw + e_ * RWP + c_) = (unsigned long long)pk2(w4[q].x, w4[q].y) | ((unsigned long long)pk2(w4[q].z, w4[q].w) << 32); } }
    const float rbias = A->in[I_RB][l * NEXP + (tid & 31)];
    for (int chunk = bidx; chunk < T / 128; chunk += gsz) {
        const int cb = (chunk * 128) / SEQ; const float* mod = WS(float, WS_MOD) + ((size_t)l * NB + cb) * 6144;
        __syncthreads();
        for (int i = tid; i < 5 * 256; i += 512) { const int vsel = i >> 8, c4 = (i & 255) * 4;
            const float* sp = vsel == 0 ? mod + 2048 : vsel == 1 ? mod + 4096 : vsel == 2 ? mod + 3072 : vsel == 3 ? A->in[I_LN1G] + l * D : A->in[I_LN1B] + l * D;
            *(LAS f32x4*)(VT + vsel * 1024 + c4) = *(const GAS f32x4*)(sp + c4); }
        if (tid < 32) lcnt[tid] = 0u; if (tid == 32) nrec[0] = 0u;
        __syncthreads();
        const int tbase = chunk * 128 + 2 * wave;
        unsigned long long px[2][4], py[2][4];
#define R1_LOAD(t, tk) do { _Pragma("unroll") for (int j = 0; j < 4; ++j) { const int c = 4 * lane + 256 * j; \
            px[t][j] = *(const GAS unsigned long long*)(xin + (size_t)(tk) * D + c); py[t][j] = *(const GAS unsigned long long*)(Y + (size_t)(tk) * D + c); } } while (0)
        R1_LOAD(0, tbase); R1_LOAD(1, tbase + 1);
#pragma unroll 1
        for (int it_ = 0; it_ < 8; ++it_) {
#pragma unroll
            for (int t = 0; t < 2; ++t) {
                const int tok = tbase + 16 * it_ + t;
                f32x4 v[4]; float s = 0.f;
#pragma unroll
                for (int j = 0; j < 4; ++j) { const int c = 4 * lane + 256 * j;
                    const unsigned long long xr = px[t][j]; const f32x4 g1 = *(const LAS f32x4*)(VT + c);
                    f32x4 x; x.x = __uint_as_float((unsigned)xr << 16); x.y = __uint_as_float((unsigned)xr & 0xffff0000u); x.z = __uint_as_float((unsigned)(xr >> 32) << 16); x.w = __uint_as_float((unsigned)(xr >> 32) & 0xffff0000u);
                    const unsigned long long yr = py[t][j];
                    f32x4 y; y.x = __uint_as_float((unsigned)yr << 16); y.y = __uint_as_float((unsigned)yr & 0xffff0000u); y.z = __uint_as_float((unsigned)(yr >> 32) << 16); y.w = __uint_as_float((unsigned)(yr >> 32) & 0xffff0000u);
                    v[j] = x * DN_ALPHA + (1.0f + g1) * y; s += (v[j].x + v[j].y) + (v[j].z + v[j].w); }
                if (it_ + 1 < 8) R1_LOAD(t, tok + 16);
                const float mean = wave_sum(s) * (1.0f / D); float s2 = 0.f;
#pragma unroll
                for (int j = 0; j < 4; ++j) { v[j] = v[j] - mean; s2 += (v[j].x * v[j].x + v[j].y * v[j].y) + (v[j].z * v[j].z + v[j].w * v[j].w); }
                const float rstd = 1.0f / sqrtf(wave_sum(s2) * (1.0f / D) + LN_EPS);
#pragma unroll
                for (int j = 0; j < 4; ++j) { const int c = 4 * lane + 256 * j;
                    const f32x4 xn = v[j] * rstd * *(const LAS f32x4*)(VT + 3072 + c) + *(const LAS f32x4*)(VT + 4096 + c);
                    *(GAS unsigned long long*)(XB + (size_t)tok * D + c) = (unsigned long long)pk2(xn.x, xn.y) | ((unsigned long long)pk2(xn.z, xn.w) << 32);
                    const f32x4 u2 = xn * (1.0f + *(const LAS f32x4*)(VT + 1024 + c)) + *(const LAS f32x4*)(VT + 2048 + c);
                    *(GAS unsigned*)((unsigned char*)U + (size_t)tok * D + c) = pg8::pk4_fp8(u2.x, u2.y, u2.z, u2.w, 16.0f);
                    *(LAS unsigned long long*)(UT + (2 * wave + t) * RWP + c) = (unsigned long long)pk2(u2.x, u2.y) | ((unsigned long long)pk2(u2.z, u2.w) << 32); }
            }
            __syncthreads();
            { const int fr = lane & 15, fq = lane >> 4;
              f32x4 pacc[2] = {(f32x4){0.f, 0.f, 0.f, 0.f}, (f32x4){0.f, 0.f, 0.f, 0.f}};
#pragma unroll
              for (int ks = 0; ks < 4; ++ks) { const int k0 = 128 * wave + 32 * ks + 8 * fq;
                  const bf16x8 a = *(const LAS bf16x8*)(UT + fr * RWP + k0);
#pragma unroll
                  for (int n = 0; n < 2; ++n) { const bf16x8 b = *(const LAS bf16x8*)(rw + (16 * n + fr) * RWP + k0); pacc[n] = __builtin_amdgcn_mfma_f32_16x16x32_bf16(a, b, pacc[n], 0, 0, 0); } }
#pragma unroll
              for (int n = 0; n < 2; ++n)
#pragma unroll
                  for (int g = 0; g < 4; ++g) PT[(wave * 16 + 4 * fq + g) * 33 + 16 * n + fr] = pacc[n][g]; }
            __syncthreads();
            {
                const int slot = tid >> 5, ex = tid & 31;
                float lg_ = rbias;
#pragma unroll
                for (int w = 0; w < 8; ++w) lg_ += PT[(w * 16 + slot) * 33 + ex];
                LG[slot * 33 + ex] = lg_;
                LDS_WAIT(); asm volatile("" ::: "memory");
                int rank = 0;
#pragma unroll
                for (int j = 0; j < 32; ++j) { const float lj = LG[slot * 33 + j]; rank += (lj > lg_ || (lj == lg_ && j < ex)) ? 1 : 0; }
                if (rank < 4) TP[slot * 4 + rank] = lg_;
                LDS_WAIT(); asm volatile("" ::: "memory");
                const int tok = chunk * 128 + 16 * it_ + slot;
                if (rank < 4) {
                    const float t0 = TP[slot * 4], e1 = __expf(TP[slot * 4 + 1] - t0), e2 = __expf(TP[slot * 4 + 2] - t0), e3 = __expf(TP[slot * 4 + 3] - t0);
                    const float pk = __expf(lg_ - t0) / (1.0f + e1 + e2 + e3);
                    const unsigned lp = __hip_atomic_fetch_add(lcnt + ex, 1u, __ATOMIC_RELAXED, __HIP_MEMORY_SCOPE_WORKGROUP);
                    const unsigned ri = __hip_atomic_fetch_add(nrec, 1u, __ATOMIC_RELAXED, __HIP_MEMORY_SCOPE_WORKGROUP);
                    if (ri < 600u) { LAS unsigned* rr = rec + ri * 3; rr[0] = (unsigned)tok * 4u + (unsigned)rank; rr[1] = (unsigned)ex | (lp << 8); rr[2] = __float_as_uint(pk); } }
            }
            __syncthreads();
        }
#undef R1_LOAD
        if (tid < 32) lbase[tid] = __hip_atomic_fetch_add(cnt + tid * 64, lcnt[tid], __ATOMIC_RELAXED, __HIP_MEMORY_SCOPE_AGENT);
        __syncthreads();
        { const int n = (int)min(nrec[0], 600u);
          for (int i = tid; i < n; i += 512) { const unsigned r0 = rec[i * 3], r1 = rec[i * 3 + 1], r2 = rec[i * 3 + 2]; const unsigned ek = r1 & 255u;
              const unsigned pos = (dry ? 0u : lbase[ek]) + (r1 >> 8);
              *(GAS v4u*)(TOK + (size_t)r0 * 4) = (v4u){ek, pos, r2, 0u}; RMAP[(size_t)ek * T + pos] = r0 >> 2; } }
    }
    __syncthreads();
}
__device__ __forceinline__ int moe_tables(LAS unsigned char* lds, int l, int wvx) {
    CArgs* A = kargs();
    LAS unsigned* base = (LAS unsigned*)(lds + TAB_OFF); LAS unsigned char* tile_e = lds + TAB_OFF + 256; LAS unsigned* cntl = (LAS unsigned*)(lds + TAB_OFF + 1024);
    const unsigned* cnt = WS(unsigned, WS_CTL) + CW_CNT + l * NEXP * 64;
    if (wvx == 0) {
        const int lane = lane_id_(), e = lane & 31;
        const unsigned c = __hip_atomic_load(cnt + e * 64, __ATOMIC_RELAXED, __HIP_MEMORY_SCOPE_AGENT);
        const int nt = (int)((c + 255u) >> 8); int incl = nt;
#pragma unroll
        for (int o = 1; o < 32; o <<= 1) { const int t_ = shupi(incl, lane, o); if (e >= o) incl += t_; }
        if (lane < 32) { const int t0 = incl - nt; base[e] = (unsigned)t0 << 8; cntl[e] = c; if (e == 31) base[NEXP] = (unsigned)incl << 8;
#pragma unroll 1
            for (int t = 0; t < nt; ++t) tile_e[t0 + t] = (unsigned char)e; }
    }
    __syncthreads();
    return (int)(base[NEXP] >> 8);
}
__device__ __forceinline__ void ph_row2(LAS unsigned char* lds, int l, int wvx, bool dry = false) {
    TIDX;
    (void)moe_tables(lds, l, wvx);
    const LAS unsigned* base = (const LAS unsigned*)(lds + TAB_OFF);
    bf16* XB = WS(bf16, WS_XB); const bf16* YM = WS(bf16, WS_YM); bf16* U = WS(bf16, WS_U); const unsigned* TOK = WS(unsigned, WS_TOK);
    const bool fin = (l == DEPTH - 1); float* dstf = dry ? WS(float, WS_DUMMY) : A->out; bf16* dstb = dry ? WS(bf16, WS_DUMMY) : XB; bf16* Uw = dry ? WS(bf16, WS_DUMMY + 128 * MiB) : U;
    LAS bf16* b2l = (LAS bf16*)lds; LAS float* VT = (LAS float*)(lds + 65536);
    { const GAS f32x4* src = (const GAS f32x4*)(A->in[I_B2] + (size_t)l * NEXP * D); f32x4 w4[16];
#pragma unroll
      for (int q = 0; q < 16; ++q) w4[q] = src[tid + 512 * q];
#pragma unroll
      for (int q = 0; q < 16; ++q) *(LAS unsigned long long*)(b2l + (size_t)(tid + 512 * q) * 4) = (unsigned long long)pk2(w4[q].x, w4[q].y) | ((unsigned long long)pk2(w4[q].z, w4[q].w) << 32); }
    for (int chunk = bidx; chunk < T / 128; chunk += gsz) {
        const int cb = (chunk * 128) / SEQ; const float* mod = WS(float, WS_MOD) + ((size_t)l * NB + cb) * 6144; const float* modn = WS(float, WS_MOD) + ((size_t)(l + 1 < DEPTH ? l + 1 : l) * NB + cb) * 6144;
        __syncthreads();
        for (int i = tid; i < 5 * 256; i += 512) { const int vsel = i >> 8, c4 = (i & 255) * 4;
            const float* sp = vsel == 0 ? mod + 5120 : vsel == 1 ? modn + 1024 : vsel == 2 ? modn : vsel == 3 ? A->in[I_LN2G] + l * D : A->in[I_LN2B] + l * D;
            *(LAS f32x4*)(VT + vsel * 1024 + c4) = *(const GAS f32x4*)(sp + c4); }
        __syncthreads();
        const int tb0 = chunk * 128 + wave;
        LAS v4u* RC = (LAS v4u*)(lds + 65536 + 20480) + wave * 64;
        RC[lane] = *(const GAS v4u*)(TOK + ((size_t)(tb0 + 8 * (lane >> 2)) * 4 + (lane & 3)) * 4);
        LDS_WAIT(); asm volatile("" ::: "memory");
        unsigned yq[4][4][4]; unsigned long long xq[4][4];
#define R2_ROWS(S, ti) do { _Pragma("unroll") for (int k = 0; k < 4; ++k) { const v4u rc_ = RC[(ti) * 4 + k]; const size_t row_ = (size_t)base[rc_.x] + rc_.y; \
            _Pragma("unroll") for (int j = 0; j < 4; ++j) yq[S][k][j] = *(const GAS unsigned*)((const unsigned char*)YM + row_ * D + 4 * lane + 256 * j); } \
            _Pragma("unroll") for (int j = 0; j < 4; ++j) xq[S][j] = *(const GAS unsigned long long*)(XB + (size_t)(tb0 + 8 * (ti)) * D + 4 * lane + 256 * j); } while (0)
#define R2_BODY(S, ti) do { const int it_ = (ti); const int tok = tb0 + 8 * it_; \
            if (it_ + 3 < 16) R2_ROWS(((S) + 3) & 3, it_ + 3); \
            f32x4 acc[4]; \
            _Pragma("unroll") for (int j = 0; j < 4; ++j) acc[j] = (f32x4){0.f, 0.f, 0.f, 0.f}; \
            _Pragma("unroll") for (int k = 0; k < 4; ++k) { const v4u rc_ = RC[it_ * 4 + k]; const float p = __uint_as_float(rc_.z); \
                _Pragma("unroll") for (int j = 0; j < 4; ++j) { const int c = 4 * lane + 256 * j; const unsigned yr = yq[S][k][j]; \
                    typedef float f32x2v_ __attribute__((ext_vector_type(2))); const f32x2v_ ylo = __builtin_amdgcn_cvt_pk_f32_fp8(yr, false), yhi = __builtin_amdgcn_cvt_pk_f32_fp8(yr, true); \
                    const f32x4 y = (f32x4){ylo.x, ylo.y, yhi.x, yhi.y} * (1.0f / 64.0f); \
                    const unsigned long long bq = *(const LAS unsigned long long*)(b2l + rc_.x * D + c); \
                    f32x4 bb; bb.x = __uint_as_float((unsigned)bq << 16); bb.y = __uint_as_float((unsigned)bq & 0xffff0000u); bb.z = __uint_as_float((unsigned)(bq >> 32) << 16); bb.w = __uint_as_float((unsigned)(bq >> 32) & 0xffff0000u); \
                    acc[j] = acc[j] + p * (y + bb); } } \
            f32x4 v[4]; float s = 0.f; \
            _Pragma("unroll") for (int j = 0; j < 4; ++j) { const int c = 4 * lane + 256 * j; const unsigned long long xr = xq[S][j]; f32x4 x; \
                x.x = __uint_as_float((unsigned)xr << 16); x.y = __uint_as_float((unsigned)xr & 0xffff0000u); x.z = __uint_as_float((unsigned)(xr >> 32) << 16); x.w = __uint_as_float((unsigned)(xr >> 32) & 0xffff0000u); \
                v[j] = x * DN_ALPHA + (1.0f + *(const LAS f32x4*)(VT + c)) * acc[j]; s += (v[j].x + v[j].y) + (v[j].z + v[j].w); } \
            const float mean = wave_sum(s) * (1.0f / D); float s2 = 0.f; \
            _Pragma("unroll") for (int j = 0; j < 4; ++j) { v[j] = v[j] - mean; s2 += (v[j].x * v[j].x + v[j].y * v[j].y) + (v[j].z * v[j].z + v[j].w * v[j].w); } \
            const float rstd = 1.0f / sqrtf(wave_sum(s2) * (1.0f / D) + LN_EPS); \
            _Pragma("unroll") for (int j = 0; j < 4; ++j) { const int c = 4 * lane + 256 * j; \
                const f32x4 xn = v[j] * rstd * *(const LAS f32x4*)(VT + 3072 + c) + *(const LAS f32x4*)(VT + 4096 + c); \
                if (fin) *(GAS f32x4*)(dstf + (size_t)tok * D + c) = xn; else *(GAS unsigned long long*)(dstb + (size_t)tok * D + c) = (unsigned long long)pk2(xn.x, xn.y) | ((unsigned long long)pk2(xn.z, xn.w) << 32); \
                if (l + 1 < DEPTH) { const f32x4 u = xn * (1.0f + *(const LAS f32x4*)(VT + 1024 + c)) + *(const LAS f32x4*)(VT + 2048 + c); \
                    R2_USTORE(u); } } } while (0)
#ifdef INPROJ_F8
#define R2_USTORE(u) *(GAS unsigned*)((unsigned char*)Uw + (size_t)tok * D + c) = pg8::pk4_fp8(u.x, u.y, u.z, u.w, 16.0f)
#else
#define R2_USTORE(u) *(GAS unsigned long long*)(Uw + (size_t)tok * D + c) = (unsigned long long)pk2(u.x, u.y) | ((unsigned long long)pk2(u.z, u.w) << 32)
#endif
        R2_ROWS(0, 0); R2_ROWS(1, 1); R2_ROWS(2, 2);
#pragma unroll 1
        for (int it4 = 0; it4 < 16; it4 += 4) { R2_BODY(0, it4); R2_BODY(1, it4 + 1); R2_BODY(2, it4 + 2); R2_BODY(3, it4 + 3); }
#undef R2_BODY
#undef R2_USTORE
#undef R2_ROWS
    }
    __syncthreads();
}
__global__ void __launch_bounds__(NWAVES * 64, 2) mega_fwd(Args A_) {
    extern __shared__ __attribute__((aligned(16))) unsigned char lds_raw[];
    LAS unsigned char* lds = (LAS unsigned char*)lds_raw;
    const int tid = threadIdx.x; const int wv0 = __builtin_amdgcn_readfirstlane(tid >> 6);
    volatile LAS unsigned* MISC = (volatile LAS unsigned*)(lds + MISC_OFF);
    for (int u = tid; u < (LDS_BYTES - TAB_OFF) / 4; u += NWAVES * 64) ((LAS unsigned*)(lds + TAB_OFF))[u] = 0u;
    __syncthreads();
    CArgs* A = kargs(); const bool multi = (A->s_hi - A->s_lo) > 1;
    if (multi) (void)xcd_barrier_post(WS(unsigned, WS_CTL) + CW_BAR + A->li * XCD_BAR_WORDS, MISC + 8);
    const int lo = A->s_lo, hi = A->s_hi;
#ifndef PHMASK
#define PHMASK 0xffffffffu
#endif
#define PHM(b) (((PHMASK) >> (b)) & 1u)
#ifndef RPTMASK
#define RPTMASK 0u
#endif
#define RPT(b) _Pragma("unroll 1") for (int rep_ = 0; rep_ < ((((RPTMASK) >> (b)) & 1u) ? 2 : 1); ++rep_)
#define RUN(s) (lo <= (s) && (s) < hi)
#ifdef BAR2
#define BAR2X(A_) xcd_barrier_fn((unsigned*)(A_->ws + WS_CTL) + CW_BAR + A_->li * XCD_BAR_WORDS, xb_xcc_id(), (volatile LAS unsigned*)(lds_launder(lds) + MISC_OFF) + 8, tid_of(wv0) == 0)
#else
#define BAR2X(A_) do {} while (0)
#endif
#define SEAM(s) do { if ((s) + 1 < hi) { CArgs* A_ = kargs(); xcd_barrier_fn((unsigned*)(A_->ws + WS_CTL) + CW_BAR + A_->li * XCD_BAR_WORDS, xb_xcc_id(), (volatile LAS unsigned*)(lds_launder(lds) + MISC_OFF) + 8, tid_of(wv0) == 0); BAR2X(A_); } } while (0)
    if (RUN(0)) { if (PHM(0)) RPT(0) pro_a(lds_launder(lds), wv0); SEAM(0); }
    if (RUN(1)) { if (PHM(1)) RPT(1) pro_b(wv0); SEAM(1); }
    for (int l = 0; l < DEPTH; ++l) {
        const int sb = 2 + NPH * l;
        if (RUN(sb + PH_IN)) { CArgs* A = kargs();
#ifdef INPROJ_F8
            pg8::Gemm g{WS(bf16, WS_U), (const bf16*)(WS(unsigned char, WS_WIN) + (size_t)l * NHC * D), T, NHC, D / 2}; pg8::StaticOrder S; S.init(T, NHC, gsz_(), bid_());
            pg8::EpiIn E{WS(bf16, WS_H), WS(unsigned, WS_CS16), 1.0f / 4096.0f};
            if (PHM(2)) RPT(2) pg8::gemm_phase<pg8::EpiIn, pg8::StaticOrder, true, true, pg8::DirectA, true>(lds_launder(lds), wv0, g, S, E, pg8::DirectA(), 0, 0);
#else
            pg8::Gemm g{WS(bf16, WS_U), WS(bf16, WS_WIN) + (size_t)l * NHC * D, T, NHC, D}; pg8::StaticOrder S; S.init(T, NHC, gsz_(), bid_());
            pg8::EpiIn E{WS(bf16, WS_H), WS(unsigned, WS_CS16), 1.0f};
            if ((RPTMASK >> 22) & 1u) pg8::gemm_phase<pg8::EpiNull, pg8::StaticOrder, true, true>(lds_launder(lds), wv0, g, S, pg8::EpiNull());
            if (PHM(2)) RPT(2) pg8::gemm_phase<pg8::EpiIn, pg8::StaticOrder, true, true>(lds_launder(lds), wv0, g, S, E);
#endif
            SEAM(sb + PH_IN);
        }
        if (RUN(sb + PH_POST)) { if (PHM(3)) RPT(3) ph_post(l, wv0); SEAM(sb + PH_POST); }
        if (RUN(sb + PH_MIXA)) { if (PHM(4)) RPT(4) ph_idx_scores(lds_launder(lds), wv0); if (PHM(5)) RPT(16) ph_mlstm_m1(lds_launder(lds), l, wv0); if (PHM(6)) RPT(6) ph_diff_attn(lds_launder(lds), wv0); SEAM(sb + PH_MIXA); }
        if (RUN(sb + PH_SEL)) { if (PHM(5)) RPT(17) ph_mlstm_m2(wv0);  SEAM(sb + PH_SEL); }
        if (RUN(sb + PH_DSA)) { if (PHM(5)) RPT(18) ph_mlstm_m3(lds_launder(lds), l, wv0); if (PHM(8)) RPT(8) { ph_diff_post(l, wv0); ph_dsa_attn(lds_launder(lds), wv0); } SEAM(sb + PH_DSA); }
        if (RUN(sb + PH_OUT)) { CArgs* A = kargs();
            pg8::Gemm g{WS(bf16, WS_MIX), WS(bf16, WS_WOUT) + (size_t)l * D * D, T, D, D}; pg8::StaticOrder S; S.init(T, D, gsz_(), bid_());
            pg8::EpiBf16<0> E{WS(bf16, WS_Y), D, nullptr, 0, 0, 1.f};
            if ((RPTMASK >> 23) & 1u) pg8::gemm_phase<pg8::EpiNull, pg8::StaticOrder, true, true>(lds_launder(lds), wv0, g, S, pg8::EpiNull());
            if (PHM(9)) RPT(9) pg8::gemm_phase<pg8::EpiBf16<0>, pg8::StaticOrder, true, true>(lds_launder(lds), wv0, g, S, E);
            SEAM(sb + PH_OUT);
        }
        if (RUN(sb + PH_ROW1)) { if (PHM(10)) { if ((RPTMASK >> 10) & 1u) ph_row1(lds_launder(lds), l, wv0, true); ph_row1(lds_launder(lds), l, wv0); } SEAM(sb + PH_ROW1); }
        if (RUN(sb + PH_G1)) { CArgs* A = kargs();
            const int nrt = moe_tables(lds_launder(lds), l, wv0);
            pg8::Gemm g{WS(bf16, WS_U), (const bf16*)(WS(unsigned char, WS_W1) + (size_t)l * NEXP * 2048 * D), RPAD, NEXP * 2048, D / 2}; pg8::MoeOrder S; S.init(nrt, 8, gsz_(), bid_(), (const LAS unsigned char*)(lds_launder(lds) + TAB_OFF + 256));
            pg8::EpiSwiGLU<true> E{WS(bf16, WS_HM), A->in[I_B1] + (size_t)l * NEXP * 2048, 1.0f / 4096.0f, lds_launder(lds) + TAB_OFF + 2048};
            LAS unsigned char* tb = lds_launder(lds) + TAB_OFF;
            pg8::MoeGatherA AM{WS(unsigned, WS_XG), (const LAS unsigned*)tb, (const LAS unsigned*)(tb + 1024), (const LAS unsigned char*)(tb + 256), T, (LAS unsigned*)(tb + 4096)};
            if ((RPTMASK >> 20) & 1u) pg8::gemm_phase<pg8::EpiNull, pg8::MoeOrder, true, true, pg8::MoeGatherA, true>(lds_launder(lds), wv0, g, S, pg8::EpiNull(), AM, 0, 0);
            if ((RPTMASK >> 24) & 1u) pg8::gemm_phase<pg8::EpiSwiGLU<true>, pg8::MoeOrder, true, true, pg8::MoeGatherA, true>(lds_launder(lds), wv0, g, S, E, AM, 0, 0);
            if (PHM(12)) RPT(12) pg8::gemm_phase<pg8::EpiSwiGLU<true>, pg8::MoeOrder, true, true, pg8::MoeGatherA, true>(lds_launder(lds), wv0, g, S, E, AM, 0, 0);
            SEAM(sb + PH_G1);
        }
        if (RUN(sb + PH_G2)) { CArgs* A = kargs();
            const int nrt = moe_tables(lds_launder(lds), l, wv0);
            pg8::Gemm g{WS(bf16, WS_HM), (const bf16*)(WS(unsigned char, WS_W2) + (size_t)l * NEXP * D * D), RPAD, NEXP * D, D / 2}; pg8::MoeOrder S; S.init(nrt, 4, gsz_(), bid_(), (const LAS unsigned char*)(lds_launder(lds) + TAB_OFF + 256));
            pg8::EpiMoeOut E{WS(bf16, WS_YM), 1.0f / 2048.0f};
            if ((RPTMASK >> 21) & 1u) pg8::gemm_phase<pg8::EpiNull, pg8::MoeOrder, true, true, pg8::DirectA, true>(lds_launder(lds), wv0, g, S, pg8::EpiNull(), pg8::DirectA(), 0, 0);
            if ((RPTMASK >> 25) & 1u) pg8::gemm_phase<pg8::EpiMoeOut, pg8::MoeOrder, true, true, pg8::DirectA, true>(lds_launder(lds), wv0, g, S, E, pg8::DirectA(), 0, 0);
            if (PHM(13)) RPT(13) pg8::gemm_phase<pg8::EpiMoeOut, pg8::MoeOrder, true, true, pg8::DirectA, true>(lds_launder(lds), wv0, g, S, E, pg8::DirectA(), 0, 0);
            SEAM(sb + PH_G2);
        }
        if (RUN(sb + PH_ROW2)) { if (PHM(14)) { if ((RPTMASK >> 14) & 1u) ph_row2(lds_launder(lds), l, wv0, true); ph_row2(lds_launder(lds), l, wv0); } SEAM(sb + PH_ROW2); }
    }
#undef RUN
#undef SEAM
}

#ifndef MK_STEPS_PER_LAUNCH
#define MK_STEPS_PER_LAUNCH 1000
#endif
extern "C" void kernel_launch(void* const* d_in, const int* in_sizes, int n_in, void* d_out, int out_size, void* d_ws, size_t ws_size, hipStream_t stream) {
    static int grid = 0;
    if (grid == 0) {
        if (n_in != 25 || out_size != T * D || ws_size < WS_END4) { fprintf(stderr, "kernel_launch: unexpected shapes (n_in %d out %d ws %zu)\n", n_in, out_size, ws_size); grid = -1; return; }
        int dev = 0, cus = 0, per_cu = 0;
        if (hipGetDevice(&dev) != hipSuccess || hipDeviceGetAttribute(&cus, hipDeviceAttributeMultiprocessorCount, dev) != hipSuccess) { grid = -1; return; }
        if (hipFuncSetAttribute((const void*)mega_fwd, hipFuncAttributeMaxDynamicSharedMemorySize, LDS_BYTES) != hipSuccess) { fprintf(stderr, "kernel_launch: hipFuncSetAttribute failed\n"); grid = -1; return; }
        if (hipOccupancyMaxActiveBlocksPerMultiprocessor(&per_cu, (const void*)mega_fwd, NWAVES * 64, LDS_BYTES) != hipSuccess || per_cu < 1) { fprintf(stderr, "kernel_launch: occupancy query says %d\n", per_cu); }
        (void)hipGetLastError();
        grid = cus;
    }
    if (grid < 0) return;
    if (hipMemsetAsync((char*)d_ws + WS_CTL, 0, CTL_ZERO_BYTES, stream) != hipSuccess) return;
    Args a{};
    for (int i = 0; i < 25; ++i) a.in[i] = (const float*)d_in[i];
    a.out = (float*)d_out; a.ws = (unsigned char*)d_ws;
    int li = 0;
    for (int s = 0; s < NSTEPS; s += MK_STEPS_PER_LAUNCH, ++li) {
        a.s_lo = s; a.s_hi = (s + MK_STEPS_PER_LAUNCH < NSTEPS) ? s + MK_STEPS_PER_LAUNCH : NSTEPS; a.li = li; a.pad = 0;
        hipLaunchKernelGGL(mega_fwd, dim3(grid), dim3(NWAVES * 64), LDS_BYTES, stream, a);
    }
}
```

```cpp
#include <hip/hip_runtime.h>
#include <cstdio>
#include <cstdint>

__device__ __forceinline__ int lane_id_() { int l_; asm volatile("v_mbcnt_lo_u32_b32 %0, -1, 0\n\tv_mbcnt_hi_u32_b32 %0, -1, %0" : "=&v"(l_)); return l_; }
namespace pg8 {
#define PG8_LAS __attribute__((address_space(3)))
typedef unsigned short bf16_t;
typedef short bf16x8 __attribute__((ext_vector_type(8)));
typedef float f32x4 __attribute__((ext_vector_type(4)));
typedef unsigned u32x4 __attribute__((ext_vector_type(4)));
constexpr int BM = 256, BK = 64, HALF = 128, HTB = HALF * BK * 2  , STAGE_BYTES = 8 * HTB, NXCD = 8, WGM = 8;

__host__ __device__ __forceinline__ int lds_byte(int r, int c) { const int st = (r >> 4) * 2 + (c >> 5), rr = r & 15, cc = c & 31, ob = rr * 64 + cc * 2; return st * 1024 + (ob ^ (((ob >> 9) & 1) << 5)); }
__host__ __device__ __forceinline__ void stage_rc(int b, int& R, int& C) { const int st = b / 1024, sb = b % 1024, swz = sb ^ (((sb >> 9) & 1) << 5); R = (st >> 1) * 16 + swz / 64; C = (st & 1) * 32 + (swz % 64) / 2; }
__host__ __device__ __forceinline__ int perm32(int rho) { const int n = rho >> 4, i = rho & 15; return 8 * (i >> 2) + 4 * n + (i & 3); }

struct Unit { int pm, pn; };
struct Gemm { const bf16_t* A; const bf16_t* Bt; int M, N, K; };

struct StaticOrder {
    int nM, nN, nwg, G, c;
    __host__ __device__ void init(int M, int N, int G_, int c_) { nM = M / BM; nN = N / BM; nwg = nM * nN; G = G_; c = c_; }
    __host__ __device__ bool next(int i, Unit& u) const {
        const long L = (long)i * G + c; if (L >= nwg) return false;
        int wgid = (int)L; { const int q = nwg / NXCD, r = nwg % NXCD, xcd = wgid % NXCD, off = wgid / NXCD; wgid = (xcd < r ? xcd * (q + 1) : r * (q + 1) + (xcd - r) * q) + off; }
        const int nig = WGM * nN, gid = wgid / nig, fm = gid * WGM, gsz = (nM - fm) < WGM ? (nM - fm) : WGM;
        u.pm = fm + ((wgid % nig) % gsz); u.pn = (wgid % nig) / gsz; return true;
    }
    __device__ __forceinline__ void a_ready(const Unit&) const {}
    __device__ __forceinline__ void done(const Unit&) const {}
};
struct MoeOrder {
    int nM, nN, nwg, G, c; const PG8_LAS unsigned char* tile_e;
    __device__ void init(int nRT, int NTN, int G_, int c_, const PG8_LAS unsigned char* te) { nM = nRT; nN = NTN; nwg = nM * nN; G = G_; c = c_; tile_e = te; }
    __device__ bool next(int i, Unit& u) const {
        const long L = (long)i * G + c; if (L >= nwg) return false;
        int wgid = (int)L; { const int q = nwg / NXCD, r = nwg % NXCD, xcd = wgid % NXCD, off = wgid / NXCD; wgid = (xcd < r ? xcd * (q + 1) : r * (q + 1) + (xcd - r) * q) + off; }
        const int nig = WGM * nN, gid = wgid / nig, fm = gid * WGM, gsz = (nM - fm) < WGM ? (nM - fm) : WGM;
        u.pm = fm + ((wgid % nig) % gsz); const int pl = (wgid % nig) / gsz; u.pn = (int)tile_e[u.pm] * nN + pl; return true;
    }
    __device__ __forceinline__ void a_ready(const Unit&) const {}
    __device__ __forceinline__ void done(const Unit&) const {}
};
struct MoeGatherA {
    static constexpr bool GATHER = true;
    const unsigned* rowmap; const PG8_LAS unsigned* base; const PG8_LAS unsigned* cnt; const PG8_LAS unsigned char* tile_e; int ntok; PG8_LAS unsigned* slot;
    __device__ __forceinline__ const unsigned* tokptr(const Unit& u, int h, int rA) const {
        const int e = tile_e[u.pm]; const unsigned pos = (unsigned)u.pm * 256u - base[e] + 128u * h + (unsigned)rA;
        return rowmap + (size_t)e * ntok + (pos < cnt[e] ? pos : 0u);
    }
    __device__ __forceinline__ unsigned off(const Unit& u, int h, int rA, int cA, int K) const { return (*tokptr(u, h, rA) * (unsigned)K + (unsigned)cA) * 2u; }
};
__device__ __forceinline__ unsigned cvt_pk_bf16(float lo, float hi) { unsigned r; asm volatile("v_cvt_pk_bf16_f32 %0, %1, %2" : "=v"(r) : "v"(lo), "v"(hi)); return r; }
typedef float f32x2 __attribute__((ext_vector_type(2)));
__device__ __forceinline__ f32x2 gelu_pk(f32x2 v) {
    const f32x2 av = __builtin_elementwise_abs(v), d = av * 0.2316418882f + 1.0f;
    f32x2 t; t.x = __builtin_amdgcn_rcpf(d.x); t.y = __builtin_amdgcn_rcpf(d.y);
    f32x2 q = t * 0.5307027145f + (-0.7265760135f); q = q * t + 0.7107068705f; q = q * t + (-0.142248368f); q = q * t + 0.127414796f; q = q * t;
    const f32x2 s = (v * v) * (-0.72134752044f);
    f32x2 e; e.x = __builtin_amdgcn_exp2f(s.x); e.y = __builtin_amdgcn_exp2f(s.y);
    const f32x2 m = v * (q * e), r = v - m;
    f32x2 o; o.x = v.x < 0.f ? m.x : r.x; o.y = v.y < 0.f ? m.y : r.y; return o;
}

template <int ACT  > struct EpiBf16 {
    static constexpr bool PERM = true, AFTER_DRAIN = false, PREFETCH = false; static constexpr int NST = 16; static_assert(ACT == 0 || ACT == 1, "EpiBf16: ACT is 0 (none) or 1 (gelu_pk)");
    bf16_t* O; int ldc; const float* bias; int split_cols; size_t split_stride; float scale0;
    __device__ __forceinline__ void operator()(const f32x4 (&acc)[2][2][4][2], const Unit& u, int wr, int wc, int fr, int fq) const {
        const int row0 = u.pm * BM + wr * 64 + fr; int colt = u.pn * BM; bf16_t* base = O;
        float sc = 1.f; if (split_cols) { const int t = colt / split_cols; base += (size_t)t * split_stride; colt -= t * split_cols; if (t == 0) sc = scale0; }
        const int col0 = colt + wc * 32 + 8 * fq, bcol0 = u.pn * BM + wc * 32 + 8 * fq;
        f32x4 bv[2][2];
#pragma unroll
        for (int bj = 0; bj < 2; ++bj)
#pragma unroll
            for (int n = 0; n < 2; ++n) bv[bj][n] = bias ? *(const f32x4*)(bias + bcol0 + bj * HALF + 4 * n) : (f32x4){0.f, 0.f, 0.f, 0.f};
#pragma unroll
        for (int ai = 0; ai < 2; ++ai)
#pragma unroll
            for (int m = 0; m < 4; ++m) { bf16_t* rowp = base + (size_t)(row0 + ai * HALF + m * 16) * ldc + col0;
#pragma unroll
                for (int bj = 0; bj < 2; ++bj) { f32x4 v0 = acc[ai][bj][m][0] + bv[bj][0], v1 = acc[ai][bj][m][1] + bv[bj][1];
                    if (ACT == 1) { f32x2 a = gelu_pk((f32x2){v0[0], v0[1]}), b = gelu_pk((f32x2){v0[2], v0[3]}), c = gelu_pk((f32x2){v1[0], v1[1]}), d = gelu_pk((f32x2){v1[2], v1[3]});
                        v0 = (f32x4){a.x, a.y, b.x, b.y}; v1 = (f32x4){c.x, c.y, d.x, d.y}; }
                    v0 = v0 * sc; v1 = v1 * sc; u32x4 w; w.x = cvt_pk_bf16(v0[0], v0[1]); w.y = cvt_pk_bf16(v0[2], v0[3]); w.z = cvt_pk_bf16(v1[0], v1[1]); w.w = cvt_pk_bf16(v1[2], v1[3]);
                    *(u32x4*)(rowp + bj * HALF) = w; } }
    }
};
constexpr float C2 = 0.125f * 1.4426950408889634f;
struct EpiIn {
    static constexpr bool PERM = true, AFTER_DRAIN = false, PREFETCH = false; static constexpr int NST = 16;
    bf16_t* O; const unsigned* cs; float asc;
    static __device__ __forceinline__ float h_lo(unsigned w) { return (float)__builtin_bit_cast(_Float16, (unsigned short)(w & 0xffffu)); }
    static __device__ __forceinline__ float h_hi(unsigned w) { return (float)__builtin_bit_cast(_Float16, (unsigned short)(w >> 16)); }
    __device__ __forceinline__ void operator()(const f32x4 (&acc)[2][2][4][2], const Unit& u, int wr, int wc, int fr, int fq) const {
        const int pn = u.pn;
        const bool rope = (0x6CF0 >> pn) & 1;
        const float sc = (((0x0430 >> pn) & 1) ? C2 : 1.f) * asc;
        const int row0 = u.pm * BM + wr * 64 + fr, col0 = pn * BM + wc * 32 + 8 * fq, i0 = (wc & 1) * 16 + 4 * fq;
        u32x4 cw[2][4];
#pragma unroll
        for (int ai = 0; ai < 2; ++ai)
#pragma unroll
            for (int m = 0; m < 4; ++m) cw[ai][m] = (u32x4){0x3C00u, 0x3C00u, 0x3C00u, 0x3C00u};
        if (rope) {
#pragma unroll
            for (int ai = 0; ai < 2; ++ai)
#pragma unroll
                for (int m = 0; m < 4; ++m) cw[ai][m] = *(const u32x4*)(cs + (size_t)(row0 + ai * HALF + m * 16) * 32 + i0);
        }
#pragma unroll
        for (int ai = 0; ai < 2; ++ai) {
#pragma unroll
            for (int m = 0; m < 4; ++m) {
                const int row = row0 + ai * HALF + m * 16;
                const u32x4 cq = cw[ai][m];
                const f32x4 ca = (f32x4){h_lo(cq.x), h_hi(cq.x), h_lo(cq.y), h_hi(cq.y)} * sc, cb = (f32x4){h_lo(cq.z), h_hi(cq.z), h_lo(cq.w), h_hi(cq.w)} * sc;
                bf16_t* rowp = O + (size_t)row * 4096 + col0;
#pragma unroll
                for (int bj = 0; bj < 2; ++bj) {
                    const f32x4 v0 = acc[ai][bj][m][0], v1 = acc[ai][bj][m][1];
                    f32x4 r0, r1;
                    r0[0] = v0[0] * ca[0] - v0[1] * ca[1]; r0[1] = v0[1] * ca[0] + v0[0] * ca[1];
                    r0[2] = v0[2] * ca[2] - v0[3] * ca[3]; r0[3] = v0[3] * ca[2] + v0[2] * ca[3];
                    r1[0] = v1[0] * cb[0] - v1[1] * cb[1]; r1[1] = v1[1] * cb[0] + v1[0] * cb[1];
                    r1[2] = v1[2] * cb[2] - v1[3] * cb[3]; r1[3] = v1[3] * cb[2] + v1[2] * cb[3];
                    u32x4 w; w.x = cvt_pk_bf16(r0[0], r0[1]); w.y = cvt_pk_bf16(r0[2], r0[3]); w.z = cvt_pk_bf16(r1[0], r1[1]); w.w = cvt_pk_bf16(r1[2], r1[3]);
                    *(u32x4*)(rowp + bj * HALF) = w;
                }
            }
            asm volatile("" ::: "memory");
        }
    }
};
__device__ __forceinline__ unsigned pk4_fp8(float a, float b, float c, float d, float sc) {
    a = fminf(fmaxf(a * sc, -448.f), 448.f); b = fminf(fmaxf(b * sc, -448.f), 448.f); c = fminf(fmaxf(c * sc, -448.f), 448.f); d = fminf(fmaxf(d * sc, -448.f), 448.f);
    int w = __builtin_amdgcn_cvt_pk_fp8_f32(a, b, 0, false); w = __builtin_amdgcn_cvt_pk_fp8_f32(c, d, w, true); return (unsigned)w; }
__device__ __forceinline__ unsigned pk4_fp8_raw(float a, float b, float c, float d) { int w = __builtin_amdgcn_cvt_pk_fp8_f32(a, b, 0, false); w = __builtin_amdgcn_cvt_pk_fp8_f32(c, d, w, true); return (unsigned)w; }
template <bool F8OUT> struct EpiSwiGLU {
    static constexpr bool PERM = true, AFTER_DRAIN = false, PREFETCH = true; static constexpr int NST = 8;
    bf16_t* O; const float* b1; float asc; PG8_LAS unsigned char* side;
    __device__ __forceinline__ void prefetch(const Unit& u, int slot, int wid, int lane) const {
        if (wid == 0) { const int ln = lane_id_(); const int e = u.pn >> 3, pl = u.pn & 7; const float* ub = b1 + (size_t)e * 2048 + pl * 128; asm("" : "+s"(ub)); const float* src = ub + ((ln & 32) ? 1024 : 0) + (ln & 31) * 4;
            __builtin_amdgcn_global_load_lds((const unsigned*)src, (PG8_LAS unsigned*)(side + slot * 1024), 16, 0, 0); } }
    __device__ __forceinline__ void operator()(const f32x4 (&acc)[2][2][4][2], const Unit& u, int wr, int wc, int fr, int fq, int slot) const {
        constexpr float OS = F8OUT ? 8.0f : 1.0f;
        const int pl = u.pn & 7, colh = pl * 128 + wc * 32 + 8 * fq;
        const PG8_LAS float* bp = (const PG8_LAS float*)(side + slot * 1024) + wc * 32 + 8 * fq;
        f32x4 bg[2], bu[2];
#pragma unroll
        for (int n = 0; n < 2; ++n) { bg[n] = *(const PG8_LAS f32x4*)(bp + 4 * n); bu[n] = *(const PG8_LAS f32x4*)(bp + 128 + 4 * n); }
        const int row0 = u.pm * BM + wr * 64 + fr;
#pragma unroll
        for (int ai = 0; ai < 2; ++ai)
#pragma unroll
            for (int m = 0; m < 4; ++m) {
                f32x4 o[2];
#pragma unroll
                for (int n = 0; n < 2; ++n) {
                    const f32x4 g4 = acc[ai][0][m][n] * asc + bg[n], u4 = acc[ai][1][m][n] * asc + bu[n];
#pragma unroll
                    for (int c = 0; c < 4; ++c) {
                        const float g = fminf(g4[c], 7.0f), up = fminf(fmaxf(u4[c], -7.0f), 7.0f);
                        const float sg = __builtin_amdgcn_rcpf(1.0f + __builtin_amdgcn_exp2f(-1.702f * 1.4426950408889634f * g));
                        o[n][c] = (up * OS + OS) * (g * sg);
                    }
                }
                if constexpr (F8OUT) { typedef unsigned u32x2_ __attribute__((ext_vector_type(2))); u32x2_ w; w.x = pk4_fp8_raw(o[0][0], o[0][1], o[0][2], o[0][3]); w.y = pk4_fp8_raw(o[1][0], o[1][1], o[1][2], o[1][3]);
                    *(u32x2_*)((unsigned char*)O + (size_t)(row0 + ai * HALF + m * 16) * 1024 + colh) = w; }
                else { u32x4 w; w.x = cvt_pk_bf16(o[0][0], o[0][1]); w.y = cvt_pk_bf16(o[0][2], o[0][3]); w.z = cvt_pk_bf16(o[1][0], o[1][1]); w.w = cvt_pk_bf16(o[1][2], o[1][3]);
                    *(u32x4*)(O + (size_t)(row0 + ai * HALF + m * 16) * 1024 + colh) = w; }
            }
    }
};
struct EpiMoeOut {
    static constexpr bool PERM = true, AFTER_DRAIN = false, PREFETCH = false; static constexpr int NST = 8;
    bf16_t* O; float asc;
    __device__ __forceinline__ void operator()(const f32x4 (&acc)[2][2][4][2], const Unit& u, int wr, int wc, int fr, int fq) const {
        const int row0 = u.pm * BM + wr * 64 + fr, col0 = (u.pn & 3) * BM + wc * 64 + 16 * fq;
#pragma unroll
        for (int ai = 0; ai < 2; ++ai)
#pragma unroll
            for (int m = 0; m < 4; ++m) { unsigned char* rowp = (unsigned char*)O + (size_t)(row0 + ai * HALF + m * 16) * 1024 + col0;
                u32x4 w;
                { const f32x4 v0 = acc[ai][0][m][0], v1 = acc[ai][0][m][1]; w.x = pk4_fp8(v0[0], v0[1], v0[2], v0[3], 64.0f * asc); w.y = pk4_fp8(v1[0], v1[1], v1[2], v1[3], 64.0f * asc); }
                { const f32x4 v0 = acc[ai][1][m][0], v1 = acc[ai][1][m][1]; w.z = pk4_fp8(v0[0], v0[1], v0[2], v0[3], 64.0f * asc); w.w = pk4_fp8(v1[0], v1[1], v1[2], v1[3], 64.0f * asc); }
                *(u32x4*)rowp = w; }
    }
};

struct EpiNull { static constexpr bool PERM = true, AFTER_DRAIN = false, PREFETCH = false;
    __device__ __forceinline__ void operator()(const f32x4 (&acc)[2][2][4][2], const Unit& u, int wr, int wc, int fr, int fq) const {
#pragma unroll
        for (int a = 0; a < 2; ++a)
#pragma unroll
            for (int b = 0; b < 2; ++b)
#pragma unroll
                for (int m = 0; m < 4; ++m)
#pragma unroll
                    for (int n = 0; n < 2; ++n) asm volatile("" :: "v"(acc[a][b][m][n]));
    } };
struct DirectA { static constexpr bool GATHER = false; __device__ __forceinline__ unsigned off(const Unit&, int, int, int, int) const { return 0u; } };
typedef int v8i32 __attribute__((ext_vector_type(8)));
template <class E, class = void> struct epi_nst { static constexpr int v = 0; };
template <class E> struct epi_nst<E, decltype((void)E::NST)> { static constexpr int v = E::NST; };
template <class Epi, class Sched, bool ALIGN_EPI = false, bool SP2 = false, class AMap = DirectA, bool F8 = false>
__device__ __forceinline__ void gemm_phase(PG8_LAS unsigned char* lds, int wvx, const Gemm g, const Sched& S, const Epi& E, const AMap& AM = AMap(), int scA = 0x7f7f7f7f, int scB = 0x7f7f7f7f) {
    int tid_ = wvx * 64 + lane_id_(); asm volatile("" : "+v"(tid_));
    const int tid = tid_, wid = __builtin_amdgcn_readfirstlane(tid >> 6), lane = tid & 63, wr = wid >> 2, wc = wid & 3, fr = lane & 15, fq = lane >> 4;
    const int K = g.K, nt = K / BK;
    unsigned voffB[2], vA[2];
#pragma unroll
    for (int i = 0; i < 2; ++i) { int R, C; stage_rc(tid * 16 + i * 8192, R, C); const int Rb = Epi::PERM ? ((R & ~31) + perm32(R & 31)) : R;
        vA[i] = (unsigned)(R * K + C) * 2u; voffB[i] = (unsigned)(Rb * K + C) * 2u; }
    const size_t kstep = (size_t)(BK * 2);
    const size_t hstep = (size_t)HALF * K * 2;
    const size_t tstep = 2 * hstep;
    const unsigned ldsw = (unsigned)wid * 1024u;
    const int aoff = lds_byte(wr * 64 + fr, fq * 8), boff = lds_byte(wc * 32 + fr, fq * 8);
#define PG8_SA(b, h) (((b) * 2 + (h)) * HTB)
#define PG8_SB(b, h) ((4 + (b) * 2 + (h)) * HTB)
#define PG8_STAGEA(bufoff, kb, h, nx) do { size_t ubx_ = (size_t)(kb); unsigned lo_[2]; \
        if constexpr (AMap::GATHER) { _Pragma("unroll") for (int _i = 0; _i < 2; ++_i) lo_[_i] = (nx) ? oN[h][_i] : oC[h][_i]; } \
        else { ubx_ += (nx) ? uN[h] : uC[h]; _Pragma("unroll") for (int _i = 0; _i < 2; ++_i) lo_[_i] = vA[_i]; } \
        const char* ub_ = Abase + ubx_; asm("" : "+s"(ub_)); _Pragma("unroll") for (int _i = 0; _i < 2; ++_i) asm("" : "+v"(lo_[_i]));     \
        _Pragma("unroll") for (int _i = 0; _i < 2; ++_i) \
        __builtin_amdgcn_global_load_lds((const unsigned*)(ub_ + lo_[_i]), (PG8_LAS unsigned*)(lds + (bufoff) + ldsw + _i * 8192), 16, 0, 0); } while (0)
#define PG8_AOFF(dstL, dstU, u) do { if constexpr (AMap::GATHER) { int t2_ = wvx * 64 + lane_id_(); asm volatile("" : "+v"(t2_)); _Pragma("unroll") for (int _i = 0; _i < 2; ++_i) { int R_, C_; stage_rc(t2_ * 16 + _i * 8192, R_, C_); \
            _Pragma("unroll") for (int _h = 0; _h < 2; ++_h) dstL[_h][_i] = AM.off(u, _h, R_, C_, K); } } \
        else { _Pragma("unroll") for (int _h = 0; _h < 2; ++_h) dstU[_h] = ((size_t)(u).pm * BM + 128 * _h) * (size_t)K * 2; } } while (0)
#define PG8_TOKDMA(u) do { int t2_ = wvx * 64 + lane_id_(); asm volatile("" : "+v"(t2_)); _Pragma("unroll") for (int _i = 0; _i < 2; ++_i) { int R_, C_; stage_rc(t2_ * 16 + _i * 8192, R_, C_); \
            _Pragma("unroll") for (int _h = 0; _h < 2; ++_h) __builtin_amdgcn_global_load_lds(AM.tokptr(u, _h, R_), AM.slot + wvx * 256 + (_h * 2 + _i) * 64, 4, 0, 0); } } while (0)
#define PG8_TOKOFF(dstL) do { int t2_ = wvx * 64 + lane_id_(); asm volatile("" : "+v"(t2_)); _Pragma("unroll") for (int _i = 0; _i < 2; ++_i) { int R_, C_; stage_rc(t2_ * 16 + _i * 8192, R_, C_); \
            _Pragma("unroll") for (int _h = 0; _h < 2; ++_h) dstL[_h][_i] = (AM.slot[wvx * 256 + (_h * 2 + _i) * 64 + (t2_ & 63)] * (unsigned)K + (unsigned)C_) * 2u; } } while (0)
#define PG8_STAGE(bufoff, gbase, voff) do { const char* ub_ = (const char*)(gbase); asm("" : "+s"(ub_)); _Pragma("unroll") for (int _i = 0; _i < 2; ++_i) \
        __builtin_amdgcn_global_load_lds((const unsigned*)(ub_ + (voff)[_i]), (PG8_LAS unsigned*)(lds + (bufoff) + ldsw + _i * 8192), 16, 0, 0); } while (0)
#define PG8_LDA(dst, b, h) do { _Pragma("unroll") for (int m = 0; m < 4; ++m) _Pragma("unroll") for (int k = 0; k < 2; ++k) dst[m][k] = *(const PG8_LAS bf16x8*)(lds + PG8_SA(b, h) + aoff + m * 2048 + k * 1024); } while (0)
#define PG8_LDB(dst, b, h) do { _Pragma("unroll") for (int n = 0; n < 2; ++n) _Pragma("unroll") for (int k = 0; k < 2; ++k) dst[n][k] = *(const PG8_LAS bf16x8*)(lds + PG8_SB(b, h) + boff + n * 2048 + k * 1024); } while (0)
#define PG8_CAT(x) __builtin_bit_cast(v8i32, __builtin_shufflevector(x[0], x[1], 0, 1, 2, 3, 4, 5, 6, 7, 8, 9, 10, 11, 12, 13, 14, 15))
#define PG8_MMA(ai, bj, At, Bt) do { __builtin_amdgcn_s_setprio(1); _Pragma("unroll") for (int m = 0; m < 4; ++m) _Pragma("unroll") for (int n = 0; n < 2; ++n) { \
        if constexpr (F8) acc[ai][bj][m][n] = __builtin_amdgcn_mfma_scale_f32_16x16x128_f8f6f4(PG8_CAT(Bt[n]), PG8_CAT(At[m]), acc[ai][bj][m][n], 0, 0, 0, scB, 0, scA); \
        else { _Pragma("unroll") for (int k = 0; k < 2; ++k) acc[ai][bj][m][n] = __builtin_amdgcn_mfma_f32_16x16x32_bf16(Bt[n][k], At[m][k], acc[ai][bj][m][n], 0, 0, 0); } } __builtin_amdgcn_s_setprio(0); } while (0)
#define PG8_WAIT_V(n) asm volatile("s_waitcnt vmcnt(" #n ")" ::: "memory")
#define PG8_WAIT_VR(n) do { if (rlx) asm volatile("s_waitcnt vmcnt(%0)" :: "n"((n) + epi_nst<Epi>::v) : "memory"); else PG8_WAIT_V(n); } while (0)
#define PG8_WAIT_L(n) asm volatile("s_waitcnt lgkmcnt(" #n ")" ::: "memory")
#define PG8_BAR __builtin_amdgcn_s_barrier()
#define PG8_SCHED __builtin_amdgcn_sched_barrier(0)
    Unit cur, nxt; int ui = 0;
    if (!S.next(0, cur)) return;
    f32x4 acc[2][2][4][2];
#pragma unroll
    for (int a = 0; a < 2; ++a)
#pragma unroll
        for (int b = 0; b < 2; ++b)
#pragma unroll
            for (int m = 0; m < 4; ++m)
#pragma unroll
                for (int n = 0; n < 2; ++n) acc[a][b][m][n] = (f32x4){0.f, 0.f, 0.f, 0.f};
    bf16x8 At[4][2], B0[2][2], B1[2][2];
    const char* Abase = (const char*)g.A; const char* cB = (const char*)g.Bt + (size_t)cur.pn * tstep;
    unsigned oC[2][2], oN[2][2]; size_t uC[2] = {0, 0}, uN[2] = {0, 0}; PG8_AOFF(oC, uC, cur); if constexpr (AMap::GATHER) { _Pragma("unroll") for (int _h = 0; _h < 2; ++_h) { oN[_h][0] = oC[_h][0]; oN[_h][1] = oC[_h][1]; } }
    if constexpr (AMap::GATHER) { Unit n1_; if (S.next(1, n1_)) PG8_TOKDMA(n1_); }
    S.a_ready(cur);
    if constexpr (Epi::PREFETCH) E.prefetch(cur, 0, wid, lane);
    if constexpr (SP2) {
        PG8_STAGE(PG8_SB(0, 0), cB, voffB); PG8_STAGE(PG8_SB(0, 1), cB + hstep, voffB); PG8_STAGEA(PG8_SA(0, 0), 0, 0, false); PG8_STAGEA(PG8_SA(0, 1), 0, 1, false);
        if (wr == 1) PG8_BAR;
        PG8_WAIT_V(2); PG8_BAR;
        PG8_STAGE(PG8_SB(1, 0), cB + kstep, voffB); PG8_STAGEA(PG8_SA(1, 0), kstep, 0, false); PG8_STAGE(PG8_SB(1, 1), cB + hstep + kstep, voffB);
        PG8_WAIT_V(6); PG8_BAR;
    } else {
        PG8_STAGE(PG8_SB(0, 0), cB, voffB); PG8_STAGEA(PG8_SA(0, 0), 0, 0, false); PG8_STAGE(PG8_SB(0, 1), cB + hstep, voffB); PG8_STAGEA(PG8_SA(0, 1), 0, 1, false);
        if (wr == 1) PG8_BAR;
        PG8_WAIT_V(4); PG8_BAR;
        PG8_STAGE(PG8_SB(1, 0), cB + kstep, voffB); PG8_STAGEA(PG8_SA(1, 0), kstep, 0, false); PG8_STAGE(PG8_SB(1, 1), cB + hstep + kstep, voffB);
        PG8_WAIT_V(6); PG8_BAR;
    }
    for (;;) {
        const bool has_next = S.next(ui + 1, nxt);
        if constexpr (Epi::PREFETCH) { if (has_next) E.prefetch(nxt, (ui + 1) & 1, wid, lane); }
        const char* nB = has_next ? (const char*)g.Bt + (size_t)nxt.pn * tstep : cB;
        if constexpr (!AMap::GATHER) { if (has_next) { PG8_AOFF(oN, uN, nxt); } else {
#pragma unroll
            for (int _h = 0; _h < 2; ++_h) { uN[_h] = uC[_h]; } } }
#pragma unroll 1
        for (int t = 0; t < nt; t += 2) {
            const bool last = (t == nt - 2), rlx = SP2 && (t == 0) && (ui > 0);
            const size_t ka1 = (size_t)(t + 1) * kstep, ka2 = last ? (size_t)0 : (size_t)(t + 2) * kstep, ka3 = ka2 + kstep;
            const char* b2 = last ? nB : cB + (size_t)(t + 2) * kstep; const char* b3 = b2 + kstep;
            if (last && has_next) S.a_ready(nxt);
            if constexpr (AMap::GATHER) { if (last) { if (has_next) { PG8_TOKOFF(oN); } else {
#pragma unroll
                for (int _h = 0; _h < 2; ++_h) { oN[_h][0] = oC[_h][0]; oN[_h][1] = oC[_h][1]; } } } }
            if constexpr (SP2) {
            PG8_LDB(B0, 0, 0); PG8_LDB(B1, 0, 1); PG8_SCHED; PG8_LDA(At, 0, 0); if (!(ALIGN_EPI && rlx)) PG8_STAGEA(PG8_SA(1, 1), ka1, 1, false);
            PG8_WAIT_VR(8); PG8_WAIT_L(0); PG8_BAR; PG8_MMA(0, 0, At, B0); PG8_MMA(0, 1, At, B1); PG8_BAR; PG8_SCHED;
            PG8_LDA(At, 0, 1); PG8_STAGE(PG8_SB(0, 0), b2, voffB); PG8_STAGE(PG8_SB(0, 1), b2 + hstep, voffB); PG8_STAGEA(PG8_SA(0, 0), ka2, 0, last);
            PG8_WAIT_VR(8); PG8_WAIT_L(0); PG8_BAR; PG8_MMA(1, 0, At, B0); PG8_MMA(1, 1, At, B1); PG8_BAR; PG8_SCHED;
            PG8_LDB(B0, 1, 0); PG8_LDB(B1, 1, 1); PG8_SCHED; PG8_LDA(At, 1, 0); PG8_STAGEA(PG8_SA(0, 1), ka2, 1, last);
            if constexpr (ALIGN_EPI) PG8_WAIT_VR(8); else PG8_WAIT_V(8); PG8_WAIT_L(0); PG8_BAR; PG8_MMA(0, 0, At, B0); PG8_MMA(0, 1, At, B1); PG8_BAR; PG8_SCHED;
            PG8_LDA(At, 1, 1); PG8_STAGE(PG8_SB(1, 0), b3, voffB); PG8_STAGE(PG8_SB(1, 1), b3 + hstep, voffB); PG8_STAGEA(PG8_SA(1, 0), ka3, 0, last);
            PG8_WAIT_V(8); PG8_WAIT_L(0); PG8_BAR; PG8_MMA(1, 0, At, B0); PG8_MMA(1, 1, At, B1); PG8_BAR; PG8_SCHED;
            } else {
            PG8_LDB(B0, 0, 0); PG8_SCHED; PG8_LDA(At, 0, 0); PG8_STAGEA(PG8_SA(1, 1), ka1, 1, false);
            PG8_WAIT_L(8); PG8_BAR; PG8_WAIT_L(0); PG8_MMA(0, 0, At, B0); PG8_BAR; PG8_SCHED;
            PG8_LDB(B1, 0, 1); PG8_STAGE(PG8_SB(0, 0), b2, voffB);
            PG8_BAR; PG8_WAIT_L(0); PG8_MMA(0, 1, At, B1); PG8_BAR;
            PG8_LDA(At, 0, 1); PG8_STAGEA(PG8_SA(0, 0), ka2, 0, last);
            PG8_BAR; PG8_WAIT_L(0); PG8_MMA(1, 0, At, B0); PG8_BAR; PG8_SCHED;
            PG8_STAGE(PG8_SB(0, 1), b2 + hstep, voffB);
            PG8_WAIT_V(6); PG8_BAR; PG8_MMA(1, 1, At, B1); PG8_BAR;
            PG8_LDB(B0, 1, 0); PG8_SCHED; PG8_LDA(At, 1, 0); PG8_STAGEA(PG8_SA(0, 1), ka2, 1, last);
            PG8_WAIT_L(8); PG8_BAR; PG8_WAIT_L(0); PG8_MMA(0, 0, At, B0); PG8_BAR; PG8_SCHED;
            PG8_LDB(B1, 1, 1); PG8_STAGE(PG8_SB(1, 0), b3, voffB);
            PG8_BAR; PG8_WAIT_L(0); PG8_MMA(0, 1, At, B1); PG8_BAR;
            PG8_LDA(At, 1, 1); PG8_STAGEA(PG8_SA(1, 0), ka3, 0, last);
            PG8_BAR; PG8_WAIT_L(0); PG8_MMA(1, 0, At, B0); PG8_BAR; PG8_SCHED;
            PG8_STAGE(PG8_SB(1, 1), b3 + hstep, voffB);
            PG8_WAIT_V(6); PG8_BAR; PG8_MMA(1, 1, At, B1); PG8_BAR;
            }
        }
        if constexpr (ALIGN_EPI) { if (wr == 0) PG8_BAR; }
        if constexpr (ALIGN_EPI && SP2) { if (has_next) PG8_STAGEA(PG8_SA(1, 1), kstep, 1, true); PG8_SCHED; }
        if constexpr (AMap::GATHER) { if (has_next) { Unit n2_; if (S.next(ui + 2, n2_)) PG8_TOKDMA(n2_); } }
        if constexpr (!Epi::AFTER_DRAIN) { const int l2_ = lane_id_(); const int fr_ = l2_ & 15, fq_ = l2_ >> 4;
            if constexpr (Epi::PREFETCH) E(acc, cur, wr, wc, fr_, fq_, ui & 1); else E(acc, cur, wr, wc, fr_, fq_); S.done(cur); }
        if (!has_next) break;
#pragma unroll
        for (int a = 0; a < 2; ++a)
#pragma unroll
            for (int b = 0; b < 2; ++b)
#pragma unroll
                for (int m = 0; m < 4; ++m)
#pragma unroll
                    for (int n = 0; n < 2; ++n) acc[a][b][m][n] = (f32x4){0.f, 0.f, 0.f, 0.f};
        cur = nxt; cB = nB; ++ui;
#pragma unroll
        for (int _h = 0; _h < 2; ++_h) { oC[_h][0] = oN[_h][0]; oC[_h][1] = oN[_h][1]; uC[_h] = uN[_h]; }
        if constexpr (ALIGN_EPI) { if (wr == 1) PG8_BAR; }
    }
    PG8_WAIT_V(0);
    if constexpr (!ALIGN_EPI) { if (wr == 0) PG8_BAR; }
    PG8_BAR;
    if constexpr (Epi::AFTER_DRAIN) { E.fused(acc, cur, wr, wc, fr, fq, lds, wid, lane); S.done(cur); }
#undef PG8_SA
#undef PG8_SB
#undef PG8_STAGE
#undef PG8_STAGEA
#undef PG8_AOFF
#undef PG8_TOKDMA
#undef PG8_TOKOFF
#undef PG8_LDA
#undef PG8_LDB
#undef PG8_MMA
#undef PG8_CAT
#undef PG8_WAIT_V
#undef PG8_WAIT_VR
#undef PG8_WAIT_L
#undef PG8_BAR
#undef PG8_SCHED
}
}
namespace attn_body {
using bf16=unsigned short;
using bf16x8=__attribute__((ext_vector_type(8)))short;
using s16x4=__attribute__((ext_vector_type(4)))short;
using f32x16=__attribute__((ext_vector_type(16)))float;
using u32x4=__attribute__((ext_vector_type(4)))unsigned;
constexpr int SEQ=2048,D=64,DM=4096,DMO=1024;
constexpr int NW=8,QBLK=32,QB=QBLK*NW,KVBLK=64,NQB=SEQ/QB;
__device__ __forceinline__ unsigned f2bf_(float f){unsigned u=__builtin_bit_cast(unsigned,f);return (u+0x7fffu+((u>>16)&1u))>>16;}
__device__ __forceinline__ int crow(int r,int hi){return (r&3)+8*(r>>2)+4*hi;}
#define SBAR() __builtin_amdgcn_sched_barrier(0)
__device__ __forceinline__ void cmask(f32x16&p0,f32x16&p1,int jb,int qrel,int hi){
  const float NEG=-INFINITY; int kb=64*jb+4*hi;
  #pragma unroll
  for(int r=0;r<16;++r){int kv=kb+(r&3)+8*(r>>2); if(kv>qrel)p0[r]=NEG; if(kv+32>qrel)p1[r]=NEG;}
}

__device__ __forceinline__ uint2 mld_asm(const unsigned*p){ uint2 v; asm volatile("global_load_dwordx2 %0, %1, off":"=v"(v):"v"(p):"memory"); return v; }
__device__ __forceinline__ void bmask(f32x16&p0,f32x16&p1,uint2 w,int hi){
  const float NEG=-INFINITY; const unsigned a=w.x>>(4*hi), b=w.y>>(4*hi);
  #pragma unroll
  for(int r=0;r<16;++r){const int bit=(r&3)+8*(r>>2); if(!((a>>bit)&1u))p0[r]=NEG; if(!((b>>bit)&1u))p1[r]=NEG;}
}
constexpr int NSLOT=3, SLOTB=8192;
constexpr int LDS_K=0, LDS_V=NSLOT*SLOTB, LDS_WS=2*NSLOT*SLOTB, LDS_OST=LDS_WS+NW*64*4, LDS_BYTES=LDS_OST+NW*4096;
constexpr float C2=0.125f*1.4426950408889634f;
__device__ __forceinline__ void glds16(const void*gsrc,unsigned lds_dst){unsigned keep;
  asm volatile("s_mov_b32 %0, m0\n\ts_mov_b32 m0, %2\n\ts_nop 0\n\tglobal_load_lds_dwordx4 %1, off\n\ts_mov_b32 m0, %0":"=&s"(keep):"v"(gsrc),"s"(lds_dst):"memory");}
__device__ __forceinline__ float max3f(float a,float b,float c){float r;asm("v_max3_f32 %0, %1, %2, %3":"=v"(r):"v"(a),"v"(b),"v"(c));return r;}
__device__ __forceinline__ float max2f(float a,float b){float r;asm("v_max_f32_e32 %0, %1, %2":"=v"(r):"v"(a),"v"(b));return r;}
__device__ __forceinline__ float fadd_s(float a,float b){float r;asm("v_add_f32_e32 %0, %1, %2":"=v"(r):"v"(a),"v"(b));return r;}
__device__ __forceinline__ float fsub_s(float a,float b){float r;asm("v_sub_f32_e32 %0, %1, %2":"=v"(r):"v"(a),"v"(b));return r;}
typedef float f32x2_t __attribute__((ext_vector_type(2))); typedef __bf16 bf16x2_t __attribute__((ext_vector_type(2)));
__device__ __forceinline__ unsigned cvtpk_s(float lo,float hi){f32x2_t v={lo,hi};bf16x2_t b=__builtin_convertvector(v,bf16x2_t);return __builtin_bit_cast(unsigned,b);}
#define WAIT_BAR(N) asm volatile("s_waitcnt vmcnt(" #N ") lgkmcnt(0)\n\ts_barrier":::"memory")

__device__ __forceinline__ void qkt(f32x16&p0,f32x16&p1,const char*Kslot,const bf16x8*qr,const f32x16&negm,int r32,int hi){
  const char*kb=Kslot+hi*1024+r32*16;
  #pragma unroll
  for(int d0=0;d0<4;++d0){
    const bf16x8 b0=*reinterpret_cast<const bf16x8*>(kb+d0*2048);
    const bf16x8 b1=*reinterpret_cast<const bf16x8*>(kb+d0*2048+512);
    if(d0==0){p0=__builtin_amdgcn_mfma_f32_32x32x16_bf16(b0,qr[0],negm,0,0,0);p1=__builtin_amdgcn_mfma_f32_32x32x16_bf16(b1,qr[0],negm,0,0,0);}
    else{p0=__builtin_amdgcn_mfma_f32_32x32x16_bf16(b0,qr[d0],p0,0,0,0);p1=__builtin_amdgcn_mfma_f32_32x32x16_bf16(b1,qr[d0],p1,0,0,0);}}
}
typedef __attribute__((address_space(3))) const char* lds_cptr;
typedef short v4i16_t __attribute__((ext_vector_type(4)));
__device__ __forceinline__ void kload8(bf16x8*kf,lds_cptr kp){
  kf[0]=*(const __attribute__((address_space(3))) bf16x8*)(kp);      kf[1]=*(const __attribute__((address_space(3))) bf16x8*)(kp+512);
  kf[2]=*(const __attribute__((address_space(3))) bf16x8*)(kp+2048); kf[3]=*(const __attribute__((address_space(3))) bf16x8*)(kp+2560);
  kf[4]=*(const __attribute__((address_space(3))) bf16x8*)(kp+4096); kf[5]=*(const __attribute__((address_space(3))) bf16x8*)(kp+4608);
  kf[6]=*(const __attribute__((address_space(3))) bf16x8*)(kp+6144); kf[7]=*(const __attribute__((address_space(3))) bf16x8*)(kp+6656);
}
__device__ __forceinline__ void kload2(bf16x8*kf,lds_cptr kp,int j){ kf[2*j]=*(const __attribute__((address_space(3))) bf16x8*)(kp+j*2048); kf[2*j+1]=*(const __attribute__((address_space(3))) bf16x8*)(kp+j*2048+512); }
__device__ __forceinline__ s16x4 vtr(lds_cptr p){ return __builtin_bit_cast(s16x4,__builtin_amdgcn_ds_read_tr16_b64_v4i16((__attribute__((address_space(3))) v4i16_t*)p)); }
__device__ __forceinline__ float rowmax(const f32x16&p0,const f32x16&p1){
  float a=max3f(p0[0],p0[1],p1[0]),b=max3f(p0[2],p0[3],p1[1]);a=max3f(a,p1[2],p1[3]);
  #pragma unroll
  for(int r=4;r<16;r+=4){a=max3f(a,p0[r],p0[r+1]);b=max3f(b,p0[r+2],p0[r+3]);a=max3f(a,p1[r],p1[r+1]);b=max3f(b,p1[r+2],p1[r+3]);}
  const float m=max2f(a,b);
  auto rr=__builtin_amdgcn_permlane32_swap(__float_as_uint(m),__float_as_uint(m),false,false);
  return max2f(__uint_as_float(rr[0]),__uint_as_float(rr[1]));
}
__device__ __forceinline__ void pv(f32x16*o,int vb,bf16x8 pa0,bf16x8 pa1,bf16x8 pa2,bf16x8 pa3){
  #pragma unroll
  for(int d0=0;d0<2;++d0){s16x4 lo[4],hi[4];
    #pragma unroll
    for(int ks=0;ks<4;++ks){
      asm volatile("ds_read_b64_tr_b16 %0,%1 offset:%c2":"=&v"(lo[ks]):"v"(vb),"i"(d0*4096+ks*1024):"memory");
      asm volatile("ds_read_b64_tr_b16 %0,%1 offset:%c2":"=&v"(hi[ks]):"v"(vb),"i"(d0*4096+ks*1024+512):"memory");}
    asm volatile("s_waitcnt lgkmcnt(0)":::"memory");SBAR();
    #define PK(k) (bf16x8){lo[k][0],lo[k][1],lo[k][2],lo[k][3],hi[k][0],hi[k][1],hi[k][2],hi[k][3]}
    o[d0]=__builtin_amdgcn_mfma_f32_32x32x16_bf16(pa0,PK(0),o[d0],0,0,0);
    o[d0]=__builtin_amdgcn_mfma_f32_32x32x16_bf16(pa1,PK(1),o[d0],0,0,0);
    o[d0]=__builtin_amdgcn_mfma_f32_32x32x16_bf16(pa2,PK(2),o[d0],0,0,0);
    o[d0]=__builtin_amdgcn_mfma_f32_32x32x16_bf16(pa3,PK(3),o[d0],0,0,0);
    #undef PK
  }
}

#ifndef ATTN_STORE16
#define ATTN_STORE16(p,v) (*(u32x4*)(p)=(v))
#endif
template<int THRL,bool MASKED> __device__ __forceinline__ void attn_unit(int wvx,int b,int qb,const bf16*Q,const bf16*__restrict__ K,const bf16*__restrict__ V,bf16*O,const unsigned*MASK,char*shm){
  int tid_=wvx*64+lane_id_(); asm volatile("":"+v"(tid_));
  const int tid=tid_,lane=tid&63,r32=lane&31,hi=lane>>5; const int wid=__builtin_amdgcn_readfirstlane(tid>>6);
  const long rowbase=(long)b*SEQ; const int q0=qb*QB;
  const bf16*Qw=Q+(rowbase+q0+wid*QBLK)*DM;
  const bf16*Kh=K+rowbase*DM,*Vh=V+rowbase*DM;
  const unsigned*mrow=MASK+(size_t)(rowbase+q0+wid*QBLK+r32)*64;
  #define MLD(tt) mld_asm(mrow+2*(tt))
  const unsigned lds0=(unsigned)(uintptr_t)shm;
  float*wsf=(float*)(shm+LDS_WS)+wid*64;
  const bf16*ksrc=Kh+(long)lane*DM+wid*8;
  const bf16*vsrc=Vh+(long)(16*(wid&3)+(lane>>2))*DM+(wid>>2)*32+(lane&3)*8;
  const unsigned kdst=lds0+LDS_K+wid*1024, vdst=lds0+LDS_V+wid*1024;
  #define DMA_K(t,slot) glds16(ksrc+(long)(t)*KVBLK*DM,(unsigned)__builtin_amdgcn_readfirstlane(kdst+(slot)))
  #define DMA_V(t,slot) glds16(vsrc+(long)(t)*KVBLK*DM,(unsigned)__builtin_amdgcn_readfirstlane(vdst+(slot)))
  const int vb0=(int)(lds0+LDS_V)+((lane>>4)&1)*32+(lane&3)*8+(4*hi+((lane&15)>>2))*64;
  const char*Kbase=shm+LDS_K; bf16x8 kf[8];
  const lds_cptr shm3=(lds_cptr)shm; const lds_cptr kp0=shm3+LDS_K+hi*1024+r32*16; const lds_cptr vp0=shm3+LDS_V+((lane>>4)&1)*32+(lane&3)*8+(4*hi+((lane&15)>>2))*64;
  const int NT=(q0+QB)/KVBLK;
  uint2 mw_cur=make_uint2(~0u,~0u), mw_next=make_uint2(~0u,~0u); if(MASKED){ mw_cur=MLD(0); mw_next=MLD(1); }
  DMA_K(0,0);DMA_V(0,0);DMA_K(1,SLOTB);
  bf16x8 qr[4];
  #pragma unroll
  for(int d0=0;d0<4;++d0)qr[d0]=*reinterpret_cast<const bf16x8*>(&Qw[(long)r32*DM+d0*16+hi*8]);
  float mhat=0.f,l_reg=0.f;f32x16 o[2];o[0]=f32x16{};o[1]=f32x16{};f32x16 negm=f32x16{};asm volatile("":"+v"(negm));
  const int qrel=wid*QBLK+r32;
  #define CMASK(P0,P1,t) do{ if(MASKED){bmask(P0,P1,mw_cur,hi);} else {int jb_=(t)-(NT-4); if(jb_>=0)cmask(P0,P1,jb_,qrel,hi);} }while(0)
  bool resc=false;
  #define START(P0,P1) do{ float rm=rowmax(P0,P1); if(MASKED)rm=max2f(rm,-64.f); resc=false; \
    { const float dl=rm; mhat=fadd_s(mhat,dl); \
      _Pragma("unroll") for(int r=0;r<16;++r){P0[r]=fsub_s(P0[r],dl);P1[r]=fsub_s(P1[r],dl);} \
      _Pragma("unroll") for(int r=0;r<16;++r)negm[r]=-mhat; asm volatile("":"+v"(negm)); } \
    _Pragma("unroll") for(int r=0;r<16;++r)P0[r]=__builtin_amdgcn_exp2f(P0[r]); }while(0)
  #define RESC() do{ if(resc){ asm volatile("s_waitcnt lgkmcnt(0)":::"memory"); \
      _Pragma("unroll") for(int d_=0;d_<2;++d_) _Pragma("unroll") for(int r=0;r<16;++r)o[d_][r]*=wsf[crow(r,hi)]; } }while(0)
  f32x16 pA0,pA1,pB0,pB1;
  int sl_prev=0,sl_cur=0,sl_next=SLOTB;
  #define ROT() do{sl_prev=sl_cur;sl_cur=sl_next;sl_next=(sl_next==(NSLOT-1)*SLOTB)?0:sl_next+SLOTB;}while(0)
  DMA_K(2,2*SLOTB);
  WAIT_BAR(3);
  qkt(pA0,pA1,Kbase,qr,negm,r32,hi);asm volatile("s_nop 15\n\ts_nop 7":"+v"(pA0),"+v"(pA1));CMASK(pA0,pA1,0);
  START(pA0,pA1);
  _Pragma("unroll") for(int r=0;r<16;++r)pA1[r]=__builtin_amdgcn_exp2f(pA1[r]);
  WAIT_BAR(0);
  DMA_K(3,0);DMA_V(1,SLOTB);
  ROT();
  kload8(kf,kp0+sl_cur);
  WAIT_BAR(2);
  s16x4 vlo[8],vhi[8]; u32x4 pw0,pw1,pw2,pw3;
  #define PKW(P,B) cvtpk_s(P[B],P[B+1])
  #define PAF(k) __builtin_bit_cast(bf16x8,pw##k)
  #define VFR(i) (bf16x8){vlo[i][0],vlo[i][1],vlo[i][2],vlo[i][3],vhi[i][0],vhi[i][1],vhi[i][2],vhi[i][3]}
  #define PIN(x) asm volatile("":"+v"(x))
  #define MX3(a,b,c) __builtin_fmaxf(__builtin_fmaxf((a),(b)),(c))
  #define GAPA(MF,A0,A1,A2,A3,W0,W1,PW) do{ MF; sacc+=A0; sacc+=A1; sacc+=A2; sacc+=A3; PIN(sacc); W0; W1; PIN(PW); SBAR(); }while(0)
  #define EX(v) __builtin_amdgcn_exp2f(v)
  #define GAPB(MF,X,B) do{ MF; X[B]=EX(X[B]); X[B+1]=EX(X[B+1]); X[B+2]=EX(X[B+2]); X[B+3]=EX(X[B+3]); PIN(X); SBAR(); }while(0)
  #define VRD(i) do{ vlo[i]=vtr(vp_+(((i)>>2)*4096+((i)&3)*1024)); vhi[i]=vtr(vp_+(((i)>>2)*4096+((i)&3)*1024+512)); }while(0)
  #define KRD(G,j) do{ if(G){ kload2(kf,kp0+sl_next,j); SBAR(); } }while(0)
  #define STEP(C0,C1,P0,P1,t,GK,GV,GL) do{ SBAR(); if(MASKED){ mw_cur=mw_next; if((t)+1<NT) mw_next=MLD((t)+1); } \
    const lds_cptr vp_=vp0+sl_prev; \
    VRD(0); SBAR(); float sacc=(P0[0]+P0[1]); \
    GAPA(C0=__builtin_amdgcn_mfma_f32_32x32x16_bf16(kf[0],qr[0],negm,0,0,0), P0[2],P0[3],P0[4],P0[5],     pw0[0]=PKW(P0,0), pw0[1]=PKW(P0,2), pw0); \
    VRD(4); SBAR(); GAPA(C1=__builtin_amdgcn_mfma_f32_32x32x16_bf16(kf[1],qr[0],negm,0,0,0), P0[6],P0[7],P0[8],P0[9],     pw0[2]=PKW(P0,4), pw0[3]=PKW(P0,6), pw0); \
    VRD(1); SBAR(); GAPA(C0=__builtin_amdgcn_mfma_f32_32x32x16_bf16(kf[2],qr[1],C0,0,0,0),   P0[10],P0[11],P0[12],P0[13], pw1[0]=PKW(P0,8), pw1[1]=PKW(P0,10), pw1); \
    VRD(5); SBAR(); GAPA(C1=__builtin_amdgcn_mfma_f32_32x32x16_bf16(kf[3],qr[1],C1,0,0,0),   P0[14],P0[15],P1[0],P1[1],   pw1[2]=PKW(P0,12),pw1[3]=PKW(P0,14), pw1); \
    VRD(2); SBAR(); GAPA(C0=__builtin_amdgcn_mfma_f32_32x32x16_bf16(kf[4],qr[2],C0,0,0,0),   P1[2],P1[3],P1[4],P1[5],     pw2[0]=PKW(P1,0), pw2[1]=PKW(P1,2), pw2); \
    VRD(6); SBAR(); GAPA(C1=__builtin_amdgcn_mfma_f32_32x32x16_bf16(kf[5],qr[2],C1,0,0,0),   P1[6],P1[7],P1[8],P1[9],     pw2[2]=PKW(P1,4), pw2[3]=PKW(P1,6), pw2); \
    VRD(3); SBAR(); GAPA(C0=__builtin_amdgcn_mfma_f32_32x32x16_bf16(kf[6],qr[3],C0,0,0,0),   P1[10],P1[11],P1[12],P1[13], pw3[0]=PKW(P1,8), pw3[1]=PKW(P1,10), pw3); \
    VRD(7); SBAR(); GAPA(C1=__builtin_amdgcn_mfma_f32_32x32x16_bf16(kf[7],qr[3],C1,0,0,0),   P1[14],P1[15],0.f,0.f,       pw3[2]=PKW(P1,12),pw3[3]=PKW(P1,14), pw3); \
    l_reg+=sacc; \
    if(GK){DMA_K((t)+3,sl_cur);} if(GV){DMA_V((t)+1,sl_next);} \
    CMASK(C0,C1,t); \
    { float a=MX3(C0[0],C0[1],C1[0]),b=MX3(C0[2],C0[3],C1[1]); a=MX3(a,C1[2],C1[3]); \
      _Pragma("unroll") for(int r=4;r<16;r+=4){a=MX3(a,C0[r],C0[r+1]);b=MX3(b,C0[r+2],C0[r+3]);a=MX3(a,C1[r],C1[r+1]);b=MX3(b,C1[r+2],C1[r+3]);} \
      float rm=__builtin_fmaxf(a,b); { auto rr=__builtin_amdgcn_permlane32_swap(__float_as_uint(rm),__float_as_uint(rm),false,false); rm=__builtin_fmaxf(__uint_as_float(rr[0]),__uint_as_float(rr[1])); } \
      resc=false; \
      if(__builtin_expect(__any(rm>(float)THRL),0)){ const float dl=__builtin_fmaxf(rm,0.f); mhat+=dl; \
        _Pragma("unroll") for(int r=0;r<16;++r){C0[r]-=dl;C1[r]-=dl;} \
        _Pragma("unroll") for(int r=0;r<16;++r)negm[r]=-mhat; asm volatile("":"+v"(negm)); \
        const float f=__builtin_amdgcn_exp2f(-dl); l_reg*=f; if(hi==0)wsf[r32]=f; resc=true; } } \
    SBAR(); \
    GAPB(o[0]=__builtin_amdgcn_mfma_f32_32x32x16_bf16(PAF(0),VFR(0),o[0],0,0,0), C0,0); \
    GAPB(o[1]=__builtin_amdgcn_mfma_f32_32x32x16_bf16(PAF(0),VFR(4),o[1],0,0,0), C0,4); \
    KRD(GL,0); GAPB(o[0]=__builtin_amdgcn_mfma_f32_32x32x16_bf16(PAF(1),VFR(1),o[0],0,0,0), C0,8); \
    KRD(GL,1); GAPB(o[1]=__builtin_amdgcn_mfma_f32_32x32x16_bf16(PAF(1),VFR(5),o[1],0,0,0), C0,12); \
    KRD(GL,2); GAPB(o[0]=__builtin_amdgcn_mfma_f32_32x32x16_bf16(PAF(2),VFR(2),o[0],0,0,0), C1,0); \
    KRD(GL,3); GAPB(o[1]=__builtin_amdgcn_mfma_f32_32x32x16_bf16(PAF(2),VFR(6),o[1],0,0,0), C1,4); \
    GAPB(o[0]=__builtin_amdgcn_mfma_f32_32x32x16_bf16(PAF(3),VFR(3),o[0],0,0,0), C1,8); \
    GAPB(o[1]=__builtin_amdgcn_mfma_f32_32x32x16_bf16(PAF(3),VFR(7),o[1],0,0,0), C1,12); \
    }while(0)
  int t=1;
  #undef CMASK
  #define CMASK(P0,P1,t) do{ if(MASKED){bmask(P0,P1,mw_cur,hi);} }while(0)
  for(;t+5<NT;t+=2){
    STEP(pB0,pB1,pA0,pA1,t,true,true,true);     WAIT_BAR(2); RESC(); ROT();
    STEP(pA0,pA1,pB0,pB1,t+1,true,true,true);   WAIT_BAR(2); RESC(); ROT();
  }
  #undef CMASK
  #define CMASK(P0,P1,t) do{ if(MASKED){bmask(P0,P1,mw_cur,hi);} else {int jb_=(t)-(NT-4); if(jb_>=0)cmask(P0,P1,jb_,qrel,hi);} }while(0)
  #define ENDW(tt) do{ if((tt)+3<NT){WAIT_BAR(2);} else if((tt)+2<NT){WAIT_BAR(1);} else {WAIT_BAR(0);} }while(0)
  for(;t+1<NT;t+=2){
    STEP(pB0,pB1,pA0,pA1,t,(t+3<NT),(t+1<NT),(t+1<NT));       ENDW(t);   RESC(); ROT();
    STEP(pA0,pA1,pB0,pB1,t+1,(t+4<NT),(t+2<NT),(t+2<NT));     ENDW(t+1); RESC(); ROT();
  }
  STEP(pB0,pB1,pA0,pA1,NT-1,false,false,false); RESC();
  { float sacc=pB0[0]+pB0[1]; _Pragma("unroll") for(int r=2;r<16;++r)sacc+=pB0[r]; _Pragma("unroll") for(int r=0;r<16;++r)sacc+=pB1[r]; l_reg+=sacc;
    pw0=(u32x4){PKW(pB0,0),PKW(pB0,2),PKW(pB0,4),PKW(pB0,6)};pw1=(u32x4){PKW(pB0,8),PKW(pB0,10),PKW(pB0,12),PKW(pB0,14)};pw2=(u32x4){PKW(pB1,0),PKW(pB1,2),PKW(pB1,4),PKW(pB1,6)};pw3=(u32x4){PKW(pB1,8),PKW(pB1,10),PKW(pB1,12),PKW(pB1,14)};
    SBAR(); pv(o,vb0+sl_cur,PAF(0),PAF(1),PAF(2),PAF(3)); }
  #undef PKW
  #undef PAF
  #undef VFR
  #undef PIN
  #undef MX3
  #undef GAPA
  #undef GAPB
  #undef EX
  #undef VRD
  #undef KRD
  #undef STEP
  #undef ENDW
  {auto rr=__builtin_amdgcn_permlane32_swap(__float_as_uint(l_reg),__float_as_uint(l_reg),false,false);l_reg=__uint_as_float(rr[0])+__uint_as_float(rr[1]);}
  if(hi==0)wsf[32+r32]=l_reg;asm volatile("s_waitcnt lgkmcnt(0)":::"memory");
  float rli[16];
  #pragma unroll
  for(int r=0;r<16;++r)rli[r]=__builtin_amdgcn_rcpf(wsf[32+crow(r,hi)]);
  bf16*Ow=O+(rowbase+q0+wid*QBLK)*DMO;
  { bf16*stg=(bf16*)(shm+LDS_OST)+wid*2048;
    #pragma unroll
    for(int r=0;r<16;++r){const int orow=crow(r,hi);
      #pragma unroll
      for(int d0=0;d0<2;++d0)stg[orow*64+d0*32+r32]=(bf16)f2bf_(o[d0][r]*rli[r]);}
    asm volatile("s_waitcnt lgkmcnt(0)":::"memory");
    #pragma unroll
    for(int i=0;i<4;++i){const int row=i*8+(lane>>3),ch=lane&7; const u32x4 v=*(const u32x4*)(stg+row*64+ch*8); ATTN_STORE16(Ow+(long)row*DMO+ch*8,v);} }
  asm volatile("s_waitcnt lgkmcnt(0)\n\ts_barrier":::"memory");
  #undef DMA_K
  #undef DMA_V
  #undef MLD
  #undef CMASK
  #undef START
  #undef RESC
  #undef ROT
}
constexpr int ATTN_LDS_BYTES=LDS_BYTES;
#undef SBAR
#undef WAIT_BAR
}
#define GAS __attribute__((address_space(1)))
#define LAS __attribute__((address_space(3)))
typedef unsigned short bf16;
typedef unsigned v4u __attribute__((ext_vector_type(4)));
typedef float f32x4 __attribute__((ext_vector_type(4)));
typedef short bf16x8 __attribute__((ext_vector_type(8)));
typedef GAS unsigned gu32;
typedef GAS unsigned long long gu64;
#define RLX_AGENT __ATOMIC_RELAXED, __HIP_MEMORY_SCOPE_AGENT
#define LDS_WAIT() asm volatile("s_waitcnt lgkmcnt(0)" ::: "memory")
#define VM_WAIT() asm volatile("s_waitcnt vmcnt(0)" ::: "memory")
__device__ __forceinline__ unsigned long long rt() { return __builtin_amdgcn_s_memrealtime(); }
__device__ __forceinline__ unsigned f2bf(float f) { unsigned u = __builtin_bit_cast(unsigned, f); return (u + 0x7fffu + ((u >> 16) & 1u)) >> 16; }
__device__ __forceinline__ unsigned pk2(float lo, float hi) { unsigned r; asm("v_cvt_pk_bf16_f32 %0, %1, %2" : "=v"(r) : "v"(lo), "v"(hi)); return r; }
__device__ __forceinline__ int tid_of(int wvx) { return wvx * 64 + lane_id_(); }
__device__ __forceinline__ int bid_() { int b_ = (int)blockIdx.x; asm volatile("" : "+s"(b_)); return b_; }
__device__ __forceinline__ int gsz_() { int g_ = (int)gridDim.x; asm volatile("" : "+s"(g_)); return g_; }
#define XB_TMO      128
#define XB_XCNT(j)  (256  + 64 * (j))
#define XB_XSUB(j)  (1280 + 64 * (j))
#define XB_XGEN(j)  (2304 + 64 * (j))
#define XB_TOP      3328
#define XB_TOPGEN   3392
#define XCD_BAR_WORDS 3456
#define XB_SPIN_CAP (1u << 20)

__device__ __forceinline__ unsigned xb_ld(unsigned* p)              { return __hip_atomic_load(p, __ATOMIC_RELAXED, __HIP_MEMORY_SCOPE_AGENT); }
__device__ __forceinline__ unsigned xb_add(unsigned* p, unsigned v) { return __hip_atomic_fetch_add(p, v, __ATOMIC_RELAXED, __HIP_MEMORY_SCOPE_AGENT); }
__device__ __forceinline__ unsigned xb_xcc_id() { return (unsigned)__builtin_amdgcn_s_getreg((3 << 11) | 20) & 0xFu; }
#define XB_SPIN(cond, bar) do { unsigned _sp = 0; while (cond) { __builtin_amdgcn_s_sleep(1); \
    if ((++_sp & 255u) == 0u) { if (xb_ld(&(bar)[XB_TMO])) break; if (_sp > XB_SPIN_CAP) { atomicAdd(&(bar)[XB_TMO], 1u); break; } } } } while (0)

struct XcdBarrier {
    unsigned* bar; unsigned x;
    volatile LAS unsigned* st;
};

__device__ __forceinline__ XcdBarrier xcd_barrier_post(unsigned* bar, volatile LAS unsigned* st) {
    XcdBarrier b; b.bar = bar; b.x = xb_xcc_id(); b.st = st;
    if (threadIdx.x == 0) (void)xb_add(&bar[XB_XCNT(b.x)], 1u);
    return b;
}
__device__ __forceinline__ void xcd_barrier_complete(unsigned* bar, unsigned x, unsigned& nloc, unsigned& nx) {
    const unsigned G = gridDim.x * gridDim.y * gridDim.z;
    unsigned sum, cnt, mine, sp = 0u;
    for (;;) {
        sum = 0u; cnt = 0u; mine = 0u;
#pragma unroll
        for (unsigned j = 0; j < 16; ++j) { const unsigned c = xb_ld(&bar[XB_XCNT(j)]); sum += c; cnt += (c > 0u) ? 1u : 0u; mine = (j == x) ? c : mine; }
        if (sum == G) break;
        __builtin_amdgcn_s_sleep(1);
        if ((++sp & 255u) == 0u) { if (xb_ld(&bar[XB_TMO])) break; if (sp > XB_SPIN_CAP) { atomicAdd(&bar[XB_TMO], 1u); break; } }
    }
    nloc = mine > 0u ? mine : 1u; nx = cnt > 0u ? cnt : 1u;
}

__device__ __attribute__((noinline)) void xcd_barrier_fn(unsigned* bar_, unsigned x_, volatile LAS unsigned* st_, bool leader_) {
    XcdBarrier b; b.bar = bar_; b.x = x_; b.st = st_;
    asm volatile("s_waitcnt vmcnt(0)" ::: "memory");
    __syncthreads();
    if (leader_) {
        unsigned* bar = b.bar;
        __builtin_amdgcn_s_waitcnt(0);
        unsigned nloc = b.st[0], nx = b.st[1];
        if (nloc == 0u) { xcd_barrier_complete(bar, b.x, nloc, nx); b.st[0] = nloc; b.st[1] = nx; }
        const unsigned old = xb_add(&bar[XB_XSUB(b.x)], 1u);
        const unsigned gen = old / nloc;
        if (old + 1u == (gen + 1u) * nloc) {
            __builtin_amdgcn_fence(__ATOMIC_RELEASE, "agent");
            asm volatile("s_waitcnt vmcnt(0)" ::: "memory");
            const unsigned og = xb_add(&bar[XB_TOP], 1u);
            const unsigned tg = og / nx;
            if (og + 1u == (tg + 1u) * nx) xb_add(&bar[XB_TOPGEN], 1u);
            else XB_SPIN(xb_ld(&bar[XB_TOPGEN]) == tg, bar);
            __builtin_amdgcn_fence(__ATOMIC_ACQUIRE, "agent");
            xb_add(&bar[XB_XGEN(b.x)], 1u);
            asm volatile("s_waitcnt vmcnt(0)" ::: "memory");
        } else {
            XB_SPIN(xb_ld(&bar[XB_XGEN(b.x)]) == gen, bar);
            __builtin_amdgcn_fence(__ATOMIC_ACQUIRE, "agent");
            asm volatile("s_waitcnt vmcnt(0)" ::: "memory");
        }
    }
    __syncthreads();
}


constexpr int NB = 16, SEQ = 2048, T = NB * SEQ, D = 1024, DEPTH = 4, NHC = 4096, NEXP = 32, NWAVES = 8;
constexpr int NIN = 3920;
constexpr float LN_EPS = 1e-5f, DN_ALPHA = 1.6817928305074290f;
constexpr int RPAD = T * 4 + NEXP * 256;
constexpr int HC_MQ = 0, HC_MK = 256, HC_MV = 512, HC_MO = 768, HC_DQ = 1024, HC_DK = 1536, HC_DV = 2048, HC_SQ = 2560, HC_SK = 2816, HC_SV = 3072, HC_XQ = 3328, HC_XK = 3840, HC_MI = 3904, HC_MF = 3908, HC_XW = 3912;
constexpr size_t MiB = 1u << 20;
constexpr size_t WS_CTL = 0, CTL_ZERO_BYTES = 128 * 1024;
constexpr size_t WS_MOD = 2 * MiB;
constexpr size_t WS_LAM = WS_MOD + 7 * MiB / 4;
constexpr size_t WS_RWT = 4 * MiB;
constexpr size_t WS_CS = 8 * MiB;
constexpr size_t WS_WIN = 16 * MiB;
constexpr size_t WS_WOUT = 48 * MiB;
constexpr size_t WS_W1 = 64 * MiB;
constexpr size_t WS_W2 = 576 * MiB;
constexpr size_t WS_XB = 832 * MiB;
constexpr size_t WS_U = 960 * MiB;
constexpr size_t WS_H = 1024 * MiB;
constexpr size_t WS_QKC = 1280 * MiB;
constexpr size_t WS_XKP = 1312 * MiB;
constexpr size_t WS_MASK = 1316 * MiB;
constexpr size_t WS_TOK = 1324 * MiB;
constexpr size_t WS_CS16 = 1328 * MiB;
constexpr size_t WS_MIX = 1344 * MiB;
constexpr size_t WS_Y = 1408 * MiB;
constexpr size_t WS_SC = 1472 * MiB;
constexpr size_t WS_XG = 1728 * MiB;
constexpr size_t WS_HM = 2000 * MiB;
constexpr size_t WS_YM = 2272 * MiB;
constexpr size_t WS_END = 2544 * MiB;
constexpr int CW_CNT = 1024;
constexpr int CW_BAR = 16384;
constexpr int RING_BYTES = 131072, TAB_OFF = RING_BYTES, LDS_BYTES = 147456, MISC_OFF = LDS_BYTES - 256;
constexpr int NPH = 10, NSTEPS = 2 + NPH * DEPTH;
enum { PH_IN = 0, PH_POST, PH_MIXA, PH_SEL, PH_DSA, PH_OUT, PH_ROW1, PH_G1, PH_G2, PH_ROW2 };

typedef unsigned short us8 __attribute__((ext_vector_type(8)));
__device__ __forceinline__ float bf2f(bf16 h) { return __uint_as_float((unsigned)h << 16); }
#define DPPF(x, c) __int_as_float(__builtin_amdgcn_update_dpp(0, __float_as_int(x), c, 0xF, 0xF, true))
__device__ __forceinline__ float wave_sum(float v) {
    v += DPPF(v, 0xB1); v += DPPF(v, 0x4E); v += DPPF(v, 0x141); v += DPPF(v, 0x140);
    return (__int_as_float(__builtin_amdgcn_readlane(__float_as_int(v), 0)) + __int_as_float(__builtin_amdgcn_readlane(__float_as_int(v), 16))) + (__int_as_float(__builtin_amdgcn_readlane(__float_as_int(v), 32)) + __int_as_float(__builtin_amdgcn_readlane(__float_as_int(v), 48)));
}
__device__ __forceinline__ float wave_max(float v) {
    v = fmaxf(v, DPPF(v, 0xB1)); v = fmaxf(v, DPPF(v, 0x4E)); v = fmaxf(v, DPPF(v, 0x141)); v = fmaxf(v, DPPF(v, 0x140));
    return fmaxf(fmaxf(__int_as_float(__builtin_amdgcn_readlane(__float_as_int(v), 0)), __int_as_float(__builtin_amdgcn_readlane(__float_as_int(v), 16))), fmaxf(__int_as_float(__builtin_amdgcn_readlane(__float_as_int(v), 32)), __int_as_float(__builtin_amdgcn_readlane(__float_as_int(v), 48))));
}
__device__ __forceinline__ float shx(float v, int lane, int m) { return __int_as_float(__builtin_amdgcn_ds_bpermute((lane ^ m) << 2, __float_as_int(v))); }
__device__ __forceinline__ int shxi(int v, int lane, int m) { return __builtin_amdgcn_ds_bpermute((lane ^ m) << 2, v); }
__device__ __forceinline__ float shup(float v, int lane, int o) { return __int_as_float(__builtin_amdgcn_ds_bpermute(((lane - o) & 63) << 2, __float_as_int(v))); }
__device__ __forceinline__ int shupi(int v, int lane, int o) { return __builtin_amdgcn_ds_bpermute(((lane - o) & 63) << 2, v); }
__device__ __forceinline__ float sigmoidf_(float x) { return 1.0f / (1.0f + __expf(-x)); }
struct Ctx {
    LAS unsigned char* lds;
    int tid, lane, wave, gw, ngw;
    const float* in[25];
    float* out; unsigned char* ws;
};
#define WSP(type, off) ((type*)(C.ws + (off)))
enum { I_X = 0, I_C, I_POS, I_WIN, I_GATEB, I_CONVW, I_CONVB, I_MNORM, I_DFLAM, I_DFNORM, I_IDXG, I_IDXB, I_WOUT, I_ADAW, I_ADAB, I_LN1G, I_LN1B, I_LN2G, I_LN2B, I_RW, I_RB, I_W1, I_B1, I_W2, I_B2 };

__device__ __forceinline__ int in_dest_col(int n) {
    auto rp = [](int j) { const int hd = j >> 6, d = j & 63; return hd * 64 + ((d < 32) ? 2 * d : 2 * (d - 32) + 1); };
    if (n < 256) return HC_MQ + n;
    if (n < 512) return HC_MK + (n - 256);
    if (n < 768) return HC_MV + (n - 512);
    if (n < 772) return HC_MI + (n - 768);
    if (n < 776) return HC_MF + (n - 772);
    if (n < 1032) return HC_MO + (n - 776);
    if (n < 1544) return HC_DQ + rp(n - 1032);
    if (n < 2056) return HC_DK + rp(n - 1544);
    if (n < 2568) return HC_DV + (n - 2056);
    if (n < 2824) return HC_SQ + rp(n - 2568);
    if (n < 3080) return HC_SK + rp(n - 2824);
    if (n < 3336) return HC_SV + (n - 3080);
    if (n < 3848) return HC_XQ + rp(n - 3336);
    if (n < 3912) return HC_XK + (n - 3848);
    return HC_XW + (n - 3912);
}
template <class F> __device__ __forceinline__ void transpose_item(const float* W, int ldw, int K, int nvalid, int k0, int n0, bf16* WT, LAS float* scr, int lane, F drow) {
    const int nn = n0 + (lane & 31); const bool ok = nn < nvalid;
    float tv_[32];
#pragma unroll
    for (int i = 0; i < 32; ++i) { const int kk = 2 * i + (lane >> 5); tv_[i] = ok ? W[(size_t)(k0 + kk) * ldw + nn] : 0.f; }
#pragma unroll
    for (int i = 0; i < 32; ++i) { const int kk = 2 * i + (lane >> 5); scr[kk * 33 + (lane & 31)] = tv_[i]; }
    LDS_WAIT(); asm volatile("" ::: "memory");
    const int c = lane & 7;
#pragma unroll
    for (int j = 0; j < 4; ++j) { const int n = (lane >> 3) + 8 * j; const LAS float* s = scr + (8 * c) * 33 + n;
        v4u o; o.x = pk2(s[0 * 33], s[1 * 33]); o.y = pk2(s[2 * 33], s[3 * 33]); o.z = pk2(s[4 * 33], s[5 * 33]); o.w = pk2(s[6 * 33], s[7 * 33]);
        if (n0 + n < nvalid) *(GAS v4u*)(WT + (size_t)drow(n0 + n) * K + k0 + 8 * c) = o; }
    LDS_WAIT(); asm volatile("" ::: "memory");
}

template <class F> __device__ __forceinline__ void transpose_item_f8(const float* W, int ldw, int K, int nvalid, int k0, int n0, unsigned char* WT8, LAS float* scr, int lane, float sc, F drow) {
    const int nn = n0 + (lane & 31); const bool ok = nn < nvalid;
    float tv_[32];
#pragma unroll
    for (int i = 0; i < 32; ++i) { const int kk = 2 * i + (lane >> 5); tv_[i] = ok ? W[(size_t)(k0 + kk) * ldw + nn] : 0.f; }
#pragma unroll
    for (int i = 0; i < 32; ++i) { const int kk = 2 * i + (lane >> 5); scr[kk * 33 + (lane & 31)] = tv_[i]; }
    LDS_WAIT(); asm volatile("" ::: "memory");
    const int c = lane & 7;
#pragma unroll
    for (int j = 0; j < 4; ++j) { const int n = (lane >> 3) + 8 * j; const LAS float* s = scr + (8 * c) * 33 + n;
        typedef unsigned u32x2_ __attribute__((ext_vector_type(2))); u32x2_ o; o.x = pg8::pk4_fp8(s[0 * 33], s[1 * 33], s[2 * 33], s[3 * 33], sc); o.y = pg8::pk4_fp8(s[4 * 33], s[5 * 33], s[6 * 33], s[7 * 33], sc);
        if (n0 + n < nvalid) *(GAS u32x2_*)(WT8 + (size_t)drow(n0 + n) * K + k0 + 8 * c) = o; }
    LDS_WAIT(); asm volatile("" ::: "memory");
}
struct Args { const float* in[25]; float* out; unsigned char* ws; int s_lo, s_hi, li, pad; };
typedef __attribute__((address_space(4))) const Args CArgs;
__device__ __forceinline__ CArgs* kargs() { CArgs* p = (CArgs*)__builtin_amdgcn_kernarg_segment_ptr(); asm volatile("" : "+s"(p)); return p; }
__device__ __forceinline__ LAS unsigned char* lds_launder(LAS unsigned char* q) { unsigned v = (unsigned)(size_t)q; asm volatile("" : "+s"(v)); return (LAS unsigned char*)(size_t)v; }
#define WS(type, off) ((type*)(A->ws + (off)))
#define TIDX CArgs* A = kargs(); int tid_ = tid_of(wvx); asm volatile("" : "+v"(tid_)); const int tid = tid_, lane = tid & 63, wave = __builtin_amdgcn_readfirstlane(tid >> 6); const int bidx = bid_(), gsz = gsz_(); const int gw = bidx * NWAVES + wave, ngw = gsz * NWAVES; (void)bidx; (void)gsz; (void)lane; (void)gw; (void)ngw

#ifndef PRORPT
#define PRORPT 0u
#endif
#define PRPT(b) _Pragma("unroll 1") for (int prep_ = 0; prep_ < ((((PRORPT) >> (b)) & 1u) ? 2 : 1); ++prep_)
__device__ __forceinline__ void pro_a(LAS unsigned char* lds, int wvx) {
    TIDX;
    LAS float* scr = (LAS float*)(lds + wave * 16384);
    constexpr int IT_IN = 16 * 123, IT_OUT = 16 * 32, IT_W1 = 16 * 64, IT_W2 = 16 * 32;
    constexpr int N_IN = DEPTH * IT_IN, N_OUT = DEPTH * IT_OUT, N_W1 = DEPTH * NEXP * IT_W1, N_W2 = DEPTH * NEXP * IT_W2;
    constexpr int NITEMS = N_IN + N_OUT;
    PRPT(0) for (int it = gw; it < NITEMS; it += ngw) {
        int r = it;
        if (r < N_IN) { const int l = r / IT_IN, q = r % IT_IN, kb = q / 123, nb = q % 123;
#ifdef INPROJ_F8
            transpose_item_f8(A->in[I_WIN] + (size_t)l * D * NIN, NIN, D, NIN, kb * 64, nb * 32, WS(unsigned char, WS_WIN) + (size_t)l * NHC * D, scr, lane, 256.0f, [](int n) { return in_dest_col(n); }); continue; }
#else
            transpose_item(A->in[I_WIN] + (size_t)l * D * NIN, NIN, D, NIN, kb * 64, nb * 32, WS(bf16, WS_WIN) + (size_t)l * NHC * D, scr, lane, [](int n) { return in_dest_col(n); }); continue; }
#endif
        r -= N_IN;
        { const int l = r / IT_OUT, q = r % IT_OUT, kb = q / 32, nb = q % 32;
            transpose_item(A->in[I_WOUT] + (size_t)l * D * D, D, D, D, kb * 64, nb * 32, WS(bf16, WS_WOUT) + (size_t)l * D * D, scr, lane, [](int n) { return n; }); }
    }
    PRPT(1) {
        constexpr int JW1 = 8 * 8, JW2 = 8 * 4, M_W1 = DEPTH * NEXP * JW1, M_W2 = DEPTH * NEXP * JW2, NX = M_W1 + M_W2;
        constexpr int XPITCH = 144, XTILE = 256 * XPITCH;
        __syncthreads();
        f32x4 tv_[16];
        const float* src_n = nullptr; unsigned char* dst_n = nullptr; int ldw_n = 0, k0_n = 0, n0_n = 0; bool w1_n = false;
        auto decode = [&](int r) {
            w1_n = r < M_W1;
            if (w1_n) { const int le = r / JW1, q = r % JW1; k0_n = (q / 8) * 128; n0_n = (q % 8) * 256; ldw_n = 2048; src_n = A->in[I_W1] + (size_t)le * D * 2048; dst_n = WS(unsigned char, WS_W1) + (size_t)le * 2048 * D; }
            else { r -= M_W1; const int le = r / JW2, q = r % JW2; k0_n = (q / 4) * 128; n0_n = (q % 4) * 256; ldw_n = D; src_n = A->in[I_W2] + (size_t)le * D * D; dst_n = WS(unsigned char, WS_W2) + (size_t)le * D * D; }
        };
        int it = bidx, buf = 0;
        if (it < NX) { decode(it); const float* sp = src_n + (size_t)(k0_n + 16 * wave) * ldw_n + n0_n + 4 * lane;
#pragma unroll
            for (int r = 0; r < 16; ++r) tv_[r] = *(const GAS f32x4*)(sp + (size_t)r * ldw_n); }
#pragma unroll 1
        while (it < NX) {
            LAS unsigned char* tile = lds + buf * XTILE;
#pragma unroll
            for (int j = 0; j < 4; ++j) { v4u o;
                o.x = pg8::pk4_fp8(tv_[0][j], tv_[1][j], tv_[2][j], tv_[3][j], 256.0f); o.y = pg8::pk4_fp8(tv_[4][j], tv_[5][j], tv_[6][j], tv_[7][j], 256.0f);
                o.z = pg8::pk4_fp8(tv_[8][j], tv_[9][j], tv_[10][j], tv_[11][j], 256.0f); o.w = pg8::pk4_fp8(tv_[12][j], tv_[13][j], tv_[14][j], tv_[15][j], 256.0f);
                *(LAS v4u*)(tile + (j * 64 + lane) * XPITCH + 16 * wave) = o; }
            unsigned char* const dst = dst_n; const int k0 = k0_n, n0 = n0_n; const bool w1 = w1_n;
            it += gsz;
            if (it < NX) { decode(it); const float* sp = src_n + (size_t)(k0_n + 16 * wave) * ldw_n + n0_n + 4 * lane;
#pragma unroll
                for (int r = 0; r < 16; ++r) tv_[r] = *(const GAS f32x4*)(sp + (size_t)r * ldw_n); }
            asm volatile("s_waitcnt lgkmcnt(0)\n\ts_barrier" ::: "memory");
#pragma unroll
            for (int rr = 0; rr < 4; ++rr) { const int idx = rr * 512 + tid, sl = idx >> 3, seg = idx & 7; const int n = n0 + (sl & 63) * 4 + (sl >> 6);
                const v4u v = *(const LAS v4u*)(tile + sl * XPITCH + 16 * seg);
                const int up = n >> 10, jj = n & 1023; const int j8 = n & 255;
                const int drow = w1 ? ((jj >> 7) * 256 + up * 128 + (jj & 127)) : ((n & ~255) + ((j8 >> 3) & 1) * 128 + (j8 >> 6) * 32 + ((j8 >> 4) & 3) * 8 + (j8 & 7));
                *(GAS v4u*)(dst + (size_t)drow * D + k0 + 16 * seg) = v; }
            buf ^= 1;
        }
        __syncthreads();
    }
    for (int r = gw; r < DEPTH * (NHC - NIN); r += ngw) { const int l = r / (NHC - NIN), row = NIN + r % (NHC - NIN);
#ifdef INPROJ_F8
        GAS v4u* p = (GAS v4u*)(WS(unsigned char, WS_WIN) + ((size_t)l * NHC + row) * D) + lane; p[0] = (v4u){0u, 0u, 0u, 0u}; }
#else
        GAS v4u* p = (GAS v4u*)(WS(bf16, WS_WIN) + ((size_t)l * NHC + row) * D) + lane; p[0] = (v4u){0u, 0u, 0u, 0u}; p[64] = (v4u){0u, 0u, 0u, 0u}; }
#endif
    PRPT(2) for (int idx = bidx * 512 + tid; idx < T * 32; idx += gsz * 512) {
        const int tok = idx >> 5, i = idx & 31;
        const double inv = exp(-(double)i * (9.210340371976184 / 32.0));
        const double ang = (double)((const int*)A->in[I_POS])[tok] * inv;
        const double rev = ang * 0.15915494309189535;
        const float fr = (float)(rev - rint(rev));
        float2 v; v.x = __builtin_amdgcn_cosf(fr); v.y = __builtin_amdgcn_sinf(fr);
        WS(float2, WS_CS)[idx] = v;
        { const _Float16 hc = (_Float16)v.x, hs = (_Float16)v.y; WS(unsigned, WS_CS16)[idx] = (unsigned)__builtin_bit_cast(unsigned short, hc) | ((unsigned)__builtin_bit_cast(unsigned short, hs) << 16); }
    }
    for (int idx = bidx * 512 + tid; idx < DEPTH * NEXP * D; idx += gsz * 512) {
        const int l = idx / (NEXP * D), r = idx % (NEXP * D), e = r / D, d = r % D;
        WS(float, WS_RWT)[idx] = A->in[I_RW][((size_t)l * D + d) * NEXP + e];
    }
    if (bidx == 0 && wave == 0) {
        for (int l = 0; l < DEPTH; ++l) { const float* lf = A->in[I_DFLAM] + l * 256;
            const float a = wave_sum(lf[lane] * lf[64 + lane]), b = wave_sum(lf[128 + lane] * lf[192 + lane]);
            if (lane == 0) WS(float, WS_LAM)[l] = __expf(a) - __expf(b) + (0.8f - 0.6f * __expf(-0.3f * (float)l)); }
    }
    __syncthreads();
    PRPT(3) {
        LAS float* ca = (LAS float*)lds;
        LAS float* part = (LAS float*)(lds + 65536);
        for (int i = tid; i < NB * D; i += 512) { const float v = A->in[I_C][i]; ca[(i & (D - 1)) * NB + (i >> 10)] = v / (1.0f + __expf(-v)); }
        __syncthreads();
#pragma unroll 1
        for (int cg = bidx; cg < (DEPTH * 6144) / 96; cg += gsz) {
            const int l = cg >> 6, m0 = (cg & 63) * 96;
            const int r = lane >> 5, cl = lane & 31;
            const float* w = A->in[I_ADAW] + (size_t)l * D * 6144 + m0 + cl + (size_t)(wave * 128 + r) * 6144;
            const LAS float* cp = ca + (wave * 128 + r) * NB;
            float acc[NB][3];
#pragma unroll
            for (int b = 0; b < NB; ++b) { acc[b][0] = 0.f; acc[b][1] = 0.f; acc[b][2] = 0.f; }
#pragma unroll 4
            for (int i = 0; i < 64; ++i) {
                const float w0 = w[(size_t)i * 2 * 6144], w1_ = w[(size_t)i * 2 * 6144 + 32], w2_ = w[(size_t)i * 2 * 6144 + 64];
                const LAS f32x4* c4 = (const LAS f32x4*)(cp + i * 2 * NB);
#pragma unroll
                for (int q = 0; q < 4; ++q) { const f32x4 cv = c4[q];
                    acc[4 * q + 0][0] += cv.x * w0; acc[4 * q + 0][1] += cv.x * w1_; acc[4 * q + 0][2] += cv.x * w2_;
                    acc[4 * q + 1][0] += cv.y * w0; acc[4 * q + 1][1] += cv.y * w1_; acc[4 * q + 1][2] += cv.y * w2_;
                    acc[4 * q + 2][0] += cv.z * w0; acc[4 * q + 2][1] += cv.z * w1_; acc[4 * q + 2][2] += cv.z * w2_;
                    acc[4 * q + 3][0] += cv.w * w0; acc[4 * q + 3][1] += cv.w * w1_; acc[4 * q + 3][2] += cv.w * w2_; }
            }
#pragma unroll
            for (int b = 0; b < NB; ++b) {
#pragma unroll
                for (int j = 0; j < 3; ++j) { const float v = acc[b][j] + shx(acc[b][j], lane, 32); if (r == 0) part[(wave * NB + b) * 96 + 32 * j + cl] = v; } }
            __syncthreads();
            for (int idx = tid; idx < NB * 96; idx += 512) { const int b = idx / 96, j = idx % 96; float v = A->in[I_ADAB][l * 6144 + m0 + j];
#pragma unroll
                for (int wv_ = 0; wv_ < NWAVES; ++wv_) v += part[(wv_ * NB + b) * 96 + j];
                WS(float, WS_MOD)[((size_t)l * NB + b) * 6144 + m0 + j] = v; }
            __syncthreads();
        }
    }
}
__device__ __forceinline__ void pro_b(int wvx) {
    TIDX;
    for (int tok = gw; tok < T; tok += ngw) {
        const int b = tok / SEQ; const float* mod = WS(float, WS_MOD) + (size_t)b * 6144;
        const GAS f32x4* xr = (const GAS f32x4*)(A->in[I_X] + (size_t)tok * D) + lane;
        GAS unsigned long long* o8 = (GAS unsigned long long*)(WS(bf16, WS_U) + (size_t)tok * D) + lane;
#pragma unroll
        for (int j = 0; j < 4; ++j) { const f32x4 x = xr[64 * j]; const f32x4 sh = *(const f32x4*)(mod + 4 * lane + 256 * j), sc = *(const f32x4*)(mod + 1024 + 4 * lane + 256 * j);
            const f32x4 u = x * (1.0f + sc) + sh;
            ((GAS unsigned long long*)(WS(bf16, WS_XB) + (size_t)tok * D) + lane)[64 * j] = (unsigned long long)pk2(x.x, x.y) | ((unsigned long long)pk2(x.z, x.w) << 32);
#ifdef INPROJ_F8
            ((GAS unsigned*)(WS(unsigned char, WS_U) + (size_t)tok * D) + lane)[64 * j] = pg8::pk4_fp8(u.x, u.y, u.z, u.w, 16.0f); }
#else
            o8[64 * j] = (unsigned long long)pk2(u.x, u.y) | ((unsigned long long)pk2(u.z, u.w) << 32); }
#endif
    }
}
__device__ __forceinline__ void ph_post(int l, int wvx) {
    TIDX;
    const bf16* H = WS(bf16, WS_H); bf16* XKP = WS(bf16, WS_XKP); bf16* QKC = WS(bf16, WS_QKC);
    const float* cw = A->in[I_CONVW] + (size_t)l * 4 * 512; const float* cb = A->in[I_CONVB] + (size_t)l * 512;
    const float gi = A->in[I_IDXG][l * 64 + lane], bi = A->in[I_IDXB][l * 64 + lane];
    float cwr[4][8], cbr[8];
#pragma unroll
    for (int c = 0; c < 8; ++c) { cbr[c] = cb[8 * lane + c];
#pragma unroll
        for (int j = 0; j < 4; ++j) cwr[j][c] = cw[j * 512 + 8 * lane + c]; }
    bf16 nxk = 0; float2 ncs = make_float2(1.f, 0.f); v4u nraw[4];
#define POST_LOAD(tk) do { const int s_ = (tk) % SEQ; nxk = H[(size_t)(tk) * NHC + HC_XK + lane]; ncs = WS(float2, WS_CS)[(size_t)(tk) * 32 + (lane & 31)]; \
        _Pragma("unroll") for (int j = 0; j < 4; ++j) { nraw[j] = (v4u){0u, 0u, 0u, 0u}; if (s_ - 3 + j >= 0) nraw[j] = *(const GAS v4u*)(H + (size_t)((tk) - 3 + j) * NHC + 8 * lane); } } while (0)
    if (gw < T) POST_LOAD(gw);
    for (int tok = gw; tok < T; tok += ngw) {
        const bf16 cxk = nxk; const float2 cs = ncs; v4u craw[4];
#pragma unroll
        for (int j = 0; j < 4; ++j) craw[j] = nraw[j];
        if (tok + ngw < T) POST_LOAD(tok + ngw);
        {
            const float v = bf2f(cxk);
            const float mean = wave_sum(v) * (1.0f / 64.0f); const float dv = v - mean;
            const float var = wave_sum(dv * dv) * (1.0f / 64.0f);
            const float nv = dv * (1.0f / sqrtf(var + LN_EPS)) * gi + bi;
            const float pv = shx(nv, lane, 32);
            const int i = lane & 31;
            const float o = (lane < 32) ? (nv * cs.x - pv * cs.y) : (nv * cs.x + pv * cs.y);
            XKP[(size_t)tok * 64 + 2 * i + (lane >> 5)] = (bf16)f2bf(o);
        }
        {
            const int c0 = 8 * lane;
            float acc[8];
#pragma unroll
            for (int c = 0; c < 8; ++c) acc[c] = cbr[c];
#pragma unroll
            for (int j = 0; j < 4; ++j) {
                const unsigned rw[4] = {craw[j].x, craw[j].y, craw[j].z, craw[j].w};
#pragma unroll
                for (int c = 0; c < 8; ++c) { const float x = __uint_as_float((c & 1) ? (rw[c >> 1] & 0xffff0000u) : (rw[c >> 1] << 16)); acc[c] += cwr[j][c] * x; }
            }
            v4u o;
#define SILU(x) ((x) / (1.0f + __expf(-(x))))
            o.x = pk2(SILU(acc[0]), SILU(acc[1])); o.y = pk2(SILU(acc[2]), SILU(acc[3])); o.z = pk2(SILU(acc[4]), SILU(acc[5])); o.w = pk2(SILU(acc[6]), SILU(acc[7]));
#undef SILU
            *(GAS v4u*)(QKC + (size_t)tok * 512 + c0) = o;
        }
    }
#undef POST_LOAD
}
typedef float f32x16 __attribute__((ext_vector_type(16)));
__device__ __forceinline__ void select_load(const float* SC, int tok, int lane, f32x4 (&raw)[8]);
__device__ __forceinline__ void select_row(const f32x4 (&raw)[8], unsigned* MASK, int tok, int lane);
__device__ __forceinline__ void ph_idx_scores(LAS unsigned char* lds, int wvx) {
    TIDX;
    const bf16* H = WS(bf16, WS_H); const bf16* XKP = WS(bf16, WS_XKP); float* SC = WS(float, WS_SC); unsigned* MASK = WS(unsigned, WS_MASK);
    const int r = lane & 31, hh = lane >> 5, ql = r >> 3, hd = r & 7;
    constexpr int KP = 144;
    LAS unsigned char* kt = lds;
    const int skey = tid >> 3, sch = tid & 7;
    for (int item = bidx; item < 256; item += gsz) {
        const int b = item >> 4, p = item & 15;
#pragma unroll 1
        for (int sub = 0; sub < 2; ++sub) {
            const int qblk = sub ? 31 - p : p, q0 = qblk * 64 + 8 * wave, tok0 = b * SEQ + q0;
            bf16x8 af[2][4];
#pragma unroll
            for (int g = 0; g < 2; ++g) { const bf16* ap = H + (size_t)(tok0 + 4 * g + ql) * NHC + HC_XQ + hd * 64 + 8 * hh;
#pragma unroll
              for (int ks = 0; ks < 4; ++ks) af[g][ks] = *(const GAS bf16x8*)(ap + ks * 16); }
            float wv[2][4][4];
#pragma unroll
            for (int g = 0; g < 2; ++g)
#pragma unroll
                for (int q = 0; q < 4; ++q)
#pragma unroll
                    for (int i = 0; i < 4; ++i) wv[g][q][i] = bf2f(H[(size_t)(tok0 + 4 * g + q) * NHC + HC_XW + 4 * hh + i]);
            const int npair = qblk + 1;
            const bf16* ksrc = XKP + (size_t)(b * SEQ + skey) * 64 + 8 * sch;
            __syncthreads();
            { const v4u t0 = *(const GAS v4u*)ksrc; *(LAS v4u*)(kt + skey * KP + 16 * sch) = t0; }
            v4u stg = (v4u){0u, 0u, 0u, 0u};
            if (npair > 1) stg = *(const GAS v4u*)(ksrc + 4096);
            __syncthreads();
            for (int pr = 0; pr < npair; ++pr) {
                const LAS unsigned char* kb = kt + (pr & 1) * (64 * KP);
                bf16x8 bc[2][4];
#pragma unroll
                for (int t2 = 0; t2 < 2; ++t2)
#pragma unroll
                    for (int ks = 0; ks < 4; ++ks) bc[t2][ks] = *(const LAS bf16x8*)(kb + (32 * t2 + r) * KP + 32 * ks + 16 * hh);
                v4u stg2 = (v4u){0u, 0u, 0u, 0u};
                if (pr + 2 < npair) stg2 = *(const GAS v4u*)(ksrc + (size_t)(pr + 2) * 4096);
#pragma unroll
                for (int t2 = 0; t2 < 2; ++t2) {
                    const int key = pr * 64 + t2 * 32 + r;
#pragma unroll
                    for (int g = 0; g < 2; ++g) {
                        f32x16 acc = {};
#pragma unroll
                        for (int ks = 0; ks < 4; ++ks) acc = __builtin_amdgcn_mfma_f32_32x32x16_bf16(af[g][ks], bc[t2][ks], acc, 0, 0, 0);
                        float tot[4];
#pragma unroll
                        for (int q = 0; q < 4; ++q) { float pp = 0.f;
#pragma unroll
                            for (int i = 0; i < 4; ++i) pp += wv[g][q][i] * fmaxf(acc[4 * q + i], 0.f);
                            tot[q] = pp + shx(pp, lane, 32); }
                        const float o0 = hh ? tot[2] : tot[0], o1 = hh ? tot[3] : tot[1];
                        SC[(size_t)(tok0 + 4 * g + 2 * hh) * SEQ + key] = o0; SC[(size_t)(tok0 + 4 * g + 2 * hh + 1) * SEQ + key] = o1;
                    }
                }
                if (pr + 1 < npair) *(LAS v4u*)(kt + ((pr + 1) & 1) * (64 * KP) + skey * KP + 16 * sch) = stg;
                stg = stg2;
                __syncthreads();
            }
            asm volatile("s_waitcnt vmcnt(0)" ::: "memory"); __builtin_amdgcn_fence(__ATOMIC_ACQUIRE, "agent"); asm volatile("s_waitcnt vmcnt(0)" ::: "memory");
            { f32x4 rawc[8], rawn[8]; select_load(SC, tok0, lane, rawc);
#pragma unroll 1
              for (int q = 0; q < 8; ++q) { if (q + 1 < 8) select_load(SC, tok0 + q + 1, lane, rawn);
                  select_row(rawc, MASK, tok0 + q, lane);
#pragma unroll
                  for (int j = 0; j < 8; ++j) rawc[j] = rawn[j]; } }
        }
    }
}
constexpr size_t WS_OD = WS_END;
constexpr size_t WS_END2 = WS_END + 64 * MiB;
__device__ __forceinline__ void ph_diff_attn(LAS unsigned char* lds, int wvx) {
    CArgs* A = kargs();
    const int G = gsz_(), bx = bid_(), vcu = (G % 8 == 0) ? (bx % 8) * (G / 8) + bx / 8 : bx;
    const bf16* H = WS(bf16, WS_H); bf16* OD = WS(bf16, WS_OD);
    for (int item = vcu; item < NB * 16; item += G) {
        const int b = item >> 4, vh = item & 15, g = vh >> 1, half = vh & 1;
#pragma unroll 1
        for (int qb = 7; qb >= 0; --qb)
            attn_body::attn_unit<8, false>(wvx, b, qb, H + HC_DQ + g * 64, H + HC_DK + g * 64, H + HC_DV + (g >> 1) * 128 + half * 64, OD + g * 128 + half * 64, nullptr, (char*)lds);
    }
}
__device__ __forceinline__ void ph_diff_post(int l, int wvx) {
    TIDX;
    const bf16* OD = WS(bf16, WS_OD); bf16* MIX = WS(bf16, WS_MIX);
    const float lam = WS(float, WS_LAM)[l], sc1m = 1.0f - (0.8f - 0.6f * __expf(-0.3f * (float)l));
    const int h = lane >> 4, c0 = (lane & 15) * 8;
    float gv[8];
    { const float* g = A->in[I_DFNORM] + l * 512 + h * 128 + c0;
#pragma unroll
      for (int e = 0; e < 8; ++e) gv[e] = g[e] * sc1m; }
    us8 n1 = {}, n2 = {};
    if (gw < T) { n1 = *(const GAS us8*)(OD + (size_t)gw * D + (2 * h) * 128 + c0); n2 = *(const GAS us8*)(OD + (size_t)gw * D + (2 * h + 1) * 128 + c0); }
    for (int tok = gw; tok < T; tok += ngw) {
        const us8 a1 = n1, a2 = n2;
        if (tok + ngw < T) { n1 = *(const GAS us8*)(OD + (size_t)(tok + ngw) * D + (2 * h) * 128 + c0); n2 = *(const GAS us8*)(OD + (size_t)(tok + ngw) * D + (2 * h + 1) * 128 + c0); }
        float d[8], ss = 0.f;
#pragma unroll
        for (int e = 0; e < 8; ++e) { d[e] = bf2f(a1[e]) - lam * bf2f(a2[e]); ss += d[e] * d[e]; }
        ss += DPPF(ss, 0xB1); ss += DPPF(ss, 0x4E); ss += DPPF(ss, 0x141); ss += DPPF(ss, 0x140);
        const float rs = 1.0f / sqrtf(ss * (1.0f / 128.0f) + LN_EPS);
        v4u o; o.x = pk2(d[0] * rs * gv[0], d[1] * rs * gv[1]); o.y = pk2(d[2] * rs * gv[2], d[3] * rs * gv[3]); o.z = pk2(d[4] * rs * gv[4], d[5] * rs * gv[5]); o.w = pk2(d[6] * rs * gv[6], d[7] * rs * gv[7]);
        *(GAS v4u*)(MIX + (size_t)tok * D + 256 + h * 128 + c0) = o;
    }
}
__device__ __forceinline__ void ph_dsa_attn(LAS unsigned char* lds, int wvx) {
    CArgs* A = kargs();
    const int G = gsz_(), bx = bid_(), vcu = (G % 8 == 0) ? (bx % 8) * (G / 8) + bx / 8 : bx;
    const bf16* H = WS(bf16, WS_H); bf16* MIX = WS(bf16, WS_MIX); const unsigned* MASK = WS(unsigned, WS_MASK);
    for (int item = vcu; item < NB * 4 * 4; item += G) {
        const int bh = item >> 2, p = item & 3, b = bh >> 2, h = bh & 3;
        attn_body::attn_unit<8, true>(wvx, b, 7 - p, H + HC_SQ + h * 64, H + HC_SK + h * 64, H + HC_SV + h * 64, MIX + 768 + h * 64, MASK, (char*)lds);
        attn_body::attn_unit<8, true>(wvx, b, p, H + HC_SQ + h * 64, H + HC_SK + h * 64, H + HC_SV + h * 64, MIX + 768 + h * 64, MASK, (char*)lds);
    }
}
constexpr size_t WS_DC = WS_END2;
constexpr size_t WS_CST = WS_DC + 32 * MiB;
constexpr size_t WS_DN = WS_CST + 32 * MiB;
constexpr size_t WS_END3 = WS_DN + 4 * MiB;
constexpr size_t WS_DUMMY = WS_END3;
constexpr size_t WS_END4 = WS_DUMMY + 256 * MiB;
typedef float f32x2_ __attribute__((ext_vector_type(2)));
constexpr int MP = 68;
__device__ __forceinline__ float log_sigmoid_(float x) { return fminf(x, 0.f) - log1pf(__expf(-fabsf(x))); }
__device__ __forceinline__ void mlstm_gates(bf16 iraw, bf16 fraw, float gbi, float gbf, int lane, LAS float* bcum, LAS float* av) {
    const float ip = bf2f(iraw) + gbi; float lf = log_sigmoid_(bf2f(fraw) + gbf);
#pragma unroll
    for (int o = 1; o < 64; o <<= 1) { const float t_ = shup(lf, lane, o); if (lane >= o) lf += t_; }
    bcum[lane] = lf; av[lane] = ip - lf;
}
constexpr int PB = 72;

__device__ __forceinline__ f32x16 mfma_tile(const LAS bf16* Xa, int mt, const LAS bf16* Xb, int nt, int r, int hh, f32x16 acc) {
#pragma unroll
    for (int ks = 0; ks < 4; ++ks) { const bf16x8 a = *(const LAS bf16x8*)(Xa + (32 * mt + r) * PB + 16 * ks + 8 * hh), b = *(const LAS bf16x8*)(Xb + (32 * nt + r) * PB + 16 * ks + 8 * hh);
        acc = __builtin_amdgcn_mfma_f32_32x32x16_bf16(a, b, acc, 0, 0, 0); }
    return acc;
}
__device__ __forceinline__ void ph_mlstm_m1(LAS unsigned char* lds, int l, int wvx) {
    TIDX;
    const bf16* H = WS(bf16, WS_H); const bf16* QKC = WS(bf16, WS_QKC);
    float* DC = WS(float, WS_DC); float* DN = WS(float, WS_DN); float* SCAL = WS(float, WS_DN + 2 * MiB);
    LAS bf16* kT = (LAS bf16*)lds; LAS bf16* vwT = kT + 64 * PB;
    LAS float* bcum = (LAS float*)(vwT + 96 * PB); LAS float* av = bcum + 64; LAS float* wv = av + 64;
    const int r = lane & 31, hh = lane >> 5, srow = tid >> 3, ch = tid & 7;
    us8 nk = {}, nv_ = {}; bf16 nig = 0, nfg = 0;
#define M1_LOAD(uu) do { const int bh_ = (uu) >> 5, c_ = (uu) & 31, t0_ = (bh_ >> 2) * SEQ + c_ * 64, h_ = bh_ & 3; \
        nk = *(const GAS us8*)(QKC + (size_t)(t0_ + srow) * 512 + 256 + h_ * 64 + 8 * ch); nv_ = *(const GAS us8*)(H + (size_t)(t0_ + srow) * NHC + HC_MV + h_ * 64 + 8 * ch); \
        if (wave == 0) { nig = H[(size_t)(t0_ + lane) * NHC + HC_MI + h_]; nfg = H[(size_t)(t0_ + lane) * NHC + HC_MF + h_]; } } while (0)
    M1_LOAD(bidx);
    for (int u = bidx; u < NB * 4 * 32; u += gsz) {
        const int bh = u >> 5, c = u & 31, b = bh >> 2, h = bh & 3, tok0 = b * SEQ + c * 64; (void)tok0;
        const us8 kraw = nk, vraw = nv_; const bf16 igr = nig, fgr = nfg;
        if (u + gsz < NB * 4 * 32) M1_LOAD(u + gsz);
        if (wave == 0) { mlstm_gates(igr, fgr, A->in[I_GATEB][l * 8 + h], A->in[I_GATEB][l * 8 + 4 + h], lane, bcum, av); }
        __syncthreads();
        if (wave == 0) { const float a = av[lane], amax = wave_max(a); wv[lane] = __expf(a - amax); if (lane == 0) { SCAL[u * 4 + 0] = bcum[63]; SCAL[u * 4 + 1] = bcum[63] + amax; } }
        __syncthreads();
        { const float w = wv[srow];
#pragma unroll
          for (int e = 0; e < 8; ++e) { kT[(8 * ch + e) * PB + srow] = kraw[e]; vwT[(8 * ch + e) * PB + srow] = (bf16)f2bf(w * bf2f(vraw[e])); }
          if (tid < 64) vwT[64 * PB + tid] = (bf16)f2bf(wv[tid]);
          for (int i = tid; i < 31 * 64; i += 512) vwT[(65 + i / 64) * PB + (i & 63)] = 0; }
        __syncthreads();
        if (wave < 6) { const int mt = wave >> 1, nt = wave & 1;
            f32x16 acc = {}; acc = mfma_tile(vwT, mt, kT, nt, r, hh, acc);
#pragma unroll
            for (int g = 0; g < 16; ++g) { const int vrow = 32 * mt + (g & 3) + 8 * (g >> 2) + 4 * hh, d = 32 * nt + r;
                if (vrow < 64) DC[(size_t)u * 4096 + vrow * 64 + d] = acc[g]; else if (vrow == 64) DN[(size_t)u * 64 + d] = acc[g]; } }
        __syncthreads();
    }
#undef M1_LOAD
}
__device__ __forceinline__ void ph_mlstm_m2(int wvx) {
    TIDX;
    const float* DC = WS(float, WS_DC); float* CS = WS(float, WS_CST); const float* DN = WS(float, WS_DN); float* NS = WS(float, WS_DN + 1 * MiB); float* SCAL = WS(float, WS_DN + 2 * MiB);
    for (int item = bidx; item < NB * 4 * 4; item += gsz) {
        const int bh = item >> 2, qtr = item & 3, e0 = qtr * 1024 + tid * 2;
        f32x2_ dc[32]; float dn[32];
#pragma unroll
        for (int c = 0; c < 32; ++c) { dc[c] = *(const GAS f32x2_*)(DC + (size_t)(bh * 32 + c) * 4096 + e0); dn[c] = (qtr == 0 && tid < 64) ? DN[(size_t)(bh * 32 + c) * 64 + tid] : 0.f; }
        float z_ = 0.f; asm volatile("" : "+v"(z_));
        float m = 0.f; f32x2_ C = (f32x2_){z_, z_}; float n = z_;
#pragma unroll
        for (int c = 0; c < 32; ++c) {
            const int u = bh * 32 + c;
            const float bl = SCAL[u * 4 + 0], ml = SCAL[u * 4 + 1];
            *(GAS f32x2_*)(CS + (size_t)u * 4096 + e0) = C;
            if (qtr == 0 && tid < 64) NS[(size_t)u * 64 + tid] = n;
            if (qtr == 0 && tid == 0) SCAL[u * 4 + 2] = m;
            const float mn = fmaxf(bl + m, ml), f1 = __expf(bl + m - mn), f2 = __expf(ml - mn);
            C.x = f1 * C.x + f2 * dc[c].x; C.y = f1 * C.y + f2 * dc[c].y;
            n = f1 * n + f2 * dn[c];
            m = mn;
        }
    }
}
__device__ __forceinline__ void ph_mlstm_m3(LAS unsigned char* lds, int l, int wvx) {
    TIDX;
    const bf16* H = WS(bf16, WS_H); const bf16* QKC = WS(bf16, WS_QKC); bf16* MIX = WS(bf16, WS_MIX);
    const float* CS = WS(float, WS_CST); const float* NS = WS(float, WS_DN + 1 * MiB); const float* SCAL = WS(float, WS_DN + 2 * MiB);
    LAS bf16* qS = (LAS bf16*)lds; LAS bf16* kS = qS + 64 * PB; LAS bf16* vT = kS + 64 * PB; LAS bf16* cT = vT + 96 * PB; LAS bf16* Sb = cT + 96 * PB;
    LAS float* hS = (LAS float*)(Sb + 64 * PB);
    LAS float* bcum = hS + 64 * MP; LAS float* av = bcum + 64; LAS float* mm = av + 64; LAS float* inter = mm + 64; LAS float* dinv = inter + 64;
    const int r = lane & 31, hh = lane >> 5, srow = tid >> 3, ch = tid & 7;
    us8 nq = {}, nk = {}, nv_ = {}; f32x4 nc0 = {}, nc1 = {}; bf16 nog[8] = {}; bf16 nig = 0, nfg = 0; float nns = 0.f, nmc = 0.f;
#define M3_LOAD(uu) do { const int bh_ = (uu) >> 5, c_ = (uu) & 31, t0_ = (bh_ >> 2) * SEQ + c_ * 64, h_ = bh_ & 3; \
        nq = *(const GAS us8*)(QKC + (size_t)(t0_ + srow) * 512 + h_ * 64 + 8 * ch); nk = *(const GAS us8*)(QKC + (size_t)(t0_ + srow) * 512 + 256 + h_ * 64 + 8 * ch); \
        nv_ = *(const GAS us8*)(H + (size_t)(t0_ + srow) * NHC + HC_MV + h_ * 64 + 8 * ch); \
        nc0 = *(const GAS f32x4*)(CS + (size_t)(uu) * 4096 + srow * 64 + 8 * ch); nc1 = *(const GAS f32x4*)(CS + (size_t)(uu) * 4096 + srow * 64 + 8 * ch + 4); \
        _Pragma("unroll") for (int j = 0; j < 8; ++j) nog[j] = H[(size_t)(t0_ + wave + 8 * j) * NHC + HC_MO + h_ * 64 + lane]; \
        nmc = SCAL[(uu) * 4 + 2]; if (tid < 64) nns = NS[(size_t)(uu) * 64 + tid]; \
        if (wave == 0) { nig = H[(size_t)(t0_ + lane) * NHC + HC_MI + h_]; nfg = H[(size_t)(t0_ + lane) * NHC + HC_MF + h_]; } } while (0)
    M3_LOAD(bidx);
    for (int u = bidx; u < NB * 4 * 32; u += gsz) {
        const int bh = u >> 5, c = u & 31, b = bh >> 2, h = bh & 3, tok0 = b * SEQ + c * 64;
        const float mc = nmc, nsv = nns;
        bf16 ograw[8];
#pragma unroll
        for (int j = 0; j < 8; ++j) ograw[j] = nog[j];
        const float gnorm = A->in[I_MNORM][l * 256 + h * 64 + lane];
        const us8 qraw = nq, kraw = nk, vraw = nv_; const f32x4 c0 = nc0, c1 = nc1; const bf16 igr = nig, fgr = nfg;
        if (u + gsz < NB * 4 * 32) M3_LOAD(u + gsz);
        {
            us8 qs;
#pragma unroll
            for (int e = 0; e < 8; ++e) qs[e] = (bf16)f2bf(bf2f(qraw[e]) * 0.125f);
            *(LAS us8*)(qS + srow * PB + 8 * ch) = qs; *(LAS us8*)(kS + srow * PB + 8 * ch) = kraw;
#pragma unroll
            for (int e = 0; e < 8; ++e) vT[(8 * ch + e) * PB + srow] = vraw[e];
            v4u cp; cp.x = pk2(c0[0], c0[1]); cp.y = pk2(c0[2], c0[3]); cp.z = pk2(c1[0], c1[1]); cp.w = pk2(c1[2], c1[3]);
            *(LAS v4u*)(cT + srow * PB + 8 * ch) = cp;
            if (tid < 64) { vT[64 * PB + tid] = (bf16)0x3f80; cT[64 * PB + tid] = (bf16)f2bf(nsv); }
            for (int i = tid; i < 31 * 64; i += 512) { vT[(65 + i / 64) * PB + (i & 63)] = 0; cT[(65 + i / 64) * PB + (i & 63)] = 0; }
        }
        if (wave == 0) { mlstm_gates(igr, fgr, A->in[I_GATEB][l * 8 + h], A->in[I_GATEB][l * 8 + 4 + h], lane, bcum, av); }
        __syncthreads();
        if (wave == 0) { float pm = av[lane];
#pragma unroll
            for (int o = 1; o < 64; o <<= 1) { const float t_ = shup(pm, lane, o); if (lane >= o) pm = fmaxf(pm, t_); }
            const float m_ = fmaxf(mc, pm); mm[lane] = m_; inter[lane] = __expf(mc - m_); }
        __syncthreads();
        if (wave < 4) { const int tt = wave >> 1, st = wave & 1;
            f32x16 acc = {}; acc = mfma_tile(qS, tt, kS, st, r, hh, acc);
            const int s = 32 * st + r; const float as = av[s];
#pragma unroll
            for (int g = 0; g < 16; ++g) { const int t = 32 * tt + (g & 3) + 8 * (g >> 2) + 4 * hh;
                const float val = (s <= t) ? acc[g] * __expf(as - mm[t]) : 0.f; Sb[t * PB + s] = (bf16)f2bf(val); } }
        __syncthreads();
        f32x16 aS = {}, aC = {}; const int tt = (wave < 6) ? wave / 3 : 0, nt = (wave < 6) ? wave % 3 : 0;
        if (wave < 6) { aS = mfma_tile(Sb, tt, vT, nt, r, hh, aS); aC = mfma_tile(qS, tt, cT, nt, r, hh, aC); }
        if (wave < 6 && nt == 2 && r == 0) {
#pragma unroll
            for (int g = 0; g < 16; ++g) { const int t = 32 * tt + (g & 3) + 8 * (g >> 2) + 4 * hh;
                const float dn = aS[g] + inter[t] * aC[g]; dinv[t] = 1.0f / fmaxf(fabsf(dn), __expf(-(bcum[t] + mm[t]))); } }
        __syncthreads();
        if (wave < 6 && nt < 2) {
#pragma unroll
            for (int g = 0; g < 16; ++g) { const int t = 32 * tt + (g & 3) + 8 * (g >> 2) + 4 * hh;
                hS[t * MP + 32 * nt + r] = (aS[g] + inter[t] * aC[g]) * dinv[t]; } }
        __syncthreads();
#pragma unroll
        for (int j = 0; j < 8; ++j) { const int t = wave + 8 * j, vc = lane; const size_t tk = (size_t)(tok0 + t);
            const float hv = hS[t * MP + vc];
            const float mean = wave_sum(hv) * (1.0f / 64.0f), hc = hv - mean;
            const float rs = 1.0f / sqrtf(wave_sum(hc * hc) * (1.0f / 64.0f) + LN_EPS);
            const float og = sigmoidf_(bf2f(ograw[j]));
            MIX[tk * D + h * 64 + vc] = (bf16)f2bf(og * (hc * rs * gnorm)); }
        __syncthreads();
    }
#undef M3_LOAD
}
__device__ __forceinline__ int wave_sum_i(int x) {
    x += __builtin_amdgcn_update_dpp(0, x, 0xB1, 0xF, 0xF, true);
    x += __builtin_amdgcn_update_dpp(0, x, 0x4E, 0xF, 0xF, true);
    x += __builtin_amdgcn_update_dpp(0, x, 0x141, 0xF, 0xF, true);
    x += __builtin_amdgcn_update_dpp(0, x, 0x140, 0xF, 0xF, true);
    return __builtin_amdgcn_readlane(x, 0) + __builtin_amdgcn_readlane(x, 16) + __builtin_amdgcn_readlane(x, 32) + __builtin_amdgcn_readlane(x, 48);
}
__device__ __forceinline__ void select_load(const float* SC, int tok, int lane, f32x4 (&raw)[8]) {
    const int tl = tok % SEQ, lo = 32 * lane; const bool need = (tl >= 256) && (tl + 1 - lo > 0);
#pragma unroll
    for (int j = 0; j < 8; ++j) { raw[j] = (f32x4){0.f, 0.f, 0.f, 0.f}; if (need) raw[j] = *(const GAS f32x4*)(SC + (size_t)tok * SEQ + lo + 4 * j); }
}
__device__ __forceinline__ void select_row(const f32x4 (&raw)[8], unsigned* MASK, int tok, int lane) {
        const int tl = tok % SEQ, lo = 32 * lane;
        const int nv = min(max(tl + 1 - lo, 0), 32);
        unsigned cand = (nv >= 32) ? 0xffffffffu : ((1u << nv) - 1u);
        if (tl < 256) { MASK[(size_t)tok * 64 + lane] = cand; return; }
        unsigned a[32];
#pragma unroll
        for (int j = 0; j < 8; ++j) {
            const f32x4 v = raw[j];
#pragma unroll
            for (int c = 0; c < 4; ++c) { unsigned u = __float_as_uint(v[c]); u = (u == 0x80000000u) ? 0u : u; a[4 * j + c] = (u >> 31) ? ~u : (u | 0x80000000u); }
        }
#define TSTAGE(J, M) _Pragma("unroll") for (int k0 = 0; k0 < 32; ++k0) { if ((k0 & J) == 0) { const unsigned x_ = a[k0], y_ = a[k0 + J];   \
            a[k0] = ((y_ << J) & ((M) << J)) | (x_ & ~((M) << J)); a[k0 + J] = ((x_ >> J) & (M)) | (y_ & ~(M)); } }
#define PSTAGE(J, SA, SB) _Pragma("unroll") for (int k0 = 0; k0 < 32; ++k0) { if ((k0 & J) == 0) { const unsigned x_ = a[k0], y_ = a[k0 + J]; a[k0] = __builtin_amdgcn_perm(y_, x_, SA); a[k0 + J] = __builtin_amdgcn_perm(y_, x_, SB); } }
        PSTAGE(16, 0x05040100u, 0x07060302u) PSTAGE(8, 0x06020400u, 0x07030501u) TSTAGE(4, 0x0F0F0F0Fu) TSTAGE(2, 0x33333333u) TSTAGE(1, 0x55555555u)
#undef PSTAGE
#undef TSTAGE
        unsigned sel = 0u; int need = 256, ncand = tl + 1;
#pragma unroll
        for (int b = 31; b >= 0; --b) {
            if (ncand != need) {
                const unsigned hit = cand & a[b];
                const int cnt = wave_sum_i(__popc(hit));
                if (cnt >= need) { cand = hit; ncand = cnt; }
                else { sel |= hit; cand &= ~a[b]; need -= cnt; ncand -= cnt; }
            }
        }
        if (ncand == need) sel |= cand;
        else {
            const int my = __popc(cand); int incl = my;
#pragma unroll
            for (int o = 1; o < 64; o <<= 1) { const int t_ = shupi(incl, lane, o); if (lane >= o) incl += t_; }
            const int take = min(max(need - (incl - my), 0), my); int taken = 0;
#pragma unroll 1
            for (int k = 0; k < 32; ++k) { if (((cand >> k) & 1u) && taken < take) { sel |= 1u << k; ++taken; } }
        }
        MASK[(size_t)tok * 64 + lane] = sel;
}
constexpr int R1_OFF = RING_BYTES + 8192;
__device__ __forceinline__ void ph_row1(LAS unsigned char* lds, int l, int wvx, bool dry = false) {
    TIDX;
    const bf16* xin = WS(bf16, WS_XB); bf16* XB = dry ? WS(bf16, WS_DUMMY) : WS(bf16, WS_XB);
    const bf16* Y = WS(bf16, WS_Y); bf16* U = dry ? WS(bf16, WS_DUMMY + 128 * MiB) : WS(bf16, WS_U);
    unsigned* cnt = dry ? WS(unsigned, WS_DUMMY + 200 * MiB) : WS(unsigned, WS_CTL) + CW_CNT + l * NEXP * 64; unsigned* TOK = dry ? WS(unsigned, WS_DUMMY + 192 * MiB) : WS(unsigned, WS_TOK);
    unsigned* RMAP = dry ? WS(unsigned, WS_DUMMY + 208 * MiB) : WS(unsigned, WS_XG);
    constexpr int RWP = 1032;
    LAS bf16* rw = (LAS bf16*)lds; LAS bf16* UT = rw + 32 * RWP; LAS float* PT = (LAS float*)(UT + 16 * RWP); LAS float* LG = PT + 8 * 16 * 33; LAS float* TP = LG + 16 * 33; LAS float* VT = TP + 64;
    static_assert((32 * RWP + 16 * RWP) * 2 + (8 * 16 * 33 + 16 * 33 + 64 + 5 * 1024) * 4 <= R1_OFF, "row1 LDS map");
    LAS unsigned* lcnt = (LAS unsigned*)(lds + R1_OFF); LAS unsigned* lbase = lcnt + 32; LAS unsigned* nrec = lbase + 32; LAS unsigned* rec = nrec + 4;
    { const GAS f32x4* src = (const GAS f32x4*)(WS(float, WS_RWT) + (size_t)l * NEXP * D);
      f32x4 w4[16];
#pragma unroll
      for (int q = 0; q < 16; ++q) w4[q] = src[tid + 512 * q];
#pragma unroll
      for (int q = 0; q < 16; ++q) { const int i = tid + 512 * q, e_ = i >> 8, c_ = (i & 255) * 4; *(LAS unsigned long long*)(rw + e_ * RWP + c_) = (unsigned long long)pk2(w4[q].x, w4[q].y) | ((unsigned long long)pk2(w4[q].z, w4[q].w) << 32); } }
    const float rbias = A->in[I_RB][l * NEXP + (tid & 31)];
    for (int chunk = bidx; chunk < T / 128; chunk += gsz) {
        const int cb = (chunk * 128) / SEQ; const float* mod = WS(float, WS_MOD) + ((size_t)l * NB + cb) * 6144;
        __syncthreads();
        for (int i = tid; i < 5 * 256; i += 512) { const int vsel = i >> 8, c4 = (i & 255) * 4;
            const float* sp = vsel == 0 ? mod + 2048 : vsel == 1 ? mod + 4096 : vsel == 2 ? mod + 3072 : vsel == 3 ? A->in[I_LN1G] + l * D : A->in[I_LN1B] + l * D;
            *(LAS f32x4*)(VT + vsel * 1024 + c4) = *(const GAS f32x4*)(sp + c4); }
        if (tid < 32) lcnt[tid] = 0u; if (tid == 32) nrec[0] = 0u;
        __syncthreads();
        const int tbase = chunk * 128 + 2 * wave;
        unsigned long long px[2][4], py[2][4];
#define R1_LOAD(t, tk) do { _Pragma("unroll") for (int j = 0; j < 4; ++j) { const int c = 4 * lane + 256 * j; \
            px[t][j] = *(const GAS unsigned long long*)(xin + (size_t)(tk) * D + c); py[t][j] = *(const GAS unsigned long long*)(Y + (size_t)(tk) * D + c); } } while (0)
        R1_LOAD(0, tbase); R1_LOAD(1, tbase + 1);
#pragma unroll 1
        for (int it_ = 0; it_ < 8; ++it_) {
#pragma unroll
            for (int t = 0; t < 2; ++t) {
                const int tok = tbase + 16 * it_ + t;
                f32x4 v[4]; float s = 0.f;
#pragma unroll
                for (int j = 0; j < 4; ++j) { const int c = 4 * lane + 256 * j;
                    const unsigned long long xr = px[t][j]; const f32x4 g1 = *(const LAS f32x4*)(VT + c);
                    f32x4 x; x.x = __uint_as_float((unsigned)xr << 16); x.y = __uint_as_float((unsigned)xr & 0xffff0000u); x.z = __uint_as_float((unsigned)(xr >> 32) << 16); x.w = __uint_as_float((unsigned)(xr >> 32) & 0xffff0000u);
                    const unsigned long long yr = py[t][j];
                    f32x4 y; y.x = __uint_as_float((unsigned)yr << 16); y.y = __uint_as_float((unsigned)yr & 0xffff0000u); y.z = __uint_as_float((unsigned)(yr >> 32) << 16); y.w = __uint_as_float((unsigned)(yr >> 32) & 0xffff0000u);
                    v[j] = x * DN_ALPHA + (1.0f + g1) * y; s += (v[j].x + v[j].y) + (v[j].z + v[j].w); }
                if (it_ + 1 < 8) R1_LOAD(t, tok + 16);
                const float mean = wave_sum(s) * (1.0f / D); float s2 = 0.f;
#pragma unroll
                for (int j = 0; j < 4; ++j) { v[j] = v[j] - mean; s2 += (v[j].x * v[j].x + v[j].y * v[j].y) + (v[j].z * v[j].z + v[j].w * v[j].w); }
                const float rstd = 1.0f / sqrtf(wave_sum(s2) * (1.0f / D) + LN_EPS);
#pragma unroll
                for (int j = 0; j < 4; ++j) { const int c = 4 * lane + 256 * j;
                    const f32x4 xn = v[j] * rstd * *(const LAS f32x4*)(VT + 3072 + c) + *(const LAS f32x4*)(VT + 4096 + c);
                    *(GAS unsigned long long*)(XB + (size_t)tok * D + c) = (unsigned long long)pk2(xn.x, xn.y) | ((unsigned long long)pk2(xn.z, xn.w) << 32);
                    const f32x4 u2 = xn * (1.0f + *(const LAS f32x4*)(VT + 1024 + c)) + *(const LAS f32x4*)(VT + 2048 + c);
                    *(GAS unsigned*)((unsigned char*)U + (size_t)tok * D + c) = pg8::pk4_fp8(u2.x, u2.y, u2.z, u2.w, 16.0f);
                    *(LAS unsigned long long*)(UT + (2 * wave + t) * RWP + c) = (unsigned long long)pk2(u2.x, u2.y) | ((unsigned long long)pk2(u2.z, u2.w) << 32); }
            }
            __syncthreads();
            { const int fr = lane & 15, fq = lane >> 4;
              f32x4 pacc[2] = {(f32x4){0.f, 0.f, 0.f, 0.f}, (f32x4){0.f, 0.f, 0.f, 0.f}};
#pragma unroll
              for (int ks = 0; ks < 4; ++ks) { const int k0 = 128 * wave + 32 * ks + 8 * fq;
                  const bf16x8 a = *(const LAS bf16x8*)(UT + fr * RWP + k0);
#pragma unroll
                  for (int n = 0; n < 2; ++n) { const bf16x8 b = *(const LAS bf16x8*)(rw + (16 * n + fr) * RWP + k0); pacc[n] = __builtin_amdgcn_mfma_f32_16x16x32_bf16(a, b, pacc[n], 0, 0, 0); } }
#pragma unroll
              for (int n = 0; n < 2; ++n)
#pragma unroll
                  for (int g = 0; g < 4; ++g) PT[(wave * 16 + 4 * fq + g) * 33 + 16 * n + fr] = pacc[n][g]; }
            __syncthreads();
            {
                const int slot = tid >> 5, ex = tid & 31;
                float lg_ = rbias;
#pragma unroll
                for (int w = 0; w < 8; ++w) lg_ += PT[(w * 16 + slot) * 33 + ex];
                LG[slot * 33 + ex] = lg_;
                LDS_WAIT(); asm volatile("" ::: "memory");
                int rank = 0;
#pragma unroll
                for (int j = 0; j < 32; ++j) { const float lj = LG[slot * 33 + j]; rank += (lj > lg_ || (lj == lg_ && j < ex)) ? 1 : 0; }
                if (rank < 4) TP[slot * 4 + rank] = lg_;
                LDS_WAIT(); asm volatile("" ::: "memory");
                const int tok = chunk * 128 + 16 * it_ + slot;
                if (rank < 4) {
                    const float t0 = TP[slot * 4], e1 = __expf(TP[slot * 4 + 1] - t0), e2 = __expf(TP[slot * 4 + 2] - t0), e3 = __expf(TP[slot * 4 + 3] - t0);
                    const float pk = __expf(lg_ - t0) / (1.0f + e1 + e2 + e3);
                    const unsigned lp = __hip_atomic_fetch_add(lcnt + ex, 1u, __ATOMIC_RELAXED, __HIP_MEMORY_SCOPE_WORKGROUP);
                    const unsigned ri = __hip_atomic_fetch_add(nrec, 1u, __ATOMIC_RELAXED, __HIP_MEMORY_SCOPE_WORKGROUP);
                    if (ri < 600u) { LAS unsigned* rr = rec + ri * 3; rr[0] = (unsigned)tok * 4u + (unsigned)rank; rr[1] = (unsigned)ex | (lp << 8); rr[2] = __float_as_uint(pk); } }
            }
            __syncthreads();
        }
#undef R1_LOAD
        if (tid < 32) lbase[tid] = __hip_atomic_fetch_add(cnt + tid * 64, lcnt[tid], __ATOMIC_RELAXED, __HIP_MEMORY_SCOPE_AGENT);
        __syncthreads();
        { const int n = (int)min(nrec[0], 600u);
          for (int i = tid; i < n; i += 512) { const unsigned r0 = rec[i * 3], r1 = rec[i * 3 + 1], r2 = rec[i * 3 + 2]; const unsigned ek = r1 & 255u;
              const unsigned pos = (dry ? 0u : lbase[ek]) + (r1 >> 8);
              *(GAS v4u*)(TOK + (size_t)r0 * 4) = (v4u){ek, pos, r2, 0u}; RMAP[(size_t)ek * T + pos] = r0 >> 2; } }
    }
    __syncthreads();
}
__device__ __forceinline__ int moe_tables(LAS unsigned char* lds, int l, int wvx) {
    CArgs* A = kargs();
    LAS unsigned* base = (LAS unsigned*)(lds + TAB_OFF); LAS unsigned char* tile_e = lds + TAB_OFF + 256; LAS unsigned* cntl = (LAS unsigned*)(lds + TAB_OFF + 1024);
    const unsigned* cnt = WS(unsigned, WS_CTL) + CW_CNT + l * NEXP * 64;
    if (wvx == 0) {
        const int lane = lane_id_(), e = lane & 31;
        const unsigned c = __hip_atomic_load(cnt + e * 64, __ATOMIC_RELAXED, __HIP_MEMORY_SCOPE_AGENT);
        const int nt = (int)((c + 255u) >> 8); int incl = nt;
#pragma unroll
        for (int o = 1; o < 32; o <<= 1) { const int t_ = shupi(incl, lane, o); if (e >= o) incl += t_; }
        if (lane < 32) { const int t0 = incl - nt; base[e] = (unsigned)t0 << 8; cntl[e] = c; if (e == 31) base[NEXP] = (unsigned)incl << 8;
#pragma unroll 1
            for (int t = 0; t < nt; ++t) tile_e[t0 + t] = (unsigned char)e; }
    }
    __syncthreads();
    return (int)(base[NEXP] >> 8);
}
__device__ __forceinline__ void ph_row2(LAS unsigned char* lds, int l, int wvx, bool dry = false) {
    TIDX;
    (void)moe_tables(lds, l, wvx);
    const LAS unsigned* base = (const LAS unsigned*)(lds + TAB_OFF);
    bf16* XB = WS(bf16, WS_XB); const bf16* YM = WS(bf16, WS_YM); bf16* U = WS(bf16, WS_U); const unsigned* TOK = WS(unsigned, WS_TOK);
    const bool fin = (l == DEPTH - 1); float* dstf = dry ? WS(float, WS_DUMMY) : A->out; bf16* dstb = dry ? WS(bf16, WS_DUMMY) : XB; bf16* Uw = dry ? WS(bf16, WS_DUMMY + 128 * MiB) : U;
    LAS bf16* b2l = (LAS bf16*)lds; LAS float* VT = (LAS float*)(lds + 65536);
    { const GAS f32x4* src = (const GAS f32x4*)(A->in[I_B2] + (size_t)l * NEXP * D); f32x4 w4[16];
#pragma unroll
      for (int q = 0; q < 16; ++q) w4[q] = src[tid + 512 * q];
#pragma unroll
      for (int q = 0; q < 16; ++q) *(LAS unsigned long long*)(b2l + (size_t)(tid + 512 * q) * 4) = (unsigned long long)pk2(w4[q].x, w4[q].y) | ((unsigned long long)pk2(w4[q].z, w4[q].w) << 32); }
    for (int chunk = bidx; chunk < T / 128; chunk += gsz) {
        const int cb = (chunk * 128) / SEQ; const float* mod = WS(float, WS_MOD) + ((size_t)l * NB + cb) * 6144; const float* modn = WS(float, WS_MOD) + ((size_t)(l + 1 < DEPTH ? l + 1 : l) * NB + cb) * 6144;
        __syncthreads();
        for (int i = tid; i < 5 * 256; i += 512) { const int vsel = i >> 8, c4 = (i & 255) * 4;
            const float* sp = vsel == 0 ? mod + 5120 : vsel == 1 ? modn + 1024 : vsel == 2 ? modn : vsel == 3 ? A->in[I_LN2G] + l * D : A->in[I_LN2B] + l * D;
            *(LAS f32x4*)(VT + vsel * 1024 + c4) = *(const GAS f32x4*)(sp + c4); }
        __syncthreads();
        const int tb0 = chunk * 128 + wave;
        LAS v4u* RC = (LAS v4u*)(lds + 65536 + 20480) + wave * 64;
        RC[lane] = *(const GAS v4u*)(TOK + ((size_t)(tb0 + 8 * (lane >> 2)) * 4 + (lane & 3)) * 4);
        LDS_WAIT(); asm volatile("" ::: "memory");
        unsigned yq[4][4][4]; unsigned long long xq[4][4];
#define R2_ROWS(S, ti) do { _Pragma("unroll") for (int k = 0; k < 4; ++k) { const v4u rc_ = RC[(ti) * 4 + k]; const size_t row_ = (size_t)base[rc_.x] + rc_.y; \
            _Pragma("unroll") for (int j = 0; j < 4; ++j) yq[S][k][j] = *(const GAS unsigned*)((const unsigned char*)YM + row_ * D + 4 * lane + 256 * j); } \
            _Pragma("unroll") for (int j = 0; j < 4; ++j) xq[S][j] = *(const GAS unsigned long long*)(XB + (size_t)(tb0 + 8 * (ti)) * D + 4 * lane + 256 * j); } while (0)
#define R2_BODY(S, ti) do { const int it_ = (ti); const int tok = tb0 + 8 * it_; \
            if (it_ + 3 < 16) R2_ROWS(((S) + 3) & 3, it_ + 3); \
            f32x4 acc[4]; \
            _Pragma("unroll") for (int j = 0; j < 4; ++j) acc[j] = (f32x4){0.f, 0.f, 0.f, 0.f}; \
            _Pragma("unroll") for (int k = 0; k < 4; ++k) { const v4u rc_ = RC[it_ * 4 + k]; const float p = __uint_as_float(rc_.z); \
                _Pragma("unroll") for (int j = 0; j < 4; ++j) { const int c = 4 * lane + 256 * j; const unsigned yr = yq[S][k][j]; \
                    typedef float f32x2v_ __attribute__((ext_vector_type(2))); const f32x2v_ ylo = __builtin_amdgcn_cvt_pk_f32_fp8(yr, false), yhi = __builtin_amdgcn_cvt_pk_f32_fp8(yr, true); \
                    const f32x4 y = (f32x4){ylo.x, ylo.y, yhi.x, yhi.y} * (1.0f / 64.0f); \
                    const unsigned long long bq = *(const LAS unsigned long long*)(b2l + rc_.x * D + c); \
                    f32x4 bb; bb.x = __uint_as_float((unsigned)bq << 16); bb.y = __uint_as_float((unsigned)bq & 0xffff0000u); bb.z = __uint_as_float((unsigned)(bq >> 32) << 16); bb.w = __uint_as_float((unsigned)(bq >> 32) & 0xffff0000u); \
                    acc[j] = acc[j] + p * (y + bb); } } \
            f32x4 v[4]; float s = 0.f; \
            _Pragma("unroll") for (int j = 0; j < 4; ++j) { const int c = 4 * lane + 256 * j; const unsigned long long xr = xq[S][j]; f32x4 x; \
                x.x = __uint_as_float((unsigned)xr << 16); x.y = __uint_as_float((unsigned)xr & 0xffff0000u); x.z = __uint_as_float((unsigned)(xr >> 32) << 16); x.w = __uint_as_float((unsigned)(xr >> 32) & 0xffff0000u); \
                v[j] = x * DN_ALPHA + (1.0f + *(const LAS f32x4*)(VT + c)) * acc[j]; s += (v[j].x + v[j].y) + (v[j].z + v[j].w); } \
            const float mean = wave_sum(s) * (1.0f / D); float s2 = 0.f; \
            _Pragma("unroll") for (int j = 0; j < 4; ++j) { v[j] = v[j] - mean; s2 += (v[j].x * v[j].x + v[j].y * v[j].y) + (v[j].z * v[j].z + v[j].w * v[j].w); } \
            const float rstd = 1.0f / sqrtf(wave_sum(s2) * (1.0f / D) + LN_EPS); \
            _Pragma("unroll") for (int j = 0; j < 4; ++j) { const int c = 4 * lane + 256 * j; \
                const f32x4 xn = v[j] * rstd * *(const LAS f32x4*)(VT + 3072 + c) + *(const LAS f32x4*)(VT + 4096 + c); \
                if (fin) *(GAS f32x4*)(dstf + (size_t)tok * D + c) = xn; else *(GAS unsigned long long*)(dstb + (size_t)tok * D + c) = (unsigned long long)pk2(xn.x, xn.y) | ((unsigned long long)pk2(xn.z, xn.w) << 32); \
                if (l + 1 < DEPTH) { const f32x4 u = xn * (1.0f + *(const LAS f32x4*)(VT + 1024 + c)) + *(const LAS f32x4*)(VT + 2048 + c); \
                    R2_USTORE(u); } } } while (0)
#ifdef INPROJ_F8
#define R2_USTORE(u) *(GAS unsigned*)((unsigned char*)Uw + (size_t)tok * D + c) = pg8::pk4_fp8(u.x, u.y, u.z, u.w, 16.0f)
#else
#define R2_USTORE(u) *(GAS unsigned long long*)(Uw + (size_t)tok * D + c) = (unsigned long long)pk2(u.x, u.y) | ((unsigned long long)pk2(u.z, u.w) << 32)
#endif
        R2_ROWS(0, 0); R2_ROWS(1, 1); R2_ROWS(2, 2);
#pragma unroll 1
        for (int it4 = 0; it4 < 16; it4 += 4) { R2_BODY(0, it4); R2_BODY(1, it4 + 1); R2_BODY(2, it4 + 2); R2_BODY(3, it4 + 3); }
#undef R2_BODY
#undef R2_USTORE
#undef R2_ROWS
    }
    __syncthreads();
}
__global__ void __launch_bounds__(NWAVES * 64, 2) mega_fwd(Args A_) {
    extern __shared__ __attribute__((aligned(16))) unsigned char lds_raw[];
    LAS unsigned char* lds = (LAS unsigned char*)lds_raw;
    const int tid = threadIdx.x; const int wv0 = __builtin_amdgcn_readfirstlane(tid >> 6);
    volatile LAS unsigned* MISC = (volatile LAS unsigned*)(lds + MISC_OFF);
    for (int u = tid; u < (LDS_BYTES - TAB_OFF) / 4; u += NWAVES * 64) ((LAS unsigned*)(lds + TAB_OFF))[u] = 0u;
    __syncthreads();
    CArgs* A = kargs(); const bool multi = (A->s_hi - A->s_lo) > 1;
    if (multi) (void)xcd_barrier_post(WS(unsigned, WS_CTL) + CW_BAR + A->li * XCD_BAR_WORDS, MISC + 8);
    const int lo = A->s_lo, hi = A->s_hi;
#ifndef PHMASK
#define PHMASK 0xffffffffu
#endif
#define PHM(b) (((PHMASK) >> (b)) & 1u)
#ifndef RPTMASK
#define RPTMASK 0u
#endif
#define RPT(b) _Pragma("unroll 1") for (int rep_ = 0; rep_ < ((((RPTMASK) >> (b)) & 1u) ? 2 : 1); ++rep_)
#define RUN(s) (lo <= (s) && (s) < hi)
#ifdef BAR2
#define BAR2X(A_) xcd_barrier_fn((unsigned*)(A_->ws + WS_CTL) + CW_BAR + A_->li * XCD_BAR_WORDS, xb_xcc_id(), (volatile LAS unsigned*)(lds_launder(lds) + MISC_OFF) + 8, tid_of(wv0) == 0)
#else
#define BAR2X(A_) do {} while (0)
#endif
#define SEAM(s) do { if ((s) + 1 < hi) { CArgs* A_ = kargs(); xcd_barrier_fn((unsigned*)(A_->ws + WS_CTL) + CW_BAR + A_->li * XCD_BAR_WORDS, xb_xcc_id(), (volatile LAS unsigned*)(lds_launder(lds) + MISC_OFF) + 8, tid_of(wv0) == 0); BAR2X(A_); } } while (0)
    if (RUN(0)) { if (PHM(0)) RPT(0) pro_a(lds_launder(lds), wv0); SEAM(0); }
    if (RUN(1)) { if (PHM(1)) RPT(1) pro_b(wv0); SEAM(1); }
    for (int l = 0; l < DEPTH; ++l) {
        const int sb = 2 + NPH * l;
        if (RUN(sb + PH_IN)) { CArgs* A = kargs();
#ifdef INPROJ_F8
            pg8::Gemm g{WS(bf16, WS_U), (const bf16*)(WS(unsigned char, WS_WIN) + (size_t)l * NHC * D), T, NHC, D / 2}; pg8::StaticOrder S; S.init(T, NHC, gsz_(), bid_());
            pg8::EpiIn E{WS(bf16, WS_H), WS(unsigned, WS_CS16), 1.0f / 4096.0f};
            if (PHM(2)) RPT(2) pg8::gemm_phase<pg8::EpiIn, pg8::StaticOrder, true, true, pg8::DirectA, true>(lds_launder(lds), wv0, g, S, E, pg8::DirectA(), 0, 0);
#else
            pg8::Gemm g{WS(bf16, WS_U), WS(bf16, WS_WIN) + (size_t)l * NHC * D, T, NHC, D}; pg8::StaticOrder S; S.init(T, NHC, gsz_(), bid_());
            pg8::EpiIn E{WS(bf16, WS_H), WS(unsigned, WS_CS16), 1.0f};
            if ((RPTMASK >> 22) & 1u) pg8::gemm_phase<pg8::EpiNull, pg8::StaticOrder, true, true>(lds_launder(lds), wv0, g, S, pg8::EpiNull());
            if (PHM(2)) RPT(2) pg8::gemm_phase<pg8::EpiIn, pg8::StaticOrder, true, true>(lds_launder(lds), wv0, g, S, E);
#endif
            SEAM(sb + PH_IN);
        }
        if (RUN(sb + PH_POST)) { if (PHM(3)) RPT(3) ph_post(l, wv0); SEAM(sb + PH_POST); }
        if (RUN(sb + PH_MIXA)) { if (PHM(4)) RPT(4) ph_idx_scores(lds_launder(lds), wv0); if (PHM(5)) RPT(16) ph_mlstm_m1(lds_launder(lds), l, wv0); if (PHM(6)) RPT(6) ph_diff_attn(lds_launder(lds), wv0); SEAM(sb + PH_MIXA); }
        if (RUN(sb + PH_SEL)) { if (PHM(5)) RPT(17) ph_mlstm_m2(wv0);  SEAM(sb + PH_SEL); }
        if (RUN(sb + PH_DSA)) { if (PHM(5)) RPT(18) ph_mlstm_m3(lds_launder(lds), l, wv0); if (PHM(8)) RPT(8) { ph_diff_post(l, wv0); ph_dsa_attn(lds_launder(lds), wv0); } SEAM(sb + PH_DSA); }
        if (RUN(sb + PH_OUT)) { CArgs* A = kargs();
            pg8::Gemm g{WS(bf16, WS_MIX), WS(bf16, WS_WOUT) + (size_t)l * D * D, T, D, D}; pg8::StaticOrder S; S.init(T, D, gsz_(), bid_());
            pg8::EpiBf16<0> E{WS(bf16, WS_Y), D, nullptr, 0, 0, 1.f};
            if ((RPTMASK >> 23) & 1u) pg8::gemm_phase<pg8::EpiNull, pg8::StaticOrder, true, true>(lds_launder(lds), wv0, g, S, pg8::EpiNull());
            if (PHM(9)) RPT(9) pg8::gemm_phase<pg8::EpiBf16<0>, pg8::StaticOrder, true, true>(lds_launder(lds), wv0, g, S, E);
            SEAM(sb + PH_OUT);
        }
        if (RUN(sb + PH_ROW1)) { if (PHM(10)) { if ((RPTMASK >> 10) & 1u) ph_row1(lds_launder(lds), l, wv0, true); ph_row1(lds_launder(lds), l, wv0); } SEAM(sb + PH_ROW1); }
        if (RUN(sb + PH_G1)) { CArgs* A = kargs();
            const int nrt = moe_tables(lds_launder(lds), l, wv0);
            pg8::Gemm g{WS(bf16, WS_U), (const bf16*)(WS(unsigned char, WS_W1) + (size_t)l * NEXP * 2048 * D), RPAD, NEXP * 2048, D / 2}; pg8::MoeOrder S; S.init(nrt, 8, gsz_(), bid_(), (const LAS unsigned char*)(lds_launder(lds) + TAB_OFF + 256));
            pg8::EpiSwiGLU<true> E{WS(bf16, WS_HM), A->in[I_B1] + (size_t)l * NEXP * 2048, 1.0f / 4096.0f, lds_launder(lds) + TAB_OFF + 2048};
            LAS unsigned char* tb = lds_launder(lds) + TAB_OFF;
            pg8::MoeGatherA AM{WS(unsigned, WS_XG), (const LAS unsigned*)tb, (const LAS unsigned*)(tb + 1024), (const LAS unsigned char*)(tb + 256), T, (LAS unsigned*)(tb + 4096)};
            if ((RPTMASK >> 20) & 1u) pg8::gemm_phase<pg8::EpiNull, pg8::MoeOrder, true, true, pg8::MoeGatherA, true>(lds_launder(lds), wv0, g, S, pg8::EpiNull(), AM, 0, 0);
            if ((RPTMASK >> 24) & 1u) pg8::gemm_phase<pg8::EpiSwiGLU<true>, pg8::MoeOrder, true, true, pg8::MoeGatherA, true>(lds_launder(lds), wv0, g, S, E, AM, 0, 0);
            if (PHM(12)) RPT(12) pg8::gemm_phase<pg8::EpiSwiGLU<true>, pg8::MoeOrder, true, true, pg8::MoeGatherA, true>(lds_launder(lds), wv0, g, S, E, AM, 0, 0);
            SEAM(sb + PH_G1);
        }
        if (RUN(sb + PH_G2)) { CArgs* A = kargs();
            const int nrt = moe_tables(lds_launder(lds), l, wv0);
            pg8::Gemm g{WS(bf16, WS_HM), (const bf16*)(WS(unsigned char, WS_W2) + (size_t)l * NEXP * D * D), RPAD, NEXP * D, D / 2}; pg8::MoeOrder S; S.init(nrt, 4, gsz_(), bid_(), (const LAS unsigned char*)(lds_launder(lds) + TAB_OFF + 256));
            pg8::EpiMoeOut E{WS(bf16, WS_YM), 1.0f / 2048.0f};
            if ((RPTMASK >> 21) & 1u) pg8::gemm_phase<pg8::EpiNull, pg8::MoeOrder, true, true, pg8::DirectA, true>(lds_launder(lds), wv0, g, S, pg8::EpiNull(), pg8::DirectA(), 0, 0);
            if ((RPTMASK >> 25) & 1u) pg8::gemm_phase<pg8::EpiMoeOut, pg8::MoeOrder, true, true, pg8::DirectA, true>(lds_launder(lds), wv0, g, S, E, pg8::DirectA(), 0, 0);
            if (PHM(13)) RPT(13) pg8::gemm_phase<pg8::EpiMoeOut, pg8::MoeOrder, true, true, pg8::DirectA, true>(lds_launder(lds), wv0, g, S, E, pg8::DirectA(), 0, 0);
            SEAM(sb + PH_G2);
        }
        if (RUN(sb + PH_ROW2)) { if (PHM(14)) { if ((RPTMASK >> 14) & 1u) ph_row2(lds_launder(lds), l, wv0, true); ph_row2(lds_launder(lds), l, wv0); } SEAM(sb + PH_ROW2); }
    }
#undef RUN
#undef SEAM
}

#ifndef MK_STEPS_PER_LAUNCH
#define MK_STEPS_PER_LAUNCH 1000
#endif
extern "C" void kernel_launch(void* const* d_in, const int* in_sizes, int n_in, void* d_out, int out_size, void* d_ws, size_t ws_size, hipStream_t stream) {
    static int grid = 0;
    if (grid == 0) {
        if (n_in != 25 || out_size != T * D || ws_size < WS_END4) { fprintf(stderr, "kernel_launch: unexpected shapes (n_in %d out %d ws %zu)\n", n_in, out_size, ws_size); grid = -1; return; }
        int dev = 0, cus = 0, per_cu = 0;
        if (hipGetDevice(&dev) != hipSuccess || hipDeviceGetAttribute(&cus, hipDeviceAttributeMultiprocessorCount, dev) != hipSuccess) { grid = -1; return; }
        if (hipFuncSetAttribute((const void*)mega_fwd, hipFuncAttributeMaxDynamicSharedMemorySize, LDS_BYTES) != hipSuccess) { fprintf(stderr, "kernel_launch: hipFuncSetAttribute failed\n"); grid = -1; return; }
        if (hipOccupancyMaxActiveBlocksPerMultiprocessor(&per_cu, (const void*)mega_fwd, NWAVES * 64, LDS_BYTES) != hipSuccess || per_cu < 1) { fprintf(stderr, "kernel_launch: occupancy query says %d\n", per_cu); }
        (void)hipGetLastError();
        grid = cus;
    }
    if (grid < 0) return;
    if (hipMemsetAsync((char*)d_ws + WS_CTL, 0, CTL_ZERO_BYTES, stream) != hipSuccess) return;
    Args a{};
    for (int i = 0; i < 25; ++i) a.in[i] = (const float*)d_in[i];
    a.out = (float*)d_out; a.ws = (unsigned char*)d_ws;
    int li = 0;
    for (int s = 0; s < NSTEPS; s += MK_STEPS_PER_LAUNCH, ++li) {
        a.s_lo = s; a.s_hi = (s + MK_STEPS_PER_LAUNCH < NSTEPS) ? s + MK_STEPS_PER_LAUNCH : NSTEPS; a.li = li; a.pad = 0;
        hipLaunchKernelGGL(mega_fwd, dim3(grid), dim3(NWAVES * 64), LDS_BYTES, stream, a);
    }
}
```

```cpp
#define INPROJ_F8 1
#include <hip/hip_runtime.h>
#include <cstdio>
#include <cstdint>

__device__ __forceinline__ int lane_id_() { int l_; asm volatile("v_mbcnt_lo_u32_b32 %0, -1, 0\n\tv_mbcnt_hi_u32_b32 %0, -1, %0" : "=&v"(l_)); return l_; }
namespace pg8 {
#define PG8_LAS __attribute__((address_space(3)))
typedef unsigned short bf16_t;
typedef short bf16x8 __attribute__((ext_vector_type(8)));
typedef float f32x4 __attribute__((ext_vector_type(4)));
typedef unsigned u32x4 __attribute__((ext_vector_type(4)));
constexpr int BM = 256, BK = 64, HALF = 128, HTB = HALF * BK * 2  , STAGE_BYTES = 8 * HTB, NXCD = 8, WGM = 8;

__host__ __device__ __forceinline__ int lds_byte(int r, int c) { const int st = (r >> 4) * 2 + (c >> 5), rr = r & 15, cc = c & 31, ob = rr * 64 + cc * 2; return st * 1024 + (ob ^ (((ob >> 9) & 1) << 5)); }
__host__ __device__ __forceinline__ void stage_rc(int b, int& R, int& C) { const int st = b / 1024, sb = b % 1024, swz = sb ^ (((sb >> 9) & 1) << 5); R = (st >> 1) * 16 + swz / 64; C = (st & 1) * 32 + (swz % 64) / 2; }
__host__ __device__ __forceinline__ int perm32(int rho) { const int n = rho >> 4, i = rho & 15; return 8 * (i >> 2) + 4 * n + (i & 3); }

struct Unit { int pm, pn; };
struct Gemm { const bf16_t* A; const bf16_t* Bt; int M, N, K; };

struct StaticOrder {
    int nM, nN, nwg, G, c;
    __host__ __device__ void init(int M, int N, int G_, int c_) { nM = M / BM; nN = N / BM; nwg = nM * nN; G = G_; c = c_; }
    __host__ __device__ bool next(int i, Unit& u) const {
        const long L = (long)i * G + c; if (L >= nwg) return false;
        int wgid = (int)L; { const int q = nwg / NXCD, r = nwg % NXCD, xcd = wgid % NXCD, off = wgid / NXCD; wgid = (xcd < r ? xcd * (q + 1) : r * (q + 1) + (xcd - r) * q) + off; }
        const int nig = WGM * nN, gid = wgid / nig, fm = gid * WGM, gsz = (nM - fm) < WGM ? (nM - fm) : WGM;
        u.pm = fm + ((wgid % nig) % gsz); u.pn = (wgid % nig) / gsz; return true;
    }
    __device__ __forceinline__ void a_ready(const Unit&) const {}
    __device__ __forceinline__ void done(const Unit&) const {}
};
struct MoeOrder {
    int nM, nN, nwg, G, c; const PG8_LAS unsigned char* tile_e;
    __device__ void init(int nRT, int NTN, int G_, int c_, const PG8_LAS unsigned char* te) { nM = nRT; nN = NTN; nwg = nM * nN; G = G_; c = c_; tile_e = te; }
    __device__ bool next(int i, Unit& u) const {
        const long L = (long)i * G + c; if (L >= nwg) return false;
        int wgid = (int)L; { const int q = nwg / NXCD, r = nwg % NXCD, xcd = wgid % NXCD, off = wgid / NXCD; wgid = (xcd < r ? xcd * (q + 1) : r * (q + 1) + (xcd - r) * q) + off; }
        const int nig = WGM * nN, gid = wgid / nig, fm = gid * WGM, gsz = (nM - fm) < WGM ? (nM - fm) : WGM;
        u.pm = fm + ((wgid % nig) % gsz); const int pl = (wgid % nig) / gsz; u.pn = (int)tile_e[u.pm] * nN + pl; return true;
    }
    __device__ __forceinline__ void a_ready(const Unit&) const {}
    __device__ __forceinline__ void done(const Unit&) const {}
};
struct MoeGatherA {
    static constexpr bool GATHER = true;
    const unsigned* rowmap; const PG8_LAS unsigned* base; const PG8_LAS unsigned* cnt; const PG8_LAS unsigned char* tile_e; int ntok; PG8_LAS unsigned* slot;
    __device__ __forceinline__ const unsigned* tokptr(const Unit& u, int h, int rA) const {
        const int e = tile_e[u.pm]; const unsigned pos = (unsigned)u.pm * 256u - base[e] + 128u * h + (unsigned)rA;
        return rowmap + (size_t)e * ntok + (pos < cnt[e] ? pos : 0u);
    }
    __device__ __forceinline__ unsigned off(const Unit& u, int h, int rA, int cA, int K) const { return (*tokptr(u, h, rA) * (unsigned)K + (unsigned)cA) * 2u; }
};
__device__ __forceinline__ unsigned cvt_pk_bf16(float lo, float hi) { unsigned r; asm volatile("v_cvt_pk_bf16_f32 %0, %1, %2" : "=v"(r) : "v"(lo), "v"(hi)); return r; }
typedef float f32x2 __attribute__((ext_vector_type(2)));
__device__ __forceinline__ f32x2 gelu_pk(f32x2 v) {
    const f32x2 av = __builtin_elementwise_abs(v), d = av * 0.2316418882f + 1.0f;
    f32x2 t; t.x = __builtin_amdgcn_rcpf(d.x); t.y = __builtin_amdgcn_rcpf(d.y);
    f32x2 q = t * 0.5307027145f + (-0.7265760135f); q = q * t + 0.7107068705f; q = q * t + (-0.142248368f); q = q * t + 0.127414796f; q = q * t;
    const f32x2 s = (v * v) * (-0.72134752044f);
    f32x2 e; e.x = __builtin_amdgcn_exp2f(s.x); e.y = __builtin_amdgcn_exp2f(s.y);
    const f32x2 m = v * (q * e), r = v - m;
    f32x2 o; o.x = v.x < 0.f ? m.x : r.x; o.y = v.y < 0.f ? m.y : r.y; return o;
}

template <int ACT  > struct EpiBf16 {
    static constexpr bool PERM = true, AFTER_DRAIN = false, PREFETCH = false; static constexpr int NST = 16; static_assert(ACT == 0 || ACT == 1, "EpiBf16: ACT is 0 (none) or 1 (gelu_pk)");
    bf16_t* O; int ldc; const float* bias; int split_cols; size_t split_stride; float scale0;
    __device__ __forceinline__ void operator()(const f32x4 (&acc)[2][2][4][2], const Unit& u, int wr, int wc, int fr, int fq) const {
        const int row0 = u.pm * BM + wr * 64 + fr; int colt = u.pn * BM; bf16_t* base = O;
        float sc = 1.f; if (split_cols) { const int t = colt / split_cols; base += (size_t)t * split_stride; colt -= t * split_cols; if (t == 0) sc = scale0; }
        const int col0 = colt + wc * 32 + 8 * fq, bcol0 = u.pn * BM + wc * 32 + 8 * fq;
        f32x4 bv[2][2];
#pragma unroll
        for (int bj = 0; bj < 2; ++bj)
#pragma unroll
            for (int n = 0; n < 2; ++n) bv[bj][n] = bias ? *(const f32x4*)(bias + bcol0 + bj * HALF + 4 * n) : (f32x4){0.f, 0.f, 0.f, 0.f};
#pragma unroll
        for (int ai = 0; ai < 2; ++ai)
#pragma unroll
            for (int m = 0; m < 4; ++m) { bf16_t* rowp = base + (size_t)(row0 + ai * HALF + m * 16) * ldc + col0;
#pragma unroll
                for (int bj = 0; bj < 2; ++bj) { f32x4 v0 = acc[ai][bj][m][0] + bv[bj][0], v1 = acc[ai][bj][m][1] + bv[bj][1];
                    if (ACT == 1) { f32x2 a = gelu_pk((f32x2){v0[0], v0[1]}), b = gelu_pk((f32x2){v0[2], v0[3]}), c = gelu_pk((f32x2){v1[0], v1[1]}), d = gelu_pk((f32x2){v1[2], v1[3]});
                        v0 = (f32x4){a.x, a.y, b.x, b.y}; v1 = (f32x4){c.x, c.y, d.x, d.y}; }
                    v0 = v0 * sc; v1 = v1 * sc; u32x4 w; w.x = cvt_pk_bf16(v0[0], v0[1]); w.y = cvt_pk_bf16(v0[2], v0[3]); w.z = cvt_pk_bf16(v1[0], v1[1]); w.w = cvt_pk_bf16(v1[2], v1[3]);
                    *(u32x4*)(rowp + bj * HALF) = w; } }
    }
};
constexpr float C2 = 0.125f * 1.4426950408889634f;
struct EpiIn {
    static constexpr bool PERM = true, AFTER_DRAIN = false, PREFETCH = false; static constexpr int NST = 16;
    bf16_t* O; const unsigned* cs; float asc;
    static __device__ __forceinline__ float h_lo(unsigned w) { return (float)__builtin_bit_cast(_Float16, (unsigned short)(w & 0xffffu)); }
    static __device__ __forceinline__ float h_hi(unsigned w) { return (float)__builtin_bit_cast(_Float16, (unsigned short)(w >> 16)); }
    __device__ __forceinline__ void operator()(const f32x4 (&acc)[2][2][4][2], const Unit& u, int wr, int wc, int fr, int fq) const {
        const int pn = u.pn;
        const bool rope = (0x6CF0 >> pn) & 1;
        const float sc = (((0x0430 >> pn) & 1) ? C2 : 1.f) * asc;
        const int row0 = u.pm * BM + wr * 64 + fr, col0 = pn * BM + wc * 32 + 8 * fq, i0 = (wc & 1) * 16 + 4 * fq;
        u32x4 cw[2][4];
#pragma unroll
        for (int ai = 0; ai < 2; ++ai)
#pragma unroll
            for (int m = 0; m < 4; ++m) cw[ai][m] = (u32x4){0x3C00u, 0x3C00u, 0x3C00u, 0x3C00u};
        if (rope) {
#pragma unroll
            for (int ai = 0; ai < 2; ++ai)
#pragma unroll
                for (int m = 0; m < 4; ++m) cw[ai][m] = *(const u32x4*)(cs + (size_t)(row0 + ai * HALF + m * 16) * 32 + i0);
        }
#pragma unroll
        for (int ai = 0; ai < 2; ++ai) {
#pragma unroll
            for (int m = 0; m < 4; ++m) {
                const int row = row0 + ai * HALF + m * 16;
                const u32x4 cq = cw[ai][m];
                const f32x4 ca = (f32x4){h_lo(cq.x), h_hi(cq.x), h_lo(cq.y), h_hi(cq.y)} * sc, cb = (f32x4){h_lo(cq.z), h_hi(cq.z), h_lo(cq.w), h_hi(cq.w)} * sc;
                bf16_t* rowp = O + (size_t)row * 4096 + col0;
#pragma unroll
                for (int bj = 0; bj < 2; ++bj) {
                    const f32x4 v0 = acc[ai][bj][m][0], v1 = acc[ai][bj][m][1];
                    f32x4 r0, r1;
                    r0[0] = v0[0] * ca[0] - v0[1] * ca[1]; r0[1] = v0[1] * ca[0] + v0[0] * ca[1];
                    r0[2] = v0[2] * ca[2] - v0[3] * ca[3]; r0[3] = v0[3] * ca[2] + v0[2] * ca[3];
                    r1[0] = v1[0] * cb[0] - v1[1] * cb[1]; r1[1] = v1[1] * cb[0] + v1[0] * cb[1];
                    r1[2] = v1[2] * cb[2] - v1[3] * cb[3]; r1[3] = v1[3] * cb[2] + v1[2] * cb[3];
                    u32x4 w; w.x = cvt_pk_bf16(r0[0], r0[1]); w.y = cvt_pk_bf16(r0[2], r0[3]); w.z = cvt_pk_bf16(r1[0], r1[1]); w.w = cvt_pk_bf16(r1[2], r1[3]);
                    *(u32x4*)(rowp + bj * HALF) = w;
                }
            }
            asm volatile("" ::: "memory");
        }
    }
};
__device__ __forceinline__ unsigned pk4_fp8(float a, float b, float c, float d, float sc) {
    a = fminf(fmaxf(a * sc, -448.f), 448.f); b = fminf(fmaxf(b * sc, -448.f), 448.f); c = fminf(fmaxf(c * sc, -448.f), 448.f); d = fminf(fmaxf(d * sc, -448.f), 448.f);
    int w = __builtin_amdgcn_cvt_pk_fp8_f32(a, b, 0, false); w = __builtin_amdgcn_cvt_pk_fp8_f32(c, d, w, true); return (unsigned)w; }
__device__ __forceinline__ unsigned pk4_fp8_raw(float a, float b, float c, float d) { int w = __builtin_amdgcn_cvt_pk_fp8_f32(a, b, 0, false); w = __builtin_amdgcn_cvt_pk_fp8_f32(c, d, w, true); return (unsigned)w; }
template <bool F8OUT> struct EpiSwiGLU {
    static constexpr bool PERM = true, AFTER_DRAIN = false, PREFETCH = true; static constexpr int NST = 8;
    bf16_t* O; const float* b1; float asc; PG8_LAS unsigned char* side;
    __device__ __forceinline__ void prefetch(const Unit& u, int slot, int wid, int lane) const {
        if (wid == 0) { const int ln = lane_id_(); const int e = u.pn >> 3, pl = u.pn & 7; const float* ub = b1 + (size_t)e * 2048 + pl * 128; asm("" : "+s"(ub)); const float* src = ub + ((ln & 32) ? 1024 : 0) + (ln & 31) * 4;
            __builtin_amdgcn_global_load_lds((const unsigned*)src, (PG8_LAS unsigned*)(side + slot * 1024), 16, 0, 0); } }
    __device__ __forceinline__ void operator()(const f32x4 (&acc)[2][2][4][2], const Unit& u, int wr, int wc, int fr, int fq, int slot) const {
        constexpr float OS = F8OUT ? 8.0f : 1.0f;
        const int pl = u.pn & 7, colh = pl * 128 + wc * 32 + 8 * fq;
        const PG8_LAS float* bp = (const PG8_LAS float*)(side + slot * 1024) + wc * 32 + 8 * fq;
        f32x4 bg[2], bu[2];
#pragma unroll
        for (int n = 0; n < 2; ++n) { bg[n] = *(const PG8_LAS f32x4*)(bp + 4 * n); bu[n] = *(const PG8_LAS f32x4*)(bp + 128 + 4 * n) * OS + OS; }
        const float ascu = asc * OS;
        const int row0 = u.pm * BM + wr * 64 + fr;
#pragma unroll
        for (int ai = 0; ai < 2; ++ai)
#pragma unroll
            for (int m = 0; m < 4; ++m) {
                f32x4 o[2];
#pragma unroll
                for (int n = 0; n < 2; ++n) {
                    const f32x4 g4 = acc[ai][0][m][n] * asc + bg[n], u4 = acc[ai][1][m][n] * ascu + bu[n];
#pragma unroll
                    for (int c = 0; c < 4; ++c) {
                        const float g = fminf(g4[c], 7.0f), up1 = fminf(fmaxf(u4[c], -6.0f * OS), 8.0f * OS);
                        const float sg = __builtin_amdgcn_rcpf(1.0f + __builtin_amdgcn_exp2f(-1.702f * 1.4426950408889634f * g));
                        o[n][c] = up1 * (g * sg);
                    }
                }
                if constexpr (F8OUT) { typedef unsigned u32x2_ __attribute__((ext_vector_type(2))); u32x2_ w; w.x = pk4_fp8_raw(o[0][0], o[0][1], o[0][2], o[0][3]); w.y = pk4_fp8_raw(o[1][0], o[1][1], o[1][2], o[1][3]);
                    *(u32x2_*)((unsigned char*)O + (size_t)(row0 + ai * HALF + m * 16) * 1024 + colh) = w; }
                else { u32x4 w; w.x = cvt_pk_bf16(o[0][0], o[0][1]); w.y = cvt_pk_bf16(o[0][2], o[0][3]); w.z = cvt_pk_bf16(o[1][0], o[1][1]); w.w = cvt_pk_bf16(o[1][2], o[1][3]);
                    *(u32x4*)(O + (size_t)(row0 + ai * HALF + m * 16) * 1024 + colh) = w; }
            }
    }
};
struct EpiMoeOut {
    static constexpr bool PERM = true, AFTER_DRAIN = false, PREFETCH = false; static constexpr int NST = 8;
    bf16_t* O; float asc;
    __device__ __forceinline__ void operator()(const f32x4 (&acc)[2][2][4][2], const Unit& u, int wr, int wc, int fr, int fq) const {
        const int row0 = u.pm * BM + wr * 64 + fr, col0 = (u.pn & 3) * BM + wc * 64 + 16 * fq;
#pragma unroll
        for (int ai = 0; ai < 2; ++ai)
#pragma unroll
            for (int m = 0; m < 4; ++m) { unsigned char* rowp = (unsigned char*)O + (size_t)(row0 + ai * HALF + m * 16) * 1024 + col0;
                u32x4 w;
                { const f32x4 v0 = acc[ai][0][m][0], v1 = acc[ai][0][m][1]; w.x = pk4_fp8(v0[0], v0[1], v0[2], v0[3], 64.0f * asc); w.y = pk4_fp8(v1[0], v1[1], v1[2], v1[3], 64.0f * asc); }
                { const f32x4 v0 = acc[ai][1][m][0], v1 = acc[ai][1][m][1]; w.z = pk4_fp8(v0[0], v0[1], v0[2], v0[3], 64.0f * asc); w.w = pk4_fp8(v1[0], v1[1], v1[2], v1[3], 64.0f * asc); }
                *(u32x4*)rowp = w; }
    }
};

struct EpiNull { static constexpr bool PERM = true, AFTER_DRAIN = false, PREFETCH = false;
    __device__ __forceinline__ void operator()(const f32x4 (&acc)[2][2][4][2], const Unit& u, int wr, int wc, int fr, int fq) const {
#pragma unroll
        for (int a = 0; a < 2; ++a)
#pragma unroll
            for (int b = 0; b < 2; ++b)
#pragma unroll
                for (int m = 0; m < 4; ++m)
#pragma unroll
                    for (int n = 0; n < 2; ++n) asm volatile("" :: "v"(acc[a][b][m][n]));
    } };
struct DirectA { static constexpr bool GATHER = false; __device__ __forceinline__ unsigned off(const Unit&, int, int, int, int) const { return 0u; } };
typedef int v8i32 __attribute__((ext_vector_type(8)));
template <class E, class = void> struct epi_nst { static constexpr int v = 0; };
template <class E> struct epi_nst<E, decltype((void)E::NST)> { static constexpr int v = E::NST; };
template <class Epi, class Sched, bool ALIGN_EPI = false, bool SP2 = false, class AMap = DirectA, bool F8 = false>
__device__ __forceinline__ void gemm_phase(PG8_LAS unsigned char* lds, int wvx, const Gemm g, const Sched& S, const Epi& E, const AMap& AM = AMap(), int scA = 0x7f7f7f7f, int scB = 0x7f7f7f7f) {
    int tid_ = wvx * 64 + lane_id_(); asm volatile("" : "+v"(tid_));
    const int tid = tid_, wid = __builtin_amdgcn_readfirstlane(tid >> 6), lane = tid & 63, wr = wid >> 2, wc = wid & 3, fr = lane & 15, fq = lane >> 4;
    const int K = g.K, nt = K / BK;
    unsigned voffB[2], vA[2];
#pragma unroll
    for (int i = 0; i < 2; ++i) { int R, C; stage_rc(tid * 16 + i * 8192, R, C); const int Rb = Epi::PERM ? ((R & ~31) + perm32(R & 31)) : R;
        vA[i] = (unsigned)(R * K + C) * 2u; voffB[i] = (unsigned)(Rb * K + C) * 2u; }
    const size_t kstep = (size_t)(BK * 2);
    const size_t hstep = (size_t)HALF * K * 2;
    const size_t tstep = 2 * hstep;
    const unsigned ldsw = (unsigned)wid * 1024u;
    const int aoff = lds_byte(wr * 64 + fr, fq * 8), boff = lds_byte(wc * 32 + fr, fq * 8);
#define PG8_SA(b, h) (((b) * 2 + (h)) * HTB)
#define PG8_SB(b, h) ((4 + (b) * 2 + (h)) * HTB)
#define PG8_STAGEA(bufoff, kb, h, nx) do { size_t ubx_ = (size_t)(kb); unsigned lo_[2]; \
        if constexpr (AMap::GATHER) { _Pragma("unroll") for (int _i = 0; _i < 2; ++_i) lo_[_i] = (nx) ? oN[h][_i] : oC[h][_i]; } \
        else { ubx_ += (nx) ? uN[h] : uC[h]; _Pragma("unroll") for (int _i = 0; _i < 2; ++_i) lo_[_i] = vA[_i]; } \
        const char* ub_ = Abase + ubx_; asm("" : "+s"(ub_)); _Pragma("unroll") for (int _i = 0; _i < 2; ++_i) asm("" : "+v"(lo_[_i]));     \
        _Pragma("unroll") for (int _i = 0; _i < 2; ++_i) \
        __builtin_amdgcn_global_load_lds((const unsigned*)(ub_ + lo_[_i]), (PG8_LAS unsigned*)(lds + (bufoff) + ldsw + _i * 8192), 16, 0, 0); } while (0)
#define PG8_AOFF(dstL, dstU, u) do { if constexpr (AMap::GATHER) { int t2_ = wvx * 64 + lane_id_(); asm volatile("" : "+v"(t2_)); _Pragma("unroll") for (int _i = 0; _i < 2; ++_i) { int R_, C_; stage_rc(t2_ * 16 + _i * 8192, R_, C_); \
            _Pragma("unroll") for (int _h = 0; _h < 2; ++_h) dstL[_h][_i] = AM.off(u, _h, R_, C_, K); } } \
        else { _Pragma("unroll") for (int _h = 0; _h < 2; ++_h) dstU[_h] = ((size_t)(u).pm * BM + 128 * _h) * (size_t)K * 2; } } while (0)
#define PG8_TOKDMA(u) do { int t2_ = wvx * 64 + lane_id_(); asm volatile("" : "+v"(t2_)); _Pragma("unroll") for (int _i = 0; _i < 2; ++_i) { int R_, C_; stage_rc(t2_ * 16 + _i * 8192, R_, C_); \
            _Pragma("unroll") for (int _h = 0; _h < 2; ++_h) __builtin_amdgcn_global_load_lds(AM.tokptr(u, _h, R_), AM.slot + wvx * 256 + (_h * 2 + _i) * 64, 4, 0, 0); } } while (0)
#define PG8_TOKOFF(dstL) do { int t2_ = wvx * 64 + lane_id_(); asm volatile("" : "+v"(t2_)); _Pragma("unroll") for (int _i = 0; _i < 2; ++_i) { int R_, C_; stage_rc(t2_ * 16 + _i * 8192, R_, C_); \
            _Pragma("unroll") for (int _h = 0; _h < 2; ++_h) dstL[_h][_i] = (AM.slot[wvx * 256 + (_h * 2 + _i) * 64 + (t2_ & 63)] * (unsigned)K + (unsigned)C_) * 2u; } } while (0)
#define PG8_STAGE(bufoff, gbase, voff) do { const char* ub_ = (const char*)(gbase); asm("" : "+s"(ub_)); _Pragma("unroll") for (int _i = 0; _i < 2; ++_i) \
        __builtin_amdgcn_global_load_lds((const unsigned*)(ub_ + (voff)[_i]), (PG8_LAS unsigned*)(lds + (bufoff) + ldsw + _i * 8192), 16, 0, 0); } while (0)
#define PG8_LDA(dst, b, h) do { _Pragma("unroll") for (int m = 0; m < 4; ++m) _Pragma("unroll") for (int k = 0; k < 2; ++k) dst[m][k] = *(const PG8_LAS bf16x8*)(lds + PG8_SA(b, h) + aoff + m * 2048 + k * 1024); } while (0)
#define PG8_LDB(dst, b, h) do { _Pragma("unroll") for (int n = 0; n < 2; ++n) _Pragma("unroll") for (int k = 0; k < 2; ++k) dst[n][k] = *(const PG8_LAS bf16x8*)(lds + PG8_SB(b, h) + boff + n * 2048 + k * 1024); } while (0)
#define PG8_CAT(x) __builtin_bit_cast(v8i32, __builtin_shufflevector(x[0], x[1], 0, 1, 2, 3, 4, 5, 6, 7, 8, 9, 10, 11, 12, 13, 14, 15))
#define PG8_MMA(ai, bj, At, Bt) do { __builtin_amdgcn_s_setprio(1); _Pragma("unroll") for (int m = 0; m < 4; ++m) _Pragma("unroll") for (int n = 0; n < 2; ++n) { \
        if constexpr (F8) acc[ai][bj][m][n] = __builtin_amdgcn_mfma_scale_f32_16x16x128_f8f6f4(PG8_CAT(Bt[n]), PG8_CAT(At[m]), acc[ai][bj][m][n], 0, 0, 0, scB, 0, scA); \
        else { _Pragma("unroll") for (int k = 0; k < 2; ++k) acc[ai][bj][m][n] = __builtin_amdgcn_mfma_f32_16x16x32_bf16(Bt[n][k], At[m][k], acc[ai][bj][m][n], 0, 0, 0); } } __builtin_amdgcn_s_setprio(0); } while (0)
#define PG8_WAIT_V(n) asm volatile("s_waitcnt vmcnt(" #n ")" ::: "memory")
#define PG8_WAIT_VR(n) do { if (rlx) asm volatile("s_waitcnt vmcnt(%0)" :: "n"((n) + epi_nst<Epi>::v) : "memory"); else PG8_WAIT_V(n); } while (0)
#define PG8_WAIT_L(n) asm volatile("s_waitcnt lgkmcnt(" #n ")" ::: "memory")
#define PG8_BAR __builtin_amdgcn_s_barrier()
#define PG8_SCHED __builtin_amdgcn_sched_barrier(0)
    Unit cur, nxt; int ui = 0;
    if (!S.next(0, cur)) return;
    f32x4 acc[2][2][4][2];
#pragma unroll
    for (int a = 0; a < 2; ++a)
#pragma unroll
        for (int b = 0; b < 2; ++b)
#pragma unroll
            for (int m = 0; m < 4; ++m)
#pragma unroll
                for (int n = 0; n < 2; ++n) acc[a][b][m][n] = (f32x4){0.f, 0.f, 0.f, 0.f};
    bf16x8 At[4][2], B0[2][2], B1[2][2];
    const char* Abase = (const char*)g.A; const char* cB = (const char*)g.Bt + (size_t)cur.pn * tstep;
    unsigned oC[2][2], oN[2][2]; size_t uC[2] = {0, 0}, uN[2] = {0, 0}; PG8_AOFF(oC, uC, cur); if constexpr (AMap::GATHER) { _Pragma("unroll") for (int _h = 0; _h < 2; ++_h) { oN[_h][0] = oC[_h][0]; oN[_h][1] = oC[_h][1]; } }
    if constexpr (AMap::GATHER) { Unit n1_; if (S.next(1, n1_)) PG8_TOKDMA(n1_); }
    S.a_ready(cur);
    if constexpr (Epi::PREFETCH) E.prefetch(cur, 0, wid, lane);
    if constexpr (SP2) {
        PG8_STAGE(PG8_SB(0, 0), cB, voffB); PG8_STAGE(PG8_SB(0, 1), cB + hstep, voffB); PG8_STAGEA(PG8_SA(0, 0), 0, 0, false); PG8_STAGEA(PG8_SA(0, 1), 0, 1, false);
        if (wr == 1) PG8_BAR;
        PG8_WAIT_V(2); PG8_BAR;
        PG8_STAGE(PG8_SB(1, 0), cB + kstep, voffB); PG8_STAGEA(PG8_SA(1, 0), kstep, 0, false); PG8_STAGE(PG8_SB(1, 1), cB + hstep + kstep, voffB);
        PG8_WAIT_V(6); PG8_BAR;
    } else {
        PG8_STAGE(PG8_SB(0, 0), cB, voffB); PG8_STAGEA(PG8_SA(0, 0), 0, 0, false); PG8_STAGE(PG8_SB(0, 1), cB + hstep, voffB); PG8_STAGEA(PG8_SA(0, 1), 0, 1, false);
        if (wr == 1) PG8_BAR;
        PG8_WAIT_V(4); PG8_BAR;
        PG8_STAGE(PG8_SB(1, 0), cB + kstep, voffB); PG8_STAGEA(PG8_SA(1, 0), kstep, 0, false); PG8_STAGE(PG8_SB(1, 1), cB + hstep + kstep, voffB);
        PG8_WAIT_V(6); PG8_BAR;
    }
    for (;;) {
        const bool has_next = S.next(ui + 1, nxt);
        if constexpr (Epi::PREFETCH) { if (has_next) E.prefetch(nxt, (ui + 1) & 1, wid, lane); }
        const char* nB = has_next ? (const char*)g.Bt + (size_t)nxt.pn * tstep : cB;
        if constexpr (!AMap::GATHER) { if (has_next) { PG8_AOFF(oN, uN, nxt); } else {
#pragma unroll
            for (int _h = 0; _h < 2; ++_h) { uN[_h] = uC[_h]; } } }
#pragma unroll 1
        for (int t = 0; t < nt; t += 2) {
            const bool last = (t == nt - 2), rlx = SP2 && (t == 0) && (ui > 0);
            const size_t ka1 = (size_t)(t + 1) * kstep, ka2 = last ? (size_t)0 : (size_t)(t + 2) * kstep, ka3 = ka2 + kstep;
            const char* b2 = last ? nB : cB + (size_t)(t + 2) * kstep; const char* b3 = b2 + kstep;
            if (last && has_next) S.a_ready(nxt);
            if constexpr (AMap::GATHER) { if (last) { if (has_next) { PG8_TOKOFF(oN); } else {
#pragma unroll
                for (int _h = 0; _h < 2; ++_h) { oN[_h][0] = oC[_h][0]; oN[_h][1] = oC[_h][1]; } } } }
            if constexpr (SP2) {
            PG8_LDB(B0, 0, 0); PG8_LDB(B1, 0, 1); PG8_SCHED; PG8_LDA(At, 0, 0); if (!(ALIGN_EPI && rlx)) PG8_STAGEA(PG8_SA(1, 1), ka1, 1, false);
            PG8_WAIT_VR(8); PG8_WAIT_L(0); PG8_BAR; PG8_MMA(0, 0, At, B0); PG8_MMA(0, 1, At, B1); PG8_BAR; PG8_SCHED;
            PG8_LDA(At, 0, 1); PG8_STAGE(PG8_SB(0, 0), b2, voffB); PG8_STAGE(PG8_SB(0, 1), b2 + hstep, voffB); PG8_STAGEA(PG8_SA(0, 0), ka2, 0, last);
            PG8_WAIT_VR(8); PG8_WAIT_L(0); PG8_BAR; PG8_MMA(1, 0, At, B0); PG8_MMA(1, 1, At, B1); PG8_BAR; PG8_SCHED;
            PG8_LDB(B0, 1, 0); PG8_LDB(B1, 1, 1); PG8_SCHED; PG8_LDA(At, 1, 0); PG8_STAGEA(PG8_SA(0, 1), ka2, 1, last);
            if constexpr (ALIGN_EPI) PG8_WAIT_VR(8); else PG8_WAIT_V(8); PG8_WAIT_L(0); PG8_BAR; PG8_MMA(0, 0, At, B0); PG8_MMA(0, 1, At, B1); PG8_BAR; PG8_SCHED;
            PG8_LDA(At, 1, 1); PG8_STAGE(PG8_SB(1, 0), b3, voffB); PG8_STAGE(PG8_SB(1, 1), b3 + hstep, voffB); PG8_STAGEA(PG8_SA(1, 0), ka3, 0, last);
            PG8_WAIT_V(8); PG8_WAIT_L(0); PG8_BAR; PG8_MMA(1, 0, At, B0); PG8_MMA(1, 1, At, B1); PG8_BAR; PG8_SCHED;
            } else {
            PG8_LDB(B0, 0, 0); PG8_SCHED; PG8_LDA(At, 0, 0); PG8_STAGEA(PG8_SA(1, 1), ka1, 1, false);
            PG8_WAIT_L(8); PG8_BAR; PG8_WAIT_L(0); PG8_MMA(0, 0, At, B0); PG8_BAR; PG8_SCHED;
            PG8_LDB(B1, 0, 1); PG8_STAGE(PG8_SB(0, 0), b2, voffB);
            PG8_BAR; PG8_WAIT_L(0); PG8_MMA(0, 1, At, B1); PG8_BAR;
            PG8_LDA(At, 0, 1); PG8_STAGEA(PG8_SA(0, 0), ka2, 0, last);
            PG8_BAR; PG8_WAIT_L(0); PG8_MMA(1, 0, At, B0); PG8_BAR; PG8_SCHED;
            PG8_STAGE(PG8_SB(0, 1), b2 + hstep, voffB);
            PG8_WAIT_V(6); PG8_BAR; PG8_MMA(1, 1, At, B1); PG8_BAR;
            PG8_LDB(B0, 1, 0); PG8_SCHED; PG8_LDA(At, 1, 0); PG8_STAGEA(PG8_SA(0, 1), ka2, 1, last);
            PG8_WAIT_L(8); PG8_BAR; PG8_WAIT_L(0); PG8_MMA(0, 0, At, B0); PG8_BAR; PG8_SCHED;
            PG8_LDB(B1, 1, 1); PG8_STAGE(PG8_SB(1, 0), b3, voffB);
            PG8_BAR; PG8_WAIT_L(0); PG8_MMA(0, 1, At, B1); PG8_BAR;
            PG8_LDA(At, 1, 1); PG8_STAGEA(PG8_SA(1, 0), ka3, 0, last);
            PG8_BAR; PG8_WAIT_L(0); PG8_MMA(1, 0, At, B0); PG8_BAR; PG8_SCHED;
            PG8_STAGE(PG8_SB(1, 1), b3 + hstep, voffB);
            PG8_WAIT_V(6); PG8_BAR; PG8_MMA(1, 1, At, B1); PG8_BAR;
            }
        }
        if constexpr (ALIGN_EPI) { if (wr == 0) PG8_BAR; }
        if constexpr (ALIGN_EPI && SP2) { if (has_next) PG8_STAGEA(PG8_SA(1, 1), kstep, 1, true); PG8_SCHED; }
        if constexpr (AMap::GATHER) { if (has_next) { Unit n2_; if (S.next(ui + 2, n2_)) PG8_TOKDMA(n2_); } }
        if constexpr (!Epi::AFTER_DRAIN) { const int l2_ = lane_id_(); const int fr_ = l2_ & 15, fq_ = l2_ >> 4;
            if constexpr (Epi::PREFETCH) E(acc, cur, wr, wc, fr_, fq_, ui & 1); else E(acc, cur, wr, wc, fr_, fq_); S.done(cur); }
        if (!has_next) break;
#pragma unroll
        for (int a = 0; a < 2; ++a)
#pragma unroll
            for (int b = 0; b < 2; ++b)
#pragma unroll
                for (int m = 0; m < 4; ++m)
#pragma unroll
                    for (int n = 0; n < 2; ++n) acc[a][b][m][n] = (f32x4){0.f, 0.f, 0.f, 0.f};
        cur = nxt; cB = nB; ++ui;
#pragma unroll
        for (int _h = 0; _h < 2; ++_h) { oC[_h][0] = oN[_h][0]; oC[_h][1] = oN[_h][1]; uC[_h] = uN[_h]; }
        if constexpr (ALIGN_EPI) { if (wr == 1) PG8_BAR; }
    }
    PG8_WAIT_V(0);
    if constexpr (!ALIGN_EPI) { if (wr == 0) PG8_BAR; }
    PG8_BAR;
    if constexpr (Epi::AFTER_DRAIN) { E.fused(acc, cur, wr, wc, fr, fq, lds, wid, lane); S.done(cur); }
#undef PG8_SA
#undef PG8_SB
#undef PG8_STAGE
#undef PG8_STAGEA
#undef PG8_AOFF
#undef PG8_TOKDMA
#undef PG8_TOKOFF
#undef PG8_LDA
#undef PG8_LDB
#undef PG8_MMA
#undef PG8_CAT
#undef PG8_WAIT_V
#undef PG8_WAIT_VR
#undef PG8_WAIT_L
#undef PG8_BAR
#undef PG8_SCHED
}
}
namespace attn_body {
using bf16=unsigned short;
using bf16x8=__attribute__((ext_vector_type(8)))short;
using s16x4=__attribute__((ext_vector_type(4)))short;
using f32x16=__attribute__((ext_vector_type(16)))float;
using u32x4=__attribute__((ext_vector_type(4)))unsigned;
constexpr int SEQ=2048,D=64,DM=4096,DMO=1024;
constexpr int NW=8,QBLK=32,QB=QBLK*NW,KVBLK=64,NQB=SEQ/QB;
__device__ __forceinline__ unsigned f2bf_(float f){unsigned u=__builtin_bit_cast(unsigned,f);return (u+0x7fffu+((u>>16)&1u))>>16;}
__device__ __forceinline__ int crow(int r,int hi){return (r&3)+8*(r>>2)+4*hi;}
#define SBAR() __builtin_amdgcn_sched_barrier(0)
__device__ __forceinline__ void cmask(f32x16&p0,f32x16&p1,int jb,int qrel,int hi){
  const float NEG=-INFINITY; int kb=64*jb+4*hi;
  #pragma unroll
  for(int r=0;r<16;++r){int kv=kb+(r&3)+8*(r>>2); if(kv>qrel)p0[r]=NEG; if(kv+32>qrel)p1[r]=NEG;}
}

__device__ __forceinline__ uint2 mld_asm(const unsigned*p){ uint2 v; asm volatile("global_load_dwordx2 %0, %1, off":"=v"(v):"v"(p):"memory"); return v; }
__device__ __forceinline__ void bmask(f32x16&p0,f32x16&p1,uint2 w,int hi){
  const float NEG=-INFINITY; const unsigned a=w.x>>(4*hi), b=w.y>>(4*hi);
  #pragma unroll
  for(int r=0;r<16;++r){const int bit=(r&3)+8*(r>>2); if(!((a>>bit)&1u))p0[r]=NEG; if(!((b>>bit)&1u))p1[r]=NEG;}
}
constexpr int NSLOT=3, SLOTB=8192;
constexpr int LDS_K=0, LDS_V=NSLOT*SLOTB, LDS_WS=2*NSLOT*SLOTB, LDS_OST=LDS_WS+NW*64*4, LDS_BYTES=LDS_OST+NW*4096;
constexpr float C2=0.125f*1.4426950408889634f;
__device__ __forceinline__ void glds16(const void*gsrc,unsigned lds_dst){unsigned keep;
  asm volatile("s_mov_b32 %0, m0\n\ts_mov_b32 m0, %2\n\ts_nop 0\n\tglobal_load_lds_dwordx4 %1, off\n\ts_mov_b32 m0, %0":"=&s"(keep):"v"(gsrc),"s"(lds_dst):"memory");}
__device__ __forceinline__ float max3f(float a,float b,float c){float r;asm("v_max3_f32 %0, %1, %2, %3":"=v"(r):"v"(a),"v"(b),"v"(c));return r;}
__device__ __forceinline__ float max2f(float a,float b){float r;asm("v_max_f32_e32 %0, %1, %2":"=v"(r):"v"(a),"v"(b));return r;}
__device__ __forceinline__ float fadd_s(float a,float b){float r;asm("v_add_f32_e32 %0, %1, %2":"=v"(r):"v"(a),"v"(b));return r;}
__device__ __forceinline__ float fsub_s(float a,float b){float r;asm("v_sub_f32_e32 %0, %1, %2":"=v"(r):"v"(a),"v"(b));return r;}
typedef float f32x2_t __attribute__((ext_vector_type(2))); typedef __bf16 bf16x2_t __attribute__((ext_vector_type(2)));
__device__ __forceinline__ unsigned cvtpk_s(float lo,float hi){f32x2_t v={lo,hi};bf16x2_t b=__builtin_convertvector(v,bf16x2_t);return __builtin_bit_cast(unsigned,b);}
#define WAIT_BAR(N) asm volatile("s_waitcnt vmcnt(" #N ") lgkmcnt(0)\n\ts_barrier":::"memory")

__device__ __forceinline__ void qkt(f32x16&p0,f32x16&p1,const char*Kslot,const bf16x8*qr,const f32x16&negm,int r32,int hi){
  const char*kb=Kslot+hi*1024+r32*16;
  #pragma unroll
  for(int d0=0;d0<4;++d0){
    const bf16x8 b0=*reinterpret_cast<const bf16x8*>(kb+d0*2048);
    const bf16x8 b1=*reinterpret_cast<const bf16x8*>(kb+d0*2048+512);
    if(d0==0){p0=__builtin_amdgcn_mfma_f32_32x32x16_bf16(b0,qr[0],negm,0,0,0);p1=__builtin_amdgcn_mfma_f32_32x32x16_bf16(b1,qr[0],negm,0,0,0);}
    else{p0=__builtin_amdgcn_mfma_f32_32x32x16_bf16(b0,qr[d0],p0,0,0,0);p1=__builtin_amdgcn_mfma_f32_32x32x16_bf16(b1,qr[d0],p1,0,0,0);}}
}
typedef __attribute__((address_space(3))) const char* lds_cptr;
typedef short v4i16_t __attribute__((ext_vector_type(4)));
__device__ __forceinline__ void kload8(bf16x8*kf,lds_cptr kp){
  kf[0]=*(const __attribute__((address_space(3))) bf16x8*)(kp);      kf[1]=*(const __attribute__((address_space(3))) bf16x8*)(kp+512);
  kf[2]=*(const __attribute__((address_space(3))) bf16x8*)(kp+2048); kf[3]=*(const __attribute__((address_space(3))) bf16x8*)(kp+2560);
  kf[4]=*(const __attribute__((address_space(3))) bf16x8*)(kp+4096); kf[5]=*(const __attribute__((address_space(3))) bf16x8*)(kp+4608);
  kf[6]=*(const __attribute__((address_space(3))) bf16x8*)(kp+6144); kf[7]=*(const __attribute__((address_space(3))) bf16x8*)(kp+6656);
}
__device__ __forceinline__ void kload2(bf16x8*kf,lds_cptr kp,int j){ kf[2*j]=*(const __attribute__((address_space(3))) bf16x8*)(kp+j*2048); kf[2*j+1]=*(const __attribute__((address_space(3))) bf16x8*)(kp+j*2048+512); }
__device__ __forceinline__ s16x4 vtr(lds_cptr p){ return __builtin_bit_cast(s16x4,__builtin_amdgcn_ds_read_tr16_b64_v4i16((__attribute__((address_space(3))) v4i16_t*)p)); }
__device__ __forceinline__ float rowmax(const f32x16&p0,const f32x16&p1){
  float a=max3f(p0[0],p0[1],p1[0]),b=max3f(p0[2],p0[3],p1[1]);a=max3f(a,p1[2],p1[3]);
  #pragma unroll
  for(int r=4;r<16;r+=4){a=max3f(a,p0[r],p0[r+1]);b=max3f(b,p0[r+2],p0[r+3]);a=max3f(a,p1[r],p1[r+1]);b=max3f(b,p1[r+2],p1[r+3]);}
  const float m=max2f(a,b);
  auto rr=__builtin_amdgcn_permlane32_swap(__float_as_uint(m),__float_as_uint(m),false,false);
  return max2f(__uint_as_float(rr[0]),__uint_as_float(rr[1]));
}
__device__ __forceinline__ void pv(f32x16*o,int vb,bf16x8 pa0,bf16x8 pa1,bf16x8 pa2,bf16x8 pa3){
  #pragma unroll
  for(int d0=0;d0<2;++d0){s16x4 lo[4],hi[4];
    #pragma unroll
    for(int ks=0;ks<4;++ks){
      asm volatile("ds_read_b64_tr_b16 %0,%1 offset:%c2":"=&v"(lo[ks]):"v"(vb),"i"(d0*4096+ks*1024):"memory");
      asm volatile("ds_read_b64_tr_b16 %0,%1 offset:%c2":"=&v"(hi[ks]):"v"(vb),"i"(d0*4096+ks*1024+512):"memory");}
    asm volatile("s_waitcnt lgkmcnt(0)":::"memory");SBAR();
    #define PK(k) (bf16x8){lo[k][0],lo[k][1],lo[k][2],lo[k][3],hi[k][0],hi[k][1],hi[k][2],hi[k][3]}
    o[d0]=__builtin_amdgcn_mfma_f32_32x32x16_bf16(pa0,PK(0),o[d0],0,0,0);
    o[d0]=__builtin_amdgcn_mfma_f32_32x32x16_bf16(pa1,PK(1),o[d0],0,0,0);
    o[d0]=__builtin_amdgcn_mfma_f32_32x32x16_bf16(pa2,PK(2),o[d0],0,0,0);
    o[d0]=__builtin_amdgcn_mfma_f32_32x32x16_bf16(pa3,PK(3),o[d0],0,0,0);
    #undef PK
  }
}

#ifndef ATTN_STORE16
#define ATTN_STORE16(p,v) (*(u32x4*)(p)=(v))
#endif
template<int THRL,bool MASKED> __device__ __forceinline__ void attn_unit(int wvx,int b,int qb,const bf16*Q,const bf16*__restrict__ K,const bf16*__restrict__ V,bf16*O,const unsigned*MASK,char*shm){
  int tid_=wvx*64+lane_id_(); asm volatile("":"+v"(tid_));
  const int tid=tid_,lane=tid&63,r32=lane&31,hi=lane>>5; const int wid=__builtin_amdgcn_readfirstlane(tid>>6);
  const long rowbase=(long)b*SEQ; const int q0=qb*QB;
  const bf16*Qw=Q+(rowbase+q0+wid*QBLK)*DM;
  const bf16*Kh=K+rowbase*DM,*Vh=V+rowbase*DM;
  const unsigned*mrow=MASK+(size_t)(rowbase+q0+wid*QBLK+r32)*64;
  #define MLD(tt) mld_asm(mrow+2*(tt))
  const unsigned lds0=(unsigned)(uintptr_t)shm;
  float*wsf=(float*)(shm+LDS_WS)+wid*64;
  const bf16*ksrc=Kh+(long)lane*DM+wid*8;
  const bf16*vsrc=Vh+(long)(16*(wid&3)+(lane>>2))*DM+(wid>>2)*32+(lane&3)*8;
  const unsigned kdst=lds0+LDS_K+wid*1024, vdst=lds0+LDS_V+wid*1024;
  #define DMA_K(t,slot) glds16(ksrc+(long)(t)*KVBLK*DM,(unsigned)__builtin_amdgcn_readfirstlane(kdst+(slot)))
  #define DMA_V(t,slot) glds16(vsrc+(long)(t)*KVBLK*DM,(unsigned)__builtin_amdgcn_readfirstlane(vdst+(slot)))
  const int vb0=(int)(lds0+LDS_V)+((lane>>4)&1)*32+(lane&3)*8+(4*hi+((lane&15)>>2))*64;
  const char*Kbase=shm+LDS_K; bf16x8 kf[8];
  const lds_cptr shm3=(lds_cptr)shm; const lds_cptr kp0=shm3+LDS_K+hi*1024+r32*16; const lds_cptr vp0=shm3+LDS_V+((lane>>4)&1)*32+(lane&3)*8+(4*hi+((lane&15)>>2))*64;
  const int NT=(q0+QB)/KVBLK;
  uint2 mw_cur=make_uint2(~0u,~0u), mw_next=make_uint2(~0u,~0u); if(MASKED){ mw_cur=MLD(0); mw_next=MLD(1); }
  DMA_K(0,0);DMA_V(0,0);DMA_K(1,SLOTB);
  bf16x8 qr[4];
  #pragma unroll
  for(int d0=0;d0<4;++d0)qr[d0]=*reinterpret_cast<const bf16x8*>(&Qw[(long)r32*DM+d0*16+hi*8]);
  float mhat=0.f,l_reg=0.f;f32x16 o[2];o[0]=f32x16{};o[1]=f32x16{};f32x16 negm=f32x16{};asm volatile("":"+v"(negm));
  const int qrel=wid*QBLK+r32;
  #define CMASK(P0,P1,t) do{ if(MASKED){bmask(P0,P1,mw_cur,hi);} else {int jb_=(t)-(NT-4); if(jb_>=0)cmask(P0,P1,jb_,qrel,hi);} }while(0)
  bool resc=false;
  #define START(P0,P1) do{ float rm=rowmax(P0,P1); if(MASKED)rm=max2f(rm,-64.f); resc=false; \
    { const float dl=rm; mhat=fadd_s(mhat,dl); \
      _Pragma("unroll") for(int r=0;r<16;++r){P0[r]=fsub_s(P0[r],dl);P1[r]=fsub_s(P1[r],dl);} \
      _Pragma("unroll") for(int r=0;r<16;++r)negm[r]=-mhat; asm volatile("":"+v"(negm)); } \
    _Pragma("unroll") for(int r=0;r<16;++r)P0[r]=__builtin_amdgcn_exp2f(P0[r]); }while(0)
  #define RESC() do{ if(resc){ asm volatile("s_waitcnt lgkmcnt(0)":::"memory"); \
      _Pragma("unroll") for(int d_=0;d_<2;++d_) _Pragma("unroll") for(int r=0;r<16;++r)o[d_][r]*=wsf[crow(r,hi)]; } }while(0)
  f32x16 pA0,pA1,pB0,pB1;
  int sl_prev=0,sl_cur=0,sl_next=SLOTB;
  #define ROT() do{sl_prev=sl_cur;sl_cur=sl_next;sl_next=(sl_next==(NSLOT-1)*SLOTB)?0:sl_next+SLOTB;}while(0)
  DMA_K(2,2*SLOTB);
  WAIT_BAR(3);
  qkt(pA0,pA1,Kbase,qr,negm,r32,hi);asm volatile("s_nop 15\n\ts_nop 7":"+v"(pA0),"+v"(pA1));CMASK(pA0,pA1,0);
  START(pA0,pA1);
  _Pragma("unroll") for(int r=0;r<16;++r)pA1[r]=__builtin_amdgcn_exp2f(pA1[r]);
  WAIT_BAR(0);
  DMA_K(3,0);DMA_V(1,SLOTB);
  ROT();
  kload8(kf,kp0+sl_cur);
  WAIT_BAR(2);
  s16x4 vlo[8],vhi[8]; u32x4 pw0,pw1,pw2,pw3;
  #define PKW(P,B) cvtpk_s(P[B],P[B+1])
  #define PAF(k) __builtin_bit_cast(bf16x8,pw##k)
  #define VFR(i) (bf16x8){vlo[i][0],vlo[i][1],vlo[i][2],vlo[i][3],vhi[i][0],vhi[i][1],vhi[i][2],vhi[i][3]}
  #define PIN(x) asm volatile("":"+v"(x))
  #define MX3(a,b,c) __builtin_fmaxf(__builtin_fmaxf((a),(b)),(c))
  #define GAPA(MF,A0,A1,A2,A3,W0,W1,PW) do{ MF; sacc+=A0; sacc+=A1; sacc+=A2; sacc+=A3; PIN(sacc); W0; W1; PIN(PW); SBAR(); }while(0)
  #define EX(v) __builtin_amdgcn_exp2f(v)
  #define GAPB(MF,X,B) do{ MF; X[B]=EX(X[B]); X[B+1]=EX(X[B+1]); X[B+2]=EX(X[B+2]); X[B+3]=EX(X[B+3]); PIN(X); SBAR(); }while(0)
  #define VRD(i) do{ vlo[i]=vtr(vp_+(((i)>>2)*4096+((i)&3)*1024)); vhi[i]=vtr(vp_+(((i)>>2)*4096+((i)&3)*1024+512)); }while(0)
  #define KRD(G,j) do{ if(G){ kload2(kf,kp0+sl_next,j); SBAR(); } }while(0)
  #define STEP(C0,C1,P0,P1,t,GK,GV,GL) do{ SBAR(); if(MASKED){ mw_cur=mw_next; if((t)+1<NT) mw_next=MLD((t)+1); } \
    const lds_cptr vp_=vp0+sl_prev; \
    VRD(0); SBAR(); float sacc=(P0[0]+P0[1]); \
    GAPA(C0=__builtin_amdgcn_mfma_f32_32x32x16_bf16(kf[0],qr[0],negm,0,0,0), P0[2],P0[3],P0[4],P0[5],     pw0[0]=PKW(P0,0), pw0[1]=PKW(P0,2), pw0); \
    VRD(4); SBAR(); GAPA(C1=__builtin_amdgcn_mfma_f32_32x32x16_bf16(kf[1],qr[0],negm,0,0,0), P0[6],P0[7],P0[8],P0[9],     pw0[2]=PKW(P0,4), pw0[3]=PKW(P0,6), pw0); \
    VRD(1); SBAR(); GAPA(C0=__builtin_amdgcn_mfma_f32_32x32x16_bf16(kf[2],qr[1],C0,0,0,0),   P0[10],P0[11],P0[12],P0[13], pw1[0]=PKW(P0,8), pw1[1]=PKW(P0,10), pw1); \
    VRD(5); SBAR(); GAPA(C1=__builtin_amdgcn_mfma_f32_32x32x16_bf16(kf[3],qr[1],C1,0,0,0),   P0[14],P0[15],P1[0],P1[1],   pw1[2]=PKW(P0,12),pw1[3]=PKW(P0,14), pw1); \
    VRD(2); SBAR(); GAPA(C0=__builtin_amdgcn_mfma_f32_32x32x16_bf16(kf[4],qr[2],C0,0,0,0),   P1[2],P1[3],P1[4],P1[5],     pw2[0]=PKW(P1,0), pw2[1]=PKW(P1,2), pw2); \
    VRD(6); SBAR(); GAPA(C1=__builtin_amdgcn_mfma_f32_32x32x16_bf16(kf[5],qr[2],C1,0,0,0),   P1[6],P1[7],P1[8],P1[9],     pw2[2]=PKW(P1,4), pw2[3]=PKW(P1,6), pw2); \
    VRD(3); SBAR(); GAPA(C0=__builtin_amdgcn_mfma_f32_32x32x16_bf16(kf[6],qr[3],C0,0,0,0),   P1[10],P1[11],P1[12],P1[13], pw3[0]=PKW(P1,8), pw3[1]=PKW(P1,10), pw3); \
    VRD(7); SBAR(); GAPA(C1=__builtin_amdgcn_mfma_f32_32x32x16_bf16(kf[7],qr[3],C1,0,0,0),   P1[14],P1[15],0.f,0.f,       pw3[2]=PKW(P1,12),pw3[3]=PKW(P1,14), pw3); \
    l_reg+=sacc; \
    if(GK){DMA_K((t)+3,sl_cur);} if(GV){DMA_V((t)+1,sl_next);} \
    CMASK(C0,C1,t); \
    { float a=MX3(C0[0],C0[1],C1[0]),b=MX3(C0[2],C0[3],C1[1]); a=MX3(a,C1[2],C1[3]); \
      _Pragma("unroll") for(int r=4;r<16;r+=4){a=MX3(a,C0[r],C0[r+1]);b=MX3(b,C0[r+2],C0[r+3]);a=MX3(a,C1[r],C1[r+1]);b=MX3(b,C1[r+2],C1[r+3]);} \
      float rm=__builtin_fmaxf(a,b); { auto rr=__builtin_amdgcn_permlane32_swap(__float_as_uint(rm),__float_as_uint(rm),false,false); rm=__builtin_fmaxf(__uint_as_float(rr[0]),__uint_as_float(rr[1])); } \
      resc=false; \
      if(__builtin_expect(__any(rm>(float)THRL),0)){ const float dl=__builtin_fmaxf(rm,0.f); mhat+=dl; \
        _Pragma("unroll") for(int r=0;r<16;++r){C0[r]-=dl;C1[r]-=dl;} \
        _Pragma("unroll") for(int r=0;r<16;++r)negm[r]=-mhat; asm volatile("":"+v"(negm)); \
        const float f=__builtin_amdgcn_exp2f(-dl); l_reg*=f; if(hi==0)wsf[r32]=f; resc=true; } } \
    SBAR(); \
    GAPB(o[0]=__builtin_amdgcn_mfma_f32_32x32x16_bf16(PAF(0),VFR(0),o[0],0,0,0), C0,0); \
    GAPB(o[1]=__builtin_amdgcn_mfma_f32_32x32x16_bf16(PAF(0),VFR(4),o[1],0,0,0), C0,4); \
    KRD(GL,0); GAPB(o[0]=__builtin_amdgcn_mfma_f32_32x32x16_bf16(PAF(1),VFR(1),o[0],0,0,0), C0,8); \
    KRD(GL,1); GAPB(o[1]=__builtin_amdgcn_mfma_f32_32x32x16_bf16(PAF(1),VFR(5),o[1],0,0,0), C0,12); \
    KRD(GL,2); GAPB(o[0]=__builtin_amdgcn_mfma_f32_32x32x16_bf16(PAF(2),VFR(2),o[0],0,0,0), C1,0); \
    KRD(GL,3); GAPB(o[1]=__builtin_amdgcn_mfma_f32_32x32x16_bf16(PAF(2),VFR(6),o[1],0,0,0), C1,4); \
    GAPB(o[0]=__builtin_amdgcn_mfma_f32_32x32x16_bf16(PAF(3),VFR(3),o[0],0,0,0), C1,8); \
    GAPB(o[1]=__builtin_amdgcn_mfma_f32_32x32x16_bf16(PAF(3),VFR(7),o[1],0,0,0), C1,12); \
    }while(0)
  int t=1;
  #undef CMASK
  #define CMASK(P0,P1,t) do{ if(MASKED){bmask(P0,P1,mw_cur,hi);} }while(0)
  for(;t+5<NT;t+=2){
    STEP(pB0,pB1,pA0,pA1,t,true,true,true);     WAIT_BAR(2); RESC(); ROT();
    STEP(pA0,pA1,pB0,pB1,t+1,true,true,true);   WAIT_BAR(2); RESC(); ROT();
  }
  #undef CMASK
  #define CMASK(P0,P1,t) do{ if(MASKED){bmask(P0,P1,mw_cur,hi);} else {int jb_=(t)-(NT-4); if(jb_>=0)cmask(P0,P1,jb_,qrel,hi);} }while(0)
  #define ENDW(tt) do{ if((tt)+3<NT){WAIT_BAR(2);} else if((tt)+2<NT){WAIT_BAR(1);} else {WAIT_BAR(0);} }while(0)
  for(;t+1<NT;t+=2){
    STEP(pB0,pB1,pA0,pA1,t,(t+3<NT),(t+1<NT),(t+1<NT));       ENDW(t);   RESC(); ROT();
    STEP(pA0,pA1,pB0,pB1,t+1,(t+4<NT),(t+2<NT),(t+2<NT));     ENDW(t+1); RESC(); ROT();
  }
  STEP(pB0,pB1,pA0,pA1,NT-1,false,false,false); RESC();
  { float sacc=pB0[0]+pB0[1]; _Pragma("unroll") for(int r=2;r<16;++r)sacc+=pB0[r]; _Pragma("unroll") for(int r=0;r<16;++r)sacc+=pB1[r]; l_reg+=sacc;
    pw0=(u32x4){PKW(pB0,0),PKW(pB0,2),PKW(pB0,4),PKW(pB0,6)};pw1=(u32x4){PKW(pB0,8),PKW(pB0,10),PKW(pB0,12),PKW(pB0,14)};pw2=(u32x4){PKW(pB1,0),PKW(pB1,2),PKW(pB1,4),PKW(pB1,6)};pw3=(u32x4){PKW(pB1,8),PKW(pB1,10),PKW(pB1,12),PKW(pB1,14)};
    SBAR(); pv(o,vb0+sl_cur,PAF(0),PAF(1),PAF(2),PAF(3)); }
  #undef PKW
  #undef PAF
  #undef VFR
  #undef PIN
  #undef MX3
  #undef GAPA
  #undef GAPB
  #undef EX
  #undef VRD
  #undef KRD
  #undef STEP
  #undef ENDW
  {auto rr=__builtin_amdgcn_permlane32_swap(__float_as_uint(l_reg),__float_as_uint(l_reg),false,false);l_reg=__uint_as_float(rr[0])+__uint_as_float(rr[1]);}
  if(hi==0)wsf[32+r32]=l_reg;asm volatile("s_waitcnt lgkmcnt(0)":::"memory");
  float rli[16];
  #pragma unroll
  for(int r=0;r<16;++r)rli[r]=__builtin_amdgcn_rcpf(wsf[32+crow(r,hi)]);
  bf16*Ow=O+(rowbase+q0+wid*QBLK)*DMO;
  { bf16*stg=(bf16*)(shm+LDS_OST)+wid*2048;
    #pragma unroll
    for(int r=0;r<16;++r){const int orow=crow(r,hi);
      #pragma unroll
      for(int d0=0;d0<2;++d0)stg[orow*64+d0*32+r32]=(bf16)f2bf_(o[d0][r]*rli[r]);}
    asm volatile("s_waitcnt lgkmcnt(0)":::"memory");
    #pragma unroll
    for(int i=0;i<4;++i){const int row=i*8+(lane>>3),ch=lane&7; const u32x4 v=*(const u32x4*)(stg+row*64+ch*8); ATTN_STORE16(Ow+(long)row*DMO+ch*8,v);} }
  asm volatile("s_waitcnt lgkmcnt(0)\n\ts_barrier":::"memory");
  #undef DMA_K
  #undef DMA_V
  #undef MLD
  #undef CMASK
  #undef START
  #undef RESC
  #undef ROT
}
constexpr int ATTN_LDS_BYTES=LDS_BYTES;
#undef SBAR
#undef WAIT_BAR
}
#define GAS __attribute__((address_space(1)))
#define LAS __attribute__((address_space(3)))
typedef unsigned short bf16;
typedef unsigned v4u __attribute__((ext_vector_type(4)));
typedef float f32x4 __attribute__((ext_vector_type(4)));
typedef short bf16x8 __attribute__((ext_vector_type(8)));
typedef GAS unsigned gu32;
typedef GAS unsigned long long gu64;
#define RLX_AGENT __ATOMIC_RELAXED, __HIP_MEMORY_SCOPE_AGENT
#define LDS_WAIT() asm volatile("s_waitcnt lgkmcnt(0)" ::: "memory")
#define VM_WAIT() asm volatile("s_waitcnt vmcnt(0)" ::: "memory")
__device__ __forceinline__ unsigned long long rt() { return __builtin_amdgcn_s_memrealtime(); }
__device__ __forceinline__ unsigned f2bf(float f) { unsigned r; asm("v_cvt_pk_bf16_f32 %0, %1, %1" : "=v"(r) : "v"(f)); return r & 0xffffu; }
__device__ __forceinline__ unsigned pk2(float lo, float hi) { unsigned r; asm("v_cvt_pk_bf16_f32 %0, %1, %2" : "=v"(r) : "v"(lo), "v"(hi)); return r; }
__device__ __forceinline__ int tid_of(int wvx) { return wvx * 64 + lane_id_(); }
__device__ __forceinline__ int bid_() { int b_ = (int)blockIdx.x; asm volatile("" : "+s"(b_)); return b_; }
__device__ __forceinline__ int gsz_() { int g_ = (int)gridDim.x; asm volatile("" : "+s"(g_)); return g_; }
#define XB_TMO      128
#define XB_XCNT(j)  (256  + 64 * (j))
#define XB_XSUB(j)  (1280 + 64 * (j))
#define XB_XGEN(j)  (2304 + 64 * (j))
#define XB_TOP      3328
#define XB_TOPGEN   3392
#define XCD_BAR_WORDS 3456
#define XB_SPIN_CAP (1u << 20)

__device__ __forceinline__ unsigned xb_ld(unsigned* p)              { return __hip_atomic_load(p, __ATOMIC_RELAXED, __HIP_MEMORY_SCOPE_AGENT); }
__device__ __forceinline__ unsigned xb_add(unsigned* p, unsigned v) { return __hip_atomic_fetch_add(p, v, __ATOMIC_RELAXED, __HIP_MEMORY_SCOPE_AGENT); }
__device__ __forceinline__ unsigned xb_xcc_id() { return (unsigned)__builtin_amdgcn_s_getreg((3 << 11) | 20) & 0xFu; }
#define XB_SPIN(cond, bar) do { unsigned _sp = 0; while (cond) { __builtin_amdgcn_s_sleep(1); \
    if ((++_sp & 255u) == 0u) { if (xb_ld(&(bar)[XB_TMO])) break; if (_sp > XB_SPIN_CAP) { atomicAdd(&(bar)[XB_TMO], 1u); break; } } } } while (0)

struct XcdBarrier {
    unsigned* bar; unsigned x;
    volatile LAS unsigned* st;
};

__device__ __forceinline__ XcdBarrier xcd_barrier_post(unsigned* bar, volatile LAS unsigned* st) {
    XcdBarrier b; b.bar = bar; b.x = xb_xcc_id(); b.st = st;
    if (threadIdx.x == 0) (void)xb_add(&bar[XB_XCNT(b.x)], 1u);
    return b;
}
__device__ __forceinline__ void xcd_barrier_complete(unsigned* bar, unsigned x, unsigned& nloc, unsigned& nx) {
    const unsigned G = gridDim.x * gridDim.y * gridDim.z;
    unsigned sum, cnt, mine, sp = 0u;
    for (;;) {
        sum = 0u; cnt = 0u; mine = 0u;
#pragma unroll
        for (unsigned j = 0; j < 16; ++j) { const unsigned c = xb_ld(&bar[XB_XCNT(j)]); sum += c; cnt += (c > 0u) ? 1u : 0u; mine = (j == x) ? c : mine; }
        if (sum == G) break;
        __builtin_amdgcn_s_sleep(1);
        if ((++sp & 255u) == 0u) { if (xb_ld(&bar[XB_TMO])) break; if (sp > XB_SPIN_CAP) { atomicAdd(&bar[XB_TMO], 1u); break; } }
    }
    nloc = mine > 0u ? mine : 1u; nx = cnt > 0u ? cnt : 1u;
}

__device__ __attribute__((noinline)) void xcd_barrier_fn(unsigned* bar_, unsigned x_, volatile LAS unsigned* st_, bool leader_) {
    XcdBarrier b; b.bar = bar_; b.x = x_; b.st = st_;
    asm volatile("s_waitcnt vmcnt(0)" ::: "memory");
    __syncthreads();
    if (leader_) {
        unsigned* bar = b.bar;
        __builtin_amdgcn_s_waitcnt(0);
        unsigned nloc = b.st[0], nx = b.st[1];
        if (nloc == 0u) { xcd_barrier_complete(bar, b.x, nloc, nx); b.st[0] = nloc; b.st[1] = nx; }
        const unsigned old = xb_add(&bar[XB_XSUB(b.x)], 1u);
        const unsigned gen = old / nloc;
        if (old + 1u == (gen + 1u) * nloc) {
            __builtin_amdgcn_fence(__ATOMIC_RELEASE, "agent");
            asm volatile("s_waitcnt vmcnt(0)" ::: "memory");
            const unsigned og = xb_add(&bar[XB_TOP], 1u);
            const unsigned tg = og / nx;
            if (og + 1u == (tg + 1u) * nx) xb_add(&bar[XB_TOPGEN], 1u);
            else XB_SPIN(xb_ld(&bar[XB_TOPGEN]) == tg, bar);
            __builtin_amdgcn_fence(__ATOMIC_ACQUIRE, "agent");
            xb_add(&bar[XB_XGEN(b.x)], 1u);
            asm volatile("s_waitcnt vmcnt(0)" ::: "memory");
        } else {
            XB_SPIN(xb_ld(&bar[XB_XGEN(b.x)]) == gen, bar);
            __builtin_amdgcn_fence(__ATOMIC_ACQUIRE, "agent");
            asm volatile("s_waitcnt vmcnt(0)" ::: "memory");
        }
    }
    __syncthreads();
}


constexpr int NB = 16, SEQ = 2048, T = NB * SEQ, D = 1024, DEPTH = 4, NHC = 4096, NEXP = 32, NWAVES = 8;
constexpr int NIN = 3920;
constexpr float LN_EPS = 1e-5f, DN_ALPHA = 1.6817928305074290f;
constexpr int RPAD = T * 4 + NEXP * 256;
constexpr int HC_MQ = 0, HC_MK = 256, HC_MV = 512, HC_MO = 768, HC_DQ = 1024, HC_DK = 1536, HC_DV = 2048, HC_SQ = 2560, HC_SK = 2816, HC_SV = 3072, HC_XQ = 3328, HC_XK = 3840, HC_MI = 3904, HC_MF = 3908, HC_XW = 3912;
constexpr size_t MiB = 1u << 20;
constexpr size_t WS_CTL = 0, CTL_ZERO_BYTES = 128 * 1024;
constexpr size_t WS_MOD = 2 * MiB;
constexpr size_t WS_LAM = WS_MOD + 7 * MiB / 4;
constexpr size_t WS_RWT = 4 * MiB;
constexpr size_t WS_CS = 8 * MiB;
constexpr size_t WS_WIN = 16 * MiB;
constexpr size_t WS_WOUT = 48 * MiB;
constexpr size_t WS_W1 = 64 * MiB;
constexpr size_t WS_W2 = 576 * MiB;
constexpr size_t WS_XB = 832 * MiB;
constexpr size_t WS_U = 960 * MiB;
constexpr size_t WS_H = 1024 * MiB;
constexpr size_t WS_QKC = 1280 * MiB;
constexpr size_t WS_XKP = 1312 * MiB;
constexpr size_t WS_MASK = 1316 * MiB;
constexpr size_t WS_TOK = 1324 * MiB;
constexpr size_t WS_CS16 = 1328 * MiB;
constexpr size_t WS_MIX = 1344 * MiB;
constexpr size_t WS_Y = 1408 * MiB;
constexpr size_t WS_SC = 1472 * MiB;
constexpr size_t WS_XG = 1728 * MiB;
constexpr size_t WS_HM = 2000 * MiB;
constexpr size_t WS_YM = 2272 * MiB;
constexpr size_t WS_END = 2544 * MiB;
constexpr int CW_CNT = 1024;
constexpr int CW_BAR = 16384;
constexpr int RING_BYTES = 131072, TAB_OFF = RING_BYTES, LDS_BYTES = 147456, MISC_OFF = LDS_BYTES - 256;
constexpr int NPH = 10, NSTEPS = 2 + NPH * DEPTH;
enum { PH_IN = 0, PH_POST, PH_MIXA, PH_SEL, PH_DSA, PH_OUT, PH_ROW1, PH_G1, PH_G2, PH_ROW2 };

typedef unsigned short us8 __attribute__((ext_vector_type(8)));
__device__ __forceinline__ float bf2f(bf16 h) { return __uint_as_float((unsigned)h << 16); }
#define DPPF(x, c) __int_as_float(__builtin_amdgcn_update_dpp(0, __float_as_int(x), c, 0xF, 0xF, true))
__device__ __forceinline__ float wave_sum(float v) {
    v += DPPF(v, 0xB1); v += DPPF(v, 0x4E); v += DPPF(v, 0x141); v += DPPF(v, 0x140);
    return (__int_as_float(__builtin_amdgcn_readlane(__float_as_int(v), 0)) + __int_as_float(__builtin_amdgcn_readlane(__float_as_int(v), 16))) + (__int_as_float(__builtin_amdgcn_readlane(__float_as_int(v), 32)) + __int_as_float(__builtin_amdgcn_readlane(__float_as_int(v), 48)));
}
__device__ __forceinline__ float wave_max(float v) {
    v = fmaxf(v, DPPF(v, 0xB1)); v = fmaxf(v, DPPF(v, 0x4E)); v = fmaxf(v, DPPF(v, 0x141)); v = fmaxf(v, DPPF(v, 0x140));
    return fmaxf(fmaxf(__int_as_float(__builtin_amdgcn_readlane(__float_as_int(v), 0)), __int_as_float(__builtin_amdgcn_readlane(__float_as_int(v), 16))), fmaxf(__int_as_float(__builtin_amdgcn_readlane(__float_as_int(v), 32)), __int_as_float(__builtin_amdgcn_readlane(__float_as_int(v), 48))));
}
__device__ __forceinline__ float shx(float v, int lane, int m) { return __int_as_float(__builtin_amdgcn_ds_bpermute((lane ^ m) << 2, __float_as_int(v))); }
__device__ __forceinline__ int shxi(int v, int lane, int m) { return __builtin_amdgcn_ds_bpermute((lane ^ m) << 2, v); }
__device__ __forceinline__ float shup(float v, int lane, int o) { return __int_as_float(__builtin_amdgcn_ds_bpermute(((lane - o) & 63) << 2, __float_as_int(v))); }
__device__ __forceinline__ int shupi(int v, int lane, int o) { return __builtin_amdgcn_ds_bpermute(((lane - o) & 63) << 2, v); }
__device__ __forceinline__ float sigmoidf_(float x) { return 1.0f / (1.0f + __expf(-x)); }
struct Ctx {
    LAS unsigned char* lds;
    int tid, lane, wave, gw, ngw;
    const float* in[25];
    float* out; unsigned char* ws;
};
#define WSP(type, off) ((type*)(C.ws + (off)))
enum { I_X = 0, I_C, I_POS, I_WIN, I_GATEB, I_CONVW, I_CONVB, I_MNORM, I_DFLAM, I_DFNORM, I_IDXG, I_IDXB, I_WOUT, I_ADAW, I_ADAB, I_LN1G, I_LN1B, I_LN2G, I_LN2B, I_RW, I_RB, I_W1, I_B1, I_W2, I_B2 };

__device__ __forceinline__ int in_dest_col(int n) {
    auto rp = [](int j) { const int hd = j >> 6, d = j & 63; return hd * 64 + ((d < 32) ? 2 * d : 2 * (d - 32) + 1); };
    if (n < 256) return HC_MQ + n;
    if (n < 512) return HC_MK + (n - 256);
    if (n < 768) return HC_MV + (n - 512);
    if (n < 772) return HC_MI + (n - 768);
    if (n < 776) return HC_MF + (n - 772);
    if (n < 1032) return HC_MO + (n - 776);
    if (n < 1544) return HC_DQ + rp(n - 1032);
    if (n < 2056) return HC_DK + rp(n - 1544);
    if (n < 2568) return HC_DV + (n - 2056);
    if (n < 2824) return HC_SQ + rp(n - 2568);
    if (n < 3080) return HC_SK + rp(n - 2824);
    if (n < 3336) return HC_SV + (n - 3080);
    if (n < 3848) return HC_XQ + rp(n - 3336);
    if (n < 3912) return HC_XK + (n - 3848);
    return HC_XW + (n - 3912);
}
template <class F> __device__ __forceinline__ void transpose_item(const float* W, int ldw, int K, int nvalid, int k0, int n0, bf16* WT, LAS float* scr, int lane, F drow) {
    const int nn = n0 + (lane & 31); const bool ok = nn < nvalid;
    float tv_[32];
#pragma unroll
    for (int i = 0; i < 32; ++i) { const int kk = 2 * i + (lane >> 5); tv_[i] = ok ? W[(size_t)(k0 + kk) * ldw + nn] : 0.f; }
#pragma unroll
    for (int i = 0; i < 32; ++i) { const int kk = 2 * i + (lane >> 5); scr[kk * 33 + (lane & 31)] = tv_[i]; }
    LDS_WAIT(); asm volatile("" ::: "memory");
    const int c = lane & 7;
#pragma unroll
    for (int j = 0; j < 4; ++j) { const int n = (lane >> 3) + 8 * j; const LAS float* s = scr + (8 * c) * 33 + n;
        v4u o; o.x = pk2(s[0 * 33], s[1 * 33]); o.y = pk2(s[2 * 33], s[3 * 33]); o.z = pk2(s[4 * 33], s[5 * 33]); o.w = pk2(s[6 * 33], s[7 * 33]);
        if (n0 + n < nvalid) *(GAS v4u*)(WT + (size_t)drow(n0 + n) * K + k0 + 8 * c) = o; }
    LDS_WAIT(); asm volatile("" ::: "memory");
}

template <class F> __device__ __forceinline__ void transpose_item_f8(const float* W, int ldw, int K, int nvalid, int k0, int n0, unsigned char* WT8, LAS float* scr, int lane, float sc, F drow) {
    const int nn = n0 + (lane & 31); const bool ok = nn < nvalid;
    float tv_[32];
#pragma unroll
    for (int i = 0; i < 32; ++i) { const int kk = 2 * i + (lane >> 5); tv_[i] = ok ? W[(size_t)(k0 + kk) * ldw + nn] : 0.f; }
#pragma unroll
    for (int i = 0; i < 32; ++i) { const int kk = 2 * i + (lane >> 5); scr[kk * 33 + (lane & 31)] = tv_[i]; }
    LDS_WAIT(); asm volatile("" ::: "memory");
    const int c = lane & 7;
#pragma unroll
    for (int j = 0; j < 4; ++j) { const int n = (lane >> 3) + 8 * j; const LAS float* s = scr + (8 * c) * 33 + n;
        typedef unsigned u32x2_ __attribute__((ext_vector_type(2))); u32x2_ o; o.x = pg8::pk4_fp8(s[0 * 33], s[1 * 33], s[2 * 33], s[3 * 33], sc); o.y = pg8::pk4_fp8(s[4 * 33], s[5 * 33], s[6 * 33], s[7 * 33], sc);
        if (n0 + n < nvalid) *(GAS u32x2_*)(WT8 + (size_t)drow(n0 + n) * K + k0 + 8 * c) = o; }
    LDS_WAIT(); asm volatile("" ::: "memory");
}
struct Args { const float* in[25]; float* out; unsigned char* ws; int s_lo, s_hi, li, pad; };
typedef __attribute__((address_space(4))) const Args CArgs;
__device__ __forceinline__ CArgs* kargs() { CArgs* p = (CArgs*)__builtin_amdgcn_kernarg_segment_ptr(); asm volatile("" : "+s"(p)); return p; }
__device__ __forceinline__ LAS unsigned char* lds_launder(LAS unsigned char* q) { unsigned v = (unsigned)(size_t)q; asm volatile("" : "+s"(v)); return (LAS unsigned char*)(size_t)v; }
#define WS(type, off) ((type*)(A->ws + (off)))
#define TIDX CArgs* A = kargs(); int tid_ = tid_of(wvx); asm volatile("" : "+v"(tid_)); const int tid = tid_, lane = tid & 63, wave = __builtin_amdgcn_readfirstlane(tid >> 6); const int bidx = bid_(), gsz = gsz_(); const int gw = bidx * NWAVES + wave, ngw = gsz * NWAVES; (void)bidx; (void)gsz; (void)lane; (void)gw; (void)ngw

#ifndef PRORPT
#define PRORPT 0u
#endif
#define PRPT(b) _Pragma("unroll 1") for (int prep_ = 0; prep_ < ((((PRORPT) >> (b)) & 1u) ? 2 : 1); ++prep_)
__device__ __forceinline__ void pro_a(LAS unsigned char* lds, int wvx) {
    TIDX;
    LAS float* scr = (LAS float*)(lds + wave * 16384);
    constexpr int IT_IN = 16 * 123, IT_OUT = 16 * 32, IT_W1 = 16 * 64, IT_W2 = 16 * 32;
    constexpr int N_IN = DEPTH * IT_IN, N_OUT = DEPTH * IT_OUT, N_W1 = DEPTH * NEXP * IT_W1, N_W2 = DEPTH * NEXP * IT_W2;
    constexpr int NITEMS = N_IN + N_OUT;
    PRPT(0) for (int it = gw; it < NITEMS; it += ngw) {
        int r = it;
        if (r < N_IN) { const int l = r / IT_IN, q = r % IT_IN, kb = q / 123, nb = q % 123;
#ifdef INPROJ_F8
            transpose_item_f8(A->in[I_WIN] + (size_t)l * D * NIN, NIN, D, NIN, kb * 64, nb * 32, WS(unsigned char, WS_WIN) + (size_t)l * NHC * D, scr, lane, 256.0f, [](int n) { return in_dest_col(n); }); continue; }
#else
            transpose_item(A->in[I_WIN] + (size_t)l * D * NIN, NIN, D, NIN, kb * 64, nb * 32, WS(bf16, WS_WIN) + (size_t)l * NHC * D, scr, lane, [](int n) { return in_dest_col(n); }); continue; }
#endif
        r -= N_IN;
        { const int l = r / IT_OUT, q = r % IT_OUT, kb = q / 32, nb = q % 32;
            transpose_item(A->in[I_WOUT] + (size_t)l * D * D, D, D, D, kb * 64, nb * 32, WS(bf16, WS_WOUT) + (size_t)l * D * D, scr, lane, [](int n) { return n; }); }
    }
    PRPT(1) {
        constexpr int JW1 = 8 * 8, JW2 = 8 * 4, M_W1 = DEPTH * NEXP * JW1, M_W2 = DEPTH * NEXP * JW2, NX = M_W1 + M_W2;
        constexpr int XPITCH = 144, XTILE = 256 * XPITCH;
        __syncthreads();
        f32x4 tv_[16];
        const float* src_n = nullptr; unsigned char* dst_n = nullptr; int ldw_n = 0, k0_n = 0, n0_n = 0; bool w1_n = false;
        auto decode = [&](int r) {
            w1_n = r < M_W1;
            if (w1_n) { const int le = r / JW1, q = r % JW1; k0_n = (q / 8) * 128; n0_n = (q % 8) * 256; ldw_n = 2048; src_n = A->in[I_W1] + (size_t)le * D * 2048; dst_n = WS(unsigned char, WS_W1) + (size_t)le * 2048 * D; }
            else { r -= M_W1; const int le = r / JW2, q = r % JW2; k0_n = (q / 4) * 128; n0_n = (q % 4) * 256; ldw_n = D; src_n = A->in[I_W2] + (size_t)le * D * D; dst_n = WS(unsigned char, WS_W2) + (size_t)le * D * D; }
        };
        int it = bidx, buf = 0;
        if (it < NX) { decode(it); const float* sp = src_n + (size_t)(k0_n + 16 * wave) * ldw_n + n0_n + 4 * lane;
#pragma unroll
            for (int r = 0; r < 16; ++r) tv_[r] = *(const GAS f32x4*)(sp + (size_t)r * ldw_n); }
#pragma unroll 1
        while (it < NX) {
            LAS unsigned char* tile = lds + buf * XTILE;
#pragma unroll
            for (int j = 0; j < 4; ++j) { v4u o;
                o.x = pg8::pk4_fp8(tv_[0][j], tv_[1][j], tv_[2][j], tv_[3][j], 256.0f); o.y = pg8::pk4_fp8(tv_[4][j], tv_[5][j], tv_[6][j], tv_[7][j], 256.0f);
                o.z = pg8::pk4_fp8(tv_[8][j], tv_[9][j], tv_[10][j], tv_[11][j], 256.0f); o.w = pg8::pk4_fp8(tv_[12][j], tv_[13][j], tv_[14][j], tv_[15][j], 256.0f);
                *(LAS v4u*)(tile + (j * 64 + lane) * XPITCH + 16 * wave) = o; }
            unsigned char* const dst = dst_n; const int k0 = k0_n, n0 = n0_n; const bool w1 = w1_n;
            it += gsz;
            if (it < NX) { decode(it); const float* sp = src_n + (size_t)(k0_n + 16 * wave) * ldw_n + n0_n + 4 * lane;
#pragma unroll
                for (int r = 0; r < 16; ++r) tv_[r] = *(const GAS f32x4*)(sp + (size_t)r * ldw_n); }
            asm volatile("s_waitcnt lgkmcnt(0)\n\ts_barrier" ::: "memory");
#pragma unroll
            for (int rr = 0; rr < 4; ++rr) { const int idx = rr * 512 + tid, sl = idx >> 3, seg = idx & 7; const int n = n0 + (sl & 63) * 4 + (sl >> 6);
                const v4u v = *(const LAS v4u*)(tile + sl * XPITCH + 16 * seg);
                const int up = n >> 10, jj = n & 1023; const int j8 = n & 255;
                const int drow = w1 ? ((jj >> 7) * 256 + up * 128 + (jj & 127)) : ((n & ~255) + ((j8 >> 3) & 1) * 128 + (j8 >> 6) * 32 + ((j8 >> 4) & 3) * 8 + (j8 & 7));
                *(GAS v4u*)(dst + (size_t)drow * D + k0 + 16 * seg) = v; }
            buf ^= 1;
        }
        __syncthreads();
    }
    for (int r = gw; r < DEPTH * (NHC - NIN); r += ngw) { const int l = r / (NHC - NIN), row = NIN + r % (NHC - NIN);
#ifdef INPROJ_F8
        GAS v4u* p = (GAS v4u*)(WS(unsigned char, WS_WIN) + ((size_t)l * NHC + row) * D) + lane; p[0] = (v4u){0u, 0u, 0u, 0u}; }
#else
        GAS v4u* p = (GAS v4u*)(WS(bf16, WS_WIN) + ((size_t)l * NHC + row) * D) + lane; p[0] = (v4u){0u, 0u, 0u, 0u}; p[64] = (v4u){0u, 0u, 0u, 0u}; }
#endif
    PRPT(2) for (int idx = bidx * 512 + tid; idx < T * 32; idx += gsz * 512) {
        const int tok = idx >> 5, i = idx & 31;
        const double inv = exp(-(double)i * (9.210340371976184 / 32.0));
        const double ang = (double)((const int*)A->in[I_POS])[tok] * inv;
        const double rev = ang * 0.15915494309189535;
        const float fr = (float)(rev - rint(rev));
        float2 v; v.x = __builtin_amdgcn_cosf(fr); v.y = __builtin_amdgcn_sinf(fr);
        WS(float2, WS_CS)[idx] = v;
        { const _Float16 hc = (_Float16)v.x, hs = (_Float16)v.y; WS(unsigned, WS_CS16)[idx] = (unsigned)__builtin_bit_cast(unsigned short, hc) | ((unsigned)__builtin_bit_cast(unsigned short, hs) << 16); }
    }
    for (int idx = bidx * 512 + tid; idx < DEPTH * NEXP * D; idx += gsz * 512) {
        const int l = idx / (NEXP * D), r = idx % (NEXP * D), e = r / D, d = r % D;
        WS(float, WS_RWT)[idx] = A->in[I_RW][((size_t)l * D + d) * NEXP + e];
    }
    if (bidx == 0 && wave == 0) {
        for (int l = 0; l < DEPTH; ++l) { const float* lf = A->in[I_DFLAM] + l * 256;
            const float a = wave_sum(lf[lane] * lf[64 + lane]), b = wave_sum(lf[128 + lane] * lf[192 + lane]);
            if (lane == 0) WS(float, WS_LAM)[l] = __expf(a) - __expf(b) + (0.8f - 0.6f * __expf(-0.3f * (float)l)); }
    }
    __syncthreads();
    PRPT(3) {
        LAS float* ca = (LAS float*)lds;
        LAS float* part = (LAS float*)(lds + 65536);
        for (int i = tid; i < NB * D; i += 512) { const float v = A->in[I_C][i]; ca[(i & (D - 1)) * NB + (i >> 10)] = v / (1.0f + __expf(-v)); }
        __syncthreads();
#pragma unroll 1
        for (int cg = bidx; cg < (DEPTH * 6144) / 96; cg += gsz) {
            const int l = cg >> 6, m0 = (cg & 63) * 96;
            const int r = lane >> 5, cl = lane & 31;
            const float* w = A->in[I_ADAW] + (size_t)l * D * 6144 + m0 + cl + (size_t)(wave * 128 + r) * 6144;
            const LAS float* cp = ca + (wave * 128 + r) * NB;
            float acc[NB][3];
#pragma unroll
            for (int b = 0; b < NB; ++b) { acc[b][0] = 0.f; acc[b][1] = 0.f; acc[b][2] = 0.f; }
#pragma unroll 4
            for (int i = 0; i < 64; ++i) {
                const float w0 = w[(size_t)i * 2 * 6144], w1_ = w[(size_t)i * 2 * 6144 + 32], w2_ = w[(size_t)i * 2 * 6144 + 64];
                const LAS f32x4* c4 = (const LAS f32x4*)(cp + i * 2 * NB);
#pragma unroll
                for (int q = 0; q < 4; ++q) { const f32x4 cv = c4[q];
                    acc[4 * q + 0][0] += cv.x * w0; acc[4 * q + 0][1] += cv.x * w1_; acc[4 * q + 0][2] += cv.x * w2_;
                    acc[4 * q + 1][0] += cv.y * w0; acc[4 * q + 1][1] += cv.y * w1_; acc[4 * q + 1][2] += cv.y * w2_;
                    acc[4 * q + 2][0] += cv.z * w0; acc[4 * q + 2][1] += cv.z * w1_; acc[4 * q + 2][2] += cv.z * w2_;
                    acc[4 * q + 3][0] += cv.w * w0; acc[4 * q + 3][1] += cv.w * w1_; acc[4 * q + 3][2] += cv.w * w2_; }
            }
#pragma unroll
            for (int b = 0; b < NB; ++b) {
#pragma unroll
                for (int j = 0; j < 3; ++j) { const float v = acc[b][j] + shx(acc[b][j], lane, 32); if (r == 0) part[(wave * NB + b) * 96 + 32 * j + cl] = v; } }
            __syncthreads();
            for (int idx = tid; idx < NB * 96; idx += 512) { const int b = idx / 96, j = idx % 96; float v = A->in[I_ADAB][l * 6144 + m0 + j];
#pragma unroll
                for (int wv_ = 0; wv_ < NWAVES; ++wv_) v += part[(wv_ * NB + b) * 96 + j];
                WS(float, WS_MOD)[((size_t)l * NB + b) * 6144 + m0 + j] = v; }
            __syncthreads();
        }
    }
}
__device__ __forceinline__ void pro_b(int wvx) {
    TIDX;
    for (int tok = gw; tok < T; tok += ngw) {
        const int b = tok / SEQ; const float* mod = WS(float, WS_MOD) + (size_t)b * 6144;
        const GAS f32x4* xr = (const GAS f32x4*)(A->in[I_X] + (size_t)tok * D) + lane;
        GAS unsigned long long* o8 = (GAS unsigned long long*)(WS(bf16, WS_U) + (size_t)tok * D) + lane;
#pragma unroll
        for (int j = 0; j < 4; ++j) { const f32x4 x = xr[64 * j]; const f32x4 sh = *(const f32x4*)(mod + 4 * lane + 256 * j), sc = *(const f32x4*)(mod + 1024 + 4 * lane + 256 * j);
            const f32x4 u = x * (1.0f + sc) + sh;
            ((GAS unsigned long long*)(WS(bf16, WS_XB) + (size_t)tok * D) + lane)[64 * j] = (unsigned long long)pk2(x.x, x.y) | ((unsigned long long)pk2(x.z, x.w) << 32);
#ifdef INPROJ_F8
            ((GAS unsigned*)(WS(unsigned char, WS_U) + (size_t)tok * D) + lane)[64 * j] = pg8::pk4_fp8(u.x, u.y, u.z, u.w, 16.0f); }
#else
            o8[64 * j] = (unsigned long long)pk2(u.x, u.y) | ((unsigned long long)pk2(u.z, u.w) << 32); }
#endif
    }
}
__device__ __forceinline__ void ph_post(int l, int wvx) {
    TIDX;
    const bf16* H = WS(bf16, WS_H); bf16* XKP = WS(bf16, WS_XKP); bf16* QKC = WS(bf16, WS_QKC);
    const float* cw = A->in[I_CONVW] + (size_t)l * 4 * 512; const float* cb = A->in[I_CONVB] + (size_t)l * 512;
    const float gi = A->in[I_IDXG][l * 64 + lane], bi = A->in[I_IDXB][l * 64 + lane];
    float cwr[4][8], cbr[8];
#pragma unroll
    for (int c = 0; c < 8; ++c) { cbr[c] = cb[8 * lane + c];
#pragma unroll
        for (int j = 0; j < 4; ++j) cwr[j][c] = cw[j * 512 + 8 * lane + c]; }
    bf16 nxk = 0; float2 ncs = make_float2(1.f, 0.f); v4u nraw[4];
#define POST_LOAD(tk) do { const int s_ = (tk) % SEQ; nxk = H[(size_t)(tk) * NHC + HC_XK + lane]; ncs = WS(float2, WS_CS)[(size_t)(tk) * 32 + (lane & 31)]; \
        _Pragma("unroll") for (int j = 0; j < 4; ++j) { nraw[j] = (v4u){0u, 0u, 0u, 0u}; if (s_ - 3 + j >= 0) nraw[j] = *(const GAS v4u*)(H + (size_t)((tk) - 3 + j) * NHC + 8 * lane); } } while (0)
    if (gw < T) POST_LOAD(gw);
    for (int tok = gw; tok < T; tok += ngw) {
        const bf16 cxk = nxk; const float2 cs = ncs; v4u craw[4];
#pragma unroll
        for (int j = 0; j < 4; ++j) craw[j] = nraw[j];
        if (tok + ngw < T) POST_LOAD(tok + ngw);
        {
            const float v = bf2f(cxk);
            const float mean = wave_sum(v) * (1.0f / 64.0f); const float dv = v - mean;
            const float var = wave_sum(dv * dv) * (1.0f / 64.0f);
            const float nv = dv * (1.0f / sqrtf(var + LN_EPS)) * gi + bi;
            const float pv = shx(nv, lane, 32);
            const int i = lane & 31;
            const float o = (lane < 32) ? (nv * cs.x - pv * cs.y) : (nv * cs.x + pv * cs.y);
            XKP[(size_t)tok * 64 + 2 * i + (lane >> 5)] = (bf16)f2bf(o);
        }
        {
            const int c0 = 8 * lane;
            float acc[8];
#pragma unroll
            for (int c = 0; c < 8; ++c) acc[c] = cbr[c];
#pragma unroll
            for (int j = 0; j < 4; ++j) {
                const unsigned rw[4] = {craw[j].x, craw[j].y, craw[j].z, craw[j].w};
#pragma unroll
                for (int c = 0; c < 8; ++c) { const float x = __uint_as_float((c & 1) ? (rw[c >> 1] & 0xffff0000u) : (rw[c >> 1] << 16)); acc[c] += cwr[j][c] * x; }
            }
            v4u o;
#define SILU(x) ((x) / (1.0f + __expf(-(x))))
            o.x = pk2(SILU(acc[0]), SILU(acc[1])); o.y = pk2(SILU(acc[2]), SILU(acc[3])); o.z = pk2(SILU(acc[4]), SILU(acc[5])); o.w = pk2(SILU(acc[6]), SILU(acc[7]));
#undef SILU
            *(GAS v4u*)(QKC + (size_t)tok * 512 + c0) = o;
        }
    }
#undef POST_LOAD
}
typedef float f32x16 __attribute__((ext_vector_type(16)));
__device__ __forceinline__ void select_load(const float* SC, int tok, int lane, f32x4 (&raw)[8]);
__device__ __forceinline__ void select_row(const f32x4 (&raw)[8], unsigned* MASK, int tok, int lane);
__device__ __forceinline__ void ph_idx_scores(LAS unsigned char* lds, int wvx) {
    TIDX;
    const bf16* H = WS(bf16, WS_H); const bf16* XKP = WS(bf16, WS_XKP); float* SC = WS(float, WS_SC); unsigned* MASK = WS(unsigned, WS_MASK);
    const int r = lane & 31, hh = lane >> 5, ql = r >> 3, hd = r & 7;
    constexpr int KP = 144;
    LAS unsigned char* kt = lds;
    const int skey = tid >> 3, sch = tid & 7;
    for (int item = bidx; item < 256; item += gsz) {
        const int b = item >> 4, p = item & 15;
#pragma unroll 1
        for (int sub = 0; sub < 2; ++sub) {
            const int qblk = sub ? 31 - p : p, q0 = qblk * 64 + 8 * wave, tok0 = b * SEQ + q0;
            bf16x8 af[2][4];
#pragma unroll
            for (int g = 0; g < 2; ++g) { const bf16* ap = H + (size_t)(tok0 + 4 * g + ql) * NHC + HC_XQ + hd * 64 + 8 * hh;
#pragma unroll
              for (int ks = 0; ks < 4; ++ks) af[g][ks] = *(const GAS bf16x8*)(ap + ks * 16); }
            float wv[2][4][4];
#pragma unroll
            for (int g = 0; g < 2; ++g)
#pragma unroll
                for (int q = 0; q < 4; ++q)
#pragma unroll
                    for (int i = 0; i < 4; ++i) wv[g][q][i] = bf2f(H[(size_t)(tok0 + 4 * g + q) * NHC + HC_XW + 4 * hh + i]);
            const int npair = qblk + 1;
            const bf16* ksrc = XKP + (size_t)(b * SEQ + skey) * 64 + 8 * sch;
            __syncthreads();
            { const v4u t0 = *(const GAS v4u*)ksrc; *(LAS v4u*)(kt + skey * KP + 16 * sch) = t0; }
            v4u stg = (v4u){0u, 0u, 0u, 0u};
            if (npair > 1) stg = *(const GAS v4u*)(ksrc + 4096);
            __syncthreads();
            for (int pr = 0; pr < npair; ++pr) {
                const LAS unsigned char* kb = kt + (pr & 1) * (64 * KP);
                bf16x8 bc[2][4];
#pragma unroll
                for (int t2 = 0; t2 < 2; ++t2)
#pragma unroll
                    for (int ks = 0; ks < 4; ++ks) bc[t2][ks] = *(const LAS bf16x8*)(kb + (32 * t2 + r) * KP + 32 * ks + 16 * hh);
                v4u stg2 = (v4u){0u, 0u, 0u, 0u};
                if (pr + 2 < npair) stg2 = *(const GAS v4u*)(ksrc + (size_t)(pr + 2) * 4096);
#pragma unroll
                for (int t2 = 0; t2 < 2; ++t2) {
                    const int key = pr * 64 + t2 * 32 + r;
#pragma unroll
                    for (int g = 0; g < 2; ++g) {
                        f32x16 acc = {};
                        __builtin_amdgcn_s_setprio(1);
#pragma unroll
                        for (int ks = 0; ks < 4; ++ks) acc = __builtin_amdgcn_mfma_f32_32x32x16_bf16(af[g][ks], bc[t2][ks], acc, 0, 0, 0);
                        __builtin_amdgcn_s_setprio(0);
                        float tot[4];
#pragma unroll
                        for (int q = 0; q < 4; ++q) { float pp = 0.f;
#pragma unroll
                            for (int i = 0; i < 4; ++i) pp += wv[g][q][i] * fmaxf(acc[4 * q + i], 0.f);
                            tot[q] = pp + shx(pp, lane, 32); }
                        const float o0 = hh ? tot[2] : tot[0], o1 = hh ? tot[3] : tot[1];
                        SC[(size_t)(tok0 + 4 * g + 2 * hh) * SEQ + key] = o0; SC[(size_t)(tok0 + 4 * g + 2 * hh + 1) * SEQ + key] = o1;
                    }
                }
                if (pr + 1 < npair) *(LAS v4u*)(kt + ((pr + 1) & 1) * (64 * KP) + skey * KP + 16 * sch) = stg;
                stg = stg2;
                __syncthreads();
            }
            asm volatile("s_waitcnt vmcnt(0)" ::: "memory"); __builtin_amdgcn_fence(__ATOMIC_ACQUIRE, "agent"); asm volatile("s_waitcnt vmcnt(0)" ::: "memory");
            { f32x4 rawc[8], rawn[8]; select_load(SC, tok0, lane, rawc);
#pragma unroll 1
              for (int q = 0; q < 8; ++q) { if (q + 1 < 8) select_load(SC, tok0 + q + 1, lane, rawn);
                  select_row(rawc, MASK, tok0 + q, lane);
#pragma unroll
                  for (int j = 0; j < 8; ++j) rawc[j] = rawn[j]; } }
        }
    }
}
constexpr size_t WS_OD = WS_END;
constexpr size_t WS_END2 = WS_END + 64 * MiB;
__device__ __forceinline__ void ph_diff_attn(LAS unsigned char* lds, int wvx) {
    CArgs* A = kargs();
    const int G = gsz_(), bx = bid_(), vcu = (G % 8 == 0) ? (bx % 8) * (G / 8) + bx / 8 : bx;
    const bf16* H = WS(bf16, WS_H); bf16* OD = WS(bf16, WS_OD);
    for (int item = vcu; item < NB * 16; item += G) {
        const int b = item >> 4, vh = item & 15, g = vh >> 1, half = vh & 1;
#pragma unroll 1
        for (int qb = 7; qb >= 0; --qb)
            attn_body::attn_unit<8, false>(wvx, b, qb, H + HC_DQ + g * 64, H + HC_DK + g * 64, H + HC_DV + (g >> 1) * 128 + half * 64, OD + g * 128 + half * 64, nullptr, (char*)lds);
    }
}
__device__ __forceinline__ void ph_diff_post(int l, int wvx) {
    TIDX;
    const bf16* OD = WS(bf16, WS_OD); bf16* MIX = WS(bf16, WS_MIX);
    const float lam = WS(float, WS_LAM)[l], sc1m = 1.0f - (0.8f - 0.6f * __expf(-0.3f * (float)l));
    const int h = lane >> 4, c0 = (lane & 15) * 8;
    float gv[8];
    { const float* g = A->in[I_DFNORM] + l * 512 + h * 128 + c0;
#pragma unroll
      for (int e = 0; e < 8; ++e) gv[e] = g[e] * sc1m; }
    us8 n1 = {}, n2 = {};
    if (gw < T) { n1 = *(const GAS us8*)(OD + (size_t)gw * D + (2 * h) * 128 + c0); n2 = *(const GAS us8*)(OD + (size_t)gw * D + (2 * h + 1) * 128 + c0); }
    for (int tok = gw; tok < T; tok += ngw) {
        const us8 a1 = n1, a2 = n2;
        if (tok + ngw < T) { n1 = *(const GAS us8*)(OD + (size_t)(tok + ngw) * D + (2 * h) * 128 + c0); n2 = *(const GAS us8*)(OD + (size_t)(tok + ngw) * D + (2 * h + 1) * 128 + c0); }
        float d[8], ss = 0.f;
#pragma unroll
        for (int e = 0; e < 8; ++e) { d[e] = bf2f(a1[e]) - lam * bf2f(a2[e]); ss += d[e] * d[e]; }
        ss += DPPF(ss, 0xB1); ss += DPPF(ss, 0x4E); ss += DPPF(ss, 0x141); ss += DPPF(ss, 0x140);
        const float rs = 1.0f / sqrtf(ss * (1.0f / 128.0f) + LN_EPS);
        v4u o; o.x = pk2(d[0] * rs * gv[0], d[1] * rs * gv[1]); o.y = pk2(d[2] * rs * gv[2], d[3] * rs * gv[3]); o.z = pk2(d[4] * rs * gv[4], d[5] * rs * gv[5]); o.w = pk2(d[6] * rs * gv[6], d[7] * rs * gv[7]);
        *(GAS v4u*)(MIX + (size_t)tok * D + 256 + h * 128 + c0) = o;
    }
}
__device__ __forceinline__ void ph_dsa_attn(LAS unsigned char* lds, int wvx) {
    CArgs* A = kargs();
    const int G = gsz_(), bx = bid_(), vcu = (G % 8 == 0) ? (bx % 8) * (G / 8) + bx / 8 : bx;
    const bf16* H = WS(bf16, WS_H); bf16* MIX = WS(bf16, WS_MIX); const unsigned* MASK = WS(unsigned, WS_MASK);
    for (int item = vcu; item < NB * 4 * 4; item += G) {
        const int bh = item >> 2, p = item & 3, b = bh >> 2, h = bh & 3;
        attn_body::attn_unit<8, true>(wvx, b, 7 - p, H + HC_SQ + h * 64, H + HC_SK + h * 64, H + HC_SV + h * 64, MIX + 768 + h * 64, MASK, (char*)lds);
        attn_body::attn_unit<8, true>(wvx, b, p, H + HC_SQ + h * 64, H + HC_SK + h * 64, H + HC_SV + h * 64, MIX + 768 + h * 64, MASK, (char*)lds);
    }
}
constexpr size_t WS_DC = WS_END2;
constexpr size_t WS_CST = WS_DC + 32 * MiB;
constexpr size_t WS_DN = WS_CST + 32 * MiB;
constexpr size_t WS_END3 = WS_DN + 4 * MiB;
constexpr size_t WS_DUMMY = WS_END3;
constexpr size_t WS_END4 = WS_DUMMY + 256 * MiB;
typedef float f32x2_ __attribute__((ext_vector_type(2)));
constexpr int MP = 68;
__device__ __forceinline__ float log_sigmoid_(float x) { return fminf(x, 0.f) - log1pf(__expf(-fabsf(x))); }
__device__ __forceinline__ void mlstm_gates(bf16 iraw, bf16 fraw, float gbi, float gbf, int lane, LAS float* bcum, LAS float* av) {
    const float ip = bf2f(iraw) + gbi; float lf = log_sigmoid_(bf2f(fraw) + gbf);
#pragma unroll
    for (int o = 1; o < 64; o <<= 1) { const float t_ = shup(lf, lane, o); if (lane >= o) lf += t_; }
    bcum[lane] = lf; av[lane] = ip - lf;
}
constexpr int PB = 72;

__device__ __forceinline__ f32x16 mfma_tile(const LAS bf16* Xa, int mt, const LAS bf16* Xb, int nt, int r, int hh, f32x16 acc) {
#pragma unroll
    for (int ks = 0; ks < 4; ++ks) { const bf16x8 a = *(const LAS bf16x8*)(Xa + (32 * mt + r) * PB + 16 * ks + 8 * hh), b = *(const LAS bf16x8*)(Xb + (32 * nt + r) * PB + 16 * ks + 8 * hh);
        acc = __builtin_amdgcn_mfma_f32_32x32x16_bf16(a, b, acc, 0, 0, 0); }
    return acc;
}
__device__ __forceinline__ void ph_mlstm_m1(LAS unsigned char* lds, int l, int wvx) {
    TIDX;
    const bf16* H = WS(bf16, WS_H); const bf16* QKC = WS(bf16, WS_QKC);
    float* DC = WS(float, WS_DC); float* DN = WS(float, WS_DN); float* SCAL = WS(float, WS_DN + 2 * MiB);
    LAS bf16* kT = (LAS bf16*)lds; LAS bf16* vwT = kT + 64 * PB;
    LAS float* bcum = (LAS float*)(vwT + 96 * PB); LAS float* av = bcum + 64; LAS float* wv = av + 64;
    const int r = lane & 31, hh = lane >> 5, srow = tid >> 3, ch = tid & 7;
    us8 nk = {}, nv_ = {}; bf16 nig = 0, nfg = 0;
#define M1_LOAD(uu) do { const int bh_ = (uu) >> 5, c_ = (uu) & 31, t0_ = (bh_ >> 2) * SEQ + c_ * 64, h_ = bh_ & 3; \
        nk = *(const GAS us8*)(QKC + (size_t)(t0_ + srow) * 512 + 256 + h_ * 64 + 8 * ch); nv_ = *(const GAS us8*)(H + (size_t)(t0_ + srow) * NHC + HC_MV + h_ * 64 + 8 * ch); \
        if (wave == 0) { nig = H[(size_t)(t0_ + lane) * NHC + HC_MI + h_]; nfg = H[(size_t)(t0_ + lane) * NHC + HC_MF + h_]; } } while (0)
    M1_LOAD(bidx);
    for (int u = bidx; u < NB * 4 * 32; u += gsz) {
        const int bh = u >> 5, c = u & 31, b = bh >> 2, h = bh & 3, tok0 = b * SEQ + c * 64; (void)tok0;
        const us8 kraw = nk, vraw = nv_; const bf16 igr = nig, fgr = nfg;
        if (u + gsz < NB * 4 * 32) M1_LOAD(u + gsz);
        if (wave == 0) { mlstm_gates(igr, fgr, A->in[I_GATEB][l * 8 + h], A->in[I_GATEB][l * 8 + 4 + h], lane, bcum, av); LDS_WAIT(); asm volatile("" ::: "memory");
            const float a = av[lane], amax = wave_max(a); wv[lane] = __expf(a - amax); if (lane == 0) { SCAL[u * 4 + 0] = bcum[63]; SCAL[u * 4 + 1] = bcum[63] + amax; } }
        __syncthreads();
        { const float w = wv[srow];
#pragma unroll
          for (int e = 0; e < 8; ++e) { kT[(8 * ch + e) * PB + srow] = kraw[e]; vwT[(8 * ch + e) * PB + srow] = (bf16)f2bf(w * bf2f(vraw[e])); }
          if (tid < 64) vwT[64 * PB + tid] = (bf16)f2bf(wv[tid]);
          for (int i = tid; i < 31 * 64; i += 512) vwT[(65 + i / 64) * PB + (i & 63)] = 0; }
        __syncthreads();
        if (wave < 6) { const int mt = wave >> 1, nt = wave & 1;
            f32x16 acc = {}; acc = mfma_tile(vwT, mt, kT, nt, r, hh, acc);
#pragma unroll
            for (int g = 0; g < 16; ++g) { const int vrow = 32 * mt + (g & 3) + 8 * (g >> 2) + 4 * hh, d = 32 * nt + r;
                if (vrow < 64) DC[(size_t)u * 4096 + vrow * 64 + d] = acc[g]; else if (vrow == 64) DN[(size_t)u * 64 + d] = acc[g]; } }
    }
#undef M1_LOAD
    __syncthreads();
}
__device__ __forceinline__ void ph_mlstm_m2(int wvx) {
    TIDX;
    const float* DC = WS(float, WS_DC); float* CS = WS(float, WS_CST); const float* DN = WS(float, WS_DN); float* NS = WS(float, WS_DN + 1 * MiB); float* SCAL = WS(float, WS_DN + 2 * MiB);
    for (int item = bidx; item < NB * 4 * 4; item += gsz) {
        const int bh = item >> 2, qtr = item & 3, e0 = qtr * 1024 + tid * 2;
        f32x2_ dc[32]; float dn[32];
#pragma unroll
        for (int c = 0; c < 32; ++c) { dc[c] = *(const GAS f32x2_*)(DC + (size_t)(bh * 32 + c) * 4096 + e0); dn[c] = (qtr == 0 && tid < 64) ? DN[(size_t)(bh * 32 + c) * 64 + tid] : 0.f; }
        float z_ = 0.f; asm volatile("" : "+v"(z_));
        float m = 0.f; f32x2_ C = (f32x2_){z_, z_}; float n = z_;
#pragma unroll
        for (int c = 0; c < 32; ++c) {
            const int u = bh * 32 + c;
            const float bl = SCAL[u * 4 + 0], ml = SCAL[u * 4 + 1];
            *(GAS f32x2_*)(CS + (size_t)u * 4096 + e0) = C;
            if (qtr == 0 && tid < 64) NS[(size_t)u * 64 + tid] = n;
            if (qtr == 0 && tid == 0) SCAL[u * 4 + 2] = m;
            const float mn = fmaxf(bl + m, ml), f1 = __expf(bl + m - mn), f2 = __expf(ml - mn);
            C.x = f1 * C.x + f2 * dc[c].x; C.y = f1 * C.y + f2 * dc[c].y;
            n = f1 * n + f2 * dn[c];
            m = mn;
        }
    }
}
__device__ __forceinline__ void ph_mlstm_m3(LAS unsigned char* lds, int l, int wvx) {
    TIDX;
    const bf16* H = WS(bf16, WS_H); const bf16* QKC = WS(bf16, WS_QKC); bf16* MIX = WS(bf16, WS_MIX);
    const float* CS = WS(float, WS_CST); const float* NS = WS(float, WS_DN + 1 * MiB); const float* SCAL = WS(float, WS_DN + 2 * MiB);
    LAS bf16* qS = (LAS bf16*)lds; LAS bf16* kS = qS + 64 * PB; LAS bf16* vT = kS + 64 * PB; LAS bf16* cT = vT + 96 * PB; LAS bf16* Sb = cT + 96 * PB;
    LAS float* hS = (LAS float*)(Sb + 64 * PB);
    LAS float* bcum = hS + 64 * MP; LAS float* av = bcum + 64; LAS float* mm = av + 64; LAS float* inter = mm + 64; LAS float* dinv = inter + 64;
    const int r = lane & 31, hh = lane >> 5, srow = tid >> 3, ch = tid & 7;
    us8 nq = {}, nk = {}, nv_ = {}; f32x4 nc0 = {}, nc1 = {}; bf16 nog[8] = {}; bf16 nig = 0, nfg = 0; float nns = 0.f, nmc = 0.f;
#define M3_LOAD(uu) do { const int bh_ = (uu) >> 5, c_ = (uu) & 31, t0_ = (bh_ >> 2) * SEQ + c_ * 64, h_ = bh_ & 3; \
        nq = *(const GAS us8*)(QKC + (size_t)(t0_ + srow) * 512 + h_ * 64 + 8 * ch); nk = *(const GAS us8*)(QKC + (size_t)(t0_ + srow) * 512 + 256 + h_ * 64 + 8 * ch); \
        nv_ = *(const GAS us8*)(H + (size_t)(t0_ + srow) * NHC + HC_MV + h_ * 64 + 8 * ch); \
        nc0 = *(const GAS f32x4*)(CS + (size_t)(uu) * 4096 + srow * 64 + 8 * ch); nc1 = *(const GAS f32x4*)(CS + (size_t)(uu) * 4096 + srow * 64 + 8 * ch + 4); \
        _Pragma("unroll") for (int j = 0; j < 8; ++j) nog[j] = H[(size_t)(t0_ + wave + 8 * j) * NHC + HC_MO + h_ * 64 + lane]; \
        nmc = SCAL[(uu) * 4 + 2]; if (tid < 64) nns = NS[(size_t)(uu) * 64 + tid]; \
        if (wave == 0) { nig = H[(size_t)(t0_ + lane) * NHC + HC_MI + h_]; nfg = H[(size_t)(t0_ + lane) * NHC + HC_MF + h_]; } } while (0)
    M3_LOAD(bidx);
    for (int u = bidx; u < NB * 4 * 32; u += gsz) {
        const int bh = u >> 5, c = u & 31, b = bh >> 2, h = bh & 3, tok0 = b * SEQ + c * 64;
        const float mc = nmc, nsv = nns;
        bf16 ograw[8];
#pragma unroll
        for (int j = 0; j < 8; ++j) ograw[j] = nog[j];
        const float gnorm = A->in[I_MNORM][l * 256 + h * 64 + lane];
        const us8 qraw = nq, kraw = nk, vraw = nv_; const f32x4 c0 = nc0, c1 = nc1; const bf16 igr = nig, fgr = nfg;
        if (u + gsz < NB * 4 * 32) M3_LOAD(u + gsz);
        {
            us8 qs;
#pragma unroll
            for (int e = 0; e < 8; ++e) qs[e] = (bf16)f2bf(bf2f(qraw[e]) * 0.125f);
            *(LAS us8*)(qS + srow * PB + 8 * ch) = qs; *(LAS us8*)(kS + srow * PB + 8 * ch) = kraw;
#pragma unroll
            for (int e = 0; e < 8; ++e) vT[(8 * ch + e) * PB + srow] = vraw[e];
            v4u cp; cp.x = pk2(c0[0], c0[1]); cp.y = pk2(c0[2], c0[3]); cp.z = pk2(c1[0], c1[1]); cp.w = pk2(c1[2], c1[3]);
            *(LAS v4u*)(cT + srow * PB + 8 * ch) = cp;
            if (tid < 64) { vT[64 * PB + tid] = (bf16)0x3f80; cT[64 * PB + tid] = (bf16)f2bf(nsv); }
            for (int i = tid; i < 31 * 64; i += 512) { vT[(65 + i / 64) * PB + (i & 63)] = 0; cT[(65 + i / 64) * PB + (i & 63)] = 0; }
        }
        if (wave == 0) { mlstm_gates(igr, fgr, A->in[I_GATEB][l * 8 + h], A->in[I_GATEB][l * 8 + 4 + h], lane, bcum, av); LDS_WAIT(); asm volatile("" ::: "memory");
            float pm = av[lane];
#pragma unroll
            for (int o = 1; o < 64; o <<= 1) { const float t_ = shup(pm, lane, o); if (lane >= o) pm = fmaxf(pm, t_); }
            const float m_ = fmaxf(mc, pm); mm[lane] = m_; inter[lane] = __expf(mc - m_); }
        __syncthreads();
        if (wave < 4) { const int tt = wave >> 1, st = wave & 1;
            f32x16 acc = {}; acc = mfma_tile(qS, tt, kS, st, r, hh, acc);
            const int s = 32 * st + r; const float as = av[s];
#pragma unroll
            for (int g = 0; g < 16; ++g) { const int t = 32 * tt + (g & 3) + 8 * (g >> 2) + 4 * hh;
                const float val = (s <= t) ? acc[g] * __expf(as - mm[t]) : 0.f; Sb[t * PB + s] = (bf16)f2bf(val); } }
        __syncthreads();
        f32x16 aS = {}, aC = {}; const int tt = (wave < 6) ? wave / 3 : 0, nt = (wave < 6) ? wave % 3 : 0;
        if (wave < 6) { aS = mfma_tile(Sb, tt, vT, nt, r, hh, aS); aC = mfma_tile(qS, tt, cT, nt, r, hh, aC); }
        if (wave < 6 && nt == 2 && r == 0) {
#pragma unroll
            for (int g = 0; g < 16; ++g) { const int t = 32 * tt + (g & 3) + 8 * (g >> 2) + 4 * hh;
                const float dn = aS[g] + inter[t] * aC[g]; dinv[t] = 1.0f / fmaxf(fabsf(dn), __expf(-(bcum[t] + mm[t]))); } }
        if (wave < 6 && nt < 2) {
#pragma unroll
            for (int g = 0; g < 16; ++g) { const int t = 32 * tt + (g & 3) + 8 * (g >> 2) + 4 * hh;
                hS[t * MP + 32 * nt + r] = aS[g] + inter[t] * aC[g]; } }
        __syncthreads();
#pragma unroll
        for (int j = 0; j < 8; ++j) { const int t = wave + 8 * j, vc = lane; const size_t tk = (size_t)(tok0 + t);
            const float hv = hS[t * MP + vc] * dinv[t];
            const float mean = wave_sum(hv) * (1.0f / 64.0f), hc = hv - mean;
            const float rs = 1.0f / sqrtf(wave_sum(hc * hc) * (1.0f / 64.0f) + LN_EPS);
            const float og = sigmoidf_(bf2f(ograw[j]));
            MIX[tk * D + h * 64 + vc] = (bf16)f2bf(og * (hc * rs * gnorm)); }
    }
#undef M3_LOAD
    __syncthreads();
}
__device__ __forceinline__ int wave_sum_i(int x) {
    x += __builtin_amdgcn_update_dpp(0, x, 0xB1, 0xF, 0xF, true);
    x += __builtin_amdgcn_update_dpp(0, x, 0x4E, 0xF, 0xF, true);
    x += __builtin_amdgcn_update_dpp(0, x, 0x141, 0xF, 0xF, true);
    x += __builtin_amdgcn_update_dpp(0, x, 0x140, 0xF, 0xF, true);
    return __builtin_amdgcn_readlane(x, 0) + __builtin_amdgcn_readlane(x, 16) + __builtin_amdgcn_readlane(x, 32) + __builtin_amdgcn_readlane(x, 48);
}
__device__ __forceinline__ void select_load(const float* SC, int tok, int lane, f32x4 (&raw)[8]) {
    const int tl = tok % SEQ, lo = 32 * lane; const bool need = (tl >= 256) && (tl + 1 - lo > 0);
#pragma unroll
    for (int j = 0; j < 8; ++j) { raw[j] = (f32x4){0.f, 0.f, 0.f, 0.f}; if (need) raw[j] = *(const GAS f32x4*)(SC + (size_t)tok * SEQ + lo + 4 * j); }
}
__device__ __forceinline__ void select_row(const f32x4 (&raw)[8], unsigned* MASK, int tok, int lane) {
        const int tl = tok % SEQ, lo = 32 * lane;
        const int nv = min(max(tl + 1 - lo, 0), 32);
        unsigned cand = (nv >= 32) ? 0xffffffffu : ((1u << nv) - 1u);
        if (tl < 256) { MASK[(size_t)tok * 64 + lane] = cand; return; }
        unsigned a[32];
#pragma unroll
        for (int j = 0; j < 8; ++j) {
            const f32x4 v = raw[j];
#pragma unroll
            for (int c = 0; c < 4; ++c) { const unsigned u = __float_as_uint(v[c] + 0.0f);
                a[4 * j + c] = u ^ ((unsigned)((int)u >> 31) | 0x80000000u); }
        }
#define TSTAGE(J, M) _Pragma("unroll") for (int k0 = 0; k0 < 32; ++k0) { if ((k0 & J) == 0) { const unsigned x_ = a[k0], y_ = a[k0 + J];   \
            a[k0] = ((y_ << J) & ((M) << J)) | (x_ & ~((M) << J)); a[k0 + J] = ((x_ >> J) & (M)) | (y_ & ~(M)); } }
#define PSTAGE(J, SA, SB) _Pragma("unroll") for (int k0 = 0; k0 < 32; ++k0) { if ((k0 & J) == 0) { const unsigned x_ = a[k0], y_ = a[k0 + J]; a[k0] = __builtin_amdgcn_perm(y_, x_, SA); a[k0 + J] = __builtin_amdgcn_perm(y_, x_, SB); } }
        PSTAGE(16, 0x05040100u, 0x07060302u) PSTAGE(8, 0x06020400u, 0x07030501u) TSTAGE(4, 0x0F0F0F0Fu) TSTAGE(2, 0x33333333u) TSTAGE(1, 0x55555555u)
#undef PSTAGE
#undef TSTAGE
        unsigned sel = 0u; int need = 256, ncand = tl + 1;
#pragma unroll
        for (int b = 31; b >= 0; --b) {
            if (ncand != need) {
                const unsigned hit = cand & a[b];
                const int cnt = wave_sum_i(__popc(hit));
                if (cnt >= need) { cand = hit; ncand = cnt; }
                else { sel |= hit; cand &= ~a[b]; need -= cnt; ncand -= cnt; }
            }
        }
        if (ncand == need) sel |= cand;
        else {
            const int my = __popc(cand); int incl = my;
#pragma unroll
            for (int o = 1; o < 64; o <<= 1) { const int t_ = shupi(incl, lane, o); if (lane >= o) incl += t_; }
            const int take = min(max(need - (incl - my), 0), my); int taken = 0;
#pragma unroll 1
            for (int k = 0; k < 32; ++k) { if (((cand >> k) & 1u) && taken < take) { sel |= 1u << k; ++taken; } }
        }
        MASK[(size_t)tok * 64 + lane] = sel;
}
constexpr int R1_OFF = RING_BYTES + 8192;
__device__ __forceinline__ void ph_row1(LAS unsigned char* lds, int l, int wvx, bool dry = false) {
    TIDX;
    const bf16* xin = WS(bf16, WS_XB); bf16* XB = dry ? WS(bf16, WS_DUMMY) : WS(bf16, WS_XB);
    const bf16* Y = WS(bf16, WS_Y); bf16* U = dry ? WS(bf16, WS_DUMMY + 128 * MiB) : WS(bf16, WS_U);
    unsigned* cnt = dry ? WS(unsigned, WS_DUMMY + 200 * MiB) : WS(unsigned, WS_CTL) + CW_CNT + l * NEXP * 64; unsigned* TOK = dry ? WS(unsigned, WS_DUMMY + 192 * MiB) : WS(unsigned, WS_TOK);
    unsigned* RMAP = dry ? WS(unsigned, WS_DUMMY + 208 * MiB) : WS(unsigned, WS_XG);
    constexpr int RWP = 1032;
    LAS bf16* rw = (LAS bf16*)lds; LAS bf16* UT = rw + 32 * RWP; LAS float* PT = (LAS float*)(UT + 16 * RWP); LAS float* LG = PT + 8 * 16 * 33; LAS float* TP = LG + 16 * 33; LAS float* VT = TP + 64;
    static_assert((32 * RWP + 16 * RWP) * 2 + (8 * 16 * 33 + 16 * 33 + 64 + 5 * 1024) * 4 <= R1_OFF, "row1 LDS map");
    LAS unsigned* lcnt = (LAS unsigned*)(lds + R1_OFF); LAS unsigned* lbase = lcnt + 32; LAS unsigned* nrec = lbase + 32; LAS unsigned* rec = nrec + 4;
    { const GAS f32x4* src = (const GAS f32x4*)(WS(float, WS_RWT) + (size_t)l * NEXP * D);
      f32x4 w4[16];
#pragma unroll
      for (int q = 0; q < 16; ++q) w4[q] = src[tid + 512 * q];
#pragma unroll
      for (int q = 0; q < 16; ++q) { const int i = tid + 512 * q, e_ = i >> 8, c_ = (i & 255) * 4; *(LAS unsigned long long*)(rw + e_ * RWP + c_) = (unsigned long long)pk2(w4[q].x * 0.0625f, w4[q].y * 0.0625f) | ((unsigned long long)pk2(w4[q].z * 0.0625f, w4[q].w * 0.0625f) << 32); } }
    const float rbias = A->in[I_RB][l * NEXP + (tid & 31)];
    for (int chunk = bidx; chunk < T / 128; chunk += gsz) {
        const int cb = (chunk * 128) / SEQ; const float* mod = WS(float, WS_MOD) + ((size_t)l * NB + cb) * 6144;
        __syncthreads();
        for (int i = tid; i < 5 * 256; i += 512) { const int vsel = i >> 8, c4 = (i & 255) * 4;
            const float* sp = vsel == 0 ? mod + 2048 : vsel == 1 ? mod + 4096 : vsel == 2 ? mod + 3072 : vsel == 3 ? A->in[I_LN1G] + l * D : A->in[I_LN1B] + l * D;
            *(LAS f32x4*)(VT + vsel * 1024 + c4) = (*(const GAS f32x4*)(sp + c4) + (vsel < 2 ? 1.0f : 0.0f)) * ((vsel == 1 || vsel == 2) ? 16.0f : 1.0f); }
        if (tid < 32) lcnt[tid] = 0u; if (tid == 32) nrec[0] = 0u;
        __syncthreads();
        const int tbase = chunk * 128 + 2 * wave;
        unsigned long long px[2][4], py[2][4];
#define R1_LOAD(t, tk) do { _Pragma("unroll") for (int j = 0; j < 4; ++j) { const int c = 4 * lane + 256 * j; \
            px[t][j] = *(const GAS unsigned long long*)(xin + (size_t)(tk) * D + c); py[t][j] = *(const GAS unsigned long long*)(Y + (size_t)(tk) * D + c); } } while (0)
        R1_LOAD(0, tbase); R1_LOAD(1, tbase + 1);
#pragma unroll 1
        for (int it_ = 0; it_ < 8; ++it_) {
#pragma unroll
            for (int t = 0; t < 2; ++t) {
                const int tok = tbase + 16 * it_ + t;
                f32x4 v[4]; float s = 0.f;
#pragma unroll
                for (int j = 0; j < 4; ++j) { const int c = 4 * lane + 256 * j;
                    const unsigned long long xr = px[t][j]; const f32x4 g1 = *(const LAS f32x4*)(VT + c);
                    f32x4 x; x.x = __uint_as_float((unsigned)xr << 16); x.y = __uint_as_float((unsigned)xr & 0xffff0000u); x.z = __uint_as_float((unsigned)(xr >> 32) << 16); x.w = __uint_as_float((unsigned)(xr >> 32) & 0xffff0000u);
                    const unsigned long long yr = py[t][j];
                    f32x4 y; y.x = __uint_as_float((unsigned)yr << 16); y.y = __uint_as_float((unsigned)yr & 0xffff0000u); y.z = __uint_as_float((unsigned)(yr >> 32) << 16); y.w = __uint_as_float((unsigned)(yr >> 32) & 0xffff0000u);
                    v[j] = x * DN_ALPHA + g1 * y; s += (v[j].x + v[j].y) + (v[j].z + v[j].w); }
                if (it_ + 1 < 8) R1_LOAD(t, tok + 16);
                const float mean = wave_sum(s) * (1.0f / D); float s2 = 0.f;
#pragma unroll
                for (int j = 0; j < 4; ++j) { v[j] = v[j] - mean; s2 += (v[j].x * v[j].x + v[j].y * v[j].y) + (v[j].z * v[j].z + v[j].w * v[j].w); }
                const float rstd = 1.0f / sqrtf(wave_sum(s2) * (1.0f / D) + LN_EPS);
#pragma unroll
                for (int j = 0; j < 4; ++j) { const int c = 4 * lane + 256 * j;
                    const f32x4 xn = v[j] * rstd * *(const LAS f32x4*)(VT + 3072 + c) + *(const LAS f32x4*)(VT + 4096 + c);
                    *(GAS unsigned long long*)(XB + (size_t)tok * D + c) = (unsigned long long)pk2(xn.x, xn.y) | ((unsigned long long)pk2(xn.z, xn.w) << 32);
                    const f32x4 u2 = xn * *(const LAS f32x4*)(VT + 1024 + c) + *(const LAS f32x4*)(VT + 2048 + c);
                    *(GAS unsigned*)((unsigned char*)U + (size_t)tok * D + c) = pg8::pk4_fp8(u2.x, u2.y, u2.z, u2.w, 1.0f);
                    *(LAS unsigned long long*)(UT + (2 * wave + t) * RWP + c) = (unsigned long long)pk2(u2.x, u2.y) | ((unsigned long long)pk2(u2.z, u2.w) << 32); }
            }
            __syncthreads();
            { const int fr = lane & 15, fq = lane >> 4;
              f32x4 pacc[2] = {(f32x4){0.f, 0.f, 0.f, 0.f}, (f32x4){0.f, 0.f, 0.f, 0.f}};
#pragma unroll
              for (int ks = 0; ks < 4; ++ks) { const int k0 = 128 * wave + 32 * ks + 8 * fq;
                  const bf16x8 a = *(const LAS bf16x8*)(UT + fr * RWP + k0);
#pragma unroll
                  for (int n = 0; n < 2; ++n) { const bf16x8 b = *(const LAS bf16x8*)(rw + (16 * n + fr) * RWP + k0); pacc[n] = __builtin_amdgcn_mfma_f32_16x16x32_bf16(a, b, pacc[n], 0, 0, 0); } }
#pragma unroll
              for (int n = 0; n < 2; ++n)
#pragma unroll
                  for (int g = 0; g < 4; ++g) PT[(wave * 16 + 4 * fq + g) * 33 + 16 * n + fr] = pacc[n][g]; }
            __syncthreads();
            {
                const int slot = tid >> 5, ex = tid & 31;
                float lg_ = rbias;
#pragma unroll
                for (int w = 0; w < 8; ++w) lg_ += PT[(w * 16 + slot) * 33 + ex];
                LG[slot * 33 + ex] = lg_;
                LDS_WAIT(); asm volatile("" ::: "memory");
                int rank = 0;
#pragma unroll
                for (int j = 0; j < 32; ++j) { const float lj = LG[slot * 33 + j]; rank += (lj > lg_ || (lj == lg_ && j < ex)) ? 1 : 0; }
                if (rank < 4) TP[slot * 4 + rank] = lg_;
                LDS_WAIT(); asm volatile("" ::: "memory");
                const int tok = chunk * 128 + 16 * it_ + slot;
                if (rank < 4) {
                    const float t0 = TP[slot * 4], e1 = __expf(TP[slot * 4 + 1] - t0), e2 = __expf(TP[slot * 4 + 2] - t0), e3 = __expf(TP[slot * 4 + 3] - t0);
                    const float pk = __expf(lg_ - t0) / (1.0f + e1 + e2 + e3);
                    const unsigned lp = __hip_atomic_fetch_add(lcnt + ex, 1u, __ATOMIC_RELAXED, __HIP_MEMORY_SCOPE_WORKGROUP);
                    const unsigned ri = __hip_atomic_fetch_add(nrec, 1u, __ATOMIC_RELAXED, __HIP_MEMORY_SCOPE_WORKGROUP);
                    if (ri < 600u) { LAS unsigned* rr = rec + ri * 3; rr[0] = (unsigned)tok * 4u + (unsigned)rank; rr[1] = (unsigned)ex | (lp << 8); rr[2] = __float_as_uint(pk); } }
            }
        }
#undef R1_LOAD
        __syncthreads();
        if (tid < 32) lbase[tid] = __hip_atomic_fetch_add(cnt + tid * 64, lcnt[tid], __ATOMIC_RELAXED, __HIP_MEMORY_SCOPE_AGENT);
        __syncthreads();
        { const int n = (int)min(nrec[0], 600u);
          for (int i = tid; i < n; i += 512) { const unsigned r0 = rec[i * 3], r1 = rec[i * 3 + 1], r2 = rec[i * 3 + 2]; const unsigned ek = r1 & 255u;
              const unsigned pos = (dry ? 0u : lbase[ek]) + (r1 >> 8);
              *(GAS v4u*)(TOK + (size_t)r0 * 4) = (v4u){ek, pos, r2, 0u}; RMAP[(size_t)ek * T + pos] = r0 >> 2; } }
    }
    __syncthreads();
}
__device__ __forceinline__ int moe_tables(LAS unsigned char* lds, int l, int wvx) {
    CArgs* A = kargs();
    LAS unsigned* base = (LAS unsigned*)(lds + TAB_OFF); LAS unsigned char* tile_e = lds + TAB_OFF + 256; LAS unsigned* cntl = (LAS unsigned*)(lds + TAB_OFF + 1024);
    const unsigned* cnt = WS(unsigned, WS_CTL) + CW_CNT + l * NEXP * 64;
    if (wvx == 0) {
        const int lane = lane_id_(), e = lane & 31;
        const unsigned c = __hip_atomic_load(cnt + e * 64, __ATOMIC_RELAXED, __HIP_MEMORY_SCOPE_AGENT);
        const int nt = (int)((c + 255u) >> 8); int incl = nt;
#pragma unroll
        for (int o = 1; o < 32; o <<= 1) { const int t_ = shupi(incl, lane, o); if (e >= o) incl += t_; }
        if (lane < 32) { const int t0 = incl - nt; base[e] = (unsigned)t0 << 8; cntl[e] = c; if (e == 31) base[NEXP] = (unsigned)incl << 8;
#pragma unroll 1
            for (int t = 0; t < nt; ++t) tile_e[t0 + t] = (unsigned char)e; }
    }
    __syncthreads();
    return (int)(base[NEXP] >> 8);
}
__device__ __forceinline__ void ph_row2(LAS unsigned char* lds, int l, int wvx, bool dry = false) {
    TIDX;
    const LAS unsigned* base = (const LAS unsigned*)(lds + TAB_OFF);
    bf16* XB = WS(bf16, WS_XB); const bf16* YM = WS(bf16, WS_YM); bf16* U = WS(bf16, WS_U); const unsigned* TOK = WS(unsigned, WS_TOK);
    const bool fin = (l == DEPTH - 1); float* dstf = dry ? WS(float, WS_DUMMY) : A->out; bf16* dstb = dry ? WS(bf16, WS_DUMMY) : XB; bf16* Uw = dry ? WS(bf16, WS_DUMMY + 128 * MiB) : U;
    LAS bf16* b2l = (LAS bf16*)lds; LAS float* VT = (LAS float*)(lds + 65536);
    { const GAS f32x4* src = (const GAS f32x4*)(A->in[I_B2] + (size_t)l * NEXP * D); f32x4 w4[16];
#pragma unroll
      for (int q = 0; q < 16; ++q) w4[q] = src[tid + 512 * q];
#pragma unroll
      for (int q = 0; q < 16; ++q) *(LAS unsigned long long*)(b2l + (size_t)(tid + 512 * q) * 4) = (unsigned long long)pk2(w4[q].x, w4[q].y) | ((unsigned long long)pk2(w4[q].z, w4[q].w) << 32); }
    for (int chunk = bidx; chunk < T / 128; chunk += gsz) {
        const int cb = (chunk * 128) / SEQ; const float* mod = WS(float, WS_MOD) + ((size_t)l * NB + cb) * 6144; const float* modn = WS(float, WS_MOD) + ((size_t)(l + 1 < DEPTH ? l + 1 : l) * NB + cb) * 6144;
        __syncthreads();
        for (int i = tid; i < 5 * 256; i += 512) { const int vsel = i >> 8, c4 = (i & 255) * 4;
            const float* sp = vsel == 0 ? mod + 5120 : vsel == 1 ? modn + 1024 : vsel == 2 ? modn : vsel == 3 ? A->in[I_LN2G] + l * D : A->in[I_LN2B] + l * D;
            *(LAS f32x4*)(VT + vsel * 1024 + c4) = *(const GAS f32x4*)(sp + c4) + (vsel < 2 ? 1.0f : 0.0f); }
        __syncthreads();
        const int tb0 = chunk * 128 + wave;
        LAS v4u* RC = (LAS v4u*)(lds + 65536 + 20480) + wave * 64;
        RC[lane] = *(const GAS v4u*)(TOK + ((size_t)(tb0 + 8 * (lane >> 2)) * 4 + (lane & 3)) * 4);
        LDS_WAIT(); asm volatile("" ::: "memory");
        unsigned yq[4][4][4]; unsigned long long xq[4][4];
#define R2_ROWS(S, ti) do { _Pragma("unroll") for (int k = 0; k < 4; ++k) { const v4u rc_ = RC[(ti) * 4 + k]; const size_t row_ = (size_t)base[rc_.x] + rc_.y; \
            _Pragma("unroll") for (int j = 0; j < 4; ++j) yq[S][k][j] = *(const GAS unsigned*)((const unsigned char*)YM + row_ * D + 4 * lane + 256 * j); } \
            _Pragma("unroll") for (int j = 0; j < 4; ++j) xq[S][j] = *(const GAS unsigned long long*)(XB + (size_t)(tb0 + 8 * (ti)) * D + 4 * lane + 256 * j); } while (0)
#define R2_BODY(S, ti) do { const int it_ = (ti); const int tok = tb0 + 8 * it_; \
            if (it_ + 3 < 16) R2_ROWS(((S) + 3) & 3, it_ + 3); \
            f32x4 acc[4]; \
            _Pragma("unroll") for (int j = 0; j < 4; ++j) acc[j] = (f32x4){0.f, 0.f, 0.f, 0.f}; \
            _Pragma("unroll") for (int k = 0; k < 4; ++k) { const v4u rc_ = RC[it_ * 4 + k]; const float p = __uint_as_float(rc_.z), p64 = p * (1.0f / 64.0f); \
                _Pragma("unroll") for (int j = 0; j < 4; ++j) { const int c = 4 * lane + 256 * j; const unsigned yr = yq[S][k][j]; \
                    typedef float f32x2v_ __attribute__((ext_vector_type(2))); const f32x2v_ ylo = __builtin_amdgcn_cvt_pk_f32_fp8(yr, false), yhi = __builtin_amdgcn_cvt_pk_f32_fp8(yr, true); \
                    const f32x4 y = (f32x4){ylo.x, ylo.y, yhi.x, yhi.y};        \
                    const unsigned long long bq = *(const LAS unsigned long long*)(b2l + rc_.x * D + c); \
                    f32x4 bb; bb.x = __uint_as_float((unsigned)bq << 16); bb.y = __uint_as_float((unsigned)bq & 0xffff0000u); bb.z = __uint_as_float((unsigned)(bq >> 32) << 16); bb.w = __uint_as_float((unsigned)(bq >> 32) & 0xffff0000u); \
                    acc[j] = acc[j] + p64 * y + p * bb; } } \
            f32x4 v[4]; float s = 0.f; \
            _Pragma("unroll") for (int j = 0; j < 4; ++j) { const int c = 4 * lane + 256 * j; const unsigned long long xr = xq[S][j]; f32x4 x; \
                x.x = __uint_as_float((unsigned)xr << 16); x.y = __uint_as_float((unsigned)xr & 0xffff0000u); x.z = __uint_as_float((unsigned)(xr >> 32) << 16); x.w = __uint_as_float((unsigned)(xr >> 32) & 0xffff0000u); \
                v[j] = x * DN_ALPHA + *(const LAS f32x4*)(VT + c) * acc[j]; s += (v[j].x + v[j].y) + (v[j].z + v[j].w); } \
            const float mean = wave_sum(s) * (1.0f / D); float s2 = 0.f; \
            _Pragma("unroll") for (int j = 0; j < 4; ++j) { v[j] = v[j] - mean; s2 += (v[j].x * v[j].x + v[j].y * v[j].y) + (v[j].z * v[j].z + v[j].w * v[j].w); } \
            const float rstd = 1.0f / sqrtf(wave_sum(s2) * (1.0f / D) + LN_EPS); \
            _Pragma("unroll") for (int j = 0; j < 4; ++j) { const int c = 4 * lane + 256 * j; \
                const f32x4 xn = v[j] * rstd * *(const LAS f32x4*)(VT + 3072 + c) + *(const LAS f32x4*)(VT + 4096 + c); \
                if (fin) *(GAS f32x4*)(dstf + (size_t)tok * D + c) = xn; else *(GAS unsigned long long*)(dstb + (size_t)tok * D + c) = (unsigned long long)pk2(xn.x, xn.y) | ((unsigned long long)pk2(xn.z, xn.w) << 32); \
                if (l + 1 < DEPTH) { const f32x4 u = xn * *(const LAS f32x4*)(VT + 1024 + c) + *(const LAS f32x4*)(VT + 2048 + c); \
                    R2_USTORE(u); } } } while (0)
#ifdef INPROJ_F8
#define R2_USTORE(u) *(GAS unsigned*)((unsigned char*)Uw + (size_t)tok * D + c) = pg8::pk4_fp8(u.x, u.y, u.z, u.w, 16.0f)
#else
#define R2_USTORE(u) *(GAS unsigned long long*)(Uw + (size_t)tok * D + c) = (unsigned long long)pk2(u.x, u.y) | ((unsigned long long)pk2(u.z, u.w) << 32)
#endif
        R2_ROWS(0, 0); R2_ROWS(1, 1); R2_ROWS(2, 2);
#pragma unroll 1
        for (int it4 = 0; it4 < 16; it4 += 4) { R2_BODY(0, it4); R2_BODY(1, it4 + 1); R2_BODY(2, it4 + 2); R2_BODY(3, it4 + 3); }
#undef R2_BODY
#undef R2_USTORE
#undef R2_ROWS
    }
    __syncthreads();
}
__global__ void __launch_bounds__(NWAVES * 64, 2) mega_fwd(Args A_) {
    extern __shared__ __attribute__((aligned(16))) unsigned char lds_raw[];
    LAS unsigned char* lds = (LAS unsigned char*)lds_raw;
    const int tid = threadIdx.x; const int wv0 = __builtin_amdgcn_readfirstlane(tid >> 6);
    volatile LAS unsigned* MISC = (volatile LAS unsigned*)(lds + MISC_OFF);
    for (int u = tid; u < (LDS_BYTES - TAB_OFF) / 4; u += NWAVES * 64) ((LAS unsigned*)(lds + TAB_OFF))[u] = 0u;
    __syncthreads();
    CArgs* A = kargs(); const bool multi = (A->s_hi - A->s_lo) > 1;
    if (multi) (void)xcd_barrier_post(WS(unsigned, WS_CTL) + CW_BAR + A->li * XCD_BAR_WORDS, MISC + 8);
    const int lo = A->s_lo, hi = A->s_hi;
#ifndef PHMASK
#define PHMASK 0xffffffffu
#endif
#define PHM(b) (((PHMASK) >> (b)) & 1u)
#ifndef RPTMASK
#define RPTMASK 0u
#endif
#define RPT(b) _Pragma("unroll 1") for (int rep_ = 0; rep_ < ((((RPTMASK) >> (b)) & 1u) ? 2 : 1); ++rep_)
#define RUN(s) (lo <= (s) && (s) < hi)
#ifdef BAR2
#define BAR2X(A_) xcd_barrier_fn((unsigned*)(A_->ws + WS_CTL) + CW_BAR + A_->li * XCD_BAR_WORDS, xb_xcc_id(), (volatile LAS unsigned*)(lds_launder(lds) + MISC_OFF) + 8, tid_of(wv0) == 0)
#else
#define BAR2X(A_) do {} while (0)
#endif
#define SEAM(s) do { if ((s) + 1 < hi) { CArgs* A_ = kargs(); xcd_barrier_fn((unsigned*)(A_->ws + WS_CTL) + CW_BAR + A_->li * XCD_BAR_WORDS, xb_xcc_id(), (volatile LAS unsigned*)(lds_launder(lds) + MISC_OFF) + 8, tid_of(wv0) == 0); BAR2X(A_); } } while (0)
    if (RUN(0)) { if (PHM(0)) RPT(0) pro_a(lds_launder(lds), wv0); SEAM(0); }
    if (RUN(1)) { if (PHM(1)) RPT(1) pro_b(wv0); SEAM(1); }
    for (int l = 0; l < DEPTH; ++l) {
        const int sb = 2 + NPH * l;
        if (RUN(sb + PH_IN)) { CArgs* A = kargs();
#ifdef INPROJ_F8
            pg8::Gemm g{WS(bf16, WS_U), (const bf16*)(WS(unsigned char, WS_WIN) + (size_t)l * NHC * D), T, NHC, D / 2}; pg8::StaticOrder S; S.init(T, NHC, gsz_(), bid_());
            pg8::EpiIn E{WS(bf16, WS_H), WS(unsigned, WS_CS16), 1.0f / 4096.0f};
            if (PHM(2)) RPT(2) pg8::gemm_phase<pg8::EpiIn, pg8::StaticOrder, true, true, pg8::DirectA, true>(lds_launder(lds), wv0, g, S, E, pg8::DirectA(), 0, 0);
#else
            pg8::Gemm g{WS(bf16, WS_U), WS(bf16, WS_WIN) + (size_t)l * NHC * D, T, NHC, D}; pg8::StaticOrder S; S.init(T, NHC, gsz_(), bid_());
            pg8::EpiIn E{WS(bf16, WS_H), WS(unsigned, WS_CS16), 1.0f};
            if ((RPTMASK >> 22) & 1u) pg8::gemm_phase<pg8::EpiNull, pg8::StaticOrder, true, true>(lds_launder(lds), wv0, g, S, pg8::EpiNull());
            if (PHM(2)) RPT(2) pg8::gemm_phase<pg8::EpiIn, pg8::StaticOrder, true, true>(lds_launder(lds), wv0, g, S, E);
#endif
            SEAM(sb + PH_IN);
        }
        if (RUN(sb + PH_POST)) { if (PHM(3)) RPT(3) ph_post(l, wv0); SEAM(sb + PH_POST); }
        if (RUN(sb + PH_MIXA)) { if (PHM(6)) RPT(6) ph_diff_attn(lds_launder(lds), wv0); if (PHM(5)) RPT(16) ph_mlstm_m1(lds_launder(lds), l, wv0); if (PHM(4)) RPT(4) ph_idx_scores(lds_launder(lds), wv0); SEAM(sb + PH_MIXA); }
        if (RUN(sb + PH_SEL)) { if (PHM(5)) RPT(17) ph_mlstm_m2(wv0);  SEAM(sb + PH_SEL); }
        if (RUN(sb + PH_DSA)) { if (PHM(5)) RPT(18) ph_mlstm_m3(lds_launder(lds), l, wv0); if (PHM(8)) RPT(8) { ph_diff_post(l, wv0); ph_dsa_attn(lds_launder(lds), wv0); } SEAM(sb + PH_DSA); }
        if (RUN(sb + PH_OUT)) { CArgs* A = kargs();
            pg8::Gemm g{WS(bf16, WS_MIX), WS(bf16, WS_WOUT) + (size_t)l * D * D, T, D, D}; pg8::StaticOrder S; S.init(T, D, gsz_(), bid_());
            pg8::EpiBf16<0> E{WS(bf16, WS_Y), D, nullptr, 0, 0, 1.f};
            if ((RPTMASK >> 23) & 1u) pg8::gemm_phase<pg8::EpiNull, pg8::StaticOrder, true, true>(lds_launder(lds), wv0, g, S, pg8::EpiNull());
            if (PHM(9)) RPT(9) pg8::gemm_phase<pg8::EpiBf16<0>, pg8::StaticOrder, true, true>(lds_launder(lds), wv0, g, S, E);
            SEAM(sb + PH_OUT);
        }
        if (RUN(sb + PH_ROW1)) { if (PHM(10)) { if ((RPTMASK >> 10) & 1u) ph_row1(lds_launder(lds), l, wv0, true); ph_row1(lds_launder(lds), l, wv0); } SEAM(sb + PH_ROW1); }
        if (RUN(sb + PH_G1)) { CArgs* A = kargs();
            const int nrt = moe_tables(lds_launder(lds), l, wv0);
            pg8::Gemm g{WS(bf16, WS_U), (const bf16*)(WS(unsigned char, WS_W1) + (size_t)l * NEXP * 2048 * D), RPAD, NEXP * 2048, D / 2}; pg8::MoeOrder S; S.init(nrt, 8, gsz_(), bid_(), (const LAS unsigned char*)(lds_launder(lds) + TAB_OFF + 256));
            pg8::EpiSwiGLU<true> E{WS(bf16, WS_HM), A->in[I_B1] + (size_t)l * NEXP * 2048, 1.0f / 4096.0f, lds_launder(lds) + TAB_OFF + 2048};
            LAS unsigned char* tb = lds_launder(lds) + TAB_OFF;
            pg8::MoeGatherA AM{WS(unsigned, WS_XG), (const LAS unsigned*)tb, (const LAS unsigned*)(tb + 1024), (const LAS unsigned char*)(tb + 256), T, (LAS unsigned*)(tb + 4096)};
            if ((RPTMASK >> 20) & 1u) pg8::gemm_phase<pg8::EpiNull, pg8::MoeOrder, true, true, pg8::MoeGatherA, true>(lds_launder(lds), wv0, g, S, pg8::EpiNull(), AM, 0, 0);
            if ((RPTMASK >> 24) & 1u) pg8::gemm_phase<pg8::EpiSwiGLU<true>, pg8::MoeOrder, true, true, pg8::MoeGatherA, true>(lds_launder(lds), wv0, g, S, E, AM, 0, 0);
            if (PHM(12)) RPT(12) pg8::gemm_phase<pg8::EpiSwiGLU<true>, pg8::MoeOrder, true, true, pg8::MoeGatherA, true>(lds_launder(lds), wv0, g, S, E, AM, 0, 0);
            SEAM(sb + PH_G1);
        }
        if (RUN(sb + PH_G2)) { CArgs* A = kargs();
            const int nrt = (int)(*(const LAS unsigned*)(lds_launder(lds) + TAB_OFF + 4 * NEXP) >> 8);
            pg8::Gemm g{WS(bf16, WS_HM), (const bf16*)(WS(unsigned char, WS_W2) + (size_t)l * NEXP * D * D), RPAD, NEXP * D, D / 2}; pg8::MoeOrder S; S.init(nrt, 4, gsz_(), bid_(), (const LAS unsigned char*)(lds_launder(lds) + TAB_OFF + 256));
            pg8::EpiMoeOut E{WS(bf16, WS_YM), 1.0f / 2048.0f};
            if ((RPTMASK >> 21) & 1u) pg8::gemm_phase<pg8::EpiNull, pg8::MoeOrder, true, true, pg8::DirectA, true>(lds_launder(lds), wv0, g, S, pg8::EpiNull(), pg8::DirectA(), 0, 0);
            if ((RPTMASK >> 25) & 1u) pg8::gemm_phase<pg8::EpiMoeOut, pg8::MoeOrder, true, true, pg8::DirectA, true>(lds_launder(lds), wv0, g, S, E, pg8::DirectA(), 0, 0);
            if (PHM(13)) RPT(13) pg8::gemm_phase<pg8::EpiMoeOut, pg8::MoeOrder, true, true, pg8::DirectA, true>(lds_launder(lds), wv0, g, S, E, pg8::DirectA(), 0, 0);
            SEAM(sb + PH_G2);
        }
        if (RUN(sb + PH_ROW2)) { if (PHM(14)) { if ((RPTMASK >> 14) & 1u) ph_row2(lds_launder(lds), l, wv0, true); ph_row2(lds_launder(lds), l, wv0); } SEAM(sb + PH_ROW2); }
    }
#undef RUN
#undef SEAM
}

#ifndef MK_STEPS_PER_LAUNCH
#define MK_STEPS_PER_LAUNCH 1000
#endif
extern "C" void kernel_launch(void* const* d_in, const int* in_sizes, int n_in, void* d_out, int out_size, void* d_ws, size_t ws_size, hipStream_t stream) {
    static int grid = 0;
    if (grid == 0) {
        if (n_in != 25 || out_size != T * D || ws_size < WS_END4) { fprintf(stderr, "kernel_launch: unexpected shapes (n_in %d out %d ws %zu)\n", n_in, out_size, ws_size); grid = -1; return; }
        int dev = 0, cus = 0, per_cu = 0;
        if (hipGetDevice(&dev) != hipSuccess || hipDeviceGetAttribute(&cus, hipDeviceAttributeMultiprocessorCount, dev) != hipSuccess) { grid = -1; return; }
        if (hipFuncSetAttribute((const void*)mega_fwd, hipFuncAttributeMaxDynamicSharedMemorySize, LDS_BYTES) != hipSuccess) { fprintf(stderr, "kernel_launch: hipFuncSetAttribute failed\n"); grid = -1; return; }
        if (hipOccupancyMaxActiveBlocksPerMultiprocessor(&per_cu, (const void*)mega_fwd, NWAVES * 64, LDS_BYTES) != hipSuccess || per_cu < 1) { fprintf(stderr, "kernel_launch: occupancy query says %d\n", per_cu); }
        (void)hipGetLastError();
        grid = cus;
    }
    if (grid < 0) return;
    if (hipMemsetAsync((char*)d_ws + WS_CTL, 0, CTL_ZERO_BYTES, stream) != hipSuccess) return;
    Args a{};
    for (int i = 0; i < 25; ++i) a.in[i] = (const float*)d_in[i];
    a.out = (float*)d_out; a.ws = (unsigned char*)d_ws;
    int li = 0;
    for (int s = 0; s < NSTEPS; s += MK_STEPS_PER_LAUNCH, ++li) {
        a.s_lo = s; a.s_hi = (s + MK_STEPS_PER_LAUNCH < NSTEPS) ? s + MK_STEPS_PER_LAUNCH : NSTEPS; a.li = li; a.pad = 0;
        hipLaunchKernelGGL(mega_fwd, dim3(grid), dim3(NWAVES * 64), LDS_BYTES, stream, a);
    }
}
```
